# Optimizing an MI355X kernel written in HIP

```python
import jax, jax.numpy as jnp
from jax import lax
import numpy as np

D_MODEL = 1024
BATCH = 4
SEQ = 4096
DEPTH = 2

CHUNK = 64
N_META = 16
Q_BLOCK = 128
A_HEADS = 8
A_KV_HEADS = 2
A_HEAD_DIM = 64
IDX_HEADS = 8
IDX_DIM = 32
TOPK_MAX = 256
A_Q = A_HEADS * A_HEAD_DIM
A_KV = A_KV_HEADS * A_HEAD_DIM
IDX_Q = IDX_HEADS * IDX_DIM
A_COLS = A_Q + 2 * A_KV + IDX_Q + IDX_DIM + IDX_HEADS
R_HEADS = 8
R_HEAD_DIM = 64
R_WIDTH = R_HEADS * R_HEAD_DIM
W_LORA = 64
A_LORA = 64
G_LORA = 128
R_COLS = 3 * R_WIDTH + W_LORA + A_LORA + G_LORA
GN_EPS = 64e-5
GATE_COLS = 2 * D_MODEL
IN_COLS = A_COLS + R_COLS + GATE_COLS
N_EXPERTS = 16
N_GROUPS = 4
EXPERTS_PER_GROUP = N_EXPERTS // N_GROUPS
TOP_K_EXPERTS = 2
D_EXPERT = 512
LN_EPS = 1e-5
ALPHA = (2 * DEPTH) ** 0.25
BETA = (8 * DEPTH) ** -0.25

kernel_name = 'hybrid_dsa_rwkv7_grouped_moe_deepnorm'


def layer_norm(x, g, b):
    xf = x.astype(jnp.float32)
    mu = jnp.mean(xf, axis=-1, keepdims=True)
    var = jnp.mean(jnp.square(xf - mu), axis=-1, keepdims=True)
    return ((xf - mu) * lax.rsqrt(var + LN_EPS) * g.astype(jnp.float32) + b.astype(jnp.float32)).astype(x.dtype)


def split_cols(u, sizes):
    outs, off = [], 0
    for s in sizes:
        outs.append(u[..., off:off + s])
        off += s
    return outs


def chunk_ids(n):
    p = jnp.arange(n)
    return jnp.where(p < N_META, 0, 1 + (p - N_META) // CHUNK)


def dsa_attention(q, k, v, qi, ki, wi, topk):
    B, L = q.shape[0], q.shape[1]
    n_blocks = -(-L // Q_BLOCK)
    Lp = n_blocks * Q_BLOCK
    pad = Lp - L
    padq = lambda a: jnp.pad(a, [(0, 0), (0, pad)] + [(0, 0)] * (a.ndim - 2))
    q, qi, wi = padq(q), padq(qi), padq(wi)
    cid_k = chunk_ids(L)
    cid_q = chunk_ids(Lp)
    scale = A_HEAD_DIM ** -0.5
    group = A_HEADS // A_KV_HEADS
    gather = jax.vmap(lambda a, ii: a[ii])

    def block(i):
        s0 = i * Q_BLOCK
        qb = lax.dynamic_slice_in_dim(q, s0, Q_BLOCK, axis=1)
        qib = lax.dynamic_slice_in_dim(qi, s0, Q_BLOCK, axis=1)
        wib = lax.dynamic_slice_in_dim(wi, s0, Q_BLOCK, axis=1)
        cq = lax.dynamic_slice_in_dim(cid_q, s0, Q_BLOCK)
        rel = jax.nn.relu(jnp.einsum('bqhd,bsd->bqhs', qib, ki)).astype(jnp.float32)
        idx_score = jnp.einsum('bqh,bqhs->bqs', wib.astype(jnp.float32), rel)
        admissible = cid_k[None, :] <= cq[:, None]
        idx_score = jnp.where(admissible[None], idx_score, -jnp.inf)
        _, sel = lax.top_k(idx_score, topk)
        ks = gather(k, sel)
        vs = gather(v, sel)
        valid = cid_k[sel] <= cq[None, :, None]
        qg = qb.reshape(B, Q_BLOCK, A_KV_HEADS, group, A_HEAD_DIM)
        s = jnp.einsum('bqngd,bqknd->bqngk', qg, ks).astype(jnp.float32) * scale
        s = jnp.where(valid[:, :, None, None, :], s, -jnp.inf)
        p = jax.nn.softmax(s, axis=-1).astype(vs.dtype)
        o = jnp.einsum('bqngk,bqknd->bqngd', p, vs)
        return o.reshape(B, Q_BLOCK, A_Q)

    out = lax.map(block, jnp.arange(n_blocks))
    out = jnp.moveaxis(out, 0, 1).reshape(B, Lp, A_Q)
    return out[:, :L]


def rwkv7_time_mix(u, mu, w0, w_up, a0, a_up, g_up, k_k, k_a, r_k, gn_g, gn_b):
    B, L, _ = u.shape
    dt = u.dtype
    u = u.astype(jnp.float32)
    u_prev = jnp.pad(u, ((0, 0), (1, 0), (0, 0)))[:, :-1]
    u = u + (u_prev - u) * mu.astype(jnp.float32)
    r, k, v, xw, xa, xg = split_cols(u, [R_WIDTH, R_WIDTH, R_WIDTH, W_LORA, A_LORA, G_LORA])
    f32 = lambda t: t.astype(jnp.float32)
    logw = -jax.nn.softplus(-(f32(w0) + jnp.tanh(xw) @ f32(w_up))) - 0.5
    decay = jnp.exp(-jnp.exp(logw))
    a = jax.nn.sigmoid(f32(a0) + xa @ f32(a_up))
    g = jax.nn.sigmoid(xg) @ f32(g_up)
    hd = lambda t: t.reshape(B, L, R_HEADS, R_HEAD_DIM)
    kk = hd(k * f32(k_k))
    kk = kk * lax.rsqrt(jnp.maximum(jnp.sum(kk * kk, axis=-1, keepdims=True), 1e-24))
    k = k * (1.0 + (a - 1.0) * f32(k_a))
    rh, kh, vh, wh, ah = hd(r), hd(k), hd(v), hd(decay), hd(a)

    def step(S, inp):
        r_t, w_t, kk_t, a_t, v_t, k_t = inp
        sa = jnp.einsum('bhvk,bhk->bhv', S, -kk_t)
        S = S * w_t[:, :, None, :] + sa[..., None] * (kk_t * a_t)[:, :, None, :] + v_t[..., None] * k_t[:, :, None, :]
        y = jnp.einsum('bhvk,bhk->bhv', S, r_t)
        return S, y

    xs = tuple(jnp.moveaxis(t, 1, 0) for t in (rh, wh, kk, ah, vh, kh))
    S0 = jnp.zeros((B, R_HEADS, R_HEAD_DIM, R_HEAD_DIM), jnp.float32)
    _, y = lax.scan(step, S0, xs)
    y = jnp.moveaxis(y, 0, 1)
    m = jnp.mean(y, axis=-1, keepdims=True)
    var = jnp.mean(jnp.square(y - m), axis=-1, keepdims=True)
    y = ((y - m) * lax.rsqrt(var + GN_EPS)).reshape(B, L, R_WIDTH) * f32(gn_g) + f32(gn_b)
    bonus = (jnp.sum(rh * kh * f32(r_k), axis=-1, keepdims=True) * vh).reshape(B, L, R_WIDTH)
    return ((y + bonus) * g).astype(dt)


def token_mixers(h, w_in, b_gate, mu, w0, w_up, a0, a_up, g_up, k_k, k_a, r_k, gn_g, gn_b, w_branch_a, w_branch_b, w_out, topk):
    B, L, _ = h.shape
    u = h @ w_in
    ua, ur, ug = split_cols(u, [A_COLS, R_COLS, GATE_COLS])
    q, k, v, qi, ki, wi = split_cols(ua, [A_Q, A_KV, A_KV, IDX_Q, IDX_DIM, IDX_HEADS])
    o_a = dsa_attention(q.reshape(B, L, A_HEADS, A_HEAD_DIM), k.reshape(B, L, A_KV_HEADS, A_HEAD_DIM),
                        v.reshape(B, L, A_KV_HEADS, A_HEAD_DIM), qi.reshape(B, L, IDX_HEADS, IDX_DIM), ki, wi, topk)
    o_b = rwkv7_time_mix(ur, mu, w0, w_up, a0, a_up, g_up, k_k, k_a, r_k, gn_g, gn_b)
    gates = jax.nn.sigmoid((ug + b_gate).astype(jnp.float32)).astype(h.dtype)
    g_a, g_b = split_cols(gates, [D_MODEL, D_MODEL])
    merged = g_a * (o_a @ w_branch_a) + g_b * (o_b @ w_branch_b)
    return merged @ w_out


def grouped_moe(h, w_router, b_router, w1, w3, w2):
    B, L, D = h.shape
    x = h.reshape(B * L, D)
    T = x.shape[0]
    s = jax.nn.sigmoid((x @ w_router).astype(jnp.float32))
    sel = s + b_router.astype(jnp.float32)
    sg = sel.reshape(T, N_GROUPS, EXPERTS_PER_GROUP)
    group_score = jnp.sum(lax.top_k(sg, TOP_K_EXPERTS)[0], axis=-1)
    g_star = jnp.argmax(group_score, axis=-1)
    in_group = sg[jnp.arange(T), g_star]
    _, j = lax.top_k(in_group, TOP_K_EXPERTS)
    experts = g_star[:, None] * EXPERTS_PER_GROUP + j
    gate = jnp.take_along_axis(s, experts, axis=-1)
    gate = gate / jnp.sum(gate, axis=-1, keepdims=True)
    combine = jnp.sum(jax.nn.one_hot(experts, N_EXPERTS, dtype=jnp.float32) * gate[..., None], axis=1).astype(x.dtype)
    y = jnp.zeros_like(x)
    for e in range(N_EXPERTS):
        he = (jax.nn.silu(x @ w1[e]) * (x @ w3[e])) @ w2[e]
        y = y + combine[:, e:e + 1] * he
    return y.reshape(B, L, D)


def setup_inputs(seed: int = 0) -> dict:
    key = jax.random.key(seed)
    ks = jax.random.split(key, 32)
    nrm = lambda k, shape, s: jax.random.normal(k, shape, jnp.float32) * s
    uni = lambda k, shape, lo, hi: jax.random.uniform(k, shape, jnp.float32, lo, hi)
    return {
        'x': nrm(ks[0], (BATCH, SEQ, D_MODEL), 1.0),
        'meta_tokens': nrm(ks[1], (N_META, D_MODEL), 1.0),
        'ln_in_g': 1.0 + nrm(ks[2], (D_MODEL,), 0.02),
        'ln_in_b': nrm(ks[3], (D_MODEL,), 0.02),
        'w_in': nrm(ks[4], (DEPTH, D_MODEL, IN_COLS), D_MODEL ** -0.5),
        'b_gate': nrm(ks[5], (DEPTH, GATE_COLS), 0.02),
        'rwkv_mu': uni(ks[6], (DEPTH, R_COLS), 0.0, 1.0),
        'rwkv_w0': uni(ks[7], (DEPTH, R_WIDTH), -6.0, 1.0),
        'rwkv_w_up': nrm(ks[8], (DEPTH, W_LORA, R_WIDTH), 0.1),
        'rwkv_a0': nrm(ks[9], (DEPTH, R_WIDTH), 0.5),
        'rwkv_a_up': nrm(ks[10], (DEPTH, A_LORA, R_WIDTH), 0.5 * A_LORA ** -0.5),
        'rwkv_g_up': nrm(ks[11], (DEPTH, G_LORA, R_WIDTH), G_LORA ** -0.5),
        'rwkv_k_k': 0.85 + nrm(ks[12], (DEPTH, R_WIDTH), 0.05),
        'rwkv_k_a': 1.0 + nrm(ks[13], (DEPTH, R_WIDTH), 0.05),
        'rwkv_r_k': nrm(ks[14], (DEPTH, R_HEADS, R_HEAD_DIM), 0.1),
        'rwkv_gn_g': 1.0 + nrm(ks[15], (DEPTH, R_WIDTH), 0.02),
        'rwkv_gn_b': nrm(ks[16], (DEPTH, R_WIDTH), 0.02),
        'w_branch_a': nrm(ks[17], (DEPTH, A_Q, D_MODEL), BETA * A_Q ** -0.5),
        'w_branch_b': nrm(ks[18], (DEPTH, R_WIDTH, D_MODEL), BETA * R_WIDTH ** -0.5),
        'w_out': nrm(ks[19], (DEPTH, D_MODEL, D_MODEL), BETA * D_MODEL ** -0.5),
        'ln1_g': 1.0 + nrm(ks[20], (DEPTH, D_MODEL), 0.02),
        'ln1_b': nrm(ks[21], (DEPTH, D_MODEL), 0.02),
        'ln2_g': 1.0 + nrm(ks[22], (DEPTH, D_MODEL), 0.02),
        'ln2_b': nrm(ks[23], (DEPTH, D_MODEL), 0.02),
        'w_router': nrm(ks[24], (D_MODEL, N_EXPERTS), D_MODEL ** -0.5),
        'b_router': nrm(ks[25], (N_EXPERTS,), 0.01),
        'w_exp1': nrm(ks[26], (DEPTH, N_EXPERTS, D_MODEL, D_EXPERT), D_MODEL ** -0.5),
        'w_exp3': nrm(ks[27], (DEPTH, N_EXPERTS, D_MODEL, D_EXPERT), D_MODEL ** -0.5),
        'w_exp2': nrm(ks[28], (DEPTH, N_EXPERTS, D_EXPERT, D_MODEL), BETA * D_EXPERT ** -0.5),
    }


def reference(x, meta_tokens, ln_in_g, ln_in_b, w_in, b_gate, rwkv_mu, rwkv_w0, rwkv_w_up, rwkv_a0, rwkv_a_up,
              rwkv_g_up, rwkv_k_k, rwkv_k_a, rwkv_r_k, rwkv_gn_g, rwkv_gn_b, w_branch_a, w_branch_b, w_out,
              ln1_g, ln1_b, ln2_g, ln2_b, w_router, b_router, w_exp1, w_exp3, w_exp2):
    B, S, D = x.shape
    topk = min(TOPK_MAX, S // 4)
    meta = jnp.broadcast_to(meta_tokens[None].astype(x.dtype), (B, N_META, D))
    h = layer_norm(jnp.concatenate([meta, x], axis=1), ln_in_g, ln_in_b)
    for l in range(DEPTH):
        mix = token_mixers(h, w_in[l], b_gate[l], rwkv_mu[l], rwkv_w0[l], rwkv_w_up[l], rwkv_a0[l], rwkv_a_up[l],
                           rwkv_g_up[l], rwkv_k_k[l], rwkv_k_a[l], rwkv_r_k[l], rwkv_gn_g[l], rwkv_gn_b[l],
                           w_branch_a[l], w_branch_b[l], w_out[l], topk)
        h = layer_norm(ALPHA * h + mix, ln1_g[l], ln1_b[l])
        ffn = grouped_moe(h, w_router, b_router, w_exp1[l], w_exp3[l], w_exp2[l])
        h = layer_norm(ALPHA * h + ffn, ln2_g[l], ln2_b[l])
    return h[:, N_META:]
```

```cpp
#include <hip/hip_runtime.h>
#include <hip/hip_cooperative_groups.h>
#include <cstdio>
#include <cstdint>
namespace cg = cooperative_groups;

#define LAS __attribute__((address_space(3)))
typedef unsigned short bf16_t;
typedef short bf16x8 __attribute__((ext_vector_type(8)));
typedef float f32x4 __attribute__((ext_vector_type(4)));
typedef float f32x2 __attribute__((ext_vector_type(2)));
typedef unsigned u32x4 __attribute__((ext_vector_type(4)));
typedef unsigned u32x2 __attribute__((ext_vector_type(2)));

constexpr int NTHREADS = 512, NWAVES = 8;
constexpr int D = 1024, BATCH = 4, SEQ = 4096, DEPTH = 2;
constexpr int LP = 4160;
constexpr int T = BATCH * LP;
constexpr int NCH = LP / 64;
constexpr int PADM = 48;
constexpr int A_COLS = 1064, R_COLS = 1792, IN_COLS = 4904;
constexpr int UA = 1280;
constexpr int UARW = 3072;
constexpr int NIN = 5120;
constexpr float LN_EPS = 1e-5f, GN_EPS = 64e-5f;
constexpr float ALPHA = 1.41421356237309515f;
constexpr int C_Q = 0, C_K = 512, C_V = 640, C_QI = 768, C_KI = 1024, C_WI = 1056;
constexpr int C_R = UA, C_RK = UA + 512, C_RV = UA + 1024, C_XW = UA + 1536, C_XA = UA + 1600, C_XG = UA + 1664;

constexpr size_t MiB = 1u << 20;
constexpr size_t WS_CTL = 0;
constexpr size_t WS_HM = 1 * MiB;
constexpr size_t WS_WSMALL = 2 * MiB;
constexpr size_t WSMALL_LAYER = 14 * MiB;
constexpr size_t WS_HB = 30 * MiB;
constexpr size_t WS_UAR = 63 * MiB;
constexpr size_t WS_GATES = 161 * MiB;
constexpr size_t WS_OAB = 226 * MiB;
constexpr size_t WS_LIST = 259 * MiB;
constexpr size_t WS_END = 262 * MiB;
constexpr size_t WS_MERGED = WS_UAR;
constexpr size_t WS_ACT = WS_UAR + 33 * MiB;
constexpr size_t WS_WEXP = WS_GATES;
constexpr int ACT_ROWS_MAX = 16448 + 24 * 256;
static_assert(WS_ACT + (size_t)ACT_ROWS_MAX * 2048 <= WS_GATES, "act fits");
constexpr int CW_CLS = 64;

constexpr int LDS_BYTES = 155648;

struct Params {
    const float* in[29];
    float* out;
    unsigned char* ws;
};
enum { I_X = 0, I_META, I_LNIN_G, I_LNIN_B, I_WIN, I_BGATE, I_MU, I_W0, I_WUP, I_A0, I_AUP, I_GUP, I_KK, I_KA, I_RK, I_GNG, I_GNB,
       I_WBA, I_WBB, I_WOUT, I_LN1G, I_LN1B, I_LN2G, I_LN2B, I_WROUTER, I_BROUTER, I_WEXP1, I_WEXP3, I_WEXP2 };

__device__ __forceinline__ int otid() { int t = threadIdx.x; asm volatile("" : "+v"(t)); return t; }
__device__ __forceinline__ int obid() { int b = blockIdx.x; asm volatile("" : "+s"(b)); return b; }
__device__ __forceinline__ unsigned f2bf(float f) { unsigned u = __builtin_bit_cast(unsigned, f); return (u + 0x7fffu + ((u >> 16) & 1u)) >> 16; }
__device__ __forceinline__ unsigned pk2(float lo, float hi) { return f2bf(lo) | (f2bf(hi) << 16); }
__device__ __forceinline__ float bf2f(unsigned short b) { return __builtin_bit_cast(float, (unsigned)b << 16); }
__device__ __forceinline__ float bflo(unsigned w) { return __builtin_bit_cast(float, w << 16); }
__device__ __forceinline__ float bfhi(unsigned w) { return __builtin_bit_cast(float, w & 0xffff0000u); }
__device__ __forceinline__ float wave_sum(float v) {
#pragma unroll
    for (int o = 1; o < 64; o <<= 1) v += __shfl_xor(v, o);
    return v;
}
__device__ __forceinline__ float wave_max(float v) {
#pragma unroll
    for (int o = 1; o < 64; o <<= 1) v = fmaxf(v, __shfl_xor(v, o));
    return v;
}
__device__ __forceinline__ float sigmoidf_(float x) { return 1.0f / (1.0f + __expf(-x)); }
__device__ __forceinline__ float* hrow(const Params& p, int r) {
    const int b = r / LP, pos = r - b * LP;
    return pos >= 64 ? p.out + ((size_t)(b * SEQ + (pos - 64)) << 10) : (float*)(p.ws + WS_HM) + ((size_t)(b * 64 + pos) << 10);
}
__device__ __forceinline__ bool is_dummy(int r) { return (r % LP) < PADM; }

__device__ __forceinline__ void transpose_item(const float* src, int ld_src, int col0, int nvalid, bf16_t* dst  , int ld_dst, LAS float* scr, int lane) {
    const int c = lane & 31;
#pragma unroll 8
    for (int i = 0; i < 32; ++i) { const int kk = 2 * i + (lane >> 5); scr[kk * 33 + c] = c < nvalid ? src[(size_t)kk * ld_src + col0 + c] : 0.f; }
    asm volatile("s_waitcnt lgkmcnt(0)" ::: "memory");
    const int ch = lane & 7;
#pragma unroll
    for (int j = 0; j < 4; ++j) { const int n = (lane >> 3) + 8 * j; const LAS float* s = scr + (8 * ch) * 33 + n;
        u32x4 o; o.x = pk2(s[0 * 33], s[1 * 33]); o.y = pk2(s[2 * 33], s[3 * 33]); o.z = pk2(s[4 * 33], s[5 * 33]); o.w = pk2(s[6 * 33], s[7 * 33]);
        *(u32x4*)(dst + (size_t)n * ld_dst + 8 * ch) = o; }
    asm volatile("s_waitcnt lgkmcnt(0)" ::: "memory");
}

namespace g8 {
constexpr int BM = 256, BK = 64, HALF = 128, HTB = HALF * BK * 2, STAGE_BYTES = 8 * HTB;
__host__ __device__ __forceinline__ int lds_byte(int r, int c) { const int st = (r >> 4) * 2 + (c >> 5), rr = r & 15, cc = c & 31, ob = rr * 64 + cc * 2; return st * 1024 + (ob ^ (((ob >> 9) & 1) << 5)); }
__host__ __device__ __forceinline__ void stage_rc(int b, int& R, int& C) { const int st = b / 1024, sb = b % 1024, swz = sb ^ (((sb >> 9) & 1) << 5); R = (st >> 1) * 16 + swz / 64; C = (st & 1) * 32 + (swz % 64) / 2; }
__host__ __device__ __forceinline__ int perm32(int rho) { const int n = rho >> 4, i = rho & 15; return 8 * (i >> 2) + 4 * n + (i & 3); }

struct KSeg {
    const char* A;
    const char* B0;
    const char* B1;
    int nt;
    int nt0;
    const char* A2;
    const char* B02;
    const char* B12;
};
__device__ __forceinline__ KSeg seg1(const char* A, const char* B0, const char* B1, int nt) { KSeg s; s.A = A; s.B0 = B0; s.B1 = B1; s.nt = nt; s.nt0 = nt; s.A2 = A; s.B02 = B0; s.B12 = B1; return s; }
typedef f32x4 Acc[2][2][4][2];

template <bool GATHER, bool TWOSEG>
__device__ __forceinline__ void kloop(LAS unsigned char* lds, Acc& acc, const KSeg s, const unsigned (&voffA)[2][2], const unsigned (&voffB)[2], const unsigned hstepA) {
    int tid = threadIdx.x; asm volatile("" : "+v"(tid));
    const int wid = __builtin_amdgcn_readfirstlane(tid >> 6), lane = tid & 63, wr = wid >> 2, wc = wid & 3, fr = lane & 15, fq = lane >> 4;
    const unsigned ldsw = (unsigned)wid * 1024u;
    const int aoff = lds_byte(wr * 64 + fr, fq * 8), boff = lds_byte(wc * 32 + fr, fq * 8);
    const int nt = s.nt;
#define G8_SA(b, h) (((b) * 2 + (h)) * HTB)
#define G8_SB(b, h) ((4 + (b) * 2 + (h)) * HTB)
#define G8_STAGE(bufoff, gbase, voff) do { _Pragma("unroll") for (int _i = 0; _i < 2; ++_i) \
        __builtin_amdgcn_global_load_lds((const unsigned*)((const char*)(gbase) + (voff)[_i]), (LAS unsigned*)(lds + (bufoff) + ldsw + _i * 8192), 16, 0, 0); } while (0)
#define G8_LDA(dst, b, h) do { _Pragma("unroll") for (int m = 0; m < 4; ++m) _Pragma("unroll") for (int k = 0; k < 2; ++k) dst[m][k] = *(const LAS bf16x8*)(lds + G8_SA(b, h) + aoff + m * 2048 + k * 1024); } while (0)
#define G8_LDB(dst, b, h) do { _Pragma("unroll") for (int n = 0; n < 2; ++n) _Pragma("unroll") for (int k = 0; k < 2; ++k) dst[n][k] = *(const LAS bf16x8*)(lds + G8_SB(b, h) + boff + n * 2048 + k * 1024); } while (0)
#define G8_MMA(ai, bj, At, Bt) do { __builtin_amdgcn_s_setprio(1); _Pragma("unroll") for (int m = 0; m < 4; ++m) _Pragma("unroll") for (int n = 0; n < 2; ++n) _Pragma("unroll") for (int k = 0; k < 2; ++k) \
        acc[ai][bj][m][n] = __builtin_amdgcn_mfma_f32_16x16x32_bf16(Bt[n][k], At[m][k], acc[ai][bj][m][n], 0, 0, 0); __builtin_amdgcn_s_setprio(0); } while (0)
#define G8_WAIT_V(n) asm volatile("s_waitcnt vmcnt(" #n ")" ::: "memory")
#define G8_WAIT_L(n) asm volatile("s_waitcnt lgkmcnt(" #n ")" ::: "memory")
#define G8_BAR __builtin_amdgcn_s_barrier()
#define G8_SCHED __builtin_amdgcn_sched_barrier(0)
    bf16x8 At[4][2], B0[2][2], B1[2][2];
    const char* pA = s.A; const char* pB0 = s.B0; const char* pB1 = s.B1;
    constexpr int KS = BK * 2;
    const int nt0 = TWOSEG ? s.nt0 : 0; const char* qA = TWOSEG ? s.A2 - (size_t)nt0 * KS : pA; const char* qB0 = TWOSEG ? s.B02 - (size_t)nt0 * KS : pB0; const char* qB1 = TWOSEG ? s.B12 - (size_t)nt0 * KS : pB1;
#define G8_TA(t) ((TWOSEG ? ((t) < nt0 ? pA : qA) : pA) + (size_t)(t) * KS)
#define G8_TB0(t) ((TWOSEG ? ((t) < nt0 ? pB0 : qB0) : pB0) + (size_t)(t) * KS)
#define G8_TB1(t) ((TWOSEG ? ((t) < nt0 ? pB1 : qB1) : pB1) + (size_t)(t) * KS)
#define G8_VA1 voffA[GATHER ? 1 : 0]
#define G8_H1(ptr) ((ptr) + (GATHER ? 0u : hstepA))
    G8_STAGE(G8_SB(0, 0), pB0, voffB); G8_STAGE(G8_SA(0, 0), pA, voffA[0]); G8_STAGE(G8_SB(0, 1), pB1, voffB); G8_STAGE(G8_SA(0, 1), G8_H1(pA), G8_VA1);
    if (wr == 1) G8_BAR;
    G8_WAIT_V(4); G8_BAR;
    G8_STAGE(G8_SB(1, 0), pB0 + KS, voffB); G8_STAGE(G8_SA(1, 0), pA + KS, voffA[0]); G8_STAGE(G8_SB(1, 1), pB1 + KS, voffB);
    G8_WAIT_V(6); G8_BAR;
    for (int t = 0; t < nt - 2; t += 2) {
        const char* a1 = G8_TA(t + 1);
        const char* a2 = G8_TA(t + 2); const char* b02 = G8_TB0(t + 2); const char* b12 = G8_TB1(t + 2);
        const char* a3 = G8_TA(t + 3); const char* b03 = G8_TB0(t + 3); const char* b13 = G8_TB1(t + 3);
        G8_LDB(B0, 0, 0); G8_SCHED; G8_LDA(At, 0, 0); G8_STAGE(G8_SA(1, 1), G8_H1(a1), G8_VA1);
        G8_WAIT_L(8); G8_BAR; G8_WAIT_L(0); G8_MMA(0, 0, At, B0); G8_BAR; G8_SCHED;
        G8_LDB(B1, 0, 1); G8_STAGE(G8_SB(0, 0), b02, voffB);
        G8_BAR; G8_WAIT_L(0); G8_MMA(0, 1, At, B1); G8_BAR;
        G8_LDA(At, 0, 1); G8_STAGE(G8_SA(0, 0), a2, voffA[0]);
        G8_BAR; G8_WAIT_L(0); G8_MMA(1, 0, At, B0); G8_BAR; G8_SCHED;
        G8_STAGE(G8_SB(0, 1), b12, voffB);
        G8_WAIT_V(6); G8_BAR; G8_MMA(1, 1, At, B1); G8_BAR;
        G8_LDB(B0, 1, 0); G8_SCHED; G8_LDA(At, 1, 0); G8_STAGE(G8_SA(0, 1), G8_H1(a2), G8_VA1);
        G8_WAIT_L(8); G8_BAR; G8_WAIT_L(0); G8_MMA(0, 0, At, B0); G8_BAR; G8_SCHED;
        G8_LDB(B1, 1, 1); G8_STAGE(G8_SB(1, 0), b03, voffB);
        G8_BAR; G8_WAIT_L(0); G8_MMA(0, 1, At, B1); G8_BAR;
        G8_LDA(At, 1, 1); G8_STAGE(G8_SA(1, 0), a3, voffA[0]);
        G8_BAR; G8_WAIT_L(0); G8_MMA(1, 0, At, B0); G8_BAR; G8_SCHED;
        G8_STAGE(G8_SB(1, 1), b13, voffB);
        G8_WAIT_V(6); G8_BAR; G8_MMA(1, 1, At, B1); G8_BAR;
    }
    { const char* a1 = G8_TA(nt - 1);
      G8_LDB(B0, 0, 0); G8_LDA(At, 0, 0); G8_STAGE(G8_SA(1, 1), G8_H1(a1), G8_VA1);
      G8_BAR; G8_WAIT_L(0); G8_MMA(0, 0, At, B0); G8_BAR;
      G8_LDB(B1, 0, 1); G8_BAR; G8_WAIT_L(0); G8_MMA(0, 1, At, B1); G8_BAR;
      G8_LDA(At, 0, 1); G8_WAIT_V(4); G8_BAR; G8_WAIT_L(0); G8_MMA(1, 0, At, B0); G8_MMA(1, 1, At, B1); G8_BAR; }
    { G8_LDB(B0, 1, 0); G8_LDA(At, 1, 0); G8_WAIT_V(2); G8_BAR; G8_WAIT_L(0); G8_MMA(0, 0, At, B0); G8_BAR;
      G8_LDB(B1, 1, 1); G8_WAIT_V(0); G8_BAR; G8_WAIT_L(0); G8_MMA(0, 1, At, B1); G8_BAR;
      G8_LDA(At, 1, 1); G8_BAR; G8_WAIT_L(0); G8_MMA(1, 0, At, B0); G8_MMA(1, 1, At, B1); G8_BAR; }
    if (wr == 0) G8_BAR;
#undef G8_TA
#undef G8_VA1
#undef G8_H1
#undef G8_TB0
#undef G8_TB1
#undef G8_SA
#undef G8_SB
#undef G8_STAGE
#undef G8_LDA
#undef G8_LDB
#undef G8_MMA
#undef G8_WAIT_V
#undef G8_WAIT_L
#undef G8_BAR
#undef G8_SCHED
}
__device__ __forceinline__ void zero_acc(Acc& acc) {
#pragma unroll
    for (int a = 0; a < 2; ++a)
#pragma unroll
        for (int b = 0; b < 2; ++b)
#pragma unroll
            for (int m = 0; m < 4; ++m)
#pragma unroll
                for (int n = 0; n < 2; ++n) acc[a][b][m][n] = (f32x4){0.f, 0.f, 0.f, 0.f};
}
__device__ __forceinline__ void make_voff_contig(unsigned (&voffA)[2][2], unsigned pitchA) {
    int tid = threadIdx.x; asm volatile("" : "+v"(tid));
#pragma unroll
    for (int i = 0; i < 2; ++i) { int R, C; stage_rc(tid * 16 + i * 8192, R, C);
        voffA[0][i] = (unsigned)R * pitchA + (unsigned)C * 2u; voffA[1][i] = 0u; }
}
__device__ __forceinline__ void make_voffB(unsigned (&voffB)[2], unsigned pitchB, bool perm) {
    int tid = threadIdx.x; asm volatile("" : "+v"(tid));
#pragma unroll
    for (int i = 0; i < 2; ++i) { int R, C; stage_rc(tid * 16 + i * 8192, R, C); const int Rb = perm ? ((R & ~31) + perm32(R & 31)) : R;
        voffB[i] = (unsigned)Rb * pitchB + (unsigned)C * 2u; }
}
}

__device__ __forceinline__ bool unit_order(int i, int G, int c, int nM, int nN, int& pm, int& pn) {
    const int nwg = nM * nN; const long L = (long)i * G + c; if (L >= nwg) return false;
    int wgid = (int)L; { const int q = nwg / 8, r = nwg % 8, xcd = wgid % 8, off = wgid / 8; wgid = (xcd < r ? xcd * (q + 1) : r * (q + 1) + (xcd - r) * q) + off; }
    const int WGM = 8, nig = WGM * nN, gid = wgid / nig, fm = gid * WGM, gsz = (nM - fm) < WGM ? (nM - fm) : WGM;
    pm = fm + ((wgid % nig) % gsz); pn = (wgid % nig) / gsz; return true;
}

__device__ __forceinline__ void conv_small_weights(const Params& p, LAS unsigned char* lds) {
    const int tid = otid(), lane = tid & 63, wave = tid >> 6, gw = obid() * NWAVES + wave, NGW = gridDim.x * NWAVES;
    LAS float* scr = (LAS float*)(lds + wave * 16384);
    constexpr int I_IN = 16 * (NIN / 32), I_A = 8 * 32, I_O = 16 * 32, PER = I_IN + 2 * I_A + I_O;
    for (int it = gw; it < DEPTH * PER; it += NGW) {
        const int l = it / PER; int r = it % PER;
        unsigned char* wl = p.ws + WS_WSMALL + (size_t)l * WSMALL_LAYER;
        if (r < I_IN) { const int kb = r / (NIN / 32), nb = r % (NIN / 32), n0 = nb * 32, k0 = kb * 64;
            int col0, nvalid; if (n0 < UA) { col0 = n0; nvalid = A_COLS - n0; nvalid = nvalid < 0 ? 0 : (nvalid > 32 ? 32 : nvalid); } else { col0 = n0 - (UA - A_COLS); nvalid = 32; }
            transpose_item(p.in[I_WIN] + (size_t)l * D * IN_COLS + (size_t)k0 * IN_COLS, IN_COLS, col0, nvalid, (bf16_t*)wl + (size_t)n0 * D + k0, D, scr, lane); continue; }
        r -= I_IN;
        if (r < 2 * I_A) { const int which = r / I_A; r %= I_A; const int kb = r / 32, nb = r % 32;
            const float* src = p.in[which ? I_WBB : I_WBA] + (size_t)l * 512 * D + (size_t)(kb * 64) * D;
            transpose_item(src, D, nb * 32, 32, (bf16_t*)(wl + (10 + which) * MiB) + (size_t)(nb * 32) * 512 + kb * 64, 512, scr, lane); continue; }
        r -= 2 * I_A;
        { const int kb = r / 32, nb = r % 32;
          transpose_item(p.in[I_WOUT] + (size_t)l * D * D + (size_t)(kb * 64) * D, D, nb * 32, 32, (bf16_t*)(wl + 12 * MiB) + (size_t)(nb * 32) * D + kb * 64, D, scr, lane); }
    }
}
__device__ __forceinline__ void conv_expert_weights(const Params& p, int l, LAS unsigned char* lds) {
    const int tid = otid(), lane = tid & 63, wave = tid >> 6, gw = obid() * NWAVES + wave, NGW = gridDim.x * NWAVES;
    LAS float* scr = (LAS float*)(lds + wave * 16384);
    constexpr int I_13 = 16 * 32, I_2 = 8 * 32, PER = I_13 + I_2;
    for (int it = gw; it < 16 * PER; it += NGW) {
        const int e = it / PER; int r = it % PER;
        if (r < I_13) { const int kb = r / 32, nb = r % 32, n0 = nb * 32, j = n0 >> 8, half = (n0 >> 7) & 1, c = 128 * j + (n0 & 127);
            const float* src = p.in[half ? I_WEXP3 : I_WEXP1] + (size_t)(l * 16 + e) * D * 512 + (size_t)(kb * 64) * 512;
            transpose_item(src, 512, c, 32, (bf16_t*)(p.ws + WS_WEXP) + (size_t)e * 1024 * 1024 + (size_t)n0 * 1024 + kb * 64, 1024, scr, lane); continue; }
        r -= I_13;
        { const int kb = r / 32, nb = r % 32;
          const float* src = p.in[I_WEXP2] + (size_t)(l * 16 + e) * 512 * D + (size_t)(kb * 64) * D;
          transpose_item(src, D, nb * 32, 32, (bf16_t*)(p.ws + WS_WEXP + 32 * MiB) + (size_t)e * 1024 * 512 + (size_t)(nb * 32) * 512 + kb * 64, 512, scr, lane); }
    }
}

__device__ __forceinline__ void ln_wave(f32x4 (&v)[4], const float* g, const float* bta, int lane) {
    float s = 0.f;
#pragma unroll
    for (int j = 0; j < 4; ++j) s += (v[j][0] + v[j][1]) + (v[j][2] + v[j][3]);
    const float mean = wave_sum(s) * (1.f / D); float s2 = 0.f;
#pragma unroll
    for (int j = 0; j < 4; ++j) { v[j] = v[j] - mean; s2 += (v[j][0] * v[j][0] + v[j][1] * v[j][1]) + (v[j][2] * v[j][2] + v[j][3] * v[j][3]); }
    const float rstd = 1.f / sqrtf(wave_sum(s2) * (1.f / D) + LN_EPS);
#pragma unroll
    for (int j = 0; j < 4; ++j) { const f32x4 gg = *(const f32x4*)(g + 4 * lane + 256 * j), bb = *(const f32x4*)(bta + 4 * lane + 256 * j); v[j] = v[j] * rstd * gg + bb; }
}
__device__ __forceinline__ void store_row(const Params& p, int r, const f32x4 (&v)[4], int lane, bool zero) {
    float* hr = hrow(p, r); bf16_t* hb = (bf16_t*)(p.ws + WS_HB) + (size_t)r * D;
#pragma unroll
    for (int j = 0; j < 4; ++j) { const f32x4 o = zero ? (f32x4){0.f, 0.f, 0.f, 0.f} : v[j];
        *(f32x4*)(hr + 4 * lane + 256 * j) = o; u32x2 w; w.x = pk2(o[0], o[1]); w.y = pk2(o[2], o[3]); *(u32x2*)(hb + 4 * lane + 256 * j) = w; }
}
__device__ __forceinline__ void ln_in_phase(const Params& p) {
    const int tid = otid(), lane = tid & 63, gw = obid() * NWAVES + (tid >> 6), NGW = gridDim.x * NWAVES;
    for (int r = gw; r < T; r += NGW) {
        const int b = r / LP, pos = r - b * LP; f32x4 v[4];
        if (pos < PADM) {
#pragma unroll
            for (int j = 0; j < 4; ++j) v[j] = (f32x4){0.f, 0.f, 0.f, 0.f};
            store_row(p, r, v, lane, true); continue; }
        const float* src = pos < 64 ? p.in[I_META] + (size_t)(pos - PADM) * D : p.in[I_X] + ((size_t)(b * SEQ + pos - 64) << 10);
#pragma unroll
        for (int j = 0; j < 4; ++j) v[j] = *(const f32x4*)(src + 4 * lane + 256 * j);
        ln_wave(v, p.in[I_LNIN_G], p.in[I_LNIN_B], lane);
        store_row(p, r, v, lane, false);
    }
}

#define EPI_COORDS() int tid_ = threadIdx.x; asm volatile("" : "+v"(tid_)); const int wid = tid_ >> 6, lane = tid_ & 63, wr = wid >> 2, wc = wid & 3, fr = lane & 15, fq = lane >> 4; (void)wr; (void)wc; (void)fr; (void)fq
__device__ __forceinline__ void inproj_phase(const Params& p, int l, LAS unsigned char* lds) {
    unsigned voffA[2][2], voffB[2]; g8::make_voff_contig(voffA, D * 2); g8::make_voffB(voffB, D * 2, true);
    const char* Ab = (const char*)(p.ws + WS_HB); const char* Bb = (const char*)(p.ws + WS_WSMALL + (size_t)l * WSMALL_LAYER);
    const float* bg = p.in[I_BGATE] + l * 2048;
    int pm, pn; const int bid = obid();
    for (int i = 0; unit_order(i, gridDim.x, bid, T / 256, NIN / 256, pm, pn); ++i) {
        g8::Acc acc; g8::zero_acc(acc);
        const g8::KSeg s = g8::seg1(Ab + (size_t)pm * 256 * D * 2, Bb + (size_t)pn * 256 * D * 2, Bb + (size_t)(pn * 256 + 128) * D * 2, D / 64);
        g8::kloop<false, false>(lds, acc, s, voffA, voffB, 128 * D * 2);
        EPI_COORDS();
        const int row0 = pm * 256 + wr * 64 + fr;
        if (pn < 12) {
            bf16_t* O = (bf16_t*)(p.ws + WS_UAR);
#pragma unroll
            for (int ai = 0; ai < 2; ++ai)
#pragma unroll
                for (int m = 0; m < 4; ++m) { asm volatile("" ::: "memory"); bf16_t* rp = O + (size_t)(row0 + ai * 128 + m * 16) * UARW + pn * 256 + wc * 32 + 8 * fq;
#pragma unroll
                    for (int bj = 0; bj < 2; ++bj) { const f32x4 v0 = acc[ai][bj][m][0], v1 = acc[ai][bj][m][1]; u32x4 w; w.x = pk2(v0[0], v0[1]); w.y = pk2(v0[2], v0[3]); w.z = pk2(v1[0], v1[1]); w.w = pk2(v1[2], v1[3]);
                        *(u32x4*)(rp + bj * 128) = w; } }
        } else {
            bf16_t* O = (bf16_t*)(p.ws + WS_GATES); const int colb = (pn - 12) * 256 + wc * 32 + 8 * fq;
            f32x4 bv[2][2];
#pragma unroll
            for (int bj = 0; bj < 2; ++bj) { bv[bj][0] = *(const f32x4*)(bg + colb + bj * 128); bv[bj][1] = *(const f32x4*)(bg + colb + bj * 128 + 4); }
#pragma unroll
            for (int ai = 0; ai < 2; ++ai)
#pragma unroll
                for (int m = 0; m < 4; ++m) { asm volatile("" ::: "memory"); bf16_t* rp = O + (size_t)(row0 + ai * 128 + m * 16) * 2048 + colb;
#pragma unroll
                    for (int bj = 0; bj < 2; ++bj) { f32x4 v0 = acc[ai][bj][m][0] + bv[bj][0], v1 = acc[ai][bj][m][1] + bv[bj][1];
#pragma unroll
                        for (int e = 0; e < 4; ++e) { v0[e] = sigmoidf_(v0[e]); v1[e] = sigmoidf_(v1[e]); }
                        u32x4 w; w.x = pk2(v0[0], v0[1]); w.y = pk2(v0[2], v0[3]); w.z = pk2(v1[0], v1[1]); w.w = pk2(v1[2], v1[3]);
                        *(u32x4*)(rp + bj * 128) = w; } }
        }
    }
}
__device__ __forceinline__ void merge_phase(const Params& p, int l, LAS unsigned char* lds) {
    unsigned voffA[2][2], voffB[2]; g8::make_voff_contig(voffA, D * 2); g8::make_voffB(voffB, 512 * 2, true);
    const char* Ab = (const char*)(p.ws + WS_OAB); const char* wl = (const char*)(p.ws + WS_WSMALL + (size_t)l * WSMALL_LAYER);
    const bf16_t* GT = (const bf16_t*)(p.ws + WS_GATES); bf16_t* O = (bf16_t*)(p.ws + WS_MERGED);
    int pm, pn; const int bid = obid();
    for (int i = 0; unit_order(i, gridDim.x, bid, T / 256, 4, pm, pn); ++i) {
#pragma unroll 1
        for (int br = 0; br < 2; ++br) {
            g8::Acc acc; g8::zero_acc(acc);
            const char* Bt = wl + (10 + br) * MiB + (size_t)pn * 256 * 512 * 2;
            const g8::KSeg s = g8::seg1(Ab + (size_t)pm * 256 * D * 2 + br * 1024, Bt, Bt + (size_t)128 * 512 * 2, 8);
            g8::kloop<false, false>(lds, acc, s, voffA, voffB, 128 * D * 2);
            EPI_COORDS();
            const int row0 = pm * 256 + wr * 64 + fr, colb = pn * 256 + wc * 32 + 8 * fq;
#pragma unroll
            for (int ai = 0; ai < 2; ++ai)
#pragma unroll
                for (int m = 0; m < 4; ++m) { asm volatile("" ::: "memory"); const size_t ro = (size_t)(row0 + ai * 128 + m * 16); const bf16_t* gp = GT + ro * 2048 + br * 1024 + colb; bf16_t* op = O + ro * D + colb;
#pragma unroll
                    for (int bj = 0; bj < 2; ++bj) { const u32x4 g = *(const u32x4*)(gp + bj * 128); const f32x4 v0 = acc[ai][bj][m][0], v1 = acc[ai][bj][m][1];
                        float o[8] = {v0[0] * bflo(g.x), v0[1] * bfhi(g.x), v0[2] * bflo(g.y), v0[3] * bfhi(g.y), v1[0] * bflo(g.z), v1[1] * bfhi(g.z), v1[2] * bflo(g.w), v1[3] * bfhi(g.w)};
                        if (br) { const u32x4 pr = *(const u32x4*)(op + bj * 128);
                            o[0] += bflo(pr.x); o[1] += bfhi(pr.x); o[2] += bflo(pr.y); o[3] += bfhi(pr.y); o[4] += bflo(pr.z); o[5] += bfhi(pr.z); o[6] += bflo(pr.w); o[7] += bfhi(pr.w); }
                        u32x4 w; w.x = pk2(o[0], o[1]); w.y = pk2(o[2], o[3]); w.z = pk2(o[4], o[5]); w.w = pk2(o[6], o[7]);
                        *(u32x4*)(op + bj * 128) = w; } }
        }
    }
}
__device__ __forceinline__ void wout_phase(const Params& p, int l, LAS unsigned char* lds) {
    unsigned voffA[2][2], voffB[2]; g8::make_voff_contig(voffA, D * 2); g8::make_voffB(voffB, D * 2, false);
    const char* Ab = (const char*)(p.ws + WS_MERGED); const char* Bb = (const char*)(p.ws + WS_WSMALL + (size_t)l * WSMALL_LAYER + 12 * MiB);
    int pm, pn; const int bid = obid();
    for (int i = 0; unit_order(i, gridDim.x, bid, T / 256, 4, pm, pn); ++i) {
        g8::Acc acc; g8::zero_acc(acc);
        const g8::KSeg s = g8::seg1(Ab + (size_t)pm * 256 * D * 2, Bb + (size_t)pn * 256 * D * 2, Bb + (size_t)(pn * 256 + 128) * D * 2, D / 64);
        g8::kloop<false, false>(lds, acc, s, voffA, voffB, 128 * D * 2);
        EPI_COORDS();
        const int row0 = pm * 256 + wr * 64 + fr, col0 = pn * 256 + wc * 32 + 4 * fq;
#pragma unroll
        for (int ai = 0; ai < 2; ++ai)
#pragma unroll
            for (int m = 0; m < 4; ++m) { asm volatile("" ::: "memory"); float* hr = hrow(p, row0 + ai * 128 + m * 16) + col0;
#pragma unroll
                for (int bj = 0; bj < 2; ++bj)
#pragma unroll
                    for (int n = 0; n < 2; ++n) { f32x4* hp = (f32x4*)(hr + bj * 128 + n * 16); *hp = *hp * ALPHA + acc[ai][bj][m][n]; } }
    }
}

constexpr int ATTN_WAVE_LDS = 16640 + 1024 + 2048 + 64 + 512;
__device__ __forceinline__ unsigned score_key(float s) { s += 0.0f; const unsigned u = __builtin_bit_cast(unsigned, s); return (u & 0x80000000u) ? ~u : (u | 0x80000000u); }
__device__ void attn_naive_query(const Params& p, int row, unsigned char* wl, int lane) {
    const bf16_t* U = (const bf16_t*)(p.ws + WS_UAR);
    bf16_t* OA = (bf16_t*)(p.ws + WS_OAB) + (size_t)row * D;
    const int b = row / LP, pos = row - b * LP;
    if (pos < PADM) {
#pragma unroll
        for (int j = 0; j < 8; ++j) OA[j * 64 + lane] = 0;
        return;
    }
    const int nadm = 64 * ((pos >> 6) + 1) - PADM;
    unsigned* keys = (unsigned*)wl; float* p_s = (float*)wl;
    float* qi_s = (float*)(wl + 16640); float* q_s = qi_s + 256; float* w_s = q_s + 512; unsigned short* sel_s = (unsigned short*)(w_s + 16);
    const bf16_t* urow = U + (size_t)row * UARW;
    for (int i = lane; i < 256; i += 64) qi_s[i] = bf2f(urow[C_QI + i]);
    for (int i = lane; i < 512; i += 64) q_s[i] = bf2f(urow[C_Q + i]);
    if (lane < 8) w_s[lane] = bf2f(urow[C_WI + lane]);
    __builtin_amdgcn_fence(__ATOMIC_RELEASE, "wavefront"); __builtin_amdgcn_wave_barrier(); __builtin_amdgcn_fence(__ATOMIC_ACQUIRE, "wavefront");
    const int nj = (nadm + 63) >> 6;
    for (int j = 0; j < nj; ++j) {
        const int ki_idx = lane + 64 * j; unsigned key = 0u;
        if (ki_idx < nadm) {
            const u32x4* kp = (const u32x4*)(U + (size_t)(b * LP + PADM + ki_idx) * UARW + C_KI);
            float kf[32];
#pragma unroll
            for (int c4 = 0; c4 < 4; ++c4) { const u32x4 w = kp[c4];
                kf[c4 * 8 + 0] = bflo(w.x); kf[c4 * 8 + 1] = bfhi(w.x); kf[c4 * 8 + 2] = bflo(w.y); kf[c4 * 8 + 3] = bfhi(w.y);
                kf[c4 * 8 + 4] = bflo(w.z); kf[c4 * 8 + 5] = bfhi(w.z); kf[c4 * 8 + 6] = bflo(w.w); kf[c4 * 8 + 7] = bfhi(w.w); }
            float sc = 0.f;
#pragma unroll 1
            for (int h = 0; h < 8; ++h) { float d = 0.f; asm volatile("" ::: "memory");
#pragma unroll
                for (int e = 0; e < 32; ++e) d = fmaf(qi_s[h * 32 + e], kf[e], d);
                sc = fmaf(w_s[h], fmaxf(d, 0.f), sc); }
            key = score_key(sc); if (key == 0u) key = 1u;
        }
        keys[ki_idx] = key;
    }
    __builtin_amdgcn_fence(__ATOMIC_RELEASE, "wavefront"); __builtin_amdgcn_wave_barrier(); __builtin_amdgcn_fence(__ATOMIC_ACQUIRE, "wavefront");
    unsigned thr = 0u; int need_ties = 0x7fffffff;
    if (nadm > 256) {
        unsigned prefix = 0u; int remaining = 256;
        for (int bit = 31; bit >= 0; --bit) {
            const unsigned cand = prefix | (1u << bit); int cnt = 0;
            for (int j = 0; j < nj; ++j) { const unsigned k = keys[lane + 64 * j]; cnt += __builtin_popcountll(__ballot((k >> bit) == (cand >> bit))); }
            if (cnt >= remaining) prefix = cand; else remaining -= cnt;
        }
        thr = prefix; need_ties = remaining;
    } else thr = 1u;
    int nsel = 0, ties_seen = 0;
    for (int j = 0; j < nj; ++j) {
        const unsigned k = keys[lane + 64 * j];
        const unsigned long long tm = __ballot(k == thr && k != 0u);
        const unsigned long long lt = (1ull << lane) - 1ull;
        const int myrank = ties_seen + __builtin_popcountll(tm & lt);
        const bool selme = (k > thr) || (k == thr && k != 0u && myrank < need_ties);
        const unsigned long long sm = __ballot(selme);
        if (selme) sel_s[nsel + __builtin_popcountll(sm & lt)] = (unsigned short)(PADM + lane + 64 * j);
        nsel += __builtin_popcountll(sm); ties_seen += __builtin_popcountll(tm);
    }
    __builtin_amdgcn_fence(__ATOMIC_RELEASE, "wavefront"); __builtin_amdgcn_wave_barrier(); __builtin_amdgcn_fence(__ATOMIC_ACQUIRE, "wavefront");
    float sc[4][8];
#pragma unroll
    for (int m = 0; m < 4; ++m) {
        asm volatile("" ::: "memory");
        const int i = lane + 64 * m; const bool valid = i < nsel; const int ps = valid ? sel_s[i] : PADM;
        const bf16_t* krow = U + (size_t)(b * LP + ps) * UARW + C_K;
#pragma unroll
        for (int n = 0; n < 2; ++n) {
            float a0 = 0.f, a1 = 0.f, a2 = 0.f, a3 = 0.f;
#pragma unroll 1
            for (int c8 = 0; c8 < 8; ++c8) { asm volatile("" ::: "memory"); const u32x4 w = *(const u32x4*)(krow + n * 64 + c8 * 8);
                float kf[8] = {bflo(w.x), bfhi(w.x), bflo(w.y), bfhi(w.y), bflo(w.z), bfhi(w.z), bflo(w.w), bfhi(w.w)};
#pragma unroll
                for (int e = 0; e < 8; ++e) { const int dd = c8 * 8 + e;
                    a0 = fmaf(q_s[(n * 4 + 0) * 64 + dd], kf[e], a0); a1 = fmaf(q_s[(n * 4 + 1) * 64 + dd], kf[e], a1);
                    a2 = fmaf(q_s[(n * 4 + 2) * 64 + dd], kf[e], a2); a3 = fmaf(q_s[(n * 4 + 3) * 64 + dd], kf[e], a3); } }
            sc[m][n * 4 + 0] = valid ? a0 * 0.125f : -INFINITY; sc[m][n * 4 + 1] = valid ? a1 * 0.125f : -INFINITY;
            sc[m][n * 4 + 2] = valid ? a2 * 0.125f : -INFINITY; sc[m][n * 4 + 3] = valid ? a3 * 0.125f : -INFINITY;
        }
    }
    __builtin_amdgcn_wave_barrier();
    float linv[8];
#pragma unroll
    for (int h = 0; h < 8; ++h) {
        const float mx = wave_max(fmaxf(fmaxf(sc[0][h], sc[1][h]), fmaxf(sc[2][h], sc[3][h]))); float s = 0.f;
#pragma unroll
        for (int m = 0; m < 4; ++m) { const float e = __expf(sc[m][h] - mx); sc[m][h] = e; s += e; }
        linv[h] = 1.0f / wave_sum(s);
    }
#pragma unroll
    for (int m = 0; m < 4; ++m) { const int i = lane + 64 * m;
#pragma unroll
        for (int h = 0; h < 8; ++h) p_s[i * 8 + h] = sc[m][h]; }
    __builtin_amdgcn_fence(__ATOMIC_RELEASE, "wavefront"); __builtin_amdgcn_wave_barrier(); __builtin_amdgcn_fence(__ATOMIC_ACQUIRE, "wavefront");
    float o[8] = {0.f, 0.f, 0.f, 0.f, 0.f, 0.f, 0.f, 0.f};
    for (int i = 0; i < nsel; ++i) {
        const int ps = sel_s[i]; const bf16_t* vrow = U + (size_t)(b * LP + ps) * UARW + C_V;
        const float v0 = bf2f(vrow[lane]), v1 = bf2f(vrow[64 + lane]);
        const f32x4 pa = *(const f32x4*)(p_s + i * 8), pb = *(const f32x4*)(p_s + i * 8 + 4);
        o[0] = fmaf(pa[0], v0, o[0]); o[1] = fmaf(pa[1], v0, o[1]); o[2] = fmaf(pa[2], v0, o[2]); o[3] = fmaf(pa[3], v0, o[3]);
        o[4] = fmaf(pb[0], v1, o[4]); o[5] = fmaf(pb[1], v1, o[5]); o[6] = fmaf(pb[2], v1, o[6]); o[7] = fmaf(pb[3], v1, o[7]);
    }
#pragma unroll
    for (int h = 0; h < 8; ++h) OA[h * 64 + lane] = (bf16_t)f2bf(o[h] * linv[h]);
    __builtin_amdgcn_wave_barrier();
}

__device__ void rwkv_naive(const Params& p, int l, int bh, unsigned char* lds) {
    const int b = bh >> 3, h = bh & 7, tid = otid(), lane = tid & 63, wid = tid >> 6;
    const bf16_t* U = (const bf16_t*)(p.ws + WS_UAR);
    bf16_t* OB = (bf16_t*)(p.ws + WS_OAB);
    float* xs = (float*)lds;
    float* vr = xs + 32 * 256;
    float* vw = vr + 2048; float* vkk = vw + 2048; float* vbb = vkk + 2048; float* vk = vbb + 2048; float* vv = vk + 2048;
    float* gg = vv + 2048; float* bon = gg + 2048; float* ys = bon + 2048;
    const float* mu = p.in[I_MU] + l * R_COLS;
    const int hd = h * 64 + lane;
    const float w0 = p.in[I_W0][l * 512 + hd], a0 = p.in[I_A0][l * 512 + hd], kkc = p.in[I_KK][l * 512 + hd], kac = p.in[I_KA][l * 512 + hd], rkc = p.in[I_RK][l * 512 + hd];
    const float gng = p.in[I_GNG][l * 512 + hd], gnb = p.in[I_GNB][l * 512 + hd];
    const float mur = mu[hd], muk = mu[512 + hd], muv = mu[1024 + hd];
    const float* wup = p.in[I_WUP] + (size_t)l * 64 * 512 + hd; const float* aup = p.in[I_AUP] + (size_t)l * 64 * 512 + hd; const float* gup = p.in[I_GUP] + (size_t)l * 128 * 512 + hd;
    float S[8];
#pragma unroll
    for (int i = 0; i < 8; ++i) S[i] = 0.f;
    const int sv = tid >> 3, sq = tid & 7;
    for (int p0 = 0; p0 < LP; p0 += 32) {
        for (int idx = tid; idx < 32 * 256; idx += NTHREADS) {
            const int tt = idx >> 8, j = idx & 255, pos = p0 + tt; const size_t ro = (size_t)(b * LP + pos) * UARW;
            const float x = bf2f(U[ro + C_XW + j]); const float xp = pos > 0 ? bf2f(U[ro - UARW + C_XW + j]) : 0.f;
            float xv = x + (xp - x) * mu[1536 + j];
            if (j < 64) xv = tanhf(xv); else if (j >= 128) xv = sigmoidf_(xv);
            xs[idx] = xv;
        }
        __syncthreads();
        {
            float dw[4] = {0.f, 0.f, 0.f, 0.f}, da[4] = {0.f, 0.f, 0.f, 0.f}, dg[4] = {0.f, 0.f, 0.f, 0.f};
            for (int j = 0; j < 64; ++j) { const float w1 = wup[(size_t)j * 512], w2 = aup[(size_t)j * 512];
#pragma unroll
                for (int k = 0; k < 4; ++k) { dw[k] = fmaf(xs[(wid * 4 + k) * 256 + j], w1, dw[k]); da[k] = fmaf(xs[(wid * 4 + k) * 256 + 64 + j], w2, da[k]); } }
            for (int j = 0; j < 128; ++j) { const float w3 = gup[(size_t)j * 512];
#pragma unroll
                for (int k = 0; k < 4; ++k) dg[k] = fmaf(xs[(wid * 4 + k) * 256 + 128 + j], w3, dg[k]); }
#pragma unroll
            for (int k = 0; k < 4; ++k) {
                const int tt = wid * 4 + k, pos = p0 + tt; const size_t ro = (size_t)(b * LP + pos) * UARW;
                float r = bf2f(U[ro + C_R + hd]), kx = bf2f(U[ro + C_RK + hd]), vx = bf2f(U[ro + C_RV + hd]);
                if (pos > 0) { const float rp = bf2f(U[ro - UARW + C_R + hd]), kp = bf2f(U[ro - UARW + C_RK + hd]), vp = bf2f(U[ro - UARW + C_RV + hd]);
                    r += (rp - r) * mur; kx += (kp - kx) * muk; vx += (vp - vx) * muv; }
                else { r -= r * mur; kx -= kx * muk; vx -= vx * muv; }
                const float z = -(w0 + dw[k]); const float sp = fmaxf(z, 0.f) + log1pf(__expf(-fabsf(z)));
                const float logw = -sp - 0.5f; const float w = __expf(-__expf(logw));
                const float a = sigmoidf_(a0 + da[k]);
                float kk = kx * kkc; const float nrm = wave_sum(kk * kk); kk *= rsqrtf(fmaxf(nrm, 1e-24f));
                const float kmod = kx * (1.0f + (a - 1.0f) * kac);
                const float bsum = wave_sum(r * kmod * rkc);
                vr[tt * 64 + lane] = r; vw[tt * 64 + lane] = w; vkk[tt * 64 + lane] = kk; vbb[tt * 64 + lane] = kk * a; vk[tt * 64 + lane] = kmod; vv[tt * 64 + lane] = vx;
                gg[tt * 64 + lane] = dg[k]; bon[tt * 64 + lane] = bsum * vx;
            }
        }
        __syncthreads();
        for (int tt = 0; tt < 32; ++tt) {
            const f32x4 k0 = *(const f32x4*)(vkk + tt * 64 + sq * 8), k1 = *(const f32x4*)(vkk + tt * 64 + sq * 8 + 4);
            const f32x4 w0v = *(const f32x4*)(vw + tt * 64 + sq * 8), w1v = *(const f32x4*)(vw + tt * 64 + sq * 8 + 4);
            const f32x4 b0 = *(const f32x4*)(vbb + tt * 64 + sq * 8), b1 = *(const f32x4*)(vbb + tt * 64 + sq * 8 + 4);
            const f32x4 m0 = *(const f32x4*)(vk + tt * 64 + sq * 8), m1 = *(const f32x4*)(vk + tt * 64 + sq * 8 + 4);
            const f32x4 r0 = *(const f32x4*)(vr + tt * 64 + sq * 8), r1 = *(const f32x4*)(vr + tt * 64 + sq * 8 + 4);
            const float vt = vv[tt * 64 + sv];
            float sa = 0.f;
#pragma unroll
            for (int i = 0; i < 4; ++i) { sa = fmaf(S[i], k0[i], sa); sa = fmaf(S[4 + i], k1[i], sa); }
            sa += __shfl_xor(sa, 1); sa += __shfl_xor(sa, 2); sa += __shfl_xor(sa, 4);
            sa = -sa; float y = 0.f;
#pragma unroll
            for (int i = 0; i < 4; ++i) { S[i] = S[i] * w0v[i] + sa * b0[i] + vt * m0[i]; S[4 + i] = S[4 + i] * w1v[i] + sa * b1[i] + vt * m1[i];
                y = fmaf(S[i], r0[i], y); y = fmaf(S[4 + i], r1[i], y); }
            y += __shfl_xor(y, 1); y += __shfl_xor(y, 2); y += __shfl_xor(y, 4);
            if (sq == 0) ys[tt * 64 + sv] = y;
        }
        __syncthreads();
#pragma unroll
        for (int k = 0; k < 4; ++k) { const int tt = wid * 4 + k, pos = p0 + tt; const float y = ys[tt * 64 + lane];
            const float m = wave_sum(y) * (1.f / 64.f); const float dv = y - m; const float var = wave_sum(dv * dv) * (1.f / 64.f);
            const float o = (dv * rsqrtf(var + GN_EPS) * gng + gnb + bon[tt * 64 + lane]) * gg[tt * 64 + lane];
            OB[(size_t)(b * LP + pos) * D + 512 + hd] = (bf16_t)f2bf(o); }
        __syncthreads();
    }
}

__device__ __forceinline__ int pair_index(int a, int b) {   return a == 0 ? b - 1 : (a == 1 ? b + 1 : 5); }
__device__ __forceinline__ void pair_of(int idx, int& a, int& b) { a = idx < 3 ? 0 : (idx < 5 ? 1 : 2); b = idx < 3 ? idx + 1 : (idx < 5 ? idx - 1 : 3); }
__device__ __forceinline__ void ln1_router_phase(const Params& p, int l, unsigned char* lds) {
    const int tid = otid(), lane = tid & 63, gw = obid() * NWAVES + (tid >> 6), NGW = gridDim.x * NWAVES;
    float* wr_s = (float*)lds;
    for (int i = tid; i < D * 16 / 4; i += NTHREADS) ((f32x4*)wr_s)[i] = ((const f32x4*)p.in[I_WROUTER])[i];
    __syncthreads();
    unsigned* cls_cnt = (unsigned*)(p.ws + WS_CTL) + CW_CLS + l * 32;
    int* lists = (int*)(p.ws + WS_LIST); f32x2* gl = (f32x2*)(p.ws + WS_LIST + 2 * MiB);
    const float* g = p.in[I_LN1G] + l * D; const float* bt = p.in[I_LN1B] + l * D;
    for (int r = gw; r < T; r += NGW) {
        f32x4 v[4];
        if (is_dummy(r)) {
#pragma unroll
            for (int j = 0; j < 4; ++j) v[j] = (f32x4){0.f, 0.f, 0.f, 0.f};
            store_row(p, r, v, lane, true); continue; }
        const float* hr = hrow(p, r);
#pragma unroll
        for (int j = 0; j < 4; ++j) v[j] = *(const f32x4*)(hr + 4 * lane + 256 * j);
        ln_wave(v, g, bt, lane);
        store_row(p, r, v, lane, false);
        float lg[16];
#pragma unroll
        for (int e = 0; e < 16; ++e) lg[e] = 0.f;
#pragma unroll
        for (int j = 0; j < 4; ++j)
#pragma unroll
            for (int c = 0; c < 4; ++c) { const float x = v[j][c]; const float* wrow = wr_s + (size_t)(4 * lane + 256 * j + c) * 16;
#pragma unroll
                for (int e4 = 0; e4 < 4; ++e4) { const f32x4 w = *(const f32x4*)(wrow + 4 * e4);
                    lg[4 * e4 + 0] = fmaf(x, w[0], lg[4 * e4 + 0]); lg[4 * e4 + 1] = fmaf(x, w[1], lg[4 * e4 + 1]); lg[4 * e4 + 2] = fmaf(x, w[2], lg[4 * e4 + 2]); lg[4 * e4 + 3] = fmaf(x, w[3], lg[4 * e4 + 3]); } }
#pragma unroll
        for (int e = 0; e < 16; ++e) lg[e] = wave_sum(lg[e]);
        float s[16], sel[16];
#pragma unroll
        for (int e = 0; e < 16; ++e) { s[e] = sigmoidf_(lg[e]); sel[e] = s[e] + p.in[I_BROUTER][e]; }
        int gbest = 0; float gsc = -INFINITY;
#pragma unroll
        for (int gi = 0; gi < 4; ++gi) { float m1 = -INFINITY, m2 = -INFINITY;
#pragma unroll
            for (int j = 0; j < 4; ++j) { const float x = sel[gi * 4 + j]; if (x > m1) { m2 = m1; m1 = x; } else if (x > m2) m2 = x; }
            const float sc = m1 + m2; if (sc > gsc) { gsc = sc; gbest = gi; } }
        float sg[4], sgs[4];
#pragma unroll
        for (int j = 0; j < 4; ++j) { sg[j] = gbest == 0 ? sel[j] : (gbest == 1 ? sel[4 + j] : (gbest == 2 ? sel[8 + j] : sel[12 + j])); sgs[j] = gbest == 0 ? s[j] : (gbest == 1 ? s[4 + j] : (gbest == 2 ? s[8 + j] : s[12 + j])); }
        int j1 = 0;
#pragma unroll
        for (int j = 1; j < 4; ++j) if (sg[j] > sg[j1]) j1 = j;
        int j2 = j1 == 0 ? 1 : 0;
#pragma unroll
        for (int j = 0; j < 4; ++j) if (j != j1 && j != j2 && sg[j] > sg[j2]) j2 = j;
        const int ja = j1 < j2 ? j1 : j2, jb = j1 < j2 ? j2 : j1;
        float sa_ = 0.f, sb_ = 0.f;
#pragma unroll
        for (int j = 0; j < 4; ++j) { if (j == ja) sa_ = sgs[j]; if (j == jb) sb_ = sgs[j]; }
        const float inv = 1.0f / (sa_ + sb_);
        const int cls = gbest * 6 + pair_index(ja, jb);
        if (lane == 0) { const unsigned slot = atomicAdd(cls_cnt + cls, 1u); lists[(size_t)cls * T + slot] = r; gl[r] = (f32x2){sa_ * inv, sb_ * inv}; }
    }
}

struct ClsTab { int cnt[24]; int tile0[25]; int row0[24]; };
__device__ __forceinline__ void build_cls_table(const Params& p, int l, int* tab  ) {
    if (otid() == 0) { const unsigned* c = (const unsigned*)(p.ws + WS_CTL) + CW_CLS + l * 32; int acc = 0;
        for (int i = 0; i < 24; ++i) { const int n = (int)__hip_atomic_load(c + i, __ATOMIC_RELAXED, __HIP_MEMORY_SCOPE_AGENT); tab[i] = n; tab[24 + i] = acc; acc += (n + 255) >> 8; }
        tab[48] = acc; }
    __syncthreads();
}
__device__ __forceinline__ int find_cls(const int* tab, int tile) { int c = 0;
#pragma unroll 1
    for (int i = 1; i < 24; ++i) if (tile >= tab[24 + i]) c = i;
    return c; }
__device__ __forceinline__ void moe_a_phase(const Params& p, int l, LAS unsigned char* lds, const int* tab) {
    const int tid = otid();
    unsigned voffB[2]; g8::make_voffB(voffB, D * 2, true);
    const int* lists = (const int*)(p.ws + WS_LIST); const f32x2* gl = (const f32x2*)(p.ws + WS_LIST + 2 * MiB);
    bf16_t* ACT = (bf16_t*)(p.ws + WS_ACT);
    const int ntiles = tab[48], nunits = ntiles * 8;
    for (int u = obid(); u < nunits; u += gridDim.x) {
        const int tile = u >> 3, pn = u & 7, cls = find_cls(tab, tile), rt = tile - tab[24 + cls], n = tab[cls];
        int ja, jb; pair_of(cls % 6, ja, jb); const int eslot = pn >> 2, e = (cls / 6) * 4 + (eslot ? jb : ja), jblk = pn & 3;
        unsigned voffA[2][2];
#pragma unroll
        for (int i = 0; i < 2; ++i) { int R, C; g8::stage_rc(tid * 16 + i * 8192, R, C);
#pragma unroll
            for (int hh = 0; hh < 2; ++hh) { const int li = rt * 256 + R + hh * 128; const int tok = li < n ? lists[(size_t)cls * T + li] : 0;
                voffA[hh][i] = (unsigned)tok * (D * 2) + (unsigned)C * 2u; } }
        g8::Acc acc; g8::zero_acc(acc);
        const char* Bb = (const char*)(p.ws + WS_WEXP) + ((size_t)e * 1024 + jblk * 256) * D * 2;
        const g8::KSeg s = g8::seg1((const char*)(p.ws + WS_HB), Bb, Bb + (size_t)128 * D * 2, D / 64);
        g8::kloop<true, false>(lds, acc, s, voffA, voffB, 0);
        EPI_COORDS();
#pragma unroll
        for (int ai = 0; ai < 2; ++ai)
#pragma unroll
            for (int m = 0; m < 4; ++m) { asm volatile("" ::: "memory"); const int li = rt * 256 + ai * 128 + wr * 64 + m * 16 + fr; const int tok = li < n ? lists[(size_t)cls * T + li] : -1;
                float gate = 0.f; if (tok >= 0) { const f32x2 g2 = gl[tok]; gate = eslot ? g2[1] : g2[0]; }
                const f32x4 h1a = acc[ai][0][m][0], h1b = acc[ai][0][m][1], h3a = acc[ai][1][m][0], h3b = acc[ai][1][m][1];
                float o[8];
#pragma unroll
                for (int c = 0; c < 4; ++c) { o[c] = gate * (h1a[c] * sigmoidf_(h1a[c])) * h3a[c]; o[4 + c] = gate * (h1b[c] * sigmoidf_(h1b[c])) * h3b[c]; }
                u32x4 w; w.x = pk2(o[0], o[1]); w.y = pk2(o[2], o[3]); w.z = pk2(o[4], o[5]); w.w = pk2(o[6], o[7]);
                *(u32x4*)(ACT + (size_t)(tile * 256 + ai * 128 + wr * 64 + m * 16 + fr) * D + eslot * 512 + jblk * 128 + wc * 32 + 8 * fq) = w; }
    }
}
__device__ __forceinline__ void moe_b_phase(const Params& p, int l, LAS unsigned char* lds, const int* tab) {
    unsigned voffA[2][2], voffB[2]; g8::make_voff_contig(voffA, D * 2); g8::make_voffB(voffB, 512 * 2, false);
    const int* lists = (const int*)(p.ws + WS_LIST);
    const int ntiles = tab[48], nunits = ntiles * 4;
    for (int u = obid(); u < nunits; u += gridDim.x) {
        const int tile = u >> 2, pn = u & 3, cls = find_cls(tab, tile), rt = tile - tab[24 + cls], n = tab[cls];
        int ja, jb; pair_of(cls % 6, ja, jb); const int ea = (cls / 6) * 4 + ja, eb = (cls / 6) * 4 + jb;
        g8::Acc acc; g8::zero_acc(acc);
        const char* At = (const char*)(p.ws + WS_ACT) + (size_t)tile * 256 * D * 2;
        const char* W2 = (const char*)(p.ws + WS_WEXP + 32 * MiB);
        const char* Ba = W2 + ((size_t)ea * 1024 + pn * 256) * 512 * 2; const char* Bb = W2 + ((size_t)eb * 1024 + pn * 256) * 512 * 2;
        g8::KSeg s2 = g8::seg1(At, Ba, Ba + (size_t)128 * 512 * 2, 16); s2.nt0 = 8; s2.A2 = At + 1024; s2.B02 = Bb; s2.B12 = Bb + (size_t)128 * 512 * 2;
        g8::kloop<false, true>(lds, acc, s2, voffA, voffB, 128 * D * 2);
        EPI_COORDS();
        const int col0 = pn * 256 + wc * 32 + 4 * fq;
#pragma unroll
        for (int ai = 0; ai < 2; ++ai)
#pragma unroll
            for (int m = 0; m < 4; ++m) { asm volatile("" ::: "memory"); const int li = rt * 256 + ai * 128 + wr * 64 + m * 16 + fr;
                if (li < n) { const int tok = lists[(size_t)cls * T + li]; float* hr = hrow(p, tok) + col0;
#pragma unroll
                    for (int bj = 0; bj < 2; ++bj)
#pragma unroll
                        for (int nn = 0; nn < 2; ++nn) { f32x4* hp = (f32x4*)(hr + bj * 128 + nn * 16); *hp = *hp * ALPHA + acc[ai][bj][m][nn]; } } }
    }
}
__device__ __forceinline__ void ln2_phase(const Params& p, int l) {
    const int tid = otid(), lane = tid & 63, gw = obid() * NWAVES + (tid >> 6), NGW = gridDim.x * NWAVES;
    const float* g = p.in[I_LN2G] + l * D; const float* bt = p.in[I_LN2B] + l * D;
    for (int r = gw; r < T; r += NGW) {
        f32x4 v[4];
        if (is_dummy(r)) {
#pragma unroll
            for (int j = 0; j < 4; ++j) v[j] = (f32x4){0.f, 0.f, 0.f, 0.f};
            store_row(p, r, v, lane, true); continue; }
        const float* hr = hrow(p, r);
#pragma unroll
        for (int j = 0; j < 4; ++j) v[j] = *(const f32x4*)(hr + 4 * lane + 256 * j);
        ln_wave(v, g, bt, lane);
        store_row(p, r, v, lane, false);
    }
}

__device__ __forceinline__ const Params& PP() { const Params* q = (const Params*)__builtin_amdgcn_kernarg_segment_ptr(); asm volatile("" : "+s"(q)); return *q; }
__global__ void __launch_bounds__(NTHREADS, 2) mega(Params p_unused) {
    extern __shared__ __attribute__((aligned(16))) unsigned char lds[];
    cg::grid_group grid = cg::this_grid();
    LAS unsigned char* ldsl = (LAS unsigned char*)lds;
    int* tab = (int*)(lds + 140 * 1024);

    conv_small_weights(PP(), ldsl);
    ln_in_phase(PP());
    grid.sync();
#pragma unroll 1
    for (int l = 0; l < DEPTH; ++l) {
        inproj_phase(PP(), l, ldsl);
        grid.sync();
        const int bid = obid();
        if (bid < 32) { rwkv_naive(PP(), l, bid, lds); }
        else {
            const int t_ = otid(), wave = t_ >> 6, lane = t_ & 63;
            if (wave < 6) {
                const int nw = (gridDim.x - 32) * 6, w0 = (bid - 32) * 6 + wave;
                for (int r = w0; r < T; r += nw) attn_naive_query(PP(), r, lds + wave * ATTN_WAVE_LDS, lane);
            }
        }
        grid.sync();
        merge_phase(PP(), l, ldsl);
        grid.sync();
        wout_phase(PP(), l, ldsl);
        conv_expert_weights(PP(), l, ldsl);
        grid.sync();
        ln1_router_phase(PP(), l, lds);
        grid.sync();
        build_cls_table(PP(), l, tab);
        moe_a_phase(PP(), l, ldsl, tab);
        grid.sync();
        moe_b_phase(PP(), l, ldsl, tab);
        grid.sync();
        ln2_phase(PP(), l);
        grid.sync();
    }
}

extern "C" void kernel_launch(void* const* d_in, const int* in_sizes, int n_in, void* d_out, int out_size,
                              void* d_ws, size_t ws_size, hipStream_t stream) {
    static int grid_blocks = 0;
    if (grid_blocks == 0) {
        int dev = 0, cus = 0, per_cu = 0;
        if (n_in != 29 || ws_size < WS_END || out_size != BATCH * SEQ * D) { fprintf(stderr, "kernel_launch: unexpected problem (n_in %d, ws %zu, out %d)\n", n_in, ws_size, out_size); grid_blocks = -1; return; }
        (void)hipGetDevice(&dev);
        (void)hipDeviceGetAttribute(&cus, hipDeviceAttributeMultiprocessorCount, dev);
        (void)hipFuncSetAttribute((const void*)mega, hipFuncAttributeMaxDynamicSharedMemorySize, LDS_BYTES);
        (void)hipOccupancyMaxActiveBlocksPerMultiprocessor(&per_cu, (const void*)mega, NTHREADS, LDS_BYTES);
        if (per_cu < 1) { fprintf(stderr, "occupancy query returned %d\n", per_cu); grid_blocks = -1; return; }
        grid_blocks = cus;
    }
    if (grid_blocks < 0) return;
    (void)hipMemsetAsync((char*)d_ws + WS_CTL, 0, 4096, stream);
    Params p{};
    for (int i = 0; i < 29; ++i) p.in[i] = (const float*)d_in[i];
    p.out = (float*)d_out; p.ws = (unsigned char*)d_ws;
    void* args[] = {&p};
    hipError_t e = hipLaunchCooperativeKernel((const void*)mega, dim3(grid_blocks), dim3(NTHREADS), args, LDS_BYTES, stream);
    if (e != hipSuccess) fprintf(stderr, "cooperative launch failed: %s (grid %d)\n", hipGetErrorString(e), grid_blocks);
}
```

```cpp
#include <hip/hip_runtime.h>
#include <hip/hip_cooperative_groups.h>
#include <cstdio>
#include <cstdint>
namespace cg = cooperative_groups;

#define LAS __attribute__((address_space(3)))
typedef unsigned short bf16_t;
typedef short bf16x8 __attribute__((ext_vector_type(8)));
typedef float f32x4 __attribute__((ext_vector_type(4)));
typedef float f32x2 __attribute__((ext_vector_type(2)));
typedef unsigned u32x4 __attribute__((ext_vector_type(4)));
typedef unsigned u32x2 __attribute__((ext_vector_type(2)));

constexpr int NTHREADS = 512, NWAVES = 8;
constexpr int D = 1024, BATCH = 4, SEQ = 4096, DEPTH = 2;
constexpr int LP = 4160;
constexpr int T = BATCH * LP;
constexpr int NCH = LP / 64;
constexpr int PADM = 48;
constexpr int A_COLS = 1064, R_COLS = 1792, IN_COLS = 4904;
constexpr int UA = 1280;
constexpr int UARW = 3072;
constexpr int NIN = 5120;
constexpr float LN_EPS = 1e-5f, GN_EPS = 64e-5f;
constexpr float ALPHA = 1.41421356237309515f;
constexpr int C_Q = 0, C_K = 512, C_V = 640, C_QI = 768, C_KI = 1024, C_WI = 1056;
constexpr int C_R = UA, C_RK = UA + 512, C_RV = UA + 1024, C_XW = UA + 1536, C_XA = UA + 1600, C_XG = UA + 1664;

constexpr size_t MiB = 1u << 20;
constexpr size_t WS_CTL = 0;
constexpr size_t WS_HM = 1 * MiB;
constexpr size_t WS_WSMALL = 2 * MiB;
constexpr size_t WSMALL_LAYER = 14 * MiB;
constexpr size_t WS_HB = 30 * MiB;
constexpr size_t WS_UAR = 63 * MiB;
constexpr size_t WS_GATES = 161 * MiB;
constexpr size_t WS_OAB = 226 * MiB;
constexpr size_t WS_LIST = WS_GATES + 48 * MiB;
constexpr size_t WS_END = 308 * MiB;
constexpr size_t WS_MERGED = WS_UAR;
constexpr size_t WS_ACT = WS_UAR + 33 * MiB;
constexpr size_t WS_WEXP = WS_GATES;
constexpr int ACT_ROWS_MAX = 16448 + 24 * 256;
static_assert(WS_ACT + (size_t)ACT_ROWS_MAX * 2048 <= WS_GATES, "act fits");
constexpr int CW_CLS = 64;

constexpr int LDS_BYTES = 155648;

struct Params {
    const float* in[29];
    float* out;
    unsigned char* ws;
};
enum { I_X = 0, I_META, I_LNIN_G, I_LNIN_B, I_WIN, I_BGATE, I_MU, I_W0, I_WUP, I_A0, I_AUP, I_GUP, I_KK, I_KA, I_RK, I_GNG, I_GNB,
       I_WBA, I_WBB, I_WOUT, I_LN1G, I_LN1B, I_LN2G, I_LN2B, I_WROUTER, I_BROUTER, I_WEXP1, I_WEXP3, I_WEXP2 };

__device__ __forceinline__ int otid() { int t = threadIdx.x; asm volatile("" : "+v"(t)); return t; }
__device__ __forceinline__ int ozero() { int z = 0; asm volatile("" : "+s"(z)); return z; }
__device__ __forceinline__ int obid() { int b = blockIdx.x; asm volatile("" : "+s"(b)); return b; }
__device__ __forceinline__ unsigned f2bf(float f) { unsigned u = __builtin_bit_cast(unsigned, f); return (u + 0x7fffu + ((u >> 16) & 1u)) >> 16; }
__device__ __forceinline__ unsigned pk2(float lo, float hi) { return f2bf(lo) | (f2bf(hi) << 16); }
__device__ __forceinline__ float bf2f(unsigned short b) { return __builtin_bit_cast(float, (unsigned)b << 16); }
__device__ __forceinline__ float bflo(unsigned w) { return __builtin_bit_cast(float, w << 16); }
__device__ __forceinline__ float bfhi(unsigned w) { return __builtin_bit_cast(float, w & 0xffff0000u); }
__device__ __forceinline__ float wave_sum(float v) {
#pragma unroll
    for (int o = 1; o < 64; o <<= 1) v += __shfl_xor(v, o);
    return v;
}
__device__ __forceinline__ float wave_max(float v) {
#pragma unroll
    for (int o = 1; o < 64; o <<= 1) v = fmaxf(v, __shfl_xor(v, o));
    return v;
}
__device__ __forceinline__ float sigmoidf_(float x) { return 1.0f / (1.0f + __expf(-x)); }
__device__ __forceinline__ float* hrow(const Params& p, int r) {
    const int b = r / LP, pos = r - b * LP;
    return pos >= 64 ? p.out + ((size_t)(b * SEQ + (pos - 64)) << 10) : (float*)(p.ws + WS_HM) + ((size_t)(b * 64 + pos) << 10);
}
__device__ __forceinline__ bool is_dummy(int r) { return (r % LP) < PADM; }

__device__ __forceinline__ void transpose_item(const float* src, int ld_src, int col0, int nvalid, bf16_t* dst  , int ld_dst, LAS float* scr, int lane) {
    const int c = lane & 31;
#pragma unroll 8
    for (int i = 0; i < 32; ++i) { const int kk = 2 * i + (lane >> 5); scr[kk * 33 + c] = c < nvalid ? src[(size_t)kk * ld_src + col0 + c] : 0.f; }
    asm volatile("s_waitcnt lgkmcnt(0)" ::: "memory");
    const int ch = lane & 7;
#pragma unroll
    for (int j = 0; j < 4; ++j) { const int n = (lane >> 3) + 8 * j; const LAS float* s = scr + (8 * ch) * 33 + n;
        u32x4 o; o.x = pk2(s[0 * 33], s[1 * 33]); o.y = pk2(s[2 * 33], s[3 * 33]); o.z = pk2(s[4 * 33], s[5 * 33]); o.w = pk2(s[6 * 33], s[7 * 33]);
        *(u32x4*)(dst + (size_t)n * ld_dst + 8 * ch) = o; }
    asm volatile("s_waitcnt lgkmcnt(0)" ::: "memory");
}

namespace g8 {
constexpr int BM = 256, BK = 64, HALF = 128, HTB = HALF * BK * 2, STAGE_BYTES = 8 * HTB;
__host__ __device__ __forceinline__ int lds_byte(int r, int c) { const int st = (r >> 4) * 2 + (c >> 5), rr = r & 15, cc = c & 31, ob = rr * 64 + cc * 2; return st * 1024 + (ob ^ (((ob >> 9) & 1) << 5)); }
__host__ __device__ __forceinline__ void stage_rc(int b, int& R, int& C) { const int st = b / 1024, sb = b % 1024, swz = sb ^ (((sb >> 9) & 1) << 5); R = (st >> 1) * 16 + swz / 64; C = (st & 1) * 32 + (swz % 64) / 2; }
__host__ __device__ __forceinline__ int perm32(int rho) { const int n = rho >> 4, i = rho & 15; return 8 * (i >> 2) + 4 * n + (i & 3); }

struct KSeg {
    const char* A;
    const char* B0;
    const char* B1;
    int nt;
    int nt0;
    const char* A2;
    const char* B02;
    const char* B12;
};
__device__ __forceinline__ KSeg seg1(const char* A, const char* B0, const char* B1, int nt) { KSeg s; s.A = A; s.B0 = B0; s.B1 = B1; s.nt = nt; s.nt0 = nt; s.A2 = A; s.B02 = B0; s.B12 = B1; return s; }
typedef f32x4 Acc[2][2][4][2];

template <bool GATHER, bool TWOSEG>
__device__ __forceinline__ void kloop(LAS unsigned char* lds, Acc& acc, const KSeg s, const unsigned (&voffA)[2][2], const unsigned (&voffB)[2], const unsigned hstepA) {
    int tid = threadIdx.x; asm volatile("" : "+v"(tid));
    const int wid = __builtin_amdgcn_readfirstlane(tid >> 6), lane = tid & 63, wr = wid >> 2, wc = wid & 3, fr = lane & 15, fq = lane >> 4;
    const unsigned ldsw = (unsigned)wid * 1024u;
    const int aoff = lds_byte(wr * 64 + fr, fq * 8), boff = lds_byte(wc * 32 + fr, fq * 8);
    const int nt = s.nt;
#define G8_SA(b, h) (((b) * 2 + (h)) * HTB)
#define G8_SB(b, h) ((4 + (b) * 2 + (h)) * HTB)
#define G8_STAGE(bufoff, gbase, voff) do { _Pragma("unroll") for (int _i = 0; _i < 2; ++_i) \
        __builtin_amdgcn_global_load_lds((const unsigned*)((const char*)(gbase) + (voff)[_i]), (LAS unsigned*)(lds + (bufoff) + ldsw + _i * 8192), 16, 0, 0); } while (0)
#define G8_LDA(dst, b, h) do { _Pragma("unroll") for (int m = 0; m < 4; ++m) _Pragma("unroll") for (int k = 0; k < 2; ++k) dst[m][k] = *(const LAS bf16x8*)(lds + G8_SA(b, h) + aoff + m * 2048 + k * 1024); } while (0)
#define G8_LDB(dst, b, h) do { _Pragma("unroll") for (int n = 0; n < 2; ++n) _Pragma("unroll") for (int k = 0; k < 2; ++k) dst[n][k] = *(const LAS bf16x8*)(lds + G8_SB(b, h) + boff + n * 2048 + k * 1024); } while (0)
#define G8_MMA(ai, bj, At, Bt) do { __builtin_amdgcn_s_setprio(1); _Pragma("unroll") for (int m = 0; m < 4; ++m) _Pragma("unroll") for (int n = 0; n < 2; ++n) _Pragma("unroll") for (int k = 0; k < 2; ++k) \
        acc[ai][bj][m][n] = __builtin_amdgcn_mfma_f32_16x16x32_bf16(Bt[n][k], At[m][k], acc[ai][bj][m][n], 0, 0, 0); __builtin_amdgcn_s_setprio(0); } while (0)
#define G8_WAIT_V(n) asm volatile("s_waitcnt vmcnt(" #n ")" ::: "memory")
#define G8_WAIT_L(n) asm volatile("s_waitcnt lgkmcnt(" #n ")" ::: "memory")
#define G8_BAR __builtin_amdgcn_s_barrier()
#define G8_SCHED __builtin_amdgcn_sched_barrier(0)
    bf16x8 At[4][2], B0[2][2], B1[2][2];
    const char* pA = s.A; const char* pB0 = s.B0; const char* pB1 = s.B1;
    constexpr int KS = BK * 2;
    const int nt0 = TWOSEG ? s.nt0 : 0; const char* qA = TWOSEG ? s.A2 - (size_t)nt0 * KS : pA; const char* qB0 = TWOSEG ? s.B02 - (size_t)nt0 * KS : pB0; const char* qB1 = TWOSEG ? s.B12 - (size_t)nt0 * KS : pB1;
#define G8_TA(t) ((TWOSEG ? ((t) < nt0 ? pA : qA) : pA) + (size_t)(t) * KS)
#define G8_TB0(t) ((TWOSEG ? ((t) < nt0 ? pB0 : qB0) : pB0) + (size_t)(t) * KS)
#define G8_TB1(t) ((TWOSEG ? ((t) < nt0 ? pB1 : qB1) : pB1) + (size_t)(t) * KS)
#define G8_VA1 voffA[GATHER ? 1 : 0]
#define G8_H1(ptr) ((ptr) + (GATHER ? 0u : hstepA))
    G8_STAGE(G8_SB(0, 0), pB0, voffB); G8_STAGE(G8_SA(0, 0), pA, voffA[0]); G8_STAGE(G8_SB(0, 1), pB1, voffB); G8_STAGE(G8_SA(0, 1), G8_H1(pA), G8_VA1);
    if (wr == 1) G8_BAR;
    G8_WAIT_V(4); G8_BAR;
    G8_STAGE(G8_SB(1, 0), pB0 + KS, voffB); G8_STAGE(G8_SA(1, 0), pA + KS, voffA[0]); G8_STAGE(G8_SB(1, 1), pB1 + KS, voffB);
    G8_WAIT_V(6); G8_BAR;
    for (int t = 0; t < nt - 2; t += 2) {
        const char* a1 = G8_TA(t + 1);
        const char* a2 = G8_TA(t + 2); const char* b02 = G8_TB0(t + 2); const char* b12 = G8_TB1(t + 2);
        const char* a3 = G8_TA(t + 3); const char* b03 = G8_TB0(t + 3); const char* b13 = G8_TB1(t + 3);
        G8_LDB(B0, 0, 0); G8_SCHED; G8_LDA(At, 0, 0); G8_STAGE(G8_SA(1, 1), G8_H1(a1), G8_VA1);
        G8_WAIT_L(8); G8_BAR; G8_WAIT_L(0); G8_MMA(0, 0, At, B0); G8_BAR; G8_SCHED;
        G8_LDB(B1, 0, 1); G8_STAGE(G8_SB(0, 0), b02, voffB);
        G8_BAR; G8_WAIT_L(0); G8_MMA(0, 1, At, B1); G8_BAR;
        G8_LDA(At, 0, 1); G8_STAGE(G8_SA(0, 0), a2, voffA[0]);
        G8_BAR; G8_WAIT_L(0); G8_MMA(1, 0, At, B0); G8_BAR; G8_SCHED;
        G8_STAGE(G8_SB(0, 1), b12, voffB);
        G8_WAIT_V(6); G8_BAR; G8_MMA(1, 1, At, B1); G8_BAR;
        G8_LDB(B0, 1, 0); G8_SCHED; G8_LDA(At, 1, 0); G8_STAGE(G8_SA(0, 1), G8_H1(a2), G8_VA1);
        G8_WAIT_L(8); G8_BAR; G8_WAIT_L(0); G8_MMA(0, 0, At, B0); G8_BAR; G8_SCHED;
        G8_LDB(B1, 1, 1); G8_STAGE(G8_SB(1, 0), b03, voffB);
        G8_BAR; G8_WAIT_L(0); G8_MMA(0, 1, At, B1); G8_BAR;
        G8_LDA(At, 1, 1); G8_STAGE(G8_SA(1, 0), a3, voffA[0]);
        G8_BAR; G8_WAIT_L(0); G8_MMA(1, 0, At, B0); G8_BAR; G8_SCHED;
        G8_STAGE(G8_SB(1, 1), b13, voffB);
        G8_WAIT_V(6); G8_BAR; G8_MMA(1, 1, At, B1); G8_BAR;
    }
    { const char* a1 = G8_TA(nt - 1);
      G8_LDB(B0, 0, 0); G8_LDA(At, 0, 0); G8_STAGE(G8_SA(1, 1), G8_H1(a1), G8_VA1);
      G8_BAR; G8_WAIT_L(0); G8_MMA(0, 0, At, B0); G8_BAR;
      G8_LDB(B1, 0, 1); G8_BAR; G8_WAIT_L(0); G8_MMA(0, 1, At, B1); G8_BAR;
      G8_LDA(At, 0, 1); G8_WAIT_V(4); G8_BAR; G8_WAIT_L(0); G8_MMA(1, 0, At, B0); G8_MMA(1, 1, At, B1); G8_BAR; }
    { G8_LDB(B0, 1, 0); G8_LDA(At, 1, 0); G8_WAIT_V(2); G8_BAR; G8_WAIT_L(0); G8_MMA(0, 0, At, B0); G8_BAR;
      G8_LDB(B1, 1, 1); G8_WAIT_V(0); G8_BAR; G8_WAIT_L(0); G8_MMA(0, 1, At, B1); G8_BAR;
      G8_LDA(At, 1, 1); G8_BAR; G8_WAIT_L(0); G8_MMA(1, 0, At, B0); G8_MMA(1, 1, At, B1); G8_BAR; }
    if (wr == 0) G8_BAR;
#undef G8_TA
#undef G8_VA1
#undef G8_H1
#undef G8_TB0
#undef G8_TB1
#undef G8_SA
#undef G8_SB
#undef G8_STAGE
#undef G8_LDA
#undef G8_LDB
#undef G8_MMA
#undef G8_WAIT_V
#undef G8_WAIT_L
#undef G8_BAR
#undef G8_SCHED
}
__device__ __forceinline__ void zero_acc(Acc& acc) {
#pragma unroll
    for (int a = 0; a < 2; ++a)
#pragma unroll
        for (int b = 0; b < 2; ++b)
#pragma unroll
            for (int m = 0; m < 4; ++m)
#pragma unroll
                for (int n = 0; n < 2; ++n) acc[a][b][m][n] = (f32x4){0.f, 0.f, 0.f, 0.f};
}
__device__ __forceinline__ void make_voff_contig(unsigned (&voffA)[2][2], unsigned pitchA) {
    int tid = threadIdx.x; asm volatile("" : "+v"(tid));
#pragma unroll
    for (int i = 0; i < 2; ++i) { int R, C; stage_rc(tid * 16 + i * 8192, R, C);
        voffA[0][i] = (unsigned)R * pitchA + (unsigned)C * 2u; voffA[1][i] = 0u; }
}
__device__ __forceinline__ void make_voffB(unsigned (&voffB)[2], unsigned pitchB, bool perm) {
    int tid = threadIdx.x; asm volatile("" : "+v"(tid));
#pragma unroll
    for (int i = 0; i < 2; ++i) { int R, C; stage_rc(tid * 16 + i * 8192, R, C); const int Rb = perm ? ((R & ~31) + perm32(R & 31)) : R;
        voffB[i] = (unsigned)Rb * pitchB + (unsigned)C * 2u; }
}
}

__device__ __forceinline__ bool unit_order(int i, int G, int c, int nM, int nN, int& pm, int& pn) {
    const int nwg = nM * nN; const long L = (long)i * G + c; if (L >= nwg) return false;
    int wgid = (int)L; { const int q = nwg / 8, r = nwg % 8, xcd = wgid % 8, off = wgid / 8; wgid = (xcd < r ? xcd * (q + 1) : r * (q + 1) + (xcd - r) * q) + off; }
    const int WGM = 8, nig = WGM * nN, gid = wgid / nig, fm = gid * WGM, gsz = (nM - fm) < WGM ? (nM - fm) : WGM;
    pm = fm + ((wgid % nig) % gsz); pn = (wgid % nig) / gsz; return true;
}

__device__ __forceinline__ void conv_small_weights(const Params& p, LAS unsigned char* lds) {
    const int tid = otid(), lane = tid & 63, wave = tid >> 6, gw = obid() * NWAVES + wave, NGW = gridDim.x * NWAVES;
    LAS float* scr = (LAS float*)(lds + wave * 16384);
    constexpr int I_IN = 16 * (NIN / 32), I_A = 8 * 32, I_O = 16 * 32, I_L = 64, PER = I_IN + 2 * I_A + I_O + I_L;
    for (int it = gw; it < DEPTH * PER; it += NGW) {
        const int l = it / PER; int r = it % PER;
        unsigned char* wl = p.ws + WS_WSMALL + (size_t)l * WSMALL_LAYER;
        if (r < I_IN) { const int kb = r / (NIN / 32), nb = r % (NIN / 32), n0 = nb * 32, k0 = kb * 64;
            int col0, nvalid; if (n0 < UA) { col0 = n0; nvalid = A_COLS - n0; nvalid = nvalid < 0 ? 0 : (nvalid > 32 ? 32 : nvalid); } else { col0 = n0 - (UA - A_COLS); nvalid = 32; }
            transpose_item(p.in[I_WIN] + (size_t)l * D * IN_COLS + (size_t)k0 * IN_COLS, IN_COLS, col0, nvalid, (bf16_t*)wl + (size_t)n0 * D + k0, D, scr, lane); continue; }
        r -= I_IN;
        if (r < 2 * I_A) { const int which = r / I_A; r %= I_A; const int kb = r / 32, nb = r % 32;
            const float* src = p.in[which ? I_WBB : I_WBA] + (size_t)l * 512 * D + (size_t)(kb * 64) * D;
            transpose_item(src, D, nb * 32, 32, (bf16_t*)(wl + (10 + which) * MiB) + (size_t)(nb * 32) * 512 + kb * 64, 512, scr, lane); continue; }
        r -= 2 * I_A;
        if (r < I_O) { const int kb = r / 32, nb = r % 32;
          transpose_item(p.in[I_WOUT] + (size_t)l * D * D + (size_t)(kb * 64) * D, D, nb * 32, 32, (bf16_t*)(wl + 12 * MiB) + (size_t)(nb * 32) * D + kb * 64, D, scr, lane); continue; }
        r -= I_O;
        { bf16_t* lo = (bf16_t*)(p.ws + 65536 + (size_t)l * 262144);
          if (r < 16) transpose_item(p.in[I_WUP] + (size_t)l * 64 * 512, 512, r * 32, 32, lo + (size_t)(r * 32) * 64, 64, scr, lane);
          else if (r < 32) transpose_item(p.in[I_AUP] + (size_t)l * 64 * 512, 512, (r - 16) * 32, 32, lo + 32768 + (size_t)((r - 16) * 32) * 64, 64, scr, lane);
          else { const int q = r - 32, kb = q >> 4, nb = q & 15; transpose_item(p.in[I_GUP] + (size_t)l * 128 * 512 + (size_t)(kb * 64) * 512, 512, nb * 32, 32, lo + 65536 + (size_t)(nb * 32) * 128 + kb * 64, 128, scr, lane); } }
    }
}
__device__ __forceinline__ void conv_expert_weights(const Params& p, int l, LAS unsigned char* lds) {
    const int tid = otid(), lane = tid & 63, wave = tid >> 6, gw = obid() * NWAVES + wave, NGW = gridDim.x * NWAVES;
    LAS float* scr = (LAS float*)(lds + wave * 16384);
    constexpr int I_13 = 16 * 32, I_2 = 8 * 32, PER = I_13 + I_2;
    for (int it = gw; it < 16 * PER; it += NGW) {
        const int e = it / PER; int r = it % PER;
        if (r < I_13) { const int kb = r / 32, nb = r % 32, n0 = nb * 32, j = n0 >> 8, half = (n0 >> 7) & 1, c = 128 * j + (n0 & 127);
            const float* src = p.in[half ? I_WEXP3 : I_WEXP1] + (size_t)(l * 16 + e) * D * 512 + (size_t)(kb * 64) * 512;
            transpose_item(src, 512, c, 32, (bf16_t*)(p.ws + WS_WEXP) + (size_t)e * 1024 * 1024 + (size_t)n0 * 1024 + kb * 64, 1024, scr, lane); continue; }
        r -= I_13;
        { const int kb = r / 32, nb = r % 32;
          const float* src = p.in[I_WEXP2] + (size_t)(l * 16 + e) * 512 * D + (size_t)(kb * 64) * D;
          transpose_item(src, D, nb * 32, 32, (bf16_t*)(p.ws + WS_WEXP + 32 * MiB) + (size_t)e * 1024 * 512 + (size_t)(nb * 32) * 512 + kb * 64, 512, scr, lane); }
    }
}

__device__ __forceinline__ void ln_wave(f32x4 (&v)[4], const float* g, const float* bta, int lane) {
    float s = 0.f;
#pragma unroll
    for (int j = 0; j < 4; ++j) s += (v[j][0] + v[j][1]) + (v[j][2] + v[j][3]);
    const float mean = wave_sum(s) * (1.f / D); float s2 = 0.f;
#pragma unroll
    for (int j = 0; j < 4; ++j) { v[j] = v[j] - mean; s2 += (v[j][0] * v[j][0] + v[j][1] * v[j][1]) + (v[j][2] * v[j][2] + v[j][3] * v[j][3]); }
    const float rstd = 1.f / sqrtf(wave_sum(s2) * (1.f / D) + LN_EPS);
#pragma unroll
    for (int j = 0; j < 4; ++j) { const f32x4 gg = *(const f32x4*)(g + 4 * lane + 256 * j), bb = *(const f32x4*)(bta + 4 * lane + 256 * j); v[j] = v[j] * rstd * gg + bb; }
}
__device__ __forceinline__ void store_row(const Params& p, int r, const f32x4 (&v)[4], int lane, bool zero) {
    float* hr = hrow(p, r); bf16_t* hb = (bf16_t*)(p.ws + WS_HB) + (size_t)r * D;
#pragma unroll
    for (int j = 0; j < 4; ++j) { const f32x4 o = zero ? (f32x4){0.f, 0.f, 0.f, 0.f} : v[j];
        *(f32x4*)(hr + 4 * lane + 256 * j) = o; u32x2 w; w.x = pk2(o[0], o[1]); w.y = pk2(o[2], o[3]); *(u32x2*)(hb + 4 * lane + 256 * j) = w; }
}
__device__ __forceinline__ void ln_in_phase(const Params& p) {
    const int tid = otid(), lane = tid & 63, gw = obid() * NWAVES + (tid >> 6), NGW = gridDim.x * NWAVES;
    for (int r = gw; r < T; r += NGW) {
        const int b = r / LP, pos = r - b * LP; f32x4 v[4];
        if (pos < PADM) {
#pragma unroll
            for (int j = 0; j < 4; ++j) v[j] = (f32x4){0.f, 0.f, 0.f, 0.f};
            store_row(p, r, v, lane, true); continue; }
        const float* src = pos < 64 ? p.in[I_META] + (size_t)(pos - PADM) * D : p.in[I_X] + ((size_t)(b * SEQ + pos - 64) << 10);
#pragma unroll
        for (int j = 0; j < 4; ++j) v[j] = *(const f32x4*)(src + 4 * lane + 256 * j);
        ln_wave(v, p.in[I_LNIN_G], p.in[I_LNIN_B], lane);
        store_row(p, r, v, lane, false);
    }
}

__device__ __forceinline__ const Params& PP() { const Params* q = (const Params*)__builtin_amdgcn_kernarg_segment_ptr(); asm volatile("" : "+s"(q)); return *q; }

#define EPI_COORDS() int tid_ = threadIdx.x; asm volatile("" : "+v"(tid_)); const int wid = tid_ >> 6, lane = tid_ & 63, wr = wid >> 2, wc = wid & 3, fr = lane & 15, fq = lane >> 4; (void)wr; (void)wc; (void)fr; (void)fq
__device__ __forceinline__ void inproj_phase(const Params& p, int l, LAS unsigned char* lds) {
    unsigned voffA[2][2], voffB[2]; g8::make_voff_contig(voffA, D * 2); g8::make_voffB(voffB, D * 2, true);
    int pm, pn; const int bid = obid();
    for (int i = 0; unit_order(i, gridDim.x, bid, T / 256, NIN / 256, pm, pn); ++i) {
        g8::Acc acc; g8::zero_acc(acc);
        const char* Ab = (const char*)(PP().ws + WS_HB); const char* Bb = (const char*)(PP().ws + WS_WSMALL + (size_t)l * WSMALL_LAYER);
        const g8::KSeg s = g8::seg1(Ab + (size_t)pm * 256 * D * 2, Bb + (size_t)pn * 256 * D * 2, Bb + (size_t)(pn * 256 + 128) * D * 2, D / 64);
        g8::kloop<false, false>(lds, acc, s, voffA, voffB, 128 * D * 2);
        EPI_COORDS();
        const int row0 = pm * 256 + wr * 64 + fr;
        if (pn < 12) {
            bf16_t* O = (bf16_t*)(PP().ws + WS_UAR);
#pragma unroll
            for (int ai = 0; ai < 2; ++ai)
#pragma unroll
                for (int m = 0; m < 4; ++m) { asm volatile("" ::: "memory"); bf16_t* rp = O + (size_t)(row0 + ai * 128 + m * 16) * UARW + pn * 256 + wc * 32 + 8 * fq;
#pragma unroll
                    for (int bj = 0; bj < 2; ++bj) { const f32x4 v0 = acc[ai][bj][m][0], v1 = acc[ai][bj][m][1]; u32x4 w; w.x = pk2(v0[0], v0[1]); w.y = pk2(v0[2], v0[3]); w.z = pk2(v1[0], v1[1]); w.w = pk2(v1[2], v1[3]);
                        *(u32x4*)(rp + bj * 128) = w; } }
        } else {
            bf16_t* O = (bf16_t*)(PP().ws + WS_GATES); const int colb = (pn - 12) * 256 + wc * 32 + 8 * fq; const float* bg = PP().in[I_BGATE] + l * 2048;
            f32x4 bv[2][2];
#pragma unroll
            for (int bj = 0; bj < 2; ++bj) { bv[bj][0] = *(const f32x4*)(bg + colb + bj * 128); bv[bj][1] = *(const f32x4*)(bg + colb + bj * 128 + 4); }
#pragma unroll
            for (int ai = 0; ai < 2; ++ai)
#pragma unroll
                for (int m = 0; m < 4; ++m) { asm volatile("" ::: "memory"); bf16_t* rp = O + (size_t)(row0 + ai * 128 + m * 16) * 2048 + colb;
#pragma unroll
                    for (int bj = 0; bj < 2; ++bj) { f32x4 v0 = acc[ai][bj][m][0] + bv[bj][0], v1 = acc[ai][bj][m][1] + bv[bj][1];
#pragma unroll
                        for (int e = 0; e < 4; ++e) { v0[e] = sigmoidf_(v0[e]); v1[e] = sigmoidf_(v1[e]); }
                        u32x4 w; w.x = pk2(v0[0], v0[1]); w.y = pk2(v0[2], v0[3]); w.z = pk2(v1[0], v1[1]); w.w = pk2(v1[2], v1[3]);
                        *(u32x4*)(rp + bj * 128) = w; } }
        }
    }
}
__device__ __forceinline__ void merge_phase(const Params& p, int l, LAS unsigned char* lds) {
    unsigned voffA[2][2], voffB[2]; g8::make_voff_contig(voffA, D * 2); g8::make_voffB(voffB, 512 * 2, true);
    int pm, pn; const int bid = obid();
    for (int i = 0; unit_order(i, gridDim.x, bid, T / 256, 4, pm, pn); ++i) {
#pragma unroll 1
        for (int br = 0; br < 2; ++br) {
            g8::Acc acc; g8::zero_acc(acc);
            const char* Bt = (const char*)(PP().ws + WS_WSMALL + (size_t)l * WSMALL_LAYER) + (10 + br) * MiB + (size_t)pn * 256 * 512 * 2;
            const g8::KSeg s = g8::seg1((const char*)(PP().ws + WS_OAB) + (size_t)pm * 256 * D * 2 + br * 1024, Bt, Bt + (size_t)128 * 512 * 2, 8);
            g8::kloop<false, false>(lds, acc, s, voffA, voffB, 128 * D * 2);
            EPI_COORDS();
            const bf16_t* GT = (const bf16_t*)(PP().ws + WS_GATES); bf16_t* O = (bf16_t*)(PP().ws + WS_MERGED);
            const int row0 = pm * 256 + wr * 64 + fr, colb = pn * 256 + wc * 32 + 8 * fq;
#pragma unroll
            for (int ai = 0; ai < 2; ++ai)
#pragma unroll
                for (int m = 0; m < 4; ++m) { asm volatile("" ::: "memory"); const size_t ro = (size_t)(row0 + ai * 128 + m * 16); const bf16_t* gp = GT + ro * 2048 + br * 1024 + colb; bf16_t* op = O + ro * D + colb;
#pragma unroll
                    for (int bj = 0; bj < 2; ++bj) { const u32x4 g = *(const u32x4*)(gp + bj * 128); const f32x4 v0 = acc[ai][bj][m][0], v1 = acc[ai][bj][m][1];
                        float o[8] = {v0[0] * bflo(g.x), v0[1] * bfhi(g.x), v0[2] * bflo(g.y), v0[3] * bfhi(g.y), v1[0] * bflo(g.z), v1[1] * bfhi(g.z), v1[2] * bflo(g.w), v1[3] * bfhi(g.w)};
                        if (br) { const u32x4 pr = *(const u32x4*)(op + bj * 128);
                            o[0] += bflo(pr.x); o[1] += bfhi(pr.x); o[2] += bflo(pr.y); o[3] += bfhi(pr.y); o[4] += bflo(pr.z); o[5] += bfhi(pr.z); o[6] += bflo(pr.w); o[7] += bfhi(pr.w); }
                        u32x4 w; w.x = pk2(o[0], o[1]); w.y = pk2(o[2], o[3]); w.z = pk2(o[4], o[5]); w.w = pk2(o[6], o[7]);
                        *(u32x4*)(op + bj * 128) = w; } }
        }
    }
}
__device__ __forceinline__ void wout_phase(const Params& p, int l, LAS unsigned char* lds) {
    unsigned voffA[2][2], voffB[2]; g8::make_voff_contig(voffA, D * 2); g8::make_voffB(voffB, D * 2, false);
    int pm, pn; const int bid = obid();
    for (int i = 0; unit_order(i, gridDim.x, bid, T / 256, 4, pm, pn); ++i) {
        g8::Acc acc; g8::zero_acc(acc);
        const char* Ab = (const char*)(PP().ws + WS_MERGED); const char* Bb = (const char*)(PP().ws + WS_WSMALL + (size_t)l * WSMALL_LAYER + 12 * MiB);
        const g8::KSeg s = g8::seg1(Ab + (size_t)pm * 256 * D * 2, Bb + (size_t)pn * 256 * D * 2, Bb + (size_t)(pn * 256 + 128) * D * 2, D / 64);
        g8::kloop<false, false>(lds, acc, s, voffA, voffB, 128 * D * 2);
        EPI_COORDS();
        const int row0 = pm * 256 + wr * 64 + fr, col0 = pn * 256 + wc * 32 + 4 * fq;
#pragma unroll
        for (int ai = 0; ai < 2; ++ai)
#pragma unroll
            for (int m = 0; m < 4; ++m) { asm volatile("" ::: "memory"); float* hr = hrow(PP(), row0 + ai * 128 + m * 16) + col0;
#pragma unroll
                for (int bj = 0; bj < 2; ++bj)
#pragma unroll
                    for (int n = 0; n < 2; ++n) { f32x4* hp = (f32x4*)(hr + bj * 128 + n * 16); *hp = *hp * ALPHA + acc[ai][bj][m][n]; } }
    }
}

constexpr int ATTN_WAVE_LDS = 16640 + 1024 + 2048 + 64 + 512;
__device__ __forceinline__ unsigned score_key(float s) { s += 0.0f; const unsigned u = __builtin_bit_cast(unsigned, s); return (u & 0x80000000u) ? ~u : (u | 0x80000000u); }
__device__ void attn_naive_query(const Params& p, int row, unsigned char* wl, int lane) {
    const bf16_t* U = (const bf16_t*)(p.ws + WS_UAR);
    bf16_t* OA = (bf16_t*)(p.ws + WS_OAB) + (size_t)row * D;
    const int b = row / LP, pos = row - b * LP;
    if (pos < PADM) {
#pragma unroll
        for (int j = 0; j < 8; ++j) OA[j * 64 + lane] = 0;
        return;
    }
    const int nadm = 64 * ((pos >> 6) + 1) - PADM;
    unsigned* keys = (unsigned*)wl; float* p_s = (float*)wl;
    float* qi_s = (float*)(wl + 16640); float* q_s = qi_s + 256; float* w_s = q_s + 512; unsigned short* sel_s = (unsigned short*)(w_s + 16);
    const bf16_t* urow = U + (size_t)row * UARW;
    for (int i = lane; i < 256; i += 64) qi_s[i] = bf2f(urow[C_QI + i]);
    for (int i = lane; i < 512; i += 64) q_s[i] = bf2f(urow[C_Q + i]);
    if (lane < 8) w_s[lane] = bf2f(urow[C_WI + lane]);
    __builtin_amdgcn_fence(__ATOMIC_RELEASE, "wavefront"); __builtin_amdgcn_wave_barrier(); __builtin_amdgcn_fence(__ATOMIC_ACQUIRE, "wavefront");
    const int nj = (nadm + 63) >> 6;
    for (int j = 0; j < nj; ++j) {
        const int ki_idx = lane + 64 * j; unsigned key = 0u;
        if (ki_idx < nadm) {
            const u32x4* kp = (const u32x4*)(U + (size_t)(b * LP + PADM + ki_idx) * UARW + C_KI);
            float kf[32];
#pragma unroll
            for (int c4 = 0; c4 < 4; ++c4) { const u32x4 w = kp[c4];
                kf[c4 * 8 + 0] = bflo(w.x); kf[c4 * 8 + 1] = bfhi(w.x); kf[c4 * 8 + 2] = bflo(w.y); kf[c4 * 8 + 3] = bfhi(w.y);
                kf[c4 * 8 + 4] = bflo(w.z); kf[c4 * 8 + 5] = bfhi(w.z); kf[c4 * 8 + 6] = bflo(w.w); kf[c4 * 8 + 7] = bfhi(w.w); }
            float sc = 0.f;
#pragma unroll 1
            for (int h = 0; h < 8; ++h) { float d = 0.f; asm volatile("" ::: "memory");
#pragma unroll
                for (int e = 0; e < 32; ++e) d = fmaf(qi_s[h * 32 + e], kf[e], d);
                sc = fmaf(w_s[h], fmaxf(d, 0.f), sc); }
            key = score_key(sc); if (key == 0u) key = 1u;
        }
        keys[ki_idx] = key;
    }
    __builtin_amdgcn_fence(__ATOMIC_RELEASE, "wavefront"); __builtin_amdgcn_wave_barrier(); __builtin_amdgcn_fence(__ATOMIC_ACQUIRE, "wavefront");
    unsigned thr = 0u; int need_ties = 0x7fffffff;
    if (nadm > 256) {
        unsigned prefix = 0u; int remaining = 256;
        for (int bit = 31; bit >= 0; --bit) {
            const unsigned cand = prefix | (1u << bit); int cnt = 0;
            for (int j = 0; j < nj; ++j) { const unsigned k = keys[lane + 64 * j]; cnt += __builtin_popcountll(__ballot((k >> bit) == (cand >> bit))); }
            if (cnt >= remaining) prefix = cand; else remaining -= cnt;
        }
        thr = prefix; need_ties = remaining;
    } else thr = 1u;
    int nsel = 0, ties_seen = 0;
    for (int j = 0; j < nj; ++j) {
        const unsigned k = keys[lane + 64 * j];
        const unsigned long long tm = __ballot(k == thr && k != 0u);
        const unsigned long long lt = (1ull << lane) - 1ull;
        const int myrank = ties_seen + __builtin_popcountll(tm & lt);
        const bool selme = (k > thr) || (k == thr && k != 0u && myrank < need_ties);
        const unsigned long long sm = __ballot(selme);
        if (selme) sel_s[nsel + __builtin_popcountll(sm & lt)] = (unsigned short)(PADM + lane + 64 * j);
        nsel += __builtin_popcountll(sm); ties_seen += __builtin_popcountll(tm);
    }
    __builtin_amdgcn_fence(__ATOMIC_RELEASE, "wavefront"); __builtin_amdgcn_wave_barrier(); __builtin_amdgcn_fence(__ATOMIC_ACQUIRE, "wavefront");
    float sc[4][8];
#pragma unroll
    for (int m = 0; m < 4; ++m) {
        asm volatile("" ::: "memory");
        const int i = lane + 64 * m; const bool valid = i < nsel; const int ps = valid ? sel_s[i] : PADM;
        const bf16_t* krow = U + (size_t)(b * LP + ps) * UARW + C_K;
#pragma unroll
        for (int n = 0; n < 2; ++n) {
            float a0 = 0.f, a1 = 0.f, a2 = 0.f, a3 = 0.f;
#pragma unroll 1
            for (int c8 = 0; c8 < 8; ++c8) { asm volatile("" ::: "memory"); const u32x4 w = *(const u32x4*)(krow + n * 64 + c8 * 8);
                float kf[8] = {bflo(w.x), bfhi(w.x), bflo(w.y), bfhi(w.y), bflo(w.z), bfhi(w.z), bflo(w.w), bfhi(w.w)};
#pragma unroll
                for (int e = 0; e < 8; ++e) { const int dd = c8 * 8 + e;
                    a0 = fmaf(q_s[(n * 4 + 0) * 64 + dd], kf[e], a0); a1 = fmaf(q_s[(n * 4 + 1) * 64 + dd], kf[e], a1);
                    a2 = fmaf(q_s[(n * 4 + 2) * 64 + dd], kf[e], a2); a3 = fmaf(q_s[(n * 4 + 3) * 64 + dd], kf[e], a3); } }
            sc[m][n * 4 + 0] = valid ? a0 * 0.125f : -INFINITY; sc[m][n * 4 + 1] = valid ? a1 * 0.125f : -INFINITY;
            sc[m][n * 4 + 2] = valid ? a2 * 0.125f : -INFINITY; sc[m][n * 4 + 3] = valid ? a3 * 0.125f : -INFINITY;
        }
    }
    __builtin_amdgcn_wave_barrier();
    float linv[8];
#pragma unroll
    for (int h = 0; h < 8; ++h) {
        const float mx = wave_max(fmaxf(fmaxf(sc[0][h], sc[1][h]), fmaxf(sc[2][h], sc[3][h]))); float s = 0.f;
#pragma unroll
        for (int m = 0; m < 4; ++m) { const float e = __expf(sc[m][h] - mx); sc[m][h] = e; s += e; }
        linv[h] = 1.0f / wave_sum(s);
    }
#pragma unroll
    for (int m = 0; m < 4; ++m) { const int i = lane + 64 * m;
#pragma unroll
        for (int h = 0; h < 8; ++h) p_s[i * 8 + h] = sc[m][h]; }
    __builtin_amdgcn_fence(__ATOMIC_RELEASE, "wavefront"); __builtin_amdgcn_wave_barrier(); __builtin_amdgcn_fence(__ATOMIC_ACQUIRE, "wavefront");
    float o[8] = {0.f, 0.f, 0.f, 0.f, 0.f, 0.f, 0.f, 0.f};
    for (int i = 0; i < nsel; ++i) {
        const int ps = sel_s[i]; const bf16_t* vrow = U + (size_t)(b * LP + ps) * UARW + C_V;
        const float v0 = bf2f(vrow[lane]), v1 = bf2f(vrow[64 + lane]);
        const f32x4 pa = *(const f32x4*)(p_s + i * 8), pb = *(const f32x4*)(p_s + i * 8 + 4);
        o[0] = fmaf(pa[0], v0, o[0]); o[1] = fmaf(pa[1], v0, o[1]); o[2] = fmaf(pa[2], v0, o[2]); o[3] = fmaf(pa[3], v0, o[3]);
        o[4] = fmaf(pb[0], v1, o[4]); o[5] = fmaf(pb[1], v1, o[5]); o[6] = fmaf(pb[2], v1, o[6]); o[7] = fmaf(pb[3], v1, o[7]);
    }
#pragma unroll
    for (int h = 0; h < 8; ++h) OA[h * 64 + lane] = (bf16_t)f2bf(o[h] * linv[h]);
    __builtin_amdgcn_wave_barrier();
}


typedef float f32x16 __attribute__((ext_vector_type(16)));
typedef short s16x4 __attribute__((ext_vector_type(4)));
constexpr int AT_HIST = 0;
constexpr int AT_MASK = 32768;
constexpr int AT_QST = AT_MASK + 16640;
constexpr int AT_KV = 53248;
constexpr int AT_UNIT = AT_KV + 32768;
constexpr int CW_ATT = 32;
__device__ __forceinline__ int img_off(int row, int ch) { return 2048 * (row >> 3) + 512 * (ch >> 2) + 64 * (row & 7) + 16 * ((ch & 3) ^ ((row >> 2) & 3)); }
__device__ __forceinline__ unsigned comp_key(float sc, int pos) { return (score_key(sc) & 0xFFFFE000u) | (unsigned)(0x1FFF - pos); }

__device__ __forceinline__ void attn_unit(const Params& p, unsigned char* lds, int b, int qt) {
    const int tid = otid(), wave = tid >> 6, lane = tid & 63, r = lane & 31, hh = lane >> 5;
    const bf16_t* U = (const bf16_t*)(p.ws + WS_UAR);
    LAS unsigned char* L = (LAS unsigned char*)lds;
    LAS unsigned* hist = (LAS unsigned*)(L + AT_HIST); LAS unsigned* maskw = (LAS unsigned*)(L + AT_MASK);
    LAS unsigned* qpre = (LAS unsigned*)(L + AT_QST); LAS unsigned* qrem = qpre + 32; LAS unsigned* segs = qpre + 64;
    const int c = qt >> 1, nkt = 2 * c + 1, nadm = 64 * (c + 1) - PADM;
    const size_t qrow = (size_t)(b * LP + 32 * qt + r);
    if (nadm > 256) {
        bf16x8 qf[8][2]; float wq[8];
#pragma unroll
        for (int h = 0; h < 8; ++h)
#pragma unroll
            for (int kk = 0; kk < 2; ++kk) qf[h][kk] = *(const bf16x8*)(U + qrow * UARW + C_QI + h * 32 + 16 * kk + 8 * hh);
        { const u32x4 w = *(const u32x4*)(U + qrow * UARW + C_WI);
          wq[0] = bflo(w.x); wq[1] = bfhi(w.x); wq[2] = bflo(w.y); wq[3] = bfhi(w.y); wq[4] = bflo(w.z); wq[5] = bfhi(w.z); wq[6] = bflo(w.w); wq[7] = bfhi(w.w); }
        if (tid < 32) { qpre[tid] = 0u; qrem[tid] = 256u; }
#pragma unroll 1
        for (int pass = 0; pass < 5; ++pass) {
            if (pass < 4) { for (int i = tid; i < 256 * 32 / 4; i += NTHREADS) ((LAS u32x4*)hist)[i] = (u32x4){0u, 0u, 0u, 0u}; }
            __syncthreads();
            const unsigned pre = qpre[r]; const int shift = 24 - 8 * pass;
#pragma unroll 1
            for (int kt = 1 + wave; kt <= nkt; kt += NWAVES) {
                const bf16_t* kp = U + (size_t)(b * LP + 32 * kt + r) * UARW + C_KI + 8 * hh;
                const bf16x8 a0 = *(const bf16x8*)kp, a1 = *(const bf16x8*)(kp + 16);
                f32x16 sc;
#pragma unroll
                for (int e = 0; e < 16; ++e) sc[e] = 0.f;
#pragma unroll
                for (int h = 0; h < 8; ++h) { f32x16 d;
#pragma unroll
                    for (int e = 0; e < 16; ++e) d[e] = 0.f;
                    d = __builtin_amdgcn_mfma_f32_32x32x16_bf16(a0, qf[h][0], d, 0, 0, 0); d = __builtin_amdgcn_mfma_f32_32x32x16_bf16(a1, qf[h][1], d, 0, 0, 0);
#pragma unroll
                    for (int e = 0; e < 16; ++e) sc[e] = fmaf(wq[h], fmaxf(d[e], 0.f), sc[e]); }
                unsigned word = 0u;
#pragma unroll
                for (int e = 0; e < 16; ++e) { const int kidx = (e & 3) + 8 * (e >> 2) + 4 * hh, pos = 32 * kt + kidx;
                    const unsigned comp = pos >= PADM ? comp_key(sc[e], pos) : 0u;
                    if (pass < 4) { const bool match = comp != 0u && (pass == 0 || (comp >> (shift + 8)) == pre);
                        if (match) __hip_atomic_fetch_add(hist + ((comp >> shift) & 255u) * 32 + r, 1u, __ATOMIC_RELAXED, __HIP_MEMORY_SCOPE_WORKGROUP); }
                    else word |= (comp >= pre && comp != 0u ? 1u : 0u) << kidx; }
                if (pass == 4) { word |= (unsigned)__shfl_xor((int)word, 32); if (hh == 0) maskw[kt * 32 + r] = word; }
            }
            __syncthreads();
            if (pass < 4) {
                { const int q = tid & 31, seg = tid >> 5; unsigned ss = 0u;
#pragma unroll
                  for (int i = 0; i < 16; ++i) ss += hist[(seg * 16 + i) * 32 + q];
                  segs[seg * 32 + q] = ss; }
                __syncthreads();
                if (tid < 32) { const unsigned rem = qrem[tid]; unsigned cum = 0u; int seg = 15;
                    while (seg > 0 && cum + segs[seg * 32 + tid] < rem) { cum += segs[seg * 32 + tid]; --seg; }
                    int bin = seg * 16 + 15;
                    while (bin > seg * 16 && cum + hist[bin * 32 + tid] < rem) { cum += hist[bin * 32 + tid]; --bin; }
                    qrem[tid] = rem - cum; qpre[tid] = (qpre[tid] << 8) | (unsigned)bin; }
                __syncthreads();
            }
        }
    } else {
        for (int kt = 1 + wave; kt <= nkt; kt += NWAVES) if (hh == 0) maskw[kt * 32 + r] = kt == 1 ? 0xFFFF0000u : 0xFFFFFFFFu;
        __syncthreads();
    }
    {
        const int h = wave, n = h >> 2;
        bf16x8 qf4[4];
#pragma unroll
        for (int kk = 0; kk < 4; ++kk) qf4[kk] = *(const bf16x8*)(U + qrow * UARW + C_Q + h * 64 + 16 * kk + 8 * hh);
        f32x16 o0, o1;
#pragma unroll
        for (int e = 0; e < 16; ++e) { o0[e] = 0.f; o1[e] = 0.f; }
        float m = -1e30f, lsum = 0.f;
        const int srow = tid >> 4, sch = tid & 15; const int soff = img_off(srow, sch);
        const bf16_t* sbase = U + (size_t)(b * LP + srow) * UARW + sch * 8;
        u32x4 kreg = *(const u32x4*)(sbase + (size_t)32 * UARW + C_K), vreg = *(const u32x4*)(sbase + (size_t)32 * UARW + C_V);
        *(LAS u32x4*)(L + AT_KV + soff) = kreg; *(LAS u32x4*)(L + AT_KV + 8192 + soff) = vreg;
        __syncthreads();
        const int g = (lane >> 4) & 1, q_ = (lane & 15) >> 2, p_ = lane & 3;
        constexpr float SCL = 0.125f * 1.44269504088896f;
#pragma unroll 1
        for (int i = 0; i < nkt; ++i) {
            const int kt = 1 + i; LAS unsigned char* Kimg = L + AT_KV + (i & 1) * 16384; LAS unsigned char* Vimg = Kimg + 8192;
            if (i + 1 < nkt) { kreg = *(const u32x4*)(sbase + (size_t)(32 * (kt + 1)) * UARW + C_K); vreg = *(const u32x4*)(sbase + (size_t)(32 * (kt + 1)) * UARW + C_V); }
            f32x16 s;
#pragma unroll
            for (int e = 0; e < 16; ++e) s[e] = 0.f;
#pragma unroll
            for (int kk = 0; kk < 4; ++kk) { const bf16x8 a = *(const LAS bf16x8*)(Kimg + img_off(r, 8 * n + 2 * kk + hh)); s = __builtin_amdgcn_mfma_f32_32x32x16_bf16(a, qf4[kk], s, 0, 0, 0); }
            const unsigned mw = maskw[kt * 32 + r] >> (4 * hh);
            float tmax = -1e30f;
#pragma unroll
            for (int e = 0; e < 16; ++e) { const bool sel = (mw >> ((e & 3) + 8 * (e >> 2))) & 1u; s[e] = sel ? s[e] * SCL : -1e30f; tmax = fmaxf(tmax, s[e]); }
            tmax = fmaxf(tmax, __shfl_xor(tmax, 32));
            const float mnew = fmaxf(m, tmax), alpha = __builtin_amdgcn_exp2f(m - mnew); m = mnew;
            float ps = 0.f;
#pragma unroll
            for (int e = 0; e < 16; ++e) { const bool sel = (mw >> ((e & 3) + 8 * (e >> 2))) & 1u; const float pe = sel ? __builtin_amdgcn_exp2f(s[e] - mnew) : 0.f; s[e] = pe; ps += pe; }
            lsum = lsum * alpha + ps;
#pragma unroll
            for (int e = 0; e < 16; ++e) { o0[e] *= alpha; o1[e] *= alpha; }
            bf16x8 pf[2];
#pragma unroll
            for (int ks = 0; ks < 2; ++ks) { u32x4 w; w.x = pk2(s[8 * ks + 0], s[8 * ks + 1]); w.y = pk2(s[8 * ks + 2], s[8 * ks + 3]); w.z = pk2(s[8 * ks + 4], s[8 * ks + 5]); w.w = pk2(s[8 * ks + 6], s[8 * ks + 7]); pf[ks] = __builtin_bit_cast(bf16x8, w); }
#pragma unroll
            for (int ks = 0; ks < 2; ++ks)
#pragma unroll
                for (int dt = 0; dt < 2; ++dt) { const int c0 = 8 * n + 4 * dt + 2 * g + (p_ >> 1);
                    const s16x4 lo = __builtin_amdgcn_ds_read_tr16_b64_v4i16((LAS s16x4*)(Vimg + img_off(16 * ks + 4 * hh + q_, c0) + 8 * (p_ & 1)));
                    const s16x4 hi = __builtin_amdgcn_ds_read_tr16_b64_v4i16((LAS s16x4*)(Vimg + img_off(16 * ks + 8 + 4 * hh + q_, c0) + 8 * (p_ & 1)));
                    const bf16x8 a = __builtin_shufflevector(lo, hi, 0, 1, 2, 3, 4, 5, 6, 7);
                    if (dt == 0) o0 = __builtin_amdgcn_mfma_f32_32x32x16_bf16(a, pf[ks], o0, 0, 0, 0); else o1 = __builtin_amdgcn_mfma_f32_32x32x16_bf16(a, pf[ks], o1, 0, 0, 0); }
            if (i + 1 < nkt) { LAS unsigned char* Kn = L + AT_KV + ((i + 1) & 1) * 16384; *(LAS u32x4*)(Kn + soff) = kreg; *(LAS u32x4*)(Kn + 8192 + soff) = vreg; }
            __syncthreads();
        }
        lsum += __shfl_xor(lsum, 32);
        const float inv = lsum > 0.f ? 1.0f / lsum : 0.f;
        bf16_t* orow = (bf16_t*)(p.ws + WS_OAB) + qrow * D + h * 64 + 4 * hh;
#pragma unroll
        for (int g4 = 0; g4 < 4; ++g4) { u32x2 w0, w1;
            w0.x = pk2(o0[4 * g4] * inv, o0[4 * g4 + 1] * inv); w0.y = pk2(o0[4 * g4 + 2] * inv, o0[4 * g4 + 3] * inv);
            w1.x = pk2(o1[4 * g4] * inv, o1[4 * g4 + 1] * inv); w1.y = pk2(o1[4 * g4 + 2] * inv, o1[4 * g4 + 3] * inv);
            *(u32x2*)(orow + 8 * g4) = w0; *(u32x2*)(orow + 32 + 8 * g4) = w1; }
        if (qt == 1) {
            bf16_t* z = (bf16_t*)(p.ws + WS_OAB) + (size_t)(b * LP + r) * D + h * 64 + 32 * hh;
#pragma unroll
            for (int j = 0; j < 4; ++j) *(u32x4*)(z + 8 * j) = (u32x4){0u, 0u, 0u, 0u};
        }
    }
}
__device__ __forceinline__ void attn_phase(const Params& p, int l, unsigned char* lds) {
    unsigned* ctr = (unsigned*)(p.ws + WS_CTL) + CW_ATT + l;
    volatile int* uw = (volatile int*)(lds + AT_UNIT);
    for (;;) {
        __syncthreads();
        if (otid() == 0) *uw = (int)atomicAdd(ctr, 1u);
        __syncthreads();
        const int u = *uw;
        if (u >= 4 * 129) break;
        attn_unit(p, lds, u & 3, 129 - (u >> 2));
    }
}


constexpr size_t WS_RW1 = WS_HB;
constexpr size_t WS_RW2 = 259 * MiB;
constexpr size_t RW2_ARR = (size_t)2080 * 8192;
constexpr size_t WS_LORA = 65536;
constexpr int PS = 72;
constexpr int R1_XW = 0, R1_XA = 9216, R1_XG = 18432;
constexpr int R1_RHS = 0;
constexpr int R1_E = 35840, R1_AA = R1_E + 16640, R1_GS = R1_AA + 9216;
constexpr int R1_LABT = R1_E, R1_LAK = R1_E + 16384;
constexpr int R1_AT = R1_GS + 9216, R1_RT = R1_AT + 9216, R1_BT = R1_RT + 9216, R1_KT = R1_BT + 9216;
constexpr int R1_WT = R1_AT, R1_ZT = R1_BT;
constexpr int R1_BTT = R1_KT + 9216, R1_KTT = R1_BTT + 9216, R1_VT = R1_KTT + 9216;
constexpr int R1_MRB = R1_VT + 9216, R1_MRK = R1_MRB + 9216;
constexpr int R1_BS = R1_MRK + 9216, R1_GC = R1_BS + 256, R1_END = R1_GC + 256;
static_assert(R1_END <= LDS_BYTES && R1_LAK + 9216 <= R1_AT && R1_RHS + 33280 <= R1_E, "R1 LDS map");
__device__ __forceinline__ f32x4 mfma16(bf16x8 a, bf16x8 b, f32x4 c) { return __builtin_amdgcn_mfma_f32_16x16x32_bf16(a, b, c, 0, 0, 0); }
__device__ __forceinline__ u32x2 pk4(f32x4 v) { u32x2 w; w.x = pk2(v[0], v[1]); w.y = pk2(v[2], v[3]); return w; }

__device__ __forceinline__ void rwkv_prep_unit(const Params& p, int l, int unit, unsigned char* lds) {
    const int tid = otid(), wave = tid >> 6, lane = tid & 63, c15 = lane & 15, g = lane >> 4;
    const int h = unit & 7, bc = unit >> 3, b = bc / NCH, c = bc - b * NCH;
    LAS unsigned char* L = (LAS unsigned char*)lds;
    const bf16_t* U = (const bf16_t*)(p.ws + WS_UAR);
    const int t = tid >> 3, dq = tid & 7, d0 = dq * 8;
    const int row = b * LP + 64 * c + t; const bool hasprev = (64 * c + t) > 0;
    float rr[8], kx[8], vx[8], kk[8];
    {
        const bf16_t* uc = U + (size_t)row * UARW; const bf16_t* up = hasprev ? uc - UARW : uc;
        const float* mu = p.in[I_MU] + l * R_COLS;
        auto shift8 = [&](int col, int mucol, float (&out)[8]) {
            const u32x4 a = *(const u32x4*)(uc + col), q = *(const u32x4*)(up + col);
            const f32x4 m0 = *(const f32x4*)(mu + mucol), m1 = *(const f32x4*)(mu + mucol + 4);
            const float x[8] = {bflo(a.x), bfhi(a.x), bflo(a.y), bfhi(a.y), bflo(a.z), bfhi(a.z), bflo(a.w), bfhi(a.w)};
            const float y[8] = {bflo(q.x), bfhi(q.x), bflo(q.y), bfhi(q.y), bflo(q.z), bfhi(q.z), bflo(q.w), bfhi(q.w)};
#pragma unroll
            for (int i = 0; i < 8; ++i) { const float xp = hasprev ? y[i] : 0.f; out[i] = x[i] + (xp - x[i]) * (i < 4 ? m0[i] : m1[i - 4]); } };
        shift8(C_R + h * 64 + d0, h * 64 + d0, rr); shift8(C_RK + h * 64 + d0, 512 + h * 64 + d0, kx); shift8(C_RV + h * 64 + d0, 1024 + h * 64 + d0, vx);
        float xw[8], xa[8], xg0[8], xg1[8];
        shift8(C_XW + d0, 1536 + d0, xw); shift8(C_XA + d0, 1600 + d0, xa); shift8(C_XG + d0, 1664 + d0, xg0); shift8(C_XG + 64 + d0, 1728 + d0, xg1);
        float n2 = 0.f;
        { const f32x4 k0 = *(const f32x4*)(p.in[I_KK] + l * 512 + h * 64 + d0), k1 = *(const f32x4*)(p.in[I_KK] + l * 512 + h * 64 + d0 + 4);
#pragma unroll
          for (int i = 0; i < 8; ++i) { kk[i] = kx[i] * (i < 4 ? k0[i] : k1[i - 4]); n2 = fmaf(kk[i], kk[i], n2); } }
        n2 += __shfl_xor(n2, 1); n2 += __shfl_xor(n2, 2); n2 += __shfl_xor(n2, 4);
        const float rn = rsqrtf(fmaxf(n2, 1e-24f));
#pragma unroll
        for (int i = 0; i < 8; ++i) { kk[i] *= rn; xw[i] = tanhf(xw[i]); xg0[i] = sigmoidf_(xg0[i]); xg1[i] = sigmoidf_(xg1[i]); }
        u32x4 w;
        w.x = pk2(xw[0], xw[1]); w.y = pk2(xw[2], xw[3]); w.z = pk2(xw[4], xw[5]); w.w = pk2(xw[6], xw[7]); *(LAS u32x4*)(L + R1_XW + (t * PS + d0) * 2) = w;
        w.x = pk2(xa[0], xa[1]); w.y = pk2(xa[2], xa[3]); w.z = pk2(xa[4], xa[5]); w.w = pk2(xa[6], xa[7]); *(LAS u32x4*)(L + R1_XA + (t * PS + d0) * 2) = w;
        w.x = pk2(xg0[0], xg0[1]); w.y = pk2(xg0[2], xg0[3]); w.z = pk2(xg0[4], xg0[5]); w.w = pk2(xg0[6], xg0[7]); *(LAS u32x4*)(L + R1_XG + (t * 136 + d0) * 2) = w;
        w.x = pk2(xg1[0], xg1[1]); w.y = pk2(xg1[2], xg1[3]); w.z = pk2(xg1[4], xg1[5]); w.w = pk2(xg1[6], xg1[7]); *(LAS u32x4*)(L + R1_XG + (t * 136 + 64 + d0) * 2) = w;
    }
    __syncthreads();
    const int tm = wave >> 1;
    unsigned char* rw2 = p.ws + WS_RW2 + (size_t)unit * 8192;
    {
        const bf16_t* lora = (const bf16_t*)(p.ws + WS_LORA + (size_t)l * 262144);
#pragma unroll
        for (int nn = 0; nn < 2; ++nn) { const int tn = 2 * (wave & 1) + nn, dcol = 16 * tn + c15, hd = h * 64 + dcol;
            f32x4 aw = {0.f, 0.f, 0.f, 0.f}, aa = aw, ag = aw;
#pragma unroll
            for (int s2 = 0; s2 < 2; ++s2) {
                const bf16x8 xa_ = *(const LAS bf16x8*)(L + R1_XW + ((16 * tm + c15) * PS + 32 * s2 + 8 * g) * 2), xb_ = *(const LAS bf16x8*)(L + R1_XA + ((16 * tm + c15) * PS + 32 * s2 + 8 * g) * 2);
                aw = mfma16(xa_, *(const bf16x8*)(lora + (size_t)hd * 64 + 32 * s2 + 8 * g), aw);
                aa = mfma16(xb_, *(const bf16x8*)(lora + 32768 + (size_t)hd * 64 + 32 * s2 + 8 * g), aa); }
#pragma unroll
            for (int s4 = 0; s4 < 4; ++s4) ag = mfma16(*(const LAS bf16x8*)(L + R1_XG + ((16 * tm + c15) * 136 + 32 * s4 + 8 * g) * 2), *(const bf16x8*)(lora + 65536 + (size_t)hd * 128 + 32 * s4 + 8 * g), ag);
            const float w0 = p.in[I_W0][l * 512 + hd], a0 = p.in[I_A0][l * 512 + hd];
#pragma unroll
            for (int e = 0; e < 4; ++e) { const int tt = 16 * tm + 4 * g + e;
                const float z = -(w0 + aw[e]); const float sp = fmaxf(z, 0.f) + log1pf(__expf(-fabsf(z)));
                *(LAS float*)(L + R1_E + (tt * 65 + dcol) * 4) = __expf(-sp - 0.5f);
                *(LAS unsigned short*)(L + R1_AA + (tt * PS + dcol) * 2) = (unsigned short)f2bf(sigmoidf_(a0 + aa[e]));
                *(LAS unsigned short*)(L + R1_GS + (tt * PS + dcol) * 2) = (unsigned short)f2bf(ag[e]); }
            *(u32x2*)(rw2 + 2 * RW2_ARR + (size_t)(dcol * 64 + 16 * tm + 4 * g) * 2) = pk4(ag);
        }
    }
    __syncthreads();
    if (tid < 64) { float cum = 0.f;
#pragma unroll 8
        for (int tt = 0; tt < 64; ++tt) { LAS float* e = (LAS float*)(L + R1_E + (tt * 65 + tid) * 4); cum += *e; *e = cum; } }
    __syncthreads();
    {
        const f32x4 ka0 = *(const f32x4*)(p.in[I_KA] + l * 512 + h * 64 + d0), ka1 = *(const f32x4*)(p.in[I_KA] + l * 512 + h * 64 + d0 + 4);
        const f32x4 rk0 = *(const f32x4*)(p.in[I_RK] + l * 512 + h * 64 + d0), rk1 = *(const f32x4*)(p.in[I_RK] + l * 512 + h * 64 + d0 + 4);
        const u32x4 aw_ = *(const LAS u32x4*)(L + R1_AA + (t * PS + d0) * 2);
        const float av[8] = {bflo(aw_.x), bfhi(aw_.x), bflo(aw_.y), bfhi(aw_.y), bflo(aw_.z), bfhi(aw_.z), bflo(aw_.w), bfhi(aw_.w)};
        float At[8], Bt[8], Kt[8], Rt[8]; float bpart = 0.f;
#pragma unroll
        for (int i = 0; i < 8; ++i) {
            const float cumt = *(const LAS float*)(L + R1_E + (t * 65 + d0 + i) * 4), cump = t > 0 ? *(const LAS float*)(L + R1_E + ((t - 1) * 65 + d0 + i) * 4) : 0.f;
            const float gam = __expf(-cumt), gprev = __expf(-cump), ginv = __expf(cumt);
            const float kmod = kx[i] * (1.0f + (av[i] - 1.0f) * (i < 4 ? ka0[i] : ka1[i - 4]));
            At[i] = -gprev * kk[i]; Bt[i] = kk[i] * av[i] * ginv; Kt[i] = kmod * ginv; Rt[i] = rr[i] * gam;
            bpart = fmaf(rr[i] * kmod, (i < 4 ? rk0[i] : rk1[i - 4]), bpart);
            if (t == 63) *(LAS float*)(L + R1_GC + (d0 + i) * 4) = gam;
            *(LAS float*)(L + R1_RHS + ((d0 + i) * 65 + t) * 4) = At[i];
            *(LAS unsigned short*)(L + R1_BTT + ((d0 + i) * PS + t) * 2) = (unsigned short)f2bf(Bt[i]);
            *(LAS unsigned short*)(L + R1_KTT + ((d0 + i) * PS + t) * 2) = (unsigned short)f2bf(Kt[i]);
            *(LAS unsigned short*)(L + R1_VT + ((d0 + i) * PS + t) * 2) = (unsigned short)f2bf(vx[i]);
        }
        u32x4 w;
        w.x = pk2(At[0], At[1]); w.y = pk2(At[2], At[3]); w.z = pk2(At[4], At[5]); w.w = pk2(At[6], At[7]); *(LAS u32x4*)(L + R1_AT + (t * PS + d0) * 2) = w;
        w.x = pk2(Rt[0], Rt[1]); w.y = pk2(Rt[2], Rt[3]); w.z = pk2(Rt[4], Rt[5]); w.w = pk2(Rt[6], Rt[7]); *(LAS u32x4*)(L + R1_RT + (t * PS + d0) * 2) = w;
        w.x = pk2(Bt[0], Bt[1]); w.y = pk2(Bt[2], Bt[3]); w.z = pk2(Bt[4], Bt[5]); w.w = pk2(Bt[6], Bt[7]); *(LAS u32x4*)(L + R1_BT + (t * PS + d0) * 2) = w;
        w.x = pk2(Kt[0], Kt[1]); w.y = pk2(Kt[2], Kt[3]); w.z = pk2(Kt[4], Kt[5]); w.w = pk2(Kt[6], Kt[7]); *(LAS u32x4*)(L + R1_KT + (t * PS + d0) * 2) = w;
        bpart += __shfl_xor(bpart, 1); bpart += __shfl_xor(bpart, 2); bpart += __shfl_xor(bpart, 4);
        const u32x4 gw = *(const LAS u32x4*)(L + R1_GS + (t * PS + d0) * 2);
        const float gv[8] = {bflo(gw.x), bfhi(gw.x), bflo(gw.y), bfhi(gw.y), bflo(gw.z), bfhi(gw.z), bflo(gw.w), bfhi(gw.w)};
        w.x = pk2(bpart * vx[0] * gv[0], bpart * vx[1] * gv[1]); w.y = pk2(bpart * vx[2] * gv[2], bpart * vx[3] * gv[3]);
        w.z = pk2(bpart * vx[4] * gv[4], bpart * vx[5] * gv[5]); w.w = pk2(bpart * vx[6] * gv[6], bpart * vx[7] * gv[7]);
        *(u32x4*)((bf16_t*)(p.ws + WS_OAB) + (size_t)row * D + 512 + h * 64 + d0) = w;
    }
    __syncthreads();
    {
        f32x4 gab[2], gak[2], grb[2], grk[2];
#pragma unroll
        for (int nn = 0; nn < 2; ++nn) { const int tn = 2 * (wave & 1) + nn;
            gab[nn] = (f32x4){0.f, 0.f, 0.f, 0.f}; gak[nn] = gab[nn]; grb[nn] = gab[nn]; grk[nn] = gab[nn];
            if (tn <= tm) {
#pragma unroll
                for (int s2 = 0; s2 < 2; ++s2) { const int ao = ((16 * tm + c15) * PS + 32 * s2 + 8 * g) * 2, bo = ((16 * tn + c15) * PS + 32 * s2 + 8 * g) * 2;
                    const bf16x8 fa = *(const LAS bf16x8*)(L + R1_AT + ao), fr_ = *(const LAS bf16x8*)(L + R1_RT + ao), fb = *(const LAS bf16x8*)(L + R1_BT + bo), fk = *(const LAS bf16x8*)(L + R1_KT + bo);
                    gab[nn] = mfma16(fa, fb, gab[nn]); gak[nn] = mfma16(fa, fk, gak[nn]); grb[nn] = mfma16(fr_, fb, grb[nn]); grk[nn] = mfma16(fr_, fk, grk[nn]); } } }
        __syncthreads();
#pragma unroll
        for (int nn = 0; nn < 2; ++nn) { const int tn = 2 * (wave & 1) + nn, icol = 16 * tn + c15;
            f32x4 lab;
#pragma unroll
            for (int e = 0; e < 4; ++e) { const int tt = 16 * tm + 4 * g + e; const bool strict = icol < tt, incl = icol <= tt;
                lab[e] = strict ? gab[nn][e] : 0.f;
                *(LAS unsigned short*)(L + R1_LAK + (tt * PS + icol) * 2) = (unsigned short)f2bf(strict ? gak[nn][e] : 0.f);
                *(LAS unsigned short*)(L + R1_MRB + (tt * PS + icol) * 2) = (unsigned short)f2bf(incl ? grb[nn][e] : 0.f);
                *(LAS unsigned short*)(L + R1_MRK + (tt * PS + icol) * 2) = (unsigned short)f2bf(incl ? grk[nn][e] : 0.f); }
            *(LAS f32x4*)(L + R1_LABT + (icol * 64 + 16 * tm + 4 * g) * 4) = lab; }
    }
    __syncthreads();
    {
#pragma unroll
        for (int nn = 0; nn < 2; ++nn) { const int tn = 2 * (wave & 1) + nn; f32x4 acc = {0.f, 0.f, 0.f, 0.f};
#pragma unroll
            for (int s2 = 0; s2 < 2; ++s2) acc = mfma16(*(const LAS bf16x8*)(L + R1_LAK + ((16 * tm + c15) * PS + 32 * s2 + 8 * g) * 2), *(const LAS bf16x8*)(L + R1_VT + ((16 * tn + c15) * PS + 32 * s2 + 8 * g) * 2), acc);
#pragma unroll
            for (int e = 0; e < 4; ++e) *(LAS float*)(L + R1_RHS + ((64 + 16 * tn + c15) * 65 + 16 * tm + 4 * g + e) * 4) = acc[e]; }
    }
    __syncthreads();
    if (tid < 128) {
        LAS float* xr = (LAS float*)(L + R1_RHS + tid * 65 * 4);
#pragma unroll 1
        for (int Tb = 0; Tb < 4; ++Tb) {
            float acc[16];
#pragma unroll
            for (int e = 0; e < 16; ++e) acc[e] = xr[16 * Tb + e];
#pragma unroll 1
            for (int i = 0; i < 16 * Tb; ++i) { const float xi = xr[i];
#pragma unroll
                for (int q = 0; q < 4; ++q) { const f32x4 lv = *(const LAS f32x4*)(L + R1_LABT + (i * 64 + 16 * Tb + 4 * q) * 4);
#pragma unroll
                    for (int e = 0; e < 4; ++e) acc[4 * q + e] = fmaf(lv[e], xi, acc[4 * q + e]); } }
#pragma unroll
            for (int ii = 0; ii < 15; ++ii) { const float xi = acc[ii];
#pragma unroll
                for (int q = (ii + 1) / 4; q < 4; ++q) { const f32x4 lv = *(const LAS f32x4*)(L + R1_LABT + ((16 * Tb + ii) * 64 + 16 * Tb + 4 * q) * 4);
#pragma unroll
                    for (int e = 0; e < 4; ++e) if (4 * q + e > ii) acc[4 * q + e] = fmaf(lv[e], xi, acc[4 * q + e]); } }
#pragma unroll
            for (int e = 0; e < 16; ++e) xr[16 * Tb + e] = acc[e];
        }
        LAS unsigned char* dst = L + (tid < 64 ? R1_WT + tid * PS * 2 : R1_ZT + (tid - 64) * PS * 2);
#pragma unroll
        for (int q8 = 0; q8 < 8; ++q8) { u32x4 w; w.x = pk2(xr[8 * q8], xr[8 * q8 + 1]); w.y = pk2(xr[8 * q8 + 2], xr[8 * q8 + 3]); w.z = pk2(xr[8 * q8 + 4], xr[8 * q8 + 5]); w.w = pk2(xr[8 * q8 + 6], xr[8 * q8 + 7]); *(LAS u32x4*)(dst + q8 * 16) = w; }
    }
    __syncthreads();
    {
        unsigned char* rw1 = p.ws + WS_RW1 + (size_t)unit * 16384;
#pragma unroll
        for (int nn = 0; nn < 2; ++nn) { const int tn = 2 * (wave & 1) + nn, col = 16 * tn + c15, r0 = 16 * tm + 4 * g;
            f32x4 aP = {0.f, 0.f, 0.f, 0.f}, aQ = aP, aG = aP, aY = aP;
#pragma unroll
            for (int s2 = 0; s2 < 2; ++s2) { const int ro = ((16 * tm + c15) * PS + 32 * s2 + 8 * g) * 2, co = ((16 * tn + c15) * PS + 32 * s2 + 8 * g) * 2;
                const bf16x8 fWT = *(const LAS bf16x8*)(L + R1_WT + ro), fBTT = *(const LAS bf16x8*)(L + R1_BTT + ro), fKTT = *(const LAS bf16x8*)(L + R1_KTT + ro), fMRB = *(const LAS bf16x8*)(L + R1_MRB + ro), fMRK = *(const LAS bf16x8*)(L + R1_MRK + ro);
                const bf16x8 cBTT = *(const LAS bf16x8*)(L + R1_BTT + co), cZT = *(const LAS bf16x8*)(L + R1_ZT + co), cVT = *(const LAS bf16x8*)(L + R1_VT + co), cMRB = *(const LAS bf16x8*)(L + R1_MRB + co);
                aP = mfma16(fWT, cBTT, aP);
                aQ = mfma16(fBTT, cZT, aQ); aQ = mfma16(fKTT, cVT, aQ);
                aG = mfma16(fWT, cMRB, aG);
                aY = mfma16(fMRB, cZT, aY); aY = mfma16(fMRK, cVT, aY); }
            const float gcc = *(const LAS float*)(L + R1_GC + col * 4);
            const f32x4 gcr = *(const LAS f32x4*)(L + R1_GC + r0 * 4);
            const u32x2 rtw = *(const LAS u32x2*)(L + R1_RT + (col * PS + r0) * 2);
#pragma unroll
            for (int e = 0; e < 4; ++e) { aP[e] = (aP[e] + ((r0 + e) == col ? 1.0f : 0.f)) * gcc; aQ[e] *= gcr[e]; }
            aG[0] += bflo(rtw.x); aG[1] += bfhi(rtw.x); aG[2] += bflo(rtw.y); aG[3] += bfhi(rtw.y);
            *(u32x2*)(rw1 + (size_t)(col * 64 + r0) * 2) = pk4(aP);
            *(u32x2*)(rw1 + 8192 + (size_t)(col * 64 + r0) * 2) = pk4(aG);
            *(u32x2*)(rw2 + (size_t)(col * 64 + r0) * 2) = pk4(aQ);
            *(u32x2*)(rw2 + RW2_ARR + (size_t)(col * 64 + r0) * 2) = pk4(aY); }
    }
    __syncthreads();
}

constexpr int R2_SV = 0, R2_PART = 2 * 64 * PS * 2;
__device__ __forceinline__ void rwkv_scan(const Params& p, int l, int bh, unsigned char* lds) {
    const int tid = otid(), wave = tid >> 6, lane = tid & 63, c15 = lane & 15, g = lane >> 4;
    const int b = bh >> 3, h = bh & 7, role = wave >> 2, j = wave & 3, vcol = 16 * j + c15;
    LAS unsigned char* L = (LAS unsigned char*)lds;
    for (int i = tid; i < 2 * 64 * PS * 2 / 4; i += NTHREADS) ((LAS unsigned*)(L + R2_SV))[i] = 0u;
    __syncthreads();
    const float gng = p.in[I_GNG][l * 512 + h * 64 + vcol], gnb = p.in[I_GNB][l * 512 + h * 64 + vcol];
    bf16_t* OB = (bf16_t*)(p.ws + WS_OAB) + 512 + h * 64 + vcol;
    f32x4 yprev[4];
#pragma unroll
    for (int m = 0; m < 4; ++m) yprev[m] = (f32x4){0.f, 0.f, 0.f, 0.f};
#pragma unroll 1
    for (int c = 0; c <= NCH; ++c) {
        const int cur = c & 1;
        if (c < NCH) {
            const int unit = (b * NCH + c) * 8 + h;
            const unsigned char* rw1 = p.ws + WS_RW1 + (size_t)unit * 16384 + (role ? 8192 : 0);
            const unsigned char* rw2 = p.ws + WS_RW2 + (size_t)unit * 8192 + (role ? RW2_ARR : 0);
            bf16x8 bf_[2];
#pragma unroll
            for (int s2 = 0; s2 < 2; ++s2) bf_[s2] = *(const LAS bf16x8*)(L + R2_SV + cur * 64 * PS * 2 + (vcol * PS + 32 * s2 + 8 * g) * 2);
            f32x4 acc[4];
#pragma unroll
            for (int m = 0; m < 4; ++m) { const u32x2 iw = *(const u32x2*)(rw2 + (size_t)(vcol * 64 + 16 * m + 4 * g) * 2);
                acc[m] = (f32x4){bflo(iw.x), bfhi(iw.x), bflo(iw.y), bfhi(iw.y)};
#pragma unroll
                for (int s2 = 0; s2 < 2; ++s2) acc[m] = mfma16(*(const bf16x8*)(rw1 + (size_t)((16 * m + c15) * 64 + 32 * s2 + 8 * g) * 2), bf_[s2], acc[m]); }
            if (role == 0) {
#pragma unroll
                for (int m = 0; m < 4; ++m) *(LAS u32x2*)(L + R2_SV + (cur ^ 1) * 64 * PS * 2 + (vcol * PS + 16 * m + 4 * g) * 2) = pk4(acc[m]);
            } else {
                if (c > 0) {
                    const unsigned char* gg = p.ws + WS_RW2 + 2 * RW2_ARR + (size_t)(unit - 8) * 8192;
#pragma unroll
                    for (int m = 0; m < 4; ++m) { const u32x2 gw = *(const u32x2*)(gg + (size_t)(vcol * 64 + 16 * m + 4 * g) * 2); const float gv[4] = {bflo(gw.x), bfhi(gw.x), bflo(gw.y), bfhi(gw.y)};
#pragma unroll
                        for (int e = 0; e < 4; ++e) { const int tt = 16 * m + 4 * g + e; float s1 = 0.f, s2_ = 0.f;
#pragma unroll
                            for (int jj = 0; jj < 4; ++jj) { const f32x2 pp = *(const LAS f32x2*)(L + R2_PART + (((cur ^ 1) * 4 + jj) * 64 + tt) * 8); s1 += pp[0]; s2_ += pp[1]; }
                            const float mean = s1 * (1.f / 64.f), var = fmaxf(s2_ * (1.f / 64.f) - mean * mean, 0.f);
                            bf16_t* op = OB + (size_t)(b * LP + 64 * (c - 1) + tt) * D;
                            const float o = bf2f(*op) + ((yprev[m][e] - mean) * rsqrtf(var + GN_EPS) * gng + gnb) * gv[e];
                            *op = (bf16_t)f2bf(o); } }
                }
#pragma unroll
                for (int m = 0; m < 4; ++m) { yprev[m] = acc[m];
#pragma unroll
                    for (int e = 0; e < 4; ++e) { float s1 = acc[m][e], s2_ = acc[m][e] * acc[m][e];
#pragma unroll
                        for (int o = 1; o < 16; o <<= 1) { s1 += __shfl_xor(s1, o); s2_ += __shfl_xor(s2_, o); }
                        if (c15 == 0) *(LAS f32x2*)(L + R2_PART + ((cur * 4 + j) * 64 + 16 * m + 4 * g + e) * 8) = (f32x2){s1, s2_}; } }
            }
        } else if (role == 1) {
            const int unit = (b * NCH + NCH - 1) * 8 + h;
            const unsigned char* gg = p.ws + WS_RW2 + 2 * RW2_ARR + (size_t)unit * 8192;
#pragma unroll
            for (int m = 0; m < 4; ++m) { const u32x2 gw = *(const u32x2*)(gg + (size_t)(vcol * 64 + 16 * m + 4 * g) * 2); const float gv[4] = {bflo(gw.x), bfhi(gw.x), bflo(gw.y), bfhi(gw.y)};
#pragma unroll
                for (int e = 0; e < 4; ++e) { const int tt = 16 * m + 4 * g + e; float s1 = 0.f, s2_ = 0.f;
#pragma unroll
                    for (int jj = 0; jj < 4; ++jj) { const f32x2 pp = *(const LAS f32x2*)(L + R2_PART + (((cur ^ 1) * 4 + jj) * 64 + tt) * 8); s1 += pp[0]; s2_ += pp[1]; }
                    const float mean = s1 * (1.f / 64.f), var = fmaxf(s2_ * (1.f / 64.f) - mean * mean, 0.f);
                    bf16_t* op = OB + (size_t)(b * LP + 64 * (NCH - 1) + tt) * D;
                    const float o = bf2f(*op) + ((yprev[m][e] - mean) * rsqrtf(var + GN_EPS) * gng + gnb) * gv[e];
                    *op = (bf16_t)f2bf(o); } }
        }
        __syncthreads();
    }
}

__device__ void rwkv_naive(const Params& p, int l, int bh, unsigned char* lds) {
    const int b = bh >> 3, h = bh & 7, tid = otid(), lane = tid & 63, wid = tid >> 6;
    const bf16_t* U = (const bf16_t*)(p.ws + WS_UAR);
    bf16_t* OB = (bf16_t*)(p.ws + WS_OAB);
    float* xs = (float*)lds;
    float* vr = xs + 32 * 256;
    float* vw = vr + 2048; float* vkk = vw + 2048; float* vbb = vkk + 2048; float* vk = vbb + 2048; float* vv = vk + 2048;
    float* gg = vv + 2048; float* bon = gg + 2048; float* ys = bon + 2048;
    const float* mu = p.in[I_MU] + l * R_COLS;
    const int hd = h * 64 + lane;
    const float w0 = p.in[I_W0][l * 512 + hd], a0 = p.in[I_A0][l * 512 + hd], kkc = p.in[I_KK][l * 512 + hd], kac = p.in[I_KA][l * 512 + hd], rkc = p.in[I_RK][l * 512 + hd];
    const float gng = p.in[I_GNG][l * 512 + hd], gnb = p.in[I_GNB][l * 512 + hd];
    const float mur = mu[hd], muk = mu[512 + hd], muv = mu[1024 + hd];
    const float* wup = p.in[I_WUP] + (size_t)l * 64 * 512 + hd; const float* aup = p.in[I_AUP] + (size_t)l * 64 * 512 + hd; const float* gup = p.in[I_GUP] + (size_t)l * 128 * 512 + hd;
    float S[8];
#pragma unroll
    for (int i = 0; i < 8; ++i) S[i] = 0.f;
    const int sv = tid >> 3, sq = tid & 7;
    for (int p0 = 0; p0 < LP; p0 += 32) {
        for (int idx = tid; idx < 32 * 256; idx += NTHREADS) {
            const int tt = idx >> 8, j = idx & 255, pos = p0 + tt; const size_t ro = (size_t)(b * LP + pos) * UARW;
            const float x = bf2f(U[ro + C_XW + j]); const float xp = pos > 0 ? bf2f(U[ro - UARW + C_XW + j]) : 0.f;
            float xv = x + (xp - x) * mu[1536 + j];
            if (j < 64) xv = tanhf(xv); else if (j >= 128) xv = sigmoidf_(xv);
            xs[idx] = xv;
        }
        __syncthreads();
        {
            float dw[4] = {0.f, 0.f, 0.f, 0.f}, da[4] = {0.f, 0.f, 0.f, 0.f}, dg[4] = {0.f, 0.f, 0.f, 0.f};
            for (int j = 0; j < 64; ++j) { const float w1 = wup[(size_t)j * 512], w2 = aup[(size_t)j * 512];
#pragma unroll
                for (int k = 0; k < 4; ++k) { dw[k] = fmaf(xs[(wid * 4 + k) * 256 + j], w1, dw[k]); da[k] = fmaf(xs[(wid * 4 + k) * 256 + 64 + j], w2, da[k]); } }
            for (int j = 0; j < 128; ++j) { const float w3 = gup[(size_t)j * 512];
#pragma unroll
                for (int k = 0; k < 4; ++k) dg[k] = fmaf(xs[(wid * 4 + k) * 256 + 128 + j], w3, dg[k]); }
#pragma unroll
            for (int k = 0; k < 4; ++k) {
                const int tt = wid * 4 + k, pos = p0 + tt; const size_t ro = (size_t)(b * LP + pos) * UARW;
                float r = bf2f(U[ro + C_R + hd]), kx = bf2f(U[ro + C_RK + hd]), vx = bf2f(U[ro + C_RV + hd]);
                if (pos > 0) { const float rp = bf2f(U[ro - UARW + C_R + hd]), kp = bf2f(U[ro - UARW + C_RK + hd]), vp = bf2f(U[ro - UARW + C_RV + hd]);
                    r += (rp - r) * mur; kx += (kp - kx) * muk; vx += (vp - vx) * muv; }
                else { r -= r * mur; kx -= kx * muk; vx -= vx * muv; }
                const float z = -(w0 + dw[k]); const float sp = fmaxf(z, 0.f) + log1pf(__expf(-fabsf(z)));
                const float logw = -sp - 0.5f; const float w = __expf(-__expf(logw));
                const float a = sigmoidf_(a0 + da[k]);
                float kk = kx * kkc; const float nrm = wave_sum(kk * kk); kk *= rsqrtf(fmaxf(nrm, 1e-24f));
                const float kmod = kx * (1.0f + (a - 1.0f) * kac);
                const float bsum = wave_sum(r * kmod * rkc);
                vr[tt * 64 + lane] = r; vw[tt * 64 + lane] = w; vkk[tt * 64 + lane] = kk; vbb[tt * 64 + lane] = kk * a; vk[tt * 64 + lane] = kmod; vv[tt * 64 + lane] = vx;
                gg[tt * 64 + lane] = dg[k]; bon[tt * 64 + lane] = bsum * vx;
            }
        }
        __syncthreads();
        for (int tt = 0; tt < 32; ++tt) {
            const f32x4 k0 = *(const f32x4*)(vkk + tt * 64 + sq * 8), k1 = *(const f32x4*)(vkk + tt * 64 + sq * 8 + 4);
            const f32x4 w0v = *(const f32x4*)(vw + tt * 64 + sq * 8), w1v = *(const f32x4*)(vw + tt * 64 + sq * 8 + 4);
            const f32x4 b0 = *(const f32x4*)(vbb + tt * 64 + sq * 8), b1 = *(const f32x4*)(vbb + tt * 64 + sq * 8 + 4);
            const f32x4 m0 = *(const f32x4*)(vk + tt * 64 + sq * 8), m1 = *(const f32x4*)(vk + tt * 64 + sq * 8 + 4);
            const f32x4 r0 = *(const f32x4*)(vr + tt * 64 + sq * 8), r1 = *(const f32x4*)(vr + tt * 64 + sq * 8 + 4);
            const float vt = vv[tt * 64 + sv];
            float sa = 0.f;
#pragma unroll
            for (int i = 0; i < 4; ++i) { sa = fmaf(S[i], k0[i], sa); sa = fmaf(S[4 + i], k1[i], sa); }
            sa += __shfl_xor(sa, 1); sa += __shfl_xor(sa, 2); sa += __shfl_xor(sa, 4);
            sa = -sa; float y = 0.f;
#pragma unroll
            for (int i = 0; i < 4; ++i) { S[i] = S[i] * w0v[i] + sa * b0[i] + vt * m0[i]; S[4 + i] = S[4 + i] * w1v[i] + sa * b1[i] + vt * m1[i];
                y = fmaf(S[i], r0[i], y); y = fmaf(S[4 + i], r1[i], y); }
            y += __shfl_xor(y, 1); y += __shfl_xor(y, 2); y += __shfl_xor(y, 4);
            if (sq == 0) ys[tt * 64 + sv] = y;
        }
        __syncthreads();
#pragma unroll
        for (int k = 0; k < 4; ++k) { const int tt = wid * 4 + k, pos = p0 + tt; const float y = ys[tt * 64 + lane];
            const float m = wave_sum(y) * (1.f / 64.f); const float dv = y - m; const float var = wave_sum(dv * dv) * (1.f / 64.f);
            const float o = (dv * rsqrtf(var + GN_EPS) * gng + gnb + bon[tt * 64 + lane]) * gg[tt * 64 + lane];
            OB[(size_t)(b * LP + pos) * D + 512 + hd] = (bf16_t)f2bf(o); }
        __syncthreads();
    }
}

__device__ __forceinline__ int pair_index(int a, int b) {   return a == 0 ? b - 1 : (a == 1 ? b + 1 : 5); }
__device__ __forceinline__ void pair_of(int idx, int& a, int& b) { a = idx < 3 ? 0 : (idx < 5 ? 1 : 2); b = idx < 3 ? idx + 1 : (idx < 5 ? idx - 1 : 3); }
__device__ __forceinline__ void ln1_router_phase(const Params& p, int l, unsigned char* lds) {
    const int tid = otid(), lane = tid & 63, gw = obid() * NWAVES + (tid >> 6), NGW = gridDim.x * NWAVES;
    float* wr_s = (float*)lds;
    for (int i = tid; i < D * 16 / 4; i += NTHREADS) ((f32x4*)wr_s)[i] = ((const f32x4*)p.in[I_WROUTER])[i];
    __syncthreads();
    unsigned* cls_cnt = (unsigned*)(p.ws + WS_CTL) + CW_CLS + l * 32;
    int* lists = (int*)(p.ws + WS_LIST); f32x2* gl = (f32x2*)(p.ws + WS_LIST + 2 * MiB);
    const float* g = p.in[I_LN1G] + l * D; const float* bt = p.in[I_LN1B] + l * D;
    for (int r = gw; r < T; r += NGW) {
        f32x4 v[4];
        if (is_dummy(r)) {
#pragma unroll
            for (int j = 0; j < 4; ++j) v[j] = (f32x4){0.f, 0.f, 0.f, 0.f};
            store_row(p, r, v, lane, true); continue; }
        const float* hr = hrow(p, r);
#pragma unroll
        for (int j = 0; j < 4; ++j) v[j] = *(const f32x4*)(hr + 4 * lane + 256 * j);
        ln_wave(v, g, bt, lane);
        store_row(p, r, v, lane, false);
        float lg[16];
#pragma unroll
        for (int e = 0; e < 16; ++e) lg[e] = 0.f;
#pragma unroll
        for (int j = 0; j < 4; ++j)
#pragma unroll
            for (int c = 0; c < 4; ++c) { const float x = v[j][c]; const float* wrow = wr_s + (size_t)(4 * lane + 256 * j + c) * 16;
#pragma unroll
                for (int e4 = 0; e4 < 4; ++e4) { const f32x4 w = *(const f32x4*)(wrow + 4 * e4);
                    lg[4 * e4 + 0] = fmaf(x, w[0], lg[4 * e4 + 0]); lg[4 * e4 + 1] = fmaf(x, w[1], lg[4 * e4 + 1]); lg[4 * e4 + 2] = fmaf(x, w[2], lg[4 * e4 + 2]); lg[4 * e4 + 3] = fmaf(x, w[3], lg[4 * e4 + 3]); } }
#pragma unroll
        for (int e = 0; e < 16; ++e) lg[e] = wave_sum(lg[e]);
        float s[16], sel[16];
#pragma unroll
        for (int e = 0; e < 16; ++e) { s[e] = sigmoidf_(lg[e]); sel[e] = s[e] + p.in[I_BROUTER][e]; }
        int gbest = 0; float gsc = -INFINITY;
#pragma unroll
        for (int gi = 0; gi < 4; ++gi) { float m1 = -INFINITY, m2 = -INFINITY;
#pragma unroll
            for (int j = 0; j < 4; ++j) { const float x = sel[gi * 4 + j]; if (x > m1) { m2 = m1; m1 = x; } else if (x > m2) m2 = x; }
            const float sc = m1 + m2; if (sc > gsc) { gsc = sc; gbest = gi; } }
        float sg[4], sgs[4];
#pragma unroll
        for (int j = 0; j < 4; ++j) { sg[j] = gbest == 0 ? sel[j] : (gbest == 1 ? sel[4 + j] : (gbest == 2 ? sel[8 + j] : sel[12 + j])); sgs[j] = gbest == 0 ? s[j] : (gbest == 1 ? s[4 + j] : (gbest == 2 ? s[8 + j] : s[12 + j])); }
        int j1 = 0;
#pragma unroll
        for (int j = 1; j < 4; ++j) if (sg[j] > sg[j1]) j1 = j;
        int j2 = j1 == 0 ? 1 : 0;
#pragma unroll
        for (int j = 0; j < 4; ++j) if (j != j1 && j != j2 && sg[j] > sg[j2]) j2 = j;
        const int ja = j1 < j2 ? j1 : j2, jb = j1 < j2 ? j2 : j1;
        float sa_ = 0.f, sb_ = 0.f;
#pragma unroll
        for (int j = 0; j < 4; ++j) { if (j == ja) sa_ = sgs[j]; if (j == jb) sb_ = sgs[j]; }
        const float inv = 1.0f / (sa_ + sb_);
        const int cls = gbest * 6 + pair_index(ja, jb);
        if (lane == 0) { const unsigned slot = atomicAdd(cls_cnt + cls, 1u); lists[(size_t)cls * T + slot] = r; gl[r] = (f32x2){sa_ * inv, sb_ * inv}; }
    }
}

struct ClsTab { int cnt[24]; int tile0[25]; int row0[24]; };
__device__ __forceinline__ void build_cls_table(const Params& p, int l, int* tab  ) {
    if (otid() == 0) { const unsigned* c = (const unsigned*)(p.ws + WS_CTL) + CW_CLS + l * 32; int acc = 0;
        for (int i = 0; i < 24; ++i) { const int n = (int)__hip_atomic_load(c + i, __ATOMIC_RELAXED, __HIP_MEMORY_SCOPE_AGENT); tab[i] = n; tab[24 + i] = acc; acc += (n + 255) >> 8; }
        tab[48] = acc; }
    __syncthreads();
}
__device__ __forceinline__ int find_cls(const int* tab, int tile) { int c = 0;
#pragma unroll 1
    for (int i = 1; i < 24; ++i) if (tile >= tab[24 + i]) c = i;
    return c; }
__device__ __forceinline__ void moe_a_phase(const Params& p, int l, LAS unsigned char* lds, const int* tab) {
    const int tid = otid();
    unsigned voffB[2]; g8::make_voffB(voffB, D * 2, true);
    const int ntiles = tab[48], nunits = ntiles * 8;
    for (int u = obid(); u < nunits; u += gridDim.x) {
        const int tile = u >> 3, pn = u & 7, cls = find_cls(tab, tile), rt = tile - tab[24 + cls], n = tab[cls];
        int ja, jb; pair_of(cls % 6, ja, jb); const int eslot = pn >> 2, e = (cls / 6) * 4 + (eslot ? jb : ja), jblk = pn & 3;
        unsigned voffA[2][2]; { const int* lists = (const int*)(PP().ws + WS_LIST);
#pragma unroll
        for (int i = 0; i < 2; ++i) { int R, C; g8::stage_rc(tid * 16 + i * 8192, R, C);
#pragma unroll
            for (int hh = 0; hh < 2; ++hh) { const int li = rt * 256 + R + hh * 128; const int tok = li < n ? lists[(size_t)cls * T + li] : 0;
                voffA[hh][i] = (unsigned)tok * (D * 2) + (unsigned)C * 2u; } } }
        g8::Acc acc; g8::zero_acc(acc);
        const char* Bb = (const char*)(PP().ws + WS_WEXP) + ((size_t)e * 1024 + jblk * 256) * D * 2;
        const g8::KSeg s = g8::seg1((const char*)(PP().ws + WS_HB), Bb, Bb + (size_t)128 * D * 2, D / 64);
        g8::kloop<true, false>(lds, acc, s, voffA, voffB, 0);
        EPI_COORDS();
        const int* lists = (const int*)(PP().ws + WS_LIST); const f32x2* gl = (const f32x2*)(PP().ws + WS_LIST + 2 * MiB); bf16_t* ACT = (bf16_t*)(PP().ws + WS_ACT);
#pragma unroll
        for (int ai = 0; ai < 2; ++ai)
#pragma unroll
            for (int m = 0; m < 4; ++m) { asm volatile("" ::: "memory"); const int li = rt * 256 + ai * 128 + wr * 64 + m * 16 + fr; const int tok = li < n ? lists[(size_t)cls * T + li] : -1;
                float gate = 0.f; if (tok >= 0) { const f32x2 g2 = gl[tok]; gate = eslot ? g2[1] : g2[0]; }
                const f32x4 h1a = acc[ai][0][m][0], h1b = acc[ai][0][m][1], h3a = acc[ai][1][m][0], h3b = acc[ai][1][m][1];
                float o[8];
#pragma unroll
                for (int c = 0; c < 4; ++c) { o[c] = gate * (h1a[c] * sigmoidf_(h1a[c])) * h3a[c]; o[4 + c] = gate * (h1b[c] * sigmoidf_(h1b[c])) * h3b[c]; }
                u32x4 w; w.x = pk2(o[0], o[1]); w.y = pk2(o[2], o[3]); w.z = pk2(o[4], o[5]); w.w = pk2(o[6], o[7]);
                *(u32x4*)(ACT + (size_t)(tile * 256 + ai * 128 + wr * 64 + m * 16 + fr) * D + eslot * 512 + jblk * 128 + wc * 32 + 8 * fq) = w; }
    }
}
__device__ __forceinline__ void moe_b_phase(const Params& p, int l, LAS unsigned char* lds, const int* tab) {
    unsigned voffA[2][2], voffB[2]; g8::make_voff_contig(voffA, D * 2); g8::make_voffB(voffB, 512 * 2, false);
    const int ntiles = tab[48], nunits = ntiles * 4;
    for (int u = obid(); u < nunits; u += gridDim.x) {
        const int tile = u >> 2, pn = u & 3, cls = find_cls(tab, tile), rt = tile - tab[24 + cls], n = tab[cls];
        int ja, jb; pair_of(cls % 6, ja, jb); const int ea = (cls / 6) * 4 + ja, eb = (cls / 6) * 4 + jb;
        g8::Acc acc; g8::zero_acc(acc);
        const char* At = (const char*)(PP().ws + WS_ACT) + (size_t)tile * 256 * D * 2;
        const char* W2 = (const char*)(PP().ws + WS_WEXP + 32 * MiB);
        const char* Ba = W2 + ((size_t)ea * 1024 + pn * 256) * 512 * 2; const char* Bb = W2 + ((size_t)eb * 1024 + pn * 256) * 512 * 2;
        g8::KSeg s2 = g8::seg1(At, Ba, Ba + (size_t)128 * 512 * 2, 16); s2.nt0 = 8; s2.A2 = At + 1024; s2.B02 = Bb; s2.B12 = Bb + (size_t)128 * 512 * 2;
        g8::kloop<false, true>(lds, acc, s2, voffA, voffB, 128 * D * 2);
        EPI_COORDS();
        const int* lists = (const int*)(PP().ws + WS_LIST);
        const int col0 = pn * 256 + wc * 32 + 4 * fq;
#pragma unroll
        for (int ai = 0; ai < 2; ++ai)
#pragma unroll
            for (int m = 0; m < 4; ++m) { asm volatile("" ::: "memory"); const int li = rt * 256 + ai * 128 + wr * 64 + m * 16 + fr;
                if (li < n) { const int tok = lists[(size_t)cls * T + li]; float* hr = hrow(PP(), tok) + col0;
#pragma unroll
                    for (int bj = 0; bj < 2; ++bj)
#pragma unroll
                        for (int nn = 0; nn < 2; ++nn) { f32x4* hp = (f32x4*)(hr + bj * 128 + nn * 16); *hp = *hp * ALPHA + acc[ai][bj][m][nn]; } } }
    }
}
__device__ __forceinline__ void ln2_phase(const Params& p, int l) {
    const int tid = otid(), lane = tid & 63, gw = obid() * NWAVES + (tid >> 6), NGW = gridDim.x * NWAVES;
    const float* g = p.in[I_LN2G] + l * D; const float* bt = p.in[I_LN2B] + l * D;
    for (int r = gw; r < T; r += NGW) {
        f32x4 v[4];
        if (is_dummy(r)) {
#pragma unroll
            for (int j = 0; j < 4; ++j) v[j] = (f32x4){0.f, 0.f, 0.f, 0.f};
            store_row(p, r, v, lane, true); continue; }
        const float* hr = hrow(p, r);
#pragma unroll
        for (int j = 0; j < 4; ++j) v[j] = *(const f32x4*)(hr + 4 * lane + 256 * j);
        ln_wave(v, g, bt, lane);
        store_row(p, r, v, lane, false);
    }
}

__global__ void __launch_bounds__(NTHREADS, 2) mega(Params p_unused) {
    extern __shared__ __attribute__((aligned(16))) unsigned char lds[];
    cg::grid_group grid = cg::this_grid();
#define LDSG() (lds + ozero())
#define LDSL() ((LAS unsigned char*)lds)

    conv_small_weights(PP(), LDSL());
    ln_in_phase(PP());
    grid.sync();
#pragma unroll 1
    for (int l = 0; l < DEPTH; ++l) {
        inproj_phase(PP(), l, LDSL());
        grid.sync();
        for (int u = obid(); u < BATCH * NCH * 8; u += gridDim.x) { rwkv_prep_unit(PP(), l, u, LDSG()); }
        grid.sync();
        const int bid = obid();
        if (bid < 32) { rwkv_scan(PP(), l, bid, LDSG()); }
        else { attn_phase(PP(), l, LDSG()); }
        grid.sync();
        merge_phase(PP(), l, LDSL());
        grid.sync();
        wout_phase(PP(), l, LDSL());
        conv_expert_weights(PP(), l, LDSL());
        grid.sync();
        ln1_router_phase(PP(), l, LDSG());
        grid.sync();
        { int toff = 140 * 1024; asm volatile("" : "+s"(toff)); int* tab = (int*)(lds + toff);
          build_cls_table(PP(), l, tab);
          moe_a_phase(PP(), l, LDSL(), tab);
          grid.sync();
          moe_b_phase(PP(), l, LDSL(), tab); }
        grid.sync();
        ln2_phase(PP(), l);
        grid.sync();
    }
}

extern "C" void kernel_launch(void* const* d_in, const int* in_sizes, int n_in, void* d_out, int out_size,
                              void* d_ws, size_t ws_size, hipStream_t stream) {
    static int grid_blocks = 0;
    if (grid_blocks == 0) {
        int dev = 0, cus = 0, per_cu = 0;
        if (n_in != 29 || ws_size < WS_END || out_size != BATCH * SEQ * D) { fprintf(stderr, "kernel_launch: unexpected problem (n_in %d, ws %zu, out %d)\n", n_in, ws_size, out_size); grid_blocks = -1; return; }
        (void)hipGetDevice(&dev);
        (void)hipDeviceGetAttribute(&cus, hipDeviceAttributeMultiprocessorCount, dev);
        (void)hipFuncSetAttribute((const void*)mega, hipFuncAttributeMaxDynamicSharedMemorySize, LDS_BYTES);
        (void)hipOccupancyMaxActiveBlocksPerMultiprocessor(&per_cu, (const void*)mega, NTHREADS, LDS_BYTES);
        if (per_cu < 1) { fprintf(stderr, "occupancy query returned %d\n", per_cu); grid_blocks = -1; return; }
        grid_blocks = cus;
    }
    if (grid_blocks < 0) return;
    (void)hipMemsetAsync((char*)d_ws + WS_CTL, 0, 4096, stream);
    Params p{};
    for (int i = 0; i < 29; ++i) p.in[i] = (const float*)d_in[i];
    p.out = (float*)d_out; p.ws = (unsigned char*)d_ws;
    void* args[] = {&p};
    hipError_t e = hipLaunchCooperativeKernel((const void*)mega, dim3(grid_blocks), dim3(NTHREADS), args, LDS_BYTES, stream);
    if (e != hipSuccess) fprintf(stderr, "cooperative launch failed: %s (grid %d)\n", hipGetErrorString(e), grid_blocks);
}
```

```cpp
#include <hip/hip_runtime.h>
#include <hip/hip_cooperative_groups.h>
#include <cstdio>
#include <cstdint>
namespace cg = cooperative_groups;

#define LAS __attribute__((address_space(3)))
typedef unsigned short bf16_t;
typedef short bf16x8 __attribute__((ext_vector_type(8)));
typedef float f32x4 __attribute__((ext_vector_type(4)));
typedef float f32x2 __attribute__((ext_vector_type(2)));
typedef unsigned u32x4 __attribute__((ext_vector_type(4)));
typedef unsigned u32x2 __attribute__((ext_vector_type(2)));

constexpr int NTHREADS = 512, NWAVES = 8;
constexpr int D = 1024, BATCH = 4, SEQ = 4096, DEPTH = 2;
constexpr int LP = 4160;
constexpr int T = BATCH * LP;
constexpr int NCH = LP / 64;
constexpr int PADM = 48;
constexpr int A_COLS = 1064, R_COLS = 1792, IN_COLS = 4904;
constexpr int UA = 1280;
constexpr int UARW = 3072;
constexpr int NIN = 5120;
constexpr float LN_EPS = 1e-5f, GN_EPS = 64e-5f;
constexpr float ALPHA = 1.41421356237309515f;
constexpr int C_Q = 0, C_K = 512, C_V = 640, C_QI = 768, C_KI = 1024, C_WI = 1056;
constexpr int C_R = UA, C_RK = UA + 512, C_RV = UA + 1024, C_XW = UA + 1536, C_XA = UA + 1600, C_XG = UA + 1664;

constexpr size_t MiB = 1u << 20;
constexpr size_t WS_CTL = 0;
constexpr size_t WS_HM = 1 * MiB;
constexpr size_t WS_WSMALL = 2 * MiB;
constexpr size_t WSMALL_LAYER = 14 * MiB;
constexpr size_t WS_HB = 30 * MiB;
constexpr size_t WS_UAR = 63 * MiB;
constexpr size_t WS_GATES = 161 * MiB;
constexpr size_t WS_OAB = 226 * MiB;
constexpr size_t WS_LIST = WS_GATES + 48 * MiB;
constexpr size_t WS_END = 308 * MiB;
constexpr size_t WS_MERGED = WS_UAR;
constexpr size_t WS_ACT = WS_UAR + 33 * MiB;
constexpr size_t WS_WEXP = WS_GATES;
constexpr int ACT_ROWS_MAX = 16448 + 24 * 256;
static_assert(WS_ACT + (size_t)ACT_ROWS_MAX * 2048 <= WS_GATES, "act fits");
constexpr int CW_CLS = 64;

constexpr int LDS_BYTES = 155648;

struct Params {
    const float* in[29];
    float* out;
    unsigned char* ws;
};
enum { I_X = 0, I_META, I_LNIN_G, I_LNIN_B, I_WIN, I_BGATE, I_MU, I_W0, I_WUP, I_A0, I_AUP, I_GUP, I_KK, I_KA, I_RK, I_GNG, I_GNB,
       I_WBA, I_WBB, I_WOUT, I_LN1G, I_LN1B, I_LN2G, I_LN2B, I_WROUTER, I_BROUTER, I_WEXP1, I_WEXP3, I_WEXP2 };

__device__ __forceinline__ int otid() { int t = threadIdx.x; asm volatile("" : "+v"(t)); return t; }
__device__ __forceinline__ int ozero() { int z = 0; asm volatile("" : "+s"(z)); return z; }
__device__ __forceinline__ int obid() { int b = blockIdx.x; asm volatile("" : "+s"(b)); return b; }
__device__ __forceinline__ unsigned f2bf(float f) { unsigned u = __builtin_bit_cast(unsigned, f); return (u + 0x7fffu + ((u >> 16) & 1u)) >> 16; }
__device__ __forceinline__ unsigned pk2(float lo, float hi) { return f2bf(lo) | (f2bf(hi) << 16); }
__device__ __forceinline__ float bf2f(unsigned short b) { return __builtin_bit_cast(float, (unsigned)b << 16); }
__device__ __forceinline__ float bflo(unsigned w) { return __builtin_bit_cast(float, w << 16); }
__device__ __forceinline__ float bfhi(unsigned w) { return __builtin_bit_cast(float, w & 0xffff0000u); }
__device__ __forceinline__ float wave_sum(float v) {
#pragma unroll
    for (int o = 1; o < 64; o <<= 1) v += __shfl_xor(v, o);
    return v;
}
__device__ __forceinline__ float wave_max(float v) {
#pragma unroll
    for (int o = 1; o < 64; o <<= 1) v = fmaxf(v, __shfl_xor(v, o));
    return v;
}
__device__ __forceinline__ float sigmoidf_(float x) { return 1.0f / (1.0f + __expf(-x)); }
__device__ __forceinline__ float* hrow(const Params& p, int r) {
    const int b = r / LP, pos = r - b * LP;
    return pos >= 64 ? p.out + ((size_t)(b * SEQ + (pos - 64)) << 10) : (float*)(p.ws + WS_HM) + ((size_t)(b * 64 + pos) << 10);
}
__device__ __forceinline__ bool is_dummy(int r) { return (r % LP) < PADM; }

__device__ __forceinline__ void transpose_item(const float* src, int ld_src, int col0, int nvalid, bf16_t* dst  , int ld_dst, LAS float* scr, int lane) {
    const int c = lane & 31;
#pragma unroll 8
    for (int i = 0; i < 32; ++i) { const int kk = 2 * i + (lane >> 5); scr[kk * 33 + c] = c < nvalid ? src[(size_t)kk * ld_src + col0 + c] : 0.f; }
    asm volatile("s_waitcnt lgkmcnt(0)" ::: "memory");
    const int ch = lane & 7;
#pragma unroll
    for (int j = 0; j < 4; ++j) { const int n = (lane >> 3) + 8 * j; const LAS float* s = scr + (8 * ch) * 33 + n;
        u32x4 o; o.x = pk2(s[0 * 33], s[1 * 33]); o.y = pk2(s[2 * 33], s[3 * 33]); o.z = pk2(s[4 * 33], s[5 * 33]); o.w = pk2(s[6 * 33], s[7 * 33]);
        *(u32x4*)(dst + (size_t)n * ld_dst + 8 * ch) = o; }
    asm volatile("s_waitcnt lgkmcnt(0)" ::: "memory");
}

namespace g8 {
constexpr int BM = 256, BK = 64, HALF = 128, HTB = HALF * BK * 2, STAGE_BYTES = 8 * HTB;
__host__ __device__ __forceinline__ int lds_byte(int r, int c) { const int st = (r >> 4) * 2 + (c >> 5), rr = r & 15, cc = c & 31, ob = rr * 64 + cc * 2; return st * 1024 + (ob ^ (((ob >> 9) & 1) << 5)); }
__host__ __device__ __forceinline__ void stage_rc(int b, int& R, int& C) { const int st = b / 1024, sb = b % 1024, swz = sb ^ (((sb >> 9) & 1) << 5); R = (st >> 1) * 16 + swz / 64; C = (st & 1) * 32 + (swz % 64) / 2; }
__host__ __device__ __forceinline__ int perm32(int rho) { const int n = rho >> 4, i = rho & 15; return 8 * (i >> 2) + 4 * n + (i & 3); }

struct KSeg {
    const char* A;
    const char* B0;
    const char* B1;
    int nt;
    int nt0;
    const char* A2;
    const char* B02;
    const char* B12;
};
__device__ __forceinline__ KSeg seg1(const char* A, const char* B0, const char* B1, int nt) { KSeg s; s.A = A; s.B0 = B0; s.B1 = B1; s.nt = nt; s.nt0 = nt; s.A2 = A; s.B02 = B0; s.B12 = B1; return s; }
typedef f32x4 Acc[2][2][4][2];

template <bool GATHER, bool TWOSEG>
__device__ __forceinline__ void kloop(LAS unsigned char* lds, Acc& acc, const KSeg s, const unsigned (&voffA)[2][2], const unsigned (&voffB)[2], const unsigned hstepA) {
    int tid = threadIdx.x; asm volatile("" : "+v"(tid));
    const int wid = __builtin_amdgcn_readfirstlane(tid >> 6), lane = tid & 63, wr = wid >> 2, wc = wid & 3, fr = lane & 15, fq = lane >> 4;
    const unsigned ldsw = (unsigned)wid * 1024u;
    const int aoff = lds_byte(wr * 64 + fr, fq * 8), boff = lds_byte(wc * 32 + fr, fq * 8);
    const int nt = s.nt;
#define G8_SA(b, h) (((b) * 2 + (h)) * HTB)
#define G8_SB(b, h) ((4 + (b) * 2 + (h)) * HTB)
#define G8_STAGE(bufoff, gbase, voff) do { _Pragma("unroll") for (int _i = 0; _i < 2; ++_i) \
        __builtin_amdgcn_global_load_lds((const unsigned*)((const char*)(gbase) + (voff)[_i]), (LAS unsigned*)(lds + (bufoff) + ldsw + _i * 8192), 16, 0, 0); } while (0)
#define G8_LDA(dst, b, h) do { _Pragma("unroll") for (int m = 0; m < 4; ++m) _Pragma("unroll") for (int k = 0; k < 2; ++k) dst[m][k] = *(const LAS bf16x8*)(lds + G8_SA(b, h) + aoff + m * 2048 + k * 1024); } while (0)
#define G8_LDB(dst, b, h) do { _Pragma("unroll") for (int n = 0; n < 2; ++n) _Pragma("unroll") for (int k = 0; k < 2; ++k) dst[n][k] = *(const LAS bf16x8*)(lds + G8_SB(b, h) + boff + n * 2048 + k * 1024); } while (0)
#define G8_MMA(ai, bj, At, Bt) do { __builtin_amdgcn_s_setprio(1); _Pragma("unroll") for (int m = 0; m < 4; ++m) _Pragma("unroll") for (int n = 0; n < 2; ++n) _Pragma("unroll") for (int k = 0; k < 2; ++k) \
        acc[ai][bj][m][n] = __builtin_amdgcn_mfma_f32_16x16x32_bf16(Bt[n][k], At[m][k], acc[ai][bj][m][n], 0, 0, 0); __builtin_amdgcn_s_setprio(0); } while (0)
#define G8_WAIT_V(n) asm volatile("s_waitcnt vmcnt(" #n ")" ::: "memory")
#define G8_WAIT_L(n) asm volatile("s_waitcnt lgkmcnt(" #n ")" ::: "memory")
#define G8_BAR __builtin_amdgcn_s_barrier()
#define G8_SCHED __builtin_amdgcn_sched_barrier(0)
    bf16x8 At[4][2], B0[2][2], B1[2][2];
    const char* pA = s.A; const char* pB0 = s.B0; const char* pB1 = s.B1;
    constexpr int KS = BK * 2;
    const int nt0 = TWOSEG ? s.nt0 : 0; const char* qA = TWOSEG ? s.A2 - (size_t)nt0 * KS : pA; const char* qB0 = TWOSEG ? s.B02 - (size_t)nt0 * KS : pB0; const char* qB1 = TWOSEG ? s.B12 - (size_t)nt0 * KS : pB1;
#define G8_TA(t) ((TWOSEG ? ((t) < nt0 ? pA : qA) : pA) + (size_t)(t) * KS)
#define G8_TB0(t) ((TWOSEG ? ((t) < nt0 ? pB0 : qB0) : pB0) + (size_t)(t) * KS)
#define G8_TB1(t) ((TWOSEG ? ((t) < nt0 ? pB1 : qB1) : pB1) + (size_t)(t) * KS)
#define G8_VA1 voffA[GATHER ? 1 : 0]
#define G8_H1(ptr) ((ptr) + (GATHER ? 0u : hstepA))
    G8_STAGE(G8_SB(0, 0), pB0, voffB); G8_STAGE(G8_SA(0, 0), pA, voffA[0]); G8_STAGE(G8_SB(0, 1), pB1, voffB); G8_STAGE(G8_SA(0, 1), G8_H1(pA), G8_VA1);
    if (wr == 1) G8_BAR;
    G8_WAIT_V(4); G8_BAR;
    G8_STAGE(G8_SB(1, 0), pB0 + KS, voffB); G8_STAGE(G8_SA(1, 0), pA + KS, voffA[0]); G8_STAGE(G8_SB(1, 1), pB1 + KS, voffB);
    G8_WAIT_V(6); G8_BAR;
    for (int t = 0; t < nt - 2; t += 2) {
        const char* a1 = G8_TA(t + 1);
        const char* a2 = G8_TA(t + 2); const char* b02 = G8_TB0(t + 2); const char* b12 = G8_TB1(t + 2);
        const char* a3 = G8_TA(t + 3); const char* b03 = G8_TB0(t + 3); const char* b13 = G8_TB1(t + 3);
        G8_LDB(B0, 0, 0); G8_SCHED; G8_LDA(At, 0, 0); G8_STAGE(G8_SA(1, 1), G8_H1(a1), G8_VA1);
        G8_WAIT_L(8); G8_BAR; G8_WAIT_L(0); G8_MMA(0, 0, At, B0); G8_BAR; G8_SCHED;
        G8_LDB(B1, 0, 1); G8_STAGE(G8_SB(0, 0), b02, voffB);
        G8_BAR; G8_WAIT_L(0); G8_MMA(0, 1, At, B1); G8_BAR;
        G8_LDA(At, 0, 1); G8_STAGE(G8_SA(0, 0), a2, voffA[0]);
        G8_BAR; G8_WAIT_L(0); G8_MMA(1, 0, At, B0); G8_BAR; G8_SCHED;
        G8_STAGE(G8_SB(0, 1), b12, voffB);
        G8_WAIT_V(6); G8_BAR; G8_MMA(1, 1, At, B1); G8_BAR;
        G8_LDB(B0, 1, 0); G8_SCHED; G8_LDA(At, 1, 0); G8_STAGE(G8_SA(0, 1), G8_H1(a2), G8_VA1);
        G8_WAIT_L(8); G8_BAR; G8_WAIT_L(0); G8_MMA(0, 0, At, B0); G8_BAR; G8_SCHED;
        G8_LDB(B1, 1, 1); G8_STAGE(G8_SB(1, 0), b03, voffB);
        G8_BAR; G8_WAIT_L(0); G8_MMA(0, 1, At, B1); G8_BAR;
        G8_LDA(At, 1, 1); G8_STAGE(G8_SA(1, 0), a3, voffA[0]);
        G8_BAR; G8_WAIT_L(0); G8_MMA(1, 0, At, B0); G8_BAR; G8_SCHED;
        G8_STAGE(G8_SB(1, 1), b13, voffB);
        G8_WAIT_V(6); G8_BAR; G8_MMA(1, 1, At, B1); G8_BAR;
    }
    { const char* a1 = G8_TA(nt - 1);
      G8_LDB(B0, 0, 0); G8_LDA(At, 0, 0); G8_STAGE(G8_SA(1, 1), G8_H1(a1), G8_VA1);
      G8_BAR; G8_WAIT_L(0); G8_MMA(0, 0, At, B0); G8_BAR;
      G8_LDB(B1, 0, 1); G8_BAR; G8_WAIT_L(0); G8_MMA(0, 1, At, B1); G8_BAR;
      G8_LDA(At, 0, 1); G8_WAIT_V(4); G8_BAR; G8_WAIT_L(0); G8_MMA(1, 0, At, B0); G8_MMA(1, 1, At, B1); G8_BAR; }
    { G8_LDB(B0, 1, 0); G8_LDA(At, 1, 0); G8_WAIT_V(2); G8_BAR; G8_WAIT_L(0); G8_MMA(0, 0, At, B0); G8_BAR;
      G8_LDB(B1, 1, 1); G8_WAIT_V(0); G8_BAR; G8_WAIT_L(0); G8_MMA(0, 1, At, B1); G8_BAR;
      G8_LDA(At, 1, 1); G8_BAR; G8_WAIT_L(0); G8_MMA(1, 0, At, B0); G8_MMA(1, 1, At, B1); G8_BAR; }
    if (wr == 0) G8_BAR;
#undef G8_TA
#undef G8_VA1
#undef G8_H1
#undef G8_TB0
#undef G8_TB1
#undef G8_SA
#undef G8_SB
#undef G8_STAGE
#undef G8_LDA
#undef G8_LDB
#undef G8_MMA
#undef G8_WAIT_V
#undef G8_WAIT_L
#undef G8_BAR
#undef G8_SCHED
}
__device__ __forceinline__ void zero_acc(Acc& acc) {
#pragma unroll
    for (int a = 0; a < 2; ++a)
#pragma unroll
        for (int b = 0; b < 2; ++b)
#pragma unroll
            for (int m = 0; m < 4; ++m)
#pragma unroll
                for (int n = 0; n < 2; ++n) acc[a][b][m][n] = (f32x4){0.f, 0.f, 0.f, 0.f};
}
__device__ __forceinline__ void make_voff_contig(unsigned (&voffA)[2][2], unsigned pitchA) {
    int tid = threadIdx.x; asm volatile("" : "+v"(tid));
#pragma unroll
    for (int i = 0; i < 2; ++i) { int R, C; stage_rc(tid * 16 + i * 8192, R, C);
        voffA[0][i] = (unsigned)R * pitchA + (unsigned)C * 2u; voffA[1][i] = 0u; }
}
__device__ __forceinline__ void make_voffB(unsigned (&voffB)[2], unsigned pitchB, bool perm) {
    int tid = threadIdx.x; asm volatile("" : "+v"(tid));
#pragma unroll
    for (int i = 0; i < 2; ++i) { int R, C; stage_rc(tid * 16 + i * 8192, R, C); const int Rb = perm ? ((R & ~31) + perm32(R & 31)) : R;
        voffB[i] = (unsigned)Rb * pitchB + (unsigned)C * 2u; }
}
}

__device__ __forceinline__ bool unit_order(int i, int G, int c, int nM, int nN, int& pm, int& pn) {
    const int nwg = nM * nN; const long L = (long)i * G + c; if (L >= nwg) return false;
    int wgid = (int)L; { const int q = nwg / 8, r = nwg % 8, xcd = wgid % 8, off = wgid / 8; wgid = (xcd < r ? xcd * (q + 1) : r * (q + 1) + (xcd - r) * q) + off; }
    const int WGM = 8, nig = WGM * nN, gid = wgid / nig, fm = gid * WGM, gsz = (nM - fm) < WGM ? (nM - fm) : WGM;
    pm = fm + ((wgid % nig) % gsz); pn = (wgid % nig) / gsz; return true;
}

__device__ __forceinline__ void conv_small_weights(const Params& p, LAS unsigned char* lds) {
    const int tid = otid(), lane = tid & 63, wave = tid >> 6, gw = obid() * NWAVES + wave, NGW = gridDim.x * NWAVES;
    LAS float* scr = (LAS float*)(lds + wave * 16384);
    constexpr int I_IN = 16 * (NIN / 32), I_A = 8 * 32, I_O = 16 * 32, I_L = 64, PER = I_IN + 2 * I_A + I_O + I_L;
    for (int it = gw; it < DEPTH * PER; it += NGW) {
        const int l = it / PER; int r = it % PER;
        unsigned char* wl = p.ws + WS_WSMALL + (size_t)l * WSMALL_LAYER;
        if (r < I_IN) { const int kb = r / (NIN / 32), nb = r % (NIN / 32), n0 = nb * 32, k0 = kb * 64;
            int col0, nvalid; if (n0 < UA) { col0 = n0; nvalid = A_COLS - n0; nvalid = nvalid < 0 ? 0 : (nvalid > 32 ? 32 : nvalid); } else { col0 = n0 - (UA - A_COLS); nvalid = 32; }
            transpose_item(p.in[I_WIN] + (size_t)l * D * IN_COLS + (size_t)k0 * IN_COLS, IN_COLS, col0, nvalid, (bf16_t*)wl + (size_t)n0 * D + k0, D, scr, lane); continue; }
        r -= I_IN;
        if (r < 2 * I_A) { const int which = r / I_A; r %= I_A; const int kb = r / 32, nb = r % 32;
            const float* src = p.in[which ? I_WBB : I_WBA] + (size_t)l * 512 * D + (size_t)(kb * 64) * D;
            transpose_item(src, D, nb * 32, 32, (bf16_t*)(wl + (10 + which) * MiB) + (size_t)(nb * 32) * 512 + kb * 64, 512, scr, lane); continue; }
        r -= 2 * I_A;
        if (r < I_O) { const int kb = r / 32, nb = r % 32;
          transpose_item(p.in[I_WOUT] + (size_t)l * D * D + (size_t)(kb * 64) * D, D, nb * 32, 32, (bf16_t*)(wl + 12 * MiB) + (size_t)(nb * 32) * D + kb * 64, D, scr, lane); continue; }
        r -= I_O;
        { bf16_t* lo = (bf16_t*)(p.ws + 65536 + (size_t)l * 262144);
          if (r < 16) transpose_item(p.in[I_WUP] + (size_t)l * 64 * 512, 512, r * 32, 32, lo + (size_t)(r * 32) * 64, 64, scr, lane);
          else if (r < 32) transpose_item(p.in[I_AUP] + (size_t)l * 64 * 512, 512, (r - 16) * 32, 32, lo + 32768 + (size_t)((r - 16) * 32) * 64, 64, scr, lane);
          else { const int q = r - 32, kb = q >> 4, nb = q & 15; transpose_item(p.in[I_GUP] + (size_t)l * 128 * 512 + (size_t)(kb * 64) * 512, 512, nb * 32, 32, lo + 65536 + (size_t)(nb * 32) * 128 + kb * 64, 128, scr, lane); } }
    }
}
__device__ __forceinline__ void conv_expert_weights(const Params& p, int l, LAS unsigned char* lds) {
    const int tid = otid(), lane = tid & 63, wave = tid >> 6, gw = obid() * NWAVES + wave, NGW = gridDim.x * NWAVES;
    LAS float* scr = (LAS float*)(lds + wave * 16384);
    constexpr int I_13 = 16 * 32, I_2 = 8 * 32, PER = I_13 + I_2;
    for (int it = gw; it < 16 * PER; it += NGW) {
        const int e = it / PER; int r = it % PER;
        if (r < I_13) { const int kb = r / 32, nb = r % 32, n0 = nb * 32, j = n0 >> 8, half = (n0 >> 7) & 1, c = 128 * j + (n0 & 127);
            const float* src = p.in[half ? I_WEXP3 : I_WEXP1] + (size_t)(l * 16 + e) * D * 512 + (size_t)(kb * 64) * 512;
            transpose_item(src, 512, c, 32, (bf16_t*)(p.ws + WS_WEXP) + (size_t)e * 1024 * 1024 + (size_t)n0 * 1024 + kb * 64, 1024, scr, lane); continue; }
        r -= I_13;
        { const int kb = r / 32, nb = r % 32;
          const float* src = p.in[I_WEXP2] + (size_t)(l * 16 + e) * 512 * D + (size_t)(kb * 64) * D;
          transpose_item(src, D, nb * 32, 32, (bf16_t*)(p.ws + WS_WEXP + 32 * MiB) + (size_t)e * 1024 * 512 + (size_t)(nb * 32) * 512 + kb * 64, 512, scr, lane); }
    }
}

__device__ __forceinline__ void ln_wave(f32x4 (&v)[4], const float* g, const float* bta, int lane) {
    float s = 0.f;
#pragma unroll
    for (int j = 0; j < 4; ++j) s += (v[j][0] + v[j][1]) + (v[j][2] + v[j][3]);
    const float mean = wave_sum(s) * (1.f / D); float s2 = 0.f;
#pragma unroll
    for (int j = 0; j < 4; ++j) { v[j] = v[j] - mean; s2 += (v[j][0] * v[j][0] + v[j][1] * v[j][1]) + (v[j][2] * v[j][2] + v[j][3] * v[j][3]); }
    const float rstd = 1.f / sqrtf(wave_sum(s2) * (1.f / D) + LN_EPS);
#pragma unroll
    for (int j = 0; j < 4; ++j) { const f32x4 gg = *(const f32x4*)(g + 4 * lane + 256 * j), bb = *(const f32x4*)(bta + 4 * lane + 256 * j); v[j] = v[j] * rstd * gg + bb; }
}
__device__ __forceinline__ void store_row(const Params& p, int r, const f32x4 (&v)[4], int lane, bool zero) {
    float* hr = hrow(p, r); bf16_t* hb = (bf16_t*)(p.ws + WS_HB) + (size_t)r * D;
#pragma unroll
    for (int j = 0; j < 4; ++j) { const f32x4 o = zero ? (f32x4){0.f, 0.f, 0.f, 0.f} : v[j];
        *(f32x4*)(hr + 4 * lane + 256 * j) = o; u32x2 w; w.x = pk2(o[0], o[1]); w.y = pk2(o[2], o[3]); *(u32x2*)(hb + 4 * lane + 256 * j) = w; }
}
__device__ __forceinline__ void ln_in_phase(const Params& p) {
    const int tid = otid(), lane = tid & 63, gw = obid() * NWAVES + (tid >> 6), NGW = gridDim.x * NWAVES;
    for (int r = gw; r < T; r += NGW) {
        const int b = r / LP, pos = r - b * LP; f32x4 v[4];
        if (pos < PADM) {
#pragma unroll
            for (int j = 0; j < 4; ++j) v[j] = (f32x4){0.f, 0.f, 0.f, 0.f};
            store_row(p, r, v, lane, true); continue; }
        const float* src = pos < 64 ? p.in[I_META] + (size_t)(pos - PADM) * D : p.in[I_X] + ((size_t)(b * SEQ + pos - 64) << 10);
#pragma unroll
        for (int j = 0; j < 4; ++j) v[j] = *(const f32x4*)(src + 4 * lane + 256 * j);
        ln_wave(v, p.in[I_LNIN_G], p.in[I_LNIN_B], lane);
        store_row(p, r, v, lane, false);
    }
}

__device__ __forceinline__ const Params& PP() { const Params* q = (const Params*)__builtin_amdgcn_kernarg_segment_ptr(); asm volatile("" : "+s"(q)); return *q; }

#define EPI_COORDS() int tid_ = threadIdx.x; asm volatile("" : "+v"(tid_)); const int wid = tid_ >> 6, lane = tid_ & 63, wr = wid >> 2, wc = wid & 3, fr = lane & 15, fq = lane >> 4; (void)wr; (void)wc; (void)fr; (void)fq
__device__ __forceinline__ void inproj_phase(const Params& p, int l, LAS unsigned char* lds) {
    unsigned voffA[2][2], voffB[2]; g8::make_voff_contig(voffA, D * 2); g8::make_voffB(voffB, D * 2, true);
    int pm, pn; const int bid = obid();
    for (int i = 0; unit_order(i, gridDim.x, bid, T / 256, NIN / 256, pm, pn); ++i) {
        g8::Acc acc; g8::zero_acc(acc);
        const char* Ab = (const char*)(PP().ws + WS_HB); const char* Bb = (const char*)(PP().ws + WS_WSMALL + (size_t)l * WSMALL_LAYER);
        const g8::KSeg s = g8::seg1(Ab + (size_t)pm * 256 * D * 2, Bb + (size_t)pn * 256 * D * 2, Bb + (size_t)(pn * 256 + 128) * D * 2, D / 64);
        g8::kloop<false, false>(lds, acc, s, voffA, voffB, 128 * D * 2);
        EPI_COORDS();
        const int row0 = pm * 256 + wr * 64 + fr;
        if (pn < 12) {
            bf16_t* O = (bf16_t*)(PP().ws + WS_UAR);
#pragma unroll
            for (int ai = 0; ai < 2; ++ai)
#pragma unroll
                for (int m = 0; m < 4; ++m) { asm volatile("" ::: "memory"); bf16_t* rp = O + (size_t)(row0 + ai * 128 + m * 16) * UARW + pn * 256 + wc * 32 + 8 * fq;
#pragma unroll
                    for (int bj = 0; bj < 2; ++bj) { const f32x4 v0 = acc[ai][bj][m][0], v1 = acc[ai][bj][m][1]; u32x4 w; w.x = pk2(v0[0], v0[1]); w.y = pk2(v0[2], v0[3]); w.z = pk2(v1[0], v1[1]); w.w = pk2(v1[2], v1[3]);
                        *(u32x4*)(rp + bj * 128) = w; } }
        } else {
            bf16_t* O = (bf16_t*)(PP().ws + WS_GATES); const int colb = (pn - 12) * 256 + wc * 32 + 8 * fq; const float* bg = PP().in[I_BGATE] + l * 2048;
            f32x4 bv[2][2];
#pragma unroll
            for (int bj = 0; bj < 2; ++bj) { bv[bj][0] = *(const f32x4*)(bg + colb + bj * 128); bv[bj][1] = *(const f32x4*)(bg + colb + bj * 128 + 4); }
#pragma unroll
            for (int ai = 0; ai < 2; ++ai)
#pragma unroll
                for (int m = 0; m < 4; ++m) { asm volatile("" ::: "memory"); bf16_t* rp = O + (size_t)(row0 + ai * 128 + m * 16) * 2048 + colb;
#pragma unroll
                    for (int bj = 0; bj < 2; ++bj) { f32x4 v0 = acc[ai][bj][m][0] + bv[bj][0], v1 = acc[ai][bj][m][1] + bv[bj][1];
#pragma unroll
                        for (int e = 0; e < 4; ++e) { v0[e] = sigmoidf_(v0[e]); v1[e] = sigmoidf_(v1[e]); }
                        u32x4 w; w.x = pk2(v0[0], v0[1]); w.y = pk2(v0[2], v0[3]); w.z = pk2(v1[0], v1[1]); w.w = pk2(v1[2], v1[3]);
                        *(u32x4*)(rp + bj * 128) = w; } }
        }
    }
}
__device__ __forceinline__ void merge_phase(const Params& p, int l, LAS unsigned char* lds) {
    unsigned voffA[2][2], voffB[2]; g8::make_voff_contig(voffA, D * 2); g8::make_voffB(voffB, 512 * 2, true);
    int pm, pn; const int bid = obid();
    for (int i = 0; unit_order(i, gridDim.x, bid, T / 256, 4, pm, pn); ++i) {
#pragma unroll 1
        for (int br = 0; br < 2; ++br) {
            g8::Acc acc; g8::zero_acc(acc);
            const char* Bt = (const char*)(PP().ws + WS_WSMALL + (size_t)l * WSMALL_LAYER) + (10 + br) * MiB + (size_t)pn * 256 * 512 * 2;
            const g8::KSeg s = g8::seg1((const char*)(PP().ws + WS_OAB) + (size_t)pm * 256 * D * 2 + br * 1024, Bt, Bt + (size_t)128 * 512 * 2, 8);
            g8::kloop<false, false>(lds, acc, s, voffA, voffB, 128 * D * 2);
            EPI_COORDS();
            const bf16_t* GT = (const bf16_t*)(PP().ws + WS_GATES); bf16_t* O = (bf16_t*)(PP().ws + WS_MERGED);
            const int row0 = pm * 256 + wr * 64 + fr, colb = pn * 256 + wc * 32 + 8 * fq;
#pragma unroll
            for (int ai = 0; ai < 2; ++ai)
#pragma unroll
                for (int m = 0; m < 4; ++m) { asm volatile("" ::: "memory"); const size_t ro = (size_t)(row0 + ai * 128 + m * 16); const bf16_t* gp = GT + ro * 2048 + br * 1024 + colb; bf16_t* op = O + ro * D + colb;
#pragma unroll
                    for (int bj = 0; bj < 2; ++bj) { const u32x4 g = *(const u32x4*)(gp + bj * 128); const f32x4 v0 = acc[ai][bj][m][0], v1 = acc[ai][bj][m][1];
                        float o[8] = {v0[0] * bflo(g.x), v0[1] * bfhi(g.x), v0[2] * bflo(g.y), v0[3] * bfhi(g.y), v1[0] * bflo(g.z), v1[1] * bfhi(g.z), v1[2] * bflo(g.w), v1[3] * bfhi(g.w)};
                        if (br) { const u32x4 pr = *(const u32x4*)(op + bj * 128);
                            o[0] += bflo(pr.x); o[1] += bfhi(pr.x); o[2] += bflo(pr.y); o[3] += bfhi(pr.y); o[4] += bflo(pr.z); o[5] += bfhi(pr.z); o[6] += bflo(pr.w); o[7] += bfhi(pr.w); }
                        u32x4 w; w.x = pk2(o[0], o[1]); w.y = pk2(o[2], o[3]); w.z = pk2(o[4], o[5]); w.w = pk2(o[6], o[7]);
                        *(u32x4*)(op + bj * 128) = w; } }
        }
    }
}
__device__ __forceinline__ void wout_phase(const Params& p, int l, LAS unsigned char* lds) {
    unsigned voffA[2][2], voffB[2]; g8::make_voff_contig(voffA, D * 2); g8::make_voffB(voffB, D * 2, false);
    int pm, pn; const int bid = obid();
    for (int i = 0; unit_order(i, gridDim.x, bid, T / 256, 4, pm, pn); ++i) {
        g8::Acc acc; g8::zero_acc(acc);
        const char* Ab = (const char*)(PP().ws + WS_MERGED); const char* Bb = (const char*)(PP().ws + WS_WSMALL + (size_t)l * WSMALL_LAYER + 12 * MiB);
        const g8::KSeg s = g8::seg1(Ab + (size_t)pm * 256 * D * 2, Bb + (size_t)pn * 256 * D * 2, Bb + (size_t)(pn * 256 + 128) * D * 2, D / 64);
        g8::kloop<false, false>(lds, acc, s, voffA, voffB, 128 * D * 2);
        EPI_COORDS();
        const int row0 = pm * 256 + wr * 64 + fr, col0 = pn * 256 + wc * 32 + 4 * fq;
#pragma unroll
        for (int ai = 0; ai < 2; ++ai)
#pragma unroll
            for (int m = 0; m < 4; ++m) { asm volatile("" ::: "memory"); float* hr = hrow(PP(), row0 + ai * 128 + m * 16) + col0;
#pragma unroll
                for (int bj = 0; bj < 2; ++bj)
#pragma unroll
                    for (int n = 0; n < 2; ++n) { f32x4* hp = (f32x4*)(hr + bj * 128 + n * 16); *hp = *hp * ALPHA + acc[ai][bj][m][n]; } }
    }
}

constexpr int ATTN_WAVE_LDS = 16640 + 1024 + 2048 + 64 + 512;
__device__ __forceinline__ unsigned score_key(float s) { s += 0.0f; const unsigned u = __builtin_bit_cast(unsigned, s); return (u & 0x80000000u) ? ~u : (u | 0x80000000u); }
__device__ void attn_naive_query(const Params& p, int row, unsigned char* wl, int lane) {
    const bf16_t* U = (const bf16_t*)(p.ws + WS_UAR);
    bf16_t* OA = (bf16_t*)(p.ws + WS_OAB) + (size_t)row * D;
    const int b = row / LP, pos = row - b * LP;
    if (pos < PADM) {
#pragma unroll
        for (int j = 0; j < 8; ++j) OA[j * 64 + lane] = 0;
        return;
    }
    const int nadm = 64 * ((pos >> 6) + 1) - PADM;
    unsigned* keys = (unsigned*)wl; float* p_s = (float*)wl;
    float* qi_s = (float*)(wl + 16640); float* q_s = qi_s + 256; float* w_s = q_s + 512; unsigned short* sel_s = (unsigned short*)(w_s + 16);
    const bf16_t* urow = U + (size_t)row * UARW;
    for (int i = lane; i < 256; i += 64) qi_s[i] = bf2f(urow[C_QI + i]);
    for (int i = lane; i < 512; i += 64) q_s[i] = bf2f(urow[C_Q + i]);
    if (lane < 8) w_s[lane] = bf2f(urow[C_WI + lane]);
    __builtin_amdgcn_fence(__ATOMIC_RELEASE, "wavefront"); __builtin_amdgcn_wave_barrier(); __builtin_amdgcn_fence(__ATOMIC_ACQUIRE, "wavefront");
    const int nj = (nadm + 63) >> 6;
    for (int j = 0; j < nj; ++j) {
        const int ki_idx = lane + 64 * j; unsigned key = 0u;
        if (ki_idx < nadm) {
            const u32x4* kp = (const u32x4*)(U + (size_t)(b * LP + PADM + ki_idx) * UARW + C_KI);
            float kf[32];
#pragma unroll
            for (int c4 = 0; c4 < 4; ++c4) { const u32x4 w = kp[c4];
                kf[c4 * 8 + 0] = bflo(w.x); kf[c4 * 8 + 1] = bfhi(w.x); kf[c4 * 8 + 2] = bflo(w.y); kf[c4 * 8 + 3] = bfhi(w.y);
                kf[c4 * 8 + 4] = bflo(w.z); kf[c4 * 8 + 5] = bfhi(w.z); kf[c4 * 8 + 6] = bflo(w.w); kf[c4 * 8 + 7] = bfhi(w.w); }
            float sc = 0.f;
#pragma unroll 1
            for (int h = 0; h < 8; ++h) { float d = 0.f; asm volatile("" ::: "memory");
#pragma unroll
                for (int e = 0; e < 32; ++e) d = fmaf(qi_s[h * 32 + e], kf[e], d);
                sc = fmaf(w_s[h], fmaxf(d, 0.f), sc); }
            key = score_key(sc); if (key == 0u) key = 1u;
        }
        keys[ki_idx] = key;
    }
    __builtin_amdgcn_fence(__ATOMIC_RELEASE, "wavefront"); __builtin_amdgcn_wave_barrier(); __builtin_amdgcn_fence(__ATOMIC_ACQUIRE, "wavefront");
    unsigned thr = 0u; int need_ties = 0x7fffffff;
    if (nadm > 256) {
        unsigned prefix = 0u; int remaining = 256;
        for (int bit = 31; bit >= 0; --bit) {
            const unsigned cand = prefix | (1u << bit); int cnt = 0;
            for (int j = 0; j < nj; ++j) { const unsigned k = keys[lane + 64 * j]; cnt += __builtin_popcountll(__ballot((k >> bit) == (cand >> bit))); }
            if (cnt >= remaining) prefix = cand; else remaining -= cnt;
        }
        thr = prefix; need_ties = remaining;
    } else thr = 1u;
    int nsel = 0, ties_seen = 0;
    for (int j = 0; j < nj; ++j) {
        const unsigned k = keys[lane + 64 * j];
        const unsigned long long tm = __ballot(k == thr && k != 0u);
        const unsigned long long lt = (1ull << lane) - 1ull;
        const int myrank = ties_seen + __builtin_popcountll(tm & lt);
        const bool selme = (k > thr) || (k == thr && k != 0u && myrank < need_ties);
        const unsigned long long sm = __ballot(selme);
        if (selme) sel_s[nsel + __builtin_popcountll(sm & lt)] = (unsigned short)(PADM + lane + 64 * j);
        nsel += __builtin_popcountll(sm); ties_seen += __builtin_popcountll(tm);
    }
    __builtin_amdgcn_fence(__ATOMIC_RELEASE, "wavefront"); __builtin_amdgcn_wave_barrier(); __builtin_amdgcn_fence(__ATOMIC_ACQUIRE, "wavefront");
    float sc[4][8];
#pragma unroll
    for (int m = 0; m < 4; ++m) {
        asm volatile("" ::: "memory");
        const int i = lane + 64 * m; const bool valid = i < nsel; const int ps = valid ? sel_s[i] : PADM;
        const bf16_t* krow = U + (size_t)(b * LP + ps) * UARW + C_K;
#pragma unroll
        for (int n = 0; n < 2; ++n) {
            float a0 = 0.f, a1 = 0.f, a2 = 0.f, a3 = 0.f;
#pragma unroll 1
            for (int c8 = 0; c8 < 8; ++c8) { asm volatile("" ::: "memory"); const u32x4 w = *(const u32x4*)(krow + n * 64 + c8 * 8);
                float kf[8] = {bflo(w.x), bfhi(w.x), bflo(w.y), bfhi(w.y), bflo(w.z), bfhi(w.z), bflo(w.w), bfhi(w.w)};
#pragma unroll
                for (int e = 0; e < 8; ++e) { const int dd = c8 * 8 + e;
                    a0 = fmaf(q_s[(n * 4 + 0) * 64 + dd], kf[e], a0); a1 = fmaf(q_s[(n * 4 + 1) * 64 + dd], kf[e], a1);
                    a2 = fmaf(q_s[(n * 4 + 2) * 64 + dd], kf[e], a2); a3 = fmaf(q_s[(n * 4 + 3) * 64 + dd], kf[e], a3); } }
            sc[m][n * 4 + 0] = valid ? a0 * 0.125f : -INFINITY; sc[m][n * 4 + 1] = valid ? a1 * 0.125f : -INFINITY;
            sc[m][n * 4 + 2] = valid ? a2 * 0.125f : -INFINITY; sc[m][n * 4 + 3] = valid ? a3 * 0.125f : -INFINITY;
        }
    }
    __builtin_amdgcn_wave_barrier();
    float linv[8];
#pragma unroll
    for (int h = 0; h < 8; ++h) {
        const float mx = wave_max(fmaxf(fmaxf(sc[0][h], sc[1][h]), fmaxf(sc[2][h], sc[3][h]))); float s = 0.f;
#pragma unroll
        for (int m = 0; m < 4; ++m) { const float e = __expf(sc[m][h] - mx); sc[m][h] = e; s += e; }
        linv[h] = 1.0f / wave_sum(s);
    }
#pragma unroll
    for (int m = 0; m < 4; ++m) { const int i = lane + 64 * m;
#pragma unroll
        for (int h = 0; h < 8; ++h) p_s[i * 8 + h] = sc[m][h]; }
    __builtin_amdgcn_fence(__ATOMIC_RELEASE, "wavefront"); __builtin_amdgcn_wave_barrier(); __builtin_amdgcn_fence(__ATOMIC_ACQUIRE, "wavefront");
    float o[8] = {0.f, 0.f, 0.f, 0.f, 0.f, 0.f, 0.f, 0.f};
    for (int i = 0; i < nsel; ++i) {
        const int ps = sel_s[i]; const bf16_t* vrow = U + (size_t)(b * LP + ps) * UARW + C_V;
        const float v0 = bf2f(vrow[lane]), v1 = bf2f(vrow[64 + lane]);
        const f32x4 pa = *(const f32x4*)(p_s + i * 8), pb = *(const f32x4*)(p_s + i * 8 + 4);
        o[0] = fmaf(pa[0], v0, o[0]); o[1] = fmaf(pa[1], v0, o[1]); o[2] = fmaf(pa[2], v0, o[2]); o[3] = fmaf(pa[3], v0, o[3]);
        o[4] = fmaf(pb[0], v1, o[4]); o[5] = fmaf(pb[1], v1, o[5]); o[6] = fmaf(pb[2], v1, o[6]); o[7] = fmaf(pb[3], v1, o[7]);
    }
#pragma unroll
    for (int h = 0; h < 8; ++h) OA[h * 64 + lane] = (bf16_t)f2bf(o[h] * linv[h]);
    __builtin_amdgcn_wave_barrier();
}


typedef float f32x16 __attribute__((ext_vector_type(16)));
typedef short s16x4 __attribute__((ext_vector_type(4)));
constexpr int AT_HIST = 0;
constexpr int AT_MASK = 32768;
constexpr int AT_QST = AT_MASK + 16640;
constexpr int AT_KV = 53248;
constexpr int AT_UNIT = AT_KV + 32768;
constexpr int CW_ATT = 32;
__device__ __forceinline__ int img_off(int row, int ch) { return 2048 * (row >> 3) + 512 * (ch >> 2) + 64 * (row & 7) + 16 * ((ch & 3) ^ ((row >> 2) & 3)); }
__device__ __forceinline__ unsigned comp_key(float sc, int pos) { return (score_key(sc) & 0xFFFFE000u) | (unsigned)(0x1FFF - pos); }

__device__ __forceinline__ void attn_unit(const Params& p, unsigned char* lds, int b, int qt) {
    const int tid = otid(), wave = tid >> 6, lane = tid & 63, r = lane & 31, hh = lane >> 5;
    const bf16_t* U = (const bf16_t*)(p.ws + WS_UAR);
    LAS unsigned char* L = (LAS unsigned char*)lds;
    LAS unsigned* hist = (LAS unsigned*)(L + AT_HIST); LAS unsigned* maskw = (LAS unsigned*)(L + AT_MASK);
    LAS unsigned* qpre = (LAS unsigned*)(L + AT_QST); LAS unsigned* qrem = qpre + 32; LAS unsigned* segs = qpre + 64;
    const int c = qt >> 1, nkt = 2 * c + 1, nadm = 64 * (c + 1) - PADM;
    const size_t qrow = (size_t)(b * LP + 32 * qt + r);
    if (nadm > 256) {
        bf16x8 qf[8][2]; float wq[8];
#pragma unroll
        for (int h = 0; h < 8; ++h)
#pragma unroll
            for (int kk = 0; kk < 2; ++kk) qf[h][kk] = *(const bf16x8*)(U + qrow * UARW + C_QI + h * 32 + 16 * kk + 8 * hh);
        { const u32x4 w = *(const u32x4*)(U + qrow * UARW + C_WI);
          wq[0] = bflo(w.x); wq[1] = bfhi(w.x); wq[2] = bflo(w.y); wq[3] = bfhi(w.y); wq[4] = bflo(w.z); wq[5] = bfhi(w.z); wq[6] = bflo(w.w); wq[7] = bfhi(w.w); }
        if (tid < 32) { qpre[tid] = 0u; qrem[tid] = 256u; }
#pragma unroll 1
        for (int pass = 0; pass < 5; ++pass) {
            if (pass < 4) { for (int i = tid; i < 256 * 32 / 4; i += NTHREADS) ((LAS u32x4*)hist)[i] = (u32x4){0u, 0u, 0u, 0u}; }
            __syncthreads();
            const unsigned pre = qpre[r]; const int shift = 24 - 8 * pass;
#pragma unroll 1
            for (int kt = 1 + wave; kt <= nkt; kt += NWAVES) {
                const bf16_t* kp = U + (size_t)(b * LP + 32 * kt + r) * UARW + C_KI + 8 * hh;
                const bf16x8 a0 = *(const bf16x8*)kp, a1 = *(const bf16x8*)(kp + 16);
                f32x16 sc;
#pragma unroll
                for (int e = 0; e < 16; ++e) sc[e] = 0.f;
#pragma unroll
                for (int h = 0; h < 8; ++h) { f32x16 d;
#pragma unroll
                    for (int e = 0; e < 16; ++e) d[e] = 0.f;
                    d = __builtin_amdgcn_mfma_f32_32x32x16_bf16(a0, qf[h][0], d, 0, 0, 0); d = __builtin_amdgcn_mfma_f32_32x32x16_bf16(a1, qf[h][1], d, 0, 0, 0);
#pragma unroll
                    for (int e = 0; e < 16; ++e) sc[e] = fmaf(wq[h], fmaxf(d[e], 0.f), sc[e]); }
                unsigned word = 0u;
#pragma unroll
                for (int e = 0; e < 16; ++e) { const int kidx = (e & 3) + 8 * (e >> 2) + 4 * hh, pos = 32 * kt + kidx;
                    const unsigned comp = pos >= PADM ? comp_key(sc[e], pos) : 0u;
                    if (pass < 4) { const bool match = comp != 0u && (pass == 0 || (comp >> (shift + 8)) == pre);
                        if (match) __hip_atomic_fetch_add(hist + ((comp >> shift) & 255u) * 32 + r, 1u, __ATOMIC_RELAXED, __HIP_MEMORY_SCOPE_WORKGROUP); }
                    else word |= (comp >= pre && comp != 0u ? 1u : 0u) << kidx; }
                if (pass == 4) { word |= (unsigned)__shfl_xor((int)word, 32); if (hh == 0) maskw[kt * 32 + r] = word; }
            }
            __syncthreads();
            if (pass < 4) {
                { const int q = tid & 31, seg = tid >> 5; unsigned ss = 0u;
#pragma unroll
                  for (int i = 0; i < 16; ++i) ss += hist[(seg * 16 + i) * 32 + q];
                  segs[seg * 32 + q] = ss; }
                __syncthreads();
                if (tid < 32) { const unsigned rem = qrem[tid]; unsigned cum = 0u; int seg = 15;
                    while (seg > 0 && cum + segs[seg * 32 + tid] < rem) { cum += segs[seg * 32 + tid]; --seg; }
                    int bin = seg * 16 + 15;
                    while (bin > seg * 16 && cum + hist[bin * 32 + tid] < rem) { cum += hist[bin * 32 + tid]; --bin; }
                    qrem[tid] = rem - cum; qpre[tid] = (qpre[tid] << 8) | (unsigned)bin; }
                __syncthreads();
            }
        }
    } else {
        for (int kt = 1 + wave; kt <= nkt; kt += NWAVES) if (hh == 0) maskw[kt * 32 + r] = kt == 1 ? 0xFFFF0000u : 0xFFFFFFFFu;
        __syncthreads();
    }
    {
        const int h = wave, n = h >> 2;
        bf16x8 qf4[4];
#pragma unroll
        for (int kk = 0; kk < 4; ++kk) qf4[kk] = *(const bf16x8*)(U + qrow * UARW + C_Q + h * 64 + 16 * kk + 8 * hh);
        f32x16 o0, o1;
#pragma unroll
        for (int e = 0; e < 16; ++e) { o0[e] = 0.f; o1[e] = 0.f; }
        float m = -1e30f, lsum = 0.f;
        const int srow = tid >> 4, sch = tid & 15; const int soff = img_off(srow, sch);
        const bf16_t* sbase = U + (size_t)(b * LP + srow) * UARW + sch * 8;
        u32x4 kreg = *(const u32x4*)(sbase + (size_t)32 * UARW + C_K), vreg = *(const u32x4*)(sbase + (size_t)32 * UARW + C_V);
        *(LAS u32x4*)(L + AT_KV + soff) = kreg; *(LAS u32x4*)(L + AT_KV + 8192 + soff) = vreg;
        __syncthreads();
        const int g = (lane >> 4) & 1, q_ = (lane & 15) >> 2, p_ = lane & 3;
        constexpr float SCL = 0.125f * 1.44269504088896f;
#pragma unroll 1
        for (int i = 0; i < nkt; ++i) {
            const int kt = 1 + i; LAS unsigned char* Kimg = L + AT_KV + (i & 1) * 16384; LAS unsigned char* Vimg = Kimg + 8192;
            if (i + 1 < nkt) { kreg = *(const u32x4*)(sbase + (size_t)(32 * (kt + 1)) * UARW + C_K); vreg = *(const u32x4*)(sbase + (size_t)(32 * (kt + 1)) * UARW + C_V); }
            f32x16 s;
#pragma unroll
            for (int e = 0; e < 16; ++e) s[e] = 0.f;
#pragma unroll
            for (int kk = 0; kk < 4; ++kk) { const bf16x8 a = *(const LAS bf16x8*)(Kimg + img_off(r, 8 * n + 2 * kk + hh)); s = __builtin_amdgcn_mfma_f32_32x32x16_bf16(a, qf4[kk], s, 0, 0, 0); }
            const unsigned mw = maskw[kt * 32 + r] >> (4 * hh);
            float tmax = -1e30f;
#pragma unroll
            for (int e = 0; e < 16; ++e) { const bool sel = (mw >> ((e & 3) + 8 * (e >> 2))) & 1u; s[e] = sel ? s[e] * SCL : -1e30f; tmax = fmaxf(tmax, s[e]); }
            tmax = fmaxf(tmax, __shfl_xor(tmax, 32));
            const float mnew = fmaxf(m, tmax), alpha = __builtin_amdgcn_exp2f(m - mnew); m = mnew;
            float ps = 0.f;
#pragma unroll
            for (int e = 0; e < 16; ++e) { const bool sel = (mw >> ((e & 3) + 8 * (e >> 2))) & 1u; const float pe = sel ? __builtin_amdgcn_exp2f(s[e] - mnew) : 0.f; s[e] = pe; ps += pe; }
            lsum = lsum * alpha + ps;
#pragma unroll
            for (int e = 0; e < 16; ++e) { o0[e] *= alpha; o1[e] *= alpha; }
            bf16x8 pf[2];
#pragma unroll
            for (int ks = 0; ks < 2; ++ks) { u32x4 w; w.x = pk2(s[8 * ks + 0], s[8 * ks + 1]); w.y = pk2(s[8 * ks + 2], s[8 * ks + 3]); w.z = pk2(s[8 * ks + 4], s[8 * ks + 5]); w.w = pk2(s[8 * ks + 6], s[8 * ks + 7]); pf[ks] = __builtin_bit_cast(bf16x8, w); }
#pragma unroll
            for (int ks = 0; ks < 2; ++ks)
#pragma unroll
                for (int dt = 0; dt < 2; ++dt) { const int c0 = 8 * n + 4 * dt + 2 * g + (p_ >> 1);
                    const s16x4 lo = __builtin_amdgcn_ds_read_tr16_b64_v4i16((LAS s16x4*)(Vimg + img_off(16 * ks + 4 * hh + q_, c0) + 8 * (p_ & 1)));
                    const s16x4 hi = __builtin_amdgcn_ds_read_tr16_b64_v4i16((LAS s16x4*)(Vimg + img_off(16 * ks + 8 + 4 * hh + q_, c0) + 8 * (p_ & 1)));
                    const bf16x8 a = __builtin_shufflevector(lo, hi, 0, 1, 2, 3, 4, 5, 6, 7);
                    if (dt == 0) o0 = __builtin_amdgcn_mfma_f32_32x32x16_bf16(a, pf[ks], o0, 0, 0, 0); else o1 = __builtin_amdgcn_mfma_f32_32x32x16_bf16(a, pf[ks], o1, 0, 0, 0); }
            if (i + 1 < nkt) { LAS unsigned char* Kn = L + AT_KV + ((i + 1) & 1) * 16384; *(LAS u32x4*)(Kn + soff) = kreg; *(LAS u32x4*)(Kn + 8192 + soff) = vreg; }
            __syncthreads();
        }
        lsum += __shfl_xor(lsum, 32);
        const float inv = lsum > 0.f ? 1.0f / lsum : 0.f;
        bf16_t* orow = (bf16_t*)(p.ws + WS_OAB) + qrow * D + h * 64 + 4 * hh;
#pragma unroll
        for (int g4 = 0; g4 < 4; ++g4) { u32x2 w0, w1;
            w0.x = pk2(o0[4 * g4] * inv, o0[4 * g4 + 1] * inv); w0.y = pk2(o0[4 * g4 + 2] * inv, o0[4 * g4 + 3] * inv);
            w1.x = pk2(o1[4 * g4] * inv, o1[4 * g4 + 1] * inv); w1.y = pk2(o1[4 * g4 + 2] * inv, o1[4 * g4 + 3] * inv);
            *(u32x2*)(orow + 8 * g4) = w0; *(u32x2*)(orow + 32 + 8 * g4) = w1; }
        if (qt == 1) {
            bf16_t* z = (bf16_t*)(p.ws + WS_OAB) + (size_t)(b * LP + r) * D + h * 64 + 32 * hh;
#pragma unroll
            for (int j = 0; j < 4; ++j) *(u32x4*)(z + 8 * j) = (u32x4){0u, 0u, 0u, 0u};
        }
    }
}
__device__ __forceinline__ void attn_phase(const Params& p, int l, unsigned char* lds) {
    unsigned* ctr = (unsigned*)(p.ws + WS_CTL) + CW_ATT + l;
    volatile int* uw = (volatile int*)(lds + AT_UNIT);
    for (;;) {
        __syncthreads();
        if (otid() == 0) *uw = (int)atomicAdd(ctr, 1u);
        __syncthreads();
        const int u = *uw;
        if (u >= 4 * 129) break;
        attn_unit(p, lds, u & 3, 129 - (u >> 2));
    }
}


constexpr size_t WS_RW1 = WS_HB;
constexpr size_t WS_RW2 = 259 * MiB;
constexpr size_t RW2_ARR = (size_t)2080 * 8192;
constexpr size_t WS_LORA = 65536;
constexpr int PS = 72;
constexpr int R1_XW = 0, R1_XA = 9216, R1_XG = 18432;
constexpr int R1_RHS = 0;
constexpr int R1_E = 35840, R1_AA = R1_E + 16640, R1_GS = R1_AA + 9216;
constexpr int R1_LABT = R1_E, R1_LAK = R1_E + 16384;
constexpr int R1_AT = R1_GS + 9216, R1_RT = R1_AT + 9216, R1_BT = R1_RT + 9216, R1_KT = R1_BT + 9216;
constexpr int R1_WT = R1_AT, R1_ZT = R1_BT;
constexpr int R1_BTT = R1_KT + 9216, R1_KTT = R1_BTT + 9216, R1_VT = R1_KTT + 9216;
constexpr int R1_MRB = R1_VT + 9216, R1_MRK = R1_MRB + 9216;
constexpr int R1_BS = R1_MRK + 9216, R1_GC = R1_BS + 256, R1_END = R1_GC + 256;
static_assert(R1_END <= LDS_BYTES && R1_LAK + 9216 <= R1_AT && R1_RHS + 33280 <= R1_E, "R1 LDS map");
__device__ __forceinline__ f32x4 mfma16(bf16x8 a, bf16x8 b, f32x4 c) { return __builtin_amdgcn_mfma_f32_16x16x32_bf16(a, b, c, 0, 0, 0); }
__device__ __forceinline__ u32x2 pk4(f32x4 v) { u32x2 w; w.x = pk2(v[0], v[1]); w.y = pk2(v[2], v[3]); return w; }

__device__ __forceinline__ void rwkv_prep_unit(const Params& p, int l, int unit, unsigned char* lds) {
    const int tid = otid(), wave = tid >> 6, lane = tid & 63, c15 = lane & 15, g = lane >> 4;
    const int h = unit & 7, bc = unit >> 3, b = bc / NCH, c = bc - b * NCH;
    LAS unsigned char* L = (LAS unsigned char*)lds;
    const bf16_t* U = (const bf16_t*)(p.ws + WS_UAR);
    const int t = tid >> 3, dq = tid & 7, d0 = dq * 8;
    const int row = b * LP + 64 * c + t; const bool hasprev = (64 * c + t) > 0;
    float rr[8], kx[8], vx[8], kk[8];
    {
        const bf16_t* uc = U + (size_t)row * UARW; const bf16_t* up = hasprev ? uc - UARW : uc;
        const float* mu = p.in[I_MU] + l * R_COLS;
        auto shift8 = [&](int col, int mucol, float (&out)[8]) {
            const u32x4 a = *(const u32x4*)(uc + col), q = *(const u32x4*)(up + col);
            const f32x4 m0 = *(const f32x4*)(mu + mucol), m1 = *(const f32x4*)(mu + mucol + 4);
            const float x[8] = {bflo(a.x), bfhi(a.x), bflo(a.y), bfhi(a.y), bflo(a.z), bfhi(a.z), bflo(a.w), bfhi(a.w)};
            const float y[8] = {bflo(q.x), bfhi(q.x), bflo(q.y), bfhi(q.y), bflo(q.z), bfhi(q.z), bflo(q.w), bfhi(q.w)};
#pragma unroll
            for (int i = 0; i < 8; ++i) { const float xp = hasprev ? y[i] : 0.f; out[i] = x[i] + (xp - x[i]) * (i < 4 ? m0[i] : m1[i - 4]); } };
        shift8(C_R + h * 64 + d0, h * 64 + d0, rr); shift8(C_RK + h * 64 + d0, 512 + h * 64 + d0, kx); shift8(C_RV + h * 64 + d0, 1024 + h * 64 + d0, vx);
        float xw[8], xa[8], xg0[8], xg1[8];
        shift8(C_XW + d0, 1536 + d0, xw); shift8(C_XA + d0, 1600 + d0, xa); shift8(C_XG + d0, 1664 + d0, xg0); shift8(C_XG + 64 + d0, 1728 + d0, xg1);
        float n2 = 0.f;
        { const f32x4 k0 = *(const f32x4*)(p.in[I_KK] + l * 512 + h * 64 + d0), k1 = *(const f32x4*)(p.in[I_KK] + l * 512 + h * 64 + d0 + 4);
#pragma unroll
          for (int i = 0; i < 8; ++i) { kk[i] = kx[i] * (i < 4 ? k0[i] : k1[i - 4]); n2 = fmaf(kk[i], kk[i], n2); } }
        n2 += __shfl_xor(n2, 1); n2 += __shfl_xor(n2, 2); n2 += __shfl_xor(n2, 4);
        const float rn = rsqrtf(fmaxf(n2, 1e-24f));
#pragma unroll
        for (int i = 0; i < 8; ++i) { kk[i] *= rn; xw[i] = tanhf(xw[i]); xg0[i] = sigmoidf_(xg0[i]); xg1[i] = sigmoidf_(xg1[i]); }
        u32x4 w;
        w.x = pk2(xw[0], xw[1]); w.y = pk2(xw[2], xw[3]); w.z = pk2(xw[4], xw[5]); w.w = pk2(xw[6], xw[7]); *(LAS u32x4*)(L + R1_XW + (t * PS + d0) * 2) = w;
        w.x = pk2(xa[0], xa[1]); w.y = pk2(xa[2], xa[3]); w.z = pk2(xa[4], xa[5]); w.w = pk2(xa[6], xa[7]); *(LAS u32x4*)(L + R1_XA + (t * PS + d0) * 2) = w;
        w.x = pk2(xg0[0], xg0[1]); w.y = pk2(xg0[2], xg0[3]); w.z = pk2(xg0[4], xg0[5]); w.w = pk2(xg0[6], xg0[7]); *(LAS u32x4*)(L + R1_XG + (t * 136 + d0) * 2) = w;
        w.x = pk2(xg1[0], xg1[1]); w.y = pk2(xg1[2], xg1[3]); w.z = pk2(xg1[4], xg1[5]); w.w = pk2(xg1[6], xg1[7]); *(LAS u32x4*)(L + R1_XG + (t * 136 + 64 + d0) * 2) = w;
    }
    __syncthreads();
    const int tm = wave >> 1;
    unsigned char* rw2 = p.ws + WS_RW2 + (size_t)unit * 8192;
    {
        const bf16_t* lora = (const bf16_t*)(p.ws + WS_LORA + (size_t)l * 262144);
#pragma unroll
        for (int nn = 0; nn < 2; ++nn) { const int tn = 2 * (wave & 1) + nn, dcol = 16 * tn + c15, hd = h * 64 + dcol;
            f32x4 aw = {0.f, 0.f, 0.f, 0.f}, aa = aw, ag = aw;
#pragma unroll
            for (int s2 = 0; s2 < 2; ++s2) {
                const bf16x8 xa_ = *(const LAS bf16x8*)(L + R1_XW + ((16 * tm + c15) * PS + 32 * s2 + 8 * g) * 2), xb_ = *(const LAS bf16x8*)(L + R1_XA + ((16 * tm + c15) * PS + 32 * s2 + 8 * g) * 2);
                aw = mfma16(xa_, *(const bf16x8*)(lora + (size_t)hd * 64 + 32 * s2 + 8 * g), aw);
                aa = mfma16(xb_, *(const bf16x8*)(lora + 32768 + (size_t)hd * 64 + 32 * s2 + 8 * g), aa); }
#pragma unroll
            for (int s4 = 0; s4 < 4; ++s4) ag = mfma16(*(const LAS bf16x8*)(L + R1_XG + ((16 * tm + c15) * 136 + 32 * s4 + 8 * g) * 2), *(const bf16x8*)(lora + 65536 + (size_t)hd * 128 + 32 * s4 + 8 * g), ag);
            const float w0 = p.in[I_W0][l * 512 + hd], a0 = p.in[I_A0][l * 512 + hd];
#pragma unroll
            for (int e = 0; e < 4; ++e) { const int tt = 16 * tm + 4 * g + e;
                const float z = -(w0 + aw[e]); const float sp = fmaxf(z, 0.f) + log1pf(__expf(-fabsf(z)));
                *(LAS float*)(L + R1_E + (tt * 65 + dcol) * 4) = __expf(-sp - 0.5f);
                *(LAS unsigned short*)(L + R1_AA + (tt * PS + dcol) * 2) = (unsigned short)f2bf(sigmoidf_(a0 + aa[e]));
                *(LAS unsigned short*)(L + R1_GS + (tt * PS + dcol) * 2) = (unsigned short)f2bf(ag[e]); }
            *(u32x2*)(rw2 + 2 * RW2_ARR + (size_t)(dcol * 64 + 16 * tm + 4 * g) * 2) = pk4(ag);
        }
    }
    __syncthreads();
    if (tid < 64) { float cum = 0.f;
#pragma unroll 8
        for (int tt = 0; tt < 64; ++tt) { LAS float* e = (LAS float*)(L + R1_E + (tt * 65 + tid) * 4); cum += *e; *e = cum; } }
    __syncthreads();
    {
        const f32x4 ka0 = *(const f32x4*)(p.in[I_KA] + l * 512 + h * 64 + d0), ka1 = *(const f32x4*)(p.in[I_KA] + l * 512 + h * 64 + d0 + 4);
        const f32x4 rk0 = *(const f32x4*)(p.in[I_RK] + l * 512 + h * 64 + d0), rk1 = *(const f32x4*)(p.in[I_RK] + l * 512 + h * 64 + d0 + 4);
        const u32x4 aw_ = *(const LAS u32x4*)(L + R1_AA + (t * PS + d0) * 2);
        const float av[8] = {bflo(aw_.x), bfhi(aw_.x), bflo(aw_.y), bfhi(aw_.y), bflo(aw_.z), bfhi(aw_.z), bflo(aw_.w), bfhi(aw_.w)};
        float At[8], Bt[8], Kt[8], Rt[8]; float bpart = 0.f;
#pragma unroll
        for (int i = 0; i < 8; ++i) {
            const float cumt = *(const LAS float*)(L + R1_E + (t * 65 + d0 + i) * 4), cump = t > 0 ? *(const LAS float*)(L + R1_E + ((t - 1) * 65 + d0 + i) * 4) : 0.f;
            const float gam = __expf(-cumt), gprev = __expf(-cump), ginv = __expf(cumt);
            const float kmod = kx[i] * (1.0f + (av[i] - 1.0f) * (i < 4 ? ka0[i] : ka1[i - 4]));
            At[i] = -gprev * kk[i]; Bt[i] = kk[i] * av[i] * ginv; Kt[i] = kmod * ginv; Rt[i] = rr[i] * gam;
            bpart = fmaf(rr[i] * kmod, (i < 4 ? rk0[i] : rk1[i - 4]), bpart);
            if (t == 63) *(LAS float*)(L + R1_GC + (d0 + i) * 4) = gam;
            *(LAS float*)(L + R1_RHS + ((d0 + i) * 65 + t) * 4) = At[i];
            *(LAS unsigned short*)(L + R1_BTT + ((d0 + i) * PS + t) * 2) = (unsigned short)f2bf(Bt[i]);
            *(LAS unsigned short*)(L + R1_KTT + ((d0 + i) * PS + t) * 2) = (unsigned short)f2bf(Kt[i]);
            *(LAS unsigned short*)(L + R1_VT + ((d0 + i) * PS + t) * 2) = (unsigned short)f2bf(vx[i]);
        }
        u32x4 w;
        w.x = pk2(At[0], At[1]); w.y = pk2(At[2], At[3]); w.z = pk2(At[4], At[5]); w.w = pk2(At[6], At[7]); *(LAS u32x4*)(L + R1_AT + (t * PS + d0) * 2) = w;
        w.x = pk2(Rt[0], Rt[1]); w.y = pk2(Rt[2], Rt[3]); w.z = pk2(Rt[4], Rt[5]); w.w = pk2(Rt[6], Rt[7]); *(LAS u32x4*)(L + R1_RT + (t * PS + d0) * 2) = w;
        w.x = pk2(Bt[0], Bt[1]); w.y = pk2(Bt[2], Bt[3]); w.z = pk2(Bt[4], Bt[5]); w.w = pk2(Bt[6], Bt[7]); *(LAS u32x4*)(L + R1_BT + (t * PS + d0) * 2) = w;
        w.x = pk2(Kt[0], Kt[1]); w.y = pk2(Kt[2], Kt[3]); w.z = pk2(Kt[4], Kt[5]); w.w = pk2(Kt[6], Kt[7]); *(LAS u32x4*)(L + R1_KT + (t * PS + d0) * 2) = w;
        bpart += __shfl_xor(bpart, 1); bpart += __shfl_xor(bpart, 2); bpart += __shfl_xor(bpart, 4);
        const u32x4 gw = *(const LAS u32x4*)(L + R1_GS + (t * PS + d0) * 2);
        const float gv[8] = {bflo(gw.x), bfhi(gw.x), bflo(gw.y), bfhi(gw.y), bflo(gw.z), bfhi(gw.z), bflo(gw.w), bfhi(gw.w)};
        w.x = pk2(bpart * vx[0] * gv[0], bpart * vx[1] * gv[1]); w.y = pk2(bpart * vx[2] * gv[2], bpart * vx[3] * gv[3]);
        w.z = pk2(bpart * vx[4] * gv[4], bpart * vx[5] * gv[5]); w.w = pk2(bpart * vx[6] * gv[6], bpart * vx[7] * gv[7]);
        *(u32x4*)((bf16_t*)(p.ws + WS_OAB) + (size_t)row * D + 512 + h * 64 + d0) = w;
    }
    __syncthreads();
    {
        f32x4 gab[2], gak[2], grb[2], grk[2];
#pragma unroll
        for (int nn = 0; nn < 2; ++nn) { const int tn = 2 * (wave & 1) + nn;
            gab[nn] = (f32x4){0.f, 0.f, 0.f, 0.f}; gak[nn] = gab[nn]; grb[nn] = gab[nn]; grk[nn] = gab[nn];
            if (tn <= tm) {
#pragma unroll
                for (int s2 = 0; s2 < 2; ++s2) { const int ao = ((16 * tm + c15) * PS + 32 * s2 + 8 * g) * 2, bo = ((16 * tn + c15) * PS + 32 * s2 + 8 * g) * 2;
                    const bf16x8 fa = *(const LAS bf16x8*)(L + R1_AT + ao), fr_ = *(const LAS bf16x8*)(L + R1_RT + ao), fb = *(const LAS bf16x8*)(L + R1_BT + bo), fk = *(const LAS bf16x8*)(L + R1_KT + bo);
                    gab[nn] = mfma16(fa, fb, gab[nn]); gak[nn] = mfma16(fa, fk, gak[nn]); grb[nn] = mfma16(fr_, fb, grb[nn]); grk[nn] = mfma16(fr_, fk, grk[nn]); } } }
        __syncthreads();
#pragma unroll
        for (int nn = 0; nn < 2; ++nn) { const int tn = 2 * (wave & 1) + nn, icol = 16 * tn + c15;
            f32x4 lab;
#pragma unroll
            for (int e = 0; e < 4; ++e) { const int tt = 16 * tm + 4 * g + e; const bool strict = icol < tt, incl = icol <= tt;
                lab[e] = strict ? gab[nn][e] : 0.f;
                *(LAS unsigned short*)(L + R1_LAK + (tt * PS + icol) * 2) = (unsigned short)f2bf(strict ? gak[nn][e] : 0.f);
                *(LAS unsigned short*)(L + R1_MRB + (tt * PS + icol) * 2) = (unsigned short)f2bf(incl ? grb[nn][e] : 0.f);
                *(LAS unsigned short*)(L + R1_MRK + (tt * PS + icol) * 2) = (unsigned short)f2bf(incl ? grk[nn][e] : 0.f); }
            *(LAS f32x4*)(L + R1_LABT + (icol * 64 + 16 * tm + 4 * g) * 4) = lab; }
    }
    __syncthreads();
    {
#pragma unroll
        for (int nn = 0; nn < 2; ++nn) { const int tn = 2 * (wave & 1) + nn; f32x4 acc = {0.f, 0.f, 0.f, 0.f};
#pragma unroll
            for (int s2 = 0; s2 < 2; ++s2) acc = mfma16(*(const LAS bf16x8*)(L + R1_LAK + ((16 * tm + c15) * PS + 32 * s2 + 8 * g) * 2), *(const LAS bf16x8*)(L + R1_VT + ((16 * tn + c15) * PS + 32 * s2 + 8 * g) * 2), acc);
#pragma unroll
            for (int e = 0; e < 4; ++e) *(LAS float*)(L + R1_RHS + ((64 + 16 * tn + c15) * 65 + 16 * tm + 4 * g + e) * 4) = acc[e]; }
    }
    __syncthreads();
    if (tid < 128) {
        LAS float* xr = (LAS float*)(L + R1_RHS + tid * 65 * 4);
#pragma unroll 1
        for (int Tb = 0; Tb < 4; ++Tb) {
            float acc[16];
#pragma unroll
            for (int e = 0; e < 16; ++e) acc[e] = xr[16 * Tb + e];
#pragma unroll 1
            for (int i = 0; i < 16 * Tb; ++i) { const float xi = xr[i];
#pragma unroll
                for (int q = 0; q < 4; ++q) { const f32x4 lv = *(const LAS f32x4*)(L + R1_LABT + (i * 64 + 16 * Tb + 4 * q) * 4);
#pragma unroll
                    for (int e = 0; e < 4; ++e) acc[4 * q + e] = fmaf(lv[e], xi, acc[4 * q + e]); } }
#pragma unroll
            for (int ii = 0; ii < 15; ++ii) { const float xi = acc[ii];
#pragma unroll
                for (int q = (ii + 1) / 4; q < 4; ++q) { const f32x4 lv = *(const LAS f32x4*)(L + R1_LABT + ((16 * Tb + ii) * 64 + 16 * Tb + 4 * q) * 4);
#pragma unroll
                    for (int e = 0; e < 4; ++e) if (4 * q + e > ii) acc[4 * q + e] = fmaf(lv[e], xi, acc[4 * q + e]); } }
#pragma unroll
            for (int e = 0; e < 16; ++e) xr[16 * Tb + e] = acc[e];
        }
        LAS unsigned char* dst = L + (tid < 64 ? R1_WT + tid * PS * 2 : R1_ZT + (tid - 64) * PS * 2);
#pragma unroll
        for (int q8 = 0; q8 < 8; ++q8) { u32x4 w; w.x = pk2(xr[8 * q8], xr[8 * q8 + 1]); w.y = pk2(xr[8 * q8 + 2], xr[8 * q8 + 3]); w.z = pk2(xr[8 * q8 + 4], xr[8 * q8 + 5]); w.w = pk2(xr[8 * q8 + 6], xr[8 * q8 + 7]); *(LAS u32x4*)(dst + q8 * 16) = w; }
    }
    __syncthreads();
    {
        unsigned char* rw1 = p.ws + WS_RW1 + (size_t)unit * 16384;
#pragma unroll
        for (int nn = 0; nn < 2; ++nn) { const int tn = 2 * (wave & 1) + nn, col = 16 * tn + c15, r0 = 16 * tm + 4 * g;
            f32x4 aP = {0.f, 0.f, 0.f, 0.f}, aQ = aP, aG = aP, aY = aP;
#pragma unroll
            for (int s2 = 0; s2 < 2; ++s2) { const int ro = ((16 * tm + c15) * PS + 32 * s2 + 8 * g) * 2, co = ((16 * tn + c15) * PS + 32 * s2 + 8 * g) * 2;
                const bf16x8 fWT = *(const LAS bf16x8*)(L + R1_WT + ro), fBTT = *(const LAS bf16x8*)(L + R1_BTT + ro), fKTT = *(const LAS bf16x8*)(L + R1_KTT + ro), fMRB = *(const LAS bf16x8*)(L + R1_MRB + ro), fMRK = *(const LAS bf16x8*)(L + R1_MRK + ro);
                const bf16x8 cBTT = *(const LAS bf16x8*)(L + R1_BTT + co), cZT = *(const LAS bf16x8*)(L + R1_ZT + co), cVT = *(const LAS bf16x8*)(L + R1_VT + co), cMRB = *(const LAS bf16x8*)(L + R1_MRB + co);
                aP = mfma16(fWT, cBTT, aP);
                aQ = mfma16(fBTT, cZT, aQ); aQ = mfma16(fKTT, cVT, aQ);
                aG = mfma16(fWT, cMRB, aG);
                aY = mfma16(fMRB, cZT, aY); aY = mfma16(fMRK, cVT, aY); }
            const float gcc = *(const LAS float*)(L + R1_GC + col * 4);
            const f32x4 gcr = *(const LAS f32x4*)(L + R1_GC + r0 * 4);
            const u32x2 rtw = *(const LAS u32x2*)(L + R1_RT + (col * PS + r0) * 2);
#pragma unroll
            for (int e = 0; e < 4; ++e) { aP[e] = (aP[e] + ((r0 + e) == col ? 1.0f : 0.f)) * gcc; aQ[e] *= gcr[e]; }
            aG[0] += bflo(rtw.x); aG[1] += bfhi(rtw.x); aG[2] += bflo(rtw.y); aG[3] += bfhi(rtw.y);
            *(u32x2*)(rw1 + (size_t)(col * 64 + r0) * 2) = pk4(aP);
            *(u32x2*)(rw1 + 8192 + (size_t)(col * 64 + r0) * 2) = pk4(aG);
            *(u32x2*)(rw2 + (size_t)(col * 64 + r0) * 2) = pk4(aQ);
            *(u32x2*)(rw2 + RW2_ARR + (size_t)(col * 64 + r0) * 2) = pk4(aY); }
    }
    __syncthreads();
}

constexpr int R2_SV = 0, R2_PART = 2 * 64 * PS * 2;
__device__ __forceinline__ void rwkv_scan(const Params& p, int l, int bh, unsigned char* lds) {
    const int tid = otid(), wave = tid >> 6, lane = tid & 63, c15 = lane & 15, g = lane >> 4;
    const int b = bh >> 3, h = bh & 7, role = wave >> 2, j = wave & 3, vcol = 16 * j + c15;
    LAS unsigned char* L = (LAS unsigned char*)lds;
    for (int i = tid; i < 2 * 64 * PS * 2 / 4; i += NTHREADS) ((LAS unsigned*)(L + R2_SV))[i] = 0u;
    __syncthreads();
    const float gng = p.in[I_GNG][l * 512 + h * 64 + vcol], gnb = p.in[I_GNB][l * 512 + h * 64 + vcol];
    bf16_t* OB = (bf16_t*)(p.ws + WS_OAB) + (size_t)(b * LP) * D + 512 + h * 64 + vcol;
    const int unit0 = (b * NCH) * 8 + h;
    const unsigned char* rw1b = p.ws + WS_RW1 + (role ? 8192 : 0) + (size_t)(c15 * 64 + 8 * g) * 2;
    const unsigned char* rw2b = p.ws + WS_RW2 + (role ? RW2_ARR : 0) + (size_t)(vcol * 64 + 4 * g) * 2;
    const unsigned char* ggb = p.ws + WS_RW2 + 2 * RW2_ARR + (size_t)(vcol * 64 + 4 * g) * 2;
    bf16x8 A[4][2]; u32x2 I[4];
#pragma unroll
    for (int m = 0; m < 4; ++m) { I[m] = *(const u32x2*)(rw2b + (size_t)unit0 * 8192 + 32 * m);
#pragma unroll
        for (int s2 = 0; s2 < 2; ++s2) A[m][s2] = *(const bf16x8*)(rw1b + (size_t)unit0 * 16384 + (16 * m * 64 + 32 * s2) * 2); }
    f32x4 yprev[4]; u32x2 gprev[4]; unsigned short oldv[16];
#pragma unroll
    for (int m = 0; m < 4; ++m) { yprev[m] = (f32x4){0.f, 0.f, 0.f, 0.f}; gprev[m] = (u32x2){0u, 0u}; }
#pragma unroll
    for (int e = 0; e < 16; ++e) oldv[e] = 0;
#pragma unroll 1
    for (int c = 0; c <= NCH; ++c) {
        const int cur = c & 1;
        bf16x8 nA[4][2]; u32x2 nI[4];
        { const int cn = c + 1 < NCH ? c + 1 : NCH - 1; const size_t un = (size_t)(unit0 + 8 * cn);
#pragma unroll
          for (int m = 0; m < 4; ++m) { nI[m] = *(const u32x2*)(rw2b + un * 8192 + 32 * m);
#pragma unroll
              for (int s2 = 0; s2 < 2; ++s2) nA[m][s2] = *(const bf16x8*)(rw1b + un * 16384 + (16 * m * 64 + 32 * s2) * 2); } }
        f32x4 acc[4];
        if (c < NCH) {
            bf16x8 bf_[2];
#pragma unroll
            for (int s2 = 0; s2 < 2; ++s2) bf_[s2] = *(const LAS bf16x8*)(L + R2_SV + cur * 64 * PS * 2 + (vcol * PS + 32 * s2 + 8 * g) * 2);
#pragma unroll
            for (int m = 0; m < 4; ++m) { acc[m] = (f32x4){bflo(I[m].x), bfhi(I[m].x), bflo(I[m].y), bfhi(I[m].y)};
#pragma unroll
                for (int s2 = 0; s2 < 2; ++s2) acc[m] = mfma16(A[m][s2], bf_[s2], acc[m]); }
            if (role == 0) {
#pragma unroll
                for (int m = 0; m < 4; ++m) *(LAS u32x2*)(L + R2_SV + (cur ^ 1) * 64 * PS * 2 + (vcol * PS + 16 * m + 4 * g) * 2) = pk4(acc[m]);
            }
        }
        if (role == 1) {
            if (c > 0) {
#pragma unroll
                for (int m = 0; m < 4; ++m) { const float gv[4] = {bflo(gprev[m].x), bfhi(gprev[m].x), bflo(gprev[m].y), bfhi(gprev[m].y)};
#pragma unroll
                    for (int e = 0; e < 4; ++e) { const int tt = 16 * m + 4 * g + e; float s1 = 0.f, s2_ = 0.f;
#pragma unroll
                        for (int jj = 0; jj < 4; ++jj) { const f32x2 pp = *(const LAS f32x2*)(L + R2_PART + (((cur ^ 1) * 4 + jj) * 64 + tt) * 8); s1 += pp[0]; s2_ += pp[1]; }
                        const float mean = s1 * (1.f / 64.f), var = fmaxf(s2_ * (1.f / 64.f) - mean * mean, 0.f);
                        const float o = bf2f(oldv[4 * m + e]) + ((yprev[m][e] - mean) * rsqrtf(var + GN_EPS) * gng + gnb) * gv[e];
                        OB[(size_t)(64 * (c - 1) + tt) * D] = (bf16_t)f2bf(o); } }
            }
            if (c < NCH) {
                const size_t un = (size_t)(unit0 + 8 * c);
#pragma unroll
                for (int m = 0; m < 4; ++m) { yprev[m] = acc[m]; gprev[m] = *(const u32x2*)(ggb + un * 8192 + 32 * m);
#pragma unroll
                    for (int e = 0; e < 4; ++e) oldv[4 * m + e] = OB[(size_t)(64 * c + 16 * m + 4 * g + e) * D]; }
#pragma unroll
                for (int m = 0; m < 4; ++m)
#pragma unroll
                    for (int e = 0; e < 4; ++e) { float s1 = acc[m][e], s2_ = acc[m][e] * acc[m][e];
#pragma unroll
                        for (int o = 1; o < 16; o <<= 1) { s1 += __shfl_xor(s1, o); s2_ += __shfl_xor(s2_, o); }
                        if (c15 == 0) *(LAS f32x2*)(L + R2_PART + ((cur * 4 + j) * 64 + 16 * m + 4 * g + e) * 8) = (f32x2){s1, s2_}; }
            }
        }
        __syncthreads();
#pragma unroll
        for (int m = 0; m < 4; ++m) { I[m] = nI[m]; A[m][0] = nA[m][0]; A[m][1] = nA[m][1]; }
    }
}

__device__ void rwkv_naive(const Params& p, int l, int bh, unsigned char* lds) {
    const int b = bh >> 3, h = bh & 7, tid = otid(), lane = tid & 63, wid = tid >> 6;
    const bf16_t* U = (const bf16_t*)(p.ws + WS_UAR);
    bf16_t* OB = (bf16_t*)(p.ws + WS_OAB);
    float* xs = (float*)lds;
    float* vr = xs + 32 * 256;
    float* vw = vr + 2048; float* vkk = vw + 2048; float* vbb = vkk + 2048; float* vk = vbb + 2048; float* vv = vk + 2048;
    float* gg = vv + 2048; float* bon = gg + 2048; float* ys = bon + 2048;
    const float* mu = p.in[I_MU] + l * R_COLS;
    const int hd = h * 64 + lane;
    const float w0 = p.in[I_W0][l * 512 + hd], a0 = p.in[I_A0][l * 512 + hd], kkc = p.in[I_KK][l * 512 + hd], kac = p.in[I_KA][l * 512 + hd], rkc = p.in[I_RK][l * 512 + hd];
    const float gng = p.in[I_GNG][l * 512 + hd], gnb = p.in[I_GNB][l * 512 + hd];
    const float mur = mu[hd], muk = mu[512 + hd], muv = mu[1024 + hd];
    const float* wup = p.in[I_WUP] + (size_t)l * 64 * 512 + hd; const float* aup = p.in[I_AUP] + (size_t)l * 64 * 512 + hd; const float* gup = p.in[I_GUP] + (size_t)l * 128 * 512 + hd;
    float S[8];
#pragma unroll
    for (int i = 0; i < 8; ++i) S[i] = 0.f;
    const int sv = tid >> 3, sq = tid & 7;
    for (int p0 = 0; p0 < LP; p0 += 32) {
        for (int idx = tid; idx < 32 * 256; idx += NTHREADS) {
            const int tt = idx >> 8, j = idx & 255, pos = p0 + tt; const size_t ro = (size_t)(b * LP + pos) * UARW;
            const float x = bf2f(U[ro + C_XW + j]); const float xp = pos > 0 ? bf2f(U[ro - UARW + C_XW + j]) : 0.f;
            float xv = x + (xp - x) * mu[1536 + j];
            if (j < 64) xv = tanhf(xv); else if (j >= 128) xv = sigmoidf_(xv);
            xs[idx] = xv;
        }
        __syncthreads();
        {
            float dw[4] = {0.f, 0.f, 0.f, 0.f}, da[4] = {0.f, 0.f, 0.f, 0.f}, dg[4] = {0.f, 0.f, 0.f, 0.f};
            for (int j = 0; j < 64; ++j) { const float w1 = wup[(size_t)j * 512], w2 = aup[(size_t)j * 512];
#pragma unroll
                for (int k = 0; k < 4; ++k) { dw[k] = fmaf(xs[(wid * 4 + k) * 256 + j], w1, dw[k]); da[k] = fmaf(xs[(wid * 4 + k) * 256 + 64 + j], w2, da[k]); } }
            for (int j = 0; j < 128; ++j) { const float w3 = gup[(size_t)j * 512];
#pragma unroll
                for (int k = 0; k < 4; ++k) dg[k] = fmaf(xs[(wid * 4 + k) * 256 + 128 + j], w3, dg[k]); }
#pragma unroll
            for (int k = 0; k < 4; ++k) {
                const int tt = wid * 4 + k, pos = p0 + tt; const size_t ro = (size_t)(b * LP + pos) * UARW;
                float r = bf2f(U[ro + C_R + hd]), kx = bf2f(U[ro + C_RK + hd]), vx = bf2f(U[ro + C_RV + hd]);
                if (pos > 0) { const float rp = bf2f(U[ro - UARW + C_R + hd]), kp = bf2f(U[ro - UARW + C_RK + hd]), vp = bf2f(U[ro - UARW + C_RV + hd]);
                    r += (rp - r) * mur; kx += (kp - kx) * muk; vx += (vp - vx) * muv; }
                else { r -= r * mur; kx -= kx * muk; vx -= vx * muv; }
                const float z = -(w0 + dw[k]); const float sp = fmaxf(z, 0.f) + log1pf(__expf(-fabsf(z)));
                const float logw = -sp - 0.5f; const float w = __expf(-__expf(logw));
                const float a = sigmoidf_(a0 + da[k]);
                float kk = kx * kkc; const float nrm = wave_sum(kk * kk); kk *= rsqrtf(fmaxf(nrm, 1e-24f));
                const float kmod = kx * (1.0f + (a - 1.0f) * kac);
                const float bsum = wave_sum(r * kmod * rkc);
                vr[tt * 64 + lane] = r; vw[tt * 64 + lane] = w; vkk[tt * 64 + lane] = kk; vbb[tt * 64 + lane] = kk * a; vk[tt * 64 + lane] = kmod; vv[tt * 64 + lane] = vx;
                gg[tt * 64 + lane] = dg[k]; bon[tt * 64 + lane] = bsum * vx;
            }
        }
        __syncthreads();
        for (int tt = 0; tt < 32; ++tt) {
            const f32x4 k0 = *(const f32x4*)(vkk + tt * 64 + sq * 8), k1 = *(const f32x4*)(vkk + tt * 64 + sq * 8 + 4);
            const f32x4 w0v = *(const f32x4*)(vw + tt * 64 + sq * 8), w1v = *(const f32x4*)(vw + tt * 64 + sq * 8 + 4);
            const f32x4 b0 = *(const f32x4*)(vbb + tt * 64 + sq * 8), b1 = *(const f32x4*)(vbb + tt * 64 + sq * 8 + 4);
            const f32x4 m0 = *(const f32x4*)(vk + tt * 64 + sq * 8), m1 = *(const f32x4*)(vk + tt * 64 + sq * 8 + 4);
            const f32x4 r0 = *(const f32x4*)(vr + tt * 64 + sq * 8), r1 = *(const f32x4*)(vr + tt * 64 + sq * 8 + 4);
            const float vt = vv[tt * 64 + sv];
            float sa = 0.f;
#pragma unroll
            for (int i = 0; i < 4; ++i) { sa = fmaf(S[i], k0[i], sa); sa = fmaf(S[4 + i], k1[i], sa); }
            sa += __shfl_xor(sa, 1); sa += __shfl_xor(sa, 2); sa += __shfl_xor(sa, 4);
            sa = -sa; float y = 0.f;
#pragma unroll
            for (int i = 0; i < 4; ++i) { S[i] = S[i] * w0v[i] + sa * b0[i] + vt * m0[i]; S[4 + i] = S[4 + i] * w1v[i] + sa * b1[i] + vt * m1[i];
                y = fmaf(S[i], r0[i], y); y = fmaf(S[4 + i], r1[i], y); }
            y += __shfl_xor(y, 1); y += __shfl_xor(y, 2); y += __shfl_xor(y, 4);
            if (sq == 0) ys[tt * 64 + sv] = y;
        }
        __syncthreads();
#pragma unroll
        for (int k = 0; k < 4; ++k) { const int tt = wid * 4 + k, pos = p0 + tt; const float y = ys[tt * 64 + lane];
            const float m = wave_sum(y) * (1.f / 64.f); const float dv = y - m; const float var = wave_sum(dv * dv) * (1.f / 64.f);
            const float o = (dv * rsqrtf(var + GN_EPS) * gng + gnb + bon[tt * 64 + lane]) * gg[tt * 64 + lane];
            OB[(size_t)(b * LP + pos) * D + 512 + hd] = (bf16_t)f2bf(o); }
        __syncthreads();
    }
}

__device__ __forceinline__ int pair_index(int a, int b) {   return a == 0 ? b - 1 : (a == 1 ? b + 1 : 5); }
__device__ __forceinline__ void pair_of(int idx, int& a, int& b) { a = idx < 3 ? 0 : (idx < 5 ? 1 : 2); b = idx < 3 ? idx + 1 : (idx < 5 ? idx - 1 : 3); }
__device__ __forceinline__ void ln1_router_phase(const Params& p, int l, unsigned char* lds) {
    const int tid = otid(), lane = tid & 63, gw = obid() * NWAVES + (tid >> 6), NGW = gridDim.x * NWAVES;
    float* wr_s = (float*)lds;
    for (int i = tid; i < D * 16 / 4; i += NTHREADS) ((f32x4*)wr_s)[i] = ((const f32x4*)p.in[I_WROUTER])[i];
    __syncthreads();
    unsigned* cls_cnt = (unsigned*)(p.ws + WS_CTL) + CW_CLS + l * 32;
    int* lists = (int*)(p.ws + WS_LIST); f32x2* gl = (f32x2*)(p.ws + WS_LIST + 2 * MiB);
    const float* g = p.in[I_LN1G] + l * D; const float* bt = p.in[I_LN1B] + l * D;
    for (int r = gw; r < T; r += NGW) {
        f32x4 v[4];
        if (is_dummy(r)) {
#pragma unroll
            for (int j = 0; j < 4; ++j) v[j] = (f32x4){0.f, 0.f, 0.f, 0.f};
            store_row(p, r, v, lane, true); continue; }
        const float* hr = hrow(p, r);
#pragma unroll
        for (int j = 0; j < 4; ++j) v[j] = *(const f32x4*)(hr + 4 * lane + 256 * j);
        ln_wave(v, g, bt, lane);
        store_row(p, r, v, lane, false);
        float lg[16];
#pragma unroll
        for (int e = 0; e < 16; ++e) lg[e] = 0.f;
#pragma unroll
        for (int j = 0; j < 4; ++j)
#pragma unroll
            for (int c = 0; c < 4; ++c) { const float x = v[j][c]; const float* wrow = wr_s + (size_t)(4 * lane + 256 * j + c) * 16;
#pragma unroll
                for (int e4 = 0; e4 < 4; ++e4) { const f32x4 w = *(const f32x4*)(wrow + 4 * e4);
                    lg[4 * e4 + 0] = fmaf(x, w[0], lg[4 * e4 + 0]); lg[4 * e4 + 1] = fmaf(x, w[1], lg[4 * e4 + 1]); lg[4 * e4 + 2] = fmaf(x, w[2], lg[4 * e4 + 2]); lg[4 * e4 + 3] = fmaf(x, w[3], lg[4 * e4 + 3]); } }
#pragma unroll
        for (int e = 0; e < 16; ++e) lg[e] = wave_sum(lg[e]);
        float s[16], sel[16];
#pragma unroll
        for (int e = 0; e < 16; ++e) { s[e] = sigmoidf_(lg[e]); sel[e] = s[e] + p.in[I_BROUTER][e]; }
        int gbest = 0; float gsc = -INFINITY;
#pragma unroll
        for (int gi = 0; gi < 4; ++gi) { float m1 = -INFINITY, m2 = -INFINITY;
#pragma unroll
            for (int j = 0; j < 4; ++j) { const float x = sel[gi * 4 + j]; if (x > m1) { m2 = m1; m1 = x; } else if (x > m2) m2 = x; }
            const float sc = m1 + m2; if (sc > gsc) { gsc = sc; gbest = gi; } }
        float sg[4], sgs[4];
#pragma unroll
        for (int j = 0; j < 4; ++j) { sg[j] = gbest == 0 ? sel[j] : (gbest == 1 ? sel[4 + j] : (gbest == 2 ? sel[8 + j] : sel[12 + j])); sgs[j] = gbest == 0 ? s[j] : (gbest == 1 ? s[4 + j] : (gbest == 2 ? s[8 + j] : s[12 + j])); }
        int j1 = 0;
#pragma unroll
        for (int j = 1; j < 4; ++j) if (sg[j] > sg[j1]) j1 = j;
        int j2 = j1 == 0 ? 1 : 0;
#pragma unroll
        for (int j = 0; j < 4; ++j) if (j != j1 && j != j2 && sg[j] > sg[j2]) j2 = j;
        const int ja = j1 < j2 ? j1 : j2, jb = j1 < j2 ? j2 : j1;
        float sa_ = 0.f, sb_ = 0.f;
#pragma unroll
        for (int j = 0; j < 4; ++j) { if (j == ja) sa_ = sgs[j]; if (j == jb) sb_ = sgs[j]; }
        const float inv = 1.0f / (sa_ + sb_);
        const int cls = gbest * 6 + pair_index(ja, jb);
        if (lane == 0) { const unsigned slot = atomicAdd(cls_cnt + cls, 1u); lists[(size_t)cls * T + slot] = r; gl[r] = (f32x2){sa_ * inv, sb_ * inv}; }
    }
}

struct ClsTab { int cnt[24]; int tile0[25]; int row0[24]; };
__device__ __forceinline__ void build_cls_table(const Params& p, int l, int* tab  ) {
    if (otid() == 0) { const unsigned* c = (const unsigned*)(p.ws + WS_CTL) + CW_CLS + l * 32; int acc = 0;
        for (int i = 0; i < 24; ++i) { const int n = (int)__hip_atomic_load(c + i, __ATOMIC_RELAXED, __HIP_MEMORY_SCOPE_AGENT); tab[i] = n; tab[24 + i] = acc; acc += (n + 255) >> 8; }
        tab[48] = acc; }
    __syncthreads();
}
__device__ __forceinline__ int find_cls(const int* tab, int tile) { int c = 0;
#pragma unroll 1
    for (int i = 1; i < 24; ++i) if (tile >= tab[24 + i]) c = i;
    return c; }
__device__ __forceinline__ void moe_a_phase(const Params& p, int l, LAS unsigned char* lds, const int* tab) {
    const int tid = otid();
    unsigned voffB[2]; g8::make_voffB(voffB, D * 2, true);
    const int ntiles = tab[48], nunits = ntiles * 8;
    for (int u = obid(); u < nunits; u += gridDim.x) {
        const int tile = u >> 3, pn = u & 7, cls = find_cls(tab, tile), rt = tile - tab[24 + cls], n = tab[cls];
        int ja, jb; pair_of(cls % 6, ja, jb); const int eslot = pn >> 2, e = (cls / 6) * 4 + (eslot ? jb : ja), jblk = pn & 3;
        unsigned voffA[2][2]; { const int* lists = (const int*)(PP().ws + WS_LIST);
#pragma unroll
        for (int i = 0; i < 2; ++i) { int R, C; g8::stage_rc(tid * 16 + i * 8192, R, C);
#pragma unroll
            for (int hh = 0; hh < 2; ++hh) { const int li = rt * 256 + R + hh * 128; const int tok = li < n ? lists[(size_t)cls * T + li] : 0;
                voffA[hh][i] = (unsigned)tok * (D * 2) + (unsigned)C * 2u; } } }
        g8::Acc acc; g8::zero_acc(acc);
        const char* Bb = (const char*)(PP().ws + WS_WEXP) + ((size_t)e * 1024 + jblk * 256) * D * 2;
        const g8::KSeg s = g8::seg1((const char*)(PP().ws + WS_HB), Bb, Bb + (size_t)128 * D * 2, D / 64);
        g8::kloop<true, false>(lds, acc, s, voffA, voffB, 0);
        EPI_COORDS();
        const int* lists = (const int*)(PP().ws + WS_LIST); const f32x2* gl = (const f32x2*)(PP().ws + WS_LIST + 2 * MiB); bf16_t* ACT = (bf16_t*)(PP().ws + WS_ACT);
#pragma unroll
        for (int ai = 0; ai < 2; ++ai)
#pragma unroll
            for (int m = 0; m < 4; ++m) { asm volatile("" ::: "memory"); const int li = rt * 256 + ai * 128 + wr * 64 + m * 16 + fr; const int tok = li < n ? lists[(size_t)cls * T + li] : -1;
                float gate = 0.f; if (tok >= 0) { const f32x2 g2 = gl[tok]; gate = eslot ? g2[1] : g2[0]; }
                const f32x4 h1a = acc[ai][0][m][0], h1b = acc[ai][0][m][1], h3a = acc[ai][1][m][0], h3b = acc[ai][1][m][1];
                float o[8];
#pragma unroll
                for (int c = 0; c < 4; ++c) { o[c] = gate * (h1a[c] * sigmoidf_(h1a[c])) * h3a[c]; o[4 + c] = gate * (h1b[c] * sigmoidf_(h1b[c])) * h3b[c]; }
                u32x4 w; w.x = pk2(o[0], o[1]); w.y = pk2(o[2], o[3]); w.z = pk2(o[4], o[5]); w.w = pk2(o[6], o[7]);
                *(u32x4*)(ACT + (size_t)(tile * 256 + ai * 128 + wr * 64 + m * 16 + fr) * D + eslot * 512 + jblk * 128 + wc * 32 + 8 * fq) = w; }
    }
}
__device__ __forceinline__ void moe_b_phase(const Params& p, int l, LAS unsigned char* lds, const int* tab) {
    unsigned voffA[2][2], voffB[2]; g8::make_voff_contig(voffA, D * 2); g8::make_voffB(voffB, 512 * 2, false);
    const int ntiles = tab[48], nunits = ntiles * 4;
    for (int u = obid(); u < nunits; u += gridDim.x) {
        const int tile = u >> 2, pn = u & 3, cls = find_cls(tab, tile), rt = tile - tab[24 + cls], n = tab[cls];
        int ja, jb; pair_of(cls % 6, ja, jb); const int ea = (cls / 6) * 4 + ja, eb = (cls / 6) * 4 + jb;
        g8::Acc acc; g8::zero_acc(acc);
        const char* At = (const char*)(PP().ws + WS_ACT) + (size_t)tile * 256 * D * 2;
        const char* W2 = (const char*)(PP().ws + WS_WEXP + 32 * MiB);
        const char* Ba = W2 + ((size_t)ea * 1024 + pn * 256) * 512 * 2; const char* Bb = W2 + ((size_t)eb * 1024 + pn * 256) * 512 * 2;
        g8::KSeg s2 = g8::seg1(At, Ba, Ba + (size_t)128 * 512 * 2, 16); s2.nt0 = 8; s2.A2 = At + 1024; s2.B02 = Bb; s2.B12 = Bb + (size_t)128 * 512 * 2;
        g8::kloop<false, true>(lds, acc, s2, voffA, voffB, 128 * D * 2);
        EPI_COORDS();
        const int* lists = (const int*)(PP().ws + WS_LIST);
        const int col0 = pn * 256 + wc * 32 + 4 * fq;
#pragma unroll
        for (int ai = 0; ai < 2; ++ai)
#pragma unroll
            for (int m = 0; m < 4; ++m) { asm volatile("" ::: "memory"); const int li = rt * 256 + ai * 128 + wr * 64 + m * 16 + fr;
                if (li < n) { const int tok = lists[(size_t)cls * T + li]; float* hr = hrow(PP(), tok) + col0;
#pragma unroll
                    for (int bj = 0; bj < 2; ++bj)
#pragma unroll
                        for (int nn = 0; nn < 2; ++nn) { f32x4* hp = (f32x4*)(hr + bj * 128 + nn * 16); *hp = *hp * ALPHA + acc[ai][bj][m][nn]; } } }
    }
}
__device__ __forceinline__ void ln2_phase(const Params& p, int l) {
    const int tid = otid(), lane = tid & 63, gw = obid() * NWAVES + (tid >> 6), NGW = gridDim.x * NWAVES;
    const float* g = p.in[I_LN2G] + l * D; const float* bt = p.in[I_LN2B] + l * D;
    for (int r = gw; r < T; r += NGW) {
        f32x4 v[4];
        if (is_dummy(r)) {
#pragma unroll
            for (int j = 0; j < 4; ++j) v[j] = (f32x4){0.f, 0.f, 0.f, 0.f};
            store_row(p, r, v, lane, true); continue; }
        const float* hr = hrow(p, r);
#pragma unroll
        for (int j = 0; j < 4; ++j) v[j] = *(const f32x4*)(hr + 4 * lane + 256 * j);
        ln_wave(v, g, bt, lane);
        store_row(p, r, v, lane, false);
    }
}


#define XB_TMO      128
#define XB_XCNT(j)  (256  + 64 * (j))
#define XB_XSUB(j)  (1280 + 64 * (j))
#define XB_XGEN(j)  (2304 + 64 * (j))
#define XB_TOP      3328
#define XB_TOPGEN   3392
#define XCD_BAR_WORDS 3456
#define XB_SPIN_CAP (1u << 22)
constexpr size_t WS_BAR = 8192;
constexpr int LDS_BARST = LDS_BYTES - 16;
__device__ __forceinline__ unsigned xb_ld(unsigned* p)              { return __hip_atomic_load(p, __ATOMIC_RELAXED, __HIP_MEMORY_SCOPE_AGENT); }
__device__ __forceinline__ unsigned xb_add(unsigned* p, unsigned v) { return __hip_atomic_fetch_add(p, v, __ATOMIC_RELAXED, __HIP_MEMORY_SCOPE_AGENT); }
__device__ __forceinline__ unsigned xb_xcc_id() { return (unsigned)__builtin_amdgcn_s_getreg((3 << 11) | 20) & 0xFu; }
#define XB_SPIN(cond, bar) do { unsigned _sp = 0; while (cond) { __builtin_amdgcn_s_sleep(1); \
    if ((++_sp & 255u) == 0u) { if (xb_ld(&(bar)[XB_TMO])) break; if (_sp > XB_SPIN_CAP) { atomicAdd(&(bar)[XB_TMO], 1u); break; } } } } while (0)
__device__ __forceinline__ void xcd_barrier_complete(unsigned* bar, unsigned x, unsigned& nloc, unsigned& nx) {
    const unsigned G = gridDim.x * gridDim.y * gridDim.z;
    unsigned sum, cnt, mine, sp = 0u;
    for (;;) {
        sum = 0u; cnt = 0u; mine = 0u;
#pragma unroll
        for (unsigned j = 0; j < 16; ++j) { const unsigned c = xb_ld(&bar[XB_XCNT(j)]); sum += c; cnt += (c > 0u) ? 1u : 0u; mine = (j == x) ? c : mine; }
        if (sum == G) break;
        __builtin_amdgcn_s_sleep(1);
        if ((++sp & 255u) == 0u) { if (xb_ld(&bar[XB_TMO])) break; if (sp > XB_SPIN_CAP) { atomicAdd(&bar[XB_TMO], 1u); break; } }
    }
    nloc = mine > 0u ? mine : 1u; nx = cnt > 0u ? cnt : 1u;
}
__device__ __forceinline__ void xcd_barrier(unsigned* bar, volatile LAS unsigned* st) {
    asm volatile("s_waitcnt vmcnt(0)" ::: "memory");
    __syncthreads();
    if (threadIdx.x == 0) {
        __builtin_amdgcn_s_waitcnt(0);
        const unsigned x = xb_xcc_id();
        unsigned nloc = st[0], nx = st[1];
        if (nloc == 0u) { xcd_barrier_complete(bar, x, nloc, nx); st[0] = nloc; st[1] = nx; }
        const unsigned old = xb_add(&bar[XB_XSUB(x)], 1u);
        const unsigned gen = old / nloc;
        if (old + 1u == (gen + 1u) * nloc) {
            __builtin_amdgcn_fence(__ATOMIC_RELEASE, "agent");
            asm volatile("s_waitcnt vmcnt(0)" ::: "memory");
            const unsigned og = xb_add(&bar[XB_TOP], 1u);
            const unsigned tg = og / nx;
            if (og + 1u == (tg + 1u) * nx) xb_add(&bar[XB_TOPGEN], 1u);
            else XB_SPIN(xb_ld(&bar[XB_TOPGEN]) == tg, bar);
            __builtin_amdgcn_fence(__ATOMIC_ACQUIRE, "agent");
            xb_add(&bar[XB_XGEN(x)], 1u);
            asm volatile("s_waitcnt vmcnt(0)" ::: "memory");
        } else {
            XB_SPIN(xb_ld(&bar[XB_XGEN(x)]) == gen, bar);
            __builtin_amdgcn_fence(__ATOMIC_ACQUIRE, "agent");
            asm volatile("s_waitcnt vmcnt(0)" ::: "memory");
        }
    }
    __syncthreads();
}

__global__ void __launch_bounds__(NTHREADS, 2) mega(Params p_unused) {
    extern __shared__ __attribute__((aligned(16))) unsigned char lds[];
    cg::grid_group grid = cg::this_grid();
    volatile LAS unsigned* barst = (volatile LAS unsigned*)((LAS unsigned char*)lds + LDS_BARST);
    { unsigned* bar0 = (unsigned*)(PP().ws + WS_BAR);
      if (threadIdx.x == 0) { barst[0] = 0u; barst[1] = 0u; (void)xb_add(bar0 + XB_XCNT(xb_xcc_id()), 1u); } }
    __syncthreads();
#define GBAR() xcd_barrier((unsigned*)(PP().ws + WS_BAR), barst)
#define LDSG() (lds + ozero())
#define LDSL() ((LAS unsigned char*)lds)

    conv_small_weights(PP(), LDSL());
    ln_in_phase(PP());
    grid.sync();
#pragma unroll 1
    for (int l = 0; l < DEPTH; ++l) {
        inproj_phase(PP(), l, LDSL());
        GBAR();
        for (int u = obid(); u < BATCH * NCH * 8; u += gridDim.x) { rwkv_prep_unit(PP(), l, u, LDSG()); }
        GBAR();
        const int bid = obid();
        if (bid < 32) { rwkv_scan(PP(), l, bid, LDSG()); }
        else { attn_phase(PP(), l, LDSG()); }
        GBAR();
        merge_phase(PP(), l, LDSL());
        GBAR();
        wout_phase(PP(), l, LDSL());
        conv_expert_weights(PP(), l, LDSL());
        GBAR();
        ln1_router_phase(PP(), l, LDSG());
        GBAR();
        { int toff = 140 * 1024; asm volatile("" : "+s"(toff)); int* tab = (int*)(lds + toff);
          build_cls_table(PP(), l, tab);
          moe_a_phase(PP(), l, LDSL(), tab);
          GBAR();
          moe_b_phase(PP(), l, LDSL(), tab); }
        GBAR();
        ln2_phase(PP(), l);
        if (l + 1 < DEPTH) GBAR();
    }
}

extern "C" void kernel_launch(void* const* d_in, const int* in_sizes, int n_in, void* d_out, int out_size,
                              void* d_ws, size_t ws_size, hipStream_t stream) {
    static int grid_blocks = 0;
    if (grid_blocks == 0) {
        int dev = 0, cus = 0, per_cu = 0;
        if (n_in != 29 || ws_size < WS_END || out_size != BATCH * SEQ * D) { fprintf(stderr, "kernel_launch: unexpected problem (n_in %d, ws %zu, out %d)\n", n_in, ws_size, out_size); grid_blocks = -1; return; }
        (void)hipGetDevice(&dev);
        (void)hipDeviceGetAttribute(&cus, hipDeviceAttributeMultiprocessorCount, dev);
        (void)hipFuncSetAttribute((const void*)mega, hipFuncAttributeMaxDynamicSharedMemorySize, LDS_BYTES);
        (void)hipOccupancyMaxActiveBlocksPerMultiprocessor(&per_cu, (const void*)mega, NTHREADS, LDS_BYTES);
        if (per_cu < 1) { fprintf(stderr, "occupancy query returned %d\n", per_cu); grid_blocks = -1; return; }
        grid_blocks = cus;
    }
    if (grid_blocks < 0) return;
    (void)hipMemsetAsync((char*)d_ws + WS_CTL, 0, 32768, stream);
    Params p{};
    for (int i = 0; i < 29; ++i) p.in[i] = (const float*)d_in[i];
    p.out = (float*)d_out; p.ws = (unsigned char*)d_ws;
    void* args[] = {&p};
    hipError_t e = hipLaunchCooperativeKernel((const void*)mega, dim3(grid_blocks), dim3(NTHREADS), args, LDS_BYTES, stream);
    if (e != hipSuccess) fprintf(stderr, "cooperative launch failed: %s (grid %d)\n", hipGetErrorString(e), grid_blocks);
}
```

```cpp
#include <hip/hip_runtime.h>
#include <hip/hip_cooperative_groups.h>
#include <cstdio>
#include <cstdint>
namespace cg = cooperative_groups;

#define LAS __attribute__((address_space(3)))
typedef unsigned short bf16_t;
typedef short bf16x8 __attribute__((ext_vector_type(8)));
typedef float f32x4 __attribute__((ext_vector_type(4)));
typedef float f32x2 __attribute__((ext_vector_type(2)));
typedef unsigned u32x4 __attribute__((ext_vector_type(4)));
typedef unsigned u32x2 __attribute__((ext_vector_type(2)));

constexpr int NTHREADS = 512, NWAVES = 8;
constexpr int D = 1024, BATCH = 4, SEQ = 4096, DEPTH = 2;
constexpr int LP = 4160;
constexpr int T = BATCH * LP;
constexpr int NCH = LP / 64;
constexpr int PADM = 48;
constexpr int A_COLS = 1064, R_COLS = 1792, IN_COLS = 4904;
constexpr int UA = 1280;
constexpr int UARW = 3072;
constexpr int NIN = 5120;
constexpr float LN_EPS = 1e-5f, GN_EPS = 64e-5f;
constexpr float ALPHA = 1.41421356237309515f;
constexpr int C_Q = 0, C_K = 512, C_V = 640, C_QI = 768, C_KI = 1024, C_WI = 1056;
constexpr int C_R = UA, C_RK = UA + 512, C_RV = UA + 1024, C_XW = UA + 1536, C_XA = UA + 1600, C_XG = UA + 1664;

constexpr size_t MiB = 1u << 20;
constexpr size_t WS_CTL = 0;
constexpr size_t WS_HM = 1 * MiB;
constexpr size_t WS_WSMALL = 2 * MiB;
constexpr size_t WSMALL_LAYER = 14 * MiB;
constexpr size_t WS_HB = 30 * MiB;
constexpr size_t WS_UAR = 63 * MiB;
constexpr size_t WS_GATES = 161 * MiB;
constexpr size_t WS_OAB = 226 * MiB;
constexpr size_t WS_LIST = WS_GATES + 48 * MiB;
constexpr size_t WS_END = 308 * MiB;
constexpr size_t WS_MERGED = WS_UAR;
constexpr size_t WS_ACT = WS_UAR + 33 * MiB;
constexpr size_t WS_WEXP = WS_GATES;
constexpr int ACT_ROWS_MAX = 16448 + 24 * 256;
static_assert(WS_ACT + (size_t)ACT_ROWS_MAX * 2048 <= WS_GATES, "act fits");
constexpr int CW_CLS = 64;

constexpr int LDS_BYTES = 155648;

struct Params {
    const float* in[29];
    float* out;
    unsigned char* ws;
};
enum { I_X = 0, I_META, I_LNIN_G, I_LNIN_B, I_WIN, I_BGATE, I_MU, I_W0, I_WUP, I_A0, I_AUP, I_GUP, I_KK, I_KA, I_RK, I_GNG, I_GNB,
       I_WBA, I_WBB, I_WOUT, I_LN1G, I_LN1B, I_LN2G, I_LN2B, I_WROUTER, I_BROUTER, I_WEXP1, I_WEXP3, I_WEXP2 };

__device__ __forceinline__ int otid() { int t = threadIdx.x; asm volatile("" : "+v"(t)); return t; }
__device__ __forceinline__ const char* uptr(const char* p) { const unsigned long long v = (unsigned long long)p; const unsigned lo = __builtin_amdgcn_readfirstlane((unsigned)v), hi = __builtin_amdgcn_readfirstlane((unsigned)(v >> 32)); return (const char*)(((unsigned long long)hi << 32) | lo); }
__device__ __forceinline__ int ozero() { int z = 0; asm volatile("" : "+s"(z)); return z; }
__device__ __forceinline__ int obid() { int b = blockIdx.x; asm volatile("" : "+s"(b)); return b; }
typedef __bf16 bf16x2_t __attribute__((ext_vector_type(2)));
__device__ __forceinline__ unsigned f2bf(float f) { return (unsigned)__builtin_bit_cast(unsigned short, (__bf16)f); }
__device__ __forceinline__ unsigned pk2(float lo, float hi) { const f32x2 v = {lo, hi}; return __builtin_bit_cast(unsigned, __builtin_convertvector(v, bf16x2_t)); }
template <int CTRL> __device__ __forceinline__ float dpp_f(float v) { return __builtin_bit_cast(float, __builtin_amdgcn_update_dpp(0, __builtin_bit_cast(int, v), CTRL, 0xF, 0xF, true)); }
__device__ __forceinline__ float sum8(float v) { v += dpp_f<0xB1>(v); v += dpp_f<0x4E>(v); v += dpp_f<0x141>(v); return v; }
__device__ __forceinline__ float sum16(float v) { v = sum8(v); v += dpp_f<0x140>(v); return v; }
__device__ __forceinline__ float bf2f(unsigned short b) { return __builtin_bit_cast(float, (unsigned)b << 16); }
__device__ __forceinline__ float bflo(unsigned w) { return __builtin_bit_cast(float, w << 16); }
__device__ __forceinline__ float bfhi(unsigned w) { return __builtin_bit_cast(float, w & 0xffff0000u); }
__device__ __forceinline__ float wave_sum(float v) { v = sum16(v); v += __shfl_xor(v, 16); v += __shfl_xor(v, 32); return v; }
__device__ __forceinline__ float wave_max(float v) {
#pragma unroll
    for (int o = 1; o < 64; o <<= 1) v = fmaxf(v, __shfl_xor(v, o));
    return v;
}
__device__ __forceinline__ float sigmoidf_(float x) { return 1.0f / (1.0f + __expf(-x)); }
__device__ __forceinline__ float* hrow(const Params& p, int r) {
    const int b = r / LP, pos = r - b * LP;
    return pos >= 64 ? p.out + ((size_t)(b * SEQ + (pos - 64)) << 10) : (float*)(p.ws + WS_HM) + ((size_t)(b * 64 + pos) << 10);
}
__device__ __forceinline__ bool is_dummy(int r) { return (r % LP) < PADM; }

__device__ __forceinline__ void transpose_item(const float* src, int ld_src, int col0, int nvalid, bf16_t* dst  , int ld_dst, LAS float* scr, int lane) {
    const int c = lane & 31;
#pragma unroll 8
    for (int i = 0; i < 32; ++i) { const int kk = 2 * i + (lane >> 5); scr[kk * 33 + c] = c < nvalid ? src[(size_t)kk * ld_src + col0 + c] : 0.f; }
    asm volatile("s_waitcnt lgkmcnt(0)" ::: "memory");
    const int ch = lane & 7;
#pragma unroll
    for (int j = 0; j < 4; ++j) { const int n = (lane >> 3) + 8 * j; const LAS float* s = scr + (8 * ch) * 33 + n;
        u32x4 o; o.x = pk2(s[0 * 33], s[1 * 33]); o.y = pk2(s[2 * 33], s[3 * 33]); o.z = pk2(s[4 * 33], s[5 * 33]); o.w = pk2(s[6 * 33], s[7 * 33]);
        *(u32x4*)(dst + (size_t)n * ld_dst + 8 * ch) = o; }
    asm volatile("s_waitcnt lgkmcnt(0)" ::: "memory");
}

namespace g8 {
constexpr int BM = 256, BK = 64, HALF = 128, HTB = HALF * BK * 2, STAGE_BYTES = 8 * HTB;
__host__ __device__ __forceinline__ int lds_byte(int r, int c) { const int st = (r >> 4) * 2 + (c >> 5), rr = r & 15, cc = c & 31, ob = rr * 64 + cc * 2; return st * 1024 + (ob ^ (((ob >> 9) & 1) << 5)); }
__host__ __device__ __forceinline__ void stage_rc(int b, int& R, int& C) { const int st = b / 1024, sb = b % 1024, swz = sb ^ (((sb >> 9) & 1) << 5); R = (st >> 1) * 16 + swz / 64; C = (st & 1) * 32 + (swz % 64) / 2; }
__host__ __device__ __forceinline__ int perm32(int rho) { const int n = rho >> 4, i = rho & 15; return 8 * (i >> 2) + 4 * n + (i & 3); }

struct KSeg {
    const char* A;
    const char* B0;
    const char* B1;
    int nt;
    int nt0;
    const char* A2;
    const char* B02;
    const char* B12;
};
__device__ __forceinline__ KSeg seg1(const char* A, const char* B0, const char* B1, int nt) { KSeg s; s.A = A; s.B0 = B0; s.B1 = B1; s.nt = nt; s.nt0 = nt; s.A2 = A; s.B02 = B0; s.B12 = B1; return s; }
typedef f32x4 Acc[2][2][4][2];

template <bool GATHER, bool TWOSEG>
__device__ __forceinline__ void kloop(LAS unsigned char* lds, Acc& acc, const KSeg s, const unsigned (&voffA)[2][2], const unsigned (&voffB)[2], const unsigned hstepA) {
    int tid = threadIdx.x; asm volatile("" : "+v"(tid));
    const int wid = __builtin_amdgcn_readfirstlane(tid >> 6), lane = tid & 63, wr = wid >> 2, wc = wid & 3, fr = lane & 15, fq = lane >> 4;
    const unsigned ldsw = (unsigned)wid * 1024u;
    const int aoff = lds_byte(wr * 64 + fr, fq * 8), boff = lds_byte(wc * 32 + fr, fq * 8);
    const int nt = __builtin_amdgcn_readfirstlane(s.nt);
#define G8_SA(b, h) (((b) * 2 + (h)) * HTB)
#define G8_SB(b, h) ((4 + (b) * 2 + (h)) * HTB)
#define G8_STAGE(bufoff, gbase, voff) do { _Pragma("unroll") for (int _i = 0; _i < 2; ++_i) \
        __builtin_amdgcn_global_load_lds((const unsigned*)((const char*)(gbase) + (voff)[_i]), (LAS unsigned*)(lds + (bufoff) + ldsw + _i * 8192), 16, 0, 0); } while (0)
#define G8_LDA(dst, b, h) do { _Pragma("unroll") for (int m = 0; m < 4; ++m) _Pragma("unroll") for (int k = 0; k < 2; ++k) dst[m][k] = *(const LAS bf16x8*)(lds + G8_SA(b, h) + aoff + m * 2048 + k * 1024); } while (0)
#define G8_LDB(dst, b, h) do { _Pragma("unroll") for (int n = 0; n < 2; ++n) _Pragma("unroll") for (int k = 0; k < 2; ++k) dst[n][k] = *(const LAS bf16x8*)(lds + G8_SB(b, h) + boff + n * 2048 + k * 1024); } while (0)
#define G8_MMA(ai, bj, At, Bt) do { __builtin_amdgcn_s_setprio(1); _Pragma("unroll") for (int m = 0; m < 4; ++m) _Pragma("unroll") for (int n = 0; n < 2; ++n) _Pragma("unroll") for (int k = 0; k < 2; ++k) \
        acc[ai][bj][m][n] = __builtin_amdgcn_mfma_f32_16x16x32_bf16(Bt[n][k], At[m][k], acc[ai][bj][m][n], 0, 0, 0); __builtin_amdgcn_s_setprio(0); } while (0)
#define G8_WAIT_V(n) asm volatile("s_waitcnt vmcnt(" #n ")" ::: "memory")
#define G8_WAIT_L(n) asm volatile("s_waitcnt lgkmcnt(" #n ")" ::: "memory")
#define G8_BAR __builtin_amdgcn_s_barrier()
#define G8_SCHED __builtin_amdgcn_sched_barrier(0)
    bf16x8 At[4][2], B0[2][2], B1[2][2];
    const char* pA = uptr(s.A); const char* pB0 = uptr(s.B0); const char* pB1 = uptr(s.B1);
    constexpr int KS = BK * 2;
    const int nt0 = TWOSEG ? s.nt0 : 0; const char* qA = TWOSEG ? uptr(s.A2 - (size_t)nt0 * KS) : pA; const char* qB0 = TWOSEG ? uptr(s.B02 - (size_t)nt0 * KS) : pB0; const char* qB1 = TWOSEG ? uptr(s.B12 - (size_t)nt0 * KS) : pB1;
#define G8_TA(t) ((TWOSEG ? ((t) < nt0 ? pA : qA) : pA) + (size_t)(t) * KS)
#define G8_TB0(t) ((TWOSEG ? ((t) < nt0 ? pB0 : qB0) : pB0) + (size_t)(t) * KS)
#define G8_TB1(t) ((TWOSEG ? ((t) < nt0 ? pB1 : qB1) : pB1) + (size_t)(t) * KS)
#define G8_VA1 voffA[GATHER ? 1 : 0]
#define G8_H1(ptr) ((ptr) + (GATHER ? 0u : hstepA))
    G8_STAGE(G8_SB(0, 0), pB0, voffB); G8_STAGE(G8_SA(0, 0), pA, voffA[0]); G8_STAGE(G8_SB(0, 1), pB1, voffB); G8_STAGE(G8_SA(0, 1), G8_H1(pA), G8_VA1);
    if (wr == 1) G8_BAR;
    G8_WAIT_V(4); G8_BAR;
    G8_STAGE(G8_SB(1, 0), pB0 + KS, voffB); G8_STAGE(G8_SA(1, 0), pA + KS, voffA[0]); G8_STAGE(G8_SB(1, 1), pB1 + KS, voffB);
    G8_WAIT_V(6); G8_BAR;
    for (int t = 0; t < nt - 2; t += 2) {
        const char* a1 = G8_TA(t + 1);
        const char* a2 = G8_TA(t + 2); const char* b02 = G8_TB0(t + 2); const char* b12 = G8_TB1(t + 2);
        const char* a3 = G8_TA(t + 3); const char* b03 = G8_TB0(t + 3); const char* b13 = G8_TB1(t + 3);
        G8_LDB(B0, 0, 0); G8_SCHED; G8_LDA(At, 0, 0); G8_STAGE(G8_SA(1, 1), G8_H1(a1), G8_VA1);
        G8_WAIT_L(8); G8_BAR; G8_WAIT_L(0); G8_MMA(0, 0, At, B0); G8_BAR; G8_SCHED;
        G8_LDB(B1, 0, 1); G8_STAGE(G8_SB(0, 0), b02, voffB);
        G8_BAR; G8_WAIT_L(0); G8_MMA(0, 1, At, B1); G8_BAR;
        G8_LDA(At, 0, 1); G8_STAGE(G8_SA(0, 0), a2, voffA[0]);
        G8_BAR; G8_WAIT_L(0); G8_MMA(1, 0, At, B0); G8_BAR; G8_SCHED;
        G8_STAGE(G8_SB(0, 1), b12, voffB);
        G8_WAIT_V(6); G8_BAR; G8_MMA(1, 1, At, B1); G8_BAR;
        G8_LDB(B0, 1, 0); G8_SCHED; G8_LDA(At, 1, 0); G8_STAGE(G8_SA(0, 1), G8_H1(a2), G8_VA1);
        G8_WAIT_L(8); G8_BAR; G8_WAIT_L(0); G8_MMA(0, 0, At, B0); G8_BAR; G8_SCHED;
        G8_LDB(B1, 1, 1); G8_STAGE(G8_SB(1, 0), b03, voffB);
        G8_BAR; G8_WAIT_L(0); G8_MMA(0, 1, At, B1); G8_BAR;
        G8_LDA(At, 1, 1); G8_STAGE(G8_SA(1, 0), a3, voffA[0]);
        G8_BAR; G8_WAIT_L(0); G8_MMA(1, 0, At, B0); G8_BAR; G8_SCHED;
        G8_STAGE(G8_SB(1, 1), b13, voffB);
        G8_WAIT_V(6); G8_BAR; G8_MMA(1, 1, At, B1); G8_BAR;
    }
    { const char* a1 = G8_TA(nt - 1);
      G8_LDB(B0, 0, 0); G8_LDA(At, 0, 0); G8_STAGE(G8_SA(1, 1), G8_H1(a1), G8_VA1);
      G8_BAR; G8_WAIT_L(0); G8_MMA(0, 0, At, B0); G8_BAR;
      G8_LDB(B1, 0, 1); G8_BAR; G8_WAIT_L(0); G8_MMA(0, 1, At, B1); G8_BAR;
      G8_LDA(At, 0, 1); G8_WAIT_V(4); G8_BAR; G8_WAIT_L(0); G8_MMA(1, 0, At, B0); G8_MMA(1, 1, At, B1); G8_BAR; }
    { G8_LDB(B0, 1, 0); G8_LDA(At, 1, 0); G8_WAIT_V(2); G8_BAR; G8_WAIT_L(0); G8_MMA(0, 0, At, B0); G8_BAR;
      G8_LDB(B1, 1, 1); G8_WAIT_V(0); G8_BAR; G8_WAIT_L(0); G8_MMA(0, 1, At, B1); G8_BAR;
      G8_LDA(At, 1, 1); G8_BAR; G8_WAIT_L(0); G8_MMA(1, 0, At, B0); G8_MMA(1, 1, At, B1); G8_BAR; }
    if (wr == 0) G8_BAR;
#undef G8_TA
#undef G8_VA1
#undef G8_H1
#undef G8_TB0
#undef G8_TB1
#undef G8_SA
#undef G8_SB
#undef G8_STAGE
#undef G8_LDA
#undef G8_LDB
#undef G8_MMA
#undef G8_WAIT_V
#undef G8_WAIT_L
#undef G8_BAR
#undef G8_SCHED
}
template <bool GATHER, bool TWOSEG>
__device__ __forceinline__ void kstream(LAS unsigned char* lds, Acc& acc, const KSeg s, const KSeg nx, const bool first, const unsigned (&voffA)[2][2], const unsigned (&voffB)[2], const unsigned hstepA) {
    int tid = threadIdx.x; asm volatile("" : "+v"(tid));
    const int wid = __builtin_amdgcn_readfirstlane(tid >> 6), lane = tid & 63, wr = wid >> 2, wc = wid & 3, fr = lane & 15, fq = lane >> 4;
    const unsigned ldsw = (unsigned)wid * 1024u;
    const int aoff = lds_byte(wr * 64 + fr, fq * 8), boff = lds_byte(wc * 32 + fr, fq * 8);
    const int nt = __builtin_amdgcn_readfirstlane(s.nt);
#define G8_SA(b, h) (((b) * 2 + (h)) * HTB)
#define G8_SB(b, h) ((4 + (b) * 2 + (h)) * HTB)
#define G8_STAGE(bufoff, gbase, voff) do { _Pragma("unroll") for (int _i = 0; _i < 2; ++_i) \
        __builtin_amdgcn_global_load_lds((const unsigned*)((const char*)(gbase) + (voff)[_i]), (LAS unsigned*)(lds + (bufoff) + ldsw + _i * 8192), 16, 0, 0); } while (0)
#define G8_LDA(dst, b, h) do { _Pragma("unroll") for (int m = 0; m < 4; ++m) _Pragma("unroll") for (int k = 0; k < 2; ++k) dst[m][k] = *(const LAS bf16x8*)(lds + G8_SA(b, h) + aoff + m * 2048 + k * 1024); } while (0)
#define G8_LDB(dst, b, h) do { _Pragma("unroll") for (int n = 0; n < 2; ++n) _Pragma("unroll") for (int k = 0; k < 2; ++k) dst[n][k] = *(const LAS bf16x8*)(lds + G8_SB(b, h) + boff + n * 2048 + k * 1024); } while (0)
#define G8_MMA(ai, bj, At, Bt) do { __builtin_amdgcn_s_setprio(1); _Pragma("unroll") for (int m = 0; m < 4; ++m) _Pragma("unroll") for (int n = 0; n < 2; ++n) _Pragma("unroll") for (int k = 0; k < 2; ++k) \
        acc[ai][bj][m][n] = __builtin_amdgcn_mfma_f32_16x16x32_bf16(Bt[n][k], At[m][k], acc[ai][bj][m][n], 0, 0, 0); __builtin_amdgcn_s_setprio(0); } while (0)
#define G8_WAIT_V(n) asm volatile("s_waitcnt vmcnt(" #n ")" ::: "memory")
#define G8_WAIT_L(n) asm volatile("s_waitcnt lgkmcnt(" #n ")" ::: "memory")
#define G8_BAR __builtin_amdgcn_s_barrier()
#define G8_SCHED __builtin_amdgcn_sched_barrier(0)
    bf16x8 At[4][2], B0[2][2], B1[2][2];
    const char* pA = uptr(s.A); const char* pB0 = uptr(s.B0); const char* pB1 = uptr(s.B1);
    constexpr int KS = BK * 2;
    const int nt0 = TWOSEG ? s.nt0 : 0; const char* qA = TWOSEG ? uptr(s.A2 - (size_t)nt0 * KS) : pA; const char* qB0 = TWOSEG ? uptr(s.B02 - (size_t)nt0 * KS) : pB0; const char* qB1 = TWOSEG ? uptr(s.B12 - (size_t)nt0 * KS) : pB1;
    const char* nA = uptr(nx.A) - (size_t)nt * KS; const char* nB0 = uptr(nx.B0) - (size_t)nt * KS; const char* nB1 = uptr(nx.B1) - (size_t)nt * KS;
#define G8_TA(t) (((t) >= nt ? nA : (TWOSEG ? ((t) < nt0 ? pA : qA) : pA)) + (size_t)(t) * KS)
#define G8_TB0(t) (((t) >= nt ? nB0 : (TWOSEG ? ((t) < nt0 ? pB0 : qB0) : pB0)) + (size_t)(t) * KS)
#define G8_TB1(t) (((t) >= nt ? nB1 : (TWOSEG ? ((t) < nt0 ? pB1 : qB1) : pB1)) + (size_t)(t) * KS)
#define G8_VA1 voffA[GATHER ? 1 : 0]
#define G8_H1(ptr) ((ptr) + (GATHER ? 0u : hstepA))
    if (first) {
    G8_STAGE(G8_SB(0, 0), pB0, voffB); G8_STAGE(G8_SA(0, 0), pA, voffA[0]); G8_STAGE(G8_SB(0, 1), pB1, voffB); G8_STAGE(G8_SA(0, 1), G8_H1(pA), G8_VA1);
    if (wr == 1) G8_BAR;
    G8_WAIT_V(4); G8_BAR;
    G8_STAGE(G8_SB(1, 0), pB0 + KS, voffB); G8_STAGE(G8_SA(1, 0), pA + KS, voffA[0]); G8_STAGE(G8_SB(1, 1), pB1 + KS, voffB);
    G8_WAIT_V(6); G8_BAR;
    }
    for (int t = 0; t < nt; t += 2) {
        const char* a1 = G8_TA(t + 1);
        const char* a2 = G8_TA(t + 2); const char* b02 = G8_TB0(t + 2); const char* b12 = G8_TB1(t + 2);
        const char* a3 = G8_TA(t + 3); const char* b03 = G8_TB0(t + 3); const char* b13 = G8_TB1(t + 3);
        G8_LDB(B0, 0, 0); G8_SCHED; G8_LDA(At, 0, 0); G8_STAGE(G8_SA(1, 1), G8_H1(a1), G8_VA1);
        G8_WAIT_L(8); G8_BAR; G8_WAIT_L(0); G8_MMA(0, 0, At, B0); G8_BAR; G8_SCHED;
        G8_LDB(B1, 0, 1); G8_STAGE(G8_SB(0, 0), b02, voffB);
        G8_BAR; G8_WAIT_L(0); G8_MMA(0, 1, At, B1); G8_BAR;
        G8_LDA(At, 0, 1); G8_STAGE(G8_SA(0, 0), a2, voffA[0]);
        G8_BAR; G8_WAIT_L(0); G8_MMA(1, 0, At, B0); G8_BAR; G8_SCHED;
        G8_STAGE(G8_SB(0, 1), b12, voffB);
        G8_WAIT_V(6); G8_BAR; G8_MMA(1, 1, At, B1); G8_BAR;
        G8_LDB(B0, 1, 0); G8_SCHED; G8_LDA(At, 1, 0); G8_STAGE(G8_SA(0, 1), G8_H1(a2), G8_VA1);
        G8_WAIT_L(8); G8_BAR; G8_WAIT_L(0); G8_MMA(0, 0, At, B0); G8_BAR; G8_SCHED;
        G8_LDB(B1, 1, 1); G8_STAGE(G8_SB(1, 0), b03, voffB);
        G8_BAR; G8_WAIT_L(0); G8_MMA(0, 1, At, B1); G8_BAR;
        G8_LDA(At, 1, 1); G8_STAGE(G8_SA(1, 0), a3, voffA[0]);
        G8_BAR; G8_WAIT_L(0); G8_MMA(1, 0, At, B0); G8_BAR; G8_SCHED;
        G8_STAGE(G8_SB(1, 1), b13, voffB);
        G8_WAIT_V(6); G8_BAR; G8_MMA(1, 1, At, B1); G8_BAR;
    }
#undef G8_TA
#undef G8_VA1
#undef G8_H1
#undef G8_TB0
#undef G8_TB1
#undef G8_SA
#undef G8_SB
#undef G8_STAGE
#undef G8_LDA
#undef G8_LDB
#undef G8_MMA
#undef G8_WAIT_V
#undef G8_WAIT_L
#undef G8_BAR
#undef G8_SCHED
}
__device__ __forceinline__ void kstream_end() { asm volatile("s_waitcnt vmcnt(0)" ::: "memory"); __builtin_amdgcn_s_barrier(); }
__device__ __forceinline__ void zero_acc(Acc& acc) {
#pragma unroll
    for (int a = 0; a < 2; ++a)
#pragma unroll
        for (int b = 0; b < 2; ++b)
#pragma unroll
            for (int m = 0; m < 4; ++m)
#pragma unroll
                for (int n = 0; n < 2; ++n) acc[a][b][m][n] = (f32x4){0.f, 0.f, 0.f, 0.f};
}
__device__ __forceinline__ void make_voff_contig(unsigned (&voffA)[2][2], unsigned pitchA) {
    int tid = threadIdx.x; asm volatile("" : "+v"(tid));
#pragma unroll
    for (int i = 0; i < 2; ++i) { int R, C; stage_rc(tid * 16 + i * 8192, R, C);
        voffA[0][i] = (unsigned)R * pitchA + (unsigned)C * 2u; voffA[1][i] = 0u; }
}
__device__ __forceinline__ void make_voffB(unsigned (&voffB)[2], unsigned pitchB, bool perm) {
    int tid = threadIdx.x; asm volatile("" : "+v"(tid));
#pragma unroll
    for (int i = 0; i < 2; ++i) { int R, C; stage_rc(tid * 16 + i * 8192, R, C); const int Rb = perm ? ((R & ~31) + perm32(R & 31)) : R;
        voffB[i] = (unsigned)Rb * pitchB + (unsigned)C * 2u; }
}
}

__device__ __forceinline__ bool unit_order(int i, int G, int c, int nM, int nN, int& pm, int& pn) {
    const int nwg = nM * nN; const long L = (long)i * G + c; if (L >= nwg) return false;
    int wgid = (int)L; { const int q = nwg / 8, r = nwg % 8, xcd = wgid % 8, off = wgid / 8; wgid = (xcd < r ? xcd * (q + 1) : r * (q + 1) + (xcd - r) * q) + off; }
    const int WGM = 8, nig = WGM * nN, gid = wgid / nig, fm = gid * WGM, gsz = (nM - fm) < WGM ? (nM - fm) : WGM;
    pm = fm + ((wgid % nig) % gsz); pn = (wgid % nig) / gsz; return true;
}

__device__ __forceinline__ void conv_small_weights(const Params& p, LAS unsigned char* lds) {
    const int tid = otid(), lane = tid & 63, wave = tid >> 6, gw = obid() * NWAVES + wave, NGW = gridDim.x * NWAVES;
    LAS float* scr = (LAS float*)(lds + wave * 16384);
    constexpr int I_IN = 16 * (NIN / 32), I_A = 8 * 32, I_O = 16 * 32, I_L = 64, PER = I_IN + 2 * I_A + I_O + I_L;
    for (int it = gw; it < DEPTH * PER; it += NGW) {
        const int l = it / PER; int r = it % PER;
        unsigned char* wl = p.ws + WS_WSMALL + (size_t)l * WSMALL_LAYER;
        if (r < I_IN) { const int kb = r / (NIN / 32), nb = r % (NIN / 32), n0 = nb * 32, k0 = kb * 64;
            int col0, nvalid; if (n0 < UA) { col0 = n0; nvalid = A_COLS - n0; nvalid = nvalid < 0 ? 0 : (nvalid > 32 ? 32 : nvalid); } else { col0 = n0 - (UA - A_COLS); nvalid = 32; }
            transpose_item(p.in[I_WIN] + (size_t)l * D * IN_COLS + (size_t)k0 * IN_COLS, IN_COLS, col0, nvalid, (bf16_t*)wl + (size_t)n0 * D + k0, D, scr, lane); continue; }
        r -= I_IN;
        if (r < 2 * I_A) { const int which = r / I_A; r %= I_A; const int kb = r / 32, nb = r % 32;
            const float* src = p.in[which ? I_WBB : I_WBA] + (size_t)l * 512 * D + (size_t)(kb * 64) * D;
            transpose_item(src, D, nb * 32, 32, (bf16_t*)(wl + (10 + which) * MiB) + (size_t)(nb * 32) * 512 + kb * 64, 512, scr, lane); continue; }
        r -= 2 * I_A;
        if (r < I_O) { const int kb = r / 32, nb = r % 32;
          transpose_item(p.in[I_WOUT] + (size_t)l * D * D + (size_t)(kb * 64) * D, D, nb * 32, 32, (bf16_t*)(wl + 12 * MiB) + (size_t)(nb * 32) * D + kb * 64, D, scr, lane); continue; }
        r -= I_O;
        { bf16_t* lo = (bf16_t*)(p.ws + 65536 + (size_t)l * 262144);
          if (r < 16) transpose_item(p.in[I_WUP] + (size_t)l * 64 * 512, 512, r * 32, 32, lo + (size_t)(r * 32) * 64, 64, scr, lane);
          else if (r < 32) transpose_item(p.in[I_AUP] + (size_t)l * 64 * 512, 512, (r - 16) * 32, 32, lo + 32768 + (size_t)((r - 16) * 32) * 64, 64, scr, lane);
          else { const int q = r - 32, kb = q >> 4, nb = q & 15; transpose_item(p.in[I_GUP] + (size_t)l * 128 * 512 + (size_t)(kb * 64) * 512, 512, nb * 32, 32, lo + 65536 + (size_t)(nb * 32) * 128 + kb * 64, 128, scr, lane); } }
    }
}
__device__ __forceinline__ void conv_expert_weights(const Params& p, int l, LAS unsigned char* lds) {
    const int tid = otid(), lane = tid & 63, wave = tid >> 6, gw = obid() * NWAVES + wave, NGW = gridDim.x * NWAVES;
    LAS float* scr = (LAS float*)(lds + wave * 16384);
    constexpr int I_13 = 16 * 32, I_2 = 8 * 32, PER = I_13 + I_2;
    for (int it = gw; it < 16 * PER; it += NGW) {
        const int e = it / PER; int r = it % PER;
        if (r < I_13) { const int kb = r / 32, nb = r % 32, n0 = nb * 32, j = n0 >> 8, half = (n0 >> 7) & 1, c = 128 * j + (n0 & 127);
            const float* src = p.in[half ? I_WEXP3 : I_WEXP1] + (size_t)(l * 16 + e) * D * 512 + (size_t)(kb * 64) * 512;
            transpose_item(src, 512, c, 32, (bf16_t*)(p.ws + WS_WEXP) + (size_t)e * 1024 * 1024 + (size_t)n0 * 1024 + kb * 64, 1024, scr, lane); continue; }
        r -= I_13;
        { const int kb = r / 32, nb = r % 32;
          const float* src = p.in[I_WEXP2] + (size_t)(l * 16 + e) * 512 * D + (size_t)(kb * 64) * D;
          transpose_item(src, D, nb * 32, 32, (bf16_t*)(p.ws + WS_WEXP + 32 * MiB) + (size_t)e * 1024 * 512 + (size_t)(nb * 32) * 512 + kb * 64, 512, scr, lane); }
    }
}

__device__ __forceinline__ void ln_wave(f32x4 (&v)[4], const float* g, const float* bta, int lane) {
    float s = 0.f;
#pragma unroll
    for (int j = 0; j < 4; ++j) s += (v[j][0] + v[j][1]) + (v[j][2] + v[j][3]);
    const float mean = wave_sum(s) * (1.f / D); float s2 = 0.f;
#pragma unroll
    for (int j = 0; j < 4; ++j) { v[j] = v[j] - mean; s2 += (v[j][0] * v[j][0] + v[j][1] * v[j][1]) + (v[j][2] * v[j][2] + v[j][3] * v[j][3]); }
    const float rstd = 1.f / sqrtf(wave_sum(s2) * (1.f / D) + LN_EPS);
#pragma unroll
    for (int j = 0; j < 4; ++j) { const f32x4 gg = *(const f32x4*)(g + 4 * lane + 256 * j), bb = *(const f32x4*)(bta + 4 * lane + 256 * j); v[j] = v[j] * rstd * gg + bb; }
}
__device__ __forceinline__ void store_row(const Params& p, int r, const f32x4 (&v)[4], int lane, bool zero) {
    float* hr = hrow(p, r); bf16_t* hb = (bf16_t*)(p.ws + WS_HB) + (size_t)r * D;
#pragma unroll
    for (int j = 0; j < 4; ++j) { const f32x4 o = zero ? (f32x4){0.f, 0.f, 0.f, 0.f} : v[j];
        *(f32x4*)(hr + 4 * lane + 256 * j) = o; u32x2 w; w.x = pk2(o[0], o[1]); w.y = pk2(o[2], o[3]); *(u32x2*)(hb + 4 * lane + 256 * j) = w; }
}
__device__ __forceinline__ void ln_in_phase(const Params& p) {
    const int tid = otid(), lane = tid & 63, gw = obid() * NWAVES + (tid >> 6), NGW = gridDim.x * NWAVES;
    for (int r = gw; r < T; r += NGW) {
        const int b = r / LP, pos = r - b * LP; f32x4 v[4];
        if (pos < PADM) {
#pragma unroll
            for (int j = 0; j < 4; ++j) v[j] = (f32x4){0.f, 0.f, 0.f, 0.f};
            store_row(p, r, v, lane, true); continue; }
        const float* src = pos < 64 ? p.in[I_META] + (size_t)(pos - PADM) * D : p.in[I_X] + ((size_t)(b * SEQ + pos - 64) << 10);
#pragma unroll
        for (int j = 0; j < 4; ++j) v[j] = *(const f32x4*)(src + 4 * lane + 256 * j);
        ln_wave(v, p.in[I_LNIN_G], p.in[I_LNIN_B], lane);
        store_row(p, r, v, lane, false);
    }
}

__device__ __forceinline__ const Params& PP() { const Params* q = (const Params*)__builtin_amdgcn_kernarg_segment_ptr(); asm volatile("" : "+s"(q)); return *q; }

#define EPI_COORDS() int tid_ = threadIdx.x; asm volatile("" : "+v"(tid_)); const int wid = tid_ >> 6, lane = tid_ & 63, wr = wid >> 2, wc = wid & 3, fr = lane & 15, fq = lane >> 4; (void)wr; (void)wc; (void)fr; (void)fq
__device__ __forceinline__ void inproj_phase(const Params& p, int l, LAS unsigned char* lds) {
    unsigned voffA[2][2], voffB[2]; g8::make_voff_contig(voffA, D * 2); g8::make_voffB(voffB, D * 2, true);
    int pm, pn, pm2 = 0, pn2 = 0; const int bid = obid(); const int wr_ = __builtin_amdgcn_readfirstlane(otid() >> 6) >> 2;
    bool has = unit_order(0, gridDim.x, bid, T / 256, NIN / 256, pm, pn), first = true;
    g8::Acc acc; g8::zero_acc(acc);
    for (int i = 0; has; ++i) {
        const bool hasn = unit_order(i + 1, gridDim.x, bid, T / 256, NIN / 256, pm2, pn2);
        const char* Ab = (const char*)(PP().ws + WS_HB); const char* Bb = (const char*)(PP().ws + WS_WSMALL + (size_t)l * WSMALL_LAYER);
        const g8::KSeg s = g8::seg1(Ab + (size_t)pm * 256 * D * 2, Bb + (size_t)pn * 256 * D * 2, Bb + (size_t)(pn * 256 + 128) * D * 2, D / 64);
        const int pmn = hasn ? pm2 : pm, pnn = hasn ? pn2 : pn;
        const g8::KSeg nx = g8::seg1(Ab + (size_t)pmn * 256 * D * 2, Bb + (size_t)pnn * 256 * D * 2, Bb + (size_t)(pnn * 256 + 128) * D * 2, D / 64);
        if (!first && wr_ == 1) __builtin_amdgcn_s_barrier();
        g8::kstream<false, false>(lds, acc, s, nx, first, voffA, voffB, 128 * D * 2); first = false;
        if (wr_ == 0) __builtin_amdgcn_s_barrier();
        EPI_COORDS();
        const int row0 = pm * 256 + wr * 64 + fr;
        if (pn < 12) {
            bf16_t* O = (bf16_t*)(PP().ws + WS_UAR);
#pragma unroll
            for (int ai = 0; ai < 2; ++ai)
#pragma unroll
                for (int m = 0; m < 4; ++m) { asm volatile("" ::: "memory"); bf16_t* rp = O + (size_t)(row0 + ai * 128 + m * 16) * UARW + pn * 256 + wc * 32 + 8 * fq;
#pragma unroll
                    for (int bj = 0; bj < 2; ++bj) { const f32x4 v0 = acc[ai][bj][m][0], v1 = acc[ai][bj][m][1]; u32x4 w; w.x = pk2(v0[0], v0[1]); w.y = pk2(v0[2], v0[3]); w.z = pk2(v1[0], v1[1]); w.w = pk2(v1[2], v1[3]);
                        *(u32x4*)(rp + bj * 128) = w; } }
        } else {
            bf16_t* O = (bf16_t*)(PP().ws + WS_GATES); const int colb = (pn - 12) * 256 + wc * 32 + 8 * fq; const float* bg = PP().in[I_BGATE] + l * 2048;
            f32x4 bv[2][2];
#pragma unroll
            for (int bj = 0; bj < 2; ++bj) { bv[bj][0] = *(const f32x4*)(bg + colb + bj * 128); bv[bj][1] = *(const f32x4*)(bg + colb + bj * 128 + 4); }
#pragma unroll
            for (int ai = 0; ai < 2; ++ai)
#pragma unroll
                for (int m = 0; m < 4; ++m) { asm volatile("" ::: "memory"); bf16_t* rp = O + (size_t)(row0 + ai * 128 + m * 16) * 2048 + colb;
#pragma unroll
                    for (int bj = 0; bj < 2; ++bj) { f32x4 v0 = acc[ai][bj][m][0] + bv[bj][0], v1 = acc[ai][bj][m][1] + bv[bj][1];
#pragma unroll
                        for (int e = 0; e < 4; ++e) { v0[e] = sigmoidf_(v0[e]); v1[e] = sigmoidf_(v1[e]); }
                        u32x4 w; w.x = pk2(v0[0], v0[1]); w.y = pk2(v0[2], v0[3]); w.z = pk2(v1[0], v1[1]); w.w = pk2(v1[2], v1[3]);
                        *(u32x4*)(rp + bj * 128) = w; } }
        }
        g8::zero_acc(acc); has = hasn; pm = pm2; pn = pn2;
    }
    if (!first) g8::kstream_end();
}
__device__ __forceinline__ void merge_phase(const Params& p, int l, LAS unsigned char* lds) {
    unsigned voffA[2][2], voffB[2]; g8::make_voff_contig(voffA, D * 2); g8::make_voffB(voffB, 512 * 2, true);
    int pm, pn; const int bid = obid();
    for (int i = 0; unit_order(i, gridDim.x, bid, T / 256, 4, pm, pn); ++i) {
#pragma unroll 1
        for (int br = 0; br < 2; ++br) {
            g8::Acc acc; g8::zero_acc(acc);
            const char* Bt = (const char*)(PP().ws + WS_WSMALL + (size_t)l * WSMALL_LAYER) + (10 + br) * MiB + (size_t)pn * 256 * 512 * 2;
            const g8::KSeg s = g8::seg1((const char*)(PP().ws + WS_OAB) + (size_t)pm * 256 * D * 2 + br * 1024, Bt, Bt + (size_t)128 * 512 * 2, 8);
            g8::kloop<false, false>(lds, acc, s, voffA, voffB, 128 * D * 2);
            EPI_COORDS();
            const bf16_t* GT = (const bf16_t*)(PP().ws + WS_GATES); bf16_t* O = (bf16_t*)(PP().ws + WS_MERGED);
            const int row0 = pm * 256 + wr * 64 + fr, colb = pn * 256 + wc * 32 + 8 * fq;
#pragma unroll
            for (int ai = 0; ai < 2; ++ai) { asm volatile("" ::: "memory");
                u32x4 gq[4][2], pq[4][2];
#pragma unroll
                for (int m = 0; m < 4; ++m) { const size_t ro = (size_t)(row0 + ai * 128 + m * 16); const bf16_t* gp = GT + ro * 2048 + br * 1024 + colb; const bf16_t* op = O + ro * D + colb;
#pragma unroll
                    for (int bj = 0; bj < 2; ++bj) { gq[m][bj] = *(const u32x4*)(gp + bj * 128); pq[m][bj] = br ? *(const u32x4*)(op + bj * 128) : (u32x4){0u, 0u, 0u, 0u}; } }
#pragma unroll
                for (int m = 0; m < 4; ++m) { const size_t ro = (size_t)(row0 + ai * 128 + m * 16); bf16_t* op = O + ro * D + colb;
#pragma unroll
                    for (int bj = 0; bj < 2; ++bj) { const u32x4 g = gq[m][bj], pr = pq[m][bj]; const f32x4 v0 = acc[ai][bj][m][0], v1 = acc[ai][bj][m][1];
                        u32x4 w; w.x = pk2(v0[0] * bflo(g.x) + bflo(pr.x), v0[1] * bfhi(g.x) + bfhi(pr.x)); w.y = pk2(v0[2] * bflo(g.y) + bflo(pr.y), v0[3] * bfhi(g.y) + bfhi(pr.y));
                        w.z = pk2(v1[0] * bflo(g.z) + bflo(pr.z), v1[1] * bfhi(g.z) + bfhi(pr.z)); w.w = pk2(v1[2] * bflo(g.w) + bflo(pr.w), v1[3] * bfhi(g.w) + bfhi(pr.w));
                        *(u32x4*)(op + bj * 128) = w; } } }
        }
    }
}
__device__ __forceinline__ void wout_phase(const Params& p, int l, LAS unsigned char* lds) {
    unsigned voffA[2][2], voffB[2]; g8::make_voff_contig(voffA, D * 2); g8::make_voffB(voffB, D * 2, false);
    int pm, pn, pm2 = 0, pn2 = 0; const int bid = obid(); const int wr_ = __builtin_amdgcn_readfirstlane(otid() >> 6) >> 2;
    bool has = unit_order(0, gridDim.x, bid, T / 256, 4, pm, pn), first = true;
    g8::Acc acc; g8::zero_acc(acc);
    for (int i = 0; has; ++i) {
        const bool hasn = unit_order(i + 1, gridDim.x, bid, T / 256, 4, pm2, pn2);
        const char* Ab = (const char*)(PP().ws + WS_MERGED); const char* Bb = (const char*)(PP().ws + WS_WSMALL + (size_t)l * WSMALL_LAYER + 12 * MiB);
        const g8::KSeg s = g8::seg1(Ab + (size_t)pm * 256 * D * 2, Bb + (size_t)pn * 256 * D * 2, Bb + (size_t)(pn * 256 + 128) * D * 2, D / 64);
        const int pmn = hasn ? pm2 : pm, pnn = hasn ? pn2 : pn;
        const g8::KSeg nx = g8::seg1(Ab + (size_t)pmn * 256 * D * 2, Bb + (size_t)pnn * 256 * D * 2, Bb + (size_t)(pnn * 256 + 128) * D * 2, D / 64);
        if (!first && wr_ == 1) __builtin_amdgcn_s_barrier();
        g8::kstream<false, false>(lds, acc, s, nx, first, voffA, voffB, 128 * D * 2); first = false;
        if (wr_ == 0) __builtin_amdgcn_s_barrier();
        EPI_COORDS();
        const int row0 = pm * 256 + wr * 64 + fr, col0 = pn * 256 + wc * 32 + 4 * fq;
#pragma unroll
        for (int ai = 0; ai < 2; ++ai) { asm volatile("" ::: "memory");
            f32x4 pre[4][2][2]; float* hr[4];
#pragma unroll
            for (int m = 0; m < 4; ++m) { hr[m] = hrow(PP(), row0 + ai * 128 + m * 16) + col0;
#pragma unroll
                for (int bj = 0; bj < 2; ++bj)
#pragma unroll
                    for (int n = 0; n < 2; ++n) pre[m][bj][n] = *(const f32x4*)(hr[m] + bj * 128 + n * 16); }
#pragma unroll
            for (int m = 0; m < 4; ++m)
#pragma unroll
                for (int bj = 0; bj < 2; ++bj)
#pragma unroll
                    for (int n = 0; n < 2; ++n) *(f32x4*)(hr[m] + bj * 128 + n * 16) = pre[m][bj][n] * ALPHA + acc[ai][bj][m][n]; }
        g8::zero_acc(acc); has = hasn; pm = pm2; pn = pn2;
    }
    if (!first) g8::kstream_end();
}

constexpr int ATTN_WAVE_LDS = 16640 + 1024 + 2048 + 64 + 512;
__device__ __forceinline__ unsigned score_key(float s) { s += 0.0f; const unsigned u = __builtin_bit_cast(unsigned, s); return (u & 0x80000000u) ? ~u : (u | 0x80000000u); }
__device__ void attn_naive_query(const Params& p, int row, unsigned char* wl, int lane) {
    const bf16_t* U = (const bf16_t*)(p.ws + WS_UAR);
    bf16_t* OA = (bf16_t*)(p.ws + WS_OAB) + (size_t)row * D;
    const int b = row / LP, pos = row - b * LP;
    if (pos < PADM) {
#pragma unroll
        for (int j = 0; j < 8; ++j) OA[j * 64 + lane] = 0;
        return;
    }
    const int nadm = 64 * ((pos >> 6) + 1) - PADM;
    unsigned* keys = (unsigned*)wl; float* p_s = (float*)wl;
    float* qi_s = (float*)(wl + 16640); float* q_s = qi_s + 256; float* w_s = q_s + 512; unsigned short* sel_s = (unsigned short*)(w_s + 16);
    const bf16_t* urow = U + (size_t)row * UARW;
    for (int i = lane; i < 256; i += 64) qi_s[i] = bf2f(urow[C_QI + i]);
    for (int i = lane; i < 512; i += 64) q_s[i] = bf2f(urow[C_Q + i]);
    if (lane < 8) w_s[lane] = bf2f(urow[C_WI + lane]);
    __builtin_amdgcn_fence(__ATOMIC_RELEASE, "wavefront"); __builtin_amdgcn_wave_barrier(); __builtin_amdgcn_fence(__ATOMIC_ACQUIRE, "wavefront");
    const int nj = (nadm + 63) >> 6;
    for (int j = 0; j < nj; ++j) {
        const int ki_idx = lane + 64 * j; unsigned key = 0u;
        if (ki_idx < nadm) {
            const u32x4* kp = (const u32x4*)(U + (size_t)(b * LP + PADM + ki_idx) * UARW + C_KI);
            float kf[32];
#pragma unroll
            for (int c4 = 0; c4 < 4; ++c4) { const u32x4 w = kp[c4];
                kf[c4 * 8 + 0] = bflo(w.x); kf[c4 * 8 + 1] = bfhi(w.x); kf[c4 * 8 + 2] = bflo(w.y); kf[c4 * 8 + 3] = bfhi(w.y);
                kf[c4 * 8 + 4] = bflo(w.z); kf[c4 * 8 + 5] = bfhi(w.z); kf[c4 * 8 + 6] = bflo(w.w); kf[c4 * 8 + 7] = bfhi(w.w); }
            float sc = 0.f;
#pragma unroll 1
            for (int h = 0; h < 8; ++h) { float d = 0.f; asm volatile("" ::: "memory");
#pragma unroll
                for (int e = 0; e < 32; ++e) d = fmaf(qi_s[h * 32 + e], kf[e], d);
                sc = fmaf(w_s[h], fmaxf(d, 0.f), sc); }
            key = score_key(sc); if (key == 0u) key = 1u;
        }
        keys[ki_idx] = key;
    }
    __builtin_amdgcn_fence(__ATOMIC_RELEASE, "wavefront"); __builtin_amdgcn_wave_barrier(); __builtin_amdgcn_fence(__ATOMIC_ACQUIRE, "wavefront");
    unsigned thr = 0u; int need_ties = 0x7fffffff;
    if (nadm > 256) {
        unsigned prefix = 0u; int remaining = 256;
        for (int bit = 31; bit >= 0; --bit) {
            const unsigned cand = prefix | (1u << bit); int cnt = 0;
            for (int j = 0; j < nj; ++j) { const unsigned k = keys[lane + 64 * j]; cnt += __builtin_popcountll(__ballot((k >> bit) == (cand >> bit))); }
            if (cnt >= remaining) prefix = cand; else remaining -= cnt;
        }
        thr = prefix; need_ties = remaining;
    } else thr = 1u;
    int nsel = 0, ties_seen = 0;
    for (int j = 0; j < nj; ++j) {
        const unsigned k = keys[lane + 64 * j];
        const unsigned long long tm = __ballot(k == thr && k != 0u);
        const unsigned long long lt = (1ull << lane) - 1ull;
        const int myrank = ties_seen + __builtin_popcountll(tm & lt);
        const bool selme = (k > thr) || (k == thr && k != 0u && myrank < need_ties);
        const unsigned long long sm = __ballot(selme);
        if (selme) sel_s[nsel + __builtin_popcountll(sm & lt)] = (unsigned short)(PADM + lane + 64 * j);
        nsel += __builtin_popcountll(sm); ties_seen += __builtin_popcountll(tm);
    }
    __builtin_amdgcn_fence(__ATOMIC_RELEASE, "wavefront"); __builtin_amdgcn_wave_barrier(); __builtin_amdgcn_fence(__ATOMIC_ACQUIRE, "wavefront");
    float sc[4][8];
#pragma unroll
    for (int m = 0; m < 4; ++m) {
        asm volatile("" ::: "memory");
        const int i = lane + 64 * m; const bool valid = i < nsel; const int ps = valid ? sel_s[i] : PADM;
        const bf16_t* krow = U + (size_t)(b * LP + ps) * UARW + C_K;
#pragma unroll
        for (int n = 0; n < 2; ++n) {
            float a0 = 0.f, a1 = 0.f, a2 = 0.f, a3 = 0.f;
#pragma unroll 1
            for (int c8 = 0; c8 < 8; ++c8) { asm volatile("" ::: "memory"); const u32x4 w = *(const u32x4*)(krow + n * 64 + c8 * 8);
                float kf[8] = {bflo(w.x), bfhi(w.x), bflo(w.y), bfhi(w.y), bflo(w.z), bfhi(w.z), bflo(w.w), bfhi(w.w)};
#pragma unroll
                for (int e = 0; e < 8; ++e) { const int dd = c8 * 8 + e;
                    a0 = fmaf(q_s[(n * 4 + 0) * 64 + dd], kf[e], a0); a1 = fmaf(q_s[(n * 4 + 1) * 64 + dd], kf[e], a1);
                    a2 = fmaf(q_s[(n * 4 + 2) * 64 + dd], kf[e], a2); a3 = fmaf(q_s[(n * 4 + 3) * 64 + dd], kf[e], a3); } }
            sc[m][n * 4 + 0] = valid ? a0 * 0.125f : -INFINITY; sc[m][n * 4 + 1] = valid ? a1 * 0.125f : -INFINITY;
            sc[m][n * 4 + 2] = valid ? a2 * 0.125f : -INFINITY; sc[m][n * 4 + 3] = valid ? a3 * 0.125f : -INFINITY;
        }
    }
    __builtin_amdgcn_wave_barrier();
    float linv[8];
#pragma unroll
    for (int h = 0; h < 8; ++h) {
        const float mx = wave_max(fmaxf(fmaxf(sc[0][h], sc[1][h]), fmaxf(sc[2][h], sc[3][h]))); float s = 0.f;
#pragma unroll
        for (int m = 0; m < 4; ++m) { const float e = __expf(sc[m][h] - mx); sc[m][h] = e; s += e; }
        linv[h] = 1.0f / wave_sum(s);
    }
#pragma unroll
    for (int m = 0; m < 4; ++m) { const int i = lane + 64 * m;
#pragma unroll
        for (int h = 0; h < 8; ++h) p_s[i * 8 + h] = sc[m][h]; }
    __builtin_amdgcn_fence(__ATOMIC_RELEASE, "wavefront"); __builtin_amdgcn_wave_barrier(); __builtin_amdgcn_fence(__ATOMIC_ACQUIRE, "wavefront");
    float o[8] = {0.f, 0.f, 0.f, 0.f, 0.f, 0.f, 0.f, 0.f};
    for (int i = 0; i < nsel; ++i) {
        const int ps = sel_s[i]; const bf16_t* vrow = U + (size_t)(b * LP + ps) * UARW + C_V;
        const float v0 = bf2f(vrow[lane]), v1 = bf2f(vrow[64 + lane]);
        const f32x4 pa = *(const f32x4*)(p_s + i * 8), pb = *(const f32x4*)(p_s + i * 8 + 4);
        o[0] = fmaf(pa[0], v0, o[0]); o[1] = fmaf(pa[1], v0, o[1]); o[2] = fmaf(pa[2], v0, o[2]); o[3] = fmaf(pa[3], v0, o[3]);
        o[4] = fmaf(pb[0], v1, o[4]); o[5] = fmaf(pb[1], v1, o[5]); o[6] = fmaf(pb[2], v1, o[6]); o[7] = fmaf(pb[3], v1, o[7]);
    }
#pragma unroll
    for (int h = 0; h < 8; ++h) OA[h * 64 + lane] = (bf16_t)f2bf(o[h] * linv[h]);
    __builtin_amdgcn_wave_barrier();
}


#define LDS_BARRIER() do { asm volatile("s_waitcnt lgkmcnt(0)" ::: "memory"); __builtin_amdgcn_s_barrier(); asm volatile("" ::: "memory"); } while (0)

typedef float f32x16 __attribute__((ext_vector_type(16)));
typedef short s16x4 __attribute__((ext_vector_type(4)));
constexpr int AT_HIST = 0;
constexpr int AT_MASK = 32768;
constexpr int AT_QST = AT_MASK + 16640;
constexpr int AT_KV = 53248;
constexpr int AT_UNIT = AT_KV + 32768;
constexpr int CW_R1Q = 48;
constexpr int CW_ATT = 32;
__device__ __forceinline__ int img_off(int row, int ch) { return 2048 * (row >> 3) + 512 * (ch >> 2) + 64 * (row & 7) + 16 * ((ch & 3) ^ ((row >> 2) & 3)); }
__device__ __forceinline__ unsigned comp_key(float sc, int pos) { return (score_key(sc) & 0xFFFFE000u) | (unsigned)(0x1FFF - pos); }

__device__ __forceinline__ void attn_unit(const Params& p, unsigned char* lds, int b, int qt) {
    const int tid = otid(), wave = tid >> 6, lane = tid & 63, r = lane & 31, hh = lane >> 5;
    const bf16_t* U = (const bf16_t*)(p.ws + WS_UAR);
    LAS unsigned char* L = (LAS unsigned char*)lds;
    LAS unsigned* hist = (LAS unsigned*)(L + AT_HIST); LAS unsigned* maskw = (LAS unsigned*)(L + AT_MASK);
    LAS unsigned* qpre = (LAS unsigned*)(L + AT_QST); LAS unsigned* qrem = qpre + 32; LAS unsigned* segs = qpre + 64;
    const int c = qt >> 1, nkt = 2 * c + 1, nadm = 64 * (c + 1) - PADM;
    const size_t qrow = (size_t)(b * LP + 32 * qt + r);
    if (nadm > 256) {
        bf16x8 qf[8][2]; float wq[8];
#pragma unroll
        for (int h = 0; h < 8; ++h)
#pragma unroll
            for (int kk = 0; kk < 2; ++kk) qf[h][kk] = *(const bf16x8*)(U + qrow * UARW + C_QI + h * 32 + 16 * kk + 8 * hh);
        { const u32x4 w = *(const u32x4*)(U + qrow * UARW + C_WI);
          wq[0] = bflo(w.x); wq[1] = bfhi(w.x); wq[2] = bflo(w.y); wq[3] = bfhi(w.y); wq[4] = bflo(w.z); wq[5] = bfhi(w.z); wq[6] = bflo(w.w); wq[7] = bfhi(w.w); }
#pragma unroll
        for (int h = 0; h < 8; ++h) asm volatile("" : "+v"(qf[h][0]), "+v"(qf[h][1]), "+v"(wq[h]));
        if (tid < 32) { qpre[tid] = 0u; qrem[tid] = 256u; }
        const bf16_t* kbase = U + (size_t)(b * LP + r) * UARW + C_KI + 8 * hh;
#pragma unroll 1
        for (int pass = 0; pass < 5; ++pass) {
            if (pass < 4) { for (int i = tid; i < 256 * 32 / 4; i += NTHREADS) ((LAS u32x4*)hist)[i] = (u32x4){0u, 0u, 0u, 0u}; }
            LDS_BARRIER();
            const unsigned pre = qpre[r]; const int shift = pass < 4 ? 24 - 8 * pass : 0;
            int kt = 1 + wave;
            bf16x8 a0, a1, n0, n1;
            { const bf16_t* kp = kbase + (size_t)(32 * (kt <= nkt ? kt : 1)) * UARW; a0 = *(const bf16x8*)kp; a1 = *(const bf16x8*)(kp + 16);
              const bf16_t* kq = kbase + (size_t)(32 * (kt + NWAVES <= nkt ? kt + NWAVES : 1)) * UARW; n0 = *(const bf16x8*)kq; n1 = *(const bf16x8*)(kq + 16); }
#pragma unroll 1
            for (; kt <= nkt; kt += NWAVES) {
                const int ktn = kt + 2 * NWAVES <= nkt ? kt + 2 * NWAVES : kt;
                const bf16_t* kpn = kbase + (size_t)(32 * ktn) * UARW;
                const bf16x8 m0 = *(const bf16x8*)kpn, m1 = *(const bf16x8*)(kpn + 16);
                f32x16 sc;
#pragma unroll
                for (int e = 0; e < 16; ++e) sc[e] = 0.f;
#pragma unroll
                for (int h = 0; h < 8; ++h) { f32x16 d;
#pragma unroll
                    for (int e = 0; e < 16; ++e) d[e] = 0.f;
                    d = __builtin_amdgcn_mfma_f32_32x32x16_bf16(a0, qf[h][0], d, 0, 0, 0); d = __builtin_amdgcn_mfma_f32_32x32x16_bf16(a1, qf[h][1], d, 0, 0, 0);
#pragma unroll
                    for (int e = 0; e < 16; ++e) sc[e] = fmaf(wq[h], fmaxf(d[e], 0.f), sc[e]); }
                if (pass < 4) {
#pragma unroll
                    for (int e = 0; e < 16; ++e) { const int kidx = (e & 3) + 8 * (e >> 2) + 4 * hh, pos = 32 * kt + kidx;
                        const unsigned comp = pos >= PADM ? comp_key(sc[e], pos) : 0u;
                        const unsigned hi = (unsigned)((unsigned long long)comp >> (shift + 8));
                        const unsigned inc = (comp != 0u && hi == pre) ? 1u : 0u;
                        __hip_atomic_fetch_add(hist + ((comp >> shift) & 255u) * 32 + r, inc, __ATOMIC_RELAXED, __HIP_MEMORY_SCOPE_WORKGROUP); }
                } else {
                    unsigned word = 0u;
#pragma unroll
                    for (int e = 0; e < 16; ++e) { const int kidx = (e & 3) + 8 * (e >> 2) + 4 * hh, pos = 32 * kt + kidx;
                        const unsigned comp = pos >= PADM ? comp_key(sc[e], pos) : 0u;
                        word |= (comp >= pre && comp != 0u ? 1u : 0u) << kidx; }
                    word |= (unsigned)__shfl_xor((int)word, 32); if (hh == 0) maskw[kt * 32 + r] = word;
                }
                a0 = n0; a1 = n1; n0 = m0; n1 = m1;
            }
            LDS_BARRIER();
            if (pass < 4) {
                { const int q = tid & 31, seg = tid >> 5; unsigned ss = 0u;
#pragma unroll
                  for (int i = 0; i < 16; ++i) ss += hist[(seg * 16 + i) * 32 + q];
                  segs[seg * 32 + q] = ss; }
                LDS_BARRIER();
                if (tid < 32) { const unsigned rem = qrem[tid]; unsigned cum = 0u; int seg = 15;
                    while (seg > 0 && cum + segs[seg * 32 + tid] < rem) { cum += segs[seg * 32 + tid]; --seg; }
                    int bin = seg * 16 + 15;
                    while (bin > seg * 16 && cum + hist[bin * 32 + tid] < rem) { cum += hist[bin * 32 + tid]; --bin; }
                    qrem[tid] = rem - cum; qpre[tid] = (qpre[tid] << 8) | (unsigned)bin; }
                LDS_BARRIER();
            }
        }
    } else {
        for (int kt = 1 + wave; kt <= nkt; kt += NWAVES) if (hh == 0) maskw[kt * 32 + r] = kt == 1 ? 0xFFFF0000u : 0xFFFFFFFFu;
        LDS_BARRIER();
    }
    {
        const int h = wave, n = h >> 2;
        bf16x8 qf4[4];
#pragma unroll
        for (int kk = 0; kk < 4; ++kk) qf4[kk] = *(const bf16x8*)(U + qrow * UARW + C_Q + h * 64 + 16 * kk + 8 * hh);
        asm volatile("" : "+v"(qf4[0]), "+v"(qf4[1]), "+v"(qf4[2]), "+v"(qf4[3]));
        f32x16 o0, o1;
#pragma unroll
        for (int e = 0; e < 16; ++e) { o0[e] = 0.f; o1[e] = 0.f; }
        float m = -1e30f, lsum = 0.f;
        const int srow = tid >> 4, sch = tid & 15; const int soff = img_off(srow, sch);
        const bf16_t* sbase = U + (size_t)(b * LP + srow) * UARW + sch * 8;
        u32x4 kreg = *(const u32x4*)(sbase + (size_t)32 * UARW + C_K), vreg = *(const u32x4*)(sbase + (size_t)32 * UARW + C_V);
        *(LAS u32x4*)(L + AT_KV + soff) = kreg; *(LAS u32x4*)(L + AT_KV + 8192 + soff) = vreg;
        { const int k2 = nkt >= 2 ? 2 : 1; kreg = *(const u32x4*)(sbase + (size_t)(32 * k2) * UARW + C_K); vreg = *(const u32x4*)(sbase + (size_t)(32 * k2) * UARW + C_V); }
        LDS_BARRIER();
        const int g = (lane >> 4) & 1, q_ = (lane & 15) >> 2, p_ = lane & 3;
        constexpr float SCL = 0.125f * 1.44269504088896f;
#pragma unroll 1
        for (int i = 0; i < nkt; ++i) {
            const int kt = 1 + i; LAS unsigned char* Kimg = L + AT_KV + (i & 1) * 16384; LAS unsigned char* Vimg = Kimg + 8192;
            u32x4 kreg2, vreg2;
            { const int k3 = kt + 2 <= nkt ? kt + 2 : kt; kreg2 = *(const u32x4*)(sbase + (size_t)(32 * k3) * UARW + C_K); vreg2 = *(const u32x4*)(sbase + (size_t)(32 * k3) * UARW + C_V); }
            f32x16 s;
#pragma unroll
            for (int e = 0; e < 16; ++e) s[e] = 0.f;
#pragma unroll
            for (int kk = 0; kk < 4; ++kk) { const bf16x8 a = *(const LAS bf16x8*)(Kimg + img_off(r, 8 * n + 2 * kk + hh)); s = __builtin_amdgcn_mfma_f32_32x32x16_bf16(a, qf4[kk], s, 0, 0, 0); }
            const unsigned mw = maskw[kt * 32 + r] >> (4 * hh);
            float tmax = -INFINITY;
#pragma unroll
            for (int e = 0; e < 16; ++e) { const bool sel = (mw >> ((e & 3) + 8 * (e >> 2))) & 1u; s[e] = sel ? s[e] : -INFINITY; tmax = fmaxf(tmax, s[e]); }
            tmax = fmaxf(tmax, __shfl_xor(tmax, 32));
            const float mnew = fmaxf(m, tmax * SCL);
            if (__any(mnew > m)) { const float alpha = __builtin_amdgcn_exp2f(m - mnew); lsum *= alpha;
#pragma unroll
                for (int e = 0; e < 16; ++e) { o0[e] *= alpha; o1[e] *= alpha; } }
            m = mnew;
            float ps = 0.f;
#pragma unroll
            for (int e = 0; e < 16; ++e) { const float pe = __builtin_amdgcn_exp2f(fmaf(s[e], SCL, -mnew)); s[e] = pe; ps += pe; }
            lsum += ps;
            bf16x8 pf[2];
#pragma unroll
            for (int ks = 0; ks < 2; ++ks) { u32x4 w; w.x = pk2(s[8 * ks + 0], s[8 * ks + 1]); w.y = pk2(s[8 * ks + 2], s[8 * ks + 3]); w.z = pk2(s[8 * ks + 4], s[8 * ks + 5]); w.w = pk2(s[8 * ks + 6], s[8 * ks + 7]); pf[ks] = __builtin_bit_cast(bf16x8, w); }
#pragma unroll
            for (int ks = 0; ks < 2; ++ks)
#pragma unroll
                for (int dt = 0; dt < 2; ++dt) { const int c0 = 8 * n + 4 * dt + 2 * g + (p_ >> 1);
                    const s16x4 lo = __builtin_amdgcn_ds_read_tr16_b64_v4i16((LAS s16x4*)(Vimg + img_off(16 * ks + 4 * hh + q_, c0) + 8 * (p_ & 1)));
                    const s16x4 hi = __builtin_amdgcn_ds_read_tr16_b64_v4i16((LAS s16x4*)(Vimg + img_off(16 * ks + 8 + 4 * hh + q_, c0) + 8 * (p_ & 1)));
                    const bf16x8 a = __builtin_shufflevector(lo, hi, 0, 1, 2, 3, 4, 5, 6, 7);
                    if (dt == 0) o0 = __builtin_amdgcn_mfma_f32_32x32x16_bf16(a, pf[ks], o0, 0, 0, 0); else o1 = __builtin_amdgcn_mfma_f32_32x32x16_bf16(a, pf[ks], o1, 0, 0, 0); }
            if (i + 1 < nkt) { LAS unsigned char* Kn = L + AT_KV + ((i + 1) & 1) * 16384; *(LAS u32x4*)(Kn + soff) = kreg; *(LAS u32x4*)(Kn + 8192 + soff) = vreg; }
            kreg = kreg2; vreg = vreg2;
            LDS_BARRIER();
        }
        lsum += __shfl_xor(lsum, 32);
        const float inv = lsum > 0.f ? 1.0f / lsum : 0.f;
        bf16_t* orow = (bf16_t*)(p.ws + WS_OAB) + qrow * D + h * 64 + 4 * hh;
#pragma unroll
        for (int g4 = 0; g4 < 4; ++g4) { u32x2 w0, w1;
            w0.x = pk2(o0[4 * g4] * inv, o0[4 * g4 + 1] * inv); w0.y = pk2(o0[4 * g4 + 2] * inv, o0[4 * g4 + 3] * inv);
            w1.x = pk2(o1[4 * g4] * inv, o1[4 * g4 + 1] * inv); w1.y = pk2(o1[4 * g4 + 2] * inv, o1[4 * g4 + 3] * inv);
            *(u32x2*)(orow + 8 * g4) = w0; *(u32x2*)(orow + 32 + 8 * g4) = w1; }
        if (qt == 1) {
            bf16_t* z = (bf16_t*)(p.ws + WS_OAB) + (size_t)(b * LP + r) * D + h * 64 + 32 * hh;
#pragma unroll
            for (int j = 0; j < 4; ++j) *(u32x4*)(z + 8 * j) = (u32x4){0u, 0u, 0u, 0u};
        }
    }
}
__device__ __forceinline__ void attn_phase(const Params& p, int l, unsigned char* lds) {
    unsigned* ctr = (unsigned*)(p.ws + WS_CTL) + CW_ATT + 4 * l;
    volatile int* uw = (volatile int*)(lds + AT_UNIT);
    const int b0 = (obid() & 7) >> 1;
    for (int k = 0; k < 4; ++k) { const int b = (b0 + k) & 3;
        for (;;) {
            __syncthreads();
            if (otid() == 0) *uw = (int)atomicAdd(ctr + b, 1u);
            __syncthreads();
            const int u = *uw;
            if (u >= 129) break;
            attn_unit(p, lds, b, 129 - u);
        }
    }
}

constexpr size_t WS_RW1 = WS_HB;
constexpr size_t WS_RW2 = 259 * MiB;
constexpr size_t RW2_ARR = (size_t)2080 * 8192;
constexpr size_t WS_LORA = 65536;
constexpr int PS = 72;
constexpr int R1_XW = 0, R1_XA = 9216, R1_XG = 18432;
constexpr int R1_RHS = 0;
constexpr int R1_E = 35840, R1_AA = R1_E + 16640, R1_GS = R1_AA + 9216;
constexpr int R1_LABT = R1_E, R1_LAK = R1_E + 16384;
constexpr int R1_AT = R1_GS + 9216, R1_RT = R1_AT + 9216, R1_BT = R1_RT + 9216, R1_KT = R1_BT + 9216;
constexpr int R1_WT = R1_AT, R1_ZT = R1_BT;
constexpr int R1_BTT = R1_KT + 9216, R1_KTT = R1_BTT + 9216, R1_VT = R1_KTT + 9216;
constexpr int R1_MRB = R1_VT + 9216, R1_MRK = R1_MRB + 9216;
constexpr int R1_BS = R1_MRK + 9216, R1_GC = R1_BS + 256, R1_END = R1_GC + 256;
static_assert(R1_END <= LDS_BYTES && R1_LAK + 9216 <= R1_AT && R1_RHS + 33280 <= R1_E, "R1 LDS map");
__device__ __forceinline__ f32x4 mfma16(bf16x8 a, bf16x8 b, f32x4 c) { return __builtin_amdgcn_mfma_f32_16x16x32_bf16(a, b, c, 0, 0, 0); }
__device__ __forceinline__ u32x2 pk4(f32x4 v) { u32x2 w; w.x = pk2(v[0], v[1]); w.y = pk2(v[2], v[3]); return w; }

#ifndef PROBE_PHASE
#define PROBE_PHASE -1
#define PROBE_BLOCK 0
#endif
#define R1P(k) do { if (PROBE_PHASE == 20 + (k)) { const unsigned long long t_ = __builtin_amdgcn_s_memrealtime(); pacc += t_ - pt0; } if (PROBE_PHASE == 21 + (k)) pt0 = __builtin_amdgcn_s_memrealtime(); } while (0)
__device__ __forceinline__ void rwkv_prep_unit(const Params& p, int l, int unit, unsigned char* lds, unsigned long long& pacc) {
    unsigned long long pt0 = 0; if (PROBE_PHASE == 20) pt0 = __builtin_amdgcn_s_memrealtime();
    const int tid = otid(), wave = tid >> 6, lane = tid & 63, c15 = lane & 15, g = lane >> 4;
    const int h = unit & 7, bc = unit >> 3, b = bc / NCH, c = bc - b * NCH;
    LAS unsigned char* L = (LAS unsigned char*)lds;
    const bf16_t* U = (const bf16_t*)(p.ws + WS_UAR);
    const int t = tid >> 3, dq = tid & 7, d0 = dq * 8;
    const int row = b * LP + 64 * c + t; const bool hasprev = (64 * c + t) > 0;
    float rr[8], kx[8], vx[8], kk[8];
    {
        const bf16_t* uc = U + (size_t)row * UARW; const bf16_t* up = hasprev ? uc - UARW : uc;
        const float* mu = p.in[I_MU] + l * R_COLS;
        auto shift8 = [&](int col, int mucol, float (&out)[8]) {
            const u32x4 a = *(const u32x4*)(uc + col), q = *(const u32x4*)(up + col);
            const f32x4 m0 = *(const f32x4*)(mu + mucol), m1 = *(const f32x4*)(mu + mucol + 4);
            const float x[8] = {bflo(a.x), bfhi(a.x), bflo(a.y), bfhi(a.y), bflo(a.z), bfhi(a.z), bflo(a.w), bfhi(a.w)};
            const float y[8] = {bflo(q.x), bfhi(q.x), bflo(q.y), bfhi(q.y), bflo(q.z), bfhi(q.z), bflo(q.w), bfhi(q.w)};
#pragma unroll
            for (int i = 0; i < 8; ++i) { const float xp = hasprev ? y[i] : 0.f; out[i] = x[i] + (xp - x[i]) * (i < 4 ? m0[i] : m1[i - 4]); } };
        shift8(C_R + h * 64 + d0, h * 64 + d0, rr); shift8(C_RK + h * 64 + d0, 512 + h * 64 + d0, kx); shift8(C_RV + h * 64 + d0, 1024 + h * 64 + d0, vx);
        float xw[8], xa[8], xg0[8], xg1[8];
        shift8(C_XW + d0, 1536 + d0, xw); shift8(C_XA + d0, 1600 + d0, xa); shift8(C_XG + d0, 1664 + d0, xg0); shift8(C_XG + 64 + d0, 1728 + d0, xg1);
        float n2 = 0.f;
        { const f32x4 k0 = *(const f32x4*)(p.in[I_KK] + l * 512 + h * 64 + d0), k1 = *(const f32x4*)(p.in[I_KK] + l * 512 + h * 64 + d0 + 4);
#pragma unroll
          for (int i = 0; i < 8; ++i) { kk[i] = kx[i] * (i < 4 ? k0[i] : k1[i - 4]); n2 = fmaf(kk[i], kk[i], n2); } }
        n2 += __shfl_xor(n2, 1); n2 += __shfl_xor(n2, 2); n2 += __shfl_xor(n2, 4);
        const float rn = rsqrtf(fmaxf(n2, 1e-24f));
#pragma unroll
        for (int i = 0; i < 8; ++i) { kk[i] *= rn; xw[i] = tanhf(xw[i]); xg0[i] = sigmoidf_(xg0[i]); xg1[i] = sigmoidf_(xg1[i]); }
        u32x4 w;
        w.x = pk2(xw[0], xw[1]); w.y = pk2(xw[2], xw[3]); w.z = pk2(xw[4], xw[5]); w.w = pk2(xw[6], xw[7]); *(LAS u32x4*)(L + R1_XW + (t * PS + d0) * 2) = w;
        w.x = pk2(xa[0], xa[1]); w.y = pk2(xa[2], xa[3]); w.z = pk2(xa[4], xa[5]); w.w = pk2(xa[6], xa[7]); *(LAS u32x4*)(L + R1_XA + (t * PS + d0) * 2) = w;
        w.x = pk2(xg0[0], xg0[1]); w.y = pk2(xg0[2], xg0[3]); w.z = pk2(xg0[4], xg0[5]); w.w = pk2(xg0[6], xg0[7]); *(LAS u32x4*)(L + R1_XG + (t * 136 + d0) * 2) = w;
        w.x = pk2(xg1[0], xg1[1]); w.y = pk2(xg1[2], xg1[3]); w.z = pk2(xg1[4], xg1[5]); w.w = pk2(xg1[6], xg1[7]); *(LAS u32x4*)(L + R1_XG + (t * 136 + 64 + d0) * 2) = w;
    }
    LDS_BARRIER();
    R1P(0);
    const int tm = wave >> 1;
    unsigned char* rw2 = p.ws + WS_RW2 + (size_t)unit * 8192;
    {
        const bf16_t* lora = (const bf16_t*)(p.ws + WS_LORA + (size_t)l * 262144);
#pragma unroll
        for (int nn = 0; nn < 2; ++nn) { const int tn = 2 * (wave & 1) + nn, dcol = 16 * tn + c15, hd = h * 64 + dcol;
            f32x4 aw = {0.f, 0.f, 0.f, 0.f}, aa = aw, ag = aw;
#pragma unroll
            for (int s2 = 0; s2 < 2; ++s2) {
                const bf16x8 xa_ = *(const LAS bf16x8*)(L + R1_XW + ((16 * tm + c15) * PS + 32 * s2 + 8 * g) * 2), xb_ = *(const LAS bf16x8*)(L + R1_XA + ((16 * tm + c15) * PS + 32 * s2 + 8 * g) * 2);
                aw = mfma16(xa_, *(const bf16x8*)(lora + (size_t)hd * 64 + 32 * s2 + 8 * g), aw);
                aa = mfma16(xb_, *(const bf16x8*)(lora + 32768 + (size_t)hd * 64 + 32 * s2 + 8 * g), aa); }
#pragma unroll
            for (int s4 = 0; s4 < 4; ++s4) ag = mfma16(*(const LAS bf16x8*)(L + R1_XG + ((16 * tm + c15) * 136 + 32 * s4 + 8 * g) * 2), *(const bf16x8*)(lora + 65536 + (size_t)hd * 128 + 32 * s4 + 8 * g), ag);
            const float w0 = p.in[I_W0][l * 512 + hd], a0 = p.in[I_A0][l * 512 + hd];
#pragma unroll
            for (int e = 0; e < 4; ++e) { const int tt = 16 * tm + 4 * g + e;
                const float z = -(w0 + aw[e]); const float sp = fmaxf(z, 0.f) + log1pf(__expf(-fabsf(z)));
                *(LAS float*)(L + R1_E + (tt * 65 + dcol) * 4) = __expf(-sp - 0.5f);
                *(LAS unsigned short*)(L + R1_AA + (tt * PS + dcol) * 2) = (unsigned short)f2bf(sigmoidf_(a0 + aa[e]));
                *(LAS unsigned short*)(L + R1_GS + (tt * PS + dcol) * 2) = (unsigned short)f2bf(ag[e]); }
        }
    }
    LDS_BARRIER();
    R1P(1);
    {
        const int d = tid & 63, sg = tid >> 6; float cum = 0.f, loc[8];
#pragma unroll
        for (int i = 0; i < 8; ++i) { cum += *(const LAS float*)(L + R1_E + ((8 * sg + i) * 65 + d) * 4); loc[i] = cum; }
        *(LAS float*)(L + R1_BS + (sg * 64 + d) * 4 - 2048) = cum;
        LDS_BARRIER();
        float off = 0.f;
#pragma unroll
        for (int q = 0; q < 7; ++q) if (q < sg) off += *(const LAS float*)(L + R1_BS + (q * 64 + d) * 4 - 2048);
#pragma unroll
        for (int i = 0; i < 8; ++i) *(LAS float*)(L + R1_E + ((8 * sg + i) * 65 + d) * 4) = loc[i] + off;
    }
    LDS_BARRIER();
    R1P(2);
    {
        const f32x4 ka0 = *(const f32x4*)(p.in[I_KA] + l * 512 + h * 64 + d0), ka1 = *(const f32x4*)(p.in[I_KA] + l * 512 + h * 64 + d0 + 4);
        const f32x4 rk0 = *(const f32x4*)(p.in[I_RK] + l * 512 + h * 64 + d0), rk1 = *(const f32x4*)(p.in[I_RK] + l * 512 + h * 64 + d0 + 4);
        const u32x4 aw_ = *(const LAS u32x4*)(L + R1_AA + (t * PS + d0) * 2);
        const float av[8] = {bflo(aw_.x), bfhi(aw_.x), bflo(aw_.y), bfhi(aw_.y), bflo(aw_.z), bfhi(aw_.z), bflo(aw_.w), bfhi(aw_.w)};
        float At[8], Bt[8], Kt[8], Rt[8]; float bpart = 0.f;
#pragma unroll
        for (int i = 0; i < 8; ++i) {
            const float cumt = *(const LAS float*)(L + R1_E + (t * 65 + d0 + i) * 4), cump = t > 0 ? *(const LAS float*)(L + R1_E + ((t - 1) * 65 + d0 + i) * 4) : 0.f;
            const float gam = __expf(-cumt), gprev = __expf(-cump), ginv = __expf(cumt);
            const float kmod = kx[i] * (1.0f + (av[i] - 1.0f) * (i < 4 ? ka0[i] : ka1[i - 4]));
            At[i] = -gprev * kk[i]; Bt[i] = kk[i] * av[i] * ginv; Kt[i] = kmod * ginv; Rt[i] = rr[i] * gam;
            bpart = fmaf(rr[i] * kmod, (i < 4 ? rk0[i] : rk1[i - 4]), bpart);
            if (t == 63) *(LAS float*)(L + R1_GC + (d0 + i) * 4) = gam;
            *(LAS float*)(L + R1_RHS + ((d0 + i) * 65 + t) * 4) = At[i];
            *(LAS unsigned short*)(L + R1_BTT + ((d0 + i) * PS + t) * 2) = (unsigned short)f2bf(Bt[i]);
            *(LAS unsigned short*)(L + R1_KTT + ((d0 + i) * PS + t) * 2) = (unsigned short)f2bf(Kt[i]);
            *(LAS unsigned short*)(L + R1_VT + ((d0 + i) * PS + t) * 2) = (unsigned short)f2bf(vx[i]);
        }
        u32x4 w;
        w.x = pk2(At[0], At[1]); w.y = pk2(At[2], At[3]); w.z = pk2(At[4], At[5]); w.w = pk2(At[6], At[7]); *(LAS u32x4*)(L + R1_AT + (t * PS + d0) * 2) = w;
        w.x = pk2(Rt[0], Rt[1]); w.y = pk2(Rt[2], Rt[3]); w.z = pk2(Rt[4], Rt[5]); w.w = pk2(Rt[6], Rt[7]); *(LAS u32x4*)(L + R1_RT + (t * PS + d0) * 2) = w;
        w.x = pk2(Bt[0], Bt[1]); w.y = pk2(Bt[2], Bt[3]); w.z = pk2(Bt[4], Bt[5]); w.w = pk2(Bt[6], Bt[7]); *(LAS u32x4*)(L + R1_BT + (t * PS + d0) * 2) = w;
        w.x = pk2(Kt[0], Kt[1]); w.y = pk2(Kt[2], Kt[3]); w.z = pk2(Kt[4], Kt[5]); w.w = pk2(Kt[6], Kt[7]); *(LAS u32x4*)(L + R1_KT + (t * PS + d0) * 2) = w;
        bpart += __shfl_xor(bpart, 1); bpart += __shfl_xor(bpart, 2); bpart += __shfl_xor(bpart, 4);
        const u32x4 gw = *(const LAS u32x4*)(L + R1_GS + (t * PS + d0) * 2);
        const float gv[8] = {bflo(gw.x), bfhi(gw.x), bflo(gw.y), bfhi(gw.y), bflo(gw.z), bfhi(gw.z), bflo(gw.w), bfhi(gw.w)};
        w.x = pk2(bpart * vx[0] * gv[0], bpart * vx[1] * gv[1]); w.y = pk2(bpart * vx[2] * gv[2], bpart * vx[3] * gv[3]);
        w.z = pk2(bpart * vx[4] * gv[4], bpart * vx[5] * gv[5]); w.w = pk2(bpart * vx[6] * gv[6], bpart * vx[7] * gv[7]);
        *(u32x4*)((bf16_t*)(p.ws + WS_OAB) + (size_t)row * D + 512 + h * 64 + d0) = w;
        *(u32x4*)(rw2 + 2 * RW2_ARR + (size_t)(t * 64 + d0) * 2) = gw;
    }
    LDS_BARRIER();
    R1P(3);
    {
        f32x4 gab[2], gak[2], grb[2], grk[2];
#pragma unroll
        for (int nn = 0; nn < 2; ++nn) { const int tn = 2 * (wave & 1) + nn;
            gab[nn] = (f32x4){0.f, 0.f, 0.f, 0.f}; gak[nn] = gab[nn]; grb[nn] = gab[nn]; grk[nn] = gab[nn];
            if (tn <= tm) {
#pragma unroll
                for (int s2 = 0; s2 < 2; ++s2) { const int ao = ((16 * tm + c15) * PS + 32 * s2 + 8 * g) * 2, bo = ((16 * tn + c15) * PS + 32 * s2 + 8 * g) * 2;
                    const bf16x8 fa = *(const LAS bf16x8*)(L + R1_AT + ao), fr_ = *(const LAS bf16x8*)(L + R1_RT + ao), fb = *(const LAS bf16x8*)(L + R1_BT + bo), fk = *(const LAS bf16x8*)(L + R1_KT + bo);
                    gab[nn] = mfma16(fa, fb, gab[nn]); gak[nn] = mfma16(fa, fk, gak[nn]); grb[nn] = mfma16(fr_, fb, grb[nn]); grk[nn] = mfma16(fr_, fk, grk[nn]); } } }
        LDS_BARRIER();
#pragma unroll
        for (int nn = 0; nn < 2; ++nn) { const int tn = 2 * (wave & 1) + nn, icol = 16 * tn + c15;
            f32x4 lab;
#pragma unroll
            for (int e = 0; e < 4; ++e) { const int tt = 16 * tm + 4 * g + e; const bool strict = icol < tt, incl = icol <= tt;
                lab[e] = strict ? gab[nn][e] : 0.f;
                *(LAS unsigned short*)(L + R1_LAK + (tt * PS + icol) * 2) = (unsigned short)f2bf(strict ? gak[nn][e] : 0.f);
                *(LAS unsigned short*)(L + R1_MRB + (tt * PS + icol) * 2) = (unsigned short)f2bf(incl ? grb[nn][e] : 0.f);
                *(LAS unsigned short*)(L + R1_MRK + (tt * PS + icol) * 2) = (unsigned short)f2bf(incl ? grk[nn][e] : 0.f); }
            *(LAS f32x4*)(L + R1_LABT + (icol * 64 + 16 * tm + 4 * g) * 4) = lab; }
    }
    LDS_BARRIER();
    R1P(4);
    {
#pragma unroll
        for (int nn = 0; nn < 2; ++nn) { const int tn = 2 * (wave & 1) + nn; f32x4 acc = {0.f, 0.f, 0.f, 0.f};
#pragma unroll
            for (int s2 = 0; s2 < 2; ++s2) acc = mfma16(*(const LAS bf16x8*)(L + R1_LAK + ((16 * tm + c15) * PS + 32 * s2 + 8 * g) * 2), *(const LAS bf16x8*)(L + R1_VT + ((16 * tn + c15) * PS + 32 * s2 + 8 * g) * 2), acc);
#pragma unroll
            for (int e = 0; e < 4; ++e) *(LAS float*)(L + R1_RHS + ((64 + 16 * tn + c15) * 65 + 16 * tm + 4 * g + e) * 4) = acc[e]; }
    }
    LDS_BARRIER();
    R1P(5);
    if (tid < 128) {
        LAS float* xr = (LAS float*)(L + R1_RHS + tid * 65 * 4);
#pragma unroll 1
        for (int Tb = 0; Tb < 4; ++Tb) {
            float acc[16];
#pragma unroll
            for (int e = 0; e < 16; ++e) acc[e] = xr[16 * Tb + e];
#pragma unroll 4
            for (int i = 0; i < 16 * Tb; ++i) { const float xi = xr[i];
#pragma unroll
                for (int q = 0; q < 4; ++q) { const f32x4 lv = *(const LAS f32x4*)(L + R1_LABT + (i * 64 + 16 * Tb + 4 * q) * 4);
#pragma unroll
                    for (int e = 0; e < 4; ++e) acc[4 * q + e] = fmaf(lv[e], xi, acc[4 * q + e]); } }
#pragma unroll
            for (int ii = 0; ii < 15; ++ii) { const float xi = acc[ii];
#pragma unroll
                for (int q = (ii + 1) / 4; q < 4; ++q) { const f32x4 lv = *(const LAS f32x4*)(L + R1_LABT + ((16 * Tb + ii) * 64 + 16 * Tb + 4 * q) * 4);
#pragma unroll
                    for (int e = 0; e < 4; ++e) if (4 * q + e > ii) acc[4 * q + e] = fmaf(lv[e], xi, acc[4 * q + e]); } }
#pragma unroll
            for (int e = 0; e < 16; ++e) xr[16 * Tb + e] = acc[e];
        }
        LAS unsigned char* dst = L + (tid < 64 ? R1_WT + tid * PS * 2 : R1_ZT + (tid - 64) * PS * 2);
#pragma unroll
        for (int q8 = 0; q8 < 8; ++q8) { u32x4 w; w.x = pk2(xr[8 * q8], xr[8 * q8 + 1]); w.y = pk2(xr[8 * q8 + 2], xr[8 * q8 + 3]); w.z = pk2(xr[8 * q8 + 4], xr[8 * q8 + 5]); w.w = pk2(xr[8 * q8 + 6], xr[8 * q8 + 7]); *(LAS u32x4*)(dst + q8 * 16) = w; }
    }
    LDS_BARRIER();
    R1P(6);
    {
        unsigned char* rw1 = p.ws + WS_RW1 + (size_t)unit * 16384;
#pragma unroll
        for (int nn = 0; nn < 2; ++nn) { const int tn = 2 * (wave & 1) + nn, col = 16 * tn + c15, r0 = 16 * tm + 4 * g;
            f32x4 aP = {0.f, 0.f, 0.f, 0.f}, aQ = aP, aG = aP, aY = aP;
#pragma unroll
            for (int s2 = 0; s2 < 2; ++s2) { const int ro = ((16 * tm + c15) * PS + 32 * s2 + 8 * g) * 2, co = ((16 * tn + c15) * PS + 32 * s2 + 8 * g) * 2;
                const bf16x8 fWT = *(const LAS bf16x8*)(L + R1_WT + ro), fBTT = *(const LAS bf16x8*)(L + R1_BTT + ro), fKTT = *(const LAS bf16x8*)(L + R1_KTT + ro), fMRB = *(const LAS bf16x8*)(L + R1_MRB + ro), fMRK = *(const LAS bf16x8*)(L + R1_MRK + ro);
                const bf16x8 cBTT = *(const LAS bf16x8*)(L + R1_BTT + co), cZT = *(const LAS bf16x8*)(L + R1_ZT + co), cVT = *(const LAS bf16x8*)(L + R1_VT + co), cMRB = *(const LAS bf16x8*)(L + R1_MRB + co);
                aP = mfma16(fWT, cBTT, aP);
                aQ = mfma16(fBTT, cZT, aQ); aQ = mfma16(fKTT, cVT, aQ);
                aG = mfma16(fWT, cMRB, aG);
                aY = mfma16(fMRB, cZT, aY); aY = mfma16(fMRK, cVT, aY); }
            const float gcc = *(const LAS float*)(L + R1_GC + col * 4);
            const f32x4 gcr = *(const LAS f32x4*)(L + R1_GC + r0 * 4);
            const u32x2 rtw = *(const LAS u32x2*)(L + R1_RT + (col * PS + r0) * 2);
#pragma unroll
            for (int e = 0; e < 4; ++e) { aP[e] = (aP[e] + ((r0 + e) == col ? 1.0f : 0.f)) * gcc; aQ[e] *= gcr[e]; }
            aG[0] += bflo(rtw.x); aG[1] += bfhi(rtw.x); aG[2] += bflo(rtw.y); aG[3] += bfhi(rtw.y);
            *(u32x2*)(rw1 + (size_t)(col * 64 + r0) * 2) = pk4(aP);
            *(u32x2*)(rw1 + 8192 + (size_t)(col * 64 + r0) * 2) = pk4(aG);
            *(u32x2*)(rw2 + (size_t)(col * 64 + r0) * 2) = pk4(aQ);
            *(u32x2*)(rw2 + RW2_ARR + (size_t)(col * 64 + r0) * 2) = pk4(aY); }
    }
    LDS_BARRIER();
    R1P(7);
}

constexpr int R2_SV = 0, R2_YS = 2 * 64 * PS * 2, R2_END = R2_YS + 2 * 64 * 68 * 4;
__device__ __forceinline__ void rwkv_scan(const Params& p, int l, int bh, unsigned char* lds) {
    const int tid = otid(), wave = tid >> 6, lane = tid & 63, c15 = lane & 15, g = lane >> 4;
    const int b = bh >> 3, h = bh & 7, role = wave >> 2, j = wave & 3, vcol = 16 * j + c15;
    LAS unsigned char* L = (LAS unsigned char*)lds;
    for (int i = tid; i < 2 * 64 * PS * 2 / 4; i += NTHREADS) ((LAS unsigned*)(L + R2_SV))[i] = 0u;
    LDS_BARRIER();
    const int et = tid >> 3, ev0 = 8 * (tid & 7);
    f32x4 gn0[2], gn1[2];
    { const float* gp = p.in[I_GNG] + l * 512 + h * 64 + ev0; const float* bp = p.in[I_GNB] + l * 512 + h * 64 + ev0;
      gn0[0] = *(const f32x4*)gp; gn0[1] = *(const f32x4*)(gp + 4); gn1[0] = *(const f32x4*)bp; gn1[1] = *(const f32x4*)(bp + 4); }
    bf16_t* OB = (bf16_t*)(p.ws + WS_OAB) + (size_t)(b * LP + et) * D + 512 + h * 64 + ev0;
    const int unit0 = (b * NCH) * 8 + h;
    const unsigned char* rw1b = p.ws + WS_RW1 + (role ? 8192 : 0) + (size_t)(c15 * 64 + 8 * g) * 2;
    const unsigned char* rw2b = p.ws + WS_RW2 + (role ? RW2_ARR : 0) + (size_t)(vcol * 64 + 4 * g) * 2;
    const unsigned char* ggb = p.ws + WS_RW2 + 2 * RW2_ARR + (size_t)(et * 64 + ev0) * 2;
    bf16x8 A0[4][2], A1[4][2]; u32x2 I0[4], I1[4];
    u32x4 G0 = {0u, 0u, 0u, 0u}, O0 = G0, G1, O1;
#define R2_LOAD(AA, II, cc) do { const size_t un_ = (size_t)(unit0 + 8 * ((cc) < NCH ? (cc) : NCH - 1)); \
        _Pragma("unroll") for (int m = 0; m < 4; ++m) { II[m] = *(const u32x2*)(rw2b + un_ * 8192 + 32 * m); \
            _Pragma("unroll") for (int s2 = 0; s2 < 2; ++s2) AA[m][s2] = *(const bf16x8*)(rw1b + un_ * 16384 + (16 * m * 64 + 32 * s2) * 2); } } while (0)
    R2_LOAD(A0, I0, 0); R2_LOAD(A1, I1, 1);
    G1 = *(const u32x4*)(ggb + (size_t)unit0 * 8192); O1 = *(const u32x4*)OB;
#pragma unroll 1
    for (int c = 0; c <= NCH; ++c) {
        const int cur = c & 1;
        bf16x8 A2[4][2]; u32x2 I2[4];
        R2_LOAD(A2, I2, c + 2);
        u32x4 G2, O2; { const int cn = c + 1 < NCH ? c + 1 : NCH - 1; G2 = *(const u32x4*)(ggb + (size_t)(unit0 + 8 * cn) * 8192); O2 = *(const u32x4*)(OB + (size_t)(64 * cn) * D); }
        if (c > 0) {
            const f32x4 y0 = *(const LAS f32x4*)(L + R2_YS + ((cur ^ 1) * 64 * 68 + et * 68 + ev0) * 4), y1 = *(const LAS f32x4*)(L + R2_YS + ((cur ^ 1) * 64 * 68 + et * 68 + ev0 + 4) * 4);
            float s1 = (y0[0] + y0[1]) + (y0[2] + y0[3]) + (y1[0] + y1[1]) + (y1[2] + y1[3]);
            s1 = sum8(s1); const float mean = s1 * (1.f / 64.f);
            const f32x4 d0 = y0 - mean, d1 = y1 - mean;
            float s2_ = (d0[0] * d0[0] + d0[1] * d0[1]) + (d0[2] * d0[2] + d0[3] * d0[3]) + (d1[0] * d1[0] + d1[1] * d1[1]) + (d1[2] * d1[2] + d1[3] * d1[3]);
            s2_ = sum8(s2_); const float rstd = rsqrtf(s2_ * (1.f / 64.f) + GN_EPS);
            const float gv[8] = {bflo(G0.x), bfhi(G0.x), bflo(G0.y), bfhi(G0.y), bflo(G0.z), bfhi(G0.z), bflo(G0.w), bfhi(G0.w)};
            const float ov[8] = {bflo(O0.x), bfhi(O0.x), bflo(O0.y), bfhi(O0.y), bflo(O0.z), bfhi(O0.z), bflo(O0.w), bfhi(O0.w)};
            float o[8];
#pragma unroll
            for (int i = 0; i < 4; ++i) { o[i] = ov[i] + (d0[i] * rstd * gn0[0][i] + gn1[0][i]) * gv[i]; o[4 + i] = ov[4 + i] + (d1[i] * rstd * gn0[1][i] + gn1[1][i]) * gv[4 + i]; }
            u32x4 w; w.x = pk2(o[0], o[1]); w.y = pk2(o[2], o[3]); w.z = pk2(o[4], o[5]); w.w = pk2(o[6], o[7]);
            *(u32x4*)(OB + (size_t)(64 * (c - 1)) * D) = w;
        }
        if (c < NCH) {
            bf16x8 bf_[2];
#pragma unroll
            for (int s2 = 0; s2 < 2; ++s2) bf_[s2] = *(const LAS bf16x8*)(L + R2_SV + cur * 64 * PS * 2 + (vcol * PS + 32 * s2 + 8 * g) * 2);
            f32x4 acc[4];
#pragma unroll
            for (int m = 0; m < 4; ++m) { acc[m] = (f32x4){bflo(I0[m].x), bfhi(I0[m].x), bflo(I0[m].y), bfhi(I0[m].y)};
#pragma unroll
                for (int s2 = 0; s2 < 2; ++s2) acc[m] = mfma16(A0[m][s2], bf_[s2], acc[m]); }
            if (role == 0) {
#pragma unroll
                for (int m = 0; m < 4; ++m) *(LAS u32x2*)(L + R2_SV + (cur ^ 1) * 64 * PS * 2 + (vcol * PS + 16 * m + 4 * g) * 2) = pk4(acc[m]);
            } else {
#pragma unroll
                for (int m = 0; m < 4; ++m)
#pragma unroll
                    for (int e = 0; e < 4; ++e) *(LAS float*)(L + R2_YS + (cur * 64 * 68 + (16 * m + 4 * g + e) * 68 + vcol) * 4) = acc[m][e];
            }
        }
        LDS_BARRIER();
#pragma unroll
        for (int m = 0; m < 4; ++m) { I0[m] = I1[m]; I1[m] = I2[m]; A0[m][0] = A1[m][0]; A0[m][1] = A1[m][1]; A1[m][0] = A2[m][0]; A1[m][1] = A2[m][1]; }
        G0 = G1; O0 = O1; G1 = G2; O1 = O2;
    }
#undef R2_LOAD
}

__device__ void rwkv_naive(const Params& p, int l, int bh, unsigned char* lds) {
    const int b = bh >> 3, h = bh & 7, tid = otid(), lane = tid & 63, wid = tid >> 6;
    const bf16_t* U = (const bf16_t*)(p.ws + WS_UAR);
    bf16_t* OB = (bf16_t*)(p.ws + WS_OAB);
    float* xs = (float*)lds;
    float* vr = xs + 32 * 256;
    float* vw = vr + 2048; float* vkk = vw + 2048; float* vbb = vkk + 2048; float* vk = vbb + 2048; float* vv = vk + 2048;
    float* gg = vv + 2048; float* bon = gg + 2048; float* ys = bon + 2048;
    const float* mu = p.in[I_MU] + l * R_COLS;
    const int hd = h * 64 + lane;
    const float w0 = p.in[I_W0][l * 512 + hd], a0 = p.in[I_A0][l * 512 + hd], kkc = p.in[I_KK][l * 512 + hd], kac = p.in[I_KA][l * 512 + hd], rkc = p.in[I_RK][l * 512 + hd];
    const float gng = p.in[I_GNG][l * 512 + hd], gnb = p.in[I_GNB][l * 512 + hd];
    const float mur = mu[hd], muk = mu[512 + hd], muv = mu[1024 + hd];
    const float* wup = p.in[I_WUP] + (size_t)l * 64 * 512 + hd; const float* aup = p.in[I_AUP] + (size_t)l * 64 * 512 + hd; const float* gup = p.in[I_GUP] + (size_t)l * 128 * 512 + hd;
    float S[8];
#pragma unroll
    for (int i = 0; i < 8; ++i) S[i] = 0.f;
    const int sv = tid >> 3, sq = tid & 7;
    for (int p0 = 0; p0 < LP; p0 += 32) {
        for (int idx = tid; idx < 32 * 256; idx += NTHREADS) {
            const int tt = idx >> 8, j = idx & 255, pos = p0 + tt; const size_t ro = (size_t)(b * LP + pos) * UARW;
            const float x = bf2f(U[ro + C_XW + j]); const float xp = pos > 0 ? bf2f(U[ro - UARW + C_XW + j]) : 0.f;
            float xv = x + (xp - x) * mu[1536 + j];
            if (j < 64) xv = tanhf(xv); else if (j >= 128) xv = sigmoidf_(xv);
            xs[idx] = xv;
        }
        __syncthreads();
        {
            float dw[4] = {0.f, 0.f, 0.f, 0.f}, da[4] = {0.f, 0.f, 0.f, 0.f}, dg[4] = {0.f, 0.f, 0.f, 0.f};
            for (int j = 0; j < 64; ++j) { const float w1 = wup[(size_t)j * 512], w2 = aup[(size_t)j * 512];
#pragma unroll
                for (int k = 0; k < 4; ++k) { dw[k] = fmaf(xs[(wid * 4 + k) * 256 + j], w1, dw[k]); da[k] = fmaf(xs[(wid * 4 + k) * 256 + 64 + j], w2, da[k]); } }
            for (int j = 0; j < 128; ++j) { const float w3 = gup[(size_t)j * 512];
#pragma unroll
                for (int k = 0; k < 4; ++k) dg[k] = fmaf(xs[(wid * 4 + k) * 256 + 128 + j], w3, dg[k]); }
#pragma unroll
            for (int k = 0; k < 4; ++k) {
                const int tt = wid * 4 + k, pos = p0 + tt; const size_t ro = (size_t)(b * LP + pos) * UARW;
                float r = bf2f(U[ro + C_R + hd]), kx = bf2f(U[ro + C_RK + hd]), vx = bf2f(U[ro + C_RV + hd]);
                if (pos > 0) { const float rp = bf2f(U[ro - UARW + C_R + hd]), kp = bf2f(U[ro - UARW + C_RK + hd]), vp = bf2f(U[ro - UARW + C_RV + hd]);
                    r += (rp - r) * mur; kx += (kp - kx) * muk; vx += (vp - vx) * muv; }
                else { r -= r * mur; kx -= kx * muk; vx -= vx * muv; }
                const float z = -(w0 + dw[k]); const float sp = fmaxf(z, 0.f) + log1pf(__expf(-fabsf(z)));
                const float logw = -sp - 0.5f; const float w = __expf(-__expf(logw));
                const float a = sigmoidf_(a0 + da[k]);
                float kk = kx * kkc; const float nrm = wave_sum(kk * kk); kk *= rsqrtf(fmaxf(nrm, 1e-24f));
                const float kmod = kx * (1.0f + (a - 1.0f) * kac);
                const float bsum = wave_sum(r * kmod * rkc);
                vr[tt * 64 + lane] = r; vw[tt * 64 + lane] = w; vkk[tt * 64 + lane] = kk; vbb[tt * 64 + lane] = kk * a; vk[tt * 64 + lane] = kmod; vv[tt * 64 + lane] = vx;
                gg[tt * 64 + lane] = dg[k]; bon[tt * 64 + lane] = bsum * vx;
            }
        }
        __syncthreads();
        for (int tt = 0; tt < 32; ++tt) {
            const f32x4 k0 = *(const f32x4*)(vkk + tt * 64 + sq * 8), k1 = *(const f32x4*)(vkk + tt * 64 + sq * 8 + 4);
            const f32x4 w0v = *(const f32x4*)(vw + tt * 64 + sq * 8), w1v = *(const f32x4*)(vw + tt * 64 + sq * 8 + 4);
            const f32x4 b0 = *(const f32x4*)(vbb + tt * 64 + sq * 8), b1 = *(const f32x4*)(vbb + tt * 64 + sq * 8 + 4);
            const f32x4 m0 = *(const f32x4*)(vk + tt * 64 + sq * 8), m1 = *(const f32x4*)(vk + tt * 64 + sq * 8 + 4);
            const f32x4 r0 = *(const f32x4*)(vr + tt * 64 + sq * 8), r1 = *(const f32x4*)(vr + tt * 64 + sq * 8 + 4);
            const float vt = vv[tt * 64 + sv];
            float sa = 0.f;
#pragma unroll
            for (int i = 0; i < 4; ++i) { sa = fmaf(S[i], k0[i], sa); sa = fmaf(S[4 + i], k1[i], sa); }
            sa += __shfl_xor(sa, 1); sa += __shfl_xor(sa, 2); sa += __shfl_xor(sa, 4);
            sa = -sa; float y = 0.f;
#pragma unroll
            for (int i = 0; i < 4; ++i) { S[i] = S[i] * w0v[i] + sa * b0[i] + vt * m0[i]; S[4 + i] = S[4 + i] * w1v[i] + sa * b1[i] + vt * m1[i];
                y = fmaf(S[i], r0[i], y); y = fmaf(S[4 + i], r1[i], y); }
            y += __shfl_xor(y, 1); y += __shfl_xor(y, 2); y += __shfl_xor(y, 4);
            if (sq == 0) ys[tt * 64 + sv] = y;
        }
        __syncthreads();
#pragma unroll
        for (int k = 0; k < 4; ++k) { const int tt = wid * 4 + k, pos = p0 + tt; const float y = ys[tt * 64 + lane];
            const float m = wave_sum(y) * (1.f / 64.f); const float dv = y - m; const float var = wave_sum(dv * dv) * (1.f / 64.f);
            const float o = (dv * rsqrtf(var + GN_EPS) * gng + gnb + bon[tt * 64 + lane]) * gg[tt * 64 + lane];
            OB[(size_t)(b * LP + pos) * D + 512 + hd] = (bf16_t)f2bf(o); }
        __syncthreads();
    }
}

__device__ __forceinline__ int pair_index(int a, int b) {   return a == 0 ? b - 1 : (a == 1 ? b + 1 : 5); }
__device__ __forceinline__ void pair_of(int idx, int& a, int& b) { a = idx < 3 ? 0 : (idx < 5 ? 1 : 2); b = idx < 3 ? idx + 1 : (idx < 5 ? idx - 1 : 3); }
__device__ __forceinline__ void ln1_router_phase(const Params& p, int l, unsigned char* lds) {
    const int tid = otid(), lane = tid & 63, gw = obid() * NWAVES + (tid >> 6), NGW = gridDim.x * NWAVES;
    float* wr_s = (float*)lds;
    for (int i = tid; i < D * 16 / 4; i += NTHREADS) { const f32x4 w = ((const f32x4*)p.in[I_WROUTER])[i]; const int c = i >> 2, e0 = (i & 3) * 4;
        wr_s[(e0 + 0) * D + c] = w[0]; wr_s[(e0 + 1) * D + c] = w[1]; wr_s[(e0 + 2) * D + c] = w[2]; wr_s[(e0 + 3) * D + c] = w[3]; }
    __syncthreads();
    unsigned* cls_cnt = (unsigned*)(p.ws + WS_CTL) + CW_CLS + l * 32;
    int* lists = (int*)(p.ws + WS_LIST); f32x2* gl = (f32x2*)(p.ws + WS_LIST + 2 * MiB);
    const float* g = p.in[I_LN1G] + l * D; const float* bt = p.in[I_LN1B] + l * D;
    for (int r = gw; r < T; r += NGW) {
        f32x4 v[4];
        if (is_dummy(r)) {
#pragma unroll
            for (int j = 0; j < 4; ++j) v[j] = (f32x4){0.f, 0.f, 0.f, 0.f};
            store_row(p, r, v, lane, true); continue; }
        const float* hr = hrow(p, r);
#pragma unroll
        for (int j = 0; j < 4; ++j) v[j] = *(const f32x4*)(hr + 4 * lane + 256 * j);
        ln_wave(v, g, bt, lane);
        store_row(p, r, v, lane, false);
        float lg[16];
#pragma unroll
        for (int e = 0; e < 16; ++e) lg[e] = 0.f;
#pragma unroll
        for (int e = 0; e < 16; ++e)
#pragma unroll
            for (int j = 0; j < 4; ++j) { const f32x4 w = *(const f32x4*)(wr_s + e * D + 4 * lane + 256 * j);
                lg[e] = fmaf(v[j][0], w[0], lg[e]); lg[e] = fmaf(v[j][1], w[1], lg[e]); lg[e] = fmaf(v[j][2], w[2], lg[e]); lg[e] = fmaf(v[j][3], w[3], lg[e]); }
#pragma unroll
        for (int e = 0; e < 16; ++e) lg[e] = wave_sum(lg[e]);
        float s[16], sel[16];
#pragma unroll
        for (int e = 0; e < 16; ++e) { s[e] = sigmoidf_(lg[e]); sel[e] = s[e] + p.in[I_BROUTER][e]; }
        int gbest = 0; float gsc = -INFINITY;
#pragma unroll
        for (int gi = 0; gi < 4; ++gi) { float m1 = -INFINITY, m2 = -INFINITY;
#pragma unroll
            for (int j = 0; j < 4; ++j) { const float x = sel[gi * 4 + j]; if (x > m1) { m2 = m1; m1 = x; } else if (x > m2) m2 = x; }
            const float sc = m1 + m2; if (sc > gsc) { gsc = sc; gbest = gi; } }
        float sg[4], sgs[4];
#pragma unroll
        for (int j = 0; j < 4; ++j) { sg[j] = gbest == 0 ? sel[j] : (gbest == 1 ? sel[4 + j] : (gbest == 2 ? sel[8 + j] : sel[12 + j])); sgs[j] = gbest == 0 ? s[j] : (gbest == 1 ? s[4 + j] : (gbest == 2 ? s[8 + j] : s[12 + j])); }
        int j1 = 0;
#pragma unroll
        for (int j = 1; j < 4; ++j) if (sg[j] > sg[j1]) j1 = j;
        int j2 = j1 == 0 ? 1 : 0;
#pragma unroll
        for (int j = 0; j < 4; ++j) if (j != j1 && j != j2 && sg[j] > sg[j2]) j2 = j;
        const int ja = j1 < j2 ? j1 : j2, jb = j1 < j2 ? j2 : j1;
        float sa_ = 0.f, sb_ = 0.f;
#pragma unroll
        for (int j = 0; j < 4; ++j) { if (j == ja) sa_ = sgs[j]; if (j == jb) sb_ = sgs[j]; }
        const float inv = 1.0f / (sa_ + sb_);
        const int cls = gbest * 6 + pair_index(ja, jb);
        if (lane == 0) { const unsigned slot = atomicAdd(cls_cnt + cls, 1u); lists[(size_t)cls * T + slot] = r; gl[r] = (f32x2){sa_ * inv, sb_ * inv}; }
    }
}

struct ClsTab { int cnt[24]; int tile0[25]; int row0[24]; };
__device__ __forceinline__ void build_cls_table(const Params& p, int l, int* tab  ) {
    if (otid() == 0) { const unsigned* c = (const unsigned*)(p.ws + WS_CTL) + CW_CLS + l * 32; int acc = 0;
        for (int i = 0; i < 24; ++i) { const int n = (int)__hip_atomic_load(c + i, __ATOMIC_RELAXED, __HIP_MEMORY_SCOPE_AGENT); tab[i] = n; tab[24 + i] = acc; acc += (n + 255) >> 8; }
        tab[48] = acc; }
    __syncthreads();
}
__device__ __forceinline__ int find_cls(const int* tab, int tile) { int c = 0;
#pragma unroll 1
    for (int i = 1; i < 24; ++i) if (tile >= tab[24 + i]) c = i;
    return c; }
__device__ __forceinline__ void moe_a_phase(const Params& p, int l, LAS unsigned char* lds, const int* tab) {
    const int tid = otid();
    unsigned voffB[2]; g8::make_voffB(voffB, D * 2, true);
    const int ntiles = tab[48], nunits = ntiles * 8;
    for (int u = obid(); u < nunits; u += gridDim.x) {
        const int tile = u >> 3, pn = u & 7, cls = find_cls(tab, tile), rt = tile - tab[24 + cls], n = tab[cls];
        int ja, jb; pair_of(cls % 6, ja, jb); const int eslot = pn >> 2, e = (cls / 6) * 4 + (eslot ? jb : ja), jblk = pn & 3;
        unsigned voffA[2][2]; { const int* lists = (const int*)(PP().ws + WS_LIST);
#pragma unroll
        for (int i = 0; i < 2; ++i) { int R, C; g8::stage_rc(tid * 16 + i * 8192, R, C);
#pragma unroll
            for (int hh = 0; hh < 2; ++hh) { const int li = rt * 256 + R + hh * 128; const int tok = li < n ? lists[(size_t)cls * T + li] : 0;
                voffA[hh][i] = (unsigned)tok * (D * 2) + (unsigned)C * 2u; } } }
        g8::Acc acc; g8::zero_acc(acc);
        const char* Bb = (const char*)(PP().ws + WS_WEXP) + ((size_t)e * 1024 + jblk * 256) * D * 2;
        const g8::KSeg s = g8::seg1((const char*)(PP().ws + WS_HB), Bb, Bb + (size_t)128 * D * 2, D / 64);
        g8::kloop<true, false>(lds, acc, s, voffA, voffB, 0);
        EPI_COORDS();
        const int* lists = (const int*)(PP().ws + WS_LIST); const f32x2* gl = (const f32x2*)(PP().ws + WS_LIST + 2 * MiB); bf16_t* ACT = (bf16_t*)(PP().ws + WS_ACT);
#pragma unroll
        for (int ai = 0; ai < 2; ++ai)
#pragma unroll
            for (int m = 0; m < 4; ++m) { asm volatile("" ::: "memory"); const int li = rt * 256 + ai * 128 + wr * 64 + m * 16 + fr; const int tok = li < n ? lists[(size_t)cls * T + li] : -1;
                float gate = 0.f; if (tok >= 0) { const f32x2 g2 = gl[tok]; gate = eslot ? g2[1] : g2[0]; }
                const f32x4 h1a = acc[ai][0][m][0], h1b = acc[ai][0][m][1], h3a = acc[ai][1][m][0], h3b = acc[ai][1][m][1];
                float o[8];
#pragma unroll
                for (int c = 0; c < 4; ++c) { o[c] = gate * (h1a[c] * sigmoidf_(h1a[c])) * h3a[c]; o[4 + c] = gate * (h1b[c] * sigmoidf_(h1b[c])) * h3b[c]; }
                u32x4 w; w.x = pk2(o[0], o[1]); w.y = pk2(o[2], o[3]); w.z = pk2(o[4], o[5]); w.w = pk2(o[6], o[7]);
                *(u32x4*)(ACT + (size_t)(tile * 256 + ai * 128 + wr * 64 + m * 16 + fr) * D + eslot * 512 + jblk * 128 + wc * 32 + 8 * fq) = w; }
    }
}
__device__ __forceinline__ void moe_b_phase(const Params& p, int l, LAS unsigned char* lds, const int* tab) {
    unsigned voffA[2][2], voffB[2]; g8::make_voff_contig(voffA, D * 2); g8::make_voffB(voffB, 512 * 2, false);
    const int ntiles = tab[48], nunits = ntiles * 4;
    for (int u = obid(); u < nunits; u += gridDim.x) {
        const int tile = u >> 2, pn = u & 3, cls = find_cls(tab, tile), rt = tile - tab[24 + cls], n = tab[cls];
        int ja, jb; pair_of(cls % 6, ja, jb); const int ea = (cls / 6) * 4 + ja, eb = (cls / 6) * 4 + jb;
        g8::Acc acc; g8::zero_acc(acc);
        const char* At = (const char*)(PP().ws + WS_ACT) + (size_t)tile * 256 * D * 2;
        const char* W2 = (const char*)(PP().ws + WS_WEXP + 32 * MiB);
        const char* Ba = W2 + ((size_t)ea * 1024 + pn * 256) * 512 * 2; const char* Bb = W2 + ((size_t)eb * 1024 + pn * 256) * 512 * 2;
        g8::KSeg s2 = g8::seg1(At, Ba, Ba + (size_t)128 * 512 * 2, 16); s2.nt0 = 8; s2.A2 = At + 1024; s2.B02 = Bb; s2.B12 = Bb + (size_t)128 * 512 * 2;
        g8::kloop<false, true>(lds, acc, s2, voffA, voffB, 128 * D * 2);
        EPI_COORDS();
        const int* lists = (const int*)(PP().ws + WS_LIST);
        const int col0 = pn * 256 + wc * 32 + 4 * fq;
        int tk[2][4];
#pragma unroll
        for (int ai = 0; ai < 2; ++ai)
#pragma unroll
            for (int m = 0; m < 4; ++m) { const int li = rt * 256 + ai * 128 + wr * 64 + m * 16 + fr; tk[ai][m] = li < n ? lists[(size_t)cls * T + li] : -1; }
#pragma unroll
        for (int ai = 0; ai < 2; ++ai) { asm volatile("" ::: "memory");
            f32x4 pre[4][2][2]; float* hr[4];
#pragma unroll
            for (int m = 0; m < 4; ++m) { hr[m] = hrow(PP(), tk[ai][m] >= 0 ? tk[ai][m] : 0) + col0;
#pragma unroll
                for (int bj = 0; bj < 2; ++bj)
#pragma unroll
                    for (int nn = 0; nn < 2; ++nn) pre[m][bj][nn] = *(const f32x4*)(hr[m] + bj * 128 + nn * 16); }
#pragma unroll
            for (int m = 0; m < 4; ++m) if (tk[ai][m] >= 0) {
#pragma unroll
                for (int bj = 0; bj < 2; ++bj)
#pragma unroll
                    for (int nn = 0; nn < 2; ++nn) *(f32x4*)(hr[m] + bj * 128 + nn * 16) = pre[m][bj][nn] * ALPHA + acc[ai][bj][m][nn]; } }
    }
}
__device__ __forceinline__ void ln2_phase(const Params& p, int l) {
    const int tid = otid(), lane = tid & 63, gw = obid() * NWAVES + (tid >> 6), NGW = gridDim.x * NWAVES;
    const float* g = p.in[I_LN2G] + l * D; const float* bt = p.in[I_LN2B] + l * D;
    for (int r = gw; r < T; r += NGW) {
        f32x4 v[4];
        if (is_dummy(r)) {
#pragma unroll
            for (int j = 0; j < 4; ++j) v[j] = (f32x4){0.f, 0.f, 0.f, 0.f};
            store_row(p, r, v, lane, true); continue; }
        const float* hr = hrow(p, r);
#pragma unroll
        for (int j = 0; j < 4; ++j) v[j] = *(const f32x4*)(hr + 4 * lane + 256 * j);
        ln_wave(v, g, bt, lane);
        store_row(p, r, v, lane, false);
    }
}


#define XB_TMO      128
#define XB_XCNT(j)  (256  + 64 * (j))
#define XB_XSUB(j)  (1280 + 64 * (j))
#define XB_XGEN(j)  (2304 + 64 * (j))
#define XB_TOP      3328
#define XB_TOPGEN   3392
#define XCD_BAR_WORDS 3456
#define XB_SPIN_CAP (1u << 22)
constexpr size_t WS_BAR = 8192;
constexpr int LDS_BARST = LDS_BYTES - 16;
__device__ __forceinline__ unsigned xb_ld(unsigned* p)              { return __hip_atomic_load(p, __ATOMIC_RELAXED, __HIP_MEMORY_SCOPE_AGENT); }
__device__ __forceinline__ unsigned xb_add(unsigned* p, unsigned v) { return __hip_atomic_fetch_add(p, v, __ATOMIC_RELAXED, __HIP_MEMORY_SCOPE_AGENT); }
__device__ __forceinline__ unsigned xb_xcc_id() { return (unsigned)__builtin_amdgcn_s_getreg((3 << 11) | 20) & 0xFu; }
#define XB_SPIN(cond, bar) do { unsigned _sp = 0; while (cond) { __builtin_amdgcn_s_sleep(1); \
    if ((++_sp & 255u) == 0u) { if (xb_ld(&(bar)[XB_TMO])) break; if (_sp > XB_SPIN_CAP) { atomicAdd(&(bar)[XB_TMO], 1u); break; } } } } while (0)
__device__ __forceinline__ void xcd_barrier_complete(unsigned* bar, unsigned x, unsigned& nloc, unsigned& nx) {
    const unsigned G = gridDim.x * gridDim.y * gridDim.z;
    unsigned sum, cnt, mine, sp = 0u;
    for (;;) {
        sum = 0u; cnt = 0u; mine = 0u;
#pragma unroll
        for (unsigned j = 0; j < 16; ++j) { const unsigned c = xb_ld(&bar[XB_XCNT(j)]); sum += c; cnt += (c > 0u) ? 1u : 0u; mine = (j == x) ? c : mine; }
        if (sum == G) break;
        __builtin_amdgcn_s_sleep(1);
        if ((++sp & 255u) == 0u) { if (xb_ld(&bar[XB_TMO])) break; if (sp > XB_SPIN_CAP) { atomicAdd(&bar[XB_TMO], 1u); break; } }
    }
    nloc = mine > 0u ? mine : 1u; nx = cnt > 0u ? cnt : 1u;
}
__device__ __forceinline__ void xcd_barrier(unsigned* bar, volatile LAS unsigned* st) {
    asm volatile("s_waitcnt vmcnt(0)" ::: "memory");
    __syncthreads();
    if (threadIdx.x == 0) {
        __builtin_amdgcn_s_waitcnt(0);
        const unsigned x = xb_xcc_id();
        unsigned nloc = st[0], nx = st[1];
        if (nloc == 0u) { xcd_barrier_complete(bar, x, nloc, nx); st[0] = nloc; st[1] = nx; }
        const unsigned old = xb_add(&bar[XB_XSUB(x)], 1u);
        const unsigned gen = old / nloc;
        if (old + 1u == (gen + 1u) * nloc) {
            __builtin_amdgcn_fence(__ATOMIC_RELEASE, "agent");
            asm volatile("s_waitcnt vmcnt(0)" ::: "memory");
            const unsigned og = xb_add(&bar[XB_TOP], 1u);
            const unsigned tg = og / nx;
            if (og + 1u == (tg + 1u) * nx) xb_add(&bar[XB_TOPGEN], 1u);
            else XB_SPIN(xb_ld(&bar[XB_TOPGEN]) == tg, bar);
            __builtin_amdgcn_fence(__ATOMIC_ACQUIRE, "agent");
            xb_add(&bar[XB_XGEN(x)], 1u);
            asm volatile("s_waitcnt vmcnt(0)" ::: "memory");
        } else {
            XB_SPIN(xb_ld(&bar[XB_XGEN(x)]) == gen, bar);
            __builtin_amdgcn_fence(__ATOMIC_ACQUIRE, "agent");
            asm volatile("s_waitcnt vmcnt(0)" ::: "memory");
        }
    }
    __syncthreads();
}

__global__ void __launch_bounds__(NTHREADS, 2) mega(Params p_unused) {
    extern __shared__ __attribute__((aligned(16))) unsigned char lds[];
    cg::grid_group grid = cg::this_grid();
    volatile LAS unsigned* barst = (volatile LAS unsigned*)((LAS unsigned char*)lds + LDS_BARST);
    { unsigned* bar0 = (unsigned*)(PP().ws + WS_BAR);
      if (threadIdx.x == 0) { barst[0] = 0u; barst[1] = 0u; (void)xb_add(bar0 + XB_XCNT(xb_xcc_id()), 1u); } }
    __syncthreads();
#define GBAR() xcd_barrier((unsigned*)(PP().ws + WS_BAR), barst)
    unsigned long long pr_t0 = 0, pr_acc = 0;
#define PH_BEGIN(k) do { if (PROBE_PHASE == (k)) pr_t0 = __builtin_amdgcn_s_memrealtime(); } while (0)
#define PH_END(k) do { if (PROBE_PHASE == (k)) pr_acc += __builtin_amdgcn_s_memrealtime() - pr_t0; } while (0)
#define LDSG() (lds + ozero())
#define LDSL() ((LAS unsigned char*)lds)

    PH_BEGIN(0);
    conv_small_weights(PP(), LDSL());
    ln_in_phase(PP());
    grid.sync();
    PH_END(0);
#pragma unroll 1
    for (int l = 0; l < DEPTH; ++l) {
        PH_BEGIN(1);
        inproj_phase(PP(), l, LDSL());
        GBAR();
        PH_END(1); PH_BEGIN(2);
        if (PROBE_PHASE == 30) pr_t0 = __builtin_amdgcn_s_memrealtime();
        {
            unsigned* qctr = (unsigned*)(PP().ws + WS_CTL) + CW_R1Q + 2 * l;
            volatile int* uw = (volatile int*)(LDSG() + AT_UNIT);
            int ndone = 0;
            for (;;) {
                __syncthreads();
                if (otid() == 0) *uw = (int)atomicAdd(qctr, 1u);
                __syncthreads();
                const int u = *uw;
                if (u >= BATCH * NCH * 8) break;
                rwkv_prep_unit(PP(), l, u, LDSG(), pr_acc); ++ndone;
            }
            asm volatile("s_waitcnt vmcnt(0)" ::: "memory");
            __syncthreads();
            if (otid() == 0 && ndone > 0) { __builtin_amdgcn_fence(__ATOMIC_RELEASE, "agent"); asm volatile("s_waitcnt vmcnt(0)" ::: "memory"); __hip_atomic_fetch_add(qctr + 1, (unsigned)ndone, __ATOMIC_RELAXED, __HIP_MEMORY_SCOPE_AGENT); }
            const int bid = obid();
            if (bid < 32) {
                if (otid() == 0) { unsigned sp = 0; while (__hip_atomic_load(qctr + 1, __ATOMIC_RELAXED, __HIP_MEMORY_SCOPE_AGENT) < (unsigned)(BATCH * NCH * 8) && ++sp < (1u << 26)) __builtin_amdgcn_s_sleep(4);
                    __builtin_amdgcn_fence(__ATOMIC_ACQUIRE, "agent"); asm volatile("s_waitcnt vmcnt(0)" ::: "memory"); }
                __syncthreads();
                rwkv_scan(PP(), l, bid, LDSG());
            }
            attn_phase(PP(), l, LDSG());
        }
        GBAR();
        PH_END(3); PH_BEGIN(4);
        merge_phase(PP(), l, LDSL());
        GBAR();
        PH_END(4); PH_BEGIN(5);
        wout_phase(PP(), l, LDSL());
        conv_expert_weights(PP(), l, LDSL());
        GBAR();
        PH_END(5); PH_BEGIN(6);
        ln1_router_phase(PP(), l, LDSG());
        GBAR();
        PH_END(6); PH_BEGIN(7);
        { int toff = 140 * 1024; asm volatile("" : "+s"(toff)); int* tab = (int*)(lds + toff);
          build_cls_table(PP(), l, tab);
          moe_a_phase(PP(), l, LDSL(), tab);
          GBAR();
          PH_END(7); PH_BEGIN(8);
          moe_b_phase(PP(), l, LDSL(), tab); }
        GBAR();
        PH_END(8); PH_BEGIN(9);
        ln2_phase(PP(), l);
        if (l + 1 < DEPTH) GBAR();
        PH_END(9);
    }
    if (PROBE_PHASE >= 0 && blockIdx.x == PROBE_BLOCK && threadIdx.x == 0) { const unsigned long long t = __builtin_amdgcn_s_memrealtime(); while (__builtin_amdgcn_s_memrealtime() - t < pr_acc) __builtin_amdgcn_s_sleep(8); }
}

extern "C" void kernel_launch(void* const* d_in, const int* in_sizes, int n_in, void* d_out, int out_size,
                              void* d_ws, size_t ws_size, hipStream_t stream) {
    static int grid_blocks = 0;
    if (grid_blocks == 0) {
        int dev = 0, cus = 0, per_cu = 0;
        if (n_in != 29 || ws_size < WS_END || out_size != BATCH * SEQ * D) { fprintf(stderr, "kernel_launch: unexpected problem (n_in %d, ws %zu, out %d)\n", n_in, ws_size, out_size); grid_blocks = -1; return; }
        (void)hipGetDevice(&dev);
        (void)hipDeviceGetAttribute(&cus, hipDeviceAttributeMultiprocessorCount, dev);
        (void)hipFuncSetAttribute((const void*)mega, hipFuncAttributeMaxDynamicSharedMemorySize, LDS_BYTES);
        (void)hipOccupancyMaxActiveBlocksPerMultiprocessor(&per_cu, (const void*)mega, NTHREADS, LDS_BYTES);
        if (per_cu < 1) { fprintf(stderr, "occupancy query returned %d\n", per_cu); grid_blocks = -1; return; }
        grid_blocks = cus;
    }
    if (grid_blocks < 0) return;
    (void)hipMemsetAsync((char*)d_ws + WS_CTL, 0, 32768, stream);
    Params p{};
    for (int i = 0; i < 29; ++i) p.in[i] = (const float*)d_in[i];
    p.out = (float*)d_out; p.ws = (unsigned char*)d_ws;
    void* args[] = {&p};
    hipError_t e = hipLaunchCooperativeKernel((const void*)mega, dim3(grid_blocks), dim3(NTHREADS), args, LDS_BYTES, stream);
    if (e != hipSuccess) fprintf(stderr, "cooperative launch failed: %s (grid %d)\n", hipGetErrorString(e), grid_blocks);
}
```

```cpp
#include <hip/hip_runtime.h>
#include <hip/hip_cooperative_groups.h>
#include <cstdio>
#include <cstdint>
namespace cg = cooperative_groups;

#define LAS __attribute__((address_space(3)))
typedef unsigned short bf16_t;
typedef short bf16x8 __attribute__((ext_vector_type(8)));
typedef float f32x4 __attribute__((ext_vector_type(4)));
typedef float f32x2 __attribute__((ext_vector_type(2)));
typedef unsigned u32x4 __attribute__((ext_vector_type(4)));
typedef unsigned u32x2 __attribute__((ext_vector_type(2)));

constexpr int NTHREADS = 512, NWAVES = 8;
constexpr int D = 1024, BATCH = 4, SEQ = 4096, DEPTH = 2;
constexpr int LP = 4160;
constexpr int T = BATCH * LP;
constexpr int NCH = LP / 64;
constexpr int PADM = 48;
constexpr int A_COLS = 1064, R_COLS = 1792, IN_COLS = 4904;
constexpr int UA = 1280;
constexpr int UARW = 3072;
constexpr int NIN = 5120;
constexpr float LN_EPS = 1e-5f, GN_EPS = 64e-5f;
constexpr float ALPHA = 1.41421356237309515f;
constexpr int C_Q = 0, C_K = 512, C_V = 640, C_QI = 768, C_KI = 1024, C_WI = 1056;
constexpr int C_R = UA, C_RK = UA + 512, C_RV = UA + 1024, C_XW = UA + 1536, C_XA = UA + 1600, C_XG = UA + 1664;

constexpr size_t MiB = 1u << 20;
constexpr size_t WS_CTL = 0;
constexpr size_t WS_HM = 1 * MiB;
constexpr size_t WS_WSMALL = 2 * MiB;
constexpr size_t WSMALL_LAYER = 14 * MiB;
constexpr size_t WS_HB = 30 * MiB;
constexpr size_t WS_UAR = 63 * MiB;
constexpr size_t WS_GATES = 161 * MiB;
constexpr size_t WS_OAB = 226 * MiB;
constexpr size_t WS_LIST = WS_GATES + 48 * MiB;
constexpr size_t WS_END = 308 * MiB;
constexpr size_t WS_MERGED = WS_UAR;
constexpr size_t WS_ACT = WS_UAR + 33 * MiB;
constexpr size_t WS_WEXP = WS_GATES;
constexpr int ACT_ROWS_MAX = 16448 + 24 * 256;
static_assert(WS_ACT + (size_t)ACT_ROWS_MAX * 2048 <= WS_GATES, "act fits");
constexpr int CW_CLS = 1024;

constexpr int LDS_BYTES = 155648;

struct Params {
    const float* in[29];
    float* out;
    unsigned char* ws;
};
enum { I_X = 0, I_META, I_LNIN_G, I_LNIN_B, I_WIN, I_BGATE, I_MU, I_W0, I_WUP, I_A0, I_AUP, I_GUP, I_KK, I_KA, I_RK, I_GNG, I_GNB,
       I_WBA, I_WBB, I_WOUT, I_LN1G, I_LN1B, I_LN2G, I_LN2B, I_WROUTER, I_BROUTER, I_WEXP1, I_WEXP3, I_WEXP2 };

__device__ __forceinline__ int otid() { int t = threadIdx.x; asm volatile("" : "+v"(t)); return t; }
__device__ __forceinline__ const char* uptr(const char* p) { const unsigned long long v = (unsigned long long)p; const unsigned lo = __builtin_amdgcn_readfirstlane((unsigned)v), hi = __builtin_amdgcn_readfirstlane((unsigned)(v >> 32)); return (const char*)(((unsigned long long)hi << 32) | lo); }
__device__ __forceinline__ int ozero() { int z = 0; asm volatile("" : "+s"(z)); return z; }
__device__ __forceinline__ int obid() { int b = blockIdx.x; asm volatile("" : "+s"(b)); return b; }
typedef __bf16 bf16x2_t __attribute__((ext_vector_type(2)));
__device__ __forceinline__ unsigned f2bf(float f) { return (unsigned)__builtin_bit_cast(unsigned short, (__bf16)f); }
__device__ __forceinline__ unsigned pk2(float lo, float hi) { const f32x2 v = {lo, hi}; return __builtin_bit_cast(unsigned, __builtin_convertvector(v, bf16x2_t)); }
template <int CTRL> __device__ __forceinline__ float dpp_f(float v) { return __builtin_bit_cast(float, __builtin_amdgcn_update_dpp(0, __builtin_bit_cast(int, v), CTRL, 0xF, 0xF, true)); }
__device__ __forceinline__ float sum8(float v) { v += dpp_f<0xB1>(v); v += dpp_f<0x4E>(v); v += dpp_f<0x141>(v); return v; }
__device__ __forceinline__ float sum16(float v) { v = sum8(v); v += dpp_f<0x140>(v); return v; }
__device__ __forceinline__ float bf2f(unsigned short b) { return __builtin_bit_cast(float, (unsigned)b << 16); }
__device__ __forceinline__ float bflo(unsigned w) { return __builtin_bit_cast(float, w << 16); }
__device__ __forceinline__ float bfhi(unsigned w) { return __builtin_bit_cast(float, w & 0xffff0000u); }
__device__ __forceinline__ float wave_sum(float v) { v = sum16(v); v += __shfl_xor(v, 16); v += __shfl_xor(v, 32); return v; }
__device__ __forceinline__ float wave_max(float v) {
#pragma unroll
    for (int o = 1; o < 64; o <<= 1) v = fmaxf(v, __shfl_xor(v, o));
    return v;
}
__device__ __forceinline__ float sigmoidf_(float x) { return 1.0f / (1.0f + __expf(-x)); }
__device__ __forceinline__ float* hrow(const Params& p, int r) {
    const int b = r / LP, pos = r - b * LP;
    return pos >= 64 ? p.out + ((size_t)(b * SEQ + (pos - 64)) << 10) : (float*)(p.ws + WS_HM) + ((size_t)(b * 64 + pos) << 10);
}
__device__ __forceinline__ bool is_dummy(int r) { return (r % LP) < PADM; }

__device__ __forceinline__ void transpose_item(const float* src, int ld_src, int col0, int nvalid, bf16_t* dst  , int ld_dst, LAS float* scr, int lane) {
    const int kr = lane >> 3, c4 = (lane & 7) * 4;
    f32x4 v[8];
#pragma unroll
    for (int i = 0; i < 8; ++i) v[i] = *(const f32x4*)(src + (size_t)(8 * i + kr) * ld_src + col0 + c4);
#pragma unroll
    for (int i = 0; i < 8; ++i) { LAS float* w = scr + (8 * i + kr) * 33 + c4;
        w[0] = c4 + 0 < nvalid ? v[i][0] : 0.f; w[1] = c4 + 1 < nvalid ? v[i][1] : 0.f; w[2] = c4 + 2 < nvalid ? v[i][2] : 0.f; w[3] = c4 + 3 < nvalid ? v[i][3] : 0.f; }
    asm volatile("s_waitcnt lgkmcnt(0)" ::: "memory");
    const int ch = lane & 7;
#pragma unroll
    for (int j = 0; j < 4; ++j) { const int n = (lane >> 3) + 8 * j; const LAS float* s = scr + (8 * ch) * 33 + n;
        u32x4 o; o.x = pk2(s[0 * 33], s[1 * 33]); o.y = pk2(s[2 * 33], s[3 * 33]); o.z = pk2(s[4 * 33], s[5 * 33]); o.w = pk2(s[6 * 33], s[7 * 33]);
        *(u32x4*)(dst + (size_t)n * ld_dst + 8 * ch) = o; }
    asm volatile("s_waitcnt lgkmcnt(0)" ::: "memory");
}

namespace g8 {
constexpr int BM = 256, BK = 64, HALF = 128, HTB = HALF * BK * 2, STAGE_BYTES = 8 * HTB;
__host__ __device__ __forceinline__ int lds_byte(int r, int c) { const int st = (r >> 4) * 2 + (c >> 5), rr = r & 15, cc = c & 31, ob = rr * 64 + cc * 2; return st * 1024 + (ob ^ (((ob >> 9) & 1) << 5)); }
__host__ __device__ __forceinline__ void stage_rc(int b, int& R, int& C) { const int st = b / 1024, sb = b % 1024, swz = sb ^ (((sb >> 9) & 1) << 5); R = (st >> 1) * 16 + swz / 64; C = (st & 1) * 32 + (swz % 64) / 2; }
__host__ __device__ __forceinline__ int perm32(int rho) { const int n = rho >> 4, i = rho & 15; return 8 * (i >> 2) + 4 * n + (i & 3); }

struct KSeg {
    const char* A;
    const char* B0;
    const char* B1;
    int nt;
    int nt0;
    const char* A2;
    const char* B02;
    const char* B12;
};
__device__ __forceinline__ KSeg seg1(const char* A, const char* B0, const char* B1, int nt) { KSeg s; s.A = A; s.B0 = B0; s.B1 = B1; s.nt = nt; s.nt0 = nt; s.A2 = A; s.B02 = B0; s.B12 = B1; return s; }
typedef f32x4 Acc[2][2][4][2];

template <bool GATHER, bool TWOSEG>
__device__ __forceinline__ void kloop(LAS unsigned char* lds, Acc& acc, const KSeg s, const unsigned (&voffA)[2][2], const unsigned (&voffB)[2], const unsigned hstepA) {
    int tid = threadIdx.x; asm volatile("" : "+v"(tid));
    const int wid = __builtin_amdgcn_readfirstlane(tid >> 6), lane = tid & 63, wr = wid >> 2, wc = wid & 3, fr = lane & 15, fq = lane >> 4;
    const unsigned ldsw = (unsigned)wid * 1024u;
    const int aoff = lds_byte(wr * 64 + fr, fq * 8), boff = lds_byte(wc * 32 + fr, fq * 8);
    const int nt = __builtin_amdgcn_readfirstlane(s.nt);
#define G8_SA(b, h) (((b) * 2 + (h)) * HTB)
#define G8_SB(b, h) ((4 + (b) * 2 + (h)) * HTB)
#define G8_STAGE(bufoff, gbase, voff) do { _Pragma("unroll") for (int _i = 0; _i < 2; ++_i) \
        __builtin_amdgcn_global_load_lds((const unsigned*)((const char*)(gbase) + (voff)[_i]), (LAS unsigned*)(lds + (bufoff) + ldsw + _i * 8192), 16, 0, 0); } while (0)
#define G8_LDA(dst, b, h) do { _Pragma("unroll") for (int m = 0; m < 4; ++m) _Pragma("unroll") for (int k = 0; k < 2; ++k) dst[m][k] = *(const LAS bf16x8*)(lds + G8_SA(b, h) + aoff + m * 2048 + k * 1024); } while (0)
#define G8_LDB(dst, b, h) do { _Pragma("unroll") for (int n = 0; n < 2; ++n) _Pragma("unroll") for (int k = 0; k < 2; ++k) dst[n][k] = *(const LAS bf16x8*)(lds + G8_SB(b, h) + boff + n * 2048 + k * 1024); } while (0)
#define G8_MMA(ai, bj, At, Bt) do { __builtin_amdgcn_s_setprio(1); _Pragma("unroll") for (int m = 0; m < 4; ++m) _Pragma("unroll") for (int n = 0; n < 2; ++n) _Pragma("unroll") for (int k = 0; k < 2; ++k) \
        acc[ai][bj][m][n] = __builtin_amdgcn_mfma_f32_16x16x32_bf16(Bt[n][k], At[m][k], acc[ai][bj][m][n], 0, 0, 0); __builtin_amdgcn_s_setprio(0); } while (0)
#define G8_WAIT_V(n) asm volatile("s_waitcnt vmcnt(" #n ")" ::: "memory")
#define G8_WAIT_L(n) asm volatile("s_waitcnt lgkmcnt(" #n ")" ::: "memory")
#define G8_BAR __builtin_amdgcn_s_barrier()
#define G8_SCHED __builtin_amdgcn_sched_barrier(0)
    bf16x8 At[4][2], B0[2][2], B1[2][2];
    const char* pA = uptr(s.A); const char* pB0 = uptr(s.B0); const char* pB1 = uptr(s.B1);
    constexpr int KS = BK * 2;
    const int nt0 = TWOSEG ? s.nt0 : 0; const char* qA = TWOSEG ? uptr(s.A2 - (size_t)nt0 * KS) : pA; const char* qB0 = TWOSEG ? uptr(s.B02 - (size_t)nt0 * KS) : pB0; const char* qB1 = TWOSEG ? uptr(s.B12 - (size_t)nt0 * KS) : pB1;
#define G8_TA(t) ((TWOSEG ? ((t) < nt0 ? pA : qA) : pA) + (size_t)(t) * KS)
#define G8_TB0(t) ((TWOSEG ? ((t) < nt0 ? pB0 : qB0) : pB0) + (size_t)(t) * KS)
#define G8_TB1(t) ((TWOSEG ? ((t) < nt0 ? pB1 : qB1) : pB1) + (size_t)(t) * KS)
#define G8_VA1 voffA[GATHER ? 1 : 0]
#define G8_H1(ptr) ((ptr) + (GATHER ? 0u : hstepA))
    G8_STAGE(G8_SB(0, 0), pB0, voffB); G8_STAGE(G8_SA(0, 0), pA, voffA[0]); G8_STAGE(G8_SB(0, 1), pB1, voffB); G8_STAGE(G8_SA(0, 1), G8_H1(pA), G8_VA1);
    if (wr == 1) G8_BAR;
    G8_WAIT_V(4); G8_BAR;
    G8_STAGE(G8_SB(1, 0), pB0 + KS, voffB); G8_STAGE(G8_SA(1, 0), pA + KS, voffA[0]); G8_STAGE(G8_SB(1, 1), pB1 + KS, voffB);
    G8_WAIT_V(6); G8_BAR;
    for (int t = 0; t < nt - 2; t += 2) {
        const char* a1 = G8_TA(t + 1);
        const char* a2 = G8_TA(t + 2); const char* b02 = G8_TB0(t + 2); const char* b12 = G8_TB1(t + 2);
        const char* a3 = G8_TA(t + 3); const char* b03 = G8_TB0(t + 3); const char* b13 = G8_TB1(t + 3);
        G8_LDB(B0, 0, 0); G8_SCHED; G8_LDA(At, 0, 0); G8_STAGE(G8_SA(1, 1), G8_H1(a1), G8_VA1);
        G8_WAIT_L(8); G8_BAR; G8_WAIT_L(0); G8_MMA(0, 0, At, B0); G8_BAR; G8_SCHED;
        G8_LDB(B1, 0, 1); G8_STAGE(G8_SB(0, 0), b02, voffB);
        G8_BAR; G8_WAIT_L(0); G8_MMA(0, 1, At, B1); G8_BAR;
        G8_LDA(At, 0, 1); G8_STAGE(G8_SA(0, 0), a2, voffA[0]);
        G8_BAR; G8_WAIT_L(0); G8_MMA(1, 0, At, B0); G8_BAR; G8_SCHED;
        G8_STAGE(G8_SB(0, 1), b12, voffB);
        G8_WAIT_V(6); G8_BAR; G8_MMA(1, 1, At, B1); G8_BAR;
        G8_LDB(B0, 1, 0); G8_SCHED; G8_LDA(At, 1, 0); G8_STAGE(G8_SA(0, 1), G8_H1(a2), G8_VA1);
        G8_WAIT_L(8); G8_BAR; G8_WAIT_L(0); G8_MMA(0, 0, At, B0); G8_BAR; G8_SCHED;
        G8_LDB(B1, 1, 1); G8_STAGE(G8_SB(1, 0), b03, voffB);
        G8_BAR; G8_WAIT_L(0); G8_MMA(0, 1, At, B1); G8_BAR;
        G8_LDA(At, 1, 1); G8_STAGE(G8_SA(1, 0), a3, voffA[0]);
        G8_BAR; G8_WAIT_L(0); G8_MMA(1, 0, At, B0); G8_BAR; G8_SCHED;
        G8_STAGE(G8_SB(1, 1), b13, voffB);
        G8_WAIT_V(6); G8_BAR; G8_MMA(1, 1, At, B1); G8_BAR;
    }
    { const char* a1 = G8_TA(nt - 1);
      G8_LDB(B0, 0, 0); G8_LDA(At, 0, 0); G8_STAGE(G8_SA(1, 1), G8_H1(a1), G8_VA1);
      G8_BAR; G8_WAIT_L(0); G8_MMA(0, 0, At, B0); G8_BAR;
      G8_LDB(B1, 0, 1); G8_BAR; G8_WAIT_L(0); G8_MMA(0, 1, At, B1); G8_BAR;
      G8_LDA(At, 0, 1); G8_WAIT_V(4); G8_BAR; G8_WAIT_L(0); G8_MMA(1, 0, At, B0); G8_MMA(1, 1, At, B1); G8_BAR; }
    { G8_LDB(B0, 1, 0); G8_LDA(At, 1, 0); G8_WAIT_V(2); G8_BAR; G8_WAIT_L(0); G8_MMA(0, 0, At, B0); G8_BAR;
      G8_LDB(B1, 1, 1); G8_WAIT_V(0); G8_BAR; G8_WAIT_L(0); G8_MMA(0, 1, At, B1); G8_BAR;
      G8_LDA(At, 1, 1); G8_BAR; G8_WAIT_L(0); G8_MMA(1, 0, At, B0); G8_MMA(1, 1, At, B1); G8_BAR; }
    if (wr == 0) G8_BAR;
#undef G8_TA
#undef G8_VA1
#undef G8_H1
#undef G8_TB0
#undef G8_TB1
#undef G8_SA
#undef G8_SB
#undef G8_STAGE
#undef G8_LDA
#undef G8_LDB
#undef G8_MMA
#undef G8_WAIT_V
#undef G8_WAIT_L
#undef G8_BAR
#undef G8_SCHED
}
template <bool GATHER, bool TWOSEG>
__device__ __forceinline__ void kstream(LAS unsigned char* lds, Acc& acc, const KSeg s, const KSeg nx, const bool first, const unsigned (&voffA)[2][2], const unsigned (&voffB)[2], const unsigned hstepA) {
    int tid = threadIdx.x; asm volatile("" : "+v"(tid));
    const int wid = __builtin_amdgcn_readfirstlane(tid >> 6), lane = tid & 63, wr = wid >> 2, wc = wid & 3, fr = lane & 15, fq = lane >> 4;
    const unsigned ldsw = (unsigned)wid * 1024u;
    const int aoff = lds_byte(wr * 64 + fr, fq * 8), boff = lds_byte(wc * 32 + fr, fq * 8);
    const int nt = __builtin_amdgcn_readfirstlane(s.nt);
#define G8_SA(b, h) (((b) * 2 + (h)) * HTB)
#define G8_SB(b, h) ((4 + (b) * 2 + (h)) * HTB)
#define G8_STAGE(bufoff, gbase, voff) do { _Pragma("unroll") for (int _i = 0; _i < 2; ++_i) \
        __builtin_amdgcn_global_load_lds((const unsigned*)((const char*)(gbase) + (voff)[_i]), (LAS unsigned*)(lds + (bufoff) + ldsw + _i * 8192), 16, 0, 0); } while (0)
#define G8_LDA(dst, b, h) do { _Pragma("unroll") for (int m = 0; m < 4; ++m) _Pragma("unroll") for (int k = 0; k < 2; ++k) dst[m][k] = *(const LAS bf16x8*)(lds + G8_SA(b, h) + aoff + m * 2048 + k * 1024); } while (0)
#define G8_LDB(dst, b, h) do { _Pragma("unroll") for (int n = 0; n < 2; ++n) _Pragma("unroll") for (int k = 0; k < 2; ++k) dst[n][k] = *(const LAS bf16x8*)(lds + G8_SB(b, h) + boff + n * 2048 + k * 1024); } while (0)
#define G8_MMA(ai, bj, At, Bt) do { __builtin_amdgcn_s_setprio(1); _Pragma("unroll") for (int m = 0; m < 4; ++m) _Pragma("unroll") for (int n = 0; n < 2; ++n) _Pragma("unroll") for (int k = 0; k < 2; ++k) \
        acc[ai][bj][m][n] = __builtin_amdgcn_mfma_f32_16x16x32_bf16(Bt[n][k], At[m][k], acc[ai][bj][m][n], 0, 0, 0); __builtin_amdgcn_s_setprio(0); } while (0)
#define G8_WAIT_V(n) asm volatile("s_waitcnt vmcnt(" #n ")" ::: "memory")
#define G8_WAIT_L(n) asm volatile("s_waitcnt lgkmcnt(" #n ")" ::: "memory")
#define G8_BAR __builtin_amdgcn_s_barrier()
#define G8_SCHED __builtin_amdgcn_sched_barrier(0)
    bf16x8 At[4][2], B0[2][2], B1[2][2];
    const char* pA = uptr(s.A); const char* pB0 = uptr(s.B0); const char* pB1 = uptr(s.B1);
    constexpr int KS = BK * 2;
    const int nt0 = TWOSEG ? s.nt0 : 0; const char* qA = TWOSEG ? uptr(s.A2 - (size_t)nt0 * KS) : pA; const char* qB0 = TWOSEG ? uptr(s.B02 - (size_t)nt0 * KS) : pB0; const char* qB1 = TWOSEG ? uptr(s.B12 - (size_t)nt0 * KS) : pB1;
    const char* nA = uptr(nx.A) - (size_t)nt * KS; const char* nB0 = uptr(nx.B0) - (size_t)nt * KS; const char* nB1 = uptr(nx.B1) - (size_t)nt * KS;
#define G8_TA(t) (((t) >= nt ? nA : (TWOSEG ? ((t) < nt0 ? pA : qA) : pA)) + (size_t)(t) * KS)
#define G8_TB0(t) (((t) >= nt ? nB0 : (TWOSEG ? ((t) < nt0 ? pB0 : qB0) : pB0)) + (size_t)(t) * KS)
#define G8_TB1(t) (((t) >= nt ? nB1 : (TWOSEG ? ((t) < nt0 ? pB1 : qB1) : pB1)) + (size_t)(t) * KS)
#define G8_VA1 voffA[GATHER ? 1 : 0]
#define G8_H1(ptr) ((ptr) + (GATHER ? 0u : hstepA))
    if (first) {
    G8_STAGE(G8_SB(0, 0), pB0, voffB); G8_STAGE(G8_SA(0, 0), pA, voffA[0]); G8_STAGE(G8_SB(0, 1), pB1, voffB); G8_STAGE(G8_SA(0, 1), G8_H1(pA), G8_VA1);
    if (wr == 1) G8_BAR;
    G8_WAIT_V(4); G8_BAR;
    G8_STAGE(G8_SB(1, 0), pB0 + KS, voffB); G8_STAGE(G8_SA(1, 0), pA + KS, voffA[0]); G8_STAGE(G8_SB(1, 1), pB1 + KS, voffB);
    G8_WAIT_V(6); G8_BAR;
    }
    for (int t = 0; t < nt; t += 2) {
        const char* a1 = G8_TA(t + 1);
        const char* a2 = G8_TA(t + 2); const char* b02 = G8_TB0(t + 2); const char* b12 = G8_TB1(t + 2);
        const char* a3 = G8_TA(t + 3); const char* b03 = G8_TB0(t + 3); const char* b13 = G8_TB1(t + 3);
        G8_LDB(B0, 0, 0); G8_SCHED; G8_LDA(At, 0, 0); G8_STAGE(G8_SA(1, 1), G8_H1(a1), G8_VA1);
        G8_WAIT_L(8); G8_BAR; G8_WAIT_L(0); G8_MMA(0, 0, At, B0); G8_BAR; G8_SCHED;
        G8_LDB(B1, 0, 1); G8_STAGE(G8_SB(0, 0), b02, voffB);
        G8_BAR; G8_WAIT_L(0); G8_MMA(0, 1, At, B1); G8_BAR;
        G8_LDA(At, 0, 1); G8_STAGE(G8_SA(0, 0), a2, voffA[0]);
        G8_BAR; G8_WAIT_L(0); G8_MMA(1, 0, At, B0); G8_BAR; G8_SCHED;
        G8_STAGE(G8_SB(0, 1), b12, voffB);
        G8_WAIT_V(6); G8_BAR; G8_MMA(1, 1, At, B1); G8_BAR;
        G8_LDB(B0, 1, 0); G8_SCHED; G8_LDA(At, 1, 0); G8_STAGE(G8_SA(0, 1), G8_H1(a2), G8_VA1);
        G8_WAIT_L(8); G8_BAR; G8_WAIT_L(0); G8_MMA(0, 0, At, B0); G8_BAR; G8_SCHED;
        G8_LDB(B1, 1, 1); G8_STAGE(G8_SB(1, 0), b03, voffB);
        G8_BAR; G8_WAIT_L(0); G8_MMA(0, 1, At, B1); G8_BAR;
        G8_LDA(At, 1, 1); G8_STAGE(G8_SA(1, 0), a3, voffA[0]);
        G8_BAR; G8_WAIT_L(0); G8_MMA(1, 0, At, B0); G8_BAR; G8_SCHED;
        G8_STAGE(G8_SB(1, 1), b13, voffB);
        G8_WAIT_V(6); G8_BAR; G8_MMA(1, 1, At, B1); G8_BAR;
    }
#undef G8_TA
#undef G8_VA1
#undef G8_H1
#undef G8_TB0
#undef G8_TB1
#undef G8_SA
#undef G8_SB
#undef G8_STAGE
#undef G8_LDA
#undef G8_LDB
#undef G8_MMA
#undef G8_WAIT_V
#undef G8_WAIT_L
#undef G8_BAR
#undef G8_SCHED
}
__device__ __forceinline__ void kstream_end() { asm volatile("s_waitcnt vmcnt(0)" ::: "memory"); __builtin_amdgcn_s_barrier(); }
__device__ __forceinline__ void zero_acc(Acc& acc) {
#pragma unroll
    for (int a = 0; a < 2; ++a)
#pragma unroll
        for (int b = 0; b < 2; ++b)
#pragma unroll
            for (int m = 0; m < 4; ++m)
#pragma unroll
                for (int n = 0; n < 2; ++n) acc[a][b][m][n] = (f32x4){0.f, 0.f, 0.f, 0.f};
}
__device__ __forceinline__ void make_voff_contig(unsigned (&voffA)[2][2], unsigned pitchA) {
    int tid = threadIdx.x; asm volatile("" : "+v"(tid));
#pragma unroll
    for (int i = 0; i < 2; ++i) { int R, C; stage_rc(tid * 16 + i * 8192, R, C);
        voffA[0][i] = (unsigned)R * pitchA + (unsigned)C * 2u; voffA[1][i] = 0u; }
}
__device__ __forceinline__ void make_voffB(unsigned (&voffB)[2], unsigned pitchB, bool perm) {
    int tid = threadIdx.x; asm volatile("" : "+v"(tid));
#pragma unroll
    for (int i = 0; i < 2; ++i) { int R, C; stage_rc(tid * 16 + i * 8192, R, C); const int Rb = perm ? ((R & ~31) + perm32(R & 31)) : R;
        voffB[i] = (unsigned)Rb * pitchB + (unsigned)C * 2u; }
}
}

__device__ __forceinline__ bool unit_order(int i, int G, int c, int nM, int nN, int& pm, int& pn) {
    const int nwg = nM * nN; const long L = (long)i * G + c; if (L >= nwg) return false;
    int wgid = (int)L; { const int q = nwg / 8, r = nwg % 8, xcd = wgid % 8, off = wgid / 8; wgid = (xcd < r ? xcd * (q + 1) : r * (q + 1) + (xcd - r) * q) + off; }
    const int WGM = 8, nig = WGM * nN, gid = wgid / nig, fm = gid * WGM, gsz = (nM - fm) < WGM ? (nM - fm) : WGM;
    pm = fm + ((wgid % nig) % gsz); pn = (wgid % nig) / gsz; return true;
}

__device__ __forceinline__ void conv_small_weights(const Params& p, LAS unsigned char* lds) {
    const int tid = otid(), lane = tid & 63, wave = tid >> 6, gw = obid() * NWAVES + wave, NGW = gridDim.x * NWAVES;
    LAS float* scr = (LAS float*)(lds + wave * 16384);
    constexpr int I_IN = 16 * (NIN / 32), I_A = 8 * 32, I_O = 16 * 32, I_L = 64, PER = I_IN + 2 * I_A + I_O + I_L;
    for (int it = gw; it < DEPTH * PER; it += NGW) {
        const int l = it / PER; int r = it % PER;
        unsigned char* wl = p.ws + WS_WSMALL + (size_t)l * WSMALL_LAYER;
        if (r < I_IN) { const int kb = r / (NIN / 32), nb = r % (NIN / 32), n0 = nb * 32, k0 = kb * 64;
            int col0, nvalid; if (n0 < UA) { col0 = n0; nvalid = A_COLS - n0; nvalid = nvalid < 0 ? 0 : (nvalid > 32 ? 32 : nvalid); } else { col0 = n0 - (UA - A_COLS); nvalid = 32; }
            transpose_item(p.in[I_WIN] + (size_t)l * D * IN_COLS + (size_t)k0 * IN_COLS, IN_COLS, col0, nvalid, (bf16_t*)wl + (size_t)n0 * D + k0, D, scr, lane); continue; }
        r -= I_IN;
        if (r < 2 * I_A) { const int which = r / I_A; r %= I_A; const int kb = r / 32, nb = r % 32;
            const float* src = p.in[which ? I_WBB : I_WBA] + (size_t)l * 512 * D + (size_t)(kb * 64) * D;
            transpose_item(src, D, nb * 32, 32, (bf16_t*)(wl + (10 + which) * MiB) + (size_t)(nb * 32) * 512 + kb * 64, 512, scr, lane); continue; }
        r -= 2 * I_A;
        if (r < I_O) { const int kb = r / 32, nb = r % 32;
          transpose_item(p.in[I_WOUT] + (size_t)l * D * D + (size_t)(kb * 64) * D, D, nb * 32, 32, (bf16_t*)(wl + 12 * MiB) + (size_t)(nb * 32) * D + kb * 64, D, scr, lane); continue; }
        r -= I_O;
        { bf16_t* lo = (bf16_t*)(p.ws + 65536 + (size_t)l * 262144);
          if (r < 16) transpose_item(p.in[I_WUP] + (size_t)l * 64 * 512, 512, r * 32, 32, lo + (size_t)(r * 32) * 64, 64, scr, lane);
          else if (r < 32) transpose_item(p.in[I_AUP] + (size_t)l * 64 * 512, 512, (r - 16) * 32, 32, lo + 32768 + (size_t)((r - 16) * 32) * 64, 64, scr, lane);
          else { const int q = r - 32, kb = q >> 4, nb = q & 15; transpose_item(p.in[I_GUP] + (size_t)l * 128 * 512 + (size_t)(kb * 64) * 512, 512, nb * 32, 32, lo + 65536 + (size_t)(nb * 32) * 128 + kb * 64, 128, scr, lane); } }
    }
}
__device__ __forceinline__ void conv_expert_weights(const Params& p, int l, LAS unsigned char* lds) {
    const int tid = otid(), lane = tid & 63, wave = tid >> 6, gw = obid() * NWAVES + wave, NGW = gridDim.x * NWAVES;
    LAS float* scr = (LAS float*)(lds + wave * 16384);
    constexpr int I_13 = 16 * 32, I_2 = 8 * 32, PER = I_13 + I_2;
    for (int it = gw; it < 16 * PER; it += NGW) {
        const int e = it / PER; int r = it % PER;
        if (r < I_13) { const int kb = r / 32, nb = r % 32, n0 = nb * 32, j = n0 >> 8, half = (n0 >> 7) & 1, c = 128 * j + (n0 & 127);
            const float* src = p.in[half ? I_WEXP3 : I_WEXP1] + (size_t)(l * 16 + e) * D * 512 + (size_t)(kb * 64) * 512;
            transpose_item(src, 512, c, 32, (bf16_t*)(p.ws + WS_WEXP) + (size_t)e * 1024 * 1024 + (size_t)n0 * 1024 + kb * 64, 1024, scr, lane); continue; }
        r -= I_13;
        { const int kb = r / 32, nb = r % 32;
          const float* src = p.in[I_WEXP2] + (size_t)(l * 16 + e) * 512 * D + (size_t)(kb * 64) * D;
          transpose_item(src, D, nb * 32, 32, (bf16_t*)(p.ws + WS_WEXP + 32 * MiB) + (size_t)e * 1024 * 512 + (size_t)(nb * 32) * 512 + kb * 64, 512, scr, lane); }
    }
}

__device__ __forceinline__ void ln_wave(f32x4 (&v)[4], const float* g, const float* bta, int lane) {
    float s = 0.f;
#pragma unroll
    for (int j = 0; j < 4; ++j) s += (v[j][0] + v[j][1]) + (v[j][2] + v[j][3]);
    const float mean = wave_sum(s) * (1.f / D); float s2 = 0.f;
#pragma unroll
    for (int j = 0; j < 4; ++j) { v[j] = v[j] - mean; s2 += (v[j][0] * v[j][0] + v[j][1] * v[j][1]) + (v[j][2] * v[j][2] + v[j][3] * v[j][3]); }
    const float rstd = 1.f / sqrtf(wave_sum(s2) * (1.f / D) + LN_EPS);
#pragma unroll
    for (int j = 0; j < 4; ++j) { const f32x4 gg = *(const f32x4*)(g + 4 * lane + 256 * j), bb = *(const f32x4*)(bta + 4 * lane + 256 * j); v[j] = v[j] * rstd * gg + bb; }
}
__device__ __forceinline__ void store_row(const Params& p, int r, const f32x4 (&v)[4], int lane, bool zero) {
    float* hr = hrow(p, r); bf16_t* hb = (bf16_t*)(p.ws + WS_HB) + (size_t)r * D;
#pragma unroll
    for (int j = 0; j < 4; ++j) { const f32x4 o = zero ? (f32x4){0.f, 0.f, 0.f, 0.f} : v[j];
        *(f32x4*)(hr + 4 * lane + 256 * j) = o; u32x2 w; w.x = pk2(o[0], o[1]); w.y = pk2(o[2], o[3]); *(u32x2*)(hb + 4 * lane + 256 * j) = w; }
}
__device__ __forceinline__ void ln_in_phase(const Params& p) {
    const int tid = otid(), lane = tid & 63, gw = obid() * NWAVES + (tid >> 6), NGW = gridDim.x * NWAVES;
    for (int r = gw; r < T; r += NGW) {
        const int b = r / LP, pos = r - b * LP; f32x4 v[4];
        if (pos < PADM) {
#pragma unroll
            for (int j = 0; j < 4; ++j) v[j] = (f32x4){0.f, 0.f, 0.f, 0.f};
            store_row(p, r, v, lane, true); continue; }
        const float* src = pos < 64 ? p.in[I_META] + (size_t)(pos - PADM) * D : p.in[I_X] + ((size_t)(b * SEQ + pos - 64) << 10);
#pragma unroll
        for (int j = 0; j < 4; ++j) v[j] = *(const f32x4*)(src + 4 * lane + 256 * j);
        ln_wave(v, p.in[I_LNIN_G], p.in[I_LNIN_B], lane);
        store_row(p, r, v, lane, false);
    }
}

__device__ __forceinline__ const Params& PP() { const Params* q = (const Params*)__builtin_amdgcn_kernarg_segment_ptr(); asm volatile("" : "+s"(q)); return *q; }

#define EPI_COORDS() int tid_ = threadIdx.x; asm volatile("" : "+v"(tid_)); const int wid = tid_ >> 6, lane = tid_ & 63, wr = wid >> 2, wc = wid & 3, fr = lane & 15, fq = lane >> 4; (void)wr; (void)wc; (void)fr; (void)fq
__device__ __forceinline__ void inproj_phase(const Params& p, int l, LAS unsigned char* lds) {
    unsigned voffA[2][2], voffB[2]; g8::make_voff_contig(voffA, D * 2); g8::make_voffB(voffB, D * 2, true);
    int pm, pn, pm2 = 0, pn2 = 0; const int bid = obid(); const int wr_ = __builtin_amdgcn_readfirstlane(otid() >> 6) >> 2;
    bool has = unit_order(0, gridDim.x, bid, T / 256, NIN / 256, pm, pn), first = true;
    g8::Acc acc; g8::zero_acc(acc);
    for (int i = 0; has; ++i) {
        const bool hasn = unit_order(i + 1, gridDim.x, bid, T / 256, NIN / 256, pm2, pn2);
        const char* Ab = (const char*)(PP().ws + WS_HB); const char* Bb = (const char*)(PP().ws + WS_WSMALL + (size_t)l * WSMALL_LAYER);
        const g8::KSeg s = g8::seg1(Ab + (size_t)pm * 256 * D * 2, Bb + (size_t)pn * 256 * D * 2, Bb + (size_t)(pn * 256 + 128) * D * 2, D / 64);
        const int pmn = hasn ? pm2 : pm, pnn = hasn ? pn2 : pn;
        const g8::KSeg nx = g8::seg1(Ab + (size_t)pmn * 256 * D * 2, Bb + (size_t)pnn * 256 * D * 2, Bb + (size_t)(pnn * 256 + 128) * D * 2, D / 64);
        if (!first && wr_ == 1) __builtin_amdgcn_s_barrier();
        g8::kstream<false, false>(lds, acc, s, nx, first, voffA, voffB, 128 * D * 2); first = false;
        if (wr_ == 0) __builtin_amdgcn_s_barrier();
        EPI_COORDS();
        const int row0 = pm * 256 + wr * 64 + fr;
        if (pn < 12) {
            bf16_t* O = (bf16_t*)(PP().ws + WS_UAR);
#pragma unroll
            for (int ai = 0; ai < 2; ++ai)
#pragma unroll
                for (int m = 0; m < 4; ++m) { asm volatile("" ::: "memory"); bf16_t* rp = O + (size_t)(row0 + ai * 128 + m * 16) * UARW + pn * 256 + wc * 32 + 8 * fq;
#pragma unroll
                    for (int bj = 0; bj < 2; ++bj) { const f32x4 v0 = acc[ai][bj][m][0], v1 = acc[ai][bj][m][1]; u32x4 w; w.x = pk2(v0[0], v0[1]); w.y = pk2(v0[2], v0[3]); w.z = pk2(v1[0], v1[1]); w.w = pk2(v1[2], v1[3]);
                        *(u32x4*)(rp + bj * 128) = w; } }
        } else {
            bf16_t* O = (bf16_t*)(PP().ws + WS_GATES); const int colb = (pn - 12) * 256 + wc * 32 + 8 * fq; const float* bg = PP().in[I_BGATE] + l * 2048;
            f32x4 bv[2][2];
#pragma unroll
            for (int bj = 0; bj < 2; ++bj) { bv[bj][0] = *(const f32x4*)(bg + colb + bj * 128); bv[bj][1] = *(const f32x4*)(bg + colb + bj * 128 + 4); }
#pragma unroll
            for (int ai = 0; ai < 2; ++ai)
#pragma unroll
                for (int m = 0; m < 4; ++m) { asm volatile("" ::: "memory"); bf16_t* rp = O + (size_t)(row0 + ai * 128 + m * 16) * 2048 + colb;
#pragma unroll
                    for (int bj = 0; bj < 2; ++bj) { f32x4 v0 = acc[ai][bj][m][0] + bv[bj][0], v1 = acc[ai][bj][m][1] + bv[bj][1];
#pragma unroll
                        for (int e = 0; e < 4; ++e) { v0[e] = sigmoidf_(v0[e]); v1[e] = sigmoidf_(v1[e]); }
                        u32x4 w; w.x = pk2(v0[0], v0[1]); w.y = pk2(v0[2], v0[3]); w.z = pk2(v1[0], v1[1]); w.w = pk2(v1[2], v1[3]);
                        *(u32x4*)(rp + bj * 128) = w; } }
        }
        g8::zero_acc(acc); has = hasn; pm = pm2; pn = pn2;
    }
    if (!first) g8::kstream_end();
}
__device__ __forceinline__ void merge_phase(const Params& p, int l, LAS unsigned char* lds) {
    unsigned voffA[2][2], voffB[2]; g8::make_voff_contig(voffA, D * 2); g8::make_voffB(voffB, 512 * 2, true);
    int pm, pn; const int bid = obid();
    for (int i = 0; unit_order(i, gridDim.x, bid, T / 256, 4, pm, pn); ++i) {
#pragma unroll 1
        for (int br = 0; br < 2; ++br) {
            g8::Acc acc; g8::zero_acc(acc);
            const char* Bt = (const char*)(PP().ws + WS_WSMALL + (size_t)l * WSMALL_LAYER) + (10 + br) * MiB + (size_t)pn * 256 * 512 * 2;
            const g8::KSeg s = g8::seg1((const char*)(PP().ws + WS_OAB) + (size_t)pm * 256 * D * 2 + br * 1024, Bt, Bt + (size_t)128 * 512 * 2, 8);
            g8::kloop<false, false>(lds, acc, s, voffA, voffB, 128 * D * 2);
            EPI_COORDS();
            const bf16_t* GT = (const bf16_t*)(PP().ws + WS_GATES); bf16_t* O = (bf16_t*)(PP().ws + WS_MERGED);
            const int row0 = pm * 256 + wr * 64 + fr, colb = pn * 256 + wc * 32 + 8 * fq;
#pragma unroll
            for (int ai = 0; ai < 2; ++ai) { asm volatile("" ::: "memory");
                u32x4 gq[4][2], pq[4][2];
#pragma unroll
                for (int m = 0; m < 4; ++m) { const size_t ro = (size_t)(row0 + ai * 128 + m * 16); const bf16_t* gp = GT + ro * 2048 + br * 1024 + colb; const bf16_t* op = O + ro * D + colb;
#pragma unroll
                    for (int bj = 0; bj < 2; ++bj) { gq[m][bj] = *(const u32x4*)(gp + bj * 128); pq[m][bj] = br ? *(const u32x4*)(op + bj * 128) : (u32x4){0u, 0u, 0u, 0u}; } }
#pragma unroll
                for (int m = 0; m < 4; ++m) { const size_t ro = (size_t)(row0 + ai * 128 + m * 16); bf16_t* op = O + ro * D + colb;
#pragma unroll
                    for (int bj = 0; bj < 2; ++bj) { const u32x4 g = gq[m][bj], pr = pq[m][bj]; const f32x4 v0 = acc[ai][bj][m][0], v1 = acc[ai][bj][m][1];
                        u32x4 w; w.x = pk2(v0[0] * bflo(g.x) + bflo(pr.x), v0[1] * bfhi(g.x) + bfhi(pr.x)); w.y = pk2(v0[2] * bflo(g.y) + bflo(pr.y), v0[3] * bfhi(g.y) + bfhi(pr.y));
                        w.z = pk2(v1[0] * bflo(g.z) + bflo(pr.z), v1[1] * bfhi(g.z) + bfhi(pr.z)); w.w = pk2(v1[2] * bflo(g.w) + bflo(pr.w), v1[3] * bfhi(g.w) + bfhi(pr.w));
                        *(u32x4*)(op + bj * 128) = w; } } }
        }
    }
}
__device__ __forceinline__ void wout_phase(const Params& p, int l, LAS unsigned char* lds) {
    unsigned voffA[2][2], voffB[2]; g8::make_voff_contig(voffA, D * 2); g8::make_voffB(voffB, D * 2, false);
    int pm, pn, pm2 = 0, pn2 = 0; const int bid = obid(); const int wr_ = __builtin_amdgcn_readfirstlane(otid() >> 6) >> 2;
    bool has = unit_order(0, gridDim.x, bid, T / 256, 4, pm, pn), first = true;
    g8::Acc acc; g8::zero_acc(acc);
    for (int i = 0; has; ++i) {
        const bool hasn = unit_order(i + 1, gridDim.x, bid, T / 256, 4, pm2, pn2);
        const char* Ab = (const char*)(PP().ws + WS_MERGED); const char* Bb = (const char*)(PP().ws + WS_WSMALL + (size_t)l * WSMALL_LAYER + 12 * MiB);
        const g8::KSeg s = g8::seg1(Ab + (size_t)pm * 256 * D * 2, Bb + (size_t)pn * 256 * D * 2, Bb + (size_t)(pn * 256 + 128) * D * 2, D / 64);
        const int pmn = hasn ? pm2 : pm, pnn = hasn ? pn2 : pn;
        const g8::KSeg nx = g8::seg1(Ab + (size_t)pmn * 256 * D * 2, Bb + (size_t)pnn * 256 * D * 2, Bb + (size_t)(pnn * 256 + 128) * D * 2, D / 64);
        if (!first && wr_ == 1) __builtin_amdgcn_s_barrier();
        g8::kstream<false, false>(lds, acc, s, nx, first, voffA, voffB, 128 * D * 2); first = false;
        if (wr_ == 0) __builtin_amdgcn_s_barrier();
        EPI_COORDS();
        const int row0 = pm * 256 + wr * 64 + fr, col0 = pn * 256 + wc * 32 + 4 * fq;
#pragma unroll
        for (int ai = 0; ai < 2; ++ai) { asm volatile("" ::: "memory");
            f32x4 pre[4][2][2]; float* hr[4];
#pragma unroll
            for (int m = 0; m < 4; ++m) { hr[m] = hrow(PP(), row0 + ai * 128 + m * 16) + col0;
#pragma unroll
                for (int bj = 0; bj < 2; ++bj)
#pragma unroll
                    for (int n = 0; n < 2; ++n) pre[m][bj][n] = *(const f32x4*)(hr[m] + bj * 128 + n * 16); }
#pragma unroll
            for (int m = 0; m < 4; ++m)
#pragma unroll
                for (int bj = 0; bj < 2; ++bj)
#pragma unroll
                    for (int n = 0; n < 2; ++n) *(f32x4*)(hr[m] + bj * 128 + n * 16) = pre[m][bj][n] * ALPHA + acc[ai][bj][m][n]; }
        g8::zero_acc(acc); has = hasn; pm = pm2; pn = pn2;
    }
    if (!first) g8::kstream_end();
}

constexpr int ATTN_WAVE_LDS = 16640 + 1024 + 2048 + 64 + 512;
__device__ __forceinline__ unsigned score_key(float s) { s += 0.0f; const unsigned u = __builtin_bit_cast(unsigned, s); return (u & 0x80000000u) ? ~u : (u | 0x80000000u); }
__device__ void attn_naive_query(const Params& p, int row, unsigned char* wl, int lane) {
    const bf16_t* U = (const bf16_t*)(p.ws + WS_UAR);
    bf16_t* OA = (bf16_t*)(p.ws + WS_OAB) + (size_t)row * D;
    const int b = row / LP, pos = row - b * LP;
    if (pos < PADM) {
#pragma unroll
        for (int j = 0; j < 8; ++j) OA[j * 64 + lane] = 0;
        return;
    }
    const int nadm = 64 * ((pos >> 6) + 1) - PADM;
    unsigned* keys = (unsigned*)wl; float* p_s = (float*)wl;
    float* qi_s = (float*)(wl + 16640); float* q_s = qi_s + 256; float* w_s = q_s + 512; unsigned short* sel_s = (unsigned short*)(w_s + 16);
    const bf16_t* urow = U + (size_t)row * UARW;
    for (int i = lane; i < 256; i += 64) qi_s[i] = bf2f(urow[C_QI + i]);
    for (int i = lane; i < 512; i += 64) q_s[i] = bf2f(urow[C_Q + i]);
    if (lane < 8) w_s[lane] = bf2f(urow[C_WI + lane]);
    __builtin_amdgcn_fence(__ATOMIC_RELEASE, "wavefront"); __builtin_amdgcn_wave_barrier(); __builtin_amdgcn_fence(__ATOMIC_ACQUIRE, "wavefront");
    const int nj = (nadm + 63) >> 6;
    for (int j = 0; j < nj; ++j) {
        const int ki_idx = lane + 64 * j; unsigned key = 0u;
        if (ki_idx < nadm) {
            const u32x4* kp = (const u32x4*)(U + (size_t)(b * LP + PADM + ki_idx) * UARW + C_KI);
            float kf[32];
#pragma unroll
            for (int c4 = 0; c4 < 4; ++c4) { const u32x4 w = kp[c4];
                kf[c4 * 8 + 0] = bflo(w.x); kf[c4 * 8 + 1] = bfhi(w.x); kf[c4 * 8 + 2] = bflo(w.y); kf[c4 * 8 + 3] = bfhi(w.y);
                kf[c4 * 8 + 4] = bflo(w.z); kf[c4 * 8 + 5] = bfhi(w.z); kf[c4 * 8 + 6] = bflo(w.w); kf[c4 * 8 + 7] = bfhi(w.w); }
            float sc = 0.f;
#pragma unroll 1
            for (int h = 0; h < 8; ++h) { float d = 0.f; asm volatile("" ::: "memory");
#pragma unroll
                for (int e = 0; e < 32; ++e) d = fmaf(qi_s[h * 32 + e], kf[e], d);
                sc = fmaf(w_s[h], fmaxf(d, 0.f), sc); }
            key = score_key(sc); if (key == 0u) key = 1u;
        }
        keys[ki_idx] = key;
    }
    __builtin_amdgcn_fence(__ATOMIC_RELEASE, "wavefront"); __builtin_amdgcn_wave_barrier(); __builtin_amdgcn_fence(__ATOMIC_ACQUIRE, "wavefront");
    unsigned thr = 0u; int need_ties = 0x7fffffff;
    if (nadm > 256) {
        unsigned prefix = 0u; int remaining = 256;
        for (int bit = 31; bit >= 0; --bit) {
            const unsigned cand = prefix | (1u << bit); int cnt = 0;
            for (int j = 0; j < nj; ++j) { const unsigned k = keys[lane + 64 * j]; cnt += __builtin_popcountll(__ballot((k >> bit) == (cand >> bit))); }
            if (cnt >= remaining) prefix = cand; else remaining -= cnt;
        }
        thr = prefix; need_ties = remaining;
    } else thr = 1u;
    int nsel = 0, ties_seen = 0;
    for (int j = 0; j < nj; ++j) {
        const unsigned k = keys[lane + 64 * j];
        const unsigned long long tm = __ballot(k == thr && k != 0u);
        const unsigned long long lt = (1ull << lane) - 1ull;
        const int myrank = ties_seen + __builtin_popcountll(tm & lt);
        const bool selme = (k > thr) || (k == thr && k != 0u && myrank < need_ties);
        const unsigned long long sm = __ballot(selme);
        if (selme) sel_s[nsel + __builtin_popcountll(sm & lt)] = (unsigned short)(PADM + lane + 64 * j);
        nsel += __builtin_popcountll(sm); ties_seen += __builtin_popcountll(tm);
    }
    __builtin_amdgcn_fence(__ATOMIC_RELEASE, "wavefront"); __builtin_amdgcn_wave_barrier(); __builtin_amdgcn_fence(__ATOMIC_ACQUIRE, "wavefront");
    float sc[4][8];
#pragma unroll
    for (int m = 0; m < 4; ++m) {
        asm volatile("" ::: "memory");
        const int i = lane + 64 * m; const bool valid = i < nsel; const int ps = valid ? sel_s[i] : PADM;
        const bf16_t* krow = U + (size_t)(b * LP + ps) * UARW + C_K;
#pragma unroll
        for (int n = 0; n < 2; ++n) {
            float a0 = 0.f, a1 = 0.f, a2 = 0.f, a3 = 0.f;
#pragma unroll 1
            for (int c8 = 0; c8 < 8; ++c8) { asm volatile("" ::: "memory"); const u32x4 w = *(const u32x4*)(krow + n * 64 + c8 * 8);
                float kf[8] = {bflo(w.x), bfhi(w.x), bflo(w.y), bfhi(w.y), bflo(w.z), bfhi(w.z), bflo(w.w), bfhi(w.w)};
#pragma unroll
                for (int e = 0; e < 8; ++e) { const int dd = c8 * 8 + e;
                    a0 = fmaf(q_s[(n * 4 + 0) * 64 + dd], kf[e], a0); a1 = fmaf(q_s[(n * 4 + 1) * 64 + dd], kf[e], a1);
                    a2 = fmaf(q_s[(n * 4 + 2) * 64 + dd], kf[e], a2); a3 = fmaf(q_s[(n * 4 + 3) * 64 + dd], kf[e], a3); } }
            sc[m][n * 4 + 0] = valid ? a0 * 0.125f : -INFINITY; sc[m][n * 4 + 1] = valid ? a1 * 0.125f : -INFINITY;
            sc[m][n * 4 + 2] = valid ? a2 * 0.125f : -INFINITY; sc[m][n * 4 + 3] = valid ? a3 * 0.125f : -INFINITY;
        }
    }
    __builtin_amdgcn_wave_barrier();
    float linv[8];
#pragma unroll
    for (int h = 0; h < 8; ++h) {
        const float mx = wave_max(fmaxf(fmaxf(sc[0][h], sc[1][h]), fmaxf(sc[2][h], sc[3][h]))); float s = 0.f;
#pragma unroll
        for (int m = 0; m < 4; ++m) { const float e = __expf(sc[m][h] - mx); sc[m][h] = e; s += e; }
        linv[h] = 1.0f / wave_sum(s);
    }
#pragma unroll
    for (int m = 0; m < 4; ++m) { const int i = lane + 64 * m;
#pragma unroll
        for (int h = 0; h < 8; ++h) p_s[i * 8 + h] = sc[m][h]; }
    __builtin_amdgcn_fence(__ATOMIC_RELEASE, "wavefront"); __builtin_amdgcn_wave_barrier(); __builtin_amdgcn_fence(__ATOMIC_ACQUIRE, "wavefront");
    float o[8] = {0.f, 0.f, 0.f, 0.f, 0.f, 0.f, 0.f, 0.f};
    for (int i = 0; i < nsel; ++i) {
        const int ps = sel_s[i]; const bf16_t* vrow = U + (size_t)(b * LP + ps) * UARW + C_V;
        const float v0 = bf2f(vrow[lane]), v1 = bf2f(vrow[64 + lane]);
        const f32x4 pa = *(const f32x4*)(p_s + i * 8), pb = *(const f32x4*)(p_s + i * 8 + 4);
        o[0] = fmaf(pa[0], v0, o[0]); o[1] = fmaf(pa[1], v0, o[1]); o[2] = fmaf(pa[2], v0, o[2]); o[3] = fmaf(pa[3], v0, o[3]);
        o[4] = fmaf(pb[0], v1, o[4]); o[5] = fmaf(pb[1], v1, o[5]); o[6] = fmaf(pb[2], v1, o[6]); o[7] = fmaf(pb[3], v1, o[7]);
    }
#pragma unroll
    for (int h = 0; h < 8; ++h) OA[h * 64 + lane] = (bf16_t)f2bf(o[h] * linv[h]);
    __builtin_amdgcn_wave_barrier();
}


__device__ __forceinline__ f32x4 mfma16(bf16x8 a, bf16x8 b, f32x4 c) { return __builtin_amdgcn_mfma_f32_16x16x32_bf16(a, b, c, 0, 0, 0); }
#ifndef PROBE_PHASE
#define PROBE_PHASE -1
#endif
#define PROBE_BLOCK 0
#define LDS_BARRIER() do { asm volatile("s_waitcnt lgkmcnt(0)" ::: "memory"); __builtin_amdgcn_s_barrier(); asm volatile("" ::: "memory"); } while (0)

typedef float f32x16 __attribute__((ext_vector_type(16)));
typedef short s16x4 __attribute__((ext_vector_type(4)));
constexpr int AT_HIST = 0;
constexpr int AT_MASK = 20480;
constexpr int AT_QST = AT_MASK + 16640;
constexpr int AT_KV = 37120;
constexpr int AT_UNIT = AT_KV + 32768;
constexpr int AT_KL = AT_KV;
constexpr int AT_KL_BYTES = LDS_BYTES - 16 - AT_KL;
static_assert(4128 * 12 * 2 <= AT_KL_BYTES, "selection keys fit with 12 queries per sub-pass");
constexpr int CW_R1Q = 48;
constexpr int CW_ATT = 32;
__device__ __forceinline__ int img_off(int row, int ch) { return 2048 * (row >> 3) + 512 * (ch >> 2) + 64 * (row & 7) + 16 * ((ch & 3) ^ ((row >> 2) & 3)); }
__device__ __forceinline__ unsigned comp_key(float sc, int pos) { return (score_key(sc) & 0xFFFFE000u) | (unsigned)(0x1FFF - pos); }

__device__ __forceinline__ void attn_unit(const Params& p, unsigned char* lds, int b, int qt, unsigned long long& pacc) {
    unsigned long long pt0 = 0; if (PROBE_PHASE == 40 || PROBE_PHASE == 42) pt0 = __builtin_amdgcn_s_memrealtime();
    const int tid = otid(), wave = tid >> 6, lane = tid & 63, r = lane & 31, hh = lane >> 5;
    const bf16_t* U = (const bf16_t*)(p.ws + WS_UAR);
    LAS unsigned char* L = (LAS unsigned char*)lds;
    LAS unsigned* hist = (LAS unsigned*)(L + AT_HIST); LAS unsigned* maskw = (LAS unsigned*)(L + AT_MASK);
    const int c = qt >> 1, nkt = 2 * c + 1, nadm = 64 * (c + 1) - PADM;
    const size_t qrow = (size_t)(b * LP + 32 * qt + r);
    if (nadm > 256) {
        LAS unsigned short* KL = (LAS unsigned short*)(L + AT_KL);
        LAS unsigned* h8 = (LAS unsigned*)(L + AT_HIST);
        LAS unsigned* segc = h8 + 4096;
        LAS unsigned* st = segc + 512;
        const int NK = 32 * nkt, c15 = lane & 15, g4 = lane >> 4;
        const int qs = NK * 32 <= AT_KL_BYTES ? 16 : 12;
        for (int i = tid; i < (nkt + 1) * 32; i += NTHREADS) maskw[i] = 0u;
#pragma unroll 1
        for (int qbase = 0; qbase < 32; qbase += qs) {
            const int qn = 32 - qbase < qs ? 32 - qbase : qs; const bool qact = c15 < qn;
            bf16x8 qf[8]; float wq[8];
            { const bf16_t* qp = U + (size_t)(b * LP + 32 * qt + qbase + (qact ? c15 : 0)) * UARW;
#pragma unroll
              for (int h = 0; h < 8; ++h) qf[h] = *(const bf16x8*)(qp + C_QI + h * 32 + 8 * g4);
              const u32x4 w = *(const u32x4*)(qp + C_WI);
              wq[0] = bflo(w.x); wq[1] = bfhi(w.x); wq[2] = bflo(w.y); wq[3] = bfhi(w.y); wq[4] = bflo(w.z); wq[5] = bfhi(w.z); wq[6] = bflo(w.w); wq[7] = bfhi(w.w); }
#pragma unroll
            for (int h = 0; h < 8; ++h) asm volatile("" : "+v"(qf[h]), "+v"(wq[h]));
            for (int i = tid; i < 4096 + 512; i += NTHREADS) h8[i] = 0u;
            LDS_BARRIER();
            {
                const int ng = 2 * nkt; int j = wave;
                const bf16_t* kb = U + (size_t)(b * LP + 32 + c15) * UARW + C_KI + 8 * g4;
                bf16x8 a = *(const bf16x8*)(kb + (size_t)(16 * (j < ng ? j : 0)) * UARW), an = *(const bf16x8*)(kb + (size_t)(16 * (j + NWAVES < ng ? j + NWAVES : 0)) * UARW);
#pragma unroll 1
                for (; j < ng; j += NWAVES) {
                    const bf16x8 a2 = *(const bf16x8*)(kb + (size_t)(16 * (j + 2 * NWAVES < ng ? j + 2 * NWAVES : j)) * UARW);
                    f32x4 sc = {0.f, 0.f, 0.f, 0.f};
#pragma unroll
                    for (int h = 0; h < 8; ++h) { const f32x4 d = mfma16(a, qf[h], (f32x4){0.f, 0.f, 0.f, 0.f});
#pragma unroll
                        for (int e = 0; e < 4; ++e) sc[e] = fmaf(wq[h], fmaxf(d[e], 0.f), sc[e]); }
                    if (qact) {
#pragma unroll
                        for (int e = 0; e < 4; ++e) { const int ki = 16 * j + 4 * g4 + e;
                            const unsigned k16 = ki >= 16 ? (score_key(sc[e]) >> 16) : 0u;
                            KL[ki * qs + c15] = (unsigned short)k16;
                            __hip_atomic_fetch_add(h8 + (k16 >> 8) * 16 + c15, ki >= 16 ? 1u : 0u, __ATOMIC_RELAXED, __HIP_MEMORY_SCOPE_WORKGROUP); } }
                    a = an; an = a2;
                }
            }
            LDS_BARRIER();
            { const int q_ = tid & 15, s8 = tid >> 4; unsigned ss = 0u;
#pragma unroll
              for (int i = 0; i < 8; ++i) ss += h8[(s8 * 8 + i) * 16 + q_];
              segc[s8 * 16 + q_] = ss; }
            LDS_BARRIER();
            if (tid < qn) { unsigned sv[32];
#pragma unroll
                for (int i = 0; i < 32; ++i) sv[i] = segc[i * 16 + tid];
                unsigned cum = 0u; int sgi = 31;
#pragma unroll
                for (int i = 31; i > 0; --i) { const bool go = sgi == i && cum + sv[i] < 256u; cum += go ? sv[i] : 0u; sgi -= go ? 1 : 0; }
                int bin = sgi * 8 + 7; while (bin > sgi * 8 && cum + h8[bin * 16 + tid] < 256u) { cum += h8[bin * 16 + tid]; --bin; }
                st[tid * 4] = (unsigned)bin; st[tid * 4 + 1] = 256u - cum; }
            LDS_BARRIER();
            for (int i = tid; i < 4096; i += NTHREADS) h8[i] = 0u;
            LDS_BARRIER();
            const int q = tid & 15, sg = tid >> 4, SEG = (NK + 31) >> 5, k0 = sg * SEG, k1 = q < qn ? (k0 + SEG < NK ? k0 + SEG : NK) : k0;
            { const unsigned hb = st[q * 4];
#pragma unroll 8
              for (int k = k0; k < k1; ++k) { const unsigned kv = KL[k * qs + q]; __hip_atomic_fetch_add(h8 + (kv & 255u) * 16 + q, (kv >> 8) == hb && kv != 0u ? 1u : 0u, __ATOMIC_RELAXED, __HIP_MEMORY_SCOPE_WORKGROUP); } }
            LDS_BARRIER();
            { const int q_ = tid & 15, s8 = tid >> 4; unsigned ss = 0u;
#pragma unroll
              for (int i = 0; i < 8; ++i) ss += h8[(s8 * 8 + i) * 16 + q_];
              segc[s8 * 16 + q_] = ss; }
            LDS_BARRIER();
            if (tid < qn) { const unsigned rem = st[tid * 4 + 1]; unsigned sv[32];
#pragma unroll
                for (int i = 0; i < 32; ++i) sv[i] = segc[i * 16 + tid];
                unsigned cum = 0u; int sgi = 31;
#pragma unroll
                for (int i = 31; i > 0; --i) { const bool go = sgi == i && cum + sv[i] < rem; cum += go ? sv[i] : 0u; sgi -= go ? 1 : 0; }
                int bin = sgi * 8 + 7; while (bin > sgi * 8 && cum + h8[bin * 16 + tid] < rem) { cum += h8[bin * 16 + tid]; --bin; }
                st[tid * 4 + 2] = (st[tid * 4] << 8) | (unsigned)bin; st[tid * 4 + 3] = rem - cum; }
            LDS_BARRIER();
            const unsigned thr = st[q * 4 + 2], need = st[q * 4 + 3];
            { unsigned cnt = 0u;
#pragma unroll 8
              for (int k = k0; k < k1; ++k) cnt += KL[k * qs + q] == thr ? 1u : 0u;
              segc[sg * 16 + q] = cnt; }
            LDS_BARRIER();
            if (tid < qn) { unsigned cv[32];
#pragma unroll
                for (int s2 = 0; s2 < 32; ++s2) cv[s2] = segc[s2 * 16 + tid];
                unsigned run = 0u;
#pragma unroll
                for (int s2 = 0; s2 < 32; ++s2) { segc[s2 * 16 + tid] = run; run += cv[s2]; } }
            LDS_BARRIER();
            { unsigned rank = segc[sg * 16 + q], word = 0u; int wi = k0 >> 5;
#pragma unroll 4
              for (int k = k0; k < k1; ++k) { if ((k >> 5) != wi) { if (word) __hip_atomic_fetch_or(maskw + (wi + 1) * 32 + qbase + q, word, __ATOMIC_RELAXED, __HIP_MEMORY_SCOPE_WORKGROUP); word = 0u; wi = k >> 5; }
                  const unsigned kv = KL[k * qs + q]; const bool tie = kv == thr; const bool sel = kv > thr || (tie && rank < need); rank += tie ? 1u : 0u;
                  word |= (sel ? 1u : 0u) << (k & 31); }
              if (word) __hip_atomic_fetch_or(maskw + (wi + 1) * 32 + qbase + q, word, __ATOMIC_RELAXED, __HIP_MEMORY_SCOPE_WORKGROUP); }
            LDS_BARRIER();
        }
    } else {
        for (int kt = 1 + wave; kt <= nkt; kt += NWAVES) if (hh == 0) maskw[kt * 32 + r] = kt == 1 ? 0xFFFF0000u : 0xFFFFFFFFu;
        LDS_BARRIER();
    }
    if (PROBE_PHASE == 40) pacc += __builtin_amdgcn_s_memrealtime() - pt0;
    if (PROBE_PHASE == 41) pt0 = __builtin_amdgcn_s_memrealtime();
    {
        const int h = wave, n = h >> 2;
        bf16x8 qf4[4];
#pragma unroll
        for (int kk = 0; kk < 4; ++kk) qf4[kk] = *(const bf16x8*)(U + qrow * UARW + C_Q + h * 64 + 16 * kk + 8 * hh);
        asm volatile("" : "+v"(qf4[0]), "+v"(qf4[1]), "+v"(qf4[2]), "+v"(qf4[3]));
        f32x16 o0, o1;
#pragma unroll
        for (int e = 0; e < 16; ++e) { o0[e] = 0.f; o1[e] = 0.f; }
        float m = -1e30f, lsum = 0.f;
        const int srow = tid >> 4, sch = tid & 15; const int soff = img_off(srow, sch);
        const bf16_t* sbase = U + (size_t)(b * LP + srow) * UARW + sch * 8;
        u32x4 kreg = *(const u32x4*)(sbase + (size_t)32 * UARW + C_K), vreg = *(const u32x4*)(sbase + (size_t)32 * UARW + C_V);
        *(LAS u32x4*)(L + AT_KV + soff) = kreg; *(LAS u32x4*)(L + AT_KV + 8192 + soff) = vreg;
        { const int k2 = nkt >= 2 ? 2 : 1; kreg = *(const u32x4*)(sbase + (size_t)(32 * k2) * UARW + C_K); vreg = *(const u32x4*)(sbase + (size_t)(32 * k2) * UARW + C_V); }
        LDS_BARRIER();
        const int g = (lane >> 4) & 1, q_ = (lane & 15) >> 2, p_ = lane & 3;
        constexpr float SCL = 0.125f * 1.44269504088896f;
#pragma unroll 1
        for (int i = 0; i < nkt; ++i) {
            const int kt = 1 + i; LAS unsigned char* Kimg = L + AT_KV + (i & 1) * 16384; LAS unsigned char* Vimg = Kimg + 8192;
            u32x4 kreg2, vreg2;
            { const int k3 = kt + 2 <= nkt ? kt + 2 : kt; kreg2 = *(const u32x4*)(sbase + (size_t)(32 * k3) * UARW + C_K); vreg2 = *(const u32x4*)(sbase + (size_t)(32 * k3) * UARW + C_V); }
            f32x16 s;
#pragma unroll
            for (int e = 0; e < 16; ++e) s[e] = 0.f;
#pragma unroll
            for (int kk = 0; kk < 4; ++kk) { const bf16x8 a = *(const LAS bf16x8*)(Kimg + img_off(r, 8 * n + 2 * kk + hh)); s = __builtin_amdgcn_mfma_f32_32x32x16_bf16(a, qf4[kk], s, 0, 0, 0); }
            const unsigned mw = maskw[kt * 32 + r] >> (4 * hh);
            float tmax = -INFINITY;
#pragma unroll
            for (int e = 0; e < 16; ++e) { const bool sel = (mw >> ((e & 3) + 8 * (e >> 2))) & 1u; s[e] = sel ? s[e] : -INFINITY; tmax = fmaxf(tmax, s[e]); }
            tmax = fmaxf(tmax, __shfl_xor(tmax, 32));
            const float mnew = fmaxf(m, tmax * SCL);
            if (__any(mnew > m)) { const float alpha = __builtin_amdgcn_exp2f(m - mnew); lsum *= alpha;
#pragma unroll
                for (int e = 0; e < 16; ++e) { o0[e] *= alpha; o1[e] *= alpha; } }
            m = mnew;
            float ps = 0.f;
#pragma unroll
            for (int e = 0; e < 16; ++e) { const float pe = __builtin_amdgcn_exp2f(fmaf(s[e], SCL, -mnew)); s[e] = pe; ps += pe; }
            lsum += ps;
            bf16x8 pf[2];
#pragma unroll
            for (int ks = 0; ks < 2; ++ks) { u32x4 w; w.x = pk2(s[8 * ks + 0], s[8 * ks + 1]); w.y = pk2(s[8 * ks + 2], s[8 * ks + 3]); w.z = pk2(s[8 * ks + 4], s[8 * ks + 5]); w.w = pk2(s[8 * ks + 6], s[8 * ks + 7]); pf[ks] = __builtin_bit_cast(bf16x8, w); }
#pragma unroll
            for (int ks = 0; ks < 2; ++ks)
#pragma unroll
                for (int dt = 0; dt < 2; ++dt) { const int c0 = 8 * n + 4 * dt + 2 * g + (p_ >> 1);
                    const s16x4 lo = __builtin_amdgcn_ds_read_tr16_b64_v4i16((LAS s16x4*)(Vimg + img_off(16 * ks + 4 * hh + q_, c0) + 8 * (p_ & 1)));
                    const s16x4 hi = __builtin_amdgcn_ds_read_tr16_b64_v4i16((LAS s16x4*)(Vimg + img_off(16 * ks + 8 + 4 * hh + q_, c0) + 8 * (p_ & 1)));
                    const bf16x8 a = __builtin_shufflevector(lo, hi, 0, 1, 2, 3, 4, 5, 6, 7);
                    if (dt == 0) o0 = __builtin_amdgcn_mfma_f32_32x32x16_bf16(a, pf[ks], o0, 0, 0, 0); else o1 = __builtin_amdgcn_mfma_f32_32x32x16_bf16(a, pf[ks], o1, 0, 0, 0); }
            if (i + 1 < nkt) { LAS unsigned char* Kn = L + AT_KV + ((i + 1) & 1) * 16384; *(LAS u32x4*)(Kn + soff) = kreg; *(LAS u32x4*)(Kn + 8192 + soff) = vreg; }
            kreg = kreg2; vreg = vreg2;
            LDS_BARRIER();
        }
        lsum += __shfl_xor(lsum, 32);
        const float inv = lsum > 0.f ? 1.0f / lsum : 0.f;
        bf16_t* orow = (bf16_t*)(p.ws + WS_OAB) + qrow * D + h * 64 + 4 * hh;
#pragma unroll
        for (int g4 = 0; g4 < 4; ++g4) { u32x2 w0, w1;
            w0.x = pk2(o0[4 * g4] * inv, o0[4 * g4 + 1] * inv); w0.y = pk2(o0[4 * g4 + 2] * inv, o0[4 * g4 + 3] * inv);
            w1.x = pk2(o1[4 * g4] * inv, o1[4 * g4 + 1] * inv); w1.y = pk2(o1[4 * g4 + 2] * inv, o1[4 * g4 + 3] * inv);
            *(u32x2*)(orow + 8 * g4) = w0; *(u32x2*)(orow + 32 + 8 * g4) = w1; }
        if (qt == 1) {
            bf16_t* z = (bf16_t*)(p.ws + WS_OAB) + (size_t)(b * LP + r) * D + h * 64 + 32 * hh;
#pragma unroll
            for (int j = 0; j < 4; ++j) *(u32x4*)(z + 8 * j) = (u32x4){0u, 0u, 0u, 0u};
        }
    }
    if (PROBE_PHASE == 41 || PROBE_PHASE == 42) pacc += __builtin_amdgcn_s_memrealtime() - pt0;
}
__device__ __forceinline__ void attn_phase(const Params& p, int l, unsigned char* lds, unsigned long long& pacc) {
    unsigned* ctr = (unsigned*)(p.ws + WS_CTL) + CW_ATT + 4 * l;
    volatile int* uw = (volatile int*)(lds + AT_UNIT);
    const int b0 = (obid() & 7) >> 1;
    for (int k = 0; k < 4; ++k) { const int b = (b0 + k) & 3;
        for (;;) {
            __syncthreads();
            if (otid() == 0) *uw = (int)atomicAdd(ctr + b, 1u);
            __syncthreads();
            const int u = *uw;
            if (u >= 129) break;
            attn_unit(p, lds, b, 129 - u, pacc);
        }
    }
}

constexpr size_t WS_RW1 = WS_HB;
constexpr size_t WS_RW2 = 259 * MiB;
constexpr size_t RW2_ARR = (size_t)2080 * 8192;
constexpr size_t WS_LORA = 65536;
constexpr int PS = 72;
constexpr int R1_XW = 0, R1_XA = 9216, R1_XG = 18432;
constexpr int R1_RHS = 0;
constexpr int R1_E = 35840, R1_AA = R1_E + 16640, R1_GS = R1_AA + 9216;
constexpr int R1_LABT = R1_E, R1_LAK = R1_E + 16384;
constexpr int R1_AT = R1_GS + 9216, R1_RT = R1_AT + 9216, R1_BT = R1_RT + 9216, R1_KT = R1_BT + 9216;
constexpr int R1_WT = R1_AT, R1_ZT = R1_BT;
constexpr int R1_BTT = R1_KT + 9216, R1_KTT = R1_BTT + 9216, R1_VT = R1_KTT + 9216;
constexpr int R1_MRB = R1_VT + 9216, R1_MRK = R1_MRB + 9216;
constexpr int R1_BS = R1_MRK + 9216, R1_GC = R1_BS + 256, R1_END = R1_GC + 256;
static_assert(R1_END <= LDS_BYTES && R1_LAK + 9216 <= R1_AT && R1_RHS + 33280 <= R1_E, "R1 LDS map");
__device__ __forceinline__ u32x2 pk4(f32x4 v) { u32x2 w; w.x = pk2(v[0], v[1]); w.y = pk2(v[2], v[3]); return w; }

#ifndef PROBE_PHASE
#define PROBE_PHASE -1
#endif
#define R1P(k) do { if (PROBE_PHASE == 20 + (k)) { const unsigned long long t_ = __builtin_amdgcn_s_memrealtime(); pacc += t_ - pt0; } if (PROBE_PHASE == 21 + (k)) pt0 = __builtin_amdgcn_s_memrealtime(); } while (0)
__device__ __forceinline__ void rwkv_prep_unit(const Params& p, int l, int unit, unsigned char* lds, unsigned long long& pacc) {
    unsigned long long pt0 = 0; if (PROBE_PHASE == 20) pt0 = __builtin_amdgcn_s_memrealtime();
    const int tid = otid(), wave = tid >> 6, lane = tid & 63, c15 = lane & 15, g = lane >> 4;
    const int h = unit & 7, bc = unit >> 3, b = bc / NCH, c = bc - b * NCH;
    LAS unsigned char* L = (LAS unsigned char*)lds;
    const bf16_t* U = (const bf16_t*)(p.ws + WS_UAR);
    const int t = tid >> 3, dq = tid & 7, d0 = dq * 8;
    const int row = b * LP + 64 * c + t; const bool hasprev = (64 * c + t) > 0;
    float rr[8], kx[8], vx[8], kk[8];
    {
        const bf16_t* uc = U + (size_t)row * UARW; const bf16_t* up = hasprev ? uc - UARW : uc;
        const float* mu = p.in[I_MU] + l * R_COLS;
        auto shift8 = [&](int col, int mucol, float (&out)[8]) {
            const u32x4 a = *(const u32x4*)(uc + col), q = *(const u32x4*)(up + col);
            const f32x4 m0 = *(const f32x4*)(mu + mucol), m1 = *(const f32x4*)(mu + mucol + 4);
            const float x[8] = {bflo(a.x), bfhi(a.x), bflo(a.y), bfhi(a.y), bflo(a.z), bfhi(a.z), bflo(a.w), bfhi(a.w)};
            const float y[8] = {bflo(q.x), bfhi(q.x), bflo(q.y), bfhi(q.y), bflo(q.z), bfhi(q.z), bflo(q.w), bfhi(q.w)};
#pragma unroll
            for (int i = 0; i < 8; ++i) { const float xp = hasprev ? y[i] : 0.f; out[i] = x[i] + (xp - x[i]) * (i < 4 ? m0[i] : m1[i - 4]); } };
        shift8(C_R + h * 64 + d0, h * 64 + d0, rr); shift8(C_RK + h * 64 + d0, 512 + h * 64 + d0, kx); shift8(C_RV + h * 64 + d0, 1024 + h * 64 + d0, vx);
        float xw[8], xa[8], xg0[8], xg1[8];
        shift8(C_XW + d0, 1536 + d0, xw); shift8(C_XA + d0, 1600 + d0, xa); shift8(C_XG + d0, 1664 + d0, xg0); shift8(C_XG + 64 + d0, 1728 + d0, xg1);
        float n2 = 0.f;
        { const f32x4 k0 = *(const f32x4*)(p.in[I_KK] + l * 512 + h * 64 + d0), k1 = *(const f32x4*)(p.in[I_KK] + l * 512 + h * 64 + d0 + 4);
#pragma unroll
          for (int i = 0; i < 8; ++i) { kk[i] = kx[i] * (i < 4 ? k0[i] : k1[i - 4]); n2 = fmaf(kk[i], kk[i], n2); } }
        n2 += __shfl_xor(n2, 1); n2 += __shfl_xor(n2, 2); n2 += __shfl_xor(n2, 4);
        const float rn = rsqrtf(fmaxf(n2, 1e-24f));
#pragma unroll
        for (int i = 0; i < 8; ++i) { kk[i] *= rn; xw[i] = tanhf(xw[i]); xg0[i] = sigmoidf_(xg0[i]); xg1[i] = sigmoidf_(xg1[i]); }
        u32x4 w;
        w.x = pk2(xw[0], xw[1]); w.y = pk2(xw[2], xw[3]); w.z = pk2(xw[4], xw[5]); w.w = pk2(xw[6], xw[7]); *(LAS u32x4*)(L + R1_XW + (t * PS + d0) * 2) = w;
        w.x = pk2(xa[0], xa[1]); w.y = pk2(xa[2], xa[3]); w.z = pk2(xa[4], xa[5]); w.w = pk2(xa[6], xa[7]); *(LAS u32x4*)(L + R1_XA + (t * PS + d0) * 2) = w;
        w.x = pk2(xg0[0], xg0[1]); w.y = pk2(xg0[2], xg0[3]); w.z = pk2(xg0[4], xg0[5]); w.w = pk2(xg0[6], xg0[7]); *(LAS u32x4*)(L + R1_XG + (t * 136 + d0) * 2) = w;
        w.x = pk2(xg1[0], xg1[1]); w.y = pk2(xg1[2], xg1[3]); w.z = pk2(xg1[4], xg1[5]); w.w = pk2(xg1[6], xg1[7]); *(LAS u32x4*)(L + R1_XG + (t * 136 + 64 + d0) * 2) = w;
    }
    LDS_BARRIER();
    R1P(0);
    const int tm = wave >> 1;
    unsigned char* rw2 = p.ws + WS_RW2 + (size_t)unit * 8192;
    {
        const bf16_t* lora = (const bf16_t*)(p.ws + WS_LORA + (size_t)l * 262144);
#pragma unroll
        for (int nn = 0; nn < 2; ++nn) { const int tn = 2 * (wave & 1) + nn, dcol = 16 * tn + c15, hd = h * 64 + dcol;
            f32x4 aw = {0.f, 0.f, 0.f, 0.f}, aa = aw, ag = aw;
#pragma unroll
            for (int s2 = 0; s2 < 2; ++s2) {
                const bf16x8 xa_ = *(const LAS bf16x8*)(L + R1_XW + ((16 * tm + c15) * PS + 32 * s2 + 8 * g) * 2), xb_ = *(const LAS bf16x8*)(L + R1_XA + ((16 * tm + c15) * PS + 32 * s2 + 8 * g) * 2);
                aw = mfma16(xa_, *(const bf16x8*)(lora + (size_t)hd * 64 + 32 * s2 + 8 * g), aw);
                aa = mfma16(xb_, *(const bf16x8*)(lora + 32768 + (size_t)hd * 64 + 32 * s2 + 8 * g), aa); }
#pragma unroll
            for (int s4 = 0; s4 < 4; ++s4) ag = mfma16(*(const LAS bf16x8*)(L + R1_XG + ((16 * tm + c15) * 136 + 32 * s4 + 8 * g) * 2), *(const bf16x8*)(lora + 65536 + (size_t)hd * 128 + 32 * s4 + 8 * g), ag);
            const float w0 = p.in[I_W0][l * 512 + hd], a0 = p.in[I_A0][l * 512 + hd];
#pragma unroll
            for (int e = 0; e < 4; ++e) { const int tt = 16 * tm + 4 * g + e;
                const float z = -(w0 + aw[e]); const float sp = fmaxf(z, 0.f) + log1pf(__expf(-fabsf(z)));
                *(LAS float*)(L + R1_E + (tt * 65 + dcol) * 4) = __expf(-sp - 0.5f);
                *(LAS unsigned short*)(L + R1_AA + (tt * PS + dcol) * 2) = (unsigned short)f2bf(sigmoidf_(a0 + aa[e]));
                *(LAS unsigned short*)(L + R1_GS + (tt * PS + dcol) * 2) = (unsigned short)f2bf(ag[e]); }
        }
    }
    LDS_BARRIER();
    R1P(1);
    {
        const int d = tid & 63, sg = tid >> 6; float cum = 0.f, loc[8];
#pragma unroll
        for (int i = 0; i < 8; ++i) { cum += *(const LAS float*)(L + R1_E + ((8 * sg + i) * 65 + d) * 4); loc[i] = cum; }
        *(LAS float*)(L + R1_BS + (sg * 64 + d) * 4 - 2048) = cum;
        LDS_BARRIER();
        float off = 0.f;
#pragma unroll
        for (int q = 0; q < 7; ++q) if (q < sg) off += *(const LAS float*)(L + R1_BS + (q * 64 + d) * 4 - 2048);
#pragma unroll
        for (int i = 0; i < 8; ++i) *(LAS float*)(L + R1_E + ((8 * sg + i) * 65 + d) * 4) = loc[i] + off;
    }
    LDS_BARRIER();
    R1P(2);
    {
        const f32x4 ka0 = *(const f32x4*)(p.in[I_KA] + l * 512 + h * 64 + d0), ka1 = *(const f32x4*)(p.in[I_KA] + l * 512 + h * 64 + d0 + 4);
        const f32x4 rk0 = *(const f32x4*)(p.in[I_RK] + l * 512 + h * 64 + d0), rk1 = *(const f32x4*)(p.in[I_RK] + l * 512 + h * 64 + d0 + 4);
        const u32x4 aw_ = *(const LAS u32x4*)(L + R1_AA + (t * PS + d0) * 2);
        const float av[8] = {bflo(aw_.x), bfhi(aw_.x), bflo(aw_.y), bfhi(aw_.y), bflo(aw_.z), bfhi(aw_.z), bflo(aw_.w), bfhi(aw_.w)};
        float At[8], Bt[8], Kt[8], Rt[8]; float bpart = 0.f;
#pragma unroll
        for (int i = 0; i < 8; ++i) {
            const float cumt = *(const LAS float*)(L + R1_E + (t * 65 + d0 + i) * 4), cump = t > 0 ? *(const LAS float*)(L + R1_E + ((t - 1) * 65 + d0 + i) * 4) : 0.f;
            const float gam = __expf(-cumt), gprev = __expf(-cump), ginv = __expf(cumt);
            const float kmod = kx[i] * (1.0f + (av[i] - 1.0f) * (i < 4 ? ka0[i] : ka1[i - 4]));
            At[i] = -gprev * kk[i]; Bt[i] = kk[i] * av[i] * ginv; Kt[i] = kmod * ginv; Rt[i] = rr[i] * gam;
            bpart = fmaf(rr[i] * kmod, (i < 4 ? rk0[i] : rk1[i - 4]), bpart);
            if (t == 63) *(LAS float*)(L + R1_GC + (d0 + i) * 4) = gam;
            *(LAS float*)(L + R1_RHS + ((d0 + i) * 65 + t) * 4) = At[i];
            *(LAS unsigned short*)(L + R1_BTT + ((d0 + i) * PS + t) * 2) = (unsigned short)f2bf(Bt[i]);
            *(LAS unsigned short*)(L + R1_KTT + ((d0 + i) * PS + t) * 2) = (unsigned short)f2bf(Kt[i]);
            *(LAS unsigned short*)(L + R1_VT + ((d0 + i) * PS + t) * 2) = (unsigned short)f2bf(vx[i]);
        }
        u32x4 w;
        w.x = pk2(At[0], At[1]); w.y = pk2(At[2], At[3]); w.z = pk2(At[4], At[5]); w.w = pk2(At[6], At[7]); *(LAS u32x4*)(L + R1_AT + (t * PS + d0) * 2) = w;
        w.x = pk2(Rt[0], Rt[1]); w.y = pk2(Rt[2], Rt[3]); w.z = pk2(Rt[4], Rt[5]); w.w = pk2(Rt[6], Rt[7]); *(LAS u32x4*)(L + R1_RT + (t * PS + d0) * 2) = w;
        w.x = pk2(Bt[0], Bt[1]); w.y = pk2(Bt[2], Bt[3]); w.z = pk2(Bt[4], Bt[5]); w.w = pk2(Bt[6], Bt[7]); *(LAS u32x4*)(L + R1_BT + (t * PS + d0) * 2) = w;
        w.x = pk2(Kt[0], Kt[1]); w.y = pk2(Kt[2], Kt[3]); w.z = pk2(Kt[4], Kt[5]); w.w = pk2(Kt[6], Kt[7]); *(LAS u32x4*)(L + R1_KT + (t * PS + d0) * 2) = w;
        bpart += __shfl_xor(bpart, 1); bpart += __shfl_xor(bpart, 2); bpart += __shfl_xor(bpart, 4);
        const u32x4 gw = *(const LAS u32x4*)(L + R1_GS + (t * PS + d0) * 2);
        const float gv[8] = {bflo(gw.x), bfhi(gw.x), bflo(gw.y), bfhi(gw.y), bflo(gw.z), bfhi(gw.z), bflo(gw.w), bfhi(gw.w)};
        w.x = pk2(bpart * vx[0] * gv[0], bpart * vx[1] * gv[1]); w.y = pk2(bpart * vx[2] * gv[2], bpart * vx[3] * gv[3]);
        w.z = pk2(bpart * vx[4] * gv[4], bpart * vx[5] * gv[5]); w.w = pk2(bpart * vx[6] * gv[6], bpart * vx[7] * gv[7]);
        *(u32x4*)((bf16_t*)(p.ws + WS_OAB) + (size_t)row * D + 512 + h * 64 + d0) = w;
        *(u32x4*)(rw2 + 2 * RW2_ARR + (size_t)(t * 64 + d0) * 2) = gw;
    }
    LDS_BARRIER();
    R1P(3);
    {
        f32x4 gab[2], gak[2], grb[2], grk[2];
#pragma unroll
        for (int nn = 0; nn < 2; ++nn) { const int tn = 2 * (wave & 1) + nn;
            gab[nn] = (f32x4){0.f, 0.f, 0.f, 0.f}; gak[nn] = gab[nn]; grb[nn] = gab[nn]; grk[nn] = gab[nn];
            if (tn <= tm) {
#pragma unroll
                for (int s2 = 0; s2 < 2; ++s2) { const int ao = ((16 * tm + c15) * PS + 32 * s2 + 8 * g) * 2, bo = ((16 * tn + c15) * PS + 32 * s2 + 8 * g) * 2;
                    const bf16x8 fa = *(const LAS bf16x8*)(L + R1_AT + ao), fr_ = *(const LAS bf16x8*)(L + R1_RT + ao), fb = *(const LAS bf16x8*)(L + R1_BT + bo), fk = *(const LAS bf16x8*)(L + R1_KT + bo);
                    gab[nn] = mfma16(fa, fb, gab[nn]); gak[nn] = mfma16(fa, fk, gak[nn]); grb[nn] = mfma16(fr_, fb, grb[nn]); grk[nn] = mfma16(fr_, fk, grk[nn]); } } }
        LDS_BARRIER();
#pragma unroll
        for (int nn = 0; nn < 2; ++nn) { const int tn = 2 * (wave & 1) + nn, icol = 16 * tn + c15;
            f32x4 lab;
#pragma unroll
            for (int e = 0; e < 4; ++e) { const int tt = 16 * tm + 4 * g + e; const bool strict = icol < tt, incl = icol <= tt;
                lab[e] = strict ? gab[nn][e] : 0.f;
                *(LAS unsigned short*)(L + R1_LAK + (tt * PS + icol) * 2) = (unsigned short)f2bf(strict ? gak[nn][e] : 0.f);
                *(LAS unsigned short*)(L + R1_MRB + (tt * PS + icol) * 2) = (unsigned short)f2bf(incl ? grb[nn][e] : 0.f);
                *(LAS unsigned short*)(L + R1_MRK + (tt * PS + icol) * 2) = (unsigned short)f2bf(incl ? grk[nn][e] : 0.f); }
            *(LAS f32x4*)(L + R1_LABT + (icol * 64 + 16 * tm + 4 * g) * 4) = lab; }
    }
    LDS_BARRIER();
    R1P(4);
    {
#pragma unroll
        for (int nn = 0; nn < 2; ++nn) { const int tn = 2 * (wave & 1) + nn; f32x4 acc = {0.f, 0.f, 0.f, 0.f};
#pragma unroll
            for (int s2 = 0; s2 < 2; ++s2) acc = mfma16(*(const LAS bf16x8*)(L + R1_LAK + ((16 * tm + c15) * PS + 32 * s2 + 8 * g) * 2), *(const LAS bf16x8*)(L + R1_VT + ((16 * tn + c15) * PS + 32 * s2 + 8 * g) * 2), acc);
#pragma unroll
            for (int e = 0; e < 4; ++e) *(LAS float*)(L + R1_RHS + ((64 + 16 * tn + c15) * 65 + 16 * tm + 4 * g + e) * 4) = acc[e]; }
    }
    LDS_BARRIER();
    R1P(5);
    if (tid < 128) {
        LAS float* xr = (LAS float*)(L + R1_RHS + tid * 65 * 4);
#pragma unroll 1
        for (int Tb = 0; Tb < 4; ++Tb) {
            float acc[16];
#pragma unroll
            for (int e = 0; e < 16; ++e) acc[e] = xr[16 * Tb + e];
#pragma unroll 4
            for (int i = 0; i < 16 * Tb; ++i) { const float xi = xr[i];
#pragma unroll
                for (int q = 0; q < 4; ++q) { const f32x4 lv = *(const LAS f32x4*)(L + R1_LABT + (i * 64 + 16 * Tb + 4 * q) * 4);
#pragma unroll
                    for (int e = 0; e < 4; ++e) acc[4 * q + e] = fmaf(lv[e], xi, acc[4 * q + e]); } }
#pragma unroll
            for (int ii = 0; ii < 15; ++ii) { const float xi = acc[ii];
#pragma unroll
                for (int q = (ii + 1) / 4; q < 4; ++q) { const f32x4 lv = *(const LAS f32x4*)(L + R1_LABT + ((16 * Tb + ii) * 64 + 16 * Tb + 4 * q) * 4);
#pragma unroll
                    for (int e = 0; e < 4; ++e) if (4 * q + e > ii) acc[4 * q + e] = fmaf(lv[e], xi, acc[4 * q + e]); } }
#pragma unroll
            for (int e = 0; e < 16; ++e) xr[16 * Tb + e] = acc[e];
        }
        LAS unsigned char* dst = L + (tid < 64 ? R1_WT + tid * PS * 2 : R1_ZT + (tid - 64) * PS * 2);
#pragma unroll
        for (int q8 = 0; q8 < 8; ++q8) { u32x4 w; w.x = pk2(xr[8 * q8], xr[8 * q8 + 1]); w.y = pk2(xr[8 * q8 + 2], xr[8 * q8 + 3]); w.z = pk2(xr[8 * q8 + 4], xr[8 * q8 + 5]); w.w = pk2(xr[8 * q8 + 6], xr[8 * q8 + 7]); *(LAS u32x4*)(dst + q8 * 16) = w; }
    }
    LDS_BARRIER();
    R1P(6);
    {
        unsigned char* rw1 = p.ws + WS_RW1 + (size_t)unit * 16384;
#pragma unroll
        for (int nn = 0; nn < 2; ++nn) { const int tn = 2 * (wave & 1) + nn, col = 16 * tn + c15, r0 = 16 * tm + 4 * g;
            f32x4 aP = {0.f, 0.f, 0.f, 0.f}, aQ = aP, aG = aP, aY = aP;
#pragma unroll
            for (int s2 = 0; s2 < 2; ++s2) { const int ro = ((16 * tm + c15) * PS + 32 * s2 + 8 * g) * 2, co = ((16 * tn + c15) * PS + 32 * s2 + 8 * g) * 2;
                const bf16x8 fWT = *(const LAS bf16x8*)(L + R1_WT + ro), fBTT = *(const LAS bf16x8*)(L + R1_BTT + ro), fKTT = *(const LAS bf16x8*)(L + R1_KTT + ro), fMRB = *(const LAS bf16x8*)(L + R1_MRB + ro), fMRK = *(const LAS bf16x8*)(L + R1_MRK + ro);
                const bf16x8 cBTT = *(const LAS bf16x8*)(L + R1_BTT + co), cZT = *(const LAS bf16x8*)(L + R1_ZT + co), cVT = *(const LAS bf16x8*)(L + R1_VT + co), cMRB = *(const LAS bf16x8*)(L + R1_MRB + co);
                aP = mfma16(fWT, cBTT, aP);
                aQ = mfma16(fBTT, cZT, aQ); aQ = mfma16(fKTT, cVT, aQ);
                aG = mfma16(fWT, cMRB, aG);
                aY = mfma16(fMRB, cZT, aY); aY = mfma16(fMRK, cVT, aY); }
            const float gcc = *(const LAS float*)(L + R1_GC + col * 4);
            const f32x4 gcr = *(const LAS f32x4*)(L + R1_GC + r0 * 4);
            const u32x2 rtw = *(const LAS u32x2*)(L + R1_RT + (col * PS + r0) * 2);
#pragma unroll
            for (int e = 0; e < 4; ++e) { aP[e] = (aP[e] + ((r0 + e) == col ? 1.0f : 0.f)) * gcc; aQ[e] *= gcr[e]; }
            aG[0] += bflo(rtw.x); aG[1] += bfhi(rtw.x); aG[2] += bflo(rtw.y); aG[3] += bfhi(rtw.y);
            *(u32x2*)(rw1 + (size_t)(col * 64 + r0) * 2) = pk4(aP);
            *(u32x2*)(rw1 + 8192 + (size_t)(col * 64 + r0) * 2) = pk4(aG);
            *(u32x2*)(rw2 + (size_t)(col * 64 + r0) * 2) = pk4(aQ);
            *(u32x2*)(rw2 + RW2_ARR + (size_t)(col * 64 + r0) * 2) = pk4(aY); }
    }
    LDS_BARRIER();
    R1P(7);
}

constexpr int R2_SV = 0, R2_YS = 2 * 64 * PS * 2, R2_END = R2_YS + 2 * 64 * 68 * 4;
__device__ __forceinline__ void rwkv_scan(const Params& p, int l, int bh, unsigned char* lds) {
    const int tid = otid(), wave = tid >> 6, lane = tid & 63, c15 = lane & 15, g = lane >> 4;
    const int b = bh >> 3, h = bh & 7, role = wave >> 2, j = wave & 3, vcol = 16 * j + c15;
    LAS unsigned char* L = (LAS unsigned char*)lds;
    for (int i = tid; i < 2 * 64 * PS * 2 / 4; i += NTHREADS) ((LAS unsigned*)(L + R2_SV))[i] = 0u;
    LDS_BARRIER();
    const int et = tid >> 3, ev0 = 8 * (tid & 7);
    f32x4 gn0[2], gn1[2];
    { const float* gp = p.in[I_GNG] + l * 512 + h * 64 + ev0; const float* bp = p.in[I_GNB] + l * 512 + h * 64 + ev0;
      gn0[0] = *(const f32x4*)gp; gn0[1] = *(const f32x4*)(gp + 4); gn1[0] = *(const f32x4*)bp; gn1[1] = *(const f32x4*)(bp + 4); }
    bf16_t* OB = (bf16_t*)(p.ws + WS_OAB) + (size_t)(b * LP + et) * D + 512 + h * 64 + ev0;
    const int unit0 = (b * NCH) * 8 + h;
    const unsigned char* rw1b = p.ws + WS_RW1 + (role ? 8192 : 0) + (size_t)(c15 * 64 + 8 * g) * 2;
    const unsigned char* rw2b = p.ws + WS_RW2 + (role ? RW2_ARR : 0) + (size_t)(vcol * 64 + 4 * g) * 2;
    const unsigned char* ggb = p.ws + WS_RW2 + 2 * RW2_ARR + (size_t)(et * 64 + ev0) * 2;
    bf16x8 A0[4][2], A1[4][2]; u32x2 I0[4], I1[4];
    u32x4 G0 = {0u, 0u, 0u, 0u}, O0 = G0, G1, O1;
#define R2_LOAD(AA, II, cc) do { const size_t un_ = (size_t)(unit0 + 8 * ((cc) < NCH ? (cc) : NCH - 1)); \
        _Pragma("unroll") for (int m = 0; m < 4; ++m) { II[m] = *(const u32x2*)(rw2b + un_ * 8192 + 32 * m); \
            _Pragma("unroll") for (int s2 = 0; s2 < 2; ++s2) AA[m][s2] = *(const bf16x8*)(rw1b + un_ * 16384 + (16 * m * 64 + 32 * s2) * 2); } } while (0)
    R2_LOAD(A0, I0, 0); R2_LOAD(A1, I1, 1);
    G1 = *(const u32x4*)(ggb + (size_t)unit0 * 8192); O1 = *(const u32x4*)OB;
#pragma unroll 1
    for (int c = 0; c <= NCH; ++c) {
        const int cur = c & 1;
        bf16x8 A2[4][2]; u32x2 I2[4];
        R2_LOAD(A2, I2, c + 2);
        u32x4 G2, O2; { const int cn = c + 1 < NCH ? c + 1 : NCH - 1; G2 = *(const u32x4*)(ggb + (size_t)(unit0 + 8 * cn) * 8192); O2 = *(const u32x4*)(OB + (size_t)(64 * cn) * D); }
        if (c > 0) {
            const f32x4 y0 = *(const LAS f32x4*)(L + R2_YS + ((cur ^ 1) * 64 * 68 + et * 68 + ev0) * 4), y1 = *(const LAS f32x4*)(L + R2_YS + ((cur ^ 1) * 64 * 68 + et * 68 + ev0 + 4) * 4);
            float s1 = (y0[0] + y0[1]) + (y0[2] + y0[3]) + (y1[0] + y1[1]) + (y1[2] + y1[3]);
            s1 = sum8(s1); const float mean = s1 * (1.f / 64.f);
            const f32x4 d0 = y0 - mean, d1 = y1 - mean;
            float s2_ = (d0[0] * d0[0] + d0[1] * d0[1]) + (d0[2] * d0[2] + d0[3] * d0[3]) + (d1[0] * d1[0] + d1[1] * d1[1]) + (d1[2] * d1[2] + d1[3] * d1[3]);
            s2_ = sum8(s2_); const float rstd = rsqrtf(s2_ * (1.f / 64.f) + GN_EPS);
            const float gv[8] = {bflo(G0.x), bfhi(G0.x), bflo(G0.y), bfhi(G0.y), bflo(G0.z), bfhi(G0.z), bflo(G0.w), bfhi(G0.w)};
            const float ov[8] = {bflo(O0.x), bfhi(O0.x), bflo(O0.y), bfhi(O0.y), bflo(O0.z), bfhi(O0.z), bflo(O0.w), bfhi(O0.w)};
            float o[8];
#pragma unroll
            for (int i = 0; i < 4; ++i) { o[i] = ov[i] + (d0[i] * rstd * gn0[0][i] + gn1[0][i]) * gv[i]; o[4 + i] = ov[4 + i] + (d1[i] * rstd * gn0[1][i] + gn1[1][i]) * gv[4 + i]; }
            u32x4 w; w.x = pk2(o[0], o[1]); w.y = pk2(o[2], o[3]); w.z = pk2(o[4], o[5]); w.w = pk2(o[6], o[7]);
            *(u32x4*)(OB + (size_t)(64 * (c - 1)) * D) = w;
        }
        if (c < NCH) {
            bf16x8 bf_[2];
#pragma unroll
            for (int s2 = 0; s2 < 2; ++s2) bf_[s2] = *(const LAS bf16x8*)(L + R2_SV + cur * 64 * PS * 2 + (vcol * PS + 32 * s2 + 8 * g) * 2);
            f32x4 acc[4];
#pragma unroll
            for (int m = 0; m < 4; ++m) { acc[m] = (f32x4){bflo(I0[m].x), bfhi(I0[m].x), bflo(I0[m].y), bfhi(I0[m].y)};
#pragma unroll
                for (int s2 = 0; s2 < 2; ++s2) acc[m] = mfma16(A0[m][s2], bf_[s2], acc[m]); }
            if (role == 0) {
#pragma unroll
                for (int m = 0; m < 4; ++m) *(LAS u32x2*)(L + R2_SV + (cur ^ 1) * 64 * PS * 2 + (vcol * PS + 16 * m + 4 * g) * 2) = pk4(acc[m]);
            } else {
#pragma unroll
                for (int m = 0; m < 4; ++m)
#pragma unroll
                    for (int e = 0; e < 4; ++e) *(LAS float*)(L + R2_YS + (cur * 64 * 68 + (16 * m + 4 * g + e) * 68 + vcol) * 4) = acc[m][e];
            }
        }
        LDS_BARRIER();
#pragma unroll
        for (int m = 0; m < 4; ++m) { I0[m] = I1[m]; I1[m] = I2[m]; A0[m][0] = A1[m][0]; A0[m][1] = A1[m][1]; A1[m][0] = A2[m][0]; A1[m][1] = A2[m][1]; }
        G0 = G1; O0 = O1; G1 = G2; O1 = O2;
    }
#undef R2_LOAD
}

__device__ void rwkv_naive(const Params& p, int l, int bh, unsigned char* lds) {
    const int b = bh >> 3, h = bh & 7, tid = otid(), lane = tid & 63, wid = tid >> 6;
    const bf16_t* U = (const bf16_t*)(p.ws + WS_UAR);
    bf16_t* OB = (bf16_t*)(p.ws + WS_OAB);
    float* xs = (float*)lds;
    float* vr = xs + 32 * 256;
    float* vw = vr + 2048; float* vkk = vw + 2048; float* vbb = vkk + 2048; float* vk = vbb + 2048; float* vv = vk + 2048;
    float* gg = vv + 2048; float* bon = gg + 2048; float* ys = bon + 2048;
    const float* mu = p.in[I_MU] + l * R_COLS;
    const int hd = h * 64 + lane;
    const float w0 = p.in[I_W0][l * 512 + hd], a0 = p.in[I_A0][l * 512 + hd], kkc = p.in[I_KK][l * 512 + hd], kac = p.in[I_KA][l * 512 + hd], rkc = p.in[I_RK][l * 512 + hd];
    const float gng = p.in[I_GNG][l * 512 + hd], gnb = p.in[I_GNB][l * 512 + hd];
    const float mur = mu[hd], muk = mu[512 + hd], muv = mu[1024 + hd];
    const float* wup = p.in[I_WUP] + (size_t)l * 64 * 512 + hd; const float* aup = p.in[I_AUP] + (size_t)l * 64 * 512 + hd; const float* gup = p.in[I_GUP] + (size_t)l * 128 * 512 + hd;
    float S[8];
#pragma unroll
    for (int i = 0; i < 8; ++i) S[i] = 0.f;
    const int sv = tid >> 3, sq = tid & 7;
    for (int p0 = 0; p0 < LP; p0 += 32) {
        for (int idx = tid; idx < 32 * 256; idx += NTHREADS) {
            const int tt = idx >> 8, j = idx & 255, pos = p0 + tt; const size_t ro = (size_t)(b * LP + pos) * UARW;
            const float x = bf2f(U[ro + C_XW + j]); const float xp = pos > 0 ? bf2f(U[ro - UARW + C_XW + j]) : 0.f;
            float xv = x + (xp - x) * mu[1536 + j];
            if (j < 64) xv = tanhf(xv); else if (j >= 128) xv = sigmoidf_(xv);
            xs[idx] = xv;
        }
        __syncthreads();
        {
            float dw[4] = {0.f, 0.f, 0.f, 0.f}, da[4] = {0.f, 0.f, 0.f, 0.f}, dg[4] = {0.f, 0.f, 0.f, 0.f};
            for (int j = 0; j < 64; ++j) { const float w1 = wup[(size_t)j * 512], w2 = aup[(size_t)j * 512];
#pragma unroll
                for (int k = 0; k < 4; ++k) { dw[k] = fmaf(xs[(wid * 4 + k) * 256 + j], w1, dw[k]); da[k] = fmaf(xs[(wid * 4 + k) * 256 + 64 + j], w2, da[k]); } }
            for (int j = 0; j < 128; ++j) { const float w3 = gup[(size_t)j * 512];
#pragma unroll
                for (int k = 0; k < 4; ++k) dg[k] = fmaf(xs[(wid * 4 + k) * 256 + 128 + j], w3, dg[k]); }
#pragma unroll
            for (int k = 0; k < 4; ++k) {
                const int tt = wid * 4 + k, pos = p0 + tt; const size_t ro = (size_t)(b * LP + pos) * UARW;
                float r = bf2f(U[ro + C_R + hd]), kx = bf2f(U[ro + C_RK + hd]), vx = bf2f(U[ro + C_RV + hd]);
                if (pos > 0) { const float rp = bf2f(U[ro - UARW + C_R + hd]), kp = bf2f(U[ro - UARW + C_RK + hd]), vp = bf2f(U[ro - UARW + C_RV + hd]);
                    r += (rp - r) * mur; kx += (kp - kx) * muk; vx += (vp - vx) * muv; }
                else { r -= r * mur; kx -= kx * muk; vx -= vx * muv; }
                const float z = -(w0 + dw[k]); const float sp = fmaxf(z, 0.f) + log1pf(__expf(-fabsf(z)));
                const float logw = -sp - 0.5f; const float w = __expf(-__expf(logw));
                const float a = sigmoidf_(a0 + da[k]);
                float kk = kx * kkc; const float nrm = wave_sum(kk * kk); kk *= rsqrtf(fmaxf(nrm, 1e-24f));
                const float kmod = kx * (1.0f + (a - 1.0f) * kac);
                const float bsum = wave_sum(r * kmod * rkc);
                vr[tt * 64 + lane] = r; vw[tt * 64 + lane] = w; vkk[tt * 64 + lane] = kk; vbb[tt * 64 + lane] = kk * a; vk[tt * 64 + lane] = kmod; vv[tt * 64 + lane] = vx;
                gg[tt * 64 + lane] = dg[k]; bon[tt * 64 + lane] = bsum * vx;
            }
        }
        __syncthreads();
        for (int tt = 0; tt < 32; ++tt) {
            const f32x4 k0 = *(const f32x4*)(vkk + tt * 64 + sq * 8), k1 = *(const f32x4*)(vkk + tt * 64 + sq * 8 + 4);
            const f32x4 w0v = *(const f32x4*)(vw + tt * 64 + sq * 8), w1v = *(const f32x4*)(vw + tt * 64 + sq * 8 + 4);
            const f32x4 b0 = *(const f32x4*)(vbb + tt * 64 + sq * 8), b1 = *(const f32x4*)(vbb + tt * 64 + sq * 8 + 4);
            const f32x4 m0 = *(const f32x4*)(vk + tt * 64 + sq * 8), m1 = *(const f32x4*)(vk + tt * 64 + sq * 8 + 4);
            const f32x4 r0 = *(const f32x4*)(vr + tt * 64 + sq * 8), r1 = *(const f32x4*)(vr + tt * 64 + sq * 8 + 4);
            const float vt = vv[tt * 64 + sv];
            float sa = 0.f;
#pragma unroll
            for (int i = 0; i < 4; ++i) { sa = fmaf(S[i], k0[i], sa); sa = fmaf(S[4 + i], k1[i], sa); }
            sa += __shfl_xor(sa, 1); sa += __shfl_xor(sa, 2); sa += __shfl_xor(sa, 4);
            sa = -sa; float y = 0.f;
#pragma unroll
            for (int i = 0; i < 4; ++i) { S[i] = S[i] * w0v[i] + sa * b0[i] + vt * m0[i]; S[4 + i] = S[4 + i] * w1v[i] + sa * b1[i] + vt * m1[i];
                y = fmaf(S[i], r0[i], y); y = fmaf(S[4 + i], r1[i], y); }
            y += __shfl_xor(y, 1); y += __shfl_xor(y, 2); y += __shfl_xor(y, 4);
            if (sq == 0) ys[tt * 64 + sv] = y;
        }
        __syncthreads();
#pragma unroll
        for (int k = 0; k < 4; ++k) { const int tt = wid * 4 + k, pos = p0 + tt; const float y = ys[tt * 64 + lane];
            const float m = wave_sum(y) * (1.f / 64.f); const float dv = y - m; const float var = wave_sum(dv * dv) * (1.f / 64.f);
            const float o = (dv * rsqrtf(var + GN_EPS) * gng + gnb + bon[tt * 64 + lane]) * gg[tt * 64 + lane];
            OB[(size_t)(b * LP + pos) * D + 512 + hd] = (bf16_t)f2bf(o); }
        __syncthreads();
    }
}

__device__ __forceinline__ int pair_index(int a, int b) {   return a == 0 ? b - 1 : (a == 1 ? b + 1 : 5); }
__device__ __forceinline__ void pair_of(int idx, int& a, int& b) { a = idx < 3 ? 0 : (idx < 5 ? 1 : 2); b = idx < 3 ? idx + 1 : (idx < 5 ? idx - 1 : 3); }
__device__ __forceinline__ void ln1_router_phase(const Params& p, int l, unsigned char* lds) {
    const int tid = otid(), lane = tid & 63, gw = obid() * NWAVES + (tid >> 6), NGW = gridDim.x * NWAVES;
    int* lcnt = (int*)(lds + 65536); int* lbase = lcnt + 32; int* rec = lcnt + 64;
    if (tid < 32) lcnt[tid] = 0;
    float* wr_s = (float*)lds;
    for (int i = tid; i < D * 16 / 4; i += NTHREADS) { const f32x4 w = ((const f32x4*)p.in[I_WROUTER])[i]; const int c = i >> 2, e0 = (i & 3) * 4;
        wr_s[(e0 + 0) * D + c] = w[0]; wr_s[(e0 + 1) * D + c] = w[1]; wr_s[(e0 + 2) * D + c] = w[2]; wr_s[(e0 + 3) * D + c] = w[3]; }
    __syncthreads();
    unsigned* cls_cnt = (unsigned*)(p.ws + WS_CTL) + CW_CLS + l * 512;
    int* lists = (int*)(p.ws + WS_LIST); f32x2* gl = (f32x2*)(p.ws + WS_LIST + 2 * MiB);
    const float* g = p.in[I_LN1G] + l * D; const float* bt = p.in[I_LN1B] + l * D;
    f32x4 vn[4];
    { const float* h0 = hrow(p, gw < T ? gw : 0);
#pragma unroll
      for (int j = 0; j < 4; ++j) vn[j] = *(const f32x4*)(h0 + 4 * lane + 256 * j); }
    int nrec = 0;
    for (int r = gw; r < T; r += NGW) {
        f32x4 v[4];
#pragma unroll
        for (int j = 0; j < 4; ++j) v[j] = vn[j];
        { const float* h1 = hrow(p, r + NGW < T ? r + NGW : r);
#pragma unroll
          for (int j = 0; j < 4; ++j) vn[j] = *(const f32x4*)(h1 + 4 * lane + 256 * j); }
        if (is_dummy(r)) {
#pragma unroll
            for (int j = 0; j < 4; ++j) v[j] = (f32x4){0.f, 0.f, 0.f, 0.f};
            store_row(p, r, v, lane, true); continue; }
        ln_wave(v, g, bt, lane);
        store_row(p, r, v, lane, false);
        float lg[16];
#pragma unroll
        for (int e = 0; e < 16; ++e) lg[e] = 0.f;
#pragma unroll
        for (int e = 0; e < 16; ++e)
#pragma unroll
            for (int j = 0; j < 4; ++j) { const f32x4 w = *(const f32x4*)(wr_s + e * D + 4 * lane + 256 * j);
                lg[e] = fmaf(v[j][0], w[0], lg[e]); lg[e] = fmaf(v[j][1], w[1], lg[e]); lg[e] = fmaf(v[j][2], w[2], lg[e]); lg[e] = fmaf(v[j][3], w[3], lg[e]); }
        float mine = 0.f;
#pragma unroll
        for (int e = 0; e < 16; ++e) { const float rs = sum16(lg[e]); mine = (lane & 15) == e ? rs : mine; }
        mine += __shfl_xor(mine, 16); mine += __shfl_xor(mine, 32);
#pragma unroll
        for (int e = 0; e < 16; ++e) lg[e] = __builtin_bit_cast(float, __builtin_amdgcn_readlane(__builtin_bit_cast(int, mine), e));
        float s[16], sel[16];
#pragma unroll
        for (int e = 0; e < 16; ++e) { s[e] = sigmoidf_(lg[e]); sel[e] = s[e] + p.in[I_BROUTER][e]; }
        int gbest = 0; float gsc = -INFINITY;
#pragma unroll
        for (int gi = 0; gi < 4; ++gi) { float m1 = -INFINITY, m2 = -INFINITY;
#pragma unroll
            for (int j = 0; j < 4; ++j) { const float x = sel[gi * 4 + j]; if (x > m1) { m2 = m1; m1 = x; } else if (x > m2) m2 = x; }
            const float sc = m1 + m2; if (sc > gsc) { gsc = sc; gbest = gi; } }
        float sg[4], sgs[4];
#pragma unroll
        for (int j = 0; j < 4; ++j) { sg[j] = gbest == 0 ? sel[j] : (gbest == 1 ? sel[4 + j] : (gbest == 2 ? sel[8 + j] : sel[12 + j])); sgs[j] = gbest == 0 ? s[j] : (gbest == 1 ? s[4 + j] : (gbest == 2 ? s[8 + j] : s[12 + j])); }
        int j1 = 0;
#pragma unroll
        for (int j = 1; j < 4; ++j) if (sg[j] > sg[j1]) j1 = j;
        int j2 = j1 == 0 ? 1 : 0;
#pragma unroll
        for (int j = 0; j < 4; ++j) if (j != j1 && j != j2 && sg[j] > sg[j2]) j2 = j;
        const int ja = j1 < j2 ? j1 : j2, jb = j1 < j2 ? j2 : j1;
        float sa_ = 0.f, sb_ = 0.f;
#pragma unroll
        for (int j = 0; j < 4; ++j) { if (j == ja) sa_ = sgs[j]; if (j == jb) sb_ = sgs[j]; }
        const float inv = 1.0f / (sa_ + sb_);
        const int cls = gbest * 6 + pair_index(ja, jb);
        if (lane == 0) { const int loc = __hip_atomic_fetch_add(lcnt + cls, 1, __ATOMIC_RELAXED, __HIP_MEMORY_SCOPE_WORKGROUP); rec[(tid >> 6) * 32 + 2 * nrec] = r; rec[(tid >> 6) * 32 + 2 * nrec + 1] = (cls << 16) | loc; gl[r] = (f32x2){sa_ * inv, sb_ * inv}; }
        ++nrec;
    }
    __syncthreads();
    if (tid < 24) lbase[tid] = (int)atomicAdd(cls_cnt + 16 * tid, (unsigned)lcnt[tid]);
    __syncthreads();
    if (lane < nrec) { const int r = rec[(tid >> 6) * 32 + 2 * lane], cl = rec[(tid >> 6) * 32 + 2 * lane + 1]; const int cls = cl >> 16; lists[(size_t)cls * T + lbase[cls] + (cl & 0xffff)] = r; }
}

struct ClsTab { int cnt[24]; int tile0[25]; int row0[24]; };
__device__ __forceinline__ void build_cls_table(const Params& p, int l, int* tab  ) {
    if (otid() == 0) { const unsigned* c = (const unsigned*)(p.ws + WS_CTL) + CW_CLS + l * 512; int acc = 0;
        for (int i = 0; i < 24; ++i) { const int n = (int)__hip_atomic_load(c + 16 * i, __ATOMIC_RELAXED, __HIP_MEMORY_SCOPE_AGENT); tab[i] = n; tab[24 + i] = acc; acc += (n + 255) >> 8; }
        tab[48] = acc; }
    __syncthreads();
}
__device__ __forceinline__ int find_cls(const int* tab, int tile) { int c = 0;
#pragma unroll 1
    for (int i = 1; i < 24; ++i) if (tile >= tab[24 + i]) c = i;
    return c; }
__device__ __forceinline__ void moe_a_phase(const Params& p, int l, LAS unsigned char* lds, const int* tab) {
    const int tid = otid();
    unsigned voffB[2]; g8::make_voffB(voffB, D * 2, true);
    const int ntiles = tab[48], nunits = ntiles * 8;
    for (int u = obid(); u < nunits; u += gridDim.x) {
        const int tile = u >> 3, pn = u & 7, cls = find_cls(tab, tile), rt = tile - tab[24 + cls], n = tab[cls];
        int ja, jb; pair_of(cls % 6, ja, jb); const int eslot = pn >> 2, e = (cls / 6) * 4 + (eslot ? jb : ja), jblk = pn & 3;
        unsigned voffA[2][2]; { const int* lists = (const int*)(PP().ws + WS_LIST);
#pragma unroll
        for (int i = 0; i < 2; ++i) { int R, C; g8::stage_rc(tid * 16 + i * 8192, R, C);
#pragma unroll
            for (int hh = 0; hh < 2; ++hh) { const int li = rt * 256 + R + hh * 128; const int tok = li < n ? lists[(size_t)cls * T + li] : 0;
                voffA[hh][i] = (unsigned)tok * (D * 2) + (unsigned)C * 2u; } } }
        g8::Acc acc; g8::zero_acc(acc);
        const char* Bb = (const char*)(PP().ws + WS_WEXP) + ((size_t)e * 1024 + jblk * 256) * D * 2;
        const g8::KSeg s = g8::seg1((const char*)(PP().ws + WS_HB), Bb, Bb + (size_t)128 * D * 2, D / 64);
        g8::kloop<true, false>(lds, acc, s, voffA, voffB, 0);
        EPI_COORDS();
        const int* lists = (const int*)(PP().ws + WS_LIST); const f32x2* gl = (const f32x2*)(PP().ws + WS_LIST + 2 * MiB); bf16_t* ACT = (bf16_t*)(PP().ws + WS_ACT);
#pragma unroll
        for (int ai = 0; ai < 2; ++ai)
#pragma unroll
            for (int m = 0; m < 4; ++m) { asm volatile("" ::: "memory"); const int li = rt * 256 + ai * 128 + wr * 64 + m * 16 + fr; const int tok = li < n ? lists[(size_t)cls * T + li] : -1;
                float gate = 0.f; if (tok >= 0) { const f32x2 g2 = gl[tok]; gate = eslot ? g2[1] : g2[0]; }
                const f32x4 h1a = acc[ai][0][m][0], h1b = acc[ai][0][m][1], h3a = acc[ai][1][m][0], h3b = acc[ai][1][m][1];
                float o[8];
#pragma unroll
                for (int c = 0; c < 4; ++c) { o[c] = gate * (h1a[c] * sigmoidf_(h1a[c])) * h3a[c]; o[4 + c] = gate * (h1b[c] * sigmoidf_(h1b[c])) * h3b[c]; }
                u32x4 w; w.x = pk2(o[0], o[1]); w.y = pk2(o[2], o[3]); w.z = pk2(o[4], o[5]); w.w = pk2(o[6], o[7]);
                *(u32x4*)(ACT + (size_t)(tile * 256 + ai * 128 + wr * 64 + m * 16 + fr) * D + eslot * 512 + jblk * 128 + wc * 32 + 8 * fq) = w; }
    }
}
__device__ __forceinline__ void moe_b_phase(const Params& p, int l, LAS unsigned char* lds, const int* tab) {
    unsigned voffA[2][2], voffB[2]; g8::make_voff_contig(voffA, D * 2); g8::make_voffB(voffB, 512 * 2, false);
    const int ntiles = tab[48], nunits = ntiles * 4;
    for (int u = obid(); u < nunits; u += gridDim.x) {
        const int tile = u >> 2, pn = u & 3, cls = find_cls(tab, tile), rt = tile - tab[24 + cls], n = tab[cls];
        int ja, jb; pair_of(cls % 6, ja, jb); const int ea = (cls / 6) * 4 + ja, eb = (cls / 6) * 4 + jb;
        g8::Acc acc; g8::zero_acc(acc);
        const char* At = (const char*)(PP().ws + WS_ACT) + (size_t)tile * 256 * D * 2;
        const char* W2 = (const char*)(PP().ws + WS_WEXP + 32 * MiB);
        const char* Ba = W2 + ((size_t)ea * 1024 + pn * 256) * 512 * 2; const char* Bb = W2 + ((size_t)eb * 1024 + pn * 256) * 512 * 2;
        g8::KSeg s2 = g8::seg1(At, Ba, Ba + (size_t)128 * 512 * 2, 16); s2.nt0 = 8; s2.A2 = At + 1024; s2.B02 = Bb; s2.B12 = Bb + (size_t)128 * 512 * 2;
        g8::kloop<false, true>(lds, acc, s2, voffA, voffB, 128 * D * 2);
        EPI_COORDS();
        const int* lists = (const int*)(PP().ws + WS_LIST);
        const int col0 = pn * 256 + wc * 32 + 4 * fq;
        int tk[2][4];
#pragma unroll
        for (int ai = 0; ai < 2; ++ai)
#pragma unroll
            for (int m = 0; m < 4; ++m) { const int li = rt * 256 + ai * 128 + wr * 64 + m * 16 + fr; tk[ai][m] = li < n ? lists[(size_t)cls * T + li] : -1; }
#pragma unroll
        for (int ai = 0; ai < 2; ++ai) { asm volatile("" ::: "memory");
            f32x4 pre[4][2][2]; float* hr[4];
#pragma unroll
            for (int m = 0; m < 4; ++m) { hr[m] = hrow(PP(), tk[ai][m] >= 0 ? tk[ai][m] : 0) + col0;
#pragma unroll
                for (int bj = 0; bj < 2; ++bj)
#pragma unroll
                    for (int nn = 0; nn < 2; ++nn) pre[m][bj][nn] = *(const f32x4*)(hr[m] + bj * 128 + nn * 16); }
#pragma unroll
            for (int m = 0; m < 4; ++m) if (tk[ai][m] >= 0) {
#pragma unroll
                for (int bj = 0; bj < 2; ++bj)
#pragma unroll
                    for (int nn = 0; nn < 2; ++nn) *(f32x4*)(hr[m] + bj * 128 + nn * 16) = pre[m][bj][nn] * ALPHA + acc[ai][bj][m][nn]; } }
    }
}
__device__ __forceinline__ void ln2_phase(const Params& p, int l) {
    const int tid = otid(), lane = tid & 63, gw = obid() * NWAVES + (tid >> 6), NGW = gridDim.x * NWAVES;
    const float* g = p.in[I_LN2G] + l * D; const float* bt = p.in[I_LN2B] + l * D;
    for (int r = gw; r < T; r += NGW) {
        f32x4 v[4];
        if (is_dummy(r)) {
#pragma unroll
            for (int j = 0; j < 4; ++j) v[j] = (f32x4){0.f, 0.f, 0.f, 0.f};
            store_row(p, r, v, lane, true); continue; }
        const float* hr = hrow(p, r);
#pragma unroll
        for (int j = 0; j < 4; ++j) v[j] = *(const f32x4*)(hr + 4 * lane + 256 * j);
        ln_wave(v, g, bt, lane);
        store_row(p, r, v, lane, false);
    }
}


#define XB_TMO      128
#define XB_XCNT(j)  (256  + 64 * (j))
#define XB_XSUB(j)  (1280 + 64 * (j))
#define XB_XGEN(j)  (2304 + 64 * (j))
#define XB_TOP      3328
#define XB_TOPGEN   3392
#define XCD_BAR_WORDS 3456
#define XB_SPIN_CAP (1u << 22)
constexpr size_t WS_BAR = 8192;
constexpr int LDS_BARST = LDS_BYTES - 16;
__device__ __forceinline__ unsigned xb_ld(unsigned* p)              { return __hip_atomic_load(p, __ATOMIC_RELAXED, __HIP_MEMORY_SCOPE_AGENT); }
__device__ __forceinline__ unsigned xb_add(unsigned* p, unsigned v) { return __hip_atomic_fetch_add(p, v, __ATOMIC_RELAXED, __HIP_MEMORY_SCOPE_AGENT); }
__device__ __forceinline__ unsigned xb_xcc_id() { return (unsigned)__builtin_amdgcn_s_getreg((3 << 11) | 20) & 0xFu; }
#define XB_SPIN(cond, bar) do { unsigned _sp = 0; while (cond) { __builtin_amdgcn_s_sleep(1); \
    if ((++_sp & 255u) == 0u) { if (xb_ld(&(bar)[XB_TMO])) break; if (_sp > XB_SPIN_CAP) { atomicAdd(&(bar)[XB_TMO], 1u); break; } } } } while (0)
__device__ __forceinline__ void xcd_barrier_complete(unsigned* bar, unsigned x, unsigned& nloc, unsigned& nx) {
    const unsigned G = gridDim.x * gridDim.y * gridDim.z;
    unsigned sum, cnt, mine, sp = 0u;
    for (;;) {
        sum = 0u; cnt = 0u; mine = 0u;
#pragma unroll
        for (unsigned j = 0; j < 16; ++j) { const unsigned c = xb_ld(&bar[XB_XCNT(j)]); sum += c; cnt += (c > 0u) ? 1u : 0u; mine = (j == x) ? c : mine; }
        if (sum == G) break;
        __builtin_amdgcn_s_sleep(1);
        if ((++sp & 255u) == 0u) { if (xb_ld(&bar[XB_TMO])) break; if (sp > XB_SPIN_CAP) { atomicAdd(&bar[XB_TMO], 1u); break; } }
    }
    nloc = mine > 0u ? mine : 1u; nx = cnt > 0u ? cnt : 1u;
}
__device__ __forceinline__ void xcd_barrier(unsigned* bar, volatile LAS unsigned* st) {
    asm volatile("s_waitcnt vmcnt(0)" ::: "memory");
    __syncthreads();
    if (threadIdx.x == 0) {
        __builtin_amdgcn_s_waitcnt(0);
        const unsigned x = xb_xcc_id();
        unsigned nloc = st[0], nx = st[1];
        if (nloc == 0u) { xcd_barrier_complete(bar, x, nloc, nx); st[0] = nloc; st[1] = nx; }
        const unsigned old = xb_add(&bar[XB_XSUB(x)], 1u);
        const unsigned gen = old / nloc;
        if (old + 1u == (gen + 1u) * nloc) {
            __builtin_amdgcn_fence(__ATOMIC_RELEASE, "agent");
            asm volatile("s_waitcnt vmcnt(0)" ::: "memory");
            const unsigned og = xb_add(&bar[XB_TOP], 1u);
            const unsigned tg = og / nx;
            if (og + 1u == (tg + 1u) * nx) xb_add(&bar[XB_TOPGEN], 1u);
            else XB_SPIN(xb_ld(&bar[XB_TOPGEN]) == tg, bar);
            __builtin_amdgcn_fence(__ATOMIC_ACQUIRE, "agent");
            xb_add(&bar[XB_XGEN(x)], 1u);
            asm volatile("s_waitcnt vmcnt(0)" ::: "memory");
        } else {
            XB_SPIN(xb_ld(&bar[XB_XGEN(x)]) == gen, bar);
            __builtin_amdgcn_fence(__ATOMIC_ACQUIRE, "agent");
            asm volatile("s_waitcnt vmcnt(0)" ::: "memory");
        }
    }
    __syncthreads();
}

__global__ void __launch_bounds__(NTHREADS, 2) mega(Params p_unused) {
    extern __shared__ __attribute__((aligned(16))) unsigned char lds[];
    cg::grid_group grid = cg::this_grid();
    volatile LAS unsigned* barst = (volatile LAS unsigned*)((LAS unsigned char*)lds + LDS_BARST);
    { unsigned* bar0 = (unsigned*)(PP().ws + WS_BAR);
      if (threadIdx.x == 0) { barst[0] = 0u; barst[1] = 0u; (void)xb_add(bar0 + XB_XCNT(xb_xcc_id()), 1u); } }
    __syncthreads();
#define GBAR() xcd_barrier((unsigned*)(PP().ws + WS_BAR), barst)
    unsigned long long pr_t0 = 0, pr_acc = 0;
#define PH_BEGIN(k) do { if (PROBE_PHASE == (k)) pr_t0 = __builtin_amdgcn_s_memrealtime(); } while (0)
#define PH_END(k) do { if (PROBE_PHASE == (k)) pr_acc += __builtin_amdgcn_s_memrealtime() - pr_t0; } while (0)
#define LDSG() (lds + ozero())
#define LDSL() ((LAS unsigned char*)lds)

    PH_BEGIN(0);
    conv_small_weights(PP(), LDSL());
    ln_in_phase(PP());
    grid.sync();
    PH_END(0);
#pragma unroll 1
    for (int l = 0; l < DEPTH; ++l) {
        PH_BEGIN(1);
        inproj_phase(PP(), l, LDSL());
        GBAR();
        PH_END(1); PH_BEGIN(2);
        if (PROBE_PHASE == 30) pr_t0 = __builtin_amdgcn_s_memrealtime();
        {
            unsigned* qctr = (unsigned*)(PP().ws + WS_CTL) + CW_R1Q + 2 * l;
            volatile int* uw = (volatile int*)(LDSG() + AT_UNIT);
            int ndone = 0;
            for (;;) {
                __syncthreads();
                if (otid() == 0) *uw = (int)atomicAdd(qctr, 1u);
                __syncthreads();
                const int u = *uw;
                if (u >= BATCH * NCH * 8) break;
                rwkv_prep_unit(PP(), l, u, LDSG(), pr_acc); ++ndone;
            }
            asm volatile("s_waitcnt vmcnt(0)" ::: "memory");
            __syncthreads();
            if (otid() == 0 && ndone > 0) { __builtin_amdgcn_fence(__ATOMIC_RELEASE, "agent"); asm volatile("s_waitcnt vmcnt(0)" ::: "memory"); __hip_atomic_fetch_add(qctr + 1, (unsigned)ndone, __ATOMIC_RELAXED, __HIP_MEMORY_SCOPE_AGENT); }
            const int bid = obid();
            if (bid < 32) {
                if (otid() == 0) { unsigned sp = 0; while (__hip_atomic_load(qctr + 1, __ATOMIC_RELAXED, __HIP_MEMORY_SCOPE_AGENT) < (unsigned)(BATCH * NCH * 8) && ++sp < (1u << 26)) __builtin_amdgcn_s_sleep(4);
                    __builtin_amdgcn_fence(__ATOMIC_ACQUIRE, "agent"); asm volatile("s_waitcnt vmcnt(0)" ::: "memory"); }
                __syncthreads();
                rwkv_scan(PP(), l, bid, LDSG());
            }
            attn_phase(PP(), l, LDSG(), pr_acc);
        }
        GBAR();
        PH_END(3); PH_BEGIN(4);
        merge_phase(PP(), l, LDSL());
        GBAR();
        PH_END(4); PH_BEGIN(5);
        wout_phase(PP(), l, LDSL());
        conv_expert_weights(PP(), l, LDSL());
        GBAR();
        PH_END(5); PH_BEGIN(6);
        ln1_router_phase(PP(), l, LDSG());
        GBAR();
        PH_END(6); PH_BEGIN(7);
        { int toff = 140 * 1024; asm volatile("" : "+s"(toff)); int* tab = (int*)(lds + toff);
          build_cls_table(PP(), l, tab);
          moe_a_phase(PP(), l, LDSL(), tab);
          GBAR();
          PH_END(7); PH_BEGIN(8);
          moe_b_phase(PP(), l, LDSL(), tab); }
        GBAR();
        PH_END(8); PH_BEGIN(9);
        ln2_phase(PP(), l);
        if (l + 1 < DEPTH) GBAR();
        PH_END(9);
    }
    if (PROBE_PHASE >= 0 && blockIdx.x == PROBE_BLOCK && threadIdx.x == 0) { const unsigned long long t = __builtin_amdgcn_s_memrealtime(); while (__builtin_amdgcn_s_memrealtime() - t < pr_acc) __builtin_amdgcn_s_sleep(8); }
}

extern "C" void kernel_launch(void* const* d_in, const int* in_sizes, int n_in, void* d_out, int out_size,
                              void* d_ws, size_t ws_size, hipStream_t stream) {
    static int grid_blocks = 0;
    if (grid_blocks == 0) {
        int dev = 0, cus = 0, per_cu = 0;
        if (n_in != 29 || ws_size < WS_END || out_size != BATCH * SEQ * D) { fprintf(stderr, "kernel_launch: unexpected problem (n_in %d, ws %zu, out %d)\n", n_in, ws_size, out_size); grid_blocks = -1; return; }
        (void)hipGetDevice(&dev);
        (void)hipDeviceGetAttribute(&cus, hipDeviceAttributeMultiprocessorCount, dev);
        (void)hipFuncSetAttribute((const void*)mega, hipFuncAttributeMaxDynamicSharedMemorySize, LDS_BYTES);
        (void)hipOccupancyMaxActiveBlocksPerMultiprocessor(&per_cu, (const void*)mega, NTHREADS, LDS_BYTES);
        if (per_cu < 1) { fprintf(stderr, "occupancy query returned %d\n", per_cu); grid_blocks = -1; return; }
        grid_blocks = cus;
    }
    if (grid_blocks < 0) return;
    (void)hipMemsetAsync((char*)d_ws + WS_CTL, 0, 32768, stream);
    Params p{};
    for (int i = 0; i < 29; ++i) p.in[i] = (const float*)d_in[i];
    p.out = (float*)d_out; p.ws = (unsigned char*)d_ws;
    void* args[] = {&p};
    hipError_t e = hipLaunchCooperativeKernel((const void*)mega, dim3(grid_blocks), dim3(NTHREADS), args, LDS_BYTES, stream);
    if (e != hipSuccess) fprintf(stderr, "cooperative launch failed: %s (grid %d)\n", hipGetErrorString(e), grid_blocks);
}
```

```cpp
#include <hip/hip_runtime.h>
#include <hip/hip_cooperative_groups.h>
#include <cstdio>
#include <cstdint>
namespace cg = cooperative_groups;

#define LAS __attribute__((address_space(3)))
typedef unsigned short bf16_t;
typedef short bf16x8 __attribute__((ext_vector_type(8)));
typedef float f32x4 __attribute__((ext_vector_type(4)));
typedef float f32x2 __attribute__((ext_vector_type(2)));
typedef unsigned u32x4 __attribute__((ext_vector_type(4)));
typedef unsigned u32x2 __attribute__((ext_vector_type(2)));

constexpr int NTHREADS = 512, NWAVES = 8;
constexpr int D = 1024, BATCH = 4, SEQ = 4096, DEPTH = 2;
constexpr int LP = 4160;
constexpr int T = BATCH * LP;
constexpr int NCH = LP / 64;
constexpr int PADM = 48;
constexpr int A_COLS = 1064, R_COLS = 1792, IN_COLS = 4904;
constexpr int UA = 1280;
constexpr int UARW = 3072;
constexpr int NIN = 5120;
constexpr float LN_EPS = 1e-5f, GN_EPS = 64e-5f;
constexpr float ALPHA = 1.41421356237309515f;
constexpr int C_Q = 0, C_K = 512, C_V = 640, C_QI = 768, C_KI = 1024, C_WI = 1056;
constexpr int C_R = UA, C_RK = UA + 512, C_RV = UA + 1024, C_XW = UA + 1536, C_XA = UA + 1600, C_XG = UA + 1664;

constexpr size_t MiB = 1u << 20;
constexpr size_t WS_CTL = 0;
constexpr size_t WS_HM = 1 * MiB;
constexpr size_t WS_WSMALL = 2 * MiB;
constexpr size_t WSMALL_LAYER = 14 * MiB;
constexpr size_t WS_HB = 30 * MiB;
constexpr size_t WS_UAR = 63 * MiB;
constexpr size_t WS_GATES = 161 * MiB;
constexpr size_t WS_OAB = 226 * MiB;
constexpr size_t WS_LIST = WS_GATES + 48 * MiB;
constexpr size_t WS_END = 308 * MiB;
constexpr size_t WS_MERGED = WS_UAR;
constexpr size_t WS_ACT = WS_UAR + 33 * MiB;
constexpr size_t WS_WEXP = WS_GATES;
constexpr int ACT_ROWS_MAX = 16448 + 24 * 256;
static_assert(WS_ACT + (size_t)ACT_ROWS_MAX * 2048 <= WS_GATES, "act fits");
constexpr int CW_CLS = 1024;

constexpr int LDS_BYTES = 155648;

struct Params {
    const float* in[29];
    float* out;
    unsigned char* ws;
};
enum { I_X = 0, I_META, I_LNIN_G, I_LNIN_B, I_WIN, I_BGATE, I_MU, I_W0, I_WUP, I_A0, I_AUP, I_GUP, I_KK, I_KA, I_RK, I_GNG, I_GNB,
       I_WBA, I_WBB, I_WOUT, I_LN1G, I_LN1B, I_LN2G, I_LN2B, I_WROUTER, I_BROUTER, I_WEXP1, I_WEXP3, I_WEXP2 };

__device__ __forceinline__ int otid() { int t = threadIdx.x; asm volatile("" : "+v"(t)); return t; }
__device__ __forceinline__ const char* uptr(const char* p) { const unsigned long long v = (unsigned long long)p; const unsigned lo = __builtin_amdgcn_readfirstlane((unsigned)v), hi = __builtin_amdgcn_readfirstlane((unsigned)(v >> 32)); return (const char*)(((unsigned long long)hi << 32) | lo); }
__device__ __forceinline__ int ozero() { int z = 0; asm volatile("" : "+s"(z)); return z; }
__device__ __forceinline__ int obid() { int b = blockIdx.x; asm volatile("" : "+s"(b)); return b; }
typedef __bf16 bf16x2_t __attribute__((ext_vector_type(2)));
__device__ __forceinline__ unsigned f2bf(float f) { return (unsigned)__builtin_bit_cast(unsigned short, (__bf16)f); }
__device__ __forceinline__ unsigned pk2(float lo, float hi) { const f32x2 v = {lo, hi}; return __builtin_bit_cast(unsigned, __builtin_convertvector(v, bf16x2_t)); }
template <int CTRL> __device__ __forceinline__ float dpp_f(float v) { return __builtin_bit_cast(float, __builtin_amdgcn_update_dpp(0, __builtin_bit_cast(int, v), CTRL, 0xF, 0xF, true)); }
__device__ __forceinline__ float sum8(float v) { v += dpp_f<0xB1>(v); v += dpp_f<0x4E>(v); v += dpp_f<0x141>(v); return v; }
__device__ __forceinline__ float sum16(float v) { v = sum8(v); v += dpp_f<0x140>(v); return v; }
__device__ __forceinline__ float bf2f(unsigned short b) { return __builtin_bit_cast(float, (unsigned)b << 16); }
__device__ __forceinline__ float bflo(unsigned w) { return __builtin_bit_cast(float, w << 16); }
__device__ __forceinline__ float bfhi(unsigned w) { return __builtin_bit_cast(float, w & 0xffff0000u); }
__device__ __forceinline__ float wave_sum(float v) { v = sum16(v); v += __shfl_xor(v, 16); v += __shfl_xor(v, 32); return v; }
__device__ __forceinline__ float wave_max(float v) {
#pragma unroll
    for (int o = 1; o < 64; o <<= 1) v = fmaxf(v, __shfl_xor(v, o));
    return v;
}
__device__ __forceinline__ float sigmoidf_(float x) { return 1.0f / (1.0f + __expf(-x)); }
__device__ __forceinline__ float* hrow(const Params& p, int r) {
    const int b = r / LP, pos = r - b * LP;
    return pos >= 64 ? p.out + ((size_t)(b * SEQ + (pos - 64)) << 10) : (float*)(p.ws + WS_HM) + ((size_t)(b * 64 + pos) << 10);
}
__device__ __forceinline__ bool is_dummy(int r) { return (r % LP) < PADM; }

__device__ __forceinline__ void transpose_item(const float* src, int ld_src, int col0, int nvalid, bf16_t* dst  , int ld_dst, LAS float* scr, int lane) {
    const int kr = lane >> 3, c4 = (lane & 7) * 4;
    f32x4 v[8];
#pragma unroll
    for (int i = 0; i < 8; ++i) v[i] = *(const f32x4*)(src + (size_t)(8 * i + kr) * ld_src + col0 + c4);
#pragma unroll
    for (int i = 0; i < 8; ++i) { LAS float* w = scr + (8 * i + kr) * 33 + c4;
        w[0] = c4 + 0 < nvalid ? v[i][0] : 0.f; w[1] = c4 + 1 < nvalid ? v[i][1] : 0.f; w[2] = c4 + 2 < nvalid ? v[i][2] : 0.f; w[3] = c4 + 3 < nvalid ? v[i][3] : 0.f; }
    asm volatile("s_waitcnt lgkmcnt(0)" ::: "memory");
    const int ch = lane & 7;
#pragma unroll
    for (int j = 0; j < 4; ++j) { const int n = (lane >> 3) + 8 * j; const LAS float* s = scr + (8 * ch) * 33 + n;
        u32x4 o; o.x = pk2(s[0 * 33], s[1 * 33]); o.y = pk2(s[2 * 33], s[3 * 33]); o.z = pk2(s[4 * 33], s[5 * 33]); o.w = pk2(s[6 * 33], s[7 * 33]);
        *(u32x4*)(dst + (size_t)n * ld_dst + 8 * ch) = o; }
    asm volatile("s_waitcnt lgkmcnt(0)" ::: "memory");
}

namespace g8 {
constexpr int BM = 256, BK = 64, HALF = 128, HTB = HALF * BK * 2, STAGE_BYTES = 8 * HTB;
__host__ __device__ __forceinline__ int lds_byte(int r, int c) { const int st = (r >> 4) * 2 + (c >> 5), rr = r & 15, cc = c & 31, ob = rr * 64 + cc * 2; return st * 1024 + (ob ^ (((ob >> 9) & 1) << 5)); }
__host__ __device__ __forceinline__ void stage_rc(int b, int& R, int& C) { const int st = b / 1024, sb = b % 1024, swz = sb ^ (((sb >> 9) & 1) << 5); R = (st >> 1) * 16 + swz / 64; C = (st & 1) * 32 + (swz % 64) / 2; }
__host__ __device__ __forceinline__ int perm32(int rho) { const int n = rho >> 4, i = rho & 15; return 8 * (i >> 2) + 4 * n + (i & 3); }

struct KSeg {
    const char* A;
    const char* B0;
    const char* B1;
    int nt;
    int nt0;
    const char* A2;
    const char* B02;
    const char* B12;
};
__device__ __forceinline__ KSeg seg1(const char* A, const char* B0, const char* B1, int nt) { KSeg s; s.A = A; s.B0 = B0; s.B1 = B1; s.nt = nt; s.nt0 = nt; s.A2 = A; s.B02 = B0; s.B12 = B1; return s; }
typedef f32x4 Acc[2][2][4][2];

template <bool GATHER, bool TWOSEG>
__device__ __forceinline__ void kloop(LAS unsigned char* lds, Acc& acc, const KSeg s, const unsigned (&voffA)[2][2], const unsigned (&voffB)[2], const unsigned hstepA) {
    int tid = threadIdx.x; asm volatile("" : "+v"(tid));
    const int wid = __builtin_amdgcn_readfirstlane(tid >> 6), lane = tid & 63, wr = wid >> 2, wc = wid & 3, fr = lane & 15, fq = lane >> 4;
    const unsigned ldsw = (unsigned)wid * 1024u;
    const int aoff = lds_byte(wr * 64 + fr, fq * 8), boff = lds_byte(wc * 32 + fr, fq * 8);
    const int nt = __builtin_amdgcn_readfirstlane(s.nt);
#define G8_SA(b, h) (((b) * 2 + (h)) * HTB)
#define G8_SB(b, h) ((4 + (b) * 2 + (h)) * HTB)
#define G8_STAGE(bufoff, gbase, voff) do { _Pragma("unroll") for (int _i = 0; _i < 2; ++_i) \
        __builtin_amdgcn_global_load_lds((const unsigned*)((const char*)(gbase) + (voff)[_i]), (LAS unsigned*)(lds + (bufoff) + ldsw + _i * 8192), 16, 0, 0); } while (0)
#define G8_LDA(dst, b, h) do { _Pragma("unroll") for (int m = 0; m < 4; ++m) _Pragma("unroll") for (int k = 0; k < 2; ++k) dst[m][k] = *(const LAS bf16x8*)(lds + G8_SA(b, h) + aoff + m * 2048 + k * 1024); } while (0)
#define G8_LDB(dst, b, h) do { _Pragma("unroll") for (int n = 0; n < 2; ++n) _Pragma("unroll") for (int k = 0; k < 2; ++k) dst[n][k] = *(const LAS bf16x8*)(lds + G8_SB(b, h) + boff + n * 2048 + k * 1024); } while (0)
#define G8_MMA(ai, bj, At, Bt) do { __builtin_amdgcn_s_setprio(1); _Pragma("unroll") for (int m = 0; m < 4; ++m) _Pragma("unroll") for (int n = 0; n < 2; ++n) _Pragma("unroll") for (int k = 0; k < 2; ++k) \
        acc[ai][bj][m][n] = __builtin_amdgcn_mfma_f32_16x16x32_bf16(Bt[n][k], At[m][k], acc[ai][bj][m][n], 0, 0, 0); __builtin_amdgcn_s_setprio(0); } while (0)
#define G8_WAIT_V(n) asm volatile("s_waitcnt vmcnt(" #n ")" ::: "memory")
#define G8_WAIT_L(n) asm volatile("s_waitcnt lgkmcnt(" #n ")" ::: "memory")
#define G8_BAR __builtin_amdgcn_s_barrier()
#define G8_SCHED __builtin_amdgcn_sched_barrier(0)
    bf16x8 At[4][2], B0[2][2], B1[2][2];
    const char* pA = uptr(s.A); const char* pB0 = uptr(s.B0); const char* pB1 = uptr(s.B1);
    constexpr int KS = BK * 2;
    const int nt0 = TWOSEG ? s.nt0 : 0; const char* qA = TWOSEG ? uptr(s.A2 - (size_t)nt0 * KS) : pA; const char* qB0 = TWOSEG ? uptr(s.B02 - (size_t)nt0 * KS) : pB0; const char* qB1 = TWOSEG ? uptr(s.B12 - (size_t)nt0 * KS) : pB1;
#define G8_TA(t) ((TWOSEG ? ((t) < nt0 ? pA : qA) : pA) + (size_t)(t) * KS)
#define G8_TB0(t) ((TWOSEG ? ((t) < nt0 ? pB0 : qB0) : pB0) + (size_t)(t) * KS)
#define G8_TB1(t) ((TWOSEG ? ((t) < nt0 ? pB1 : qB1) : pB1) + (size_t)(t) * KS)
#define G8_VA1 voffA[GATHER ? 1 : 0]
#define G8_H1(ptr) ((ptr) + (GATHER ? 0u : hstepA))
    G8_STAGE(G8_SB(0, 0), pB0, voffB); G8_STAGE(G8_SA(0, 0), pA, voffA[0]); G8_STAGE(G8_SB(0, 1), pB1, voffB); G8_STAGE(G8_SA(0, 1), G8_H1(pA), G8_VA1);
    if (wr == 1) G8_BAR;
    G8_WAIT_V(4); G8_BAR;
    G8_STAGE(G8_SB(1, 0), pB0 + KS, voffB); G8_STAGE(G8_SA(1, 0), pA + KS, voffA[0]); G8_STAGE(G8_SB(1, 1), pB1 + KS, voffB);
    G8_WAIT_V(6); G8_BAR;
    for (int t = 0; t < nt - 2; t += 2) {
        const char* a1 = G8_TA(t + 1);
        const char* a2 = G8_TA(t + 2); const char* b02 = G8_TB0(t + 2); const char* b12 = G8_TB1(t + 2);
        const char* a3 = G8_TA(t + 3); const char* b03 = G8_TB0(t + 3); const char* b13 = G8_TB1(t + 3);
        G8_LDB(B0, 0, 0); G8_SCHED; G8_LDA(At, 0, 0); G8_STAGE(G8_SA(1, 1), G8_H1(a1), G8_VA1);
        G8_WAIT_L(8); G8_BAR; G8_WAIT_L(0); G8_MMA(0, 0, At, B0); G8_BAR; G8_SCHED;
        G8_LDB(B1, 0, 1); G8_STAGE(G8_SB(0, 0), b02, voffB);
        G8_BAR; G8_WAIT_L(0); G8_MMA(0, 1, At, B1); G8_BAR;
        G8_LDA(At, 0, 1); G8_STAGE(G8_SA(0, 0), a2, voffA[0]);
        G8_BAR; G8_WAIT_L(0); G8_MMA(1, 0, At, B0); G8_BAR; G8_SCHED;
        G8_STAGE(G8_SB(0, 1), b12, voffB);
        G8_WAIT_V(6); G8_BAR; G8_MMA(1, 1, At, B1); G8_BAR;
        G8_LDB(B0, 1, 0); G8_SCHED; G8_LDA(At, 1, 0); G8_STAGE(G8_SA(0, 1), G8_H1(a2), G8_VA1);
        G8_WAIT_L(8); G8_BAR; G8_WAIT_L(0); G8_MMA(0, 0, At, B0); G8_BAR; G8_SCHED;
        G8_LDB(B1, 1, 1); G8_STAGE(G8_SB(1, 0), b03, voffB);
        G8_BAR; G8_WAIT_L(0); G8_MMA(0, 1, At, B1); G8_BAR;
        G8_LDA(At, 1, 1); G8_STAGE(G8_SA(1, 0), a3, voffA[0]);
        G8_BAR; G8_WAIT_L(0); G8_MMA(1, 0, At, B0); G8_BAR; G8_SCHED;
        G8_STAGE(G8_SB(1, 1), b13, voffB);
        G8_WAIT_V(6); G8_BAR; G8_MMA(1, 1, At, B1); G8_BAR;
    }
    { const char* a1 = G8_TA(nt - 1);
      G8_LDB(B0, 0, 0); G8_LDA(At, 0, 0); G8_STAGE(G8_SA(1, 1), G8_H1(a1), G8_VA1);
      G8_BAR; G8_WAIT_L(0); G8_MMA(0, 0, At, B0); G8_BAR;
      G8_LDB(B1, 0, 1); G8_BAR; G8_WAIT_L(0); G8_MMA(0, 1, At, B1); G8_BAR;
      G8_LDA(At, 0, 1); G8_WAIT_V(4); G8_BAR; G8_WAIT_L(0); G8_MMA(1, 0, At, B0); G8_MMA(1, 1, At, B1); G8_BAR; }
    { G8_LDB(B0, 1, 0); G8_LDA(At, 1, 0); G8_WAIT_V(2); G8_BAR; G8_WAIT_L(0); G8_MMA(0, 0, At, B0); G8_BAR;
      G8_LDB(B1, 1, 1); G8_WAIT_V(0); G8_BAR; G8_WAIT_L(0); G8_MMA(0, 1, At, B1); G8_BAR;
      G8_LDA(At, 1, 1); G8_BAR; G8_WAIT_L(0); G8_MMA(1, 0, At, B0); G8_MMA(1, 1, At, B1); G8_BAR; }
    if (wr == 0) G8_BAR;
#undef G8_TA
#undef G8_VA1
#undef G8_H1
#undef G8_TB0
#undef G8_TB1
#undef G8_SA
#undef G8_SB
#undef G8_STAGE
#undef G8_LDA
#undef G8_LDB
#undef G8_MMA
#undef G8_WAIT_V
#undef G8_WAIT_L
#undef G8_BAR
#undef G8_SCHED
}
template <bool GATHER, bool TWOSEG>
__device__ __forceinline__ void kstream(LAS unsigned char* lds, Acc& acc, const KSeg s, const KSeg nx, const bool first, const unsigned (&voffA)[2][2], const unsigned (&voffB)[2], const unsigned hstepA) {
    int tid = threadIdx.x; asm volatile("" : "+v"(tid));
    const int wid = __builtin_amdgcn_readfirstlane(tid >> 6), lane = tid & 63, wr = wid >> 2, wc = wid & 3, fr = lane & 15, fq = lane >> 4;
    const unsigned ldsw = (unsigned)wid * 1024u;
    const int aoff = lds_byte(wr * 64 + fr, fq * 8), boff = lds_byte(wc * 32 + fr, fq * 8);
    const int nt = __builtin_amdgcn_readfirstlane(s.nt);
#define G8_SA(b, h) (((b) * 2 + (h)) * HTB)
#define G8_SB(b, h) ((4 + (b) * 2 + (h)) * HTB)
#define G8_STAGE(bufoff, gbase, voff) do { _Pragma("unroll") for (int _i = 0; _i < 2; ++_i) \
        __builtin_amdgcn_global_load_lds((const unsigned*)((const char*)(gbase) + (voff)[_i]), (LAS unsigned*)(lds + (bufoff) + ldsw + _i * 8192), 16, 0, 0); } while (0)
#define G8_LDA(dst, b, h) do { _Pragma("unroll") for (int m = 0; m < 4; ++m) _Pragma("unroll") for (int k = 0; k < 2; ++k) dst[m][k] = *(const LAS bf16x8*)(lds + G8_SA(b, h) + aoff + m * 2048 + k * 1024); } while (0)
#define G8_LDB(dst, b, h) do { _Pragma("unroll") for (int n = 0; n < 2; ++n) _Pragma("unroll") for (int k = 0; k < 2; ++k) dst[n][k] = *(const LAS bf16x8*)(lds + G8_SB(b, h) + boff + n * 2048 + k * 1024); } while (0)
#define G8_MMA(ai, bj, At, Bt) do { __builtin_amdgcn_s_setprio(1); _Pragma("unroll") for (int m = 0; m < 4; ++m) _Pragma("unroll") for (int n = 0; n < 2; ++n) _Pragma("unroll") for (int k = 0; k < 2; ++k) \
        acc[ai][bj][m][n] = __builtin_amdgcn_mfma_f32_16x16x32_bf16(Bt[n][k], At[m][k], acc[ai][bj][m][n], 0, 0, 0); __builtin_amdgcn_s_setprio(0); } while (0)
#define G8_WAIT_V(n) asm volatile("s_waitcnt vmcnt(" #n ")" ::: "memory")
#define G8_WAIT_L(n) asm volatile("s_waitcnt lgkmcnt(" #n ")" ::: "memory")
#define G8_BAR __builtin_amdgcn_s_barrier()
#define G8_SCHED __builtin_amdgcn_sched_barrier(0)
    bf16x8 At[4][2], B0[2][2], B1[2][2];
    const char* pA = uptr(s.A); const char* pB0 = uptr(s.B0); const char* pB1 = uptr(s.B1);
    constexpr int KS = BK * 2;
    const int nt0 = TWOSEG ? s.nt0 : 0; const char* qA = TWOSEG ? uptr(s.A2 - (size_t)nt0 * KS) : pA; const char* qB0 = TWOSEG ? uptr(s.B02 - (size_t)nt0 * KS) : pB0; const char* qB1 = TWOSEG ? uptr(s.B12 - (size_t)nt0 * KS) : pB1;
    const char* nA = uptr(nx.A) - (size_t)nt * KS; const char* nB0 = uptr(nx.B0) - (size_t)nt * KS; const char* nB1 = uptr(nx.B1) - (size_t)nt * KS;
#define G8_TA(t) (((t) >= nt ? nA : (TWOSEG ? ((t) < nt0 ? pA : qA) : pA)) + (size_t)(t) * KS)
#define G8_TB0(t) (((t) >= nt ? nB0 : (TWOSEG ? ((t) < nt0 ? pB0 : qB0) : pB0)) + (size_t)(t) * KS)
#define G8_TB1(t) (((t) >= nt ? nB1 : (TWOSEG ? ((t) < nt0 ? pB1 : qB1) : pB1)) + (size_t)(t) * KS)
#define G8_VA1 voffA[GATHER ? 1 : 0]
#define G8_H1(ptr) ((ptr) + (GATHER ? 0u : hstepA))
    if (first) {
    G8_STAGE(G8_SB(0, 0), pB0, voffB); G8_STAGE(G8_SA(0, 0), pA, voffA[0]); G8_STAGE(G8_SB(0, 1), pB1, voffB); G8_STAGE(G8_SA(0, 1), G8_H1(pA), G8_VA1);
    if (wr == 1) G8_BAR;
    G8_WAIT_V(4); G8_BAR;
    G8_STAGE(G8_SB(1, 0), pB0 + KS, voffB); G8_STAGE(G8_SA(1, 0), pA + KS, voffA[0]); G8_STAGE(G8_SB(1, 1), pB1 + KS, voffB);
    G8_WAIT_V(6); G8_BAR;
    }
    for (int t = 0; t < nt; t += 2) {
        const char* a1 = G8_TA(t + 1);
        const char* a2 = G8_TA(t + 2); const char* b02 = G8_TB0(t + 2); const char* b12 = G8_TB1(t + 2);
        const char* a3 = G8_TA(t + 3); const char* b03 = G8_TB0(t + 3); const char* b13 = G8_TB1(t + 3);
        G8_LDB(B0, 0, 0); G8_SCHED; G8_LDA(At, 0, 0); G8_STAGE(G8_SA(1, 1), G8_H1(a1), G8_VA1);
        G8_WAIT_L(8); G8_BAR; G8_WAIT_L(0); G8_MMA(0, 0, At, B0); G8_BAR; G8_SCHED;
        G8_LDB(B1, 0, 1); G8_STAGE(G8_SB(0, 0), b02, voffB);
        G8_BAR; G8_WAIT_L(0); G8_MMA(0, 1, At, B1); G8_BAR;
        G8_LDA(At, 0, 1); G8_STAGE(G8_SA(0, 0), a2, voffA[0]);
        G8_BAR; G8_WAIT_L(0); G8_MMA(1, 0, At, B0); G8_BAR; G8_SCHED;
        G8_STAGE(G8_SB(0, 1), b12, voffB);
        G8_WAIT_V(6); G8_BAR; G8_MMA(1, 1, At, B1); G8_BAR;
        G8_LDB(B0, 1, 0); G8_SCHED; G8_LDA(At, 1, 0); G8_STAGE(G8_SA(0, 1), G8_H1(a2), G8_VA1);
        G8_WAIT_L(8); G8_BAR; G8_WAIT_L(0); G8_MMA(0, 0, At, B0); G8_BAR; G8_SCHED;
        G8_LDB(B1, 1, 1); G8_STAGE(G8_SB(1, 0), b03, voffB);
        G8_BAR; G8_WAIT_L(0); G8_MMA(0, 1, At, B1); G8_BAR;
        G8_LDA(At, 1, 1); G8_STAGE(G8_SA(1, 0), a3, voffA[0]);
        G8_BAR; G8_WAIT_L(0); G8_MMA(1, 0, At, B0); G8_BAR; G8_SCHED;
        G8_STAGE(G8_SB(1, 1), b13, voffB);
        G8_WAIT_V(6); G8_BAR; G8_MMA(1, 1, At, B1); G8_BAR;
    }
#undef G8_TA
#undef G8_VA1
#undef G8_H1
#undef G8_TB0
#undef G8_TB1
#undef G8_SA
#undef G8_SB
#undef G8_STAGE
#undef G8_LDA
#undef G8_LDB
#undef G8_MMA
#undef G8_WAIT_V
#undef G8_WAIT_L
#undef G8_BAR
#undef G8_SCHED
}
__device__ __forceinline__ void kstream_end() { asm volatile("s_waitcnt vmcnt(0)" ::: "memory"); __builtin_amdgcn_s_barrier(); }
__device__ __forceinline__ void zero_acc(Acc& acc) {
#pragma unroll
    for (int a = 0; a < 2; ++a)
#pragma unroll
        for (int b = 0; b < 2; ++b)
#pragma unroll
            for (int m = 0; m < 4; ++m)
#pragma unroll
                for (int n = 0; n < 2; ++n) acc[a][b][m][n] = (f32x4){0.f, 0.f, 0.f, 0.f};
}
__device__ __forceinline__ void make_voff_contig(unsigned (&voffA)[2][2], unsigned pitchA) {
    int tid = threadIdx.x; asm volatile("" : "+v"(tid));
#pragma unroll
    for (int i = 0; i < 2; ++i) { int R, C; stage_rc(tid * 16 + i * 8192, R, C);
        voffA[0][i] = (unsigned)R * pitchA + (unsigned)C * 2u; voffA[1][i] = 0u; }
}
__device__ __forceinline__ void make_voffB(unsigned (&voffB)[2], unsigned pitchB, bool perm) {
    int tid = threadIdx.x; asm volatile("" : "+v"(tid));
#pragma unroll
    for (int i = 0; i < 2; ++i) { int R, C; stage_rc(tid * 16 + i * 8192, R, C); const int Rb = perm ? ((R & ~31) + perm32(R & 31)) : R;
        voffB[i] = (unsigned)Rb * pitchB + (unsigned)C * 2u; }
}
}

__device__ __forceinline__ bool unit_order(int i, int G, int c, int nM, int nN, int& pm, int& pn) {
    const int nwg = nM * nN; const long L = (long)i * G + c; if (L >= nwg) return false;
    int wgid = (int)L; { const int q = nwg / 8, r = nwg % 8, xcd = wgid % 8, off = wgid / 8; wgid = (xcd < r ? xcd * (q + 1) : r * (q + 1) + (xcd - r) * q) + off; }
    const int WGM = 8, nig = WGM * nN, gid = wgid / nig, fm = gid * WGM, gsz = (nM - fm) < WGM ? (nM - fm) : WGM;
    pm = fm + ((wgid % nig) % gsz); pn = (wgid % nig) / gsz; return true;
}

__device__ __forceinline__ void conv_small_weights(const Params& p, LAS unsigned char* lds) {
    const int tid = otid(), lane = tid & 63, wave = tid >> 6, gw = obid() * NWAVES + wave, NGW = gridDim.x * NWAVES;
    LAS float* scr = (LAS float*)(lds + wave * 16384);
    constexpr int I_IN = 16 * (NIN / 32), I_A = 8 * 32, I_O = 16 * 32, I_L = 64, PER = I_IN + 2 * I_A + I_O + I_L;
    for (int it = gw; it < DEPTH * PER; it += NGW) {
        const int l = it / PER; int r = it % PER;
        unsigned char* wl = p.ws + WS_WSMALL + (size_t)l * WSMALL_LAYER;
        if (r < I_IN) { const int kb = r / (NIN / 32), nb = r % (NIN / 32), n0 = nb * 32, k0 = kb * 64;
            int col0, nvalid; if (n0 < UA) { col0 = n0; nvalid = A_COLS - n0; nvalid = nvalid < 0 ? 0 : (nvalid > 32 ? 32 : nvalid); } else { col0 = n0 - (UA - A_COLS); nvalid = 32; }
            transpose_item(p.in[I_WIN] + (size_t)l * D * IN_COLS + (size_t)k0 * IN_COLS, IN_COLS, col0, nvalid, (bf16_t*)wl + (size_t)n0 * D + k0, D, scr, lane); continue; }
        r -= I_IN;
        if (r < 2 * I_A) { const int which = r / I_A; r %= I_A; const int kb = r / 32, nb = r % 32;
            const float* src = p.in[which ? I_WBB : I_WBA] + (size_t)l * 512 * D + (size_t)(kb * 64) * D;
            transpose_item(src, D, nb * 32, 32, (bf16_t*)(wl + (10 + which) * MiB) + (size_t)(nb * 32) * 512 + kb * 64, 512, scr, lane); continue; }
        r -= 2 * I_A;
        if (r < I_O) { const int kb = r / 32, nb = r % 32;
          transpose_item(p.in[I_WOUT] + (size_t)l * D * D + (size_t)(kb * 64) * D, D, nb * 32, 32, (bf16_t*)(wl + 12 * MiB) + (size_t)(nb * 32) * D + kb * 64, D, scr, lane); continue; }
        r -= I_O;
        { bf16_t* lo = (bf16_t*)(p.ws + 65536 + (size_t)l * 262144);
          if (r < 16) transpose_item(p.in[I_WUP] + (size_t)l * 64 * 512, 512, r * 32, 32, lo + (size_t)(r * 32) * 64, 64, scr, lane);
          else if (r < 32) transpose_item(p.in[I_AUP] + (size_t)l * 64 * 512, 512, (r - 16) * 32, 32, lo + 32768 + (size_t)((r - 16) * 32) * 64, 64, scr, lane);
          else { const int q = r - 32, kb = q >> 4, nb = q & 15; transpose_item(p.in[I_GUP] + (size_t)l * 128 * 512 + (size_t)(kb * 64) * 512, 512, nb * 32, 32, lo + 65536 + (size_t)(nb * 32) * 128 + kb * 64, 128, scr, lane); } }
    }
}
__device__ __forceinline__ void conv_expert_items(const Params& p, int l, LAS unsigned char* lds, int it0, int it1) {
    const int tid = otid(), lane = tid & 63, wave = tid >> 6, gw = it0 + wave, NGW = NWAVES;
    LAS float* scr = (LAS float*)(lds + wave * 16384);
    constexpr int I_13 = 16 * 32, I_2 = 8 * 32, PER = I_13 + I_2;
    for (int it = gw; it < it1; it += NGW) {
        const int e = it / PER; int r = it % PER;
        if (r < I_13) { const int kb = r / 32, nb = r % 32, n0 = nb * 32, j = n0 >> 8, half = (n0 >> 7) & 1, c = 128 * j + (n0 & 127);
            const float* src = p.in[half ? I_WEXP3 : I_WEXP1] + (size_t)(l * 16 + e) * D * 512 + (size_t)(kb * 64) * 512;
            transpose_item(src, 512, c, 32, (bf16_t*)(p.ws + WS_WEXP) + (size_t)e * 1024 * 1024 + (size_t)n0 * 1024 + kb * 64, 1024, scr, lane); continue; }
        r -= I_13;
        { const int kb = r / 32, nb = r % 32;
          const float* src = p.in[I_WEXP2] + (size_t)(l * 16 + e) * 512 * D + (size_t)(kb * 64) * D;
          transpose_item(src, D, nb * 32, 32, (bf16_t*)(p.ws + WS_WEXP + 32 * MiB) + (size_t)e * 1024 * 512 + (size_t)(nb * 32) * 512 + kb * 64, 512, scr, lane); }
    }
}

__device__ __forceinline__ void ln_wave(f32x4 (&v)[4], const float* g, const float* bta, int lane) {
    float s = 0.f;
#pragma unroll
    for (int j = 0; j < 4; ++j) s += (v[j][0] + v[j][1]) + (v[j][2] + v[j][3]);
    const float mean = wave_sum(s) * (1.f / D); float s2 = 0.f;
#pragma unroll
    for (int j = 0; j < 4; ++j) { v[j] = v[j] - mean; s2 += (v[j][0] * v[j][0] + v[j][1] * v[j][1]) + (v[j][2] * v[j][2] + v[j][3] * v[j][3]); }
    const float rstd = 1.f / sqrtf(wave_sum(s2) * (1.f / D) + LN_EPS);
#pragma unroll
    for (int j = 0; j < 4; ++j) { const f32x4 gg = *(const f32x4*)(g + 4 * lane + 256 * j), bb = *(const f32x4*)(bta + 4 * lane + 256 * j); v[j] = v[j] * rstd * gg + bb; }
}
__device__ __forceinline__ void store_row(const Params& p, int r, const f32x4 (&v)[4], int lane, bool zero) {
    float* hr = hrow(p, r); bf16_t* hb = (bf16_t*)(p.ws + WS_HB) + (size_t)r * D;
#pragma unroll
    for (int j = 0; j < 4; ++j) { const f32x4 o = zero ? (f32x4){0.f, 0.f, 0.f, 0.f} : v[j];
        *(f32x4*)(hr + 4 * lane + 256 * j) = o; u32x2 w; w.x = pk2(o[0], o[1]); w.y = pk2(o[2], o[3]); *(u32x2*)(hb + 4 * lane + 256 * j) = w; }
}
__device__ __forceinline__ void ln_in_phase(const Params& p) {
    const int tid = otid(), lane = tid & 63, gw = obid() * NWAVES + (tid >> 6), NGW = gridDim.x * NWAVES;
    for (int r = gw; r < T; r += NGW) {
        const int b = r / LP, pos = r - b * LP; f32x4 v[4];
        if (pos < PADM) {
#pragma unroll
            for (int j = 0; j < 4; ++j) v[j] = (f32x4){0.f, 0.f, 0.f, 0.f};
            store_row(p, r, v, lane, true); continue; }
        const float* src = pos < 64 ? p.in[I_META] + (size_t)(pos - PADM) * D : p.in[I_X] + ((size_t)(b * SEQ + pos - 64) << 10);
#pragma unroll
        for (int j = 0; j < 4; ++j) v[j] = *(const f32x4*)(src + 4 * lane + 256 * j);
        ln_wave(v, p.in[I_LNIN_G], p.in[I_LNIN_B], lane);
        store_row(p, r, v, lane, false);
    }
}

__device__ __forceinline__ const Params& PP() { const Params* q = (const Params*)__builtin_amdgcn_kernarg_segment_ptr(); asm volatile("" : "+s"(q)); return *q; }

#define EPI_COORDS() int tid_ = threadIdx.x; asm volatile("" : "+v"(tid_)); const int wid = tid_ >> 6, lane = tid_ & 63, wr = wid >> 2, wc = wid & 3, fr = lane & 15, fq = lane >> 4; (void)wr; (void)wc; (void)fr; (void)fq
__device__ __forceinline__ void inproj_phase(const Params& p, int l, LAS unsigned char* lds) {
    unsigned voffA[2][2], voffB[2]; g8::make_voff_contig(voffA, D * 2); g8::make_voffB(voffB, D * 2, true);
    int pm, pn, pm2 = 0, pn2 = 0; const int bid = obid(); const int wr_ = __builtin_amdgcn_readfirstlane(otid() >> 6) >> 2;
    bool has = unit_order(0, gridDim.x, bid, T / 256, NIN / 256, pm, pn), first = true;
    g8::Acc acc; g8::zero_acc(acc);
    for (int i = 0; has; ++i) {
        const bool hasn = unit_order(i + 1, gridDim.x, bid, T / 256, NIN / 256, pm2, pn2);
        const char* Ab = (const char*)(PP().ws + WS_HB); const char* Bb = (const char*)(PP().ws + WS_WSMALL + (size_t)l * WSMALL_LAYER);
        const g8::KSeg s = g8::seg1(Ab + (size_t)pm * 256 * D * 2, Bb + (size_t)pn * 256 * D * 2, Bb + (size_t)(pn * 256 + 128) * D * 2, D / 64);
        const int pmn = hasn ? pm2 : pm, pnn = hasn ? pn2 : pn;
        const g8::KSeg nx = g8::seg1(Ab + (size_t)pmn * 256 * D * 2, Bb + (size_t)pnn * 256 * D * 2, Bb + (size_t)(pnn * 256 + 128) * D * 2, D / 64);
        if (!first && wr_ == 1) __builtin_amdgcn_s_barrier();
        g8::kstream<false, false>(lds, acc, s, nx, first, voffA, voffB, 128 * D * 2); first = false;
        if (wr_ == 0) __builtin_amdgcn_s_barrier();
        EPI_COORDS();
        const int row0 = pm * 256 + wr * 64 + fr;
        if (pn < 12) {
            bf16_t* O = (bf16_t*)(PP().ws + WS_UAR);
#pragma unroll
            for (int ai = 0; ai < 2; ++ai)
#pragma unroll
                for (int m = 0; m < 4; ++m) { asm volatile("" ::: "memory"); bf16_t* rp = O + (size_t)(row0 + ai * 128 + m * 16) * UARW + pn * 256 + wc * 32 + 8 * fq;
#pragma unroll
                    for (int bj = 0; bj < 2; ++bj) { const f32x4 v0 = acc[ai][bj][m][0], v1 = acc[ai][bj][m][1]; u32x4 w; w.x = pk2(v0[0], v0[1]); w.y = pk2(v0[2], v0[3]); w.z = pk2(v1[0], v1[1]); w.w = pk2(v1[2], v1[3]);
                        *(u32x4*)(rp + bj * 128) = w; } }
        } else {
            bf16_t* O = (bf16_t*)(PP().ws + WS_GATES); const int colb = (pn - 12) * 256 + wc * 32 + 8 * fq; const float* bg = PP().in[I_BGATE] + l * 2048;
            f32x4 bv[2][2];
#pragma unroll
            for (int bj = 0; bj < 2; ++bj) { bv[bj][0] = *(const f32x4*)(bg + colb + bj * 128); bv[bj][1] = *(const f32x4*)(bg + colb + bj * 128 + 4); }
#pragma unroll
            for (int ai = 0; ai < 2; ++ai)
#pragma unroll
                for (int m = 0; m < 4; ++m) { asm volatile("" ::: "memory"); bf16_t* rp = O + (size_t)(row0 + ai * 128 + m * 16) * 2048 + colb;
#pragma unroll
                    for (int bj = 0; bj < 2; ++bj) { f32x4 v0 = acc[ai][bj][m][0] + bv[bj][0], v1 = acc[ai][bj][m][1] + bv[bj][1];
#pragma unroll
                        for (int e = 0; e < 4; ++e) { v0[e] = sigmoidf_(v0[e]); v1[e] = sigmoidf_(v1[e]); }
                        u32x4 w; w.x = pk2(v0[0], v0[1]); w.y = pk2(v0[2], v0[3]); w.z = pk2(v1[0], v1[1]); w.w = pk2(v1[2], v1[3]);
                        *(u32x4*)(rp + bj * 128) = w; } }
        }
        g8::zero_acc(acc); has = hasn; pm = pm2; pn = pn2;
    }
    if (!first) g8::kstream_end();
}
__device__ __forceinline__ void merge_unit(int l, LAS unsigned char* lds, int pm, int pn) {
    unsigned voffA[2][2], voffB[2]; g8::make_voff_contig(voffA, D * 2); g8::make_voffB(voffB, 512 * 2, true);
    {
#pragma unroll 1
        for (int br = 0; br < 2; ++br) {
            g8::Acc acc; g8::zero_acc(acc);
            const char* Bt = (const char*)(PP().ws + WS_WSMALL + (size_t)l * WSMALL_LAYER) + (10 + br) * MiB + (size_t)pn * 256 * 512 * 2;
            const g8::KSeg s = g8::seg1((const char*)(PP().ws + WS_OAB) + (size_t)pm * 256 * D * 2 + br * 1024, Bt, Bt + (size_t)128 * 512 * 2, 8);
            g8::kloop<false, false>(lds, acc, s, voffA, voffB, 128 * D * 2);
            EPI_COORDS();
            const bf16_t* GT = (const bf16_t*)(PP().ws + WS_GATES); bf16_t* O = (bf16_t*)(PP().ws + WS_MERGED);
            const int row0 = pm * 256 + wr * 64 + fr, colb = pn * 256 + wc * 32 + 8 * fq;
#pragma unroll
            for (int ai = 0; ai < 2; ++ai) { asm volatile("" ::: "memory");
                u32x4 gq[4][2], pq[4][2];
#pragma unroll
                for (int m = 0; m < 4; ++m) { const size_t ro = (size_t)(row0 + ai * 128 + m * 16); const bf16_t* gp = GT + ro * 2048 + br * 1024 + colb; const bf16_t* op = O + ro * D + colb;
#pragma unroll
                    for (int bj = 0; bj < 2; ++bj) { gq[m][bj] = *(const u32x4*)(gp + bj * 128); pq[m][bj] = br ? *(const u32x4*)(op + bj * 128) : (u32x4){0u, 0u, 0u, 0u}; } }
#pragma unroll
                for (int m = 0; m < 4; ++m) { const size_t ro = (size_t)(row0 + ai * 128 + m * 16); bf16_t* op = O + ro * D + colb;
#pragma unroll
                    for (int bj = 0; bj < 2; ++bj) { const u32x4 g = gq[m][bj], pr = pq[m][bj]; const f32x4 v0 = acc[ai][bj][m][0], v1 = acc[ai][bj][m][1];
                        u32x4 w; w.x = pk2(v0[0] * bflo(g.x) + bflo(pr.x), v0[1] * bfhi(g.x) + bfhi(pr.x)); w.y = pk2(v0[2] * bflo(g.y) + bflo(pr.y), v0[3] * bfhi(g.y) + bfhi(pr.y));
                        w.z = pk2(v1[0] * bflo(g.z) + bflo(pr.z), v1[1] * bfhi(g.z) + bfhi(pr.z)); w.w = pk2(v1[2] * bflo(g.w) + bflo(pr.w), v1[3] * bfhi(g.w) + bfhi(pr.w));
                        *(u32x4*)(op + bj * 128) = w; } } }
        }
    }
}
__device__ __forceinline__ void wout_unit(int l, LAS unsigned char* lds, int pm, int pn) {
    unsigned voffA[2][2], voffB[2]; g8::make_voff_contig(voffA, D * 2); g8::make_voffB(voffB, D * 2, false);
    g8::Acc acc; g8::zero_acc(acc);
    const char* Ab = (const char*)(PP().ws + WS_MERGED); const char* Bb = (const char*)(PP().ws + WS_WSMALL + (size_t)l * WSMALL_LAYER + 12 * MiB);
    const g8::KSeg s = g8::seg1(Ab + (size_t)pm * 256 * D * 2, Bb + (size_t)pn * 256 * D * 2, Bb + (size_t)(pn * 256 + 128) * D * 2, D / 64);
    g8::kloop<false, false>(lds, acc, s, voffA, voffB, 128 * D * 2);
    EPI_COORDS();
    const int row0 = pm * 256 + wr * 64 + fr, col0 = pn * 256 + wc * 32 + 4 * fq;
#pragma unroll
    for (int ai = 0; ai < 2; ++ai) { asm volatile("" ::: "memory");
        f32x4 pre[4][2][2]; float* hr[4];
#pragma unroll
        for (int m = 0; m < 4; ++m) { hr[m] = hrow(PP(), row0 + ai * 128 + m * 16) + col0;
#pragma unroll
            for (int bj = 0; bj < 2; ++bj)
#pragma unroll
                for (int n = 0; n < 2; ++n) pre[m][bj][n] = *(const f32x4*)(hr[m] + bj * 128 + n * 16); }
#pragma unroll
        for (int m = 0; m < 4; ++m)
#pragma unroll
            for (int bj = 0; bj < 2; ++bj)
#pragma unroll
                for (int n = 0; n < 2; ++n) *(f32x4*)(hr[m] + bj * 128 + n * 16) = pre[m][bj][n] * ALPHA + acc[ai][bj][m][n]; }
}
__device__ __forceinline__ unsigned score_key(float s) { s += 0.0f; const unsigned u = __builtin_bit_cast(unsigned, s); return (u & 0x80000000u) ? ~u : (u | 0x80000000u); }
__device__ void attn_naive_query(const Params& p, int row, unsigned char* wl, int lane) {
    const bf16_t* U = (const bf16_t*)(p.ws + WS_UAR);
    bf16_t* OA = (bf16_t*)(p.ws + WS_OAB) + (size_t)row * D;
    const int b = row / LP, pos = row - b * LP;
    if (pos < PADM) {
#pragma unroll
        for (int j = 0; j < 8; ++j) OA[j * 64 + lane] = 0;
        return;
    }
    const int nadm = 64 * ((pos >> 6) + 1) - PADM;
    unsigned* keys = (unsigned*)wl; float* p_s = (float*)wl;
    float* qi_s = (float*)(wl + 16640); float* q_s = qi_s + 256; float* w_s = q_s + 512; unsigned short* sel_s = (unsigned short*)(w_s + 16);
    const bf16_t* urow = U + (size_t)row * UARW;
    for (int i = lane; i < 256; i += 64) qi_s[i] = bf2f(urow[C_QI + i]);
    for (int i = lane; i < 512; i += 64) q_s[i] = bf2f(urow[C_Q + i]);
    if (lane < 8) w_s[lane] = bf2f(urow[C_WI + lane]);
    __builtin_amdgcn_fence(__ATOMIC_RELEASE, "wavefront"); __builtin_amdgcn_wave_barrier(); __builtin_amdgcn_fence(__ATOMIC_ACQUIRE, "wavefront");
    const int nj = (nadm + 63) >> 6;
    for (int j = 0; j < nj; ++j) {
        const int ki_idx = lane + 64 * j; unsigned key = 0u;
        if (ki_idx < nadm) {
            const u32x4* kp = (const u32x4*)(U + (size_t)(b * LP + PADM + ki_idx) * UARW + C_KI);
            float kf[32];
#pragma unroll
            for (int c4 = 0; c4 < 4; ++c4) { const u32x4 w = kp[c4];
                kf[c4 * 8 + 0] = bflo(w.x); kf[c4 * 8 + 1] = bfhi(w.x); kf[c4 * 8 + 2] = bflo(w.y); kf[c4 * 8 + 3] = bfhi(w.y);
                kf[c4 * 8 + 4] = bflo(w.z); kf[c4 * 8 + 5] = bfhi(w.z); kf[c4 * 8 + 6] = bflo(w.w); kf[c4 * 8 + 7] = bfhi(w.w); }
            float sc = 0.f;
#pragma unroll 1
            for (int h = 0; h < 8; ++h) { float d = 0.f; asm volatile("" ::: "memory");
#pragma unroll
                for (int e = 0; e < 32; ++e) d = fmaf(qi_s[h * 32 + e], kf[e], d);
                sc = fmaf(w_s[h], fmaxf(d, 0.f), sc); }
            key = score_key(sc); if (key == 0u) key = 1u;
        }
        keys[ki_idx] = key;
    }
    __builtin_amdgcn_fence(__ATOMIC_RELEASE, "wavefront"); __builtin_amdgcn_wave_barrier(); __builtin_amdgcn_fence(__ATOMIC_ACQUIRE, "wavefront");
    unsigned thr = 0u; int need_ties = 0x7fffffff;
    if (nadm > 256) {
        unsigned prefix = 0u; int remaining = 256;
        for (int bit = 31; bit >= 0; --bit) {
            const unsigned cand = prefix | (1u << bit); int cnt = 0;
            for (int j = 0; j < nj; ++j) { const unsigned k = keys[lane + 64 * j]; cnt += __builtin_popcountll(__ballot((k >> bit) == (cand >> bit))); }
            if (cnt >= remaining) prefix = cand; else remaining -= cnt;
        }
        thr = prefix; need_ties = remaining;
    } else thr = 1u;
    int nsel = 0, ties_seen = 0;
    for (int j = 0; j < nj; ++j) {
        const unsigned k = keys[lane + 64 * j];
        const unsigned long long tm = __ballot(k == thr && k != 0u);
        const unsigned long long lt = (1ull << lane) - 1ull;
        const int myrank = ties_seen + __builtin_popcountll(tm & lt);
        const bool selme = (k > thr) || (k == thr && k != 0u && myrank < need_ties);
        const unsigned long long sm = __ballot(selme);
        if (selme) sel_s[nsel + __builtin_popcountll(sm & lt)] = (unsigned short)(PADM + lane + 64 * j);
        nsel += __builtin_popcountll(sm); ties_seen += __builtin_popcountll(tm);
    }
    __builtin_amdgcn_fence(__ATOMIC_RELEASE, "wavefront"); __builtin_amdgcn_wave_barrier(); __builtin_amdgcn_fence(__ATOMIC_ACQUIRE, "wavefront");
    float sc[4][8];
#pragma unroll
    for (int m = 0; m < 4; ++m) {
        asm volatile("" ::: "memory");
        const int i = lane + 64 * m; const bool valid = i < nsel; const int ps = valid ? sel_s[i] : PADM;
        const bf16_t* krow = U + (size_t)(b * LP + ps) * UARW + C_K;
#pragma unroll
        for (int n = 0; n < 2; ++n) {
            float a0 = 0.f, a1 = 0.f, a2 = 0.f, a3 = 0.f;
#pragma unroll 1
            for (int c8 = 0; c8 < 8; ++c8) { asm volatile("" ::: "memory"); const u32x4 w = *(const u32x4*)(krow + n * 64 + c8 * 8);
                float kf[8] = {bflo(w.x), bfhi(w.x), bflo(w.y), bfhi(w.y), bflo(w.z), bfhi(w.z), bflo(w.w), bfhi(w.w)};
#pragma unroll
                for (int e = 0; e < 8; ++e) { const int dd = c8 * 8 + e;
                    a0 = fmaf(q_s[(n * 4 + 0) * 64 + dd], kf[e], a0); a1 = fmaf(q_s[(n * 4 + 1) * 64 + dd], kf[e], a1);
                    a2 = fmaf(q_s[(n * 4 + 2) * 64 + dd], kf[e], a2); a3 = fmaf(q_s[(n * 4 + 3) * 64 + dd], kf[e], a3); } }
            sc[m][n * 4 + 0] = valid ? a0 * 0.125f : -INFINITY; sc[m][n * 4 + 1] = valid ? a1 * 0.125f : -INFINITY;
            sc[m][n * 4 + 2] = valid ? a2 * 0.125f : -INFINITY; sc[m][n * 4 + 3] = valid ? a3 * 0.125f : -INFINITY;
        }
    }
    __builtin_amdgcn_wave_barrier();
    float linv[8];
#pragma unroll
    for (int h = 0; h < 8; ++h) {
        const float mx = wave_max(fmaxf(fmaxf(sc[0][h], sc[1][h]), fmaxf(sc[2][h], sc[3][h]))); float s = 0.f;
#pragma unroll
        for (int m = 0; m < 4; ++m) { const float e = __expf(sc[m][h] - mx); sc[m][h] = e; s += e; }
        linv[h] = 1.0f / wave_sum(s);
    }
#pragma unroll
    for (int m = 0; m < 4; ++m) { const int i = lane + 64 * m;
#pragma unroll
        for (int h = 0; h < 8; ++h) p_s[i * 8 + h] = sc[m][h]; }
    __builtin_amdgcn_fence(__ATOMIC_RELEASE, "wavefront"); __builtin_amdgcn_wave_barrier(); __builtin_amdgcn_fence(__ATOMIC_ACQUIRE, "wavefront");
    float o[8] = {0.f, 0.f, 0.f, 0.f, 0.f, 0.f, 0.f, 0.f};
    for (int i = 0; i < nsel; ++i) {
        const int ps = sel_s[i]; const bf16_t* vrow = U + (size_t)(b * LP + ps) * UARW + C_V;
        const float v0 = bf2f(vrow[lane]), v1 = bf2f(vrow[64 + lane]);
        const f32x4 pa = *(const f32x4*)(p_s + i * 8), pb = *(const f32x4*)(p_s + i * 8 + 4);
        o[0] = fmaf(pa[0], v0, o[0]); o[1] = fmaf(pa[1], v0, o[1]); o[2] = fmaf(pa[2], v0, o[2]); o[3] = fmaf(pa[3], v0, o[3]);
        o[4] = fmaf(pb[0], v1, o[4]); o[5] = fmaf(pb[1], v1, o[5]); o[6] = fmaf(pb[2], v1, o[6]); o[7] = fmaf(pb[3], v1, o[7]);
    }
#pragma unroll
    for (int h = 0; h < 8; ++h) OA[h * 64 + lane] = (bf16_t)f2bf(o[h] * linv[h]);
    __builtin_amdgcn_wave_barrier();
}


__device__ __forceinline__ f32x4 mfma16(bf16x8 a, bf16x8 b, f32x4 c) { return __builtin_amdgcn_mfma_f32_16x16x32_bf16(a, b, c, 0, 0, 0); }
#ifndef PROBE_PHASE
#define PROBE_PHASE -1
#endif
#define PROBE_BLOCK 0
#define LDS_BARRIER() do { asm volatile("s_waitcnt lgkmcnt(0)" ::: "memory"); __builtin_amdgcn_s_barrier(); asm volatile("" ::: "memory"); } while (0)

typedef float f32x16 __attribute__((ext_vector_type(16)));
typedef short s16x4 __attribute__((ext_vector_type(4)));
constexpr int AT_HIST = 0;
constexpr int AT_MASK = 20480;
constexpr int AT_QST = AT_MASK + 16640;
constexpr int AT_KV = 37120;
constexpr int AT_UNIT = AT_KV + 32768;
constexpr int AT_KL = AT_KV;
constexpr int AT_KL_BYTES = LDS_BYTES - 16 - AT_KL;
static_assert(4128 * 12 * 2 <= AT_KL_BYTES, "selection keys fit with 12 queries per sub-pass");
constexpr int CW_R1Q = 48;
constexpr int CW_ATT = 32;
__device__ __forceinline__ int img_off(int row, int ch) { return 2048 * (row >> 3) + 512 * (ch >> 2) + 64 * (row & 7) + 16 * ((ch & 3) ^ ((row >> 2) & 3)); }
__device__ __forceinline__ unsigned comp_key(float sc, int pos) { return (score_key(sc) & 0xFFFFE000u) | (unsigned)(0x1FFF - pos); }

__device__ __forceinline__ void attn_unit(const Params& p, unsigned char* lds, int b, int qt, unsigned long long& pacc) {
    unsigned long long pt0 = 0; if (PROBE_PHASE == 40 || PROBE_PHASE == 42) pt0 = __builtin_amdgcn_s_memrealtime();
    const int tid = otid(), wave = tid >> 6, lane = tid & 63, r = lane & 31, hh = lane >> 5;
    const bf16_t* U = (const bf16_t*)(p.ws + WS_UAR);
    LAS unsigned char* L = (LAS unsigned char*)lds;
    LAS unsigned* hist = (LAS unsigned*)(L + AT_HIST); LAS unsigned* maskw = (LAS unsigned*)(L + AT_MASK);
    const int c = qt >> 1, nkt = 2 * c + 1, nadm = 64 * (c + 1) - PADM;
    const size_t qrow = (size_t)(b * LP + 32 * qt + r);
    if (nadm > 256) {
        LAS unsigned short* KL = (LAS unsigned short*)(L + AT_KL);
        LAS unsigned* h8 = (LAS unsigned*)(L + AT_HIST);
        LAS unsigned* segc = h8 + 4096;
        LAS unsigned* st = segc + 512;
        const int NK = 32 * nkt, c15 = lane & 15, g4 = lane >> 4;
        const int qs = NK * 32 <= AT_KL_BYTES ? 16 : 12;
        for (int i = tid; i < (nkt + 1) * 32; i += NTHREADS) maskw[i] = 0u;
#pragma unroll 1
        for (int qbase = 0; qbase < 32; qbase += qs) {
            const int qn = 32 - qbase < qs ? 32 - qbase : qs; const bool qact = c15 < qn;
            bf16x8 qf[8]; float wq[8];
            { const bf16_t* qp = U + (size_t)(b * LP + 32 * qt + qbase + (qact ? c15 : 0)) * UARW;
#pragma unroll
              for (int h = 0; h < 8; ++h) qf[h] = *(const bf16x8*)(qp + C_QI + h * 32 + 8 * g4);
              const u32x4 w = *(const u32x4*)(qp + C_WI);
              wq[0] = bflo(w.x); wq[1] = bfhi(w.x); wq[2] = bflo(w.y); wq[3] = bfhi(w.y); wq[4] = bflo(w.z); wq[5] = bfhi(w.z); wq[6] = bflo(w.w); wq[7] = bfhi(w.w); }
#pragma unroll
            for (int h = 0; h < 8; ++h) asm volatile("" : "+v"(qf[h]), "+v"(wq[h]));
            for (int i = tid; i < 4096 + 512; i += NTHREADS) h8[i] = 0u;
            LDS_BARRIER();
            {
                const int ng = 2 * nkt; int j = wave;
                const bf16_t* kb = U + (size_t)(b * LP + 32 + c15) * UARW + C_KI + 8 * g4;
                bf16x8 a = *(const bf16x8*)(kb + (size_t)(16 * (j < ng ? j : 0)) * UARW), an = *(const bf16x8*)(kb + (size_t)(16 * (j + NWAVES < ng ? j + NWAVES : 0)) * UARW);
#pragma unroll 1
                for (; j < ng; j += NWAVES) {
                    const bf16x8 a2 = *(const bf16x8*)(kb + (size_t)(16 * (j + 2 * NWAVES < ng ? j + 2 * NWAVES : j)) * UARW);
                    f32x4 sc = {0.f, 0.f, 0.f, 0.f};
#pragma unroll
                    for (int h = 0; h < 8; ++h) { const f32x4 d = mfma16(a, qf[h], (f32x4){0.f, 0.f, 0.f, 0.f});
#pragma unroll
                        for (int e = 0; e < 4; ++e) sc[e] = fmaf(wq[h], fmaxf(d[e], 0.f), sc[e]); }
                    if (qact) {
#pragma unroll
                        for (int e = 0; e < 4; ++e) { const int ki = 16 * j + 4 * g4 + e;
                            const unsigned k16 = ki >= 16 ? (score_key(sc[e]) >> 16) : 0u;
                            KL[ki * qs + c15] = (unsigned short)k16;
                            __hip_atomic_fetch_add(h8 + (k16 >> 8) * 16 + c15, ki >= 16 ? 1u : 0u, __ATOMIC_RELAXED, __HIP_MEMORY_SCOPE_WORKGROUP); } }
                    a = an; an = a2;
                }
            }
            LDS_BARRIER();
            { const int q_ = tid & 15, s8 = tid >> 4; unsigned ss = 0u;
#pragma unroll
              for (int i = 0; i < 8; ++i) ss += h8[(s8 * 8 + i) * 16 + q_];
              segc[s8 * 16 + q_] = ss; }
            LDS_BARRIER();
            if (tid < qn) { unsigned sv[32];
#pragma unroll
                for (int i = 0; i < 32; ++i) sv[i] = segc[i * 16 + tid];
                unsigned cum = 0u; int sgi = 31;
#pragma unroll
                for (int i = 31; i > 0; --i) { const bool go = sgi == i && cum + sv[i] < 256u; cum += go ? sv[i] : 0u; sgi -= go ? 1 : 0; }
                int bin = sgi * 8 + 7; while (bin > sgi * 8 && cum + h8[bin * 16 + tid] < 256u) { cum += h8[bin * 16 + tid]; --bin; }
                st[tid * 4] = (unsigned)bin; st[tid * 4 + 1] = 256u - cum; }
            LDS_BARRIER();
            for (int i = tid; i < 4096; i += NTHREADS) h8[i] = 0u;
            LDS_BARRIER();
            const int q = tid & 15, sg = tid >> 4, SEG = (NK + 31) >> 5, k0 = sg * SEG, k1 = q < qn ? (k0 + SEG < NK ? k0 + SEG : NK) : k0;
            { const unsigned hb = st[q * 4];
#pragma unroll 8
              for (int k = k0; k < k1; ++k) { const unsigned kv = KL[k * qs + q]; __hip_atomic_fetch_add(h8 + (kv & 255u) * 16 + q, (kv >> 8) == hb && kv != 0u ? 1u : 0u, __ATOMIC_RELAXED, __HIP_MEMORY_SCOPE_WORKGROUP); } }
            LDS_BARRIER();
            { const int q_ = tid & 15, s8 = tid >> 4; unsigned ss = 0u;
#pragma unroll
              for (int i = 0; i < 8; ++i) ss += h8[(s8 * 8 + i) * 16 + q_];
              segc[s8 * 16 + q_] = ss; }
            LDS_BARRIER();
            if (tid < qn) { const unsigned rem = st[tid * 4 + 1]; unsigned sv[32];
#pragma unroll
                for (int i = 0; i < 32; ++i) sv[i] = segc[i * 16 + tid];
                unsigned cum = 0u; int sgi = 31;
#pragma unroll
                for (int i = 31; i > 0; --i) { const bool go = sgi == i && cum + sv[i] < rem; cum += go ? sv[i] : 0u; sgi -= go ? 1 : 0; }
                int bin = sgi * 8 + 7; while (bin > sgi * 8 && cum + h8[bin * 16 + tid] < rem) { cum += h8[bin * 16 + tid]; --bin; }
                st[tid * 4 + 2] = (st[tid * 4] << 8) | (unsigned)bin; st[tid * 4 + 3] = rem - cum; }
            LDS_BARRIER();
            const unsigned thr = st[q * 4 + 2], need = st[q * 4 + 3];
            { unsigned cnt = 0u;
#pragma unroll 8
              for (int k = k0; k < k1; ++k) cnt += KL[k * qs + q] == thr ? 1u : 0u;
              segc[sg * 16 + q] = cnt; }
            LDS_BARRIER();
            if (tid < qn) { unsigned cv[32];
#pragma unroll
                for (int s2 = 0; s2 < 32; ++s2) cv[s2] = segc[s2 * 16 + tid];
                unsigned run = 0u;
#pragma unroll
                for (int s2 = 0; s2 < 32; ++s2) { segc[s2 * 16 + tid] = run; run += cv[s2]; } }
            LDS_BARRIER();
            { unsigned rank = segc[sg * 16 + q], word = 0u; int wi = k0 >> 5;
#pragma unroll 4
              for (int k = k0; k < k1; ++k) { if ((k >> 5) != wi) { if (word) __hip_atomic_fetch_or(maskw + (wi + 1) * 32 + qbase + q, word, __ATOMIC_RELAXED, __HIP_MEMORY_SCOPE_WORKGROUP); word = 0u; wi = k >> 5; }
                  const unsigned kv = KL[k * qs + q]; const bool tie = kv == thr; const bool sel = kv > thr || (tie && rank < need); rank += tie ? 1u : 0u;
                  word |= (sel ? 1u : 0u) << (k & 31); }
              if (word) __hip_atomic_fetch_or(maskw + (wi + 1) * 32 + qbase + q, word, __ATOMIC_RELAXED, __HIP_MEMORY_SCOPE_WORKGROUP); }
            LDS_BARRIER();
        }
    } else {
        for (int kt = 1 + wave; kt <= nkt; kt += NWAVES) if (hh == 0) maskw[kt * 32 + r] = kt == 1 ? 0xFFFF0000u : 0xFFFFFFFFu;
        LDS_BARRIER();
    }
    if (PROBE_PHASE == 40) pacc += __builtin_amdgcn_s_memrealtime() - pt0;
    if (PROBE_PHASE == 41) pt0 = __builtin_amdgcn_s_memrealtime();
    {
        const int h = wave, n = h >> 2;
        bf16x8 qf4[4];
#pragma unroll
        for (int kk = 0; kk < 4; ++kk) qf4[kk] = *(const bf16x8*)(U + qrow * UARW + C_Q + h * 64 + 16 * kk + 8 * hh);
        asm volatile("" : "+v"(qf4[0]), "+v"(qf4[1]), "+v"(qf4[2]), "+v"(qf4[3]));
        f32x16 o0, o1;
#pragma unroll
        for (int e = 0; e < 16; ++e) { o0[e] = 0.f; o1[e] = 0.f; }
        float m = -1e30f, lsum = 0.f;
        const int srow = tid >> 4, sch = tid & 15; const int soff = img_off(srow, sch);
        const bf16_t* sbase = U + (size_t)(b * LP + srow) * UARW + sch * 8;
        u32x4 kreg = *(const u32x4*)(sbase + (size_t)32 * UARW + C_K), vreg = *(const u32x4*)(sbase + (size_t)32 * UARW + C_V);
        *(LAS u32x4*)(L + AT_KV + soff) = kreg; *(LAS u32x4*)(L + AT_KV + 8192 + soff) = vreg;
        { const int k2 = nkt >= 2 ? 2 : 1; kreg = *(const u32x4*)(sbase + (size_t)(32 * k2) * UARW + C_K); vreg = *(const u32x4*)(sbase + (size_t)(32 * k2) * UARW + C_V); }
        LDS_BARRIER();
        const int g = (lane >> 4) & 1, q_ = (lane & 15) >> 2, p_ = lane & 3;
        constexpr float SCL = 0.125f * 1.44269504088896f;
#pragma unroll 1
        for (int i = 0; i < nkt; ++i) {
            const int kt = 1 + i; LAS unsigned char* Kimg = L + AT_KV + (i & 1) * 16384; LAS unsigned char* Vimg = Kimg + 8192;
            u32x4 kreg2, vreg2;
            { const int k3 = kt + 2 <= nkt ? kt + 2 : kt; kreg2 = *(const u32x4*)(sbase + (size_t)(32 * k3) * UARW + C_K); vreg2 = *(const u32x4*)(sbase + (size_t)(32 * k3) * UARW + C_V); }
            f32x16 s;
#pragma unroll
            for (int e = 0; e < 16; ++e) s[e] = 0.f;
#pragma unroll
            for (int kk = 0; kk < 4; ++kk) { const bf16x8 a = *(const LAS bf16x8*)(Kimg + img_off(r, 8 * n + 2 * kk + hh)); s = __builtin_amdgcn_mfma_f32_32x32x16_bf16(a, qf4[kk], s, 0, 0, 0); }
            const unsigned mw = maskw[kt * 32 + r] >> (4 * hh);
            float tmax = -INFINITY;
#pragma unroll
            for (int e = 0; e < 16; ++e) { const bool sel = (mw >> ((e & 3) + 8 * (e >> 2))) & 1u; s[e] = sel ? s[e] : -INFINITY; tmax = fmaxf(tmax, s[e]); }
            tmax = fmaxf(tmax, __shfl_xor(tmax, 32));
            const float mnew = fmaxf(m, tmax * SCL);
            if (__any(mnew > m)) { const float alpha = __builtin_amdgcn_exp2f(m - mnew); lsum *= alpha;
#pragma unroll
                for (int e = 0; e < 16; ++e) { o0[e] *= alpha; o1[e] *= alpha; } }
            m = mnew;
            float ps = 0.f;
#pragma unroll
            for (int e = 0; e < 16; ++e) { const float pe = __builtin_amdgcn_exp2f(fmaf(s[e], SCL, -mnew)); s[e] = pe; ps += pe; }
            lsum += ps;
            bf16x8 pf[2];
#pragma unroll
            for (int ks = 0; ks < 2; ++ks) { u32x4 w; w.x = pk2(s[8 * ks + 0], s[8 * ks + 1]); w.y = pk2(s[8 * ks + 2], s[8 * ks + 3]); w.z = pk2(s[8 * ks + 4], s[8 * ks + 5]); w.w = pk2(s[8 * ks + 6], s[8 * ks + 7]); pf[ks] = __builtin_bit_cast(bf16x8, w); }
#pragma unroll
            for (int ks = 0; ks < 2; ++ks)
#pragma unroll
                for (int dt = 0; dt < 2; ++dt) { const int c0 = 8 * n + 4 * dt + 2 * g + (p_ >> 1);
                    const s16x4 lo = __builtin_amdgcn_ds_read_tr16_b64_v4i16((LAS s16x4*)(Vimg + img_off(16 * ks + 4 * hh + q_, c0) + 8 * (p_ & 1)));
                    const s16x4 hi = __builtin_amdgcn_ds_read_tr16_b64_v4i16((LAS s16x4*)(Vimg + img_off(16 * ks + 8 + 4 * hh + q_, c0) + 8 * (p_ & 1)));
                    const bf16x8 a = __builtin_shufflevector(lo, hi, 0, 1, 2, 3, 4, 5, 6, 7);
                    if (dt == 0) o0 = __builtin_amdgcn_mfma_f32_32x32x16_bf16(a, pf[ks], o0, 0, 0, 0); else o1 = __builtin_amdgcn_mfma_f32_32x32x16_bf16(a, pf[ks], o1, 0, 0, 0); }
            if (i + 1 < nkt) { LAS unsigned char* Kn = L + AT_KV + ((i + 1) & 1) * 16384; *(LAS u32x4*)(Kn + soff) = kreg; *(LAS u32x4*)(Kn + 8192 + soff) = vreg; }
            kreg = kreg2; vreg = vreg2;
            LDS_BARRIER();
        }
        lsum += __shfl_xor(lsum, 32);
        const float inv = lsum > 0.f ? 1.0f / lsum : 0.f;
        bf16_t* orow = (bf16_t*)(p.ws + WS_OAB) + qrow * D + h * 64 + 4 * hh;
#pragma unroll
        for (int g4 = 0; g4 < 4; ++g4) { u32x2 w0, w1;
            w0.x = pk2(o0[4 * g4] * inv, o0[4 * g4 + 1] * inv); w0.y = pk2(o0[4 * g4 + 2] * inv, o0[4 * g4 + 3] * inv);
            w1.x = pk2(o1[4 * g4] * inv, o1[4 * g4 + 1] * inv); w1.y = pk2(o1[4 * g4 + 2] * inv, o1[4 * g4 + 3] * inv);
            *(u32x2*)(orow + 8 * g4) = w0; *(u32x2*)(orow + 32 + 8 * g4) = w1; }
        if (qt == 1) {
            bf16_t* z = (bf16_t*)(p.ws + WS_OAB) + (size_t)(b * LP + r) * D + h * 64 + 32 * hh;
#pragma unroll
            for (int j = 0; j < 4; ++j) *(u32x4*)(z + 8 * j) = (u32x4){0u, 0u, 0u, 0u};
        }
    }
    if (PROBE_PHASE == 41 || PROBE_PHASE == 42) pacc += __builtin_amdgcn_s_memrealtime() - pt0;
}
__device__ __forceinline__ void attn_phase(const Params& p, int l, unsigned char* lds, unsigned long long& pacc) {
    unsigned* ctr = (unsigned*)(p.ws + WS_CTL) + CW_ATT + 4 * l;
    volatile int* uw = (volatile int*)(lds + AT_UNIT);
    const int b0 = (obid() & 7) >> 1;
    for (int k = 0; k < 4; ++k) { const int b = (b0 + k) & 3;
        for (;;) {
            __syncthreads();
            if (otid() == 0) *uw = (int)atomicAdd(ctr + b, 1u);
            __syncthreads();
            const int u = *uw;
            if (u >= 129) break;
            attn_unit(p, lds, b, 129 - u, pacc);
        }
    }
}

constexpr size_t WS_RW1 = WS_HB;
constexpr size_t WS_RW2 = 259 * MiB;
constexpr size_t RW2_ARR = (size_t)2080 * 8192;
constexpr size_t WS_LORA = 65536;
constexpr int PS = 72;
constexpr int R1_XW = 0, R1_XA = 9216, R1_XG = 18432;
constexpr int R1_RHS = 0;
constexpr int R1_E = 35840, R1_AA = R1_E + 16640, R1_GS = R1_AA + 9216;
constexpr int R1_LABT = R1_E, R1_LAK = R1_E + 16384;
constexpr int R1_AT = R1_GS + 9216, R1_RT = R1_AT + 9216, R1_BT = R1_RT + 9216, R1_KT = R1_BT + 9216;
constexpr int R1_WT = R1_AT, R1_ZT = R1_BT;
constexpr int R1_BTT = R1_KT + 9216, R1_KTT = R1_BTT + 9216, R1_VT = R1_KTT + 9216;
constexpr int R1_MRB = R1_VT + 9216, R1_MRK = R1_MRB + 9216;
constexpr int R1_BS = R1_MRK + 9216, R1_GC = R1_BS + 256, R1_END = R1_GC + 256;
static_assert(R1_END <= LDS_BYTES && R1_LAK + 9216 <= R1_AT && R1_RHS + 33280 <= R1_E, "R1 LDS map");
__device__ __forceinline__ u32x2 pk4(f32x4 v) { u32x2 w; w.x = pk2(v[0], v[1]); w.y = pk2(v[2], v[3]); return w; }

#ifndef PROBE_PHASE
#define PROBE_PHASE -1
#endif
#define R1P(k) do { if (PROBE_PHASE == 20 + (k)) { const unsigned long long t_ = __builtin_amdgcn_s_memrealtime(); pacc += t_ - pt0; } if (PROBE_PHASE == 21 + (k)) pt0 = __builtin_amdgcn_s_memrealtime(); } while (0)
__device__ __forceinline__ void rwkv_prep_unit(const Params& p, int l, int unit, unsigned char* lds, unsigned long long& pacc) {
    unsigned long long pt0 = 0; if (PROBE_PHASE == 20) pt0 = __builtin_amdgcn_s_memrealtime();
    const int tid = otid(), wave = tid >> 6, lane = tid & 63, c15 = lane & 15, g = lane >> 4;
    const int h = unit & 7, bc = unit >> 3, b = bc / NCH, c = bc - b * NCH;
    LAS unsigned char* L = (LAS unsigned char*)lds;
    const bf16_t* U = (const bf16_t*)(p.ws + WS_UAR);
    const int t = tid >> 3, dq = tid & 7, d0 = dq * 8;
    const int row = b * LP + 64 * c + t; const bool hasprev = (64 * c + t) > 0;
    bf16x8 lw[2][2], la[2][2], lg_[2][4];
    { const bf16_t* lora = (const bf16_t*)(p.ws + WS_LORA + (size_t)l * 262144);
#pragma unroll
      for (int nn = 0; nn < 2; ++nn) { const int hd = h * 64 + 16 * (2 * (wave & 1) + nn) + c15;
#pragma unroll
          for (int s2 = 0; s2 < 2; ++s2) { lw[nn][s2] = *(const bf16x8*)(lora + (size_t)hd * 64 + 32 * s2 + 8 * g); la[nn][s2] = *(const bf16x8*)(lora + 32768 + (size_t)hd * 64 + 32 * s2 + 8 * g); }
#pragma unroll
          for (int s4 = 0; s4 < 4; ++s4) lg_[nn][s4] = *(const bf16x8*)(lora + 65536 + (size_t)hd * 128 + 32 * s4 + 8 * g); } }
    float rr[8], kx[8], vx[8], kk[8];
    {
        const bf16_t* uc = U + (size_t)row * UARW; const bf16_t* up = hasprev ? uc - UARW : uc;
        const float* mu = p.in[I_MU] + l * R_COLS;
        auto shift8 = [&](int col, int mucol, float (&out)[8]) {
            const u32x4 a = *(const u32x4*)(uc + col), q = *(const u32x4*)(up + col);
            const f32x4 m0 = *(const f32x4*)(mu + mucol), m1 = *(const f32x4*)(mu + mucol + 4);
            const float x[8] = {bflo(a.x), bfhi(a.x), bflo(a.y), bfhi(a.y), bflo(a.z), bfhi(a.z), bflo(a.w), bfhi(a.w)};
            const float y[8] = {bflo(q.x), bfhi(q.x), bflo(q.y), bfhi(q.y), bflo(q.z), bfhi(q.z), bflo(q.w), bfhi(q.w)};
#pragma unroll
            for (int i = 0; i < 8; ++i) { const float xp = hasprev ? y[i] : 0.f; out[i] = x[i] + (xp - x[i]) * (i < 4 ? m0[i] : m1[i - 4]); } };
        shift8(C_R + h * 64 + d0, h * 64 + d0, rr); shift8(C_RK + h * 64 + d0, 512 + h * 64 + d0, kx); shift8(C_RV + h * 64 + d0, 1024 + h * 64 + d0, vx);
        float xw[8], xa[8], xg0[8], xg1[8];
        shift8(C_XW + d0, 1536 + d0, xw); shift8(C_XA + d0, 1600 + d0, xa); shift8(C_XG + d0, 1664 + d0, xg0); shift8(C_XG + 64 + d0, 1728 + d0, xg1);
        float n2 = 0.f;
        { const f32x4 k0 = *(const f32x4*)(p.in[I_KK] + l * 512 + h * 64 + d0), k1 = *(const f32x4*)(p.in[I_KK] + l * 512 + h * 64 + d0 + 4);
#pragma unroll
          for (int i = 0; i < 8; ++i) { kk[i] = kx[i] * (i < 4 ? k0[i] : k1[i - 4]); n2 = fmaf(kk[i], kk[i], n2); } }
        n2 += __shfl_xor(n2, 1); n2 += __shfl_xor(n2, 2); n2 += __shfl_xor(n2, 4);
        const float rn = rsqrtf(fmaxf(n2, 1e-24f));
#pragma unroll
        for (int i = 0; i < 8; ++i) { kk[i] *= rn; xw[i] = tanhf(xw[i]); xg0[i] = sigmoidf_(xg0[i]); xg1[i] = sigmoidf_(xg1[i]); }
        u32x4 w;
        w.x = pk2(xw[0], xw[1]); w.y = pk2(xw[2], xw[3]); w.z = pk2(xw[4], xw[5]); w.w = pk2(xw[6], xw[7]); *(LAS u32x4*)(L + R1_XW + (t * PS + d0) * 2) = w;
        w.x = pk2(xa[0], xa[1]); w.y = pk2(xa[2], xa[3]); w.z = pk2(xa[4], xa[5]); w.w = pk2(xa[6], xa[7]); *(LAS u32x4*)(L + R1_XA + (t * PS + d0) * 2) = w;
        w.x = pk2(xg0[0], xg0[1]); w.y = pk2(xg0[2], xg0[3]); w.z = pk2(xg0[4], xg0[5]); w.w = pk2(xg0[6], xg0[7]); *(LAS u32x4*)(L + R1_XG + (t * 136 + d0) * 2) = w;
        w.x = pk2(xg1[0], xg1[1]); w.y = pk2(xg1[2], xg1[3]); w.z = pk2(xg1[4], xg1[5]); w.w = pk2(xg1[6], xg1[7]); *(LAS u32x4*)(L + R1_XG + (t * 136 + 64 + d0) * 2) = w;
    }
    LDS_BARRIER();
    R1P(0);
    const int tm = wave >> 1;
    unsigned char* rw2 = p.ws + WS_RW2 + (size_t)unit * 8192;
    {
#pragma unroll
        for (int nn = 0; nn < 2; ++nn) { const int tn = 2 * (wave & 1) + nn, dcol = 16 * tn + c15, hd = h * 64 + dcol;
            f32x4 aw = {0.f, 0.f, 0.f, 0.f}, aa = aw, ag = aw;
#pragma unroll
            for (int s2 = 0; s2 < 2; ++s2) {
                const bf16x8 xa_ = *(const LAS bf16x8*)(L + R1_XW + ((16 * tm + c15) * PS + 32 * s2 + 8 * g) * 2), xb_ = *(const LAS bf16x8*)(L + R1_XA + ((16 * tm + c15) * PS + 32 * s2 + 8 * g) * 2);
                aw = mfma16(xa_, lw[nn][s2], aw);
                aa = mfma16(xb_, la[nn][s2], aa); }
#pragma unroll
            for (int s4 = 0; s4 < 4; ++s4) ag = mfma16(*(const LAS bf16x8*)(L + R1_XG + ((16 * tm + c15) * 136 + 32 * s4 + 8 * g) * 2), lg_[nn][s4], ag);
            const float w0 = p.in[I_W0][l * 512 + hd], a0 = p.in[I_A0][l * 512 + hd];
#pragma unroll
            for (int e = 0; e < 4; ++e) { const int tt = 16 * tm + 4 * g + e;
                const float z = -(w0 + aw[e]); const float sp = fmaxf(z, 0.f) + log1pf(__expf(-fabsf(z)));
                *(LAS float*)(L + R1_E + (tt * 65 + dcol) * 4) = __expf(-sp - 0.5f);
                *(LAS unsigned short*)(L + R1_AA + (tt * PS + dcol) * 2) = (unsigned short)f2bf(sigmoidf_(a0 + aa[e]));
                *(LAS unsigned short*)(L + R1_GS + (tt * PS + dcol) * 2) = (unsigned short)f2bf(ag[e]); }
        }
    }
    LDS_BARRIER();
    R1P(1);
    {
        const int d = tid & 63, sg = tid >> 6; float cum = 0.f, loc[8];
#pragma unroll
        for (int i = 0; i < 8; ++i) { cum += *(const LAS float*)(L + R1_E + ((8 * sg + i) * 65 + d) * 4); loc[i] = cum; }
        *(LAS float*)(L + R1_BS + (sg * 64 + d) * 4 - 2048) = cum;
        LDS_BARRIER();
        float off = 0.f;
#pragma unroll
        for (int q = 0; q < 7; ++q) if (q < sg) off += *(const LAS float*)(L + R1_BS + (q * 64 + d) * 4 - 2048);
#pragma unroll
        for (int i = 0; i < 8; ++i) *(LAS float*)(L + R1_E + ((8 * sg + i) * 65 + d) * 4) = loc[i] + off;
    }
    LDS_BARRIER();
    R1P(2);
    {
        const f32x4 ka0 = *(const f32x4*)(p.in[I_KA] + l * 512 + h * 64 + d0), ka1 = *(const f32x4*)(p.in[I_KA] + l * 512 + h * 64 + d0 + 4);
        const f32x4 rk0 = *(const f32x4*)(p.in[I_RK] + l * 512 + h * 64 + d0), rk1 = *(const f32x4*)(p.in[I_RK] + l * 512 + h * 64 + d0 + 4);
        const u32x4 aw_ = *(const LAS u32x4*)(L + R1_AA + (t * PS + d0) * 2);
        const float av[8] = {bflo(aw_.x), bfhi(aw_.x), bflo(aw_.y), bfhi(aw_.y), bflo(aw_.z), bfhi(aw_.z), bflo(aw_.w), bfhi(aw_.w)};
        float At[8], Bt[8], Kt[8], Rt[8]; float bpart = 0.f;
#pragma unroll
        for (int i = 0; i < 8; ++i) {
            const float cumt = *(const LAS float*)(L + R1_E + (t * 65 + d0 + i) * 4), cump = t > 0 ? *(const LAS float*)(L + R1_E + ((t - 1) * 65 + d0 + i) * 4) : 0.f;
            const float gam = __expf(-cumt), gprev = __expf(-cump), ginv = __expf(cumt);
            const float kmod = kx[i] * (1.0f + (av[i] - 1.0f) * (i < 4 ? ka0[i] : ka1[i - 4]));
            At[i] = -gprev * kk[i]; Bt[i] = kk[i] * av[i] * ginv; Kt[i] = kmod * ginv; Rt[i] = rr[i] * gam;
            bpart = fmaf(rr[i] * kmod, (i < 4 ? rk0[i] : rk1[i - 4]), bpart);
            if (t == 63) *(LAS float*)(L + R1_GC + (d0 + i) * 4) = gam;
            *(LAS float*)(L + R1_RHS + ((d0 + i) * 65 + t) * 4) = At[i];
            *(LAS unsigned short*)(L + R1_BTT + ((d0 + i) * PS + t) * 2) = (unsigned short)f2bf(Bt[i]);
            *(LAS unsigned short*)(L + R1_KTT + ((d0 + i) * PS + t) * 2) = (unsigned short)f2bf(Kt[i]);
            *(LAS unsigned short*)(L + R1_VT + ((d0 + i) * PS + t) * 2) = (unsigned short)f2bf(vx[i]);
        }
        u32x4 w;
        w.x = pk2(At[0], At[1]); w.y = pk2(At[2], At[3]); w.z = pk2(At[4], At[5]); w.w = pk2(At[6], At[7]); *(LAS u32x4*)(L + R1_AT + (t * PS + d0) * 2) = w;
        w.x = pk2(Rt[0], Rt[1]); w.y = pk2(Rt[2], Rt[3]); w.z = pk2(Rt[4], Rt[5]); w.w = pk2(Rt[6], Rt[7]); *(LAS u32x4*)(L + R1_RT + (t * PS + d0) * 2) = w;
        w.x = pk2(Bt[0], Bt[1]); w.y = pk2(Bt[2], Bt[3]); w.z = pk2(Bt[4], Bt[5]); w.w = pk2(Bt[6], Bt[7]); *(LAS u32x4*)(L + R1_BT + (t * PS + d0) * 2) = w;
        w.x = pk2(Kt[0], Kt[1]); w.y = pk2(Kt[2], Kt[3]); w.z = pk2(Kt[4], Kt[5]); w.w = pk2(Kt[6], Kt[7]); *(LAS u32x4*)(L + R1_KT + (t * PS + d0) * 2) = w;
        bpart += __shfl_xor(bpart, 1); bpart += __shfl_xor(bpart, 2); bpart += __shfl_xor(bpart, 4);
        const u32x4 gw = *(const LAS u32x4*)(L + R1_GS + (t * PS + d0) * 2);
        const float gv[8] = {bflo(gw.x), bfhi(gw.x), bflo(gw.y), bfhi(gw.y), bflo(gw.z), bfhi(gw.z), bflo(gw.w), bfhi(gw.w)};
        w.x = pk2(bpart * vx[0] * gv[0], bpart * vx[1] * gv[1]); w.y = pk2(bpart * vx[2] * gv[2], bpart * vx[3] * gv[3]);
        w.z = pk2(bpart * vx[4] * gv[4], bpart * vx[5] * gv[5]); w.w = pk2(bpart * vx[6] * gv[6], bpart * vx[7] * gv[7]);
        *(u32x4*)((bf16_t*)(p.ws + WS_OAB) + (size_t)row * D + 512 + h * 64 + d0) = w;
        *(u32x4*)(rw2 + 2 * RW2_ARR + (size_t)(t * 64 + d0) * 2) = gw;
    }
    LDS_BARRIER();
    R1P(3);
    {
        f32x4 gab[2], gak[2], grb[2], grk[2];
#pragma unroll
        for (int nn = 0; nn < 2; ++nn) { const int tn = 2 * (wave & 1) + nn;
            gab[nn] = (f32x4){0.f, 0.f, 0.f, 0.f}; gak[nn] = gab[nn]; grb[nn] = gab[nn]; grk[nn] = gab[nn];
            if (tn <= tm) {
#pragma unroll
                for (int s2 = 0; s2 < 2; ++s2) { const int ao = ((16 * tm + c15) * PS + 32 * s2 + 8 * g) * 2, bo = ((16 * tn + c15) * PS + 32 * s2 + 8 * g) * 2;
                    const bf16x8 fa = *(const LAS bf16x8*)(L + R1_AT + ao), fr_ = *(const LAS bf16x8*)(L + R1_RT + ao), fb = *(const LAS bf16x8*)(L + R1_BT + bo), fk = *(const LAS bf16x8*)(L + R1_KT + bo);
                    gab[nn] = mfma16(fa, fb, gab[nn]); gak[nn] = mfma16(fa, fk, gak[nn]); grb[nn] = mfma16(fr_, fb, grb[nn]); grk[nn] = mfma16(fr_, fk, grk[nn]); } } }
        LDS_BARRIER();
#pragma unroll
        for (int nn = 0; nn < 2; ++nn) { const int tn = 2 * (wave & 1) + nn, icol = 16 * tn + c15;
            f32x4 lab;
#pragma unroll
            for (int e = 0; e < 4; ++e) { const int tt = 16 * tm + 4 * g + e; const bool strict = icol < tt, incl = icol <= tt;
                lab[e] = strict ? gab[nn][e] : 0.f;
                *(LAS unsigned short*)(L + R1_LAK + (tt * PS + icol) * 2) = (unsigned short)f2bf(strict ? gak[nn][e] : 0.f);
                *(LAS unsigned short*)(L + R1_MRB + (tt * PS + icol) * 2) = (unsigned short)f2bf(incl ? grb[nn][e] : 0.f);
                *(LAS unsigned short*)(L + R1_MRK + (tt * PS + icol) * 2) = (unsigned short)f2bf(incl ? grk[nn][e] : 0.f); }
            *(LAS f32x4*)(L + R1_LABT + (icol * 64 + 16 * tm + 4 * g) * 4) = lab; }
    }
    LDS_BARRIER();
    R1P(4);
    {
#pragma unroll
        for (int nn = 0; nn < 2; ++nn) { const int tn = 2 * (wave & 1) + nn; f32x4 acc = {0.f, 0.f, 0.f, 0.f};
#pragma unroll
            for (int s2 = 0; s2 < 2; ++s2) acc = mfma16(*(const LAS bf16x8*)(L + R1_LAK + ((16 * tm + c15) * PS + 32 * s2 + 8 * g) * 2), *(const LAS bf16x8*)(L + R1_VT + ((16 * tn + c15) * PS + 32 * s2 + 8 * g) * 2), acc);
#pragma unroll
            for (int e = 0; e < 4; ++e) *(LAS float*)(L + R1_RHS + ((64 + 16 * tn + c15) * 65 + 16 * tm + 4 * g + e) * 4) = acc[e]; }
    }
    LDS_BARRIER();
    R1P(5);
    if (tid < 128) {
        LAS float* xr = (LAS float*)(L + R1_RHS + tid * 65 * 4);
#pragma unroll 1
        for (int Tb = 0; Tb < 4; ++Tb) {
            float acc[16];
#pragma unroll
            for (int e = 0; e < 16; ++e) acc[e] = xr[16 * Tb + e];
#pragma unroll 4
            for (int i = 0; i < 16 * Tb; ++i) { const float xi = xr[i];
#pragma unroll
                for (int q = 0; q < 4; ++q) { const f32x4 lv = *(const LAS f32x4*)(L + R1_LABT + (i * 64 + 16 * Tb + 4 * q) * 4);
#pragma unroll
                    for (int e = 0; e < 4; ++e) acc[4 * q + e] = fmaf(lv[e], xi, acc[4 * q + e]); } }
#pragma unroll
            for (int ii = 0; ii < 15; ++ii) { const float xi = acc[ii];
#pragma unroll
                for (int q = (ii + 1) / 4; q < 4; ++q) { const f32x4 lv = *(const LAS f32x4*)(L + R1_LABT + ((16 * Tb + ii) * 64 + 16 * Tb + 4 * q) * 4);
#pragma unroll
                    for (int e = 0; e < 4; ++e) if (4 * q + e > ii) acc[4 * q + e] = fmaf(lv[e], xi, acc[4 * q + e]); } }
#pragma unroll
            for (int e = 0; e < 16; ++e) xr[16 * Tb + e] = acc[e];
        }
        LAS unsigned char* dst = L + (tid < 64 ? R1_WT + tid * PS * 2 : R1_ZT + (tid - 64) * PS * 2);
#pragma unroll
        for (int q8 = 0; q8 < 8; ++q8) { u32x4 w; w.x = pk2(xr[8 * q8], xr[8 * q8 + 1]); w.y = pk2(xr[8 * q8 + 2], xr[8 * q8 + 3]); w.z = pk2(xr[8 * q8 + 4], xr[8 * q8 + 5]); w.w = pk2(xr[8 * q8 + 6], xr[8 * q8 + 7]); *(LAS u32x4*)(dst + q8 * 16) = w; }
    }
    LDS_BARRIER();
    R1P(6);
    {
        unsigned char* rw1 = p.ws + WS_RW1 + (size_t)unit * 16384;
#pragma unroll
        for (int nn = 0; nn < 2; ++nn) { const int tn = 2 * (wave & 1) + nn, col = 16 * tn + c15, r0 = 16 * tm + 4 * g;
            f32x4 aP = {0.f, 0.f, 0.f, 0.f}, aQ = aP, aG = aP, aY = aP;
#pragma unroll
            for (int s2 = 0; s2 < 2; ++s2) { const int ro = ((16 * tm + c15) * PS + 32 * s2 + 8 * g) * 2, co = ((16 * tn + c15) * PS + 32 * s2 + 8 * g) * 2;
                const bf16x8 fWT = *(const LAS bf16x8*)(L + R1_WT + ro), fBTT = *(const LAS bf16x8*)(L + R1_BTT + ro), fKTT = *(const LAS bf16x8*)(L + R1_KTT + ro), fMRB = *(const LAS bf16x8*)(L + R1_MRB + ro), fMRK = *(const LAS bf16x8*)(L + R1_MRK + ro);
                const bf16x8 cBTT = *(const LAS bf16x8*)(L + R1_BTT + co), cZT = *(const LAS bf16x8*)(L + R1_ZT + co), cVT = *(const LAS bf16x8*)(L + R1_VT + co), cMRB = *(const LAS bf16x8*)(L + R1_MRB + co);
                aP = mfma16(fWT, cBTT, aP);
                aQ = mfma16(fBTT, cZT, aQ); aQ = mfma16(fKTT, cVT, aQ);
                aG = mfma16(fWT, cMRB, aG);
                aY = mfma16(fMRB, cZT, aY); aY = mfma16(fMRK, cVT, aY); }
            const float gcc = *(const LAS float*)(L + R1_GC + col * 4);
            const f32x4 gcr = *(const LAS f32x4*)(L + R1_GC + r0 * 4);
            const u32x2 rtw = *(const LAS u32x2*)(L + R1_RT + (col * PS + r0) * 2);
#pragma unroll
            for (int e = 0; e < 4; ++e) { aP[e] = (aP[e] + ((r0 + e) == col ? 1.0f : 0.f)) * gcc; aQ[e] *= gcr[e]; }
            aG[0] += bflo(rtw.x); aG[1] += bfhi(rtw.x); aG[2] += bflo(rtw.y); aG[3] += bfhi(rtw.y);
            *(u32x2*)(rw1 + (size_t)(col * 64 + r0) * 2) = pk4(aP);
            *(u32x2*)(rw1 + 8192 + (size_t)(col * 64 + r0) * 2) = pk4(aG);
            *(u32x2*)(rw2 + (size_t)(col * 64 + r0) * 2) = pk4(aQ);
            *(u32x2*)(rw2 + RW2_ARR + (size_t)(col * 64 + r0) * 2) = pk4(aY); }
    }
    LDS_BARRIER();
    R1P(7);
}

constexpr int R2_SV = 0, R2_YS = 2 * 64 * PS * 2, R2_END = R2_YS + 2 * 64 * 68 * 4;
__device__ __forceinline__ void rwkv_scan(const Params& p, int l, int bh, unsigned char* lds) {
    const int tid = otid(), wave = tid >> 6, lane = tid & 63, c15 = lane & 15, g = lane >> 4;
    const int b = bh >> 3, h = bh & 7, role = wave >> 2, j = wave & 3, vcol = 16 * j + c15;
    LAS unsigned char* L = (LAS unsigned char*)lds;
    for (int i = tid; i < 2 * 64 * PS * 2 / 4; i += NTHREADS) ((LAS unsigned*)(L + R2_SV))[i] = 0u;
    LDS_BARRIER();
    const int et = tid >> 3, ev0 = 8 * (tid & 7);
    f32x4 gn0[2], gn1[2];
    { const float* gp = p.in[I_GNG] + l * 512 + h * 64 + ev0; const float* bp = p.in[I_GNB] + l * 512 + h * 64 + ev0;
      gn0[0] = *(const f32x4*)gp; gn0[1] = *(const f32x4*)(gp + 4); gn1[0] = *(const f32x4*)bp; gn1[1] = *(const f32x4*)(bp + 4); }
    bf16_t* OB = (bf16_t*)(p.ws + WS_OAB) + (size_t)(b * LP + et) * D + 512 + h * 64 + ev0;
    const int unit0 = (b * NCH) * 8 + h;
    const unsigned char* rw1b = p.ws + WS_RW1 + (role ? 8192 : 0) + (size_t)(c15 * 64 + 8 * g) * 2;
    const unsigned char* rw2b = p.ws + WS_RW2 + (role ? RW2_ARR : 0) + (size_t)(vcol * 64 + 4 * g) * 2;
    const unsigned char* ggb = p.ws + WS_RW2 + 2 * RW2_ARR + (size_t)(et * 64 + ev0) * 2;
    bf16x8 A0[4][2], A1[4][2]; u32x2 I0[4], I1[4];
    u32x4 G0 = {0u, 0u, 0u, 0u}, O0 = G0, G1, O1;
#define R2_LOAD(AA, II, cc) do { const size_t un_ = (size_t)(unit0 + 8 * ((cc) < NCH ? (cc) : NCH - 1)); \
        _Pragma("unroll") for (int m = 0; m < 4; ++m) { II[m] = *(const u32x2*)(rw2b + un_ * 8192 + 32 * m); \
            _Pragma("unroll") for (int s2 = 0; s2 < 2; ++s2) AA[m][s2] = *(const bf16x8*)(rw1b + un_ * 16384 + (16 * m * 64 + 32 * s2) * 2); } } while (0)
    R2_LOAD(A0, I0, 0); R2_LOAD(A1, I1, 1);
    G1 = *(const u32x4*)(ggb + (size_t)unit0 * 8192); O1 = *(const u32x4*)OB;
#pragma unroll 1
    for (int c = 0; c <= NCH; ++c) {
        const int cur = c & 1;
        bf16x8 A2[4][2]; u32x2 I2[4];
        R2_LOAD(A2, I2, c + 2);
        u32x4 G2, O2; { const int cn = c + 1 < NCH ? c + 1 : NCH - 1; G2 = *(const u32x4*)(ggb + (size_t)(unit0 + 8 * cn) * 8192); O2 = *(const u32x4*)(OB + (size_t)(64 * cn) * D); }
        if (c > 0) {
            const f32x4 y0 = *(const LAS f32x4*)(L + R2_YS + ((cur ^ 1) * 64 * 68 + et * 68 + ev0) * 4), y1 = *(const LAS f32x4*)(L + R2_YS + ((cur ^ 1) * 64 * 68 + et * 68 + ev0 + 4) * 4);
            float s1 = (y0[0] + y0[1]) + (y0[2] + y0[3]) + (y1[0] + y1[1]) + (y1[2] + y1[3]);
            s1 = sum8(s1); const float mean = s1 * (1.f / 64.f);
            const f32x4 d0 = y0 - mean, d1 = y1 - mean;
            float s2_ = (d0[0] * d0[0] + d0[1] * d0[1]) + (d0[2] * d0[2] + d0[3] * d0[3]) + (d1[0] * d1[0] + d1[1] * d1[1]) + (d1[2] * d1[2] + d1[3] * d1[3]);
            s2_ = sum8(s2_); const float rstd = rsqrtf(s2_ * (1.f / 64.f) + GN_EPS);
            const float gv[8] = {bflo(G0.x), bfhi(G0.x), bflo(G0.y), bfhi(G0.y), bflo(G0.z), bfhi(G0.z), bflo(G0.w), bfhi(G0.w)};
            const float ov[8] = {bflo(O0.x), bfhi(O0.x), bflo(O0.y), bfhi(O0.y), bflo(O0.z), bfhi(O0.z), bflo(O0.w), bfhi(O0.w)};
            float o[8];
#pragma unroll
            for (int i = 0; i < 4; ++i) { o[i] = ov[i] + (d0[i] * rstd * gn0[0][i] + gn1[0][i]) * gv[i]; o[4 + i] = ov[4 + i] + (d1[i] * rstd * gn0[1][i] + gn1[1][i]) * gv[4 + i]; }
            u32x4 w; w.x = pk2(o[0], o[1]); w.y = pk2(o[2], o[3]); w.z = pk2(o[4], o[5]); w.w = pk2(o[6], o[7]);
            *(u32x4*)(OB + (size_t)(64 * (c - 1)) * D) = w;
        }
        if (c < NCH) {
            bf16x8 bf_[2];
#pragma unroll
            for (int s2 = 0; s2 < 2; ++s2) bf_[s2] = *(const LAS bf16x8*)(L + R2_SV + cur * 64 * PS * 2 + (vcol * PS + 32 * s2 + 8 * g) * 2);
            f32x4 acc[4];
#pragma unroll
            for (int m = 0; m < 4; ++m) { acc[m] = (f32x4){bflo(I0[m].x), bfhi(I0[m].x), bflo(I0[m].y), bfhi(I0[m].y)};
#pragma unroll
                for (int s2 = 0; s2 < 2; ++s2) acc[m] = mfma16(A0[m][s2], bf_[s2], acc[m]); }
            if (role == 0) {
#pragma unroll
                for (int m = 0; m < 4; ++m) *(LAS u32x2*)(L + R2_SV + (cur ^ 1) * 64 * PS * 2 + (vcol * PS + 16 * m + 4 * g) * 2) = pk4(acc[m]);
            } else {
#pragma unroll
                for (int m = 0; m < 4; ++m)
#pragma unroll
                    for (int e = 0; e < 4; ++e) *(LAS float*)(L + R2_YS + (cur * 64 * 68 + (16 * m + 4 * g + e) * 68 + vcol) * 4) = acc[m][e];
            }
        }
        LDS_BARRIER();
#pragma unroll
        for (int m = 0; m < 4; ++m) { I0[m] = I1[m]; I1[m] = I2[m]; A0[m][0] = A1[m][0]; A0[m][1] = A1[m][1]; A1[m][0] = A2[m][0]; A1[m][1] = A2[m][1]; }
        G0 = G1; O0 = O1; G1 = G2; O1 = O2;
    }
#undef R2_LOAD
}

__device__ void rwkv_naive(const Params& p, int l, int bh, unsigned char* lds) {
    const int b = bh >> 3, h = bh & 7, tid = otid(), lane = tid & 63, wid = tid >> 6;
    const bf16_t* U = (const bf16_t*)(p.ws + WS_UAR);
    bf16_t* OB = (bf16_t*)(p.ws + WS_OAB);
    float* xs = (float*)lds;
    float* vr = xs + 32 * 256;
    float* vw = vr + 2048; float* vkk = vw + 2048; float* vbb = vkk + 2048; float* vk = vbb + 2048; float* vv = vk + 2048;
    float* gg = vv + 2048; float* bon = gg + 2048; float* ys = bon + 2048;
    const float* mu = p.in[I_MU] + l * R_COLS;
    const int hd = h * 64 + lane;
    const float w0 = p.in[I_W0][l * 512 + hd], a0 = p.in[I_A0][l * 512 + hd], kkc = p.in[I_KK][l * 512 + hd], kac = p.in[I_KA][l * 512 + hd], rkc = p.in[I_RK][l * 512 + hd];
    const float gng = p.in[I_GNG][l * 512 + hd], gnb = p.in[I_GNB][l * 512 + hd];
    const float mur = mu[hd], muk = mu[512 + hd], muv = mu[1024 + hd];
    const float* wup = p.in[I_WUP] + (size_t)l * 64 * 512 + hd; const float* aup = p.in[I_AUP] + (size_t)l * 64 * 512 + hd; const float* gup = p.in[I_GUP] + (size_t)l * 128 * 512 + hd;
    float S[8];
#pragma unroll
    for (int i = 0; i < 8; ++i) S[i] = 0.f;
    const int sv = tid >> 3, sq = tid & 7;
    for (int p0 = 0; p0 < LP; p0 += 32) {
        for (int idx = tid; idx < 32 * 256; idx += NTHREADS) {
            const int tt = idx >> 8, j = idx & 255, pos = p0 + tt; const size_t ro = (size_t)(b * LP + pos) * UARW;
            const float x = bf2f(U[ro + C_XW + j]); const float xp = pos > 0 ? bf2f(U[ro - UARW + C_XW + j]) : 0.f;
            float xv = x + (xp - x) * mu[1536 + j];
            if (j < 64) xv = tanhf(xv); else if (j >= 128) xv = sigmoidf_(xv);
            xs[idx] = xv;
        }
        __syncthreads();
        {
            float dw[4] = {0.f, 0.f, 0.f, 0.f}, da[4] = {0.f, 0.f, 0.f, 0.f}, dg[4] = {0.f, 0.f, 0.f, 0.f};
            for (int j = 0; j < 64; ++j) { const float w1 = wup[(size_t)j * 512], w2 = aup[(size_t)j * 512];
#pragma unroll
                for (int k = 0; k < 4; ++k) { dw[k] = fmaf(xs[(wid * 4 + k) * 256 + j], w1, dw[k]); da[k] = fmaf(xs[(wid * 4 + k) * 256 + 64 + j], w2, da[k]); } }
            for (int j = 0; j < 128; ++j) { const float w3 = gup[(size_t)j * 512];
#pragma unroll
                for (int k = 0; k < 4; ++k) dg[k] = fmaf(xs[(wid * 4 + k) * 256 + 128 + j], w3, dg[k]); }
#pragma unroll
            for (int k = 0; k < 4; ++k) {
                const int tt = wid * 4 + k, pos = p0 + tt; const size_t ro = (size_t)(b * LP + pos) * UARW;
                float r = bf2f(U[ro + C_R + hd]), kx = bf2f(U[ro + C_RK + hd]), vx = bf2f(U[ro + C_RV + hd]);
                if (pos > 0) { const float rp = bf2f(U[ro - UARW + C_R + hd]), kp = bf2f(U[ro - UARW + C_RK + hd]), vp = bf2f(U[ro - UARW + C_RV + hd]);
                    r += (rp - r) * mur; kx += (kp - kx) * muk; vx += (vp - vx) * muv; }
                else { r -= r * mur; kx -= kx * muk; vx -= vx * muv; }
                const float z = -(w0 + dw[k]); const float sp = fmaxf(z, 0.f) + log1pf(__expf(-fabsf(z)));
                const float logw = -sp - 0.5f; const float w = __expf(-__expf(logw));
                const float a = sigmoidf_(a0 + da[k]);
                float kk = kx * kkc; const float nrm = wave_sum(kk * kk); kk *= rsqrtf(fmaxf(nrm, 1e-24f));
                const float kmod = kx * (1.0f + (a - 1.0f) * kac);
                const float bsum = wave_sum(r * kmod * rkc);
                vr[tt * 64 + lane] = r; vw[tt * 64 + lane] = w; vkk[tt * 64 + lane] = kk; vbb[tt * 64 + lane] = kk * a; vk[tt * 64 + lane] = kmod; vv[tt * 64 + lane] = vx;
                gg[tt * 64 + lane] = dg[k]; bon[tt * 64 + lane] = bsum * vx;
            }
        }
        __syncthreads();
        for (int tt = 0; tt < 32; ++tt) {
            const f32x4 k0 = *(const f32x4*)(vkk + tt * 64 + sq * 8), k1 = *(const f32x4*)(vkk + tt * 64 + sq * 8 + 4);
            const f32x4 w0v = *(const f32x4*)(vw + tt * 64 + sq * 8), w1v = *(const f32x4*)(vw + tt * 64 + sq * 8 + 4);
            const f32x4 b0 = *(const f32x4*)(vbb + tt * 64 + sq * 8), b1 = *(const f32x4*)(vbb + tt * 64 + sq * 8 + 4);
            const f32x4 m0 = *(const f32x4*)(vk + tt * 64 + sq * 8), m1 = *(const f32x4*)(vk + tt * 64 + sq * 8 + 4);
            const f32x4 r0 = *(const f32x4*)(vr + tt * 64 + sq * 8), r1 = *(const f32x4*)(vr + tt * 64 + sq * 8 + 4);
            const float vt = vv[tt * 64 + sv];
            float sa = 0.f;
#pragma unroll
            for (int i = 0; i < 4; ++i) { sa = fmaf(S[i], k0[i], sa); sa = fmaf(S[4 + i], k1[i], sa); }
            sa += __shfl_xor(sa, 1); sa += __shfl_xor(sa, 2); sa += __shfl_xor(sa, 4);
            sa = -sa; float y = 0.f;
#pragma unroll
            for (int i = 0; i < 4; ++i) { S[i] = S[i] * w0v[i] + sa * b0[i] + vt * m0[i]; S[4 + i] = S[4 + i] * w1v[i] + sa * b1[i] + vt * m1[i];
                y = fmaf(S[i], r0[i], y); y = fmaf(S[4 + i], r1[i], y); }
            y += __shfl_xor(y, 1); y += __shfl_xor(y, 2); y += __shfl_xor(y, 4);
            if (sq == 0) ys[tt * 64 + sv] = y;
        }
        __syncthreads();
#pragma unroll
        for (int k = 0; k < 4; ++k) { const int tt = wid * 4 + k, pos = p0 + tt; const float y = ys[tt * 64 + lane];
            const float m = wave_sum(y) * (1.f / 64.f); const float dv = y - m; const float var = wave_sum(dv * dv) * (1.f / 64.f);
            const float o = (dv * rsqrtf(var + GN_EPS) * gng + gnb + bon[tt * 64 + lane]) * gg[tt * 64 + lane];
            OB[(size_t)(b * LP + pos) * D + 512 + hd] = (bf16_t)f2bf(o); }
        __syncthreads();
    }
}

__device__ __forceinline__ int pair_index(int a, int b) {   return a == 0 ? b - 1 : (a == 1 ? b + 1 : 5); }
__device__ __forceinline__ void pair_of(int idx, int& a, int& b) { a = idx < 3 ? 0 : (idx < 5 ? 1 : 2); b = idx < 3 ? idx + 1 : (idx < 5 ? idx - 1 : 3); }
__device__ __forceinline__ void ln1_rows(const Params& p, int l, unsigned char* lds, int row0, bool stage) {
    const int tid = otid(), lane = tid & 63, gw = row0 + 8 * (tid >> 6), NGW = 1, TEND = gw + 8;
    int* lcnt = (int*)(lds + 65536); int* lbase = lcnt + 32; int* rec = lcnt + 64;
    __syncthreads();
    if (tid < 32) lcnt[tid] = 0;
    float* wr_s = (float*)lds;
    if (stage) for (int i = tid; i < D * 16 / 4; i += NTHREADS) { const f32x4 w = ((const f32x4*)p.in[I_WROUTER])[i]; const int c = i >> 2, e0 = (i & 3) * 4;
        wr_s[(e0 + 0) * D + c] = w[0]; wr_s[(e0 + 1) * D + c] = w[1]; wr_s[(e0 + 2) * D + c] = w[2]; wr_s[(e0 + 3) * D + c] = w[3]; }
    __syncthreads();
    unsigned* cls_cnt = (unsigned*)(p.ws + WS_CTL) + CW_CLS + l * 512;
    int* lists = (int*)(p.ws + WS_LIST); f32x2* gl = (f32x2*)(p.ws + WS_LIST + 2 * MiB);
    const float* g = p.in[I_LN1G] + l * D; const float* bt = p.in[I_LN1B] + l * D;
    f32x4 vn[4];
    { const float* h0 = hrow(p, gw);
#pragma unroll
      for (int j = 0; j < 4; ++j) vn[j] = *(const f32x4*)(h0 + 4 * lane + 256 * j); }
    int nrec = 0;
    for (int r = gw; r < TEND; r += NGW) {
        f32x4 v[4];
#pragma unroll
        for (int j = 0; j < 4; ++j) v[j] = vn[j];
        { const float* h1 = hrow(p, r + NGW < TEND ? r + NGW : r);
#pragma unroll
          for (int j = 0; j < 4; ++j) vn[j] = *(const f32x4*)(h1 + 4 * lane + 256 * j); }
        if (is_dummy(r)) {
#pragma unroll
            for (int j = 0; j < 4; ++j) v[j] = (f32x4){0.f, 0.f, 0.f, 0.f};
            store_row(p, r, v, lane, true); continue; }
        ln_wave(v, g, bt, lane);
        store_row(p, r, v, lane, false);
        float lg[16];
#pragma unroll
        for (int e = 0; e < 16; ++e) lg[e] = 0.f;
#pragma unroll
        for (int e = 0; e < 16; ++e)
#pragma unroll
            for (int j = 0; j < 4; ++j) { const f32x4 w = *(const f32x4*)(wr_s + e * D + 4 * lane + 256 * j);
                lg[e] = fmaf(v[j][0], w[0], lg[e]); lg[e] = fmaf(v[j][1], w[1], lg[e]); lg[e] = fmaf(v[j][2], w[2], lg[e]); lg[e] = fmaf(v[j][3], w[3], lg[e]); }
        float mine = 0.f;
#pragma unroll
        for (int e = 0; e < 16; ++e) { const float rs = sum16(lg[e]); mine = (lane & 15) == e ? rs : mine; }
        mine += __shfl_xor(mine, 16); mine += __shfl_xor(mine, 32);
#pragma unroll
        for (int e = 0; e < 16; ++e) lg[e] = __builtin_bit_cast(float, __builtin_amdgcn_readlane(__builtin_bit_cast(int, mine), e));
        float s[16], sel[16];
#pragma unroll
        for (int e = 0; e < 16; ++e) { s[e] = sigmoidf_(lg[e]); sel[e] = s[e] + p.in[I_BROUTER][e]; }
        int gbest = 0; float gsc = -INFINITY;
#pragma unroll
        for (int gi = 0; gi < 4; ++gi) { float m1 = -INFINITY, m2 = -INFINITY;
#pragma unroll
            for (int j = 0; j < 4; ++j) { const float x = sel[gi * 4 + j]; if (x > m1) { m2 = m1; m1 = x; } else if (x > m2) m2 = x; }
            const float sc = m1 + m2; if (sc > gsc) { gsc = sc; gbest = gi; } }
        float sg[4], sgs[4];
#pragma unroll
        for (int j = 0; j < 4; ++j) { sg[j] = gbest == 0 ? sel[j] : (gbest == 1 ? sel[4 + j] : (gbest == 2 ? sel[8 + j] : sel[12 + j])); sgs[j] = gbest == 0 ? s[j] : (gbest == 1 ? s[4 + j] : (gbest == 2 ? s[8 + j] : s[12 + j])); }
        int j1 = 0;
#pragma unroll
        for (int j = 1; j < 4; ++j) if (sg[j] > sg[j1]) j1 = j;
        int j2 = j1 == 0 ? 1 : 0;
#pragma unroll
        for (int j = 0; j < 4; ++j) if (j != j1 && j != j2 && sg[j] > sg[j2]) j2 = j;
        const int ja = j1 < j2 ? j1 : j2, jb = j1 < j2 ? j2 : j1;
        float sa_ = 0.f, sb_ = 0.f;
#pragma unroll
        for (int j = 0; j < 4; ++j) { if (j == ja) sa_ = sgs[j]; if (j == jb) sb_ = sgs[j]; }
        const float inv = 1.0f / (sa_ + sb_);
        const int cls = gbest * 6 + pair_index(ja, jb);
        if (lane == 0) { const int loc = __hip_atomic_fetch_add(lcnt + cls, 1, __ATOMIC_RELAXED, __HIP_MEMORY_SCOPE_WORKGROUP); rec[(tid >> 6) * 32 + 2 * nrec] = r; rec[(tid >> 6) * 32 + 2 * nrec + 1] = (cls << 16) | loc; gl[r] = (f32x2){sa_ * inv, sb_ * inv}; }
        ++nrec;
    }
    __syncthreads();
    if (tid < 24) lbase[tid] = (int)atomicAdd(cls_cnt + 16 * tid, (unsigned)lcnt[tid]);
    __syncthreads();
    if (lane < nrec) { const int r = rec[(tid >> 6) * 32 + 2 * lane], cl = rec[(tid >> 6) * 32 + 2 * lane + 1]; const int cls = cl >> 16; lists[(size_t)cls * T + lbase[cls] + (cl & 0xffff)] = r; }
}


constexpr size_t WS_CH1 = 655360;
constexpr int CH1_NM = 260, CH1_NW = 260, CH1_NC = 96, CH1_NL = 260, CH1_TOT = CH1_NM + CH1_NW + CH1_NC + CH1_NL;
__device__ __forceinline__ void task_signal(unsigned* c0, unsigned* c1) {
    asm volatile("s_waitcnt vmcnt(0)" ::: "memory");
    __syncthreads();
    if (otid() == 0) { __builtin_amdgcn_fence(__ATOMIC_RELEASE, "agent"); asm volatile("s_waitcnt vmcnt(0)" ::: "memory");
        __hip_atomic_fetch_add(c0, 1u, __ATOMIC_RELAXED, __HIP_MEMORY_SCOPE_AGENT); if (c1) __hip_atomic_fetch_add(c1, 1u, __ATOMIC_RELAXED, __HIP_MEMORY_SCOPE_AGENT); }
}
__device__ __forceinline__ void task_wait(unsigned* c, unsigned target) {
    if (otid() == 0) { unsigned sp = 0; while (__hip_atomic_load(c, __ATOMIC_RELAXED, __HIP_MEMORY_SCOPE_AGENT) < target && ++sp < (1u << 24)) __builtin_amdgcn_s_sleep(2);
        __builtin_amdgcn_fence(__ATOMIC_ACQUIRE, "agent"); asm volatile("s_waitcnt vmcnt(0)" ::: "memory"); }
    __syncthreads();
}
__device__ __forceinline__ void conv_expert_items(const Params& p, int l, LAS unsigned char* lds, int it0, int it1);
__device__ __forceinline__ void chain1_phase(int l, unsigned char* lds, LAS unsigned char* ldsl) {
    int staged = 0;
    for (;;) {
        unsigned* chq = (unsigned*)(PP().ws + WS_CH1) + 1024 * l;
        volatile int* uw = (volatile int*)(lds + 144000);
        __syncthreads();
        if (otid() == 0) *uw = (int)atomicAdd(chq, 1u);
        __syncthreads();
        const int t = __builtin_amdgcn_readfirstlane(*uw);
        if (t >= CH1_TOT) break;
        if (t < CH1_NM) { const int pm = t >> 2, pn = t & 3;
            merge_unit(l, ldsl, pm, pn);
            task_signal(chq + 64 + pm, chq + 16);
        } else if (t < CH1_NM + CH1_NW) { const int u = t - CH1_NM, pm = u >> 2, pn = u & 3;
            task_wait(chq + 64 + pm, 4u);
            wout_unit(l, ldsl, pm, pn);
            task_signal(chq + 192 + pm, nullptr);
        } else if (t < CH1_NM + CH1_NW + CH1_NC) { const int u = t - CH1_NM - CH1_NW;
            task_wait(chq + 16, (unsigned)CH1_NM);
            conv_expert_items(PP(), l, ldsl, u * 128, u * 128 + 128);
        } else { const int u = t - CH1_NM - CH1_NW - CH1_NC, pm = u >> 2, qr = u & 3;
            task_wait(chq + 16, (unsigned)CH1_NM);
            task_wait(chq + 192 + pm, 4u);
            ln1_rows(PP(), l, lds, pm * 256 + qr * 64, staged == 0); staged = 1;
        }
    }
}

struct ClsTab { int cnt[24]; int tile0[25]; int row0[24]; };
__device__ __forceinline__ void build_cls_table(const Params& p, int l, int* tab  ) {
    if (otid() == 0) { const unsigned* c = (const unsigned*)(p.ws + WS_CTL) + CW_CLS + l * 512; int acc = 0;
        for (int i = 0; i < 24; ++i) { const int n = (int)__hip_atomic_load(c + 16 * i, __ATOMIC_RELAXED, __HIP_MEMORY_SCOPE_AGENT); tab[i] = n; tab[24 + i] = acc; acc += (n + 255) >> 8; }
        tab[48] = acc; }
    __syncthreads();
}
__device__ __forceinline__ int find_cls(const int* tab, int tile) { int c = 0;
#pragma unroll 1
    for (int i = 1; i < 24; ++i) if (tile >= tab[24 + i]) c = i;
    return c; }
__device__ __forceinline__ void moe_a_phase(const Params& p, int l, LAS unsigned char* lds, const int* tab) {
    const int tid = otid();
    unsigned voffB[2]; g8::make_voffB(voffB, D * 2, true);
    const int ntiles = tab[48], nunits = ntiles * 8;
    for (int u = obid(); u < nunits; u += gridDim.x) {
        const int tile = u >> 3, pn = u & 7, cls = find_cls(tab, tile), rt = tile - tab[24 + cls], n = tab[cls];
        int ja, jb; pair_of(cls % 6, ja, jb); const int eslot = pn >> 2, e = (cls / 6) * 4 + (eslot ? jb : ja), jblk = pn & 3;
        unsigned voffA[2][2]; { const int* lists = (const int*)(PP().ws + WS_LIST);
#pragma unroll
        for (int i = 0; i < 2; ++i) { int R, C; g8::stage_rc(tid * 16 + i * 8192, R, C);
#pragma unroll
            for (int hh = 0; hh < 2; ++hh) { const int li = rt * 256 + R + hh * 128; const int tok = li < n ? lists[(size_t)cls * T + li] : 0;
                voffA[hh][i] = (unsigned)tok * (D * 2) + (unsigned)C * 2u; } } }
        g8::Acc acc; g8::zero_acc(acc);
        const char* Bb = (const char*)(PP().ws + WS_WEXP) + ((size_t)e * 1024 + jblk * 256) * D * 2;
        const g8::KSeg s = g8::seg1((const char*)(PP().ws + WS_HB), Bb, Bb + (size_t)128 * D * 2, D / 64);
        g8::kloop<true, false>(lds, acc, s, voffA, voffB, 0);
        EPI_COORDS();
        const int* lists = (const int*)(PP().ws + WS_LIST); const f32x2* gl = (const f32x2*)(PP().ws + WS_LIST + 2 * MiB); bf16_t* ACT = (bf16_t*)(PP().ws + WS_ACT);
#pragma unroll
        for (int ai = 0; ai < 2; ++ai)
#pragma unroll
            for (int m = 0; m < 4; ++m) { asm volatile("" ::: "memory"); const int li = rt * 256 + ai * 128 + wr * 64 + m * 16 + fr; const int tok = li < n ? lists[(size_t)cls * T + li] : -1;
                float gate = 0.f; if (tok >= 0) { const f32x2 g2 = gl[tok]; gate = eslot ? g2[1] : g2[0]; }
                const f32x4 h1a = acc[ai][0][m][0], h1b = acc[ai][0][m][1], h3a = acc[ai][1][m][0], h3b = acc[ai][1][m][1];
                float o[8];
#pragma unroll
                for (int c = 0; c < 4; ++c) { o[c] = gate * (h1a[c] * sigmoidf_(h1a[c])) * h3a[c]; o[4 + c] = gate * (h1b[c] * sigmoidf_(h1b[c])) * h3b[c]; }
                u32x4 w; w.x = pk2(o[0], o[1]); w.y = pk2(o[2], o[3]); w.z = pk2(o[4], o[5]); w.w = pk2(o[6], o[7]);
                *(u32x4*)(ACT + (size_t)(tile * 256 + ai * 128 + wr * 64 + m * 16 + fr) * D + eslot * 512 + jblk * 128 + wc * 32 + 8 * fq) = w; }
    }
}
__device__ __forceinline__ void moe_b_phase(const Params& p, int l, LAS unsigned char* lds, const int* tab) {
    unsigned voffA[2][2], voffB[2]; g8::make_voff_contig(voffA, D * 2); g8::make_voffB(voffB, 512 * 2, false);
    const int ntiles = tab[48], nunits = ntiles * 4;
    for (int u = obid(); u < nunits; u += gridDim.x) {
        const int tile = u >> 2, pn = u & 3, cls = find_cls(tab, tile), rt = tile - tab[24 + cls], n = tab[cls];
        int ja, jb; pair_of(cls % 6, ja, jb); const int ea = (cls / 6) * 4 + ja, eb = (cls / 6) * 4 + jb;
        g8::Acc acc; g8::zero_acc(acc);
        const char* At = (const char*)(PP().ws + WS_ACT) + (size_t)tile * 256 * D * 2;
        const char* W2 = (const char*)(PP().ws + WS_WEXP + 32 * MiB);
        const char* Ba = W2 + ((size_t)ea * 1024 + pn * 256) * 512 * 2; const char* Bb = W2 + ((size_t)eb * 1024 + pn * 256) * 512 * 2;
        g8::KSeg s2 = g8::seg1(At, Ba, Ba + (size_t)128 * 512 * 2, 16); s2.nt0 = 8; s2.A2 = At + 1024; s2.B02 = Bb; s2.B12 = Bb + (size_t)128 * 512 * 2;
        g8::kloop<false, true>(lds, acc, s2, voffA, voffB, 128 * D * 2);
        EPI_COORDS();
        const int* lists = (const int*)(PP().ws + WS_LIST);
        const int col0 = pn * 256 + wc * 32 + 4 * fq;
        int tk[2][4];
#pragma unroll
        for (int ai = 0; ai < 2; ++ai)
#pragma unroll
            for (int m = 0; m < 4; ++m) { const int li = rt * 256 + ai * 128 + wr * 64 + m * 16 + fr; tk[ai][m] = li < n ? lists[(size_t)cls * T + li] : -1; }
#pragma unroll
        for (int ai = 0; ai < 2; ++ai) { asm volatile("" ::: "memory");
            f32x4 pre[4][2][2]; float* hr[4];
#pragma unroll
            for (int m = 0; m < 4; ++m) { hr[m] = hrow(PP(), tk[ai][m] >= 0 ? tk[ai][m] : 0) + col0;
#pragma unroll
                for (int bj = 0; bj < 2; ++bj)
#pragma unroll
                    for (int nn = 0; nn < 2; ++nn) pre[m][bj][nn] = *(const f32x4*)(hr[m] + bj * 128 + nn * 16); }
#pragma unroll
            for (int m = 0; m < 4; ++m) if (tk[ai][m] >= 0) {
#pragma unroll
                for (int bj = 0; bj < 2; ++bj)
#pragma unroll
                    for (int nn = 0; nn < 2; ++nn) *(f32x4*)(hr[m] + bj * 128 + nn * 16) = pre[m][bj][nn] * ALPHA + acc[ai][bj][m][nn]; } }
    }
}
__device__ __forceinline__ void ln2_phase(const Params& p, int l) {
    const int tid = otid(), lane = tid & 63, gw = obid() * NWAVES + (tid >> 6), NGW = gridDim.x * NWAVES;
    const float* g = p.in[I_LN2G] + l * D; const float* bt = p.in[I_LN2B] + l * D;
    for (int r = gw; r < T; r += NGW) {
        f32x4 v[4];
        if (is_dummy(r)) {
#pragma unroll
            for (int j = 0; j < 4; ++j) v[j] = (f32x4){0.f, 0.f, 0.f, 0.f};
            store_row(p, r, v, lane, true); continue; }
        const float* hr = hrow(p, r);
#pragma unroll
        for (int j = 0; j < 4; ++j) v[j] = *(const f32x4*)(hr + 4 * lane + 256 * j);
        ln_wave(v, g, bt, lane);
        store_row(p, r, v, lane, false);
    }
}


#define XB_TMO      128
#define XB_XCNT(j)  (256  + 64 * (j))
#define XB_XSUB(j)  (1280 + 64 * (j))
#define XB_XGEN(j)  (2304 + 64 * (j))
#define XB_TOP      3328
#define XB_TOPGEN   3392
#define XCD_BAR_WORDS 3456
#define XB_SPIN_CAP (1u << 22)
constexpr size_t WS_BAR = 8192;
constexpr int LDS_BARST = LDS_BYTES - 16;
__device__ __forceinline__ unsigned xb_ld(unsigned* p)              { return __hip_atomic_load(p, __ATOMIC_RELAXED, __HIP_MEMORY_SCOPE_AGENT); }
__device__ __forceinline__ unsigned xb_add(unsigned* p, unsigned v) { return __hip_atomic_fetch_add(p, v, __ATOMIC_RELAXED, __HIP_MEMORY_SCOPE_AGENT); }
__device__ __forceinline__ unsigned xb_xcc_id() { return (unsigned)__builtin_amdgcn_s_getreg((3 << 11) | 20) & 0xFu; }
#define XB_SPIN(cond, bar) do { unsigned _sp = 0; while (cond) { __builtin_amdgcn_s_sleep(1); \
    if ((++_sp & 255u) == 0u) { if (xb_ld(&(bar)[XB_TMO])) break; if (_sp > XB_SPIN_CAP) { atomicAdd(&(bar)[XB_TMO], 1u); break; } } } } while (0)
__device__ __forceinline__ void xcd_barrier_complete(unsigned* bar, unsigned x, unsigned& nloc, unsigned& nx) {
    const unsigned G = gridDim.x * gridDim.y * gridDim.z;
    unsigned sum, cnt, mine, sp = 0u;
    for (;;) {
        sum = 0u; cnt = 0u; mine = 0u;
#pragma unroll
        for (unsigned j = 0; j < 16; ++j) { const unsigned c = xb_ld(&bar[XB_XCNT(j)]); sum += c; cnt += (c > 0u) ? 1u : 0u; mine = (j == x) ? c : mine; }
        if (sum == G) break;
        __builtin_amdgcn_s_sleep(1);
        if ((++sp & 255u) == 0u) { if (xb_ld(&bar[XB_TMO])) break; if (sp > XB_SPIN_CAP) { atomicAdd(&bar[XB_TMO], 1u); break; } }
    }
    nloc = mine > 0u ? mine : 1u; nx = cnt > 0u ? cnt : 1u;
}
__device__ __forceinline__ void xcd_barrier(unsigned* bar, volatile LAS unsigned* st) {
    asm volatile("s_waitcnt vmcnt(0)" ::: "memory");
    __syncthreads();
    if (threadIdx.x == 0) {
        __builtin_amdgcn_s_waitcnt(0);
        const unsigned x = xb_xcc_id();
        unsigned nloc = st[0], nx = st[1];
        if (nloc == 0u) { xcd_barrier_complete(bar, x, nloc, nx); st[0] = nloc; st[1] = nx; }
        const unsigned old = xb_add(&bar[XB_XSUB(x)], 1u);
        const unsigned gen = old / nloc;
        if (old + 1u == (gen + 1u) * nloc) {
            __builtin_amdgcn_fence(__ATOMIC_RELEASE, "agent");
            asm volatile("s_waitcnt vmcnt(0)" ::: "memory");
            const unsigned og = xb_add(&bar[XB_TOP], 1u);
            const unsigned tg = og / nx;
            if (og + 1u == (tg + 1u) * nx) xb_add(&bar[XB_TOPGEN], 1u);
            else XB_SPIN(xb_ld(&bar[XB_TOPGEN]) == tg, bar);
            __builtin_amdgcn_fence(__ATOMIC_ACQUIRE, "agent");
            xb_add(&bar[XB_XGEN(x)], 1u);
            asm volatile("s_waitcnt vmcnt(0)" ::: "memory");
        } else {
            XB_SPIN(xb_ld(&bar[XB_XGEN(x)]) == gen, bar);
            __builtin_amdgcn_fence(__ATOMIC_ACQUIRE, "agent");
            asm volatile("s_waitcnt vmcnt(0)" ::: "memory");
        }
    }
    __syncthreads();
}

__global__ void __launch_bounds__(NTHREADS, 2) mega(Params p_unused) {
    extern __shared__ __attribute__((aligned(16))) unsigned char lds[];
    cg::grid_group grid = cg::this_grid();
    volatile LAS unsigned* barst = (volatile LAS unsigned*)((LAS unsigned char*)lds + LDS_BARST);
    { unsigned* bar0 = (unsigned*)(PP().ws + WS_BAR);
      if (threadIdx.x == 0) { barst[0] = 0u; barst[1] = 0u; (void)xb_add(bar0 + XB_XCNT(xb_xcc_id()), 1u); } }
    __syncthreads();
#define GBAR() xcd_barrier((unsigned*)(PP().ws + WS_BAR), barst)
    unsigned long long pr_t0 = 0, pr_acc = 0;
#define PH_BEGIN(k) do { if (PROBE_PHASE == (k)) pr_t0 = __builtin_amdgcn_s_memrealtime(); } while (0)
#define PH_END(k) do { if (PROBE_PHASE == (k)) pr_acc += __builtin_amdgcn_s_memrealtime() - pr_t0; } while (0)
#define LDSG() (lds + ozero())
#define LDSL() ((LAS unsigned char*)lds)

    PH_BEGIN(0);
    conv_small_weights(PP(), LDSL());
    ln_in_phase(PP());
    if (gridDim.y == 0x7fffffffu) grid.sync();
    GBAR();
    PH_END(0);
#pragma unroll 1
    for (int l = 0; l < DEPTH; ++l) {
        PH_BEGIN(1);
        inproj_phase(PP(), l, LDSL());
        GBAR();
        PH_END(1); PH_BEGIN(2);
        {
            unsigned* qctr = (unsigned*)(PP().ws + WS_CTL) + CW_R1Q + 2 * l;
            volatile int* uw = (volatile int*)(LDSG() + AT_UNIT);
            int ndone = 0;
            for (;;) {
                __syncthreads();
                if (otid() == 0) *uw = (int)atomicAdd(qctr, 1u);
                __syncthreads();
                const int u = *uw;
                if (u >= BATCH * NCH * 8) break;
                if (PROBE_PHASE == 30) pr_t0 = __builtin_amdgcn_s_memrealtime();
                rwkv_prep_unit(PP(), l, u, LDSG(), pr_acc); ++ndone;
                if (PROBE_PHASE == 30) pr_acc += __builtin_amdgcn_s_memrealtime() - pr_t0;
            }
            asm volatile("s_waitcnt vmcnt(0)" ::: "memory");
            __syncthreads();
            if (otid() == 0 && ndone > 0) { __builtin_amdgcn_fence(__ATOMIC_RELEASE, "agent"); asm volatile("s_waitcnt vmcnt(0)" ::: "memory"); __hip_atomic_fetch_add(qctr + 1, (unsigned)ndone, __ATOMIC_RELAXED, __HIP_MEMORY_SCOPE_AGENT); }
            const int bid = obid();
            if (bid < 32) {
                if (otid() == 0) { unsigned sp = 0; while (__hip_atomic_load(qctr + 1, __ATOMIC_RELAXED, __HIP_MEMORY_SCOPE_AGENT) < (unsigned)(BATCH * NCH * 8) && ++sp < (1u << 26)) __builtin_amdgcn_s_sleep(4);
                    __builtin_amdgcn_fence(__ATOMIC_ACQUIRE, "agent"); asm volatile("s_waitcnt vmcnt(0)" ::: "memory"); }
                __syncthreads();
                rwkv_scan(PP(), l, bid, LDSG());
            }
            attn_phase(PP(), l, LDSG(), pr_acc);
        }
        GBAR();
        PH_END(2); PH_BEGIN(4);
        chain1_phase(l, LDSG(), LDSL());
        GBAR();
        PH_END(4); PH_BEGIN(7);
        { int toff = 140 * 1024; asm volatile("" : "+s"(toff)); int* tab = (int*)(lds + toff);
          build_cls_table(PP(), l, tab);
          moe_a_phase(PP(), l, LDSL(), tab);
          GBAR();
          PH_END(7); PH_BEGIN(8);
          moe_b_phase(PP(), l, LDSL(), tab); }
        GBAR();
        PH_END(8); PH_BEGIN(9);
        ln2_phase(PP(), l);
        if (l + 1 < DEPTH) GBAR();
        PH_END(9);
    }
    if (PROBE_PHASE >= 0 && blockIdx.x == PROBE_BLOCK && threadIdx.x == 0) { const unsigned long long t = __builtin_amdgcn_s_memrealtime(); while (__builtin_amdgcn_s_memrealtime() - t < pr_acc) __builtin_amdgcn_s_sleep(8); }
}

extern "C" void kernel_launch(void* const* d_in, const int* in_sizes, int n_in, void* d_out, int out_size,
                              void* d_ws, size_t ws_size, hipStream_t stream) {
    static int grid_blocks = 0;
    if (grid_blocks == 0) {
        int dev = 0, cus = 0, per_cu = 0;
        if (n_in != 29 || ws_size < WS_END || out_size != BATCH * SEQ * D) { fprintf(stderr, "kernel_launch: unexpected problem (n_in %d, ws %zu, out %d)\n", n_in, ws_size, out_size); grid_blocks = -1; return; }
        (void)hipGetDevice(&dev);
        (void)hipDeviceGetAttribute(&cus, hipDeviceAttributeMultiprocessorCount, dev);
        (void)hipFuncSetAttribute((const void*)mega, hipFuncAttributeMaxDynamicSharedMemorySize, LDS_BYTES);
        (void)hipOccupancyMaxActiveBlocksPerMultiprocessor(&per_cu, (const void*)mega, NTHREADS, LDS_BYTES);
        if (per_cu < 1) { fprintf(stderr, "occupancy query returned %d\n", per_cu); grid_blocks = -1; return; }
        grid_blocks = cus;
    }
    if (grid_blocks < 0) return;
    (void)hipMemsetAsync((char*)d_ws + WS_CTL, 0, 32768, stream);
    (void)hipMemsetAsync((char*)d_ws + WS_CH1, 0, 16384, stream);
    Params p{};
    for (int i = 0; i < 29; ++i) p.in[i] = (const float*)d_in[i];
    p.out = (float*)d_out; p.ws = (unsigned char*)d_ws;
    void* args[] = {&p};
    hipError_t e = hipLaunchCooperativeKernel((const void*)mega, dim3(grid_blocks), dim3(NTHREADS), args, LDS_BYTES, stream);
    if (e != hipSuccess) fprintf(stderr, "cooperative launch failed: %s (grid %d)\n", hipGetErrorString(e), grid_blocks);
}
```

```cpp
#include <hip/hip_runtime.h>
#include <hip/hip_cooperative_groups.h>
#include <cstdio>
#include <cstdint>
namespace cg = cooperative_groups;

#define LAS __attribute__((address_space(3)))
typedef unsigned short bf16_t;
typedef short bf16x8 __attribute__((ext_vector_type(8)));
typedef float f32x4 __attribute__((ext_vector_type(4)));
typedef float f32x2 __attribute__((ext_vector_type(2)));
typedef unsigned u32x4 __attribute__((ext_vector_type(4)));
typedef unsigned u32x2 __attribute__((ext_vector_type(2)));

constexpr int NTHREADS = 512, NWAVES = 8;
constexpr int D = 1024, BATCH = 4, SEQ = 4096, DEPTH = 2;
constexpr int LP = 4160;
constexpr int T = BATCH * LP;
constexpr int NCH = LP / 64;
constexpr int PADM = 48;
constexpr int A_COLS = 1064, R_COLS = 1792, IN_COLS = 4904;
constexpr int UA = 1280;
constexpr int UARW = 3072;
constexpr int NIN = 5120;
constexpr float LN_EPS = 1e-5f, GN_EPS = 64e-5f;
constexpr float ALPHA = 1.41421356237309515f;
constexpr int C_Q = 0, C_K = 512, C_V = 640, C_QI = 768, C_KI = 1024, C_WI = 1056;
constexpr int C_R = UA, C_RK = UA + 512, C_RV = UA + 1024, C_XW = UA + 1536, C_XA = UA + 1600, C_XG = UA + 1664;

constexpr size_t MiB = 1u << 20;
constexpr size_t WS_CTL = 0;
constexpr size_t WS_HM = 1 * MiB;
constexpr size_t WS_WSMALL = 2 * MiB;
constexpr size_t WSMALL_LAYER = 14 * MiB;
constexpr size_t WS_HB = 30 * MiB;
constexpr size_t WS_UAR = 63 * MiB;
constexpr size_t WS_GATES = 161 * MiB;
constexpr size_t WS_OAB = 226 * MiB;
constexpr size_t WS_LIST = WS_GATES + 48 * MiB;
constexpr size_t WS_END = 308 * MiB;
constexpr size_t WS_MERGED = WS_UAR;
constexpr size_t WS_ACT = WS_UAR + 33 * MiB;
constexpr size_t WS_WEXP = WS_GATES;
constexpr int ACT_ROWS_MAX = 16448 + 24 * 256;
static_assert(WS_ACT + (size_t)ACT_ROWS_MAX * 2048 <= WS_GATES, "act fits");
constexpr int CW_CLS = 1024;

constexpr int LDS_BYTES = 155648;

struct Params {
    const float* in[29];
    float* out;
    unsigned char* ws;
};
enum { I_X = 0, I_META, I_LNIN_G, I_LNIN_B, I_WIN, I_BGATE, I_MU, I_W0, I_WUP, I_A0, I_AUP, I_GUP, I_KK, I_KA, I_RK, I_GNG, I_GNB,
       I_WBA, I_WBB, I_WOUT, I_LN1G, I_LN1B, I_LN2G, I_LN2B, I_WROUTER, I_BROUTER, I_WEXP1, I_WEXP3, I_WEXP2 };

__device__ __forceinline__ int otid() { int t = threadIdx.x; asm volatile("" : "+v"(t)); return t; }
__device__ __forceinline__ const char* uptr(const char* p) { const unsigned long long v = (unsigned long long)p; const unsigned lo = __builtin_amdgcn_readfirstlane((unsigned)v), hi = __builtin_amdgcn_readfirstlane((unsigned)(v >> 32)); return (const char*)(((unsigned long long)hi << 32) | lo); }
__device__ __forceinline__ int ozero() { int z = 0; asm volatile("" : "+s"(z)); return z; }
__device__ __forceinline__ int obid() { int b = blockIdx.x; asm volatile("" : "+s"(b)); return b; }
typedef __bf16 bf16x2_t __attribute__((ext_vector_type(2)));
__device__ __forceinline__ unsigned f2bf(float f) { return (unsigned)__builtin_bit_cast(unsigned short, (__bf16)f); }
__device__ __forceinline__ unsigned pk2(float lo, float hi) { const f32x2 v = {lo, hi}; return __builtin_bit_cast(unsigned, __builtin_convertvector(v, bf16x2_t)); }
template <int CTRL> __device__ __forceinline__ float dpp_f(float v) { return __builtin_bit_cast(float, __builtin_amdgcn_update_dpp(0, __builtin_bit_cast(int, v), CTRL, 0xF, 0xF, true)); }
__device__ __forceinline__ float sum8(float v) { v += dpp_f<0xB1>(v); v += dpp_f<0x4E>(v); v += dpp_f<0x141>(v); return v; }
__device__ __forceinline__ float sum16(float v) { v = sum8(v); v += dpp_f<0x140>(v); return v; }
__device__ __forceinline__ float bf2f(unsigned short b) { return __builtin_bit_cast(float, (unsigned)b << 16); }
__device__ __forceinline__ float bflo(unsigned w) { return __builtin_bit_cast(float, w << 16); }
__device__ __forceinline__ float bfhi(unsigned w) { return __builtin_bit_cast(float, w & 0xffff0000u); }
__device__ __forceinline__ float wave_sum(float v) { v = sum16(v); v += __shfl_xor(v, 16); v += __shfl_xor(v, 32); return v; }
__device__ __forceinline__ float wave_max(float v) {
#pragma unroll
    for (int o = 1; o < 64; o <<= 1) v = fmaxf(v, __shfl_xor(v, o));
    return v;
}
__device__ __forceinline__ float sigmoidf_(float x) { return 1.0f / (1.0f + __expf(-x)); }
__device__ __forceinline__ float* hrow(const Params& p, int r) {
    const int b = r / LP, pos = r - b * LP;
    return pos >= 64 ? p.out + ((size_t)(b * SEQ + (pos - 64)) << 10) : (float*)(p.ws + WS_HM) + ((size_t)(b * 64 + pos) << 10);
}
__device__ __forceinline__ bool is_dummy(int r) { return (r % LP) < PADM; }

__device__ __forceinline__ void transpose_item(const float* src, int ld_src, int col0, int nvalid, bf16_t* dst  , int ld_dst, LAS float* scr, int lane) {
    const int kr = lane >> 3, c4 = (lane & 7) * 4;
    f32x4 v[8];
#pragma unroll
    for (int i = 0; i < 8; ++i) v[i] = *(const f32x4*)(src + (size_t)(8 * i + kr) * ld_src + col0 + c4);
#pragma unroll
    for (int i = 0; i < 8; ++i) { LAS float* w = scr + (8 * i + kr) * 33 + c4;
        w[0] = c4 + 0 < nvalid ? v[i][0] : 0.f; w[1] = c4 + 1 < nvalid ? v[i][1] : 0.f; w[2] = c4 + 2 < nvalid ? v[i][2] : 0.f; w[3] = c4 + 3 < nvalid ? v[i][3] : 0.f; }
    asm volatile("s_waitcnt lgkmcnt(0)" ::: "memory");
    const int ch = lane & 7;
#pragma unroll
    for (int j = 0; j < 4; ++j) { const int n = (lane >> 3) + 8 * j; const LAS float* s = scr + (8 * ch) * 33 + n;
        u32x4 o; o.x = pk2(s[0 * 33], s[1 * 33]); o.y = pk2(s[2 * 33], s[3 * 33]); o.z = pk2(s[4 * 33], s[5 * 33]); o.w = pk2(s[6 * 33], s[7 * 33]);
        *(u32x4*)(dst + (size_t)n * ld_dst + 8 * ch) = o; }
    asm volatile("s_waitcnt lgkmcnt(0)" ::: "memory");
}

namespace g8 {
constexpr int BM = 256, BK = 64, HALF = 128, HTB = HALF * BK * 2, STAGE_BYTES = 8 * HTB;
__host__ __device__ __forceinline__ int lds_byte(int r, int c) { const int st = (r >> 4) * 2 + (c >> 5), rr = r & 15, cc = c & 31, ob = rr * 64 + cc * 2; return st * 1024 + (ob ^ (((ob >> 9) & 1) << 5)); }
__host__ __device__ __forceinline__ void stage_rc(int b, int& R, int& C) { const int st = b / 1024, sb = b % 1024, swz = sb ^ (((sb >> 9) & 1) << 5); R = (st >> 1) * 16 + swz / 64; C = (st & 1) * 32 + (swz % 64) / 2; }
__host__ __device__ __forceinline__ int perm32(int rho) { const int n = rho >> 4, i = rho & 15; return 8 * (i >> 2) + 4 * n + (i & 3); }

struct KSeg {
    const char* A;
    const char* B0;
    const char* B1;
    int nt;
    int nt0;
    const char* A2;
    const char* B02;
    const char* B12;
};
__device__ __forceinline__ KSeg seg1(const char* A, const char* B0, const char* B1, int nt) { KSeg s; s.A = A; s.B0 = B0; s.B1 = B1; s.nt = nt; s.nt0 = nt; s.A2 = A; s.B02 = B0; s.B12 = B1; return s; }
typedef f32x4 Acc[2][2][4][2];

template <bool GATHER, bool TWOSEG>
__device__ __forceinline__ void kloop(LAS unsigned char* lds, Acc& acc, const KSeg s, const unsigned (&voffA)[2][2], const unsigned (&voffB)[2], const unsigned hstepA) {
    int tid = threadIdx.x; asm volatile("" : "+v"(tid));
    const int wid = __builtin_amdgcn_readfirstlane(tid >> 6), lane = tid & 63, wr = wid >> 2, wc = wid & 3, fr = lane & 15, fq = lane >> 4;
    const unsigned ldsw = (unsigned)wid * 1024u;
    const int aoff = lds_byte(wr * 64 + fr, fq * 8), boff = lds_byte(wc * 32 + fr, fq * 8);
    const int nt = __builtin_amdgcn_readfirstlane(s.nt);
#define G8_SA(b, h) (((b) * 2 + (h)) * HTB)
#define G8_SB(b, h) ((4 + (b) * 2 + (h)) * HTB)
#define G8_STAGE(bufoff, gbase, voff) do { _Pragma("unroll") for (int _i = 0; _i < 2; ++_i) \
        __builtin_amdgcn_global_load_lds((const unsigned*)((const char*)(gbase) + (voff)[_i]), (LAS unsigned*)(lds + (bufoff) + ldsw + _i * 8192), 16, 0, 0); } while (0)
#define G8_LDA(dst, b, h) do { _Pragma("unroll") for (int m = 0; m < 4; ++m) _Pragma("unroll") for (int k = 0; k < 2; ++k) dst[m][k] = *(const LAS bf16x8*)(lds + G8_SA(b, h) + aoff + m * 2048 + k * 1024); } while (0)
#define G8_LDB(dst, b, h) do { _Pragma("unroll") for (int n = 0; n < 2; ++n) _Pragma("unroll") for (int k = 0; k < 2; ++k) dst[n][k] = *(const LAS bf16x8*)(lds + G8_SB(b, h) + boff + n * 2048 + k * 1024); } while (0)
#define G8_MMA(ai, bj, At, Bt) do { __builtin_amdgcn_s_setprio(1); _Pragma("unroll") for (int m = 0; m < 4; ++m) _Pragma("unroll") for (int n = 0; n < 2; ++n) _Pragma("unroll") for (int k = 0; k < 2; ++k) \
        acc[ai][bj][m][n] = __builtin_amdgcn_mfma_f32_16x16x32_bf16(Bt[n][k], At[m][k], acc[ai][bj][m][n], 0, 0, 0); __builtin_amdgcn_s_setprio(0); } while (0)
#define G8_WAIT_V(n) asm volatile("s_waitcnt vmcnt(" #n ")" ::: "memory")
#define G8_WAIT_L(n) asm volatile("s_waitcnt lgkmcnt(" #n ")" ::: "memory")
#define G8_BAR __builtin_amdgcn_s_barrier()
#define G8_SCHED __builtin_amdgcn_sched_barrier(0)
    bf16x8 At[4][2], B0[2][2], B1[2][2];
    const char* pA = uptr(s.A); const char* pB0 = uptr(s.B0); const char* pB1 = uptr(s.B1);
    constexpr int KS = BK * 2;
    const int nt0 = TWOSEG ? s.nt0 : 0; const char* qA = TWOSEG ? uptr(s.A2 - (size_t)nt0 * KS) : pA; const char* qB0 = TWOSEG ? uptr(s.B02 - (size_t)nt0 * KS) : pB0; const char* qB1 = TWOSEG ? uptr(s.B12 - (size_t)nt0 * KS) : pB1;
#define G8_TA(t) ((TWOSEG ? ((t) < nt0 ? pA : qA) : pA) + (size_t)(t) * KS)
#define G8_TB0(t) ((TWOSEG ? ((t) < nt0 ? pB0 : qB0) : pB0) + (size_t)(t) * KS)
#define G8_TB1(t) ((TWOSEG ? ((t) < nt0 ? pB1 : qB1) : pB1) + (size_t)(t) * KS)
#define G8_VA1 voffA[GATHER ? 1 : 0]
#define G8_H1(ptr) ((ptr) + (GATHER ? 0u : hstepA))
    G8_STAGE(G8_SB(0, 0), pB0, voffB); G8_STAGE(G8_SA(0, 0), pA, voffA[0]); G8_STAGE(G8_SB(0, 1), pB1, voffB); G8_STAGE(G8_SA(0, 1), G8_H1(pA), G8_VA1);
    if (wr == 1) G8_BAR;
    G8_WAIT_V(4); G8_BAR;
    G8_STAGE(G8_SB(1, 0), pB0 + KS, voffB); G8_STAGE(G8_SA(1, 0), pA + KS, voffA[0]); G8_STAGE(G8_SB(1, 1), pB1 + KS, voffB);
    G8_WAIT_V(6); G8_BAR;
    for (int t = 0; t < nt - 2; t += 2) {
        const char* a1 = G8_TA(t + 1);
        const char* a2 = G8_TA(t + 2); const char* b02 = G8_TB0(t + 2); const char* b12 = G8_TB1(t + 2);
        const char* a3 = G8_TA(t + 3); const char* b03 = G8_TB0(t + 3); const char* b13 = G8_TB1(t + 3);
        G8_LDB(B0, 0, 0); G8_SCHED; G8_LDA(At, 0, 0); G8_STAGE(G8_SA(1, 1), G8_H1(a1), G8_VA1);
        G8_WAIT_L(8); G8_BAR; G8_WAIT_L(0); G8_MMA(0, 0, At, B0); G8_BAR; G8_SCHED;
        G8_LDB(B1, 0, 1); G8_STAGE(G8_SB(0, 0), b02, voffB);
        G8_BAR; G8_WAIT_L(0); G8_MMA(0, 1, At, B1); G8_BAR;
        G8_LDA(At, 0, 1); G8_STAGE(G8_SA(0, 0), a2, voffA[0]);
        G8_BAR; G8_WAIT_L(0); G8_MMA(1, 0, At, B0); G8_BAR; G8_SCHED;
        G8_STAGE(G8_SB(0, 1), b12, voffB);
        G8_WAIT_V(6); G8_BAR; G8_MMA(1, 1, At, B1); G8_BAR;
        G8_LDB(B0, 1, 0); G8_SCHED; G8_LDA(At, 1, 0); G8_STAGE(G8_SA(0, 1), G8_H1(a2), G8_VA1);
        G8_WAIT_L(8); G8_BAR; G8_WAIT_L(0); G8_MMA(0, 0, At, B0); G8_BAR; G8_SCHED;
        G8_LDB(B1, 1, 1); G8_STAGE(G8_SB(1, 0), b03, voffB);
        G8_BAR; G8_WAIT_L(0); G8_MMA(0, 1, At, B1); G8_BAR;
        G8_LDA(At, 1, 1); G8_STAGE(G8_SA(1, 0), a3, voffA[0]);
        G8_BAR; G8_WAIT_L(0); G8_MMA(1, 0, At, B0); G8_BAR; G8_SCHED;
        G8_STAGE(G8_SB(1, 1), b13, voffB);
        G8_WAIT_V(6); G8_BAR; G8_MMA(1, 1, At, B1); G8_BAR;
    }
    { const char* a1 = G8_TA(nt - 1);
      G8_LDB(B0, 0, 0); G8_LDA(At, 0, 0); G8_STAGE(G8_SA(1, 1), G8_H1(a1), G8_VA1);
      G8_BAR; G8_WAIT_L(0); G8_MMA(0, 0, At, B0); G8_BAR;
      G8_LDB(B1, 0, 1); G8_BAR; G8_WAIT_L(0); G8_MMA(0, 1, At, B1); G8_BAR;
      G8_LDA(At, 0, 1); G8_WAIT_V(4); G8_BAR; G8_WAIT_L(0); G8_MMA(1, 0, At, B0); G8_MMA(1, 1, At, B1); G8_BAR; }
    { G8_LDB(B0, 1, 0); G8_LDA(At, 1, 0); G8_WAIT_V(2); G8_BAR; G8_WAIT_L(0); G8_MMA(0, 0, At, B0); G8_BAR;
      G8_LDB(B1, 1, 1); G8_WAIT_V(0); G8_BAR; G8_WAIT_L(0); G8_MMA(0, 1, At, B1); G8_BAR;
      G8_LDA(At, 1, 1); G8_BAR; G8_WAIT_L(0); G8_MMA(1, 0, At, B0); G8_MMA(1, 1, At, B1); G8_BAR; }
    if (wr == 0) G8_BAR;
#undef G8_TA
#undef G8_VA1
#undef G8_H1
#undef G8_TB0
#undef G8_TB1
#undef G8_SA
#undef G8_SB
#undef G8_STAGE
#undef G8_LDA
#undef G8_LDB
#undef G8_MMA
#undef G8_WAIT_V
#undef G8_WAIT_L
#undef G8_BAR
#undef G8_SCHED
}
template <bool GATHER, bool TWOSEG>
__device__ __forceinline__ void kstream(LAS unsigned char* lds, Acc& acc, const KSeg s, const KSeg nx, const bool first, const unsigned (&voffA)[2][2], const unsigned (&voffB)[2], const unsigned hstepA) {
    int tid = threadIdx.x; asm volatile("" : "+v"(tid));
    const int wid = __builtin_amdgcn_readfirstlane(tid >> 6), lane = tid & 63, wr = wid >> 2, wc = wid & 3, fr = lane & 15, fq = lane >> 4;
    const unsigned ldsw = (unsigned)wid * 1024u;
    const int aoff = lds_byte(wr * 64 + fr, fq * 8), boff = lds_byte(wc * 32 + fr, fq * 8);
    const int nt = __builtin_amdgcn_readfirstlane(s.nt);
#define G8_SA(b, h) (((b) * 2 + (h)) * HTB)
#define G8_SB(b, h) ((4 + (b) * 2 + (h)) * HTB)
#define G8_STAGE(bufoff, gbase, voff) do { _Pragma("unroll") for (int _i = 0; _i < 2; ++_i) \
        __builtin_amdgcn_global_load_lds((const unsigned*)((const char*)(gbase) + (voff)[_i]), (LAS unsigned*)(lds + (bufoff) + ldsw + _i * 8192), 16, 0, 0); } while (0)
#define G8_LDA(dst, b, h) do { _Pragma("unroll") for (int m = 0; m < 4; ++m) _Pragma("unroll") for (int k = 0; k < 2; ++k) dst[m][k] = *(const LAS bf16x8*)(lds + G8_SA(b, h) + aoff + m * 2048 + k * 1024); } while (0)
#define G8_LDB(dst, b, h) do { _Pragma("unroll") for (int n = 0; n < 2; ++n) _Pragma("unroll") for (int k = 0; k < 2; ++k) dst[n][k] = *(const LAS bf16x8*)(lds + G8_SB(b, h) + boff + n * 2048 + k * 1024); } while (0)
#define G8_MMA(ai, bj, At, Bt) do { __builtin_amdgcn_s_setprio(1); _Pragma("unroll") for (int m = 0; m < 4; ++m) _Pragma("unroll") for (int n = 0; n < 2; ++n) _Pragma("unroll") for (int k = 0; k < 2; ++k) \
        acc[ai][bj][m][n] = __builtin_amdgcn_mfma_f32_16x16x32_bf16(Bt[n][k], At[m][k], acc[ai][bj][m][n], 0, 0, 0); __builtin_amdgcn_s_setprio(0); } while (0)
#define G8_WAIT_V(n) asm volatile("s_waitcnt vmcnt(" #n ")" ::: "memory")
#define G8_WAIT_L(n) asm volatile("s_waitcnt lgkmcnt(" #n ")" ::: "memory")
#define G8_BAR __builtin_amdgcn_s_barrier()
#define G8_SCHED __builtin_amdgcn_sched_barrier(0)
    bf16x8 At[4][2], B0[2][2], B1[2][2];
    const char* pA = uptr(s.A); const char* pB0 = uptr(s.B0); const char* pB1 = uptr(s.B1);
    constexpr int KS = BK * 2;
    const int nt0 = TWOSEG ? s.nt0 : 0; const char* qA = TWOSEG ? uptr(s.A2 - (size_t)nt0 * KS) : pA; const char* qB0 = TWOSEG ? uptr(s.B02 - (size_t)nt0 * KS) : pB0; const char* qB1 = TWOSEG ? uptr(s.B12 - (size_t)nt0 * KS) : pB1;
    const char* nA = uptr(nx.A) - (size_t)nt * KS; const char* nB0 = uptr(nx.B0) - (size_t)nt * KS; const char* nB1 = uptr(nx.B1) - (size_t)nt * KS;
#define G8_TA(t) (((t) >= nt ? nA : (TWOSEG ? ((t) < nt0 ? pA : qA) : pA)) + (size_t)(t) * KS)
#define G8_TB0(t) (((t) >= nt ? nB0 : (TWOSEG ? ((t) < nt0 ? pB0 : qB0) : pB0)) + (size_t)(t) * KS)
#define G8_TB1(t) (((t) >= nt ? nB1 : (TWOSEG ? ((t) < nt0 ? pB1 : qB1) : pB1)) + (size_t)(t) * KS)
#define G8_VA1 voffA[GATHER ? 1 : 0]
#define G8_H1(ptr) ((ptr) + (GATHER ? 0u : hstepA))
    if (first) {
    G8_STAGE(G8_SB(0, 0), pB0, voffB); G8_STAGE(G8_SA(0, 0), pA, voffA[0]); G8_STAGE(G8_SB(0, 1), pB1, voffB); G8_STAGE(G8_SA(0, 1), G8_H1(pA), G8_VA1);
    if (wr == 1) G8_BAR;
    G8_WAIT_V(4); G8_BAR;
    G8_STAGE(G8_SB(1, 0), pB0 + KS, voffB); G8_STAGE(G8_SA(1, 0), pA + KS, voffA[0]); G8_STAGE(G8_SB(1, 1), pB1 + KS, voffB);
    G8_WAIT_V(6); G8_BAR;
    }
    for (int t = 0; t < nt; t += 2) {
        const char* a1 = G8_TA(t + 1);
        const char* a2 = G8_TA(t + 2); const char* b02 = G8_TB0(t + 2); const char* b12 = G8_TB1(t + 2);
        const char* a3 = G8_TA(t + 3); const char* b03 = G8_TB0(t + 3); const char* b13 = G8_TB1(t + 3);
        G8_LDB(B0, 0, 0); G8_SCHED; G8_LDA(At, 0, 0); G8_STAGE(G8_SA(1, 1), G8_H1(a1), G8_VA1);
        G8_WAIT_L(8); G8_BAR; G8_WAIT_L(0); G8_MMA(0, 0, At, B0); G8_BAR; G8_SCHED;
        G8_LDB(B1, 0, 1); G8_STAGE(G8_SB(0, 0), b02, voffB);
        G8_BAR; G8_WAIT_L(0); G8_MMA(0, 1, At, B1); G8_BAR;
        G8_LDA(At, 0, 1); G8_STAGE(G8_SA(0, 0), a2, voffA[0]);
        G8_BAR; G8_WAIT_L(0); G8_MMA(1, 0, At, B0); G8_BAR; G8_SCHED;
        G8_STAGE(G8_SB(0, 1), b12, voffB);
        G8_WAIT_V(6); G8_BAR; G8_MMA(1, 1, At, B1); G8_BAR;
        G8_LDB(B0, 1, 0); G8_SCHED; G8_LDA(At, 1, 0); G8_STAGE(G8_SA(0, 1), G8_H1(a2), G8_VA1);
        G8_WAIT_L(8); G8_BAR; G8_WAIT_L(0); G8_MMA(0, 0, At, B0); G8_BAR; G8_SCHED;
        G8_LDB(B1, 1, 1); G8_STAGE(G8_SB(1, 0), b03, voffB);
        G8_BAR; G8_WAIT_L(0); G8_MMA(0, 1, At, B1); G8_BAR;
        G8_LDA(At, 1, 1); G8_STAGE(G8_SA(1, 0), a3, voffA[0]);
        G8_BAR; G8_WAIT_L(0); G8_MMA(1, 0, At, B0); G8_BAR; G8_SCHED;
        G8_STAGE(G8_SB(1, 1), b13, voffB);
        G8_WAIT_V(6); G8_BAR; G8_MMA(1, 1, At, B1); G8_BAR;
    }
#undef G8_TA
#undef G8_VA1
#undef G8_H1
#undef G8_TB0
#undef G8_TB1
#undef G8_SA
#undef G8_SB
#undef G8_STAGE
#undef G8_LDA
#undef G8_LDB
#undef G8_MMA
#undef G8_WAIT_V
#undef G8_WAIT_L
#undef G8_BAR
#undef G8_SCHED
}
__device__ __forceinline__ void kstream_end() { asm volatile("s_waitcnt vmcnt(0)" ::: "memory"); __builtin_amdgcn_s_barrier(); }
__device__ __forceinline__ void zero_acc(Acc& acc) {
#pragma unroll
    for (int a = 0; a < 2; ++a)
#pragma unroll
        for (int b = 0; b < 2; ++b)
#pragma unroll
            for (int m = 0; m < 4; ++m)
#pragma unroll
                for (int n = 0; n < 2; ++n) acc[a][b][m][n] = (f32x4){0.f, 0.f, 0.f, 0.f};
}
__device__ __forceinline__ void make_voff_contig(unsigned (&voffA)[2][2], unsigned pitchA) {
    int tid = threadIdx.x; asm volatile("" : "+v"(tid));
#pragma unroll
    for (int i = 0; i < 2; ++i) { int R, C; stage_rc(tid * 16 + i * 8192, R, C);
        voffA[0][i] = (unsigned)R * pitchA + (unsigned)C * 2u; voffA[1][i] = 0u; }
}
__device__ __forceinline__ void make_voffB(unsigned (&voffB)[2], unsigned pitchB, bool perm) {
    int tid = threadIdx.x; asm volatile("" : "+v"(tid));
#pragma unroll
    for (int i = 0; i < 2; ++i) { int R, C; stage_rc(tid * 16 + i * 8192, R, C); const int Rb = perm ? ((R & ~31) + perm32(R & 31)) : R;
        voffB[i] = (unsigned)Rb * pitchB + (unsigned)C * 2u; }
}
}

__device__ __forceinline__ bool unit_order(int i, int G, int c, int nM, int nN, int& pm, int& pn) {
    const int nwg = nM * nN; const long L = (long)i * G + c; if (L >= nwg) return false;
    int wgid = (int)L; { const int q = nwg / 8, r = nwg % 8, xcd = wgid % 8, off = wgid / 8; wgid = (xcd < r ? xcd * (q + 1) : r * (q + 1) + (xcd - r) * q) + off; }
    const int WGM = 8, nig = WGM * nN, gid = wgid / nig, fm = gid * WGM, gsz = (nM - fm) < WGM ? (nM - fm) : WGM;
    pm = fm + ((wgid % nig) % gsz); pn = (wgid % nig) / gsz; return true;
}

__device__ __forceinline__ void conv_small_weights(const Params& p, LAS unsigned char* lds) {
    const int tid = otid(), lane = tid & 63, wave = tid >> 6, gw = obid() * NWAVES + wave, NGW = gridDim.x * NWAVES;
    LAS float* scr = (LAS float*)(lds + wave * 16384);
    constexpr int I_IN = 16 * (NIN / 32), I_A = 8 * 32, I_O = 16 * 32, I_L = 64, PER = I_IN + 2 * I_A + I_O + I_L;
    for (int it = gw; it < DEPTH * PER; it += NGW) {
        const int l = it / PER; int r = it % PER;
        unsigned char* wl = p.ws + WS_WSMALL + (size_t)l * WSMALL_LAYER;
        if (r < I_IN) { const int kb = r / (NIN / 32), nb = r % (NIN / 32), n0 = nb * 32, k0 = kb * 64;
            int col0, nvalid; if (n0 < UA) { col0 = n0; nvalid = A_COLS - n0; nvalid = nvalid < 0 ? 0 : (nvalid > 32 ? 32 : nvalid); } else { col0 = n0 - (UA - A_COLS); nvalid = 32; }
            transpose_item(p.in[I_WIN] + (size_t)l * D * IN_COLS + (size_t)k0 * IN_COLS, IN_COLS, col0, nvalid, (bf16_t*)wl + (size_t)n0 * D + k0, D, scr, lane); continue; }
        r -= I_IN;
        if (r < 2 * I_A) { const int which = r / I_A; r %= I_A; const int kb = r / 32, nb = r % 32;
            const float* src = p.in[which ? I_WBB : I_WBA] + (size_t)l * 512 * D + (size_t)(kb * 64) * D;
            transpose_item(src, D, nb * 32, 32, (bf16_t*)(wl + (10 + which) * MiB) + (size_t)(nb * 32) * 512 + kb * 64, 512, scr, lane); continue; }
        r -= 2 * I_A;
        if (r < I_O) { const int kb = r / 32, nb = r % 32;
          transpose_item(p.in[I_WOUT] + (size_t)l * D * D + (size_t)(kb * 64) * D, D, nb * 32, 32, (bf16_t*)(wl + 12 * MiB) + (size_t)(nb * 32) * D + kb * 64, D, scr, lane); continue; }
        r -= I_O;
        { bf16_t* lo = (bf16_t*)(p.ws + 65536 + (size_t)l * 262144);
          if (r < 16) transpose_item(p.in[I_WUP] + (size_t)l * 64 * 512, 512, r * 32, 32, lo + (size_t)(r * 32) * 64, 64, scr, lane);
          else if (r < 32) transpose_item(p.in[I_AUP] + (size_t)l * 64 * 512, 512, (r - 16) * 32, 32, lo + 32768 + (size_t)((r - 16) * 32) * 64, 64, scr, lane);
          else { const int q = r - 32, kb = q >> 4, nb = q & 15; transpose_item(p.in[I_GUP] + (size_t)l * 128 * 512 + (size_t)(kb * 64) * 512, 512, nb * 32, 32, lo + 65536 + (size_t)(nb * 32) * 128 + kb * 64, 128, scr, lane); } }
    }
}
__device__ __forceinline__ void conv_expert_items(const Params& p, int l, LAS unsigned char* lds, int it0, int it1) {
    const int tid = otid(), lane = tid & 63, wave = tid >> 6, gw = it0 + wave, NGW = NWAVES;
    LAS float* scr = (LAS float*)(lds + wave * 16384);
    constexpr int I_13 = 16 * 32, I_2 = 8 * 32, PER = I_13 + I_2;
    for (int it = gw; it < it1; it += NGW) {
        const int e = it / PER; int r = it % PER;
        if (r < I_13) { const int kb = r / 32, nb = r % 32, n0 = nb * 32, j = n0 >> 8, half = (n0 >> 7) & 1, c = 128 * j + (n0 & 127);
            const float* src = p.in[half ? I_WEXP3 : I_WEXP1] + (size_t)(l * 16 + e) * D * 512 + (size_t)(kb * 64) * 512;
            transpose_item(src, 512, c, 32, (bf16_t*)(p.ws + WS_WEXP) + (size_t)e * 1024 * 1024 + (size_t)n0 * 1024 + kb * 64, 1024, scr, lane); continue; }
        r -= I_13;
        { const int kb = r / 32, nb = r % 32;
          const float* src = p.in[I_WEXP2] + (size_t)(l * 16 + e) * 512 * D + (size_t)(kb * 64) * D;
          transpose_item(src, D, nb * 32, 32, (bf16_t*)(p.ws + WS_WEXP + 32 * MiB) + (size_t)e * 1024 * 512 + (size_t)(nb * 32) * 512 + kb * 64, 512, scr, lane); }
    }
}

__device__ __forceinline__ void ln_wave(f32x4 (&v)[4], const float* g, const float* bta, int lane) {
    float s = 0.f;
#pragma unroll
    for (int j = 0; j < 4; ++j) s += (v[j][0] + v[j][1]) + (v[j][2] + v[j][3]);
    const float mean = wave_sum(s) * (1.f / D); float s2 = 0.f;
#pragma unroll
    for (int j = 0; j < 4; ++j) { v[j] = v[j] - mean; s2 += (v[j][0] * v[j][0] + v[j][1] * v[j][1]) + (v[j][2] * v[j][2] + v[j][3] * v[j][3]); }
    const float rstd = 1.f / sqrtf(wave_sum(s2) * (1.f / D) + LN_EPS);
#pragma unroll
    for (int j = 0; j < 4; ++j) { const f32x4 gg = *(const f32x4*)(g + 4 * lane + 256 * j), bb = *(const f32x4*)(bta + 4 * lane + 256 * j); v[j] = v[j] * rstd * gg + bb; }
}
__device__ __forceinline__ void store_row(const Params& p, int r, const f32x4 (&v)[4], int lane, bool zero) {
    float* hr = hrow(p, r); bf16_t* hb = (bf16_t*)(p.ws + WS_HB) + (size_t)r * D;
#pragma unroll
    for (int j = 0; j < 4; ++j) { const f32x4 o = zero ? (f32x4){0.f, 0.f, 0.f, 0.f} : v[j];
        *(f32x4*)(hr + 4 * lane + 256 * j) = o; u32x2 w; w.x = pk2(o[0], o[1]); w.y = pk2(o[2], o[3]); *(u32x2*)(hb + 4 * lane + 256 * j) = w; }
}
__device__ __forceinline__ void ln_in_phase(const Params& p) {
    const int tid = otid(), lane = tid & 63, gw = obid() * NWAVES + (tid >> 6), NGW = gridDim.x * NWAVES;
    for (int r = gw; r < T; r += NGW) {
        const int b = r / LP, pos = r - b * LP; f32x4 v[4];
        if (pos < PADM) {
#pragma unroll
            for (int j = 0; j < 4; ++j) v[j] = (f32x4){0.f, 0.f, 0.f, 0.f};
            store_row(p, r, v, lane, true); continue; }
        const float* src = pos < 64 ? p.in[I_META] + (size_t)(pos - PADM) * D : p.in[I_X] + ((size_t)(b * SEQ + pos - 64) << 10);
#pragma unroll
        for (int j = 0; j < 4; ++j) v[j] = *(const f32x4*)(src + 4 * lane + 256 * j);
        ln_wave(v, p.in[I_LNIN_G], p.in[I_LNIN_B], lane);
        store_row(p, r, v, lane, false);
    }
}

__device__ __forceinline__ const Params& PP() { const Params* q = (const Params*)__builtin_amdgcn_kernarg_segment_ptr(); asm volatile("" : "+s"(q)); return *q; }

#define EPI_COORDS() int tid_ = threadIdx.x; asm volatile("" : "+v"(tid_)); const int wid = tid_ >> 6, lane = tid_ & 63, wr = wid >> 2, wc = wid & 3, fr = lane & 15, fq = lane >> 4; (void)wr; (void)wc; (void)fr; (void)fq
__device__ __forceinline__ void inproj_phase(const Params& p, int l, LAS unsigned char* lds) {
    unsigned voffA[2][2], voffB[2]; g8::make_voff_contig(voffA, D * 2); g8::make_voffB(voffB, D * 2, true);
    int pm, pn, pm2 = 0, pn2 = 0; const int bid = obid(); const int wr_ = __builtin_amdgcn_readfirstlane(otid() >> 6) >> 2;
    bool has = unit_order(0, gridDim.x, bid, T / 256, NIN / 256, pm, pn), first = true;
    g8::Acc acc; g8::zero_acc(acc);
    for (int i = 0; has; ++i) {
        const bool hasn = unit_order(i + 1, gridDim.x, bid, T / 256, NIN / 256, pm2, pn2);
        const char* Ab = (const char*)(PP().ws + WS_HB); const char* Bb = (const char*)(PP().ws + WS_WSMALL + (size_t)l * WSMALL_LAYER);
        const g8::KSeg s = g8::seg1(Ab + (size_t)pm * 256 * D * 2, Bb + (size_t)pn * 256 * D * 2, Bb + (size_t)(pn * 256 + 128) * D * 2, D / 64);
        const int pmn = hasn ? pm2 : pm, pnn = hasn ? pn2 : pn;
        const g8::KSeg nx = g8::seg1(Ab + (size_t)pmn * 256 * D * 2, Bb + (size_t)pnn * 256 * D * 2, Bb + (size_t)(pnn * 256 + 128) * D * 2, D / 64);
        if (!first && wr_ == 1) __builtin_amdgcn_s_barrier();
        g8::kstream<false, false>(lds, acc, s, nx, first, voffA, voffB, 128 * D * 2); first = false;
        if (wr_ == 0) __builtin_amdgcn_s_barrier();
        EPI_COORDS();
        const int row0 = pm * 256 + wr * 64 + fr;
        if (pn < 12) {
            bf16_t* O = (bf16_t*)(PP().ws + WS_UAR);
#pragma unroll
            for (int ai = 0; ai < 2; ++ai)
#pragma unroll
                for (int m = 0; m < 4; ++m) { asm volatile("" ::: "memory"); bf16_t* rp = O + (size_t)(row0 + ai * 128 + m * 16) * UARW + pn * 256 + wc * 32 + 8 * fq;
#pragma unroll
                    for (int bj = 0; bj < 2; ++bj) { const f32x4 v0 = acc[ai][bj][m][0], v1 = acc[ai][bj][m][1]; u32x4 w; w.x = pk2(v0[0], v0[1]); w.y = pk2(v0[2], v0[3]); w.z = pk2(v1[0], v1[1]); w.w = pk2(v1[2], v1[3]);
                        *(u32x4*)(rp + bj * 128) = w; } }
        } else {
            bf16_t* O = (bf16_t*)(PP().ws + WS_GATES); const int colb = (pn - 12) * 256 + wc * 32 + 8 * fq; const float* bg = PP().in[I_BGATE] + l * 2048;
            f32x4 bv[2][2];
#pragma unroll
            for (int bj = 0; bj < 2; ++bj) { bv[bj][0] = *(const f32x4*)(bg + colb + bj * 128); bv[bj][1] = *(const f32x4*)(bg + colb + bj * 128 + 4); }
#pragma unroll
            for (int ai = 0; ai < 2; ++ai)
#pragma unroll
                for (int m = 0; m < 4; ++m) { asm volatile("" ::: "memory"); bf16_t* rp = O + (size_t)(row0 + ai * 128 + m * 16) * 2048 + colb;
#pragma unroll
                    for (int bj = 0; bj < 2; ++bj) { f32x4 v0 = acc[ai][bj][m][0] + bv[bj][0], v1 = acc[ai][bj][m][1] + bv[bj][1];
#pragma unroll
                        for (int e = 0; e < 4; ++e) { v0[e] = sigmoidf_(v0[e]); v1[e] = sigmoidf_(v1[e]); }
                        u32x4 w; w.x = pk2(v0[0], v0[1]); w.y = pk2(v0[2], v0[3]); w.z = pk2(v1[0], v1[1]); w.w = pk2(v1[2], v1[3]);
                        *(u32x4*)(rp + bj * 128) = w; } }
        }
        g8::zero_acc(acc); has = hasn; pm = pm2; pn = pn2;
    }
    if (!first) g8::kstream_end();
}
__device__ __forceinline__ void merge_unit(int l, LAS unsigned char* lds, int pm, int pn) {
    unsigned voffA[2][2], voffB[2]; g8::make_voff_contig(voffA, D * 2); g8::make_voffB(voffB, 512 * 2, true);
    {
        const int wr_ = __builtin_amdgcn_readfirstlane(otid() >> 6) >> 2;
        g8::Acc acc; g8::zero_acc(acc);
#pragma unroll 1
        for (int br = 0; br < 2; ++br) {
            const char* Bt = (const char*)(PP().ws + WS_WSMALL + (size_t)l * WSMALL_LAYER) + (10 + br) * MiB + (size_t)pn * 256 * 512 * 2;
            const char* Bn = (const char*)(PP().ws + WS_WSMALL + (size_t)l * WSMALL_LAYER) + 11 * MiB + (size_t)pn * 256 * 512 * 2;
            const g8::KSeg s = g8::seg1((const char*)(PP().ws + WS_OAB) + (size_t)pm * 256 * D * 2 + br * 1024, Bt, Bt + (size_t)128 * 512 * 2, 8);
            const g8::KSeg nx = g8::seg1((const char*)(PP().ws + WS_OAB) + (size_t)pm * 256 * D * 2 + 1024, Bn, Bn + (size_t)128 * 512 * 2, 8);
            if (br && wr_ == 1) __builtin_amdgcn_s_barrier();
            g8::kstream<false, false>(lds, acc, s, nx, br == 0, voffA, voffB, 128 * D * 2);
            if (wr_ == 0) __builtin_amdgcn_s_barrier();
            EPI_COORDS();
            const bf16_t* GT = (const bf16_t*)(PP().ws + WS_GATES); bf16_t* O = (bf16_t*)(PP().ws + WS_MERGED);
            const int row0 = pm * 256 + wr * 64 + fr, colb = pn * 256 + wc * 32 + 8 * fq;
#pragma unroll
            for (int ai = 0; ai < 2; ++ai) { asm volatile("" ::: "memory");
                u32x4 gq[4][2], pq[4][2];
#pragma unroll
                for (int m = 0; m < 4; ++m) { const size_t ro = (size_t)(row0 + ai * 128 + m * 16); const bf16_t* gp = GT + ro * 2048 + br * 1024 + colb; const bf16_t* op = O + ro * D + colb;
#pragma unroll
                    for (int bj = 0; bj < 2; ++bj) { gq[m][bj] = *(const u32x4*)(gp + bj * 128); pq[m][bj] = br ? *(const u32x4*)(op + bj * 128) : (u32x4){0u, 0u, 0u, 0u}; } }
#pragma unroll
                for (int m = 0; m < 4; ++m) { const size_t ro = (size_t)(row0 + ai * 128 + m * 16); bf16_t* op = O + ro * D + colb;
#pragma unroll
                    for (int bj = 0; bj < 2; ++bj) { const u32x4 g = gq[m][bj], pr = pq[m][bj]; const f32x4 v0 = acc[ai][bj][m][0], v1 = acc[ai][bj][m][1];
                        u32x4 w; w.x = pk2(v0[0] * bflo(g.x) + bflo(pr.x), v0[1] * bfhi(g.x) + bfhi(pr.x)); w.y = pk2(v0[2] * bflo(g.y) + bflo(pr.y), v0[3] * bfhi(g.y) + bfhi(pr.y));
                        w.z = pk2(v1[0] * bflo(g.z) + bflo(pr.z), v1[1] * bfhi(g.z) + bfhi(pr.z)); w.w = pk2(v1[2] * bflo(g.w) + bflo(pr.w), v1[3] * bfhi(g.w) + bfhi(pr.w));
                        *(u32x4*)(op + bj * 128) = w; } } }
            g8::zero_acc(acc);
        }
        g8::kstream_end();
    }
}
__device__ __forceinline__ void wout_unit(int l, LAS unsigned char* lds, int pm, int pn) {
    unsigned voffA[2][2], voffB[2]; g8::make_voff_contig(voffA, D * 2); g8::make_voffB(voffB, D * 2, false);
    g8::Acc acc; g8::zero_acc(acc);
    const char* Ab = (const char*)(PP().ws + WS_MERGED); const char* Bb = (const char*)(PP().ws + WS_WSMALL + (size_t)l * WSMALL_LAYER + 12 * MiB);
    const g8::KSeg s = g8::seg1(Ab + (size_t)pm * 256 * D * 2, Bb + (size_t)pn * 256 * D * 2, Bb + (size_t)(pn * 256 + 128) * D * 2, D / 64);
    g8::kloop<false, false>(lds, acc, s, voffA, voffB, 128 * D * 2);
    EPI_COORDS();
    const int row0 = pm * 256 + wr * 64 + fr, col0 = pn * 256 + wc * 32 + 4 * fq;
#pragma unroll
    for (int ai = 0; ai < 2; ++ai) { asm volatile("" ::: "memory");
        f32x4 pre[4][2][2]; float* hr[4];
#pragma unroll
        for (int m = 0; m < 4; ++m) { hr[m] = hrow(PP(), row0 + ai * 128 + m * 16) + col0;
#pragma unroll
            for (int bj = 0; bj < 2; ++bj)
#pragma unroll
                for (int n = 0; n < 2; ++n) pre[m][bj][n] = *(const f32x4*)(hr[m] + bj * 128 + n * 16); }
#pragma unroll
        for (int m = 0; m < 4; ++m)
#pragma unroll
            for (int bj = 0; bj < 2; ++bj)
#pragma unroll
                for (int n = 0; n < 2; ++n) *(f32x4*)(hr[m] + bj * 128 + n * 16) = pre[m][bj][n] * ALPHA + acc[ai][bj][m][n]; }
}
__device__ __forceinline__ unsigned score_key(float s) { s += 0.0f; const unsigned u = __builtin_bit_cast(unsigned, s); return (u & 0x80000000u) ? ~u : (u | 0x80000000u); }
__device__ void attn_naive_query(const Params& p, int row, unsigned char* wl, int lane) {
    const bf16_t* U = (const bf16_t*)(p.ws + WS_UAR);
    bf16_t* OA = (bf16_t*)(p.ws + WS_OAB) + (size_t)row * D;
    const int b = row / LP, pos = row - b * LP;
    if (pos < PADM) {
#pragma unroll
        for (int j = 0; j < 8; ++j) OA[j * 64 + lane] = 0;
        return;
    }
    const int nadm = 64 * ((pos >> 6) + 1) - PADM;
    unsigned* keys = (unsigned*)wl; float* p_s = (float*)wl;
    float* qi_s = (float*)(wl + 16640); float* q_s = qi_s + 256; float* w_s = q_s + 512; unsigned short* sel_s = (unsigned short*)(w_s + 16);
    const bf16_t* urow = U + (size_t)row * UARW;
    for (int i = lane; i < 256; i += 64) qi_s[i] = bf2f(urow[C_QI + i]);
    for (int i = lane; i < 512; i += 64) q_s[i] = bf2f(urow[C_Q + i]);
    if (lane < 8) w_s[lane] = bf2f(urow[C_WI + lane]);
    __builtin_amdgcn_fence(__ATOMIC_RELEASE, "wavefront"); __builtin_amdgcn_wave_barrier(); __builtin_amdgcn_fence(__ATOMIC_ACQUIRE, "wavefront");
    const int nj = (nadm + 63) >> 6;
    for (int j = 0; j < nj; ++j) {
        const int ki_idx = lane + 64 * j; unsigned key = 0u;
        if (ki_idx < nadm) {
            const u32x4* kp = (const u32x4*)(U + (size_t)(b * LP + PADM + ki_idx) * UARW + C_KI);
            float kf[32];
#pragma unroll
            for (int c4 = 0; c4 < 4; ++c4) { const u32x4 w = kp[c4];
                kf[c4 * 8 + 0] = bflo(w.x); kf[c4 * 8 + 1] = bfhi(w.x); kf[c4 * 8 + 2] = bflo(w.y); kf[c4 * 8 + 3] = bfhi(w.y);
                kf[c4 * 8 + 4] = bflo(w.z); kf[c4 * 8 + 5] = bfhi(w.z); kf[c4 * 8 + 6] = bflo(w.w); kf[c4 * 8 + 7] = bfhi(w.w); }
            float sc = 0.f;
#pragma unroll 1
            for (int h = 0; h < 8; ++h) { float d = 0.f; asm volatile("" ::: "memory");
#pragma unroll
                for (int e = 0; e < 32; ++e) d = fmaf(qi_s[h * 32 + e], kf[e], d);
                sc = fmaf(w_s[h], fmaxf(d, 0.f), sc); }
            key = score_key(sc); if (key == 0u) key = 1u;
        }
        keys[ki_idx] = key;
    }
    __builtin_amdgcn_fence(__ATOMIC_RELEASE, "wavefront"); __builtin_amdgcn_wave_barrier(); __builtin_amdgcn_fence(__ATOMIC_ACQUIRE, "wavefront");
    unsigned thr = 0u; int need_ties = 0x7fffffff;
    if (nadm > 256) {
        unsigned prefix = 0u; int remaining = 256;
        for (int bit = 31; bit >= 0; --bit) {
            const unsigned cand = prefix | (1u << bit); int cnt = 0;
            for (int j = 0; j < nj; ++j) { const unsigned k = keys[lane + 64 * j]; cnt += __builtin_popcountll(__ballot((k >> bit) == (cand >> bit))); }
            if (cnt >= remaining) prefix = cand; else remaining -= cnt;
        }
        thr = prefix; need_ties = remaining;
    } else thr = 1u;
    int nsel = 0, ties_seen = 0;
    for (int j = 0; j < nj; ++j) {
        const unsigned k = keys[lane + 64 * j];
        const unsigned long long tm = __ballot(k == thr && k != 0u);
        const unsigned long long lt = (1ull << lane) - 1ull;
        const int myrank = ties_seen + __builtin_popcountll(tm & lt);
        const bool selme = (k > thr) || (k == thr && k != 0u && myrank < need_ties);
        const unsigned long long sm = __ballot(selme);
        if (selme) sel_s[nsel + __builtin_popcountll(sm & lt)] = (unsigned short)(PADM + lane + 64 * j);
        nsel += __builtin_popcountll(sm); ties_seen += __builtin_popcountll(tm);
    }
    __builtin_amdgcn_fence(__ATOMIC_RELEASE, "wavefront"); __builtin_amdgcn_wave_barrier(); __builtin_amdgcn_fence(__ATOMIC_ACQUIRE, "wavefront");
    float sc[4][8];
#pragma unroll
    for (int m = 0; m < 4; ++m) {
        asm volatile("" ::: "memory");
        const int i = lane + 64 * m; const bool valid = i < nsel; const int ps = valid ? sel_s[i] : PADM;
        const bf16_t* krow = U + (size_t)(b * LP + ps) * UARW + C_K;
#pragma unroll
        for (int n = 0; n < 2; ++n) {
            float a0 = 0.f, a1 = 0.f, a2 = 0.f, a3 = 0.f;
#pragma unroll 1
            for (int c8 = 0; c8 < 8; ++c8) { asm volatile("" ::: "memory"); const u32x4 w = *(const u32x4*)(krow + n * 64 + c8 * 8);
                float kf[8] = {bflo(w.x), bfhi(w.x), bflo(w.y), bfhi(w.y), bflo(w.z), bfhi(w.z), bflo(w.w), bfhi(w.w)};
#pragma unroll
                for (int e = 0; e < 8; ++e) { const int dd = c8 * 8 + e;
                    a0 = fmaf(q_s[(n * 4 + 0) * 64 + dd], kf[e], a0); a1 = fmaf(q_s[(n * 4 + 1) * 64 + dd], kf[e], a1);
                    a2 = fmaf(q_s[(n * 4 + 2) * 64 + dd], kf[e], a2); a3 = fmaf(q_s[(n * 4 + 3) * 64 + dd], kf[e], a3); } }
            sc[m][n * 4 + 0] = valid ? a0 * 0.125f : -INFINITY; sc[m][n * 4 + 1] = valid ? a1 * 0.125f : -INFINITY;
            sc[m][n * 4 + 2] = valid ? a2 * 0.125f : -INFINITY; sc[m][n * 4 + 3] = valid ? a3 * 0.125f : -INFINITY;
        }
    }
    __builtin_amdgcn_wave_barrier();
    float linv[8];
#pragma unroll
    for (int h = 0; h < 8; ++h) {
        const float mx = wave_max(fmaxf(fmaxf(sc[0][h], sc[1][h]), fmaxf(sc[2][h], sc[3][h]))); float s = 0.f;
#pragma unroll
        for (int m = 0; m < 4; ++m) { const float e = __expf(sc[m][h] - mx); sc[m][h] = e; s += e; }
        linv[h] = 1.0f / wave_sum(s);
    }
#pragma unroll
    for (int m = 0; m < 4; ++m) { const int i = lane + 64 * m;
#pragma unroll
        for (int h = 0; h < 8; ++h) p_s[i * 8 + h] = sc[m][h]; }
    __builtin_amdgcn_fence(__ATOMIC_RELEASE, "wavefront"); __builtin_amdgcn_wave_barrier(); __builtin_amdgcn_fence(__ATOMIC_ACQUIRE, "wavefront");
    float o[8] = {0.f, 0.f, 0.f, 0.f, 0.f, 0.f, 0.f, 0.f};
    for (int i = 0; i < nsel; ++i) {
        const int ps = sel_s[i]; const bf16_t* vrow = U + (size_t)(b * LP + ps) * UARW + C_V;
        const float v0 = bf2f(vrow[lane]), v1 = bf2f(vrow[64 + lane]);
        const f32x4 pa = *(const f32x4*)(p_s + i * 8), pb = *(const f32x4*)(p_s + i * 8 + 4);
        o[0] = fmaf(pa[0], v0, o[0]); o[1] = fmaf(pa[1], v0, o[1]); o[2] = fmaf(pa[2], v0, o[2]); o[3] = fmaf(pa[3], v0, o[3]);
        o[4] = fmaf(pb[0], v1, o[4]); o[5] = fmaf(pb[1], v1, o[5]); o[6] = fmaf(pb[2], v1, o[6]); o[7] = fmaf(pb[3], v1, o[7]);
    }
#pragma unroll
    for (int h = 0; h < 8; ++h) OA[h * 64 + lane] = (bf16_t)f2bf(o[h] * linv[h]);
    __builtin_amdgcn_wave_barrier();
}


__device__ __forceinline__ f32x4 mfma16(bf16x8 a, bf16x8 b, f32x4 c) { return __builtin_amdgcn_mfma_f32_16x16x32_bf16(a, b, c, 0, 0, 0); }
#ifndef PROBE_PHASE
#define PROBE_PHASE -1
#endif
#define PROBE_BLOCK 0
#define LDS_BARRIER() do { asm volatile("s_waitcnt lgkmcnt(0)" ::: "memory"); __builtin_amdgcn_s_barrier(); asm volatile("" ::: "memory"); } while (0)

typedef float f32x16 __attribute__((ext_vector_type(16)));
typedef short s16x4 __attribute__((ext_vector_type(4)));
constexpr int AT_HIST = 0;
constexpr int AT_MASK = 20480;
constexpr int AT_QST = AT_MASK + 16640;
constexpr int AT_KV = 37120;
constexpr int AT_UNIT = AT_KV + 32768;
constexpr int AT_KL = AT_KV;
constexpr int AT_KL_BYTES = LDS_BYTES - 16 - AT_KL;
static_assert(4128 * 12 * 2 <= AT_KL_BYTES, "selection keys fit with 12 queries per sub-pass");
constexpr int CW_R1Q = 48;
constexpr int CW_ATT = 32;
__device__ __forceinline__ int img_off(int row, int ch) { return 2048 * (row >> 3) + 512 * (ch >> 2) + 64 * (row & 7) + 16 * ((ch & 3) ^ ((row >> 2) & 3)); }
__device__ __forceinline__ unsigned comp_key(float sc, int pos) { return (score_key(sc) & 0xFFFFE000u) | (unsigned)(0x1FFF - pos); }

__device__ __forceinline__ void attn_unit(const Params& p, unsigned char* lds, int b, int qt, unsigned long long& pacc) {
    unsigned long long pt0 = 0; if (PROBE_PHASE == 40 || PROBE_PHASE == 42) pt0 = __builtin_amdgcn_s_memrealtime();
    const int tid = otid(), wave = tid >> 6, lane = tid & 63, r = lane & 31, hh = lane >> 5;
    const bf16_t* U = (const bf16_t*)(p.ws + WS_UAR);
    LAS unsigned char* L = (LAS unsigned char*)lds;
    LAS unsigned* hist = (LAS unsigned*)(L + AT_HIST); LAS unsigned* maskw = (LAS unsigned*)(L + AT_MASK);
    const int c = qt >> 1, nkt = 2 * c + 1, nadm = 64 * (c + 1) - PADM;
    const size_t qrow = (size_t)(b * LP + 32 * qt + r);
    if (nadm > 256) {
        LAS unsigned short* KL = (LAS unsigned short*)(L + AT_KL);
        LAS unsigned* h8 = (LAS unsigned*)(L + AT_HIST);
        LAS unsigned* segc = h8 + 4096;
        LAS unsigned* st = segc + 512;
        const int NK = 32 * nkt, c15 = lane & 15, g4 = lane >> 4;
        const int qs = NK * 32 <= AT_KL_BYTES ? 16 : 12;
        for (int i = tid; i < (nkt + 1) * 32; i += NTHREADS) maskw[i] = 0u;
#pragma unroll 1
        for (int qbase = 0; qbase < 32; qbase += qs) {
            const int qn = 32 - qbase < qs ? 32 - qbase : qs; const bool qact = c15 < qn;
            bf16x8 qf[8]; float wq[8];
            { const bf16_t* qp = U + (size_t)(b * LP + 32 * qt + qbase + (qact ? c15 : 0)) * UARW;
#pragma unroll
              for (int h = 0; h < 8; ++h) qf[h] = *(const bf16x8*)(qp + C_QI + h * 32 + 8 * g4);
              const u32x4 w = *(const u32x4*)(qp + C_WI);
              wq[0] = bflo(w.x); wq[1] = bfhi(w.x); wq[2] = bflo(w.y); wq[3] = bfhi(w.y); wq[4] = bflo(w.z); wq[5] = bfhi(w.z); wq[6] = bflo(w.w); wq[7] = bfhi(w.w); }
#pragma unroll
            for (int h = 0; h < 8; ++h) asm volatile("" : "+v"(qf[h]), "+v"(wq[h]));
            for (int i = tid; i < 4096 + 512; i += NTHREADS) h8[i] = 0u;
            LDS_BARRIER();
            {
                const int ng = 2 * nkt; int j = wave;
                const bf16_t* kb = U + (size_t)(b * LP + 32 + c15) * UARW + C_KI + 8 * g4;
                bf16x8 a = *(const bf16x8*)(kb + (size_t)(16 * (j < ng ? j : 0)) * UARW), an = *(const bf16x8*)(kb + (size_t)(16 * (j + NWAVES < ng ? j + NWAVES : 0)) * UARW);
#pragma unroll 1
                for (; j < ng; j += NWAVES) {
                    const bf16x8 a2 = *(const bf16x8*)(kb + (size_t)(16 * (j + 2 * NWAVES < ng ? j + 2 * NWAVES : j)) * UARW);
                    f32x4 sc = {0.f, 0.f, 0.f, 0.f};
#pragma unroll
                    for (int h = 0; h < 8; ++h) { const f32x4 d = mfma16(a, qf[h], (f32x4){0.f, 0.f, 0.f, 0.f});
#pragma unroll
                        for (int e = 0; e < 4; ++e) sc[e] = fmaf(wq[h], fmaxf(d[e], 0.f), sc[e]); }
                    if (qact) {
#pragma unroll
                        for (int e = 0; e < 4; ++e) { const int ki = 16 * j + 4 * g4 + e;
                            const unsigned k16 = ki >= 16 ? (score_key(sc[e]) >> 16) : 0u;
                            KL[ki * qs + c15] = (unsigned short)k16;
                            __hip_atomic_fetch_add(h8 + (k16 >> 8) * 16 + c15, ki >= 16 ? 1u : 0u, __ATOMIC_RELAXED, __HIP_MEMORY_SCOPE_WORKGROUP); } }
                    a = an; an = a2;
                }
            }
            LDS_BARRIER();
            { const int q_ = tid & 15, s8 = tid >> 4; unsigned ss = 0u;
#pragma unroll
              for (int i = 0; i < 8; ++i) ss += h8[(s8 * 8 + i) * 16 + q_];
              segc[s8 * 16 + q_] = ss; }
            LDS_BARRIER();
            if (tid < qn) { unsigned sv[32];
#pragma unroll
                for (int i = 0; i < 32; ++i) sv[i] = segc[i * 16 + tid];
                unsigned cum = 0u; int sgi = 31;
#pragma unroll
                for (int i = 31; i > 0; --i) { const bool go = sgi == i && cum + sv[i] < 256u; cum += go ? sv[i] : 0u; sgi -= go ? 1 : 0; }
                int bin = sgi * 8 + 7; while (bin > sgi * 8 && cum + h8[bin * 16 + tid] < 256u) { cum += h8[bin * 16 + tid]; --bin; }
                st[tid * 4] = (unsigned)bin; st[tid * 4 + 1] = 256u - cum; }
            LDS_BARRIER();
            for (int i = tid; i < 4096; i += NTHREADS) h8[i] = 0u;
            LDS_BARRIER();
            const int q = tid & 15, sg = tid >> 4, SEG = (NK + 31) >> 5, k0 = sg * SEG, k1 = q < qn ? (k0 + SEG < NK ? k0 + SEG : NK) : k0;
            { const unsigned hb = st[q * 4];
#pragma unroll 8
              for (int k = k0; k < k1; ++k) { const unsigned kv = KL[k * qs + q]; __hip_atomic_fetch_add(h8 + (kv & 255u) * 16 + q, (kv >> 8) == hb && kv != 0u ? 1u : 0u, __ATOMIC_RELAXED, __HIP_MEMORY_SCOPE_WORKGROUP); } }
            LDS_BARRIER();
            { const int q_ = tid & 15, s8 = tid >> 4; unsigned ss = 0u;
#pragma unroll
              for (int i = 0; i < 8; ++i) ss += h8[(s8 * 8 + i) * 16 + q_];
              segc[s8 * 16 + q_] = ss; }
            LDS_BARRIER();
            if (tid < qn) { const unsigned rem = st[tid * 4 + 1]; unsigned sv[32];
#pragma unroll
                for (int i = 0; i < 32; ++i) sv[i] = segc[i * 16 + tid];
                unsigned cum = 0u; int sgi = 31;
#pragma unroll
                for (int i = 31; i > 0; --i) { const bool go = sgi == i && cum + sv[i] < rem; cum += go ? sv[i] : 0u; sgi -= go ? 1 : 0; }
                int bin = sgi * 8 + 7; while (bin > sgi * 8 && cum + h8[bin * 16 + tid] < rem) { cum += h8[bin * 16 + tid]; --bin; }
                st[tid * 4 + 2] = (st[tid * 4] << 8) | (unsigned)bin; st[tid * 4 + 3] = rem - cum; }
            LDS_BARRIER();
            const unsigned thr = st[q * 4 + 2], need = st[q * 4 + 3];
            { unsigned cnt = 0u;
#pragma unroll 8
              for (int k = k0; k < k1; ++k) cnt += KL[k * qs + q] == thr ? 1u : 0u;
              segc[sg * 16 + q] = cnt; }
            LDS_BARRIER();
            if (tid < qn) { unsigned cv[32];
#pragma unroll
                for (int s2 = 0; s2 < 32; ++s2) cv[s2] = segc[s2 * 16 + tid];
                unsigned run = 0u;
#pragma unroll
                for (int s2 = 0; s2 < 32; ++s2) { segc[s2 * 16 + tid] = run; run += cv[s2]; } }
            LDS_BARRIER();
            { unsigned rank = segc[sg * 16 + q], word = 0u; int wi = k0 >> 5;
#pragma unroll 4
              for (int k = k0; k < k1; ++k) { if ((k >> 5) != wi) { if (word) __hip_atomic_fetch_or(maskw + (wi + 1) * 32 + qbase + q, word, __ATOMIC_RELAXED, __HIP_MEMORY_SCOPE_WORKGROUP); word = 0u; wi = k >> 5; }
                  const unsigned kv = KL[k * qs + q]; const bool tie = kv == thr; const bool sel = kv > thr || (tie && rank < need); rank += tie ? 1u : 0u;
                  word |= (sel ? 1u : 0u) << (k & 31); }
              if (word) __hip_atomic_fetch_or(maskw + (wi + 1) * 32 + qbase + q, word, __ATOMIC_RELAXED, __HIP_MEMORY_SCOPE_WORKGROUP); }
            LDS_BARRIER();
        }
    } else {
        for (int kt = 1 + wave; kt <= nkt; kt += NWAVES) if (hh == 0) maskw[kt * 32 + r] = kt == 1 ? 0xFFFF0000u : 0xFFFFFFFFu;
        LDS_BARRIER();
    }
    if (PROBE_PHASE == 40) pacc += __builtin_amdgcn_s_memrealtime() - pt0;
    if (PROBE_PHASE == 41) pt0 = __builtin_amdgcn_s_memrealtime();
    {
        const int h = wave, n = h >> 2;
        bf16x8 qf4[4];
#pragma unroll
        for (int kk = 0; kk < 4; ++kk) qf4[kk] = *(const bf16x8*)(U + qrow * UARW + C_Q + h * 64 + 16 * kk + 8 * hh);
        asm volatile("" : "+v"(qf4[0]), "+v"(qf4[1]), "+v"(qf4[2]), "+v"(qf4[3]));
        f32x16 o0, o1;
#pragma unroll
        for (int e = 0; e < 16; ++e) { o0[e] = 0.f; o1[e] = 0.f; }
        float m = -1e30f, lsum = 0.f;
        const int srow = tid >> 4, sch = tid & 15; const int soff = img_off(srow, sch);
        const bf16_t* sbase = U + (size_t)(b * LP + srow) * UARW + sch * 8;
        u32x4 kreg = *(const u32x4*)(sbase + (size_t)32 * UARW + C_K), vreg = *(const u32x4*)(sbase + (size_t)32 * UARW + C_V);
        *(LAS u32x4*)(L + AT_KV + soff) = kreg; *(LAS u32x4*)(L + AT_KV + 8192 + soff) = vreg;
        { const int k2 = nkt >= 2 ? 2 : 1; kreg = *(const u32x4*)(sbase + (size_t)(32 * k2) * UARW + C_K); vreg = *(const u32x4*)(sbase + (size_t)(32 * k2) * UARW + C_V); }
        LDS_BARRIER();
        const int g = (lane >> 4) & 1, q_ = (lane & 15) >> 2, p_ = lane & 3;
        constexpr float SCL = 0.125f * 1.44269504088896f;
#pragma unroll 1
        for (int i = 0; i < nkt; ++i) {
            const int kt = 1 + i; LAS unsigned char* Kimg = L + AT_KV + (i & 1) * 16384; LAS unsigned char* Vimg = Kimg + 8192;
            u32x4 kreg2, vreg2;
            { const int k3 = kt + 2 <= nkt ? kt + 2 : kt; kreg2 = *(const u32x4*)(sbase + (size_t)(32 * k3) * UARW + C_K); vreg2 = *(const u32x4*)(sbase + (size_t)(32 * k3) * UARW + C_V); }
            f32x16 s;
#pragma unroll
            for (int e = 0; e < 16; ++e) s[e] = 0.f;
#pragma unroll
            for (int kk = 0; kk < 4; ++kk) { const bf16x8 a = *(const LAS bf16x8*)(Kimg + img_off(r, 8 * n + 2 * kk + hh)); s = __builtin_amdgcn_mfma_f32_32x32x16_bf16(a, qf4[kk], s, 0, 0, 0); }
            const unsigned mw = maskw[kt * 32 + r] >> (4 * hh);
            float tmax = -INFINITY;
#pragma unroll
            for (int e = 0; e < 16; ++e) { const bool sel = (mw >> ((e & 3) + 8 * (e >> 2))) & 1u; s[e] = sel ? s[e] : -INFINITY; tmax = fmaxf(tmax, s[e]); }
            tmax = fmaxf(tmax, __shfl_xor(tmax, 32));
            const float mnew = fmaxf(m, tmax * SCL);
            if (__any(mnew > m)) { const float alpha = __builtin_amdgcn_exp2f(m - mnew); lsum *= alpha;
#pragma unroll
                for (int e = 0; e < 16; ++e) { o0[e] *= alpha; o1[e] *= alpha; } }
            m = mnew;
            float ps = 0.f;
#pragma unroll
            for (int e = 0; e < 16; ++e) { const float pe = __builtin_amdgcn_exp2f(fmaf(s[e], SCL, -mnew)); s[e] = pe; ps += pe; }
            lsum += ps;
            bf16x8 pf[2];
#pragma unroll
            for (int ks = 0; ks < 2; ++ks) { u32x4 w; w.x = pk2(s[8 * ks + 0], s[8 * ks + 1]); w.y = pk2(s[8 * ks + 2], s[8 * ks + 3]); w.z = pk2(s[8 * ks + 4], s[8 * ks + 5]); w.w = pk2(s[8 * ks + 6], s[8 * ks + 7]); pf[ks] = __builtin_bit_cast(bf16x8, w); }
#pragma unroll
            for (int ks = 0; ks < 2; ++ks)
#pragma unroll
                for (int dt = 0; dt < 2; ++dt) { const int c0 = 8 * n + 4 * dt + 2 * g + (p_ >> 1);
                    const s16x4 lo = __builtin_amdgcn_ds_read_tr16_b64_v4i16((LAS s16x4*)(Vimg + img_off(16 * ks + 4 * hh + q_, c0) + 8 * (p_ & 1)));
                    const s16x4 hi = __builtin_amdgcn_ds_read_tr16_b64_v4i16((LAS s16x4*)(Vimg + img_off(16 * ks + 8 + 4 * hh + q_, c0) + 8 * (p_ & 1)));
                    const bf16x8 a = __builtin_shufflevector(lo, hi, 0, 1, 2, 3, 4, 5, 6, 7);
                    if (dt == 0) o0 = __builtin_amdgcn_mfma_f32_32x32x16_bf16(a, pf[ks], o0, 0, 0, 0); else o1 = __builtin_amdgcn_mfma_f32_32x32x16_bf16(a, pf[ks], o1, 0, 0, 0); }
            if (i + 1 < nkt) { LAS unsigned char* Kn = L + AT_KV + ((i + 1) & 1) * 16384; *(LAS u32x4*)(Kn + soff) = kreg; *(LAS u32x4*)(Kn + 8192 + soff) = vreg; }
            kreg = kreg2; vreg = vreg2;
            LDS_BARRIER();
        }
        lsum += __shfl_xor(lsum, 32);
        const float inv = lsum > 0.f ? 1.0f / lsum : 0.f;
        bf16_t* orow = (bf16_t*)(p.ws + WS_OAB) + qrow * D + h * 64 + 4 * hh;
#pragma unroll
        for (int g4 = 0; g4 < 4; ++g4) { u32x2 w0, w1;
            w0.x = pk2(o0[4 * g4] * inv, o0[4 * g4 + 1] * inv); w0.y = pk2(o0[4 * g4 + 2] * inv, o0[4 * g4 + 3] * inv);
            w1.x = pk2(o1[4 * g4] * inv, o1[4 * g4 + 1] * inv); w1.y = pk2(o1[4 * g4 + 2] * inv, o1[4 * g4 + 3] * inv);
            *(u32x2*)(orow + 8 * g4) = w0; *(u32x2*)(orow + 32 + 8 * g4) = w1; }
        if (qt == 1) {
            bf16_t* z = (bf16_t*)(p.ws + WS_OAB) + (size_t)(b * LP + r) * D + h * 64 + 32 * hh;
#pragma unroll
            for (int j = 0; j < 4; ++j) *(u32x4*)(z + 8 * j) = (u32x4){0u, 0u, 0u, 0u};
        }
    }
    if (PROBE_PHASE == 41 || PROBE_PHASE == 42) pacc += __builtin_amdgcn_s_memrealtime() - pt0;
}
__device__ __forceinline__ void attn_phase(const Params& p, int l, unsigned char* lds, unsigned long long& pacc) {
    unsigned* ctr = (unsigned*)(p.ws + WS_CTL) + CW_ATT + 4 * l;
    volatile int* uw = (volatile int*)(lds + AT_UNIT);
    const int b0 = (obid() & 7) >> 1;
    for (int k = 0; k < 4; ++k) { const int b = (b0 + k) & 3;
        for (;;) {
            __syncthreads();
            if (otid() == 0) *uw = (int)atomicAdd(ctr + b, 1u);
            __syncthreads();
            const int u = *uw;
            if (u >= 129) break;
            attn_unit(p, lds, b, 129 - u, pacc);
        }
    }
}

constexpr size_t WS_RW1 = WS_HB;
constexpr size_t WS_RW2 = 259 * MiB;
constexpr size_t RW2_ARR = (size_t)2080 * 8192;
constexpr size_t WS_LORA = 65536;
constexpr int PS = 72;
constexpr int R1_XW = 0, R1_XA = 9216, R1_XG = 18432;
constexpr int R1_RHS = 0;
constexpr int R1_E = 35840, R1_AA = R1_E + 16640, R1_GS = R1_AA + 9216;
constexpr int R1_LABT = R1_E, R1_LAK = R1_E + 16384;
constexpr int R1_AT = R1_GS + 9216, R1_RT = R1_AT + 9216, R1_BT = R1_RT + 9216, R1_KT = R1_BT + 9216;
constexpr int R1_WT = R1_AT, R1_ZT = R1_BT;
constexpr int R1_BTT = R1_KT + 9216, R1_KTT = R1_BTT + 9216, R1_VT = R1_KTT + 9216;
constexpr int R1_MRB = R1_VT + 9216, R1_MRK = R1_MRB + 9216;
constexpr int R1_BS = R1_MRK + 9216, R1_GC = R1_BS + 256, R1_END = R1_GC + 256;
static_assert(R1_END <= LDS_BYTES && R1_LAK + 9216 <= R1_AT && R1_RHS + 33280 <= R1_E, "R1 LDS map");
__device__ __forceinline__ u32x2 pk4(f32x4 v) { u32x2 w; w.x = pk2(v[0], v[1]); w.y = pk2(v[2], v[3]); return w; }

#ifndef PROBE_PHASE
#define PROBE_PHASE -1
#endif
#define R1P(k) do { if (PROBE_PHASE == 20 + (k)) { const unsigned long long t_ = __builtin_amdgcn_s_memrealtime(); pacc += t_ - pt0; } if (PROBE_PHASE == 21 + (k)) pt0 = __builtin_amdgcn_s_memrealtime(); } while (0)
__device__ __forceinline__ void rwkv_prep_unit(const Params& p, int l, int unit, unsigned char* lds, unsigned long long& pacc) {
    unsigned long long pt0 = 0; if (PROBE_PHASE == 20) pt0 = __builtin_amdgcn_s_memrealtime();
    const int tid = otid(), wave = tid >> 6, lane = tid & 63, c15 = lane & 15, g = lane >> 4;
    const int h = unit & 7, bc = unit >> 3, b = bc / NCH, c = bc - b * NCH;
    LAS unsigned char* L = (LAS unsigned char*)lds;
    const bf16_t* U = (const bf16_t*)(p.ws + WS_UAR);
    const int t = tid >> 3, dq = tid & 7, d0 = dq * 8;
    const int row = b * LP + 64 * c + t; const bool hasprev = (64 * c + t) > 0;
    bf16x8 lw[2][2], la[2][2], lg_[2][4];
    { const bf16_t* lora = (const bf16_t*)(p.ws + WS_LORA + (size_t)l * 262144);
#pragma unroll
      for (int nn = 0; nn < 2; ++nn) { const int hd = h * 64 + 16 * (2 * (wave & 1) + nn) + c15;
#pragma unroll
          for (int s2 = 0; s2 < 2; ++s2) { lw[nn][s2] = *(const bf16x8*)(lora + (size_t)hd * 64 + 32 * s2 + 8 * g); la[nn][s2] = *(const bf16x8*)(lora + 32768 + (size_t)hd * 64 + 32 * s2 + 8 * g); }
#pragma unroll
          for (int s4 = 0; s4 < 4; ++s4) lg_[nn][s4] = *(const bf16x8*)(lora + 65536 + (size_t)hd * 128 + 32 * s4 + 8 * g); } }
    float rr[8], kx[8], vx[8], kk[8];
    {
        const bf16_t* uc = U + (size_t)row * UARW; const bf16_t* up = hasprev ? uc - UARW : uc;
        const float* mu = p.in[I_MU] + l * R_COLS;
        auto shift8 = [&](int col, int mucol, float (&out)[8]) {
            const u32x4 a = *(const u32x4*)(uc + col), q = *(const u32x4*)(up + col);
            const f32x4 m0 = *(const f32x4*)(mu + mucol), m1 = *(const f32x4*)(mu + mucol + 4);
            const float x[8] = {bflo(a.x), bfhi(a.x), bflo(a.y), bfhi(a.y), bflo(a.z), bfhi(a.z), bflo(a.w), bfhi(a.w)};
            const float y[8] = {bflo(q.x), bfhi(q.x), bflo(q.y), bfhi(q.y), bflo(q.z), bfhi(q.z), bflo(q.w), bfhi(q.w)};
#pragma unroll
            for (int i = 0; i < 8; ++i) { const float xp = hasprev ? y[i] : 0.f; out[i] = x[i] + (xp - x[i]) * (i < 4 ? m0[i] : m1[i - 4]); } };
        shift8(C_R + h * 64 + d0, h * 64 + d0, rr); shift8(C_RK + h * 64 + d0, 512 + h * 64 + d0, kx); shift8(C_RV + h * 64 + d0, 1024 + h * 64 + d0, vx);
        float xw[8], xa[8], xg0[8], xg1[8];
        shift8(C_XW + d0, 1536 + d0, xw); shift8(C_XA + d0, 1600 + d0, xa); shift8(C_XG + d0, 1664 + d0, xg0); shift8(C_XG + 64 + d0, 1728 + d0, xg1);
        float n2 = 0.f;
        { const f32x4 k0 = *(const f32x4*)(p.in[I_KK] + l * 512 + h * 64 + d0), k1 = *(const f32x4*)(p.in[I_KK] + l * 512 + h * 64 + d0 + 4);
#pragma unroll
          for (int i = 0; i < 8; ++i) { kk[i] = kx[i] * (i < 4 ? k0[i] : k1[i - 4]); n2 = fmaf(kk[i], kk[i], n2); } }
        n2 += __shfl_xor(n2, 1); n2 += __shfl_xor(n2, 2); n2 += __shfl_xor(n2, 4);
        const float rn = rsqrtf(fmaxf(n2, 1e-24f));
#pragma unroll
        for (int i = 0; i < 8; ++i) { kk[i] *= rn; xw[i] = tanhf(xw[i]); xg0[i] = sigmoidf_(xg0[i]); xg1[i] = sigmoidf_(xg1[i]); }
        u32x4 w;
        w.x = pk2(xw[0], xw[1]); w.y = pk2(xw[2], xw[3]); w.z = pk2(xw[4], xw[5]); w.w = pk2(xw[6], xw[7]); *(LAS u32x4*)(L + R1_XW + (t * PS + d0) * 2) = w;
        w.x = pk2(xa[0], xa[1]); w.y = pk2(xa[2], xa[3]); w.z = pk2(xa[4], xa[5]); w.w = pk2(xa[6], xa[7]); *(LAS u32x4*)(L + R1_XA + (t * PS + d0) * 2) = w;
        w.x = pk2(xg0[0], xg0[1]); w.y = pk2(xg0[2], xg0[3]); w.z = pk2(xg0[4], xg0[5]); w.w = pk2(xg0[6], xg0[7]); *(LAS u32x4*)(L + R1_XG + (t * 136 + d0) * 2) = w;
        w.x = pk2(xg1[0], xg1[1]); w.y = pk2(xg1[2], xg1[3]); w.z = pk2(xg1[4], xg1[5]); w.w = pk2(xg1[6], xg1[7]); *(LAS u32x4*)(L + R1_XG + (t * 136 + 64 + d0) * 2) = w;
    }
    LDS_BARRIER();
    R1P(0);
    const int tm = wave >> 1;
    unsigned char* rw2 = p.ws + WS_RW2 + (size_t)unit * 8192;
    {
#pragma unroll
        for (int nn = 0; nn < 2; ++nn) { const int tn = 2 * (wave & 1) + nn, dcol = 16 * tn + c15, hd = h * 64 + dcol;
            f32x4 aw = {0.f, 0.f, 0.f, 0.f}, aa = aw, ag = aw;
#pragma unroll
            for (int s2 = 0; s2 < 2; ++s2) {
                const bf16x8 xa_ = *(const LAS bf16x8*)(L + R1_XW + ((16 * tm + c15) * PS + 32 * s2 + 8 * g) * 2), xb_ = *(const LAS bf16x8*)(L + R1_XA + ((16 * tm + c15) * PS + 32 * s2 + 8 * g) * 2);
                aw = mfma16(xa_, lw[nn][s2], aw);
                aa = mfma16(xb_, la[nn][s2], aa); }
#pragma unroll
            for (int s4 = 0; s4 < 4; ++s4) ag = mfma16(*(const LAS bf16x8*)(L + R1_XG + ((16 * tm + c15) * 136 + 32 * s4 + 8 * g) * 2), lg_[nn][s4], ag);
            const float w0 = p.in[I_W0][l * 512 + hd], a0 = p.in[I_A0][l * 512 + hd];
#pragma unroll
            for (int e = 0; e < 4; ++e) { const int tt = 16 * tm + 4 * g + e;
                const float z = -(w0 + aw[e]); const float sp = fmaxf(z, 0.f) + log1pf(__expf(-fabsf(z)));
                *(LAS float*)(L + R1_E + (tt * 65 + dcol) * 4) = __expf(-sp - 0.5f);
                *(LAS unsigned short*)(L + R1_AA + (tt * PS + dcol) * 2) = (unsigned short)f2bf(sigmoidf_(a0 + aa[e]));
                *(LAS unsigned short*)(L + R1_GS + (tt * PS + dcol) * 2) = (unsigned short)f2bf(ag[e]); }
        }
    }
    LDS_BARRIER();
    R1P(1);
    {
        const int d = tid & 63, sg = tid >> 6; float cum = 0.f, loc[8];
#pragma unroll
        for (int i = 0; i < 8; ++i) { cum += *(const LAS float*)(L + R1_E + ((8 * sg + i) * 65 + d) * 4); loc[i] = cum; }
        *(LAS float*)(L + R1_BS + (sg * 64 + d) * 4 - 2048) = cum;
        LDS_BARRIER();
        float off = 0.f;
#pragma unroll
        for (int q = 0; q < 7; ++q) if (q < sg) off += *(const LAS float*)(L + R1_BS + (q * 64 + d) * 4 - 2048);
#pragma unroll
        for (int i = 0; i < 8; ++i) *(LAS float*)(L + R1_E + ((8 * sg + i) * 65 + d) * 4) = loc[i] + off;
    }
    LDS_BARRIER();
    R1P(2);
    {
        const f32x4 ka0 = *(const f32x4*)(p.in[I_KA] + l * 512 + h * 64 + d0), ka1 = *(const f32x4*)(p.in[I_KA] + l * 512 + h * 64 + d0 + 4);
        const f32x4 rk0 = *(const f32x4*)(p.in[I_RK] + l * 512 + h * 64 + d0), rk1 = *(const f32x4*)(p.in[I_RK] + l * 512 + h * 64 + d0 + 4);
        const u32x4 aw_ = *(const LAS u32x4*)(L + R1_AA + (t * PS + d0) * 2);
        const float av[8] = {bflo(aw_.x), bfhi(aw_.x), bflo(aw_.y), bfhi(aw_.y), bflo(aw_.z), bfhi(aw_.z), bflo(aw_.w), bfhi(aw_.w)};
        float At[8], Bt[8], Kt[8], Rt[8]; float bpart = 0.f;
#pragma unroll
        for (int i = 0; i < 8; ++i) {
            const float cumt = *(const LAS float*)(L + R1_E + (t * 65 + d0 + i) * 4), cump = t > 0 ? *(const LAS float*)(L + R1_E + ((t - 1) * 65 + d0 + i) * 4) : 0.f;
            const float gam = __expf(-cumt), gprev = __expf(-cump), ginv = __expf(cumt);
            const float kmod = kx[i] * (1.0f + (av[i] - 1.0f) * (i < 4 ? ka0[i] : ka1[i - 4]));
            At[i] = -gprev * kk[i]; Bt[i] = kk[i] * av[i] * ginv; Kt[i] = kmod * ginv; Rt[i] = rr[i] * gam;
            bpart = fmaf(rr[i] * kmod, (i < 4 ? rk0[i] : rk1[i - 4]), bpart);
            if (t == 63) *(LAS float*)(L + R1_GC + (d0 + i) * 4) = gam;
            *(LAS float*)(L + R1_RHS + ((d0 + i) * 65 + t) * 4) = At[i];
            *(LAS unsigned short*)(L + R1_BTT + ((d0 + i) * PS + t) * 2) = (unsigned short)f2bf(Bt[i]);
            *(LAS unsigned short*)(L + R1_KTT + ((d0 + i) * PS + t) * 2) = (unsigned short)f2bf(Kt[i]);
            *(LAS unsigned short*)(L + R1_VT + ((d0 + i) * PS + t) * 2) = (unsigned short)f2bf(vx[i]);
        }
        u32x4 w;
        w.x = pk2(At[0], At[1]); w.y = pk2(At[2], At[3]); w.z = pk2(At[4], At[5]); w.w = pk2(At[6], At[7]); *(LAS u32x4*)(L + R1_AT + (t * PS + d0) * 2) = w;
        w.x = pk2(Rt[0], Rt[1]); w.y = pk2(Rt[2], Rt[3]); w.z = pk2(Rt[4], Rt[5]); w.w = pk2(Rt[6], Rt[7]); *(LAS u32x4*)(L + R1_RT + (t * PS + d0) * 2) = w;
        w.x = pk2(Bt[0], Bt[1]); w.y = pk2(Bt[2], Bt[3]); w.z = pk2(Bt[4], Bt[5]); w.w = pk2(Bt[6], Bt[7]); *(LAS u32x4*)(L + R1_BT + (t * PS + d0) * 2) = w;
        w.x = pk2(Kt[0], Kt[1]); w.y = pk2(Kt[2], Kt[3]); w.z = pk2(Kt[4], Kt[5]); w.w = pk2(Kt[6], Kt[7]); *(LAS u32x4*)(L + R1_KT + (t * PS + d0) * 2) = w;
        bpart += __shfl_xor(bpart, 1); bpart += __shfl_xor(bpart, 2); bpart += __shfl_xor(bpart, 4);
        const u32x4 gw = *(const LAS u32x4*)(L + R1_GS + (t * PS + d0) * 2);
        const float gv[8] = {bflo(gw.x), bfhi(gw.x), bflo(gw.y), bfhi(gw.y), bflo(gw.z), bfhi(gw.z), bflo(gw.w), bfhi(gw.w)};
        w.x = pk2(bpart * vx[0] * gv[0], bpart * vx[1] * gv[1]); w.y = pk2(bpart * vx[2] * gv[2], bpart * vx[3] * gv[3]);
        w.z = pk2(bpart * vx[4] * gv[4], bpart * vx[5] * gv[5]); w.w = pk2(bpart * vx[6] * gv[6], bpart * vx[7] * gv[7]);
        *(u32x4*)((bf16_t*)(p.ws + WS_OAB) + (size_t)row * D + 512 + h * 64 + d0) = w;
        *(u32x4*)(rw2 + 2 * RW2_ARR + (size_t)(t * 64 + d0) * 2) = gw;
    }
    LDS_BARRIER();
    R1P(3);
    {
        f32x4 gab[2], gak[2], grb[2], grk[2];
#pragma unroll
        for (int nn = 0; nn < 2; ++nn) { const int tn = 2 * (wave & 1) + nn;
            gab[nn] = (f32x4){0.f, 0.f, 0.f, 0.f}; gak[nn] = gab[nn]; grb[nn] = gab[nn]; grk[nn] = gab[nn];
            if (tn <= tm) {
#pragma unroll
                for (int s2 = 0; s2 < 2; ++s2) { const int ao = ((16 * tm + c15) * PS + 32 * s2 + 8 * g) * 2, bo = ((16 * tn + c15) * PS + 32 * s2 + 8 * g) * 2;
                    const bf16x8 fa = *(const LAS bf16x8*)(L + R1_AT + ao), fr_ = *(const LAS bf16x8*)(L + R1_RT + ao), fb = *(const LAS bf16x8*)(L + R1_BT + bo), fk = *(const LAS bf16x8*)(L + R1_KT + bo);
                    gab[nn] = mfma16(fa, fb, gab[nn]); gak[nn] = mfma16(fa, fk, gak[nn]); grb[nn] = mfma16(fr_, fb, grb[nn]); grk[nn] = mfma16(fr_, fk, grk[nn]); } } }
        LDS_BARRIER();
#pragma unroll
        for (int nn = 0; nn < 2; ++nn) { const int tn = 2 * (wave & 1) + nn, icol = 16 * tn + c15;
            f32x4 lab;
#pragma unroll
            for (int e = 0; e < 4; ++e) { const int tt = 16 * tm + 4 * g + e; const bool strict = icol < tt, incl = icol <= tt;
                lab[e] = strict ? gab[nn][e] : 0.f;
                *(LAS unsigned short*)(L + R1_LAK + (tt * PS + icol) * 2) = (unsigned short)f2bf(strict ? gak[nn][e] : 0.f);
                *(LAS unsigned short*)(L + R1_MRB + (tt * PS + icol) * 2) = (unsigned short)f2bf(incl ? grb[nn][e] : 0.f);
                *(LAS unsigned short*)(L + R1_MRK + (tt * PS + icol) * 2) = (unsigned short)f2bf(incl ? grk[nn][e] : 0.f); }
            *(LAS f32x4*)(L + R1_LABT + (icol * 64 + 16 * tm + 4 * g) * 4) = lab; }
    }
    LDS_BARRIER();
    R1P(4);
    {
#pragma unroll
        for (int nn = 0; nn < 2; ++nn) { const int tn = 2 * (wave & 1) + nn; f32x4 acc = {0.f, 0.f, 0.f, 0.f};
#pragma unroll
            for (int s2 = 0; s2 < 2; ++s2) acc = mfma16(*(const LAS bf16x8*)(L + R1_LAK + ((16 * tm + c15) * PS + 32 * s2 + 8 * g) * 2), *(const LAS bf16x8*)(L + R1_VT + ((16 * tn + c15) * PS + 32 * s2 + 8 * g) * 2), acc);
#pragma unroll
            for (int e = 0; e < 4; ++e) *(LAS float*)(L + R1_RHS + ((64 + 16 * tn + c15) * 65 + 16 * tm + 4 * g + e) * 4) = acc[e]; }
    }
    LDS_BARRIER();
    R1P(5);
    if (tid < 128) {
        LAS float* xr = (LAS float*)(L + R1_RHS + tid * 65 * 4);
#pragma unroll 1
        for (int Tb = 0; Tb < 4; ++Tb) {
            float acc[16];
#pragma unroll
            for (int e = 0; e < 16; ++e) acc[e] = xr[16 * Tb + e];
#pragma unroll 4
            for (int i = 0; i < 16 * Tb; ++i) { const float xi = xr[i];
#pragma unroll
                for (int q = 0; q < 4; ++q) { const f32x4 lv = *(const LAS f32x4*)(L + R1_LABT + (i * 64 + 16 * Tb + 4 * q) * 4);
#pragma unroll
                    for (int e = 0; e < 4; ++e) acc[4 * q + e] = fmaf(lv[e], xi, acc[4 * q + e]); } }
#pragma unroll
            for (int ii = 0; ii < 15; ++ii) { const float xi = acc[ii];
#pragma unroll
                for (int q = (ii + 1) / 4; q < 4; ++q) { const f32x4 lv = *(const LAS f32x4*)(L + R1_LABT + ((16 * Tb + ii) * 64 + 16 * Tb + 4 * q) * 4);
#pragma unroll
                    for (int e = 0; e < 4; ++e) if (4 * q + e > ii) acc[4 * q + e] = fmaf(lv[e], xi, acc[4 * q + e]); } }
#pragma unroll
            for (int e = 0; e < 16; ++e) xr[16 * Tb + e] = acc[e];
        }
        LAS unsigned char* dst = L + (tid < 64 ? R1_WT + tid * PS * 2 : R1_ZT + (tid - 64) * PS * 2);
#pragma unroll
        for (int q8 = 0; q8 < 8; ++q8) { u32x4 w; w.x = pk2(xr[8 * q8], xr[8 * q8 + 1]); w.y = pk2(xr[8 * q8 + 2], xr[8 * q8 + 3]); w.z = pk2(xr[8 * q8 + 4], xr[8 * q8 + 5]); w.w = pk2(xr[8 * q8 + 6], xr[8 * q8 + 7]); *(LAS u32x4*)(dst + q8 * 16) = w; }
    }
    LDS_BARRIER();
    R1P(6);
    {
        unsigned char* rw1 = p.ws + WS_RW1 + (size_t)unit * 16384;
#pragma unroll
        for (int nn = 0; nn < 2; ++nn) { const int tn = 2 * (wave & 1) + nn, col = 16 * tn + c15, r0 = 16 * tm + 4 * g;
            f32x4 aP = {0.f, 0.f, 0.f, 0.f}, aQ = aP, aG = aP, aY = aP;
#pragma unroll
            for (int s2 = 0; s2 < 2; ++s2) { const int ro = ((16 * tm + c15) * PS + 32 * s2 + 8 * g) * 2, co = ((16 * tn + c15) * PS + 32 * s2 + 8 * g) * 2;
                const bf16x8 fWT = *(const LAS bf16x8*)(L + R1_WT + ro), fBTT = *(const LAS bf16x8*)(L + R1_BTT + ro), fKTT = *(const LAS bf16x8*)(L + R1_KTT + ro), fMRB = *(const LAS bf16x8*)(L + R1_MRB + ro), fMRK = *(const LAS bf16x8*)(L + R1_MRK + ro);
                const bf16x8 cBTT = *(const LAS bf16x8*)(L + R1_BTT + co), cZT = *(const LAS bf16x8*)(L + R1_ZT + co), cVT = *(const LAS bf16x8*)(L + R1_VT + co), cMRB = *(const LAS bf16x8*)(L + R1_MRB + co);
                aP = mfma16(fWT, cBTT, aP);
                aQ = mfma16(fBTT, cZT, aQ); aQ = mfma16(fKTT, cVT, aQ);
                aG = mfma16(fWT, cMRB, aG);
                aY = mfma16(fMRB, cZT, aY); aY = mfma16(fMRK, cVT, aY); }
            const float gcc = *(const LAS float*)(L + R1_GC + col * 4);
            const f32x4 gcr = *(const LAS f32x4*)(L + R1_GC + r0 * 4);
            const u32x2 rtw = *(const LAS u32x2*)(L + R1_RT + (col * PS + r0) * 2);
#pragma unroll
            for (int e = 0; e < 4; ++e) { aP[e] = (aP[e] + ((r0 + e) == col ? 1.0f : 0.f)) * gcc; aQ[e] *= gcr[e]; }
            aG[0] += bflo(rtw.x); aG[1] += bfhi(rtw.x); aG[2] += bflo(rtw.y); aG[3] += bfhi(rtw.y);
            *(u32x2*)(rw1 + (size_t)(col * 64 + r0) * 2) = pk4(aP);
            *(u32x2*)(rw1 + 8192 + (size_t)(col * 64 + r0) * 2) = pk4(aG);
            *(u32x2*)(rw2 + (size_t)(col * 64 + r0) * 2) = pk4(aQ);
            *(u32x2*)(rw2 + RW2_ARR + (size_t)(col * 64 + r0) * 2) = pk4(aY); }
    }
    LDS_BARRIER();
    R1P(7);
}

constexpr int R2_SV = 0, R2_YS = 2 * 64 * PS * 2, R2_END = R2_YS + 2 * 64 * 68 * 4;
__device__ __forceinline__ void rwkv_scan(const Params& p, int l, int bh, unsigned char* lds) {
    const int tid = otid(), wave = tid >> 6, lane = tid & 63, c15 = lane & 15, g = lane >> 4;
    const int b = bh >> 3, h = bh & 7, role = wave >> 2, j = wave & 3, vcol = 16 * j + c15;
    LAS unsigned char* L = (LAS unsigned char*)lds;
    for (int i = tid; i < 2 * 64 * PS * 2 / 4; i += NTHREADS) ((LAS unsigned*)(L + R2_SV))[i] = 0u;
    LDS_BARRIER();
    const int et = tid >> 3, ev0 = 8 * (tid & 7);
    f32x4 gn0[2], gn1[2];
    { const float* gp = p.in[I_GNG] + l * 512 + h * 64 + ev0; const float* bp = p.in[I_GNB] + l * 512 + h * 64 + ev0;
      gn0[0] = *(const f32x4*)gp; gn0[1] = *(const f32x4*)(gp + 4); gn1[0] = *(const f32x4*)bp; gn1[1] = *(const f32x4*)(bp + 4); }
    bf16_t* OB = (bf16_t*)(p.ws + WS_OAB) + (size_t)(b * LP + et) * D + 512 + h * 64 + ev0;
    const int unit0 = (b * NCH) * 8 + h;
    const unsigned char* rw1b = p.ws + WS_RW1 + (role ? 8192 : 0) + (size_t)(c15 * 64 + 8 * g) * 2;
    const unsigned char* rw2b = p.ws + WS_RW2 + (role ? RW2_ARR : 0) + (size_t)(vcol * 64 + 4 * g) * 2;
    const unsigned char* ggb = p.ws + WS_RW2 + 2 * RW2_ARR + (size_t)(et * 64 + ev0) * 2;
    bf16x8 A0[4][2], A1[4][2]; u32x2 I0[4], I1[4];
    u32x4 G0 = {0u, 0u, 0u, 0u}, O0 = G0, G1, O1;
#define R2_LOAD(AA, II, cc) do { const size_t un_ = (size_t)(unit0 + 8 * ((cc) < NCH ? (cc) : NCH - 1)); \
        _Pragma("unroll") for (int m = 0; m < 4; ++m) { II[m] = *(const u32x2*)(rw2b + un_ * 8192 + 32 * m); \
            _Pragma("unroll") for (int s2 = 0; s2 < 2; ++s2) AA[m][s2] = *(const bf16x8*)(rw1b + un_ * 16384 + (16 * m * 64 + 32 * s2) * 2); } } while (0)
    R2_LOAD(A0, I0, 0); R2_LOAD(A1, I1, 1);
    G1 = *(const u32x4*)(ggb + (size_t)unit0 * 8192); O1 = *(const u32x4*)OB;
#pragma unroll 1
    for (int c = 0; c <= NCH; ++c) {
        const int cur = c & 1;
        bf16x8 A2[4][2]; u32x2 I2[4];
        R2_LOAD(A2, I2, c + 2);
        u32x4 G2, O2; { const int cn = c + 1 < NCH ? c + 1 : NCH - 1; G2 = *(const u32x4*)(ggb + (size_t)(unit0 + 8 * cn) * 8192); O2 = *(const u32x4*)(OB + (size_t)(64 * cn) * D); }
        if (c > 0) {
            const f32x4 y0 = *(const LAS f32x4*)(L + R2_YS + ((cur ^ 1) * 64 * 68 + et * 68 + ev0) * 4), y1 = *(const LAS f32x4*)(L + R2_YS + ((cur ^ 1) * 64 * 68 + et * 68 + ev0 + 4) * 4);
            float s1 = (y0[0] + y0[1]) + (y0[2] + y0[3]) + (y1[0] + y1[1]) + (y1[2] + y1[3]);
            s1 = sum8(s1); const float mean = s1 * (1.f / 64.f);
            const f32x4 d0 = y0 - mean, d1 = y1 - mean;
            float s2_ = (d0[0] * d0[0] + d0[1] * d0[1]) + (d0[2] * d0[2] + d0[3] * d0[3]) + (d1[0] * d1[0] + d1[1] * d1[1]) + (d1[2] * d1[2] + d1[3] * d1[3]);
            s2_ = sum8(s2_); const float rstd = rsqrtf(s2_ * (1.f / 64.f) + GN_EPS);
            const float gv[8] = {bflo(G0.x), bfhi(G0.x), bflo(G0.y), bfhi(G0.y), bflo(G0.z), bfhi(G0.z), bflo(G0.w), bfhi(G0.w)};
            const float ov[8] = {bflo(O0.x), bfhi(O0.x), bflo(O0.y), bfhi(O0.y), bflo(O0.z), bfhi(O0.z), bflo(O0.w), bfhi(O0.w)};
            float o[8];
#pragma unroll
            for (int i = 0; i < 4; ++i) { o[i] = ov[i] + (d0[i] * rstd * gn0[0][i] + gn1[0][i]) * gv[i]; o[4 + i] = ov[4 + i] + (d1[i] * rstd * gn0[1][i] + gn1[1][i]) * gv[4 + i]; }
            u32x4 w; w.x = pk2(o[0], o[1]); w.y = pk2(o[2], o[3]); w.z = pk2(o[4], o[5]); w.w = pk2(o[6], o[7]);
            *(u32x4*)(OB + (size_t)(64 * (c - 1)) * D) = w;
        }
        if (c < NCH) {
            bf16x8 bf_[2];
#pragma unroll
            for (int s2 = 0; s2 < 2; ++s2) bf_[s2] = *(const LAS bf16x8*)(L + R2_SV + cur * 64 * PS * 2 + (vcol * PS + 32 * s2 + 8 * g) * 2);
            f32x4 acc[4];
#pragma unroll
            for (int m = 0; m < 4; ++m) { acc[m] = (f32x4){bflo(I0[m].x), bfhi(I0[m].x), bflo(I0[m].y), bfhi(I0[m].y)};
#pragma unroll
                for (int s2 = 0; s2 < 2; ++s2) acc[m] = mfma16(A0[m][s2], bf_[s2], acc[m]); }
            if (role == 0) {
#pragma unroll
                for (int m = 0; m < 4; ++m) *(LAS u32x2*)(L + R2_SV + (cur ^ 1) * 64 * PS * 2 + (vcol * PS + 16 * m + 4 * g) * 2) = pk4(acc[m]);
            } else {
#pragma unroll
                for (int m = 0; m < 4; ++m)
#pragma unroll
                    for (int e = 0; e < 4; ++e) *(LAS float*)(L + R2_YS + (cur * 64 * 68 + (16 * m + 4 * g + e) * 68 + vcol) * 4) = acc[m][e];
            }
        }
        LDS_BARRIER();
#pragma unroll
        for (int m = 0; m < 4; ++m) { I0[m] = I1[m]; I1[m] = I2[m]; A0[m][0] = A1[m][0]; A0[m][1] = A1[m][1]; A1[m][0] = A2[m][0]; A1[m][1] = A2[m][1]; }
        G0 = G1; O0 = O1; G1 = G2; O1 = O2;
    }
#undef R2_LOAD
}

__device__ void rwkv_naive(const Params& p, int l, int bh, unsigned char* lds) {
    const int b = bh >> 3, h = bh & 7, tid = otid(), lane = tid & 63, wid = tid >> 6;
    const bf16_t* U = (const bf16_t*)(p.ws + WS_UAR);
    bf16_t* OB = (bf16_t*)(p.ws + WS_OAB);
    float* xs = (float*)lds;
    float* vr = xs + 32 * 256;
    float* vw = vr + 2048; float* vkk = vw + 2048; float* vbb = vkk + 2048; float* vk = vbb + 2048; float* vv = vk + 2048;
    float* gg = vv + 2048; float* bon = gg + 2048; float* ys = bon + 2048;
    const float* mu = p.in[I_MU] + l * R_COLS;
    const int hd = h * 64 + lane;
    const float w0 = p.in[I_W0][l * 512 + hd], a0 = p.in[I_A0][l * 512 + hd], kkc = p.in[I_KK][l * 512 + hd], kac = p.in[I_KA][l * 512 + hd], rkc = p.in[I_RK][l * 512 + hd];
    const float gng = p.in[I_GNG][l * 512 + hd], gnb = p.in[I_GNB][l * 512 + hd];
    const float mur = mu[hd], muk = mu[512 + hd], muv = mu[1024 + hd];
    const float* wup = p.in[I_WUP] + (size_t)l * 64 * 512 + hd; const float* aup = p.in[I_AUP] + (size_t)l * 64 * 512 + hd; const float* gup = p.in[I_GUP] + (size_t)l * 128 * 512 + hd;
    float S[8];
#pragma unroll
    for (int i = 0; i < 8; ++i) S[i] = 0.f;
    const int sv = tid >> 3, sq = tid & 7;
    for (int p0 = 0; p0 < LP; p0 += 32) {
        for (int idx = tid; idx < 32 * 256; idx += NTHREADS) {
            const int tt = idx >> 8, j = idx & 255, pos = p0 + tt; const size_t ro = (size_t)(b * LP + pos) * UARW;
            const float x = bf2f(U[ro + C_XW + j]); const float xp = pos > 0 ? bf2f(U[ro - UARW + C_XW + j]) : 0.f;
            float xv = x + (xp - x) * mu[1536 + j];
            if (j < 64) xv = tanhf(xv); else if (j >= 128) xv = sigmoidf_(xv);
            xs[idx] = xv;
        }
        __syncthreads();
        {
            float dw[4] = {0.f, 0.f, 0.f, 0.f}, da[4] = {0.f, 0.f, 0.f, 0.f}, dg[4] = {0.f, 0.f, 0.f, 0.f};
            for (int j = 0; j < 64; ++j) { const float w1 = wup[(size_t)j * 512], w2 = aup[(size_t)j * 512];
#pragma unroll
                for (int k = 0; k < 4; ++k) { dw[k] = fmaf(xs[(wid * 4 + k) * 256 + j], w1, dw[k]); da[k] = fmaf(xs[(wid * 4 + k) * 256 + 64 + j], w2, da[k]); } }
            for (int j = 0; j < 128; ++j) { const float w3 = gup[(size_t)j * 512];
#pragma unroll
                for (int k = 0; k < 4; ++k) dg[k] = fmaf(xs[(wid * 4 + k) * 256 + 128 + j], w3, dg[k]); }
#pragma unroll
            for (int k = 0; k < 4; ++k) {
                const int tt = wid * 4 + k, pos = p0 + tt; const size_t ro = (size_t)(b * LP + pos) * UARW;
                float r = bf2f(U[ro + C_R + hd]), kx = bf2f(U[ro + C_RK + hd]), vx = bf2f(U[ro + C_RV + hd]);
                if (pos > 0) { const float rp = bf2f(U[ro - UARW + C_R + hd]), kp = bf2f(U[ro - UARW + C_RK + hd]), vp = bf2f(U[ro - UARW + C_RV + hd]);
                    r += (rp - r) * mur; kx += (kp - kx) * muk; vx += (vp - vx) * muv; }
                else { r -= r * mur; kx -= kx * muk; vx -= vx * muv; }
                const float z = -(w0 + dw[k]); const float sp = fmaxf(z, 0.f) + log1pf(__expf(-fabsf(z)));
                const float logw = -sp - 0.5f; const float w = __expf(-__expf(logw));
                const float a = sigmoidf_(a0 + da[k]);
                float kk = kx * kkc; const float nrm = wave_sum(kk * kk); kk *= rsqrtf(fmaxf(nrm, 1e-24f));
                const float kmod = kx * (1.0f + (a - 1.0f) * kac);
                const float bsum = wave_sum(r * kmod * rkc);
                vr[tt * 64 + lane] = r; vw[tt * 64 + lane] = w; vkk[tt * 64 + lane] = kk; vbb[tt * 64 + lane] = kk * a; vk[tt * 64 + lane] = kmod; vv[tt * 64 + lane] = vx;
                gg[tt * 64 + lane] = dg[k]; bon[tt * 64 + lane] = bsum * vx;
            }
        }
        __syncthreads();
        for (int tt = 0; tt < 32; ++tt) {
            const f32x4 k0 = *(const f32x4*)(vkk + tt * 64 + sq * 8), k1 = *(const f32x4*)(vkk + tt * 64 + sq * 8 + 4);
            const f32x4 w0v = *(const f32x4*)(vw + tt * 64 + sq * 8), w1v = *(const f32x4*)(vw + tt * 64 + sq * 8 + 4);
            const f32x4 b0 = *(const f32x4*)(vbb + tt * 64 + sq * 8), b1 = *(const f32x4*)(vbb + tt * 64 + sq * 8 + 4);
            const f32x4 m0 = *(const f32x4*)(vk + tt * 64 + sq * 8), m1 = *(const f32x4*)(vk + tt * 64 + sq * 8 + 4);
            const f32x4 r0 = *(const f32x4*)(vr + tt * 64 + sq * 8), r1 = *(const f32x4*)(vr + tt * 64 + sq * 8 + 4);
            const float vt = vv[tt * 64 + sv];
            float sa = 0.f;
#pragma unroll
            for (int i = 0; i < 4; ++i) { sa = fmaf(S[i], k0[i], sa); sa = fmaf(S[4 + i], k1[i], sa); }
            sa += __shfl_xor(sa, 1); sa += __shfl_xor(sa, 2); sa += __shfl_xor(sa, 4);
            sa = -sa; float y = 0.f;
#pragma unroll
            for (int i = 0; i < 4; ++i) { S[i] = S[i] * w0v[i] + sa * b0[i] + vt * m0[i]; S[4 + i] = S[4 + i] * w1v[i] + sa * b1[i] + vt * m1[i];
                y = fmaf(S[i], r0[i], y); y = fmaf(S[4 + i], r1[i], y); }
            y += __shfl_xor(y, 1); y += __shfl_xor(y, 2); y += __shfl_xor(y, 4);
            if (sq == 0) ys[tt * 64 + sv] = y;
        }
        __syncthreads();
#pragma unroll
        for (int k = 0; k < 4; ++k) { const int tt = wid * 4 + k, pos = p0 + tt; const float y = ys[tt * 64 + lane];
            const float m = wave_sum(y) * (1.f / 64.f); const float dv = y - m; const float var = wave_sum(dv * dv) * (1.f / 64.f);
            const float o = (dv * rsqrtf(var + GN_EPS) * gng + gnb + bon[tt * 64 + lane]) * gg[tt * 64 + lane];
            OB[(size_t)(b * LP + pos) * D + 512 + hd] = (bf16_t)f2bf(o); }
        __syncthreads();
    }
}

__device__ __forceinline__ int pair_index(int a, int b) {   return a == 0 ? b - 1 : (a == 1 ? b + 1 : 5); }
__device__ __forceinline__ void pair_of(int idx, int& a, int& b) { a = idx < 3 ? 0 : (idx < 5 ? 1 : 2); b = idx < 3 ? idx + 1 : (idx < 5 ? idx - 1 : 3); }
__device__ __forceinline__ void ln1_rows(const Params& p, int l, unsigned char* lds, int row0, bool stage) {
    const int tid = otid(), lane = tid & 63, gw = row0 + 8 * (tid >> 6), NGW = 1, TEND = gw + 8;
    int* lcnt = (int*)(lds + 65536); int* lbase = lcnt + 32; int* rec = lcnt + 64;
    __syncthreads();
    if (tid < 32) lcnt[tid] = 0;
    float* wr_s = (float*)lds;
    if (stage) for (int i = tid; i < D * 16 / 4; i += NTHREADS) { const f32x4 w = ((const f32x4*)p.in[I_WROUTER])[i]; const int c = i >> 2, e0 = (i & 3) * 4;
        wr_s[(e0 + 0) * D + c] = w[0]; wr_s[(e0 + 1) * D + c] = w[1]; wr_s[(e0 + 2) * D + c] = w[2]; wr_s[(e0 + 3) * D + c] = w[3]; }
    __syncthreads();
    unsigned* cls_cnt = (unsigned*)(p.ws + WS_CTL) + CW_CLS + l * 512;
    int* lists = (int*)(p.ws + WS_LIST); f32x2* gl = (f32x2*)(p.ws + WS_LIST + 2 * MiB);
    const float* g = p.in[I_LN1G] + l * D; const float* bt = p.in[I_LN1B] + l * D;
    f32x4 vn[4];
    { const float* h0 = hrow(p, gw);
#pragma unroll
      for (int j = 0; j < 4; ++j) vn[j] = *(const f32x4*)(h0 + 4 * lane + 256 * j); }
    int nrec = 0;
    for (int r = gw; r < TEND; r += NGW) {
        f32x4 v[4];
#pragma unroll
        for (int j = 0; j < 4; ++j) v[j] = vn[j];
        { const float* h1 = hrow(p, r + NGW < TEND ? r + NGW : r);
#pragma unroll
          for (int j = 0; j < 4; ++j) vn[j] = *(const f32x4*)(h1 + 4 * lane + 256 * j); }
        if (is_dummy(r)) {
#pragma unroll
            for (int j = 0; j < 4; ++j) v[j] = (f32x4){0.f, 0.f, 0.f, 0.f};
            store_row(p, r, v, lane, true); continue; }
        ln_wave(v, g, bt, lane);
        store_row(p, r, v, lane, false);
        float lg[16];
#pragma unroll
        for (int e = 0; e < 16; ++e) lg[e] = 0.f;
#pragma unroll
        for (int e = 0; e < 16; ++e)
#pragma unroll
            for (int j = 0; j < 4; ++j) { const f32x4 w = *(const f32x4*)(wr_s + e * D + 4 * lane + 256 * j);
                lg[e] = fmaf(v[j][0], w[0], lg[e]); lg[e] = fmaf(v[j][1], w[1], lg[e]); lg[e] = fmaf(v[j][2], w[2], lg[e]); lg[e] = fmaf(v[j][3], w[3], lg[e]); }
        float mine = 0.f;
#pragma unroll
        for (int e = 0; e < 16; ++e) { const float rs = sum16(lg[e]); mine = (lane & 15) == e ? rs : mine; }
        mine += __shfl_xor(mine, 16); mine += __shfl_xor(mine, 32);
#pragma unroll
        for (int e = 0; e < 16; ++e) lg[e] = __builtin_bit_cast(float, __builtin_amdgcn_readlane(__builtin_bit_cast(int, mine), e));
        float s[16], sel[16];
#pragma unroll
        for (int e = 0; e < 16; ++e) { s[e] = sigmoidf_(lg[e]); sel[e] = s[e] + p.in[I_BROUTER][e]; }
        int gbest = 0; float gsc = -INFINITY;
#pragma unroll
        for (int gi = 0; gi < 4; ++gi) { float m1 = -INFINITY, m2 = -INFINITY;
#pragma unroll
            for (int j = 0; j < 4; ++j) { const float x = sel[gi * 4 + j]; if (x > m1) { m2 = m1; m1 = x; } else if (x > m2) m2 = x; }
            const float sc = m1 + m2; if (sc > gsc) { gsc = sc; gbest = gi; } }
        float sg[4], sgs[4];
#pragma unroll
        for (int j = 0; j < 4; ++j) { sg[j] = gbest == 0 ? sel[j] : (gbest == 1 ? sel[4 + j] : (gbest == 2 ? sel[8 + j] : sel[12 + j])); sgs[j] = gbest == 0 ? s[j] : (gbest == 1 ? s[4 + j] : (gbest == 2 ? s[8 + j] : s[12 + j])); }
        int j1 = 0;
#pragma unroll
        for (int j = 1; j < 4; ++j) if (sg[j] > sg[j1]) j1 = j;
        int j2 = j1 == 0 ? 1 : 0;
#pragma unroll
        for (int j = 0; j < 4; ++j) if (j != j1 && j != j2 && sg[j] > sg[j2]) j2 = j;
        const int ja = j1 < j2 ? j1 : j2, jb = j1 < j2 ? j2 : j1;
        float sa_ = 0.f, sb_ = 0.f;
#pragma unroll
        for (int j = 0; j < 4; ++j) { if (j == ja) sa_ = sgs[j]; if (j == jb) sb_ = sgs[j]; }
        const float inv = 1.0f / (sa_ + sb_);
        const int cls = gbest * 6 + pair_index(ja, jb);
        if (lane == 0) { const int loc = __hip_atomic_fetch_add(lcnt + cls, 1, __ATOMIC_RELAXED, __HIP_MEMORY_SCOPE_WORKGROUP); rec[(tid >> 6) * 32 + 2 * nrec] = r; rec[(tid >> 6) * 32 + 2 * nrec + 1] = (cls << 16) | loc; gl[r] = (f32x2){sa_ * inv, sb_ * inv}; }
        ++nrec;
    }
    __syncthreads();
    if (tid < 24) lbase[tid] = (int)atomicAdd(cls_cnt + 16 * tid, (unsigned)lcnt[tid]);
    __syncthreads();
    if (lane < nrec) { const int r = rec[(tid >> 6) * 32 + 2 * lane], cl = rec[(tid >> 6) * 32 + 2 * lane + 1]; const int cls = cl >> 16; lists[(size_t)cls * T + lbase[cls] + (cl & 0xffff)] = r; }
}


constexpr size_t WS_CH1 = 655360;
constexpr int CH1_NM = 260, CH1_NW = 260, CH1_NC = 96, CH1_NL = 260, CH1_TOT = CH1_NM + CH1_NW + CH1_NC + CH1_NL;
__device__ __forceinline__ void task_signal(unsigned* c0, unsigned* c1) {
    asm volatile("s_waitcnt vmcnt(0)" ::: "memory");
    __syncthreads();
    if (otid() == 0) { __builtin_amdgcn_fence(__ATOMIC_RELEASE, "agent"); asm volatile("s_waitcnt vmcnt(0)" ::: "memory");
        __hip_atomic_fetch_add(c0, 1u, __ATOMIC_RELAXED, __HIP_MEMORY_SCOPE_AGENT); if (c1) __hip_atomic_fetch_add(c1, 1u, __ATOMIC_RELAXED, __HIP_MEMORY_SCOPE_AGENT); }
}
__device__ __forceinline__ void task_wait(unsigned* c, unsigned target) {
    if (otid() == 0) { unsigned sp = 0; while (__hip_atomic_load(c, __ATOMIC_RELAXED, __HIP_MEMORY_SCOPE_AGENT) < target && ++sp < (1u << 24)) __builtin_amdgcn_s_sleep(2);
        __builtin_amdgcn_fence(__ATOMIC_ACQUIRE, "agent"); asm volatile("s_waitcnt vmcnt(0)" ::: "memory"); }
    __syncthreads();
}
__device__ __forceinline__ void conv_expert_items(const Params& p, int l, LAS unsigned char* lds, int it0, int it1);
__device__ __forceinline__ void chain1_phase(int l, unsigned char* lds, LAS unsigned char* ldsl, unsigned long long& pacc) {
    unsigned long long pt0 = 0;
#define C1P_B(k) do { if (PROBE_PHASE == (k)) pt0 = __builtin_amdgcn_s_memrealtime(); } while (0)
#define C1P_E(k) do { if (PROBE_PHASE == (k)) pacc += __builtin_amdgcn_s_memrealtime() - pt0; } while (0)
    int staged = 0;
    for (;;) {
        unsigned* chq = (unsigned*)(PP().ws + WS_CH1) + 1024 * l;
        volatile int* uw = (volatile int*)(lds + 144000);
        __syncthreads();
        if (otid() == 0) *uw = (int)atomicAdd(chq, 1u);
        __syncthreads();
        const int t = __builtin_amdgcn_readfirstlane(*uw);
        if (t >= CH1_TOT) break;
        if (t < CH1_NM) { const int pm = t >> 2, pn = t & 3;
            C1P_B(50); merge_unit(l, ldsl, pm, pn);
            task_signal(chq + 64 + pm, chq + 16); C1P_E(50);
        } else if (t < CH1_NM + CH1_NW) { const int u = t - CH1_NM, pm = u >> 2, pn = u & 3;
            C1P_B(54); task_wait(chq + 64 + pm, 4u); C1P_E(54);
            C1P_B(51); wout_unit(l, ldsl, pm, pn);
            task_signal(chq + 192 + pm, nullptr); C1P_E(51);
        } else if (t < CH1_NM + CH1_NW + CH1_NC) { const int u = t - CH1_NM - CH1_NW;
            C1P_B(54); task_wait(chq + 16, (unsigned)CH1_NM); C1P_E(54);
            C1P_B(52); conv_expert_items(PP(), l, ldsl, u * 128, u * 128 + 128); C1P_E(52);
        } else { const int u = t - CH1_NM - CH1_NW - CH1_NC, pm = u >> 2, qr = u & 3;
            C1P_B(54); task_wait(chq + 16, (unsigned)CH1_NM);
            task_wait(chq + 192 + pm, 4u); C1P_E(54);
            C1P_B(53); ln1_rows(PP(), l, lds, pm * 256 + qr * 64, staged == 0); staged = 1; C1P_E(53);
        }
    }
}

struct ClsTab { int cnt[24]; int tile0[25]; int row0[24]; };
__device__ __forceinline__ void build_cls_table(const Params& p, int l, int* tab  ) {
    if (otid() == 0) { const unsigned* c = (const unsigned*)(p.ws + WS_CTL) + CW_CLS + l * 512; int acc = 0;
        for (int i = 0; i < 24; ++i) { const int n = (int)__hip_atomic_load(c + 16 * i, __ATOMIC_RELAXED, __HIP_MEMORY_SCOPE_AGENT); tab[i] = n; tab[24 + i] = acc; acc += (n + 255) >> 8; }
        tab[48] = acc; }
    __syncthreads();
}
__device__ __forceinline__ int find_cls(const int* tab, int tile) { int c = 0;
#pragma unroll 1
    for (int i = 1; i < 24; ++i) if (tile >= tab[24 + i]) c = i;
    return c; }
__device__ __forceinline__ void moe_a_phase(const Params& p, int l, LAS unsigned char* lds, const int* tab) {
    const int tid = otid();
    unsigned voffB[2]; g8::make_voffB(voffB, D * 2, true);
    const int ntiles = tab[48], nunits = ntiles * 8;
    for (int u = obid(); u < nunits; u += gridDim.x) {
        const int tile = u >> 3, pn = u & 7, cls = find_cls(tab, tile), rt = tile - tab[24 + cls], n = tab[cls];
        int ja, jb; pair_of(cls % 6, ja, jb); const int eslot = pn >> 2, e = (cls / 6) * 4 + (eslot ? jb : ja), jblk = pn & 3;
        unsigned voffA[2][2]; { const int* lists = (const int*)(PP().ws + WS_LIST);
#pragma unroll
        for (int i = 0; i < 2; ++i) { int R, C; g8::stage_rc(tid * 16 + i * 8192, R, C);
#pragma unroll
            for (int hh = 0; hh < 2; ++hh) { const int li = rt * 256 + R + hh * 128; const int tok = li < n ? lists[(size_t)cls * T + li] : 0;
                voffA[hh][i] = (unsigned)tok * (D * 2) + (unsigned)C * 2u; } } }
        g8::Acc acc; g8::zero_acc(acc);
        const char* Bb = (const char*)(PP().ws + WS_WEXP) + ((size_t)e * 1024 + jblk * 256) * D * 2;
        const g8::KSeg s = g8::seg1((const char*)(PP().ws + WS_HB), Bb, Bb + (size_t)128 * D * 2, D / 64);
        g8::kloop<true, false>(lds, acc, s, voffA, voffB, 0);
        EPI_COORDS();
        const int* lists = (const int*)(PP().ws + WS_LIST); const f32x2* gl = (const f32x2*)(PP().ws + WS_LIST + 2 * MiB); bf16_t* ACT = (bf16_t*)(PP().ws + WS_ACT);
#pragma unroll
        for (int ai = 0; ai < 2; ++ai)
#pragma unroll
            for (int m = 0; m < 4; ++m) { asm volatile("" ::: "memory"); const int li = rt * 256 + ai * 128 + wr * 64 + m * 16 + fr; const int tok = li < n ? lists[(size_t)cls * T + li] : -1;
                float gate = 0.f; if (tok >= 0) { const f32x2 g2 = gl[tok]; gate = eslot ? g2[1] : g2[0]; }
                const f32x4 h1a = acc[ai][0][m][0], h1b = acc[ai][0][m][1], h3a = acc[ai][1][m][0], h3b = acc[ai][1][m][1];
                float o[8];
#pragma unroll
                for (int c = 0; c < 4; ++c) { o[c] = gate * (h1a[c] * sigmoidf_(h1a[c])) * h3a[c]; o[4 + c] = gate * (h1b[c] * sigmoidf_(h1b[c])) * h3b[c]; }
                u32x4 w; w.x = pk2(o[0], o[1]); w.y = pk2(o[2], o[3]); w.z = pk2(o[4], o[5]); w.w = pk2(o[6], o[7]);
                *(u32x4*)(ACT + (size_t)(tile * 256 + ai * 128 + wr * 64 + m * 16 + fr) * D + eslot * 512 + jblk * 128 + wc * 32 + 8 * fq) = w; }
    }
}
__device__ __forceinline__ void moe_b_phase(const Params& p, int l, LAS unsigned char* lds, const int* tab) {
    unsigned voffA[2][2], voffB[2]; g8::make_voff_contig(voffA, D * 2); g8::make_voffB(voffB, 512 * 2, false);
    const int ntiles = tab[48], nunits = ntiles * 4;
    for (int u = obid(); u < nunits; u += gridDim.x) {
        const int tile = u >> 2, pn = u & 3, cls = find_cls(tab, tile), rt = tile - tab[24 + cls], n = tab[cls];
        int ja, jb; pair_of(cls % 6, ja, jb); const int ea = (cls / 6) * 4 + ja, eb = (cls / 6) * 4 + jb;
        g8::Acc acc; g8::zero_acc(acc);
        const char* At = (const char*)(PP().ws + WS_ACT) + (size_t)tile * 256 * D * 2;
        const char* W2 = (const char*)(PP().ws + WS_WEXP + 32 * MiB);
        const char* Ba = W2 + ((size_t)ea * 1024 + pn * 256) * 512 * 2; const char* Bb = W2 + ((size_t)eb * 1024 + pn * 256) * 512 * 2;
        g8::KSeg s2 = g8::seg1(At, Ba, Ba + (size_t)128 * 512 * 2, 16); s2.nt0 = 8; s2.A2 = At + 1024; s2.B02 = Bb; s2.B12 = Bb + (size_t)128 * 512 * 2;
        g8::kloop<false, true>(lds, acc, s2, voffA, voffB, 128 * D * 2);
        EPI_COORDS();
        const int* lists = (const int*)(PP().ws + WS_LIST);
        const int col0 = pn * 256 + wc * 32 + 4 * fq;
        int tk[2][4];
#pragma unroll
        for (int ai = 0; ai < 2; ++ai)
#pragma unroll
            for (int m = 0; m < 4; ++m) { const int li = rt * 256 + ai * 128 + wr * 64 + m * 16 + fr; tk[ai][m] = li < n ? lists[(size_t)cls * T + li] : -1; }
#pragma unroll
        for (int ai = 0; ai < 2; ++ai) { asm volatile("" ::: "memory");
            f32x4 pre[4][2][2]; float* hr[4];
#pragma unroll
            for (int m = 0; m < 4; ++m) { hr[m] = hrow(PP(), tk[ai][m] >= 0 ? tk[ai][m] : 0) + col0;
#pragma unroll
                for (int bj = 0; bj < 2; ++bj)
#pragma unroll
                    for (int nn = 0; nn < 2; ++nn) pre[m][bj][nn] = *(const f32x4*)(hr[m] + bj * 128 + nn * 16); }
#pragma unroll
            for (int m = 0; m < 4; ++m) if (tk[ai][m] >= 0) {
#pragma unroll
                for (int bj = 0; bj < 2; ++bj)
#pragma unroll
                    for (int nn = 0; nn < 2; ++nn) *(f32x4*)(hr[m] + bj * 128 + nn * 16) = pre[m][bj][nn] * ALPHA + acc[ai][bj][m][nn]; } }
    }
}
__device__ __forceinline__ void ln2_phase(const Params& p, int l) {
    const int tid = otid(), lane = tid & 63, gw = obid() * NWAVES + (tid >> 6), NGW = gridDim.x * NWAVES;
    const float* g = p.in[I_LN2G] + l * D; const float* bt = p.in[I_LN2B] + l * D;
    for (int r = gw; r < T; r += NGW) {
        f32x4 v[4];
        if (is_dummy(r)) {
#pragma unroll
            for (int j = 0; j < 4; ++j) v[j] = (f32x4){0.f, 0.f, 0.f, 0.f};
            store_row(p, r, v, lane, true); continue; }
        const float* hr = hrow(p, r);
#pragma unroll
        for (int j = 0; j < 4; ++j) v[j] = *(const f32x4*)(hr + 4 * lane + 256 * j);
        ln_wave(v, g, bt, lane);
        store_row(p, r, v, lane, false);
    }
}


#define XB_TMO      128
#define XB_XCNT(j)  (256  + 64 * (j))
#define XB_XSUB(j)  (1280 + 64 * (j))
#define XB_XGEN(j)  (2304 + 64 * (j))
#define XB_TOP      3328
#define XB_TOPGEN   3392
#define XCD_BAR_WORDS 3456
#define XB_SPIN_CAP (1u << 22)
constexpr size_t WS_BAR = 8192;
constexpr int LDS_BARST = LDS_BYTES - 16;
__device__ __forceinline__ unsigned xb_ld(unsigned* p)              { return __hip_atomic_load(p, __ATOMIC_RELAXED, __HIP_MEMORY_SCOPE_AGENT); }
__device__ __forceinline__ unsigned xb_add(unsigned* p, unsigned v) { return __hip_atomic_fetch_add(p, v, __ATOMIC_RELAXED, __HIP_MEMORY_SCOPE_AGENT); }
__device__ __forceinline__ unsigned xb_xcc_id() { return (unsigned)__builtin_amdgcn_s_getreg((3 << 11) | 20) & 0xFu; }
#define XB_SPIN(cond, bar) do { unsigned _sp = 0; while (cond) { __builtin_amdgcn_s_sleep(1); \
    if ((++_sp & 255u) == 0u) { if (xb_ld(&(bar)[XB_TMO])) break; if (_sp > XB_SPIN_CAP) { atomicAdd(&(bar)[XB_TMO], 1u); break; } } } } while (0)
__device__ __forceinline__ void xcd_barrier_complete(unsigned* bar, unsigned x, unsigned& nloc, unsigned& nx) {
    const unsigned G = gridDim.x * gridDim.y * gridDim.z;
    unsigned sum, cnt, mine, sp = 0u;
    for (;;) {
        sum = 0u; cnt = 0u; mine = 0u;
#pragma unroll
        for (unsigned j = 0; j < 16; ++j) { const unsigned c = xb_ld(&bar[XB_XCNT(j)]); sum += c; cnt += (c > 0u) ? 1u : 0u; mine = (j == x) ? c : mine; }
        if (sum == G) break;
        __builtin_amdgcn_s_sleep(1);
        if ((++sp & 255u) == 0u) { if (xb_ld(&bar[XB_TMO])) break; if (sp > XB_SPIN_CAP) { atomicAdd(&bar[XB_TMO], 1u); break; } }
    }
    nloc = mine > 0u ? mine : 1u; nx = cnt > 0u ? cnt : 1u;
}
__device__ __forceinline__ void xcd_barrier(unsigned* bar, volatile LAS unsigned* st) {
    asm volatile("s_waitcnt vmcnt(0)" ::: "memory");
    __syncthreads();
    if (threadIdx.x == 0) {
        __builtin_amdgcn_s_waitcnt(0);
        const unsigned x = xb_xcc_id();
        unsigned nloc = st[0], nx = st[1];
        if (nloc == 0u) { xcd_barrier_complete(bar, x, nloc, nx); st[0] = nloc; st[1] = nx; }
        const unsigned old = xb_add(&bar[XB_XSUB(x)], 1u);
        const unsigned gen = old / nloc;
        if (old + 1u == (gen + 1u) * nloc) {
            __builtin_amdgcn_fence(__ATOMIC_RELEASE, "agent");
            asm volatile("s_waitcnt vmcnt(0)" ::: "memory");
            const unsigned og = xb_add(&bar[XB_TOP], 1u);
            const unsigned tg = og / nx;
            if (og + 1u == (tg + 1u) * nx) xb_add(&bar[XB_TOPGEN], 1u);
            else XB_SPIN(xb_ld(&bar[XB_TOPGEN]) == tg, bar);
            __builtin_amdgcn_fence(__ATOMIC_ACQUIRE, "agent");
            xb_add(&bar[XB_XGEN(x)], 1u);
            asm volatile("s_waitcnt vmcnt(0)" ::: "memory");
        } else {
            XB_SPIN(xb_ld(&bar[XB_XGEN(x)]) == gen, bar);
            __builtin_amdgcn_fence(__ATOMIC_ACQUIRE, "agent");
            asm volatile("s_waitcnt vmcnt(0)" ::: "memory");
        }
    }
    __syncthreads();
}

__global__ void __launch_bounds__(NTHREADS, 2) mega(Params p_unused) {
    extern __shared__ __attribute__((aligned(16))) unsigned char lds[];
    cg::grid_group grid = cg::this_grid();
    volatile LAS unsigned* barst = (volatile LAS unsigned*)((LAS unsigned char*)lds + LDS_BARST);
    { unsigned* bar0 = (unsigned*)(PP().ws + WS_BAR);
      if (threadIdx.x == 0) { barst[0] = 0u; barst[1] = 0u; (void)xb_add(bar0 + XB_XCNT(xb_xcc_id()), 1u); } }
    __syncthreads();
#define GBAR() xcd_barrier((unsigned*)(PP().ws + WS_BAR), barst)
    unsigned long long pr_t0 = 0, pr_acc = 0;
#define PH_BEGIN(k) do { if (PROBE_PHASE == (k)) pr_t0 = __builtin_amdgcn_s_memrealtime(); } while (0)
#define PH_END(k) do { if (PROBE_PHASE == (k)) pr_acc += __builtin_amdgcn_s_memrealtime() - pr_t0; } while (0)
#define LDSG() (lds + ozero())
#define LDSL() ((LAS unsigned char*)lds)

    PH_BEGIN(0);
    conv_small_weights(PP(), LDSL());
    ln_in_phase(PP());
    if (gridDim.y == 0x7fffffffu) grid.sync();
    GBAR();
    PH_END(0);
#pragma unroll 1
    for (int l = 0; l < DEPTH; ++l) {
        PH_BEGIN(1);
        inproj_phase(PP(), l, LDSL());
        GBAR();
        PH_END(1); PH_BEGIN(2);
        {
            unsigned* qctr = (unsigned*)(PP().ws + WS_CTL) + CW_R1Q + 2 * l;
            volatile int* uw = (volatile int*)(LDSG() + AT_UNIT);
            int ndone = 0;
            for (;;) {
                __syncthreads();
                if (otid() == 0) *uw = (int)atomicAdd(qctr, 1u);
                __syncthreads();
                const int u = *uw;
                if (u >= BATCH * NCH * 8) break;
                if (PROBE_PHASE == 30) pr_t0 = __builtin_amdgcn_s_memrealtime();
                rwkv_prep_unit(PP(), l, u, LDSG(), pr_acc); ++ndone;
                if (PROBE_PHASE == 30) pr_acc += __builtin_amdgcn_s_memrealtime() - pr_t0;
            }
            asm volatile("s_waitcnt vmcnt(0)" ::: "memory");
            __syncthreads();
            if (otid() == 0 && ndone > 0) { __builtin_amdgcn_fence(__ATOMIC_RELEASE, "agent"); asm volatile("s_waitcnt vmcnt(0)" ::: "memory"); __hip_atomic_fetch_add(qctr + 1, (unsigned)ndone, __ATOMIC_RELAXED, __HIP_MEMORY_SCOPE_AGENT); }
            const int bid = obid();
            if (bid < 32) {
                if (otid() == 0) { unsigned sp = 0; while (__hip_atomic_load(qctr + 1, __ATOMIC_RELAXED, __HIP_MEMORY_SCOPE_AGENT) < (unsigned)(BATCH * NCH * 8) && ++sp < (1u << 26)) __builtin_amdgcn_s_sleep(4);
                    __builtin_amdgcn_fence(__ATOMIC_ACQUIRE, "agent"); asm volatile("s_waitcnt vmcnt(0)" ::: "memory"); }
                __syncthreads();
                rwkv_scan(PP(), l, bid, LDSG());
            }
            attn_phase(PP(), l, LDSG(), pr_acc);
        }
        GBAR();
        PH_END(2); PH_BEGIN(4);
        chain1_phase(l, LDSG(), LDSL(), pr_acc);
        GBAR();
        PH_END(4); PH_BEGIN(7);
        { int toff = 140 * 1024; asm volatile("" : "+s"(toff)); int* tab = (int*)(lds + toff);
          build_cls_table(PP(), l, tab);
          moe_a_phase(PP(), l, LDSL(), tab);
          GBAR();
          PH_END(7); PH_BEGIN(8);
          moe_b_phase(PP(), l, LDSL(), tab); }
        GBAR();
        PH_END(8); PH_BEGIN(9);
        ln2_phase(PP(), l);
        if (l + 1 < DEPTH) GBAR();
        PH_END(9);
    }
    if (PROBE_PHASE >= 0 && blockIdx.x == PROBE_BLOCK && threadIdx.x == 0) { const unsigned long long t = __builtin_amdgcn_s_memrealtime(); while (__builtin_amdgcn_s_memrealtime() - t < pr_acc) __builtin_amdgcn_s_sleep(8); }
}

extern "C" void kernel_launch(void* const* d_in, const int* in_sizes, int n_in, void* d_out, int out_size,
                              void* d_ws, size_t ws_size, hipStream_t stream) {
    static int grid_blocks = 0;
    if (grid_blocks == 0) {
        int dev = 0, cus = 0, per_cu = 0;
        if (n_in != 29 || ws_size < WS_END || out_size != BATCH * SEQ * D) { fprintf(stderr, "kernel_launch: unexpected problem (n_in %d, ws %zu, out %d)\n", n_in, ws_size, out_size); grid_blocks = -1; return; }
        (void)hipGetDevice(&dev);
        (void)hipDeviceGetAttribute(&cus, hipDeviceAttributeMultiprocessorCount, dev);
        (void)hipFuncSetAttribute((const void*)mega, hipFuncAttributeMaxDynamicSharedMemorySize, LDS_BYTES);
        (void)hipOccupancyMaxActiveBlocksPerMultiprocessor(&per_cu, (const void*)mega, NTHREADS, LDS_BYTES);
        if (per_cu < 1) { fprintf(stderr, "occupancy query returned %d\n", per_cu); grid_blocks = -1; return; }
        grid_blocks = cus;
    }
    if (grid_blocks < 0) return;
    (void)hipMemsetAsync((char*)d_ws + WS_CTL, 0, 32768, stream);
    (void)hipMemsetAsync((char*)d_ws + WS_CH1, 0, 16384, stream);
    Params p{};
    for (int i = 0; i < 29; ++i) p.in[i] = (const float*)d_in[i];
    p.out = (float*)d_out; p.ws = (unsigned char*)d_ws;
    void* args[] = {&p};
    hipError_t e = hipLaunchCooperativeKernel((const void*)mega, dim3(grid_blocks), dim3(NTHREADS), args, LDS_BYTES, stream);
    if (e != hipSuccess) fprintf(stderr, "cooperative launch failed: %s (grid %d)\n", hipGetErrorString(e), grid_blocks);
}
```

```cpp
#include <hip/hip_runtime.h>
#include <hip/hip_cooperative_groups.h>
#include <cstdio>
#include <cstdint>
namespace cg = cooperative_groups;

#define LAS __attribute__((address_space(3)))
typedef unsigned short bf16_t;
typedef short bf16x8 __attribute__((ext_vector_type(8)));
typedef float f32x4 __attribute__((ext_vector_type(4)));
typedef float f32x2 __attribute__((ext_vector_type(2)));
typedef unsigned u32x4 __attribute__((ext_vector_type(4)));
typedef unsigned u32x2 __attribute__((ext_vector_type(2)));

constexpr int NTHREADS = 512, NWAVES = 8;
constexpr int D = 1024, BATCH = 4, SEQ = 4096, DEPTH = 2;
constexpr int LP = 4160;
constexpr int T = BATCH * LP;
constexpr int NCH = LP / 64;
constexpr int PADM = 48;
constexpr int A_COLS = 1064, R_COLS = 1792, IN_COLS = 4904;
constexpr int UA = 1280;
constexpr int UARW = 3072;
constexpr int NIN = 5120;
constexpr float LN_EPS = 1e-5f, GN_EPS = 64e-5f;
constexpr float ALPHA = 1.41421356237309515f;
constexpr int C_Q = 0, C_K = 512, C_V = 640, C_QI = 768, C_KI = 1024, C_WI = 1056;
constexpr int C_R = UA, C_RK = UA + 512, C_RV = UA + 1024, C_XW = UA + 1536, C_XA = UA + 1600, C_XG = UA + 1664;

constexpr size_t MiB = 1u << 20;
constexpr size_t WS_CTL = 0;
constexpr size_t WS_HM = 1 * MiB;
constexpr size_t WS_WSMALL = 2 * MiB;
constexpr size_t WSMALL_LAYER = 14 * MiB;
constexpr size_t WS_HB = 30 * MiB;
constexpr size_t WS_UAR = 63 * MiB;
constexpr size_t WS_GATES = 161 * MiB;
constexpr size_t WS_OAB = 226 * MiB;
constexpr size_t WS_LIST = WS_GATES + 48 * MiB;
constexpr size_t WS_END = 308 * MiB;
constexpr size_t WS_MERGED = WS_UAR;
constexpr size_t WS_ACT = WS_UAR + 33 * MiB;
constexpr size_t WS_WEXP = WS_GATES;
constexpr int ACT_ROWS_MAX = 16448 + 24 * 256;
static_assert(WS_ACT + (size_t)ACT_ROWS_MAX * 2048 <= WS_GATES, "act fits");
constexpr int CW_CLS = 1024;

constexpr int LDS_BYTES = 155648;

struct Params {
    const float* in[29];
    float* out;
    unsigned char* ws;
};
enum { I_X = 0, I_META, I_LNIN_G, I_LNIN_B, I_WIN, I_BGATE, I_MU, I_W0, I_WUP, I_A0, I_AUP, I_GUP, I_KK, I_KA, I_RK, I_GNG, I_GNB,
       I_WBA, I_WBB, I_WOUT, I_LN1G, I_LN1B, I_LN2G, I_LN2B, I_WROUTER, I_BROUTER, I_WEXP1, I_WEXP3, I_WEXP2 };

__device__ __forceinline__ int otid() { int t = threadIdx.x; asm volatile("" : "+v"(t)); return t; }
__device__ __forceinline__ const char* uptr(const char* p) { const unsigned long long v = (unsigned long long)p; const unsigned lo = __builtin_amdgcn_readfirstlane((unsigned)v), hi = __builtin_amdgcn_readfirstlane((unsigned)(v >> 32)); return (const char*)(((unsigned long long)hi << 32) | lo); }
__device__ __forceinline__ int ozero() { int z = 0; asm volatile("" : "+s"(z)); return z; }
__device__ __forceinline__ int obid() { int b = blockIdx.x; asm volatile("" : "+s"(b)); return b; }
typedef __bf16 bf16x2_t __attribute__((ext_vector_type(2)));
__device__ __forceinline__ unsigned f2bf(float f) { return (unsigned)__builtin_bit_cast(unsigned short, (__bf16)f); }
__device__ __forceinline__ unsigned pk2(float lo, float hi) { const f32x2 v = {lo, hi}; return __builtin_bit_cast(unsigned, __builtin_convertvector(v, bf16x2_t)); }
template <int CTRL> __device__ __forceinline__ float dpp_f(float v) { return __builtin_bit_cast(float, __builtin_amdgcn_update_dpp(0, __builtin_bit_cast(int, v), CTRL, 0xF, 0xF, true)); }
__device__ __forceinline__ float sum8(float v) { v += dpp_f<0xB1>(v); v += dpp_f<0x4E>(v); v += dpp_f<0x141>(v); return v; }
__device__ __forceinline__ float sum16(float v) { v = sum8(v); v += dpp_f<0x140>(v); return v; }
__device__ __forceinline__ float bf2f(unsigned short b) { return __builtin_bit_cast(float, (unsigned)b << 16); }
__device__ __forceinline__ float bflo(unsigned w) { return __builtin_bit_cast(float, w << 16); }
__device__ __forceinline__ float bfhi(unsigned w) { return __builtin_bit_cast(float, w & 0xffff0000u); }
__device__ __forceinline__ float wave_sum(float v) { v = sum16(v); v += __shfl_xor(v, 16); v += __shfl_xor(v, 32); return v; }
__device__ __forceinline__ float wave_max(float v) {
#pragma unroll
    for (int o = 1; o < 64; o <<= 1) v = fmaxf(v, __shfl_xor(v, o));
    return v;
}
__device__ __forceinline__ float sigmoidf_(float x) { return 1.0f / (1.0f + __expf(-x)); }
__device__ __forceinline__ float* hrow(const Params& p, int r) {
    const int b = r / LP, pos = r - b * LP;
    return pos >= 64 ? p.out + ((size_t)(b * SEQ + (pos - 64)) << 10) : (float*)(p.ws + WS_HM) + ((size_t)(b * 64 + pos) << 10);
}
__device__ __forceinline__ bool is_dummy(int r) { return (r % LP) < PADM; }

__device__ __forceinline__ void transpose_item(const float* src, int ld_src, int col0, int nvalid, bf16_t* dst  , int ld_dst, LAS float* scr, int lane) {
    const int kr = lane >> 3, c4 = (lane & 7) * 4;
    f32x4 v[8];
#pragma unroll
    for (int i = 0; i < 8; ++i) v[i] = *(const f32x4*)(src + (size_t)(8 * i + kr) * ld_src + col0 + c4);
#pragma unroll
    for (int i = 0; i < 8; ++i) { LAS float* w = scr + (8 * i + kr) * 33 + c4;
        w[0] = c4 + 0 < nvalid ? v[i][0] : 0.f; w[1] = c4 + 1 < nvalid ? v[i][1] : 0.f; w[2] = c4 + 2 < nvalid ? v[i][2] : 0.f; w[3] = c4 + 3 < nvalid ? v[i][3] : 0.f; }
    asm volatile("s_waitcnt lgkmcnt(0)" ::: "memory");
    const int ch = lane & 7;
#pragma unroll
    for (int j = 0; j < 4; ++j) { const int n = (lane >> 3) + 8 * j; const LAS float* s = scr + (8 * ch) * 33 + n;
        u32x4 o; o.x = pk2(s[0 * 33], s[1 * 33]); o.y = pk2(s[2 * 33], s[3 * 33]); o.z = pk2(s[4 * 33], s[5 * 33]); o.w = pk2(s[6 * 33], s[7 * 33]);
        *(u32x4*)(dst + (size_t)n * ld_dst + 8 * ch) = o; }
    asm volatile("s_waitcnt lgkmcnt(0)" ::: "memory");
}

namespace g8 {
constexpr int BM = 256, BK = 64, HALF = 128, HTB = HALF * BK * 2, STAGE_BYTES = 8 * HTB;
__host__ __device__ __forceinline__ int lds_byte(int r, int c) { const int st = (r >> 4) * 2 + (c >> 5), rr = r & 15, cc = c & 31, ob = rr * 64 + cc * 2; return st * 1024 + (ob ^ (((ob >> 9) & 1) << 5)); }
__host__ __device__ __forceinline__ void stage_rc(int b, int& R, int& C) { const int st = b / 1024, sb = b % 1024, swz = sb ^ (((sb >> 9) & 1) << 5); R = (st >> 1) * 16 + swz / 64; C = (st & 1) * 32 + (swz % 64) / 2; }
__host__ __device__ __forceinline__ int perm32(int rho) { const int n = rho >> 4, i = rho & 15; return 8 * (i >> 2) + 4 * n + (i & 3); }

struct KSeg {
    const char* A;
    const char* B0;
    const char* B1;
    int nt;
    int nt0;
    const char* A2;
    const char* B02;
    const char* B12;
};
__device__ __forceinline__ KSeg seg1(const char* A, const char* B0, const char* B1, int nt) { KSeg s; s.A = A; s.B0 = B0; s.B1 = B1; s.nt = nt; s.nt0 = nt; s.A2 = A; s.B02 = B0; s.B12 = B1; return s; }
typedef f32x4 Acc[2][2][4][2];

template <bool GATHER, bool TWOSEG>
__device__ __forceinline__ void kloop(LAS unsigned char* lds, Acc& acc, const KSeg s, const unsigned (&voffA)[2][2], const unsigned (&voffB)[2], const unsigned hstepA) {
    int tid = threadIdx.x; asm volatile("" : "+v"(tid));
    const int wid = __builtin_amdgcn_readfirstlane(tid >> 6), lane = tid & 63, wr = wid >> 2, wc = wid & 3, fr = lane & 15, fq = lane >> 4;
    const unsigned ldsw = (unsigned)wid * 1024u;
    const int aoff = lds_byte(wr * 64 + fr, fq * 8), boff = lds_byte(wc * 32 + fr, fq * 8);
    const int nt = __builtin_amdgcn_readfirstlane(s.nt);
#define G8_SA(b, h) (((b) * 2 + (h)) * HTB)
#define G8_SB(b, h) ((4 + (b) * 2 + (h)) * HTB)
#define G8_STAGE(bufoff, gbase, voff) do { _Pragma("unroll") for (int _i = 0; _i < 2; ++_i) \
        __builtin_amdgcn_global_load_lds((const unsigned*)((const char*)(gbase) + (voff)[_i]), (LAS unsigned*)(lds + (bufoff) + ldsw + _i * 8192), 16, 0, 0); } while (0)
#define G8_LDA(dst, b, h) do { _Pragma("unroll") for (int m = 0; m < 4; ++m) _Pragma("unroll") for (int k = 0; k < 2; ++k) dst[m][k] = *(const LAS bf16x8*)(lds + G8_SA(b, h) + aoff + m * 2048 + k * 1024); } while (0)
#define G8_LDB(dst, b, h) do { _Pragma("unroll") for (int n = 0; n < 2; ++n) _Pragma("unroll") for (int k = 0; k < 2; ++k) dst[n][k] = *(const LAS bf16x8*)(lds + G8_SB(b, h) + boff + n * 2048 + k * 1024); } while (0)
#define G8_MMA(ai, bj, At, Bt) do { __builtin_amdgcn_s_setprio(1); _Pragma("unroll") for (int m = 0; m < 4; ++m) _Pragma("unroll") for (int n = 0; n < 2; ++n) _Pragma("unroll") for (int k = 0; k < 2; ++k) \
        acc[ai][bj][m][n] = __builtin_amdgcn_mfma_f32_16x16x32_bf16(Bt[n][k], At[m][k], acc[ai][bj][m][n], 0, 0, 0); __builtin_amdgcn_s_setprio(0); } while (0)
#define G8_WAIT_V(n) asm volatile("s_waitcnt vmcnt(" #n ")" ::: "memory")
#define G8_WAIT_L(n) asm volatile("s_waitcnt lgkmcnt(" #n ")" ::: "memory")
#define G8_BAR __builtin_amdgcn_s_barrier()
#define G8_SCHED __builtin_amdgcn_sched_barrier(0)
    bf16x8 At[4][2], B0[2][2], B1[2][2];
    const char* pA = uptr(s.A); const char* pB0 = uptr(s.B0); const char* pB1 = uptr(s.B1);
    constexpr int KS = BK * 2;
    const int nt0 = TWOSEG ? s.nt0 : 0; const char* qA = TWOSEG ? uptr(s.A2 - (size_t)nt0 * KS) : pA; const char* qB0 = TWOSEG ? uptr(s.B02 - (size_t)nt0 * KS) : pB0; const char* qB1 = TWOSEG ? uptr(s.B12 - (size_t)nt0 * KS) : pB1;
#define G8_TA(t) ((TWOSEG ? ((t) < nt0 ? pA : qA) : pA) + (size_t)(t) * KS)
#define G8_TB0(t) ((TWOSEG ? ((t) < nt0 ? pB0 : qB0) : pB0) + (size_t)(t) * KS)
#define G8_TB1(t) ((TWOSEG ? ((t) < nt0 ? pB1 : qB1) : pB1) + (size_t)(t) * KS)
#define G8_VA1 voffA[GATHER ? 1 : 0]
#define G8_H1(ptr) ((ptr) + (GATHER ? 0u : hstepA))
    G8_STAGE(G8_SB(0, 0), pB0, voffB); G8_STAGE(G8_SA(0, 0), pA, voffA[0]); G8_STAGE(G8_SB(0, 1), pB1, voffB); G8_STAGE(G8_SA(0, 1), G8_H1(pA), G8_VA1);
    if (wr == 1) G8_BAR;
    G8_WAIT_V(4); G8_BAR;
    G8_STAGE(G8_SB(1, 0), pB0 + KS, voffB); G8_STAGE(G8_SA(1, 0), pA + KS, voffA[0]); G8_STAGE(G8_SB(1, 1), pB1 + KS, voffB);
    G8_WAIT_V(6); G8_BAR;
    for (int t = 0; t < nt - 2; t += 2) {
        const char* a1 = G8_TA(t + 1);
        const char* a2 = G8_TA(t + 2); const char* b02 = G8_TB0(t + 2); const char* b12 = G8_TB1(t + 2);
        const char* a3 = G8_TA(t + 3); const char* b03 = G8_TB0(t + 3); const char* b13 = G8_TB1(t + 3);
        G8_LDB(B0, 0, 0); G8_SCHED; G8_LDA(At, 0, 0); G8_STAGE(G8_SA(1, 1), G8_H1(a1), G8_VA1);
        G8_WAIT_L(8); G8_BAR; G8_WAIT_L(0); G8_MMA(0, 0, At, B0); G8_BAR; G8_SCHED;
        G8_LDB(B1, 0, 1); G8_STAGE(G8_SB(0, 0), b02, voffB);
        G8_BAR; G8_WAIT_L(0); G8_MMA(0, 1, At, B1); G8_BAR;
        G8_LDA(At, 0, 1); G8_STAGE(G8_SA(0, 0), a2, voffA[0]);
        G8_BAR; G8_WAIT_L(0); G8_MMA(1, 0, At, B0); G8_BAR; G8_SCHED;
        G8_STAGE(G8_SB(0, 1), b12, voffB);
        G8_WAIT_V(6); G8_BAR; G8_MMA(1, 1, At, B1); G8_BAR;
        G8_LDB(B0, 1, 0); G8_SCHED; G8_LDA(At, 1, 0); G8_STAGE(G8_SA(0, 1), G8_H1(a2), G8_VA1);
        G8_WAIT_L(8); G8_BAR; G8_WAIT_L(0); G8_MMA(0, 0, At, B0); G8_BAR; G8_SCHED;
        G8_LDB(B1, 1, 1); G8_STAGE(G8_SB(1, 0), b03, voffB);
        G8_BAR; G8_WAIT_L(0); G8_MMA(0, 1, At, B1); G8_BAR;
        G8_LDA(At, 1, 1); G8_STAGE(G8_SA(1, 0), a3, voffA[0]);
        G8_BAR; G8_WAIT_L(0); G8_MMA(1, 0, At, B0); G8_BAR; G8_SCHED;
        G8_STAGE(G8_SB(1, 1), b13, voffB);
        G8_WAIT_V(6); G8_BAR; G8_MMA(1, 1, At, B1); G8_BAR;
    }
    { const char* a1 = G8_TA(nt - 1);
      G8_LDB(B0, 0, 0); G8_LDA(At, 0, 0); G8_STAGE(G8_SA(1, 1), G8_H1(a1), G8_VA1);
      G8_BAR; G8_WAIT_L(0); G8_MMA(0, 0, At, B0); G8_BAR;
      G8_LDB(B1, 0, 1); G8_BAR; G8_WAIT_L(0); G8_MMA(0, 1, At, B1); G8_BAR;
      G8_LDA(At, 0, 1); G8_WAIT_V(4); G8_BAR; G8_WAIT_L(0); G8_MMA(1, 0, At, B0); G8_MMA(1, 1, At, B1); G8_BAR; }
    { G8_LDB(B0, 1, 0); G8_LDA(At, 1, 0); G8_WAIT_V(2); G8_BAR; G8_WAIT_L(0); G8_MMA(0, 0, At, B0); G8_BAR;
      G8_LDB(B1, 1, 1); G8_WAIT_V(0); G8_BAR; G8_WAIT_L(0); G8_MMA(0, 1, At, B1); G8_BAR;
      G8_LDA(At, 1, 1); G8_BAR; G8_WAIT_L(0); G8_MMA(1, 0, At, B0); G8_MMA(1, 1, At, B1); G8_BAR; }
    if (wr == 0) G8_BAR;
#undef G8_TA
#undef G8_VA1
#undef G8_H1
#undef G8_TB0
#undef G8_TB1
#undef G8_SA
#undef G8_SB
#undef G8_STAGE
#undef G8_LDA
#undef G8_LDB
#undef G8_MMA
#undef G8_WAIT_V
#undef G8_WAIT_L
#undef G8_BAR
#undef G8_SCHED
}
template <bool GATHER, bool TWOSEG>
__device__ __forceinline__ void kstream(LAS unsigned char* lds, Acc& acc, const KSeg s, const KSeg nx, const bool first, const unsigned (&voffA)[2][2], const unsigned (&voffB)[2], const unsigned hstepA) {
    int tid = threadIdx.x; asm volatile("" : "+v"(tid));
    const int wid = __builtin_amdgcn_readfirstlane(tid >> 6), lane = tid & 63, wr = wid >> 2, wc = wid & 3, fr = lane & 15, fq = lane >> 4;
    const unsigned ldsw = (unsigned)wid * 1024u;
    const int aoff = lds_byte(wr * 64 + fr, fq * 8), boff = lds_byte(wc * 32 + fr, fq * 8);
    const int nt = __builtin_amdgcn_readfirstlane(s.nt);
#define G8_SA(b, h) (((b) * 2 + (h)) * HTB)
#define G8_SB(b, h) ((4 + (b) * 2 + (h)) * HTB)
#define G8_STAGE(bufoff, gbase, voff) do { _Pragma("unroll") for (int _i = 0; _i < 2; ++_i) \
        __builtin_amdgcn_global_load_lds((const unsigned*)((const char*)(gbase) + (voff)[_i]), (LAS unsigned*)(lds + (bufoff) + ldsw + _i * 8192), 16, 0, 0); } while (0)
#define G8_LDA(dst, b, h) do { _Pragma("unroll") for (int m = 0; m < 4; ++m) _Pragma("unroll") for (int k = 0; k < 2; ++k) dst[m][k] = *(const LAS bf16x8*)(lds + G8_SA(b, h) + aoff + m * 2048 + k * 1024); } while (0)
#define G8_LDB(dst, b, h) do { _Pragma("unroll") for (int n = 0; n < 2; ++n) _Pragma("unroll") for (int k = 0; k < 2; ++k) dst[n][k] = *(const LAS bf16x8*)(lds + G8_SB(b, h) + boff + n * 2048 + k * 1024); } while (0)
#define G8_MMA(ai, bj, At, Bt) do { __builtin_amdgcn_s_setprio(1); _Pragma("unroll") for (int m = 0; m < 4; ++m) _Pragma("unroll") for (int n = 0; n < 2; ++n) _Pragma("unroll") for (int k = 0; k < 2; ++k) \
        acc[ai][bj][m][n] = __builtin_amdgcn_mfma_f32_16x16x32_bf16(Bt[n][k], At[m][k], acc[ai][bj][m][n], 0, 0, 0); __builtin_amdgcn_s_setprio(0); } while (0)
#define G8_WAIT_V(n) asm volatile("s_waitcnt vmcnt(" #n ")" ::: "memory")
#define G8_WAIT_L(n) asm volatile("s_waitcnt lgkmcnt(" #n ")" ::: "memory")
#define G8_BAR __builtin_amdgcn_s_barrier()
#define G8_SCHED __builtin_amdgcn_sched_barrier(0)
    bf16x8 At[4][2], B0[2][2], B1[2][2];
    const char* pA = uptr(s.A); const char* pB0 = uptr(s.B0); const char* pB1 = uptr(s.B1);
    constexpr int KS = BK * 2;
    const int nt0 = TWOSEG ? s.nt0 : 0; const char* qA = TWOSEG ? uptr(s.A2 - (size_t)nt0 * KS) : pA; const char* qB0 = TWOSEG ? uptr(s.B02 - (size_t)nt0 * KS) : pB0; const char* qB1 = TWOSEG ? uptr(s.B12 - (size_t)nt0 * KS) : pB1;
    const char* nA = uptr(nx.A) - (size_t)nt * KS; const char* nB0 = uptr(nx.B0) - (size_t)nt * KS; const char* nB1 = uptr(nx.B1) - (size_t)nt * KS;
#define G8_TA(t) (((t) >= nt ? nA : (TWOSEG ? ((t) < nt0 ? pA : qA) : pA)) + (size_t)(t) * KS)
#define G8_TB0(t) (((t) >= nt ? nB0 : (TWOSEG ? ((t) < nt0 ? pB0 : qB0) : pB0)) + (size_t)(t) * KS)
#define G8_TB1(t) (((t) >= nt ? nB1 : (TWOSEG ? ((t) < nt0 ? pB1 : qB1) : pB1)) + (size_t)(t) * KS)
#define G8_VA1 voffA[GATHER ? 1 : 0]
#define G8_H1(ptr) ((ptr) + (GATHER ? 0u : hstepA))
    if (first) {
    G8_STAGE(G8_SB(0, 0), pB0, voffB); G8_STAGE(G8_SA(0, 0), pA, voffA[0]); G8_STAGE(G8_SB(0, 1), pB1, voffB); G8_STAGE(G8_SA(0, 1), G8_H1(pA), G8_VA1);
    if (wr == 1) G8_BAR;
    G8_WAIT_V(4); G8_BAR;
    G8_STAGE(G8_SB(1, 0), pB0 + KS, voffB); G8_STAGE(G8_SA(1, 0), pA + KS, voffA[0]); G8_STAGE(G8_SB(1, 1), pB1 + KS, voffB);
    G8_WAIT_V(6); G8_BAR;
    }
    for (int t = 0; t < nt; t += 2) {
        const char* a1 = G8_TA(t + 1);
        const char* a2 = G8_TA(t + 2); const char* b02 = G8_TB0(t + 2); const char* b12 = G8_TB1(t + 2);
        const char* a3 = G8_TA(t + 3); const char* b03 = G8_TB0(t + 3); const char* b13 = G8_TB1(t + 3);
        G8_LDB(B0, 0, 0); G8_SCHED; G8_LDA(At, 0, 0); G8_STAGE(G8_SA(1, 1), G8_H1(a1), G8_VA1);
        G8_WAIT_L(8); G8_BAR; G8_WAIT_L(0); G8_MMA(0, 0, At, B0); G8_BAR; G8_SCHED;
        G8_LDB(B1, 0, 1); G8_STAGE(G8_SB(0, 0), b02, voffB);
        G8_BAR; G8_WAIT_L(0); G8_MMA(0, 1, At, B1); G8_BAR;
        G8_LDA(At, 0, 1); G8_STAGE(G8_SA(0, 0), a2, voffA[0]);
        G8_BAR; G8_WAIT_L(0); G8_MMA(1, 0, At, B0); G8_BAR; G8_SCHED;
        G8_STAGE(G8_SB(0, 1), b12, voffB);
        G8_WAIT_V(6); G8_BAR; G8_MMA(1, 1, At, B1); G8_BAR;
        G8_LDB(B0, 1, 0); G8_SCHED; G8_LDA(At, 1, 0); G8_STAGE(G8_SA(0, 1), G8_H1(a2), G8_VA1);
        G8_WAIT_L(8); G8_BAR; G8_WAIT_L(0); G8_MMA(0, 0, At, B0); G8_BAR; G8_SCHED;
        G8_LDB(B1, 1, 1); G8_STAGE(G8_SB(1, 0), b03, voffB);
        G8_BAR; G8_WAIT_L(0); G8_MMA(0, 1, At, B1); G8_BAR;
        G8_LDA(At, 1, 1); G8_STAGE(G8_SA(1, 0), a3, voffA[0]);
        G8_BAR; G8_WAIT_L(0); G8_MMA(1, 0, At, B0); G8_BAR; G8_SCHED;
        G8_STAGE(G8_SB(1, 1), b13, voffB);
        G8_WAIT_V(6); G8_BAR; G8_MMA(1, 1, At, B1); G8_BAR;
    }
#undef G8_TA
#undef G8_VA1
#undef G8_H1
#undef G8_TB0
#undef G8_TB1
#undef G8_SA
#undef G8_SB
#undef G8_STAGE
#undef G8_LDA
#undef G8_LDB
#undef G8_MMA
#undef G8_WAIT_V
#undef G8_WAIT_L
#undef G8_BAR
#undef G8_SCHED
}
__device__ __forceinline__ void kstream_end() { asm volatile("s_waitcnt vmcnt(0)" ::: "memory"); __builtin_amdgcn_s_barrier(); }
__device__ __forceinline__ void zero_acc(Acc& acc) {
#pragma unroll
    for (int a = 0; a < 2; ++a)
#pragma unroll
        for (int b = 0; b < 2; ++b)
#pragma unroll
            for (int m = 0; m < 4; ++m)
#pragma unroll
                for (int n = 0; n < 2; ++n) acc[a][b][m][n] = (f32x4){0.f, 0.f, 0.f, 0.f};
}
__device__ __forceinline__ void make_voff_contig(unsigned (&voffA)[2][2], unsigned pitchA) {
    int tid = threadIdx.x; asm volatile("" : "+v"(tid));
#pragma unroll
    for (int i = 0; i < 2; ++i) { int R, C; stage_rc(tid * 16 + i * 8192, R, C);
        voffA[0][i] = (unsigned)R * pitchA + (unsigned)C * 2u; voffA[1][i] = 0u; }
}
__device__ __forceinline__ void make_voffB(unsigned (&voffB)[2], unsigned pitchB, bool perm) {
    int tid = threadIdx.x; asm volatile("" : "+v"(tid));
#pragma unroll
    for (int i = 0; i < 2; ++i) { int R, C; stage_rc(tid * 16 + i * 8192, R, C); const int Rb = perm ? ((R & ~31) + perm32(R & 31)) : R;
        voffB[i] = (unsigned)Rb * pitchB + (unsigned)C * 2u; }
}
}

__device__ __forceinline__ bool unit_order(int i, int G, int c, int nM, int nN, int& pm, int& pn) {
    const int nwg = nM * nN; const long L = (long)i * G + c; if (L >= nwg) return false;
    int wgid = (int)L; { const int q = nwg / 8, r = nwg % 8, xcd = wgid % 8, off = wgid / 8; wgid = (xcd < r ? xcd * (q + 1) : r * (q + 1) + (xcd - r) * q) + off; }
    const int WGM = 8, nig = WGM * nN, gid = wgid / nig, fm = gid * WGM, gsz = (nM - fm) < WGM ? (nM - fm) : WGM;
    pm = fm + ((wgid % nig) % gsz); pn = (wgid % nig) / gsz; return true;
}

__device__ __forceinline__ void conv_small_weights(const Params& p, LAS unsigned char* lds) {
    const int tid = otid(), lane = tid & 63, wave = tid >> 6, gw = obid() * NWAVES + wave, NGW = gridDim.x * NWAVES;
    LAS float* scr = (LAS float*)(lds + wave * 16384);
    constexpr int I_IN = 16 * (NIN / 32), I_A = 8 * 32, I_O = 16 * 32, I_L = 64, PER = I_IN + 2 * I_A + I_O + I_L;
    for (int it = gw; it < DEPTH * PER; it += NGW) {
        const int l = it / PER; int r = it % PER;
        unsigned char* wl = p.ws + WS_WSMALL + (size_t)l * WSMALL_LAYER;
        if (r < I_IN) { const int kb = r / (NIN / 32), nb = r % (NIN / 32), n0 = nb * 32, k0 = kb * 64;
            int col0, nvalid; if (n0 < UA) { col0 = n0; nvalid = A_COLS - n0; nvalid = nvalid < 0 ? 0 : (nvalid > 32 ? 32 : nvalid); } else { col0 = n0 - (UA - A_COLS); nvalid = 32; }
            transpose_item(p.in[I_WIN] + (size_t)l * D * IN_COLS + (size_t)k0 * IN_COLS, IN_COLS, col0, nvalid, (bf16_t*)wl + (size_t)n0 * D + k0, D, scr, lane); continue; }
        r -= I_IN;
        if (r < 2 * I_A) { const int which = r / I_A; r %= I_A; const int kb = r / 32, nb = r % 32;
            const float* src = p.in[which ? I_WBB : I_WBA] + (size_t)l * 512 * D + (size_t)(kb * 64) * D;
            transpose_item(src, D, nb * 32, 32, (bf16_t*)(wl + (10 + which) * MiB) + (size_t)(nb * 32) * 512 + kb * 64, 512, scr, lane); continue; }
        r -= 2 * I_A;
        if (r < I_O) { const int kb = r / 32, nb = r % 32;
          transpose_item(p.in[I_WOUT] + (size_t)l * D * D + (size_t)(kb * 64) * D, D, nb * 32, 32, (bf16_t*)(wl + 12 * MiB) + (size_t)(nb * 32) * D + kb * 64, D, scr, lane); continue; }
        r -= I_O;
        { bf16_t* lo = (bf16_t*)(p.ws + 65536 + (size_t)l * 262144);
          if (r < 16) transpose_item(p.in[I_WUP] + (size_t)l * 64 * 512, 512, r * 32, 32, lo + (size_t)(r * 32) * 64, 64, scr, lane);
          else if (r < 32) transpose_item(p.in[I_AUP] + (size_t)l * 64 * 512, 512, (r - 16) * 32, 32, lo + 32768 + (size_t)((r - 16) * 32) * 64, 64, scr, lane);
          else { const int q = r - 32, kb = q >> 4, nb = q & 15; transpose_item(p.in[I_GUP] + (size_t)l * 128 * 512 + (size_t)(kb * 64) * 512, 512, nb * 32, 32, lo + 65536 + (size_t)(nb * 32) * 128 + kb * 64, 128, scr, lane); } }
    }
}
__device__ __forceinline__ void conv_expert_items(const Params& p, int l, LAS unsigned char* lds, int it0, int it1) {
    const int tid = otid(), lane = tid & 63, wave = tid >> 6, gw = it0 + wave, NGW = NWAVES;
    LAS float* scr = (LAS float*)(lds + wave * 16384);
    constexpr int I_13 = 16 * 32, I_2 = 8 * 32, PER = I_13 + I_2;
    for (int it = gw; it < it1; it += NGW) {
        const int e = it / PER; int r = it % PER;
        if (r < I_13) { const int kb = r / 32, nb = r % 32, n0 = nb * 32, j = n0 >> 8, half = (n0 >> 7) & 1, c = 128 * j + (n0 & 127);
            const float* src = p.in[half ? I_WEXP3 : I_WEXP1] + (size_t)(l * 16 + e) * D * 512 + (size_t)(kb * 64) * 512;
            transpose_item(src, 512, c, 32, (bf16_t*)(p.ws + WS_WEXP) + (size_t)e * 1024 * 1024 + (size_t)n0 * 1024 + kb * 64, 1024, scr, lane); continue; }
        r -= I_13;
        { const int kb = r / 32, nb = r % 32;
          const float* src = p.in[I_WEXP2] + (size_t)(l * 16 + e) * 512 * D + (size_t)(kb * 64) * D;
          transpose_item(src, D, nb * 32, 32, (bf16_t*)(p.ws + WS_WEXP + 32 * MiB) + (size_t)e * 1024 * 512 + (size_t)(nb * 32) * 512 + kb * 64, 512, scr, lane); }
    }
}

__device__ __forceinline__ void ln_wave(f32x4 (&v)[4], const float* g, const float* bta, int lane) {
    float s = 0.f;
#pragma unroll
    for (int j = 0; j < 4; ++j) s += (v[j][0] + v[j][1]) + (v[j][2] + v[j][3]);
    const float mean = wave_sum(s) * (1.f / D); float s2 = 0.f;
#pragma unroll
    for (int j = 0; j < 4; ++j) { v[j] = v[j] - mean; s2 += (v[j][0] * v[j][0] + v[j][1] * v[j][1]) + (v[j][2] * v[j][2] + v[j][3] * v[j][3]); }
    const float rstd = 1.f / sqrtf(wave_sum(s2) * (1.f / D) + LN_EPS);
#pragma unroll
    for (int j = 0; j < 4; ++j) { const f32x4 gg = *(const f32x4*)(g + 4 * lane + 256 * j), bb = *(const f32x4*)(bta + 4 * lane + 256 * j); v[j] = v[j] * rstd * gg + bb; }
}
__device__ __forceinline__ void store_row(const Params& p, int r, const f32x4 (&v)[4], int lane, bool zero) {
    float* hr = hrow(p, r); bf16_t* hb = (bf16_t*)(p.ws + WS_HB) + (size_t)r * D;
#pragma unroll
    for (int j = 0; j < 4; ++j) { const f32x4 o = zero ? (f32x4){0.f, 0.f, 0.f, 0.f} : v[j];
        *(f32x4*)(hr + 4 * lane + 256 * j) = o; u32x2 w; w.x = pk2(o[0], o[1]); w.y = pk2(o[2], o[3]); *(u32x2*)(hb + 4 * lane + 256 * j) = w; }
}
__device__ __forceinline__ void ln_in_phase(const Params& p) {
    const int tid = otid(), lane = tid & 63, gw = obid() * NWAVES + (tid >> 6), NGW = gridDim.x * NWAVES;
    for (int r = gw; r < T; r += NGW) {
        const int b = r / LP, pos = r - b * LP; f32x4 v[4];
        if (pos < PADM) {
#pragma unroll
            for (int j = 0; j < 4; ++j) v[j] = (f32x4){0.f, 0.f, 0.f, 0.f};
            store_row(p, r, v, lane, true); continue; }
        const float* src = pos < 64 ? p.in[I_META] + (size_t)(pos - PADM) * D : p.in[I_X] + ((size_t)(b * SEQ + pos - 64) << 10);
#pragma unroll
        for (int j = 0; j < 4; ++j) v[j] = *(const f32x4*)(src + 4 * lane + 256 * j);
        ln_wave(v, p.in[I_LNIN_G], p.in[I_LNIN_B], lane);
        store_row(p, r, v, lane, false);
    }
}

__device__ __forceinline__ const Params& PP() { const Params* q = (const Params*)__builtin_amdgcn_kernarg_segment_ptr(); asm volatile("" : "+s"(q)); return *q; }

#define EPI_COORDS() int tid_ = threadIdx.x; asm volatile("" : "+v"(tid_)); const int wid = tid_ >> 6, lane = tid_ & 63, wr = wid >> 2, wc = wid & 3, fr = lane & 15, fq = lane >> 4; (void)wr; (void)wc; (void)fr; (void)fq
__device__ __forceinline__ void inproj_epi(const g8::Acc& acc, int l, int pm, int pn) {
    EPI_COORDS();
    const int row0 = pm * 256 + wr * 64 + fr;
    if (pn < 12) {
        bf16_t* O = (bf16_t*)(PP().ws + WS_UAR);
#pragma unroll
        for (int ai = 0; ai < 2; ++ai)
#pragma unroll
            for (int m = 0; m < 4; ++m) { asm volatile("" ::: "memory"); bf16_t* rp = O + (size_t)(row0 + ai * 128 + m * 16) * UARW + pn * 256 + wc * 32 + 8 * fq;
#pragma unroll
                for (int bj = 0; bj < 2; ++bj) { const f32x4 v0 = acc[ai][bj][m][0], v1 = acc[ai][bj][m][1]; u32x4 w; w.x = pk2(v0[0], v0[1]); w.y = pk2(v0[2], v0[3]); w.z = pk2(v1[0], v1[1]); w.w = pk2(v1[2], v1[3]);
                    *(u32x4*)(rp + bj * 128) = w; } }
    } else {
        bf16_t* O = (bf16_t*)(PP().ws + WS_GATES); const int colb = (pn - 12) * 256 + wc * 32 + 8 * fq; const float* bg = PP().in[I_BGATE] + l * 2048;
        f32x4 bv[2][2];
#pragma unroll
        for (int bj = 0; bj < 2; ++bj) { bv[bj][0] = *(const f32x4*)(bg + colb + bj * 128); bv[bj][1] = *(const f32x4*)(bg + colb + bj * 128 + 4); }
#pragma unroll
        for (int ai = 0; ai < 2; ++ai)
#pragma unroll
            for (int m = 0; m < 4; ++m) { asm volatile("" ::: "memory"); bf16_t* rp = O + (size_t)(row0 + ai * 128 + m * 16) * 2048 + colb;
#pragma unroll
                for (int bj = 0; bj < 2; ++bj) { f32x4 v0 = acc[ai][bj][m][0] + bv[bj][0], v1 = acc[ai][bj][m][1] + bv[bj][1];
#pragma unroll
                    for (int e = 0; e < 4; ++e) { v0[e] = sigmoidf_(v0[e]); v1[e] = sigmoidf_(v1[e]); }
                    u32x4 w; w.x = pk2(v0[0], v0[1]); w.y = pk2(v0[2], v0[3]); w.z = pk2(v1[0], v1[1]); w.w = pk2(v1[2], v1[3]);
                    *(u32x4*)(rp + bj * 128) = w; } }
    }
}
constexpr int INP_MAIN = 62 * 20 + 3 * 12, INP_TAIL = 24;
__device__ __forceinline__ bool inproj_order(int i, int G, int c, int& pm, int& pn) {
    const long L = (long)i * G + c; if (L >= INP_MAIN) return false;
    if (L < 62 * 20) return unit_order(i, G, c, 62, 20, pm, pn);
    const int r = (int)L - 62 * 20; pm = 62 + r / 12; pn = r % 12; return true;
}
__device__ __forceinline__ void inproj_phase(const Params& p, int l, LAS unsigned char* lds) {
    unsigned voffA[2][2], voffB[2]; g8::make_voff_contig(voffA, D * 2); g8::make_voffB(voffB, D * 2, true);
    int pm, pn, pm2 = 0, pn2 = 0; const int bid = obid(); const int wr_ = __builtin_amdgcn_readfirstlane(otid() >> 6) >> 2;
    bool has = inproj_order(0, gridDim.x, bid, pm, pn), first = true;
    g8::Acc acc; g8::zero_acc(acc);
    for (int i = 0; has; ++i) {
        const bool hasn = inproj_order(i + 1, gridDim.x, bid, pm2, pn2);
        const char* Ab = (const char*)(PP().ws + WS_HB); const char* Bb = (const char*)(PP().ws + WS_WSMALL + (size_t)l * WSMALL_LAYER);
        const g8::KSeg s = g8::seg1(Ab + (size_t)pm * 256 * D * 2, Bb + (size_t)pn * 256 * D * 2, Bb + (size_t)(pn * 256 + 128) * D * 2, D / 64);
        const int pmn = hasn ? pm2 : pm, pnn = hasn ? pn2 : pn;
        const g8::KSeg nx = g8::seg1(Ab + (size_t)pmn * 256 * D * 2, Bb + (size_t)pnn * 256 * D * 2, Bb + (size_t)(pnn * 256 + 128) * D * 2, D / 64);
        if (!first && wr_ == 1) __builtin_amdgcn_s_barrier();
        g8::kstream<false, false>(lds, acc, s, nx, first, voffA, voffB, 128 * D * 2); first = false;
        if (wr_ == 0) __builtin_amdgcn_s_barrier();
        inproj_epi(acc, l, pm, pn);
        g8::zero_acc(acc); has = hasn; pm = pm2; pn = pn2;
    }
    if (!first) g8::kstream_end();
}
__device__ __forceinline__ void inproj_tail_unit(int l, LAS unsigned char* lds, int g) {
    unsigned voffA[2][2], voffB[2]; g8::make_voff_contig(voffA, D * 2); g8::make_voffB(voffB, D * 2, true);
    const int pm = 62 + (g >> 3), pn = 12 + (g & 7);
    g8::Acc acc; g8::zero_acc(acc);
    const char* Ab = (const char*)(PP().ws + WS_HB); const char* Bb = (const char*)(PP().ws + WS_WSMALL + (size_t)l * WSMALL_LAYER);
    const g8::KSeg s = g8::seg1(Ab + (size_t)pm * 256 * D * 2, Bb + (size_t)pn * 256 * D * 2, Bb + (size_t)(pn * 256 + 128) * D * 2, D / 64);
    g8::kloop<false, false>(lds, acc, s, voffA, voffB, 128 * D * 2);
    inproj_epi(acc, l, pm, pn);
}
__device__ __forceinline__ void merge_unit(int l, LAS unsigned char* lds, int pm, int pn) {
    unsigned voffA[2][2], voffB[2]; g8::make_voff_contig(voffA, D * 2); g8::make_voffB(voffB, 512 * 2, true);
    {
        const int wr_ = __builtin_amdgcn_readfirstlane(otid() >> 6) >> 2;
        g8::Acc acc; g8::zero_acc(acc);
#pragma unroll 1
        for (int br = 0; br < 2; ++br) {
            const char* Bt = (const char*)(PP().ws + WS_WSMALL + (size_t)l * WSMALL_LAYER) + (10 + br) * MiB + (size_t)pn * 256 * 512 * 2;
            const char* Bn = (const char*)(PP().ws + WS_WSMALL + (size_t)l * WSMALL_LAYER) + 11 * MiB + (size_t)pn * 256 * 512 * 2;
            const g8::KSeg s = g8::seg1((const char*)(PP().ws + WS_OAB) + (size_t)pm * 256 * D * 2 + br * 1024, Bt, Bt + (size_t)128 * 512 * 2, 8);
            const g8::KSeg nx = g8::seg1((const char*)(PP().ws + WS_OAB) + (size_t)pm * 256 * D * 2 + 1024, Bn, Bn + (size_t)128 * 512 * 2, 8);
            if (br && wr_ == 1) __builtin_amdgcn_s_barrier();
            g8::kstream<false, false>(lds, acc, s, nx, br == 0, voffA, voffB, 128 * D * 2);
            if (wr_ == 0) __builtin_amdgcn_s_barrier();
            EPI_COORDS();
            const bf16_t* GT = (const bf16_t*)(PP().ws + WS_GATES); bf16_t* O = (bf16_t*)(PP().ws + WS_MERGED);
            const int row0 = pm * 256 + wr * 64 + fr, colb = pn * 256 + wc * 32 + 8 * fq;
#pragma unroll
            for (int ai = 0; ai < 2; ++ai) { asm volatile("" ::: "memory");
                u32x4 gq[4][2], pq[4][2];
#pragma unroll
                for (int m = 0; m < 4; ++m) { const size_t ro = (size_t)(row0 + ai * 128 + m * 16); const bf16_t* gp = GT + ro * 2048 + br * 1024 + colb; const bf16_t* op = O + ro * D + colb;
#pragma unroll
                    for (int bj = 0; bj < 2; ++bj) { gq[m][bj] = *(const u32x4*)(gp + bj * 128); pq[m][bj] = br ? *(const u32x4*)(op + bj * 128) : (u32x4){0u, 0u, 0u, 0u}; } }
#pragma unroll
                for (int m = 0; m < 4; ++m) { const size_t ro = (size_t)(row0 + ai * 128 + m * 16); bf16_t* op = O + ro * D + colb;
#pragma unroll
                    for (int bj = 0; bj < 2; ++bj) { const u32x4 g = gq[m][bj], pr = pq[m][bj]; const f32x4 v0 = acc[ai][bj][m][0], v1 = acc[ai][bj][m][1];
                        u32x4 w; w.x = pk2(v0[0] * bflo(g.x) + bflo(pr.x), v0[1] * bfhi(g.x) + bfhi(pr.x)); w.y = pk2(v0[2] * bflo(g.y) + bflo(pr.y), v0[3] * bfhi(g.y) + bfhi(pr.y));
                        w.z = pk2(v1[0] * bflo(g.z) + bflo(pr.z), v1[1] * bfhi(g.z) + bfhi(pr.z)); w.w = pk2(v1[2] * bflo(g.w) + bflo(pr.w), v1[3] * bfhi(g.w) + bfhi(pr.w));
                        *(u32x4*)(op + bj * 128) = w; } } }
            g8::zero_acc(acc);
        }
        g8::kstream_end();
    }
}
__device__ __forceinline__ void wout_unit(int l, LAS unsigned char* lds, int pm, int pn) {
    unsigned voffA[2][2], voffB[2]; g8::make_voff_contig(voffA, D * 2); g8::make_voffB(voffB, D * 2, false);
    g8::Acc acc; g8::zero_acc(acc);
    const char* Ab = (const char*)(PP().ws + WS_MERGED); const char* Bb = (const char*)(PP().ws + WS_WSMALL + (size_t)l * WSMALL_LAYER + 12 * MiB);
    const g8::KSeg s = g8::seg1(Ab + (size_t)pm * 256 * D * 2, Bb + (size_t)pn * 256 * D * 2, Bb + (size_t)(pn * 256 + 128) * D * 2, D / 64);
    g8::kloop<false, false>(lds, acc, s, voffA, voffB, 128 * D * 2);
    EPI_COORDS();
    const int row0 = pm * 256 + wr * 64 + fr, col0 = pn * 256 + wc * 32 + 4 * fq;
#pragma unroll
    for (int ai = 0; ai < 2; ++ai) { asm volatile("" ::: "memory");
        f32x4 pre[4][2][2]; float* hr[4];
#pragma unroll
        for (int m = 0; m < 4; ++m) { hr[m] = hrow(PP(), row0 + ai * 128 + m * 16) + col0;
#pragma unroll
            for (int bj = 0; bj < 2; ++bj)
#pragma unroll
                for (int n = 0; n < 2; ++n) pre[m][bj][n] = *(const f32x4*)(hr[m] + bj * 128 + n * 16); }
#pragma unroll
        for (int m = 0; m < 4; ++m)
#pragma unroll
            for (int bj = 0; bj < 2; ++bj)
#pragma unroll
                for (int n = 0; n < 2; ++n) *(f32x4*)(hr[m] + bj * 128 + n * 16) = pre[m][bj][n] * ALPHA + acc[ai][bj][m][n]; }
}
__device__ __forceinline__ unsigned score_key(float s) { s += 0.0f; const unsigned u = __builtin_bit_cast(unsigned, s); return (u & 0x80000000u) ? ~u : (u | 0x80000000u); }
__device__ void attn_naive_query(const Params& p, int row, unsigned char* wl, int lane) {
    const bf16_t* U = (const bf16_t*)(p.ws + WS_UAR);
    bf16_t* OA = (bf16_t*)(p.ws + WS_OAB) + (size_t)row * D;
    const int b = row / LP, pos = row - b * LP;
    if (pos < PADM) {
#pragma unroll
        for (int j = 0; j < 8; ++j) OA[j * 64 + lane] = 0;
        return;
    }
    const int nadm = 64 * ((pos >> 6) + 1) - PADM;
    unsigned* keys = (unsigned*)wl; float* p_s = (float*)wl;
    float* qi_s = (float*)(wl + 16640); float* q_s = qi_s + 256; float* w_s = q_s + 512; unsigned short* sel_s = (unsigned short*)(w_s + 16);
    const bf16_t* urow = U + (size_t)row * UARW;
    for (int i = lane; i < 256; i += 64) qi_s[i] = bf2f(urow[C_QI + i]);
    for (int i = lane; i < 512; i += 64) q_s[i] = bf2f(urow[C_Q + i]);
    if (lane < 8) w_s[lane] = bf2f(urow[C_WI + lane]);
    __builtin_amdgcn_fence(__ATOMIC_RELEASE, "wavefront"); __builtin_amdgcn_wave_barrier(); __builtin_amdgcn_fence(__ATOMIC_ACQUIRE, "wavefront");
    const int nj = (nadm + 63) >> 6;
    for (int j = 0; j < nj; ++j) {
        const int ki_idx = lane + 64 * j; unsigned key = 0u;
        if (ki_idx < nadm) {
            const u32x4* kp = (const u32x4*)(U + (size_t)(b * LP + PADM + ki_idx) * UARW + C_KI);
            float kf[32];
#pragma unroll
            for (int c4 = 0; c4 < 4; ++c4) { const u32x4 w = kp[c4];
                kf[c4 * 8 + 0] = bflo(w.x); kf[c4 * 8 + 1] = bfhi(w.x); kf[c4 * 8 + 2] = bflo(w.y); kf[c4 * 8 + 3] = bfhi(w.y);
                kf[c4 * 8 + 4] = bflo(w.z); kf[c4 * 8 + 5] = bfhi(w.z); kf[c4 * 8 + 6] = bflo(w.w); kf[c4 * 8 + 7] = bfhi(w.w); }
            float sc = 0.f;
#pragma unroll 1
            for (int h = 0; h < 8; ++h) { float d = 0.f; asm volatile("" ::: "memory");
#pragma unroll
                for (int e = 0; e < 32; ++e) d = fmaf(qi_s[h * 32 + e], kf[e], d);
                sc = fmaf(w_s[h], fmaxf(d, 0.f), sc); }
            key = score_key(sc); if (key == 0u) key = 1u;
        }
        keys[ki_idx] = key;
    }
    __builtin_amdgcn_fence(__ATOMIC_RELEASE, "wavefront"); __builtin_amdgcn_wave_barrier(); __builtin_amdgcn_fence(__ATOMIC_ACQUIRE, "wavefront");
    unsigned thr = 0u; int need_ties = 0x7fffffff;
    if (nadm > 256) {
        unsigned prefix = 0u; int remaining = 256;
        for (int bit = 31; bit >= 0; --bit) {
            const unsigned cand = prefix | (1u << bit); int cnt = 0;
            for (int j = 0; j < nj; ++j) { const unsigned k = keys[lane + 64 * j]; cnt += __builtin_popcountll(__ballot((k >> bit) == (cand >> bit))); }
            if (cnt >= remaining) prefix = cand; else remaining -= cnt;
        }
        thr = prefix; need_ties = remaining;
    } else thr = 1u;
    int nsel = 0, ties_seen = 0;
    for (int j = 0; j < nj; ++j) {
        const unsigned k = keys[lane + 64 * j];
        const unsigned long long tm = __ballot(k == thr && k != 0u);
        const unsigned long long lt = (1ull << lane) - 1ull;
        const int myrank = ties_seen + __builtin_popcountll(tm & lt);
        const bool selme = (k > thr) || (k == thr && k != 0u && myrank < need_ties);
        const unsigned long long sm = __ballot(selme);
        if (selme) sel_s[nsel + __builtin_popcountll(sm & lt)] = (unsigned short)(PADM + lane + 64 * j);
        nsel += __builtin_popcountll(sm); ties_seen += __builtin_popcountll(tm);
    }
    __builtin_amdgcn_fence(__ATOMIC_RELEASE, "wavefront"); __builtin_amdgcn_wave_barrier(); __builtin_amdgcn_fence(__ATOMIC_ACQUIRE, "wavefront");
    float sc[4][8];
#pragma unroll
    for (int m = 0; m < 4; ++m) {
        asm volatile("" ::: "memory");
        const int i = lane + 64 * m; const bool valid = i < nsel; const int ps = valid ? sel_s[i] : PADM;
        const bf16_t* krow = U + (size_t)(b * LP + ps) * UARW + C_K;
#pragma unroll
        for (int n = 0; n < 2; ++n) {
            float a0 = 0.f, a1 = 0.f, a2 = 0.f, a3 = 0.f;
#pragma unroll 1
            for (int c8 = 0; c8 < 8; ++c8) { asm volatile("" ::: "memory"); const u32x4 w = *(const u32x4*)(krow + n * 64 + c8 * 8);
                float kf[8] = {bflo(w.x), bfhi(w.x), bflo(w.y), bfhi(w.y), bflo(w.z), bfhi(w.z), bflo(w.w), bfhi(w.w)};
#pragma unroll
                for (int e = 0; e < 8; ++e) { const int dd = c8 * 8 + e;
                    a0 = fmaf(q_s[(n * 4 + 0) * 64 + dd], kf[e], a0); a1 = fmaf(q_s[(n * 4 + 1) * 64 + dd], kf[e], a1);
                    a2 = fmaf(q_s[(n * 4 + 2) * 64 + dd], kf[e], a2); a3 = fmaf(q_s[(n * 4 + 3) * 64 + dd], kf[e], a3); } }
            sc[m][n * 4 + 0] = valid ? a0 * 0.125f : -INFINITY; sc[m][n * 4 + 1] = valid ? a1 * 0.125f : -INFINITY;
            sc[m][n * 4 + 2] = valid ? a2 * 0.125f : -INFINITY; sc[m][n * 4 + 3] = valid ? a3 * 0.125f : -INFINITY;
        }
    }
    __builtin_amdgcn_wave_barrier();
    float linv[8];
#pragma unroll
    for (int h = 0; h < 8; ++h) {
        const float mx = wave_max(fmaxf(fmaxf(sc[0][h], sc[1][h]), fmaxf(sc[2][h], sc[3][h]))); float s = 0.f;
#pragma unroll
        for (int m = 0; m < 4; ++m) { const float e = __expf(sc[m][h] - mx); sc[m][h] = e; s += e; }
        linv[h] = 1.0f / wave_sum(s);
    }
#pragma unroll
    for (int m = 0; m < 4; ++m) { const int i = lane + 64 * m;
#pragma unroll
        for (int h = 0; h < 8; ++h) p_s[i * 8 + h] = sc[m][h]; }
    __builtin_amdgcn_fence(__ATOMIC_RELEASE, "wavefront"); __builtin_amdgcn_wave_barrier(); __builtin_amdgcn_fence(__ATOMIC_ACQUIRE, "wavefront");
    float o[8] = {0.f, 0.f, 0.f, 0.f, 0.f, 0.f, 0.f, 0.f};
    for (int i = 0; i < nsel; ++i) {
        const int ps = sel_s[i]; const bf16_t* vrow = U + (size_t)(b * LP + ps) * UARW + C_V;
        const float v0 = bf2f(vrow[lane]), v1 = bf2f(vrow[64 + lane]);
        const f32x4 pa = *(const f32x4*)(p_s + i * 8), pb = *(const f32x4*)(p_s + i * 8 + 4);
        o[0] = fmaf(pa[0], v0, o[0]); o[1] = fmaf(pa[1], v0, o[1]); o[2] = fmaf(pa[2], v0, o[2]); o[3] = fmaf(pa[3], v0, o[3]);
        o[4] = fmaf(pb[0], v1, o[4]); o[5] = fmaf(pb[1], v1, o[5]); o[6] = fmaf(pb[2], v1, o[6]); o[7] = fmaf(pb[3], v1, o[7]);
    }
#pragma unroll
    for (int h = 0; h < 8; ++h) OA[h * 64 + lane] = (bf16_t)f2bf(o[h] * linv[h]);
    __builtin_amdgcn_wave_barrier();
}


__device__ __forceinline__ f32x4 mfma16(bf16x8 a, bf16x8 b, f32x4 c) { return __builtin_amdgcn_mfma_f32_16x16x32_bf16(a, b, c, 0, 0, 0); }
#ifndef PROBE_PHASE
#define PROBE_PHASE -1
#endif
#define PROBE_BLOCK 0
#define LDS_BARRIER() do { asm volatile("s_waitcnt lgkmcnt(0)" ::: "memory"); __builtin_amdgcn_s_barrier(); asm volatile("" ::: "memory"); } while (0)

typedef float f32x16 __attribute__((ext_vector_type(16)));
typedef short s16x4 __attribute__((ext_vector_type(4)));
constexpr int AT_HIST = 0;
constexpr int AT_MASK = 20480;
constexpr int AT_QST = AT_MASK + 16640;
constexpr int AT_KV = 37120;
constexpr int AT_UNIT = AT_KV + 32768;
constexpr int AT_KL = AT_KV;
constexpr int AT_KL_BYTES = LDS_BYTES - 16 - AT_KL;
static_assert(4128 * 12 * 2 <= AT_KL_BYTES, "selection keys fit with 12 queries per sub-pass");
constexpr int CW_R1Q = 48;
constexpr int CW_ATT = 32;
__device__ __forceinline__ int img_off(int row, int ch) { return 2048 * (row >> 3) + 512 * (ch >> 2) + 64 * (row & 7) + 16 * ((ch & 3) ^ ((row >> 2) & 3)); }
__device__ __forceinline__ unsigned comp_key(float sc, int pos) { return (score_key(sc) & 0xFFFFE000u) | (unsigned)(0x1FFF - pos); }

__device__ __forceinline__ void attn_unit(const Params& p, unsigned char* lds, int b, int qt, unsigned long long& pacc) {
    unsigned long long pt0 = 0; if (PROBE_PHASE == 40 || PROBE_PHASE == 42) pt0 = __builtin_amdgcn_s_memrealtime();
    const int tid = otid(), wave = tid >> 6, lane = tid & 63, r = lane & 31, hh = lane >> 5;
    const bf16_t* U = (const bf16_t*)(p.ws + WS_UAR);
    LAS unsigned char* L = (LAS unsigned char*)lds;
    LAS unsigned* hist = (LAS unsigned*)(L + AT_HIST); LAS unsigned* maskw = (LAS unsigned*)(L + AT_MASK);
    const int c = qt >> 1, nkt = 2 * c + 1, nadm = 64 * (c + 1) - PADM;
    const size_t qrow = (size_t)(b * LP + 32 * qt + r);
    if (nadm > 256) {
        LAS unsigned short* KL = (LAS unsigned short*)(L + AT_KL);
        LAS unsigned* h8 = (LAS unsigned*)(L + AT_HIST);
        LAS unsigned* segc = h8 + 4096;
        LAS unsigned* st = segc + 512;
        const int NK = 32 * nkt, c15 = lane & 15, g4 = lane >> 4;
        const int qs = NK * 32 <= AT_KL_BYTES ? 16 : 12;
        for (int i = tid; i < (nkt + 1) * 32; i += NTHREADS) maskw[i] = 0u;
#pragma unroll 1
        for (int qbase = 0; qbase < 32; qbase += qs) {
            const int qn = 32 - qbase < qs ? 32 - qbase : qs; const bool qact = c15 < qn;
            bf16x8 qf[8]; float wq[8];
            { const bf16_t* qp = U + (size_t)(b * LP + 32 * qt + qbase + (qact ? c15 : 0)) * UARW;
#pragma unroll
              for (int h = 0; h < 8; ++h) qf[h] = *(const bf16x8*)(qp + C_QI + h * 32 + 8 * g4);
              const u32x4 w = *(const u32x4*)(qp + C_WI);
              wq[0] = bflo(w.x); wq[1] = bfhi(w.x); wq[2] = bflo(w.y); wq[3] = bfhi(w.y); wq[4] = bflo(w.z); wq[5] = bfhi(w.z); wq[6] = bflo(w.w); wq[7] = bfhi(w.w); }
#pragma unroll
            for (int h = 0; h < 8; ++h) asm volatile("" : "+v"(qf[h]), "+v"(wq[h]));
            for (int i = tid; i < 4096 + 512; i += NTHREADS) h8[i] = 0u;
            LDS_BARRIER();
            {
                const int ng = 2 * nkt; int j = wave;
                const bf16_t* kb = U + (size_t)(b * LP + 32 + c15) * UARW + C_KI + 8 * g4;
                bf16x8 a = *(const bf16x8*)(kb + (size_t)(16 * (j < ng ? j : 0)) * UARW), an = *(const bf16x8*)(kb + (size_t)(16 * (j + NWAVES < ng ? j + NWAVES : 0)) * UARW);
#pragma unroll 1
                for (; j < ng; j += NWAVES) {
                    const bf16x8 a2 = *(const bf16x8*)(kb + (size_t)(16 * (j + 2 * NWAVES < ng ? j + 2 * NWAVES : j)) * UARW);
                    f32x4 sc = {0.f, 0.f, 0.f, 0.f};
#pragma unroll
                    for (int h = 0; h < 8; ++h) { const f32x4 d = mfma16(a, qf[h], (f32x4){0.f, 0.f, 0.f, 0.f});
#pragma unroll
                        for (int e = 0; e < 4; ++e) sc[e] = fmaf(wq[h], fmaxf(d[e], 0.f), sc[e]); }
                    if (qact) {
#pragma unroll
                        for (int e = 0; e < 4; ++e) { const int ki = 16 * j + 4 * g4 + e;
                            const unsigned k16 = ki >= 16 ? (score_key(sc[e]) >> 16) : 0u;
                            KL[ki * qs + c15] = (unsigned short)k16;
                            __hip_atomic_fetch_add(h8 + (k16 >> 8) * 16 + c15, ki >= 16 ? 1u : 0u, __ATOMIC_RELAXED, __HIP_MEMORY_SCOPE_WORKGROUP); } }
                    a = an; an = a2;
                }
            }
            LDS_BARRIER();
            { const int q_ = tid & 15, s8 = tid >> 4; unsigned ss = 0u;
#pragma unroll
              for (int i = 0; i < 8; ++i) ss += h8[(s8 * 8 + i) * 16 + q_];
              segc[s8 * 16 + q_] = ss; }
            LDS_BARRIER();
            if (tid < qn) { unsigned sv[32];
#pragma unroll
                for (int i = 0; i < 32; ++i) sv[i] = segc[i * 16 + tid];
                unsigned cum = 0u; int sgi = 31;
#pragma unroll
                for (int i = 31; i > 0; --i) { const bool go = sgi == i && cum + sv[i] < 256u; cum += go ? sv[i] : 0u; sgi -= go ? 1 : 0; }
                int bin = sgi * 8 + 7; while (bin > sgi * 8 && cum + h8[bin * 16 + tid] < 256u) { cum += h8[bin * 16 + tid]; --bin; }
                st[tid * 4] = (unsigned)bin; st[tid * 4 + 1] = 256u - cum; }
            LDS_BARRIER();
            for (int i = tid; i < 4096; i += NTHREADS) h8[i] = 0u;
            LDS_BARRIER();
            const int q = tid & 15, sg = tid >> 4, SEG = (NK + 31) >> 5, k0 = sg * SEG, k1 = q < qn ? (k0 + SEG < NK ? k0 + SEG : NK) : k0;
            { const unsigned hb = st[q * 4];
#pragma unroll 8
              for (int k = k0; k < k1; ++k) { const unsigned kv = KL[k * qs + q]; __hip_atomic_fetch_add(h8 + (kv & 255u) * 16 + q, (kv >> 8) == hb && kv != 0u ? 1u : 0u, __ATOMIC_RELAXED, __HIP_MEMORY_SCOPE_WORKGROUP); } }
            LDS_BARRIER();
            { const int q_ = tid & 15, s8 = tid >> 4; unsigned ss = 0u;
#pragma unroll
              for (int i = 0; i < 8; ++i) ss += h8[(s8 * 8 + i) * 16 + q_];
              segc[s8 * 16 + q_] = ss; }
            LDS_BARRIER();
            if (tid < qn) { const unsigned rem = st[tid * 4 + 1]; unsigned sv[32];
#pragma unroll
                for (int i = 0; i < 32; ++i) sv[i] = segc[i * 16 + tid];
                unsigned cum = 0u; int sgi = 31;
#pragma unroll
                for (int i = 31; i > 0; --i) { const bool go = sgi == i && cum + sv[i] < rem; cum += go ? sv[i] : 0u; sgi -= go ? 1 : 0; }
                int bin = sgi * 8 + 7; while (bin > sgi * 8 && cum + h8[bin * 16 + tid] < rem) { cum += h8[bin * 16 + tid]; --bin; }
                st[tid * 4 + 2] = (st[tid * 4] << 8) | (unsigned)bin; st[tid * 4 + 3] = rem - cum; }
            LDS_BARRIER();
            const unsigned thr = st[q * 4 + 2], need = st[q * 4 + 3];
            { unsigned cnt = 0u;
#pragma unroll 8
              for (int k = k0; k < k1; ++k) cnt += KL[k * qs + q] == thr ? 1u : 0u;
              segc[sg * 16 + q] = cnt; }
            LDS_BARRIER();
            if (tid < qn) { unsigned cv[32];
#pragma unroll
                for (int s2 = 0; s2 < 32; ++s2) cv[s2] = segc[s2 * 16 + tid];
                unsigned run = 0u;
#pragma unroll
                for (int s2 = 0; s2 < 32; ++s2) { segc[s2 * 16 + tid] = run; run += cv[s2]; } }
            LDS_BARRIER();
            { unsigned rank = segc[sg * 16 + q], word = 0u; int wi = k0 >> 5;
#pragma unroll 4
              for (int k = k0; k < k1; ++k) { if ((k >> 5) != wi) { if (word) __hip_atomic_fetch_or(maskw + (wi + 1) * 32 + qbase + q, word, __ATOMIC_RELAXED, __HIP_MEMORY_SCOPE_WORKGROUP); word = 0u; wi = k >> 5; }
                  const unsigned kv = KL[k * qs + q]; const bool tie = kv == thr; const bool sel = kv > thr || (tie && rank < need); rank += tie ? 1u : 0u;
                  word |= (sel ? 1u : 0u) << (k & 31); }
              if (word) __hip_atomic_fetch_or(maskw + (wi + 1) * 32 + qbase + q, word, __ATOMIC_RELAXED, __HIP_MEMORY_SCOPE_WORKGROUP); }
            LDS_BARRIER();
        }
    } else {
        for (int kt = 1 + wave; kt <= nkt; kt += NWAVES) if (hh == 0) maskw[kt * 32 + r] = kt == 1 ? 0xFFFF0000u : 0xFFFFFFFFu;
        LDS_BARRIER();
    }
    if (PROBE_PHASE == 40) pacc += __builtin_amdgcn_s_memrealtime() - pt0;
    if (PROBE_PHASE == 41) pt0 = __builtin_amdgcn_s_memrealtime();
    {
        const int h = wave, n = h >> 2;
        bf16x8 qf4[4];
#pragma unroll
        for (int kk = 0; kk < 4; ++kk) qf4[kk] = *(const bf16x8*)(U + qrow * UARW + C_Q + h * 64 + 16 * kk + 8 * hh);
        asm volatile("" : "+v"(qf4[0]), "+v"(qf4[1]), "+v"(qf4[2]), "+v"(qf4[3]));
        f32x16 o0, o1;
#pragma unroll
        for (int e = 0; e < 16; ++e) { o0[e] = 0.f; o1[e] = 0.f; }
        float m = -1e30f, lsum = 0.f;
        const int srow = tid >> 4, sch = tid & 15; const int soff = img_off(srow, sch);
        const bf16_t* sbase = U + (size_t)(b * LP + srow) * UARW + sch * 8;
        u32x4 kreg = *(const u32x4*)(sbase + (size_t)32 * UARW + C_K), vreg = *(const u32x4*)(sbase + (size_t)32 * UARW + C_V);
        *(LAS u32x4*)(L + AT_KV + soff) = kreg; *(LAS u32x4*)(L + AT_KV + 8192 + soff) = vreg;
        { const int k2 = nkt >= 2 ? 2 : 1; kreg = *(const u32x4*)(sbase + (size_t)(32 * k2) * UARW + C_K); vreg = *(const u32x4*)(sbase + (size_t)(32 * k2) * UARW + C_V); }
        LDS_BARRIER();
        const int g = (lane >> 4) & 1, q_ = (lane & 15) >> 2, p_ = lane & 3;
        constexpr float SCL = 0.125f * 1.44269504088896f;
#pragma unroll 1
        for (int i = 0; i < nkt; ++i) {
            const int kt = 1 + i; LAS unsigned char* Kimg = L + AT_KV + (i & 1) * 16384; LAS unsigned char* Vimg = Kimg + 8192;
            u32x4 kreg2, vreg2;
            { const int k3 = kt + 2 <= nkt ? kt + 2 : kt; kreg2 = *(const u32x4*)(sbase + (size_t)(32 * k3) * UARW + C_K); vreg2 = *(const u32x4*)(sbase + (size_t)(32 * k3) * UARW + C_V); }
            f32x16 s;
#pragma unroll
            for (int e = 0; e < 16; ++e) s[e] = 0.f;
#pragma unroll
            for (int kk = 0; kk < 4; ++kk) { const bf16x8 a = *(const LAS bf16x8*)(Kimg + img_off(r, 8 * n + 2 * kk + hh)); s = __builtin_amdgcn_mfma_f32_32x32x16_bf16(a, qf4[kk], s, 0, 0, 0); }
            const unsigned mw = maskw[kt * 32 + r] >> (4 * hh);
            float tmax = -INFINITY;
#pragma unroll
            for (int e = 0; e < 16; ++e) { const bool sel = (mw >> ((e & 3) + 8 * (e >> 2))) & 1u; s[e] = sel ? s[e] : -INFINITY; tmax = fmaxf(tmax, s[e]); }
            tmax = fmaxf(tmax, __shfl_xor(tmax, 32));
            const float mnew = fmaxf(m, tmax * SCL);
            if (__any(mnew > m)) { const float alpha = __builtin_amdgcn_exp2f(m - mnew); lsum *= alpha;
#pragma unroll
                for (int e = 0; e < 16; ++e) { o0[e] *= alpha; o1[e] *= alpha; } }
            m = mnew;
            float ps = 0.f;
#pragma unroll
            for (int e = 0; e < 16; ++e) { const float pe = __builtin_amdgcn_exp2f(fmaf(s[e], SCL, -mnew)); s[e] = pe; ps += pe; }
            lsum += ps;
            bf16x8 pf[2];
#pragma unroll
            for (int ks = 0; ks < 2; ++ks) { u32x4 w; w.x = pk2(s[8 * ks + 0], s[8 * ks + 1]); w.y = pk2(s[8 * ks + 2], s[8 * ks + 3]); w.z = pk2(s[8 * ks + 4], s[8 * ks + 5]); w.w = pk2(s[8 * ks + 6], s[8 * ks + 7]); pf[ks] = __builtin_bit_cast(bf16x8, w); }
#pragma unroll
            for (int ks = 0; ks < 2; ++ks)
#pragma unroll
                for (int dt = 0; dt < 2; ++dt) { const int c0 = 8 * n + 4 * dt + 2 * g + (p_ >> 1);
                    const s16x4 lo = __builtin_amdgcn_ds_read_tr16_b64_v4i16((LAS s16x4*)(Vimg + img_off(16 * ks + 4 * hh + q_, c0) + 8 * (p_ & 1)));
                    const s16x4 hi = __builtin_amdgcn_ds_read_tr16_b64_v4i16((LAS s16x4*)(Vimg + img_off(16 * ks + 8 + 4 * hh + q_, c0) + 8 * (p_ & 1)));
                    const bf16x8 a = __builtin_shufflevector(lo, hi, 0, 1, 2, 3, 4, 5, 6, 7);
                    if (dt == 0) o0 = __builtin_amdgcn_mfma_f32_32x32x16_bf16(a, pf[ks], o0, 0, 0, 0); else o1 = __builtin_amdgcn_mfma_f32_32x32x16_bf16(a, pf[ks], o1, 0, 0, 0); }
            if (i + 1 < nkt) { LAS unsigned char* Kn = L + AT_KV + ((i + 1) & 1) * 16384; *(LAS u32x4*)(Kn + soff) = kreg; *(LAS u32x4*)(Kn + 8192 + soff) = vreg; }
            kreg = kreg2; vreg = vreg2;
            LDS_BARRIER();
        }
        lsum += __shfl_xor(lsum, 32);
        const float inv = lsum > 0.f ? 1.0f / lsum : 0.f;
        bf16_t* orow = (bf16_t*)(p.ws + WS_OAB) + qrow * D + h * 64 + 4 * hh;
#pragma unroll
        for (int g4 = 0; g4 < 4; ++g4) { u32x2 w0, w1;
            w0.x = pk2(o0[4 * g4] * inv, o0[4 * g4 + 1] * inv); w0.y = pk2(o0[4 * g4 + 2] * inv, o0[4 * g4 + 3] * inv);
            w1.x = pk2(o1[4 * g4] * inv, o1[4 * g4 + 1] * inv); w1.y = pk2(o1[4 * g4 + 2] * inv, o1[4 * g4 + 3] * inv);
            *(u32x2*)(orow + 8 * g4) = w0; *(u32x2*)(orow + 32 + 8 * g4) = w1; }
        if (qt == 1) {
            bf16_t* z = (bf16_t*)(p.ws + WS_OAB) + (size_t)(b * LP + r) * D + h * 64 + 32 * hh;
#pragma unroll
            for (int j = 0; j < 4; ++j) *(u32x4*)(z + 8 * j) = (u32x4){0u, 0u, 0u, 0u};
        }
    }
    if (PROBE_PHASE == 41 || PROBE_PHASE == 42) pacc += __builtin_amdgcn_s_memrealtime() - pt0;
}
__device__ __forceinline__ void attn_phase(const Params& p, int l, unsigned char* lds, unsigned long long& pacc) {
    unsigned* ctr = (unsigned*)(p.ws + WS_CTL) + CW_ATT + 4 * l;
    volatile int* uw = (volatile int*)(lds + AT_UNIT);
    const int b0 = (obid() & 7) >> 1;
    for (int k = 0; k < 4; ++k) { const int b = (b0 + k) & 3;
        for (;;) {
            __syncthreads();
            if (otid() == 0) *uw = (int)atomicAdd(ctr + b, 1u);
            __syncthreads();
            const int u = *uw;
            if (u >= 129) break;
            attn_unit(p, lds, b, 129 - u, pacc);
        }
    }
}

constexpr size_t WS_RW1 = WS_HB;
constexpr size_t WS_RW2 = 259 * MiB;
constexpr size_t RW2_ARR = (size_t)2080 * 8192;
constexpr size_t WS_LORA = 65536;
constexpr int PS = 72;
constexpr int R1_XW = 0, R1_XA = 9216, R1_XG = 18432;
constexpr int R1_RHS = 0;
constexpr int R1_E = 35840, R1_AA = R1_E + 16640, R1_GS = R1_AA + 9216;
constexpr int R1_LABT = R1_E, R1_LAK = R1_E + 16384;
constexpr int R1_AT = R1_GS + 9216, R1_RT = R1_AT + 9216, R1_BT = R1_RT + 9216, R1_KT = R1_BT + 9216;
constexpr int R1_WT = R1_AT, R1_ZT = R1_BT;
constexpr int R1_BTT = R1_KT + 9216, R1_KTT = R1_BTT + 9216, R1_VT = R1_KTT + 9216;
constexpr int R1_MRB = R1_VT + 9216, R1_MRK = R1_MRB + 9216;
constexpr int R1_BS = R1_MRK + 9216, R1_GC = R1_BS + 256, R1_END = R1_GC + 256;
static_assert(R1_END <= LDS_BYTES && R1_LAK + 9216 <= R1_AT && R1_RHS + 33280 <= R1_E, "R1 LDS map");
__device__ __forceinline__ u32x2 pk4(f32x4 v) { u32x2 w; w.x = pk2(v[0], v[1]); w.y = pk2(v[2], v[3]); return w; }

#ifndef PROBE_PHASE
#define PROBE_PHASE -1
#endif
#define R1P(k) do { if (PROBE_PHASE == 20 + (k)) { const unsigned long long t_ = __builtin_amdgcn_s_memrealtime(); pacc += t_ - pt0; } if (PROBE_PHASE == 21 + (k)) pt0 = __builtin_amdgcn_s_memrealtime(); } while (0)
__device__ __forceinline__ void rwkv_prep_unit(const Params& p, int l, int unit, unsigned char* lds, unsigned long long& pacc) {
    unsigned long long pt0 = 0; if (PROBE_PHASE == 20) pt0 = __builtin_amdgcn_s_memrealtime();
    const int tid = otid(), wave = tid >> 6, lane = tid & 63, c15 = lane & 15, g = lane >> 4;
    const int h = unit & 7, bc = unit >> 3, b = bc / NCH, c = bc - b * NCH;
    LAS unsigned char* L = (LAS unsigned char*)lds;
    const bf16_t* U = (const bf16_t*)(p.ws + WS_UAR);
    const int t = tid >> 3, dq = tid & 7, d0 = dq * 8;
    const int row = b * LP + 64 * c + t; const bool hasprev = (64 * c + t) > 0;
    bf16x8 lw[2][2], la[2][2], lg_[2][4];
    { const bf16_t* lora = (const bf16_t*)(p.ws + WS_LORA + (size_t)l * 262144);
#pragma unroll
      for (int nn = 0; nn < 2; ++nn) { const int hd = h * 64 + 16 * (2 * (wave & 1) + nn) + c15;
#pragma unroll
          for (int s2 = 0; s2 < 2; ++s2) { lw[nn][s2] = *(const bf16x8*)(lora + (size_t)hd * 64 + 32 * s2 + 8 * g); la[nn][s2] = *(const bf16x8*)(lora + 32768 + (size_t)hd * 64 + 32 * s2 + 8 * g); }
#pragma unroll
          for (int s4 = 0; s4 < 4; ++s4) lg_[nn][s4] = *(const bf16x8*)(lora + 65536 + (size_t)hd * 128 + 32 * s4 + 8 * g); } }
    float rr[8], kx[8], vx[8], kk[8];
    {
        const bf16_t* uc = U + (size_t)row * UARW; const bf16_t* up = hasprev ? uc - UARW : uc;
        const float* mu = p.in[I_MU] + l * R_COLS;
        auto shift8 = [&](int col, int mucol, float (&out)[8]) {
            const u32x4 a = *(const u32x4*)(uc + col), q = *(const u32x4*)(up + col);
            const f32x4 m0 = *(const f32x4*)(mu + mucol), m1 = *(const f32x4*)(mu + mucol + 4);
            const float x[8] = {bflo(a.x), bfhi(a.x), bflo(a.y), bfhi(a.y), bflo(a.z), bfhi(a.z), bflo(a.w), bfhi(a.w)};
            const float y[8] = {bflo(q.x), bfhi(q.x), bflo(q.y), bfhi(q.y), bflo(q.z), bfhi(q.z), bflo(q.w), bfhi(q.w)};
#pragma unroll
            for (int i = 0; i < 8; ++i) { const float xp = hasprev ? y[i] : 0.f; out[i] = x[i] + (xp - x[i]) * (i < 4 ? m0[i] : m1[i - 4]); } };
        shift8(C_R + h * 64 + d0, h * 64 + d0, rr); shift8(C_RK + h * 64 + d0, 512 + h * 64 + d0, kx); shift8(C_RV + h * 64 + d0, 1024 + h * 64 + d0, vx);
        float xw[8], xa[8], xg0[8], xg1[8];
        shift8(C_XW + d0, 1536 + d0, xw); shift8(C_XA + d0, 1600 + d0, xa); shift8(C_XG + d0, 1664 + d0, xg0); shift8(C_XG + 64 + d0, 1728 + d0, xg1);
        float n2 = 0.f;
        { const f32x4 k0 = *(const f32x4*)(p.in[I_KK] + l * 512 + h * 64 + d0), k1 = *(const f32x4*)(p.in[I_KK] + l * 512 + h * 64 + d0 + 4);
#pragma unroll
          for (int i = 0; i < 8; ++i) { kk[i] = kx[i] * (i < 4 ? k0[i] : k1[i - 4]); n2 = fmaf(kk[i], kk[i], n2); } }
        n2 += __shfl_xor(n2, 1); n2 += __shfl_xor(n2, 2); n2 += __shfl_xor(n2, 4);
        const float rn = rsqrtf(fmaxf(n2, 1e-24f));
#pragma unroll
        for (int i = 0; i < 8; ++i) { kk[i] *= rn; xw[i] = tanhf(xw[i]); xg0[i] = sigmoidf_(xg0[i]); xg1[i] = sigmoidf_(xg1[i]); }
        u32x4 w;
        w.x = pk2(xw[0], xw[1]); w.y = pk2(xw[2], xw[3]); w.z = pk2(xw[4], xw[5]); w.w = pk2(xw[6], xw[7]); *(LAS u32x4*)(L + R1_XW + (t * PS + d0) * 2) = w;
        w.x = pk2(xa[0], xa[1]); w.y = pk2(xa[2], xa[3]); w.z = pk2(xa[4], xa[5]); w.w = pk2(xa[6], xa[7]); *(LAS u32x4*)(L + R1_XA + (t * PS + d0) * 2) = w;
        w.x = pk2(xg0[0], xg0[1]); w.y = pk2(xg0[2], xg0[3]); w.z = pk2(xg0[4], xg0[5]); w.w = pk2(xg0[6], xg0[7]); *(LAS u32x4*)(L + R1_XG + (t * 136 + d0) * 2) = w;
        w.x = pk2(xg1[0], xg1[1]); w.y = pk2(xg1[2], xg1[3]); w.z = pk2(xg1[4], xg1[5]); w.w = pk2(xg1[6], xg1[7]); *(LAS u32x4*)(L + R1_XG + (t * 136 + 64 + d0) * 2) = w;
    }
    LDS_BARRIER();
    R1P(0);
    const int tm = wave >> 1;
    unsigned char* rw2 = p.ws + WS_RW2 + (size_t)unit * 8192;
    {
#pragma unroll
        for (int nn = 0; nn < 2; ++nn) { const int tn = 2 * (wave & 1) + nn, dcol = 16 * tn + c15, hd = h * 64 + dcol;
            f32x4 aw = {0.f, 0.f, 0.f, 0.f}, aa = aw, ag = aw;
#pragma unroll
            for (int s2 = 0; s2 < 2; ++s2) {
                const bf16x8 xa_ = *(const LAS bf16x8*)(L + R1_XW + ((16 * tm + c15) * PS + 32 * s2 + 8 * g) * 2), xb_ = *(const LAS bf16x8*)(L + R1_XA + ((16 * tm + c15) * PS + 32 * s2 + 8 * g) * 2);
                aw = mfma16(xa_, lw[nn][s2], aw);
                aa = mfma16(xb_, la[nn][s2], aa); }
#pragma unroll
            for (int s4 = 0; s4 < 4; ++s4) ag = mfma16(*(const LAS bf16x8*)(L + R1_XG + ((16 * tm + c15) * 136 + 32 * s4 + 8 * g) * 2), lg_[nn][s4], ag);
            const float w0 = p.in[I_W0][l * 512 + hd], a0 = p.in[I_A0][l * 512 + hd];
#pragma unroll
            for (int e = 0; e < 4; ++e) { const int tt = 16 * tm + 4 * g + e;
                const float z = -(w0 + aw[e]); const float sp = fmaxf(z, 0.f) + log1pf(__expf(-fabsf(z)));
                *(LAS float*)(L + R1_E + (tt * 65 + dcol) * 4) = __expf(-sp - 0.5f);
                *(LAS unsigned short*)(L + R1_AA + (tt * PS + dcol) * 2) = (unsigned short)f2bf(sigmoidf_(a0 + aa[e]));
                *(LAS unsigned short*)(L + R1_GS + (tt * PS + dcol) * 2) = (unsigned short)f2bf(ag[e]); }
        }
    }
    LDS_BARRIER();
    R1P(1);
    {
        const int d = tid & 63, sg = tid >> 6; float cum = 0.f, loc[8];
#pragma unroll
        for (int i = 0; i < 8; ++i) { cum += *(const LAS float*)(L + R1_E + ((8 * sg + i) * 65 + d) * 4); loc[i] = cum; }
        *(LAS float*)(L + R1_BS + (sg * 64 + d) * 4 - 2048) = cum;
        LDS_BARRIER();
        float off = 0.f;
#pragma unroll
        for (int q = 0; q < 7; ++q) if (q < sg) off += *(const LAS float*)(L + R1_BS + (q * 64 + d) * 4 - 2048);
#pragma unroll
        for (int i = 0; i < 8; ++i) *(LAS float*)(L + R1_E + ((8 * sg + i) * 65 + d) * 4) = loc[i] + off;
    }
    LDS_BARRIER();
    R1P(2);
    {
        const f32x4 ka0 = *(const f32x4*)(p.in[I_KA] + l * 512 + h * 64 + d0), ka1 = *(const f32x4*)(p.in[I_KA] + l * 512 + h * 64 + d0 + 4);
        const f32x4 rk0 = *(const f32x4*)(p.in[I_RK] + l * 512 + h * 64 + d0), rk1 = *(const f32x4*)(p.in[I_RK] + l * 512 + h * 64 + d0 + 4);
        const u32x4 aw_ = *(const LAS u32x4*)(L + R1_AA + (t * PS + d0) * 2);
        const float av[8] = {bflo(aw_.x), bfhi(aw_.x), bflo(aw_.y), bfhi(aw_.y), bflo(aw_.z), bfhi(aw_.z), bflo(aw_.w), bfhi(aw_.w)};
        float At[8], Bt[8], Kt[8], Rt[8]; float bpart = 0.f;
#pragma unroll
        for (int i = 0; i < 8; ++i) {
            const float cumt = *(const LAS float*)(L + R1_E + (t * 65 + d0 + i) * 4), cump = t > 0 ? *(const LAS float*)(L + R1_E + ((t - 1) * 65 + d0 + i) * 4) : 0.f;
            const float gam = __expf(-cumt), gprev = __expf(-cump), ginv = __expf(cumt);
            const float kmod = kx[i] * (1.0f + (av[i] - 1.0f) * (i < 4 ? ka0[i] : ka1[i - 4]));
            At[i] = -gprev * kk[i]; Bt[i] = kk[i] * av[i] * ginv; Kt[i] = kmod * ginv; Rt[i] = rr[i] * gam;
            bpart = fmaf(rr[i] * kmod, (i < 4 ? rk0[i] : rk1[i - 4]), bpart);
            if (t == 63) *(LAS float*)(L + R1_GC + (d0 + i) * 4) = gam;
            *(LAS float*)(L + R1_RHS + ((d0 + i) * 65 + t) * 4) = At[i];
            *(LAS unsigned short*)(L + R1_BTT + ((d0 + i) * PS + t) * 2) = (unsigned short)f2bf(Bt[i]);
            *(LAS unsigned short*)(L + R1_KTT + ((d0 + i) * PS + t) * 2) = (unsigned short)f2bf(Kt[i]);
            *(LAS unsigned short*)(L + R1_VT + ((d0 + i) * PS + t) * 2) = (unsigned short)f2bf(vx[i]);
        }
        u32x4 w;
        w.x = pk2(At[0], At[1]); w.y = pk2(At[2], At[3]); w.z = pk2(At[4], At[5]); w.w = pk2(At[6], At[7]); *(LAS u32x4*)(L + R1_AT + (t * PS + d0) * 2) = w;
        w.x = pk2(Rt[0], Rt[1]); w.y = pk2(Rt[2], Rt[3]); w.z = pk2(Rt[4], Rt[5]); w.w = pk2(Rt[6], Rt[7]); *(LAS u32x4*)(L + R1_RT + (t * PS + d0) * 2) = w;
        w.x = pk2(Bt[0], Bt[1]); w.y = pk2(Bt[2], Bt[3]); w.z = pk2(Bt[4], Bt[5]); w.w = pk2(Bt[6], Bt[7]); *(LAS u32x4*)(L + R1_BT + (t * PS + d0) * 2) = w;
        w.x = pk2(Kt[0], Kt[1]); w.y = pk2(Kt[2], Kt[3]); w.z = pk2(Kt[4], Kt[5]); w.w = pk2(Kt[6], Kt[7]); *(LAS u32x4*)(L + R1_KT + (t * PS + d0) * 2) = w;
        bpart += __shfl_xor(bpart, 1); bpart += __shfl_xor(bpart, 2); bpart += __shfl_xor(bpart, 4);
        const u32x4 gw = *(const LAS u32x4*)(L + R1_GS + (t * PS + d0) * 2);
        const float gv[8] = {bflo(gw.x), bfhi(gw.x), bflo(gw.y), bfhi(gw.y), bflo(gw.z), bfhi(gw.z), bflo(gw.w), bfhi(gw.w)};
        w.x = pk2(bpart * vx[0] * gv[0], bpart * vx[1] * gv[1]); w.y = pk2(bpart * vx[2] * gv[2], bpart * vx[3] * gv[3]);
        w.z = pk2(bpart * vx[4] * gv[4], bpart * vx[5] * gv[5]); w.w = pk2(bpart * vx[6] * gv[6], bpart * vx[7] * gv[7]);
        *(u32x4*)((bf16_t*)(p.ws + WS_OAB) + (size_t)row * D + 512 + h * 64 + d0) = w;
        *(u32x4*)(rw2 + 2 * RW2_ARR + (size_t)(t * 64 + d0) * 2) = gw;
    }
    LDS_BARRIER();
    R1P(3);
    {
        f32x4 gab[2], gak[2], grb[2], grk[2];
#pragma unroll
        for (int nn = 0; nn < 2; ++nn) { const int tn = 2 * (wave & 1) + nn;
            gab[nn] = (f32x4){0.f, 0.f, 0.f, 0.f}; gak[nn] = gab[nn]; grb[nn] = gab[nn]; grk[nn] = gab[nn];
            if (tn <= tm) {
#pragma unroll
                for (int s2 = 0; s2 < 2; ++s2) { const int ao = ((16 * tm + c15) * PS + 32 * s2 + 8 * g) * 2, bo = ((16 * tn + c15) * PS + 32 * s2 + 8 * g) * 2;
                    const bf16x8 fa = *(const LAS bf16x8*)(L + R1_AT + ao), fr_ = *(const LAS bf16x8*)(L + R1_RT + ao), fb = *(const LAS bf16x8*)(L + R1_BT + bo), fk = *(const LAS bf16x8*)(L + R1_KT + bo);
                    gab[nn] = mfma16(fa, fb, gab[nn]); gak[nn] = mfma16(fa, fk, gak[nn]); grb[nn] = mfma16(fr_, fb, grb[nn]); grk[nn] = mfma16(fr_, fk, grk[nn]); } } }
        LDS_BARRIER();
#pragma unroll
        for (int nn = 0; nn < 2; ++nn) { const int tn = 2 * (wave & 1) + nn, icol = 16 * tn + c15;
            f32x4 lab;
#pragma unroll
            for (int e = 0; e < 4; ++e) { const int tt = 16 * tm + 4 * g + e; const bool strict = icol < tt, incl = icol <= tt;
                lab[e] = strict ? gab[nn][e] : 0.f;
                *(LAS unsigned short*)(L + R1_LAK + (tt * PS + icol) * 2) = (unsigned short)f2bf(strict ? gak[nn][e] : 0.f);
                *(LAS unsigned short*)(L + R1_MRB + (tt * PS + icol) * 2) = (unsigned short)f2bf(incl ? grb[nn][e] : 0.f);
                *(LAS unsigned short*)(L + R1_MRK + (tt * PS + icol) * 2) = (unsigned short)f2bf(incl ? grk[nn][e] : 0.f); }
            *(LAS f32x4*)(L + R1_LABT + (icol * 64 + 16 * tm + 4 * g) * 4) = lab; }
    }
    LDS_BARRIER();
    R1P(4);
    {
#pragma unroll
        for (int nn = 0; nn < 2; ++nn) { const int tn = 2 * (wave & 1) + nn; f32x4 acc = {0.f, 0.f, 0.f, 0.f};
#pragma unroll
            for (int s2 = 0; s2 < 2; ++s2) acc = mfma16(*(const LAS bf16x8*)(L + R1_LAK + ((16 * tm + c15) * PS + 32 * s2 + 8 * g) * 2), *(const LAS bf16x8*)(L + R1_VT + ((16 * tn + c15) * PS + 32 * s2 + 8 * g) * 2), acc);
#pragma unroll
            for (int e = 0; e < 4; ++e) *(LAS float*)(L + R1_RHS + ((64 + 16 * tn + c15) * 65 + 16 * tm + 4 * g + e) * 4) = acc[e]; }
    }
    LDS_BARRIER();
    R1P(5);
    if (tid < 128) {
        LAS float* xr = (LAS float*)(L + R1_RHS + tid * 65 * 4);
#pragma unroll 1
        for (int Tb = 0; Tb < 4; ++Tb) {
            float acc[16];
#pragma unroll
            for (int e = 0; e < 16; ++e) acc[e] = xr[16 * Tb + e];
#pragma unroll 4
            for (int i = 0; i < 16 * Tb; ++i) { const float xi = xr[i];
#pragma unroll
                for (int q = 0; q < 4; ++q) { const f32x4 lv = *(const LAS f32x4*)(L + R1_LABT + (i * 64 + 16 * Tb + 4 * q) * 4);
#pragma unroll
                    for (int e = 0; e < 4; ++e) acc[4 * q + e] = fmaf(lv[e], xi, acc[4 * q + e]); } }
#pragma unroll
            for (int ii = 0; ii < 15; ++ii) { const float xi = acc[ii];
#pragma unroll
                for (int q = (ii + 1) / 4; q < 4; ++q) { const f32x4 lv = *(const LAS f32x4*)(L + R1_LABT + ((16 * Tb + ii) * 64 + 16 * Tb + 4 * q) * 4);
#pragma unroll
                    for (int e = 0; e < 4; ++e) if (4 * q + e > ii) acc[4 * q + e] = fmaf(lv[e], xi, acc[4 * q + e]); } }
#pragma unroll
            for (int e = 0; e < 16; ++e) xr[16 * Tb + e] = acc[e];
        }
        LAS unsigned char* dst = L + (tid < 64 ? R1_WT + tid * PS * 2 : R1_ZT + (tid - 64) * PS * 2);
#pragma unroll
        for (int q8 = 0; q8 < 8; ++q8) { u32x4 w; w.x = pk2(xr[8 * q8], xr[8 * q8 + 1]); w.y = pk2(xr[8 * q8 + 2], xr[8 * q8 + 3]); w.z = pk2(xr[8 * q8 + 4], xr[8 * q8 + 5]); w.w = pk2(xr[8 * q8 + 6], xr[8 * q8 + 7]); *(LAS u32x4*)(dst + q8 * 16) = w; }
    }
    LDS_BARRIER();
    R1P(6);
    {
        unsigned char* rw1 = p.ws + WS_RW1 + (size_t)unit * 16384;
#pragma unroll
        for (int nn = 0; nn < 2; ++nn) { const int tn = 2 * (wave & 1) + nn, col = 16 * tn + c15, r0 = 16 * tm + 4 * g;
            f32x4 aP = {0.f, 0.f, 0.f, 0.f}, aQ = aP, aG = aP, aY = aP;
#pragma unroll
            for (int s2 = 0; s2 < 2; ++s2) { const int ro = ((16 * tm + c15) * PS + 32 * s2 + 8 * g) * 2, co = ((16 * tn + c15) * PS + 32 * s2 + 8 * g) * 2;
                const bf16x8 fWT = *(const LAS bf16x8*)(L + R1_WT + ro), fBTT = *(const LAS bf16x8*)(L + R1_BTT + ro), fKTT = *(const LAS bf16x8*)(L + R1_KTT + ro), fMRB = *(const LAS bf16x8*)(L + R1_MRB + ro), fMRK = *(const LAS bf16x8*)(L + R1_MRK + ro);
                const bf16x8 cBTT = *(const LAS bf16x8*)(L + R1_BTT + co), cZT = *(const LAS bf16x8*)(L + R1_ZT + co), cVT = *(const LAS bf16x8*)(L + R1_VT + co), cMRB = *(const LAS bf16x8*)(L + R1_MRB + co);
                aP = mfma16(fWT, cBTT, aP);
                aQ = mfma16(fBTT, cZT, aQ); aQ = mfma16(fKTT, cVT, aQ);
                aG = mfma16(fWT, cMRB, aG);
                aY = mfma16(fMRB, cZT, aY); aY = mfma16(fMRK, cVT, aY); }
            const float gcc = *(const LAS float*)(L + R1_GC + col * 4);
            const f32x4 gcr = *(const LAS f32x4*)(L + R1_GC + r0 * 4);
            const u32x2 rtw = *(const LAS u32x2*)(L + R1_RT + (col * PS + r0) * 2);
#pragma unroll
            for (int e = 0; e < 4; ++e) { aP[e] = (aP[e] + ((r0 + e) == col ? 1.0f : 0.f)) * gcc; aQ[e] *= gcr[e]; }
            aG[0] += bflo(rtw.x); aG[1] += bfhi(rtw.x); aG[2] += bflo(rtw.y); aG[3] += bfhi(rtw.y);
            *(u32x2*)(rw1 + (size_t)(col * 64 + r0) * 2) = pk4(aP);
            *(u32x2*)(rw1 + 8192 + (size_t)(col * 64 + r0) * 2) = pk4(aG);
            *(u32x2*)(rw2 + (size_t)(col * 64 + r0) * 2) = pk4(aQ);
            *(u32x2*)(rw2 + RW2_ARR + (size_t)(col * 64 + r0) * 2) = pk4(aY); }
    }
    LDS_BARRIER();
    R1P(7);
}

constexpr int R2_SV = 0, R2_YS = 2 * 64 * PS * 2, R2_END = R2_YS + 2 * 64 * 68 * 4;
__device__ __forceinline__ void rwkv_scan(const Params& p, int l, int bh, unsigned char* lds) {
    const int tid = otid(), wave = tid >> 6, lane = tid & 63, c15 = lane & 15, g = lane >> 4;
    const int b = bh >> 3, h = bh & 7, role = wave >> 2, j = wave & 3, vcol = 16 * j + c15;
    LAS unsigned char* L = (LAS unsigned char*)lds;
    for (int i = tid; i < 2 * 64 * PS * 2 / 4; i += NTHREADS) ((LAS unsigned*)(L + R2_SV))[i] = 0u;
    LDS_BARRIER();
    const int et = tid >> 3, ev0 = 8 * (tid & 7);
    f32x4 gn0[2], gn1[2];
    { const float* gp = p.in[I_GNG] + l * 512 + h * 64 + ev0; const float* bp = p.in[I_GNB] + l * 512 + h * 64 + ev0;
      gn0[0] = *(const f32x4*)gp; gn0[1] = *(const f32x4*)(gp + 4); gn1[0] = *(const f32x4*)bp; gn1[1] = *(const f32x4*)(bp + 4); }
    bf16_t* OB = (bf16_t*)(p.ws + WS_OAB) + (size_t)(b * LP + et) * D + 512 + h * 64 + ev0;
    const int unit0 = (b * NCH) * 8 + h;
    const unsigned char* rw1b = p.ws + WS_RW1 + (role ? 8192 : 0) + (size_t)(c15 * 64 + 8 * g) * 2;
    const unsigned char* rw2b = p.ws + WS_RW2 + (role ? RW2_ARR : 0) + (size_t)(vcol * 64 + 4 * g) * 2;
    const unsigned char* ggb = p.ws + WS_RW2 + 2 * RW2_ARR + (size_t)(et * 64 + ev0) * 2;
    bf16x8 A0[4][2], A1[4][2]; u32x2 I0[4], I1[4];
    u32x4 G0 = {0u, 0u, 0u, 0u}, O0 = G0, G1, O1;
#define R2_LOAD(AA, II, cc) do { const size_t un_ = (size_t)(unit0 + 8 * ((cc) < NCH ? (cc) : NCH - 1)); \
        _Pragma("unroll") for (int m = 0; m < 4; ++m) { II[m] = *(const u32x2*)(rw2b + un_ * 8192 + 32 * m); \
            _Pragma("unroll") for (int s2 = 0; s2 < 2; ++s2) AA[m][s2] = *(const bf16x8*)(rw1b + un_ * 16384 + (16 * m * 64 + 32 * s2) * 2); } } while (0)
    R2_LOAD(A0, I0, 0); R2_LOAD(A1, I1, 1);
    G1 = *(const u32x4*)(ggb + (size_t)unit0 * 8192); O1 = *(const u32x4*)OB;
#pragma unroll 1
    for (int c = 0; c <= NCH; ++c) {
        const int cur = c & 1;
        bf16x8 A2[4][2]; u32x2 I2[4];
        R2_LOAD(A2, I2, c + 2);
        u32x4 G2, O2; { const int cn = c + 1 < NCH ? c + 1 : NCH - 1; G2 = *(const u32x4*)(ggb + (size_t)(unit0 + 8 * cn) * 8192); O2 = *(const u32x4*)(OB + (size_t)(64 * cn) * D); }
        if (c > 0) {
            const f32x4 y0 = *(const LAS f32x4*)(L + R2_YS + ((cur ^ 1) * 64 * 68 + et * 68 + ev0) * 4), y1 = *(const LAS f32x4*)(L + R2_YS + ((cur ^ 1) * 64 * 68 + et * 68 + ev0 + 4) * 4);
            float s1 = (y0[0] + y0[1]) + (y0[2] + y0[3]) + (y1[0] + y1[1]) + (y1[2] + y1[3]);
            s1 = sum8(s1); const float mean = s1 * (1.f / 64.f);
            const f32x4 d0 = y0 - mean, d1 = y1 - mean;
            float s2_ = (d0[0] * d0[0] + d0[1] * d0[1]) + (d0[2] * d0[2] + d0[3] * d0[3]) + (d1[0] * d1[0] + d1[1] * d1[1]) + (d1[2] * d1[2] + d1[3] * d1[3]);
            s2_ = sum8(s2_); const float rstd = rsqrtf(s2_ * (1.f / 64.f) + GN_EPS);
            const float gv[8] = {bflo(G0.x), bfhi(G0.x), bflo(G0.y), bfhi(G0.y), bflo(G0.z), bfhi(G0.z), bflo(G0.w), bfhi(G0.w)};
            const float ov[8] = {bflo(O0.x), bfhi(O0.x), bflo(O0.y), bfhi(O0.y), bflo(O0.z), bfhi(O0.z), bflo(O0.w), bfhi(O0.w)};
            float o[8];
#pragma unroll
            for (int i = 0; i < 4; ++i) { o[i] = ov[i] + (d0[i] * rstd * gn0[0][i] + gn1[0][i]) * gv[i]; o[4 + i] = ov[4 + i] + (d1[i] * rstd * gn0[1][i] + gn1[1][i]) * gv[4 + i]; }
            u32x4 w; w.x = pk2(o[0], o[1]); w.y = pk2(o[2], o[3]); w.z = pk2(o[4], o[5]); w.w = pk2(o[6], o[7]);
            *(u32x4*)(OB + (size_t)(64 * (c - 1)) * D) = w;
        }
        if (c < NCH) {
            bf16x8 bf_[2];
#pragma unroll
            for (int s2 = 0; s2 < 2; ++s2) bf_[s2] = *(const LAS bf16x8*)(L + R2_SV + cur * 64 * PS * 2 + (vcol * PS + 32 * s2 + 8 * g) * 2);
            f32x4 acc[4];
#pragma unroll
            for (int m = 0; m < 4; ++m) { acc[m] = (f32x4){bflo(I0[m].x), bfhi(I0[m].x), bflo(I0[m].y), bfhi(I0[m].y)};
#pragma unroll
                for (int s2 = 0; s2 < 2; ++s2) acc[m] = mfma16(A0[m][s2], bf_[s2], acc[m]); }
            if (role == 0) {
#pragma unroll
                for (int m = 0; m < 4; ++m) *(LAS u32x2*)(L + R2_SV + (cur ^ 1) * 64 * PS * 2 + (vcol * PS + 16 * m + 4 * g) * 2) = pk4(acc[m]);
            } else {
#pragma unroll
                for (int m = 0; m < 4; ++m)
#pragma unroll
                    for (int e = 0; e < 4; ++e) *(LAS float*)(L + R2_YS + (cur * 64 * 68 + (16 * m + 4 * g + e) * 68 + vcol) * 4) = acc[m][e];
            }
        }
        LDS_BARRIER();
#pragma unroll
        for (int m = 0; m < 4; ++m) { I0[m] = I1[m]; I1[m] = I2[m]; A0[m][0] = A1[m][0]; A0[m][1] = A1[m][1]; A1[m][0] = A2[m][0]; A1[m][1] = A2[m][1]; }
        G0 = G1; O0 = O1; G1 = G2; O1 = O2;
    }
#undef R2_LOAD
}

__device__ void rwkv_naive(const Params& p, int l, int bh, unsigned char* lds) {
    const int b = bh >> 3, h = bh & 7, tid = otid(), lane = tid & 63, wid = tid >> 6;
    const bf16_t* U = (const bf16_t*)(p.ws + WS_UAR);
    bf16_t* OB = (bf16_t*)(p.ws + WS_OAB);
    float* xs = (float*)lds;
    float* vr = xs + 32 * 256;
    float* vw = vr + 2048; float* vkk = vw + 2048; float* vbb = vkk + 2048; float* vk = vbb + 2048; float* vv = vk + 2048;
    float* gg = vv + 2048; float* bon = gg + 2048; float* ys = bon + 2048;
    const float* mu = p.in[I_MU] + l * R_COLS;
    const int hd = h * 64 + lane;
    const float w0 = p.in[I_W0][l * 512 + hd], a0 = p.in[I_A0][l * 512 + hd], kkc = p.in[I_KK][l * 512 + hd], kac = p.in[I_KA][l * 512 + hd], rkc = p.in[I_RK][l * 512 + hd];
    const float gng = p.in[I_GNG][l * 512 + hd], gnb = p.in[I_GNB][l * 512 + hd];
    const float mur = mu[hd], muk = mu[512 + hd], muv = mu[1024 + hd];
    const float* wup = p.in[I_WUP] + (size_t)l * 64 * 512 + hd; const float* aup = p.in[I_AUP] + (size_t)l * 64 * 512 + hd; const float* gup = p.in[I_GUP] + (size_t)l * 128 * 512 + hd;
    float S[8];
#pragma unroll
    for (int i = 0; i < 8; ++i) S[i] = 0.f;
    const int sv = tid >> 3, sq = tid & 7;
    for (int p0 = 0; p0 < LP; p0 += 32) {
        for (int idx = tid; idx < 32 * 256; idx += NTHREADS) {
            const int tt = idx >> 8, j = idx & 255, pos = p0 + tt; const size_t ro = (size_t)(b * LP + pos) * UARW;
            const float x = bf2f(U[ro + C_XW + j]); const float xp = pos > 0 ? bf2f(U[ro - UARW + C_XW + j]) : 0.f;
            float xv = x + (xp - x) * mu[1536 + j];
            if (j < 64) xv = tanhf(xv); else if (j >= 128) xv = sigmoidf_(xv);
            xs[idx] = xv;
        }
        __syncthreads();
        {
            float dw[4] = {0.f, 0.f, 0.f, 0.f}, da[4] = {0.f, 0.f, 0.f, 0.f}, dg[4] = {0.f, 0.f, 0.f, 0.f};
            for (int j = 0; j < 64; ++j) { const float w1 = wup[(size_t)j * 512], w2 = aup[(size_t)j * 512];
#pragma unroll
                for (int k = 0; k < 4; ++k) { dw[k] = fmaf(xs[(wid * 4 + k) * 256 + j], w1, dw[k]); da[k] = fmaf(xs[(wid * 4 + k) * 256 + 64 + j], w2, da[k]); } }
            for (int j = 0; j < 128; ++j) { const float w3 = gup[(size_t)j * 512];
#pragma unroll
                for (int k = 0; k < 4; ++k) dg[k] = fmaf(xs[(wid * 4 + k) * 256 + 128 + j], w3, dg[k]); }
#pragma unroll
            for (int k = 0; k < 4; ++k) {
                const int tt = wid * 4 + k, pos = p0 + tt; const size_t ro = (size_t)(b * LP + pos) * UARW;
                float r = bf2f(U[ro + C_R + hd]), kx = bf2f(U[ro + C_RK + hd]), vx = bf2f(U[ro + C_RV + hd]);
                if (pos > 0) { const float rp = bf2f(U[ro - UARW + C_R + hd]), kp = bf2f(U[ro - UARW + C_RK + hd]), vp = bf2f(U[ro - UARW + C_RV + hd]);
                    r += (rp - r) * mur; kx += (kp - kx) * muk; vx += (vp - vx) * muv; }
                else { r -= r * mur; kx -= kx * muk; vx -= vx * muv; }
                const float z = -(w0 + dw[k]); const float sp = fmaxf(z, 0.f) + log1pf(__expf(-fabsf(z)));
                const float logw = -sp - 0.5f; const float w = __expf(-__expf(logw));
                const float a = sigmoidf_(a0 + da[k]);
                float kk = kx * kkc; const float nrm = wave_sum(kk * kk); kk *= rsqrtf(fmaxf(nrm, 1e-24f));
                const float kmod = kx * (1.0f + (a - 1.0f) * kac);
                const float bsum = wave_sum(r * kmod * rkc);
                vr[tt * 64 + lane] = r; vw[tt * 64 + lane] = w; vkk[tt * 64 + lane] = kk; vbb[tt * 64 + lane] = kk * a; vk[tt * 64 + lane] = kmod; vv[tt * 64 + lane] = vx;
                gg[tt * 64 + lane] = dg[k]; bon[tt * 64 + lane] = bsum * vx;
            }
        }
        __syncthreads();
        for (int tt = 0; tt < 32; ++tt) {
            const f32x4 k0 = *(const f32x4*)(vkk + tt * 64 + sq * 8), k1 = *(const f32x4*)(vkk + tt * 64 + sq * 8 + 4);
            const f32x4 w0v = *(const f32x4*)(vw + tt * 64 + sq * 8), w1v = *(const f32x4*)(vw + tt * 64 + sq * 8 + 4);
            const f32x4 b0 = *(const f32x4*)(vbb + tt * 64 + sq * 8), b1 = *(const f32x4*)(vbb + tt * 64 + sq * 8 + 4);
            const f32x4 m0 = *(const f32x4*)(vk + tt * 64 + sq * 8), m1 = *(const f32x4*)(vk + tt * 64 + sq * 8 + 4);
            const f32x4 r0 = *(const f32x4*)(vr + tt * 64 + sq * 8), r1 = *(const f32x4*)(vr + tt * 64 + sq * 8 + 4);
            const float vt = vv[tt * 64 + sv];
            float sa = 0.f;
#pragma unroll
            for (int i = 0; i < 4; ++i) { sa = fmaf(S[i], k0[i], sa); sa = fmaf(S[4 + i], k1[i], sa); }
            sa += __shfl_xor(sa, 1); sa += __shfl_xor(sa, 2); sa += __shfl_xor(sa, 4);
            sa = -sa; float y = 0.f;
#pragma unroll
            for (int i = 0; i < 4; ++i) { S[i] = S[i] * w0v[i] + sa * b0[i] + vt * m0[i]; S[4 + i] = S[4 + i] * w1v[i] + sa * b1[i] + vt * m1[i];
                y = fmaf(S[i], r0[i], y); y = fmaf(S[4 + i], r1[i], y); }
            y += __shfl_xor(y, 1); y += __shfl_xor(y, 2); y += __shfl_xor(y, 4);
            if (sq == 0) ys[tt * 64 + sv] = y;
        }
        __syncthreads();
#pragma unroll
        for (int k = 0; k < 4; ++k) { const int tt = wid * 4 + k, pos = p0 + tt; const float y = ys[tt * 64 + lane];
            const float m = wave_sum(y) * (1.f / 64.f); const float dv = y - m; const float var = wave_sum(dv * dv) * (1.f / 64.f);
            const float o = (dv * rsqrtf(var + GN_EPS) * gng + gnb + bon[tt * 64 + lane]) * gg[tt * 64 + lane];
            OB[(size_t)(b * LP + pos) * D + 512 + hd] = (bf16_t)f2bf(o); }
        __syncthreads();
    }
}

__device__ __forceinline__ int pair_index(int a, int b) {   return a == 0 ? b - 1 : (a == 1 ? b + 1 : 5); }
__device__ __forceinline__ void pair_of(int idx, int& a, int& b) { a = idx < 3 ? 0 : (idx < 5 ? 1 : 2); b = idx < 3 ? idx + 1 : (idx < 5 ? idx - 1 : 3); }
__device__ __forceinline__ void ln1_rows(const Params& p, int l, unsigned char* lds, int row0, bool stage) {
    const int tid = otid(), lane = tid & 63, gw = row0 + 8 * (tid >> 6), NGW = 1, TEND = gw + 8;
    int* lcnt = (int*)(lds + 65536); int* lbase = lcnt + 32; int* rec = lcnt + 64;
    __syncthreads();
    if (tid < 32) lcnt[tid] = 0;
    float* wr_s = (float*)lds;
    if (stage) for (int i = tid; i < D * 16 / 4; i += NTHREADS) { const f32x4 w = ((const f32x4*)p.in[I_WROUTER])[i]; const int c = i >> 2, e0 = (i & 3) * 4;
        wr_s[(e0 + 0) * D + c] = w[0]; wr_s[(e0 + 1) * D + c] = w[1]; wr_s[(e0 + 2) * D + c] = w[2]; wr_s[(e0 + 3) * D + c] = w[3]; }
    __syncthreads();
    unsigned* cls_cnt = (unsigned*)(p.ws + WS_CTL) + CW_CLS + l * 512;
    int* lists = (int*)(p.ws + WS_LIST); f32x2* gl = (f32x2*)(p.ws + WS_LIST + 2 * MiB);
    const float* g = p.in[I_LN1G] + l * D; const float* bt = p.in[I_LN1B] + l * D;
    f32x4 vn[4];
    { const float* h0 = hrow(p, gw);
#pragma unroll
      for (int j = 0; j < 4; ++j) vn[j] = *(const f32x4*)(h0 + 4 * lane + 256 * j); }
    int nrec = 0;
    for (int r = gw; r < TEND; r += NGW) {
        f32x4 v[4];
#pragma unroll
        for (int j = 0; j < 4; ++j) v[j] = vn[j];
        { const float* h1 = hrow(p, r + NGW < TEND ? r + NGW : r);
#pragma unroll
          for (int j = 0; j < 4; ++j) vn[j] = *(const f32x4*)(h1 + 4 * lane + 256 * j); }
        if (is_dummy(r)) {
#pragma unroll
            for (int j = 0; j < 4; ++j) v[j] = (f32x4){0.f, 0.f, 0.f, 0.f};
            store_row(p, r, v, lane, true); continue; }
        ln_wave(v, g, bt, lane);
        store_row(p, r, v, lane, false);
        float lg[16];
#pragma unroll
        for (int e = 0; e < 16; ++e) lg[e] = 0.f;
#pragma unroll
        for (int e = 0; e < 16; ++e)
#pragma unroll
            for (int j = 0; j < 4; ++j) { const f32x4 w = *(const f32x4*)(wr_s + e * D + 4 * lane + 256 * j);
                lg[e] = fmaf(v[j][0], w[0], lg[e]); lg[e] = fmaf(v[j][1], w[1], lg[e]); lg[e] = fmaf(v[j][2], w[2], lg[e]); lg[e] = fmaf(v[j][3], w[3], lg[e]); }
        float mine = 0.f;
#pragma unroll
        for (int e = 0; e < 16; ++e) { const float rs = sum16(lg[e]); mine = (lane & 15) == e ? rs : mine; }
        mine += __shfl_xor(mine, 16); mine += __shfl_xor(mine, 32);
#pragma unroll
        for (int e = 0; e < 16; ++e) lg[e] = __builtin_bit_cast(float, __builtin_amdgcn_readlane(__builtin_bit_cast(int, mine), e));
        float s[16], sel[16];
#pragma unroll
        for (int e = 0; e < 16; ++e) { s[e] = sigmoidf_(lg[e]); sel[e] = s[e] + p.in[I_BROUTER][e]; }
        int gbest = 0; float gsc = -INFINITY;
#pragma unroll
        for (int gi = 0; gi < 4; ++gi) { float m1 = -INFINITY, m2 = -INFINITY;
#pragma unroll
            for (int j = 0; j < 4; ++j) { const float x = sel[gi * 4 + j]; if (x > m1) { m2 = m1; m1 = x; } else if (x > m2) m2 = x; }
            const float sc = m1 + m2; if (sc > gsc) { gsc = sc; gbest = gi; } }
        float sg[4], sgs[4];
#pragma unroll
        for (int j = 0; j < 4; ++j) { sg[j] = gbest == 0 ? sel[j] : (gbest == 1 ? sel[4 + j] : (gbest == 2 ? sel[8 + j] : sel[12 + j])); sgs[j] = gbest == 0 ? s[j] : (gbest == 1 ? s[4 + j] : (gbest == 2 ? s[8 + j] : s[12 + j])); }
        int j1 = 0;
#pragma unroll
        for (int j = 1; j < 4; ++j) if (sg[j] > sg[j1]) j1 = j;
        int j2 = j1 == 0 ? 1 : 0;
#pragma unroll
        for (int j = 0; j < 4; ++j) if (j != j1 && j != j2 && sg[j] > sg[j2]) j2 = j;
        const int ja = j1 < j2 ? j1 : j2, jb = j1 < j2 ? j2 : j1;
        float sa_ = 0.f, sb_ = 0.f;
#pragma unroll
        for (int j = 0; j < 4; ++j) { if (j == ja) sa_ = sgs[j]; if (j == jb) sb_ = sgs[j]; }
        const float inv = 1.0f / (sa_ + sb_);
        const int cls = gbest * 6 + pair_index(ja, jb);
        if (lane == 0) { const int loc = __hip_atomic_fetch_add(lcnt + cls, 1, __ATOMIC_RELAXED, __HIP_MEMORY_SCOPE_WORKGROUP); rec[(tid >> 6) * 32 + 2 * nrec] = r; rec[(tid >> 6) * 32 + 2 * nrec + 1] = (cls << 16) | loc; gl[r] = (f32x2){sa_ * inv, sb_ * inv}; }
        ++nrec;
    }
    __syncthreads();
    if (tid < 24) lbase[tid] = (int)atomicAdd(cls_cnt + 16 * tid, (unsigned)lcnt[tid]);
    __syncthreads();
    if (lane < nrec) { const int r = rec[(tid >> 6) * 32 + 2 * lane], cl = rec[(tid >> 6) * 32 + 2 * lane + 1]; const int cls = cl >> 16; lists[(size_t)cls * T + lbase[cls] + (cl & 0xffff)] = r; }
}


constexpr size_t WS_CH1 = 655360;
constexpr int CH1_NM = 260, CH1_NW = 260, CH1_NC = 96, CH1_NL = 260, CH1_TOT = CH1_NM + CH1_NW + CH1_NC + CH1_NL;
__device__ __forceinline__ void task_signal(unsigned* c0, unsigned* c1) {
    asm volatile("s_waitcnt vmcnt(0)" ::: "memory");
    __syncthreads();
    if (otid() == 0) { __builtin_amdgcn_fence(__ATOMIC_RELEASE, "agent"); asm volatile("s_waitcnt vmcnt(0)" ::: "memory");
        __hip_atomic_fetch_add(c0, 1u, __ATOMIC_RELAXED, __HIP_MEMORY_SCOPE_AGENT); if (c1) __hip_atomic_fetch_add(c1, 1u, __ATOMIC_RELAXED, __HIP_MEMORY_SCOPE_AGENT); }
}
__device__ __forceinline__ void task_wait(unsigned* c, unsigned target) {
    if (otid() == 0) { unsigned sp = 0; while (__hip_atomic_load(c, __ATOMIC_RELAXED, __HIP_MEMORY_SCOPE_AGENT) < target && ++sp < (1u << 24)) __builtin_amdgcn_s_sleep(2);
        __builtin_amdgcn_fence(__ATOMIC_ACQUIRE, "agent"); asm volatile("s_waitcnt vmcnt(0)" ::: "memory"); }
    __syncthreads();
}
__device__ __forceinline__ void conv_expert_items(const Params& p, int l, LAS unsigned char* lds, int it0, int it1);
__device__ __forceinline__ void chain1_phase(int l, unsigned char* lds, LAS unsigned char* ldsl, unsigned long long& pacc) {
    unsigned long long pt0 = 0;
#define C1P_B(k) do { if (PROBE_PHASE == (k)) pt0 = __builtin_amdgcn_s_memrealtime(); } while (0)
#define C1P_E(k) do { if (PROBE_PHASE == (k)) pacc += __builtin_amdgcn_s_memrealtime() - pt0; } while (0)
    int staged = 0;
    for (;;) {
        unsigned* chq = (unsigned*)(PP().ws + WS_CH1) + 1024 * l;
        volatile int* uw = (volatile int*)(lds + 144000);
        __syncthreads();
        if (otid() == 0) *uw = (int)atomicAdd(chq, 1u);
        __syncthreads();
        const int t = __builtin_amdgcn_readfirstlane(*uw);
        if (t >= CH1_TOT) break;
        if (t < CH1_NM) { const int pm = t >> 2, pn = t & 3;
            C1P_B(50); merge_unit(l, ldsl, pm, pn);
            task_signal(chq + 64 + pm, chq + 16); C1P_E(50);
        } else if (t < CH1_NM + CH1_NW) { const int u = t - CH1_NM, pm = u >> 2, pn = u & 3;
            C1P_B(54); task_wait(chq + 64 + pm, 4u); C1P_E(54);
            C1P_B(51); wout_unit(l, ldsl, pm, pn);
            task_signal(chq + 192 + pm, nullptr); C1P_E(51);
        } else if (t < CH1_NM + CH1_NW + CH1_NC) { const int u = t - CH1_NM - CH1_NW;
            C1P_B(54); task_wait(chq + 16, (unsigned)CH1_NM); C1P_E(54);
            C1P_B(52); conv_expert_items(PP(), l, ldsl, u * 128, u * 128 + 128); C1P_E(52);
        } else { const int u = t - CH1_NM - CH1_NW - CH1_NC, pm = u >> 2, qr = u & 3;
            C1P_B(54); task_wait(chq + 16, (unsigned)CH1_NM);
            task_wait(chq + 192 + pm, 4u); C1P_E(54);
            C1P_B(53); ln1_rows(PP(), l, lds, pm * 256 + qr * 64, staged == 0); staged = 1; C1P_E(53);
        }
    }
}

struct ClsTab { int cnt[24]; int tile0[25]; int row0[24]; };
__device__ __forceinline__ void build_cls_table(const Params& p, int l, int* tab  ) {
    if (otid() == 0) { const unsigned* c = (const unsigned*)(p.ws + WS_CTL) + CW_CLS + l * 512; int acc = 0;
        for (int i = 0; i < 24; ++i) { const int n = (int)__hip_atomic_load(c + 16 * i, __ATOMIC_RELAXED, __HIP_MEMORY_SCOPE_AGENT); tab[i] = n; tab[24 + i] = acc; acc += (n + 255) >> 8; }
        tab[48] = acc; }
    __syncthreads();
}
__device__ __forceinline__ int find_cls(const int* tab, int tile) { int c = 0;
#pragma unroll 1
    for (int i = 1; i < 24; ++i) if (tile >= tab[24 + i]) c = i;
    return c; }
__device__ __forceinline__ void moe_a_unit(int l, LAS unsigned char* lds, const int* tab, int tile, int pn) {
    const int tid = otid();
    unsigned voffB[2]; g8::make_voffB(voffB, D * 2, true);
    {
        const int cls = find_cls(tab, tile), rt = tile - tab[24 + cls], n = tab[cls];
        int ja, jb; pair_of(cls % 6, ja, jb); const int eslot = pn >> 2, e = (cls / 6) * 4 + (eslot ? jb : ja), jblk = pn & 3;
        unsigned voffA[2][2]; { const int* lists = (const int*)(PP().ws + WS_LIST);
#pragma unroll
        for (int i = 0; i < 2; ++i) { int R, C; g8::stage_rc(tid * 16 + i * 8192, R, C);
#pragma unroll
            for (int hh = 0; hh < 2; ++hh) { const int li = rt * 256 + R + hh * 128; const int tok = li < n ? lists[(size_t)cls * T + li] : 0;
                voffA[hh][i] = (unsigned)tok * (D * 2) + (unsigned)C * 2u; } } }
        g8::Acc acc; g8::zero_acc(acc);
        const char* Bb = (const char*)(PP().ws + WS_WEXP) + ((size_t)e * 1024 + jblk * 256) * D * 2;
        const g8::KSeg s = g8::seg1((const char*)(PP().ws + WS_HB), Bb, Bb + (size_t)128 * D * 2, D / 64);
        g8::kloop<true, false>(lds, acc, s, voffA, voffB, 0);
        EPI_COORDS();
        const int* lists = (const int*)(PP().ws + WS_LIST); const f32x2* gl = (const f32x2*)(PP().ws + WS_LIST + 2 * MiB); bf16_t* ACT = (bf16_t*)(PP().ws + WS_ACT);
        int tk[2][4]; float gt[2][4];
#pragma unroll
        for (int ai = 0; ai < 2; ++ai)
#pragma unroll
            for (int m = 0; m < 4; ++m) { const int li = rt * 256 + ai * 128 + wr * 64 + m * 16 + fr; tk[ai][m] = li < n ? lists[(size_t)cls * T + li] : -1; }
#pragma unroll
        for (int ai = 0; ai < 2; ++ai)
#pragma unroll
            for (int m = 0; m < 4; ++m) { const f32x2 g2 = gl[tk[ai][m] >= 0 ? tk[ai][m] : 0]; gt[ai][m] = tk[ai][m] >= 0 ? (eslot ? g2[1] : g2[0]) : 0.f; }
#pragma unroll
        for (int ai = 0; ai < 2; ++ai)
#pragma unroll
            for (int m = 0; m < 4; ++m) { const float gate = gt[ai][m];
                const f32x4 h1a = acc[ai][0][m][0], h1b = acc[ai][0][m][1], h3a = acc[ai][1][m][0], h3b = acc[ai][1][m][1];
                float o[8];
#pragma unroll
                for (int c = 0; c < 4; ++c) { o[c] = gate * (h1a[c] * sigmoidf_(h1a[c])) * h3a[c]; o[4 + c] = gate * (h1b[c] * sigmoidf_(h1b[c])) * h3b[c]; }
                u32x4 w; w.x = pk2(o[0], o[1]); w.y = pk2(o[2], o[3]); w.z = pk2(o[4], o[5]); w.w = pk2(o[6], o[7]);
                *(u32x4*)(ACT + (size_t)(tile * 256 + ai * 128 + wr * 64 + m * 16 + fr) * D + eslot * 512 + jblk * 128 + wc * 32 + 8 * fq) = w; }
    }
}
__device__ __forceinline__ void moe_b_unit(int l, LAS unsigned char* lds, const int* tab, int tile, int pn) {
    unsigned voffA[2][2], voffB[2]; g8::make_voff_contig(voffA, D * 2); g8::make_voffB(voffB, 512 * 2, false);
    {
        const int cls = find_cls(tab, tile), rt = tile - tab[24 + cls], n = tab[cls];
        int ja, jb; pair_of(cls % 6, ja, jb); const int ea = (cls / 6) * 4 + ja, eb = (cls / 6) * 4 + jb;
        g8::Acc acc; g8::zero_acc(acc);
        const char* At = (const char*)(PP().ws + WS_ACT) + (size_t)tile * 256 * D * 2;
        const char* W2 = (const char*)(PP().ws + WS_WEXP + 32 * MiB);
        const char* Ba = W2 + ((size_t)ea * 1024 + pn * 256) * 512 * 2; const char* Bb = W2 + ((size_t)eb * 1024 + pn * 256) * 512 * 2;
        g8::KSeg s2 = g8::seg1(At, Ba, Ba + (size_t)128 * 512 * 2, 16); s2.nt0 = 8; s2.A2 = At + 1024; s2.B02 = Bb; s2.B12 = Bb + (size_t)128 * 512 * 2;
        g8::kloop<false, true>(lds, acc, s2, voffA, voffB, 128 * D * 2);
        EPI_COORDS();
        const int* lists = (const int*)(PP().ws + WS_LIST);
        const int col0 = pn * 256 + wc * 32 + 4 * fq;
        int tk[2][4];
#pragma unroll
        for (int ai = 0; ai < 2; ++ai)
#pragma unroll
            for (int m = 0; m < 4; ++m) { const int li = rt * 256 + ai * 128 + wr * 64 + m * 16 + fr; tk[ai][m] = li < n ? lists[(size_t)cls * T + li] : -1; }
#pragma unroll
        for (int ai = 0; ai < 2; ++ai) { asm volatile("" ::: "memory");
            f32x4 pre[4][2][2]; float* hr[4];
#pragma unroll
            for (int m = 0; m < 4; ++m) { hr[m] = hrow(PP(), tk[ai][m] >= 0 ? tk[ai][m] : 0) + col0;
#pragma unroll
                for (int bj = 0; bj < 2; ++bj)
#pragma unroll
                    for (int nn = 0; nn < 2; ++nn) pre[m][bj][nn] = *(const f32x4*)(hr[m] + bj * 128 + nn * 16); }
#pragma unroll
            for (int m = 0; m < 4; ++m) if (tk[ai][m] >= 0) {
#pragma unroll
                for (int bj = 0; bj < 2; ++bj)
#pragma unroll
                    for (int nn = 0; nn < 2; ++nn) *(f32x4*)(hr[m] + bj * 128 + nn * 16) = pre[m][bj][nn] * ALPHA + acc[ai][bj][m][nn]; } }
    }
}

__device__ __forceinline__ void chain2_phase(int l, unsigned char* lds, LAS unsigned char* ldsl, const int* tab) {
    const int ntiles = tab[48], nA = 8 * ntiles, ntot = nA + 4 * ntiles;
    for (;;) {
        unsigned* chq = (unsigned*)(PP().ws + WS_CH1) + 1024 * l + 512;
        volatile int* uw = (volatile int*)(lds + 144000);
        __syncthreads();
        if (otid() == 0) *uw = (int)atomicAdd(chq, 1u);
        __syncthreads();
        const int t = __builtin_amdgcn_readfirstlane(*uw);
        if (t >= ntot) break;
        if (t < nA) { const int tile = t >> 3;
            moe_a_unit(l, ldsl, tab, tile, t & 7);
            task_signal(chq + 16 + tile, nullptr);
        } else { const int u = t - nA, tile = u >> 2;
            task_wait(chq + 16 + tile, 8u);
            moe_b_unit(l, ldsl, tab, tile, u & 3);
        }
    }
}
__device__ __forceinline__ void ln2_phase(const Params& p, int l) {
    const int tid = otid(), lane = tid & 63, gw = obid() * NWAVES + (tid >> 6), NGW = gridDim.x * NWAVES;
    const float* g = p.in[I_LN2G] + l * D; const float* bt = p.in[I_LN2B] + l * D;
    for (int r = gw; r < T; r += NGW) {
        f32x4 v[4];
        if (is_dummy(r)) {
#pragma unroll
            for (int j = 0; j < 4; ++j) v[j] = (f32x4){0.f, 0.f, 0.f, 0.f};
            store_row(p, r, v, lane, true); continue; }
        const float* hr = hrow(p, r);
#pragma unroll
        for (int j = 0; j < 4; ++j) v[j] = *(const f32x4*)(hr + 4 * lane + 256 * j);
        ln_wave(v, g, bt, lane);
        store_row(p, r, v, lane, false);
    }
}


#define XB_TMO      128
#define XB_XCNT(j)  (256  + 64 * (j))
#define XB_XSUB(j)  (1280 + 64 * (j))
#define XB_XGEN(j)  (2304 + 64 * (j))
#define XB_TOP      3328
#define XB_TOPGEN   3392
#define XCD_BAR_WORDS 3456
#define XB_SPIN_CAP (1u << 22)
constexpr size_t WS_BAR = 8192;
constexpr int LDS_BARST = LDS_BYTES - 16;
__device__ __forceinline__ unsigned xb_ld(unsigned* p)              { return __hip_atomic_load(p, __ATOMIC_RELAXED, __HIP_MEMORY_SCOPE_AGENT); }
__device__ __forceinline__ unsigned xb_add(unsigned* p, unsigned v) { return __hip_atomic_fetch_add(p, v, __ATOMIC_RELAXED, __HIP_MEMORY_SCOPE_AGENT); }
__device__ __forceinline__ unsigned xb_xcc_id() { return (unsigned)__builtin_amdgcn_s_getreg((3 << 11) | 20) & 0xFu; }
#define XB_SPIN(cond, bar) do { unsigned _sp = 0; while (cond) { __builtin_amdgcn_s_sleep(1); \
    if ((++_sp & 255u) == 0u) { if (xb_ld(&(bar)[XB_TMO])) break; if (_sp > XB_SPIN_CAP) { atomicAdd(&(bar)[XB_TMO], 1u); break; } } } } while (0)
__device__ __forceinline__ void xcd_barrier_complete(unsigned* bar, unsigned x, unsigned& nloc, unsigned& nx) {
    const unsigned G = gridDim.x * gridDim.y * gridDim.z;
    unsigned sum, cnt, mine, sp = 0u;
    for (;;) {
        sum = 0u; cnt = 0u; mine = 0u;
#pragma unroll
        for (unsigned j = 0; j < 16; ++j) { const unsigned c = xb_ld(&bar[XB_XCNT(j)]); sum += c; cnt += (c > 0u) ? 1u : 0u; mine = (j == x) ? c : mine; }
        if (sum == G) break;
        __builtin_amdgcn_s_sleep(1);
        if ((++sp & 255u) == 0u) { if (xb_ld(&bar[XB_TMO])) break; if (sp > XB_SPIN_CAP) { atomicAdd(&bar[XB_TMO], 1u); break; } }
    }
    nloc = mine > 0u ? mine : 1u; nx = cnt > 0u ? cnt : 1u;
}
__device__ __forceinline__ void xcd_barrier(unsigned* bar, volatile LAS unsigned* st) {
    asm volatile("s_waitcnt vmcnt(0)" ::: "memory");
    __syncthreads();
    if (threadIdx.x == 0) {
        __builtin_amdgcn_s_waitcnt(0);
        const unsigned x = xb_xcc_id();
        unsigned nloc = st[0], nx = st[1];
        if (nloc == 0u) { xcd_barrier_complete(bar, x, nloc, nx); st[0] = nloc; st[1] = nx; }
        const unsigned old = xb_add(&bar[XB_XSUB(x)], 1u);
        const unsigned gen = old / nloc;
        if (old + 1u == (gen + 1u) * nloc) {
            __builtin_amdgcn_fence(__ATOMIC_RELEASE, "agent");
            asm volatile("s_waitcnt vmcnt(0)" ::: "memory");
            const unsigned og = xb_add(&bar[XB_TOP], 1u);
            const unsigned tg = og / nx;
            if (og + 1u == (tg + 1u) * nx) xb_add(&bar[XB_TOPGEN], 1u);
            else XB_SPIN(xb_ld(&bar[XB_TOPGEN]) == tg, bar);
            __builtin_amdgcn_fence(__ATOMIC_ACQUIRE, "agent");
            xb_add(&bar[XB_XGEN(x)], 1u);
            asm volatile("s_waitcnt vmcnt(0)" ::: "memory");
        } else {
            XB_SPIN(xb_ld(&bar[XB_XGEN(x)]) == gen, bar);
            __builtin_amdgcn_fence(__ATOMIC_ACQUIRE, "agent");
            asm volatile("s_waitcnt vmcnt(0)" ::: "memory");
        }
    }
    __syncthreads();
}

__global__ void __launch_bounds__(NTHREADS, 2) mega(Params p_unused) {
    extern __shared__ __attribute__((aligned(16))) unsigned char lds[];
    cg::grid_group grid = cg::this_grid();
    volatile LAS unsigned* barst = (volatile LAS unsigned*)((LAS unsigned char*)lds + LDS_BARST);
    { unsigned* bar0 = (unsigned*)(PP().ws + WS_BAR);
      if (threadIdx.x == 0) { barst[0] = 0u; barst[1] = 0u; (void)xb_add(bar0 + XB_XCNT(xb_xcc_id()), 1u); } }
    __syncthreads();
#define GBAR() xcd_barrier((unsigned*)(PP().ws + WS_BAR), barst)
    unsigned long long pr_t0 = 0, pr_acc = 0;
#define PH_BEGIN(k) do { if (PROBE_PHASE == (k)) pr_t0 = __builtin_amdgcn_s_memrealtime(); } while (0)
#define PH_END(k) do { if (PROBE_PHASE == (k)) pr_acc += __builtin_amdgcn_s_memrealtime() - pr_t0; } while (0)
#define LDSG() (lds + ozero())
#define LDSL() ((LAS unsigned char*)lds)

    PH_BEGIN(0);
    conv_small_weights(PP(), LDSL());
    ln_in_phase(PP());
    if (gridDim.y == 0x7fffffffu) grid.sync();
    GBAR();
    PH_END(0);
#pragma unroll 1
    for (int l = 0; l < DEPTH; ++l) {
        PH_BEGIN(1);
        inproj_phase(PP(), l, LDSL());
        GBAR();
        PH_END(1); PH_BEGIN(2);
        {
            unsigned* qctr = (unsigned*)(PP().ws + WS_CTL) + CW_R1Q + 2 * l;
            volatile int* uw = (volatile int*)(LDSG() + AT_UNIT);
            int ndone = 0;
            for (;;) {
                __syncthreads();
                if (otid() == 0) *uw = (int)atomicAdd(qctr, 1u);
                __syncthreads();
                const int u = *uw;
                if (u >= INP_TAIL + BATCH * NCH * 8) break;
                if (u < INP_TAIL) { inproj_tail_unit(l, LDSL(), u); continue; }
                if (PROBE_PHASE == 30) pr_t0 = __builtin_amdgcn_s_memrealtime();
                rwkv_prep_unit(PP(), l, u - INP_TAIL, LDSG(), pr_acc); ++ndone;
                if (PROBE_PHASE == 30) pr_acc += __builtin_amdgcn_s_memrealtime() - pr_t0;
            }
            asm volatile("s_waitcnt vmcnt(0)" ::: "memory");
            __syncthreads();
            if (otid() == 0 && ndone > 0) { __builtin_amdgcn_fence(__ATOMIC_RELEASE, "agent"); asm volatile("s_waitcnt vmcnt(0)" ::: "memory"); __hip_atomic_fetch_add(qctr + 1, (unsigned)ndone, __ATOMIC_RELAXED, __HIP_MEMORY_SCOPE_AGENT); }
            const int bid = obid();
            if (bid < 32) {
                if (otid() == 0) { unsigned sp = 0; while (__hip_atomic_load(qctr + 1, __ATOMIC_RELAXED, __HIP_MEMORY_SCOPE_AGENT) < (unsigned)(BATCH * NCH * 8) && ++sp < (1u << 26)) __builtin_amdgcn_s_sleep(4);
                    __builtin_amdgcn_fence(__ATOMIC_ACQUIRE, "agent"); asm volatile("s_waitcnt vmcnt(0)" ::: "memory"); }
                __syncthreads();
                rwkv_scan(PP(), l, bid, LDSG());
            }
            attn_phase(PP(), l, LDSG(), pr_acc);
        }
        GBAR();
        PH_END(2); PH_BEGIN(4);
        chain1_phase(l, LDSG(), LDSL(), pr_acc);
        GBAR();
        PH_END(4); PH_BEGIN(7);
        { int toff = 140 * 1024; asm volatile("" : "+s"(toff)); int* tab = (int*)(lds + toff);
          build_cls_table(PP(), l, tab);
          chain2_phase(l, LDSG(), LDSL(), tab); }
        GBAR();
        PH_END(8); PH_BEGIN(9);
        ln2_phase(PP(), l);
        if (l + 1 < DEPTH) GBAR();
        PH_END(9);
    }
    if (PROBE_PHASE >= 0 && blockIdx.x == PROBE_BLOCK && threadIdx.x == 0) { const unsigned long long t = __builtin_amdgcn_s_memrealtime(); while (__builtin_amdgcn_s_memrealtime() - t < pr_acc) __builtin_amdgcn_s_sleep(8); }
}

extern "C" void kernel_launch(void* const* d_in, const int* in_sizes, int n_in, void* d_out, int out_size,
                              void* d_ws, size_t ws_size, hipStream_t stream) {
    static int grid_blocks = 0;
    if (grid_blocks == 0) {
        int dev = 0, cus = 0, per_cu = 0;
        if (n_in != 29 || ws_size < WS_END || out_size != BATCH * SEQ * D) { fprintf(stderr, "kernel_launch: unexpected problem (n_in %d, ws %zu, out %d)\n", n_in, ws_size, out_size); grid_blocks = -1; return; }
        (void)hipGetDevice(&dev);
        (void)hipDeviceGetAttribute(&cus, hipDeviceAttributeMultiprocessorCount, dev);
        (void)hipFuncSetAttribute((const void*)mega, hipFuncAttributeMaxDynamicSharedMemorySize, LDS_BYTES);
        (void)hipOccupancyMaxActiveBlocksPerMultiprocessor(&per_cu, (const void*)mega, NTHREADS, LDS_BYTES);
        if (per_cu < 1) { fprintf(stderr, "occupancy query returned %d\n", per_cu); grid_blocks = -1; return; }
        grid_blocks = cus;
    }
    if (grid_blocks < 0) return;
    (void)hipMemsetAsync((char*)d_ws + WS_CTL, 0, 32768, stream);
    (void)hipMemsetAsync((char*)d_ws + WS_CH1, 0, 16384, stream);
    Params p{};
    for (int i = 0; i < 29; ++i) p.in[i] = (const float*)d_in[i];
    p.out = (float*)d_out; p.ws = (unsigned char*)d_ws;
    void* args[] = {&p};
    hipError_t e = hipLaunchCooperativeKernel((const void*)mega, dim3(grid_blocks), dim3(NTHREADS), args, LDS_BYTES, stream);
    if (e != hipSuccess) fprintf(stderr, "cooperative launch failed: %s (grid %d)\n", hipGetErrorString(e), grid_blocks);
}
```

```cpp
#include <hip/hip_runtime.h>
#include <hip/hip_cooperative_groups.h>
#include <cstdio>
#include <cstdint>
namespace cg = cooperative_groups;

#define LAS __attribute__((address_space(3)))
typedef unsigned short bf16_t;
typedef short bf16x8 __attribute__((ext_vector_type(8)));
typedef float f32x4 __attribute__((ext_vector_type(4)));
typedef float f32x2 __attribute__((ext_vector_type(2)));
typedef unsigned u32x4 __attribute__((ext_vector_type(4)));
typedef unsigned u32x2 __attribute__((ext_vector_type(2)));

constexpr int NTHREADS = 512, NWAVES = 8;
constexpr int D = 1024, BATCH = 4, SEQ = 4096, DEPTH = 2;
constexpr int LP = 4160;
constexpr int T = BATCH * LP;
constexpr int NCH = LP / 64;
constexpr int PADM = 48;
constexpr int A_COLS = 1064, R_COLS = 1792, IN_COLS = 4904;
constexpr int UA = 1280;
constexpr int UARW = 3072;
constexpr int NIN = 5120;
constexpr float LN_EPS = 1e-5f, GN_EPS = 64e-5f;
constexpr float ALPHA = 1.41421356237309515f;
constexpr int C_Q = 0, C_K = 512, C_V = 640, C_QI = 768, C_KI = 1024, C_WI = 1056;
constexpr int C_R = UA, C_RK = UA + 512, C_RV = UA + 1024, C_XW = UA + 1536, C_XA = UA + 1600, C_XG = UA + 1664;

constexpr size_t MiB = 1u << 20;
constexpr size_t WS_CTL = 0;
constexpr size_t WS_HM = 1 * MiB;
constexpr size_t WS_WSMALL = 2 * MiB;
constexpr size_t WSMALL_LAYER = 14 * MiB;
constexpr size_t WS_HB = 30 * MiB;
constexpr size_t WS_UAR = 63 * MiB;
constexpr size_t WS_GATES = 161 * MiB;
constexpr size_t WS_OAB = 226 * MiB;
constexpr size_t WS_LIST = WS_GATES + 48 * MiB;
constexpr size_t WS_END = 308 * MiB;
constexpr size_t WS_MERGED = WS_UAR;
constexpr size_t WS_ACT = WS_UAR + 33 * MiB;
constexpr size_t WS_WEXP = WS_GATES;
constexpr int ACT_ROWS_MAX = 16448 + 24 * 256;
static_assert(WS_ACT + (size_t)ACT_ROWS_MAX * 2048 <= WS_GATES, "act fits");
constexpr int CW_CLS = 1024;

constexpr int LDS_BYTES = 155648;

struct Params {
    const float* in[29];
    float* out;
    unsigned char* ws;
};
enum { I_X = 0, I_META, I_LNIN_G, I_LNIN_B, I_WIN, I_BGATE, I_MU, I_W0, I_WUP, I_A0, I_AUP, I_GUP, I_KK, I_KA, I_RK, I_GNG, I_GNB,
       I_WBA, I_WBB, I_WOUT, I_LN1G, I_LN1B, I_LN2G, I_LN2B, I_WROUTER, I_BROUTER, I_WEXP1, I_WEXP3, I_WEXP2 };

__device__ __forceinline__ int otid() { int t = threadIdx.x; asm volatile("" : "+v"(t)); return t; }
__device__ __forceinline__ const char* uptr(const char* p) { const unsigned long long v = (unsigned long long)p; const unsigned lo = __builtin_amdgcn_readfirstlane((unsigned)v), hi = __builtin_amdgcn_readfirstlane((unsigned)(v >> 32)); return (const char*)(((unsigned long long)hi << 32) | lo); }
__device__ __forceinline__ int ozero() { int z = 0; asm volatile("" : "+s"(z)); return z; }
__device__ __forceinline__ int obid() { int b = blockIdx.x; asm volatile("" : "+s"(b)); return b; }
typedef __bf16 bf16x2_t __attribute__((ext_vector_type(2)));
__device__ __forceinline__ unsigned f2bf(float f) { return (unsigned)__builtin_bit_cast(unsigned short, (__bf16)f); }
__device__ __forceinline__ unsigned pk2(float lo, float hi) { const f32x2 v = {lo, hi}; return __builtin_bit_cast(unsigned, __builtin_convertvector(v, bf16x2_t)); }
template <int CTRL> __device__ __forceinline__ float dpp_f(float v) { return __builtin_bit_cast(float, __builtin_amdgcn_update_dpp(0, __builtin_bit_cast(int, v), CTRL, 0xF, 0xF, true)); }
__device__ __forceinline__ float sum8(float v) { v += dpp_f<0xB1>(v); v += dpp_f<0x4E>(v); v += dpp_f<0x141>(v); return v; }
__device__ __forceinline__ float sum16(float v) { v = sum8(v); v += dpp_f<0x140>(v); return v; }
__device__ __forceinline__ float bf2f(unsigned short b) { return __builtin_bit_cast(float, (unsigned)b << 16); }
__device__ __forceinline__ float bflo(unsigned w) { return __builtin_bit_cast(float, w << 16); }
__device__ __forceinline__ float bfhi(unsigned w) { return __builtin_bit_cast(float, w & 0xffff0000u); }
__device__ __forceinline__ float wave_sum(float v) { v = sum16(v); v += __shfl_xor(v, 16); v += __shfl_xor(v, 32); return v; }
__device__ __forceinline__ float wave_max(float v) {
#pragma unroll
    for (int o = 1; o < 64; o <<= 1) v = fmaxf(v, __shfl_xor(v, o));
    return v;
}
__device__ __forceinline__ float sigmoidf_(float x) { return __builtin_amdgcn_rcpf(1.0f + __expf(-x)); }
__device__ __forceinline__ float* hrow(const Params& p, int r) {
    const int b = r / LP, pos = r - b * LP;
    return pos >= 64 ? p.out + ((size_t)(b * SEQ + (pos - 64)) << 10) : (float*)(p.ws + WS_HM) + ((size_t)(b * 64 + pos) << 10);
}
__device__ __forceinline__ bool is_dummy(int r) { return (r % LP) < PADM; }

__device__ __forceinline__ void transpose_item(const float* src, int ld_src, int col0, int nvalid, bf16_t* dst  , int ld_dst, LAS float* scr, int lane) {
    const int kr = lane >> 3, c4 = (lane & 7) * 4;
    f32x4 v[8];
#pragma unroll
    for (int i = 0; i < 8; ++i) v[i] = *(const f32x4*)(src + (size_t)(8 * i + kr) * ld_src + col0 + c4);
#pragma unroll
    for (int i = 0; i < 8; ++i) { LAS float* w = scr + (8 * i + kr) * 33 + c4;
        w[0] = c4 + 0 < nvalid ? v[i][0] : 0.f; w[1] = c4 + 1 < nvalid ? v[i][1] : 0.f; w[2] = c4 + 2 < nvalid ? v[i][2] : 0.f; w[3] = c4 + 3 < nvalid ? v[i][3] : 0.f; }
    asm volatile("s_waitcnt lgkmcnt(0)" ::: "memory");
    const int ch = lane & 7;
#pragma unroll
    for (int j = 0; j < 4; ++j) { const int n = (lane >> 3) + 8 * j; const LAS float* s = scr + (8 * ch) * 33 + n;
        u32x4 o; o.x = pk2(s[0 * 33], s[1 * 33]); o.y = pk2(s[2 * 33], s[3 * 33]); o.z = pk2(s[4 * 33], s[5 * 33]); o.w = pk2(s[6 * 33], s[7 * 33]);
        *(u32x4*)(dst + (size_t)n * ld_dst + 8 * ch) = o; }
    asm volatile("s_waitcnt lgkmcnt(0)" ::: "memory");
}

namespace g8 {
constexpr int BM = 256, BK = 64, HALF = 128, HTB = HALF * BK * 2, STAGE_BYTES = 8 * HTB;
__host__ __device__ __forceinline__ int lds_byte(int r, int c) { const int st = (r >> 4) * 2 + (c >> 5), rr = r & 15, cc = c & 31, ob = rr * 64 + cc * 2; return st * 1024 + (ob ^ (((ob >> 9) & 1) << 5)); }
__host__ __device__ __forceinline__ void stage_rc(int b, int& R, int& C) { const int st = b / 1024, sb = b % 1024, swz = sb ^ (((sb >> 9) & 1) << 5); R = (st >> 1) * 16 + swz / 64; C = (st & 1) * 32 + (swz % 64) / 2; }
__host__ __device__ __forceinline__ int perm32(int rho) { const int n = rho >> 4, i = rho & 15; return 8 * (i >> 2) + 4 * n + (i & 3); }

struct KSeg {
    const char* A;
    const char* B0;
    const char* B1;
    int nt;
    int nt0;
    const char* A2;
    const char* B02;
    const char* B12;
};
__device__ __forceinline__ KSeg seg1(const char* A, const char* B0, const char* B1, int nt) { KSeg s; s.A = A; s.B0 = B0; s.B1 = B1; s.nt = nt; s.nt0 = nt; s.A2 = A; s.B02 = B0; s.B12 = B1; return s; }
typedef f32x4 Acc[2][2][4][2];

template <bool GATHER, bool TWOSEG>
__device__ __forceinline__ void kloop(LAS unsigned char* lds, Acc& acc, const KSeg s, const unsigned (&voffA)[2][2], const unsigned (&voffB)[2], const unsigned hstepA) {
    int tid = threadIdx.x; asm volatile("" : "+v"(tid));
    const int wid = __builtin_amdgcn_readfirstlane(tid >> 6), lane = tid & 63, wr = wid >> 2, wc = wid & 3, fr = lane & 15, fq = lane >> 4;
    const unsigned ldsw = (unsigned)wid * 1024u;
    const int aoff = lds_byte(wr * 64 + fr, fq * 8), boff = lds_byte(wc * 32 + fr, fq * 8);
    const int nt = __builtin_amdgcn_readfirstlane(s.nt);
#define G8_SA(b, h) (((b) * 2 + (h)) * HTB)
#define G8_SB(b, h) ((4 + (b) * 2 + (h)) * HTB)
#define G8_STAGE(bufoff, gbase, voff) do { _Pragma("unroll") for (int _i = 0; _i < 2; ++_i) \
        __builtin_amdgcn_global_load_lds((const unsigned*)((const char*)(gbase) + (voff)[_i]), (LAS unsigned*)(lds + (bufoff) + ldsw + _i * 8192), 16, 0, 0); } while (0)
#define G8_LDA(dst, b, h) do { _Pragma("unroll") for (int m = 0; m < 4; ++m) _Pragma("unroll") for (int k = 0; k < 2; ++k) dst[m][k] = *(const LAS bf16x8*)(lds + G8_SA(b, h) + aoff + m * 2048 + k * 1024); } while (0)
#define G8_LDB(dst, b, h) do { _Pragma("unroll") for (int n = 0; n < 2; ++n) _Pragma("unroll") for (int k = 0; k < 2; ++k) dst[n][k] = *(const LAS bf16x8*)(lds + G8_SB(b, h) + boff + n * 2048 + k * 1024); } while (0)
#define G8_MMA(ai, bj, At, Bt) do { __builtin_amdgcn_s_setprio(1); _Pragma("unroll") for (int m = 0; m < 4; ++m) _Pragma("unroll") for (int n = 0; n < 2; ++n) _Pragma("unroll") for (int k = 0; k < 2; ++k) \
        acc[ai][bj][m][n] = __builtin_amdgcn_mfma_f32_16x16x32_bf16(Bt[n][k], At[m][k], acc[ai][bj][m][n], 0, 0, 0); __builtin_amdgcn_s_setprio(0); } while (0)
#define G8_WAIT_V(n) asm volatile("s_waitcnt vmcnt(" #n ")" ::: "memory")
#define G8_WAIT_L(n) asm volatile("s_waitcnt lgkmcnt(" #n ")" ::: "memory")
#define G8_BAR __builtin_amdgcn_s_barrier()
#define G8_SCHED __builtin_amdgcn_sched_barrier(0)
    bf16x8 At[4][2], B0[2][2], B1[2][2];
    const char* pA = uptr(s.A); const char* pB0 = uptr(s.B0); const char* pB1 = uptr(s.B1);
    constexpr int KS = BK * 2;
    const int nt0 = TWOSEG ? s.nt0 : 0; const char* qA = TWOSEG ? uptr(s.A2 - (size_t)nt0 * KS) : pA; const char* qB0 = TWOSEG ? uptr(s.B02 - (size_t)nt0 * KS) : pB0; const char* qB1 = TWOSEG ? uptr(s.B12 - (size_t)nt0 * KS) : pB1;
#define G8_TA(t) ((TWOSEG ? ((t) < nt0 ? pA : qA) : pA) + (size_t)(t) * KS)
#define G8_TB0(t) ((TWOSEG ? ((t) < nt0 ? pB0 : qB0) : pB0) + (size_t)(t) * KS)
#define G8_TB1(t) ((TWOSEG ? ((t) < nt0 ? pB1 : qB1) : pB1) + (size_t)(t) * KS)
#define G8_VA1 voffA[GATHER ? 1 : 0]
#define G8_H1(ptr) ((ptr) + (GATHER ? 0u : hstepA))
    G8_STAGE(G8_SB(0, 0), pB0, voffB); G8_STAGE(G8_SA(0, 0), pA, voffA[0]); G8_STAGE(G8_SB(0, 1), pB1, voffB); G8_STAGE(G8_SA(0, 1), G8_H1(pA), G8_VA1);
    if (wr == 1) G8_BAR;
    G8_WAIT_V(4); G8_BAR;
    G8_STAGE(G8_SB(1, 0), pB0 + KS, voffB); G8_STAGE(G8_SA(1, 0), pA + KS, voffA[0]); G8_STAGE(G8_SB(1, 1), pB1 + KS, voffB);
    G8_WAIT_V(6); G8_BAR;
    for (int t = 0; t < nt - 2; t += 2) {
        const char* a1 = G8_TA(t + 1);
        const char* a2 = G8_TA(t + 2); const char* b02 = G8_TB0(t + 2); const char* b12 = G8_TB1(t + 2);
        const char* a3 = G8_TA(t + 3); const char* b03 = G8_TB0(t + 3); const char* b13 = G8_TB1(t + 3);
        G8_LDB(B0, 0, 0); G8_SCHED; G8_LDA(At, 0, 0); G8_STAGE(G8_SA(1, 1), G8_H1(a1), G8_VA1);
        G8_WAIT_L(8); G8_BAR; G8_WAIT_L(0); G8_MMA(0, 0, At, B0); G8_BAR; G8_SCHED;
        G8_LDB(B1, 0, 1); G8_STAGE(G8_SB(0, 0), b02, voffB);
        G8_BAR; G8_WAIT_L(0); G8_MMA(0, 1, At, B1); G8_BAR;
        G8_LDA(At, 0, 1); G8_STAGE(G8_SA(0, 0), a2, voffA[0]);
        G8_BAR; G8_WAIT_L(0); G8_MMA(1, 0, At, B0); G8_BAR; G8_SCHED;
        G8_STAGE(G8_SB(0, 1), b12, voffB);
        G8_WAIT_V(6); G8_BAR; G8_MMA(1, 1, At, B1); G8_BAR;
        G8_LDB(B0, 1, 0); G8_SCHED; G8_LDA(At, 1, 0); G8_STAGE(G8_SA(0, 1), G8_H1(a2), G8_VA1);
        G8_WAIT_L(8); G8_BAR; G8_WAIT_L(0); G8_MMA(0, 0, At, B0); G8_BAR; G8_SCHED;
        G8_LDB(B1, 1, 1); G8_STAGE(G8_SB(1, 0), b03, voffB);
        G8_BAR; G8_WAIT_L(0); G8_MMA(0, 1, At, B1); G8_BAR;
        G8_LDA(At, 1, 1); G8_STAGE(G8_SA(1, 0), a3, voffA[0]);
        G8_BAR; G8_WAIT_L(0); G8_MMA(1, 0, At, B0); G8_BAR; G8_SCHED;
        G8_STAGE(G8_SB(1, 1), b13, voffB);
        G8_WAIT_V(6); G8_BAR; G8_MMA(1, 1, At, B1); G8_BAR;
    }
    { const char* a1 = G8_TA(nt - 1);
      G8_LDB(B0, 0, 0); G8_LDA(At, 0, 0); G8_STAGE(G8_SA(1, 1), G8_H1(a1), G8_VA1);
      G8_BAR; G8_WAIT_L(0); G8_MMA(0, 0, At, B0); G8_BAR;
      G8_LDB(B1, 0, 1); G8_BAR; G8_WAIT_L(0); G8_MMA(0, 1, At, B1); G8_BAR;
      G8_LDA(At, 0, 1); G8_WAIT_V(4); G8_BAR; G8_WAIT_L(0); G8_MMA(1, 0, At, B0); G8_MMA(1, 1, At, B1); G8_BAR; }
    { G8_LDB(B0, 1, 0); G8_LDA(At, 1, 0); G8_WAIT_V(2); G8_BAR; G8_WAIT_L(0); G8_MMA(0, 0, At, B0); G8_BAR;
      G8_LDB(B1, 1, 1); G8_WAIT_V(0); G8_BAR; G8_WAIT_L(0); G8_MMA(0, 1, At, B1); G8_BAR;
      G8_LDA(At, 1, 1); G8_BAR; G8_WAIT_L(0); G8_MMA(1, 0, At, B0); G8_MMA(1, 1, At, B1); G8_BAR; }
    if (wr == 0) G8_BAR;
#undef G8_TA
#undef G8_VA1
#undef G8_H1
#undef G8_TB0
#undef G8_TB1
#undef G8_SA
#undef G8_SB
#undef G8_STAGE
#undef G8_LDA
#undef G8_LDB
#undef G8_MMA
#undef G8_WAIT_V
#undef G8_WAIT_L
#undef G8_BAR
#undef G8_SCHED
}
template <bool GATHER, bool TWOSEG>
__device__ __forceinline__ void kstream(LAS unsigned char* lds, Acc& acc, const KSeg s, const KSeg nx, const bool first, const unsigned (&voffA)[2][2], const unsigned (&voffB)[2], const unsigned hstepA) {
    int tid = threadIdx.x; asm volatile("" : "+v"(tid));
    const int wid = __builtin_amdgcn_readfirstlane(tid >> 6), lane = tid & 63, wr = wid >> 2, wc = wid & 3, fr = lane & 15, fq = lane >> 4;
    const unsigned ldsw = (unsigned)wid * 1024u;
    const int aoff = lds_byte(wr * 64 + fr, fq * 8), boff = lds_byte(wc * 32 + fr, fq * 8);
    const int nt = __builtin_amdgcn_readfirstlane(s.nt);
#define G8_SA(b, h) (((b) * 2 + (h)) * HTB)
#define G8_SB(b, h) ((4 + (b) * 2 + (h)) * HTB)
#define G8_STAGE(bufoff, gbase, voff) do { _Pragma("unroll") for (int _i = 0; _i < 2; ++_i) \
        __builtin_amdgcn_global_load_lds((const unsigned*)((const char*)(gbase) + (voff)[_i]), (LAS unsigned*)(lds + (bufoff) + ldsw + _i * 8192), 16, 0, 0); } while (0)
#define G8_LDA(dst, b, h) do { _Pragma("unroll") for (int m = 0; m < 4; ++m) _Pragma("unroll") for (int k = 0; k < 2; ++k) dst[m][k] = *(const LAS bf16x8*)(lds + G8_SA(b, h) + aoff + m * 2048 + k * 1024); } while (0)
#define G8_LDB(dst, b, h) do { _Pragma("unroll") for (int n = 0; n < 2; ++n) _Pragma("unroll") for (int k = 0; k < 2; ++k) dst[n][k] = *(const LAS bf16x8*)(lds + G8_SB(b, h) + boff + n * 2048 + k * 1024); } while (0)
#define G8_MMA(ai, bj, At, Bt) do { __builtin_amdgcn_s_setprio(1); _Pragma("unroll") for (int m = 0; m < 4; ++m) _Pragma("unroll") for (int n = 0; n < 2; ++n) _Pragma("unroll") for (int k = 0; k < 2; ++k) \
        acc[ai][bj][m][n] = __builtin_amdgcn_mfma_f32_16x16x32_bf16(Bt[n][k], At[m][k], acc[ai][bj][m][n], 0, 0, 0); __builtin_amdgcn_s_setprio(0); } while (0)
#define G8_WAIT_V(n) asm volatile("s_waitcnt vmcnt(" #n ")" ::: "memory")
#define G8_WAIT_L(n) asm volatile("s_waitcnt lgkmcnt(" #n ")" ::: "memory")
#define G8_BAR __builtin_amdgcn_s_barrier()
#define G8_SCHED __builtin_amdgcn_sched_barrier(0)
    bf16x8 At[4][2], B0[2][2], B1[2][2];
    const char* pA = uptr(s.A); const char* pB0 = uptr(s.B0); const char* pB1 = uptr(s.B1);
    constexpr int KS = BK * 2;
    const int nt0 = TWOSEG ? s.nt0 : 0; const char* qA = TWOSEG ? uptr(s.A2 - (size_t)nt0 * KS) : pA; const char* qB0 = TWOSEG ? uptr(s.B02 - (size_t)nt0 * KS) : pB0; const char* qB1 = TWOSEG ? uptr(s.B12 - (size_t)nt0 * KS) : pB1;
    const char* nA = uptr(nx.A) - (size_t)nt * KS; const char* nB0 = uptr(nx.B0) - (size_t)nt * KS; const char* nB1 = uptr(nx.B1) - (size_t)nt * KS;
#define G8_TA(t) (((t) >= nt ? nA : (TWOSEG ? ((t) < nt0 ? pA : qA) : pA)) + (size_t)(t) * KS)
#define G8_TB0(t) (((t) >= nt ? nB0 : (TWOSEG ? ((t) < nt0 ? pB0 : qB0) : pB0)) + (size_t)(t) * KS)
#define G8_TB1(t) (((t) >= nt ? nB1 : (TWOSEG ? ((t) < nt0 ? pB1 : qB1) : pB1)) + (size_t)(t) * KS)
#define G8_VA1 voffA[GATHER ? 1 : 0]
#define G8_H1(ptr) ((ptr) + (GATHER ? 0u : hstepA))
    if (first) {
    G8_STAGE(G8_SB(0, 0), pB0, voffB); G8_STAGE(G8_SA(0, 0), pA, voffA[0]); G8_STAGE(G8_SB(0, 1), pB1, voffB); G8_STAGE(G8_SA(0, 1), G8_H1(pA), G8_VA1);
    if (wr == 1) G8_BAR;
    G8_WAIT_V(4); G8_BAR;
    G8_STAGE(G8_SB(1, 0), pB0 + KS, voffB); G8_STAGE(G8_SA(1, 0), pA + KS, voffA[0]); G8_STAGE(G8_SB(1, 1), pB1 + KS, voffB);
    G8_WAIT_V(6); G8_BAR;
    }
    for (int t = 0; t < nt; t += 2) {
        const char* a1 = G8_TA(t + 1);
        const char* a2 = G8_TA(t + 2); const char* b02 = G8_TB0(t + 2); const char* b12 = G8_TB1(t + 2);
        const char* a3 = G8_TA(t + 3); const char* b03 = G8_TB0(t + 3); const char* b13 = G8_TB1(t + 3);
        G8_LDB(B0, 0, 0); G8_SCHED; G8_LDA(At, 0, 0); G8_STAGE(G8_SA(1, 1), G8_H1(a1), G8_VA1);
        G8_WAIT_L(8); G8_BAR; G8_WAIT_L(0); G8_MMA(0, 0, At, B0); G8_BAR; G8_SCHED;
        G8_LDB(B1, 0, 1); G8_STAGE(G8_SB(0, 0), b02, voffB);
        G8_BAR; G8_WAIT_L(0); G8_MMA(0, 1, At, B1); G8_BAR;
        G8_LDA(At, 0, 1); G8_STAGE(G8_SA(0, 0), a2, voffA[0]);
        G8_BAR; G8_WAIT_L(0); G8_MMA(1, 0, At, B0); G8_BAR; G8_SCHED;
        G8_STAGE(G8_SB(0, 1), b12, voffB);
        G8_WAIT_V(6); G8_BAR; G8_MMA(1, 1, At, B1); G8_BAR;
        G8_LDB(B0, 1, 0); G8_SCHED; G8_LDA(At, 1, 0); G8_STAGE(G8_SA(0, 1), G8_H1(a2), G8_VA1);
        G8_WAIT_L(8); G8_BAR; G8_WAIT_L(0); G8_MMA(0, 0, At, B0); G8_BAR; G8_SCHED;
        G8_LDB(B1, 1, 1); G8_STAGE(G8_SB(1, 0), b03, voffB);
        G8_BAR; G8_WAIT_L(0); G8_MMA(0, 1, At, B1); G8_BAR;
        G8_LDA(At, 1, 1); G8_STAGE(G8_SA(1, 0), a3, voffA[0]);
        G8_BAR; G8_WAIT_L(0); G8_MMA(1, 0, At, B0); G8_BAR; G8_SCHED;
        G8_STAGE(G8_SB(1, 1), b13, voffB);
        G8_WAIT_V(6); G8_BAR; G8_MMA(1, 1, At, B1); G8_BAR;
    }
#undef G8_TA
#undef G8_VA1
#undef G8_H1
#undef G8_TB0
#undef G8_TB1
#undef G8_SA
#undef G8_SB
#undef G8_STAGE
#undef G8_LDA
#undef G8_LDB
#undef G8_MMA
#undef G8_WAIT_V
#undef G8_WAIT_L
#undef G8_BAR
#undef G8_SCHED
}
__device__ __forceinline__ void kstream_end() { asm volatile("s_waitcnt vmcnt(0)" ::: "memory"); __builtin_amdgcn_s_barrier(); }
__device__ __forceinline__ void zero_acc(Acc& acc) {
#pragma unroll
    for (int a = 0; a < 2; ++a)
#pragma unroll
        for (int b = 0; b < 2; ++b)
#pragma unroll
            for (int m = 0; m < 4; ++m)
#pragma unroll
                for (int n = 0; n < 2; ++n) acc[a][b][m][n] = (f32x4){0.f, 0.f, 0.f, 0.f};
}
__device__ __forceinline__ void make_voff_contig(unsigned (&voffA)[2][2], unsigned pitchA) {
    int tid = threadIdx.x; asm volatile("" : "+v"(tid));
#pragma unroll
    for (int i = 0; i < 2; ++i) { int R, C; stage_rc(tid * 16 + i * 8192, R, C);
        voffA[0][i] = (unsigned)R * pitchA + (unsigned)C * 2u; voffA[1][i] = 0u; }
}
__device__ __forceinline__ void make_voffB(unsigned (&voffB)[2], unsigned pitchB, bool perm) {
    int tid = threadIdx.x; asm volatile("" : "+v"(tid));
#pragma unroll
    for (int i = 0; i < 2; ++i) { int R, C; stage_rc(tid * 16 + i * 8192, R, C); const int Rb = perm ? ((R & ~31) + perm32(R & 31)) : R;
        voffB[i] = (unsigned)Rb * pitchB + (unsigned)C * 2u; }
}
}

__device__ __forceinline__ bool unit_order(int i, int G, int c, int nM, int nN, int& pm, int& pn) {
    const int nwg = nM * nN; const long L = (long)i * G + c; if (L >= nwg) return false;
    int wgid = (int)L; { const int q = nwg / 8, r = nwg % 8, xcd = wgid % 8, off = wgid / 8; wgid = (xcd < r ? xcd * (q + 1) : r * (q + 1) + (xcd - r) * q) + off; }
    const int WGM = 8, nig = WGM * nN, gid = wgid / nig, fm = gid * WGM, gsz = (nM - fm) < WGM ? (nM - fm) : WGM;
    pm = fm + ((wgid % nig) % gsz); pn = (wgid % nig) / gsz; return true;
}

__device__ __forceinline__ void conv_small_weights(const Params& p, LAS unsigned char* lds) {
    const int tid = otid(), lane = tid & 63, wave = tid >> 6, gw = obid() * NWAVES + wave, NGW = gridDim.x * NWAVES;
    LAS float* scr = (LAS float*)(lds + wave * 16384);
    constexpr int I_IN = 16 * (NIN / 32), I_A = 8 * 32, I_O = 16 * 32, I_L = 64, PER = I_IN + 2 * I_A + I_O + I_L;
    for (int it = gw; it < DEPTH * PER; it += NGW) {
        const int l = it / PER; int r = it % PER;
        unsigned char* wl = p.ws + WS_WSMALL + (size_t)l * WSMALL_LAYER;
        if (r < I_IN) { const int kb = r / (NIN / 32), nb = r % (NIN / 32), n0 = nb * 32, k0 = kb * 64;
            int col0, nvalid; if (n0 < UA) { col0 = n0; nvalid = A_COLS - n0; nvalid = nvalid < 0 ? 0 : (nvalid > 32 ? 32 : nvalid); } else { col0 = n0 - (UA - A_COLS); nvalid = 32; }
            transpose_item(p.in[I_WIN] + (size_t)l * D * IN_COLS + (size_t)k0 * IN_COLS, IN_COLS, col0, nvalid, (bf16_t*)wl + (size_t)n0 * D + k0, D, scr, lane); continue; }
        r -= I_IN;
        if (r < 2 * I_A) { const int which = r / I_A; r %= I_A; const int kb = r / 32, nb = r % 32;
            const float* src = p.in[which ? I_WBB : I_WBA] + (size_t)l * 512 * D + (size_t)(kb * 64) * D;
            transpose_item(src, D, nb * 32, 32, (bf16_t*)(wl + (10 + which) * MiB) + (size_t)(nb * 32) * 512 + kb * 64, 512, scr, lane); continue; }
        r -= 2 * I_A;
        if (r < I_O) { const int kb = r / 32, nb = r % 32;
          transpose_item(p.in[I_WOUT] + (size_t)l * D * D + (size_t)(kb * 64) * D, D, nb * 32, 32, (bf16_t*)(wl + 12 * MiB) + (size_t)(nb * 32) * D + kb * 64, D, scr, lane); continue; }
        r -= I_O;
        { bf16_t* lo = (bf16_t*)(p.ws + 65536 + (size_t)l * 262144);
          if (r < 16) transpose_item(p.in[I_WUP] + (size_t)l * 64 * 512, 512, r * 32, 32, lo + (size_t)(r * 32) * 64, 64, scr, lane);
          else if (r < 32) transpose_item(p.in[I_AUP] + (size_t)l * 64 * 512, 512, (r - 16) * 32, 32, lo + 32768 + (size_t)((r - 16) * 32) * 64, 64, scr, lane);
          else { const int q = r - 32, kb = q >> 4, nb = q & 15; transpose_item(p.in[I_GUP] + (size_t)l * 128 * 512 + (size_t)(kb * 64) * 512, 512, nb * 32, 32, lo + 65536 + (size_t)(nb * 32) * 128 + kb * 64, 128, scr, lane); } }
    }
}
__device__ __forceinline__ void conv_expert_items(const Params& p, int l, LAS unsigned char* lds, int it0, int it1) {
    const int tid = otid(), lane = tid & 63, wave = tid >> 6, gw = it0 + wave, NGW = NWAVES;
    LAS float* scr = (LAS float*)(lds + wave * 16384);
    constexpr int I_13 = 16 * 32, I_2 = 8 * 32, PER = I_13 + I_2;
    for (int it = gw; it < it1; it += NGW) {
        const int e = it / PER; int r = it % PER;
        if (r < I_13) { const int kb = r / 32, nb = r % 32, n0 = nb * 32, j = n0 >> 8, half = (n0 >> 7) & 1, c = 128 * j + (n0 & 127);
            const float* src = p.in[half ? I_WEXP3 : I_WEXP1] + (size_t)(l * 16 + e) * D * 512 + (size_t)(kb * 64) * 512;
            transpose_item(src, 512, c, 32, (bf16_t*)(p.ws + WS_WEXP) + (size_t)e * 1024 * 1024 + (size_t)n0 * 1024 + kb * 64, 1024, scr, lane); continue; }
        r -= I_13;
        { const int kb = r / 32, nb = r % 32;
          const float* src = p.in[I_WEXP2] + (size_t)(l * 16 + e) * 512 * D + (size_t)(kb * 64) * D;
          transpose_item(src, D, nb * 32, 32, (bf16_t*)(p.ws + WS_WEXP + 32 * MiB) + (size_t)e * 1024 * 512 + (size_t)(nb * 32) * 512 + kb * 64, 512, scr, lane); }
    }
}

__device__ __forceinline__ void ln_wave(f32x4 (&v)[4], const float* g, const float* bta, int lane) {
    float s = 0.f;
#pragma unroll
    for (int j = 0; j < 4; ++j) s += (v[j][0] + v[j][1]) + (v[j][2] + v[j][3]);
    const float mean = wave_sum(s) * (1.f / D); float s2 = 0.f;
#pragma unroll
    for (int j = 0; j < 4; ++j) { v[j] = v[j] - mean; s2 += (v[j][0] * v[j][0] + v[j][1] * v[j][1]) + (v[j][2] * v[j][2] + v[j][3] * v[j][3]); }
    const float rstd = __builtin_amdgcn_rsqf(wave_sum(s2) * (1.f / D) + LN_EPS);
#pragma unroll
    for (int j = 0; j < 4; ++j) { const f32x4 gg = *(const f32x4*)(g + 4 * lane + 256 * j), bb = *(const f32x4*)(bta + 4 * lane + 256 * j); v[j] = v[j] * rstd * gg + bb; }
}
__device__ __forceinline__ void store_row(const Params& p, int r, const f32x4 (&v)[4], int lane, bool zero) {
    float* hr = hrow(p, r); bf16_t* hb = (bf16_t*)(p.ws + WS_HB) + (size_t)r * D;
#pragma unroll
    for (int j = 0; j < 4; ++j) { const f32x4 o = zero ? (f32x4){0.f, 0.f, 0.f, 0.f} : v[j];
        *(f32x4*)(hr + 4 * lane + 256 * j) = o; u32x2 w; w.x = pk2(o[0], o[1]); w.y = pk2(o[2], o[3]); *(u32x2*)(hb + 4 * lane + 256 * j) = w; }
}
__device__ __forceinline__ void ln_in_phase(const Params& p) {
    const int tid = otid(), lane = tid & 63, gw = obid() * NWAVES + (tid >> 6), NGW = gridDim.x * NWAVES;
    for (int r = gw; r < T; r += NGW) {
        const int b = r / LP, pos = r - b * LP; f32x4 v[4];
        if (pos < PADM) {
#pragma unroll
            for (int j = 0; j < 4; ++j) v[j] = (f32x4){0.f, 0.f, 0.f, 0.f};
            store_row(p, r, v, lane, true); continue; }
        const float* src = pos < 64 ? p.in[I_META] + (size_t)(pos - PADM) * D : p.in[I_X] + ((size_t)(b * SEQ + pos - 64) << 10);
#pragma unroll
        for (int j = 0; j < 4; ++j) v[j] = *(const f32x4*)(src + 4 * lane + 256 * j);
        ln_wave(v, p.in[I_LNIN_G], p.in[I_LNIN_B], lane);
        store_row(p, r, v, lane, false);
    }
}

__device__ __forceinline__ const Params& PP() { const Params* q = (const Params*)__builtin_amdgcn_kernarg_segment_ptr(); asm volatile("" : "+s"(q)); return *q; }

#define EPI_COORDS() int tid_ = threadIdx.x; asm volatile("" : "+v"(tid_)); const int wid = tid_ >> 6, lane = tid_ & 63, wr = wid >> 2, wc = wid & 3, fr = lane & 15, fq = lane >> 4; (void)wr; (void)wc; (void)fr; (void)fq
__device__ __forceinline__ void inproj_epi(const g8::Acc& acc, int l, int pm, int pn) {
    EPI_COORDS();
    const int row0 = pm * 256 + wr * 64 + fr;
    if (pn < 12) {
        bf16_t* O = (bf16_t*)(PP().ws + WS_UAR);
#pragma unroll
        for (int ai = 0; ai < 2; ++ai)
#pragma unroll
            for (int m = 0; m < 4; ++m) { asm volatile("" ::: "memory"); bf16_t* rp = O + (size_t)(row0 + ai * 128 + m * 16) * UARW + pn * 256 + wc * 32 + 8 * fq;
#pragma unroll
                for (int bj = 0; bj < 2; ++bj) { const f32x4 v0 = acc[ai][bj][m][0], v1 = acc[ai][bj][m][1]; u32x4 w; w.x = pk2(v0[0], v0[1]); w.y = pk2(v0[2], v0[3]); w.z = pk2(v1[0], v1[1]); w.w = pk2(v1[2], v1[3]);
                    *(u32x4*)(rp + bj * 128) = w; } }
    } else {
        bf16_t* O = (bf16_t*)(PP().ws + WS_GATES); const int colb = (pn - 12) * 256 + wc * 32 + 8 * fq; const float* bg = PP().in[I_BGATE] + l * 2048;
        f32x4 bv[2][2];
#pragma unroll
        for (int bj = 0; bj < 2; ++bj) { bv[bj][0] = *(const f32x4*)(bg + colb + bj * 128); bv[bj][1] = *(const f32x4*)(bg + colb + bj * 128 + 4); }
#pragma unroll
        for (int ai = 0; ai < 2; ++ai)
#pragma unroll
            for (int m = 0; m < 4; ++m) { asm volatile("" ::: "memory"); bf16_t* rp = O + (size_t)(row0 + ai * 128 + m * 16) * 2048 + colb;
#pragma unroll
                for (int bj = 0; bj < 2; ++bj) { f32x4 v0 = acc[ai][bj][m][0] + bv[bj][0], v1 = acc[ai][bj][m][1] + bv[bj][1];
#pragma unroll
                    for (int e = 0; e < 4; ++e) { v0[e] = sigmoidf_(v0[e]); v1[e] = sigmoidf_(v1[e]); }
                    u32x4 w; w.x = pk2(v0[0], v0[1]); w.y = pk2(v0[2], v0[3]); w.z = pk2(v1[0], v1[1]); w.w = pk2(v1[2], v1[3]);
                    *(u32x4*)(rp + bj * 128) = w; } }
    }
}
constexpr int INP_MAIN = 62 * 20 + 3 * 12, INP_TAIL = 24;
__device__ __forceinline__ bool inproj_order(int i, int G, int c, int& pm, int& pn) {
    const long L = (long)i * G + c; if (L >= INP_MAIN) return false;
    if (L < 62 * 20) return unit_order(i, G, c, 62, 20, pm, pn);
    const int r = (int)L - 62 * 20; pm = 62 + r / 12; pn = r % 12; return true;
}
__device__ __forceinline__ void inproj_phase(const Params& p, int l, LAS unsigned char* lds) {
    unsigned voffA[2][2], voffB[2]; g8::make_voff_contig(voffA, D * 2); g8::make_voffB(voffB, D * 2, true);
    int pm, pn, pm2 = 0, pn2 = 0; const int bid = obid(); const int wr_ = __builtin_amdgcn_readfirstlane(otid() >> 6) >> 2;
    bool has = inproj_order(0, gridDim.x, bid, pm, pn), first = true;
    g8::Acc acc; g8::zero_acc(acc);
    for (int i = 0; has; ++i) {
        const bool hasn = inproj_order(i + 1, gridDim.x, bid, pm2, pn2);
        const char* Ab = (const char*)(PP().ws + WS_HB); const char* Bb = (const char*)(PP().ws + WS_WSMALL + (size_t)l * WSMALL_LAYER);
        const g8::KSeg s = g8::seg1(Ab + (size_t)pm * 256 * D * 2, Bb + (size_t)pn * 256 * D * 2, Bb + (size_t)(pn * 256 + 128) * D * 2, D / 64);
        const int pmn = hasn ? pm2 : pm, pnn = hasn ? pn2 : pn;
        const g8::KSeg nx = g8::seg1(Ab + (size_t)pmn * 256 * D * 2, Bb + (size_t)pnn * 256 * D * 2, Bb + (size_t)(pnn * 256 + 128) * D * 2, D / 64);
        if (!first && wr_ == 1) __builtin_amdgcn_s_barrier();
        g8::kstream<false, false>(lds, acc, s, nx, first, voffA, voffB, 128 * D * 2); first = false;
        if (wr_ == 0) __builtin_amdgcn_s_barrier();
        inproj_epi(acc, l, pm, pn);
        g8::zero_acc(acc); has = hasn; pm = pm2; pn = pn2;
    }
    if (!first) g8::kstream_end();
}
__device__ __forceinline__ void inproj_tail_unit(int l, LAS unsigned char* lds, int g) {
    unsigned voffA[2][2], voffB[2]; g8::make_voff_contig(voffA, D * 2); g8::make_voffB(voffB, D * 2, true);
    const int pm = 62 + (g >> 3), pn = 12 + (g & 7);
    g8::Acc acc; g8::zero_acc(acc);
    const char* Ab = (const char*)(PP().ws + WS_HB); const char* Bb = (const char*)(PP().ws + WS_WSMALL + (size_t)l * WSMALL_LAYER);
    const g8::KSeg s = g8::seg1(Ab + (size_t)pm * 256 * D * 2, Bb + (size_t)pn * 256 * D * 2, Bb + (size_t)(pn * 256 + 128) * D * 2, D / 64);
    g8::kloop<false, false>(lds, acc, s, voffA, voffB, 128 * D * 2);
    inproj_epi(acc, l, pm, pn);
}
__device__ __forceinline__ void merge_unit(int l, LAS unsigned char* lds, int pm, int pn) {
    unsigned voffA[2][2], voffB[2]; g8::make_voff_contig(voffA, D * 2); g8::make_voffB(voffB, 512 * 2, true);
    {
        const int wr_ = __builtin_amdgcn_readfirstlane(otid() >> 6) >> 2;
        g8::Acc acc; g8::zero_acc(acc);
#pragma unroll 1
        for (int br = 0; br < 2; ++br) {
            const char* Bt = (const char*)(PP().ws + WS_WSMALL + (size_t)l * WSMALL_LAYER) + (10 + br) * MiB + (size_t)pn * 256 * 512 * 2;
            const char* Bn = (const char*)(PP().ws + WS_WSMALL + (size_t)l * WSMALL_LAYER) + 11 * MiB + (size_t)pn * 256 * 512 * 2;
            const g8::KSeg s = g8::seg1((const char*)(PP().ws + WS_OAB) + (size_t)pm * 256 * D * 2 + br * 1024, Bt, Bt + (size_t)128 * 512 * 2, 8);
            const g8::KSeg nx = g8::seg1((const char*)(PP().ws + WS_OAB) + (size_t)pm * 256 * D * 2 + 1024, Bn, Bn + (size_t)128 * 512 * 2, 8);
            if (br && wr_ == 1) __builtin_amdgcn_s_barrier();
            g8::kstream<false, false>(lds, acc, s, nx, br == 0, voffA, voffB, 128 * D * 2);
            if (wr_ == 0) __builtin_amdgcn_s_barrier();
            EPI_COORDS();
            const bf16_t* GT = (const bf16_t*)(PP().ws + WS_GATES); bf16_t* O = (bf16_t*)(PP().ws + WS_MERGED);
            const int row0 = pm * 256 + wr * 64 + fr, colb = pn * 256 + wc * 32 + 8 * fq;
#pragma unroll
            for (int ai = 0; ai < 2; ++ai) { asm volatile("" ::: "memory");
                u32x4 gq[4][2], pq[4][2];
#pragma unroll
                for (int m = 0; m < 4; ++m) { const size_t ro = (size_t)(row0 + ai * 128 + m * 16); const bf16_t* gp = GT + ro * 2048 + br * 1024 + colb; const bf16_t* op = O + ro * D + colb;
#pragma unroll
                    for (int bj = 0; bj < 2; ++bj) { gq[m][bj] = *(const u32x4*)(gp + bj * 128); pq[m][bj] = br ? *(const u32x4*)(op + bj * 128) : (u32x4){0u, 0u, 0u, 0u}; } }
#pragma unroll
                for (int m = 0; m < 4; ++m) { const size_t ro = (size_t)(row0 + ai * 128 + m * 16); bf16_t* op = O + ro * D + colb;
#pragma unroll
                    for (int bj = 0; bj < 2; ++bj) { const u32x4 g = gq[m][bj], pr = pq[m][bj]; const f32x4 v0 = acc[ai][bj][m][0], v1 = acc[ai][bj][m][1];
                        u32x4 w; w.x = pk2(v0[0] * bflo(g.x) + bflo(pr.x), v0[1] * bfhi(g.x) + bfhi(pr.x)); w.y = pk2(v0[2] * bflo(g.y) + bflo(pr.y), v0[3] * bfhi(g.y) + bfhi(pr.y));
                        w.z = pk2(v1[0] * bflo(g.z) + bflo(pr.z), v1[1] * bfhi(g.z) + bfhi(pr.z)); w.w = pk2(v1[2] * bflo(g.w) + bflo(pr.w), v1[3] * bfhi(g.w) + bfhi(pr.w));
                        *(u32x4*)(op + bj * 128) = w; } } }
            g8::zero_acc(acc);
        }
        g8::kstream_end();
    }
}
__device__ __forceinline__ void wout_unit(int l, LAS unsigned char* lds, int pm, int pn) {
    unsigned voffA[2][2], voffB[2]; g8::make_voff_contig(voffA, D * 2); g8::make_voffB(voffB, D * 2, false);
    g8::Acc acc; g8::zero_acc(acc);
    const char* Ab = (const char*)(PP().ws + WS_MERGED); const char* Bb = (const char*)(PP().ws + WS_WSMALL + (size_t)l * WSMALL_LAYER + 12 * MiB);
    const g8::KSeg s = g8::seg1(Ab + (size_t)pm * 256 * D * 2, Bb + (size_t)pn * 256 * D * 2, Bb + (size_t)(pn * 256 + 128) * D * 2, D / 64);
    g8::kloop<false, false>(lds, acc, s, voffA, voffB, 128 * D * 2);
    EPI_COORDS();
    const int row0 = pm * 256 + wr * 64 + fr, col0 = pn * 256 + wc * 32 + 4 * fq;
#pragma unroll
    for (int ai = 0; ai < 2; ++ai) { asm volatile("" ::: "memory");
        f32x4 pre[4][2][2]; float* hr[4];
#pragma unroll
        for (int m = 0; m < 4; ++m) { hr[m] = hrow(PP(), row0 + ai * 128 + m * 16) + col0;
#pragma unroll
            for (int bj = 0; bj < 2; ++bj)
#pragma unroll
                for (int n = 0; n < 2; ++n) pre[m][bj][n] = *(const f32x4*)(hr[m] + bj * 128 + n * 16); }
#pragma unroll
        for (int m = 0; m < 4; ++m)
#pragma unroll
            for (int bj = 0; bj < 2; ++bj)
#pragma unroll
                for (int n = 0; n < 2; ++n) *(f32x4*)(hr[m] + bj * 128 + n * 16) = pre[m][bj][n] * ALPHA + acc[ai][bj][m][n]; }
}
__device__ __forceinline__ unsigned score_key(float s) { s += 0.0f; const unsigned u = __builtin_bit_cast(unsigned, s); return (u & 0x80000000u) ? ~u : (u | 0x80000000u); }
__device__ void attn_naive_query(const Params& p, int row, unsigned char* wl, int lane) {
    const bf16_t* U = (const bf16_t*)(p.ws + WS_UAR);
    bf16_t* OA = (bf16_t*)(p.ws + WS_OAB) + (size_t)row * D;
    const int b = row / LP, pos = row - b * LP;
    if (pos < PADM) {
#pragma unroll
        for (int j = 0; j < 8; ++j) OA[j * 64 + lane] = 0;
        return;
    }
    const int nadm = 64 * ((pos >> 6) + 1) - PADM;
    unsigned* keys = (unsigned*)wl; float* p_s = (float*)wl;
    float* qi_s = (float*)(wl + 16640); float* q_s = qi_s + 256; float* w_s = q_s + 512; unsigned short* sel_s = (unsigned short*)(w_s + 16);
    const bf16_t* urow = U + (size_t)row * UARW;
    for (int i = lane; i < 256; i += 64) qi_s[i] = bf2f(urow[C_QI + i]);
    for (int i = lane; i < 512; i += 64) q_s[i] = bf2f(urow[C_Q + i]);
    if (lane < 8) w_s[lane] = bf2f(urow[C_WI + lane]);
    __builtin_amdgcn_fence(__ATOMIC_RELEASE, "wavefront"); __builtin_amdgcn_wave_barrier(); __builtin_amdgcn_fence(__ATOMIC_ACQUIRE, "wavefront");
    const int nj = (nadm + 63) >> 6;
    for (int j = 0; j < nj; ++j) {
        const int ki_idx = lane + 64 * j; unsigned key = 0u;
        if (ki_idx < nadm) {
            const u32x4* kp = (const u32x4*)(U + (size_t)(b * LP + PADM + ki_idx) * UARW + C_KI);
            float kf[32];
#pragma unroll
            for (int c4 = 0; c4 < 4; ++c4) { const u32x4 w = kp[c4];
                kf[c4 * 8 + 0] = bflo(w.x); kf[c4 * 8 + 1] = bfhi(w.x); kf[c4 * 8 + 2] = bflo(w.y); kf[c4 * 8 + 3] = bfhi(w.y);
                kf[c4 * 8 + 4] = bflo(w.z); kf[c4 * 8 + 5] = bfhi(w.z); kf[c4 * 8 + 6] = bflo(w.w); kf[c4 * 8 + 7] = bfhi(w.w); }
            float sc = 0.f;
#pragma unroll 1
            for (int h = 0; h < 8; ++h) { float d = 0.f; asm volatile("" ::: "memory");
#pragma unroll
                for (int e = 0; e < 32; ++e) d = fmaf(qi_s[h * 32 + e], kf[e], d);
                sc = fmaf(w_s[h], fmaxf(d, 0.f), sc); }
            key = score_key(sc); if (key == 0u) key = 1u;
        }
        keys[ki_idx] = key;
    }
    __builtin_amdgcn_fence(__ATOMIC_RELEASE, "wavefront"); __builtin_amdgcn_wave_barrier(); __builtin_amdgcn_fence(__ATOMIC_ACQUIRE, "wavefront");
    unsigned thr = 0u; int need_ties = 0x7fffffff;
    if (nadm > 256) {
        unsigned prefix = 0u; int remaining = 256;
        for (int bit = 31; bit >= 0; --bit) {
            const unsigned cand = prefix | (1u << bit); int cnt = 0;
            for (int j = 0; j < nj; ++j) { const unsigned k = keys[lane + 64 * j]; cnt += __builtin_popcountll(__ballot((k >> bit) == (cand >> bit))); }
            if (cnt >= remaining) prefix = cand; else remaining -= cnt;
        }
        thr = prefix; need_ties = remaining;
    } else thr = 1u;
    int nsel = 0, ties_seen = 0;
    for (int j = 0; j < nj; ++j) {
        const unsigned k = keys[lane + 64 * j];
        const unsigned long long tm = __ballot(k == thr && k != 0u);
        const unsigned long long lt = (1ull << lane) - 1ull;
        const int myrank = ties_seen + __builtin_popcountll(tm & lt);
        const bool selme = (k > thr) || (k == thr && k != 0u && myrank < need_ties);
        const unsigned long long sm = __ballot(selme);
        if (selme) sel_s[nsel + __builtin_popcountll(sm & lt)] = (unsigned short)(PADM + lane + 64 * j);
        nsel += __builtin_popcountll(sm); ties_seen += __builtin_popcountll(tm);
    }
    __builtin_amdgcn_fence(__ATOMIC_RELEASE, "wavefront"); __builtin_amdgcn_wave_barrier(); __builtin_amdgcn_fence(__ATOMIC_ACQUIRE, "wavefront");
    float sc[4][8];
#pragma unroll
    for (int m = 0; m < 4; ++m) {
        asm volatile("" ::: "memory");
        const int i = lane + 64 * m; const bool valid = i < nsel; const int ps = valid ? sel_s[i] : PADM;
        const bf16_t* krow = U + (size_t)(b * LP + ps) * UARW + C_K;
#pragma unroll
        for (int n = 0; n < 2; ++n) {
            float a0 = 0.f, a1 = 0.f, a2 = 0.f, a3 = 0.f;
#pragma unroll 1
            for (int c8 = 0; c8 < 8; ++c8) { asm volatile("" ::: "memory"); const u32x4 w = *(const u32x4*)(krow + n * 64 + c8 * 8);
                float kf[8] = {bflo(w.x), bfhi(w.x), bflo(w.y), bfhi(w.y), bflo(w.z), bfhi(w.z), bflo(w.w), bfhi(w.w)};
#pragma unroll
                for (int e = 0; e < 8; ++e) { const int dd = c8 * 8 + e;
                    a0 = fmaf(q_s[(n * 4 + 0) * 64 + dd], kf[e], a0); a1 = fmaf(q_s[(n * 4 + 1) * 64 + dd], kf[e], a1);
                    a2 = fmaf(q_s[(n * 4 + 2) * 64 + dd], kf[e], a2); a3 = fmaf(q_s[(n * 4 + 3) * 64 + dd], kf[e], a3); } }
            sc[m][n * 4 + 0] = valid ? a0 * 0.125f : -INFINITY; sc[m][n * 4 + 1] = valid ? a1 * 0.125f : -INFINITY;
            sc[m][n * 4 + 2] = valid ? a2 * 0.125f : -INFINITY; sc[m][n * 4 + 3] = valid ? a3 * 0.125f : -INFINITY;
        }
    }
    __builtin_amdgcn_wave_barrier();
    float linv[8];
#pragma unroll
    for (int h = 0; h < 8; ++h) {
        const float mx = wave_max(fmaxf(fmaxf(sc[0][h], sc[1][h]), fmaxf(sc[2][h], sc[3][h]))); float s = 0.f;
#pragma unroll
        for (int m = 0; m < 4; ++m) { const float e = __expf(sc[m][h] - mx); sc[m][h] = e; s += e; }
        linv[h] = 1.0f / wave_sum(s);
    }
#pragma unroll
    for (int m = 0; m < 4; ++m) { const int i = lane + 64 * m;
#pragma unroll
        for (int h = 0; h < 8; ++h) p_s[i * 8 + h] = sc[m][h]; }
    __builtin_amdgcn_fence(__ATOMIC_RELEASE, "wavefront"); __builtin_amdgcn_wave_barrier(); __builtin_amdgcn_fence(__ATOMIC_ACQUIRE, "wavefront");
    float o[8] = {0.f, 0.f, 0.f, 0.f, 0.f, 0.f, 0.f, 0.f};
    for (int i = 0; i < nsel; ++i) {
        const int ps = sel_s[i]; const bf16_t* vrow = U + (size_t)(b * LP + ps) * UARW + C_V;
        const float v0 = bf2f(vrow[lane]), v1 = bf2f(vrow[64 + lane]);
        const f32x4 pa = *(const f32x4*)(p_s + i * 8), pb = *(const f32x4*)(p_s + i * 8 + 4);
        o[0] = fmaf(pa[0], v0, o[0]); o[1] = fmaf(pa[1], v0, o[1]); o[2] = fmaf(pa[2], v0, o[2]); o[3] = fmaf(pa[3], v0, o[3]);
        o[4] = fmaf(pb[0], v1, o[4]); o[5] = fmaf(pb[1], v1, o[5]); o[6] = fmaf(pb[2], v1, o[6]); o[7] = fmaf(pb[3], v1, o[7]);
    }
#pragma unroll
    for (int h = 0; h < 8; ++h) OA[h * 64 + lane] = (bf16_t)f2bf(o[h] * linv[h]);
    __builtin_amdgcn_wave_barrier();
}


__device__ __forceinline__ f32x4 mfma16(bf16x8 a, bf16x8 b, f32x4 c) { return __builtin_amdgcn_mfma_f32_16x16x32_bf16(a, b, c, 0, 0, 0); }
#ifndef PROBE_PHASE
#define PROBE_PHASE -1
#endif
#define PROBE_BLOCK 0
#define LDS_BARRIER() do { asm volatile("s_waitcnt lgkmcnt(0)" ::: "memory"); __builtin_amdgcn_s_barrier(); asm volatile("" ::: "memory"); } while (0)

typedef float f32x16 __attribute__((ext_vector_type(16)));
typedef short s16x4 __attribute__((ext_vector_type(4)));
constexpr int AT_HIST = 0;
constexpr int AT_MASK = 20480;
constexpr int AT_QST = AT_MASK + 16640;
constexpr int AT_KV = 37120;
constexpr int AT_UNIT = AT_KV + 32768;
constexpr int AT_KL = AT_KV;
constexpr int AT_KL_BYTES = LDS_BYTES - 16 - AT_KL;
static_assert(4128 * 12 * 2 <= AT_KL_BYTES, "selection keys fit with 12 queries per sub-pass");
constexpr int CW_R1Q = 48;
constexpr int CW_ATT = 32;
__device__ __forceinline__ int img_off(int row, int ch) { return 2048 * (row >> 3) + 512 * (ch >> 2) + 64 * (row & 7) + 16 * ((ch & 3) ^ ((row >> 2) & 3)); }
__device__ __forceinline__ unsigned comp_key(float sc, int pos) { return (score_key(sc) & 0xFFFFE000u) | (unsigned)(0x1FFF - pos); }

__device__ __forceinline__ void attn_unit(const Params& p, unsigned char* lds, int b, int qt, unsigned long long& pacc) {
    unsigned long long pt0 = 0; if (PROBE_PHASE == 40 || PROBE_PHASE == 42) pt0 = __builtin_amdgcn_s_memrealtime();
    const int tid = otid(), wave = tid >> 6, lane = tid & 63, r = lane & 31, hh = lane >> 5;
    const bf16_t* U = (const bf16_t*)(p.ws + WS_UAR);
    LAS unsigned char* L = (LAS unsigned char*)lds;
    LAS unsigned* hist = (LAS unsigned*)(L + AT_HIST); LAS unsigned* maskw = (LAS unsigned*)(L + AT_MASK);
    const int c = qt >> 1, nkt = 2 * c + 1, nadm = 64 * (c + 1) - PADM;
    const size_t qrow = (size_t)(b * LP + 32 * qt + r);
    if (nadm > 256) {
        LAS unsigned short* KL = (LAS unsigned short*)(L + AT_KL);
        LAS unsigned* h8 = (LAS unsigned*)(L + AT_HIST);
        LAS unsigned* segc = h8 + 4096;
        LAS unsigned* st = segc + 512;
        const int NK = 32 * nkt, c15 = lane & 15, g4 = lane >> 4;
        const int qs = NK * 32 <= AT_KL_BYTES ? 16 : 12;
        for (int i = tid; i < (nkt + 1) * 32; i += NTHREADS) maskw[i] = 0u;
#pragma unroll 1
        for (int qbase = 0; qbase < 32; qbase += qs) {
            const int qn = 32 - qbase < qs ? 32 - qbase : qs; const bool qact = c15 < qn;
            bf16x8 qf[8]; float wq[8];
            { const bf16_t* qp = U + (size_t)(b * LP + 32 * qt + qbase + (qact ? c15 : 0)) * UARW;
#pragma unroll
              for (int h = 0; h < 8; ++h) qf[h] = *(const bf16x8*)(qp + C_QI + h * 32 + 8 * g4);
              const u32x4 w = *(const u32x4*)(qp + C_WI);
              wq[0] = bflo(w.x); wq[1] = bfhi(w.x); wq[2] = bflo(w.y); wq[3] = bfhi(w.y); wq[4] = bflo(w.z); wq[5] = bfhi(w.z); wq[6] = bflo(w.w); wq[7] = bfhi(w.w); }
#pragma unroll
            for (int h = 0; h < 8; ++h) asm volatile("" : "+v"(qf[h]), "+v"(wq[h]));
            for (int i = tid; i < 4096 + 512; i += NTHREADS) h8[i] = 0u;
            LDS_BARRIER();
            {
                const int ng = 2 * nkt; int j = wave;
                const bf16_t* kb = U + (size_t)(b * LP + 32 + c15) * UARW + C_KI + 8 * g4;
                bf16x8 a = *(const bf16x8*)(kb + (size_t)(16 * (j < ng ? j : 0)) * UARW), an = *(const bf16x8*)(kb + (size_t)(16 * (j + NWAVES < ng ? j + NWAVES : 0)) * UARW);
#pragma unroll 1
                for (; j < ng; j += NWAVES) {
                    const bf16x8 a2 = *(const bf16x8*)(kb + (size_t)(16 * (j + 2 * NWAVES < ng ? j + 2 * NWAVES : j)) * UARW);
                    f32x4 sc = {0.f, 0.f, 0.f, 0.f};
#pragma unroll
                    for (int h = 0; h < 8; ++h) { const f32x4 d = mfma16(a, qf[h], (f32x4){0.f, 0.f, 0.f, 0.f});
#pragma unroll
                        for (int e = 0; e < 4; ++e) sc[e] = fmaf(wq[h], fmaxf(d[e], 0.f), sc[e]); }
                    if (qact) {
#pragma unroll
                        for (int e = 0; e < 4; ++e) { const int ki = 16 * j + 4 * g4 + e;
                            const unsigned k16 = ki >= 16 ? (score_key(sc[e]) >> 16) : 0u;
                            KL[ki * qs + c15] = (unsigned short)k16;
                            __hip_atomic_fetch_add(h8 + (k16 >> 8) * 16 + c15, ki >= 16 ? 1u : 0u, __ATOMIC_RELAXED, __HIP_MEMORY_SCOPE_WORKGROUP); } }
                    a = an; an = a2;
                }
            }
            LDS_BARRIER();
            { const int q_ = tid & 15, s8 = tid >> 4; unsigned ss = 0u;
#pragma unroll
              for (int i = 0; i < 8; ++i) ss += h8[(s8 * 8 + i) * 16 + q_];
              segc[s8 * 16 + q_] = ss; }
            LDS_BARRIER();
            if (tid < qn) { unsigned sv[32];
#pragma unroll
                for (int i = 0; i < 32; ++i) sv[i] = segc[i * 16 + tid];
                unsigned cum = 0u; int sgi = 31;
#pragma unroll
                for (int i = 31; i > 0; --i) { const bool go = sgi == i && cum + sv[i] < 256u; cum += go ? sv[i] : 0u; sgi -= go ? 1 : 0; }
                int bin = sgi * 8 + 7; while (bin > sgi * 8 && cum + h8[bin * 16 + tid] < 256u) { cum += h8[bin * 16 + tid]; --bin; }
                st[tid * 4] = (unsigned)bin; st[tid * 4 + 1] = 256u - cum; }
            LDS_BARRIER();
            for (int i = tid; i < 4096; i += NTHREADS) h8[i] = 0u;
            LDS_BARRIER();
            const int q = tid & 15, sg = tid >> 4, SEG = (NK + 31) >> 5, k0 = sg * SEG, k1 = q < qn ? (k0 + SEG < NK ? k0 + SEG : NK) : k0;
            { const unsigned hb = st[q * 4];
#pragma unroll 8
              for (int k = k0; k < k1; ++k) { const unsigned kv = KL[k * qs + q]; __hip_atomic_fetch_add(h8 + (kv & 255u) * 16 + q, (kv >> 8) == hb && kv != 0u ? 1u : 0u, __ATOMIC_RELAXED, __HIP_MEMORY_SCOPE_WORKGROUP); } }
            LDS_BARRIER();
            { const int q_ = tid & 15, s8 = tid >> 4; unsigned ss = 0u;
#pragma unroll
              for (int i = 0; i < 8; ++i) ss += h8[(s8 * 8 + i) * 16 + q_];
              segc[s8 * 16 + q_] = ss; }
            LDS_BARRIER();
            if (tid < qn) { const unsigned rem = st[tid * 4 + 1]; unsigned sv[32];
#pragma unroll
                for (int i = 0; i < 32; ++i) sv[i] = segc[i * 16 + tid];
                unsigned cum = 0u; int sgi = 31;
#pragma unroll
                for (int i = 31; i > 0; --i) { const bool go = sgi == i && cum + sv[i] < rem; cum += go ? sv[i] : 0u; sgi -= go ? 1 : 0; }
                int bin = sgi * 8 + 7; while (bin > sgi * 8 && cum + h8[bin * 16 + tid] < rem) { cum += h8[bin * 16 + tid]; --bin; }
                st[tid * 4 + 2] = (st[tid * 4] << 8) | (unsigned)bin; st[tid * 4 + 3] = rem - cum; }
            LDS_BARRIER();
            const unsigned thr = st[q * 4 + 2], need = st[q * 4 + 3];
            { unsigned cnt = 0u;
#pragma unroll 8
              for (int k = k0; k < k1; ++k) cnt += KL[k * qs + q] == thr ? 1u : 0u;
              segc[sg * 16 + q] = cnt; }
            LDS_BARRIER();
            if (tid < qn) { unsigned cv[32];
#pragma unroll
                for (int s2 = 0; s2 < 32; ++s2) cv[s2] = segc[s2 * 16 + tid];
                unsigned run = 0u;
#pragma unroll
                for (int s2 = 0; s2 < 32; ++s2) { segc[s2 * 16 + tid] = run; run += cv[s2]; } }
            LDS_BARRIER();
            { unsigned rank = segc[sg * 16 + q], word = 0u; int wi = k0 >> 5;
#pragma unroll 4
              for (int k = k0; k < k1; ++k) { if ((k >> 5) != wi) { if (word) __hip_atomic_fetch_or(maskw + (wi + 1) * 32 + qbase + q, word, __ATOMIC_RELAXED, __HIP_MEMORY_SCOPE_WORKGROUP); word = 0u; wi = k >> 5; }
                  const unsigned kv = KL[k * qs + q]; const bool tie = kv == thr; const bool sel = kv > thr || (tie && rank < need); rank += tie ? 1u : 0u;
                  word |= (sel ? 1u : 0u) << (k & 31); }
              if (word) __hip_atomic_fetch_or(maskw + (wi + 1) * 32 + qbase + q, word, __ATOMIC_RELAXED, __HIP_MEMORY_SCOPE_WORKGROUP); }
            LDS_BARRIER();
        }
    } else {
        for (int kt = 1 + wave; kt <= nkt; kt += NWAVES) if (hh == 0) maskw[kt * 32 + r] = kt == 1 ? 0xFFFF0000u : 0xFFFFFFFFu;
        LDS_BARRIER();
    }
    if (PROBE_PHASE == 40) pacc += __builtin_amdgcn_s_memrealtime() - pt0;
    if (PROBE_PHASE == 41) pt0 = __builtin_amdgcn_s_memrealtime();
    {
        const int h = wave, n = h >> 2;
        bf16x8 qf4[4];
#pragma unroll
        for (int kk = 0; kk < 4; ++kk) qf4[kk] = *(const bf16x8*)(U + qrow * UARW + C_Q + h * 64 + 16 * kk + 8 * hh);
        asm volatile("" : "+v"(qf4[0]), "+v"(qf4[1]), "+v"(qf4[2]), "+v"(qf4[3]));
        f32x16 o0, o1;
#pragma unroll
        for (int e = 0; e < 16; ++e) { o0[e] = 0.f; o1[e] = 0.f; }
        float m = -1e30f, lsum = 0.f;
        const int srow = tid >> 4, sch = tid & 15; const int soff = img_off(srow, sch);
        const bf16_t* sbase = U + (size_t)(b * LP + srow) * UARW + sch * 8;
        u32x4 kreg = *(const u32x4*)(sbase + (size_t)32 * UARW + C_K), vreg = *(const u32x4*)(sbase + (size_t)32 * UARW + C_V);
        *(LAS u32x4*)(L + AT_KV + soff) = kreg; *(LAS u32x4*)(L + AT_KV + 8192 + soff) = vreg;
        { const int k2 = nkt >= 2 ? 2 : 1; kreg = *(const u32x4*)(sbase + (size_t)(32 * k2) * UARW + C_K); vreg = *(const u32x4*)(sbase + (size_t)(32 * k2) * UARW + C_V); }
        LDS_BARRIER();
        const int g = (lane >> 4) & 1, q_ = (lane & 15) >> 2, p_ = lane & 3;
        constexpr float SCL = 0.125f * 1.44269504088896f;
#pragma unroll 1
        for (int i = 0; i < nkt; ++i) {
            const int kt = 1 + i; LAS unsigned char* Kimg = L + AT_KV + (i & 1) * 16384; LAS unsigned char* Vimg = Kimg + 8192;
            u32x4 kreg2, vreg2;
            { const int k3 = kt + 2 <= nkt ? kt + 2 : kt; kreg2 = *(const u32x4*)(sbase + (size_t)(32 * k3) * UARW + C_K); vreg2 = *(const u32x4*)(sbase + (size_t)(32 * k3) * UARW + C_V); }
            f32x16 s;
#pragma unroll
            for (int e = 0; e < 16; ++e) s[e] = 0.f;
#pragma unroll
            for (int kk = 0; kk < 4; ++kk) { const bf16x8 a = *(const LAS bf16x8*)(Kimg + img_off(r, 8 * n + 2 * kk + hh)); s = __builtin_amdgcn_mfma_f32_32x32x16_bf16(a, qf4[kk], s, 0, 0, 0); }
            const unsigned mw = maskw[kt * 32 + r] >> (4 * hh);
            float tmax = -INFINITY;
#pragma unroll
            for (int e = 0; e < 16; ++e) { const bool sel = (mw >> ((e & 3) + 8 * (e >> 2))) & 1u; s[e] = sel ? s[e] : -INFINITY; tmax = fmaxf(tmax, s[e]); }
            tmax = fmaxf(tmax, __shfl_xor(tmax, 32));
            const float mnew = fmaxf(m, tmax * SCL);
            if (__any(mnew > m)) { const float alpha = __builtin_amdgcn_exp2f(m - mnew); lsum *= alpha;
#pragma unroll
                for (int e = 0; e < 16; ++e) { o0[e] *= alpha; o1[e] *= alpha; } }
            m = mnew;
            float ps = 0.f;
#pragma unroll
            for (int e = 0; e < 16; ++e) { const float pe = __builtin_amdgcn_exp2f(fmaf(s[e], SCL, -mnew)); s[e] = pe; ps += pe; }
            lsum += ps;
            bf16x8 pf[2];
#pragma unroll
            for (int ks = 0; ks < 2; ++ks) { u32x4 w; w.x = pk2(s[8 * ks + 0], s[8 * ks + 1]); w.y = pk2(s[8 * ks + 2], s[8 * ks + 3]); w.z = pk2(s[8 * ks + 4], s[8 * ks + 5]); w.w = pk2(s[8 * ks + 6], s[8 * ks + 7]); pf[ks] = __builtin_bit_cast(bf16x8, w); }
#pragma unroll
            for (int ks = 0; ks < 2; ++ks)
#pragma unroll
                for (int dt = 0; dt < 2; ++dt) { const int c0 = 8 * n + 4 * dt + 2 * g + (p_ >> 1);
                    const s16x4 lo = __builtin_amdgcn_ds_read_tr16_b64_v4i16((LAS s16x4*)(Vimg + img_off(16 * ks + 4 * hh + q_, c0) + 8 * (p_ & 1)));
                    const s16x4 hi = __builtin_amdgcn_ds_read_tr16_b64_v4i16((LAS s16x4*)(Vimg + img_off(16 * ks + 8 + 4 * hh + q_, c0) + 8 * (p_ & 1)));
                    const bf16x8 a = __builtin_shufflevector(lo, hi, 0, 1, 2, 3, 4, 5, 6, 7);
                    if (dt == 0) o0 = __builtin_amdgcn_mfma_f32_32x32x16_bf16(a, pf[ks], o0, 0, 0, 0); else o1 = __builtin_amdgcn_mfma_f32_32x32x16_bf16(a, pf[ks], o1, 0, 0, 0); }
            if (i + 1 < nkt) { LAS unsigned char* Kn = L + AT_KV + ((i + 1) & 1) * 16384; *(LAS u32x4*)(Kn + soff) = kreg; *(LAS u32x4*)(Kn + 8192 + soff) = vreg; }
            kreg = kreg2; vreg = vreg2;
            LDS_BARRIER();
        }
        lsum += __shfl_xor(lsum, 32);
        const float inv = lsum > 0.f ? 1.0f / lsum : 0.f;
        bf16_t* orow = (bf16_t*)(p.ws + WS_OAB) + qrow * D + h * 64 + 4 * hh;
#pragma unroll
        for (int g4 = 0; g4 < 4; ++g4) { u32x2 w0, w1;
            w0.x = pk2(o0[4 * g4] * inv, o0[4 * g4 + 1] * inv); w0.y = pk2(o0[4 * g4 + 2] * inv, o0[4 * g4 + 3] * inv);
            w1.x = pk2(o1[4 * g4] * inv, o1[4 * g4 + 1] * inv); w1.y = pk2(o1[4 * g4 + 2] * inv, o1[4 * g4 + 3] * inv);
            *(u32x2*)(orow + 8 * g4) = w0; *(u32x2*)(orow + 32 + 8 * g4) = w1; }
        if (qt == 1) {
            bf16_t* z = (bf16_t*)(p.ws + WS_OAB) + (size_t)(b * LP + r) * D + h * 64 + 32 * hh;
#pragma unroll
            for (int j = 0; j < 4; ++j) *(u32x4*)(z + 8 * j) = (u32x4){0u, 0u, 0u, 0u};
        }
    }
    if (PROBE_PHASE == 41 || PROBE_PHASE == 42) pacc += __builtin_amdgcn_s_memrealtime() - pt0;
}
__device__ __forceinline__ void attn_phase(const Params& p, int l, unsigned char* lds, unsigned long long& pacc) {
    unsigned* ctr = (unsigned*)(p.ws + WS_CTL) + CW_ATT + 4 * l;
    volatile int* uw = (volatile int*)(lds + AT_UNIT);
    const int b0 = (obid() & 7) >> 1;
    for (int k = 0; k < 4; ++k) { const int b = (b0 + k) & 3;
        for (;;) {
            __syncthreads();
            if (otid() == 0) *uw = (int)atomicAdd(ctr + b, 1u);
            __syncthreads();
            const int u = *uw;
            if (u >= 129) break;
            attn_unit(p, lds, b, 129 - u, pacc);
        }
    }
}

constexpr size_t WS_RW1 = WS_HB;
constexpr size_t WS_RW2 = 259 * MiB;
constexpr size_t RW2_ARR = (size_t)2080 * 8192;
constexpr size_t WS_LORA = 65536;
constexpr int PS = 72;
constexpr int R1_XW = 0, R1_XA = 9216, R1_XG = 18432;
constexpr int R1_RHS = 0;
constexpr int R1_E = 35840, R1_AA = R1_E + 16640, R1_GS = R1_AA + 9216;
constexpr int R1_LABT = R1_E, R1_LAK = R1_E + 16384;
constexpr int R1_AT = R1_GS + 9216, R1_RT = R1_AT + 9216, R1_BT = R1_RT + 9216, R1_KT = R1_BT + 9216;
constexpr int R1_WT = R1_AT, R1_ZT = R1_BT;
constexpr int R1_BTT = R1_KT + 9216, R1_KTT = R1_BTT + 9216, R1_VT = R1_KTT + 9216;
constexpr int R1_MRB = R1_VT + 9216, R1_MRK = R1_MRB + 9216;
constexpr int R1_BS = R1_MRK + 9216, R1_GC = R1_BS + 256, R1_END = R1_GC + 256;
static_assert(R1_END <= LDS_BYTES && R1_LAK + 9216 <= R1_AT && R1_RHS + 33280 <= R1_E, "R1 LDS map");
__device__ __forceinline__ u32x2 pk4(f32x4 v) { u32x2 w; w.x = pk2(v[0], v[1]); w.y = pk2(v[2], v[3]); return w; }

#ifndef PROBE_PHASE
#define PROBE_PHASE -1
#endif
#define R1P(k) do { if (PROBE_PHASE == 20 + (k)) { const unsigned long long t_ = __builtin_amdgcn_s_memrealtime(); pacc += t_ - pt0; } if (PROBE_PHASE == 21 + (k)) pt0 = __builtin_amdgcn_s_memrealtime(); } while (0)
__device__ __forceinline__ void rwkv_prep_unit(const Params& p, int l, int unit, unsigned char* lds, unsigned long long& pacc) {
    unsigned long long pt0 = 0; if (PROBE_PHASE == 20) pt0 = __builtin_amdgcn_s_memrealtime();
    const int tid = otid(), wave = tid >> 6, lane = tid & 63, c15 = lane & 15, g = lane >> 4;
    const int h = unit & 7, bc = unit >> 3, b = bc / NCH, c = bc - b * NCH;
    LAS unsigned char* L = (LAS unsigned char*)lds;
    const bf16_t* U = (const bf16_t*)(p.ws + WS_UAR);
    const int t = tid >> 3, dq = tid & 7, d0 = dq * 8;
    const int row = b * LP + 64 * c + t; const bool hasprev = (64 * c + t) > 0;
    bf16x8 lw[2][2], la[2][2], lg_[2][4];
    { const bf16_t* lora = (const bf16_t*)(p.ws + WS_LORA + (size_t)l * 262144);
#pragma unroll
      for (int nn = 0; nn < 2; ++nn) { const int hd = h * 64 + 16 * (2 * (wave & 1) + nn) + c15;
#pragma unroll
          for (int s2 = 0; s2 < 2; ++s2) { lw[nn][s2] = *(const bf16x8*)(lora + (size_t)hd * 64 + 32 * s2 + 8 * g); la[nn][s2] = *(const bf16x8*)(lora + 32768 + (size_t)hd * 64 + 32 * s2 + 8 * g); }
#pragma unroll
          for (int s4 = 0; s4 < 4; ++s4) lg_[nn][s4] = *(const bf16x8*)(lora + 65536 + (size_t)hd * 128 + 32 * s4 + 8 * g); } }
    float rr[8], kx[8], vx[8], kk[8];
    {
        const bf16_t* uc = U + (size_t)row * UARW; const bf16_t* up = hasprev ? uc - UARW : uc;
        const float* mu = p.in[I_MU] + l * R_COLS;
        auto shift8 = [&](int col, int mucol, float (&out)[8]) {
            const u32x4 a = *(const u32x4*)(uc + col), q = *(const u32x4*)(up + col);
            const f32x4 m0 = *(const f32x4*)(mu + mucol), m1 = *(const f32x4*)(mu + mucol + 4);
            const float x[8] = {bflo(a.x), bfhi(a.x), bflo(a.y), bfhi(a.y), bflo(a.z), bfhi(a.z), bflo(a.w), bfhi(a.w)};
            const float y[8] = {bflo(q.x), bfhi(q.x), bflo(q.y), bfhi(q.y), bflo(q.z), bfhi(q.z), bflo(q.w), bfhi(q.w)};
#pragma unroll
            for (int i = 0; i < 8; ++i) { const float xp = hasprev ? y[i] : 0.f; out[i] = x[i] + (xp - x[i]) * (i < 4 ? m0[i] : m1[i - 4]); } };
        shift8(C_R + h * 64 + d0, h * 64 + d0, rr); shift8(C_RK + h * 64 + d0, 512 + h * 64 + d0, kx); shift8(C_RV + h * 64 + d0, 1024 + h * 64 + d0, vx);
        float xw[8], xa[8], xg0[8], xg1[8];
        shift8(C_XW + d0, 1536 + d0, xw); shift8(C_XA + d0, 1600 + d0, xa); shift8(C_XG + d0, 1664 + d0, xg0); shift8(C_XG + 64 + d0, 1728 + d0, xg1);
        float n2 = 0.f;
        { const f32x4 k0 = *(const f32x4*)(p.in[I_KK] + l * 512 + h * 64 + d0), k1 = *(const f32x4*)(p.in[I_KK] + l * 512 + h * 64 + d0 + 4);
#pragma unroll
          for (int i = 0; i < 8; ++i) { kk[i] = kx[i] * (i < 4 ? k0[i] : k1[i - 4]); n2 = fmaf(kk[i], kk[i], n2); } }
        n2 += __shfl_xor(n2, 1); n2 += __shfl_xor(n2, 2); n2 += __shfl_xor(n2, 4);
        const float rn = rsqrtf(fmaxf(n2, 1e-24f));
#pragma unroll
        for (int i = 0; i < 8; ++i) { kk[i] *= rn; xw[i] = 1.0f - 2.0f * __builtin_amdgcn_rcpf(1.0f + __expf(2.0f * xw[i])); xg0[i] = sigmoidf_(xg0[i]); xg1[i] = sigmoidf_(xg1[i]); }
        u32x4 w;
        w.x = pk2(xw[0], xw[1]); w.y = pk2(xw[2], xw[3]); w.z = pk2(xw[4], xw[5]); w.w = pk2(xw[6], xw[7]); *(LAS u32x4*)(L + R1_XW + (t * PS + d0) * 2) = w;
        w.x = pk2(xa[0], xa[1]); w.y = pk2(xa[2], xa[3]); w.z = pk2(xa[4], xa[5]); w.w = pk2(xa[6], xa[7]); *(LAS u32x4*)(L + R1_XA + (t * PS + d0) * 2) = w;
        w.x = pk2(xg0[0], xg0[1]); w.y = pk2(xg0[2], xg0[3]); w.z = pk2(xg0[4], xg0[5]); w.w = pk2(xg0[6], xg0[7]); *(LAS u32x4*)(L + R1_XG + (t * 136 + d0) * 2) = w;
        w.x = pk2(xg1[0], xg1[1]); w.y = pk2(xg1[2], xg1[3]); w.z = pk2(xg1[4], xg1[5]); w.w = pk2(xg1[6], xg1[7]); *(LAS u32x4*)(L + R1_XG + (t * 136 + 64 + d0) * 2) = w;
    }
    LDS_BARRIER();
    R1P(0);
    const int tm = wave >> 1;
    unsigned char* rw2 = p.ws + WS_RW2 + (size_t)unit * 8192;
    {
#pragma unroll
        for (int nn = 0; nn < 2; ++nn) { const int tn = 2 * (wave & 1) + nn, dcol = 16 * tn + c15, hd = h * 64 + dcol;
            f32x4 aw = {0.f, 0.f, 0.f, 0.f}, aa = aw, ag = aw;
#pragma unroll
            for (int s2 = 0; s2 < 2; ++s2) {
                const bf16x8 xa_ = *(const LAS bf16x8*)(L + R1_XW + ((16 * tm + c15) * PS + 32 * s2 + 8 * g) * 2), xb_ = *(const LAS bf16x8*)(L + R1_XA + ((16 * tm + c15) * PS + 32 * s2 + 8 * g) * 2);
                aw = mfma16(xa_, lw[nn][s2], aw);
                aa = mfma16(xb_, la[nn][s2], aa); }
#pragma unroll
            for (int s4 = 0; s4 < 4; ++s4) ag = mfma16(*(const LAS bf16x8*)(L + R1_XG + ((16 * tm + c15) * 136 + 32 * s4 + 8 * g) * 2), lg_[nn][s4], ag);
            const float w0 = p.in[I_W0][l * 512 + hd], a0 = p.in[I_A0][l * 512 + hd];
#pragma unroll
            for (int e = 0; e < 4; ++e) { const int tt = 16 * tm + 4 * g + e;
                *(LAS float*)(L + R1_E + (tt * 65 + dcol) * 4) = 0.60653065971263342f * sigmoidf_(w0 + aw[e]);
                *(LAS unsigned short*)(L + R1_AA + (tt * PS + dcol) * 2) = (unsigned short)f2bf(sigmoidf_(a0 + aa[e]));
                *(LAS unsigned short*)(L + R1_GS + (tt * PS + dcol) * 2) = (unsigned short)f2bf(ag[e]); }
        }
    }
    LDS_BARRIER();
    R1P(1);
    {
        const int d = tid & 63, sg = tid >> 6; float cum = 0.f, loc[8];
#pragma unroll
        for (int i = 0; i < 8; ++i) { cum += *(const LAS float*)(L + R1_E + ((8 * sg + i) * 65 + d) * 4); loc[i] = cum; }
        *(LAS float*)(L + R1_BS + (sg * 64 + d) * 4 - 2048) = cum;
        LDS_BARRIER();
        float off = 0.f;
#pragma unroll
        for (int q = 0; q < 7; ++q) if (q < sg) off += *(const LAS float*)(L + R1_BS + (q * 64 + d) * 4 - 2048);
#pragma unroll
        for (int i = 0; i < 8; ++i) *(LAS float*)(L + R1_E + ((8 * sg + i) * 65 + d) * 4) = loc[i] + off;
    }
    LDS_BARRIER();
    R1P(2);
    {
        const f32x4 ka0 = *(const f32x4*)(p.in[I_KA] + l * 512 + h * 64 + d0), ka1 = *(const f32x4*)(p.in[I_KA] + l * 512 + h * 64 + d0 + 4);
        const f32x4 rk0 = *(const f32x4*)(p.in[I_RK] + l * 512 + h * 64 + d0), rk1 = *(const f32x4*)(p.in[I_RK] + l * 512 + h * 64 + d0 + 4);
        const u32x4 aw_ = *(const LAS u32x4*)(L + R1_AA + (t * PS + d0) * 2);
        const float av[8] = {bflo(aw_.x), bfhi(aw_.x), bflo(aw_.y), bfhi(aw_.y), bflo(aw_.z), bfhi(aw_.z), bflo(aw_.w), bfhi(aw_.w)};
        float At[8], Bt[8], Kt[8], Rt[8]; float bpart = 0.f;
#pragma unroll
        for (int i = 0; i < 8; ++i) {
            const float cumt = *(const LAS float*)(L + R1_E + (t * 65 + d0 + i) * 4), cump = t > 0 ? *(const LAS float*)(L + R1_E + ((t - 1) * 65 + d0 + i) * 4) : 0.f;
            const float gam = __expf(-cumt), gprev = __expf(-cump), ginv = __expf(cumt);
            const float kmod = kx[i] * (1.0f + (av[i] - 1.0f) * (i < 4 ? ka0[i] : ka1[i - 4]));
            At[i] = -gprev * kk[i]; Bt[i] = kk[i] * av[i] * ginv; Kt[i] = kmod * ginv; Rt[i] = rr[i] * gam;
            bpart = fmaf(rr[i] * kmod, (i < 4 ? rk0[i] : rk1[i - 4]), bpart);
            if (t == 63) *(LAS float*)(L + R1_GC + (d0 + i) * 4) = gam;
            *(LAS float*)(L + R1_RHS + ((d0 + i) * 65 + t) * 4) = At[i];
            *(LAS unsigned short*)(L + R1_BTT + ((d0 + i) * PS + t) * 2) = (unsigned short)f2bf(Bt[i]);
            *(LAS unsigned short*)(L + R1_KTT + ((d0 + i) * PS + t) * 2) = (unsigned short)f2bf(Kt[i]);
            *(LAS unsigned short*)(L + R1_VT + ((d0 + i) * PS + t) * 2) = (unsigned short)f2bf(vx[i]);
        }
        u32x4 w;
        w.x = pk2(At[0], At[1]); w.y = pk2(At[2], At[3]); w.z = pk2(At[4], At[5]); w.w = pk2(At[6], At[7]); *(LAS u32x4*)(L + R1_AT + (t * PS + d0) * 2) = w;
        w.x = pk2(Rt[0], Rt[1]); w.y = pk2(Rt[2], Rt[3]); w.z = pk2(Rt[4], Rt[5]); w.w = pk2(Rt[6], Rt[7]); *(LAS u32x4*)(L + R1_RT + (t * PS + d0) * 2) = w;
        w.x = pk2(Bt[0], Bt[1]); w.y = pk2(Bt[2], Bt[3]); w.z = pk2(Bt[4], Bt[5]); w.w = pk2(Bt[6], Bt[7]); *(LAS u32x4*)(L + R1_BT + (t * PS + d0) * 2) = w;
        w.x = pk2(Kt[0], Kt[1]); w.y = pk2(Kt[2], Kt[3]); w.z = pk2(Kt[4], Kt[5]); w.w = pk2(Kt[6], Kt[7]); *(LAS u32x4*)(L + R1_KT + (t * PS + d0) * 2) = w;
        bpart += __shfl_xor(bpart, 1); bpart += __shfl_xor(bpart, 2); bpart += __shfl_xor(bpart, 4);
        const u32x4 gw = *(const LAS u32x4*)(L + R1_GS + (t * PS + d0) * 2);
        const float gv[8] = {bflo(gw.x), bfhi(gw.x), bflo(gw.y), bfhi(gw.y), bflo(gw.z), bfhi(gw.z), bflo(gw.w), bfhi(gw.w)};
        w.x = pk2(bpart * vx[0] * gv[0], bpart * vx[1] * gv[1]); w.y = pk2(bpart * vx[2] * gv[2], bpart * vx[3] * gv[3]);
        w.z = pk2(bpart * vx[4] * gv[4], bpart * vx[5] * gv[5]); w.w = pk2(bpart * vx[6] * gv[6], bpart * vx[7] * gv[7]);
        *(u32x4*)((bf16_t*)(p.ws + WS_OAB) + (size_t)row * D + 512 + h * 64 + d0) = w;
        *(u32x4*)(rw2 + 2 * RW2_ARR + (size_t)(t * 64 + d0) * 2) = gw;
    }
    LDS_BARRIER();
    R1P(3);
    {
        f32x4 gab[2], gak[2], grb[2], grk[2];
#pragma unroll
        for (int nn = 0; nn < 2; ++nn) { const int tn = 2 * (wave & 1) + nn;
            gab[nn] = (f32x4){0.f, 0.f, 0.f, 0.f}; gak[nn] = gab[nn]; grb[nn] = gab[nn]; grk[nn] = gab[nn];
            if (tn <= tm) {
#pragma unroll
                for (int s2 = 0; s2 < 2; ++s2) { const int ao = ((16 * tm + c15) * PS + 32 * s2 + 8 * g) * 2, bo = ((16 * tn + c15) * PS + 32 * s2 + 8 * g) * 2;
                    const bf16x8 fa = *(const LAS bf16x8*)(L + R1_AT + ao), fr_ = *(const LAS bf16x8*)(L + R1_RT + ao), fb = *(const LAS bf16x8*)(L + R1_BT + bo), fk = *(const LAS bf16x8*)(L + R1_KT + bo);
                    gab[nn] = mfma16(fa, fb, gab[nn]); gak[nn] = mfma16(fa, fk, gak[nn]); grb[nn] = mfma16(fr_, fb, grb[nn]); grk[nn] = mfma16(fr_, fk, grk[nn]); } } }
        LDS_BARRIER();
#pragma unroll
        for (int nn = 0; nn < 2; ++nn) { const int tn = 2 * (wave & 1) + nn, icol = 16 * tn + c15;
            f32x4 lab;
#pragma unroll
            for (int e = 0; e < 4; ++e) { const int tt = 16 * tm + 4 * g + e; const bool strict = icol < tt, incl = icol <= tt;
                lab[e] = strict ? gab[nn][e] : 0.f;
                *(LAS unsigned short*)(L + R1_LAK + (tt * PS + icol) * 2) = (unsigned short)f2bf(strict ? gak[nn][e] : 0.f);
                *(LAS unsigned short*)(L + R1_MRB + (tt * PS + icol) * 2) = (unsigned short)f2bf(incl ? grb[nn][e] : 0.f);
                *(LAS unsigned short*)(L + R1_MRK + (tt * PS + icol) * 2) = (unsigned short)f2bf(incl ? grk[nn][e] : 0.f); }
            *(LAS f32x4*)(L + R1_LABT + (icol * 64 + 16 * tm + 4 * g) * 4) = lab; }
    }
    LDS_BARRIER();
    R1P(4);
    {
#pragma unroll
        for (int nn = 0; nn < 2; ++nn) { const int tn = 2 * (wave & 1) + nn; f32x4 acc = {0.f, 0.f, 0.f, 0.f};
#pragma unroll
            for (int s2 = 0; s2 < 2; ++s2) acc = mfma16(*(const LAS bf16x8*)(L + R1_LAK + ((16 * tm + c15) * PS + 32 * s2 + 8 * g) * 2), *(const LAS bf16x8*)(L + R1_VT + ((16 * tn + c15) * PS + 32 * s2 + 8 * g) * 2), acc);
#pragma unroll
            for (int e = 0; e < 4; ++e) *(LAS float*)(L + R1_RHS + ((64 + 16 * tn + c15) * 65 + 16 * tm + 4 * g + e) * 4) = acc[e]; }
    }
    LDS_BARRIER();
    R1P(5);
    if (tid < 128) {
        LAS float* xr = (LAS float*)(L + R1_RHS + tid * 65 * 4);
#pragma unroll 1
        for (int Tb = 0; Tb < 4; ++Tb) {
            float acc[16];
#pragma unroll
            for (int e = 0; e < 16; ++e) acc[e] = xr[16 * Tb + e];
#pragma unroll 4
            for (int i = 0; i < 16 * Tb; ++i) { const float xi = xr[i];
#pragma unroll
                for (int q = 0; q < 4; ++q) { const f32x4 lv = *(const LAS f32x4*)(L + R1_LABT + (i * 64 + 16 * Tb + 4 * q) * 4);
#pragma unroll
                    for (int e = 0; e < 4; ++e) acc[4 * q + e] = fmaf(lv[e], xi, acc[4 * q + e]); } }
#pragma unroll
            for (int ii = 0; ii < 15; ++ii) { const float xi = acc[ii];
#pragma unroll
                for (int q = (ii + 1) / 4; q < 4; ++q) { const f32x4 lv = *(const LAS f32x4*)(L + R1_LABT + ((16 * Tb + ii) * 64 + 16 * Tb + 4 * q) * 4);
#pragma unroll
                    for (int e = 0; e < 4; ++e) if (4 * q + e > ii) acc[4 * q + e] = fmaf(lv[e], xi, acc[4 * q + e]); } }
#pragma unroll
            for (int e = 0; e < 16; ++e) xr[16 * Tb + e] = acc[e];
        }
        LAS unsigned char* dst = L + (tid < 64 ? R1_WT + tid * PS * 2 : R1_ZT + (tid - 64) * PS * 2);
#pragma unroll
        for (int q8 = 0; q8 < 8; ++q8) { u32x4 w; w.x = pk2(xr[8 * q8], xr[8 * q8 + 1]); w.y = pk2(xr[8 * q8 + 2], xr[8 * q8 + 3]); w.z = pk2(xr[8 * q8 + 4], xr[8 * q8 + 5]); w.w = pk2(xr[8 * q8 + 6], xr[8 * q8 + 7]); *(LAS u32x4*)(dst + q8 * 16) = w; }
    }
    LDS_BARRIER();
    R1P(6);
    {
        unsigned char* rw1 = p.ws + WS_RW1 + (size_t)unit * 16384;
#pragma unroll
        for (int nn = 0; nn < 2; ++nn) { const int tn = 2 * (wave & 1) + nn, col = 16 * tn + c15, r0 = 16 * tm + 4 * g;
            f32x4 aP = {0.f, 0.f, 0.f, 0.f}, aQ = aP, aG = aP, aY = aP;
#pragma unroll
            for (int s2 = 0; s2 < 2; ++s2) { const int ro = ((16 * tm + c15) * PS + 32 * s2 + 8 * g) * 2, co = ((16 * tn + c15) * PS + 32 * s2 + 8 * g) * 2;
                const bf16x8 fWT = *(const LAS bf16x8*)(L + R1_WT + ro), fBTT = *(const LAS bf16x8*)(L + R1_BTT + ro), fKTT = *(const LAS bf16x8*)(L + R1_KTT + ro), fMRB = *(const LAS bf16x8*)(L + R1_MRB + ro), fMRK = *(const LAS bf16x8*)(L + R1_MRK + ro);
                const bf16x8 cBTT = *(const LAS bf16x8*)(L + R1_BTT + co), cZT = *(const LAS bf16x8*)(L + R1_ZT + co), cVT = *(const LAS bf16x8*)(L + R1_VT + co), cMRB = *(const LAS bf16x8*)(L + R1_MRB + co);
                aP = mfma16(fWT, cBTT, aP);
                aQ = mfma16(fBTT, cZT, aQ); aQ = mfma16(fKTT, cVT, aQ);
                aG = mfma16(fWT, cMRB, aG);
                aY = mfma16(fMRB, cZT, aY); aY = mfma16(fMRK, cVT, aY); }
            const float gcc = *(const LAS float*)(L + R1_GC + col * 4);
            const f32x4 gcr = *(const LAS f32x4*)(L + R1_GC + r0 * 4);
            const u32x2 rtw = *(const LAS u32x2*)(L + R1_RT + (col * PS + r0) * 2);
#pragma unroll
            for (int e = 0; e < 4; ++e) { aP[e] = (aP[e] + ((r0 + e) == col ? 1.0f : 0.f)) * gcc; aQ[e] *= gcr[e]; }
            aG[0] += bflo(rtw.x); aG[1] += bfhi(rtw.x); aG[2] += bflo(rtw.y); aG[3] += bfhi(rtw.y);
            *(u32x2*)(rw1 + (size_t)(col * 64 + r0) * 2) = pk4(aP);
            *(u32x2*)(rw1 + 8192 + (size_t)(col * 64 + r0) * 2) = pk4(aG);
            *(u32x2*)(rw2 + (size_t)(col * 64 + r0) * 2) = pk4(aQ);
            *(u32x2*)(rw2 + RW2_ARR + (size_t)(col * 64 + r0) * 2) = pk4(aY); }
    }
    LDS_BARRIER();
    R1P(7);
}

constexpr int R2_SV = 0, R2_YS = 2 * 64 * PS * 2, R2_END = R2_YS + 2 * 64 * 68 * 4;
__device__ __forceinline__ void rwkv_scan(const Params& p, int l, int bh, unsigned char* lds) {
    const int tid = otid(), wave = tid >> 6, lane = tid & 63, c15 = lane & 15, g = lane >> 4;
    const int b = bh >> 3, h = bh & 7, role = wave >> 2, j = wave & 3, vcol = 16 * j + c15;
    LAS unsigned char* L = (LAS unsigned char*)lds;
    for (int i = tid; i < 2 * 64 * PS * 2 / 4; i += NTHREADS) ((LAS unsigned*)(L + R2_SV))[i] = 0u;
    LDS_BARRIER();
    const int et = tid >> 3, ev0 = 8 * (tid & 7);
    f32x4 gn0[2], gn1[2];
    { const float* gp = p.in[I_GNG] + l * 512 + h * 64 + ev0; const float* bp = p.in[I_GNB] + l * 512 + h * 64 + ev0;
      gn0[0] = *(const f32x4*)gp; gn0[1] = *(const f32x4*)(gp + 4); gn1[0] = *(const f32x4*)bp; gn1[1] = *(const f32x4*)(bp + 4); }
    bf16_t* OB = (bf16_t*)(p.ws + WS_OAB) + (size_t)(b * LP + et) * D + 512 + h * 64 + ev0;
    const int unit0 = (b * NCH) * 8 + h;
    const unsigned char* rw1b = p.ws + WS_RW1 + (role ? 8192 : 0) + (size_t)(c15 * 64 + 8 * g) * 2;
    const unsigned char* rw2b = p.ws + WS_RW2 + (role ? RW2_ARR : 0) + (size_t)(vcol * 64 + 4 * g) * 2;
    const unsigned char* ggb = p.ws + WS_RW2 + 2 * RW2_ARR + (size_t)(et * 64 + ev0) * 2;
    bf16x8 A0[4][2], A1[4][2]; u32x2 I0[4], I1[4];
    u32x4 G0 = {0u, 0u, 0u, 0u}, O0 = G0, G1, O1;
#define R2_LOAD(AA, II, cc) do { const size_t un_ = (size_t)(unit0 + 8 * ((cc) < NCH ? (cc) : NCH - 1)); \
        _Pragma("unroll") for (int m = 0; m < 4; ++m) { II[m] = *(const u32x2*)(rw2b + un_ * 8192 + 32 * m); \
            _Pragma("unroll") for (int s2 = 0; s2 < 2; ++s2) AA[m][s2] = *(const bf16x8*)(rw1b + un_ * 16384 + (16 * m * 64 + 32 * s2) * 2); } } while (0)
    R2_LOAD(A0, I0, 0); R2_LOAD(A1, I1, 1);
    G1 = *(const u32x4*)(ggb + (size_t)unit0 * 8192); O1 = *(const u32x4*)OB;
#pragma unroll 1
    for (int c = 0; c <= NCH; ++c) {
        const int cur = c & 1;
        bf16x8 A2[4][2]; u32x2 I2[4];
        R2_LOAD(A2, I2, c + 2);
        u32x4 G2, O2; { const int cn = c + 1 < NCH ? c + 1 : NCH - 1; G2 = *(const u32x4*)(ggb + (size_t)(unit0 + 8 * cn) * 8192); O2 = *(const u32x4*)(OB + (size_t)(64 * cn) * D); }
        if (c > 0) {
            const f32x4 y0 = *(const LAS f32x4*)(L + R2_YS + ((cur ^ 1) * 64 * 68 + et * 68 + ev0) * 4), y1 = *(const LAS f32x4*)(L + R2_YS + ((cur ^ 1) * 64 * 68 + et * 68 + ev0 + 4) * 4);
            float s1 = (y0[0] + y0[1]) + (y0[2] + y0[3]) + (y1[0] + y1[1]) + (y1[2] + y1[3]);
            s1 = sum8(s1); const float mean = s1 * (1.f / 64.f);
            const f32x4 d0 = y0 - mean, d1 = y1 - mean;
            float s2_ = (d0[0] * d0[0] + d0[1] * d0[1]) + (d0[2] * d0[2] + d0[3] * d0[3]) + (d1[0] * d1[0] + d1[1] * d1[1]) + (d1[2] * d1[2] + d1[3] * d1[3]);
            s2_ = sum8(s2_); const float rstd = rsqrtf(s2_ * (1.f / 64.f) + GN_EPS);
            const float gv[8] = {bflo(G0.x), bfhi(G0.x), bflo(G0.y), bfhi(G0.y), bflo(G0.z), bfhi(G0.z), bflo(G0.w), bfhi(G0.w)};
            const float ov[8] = {bflo(O0.x), bfhi(O0.x), bflo(O0.y), bfhi(O0.y), bflo(O0.z), bfhi(O0.z), bflo(O0.w), bfhi(O0.w)};
            float o[8];
#pragma unroll
            for (int i = 0; i < 4; ++i) { o[i] = ov[i] + (d0[i] * rstd * gn0[0][i] + gn1[0][i]) * gv[i]; o[4 + i] = ov[4 + i] + (d1[i] * rstd * gn0[1][i] + gn1[1][i]) * gv[4 + i]; }
            u32x4 w; w.x = pk2(o[0], o[1]); w.y = pk2(o[2], o[3]); w.z = pk2(o[4], o[5]); w.w = pk2(o[6], o[7]);
            *(u32x4*)(OB + (size_t)(64 * (c - 1)) * D) = w;
        }
        if (c < NCH) {
            bf16x8 bf_[2];
#pragma unroll
            for (int s2 = 0; s2 < 2; ++s2) bf_[s2] = *(const LAS bf16x8*)(L + R2_SV + cur * 64 * PS * 2 + (vcol * PS + 32 * s2 + 8 * g) * 2);
            f32x4 acc[4];
#pragma unroll
            for (int m = 0; m < 4; ++m) { acc[m] = (f32x4){bflo(I0[m].x), bfhi(I0[m].x), bflo(I0[m].y), bfhi(I0[m].y)};
#pragma unroll
                for (int s2 = 0; s2 < 2; ++s2) acc[m] = mfma16(A0[m][s2], bf_[s2], acc[m]); }
            if (role == 0) {
#pragma unroll
                for (int m = 0; m < 4; ++m) *(LAS u32x2*)(L + R2_SV + (cur ^ 1) * 64 * PS * 2 + (vcol * PS + 16 * m + 4 * g) * 2) = pk4(acc[m]);
            } else {
#pragma unroll
                for (int m = 0; m < 4; ++m)
#pragma unroll
                    for (int e = 0; e < 4; ++e) *(LAS float*)(L + R2_YS + (cur * 64 * 68 + (16 * m + 4 * g + e) * 68 + vcol) * 4) = acc[m][e];
            }
        }
        LDS_BARRIER();
#pragma unroll
        for (int m = 0; m < 4; ++m) { I0[m] = I1[m]; I1[m] = I2[m]; A0[m][0] = A1[m][0]; A0[m][1] = A1[m][1]; A1[m][0] = A2[m][0]; A1[m][1] = A2[m][1]; }
        G0 = G1; O0 = O1; G1 = G2; O1 = O2;
    }
#undef R2_LOAD
}

__device__ void rwkv_naive(const Params& p, int l, int bh, unsigned char* lds) {
    const int b = bh >> 3, h = bh & 7, tid = otid(), lane = tid & 63, wid = tid >> 6;
    const bf16_t* U = (const bf16_t*)(p.ws + WS_UAR);
    bf16_t* OB = (bf16_t*)(p.ws + WS_OAB);
    float* xs = (float*)lds;
    float* vr = xs + 32 * 256;
    float* vw = vr + 2048; float* vkk = vw + 2048; float* vbb = vkk + 2048; float* vk = vbb + 2048; float* vv = vk + 2048;
    float* gg = vv + 2048; float* bon = gg + 2048; float* ys = bon + 2048;
    const float* mu = p.in[I_MU] + l * R_COLS;
    const int hd = h * 64 + lane;
    const float w0 = p.in[I_W0][l * 512 + hd], a0 = p.in[I_A0][l * 512 + hd], kkc = p.in[I_KK][l * 512 + hd], kac = p.in[I_KA][l * 512 + hd], rkc = p.in[I_RK][l * 512 + hd];
    const float gng = p.in[I_GNG][l * 512 + hd], gnb = p.in[I_GNB][l * 512 + hd];
    const float mur = mu[hd], muk = mu[512 + hd], muv = mu[1024 + hd];
    const float* wup = p.in[I_WUP] + (size_t)l * 64 * 512 + hd; const float* aup = p.in[I_AUP] + (size_t)l * 64 * 512 + hd; const float* gup = p.in[I_GUP] + (size_t)l * 128 * 512 + hd;
    float S[8];
#pragma unroll
    for (int i = 0; i < 8; ++i) S[i] = 0.f;
    const int sv = tid >> 3, sq = tid & 7;
    for (int p0 = 0; p0 < LP; p0 += 32) {
        for (int idx = tid; idx < 32 * 256; idx += NTHREADS) {
            const int tt = idx >> 8, j = idx & 255, pos = p0 + tt; const size_t ro = (size_t)(b * LP + pos) * UARW;
            const float x = bf2f(U[ro + C_XW + j]); const float xp = pos > 0 ? bf2f(U[ro - UARW + C_XW + j]) : 0.f;
            float xv = x + (xp - x) * mu[1536 + j];
            if (j < 64) xv = tanhf(xv); else if (j >= 128) xv = sigmoidf_(xv);
            xs[idx] = xv;
        }
        __syncthreads();
        {
            float dw[4] = {0.f, 0.f, 0.f, 0.f}, da[4] = {0.f, 0.f, 0.f, 0.f}, dg[4] = {0.f, 0.f, 0.f, 0.f};
            for (int j = 0; j < 64; ++j) { const float w1 = wup[(size_t)j * 512], w2 = aup[(size_t)j * 512];
#pragma unroll
                for (int k = 0; k < 4; ++k) { dw[k] = fmaf(xs[(wid * 4 + k) * 256 + j], w1, dw[k]); da[k] = fmaf(xs[(wid * 4 + k) * 256 + 64 + j], w2, da[k]); } }
            for (int j = 0; j < 128; ++j) { const float w3 = gup[(size_t)j * 512];
#pragma unroll
                for (int k = 0; k < 4; ++k) dg[k] = fmaf(xs[(wid * 4 + k) * 256 + 128 + j], w3, dg[k]); }
#pragma unroll
            for (int k = 0; k < 4; ++k) {
                const int tt = wid * 4 + k, pos = p0 + tt; const size_t ro = (size_t)(b * LP + pos) * UARW;
                float r = bf2f(U[ro + C_R + hd]), kx = bf2f(U[ro + C_RK + hd]), vx = bf2f(U[ro + C_RV + hd]);
                if (pos > 0) { const float rp = bf2f(U[ro - UARW + C_R + hd]), kp = bf2f(U[ro - UARW + C_RK + hd]), vp = bf2f(U[ro - UARW + C_RV + hd]);
                    r += (rp - r) * mur; kx += (kp - kx) * muk; vx += (vp - vx) * muv; }
                else { r -= r * mur; kx -= kx * muk; vx -= vx * muv; }
                const float z = -(w0 + dw[k]); const float sp = fmaxf(z, 0.f) + log1pf(__expf(-fabsf(z)));
                const float logw = -sp - 0.5f; const float w = __expf(-__expf(logw));
                const float a = sigmoidf_(a0 + da[k]);
                float kk = kx * kkc; const float nrm = wave_sum(kk * kk); kk *= rsqrtf(fmaxf(nrm, 1e-24f));
                const float kmod = kx * (1.0f + (a - 1.0f) * kac);
                const float bsum = wave_sum(r * kmod * rkc);
                vr[tt * 64 + lane] = r; vw[tt * 64 + lane] = w; vkk[tt * 64 + lane] = kk; vbb[tt * 64 + lane] = kk * a; vk[tt * 64 + lane] = kmod; vv[tt * 64 + lane] = vx;
                gg[tt * 64 + lane] = dg[k]; bon[tt * 64 + lane] = bsum * vx;
            }
        }
        __syncthreads();
        for (int tt = 0; tt < 32; ++tt) {
            const f32x4 k0 = *(const f32x4*)(vkk + tt * 64 + sq * 8), k1 = *(const f32x4*)(vkk + tt * 64 + sq * 8 + 4);
            const f32x4 w0v = *(const f32x4*)(vw + tt * 64 + sq * 8), w1v = *(const f32x4*)(vw + tt * 64 + sq * 8 + 4);
            const f32x4 b0 = *(const f32x4*)(vbb + tt * 64 + sq * 8), b1 = *(const f32x4*)(vbb + tt * 64 + sq * 8 + 4);
            const f32x4 m0 = *(const f32x4*)(vk + tt * 64 + sq * 8), m1 = *(const f32x4*)(vk + tt * 64 + sq * 8 + 4);
            const f32x4 r0 = *(const f32x4*)(vr + tt * 64 + sq * 8), r1 = *(const f32x4*)(vr + tt * 64 + sq * 8 + 4);
            const float vt = vv[tt * 64 + sv];
            float sa = 0.f;
#pragma unroll
            for (int i = 0; i < 4; ++i) { sa = fmaf(S[i], k0[i], sa); sa = fmaf(S[4 + i], k1[i], sa); }
            sa += __shfl_xor(sa, 1); sa += __shfl_xor(sa, 2); sa += __shfl_xor(sa, 4);
            sa = -sa; float y = 0.f;
#pragma unroll
            for (int i = 0; i < 4; ++i) { S[i] = S[i] * w0v[i] + sa * b0[i] + vt * m0[i]; S[4 + i] = S[4 + i] * w1v[i] + sa * b1[i] + vt * m1[i];
                y = fmaf(S[i], r0[i], y); y = fmaf(S[4 + i], r1[i], y); }
            y += __shfl_xor(y, 1); y += __shfl_xor(y, 2); y += __shfl_xor(y, 4);
            if (sq == 0) ys[tt * 64 + sv] = y;
        }
        __syncthreads();
#pragma unroll
        for (int k = 0; k < 4; ++k) { const int tt = wid * 4 + k, pos = p0 + tt; const float y = ys[tt * 64 + lane];
            const float m = wave_sum(y) * (1.f / 64.f); const float dv = y - m; const float var = wave_sum(dv * dv) * (1.f / 64.f);
            const float o = (dv * rsqrtf(var + GN_EPS) * gng + gnb + bon[tt * 64 + lane]) * gg[tt * 64 + lane];
            OB[(size_t)(b * LP + pos) * D + 512 + hd] = (bf16_t)f2bf(o); }
        __syncthreads();
    }
}

__device__ __forceinline__ int pair_index(int a, int b) {   return a == 0 ? b - 1 : (a == 1 ? b + 1 : 5); }
__device__ __forceinline__ void pair_of(int idx, int& a, int& b) { a = idx < 3 ? 0 : (idx < 5 ? 1 : 2); b = idx < 3 ? idx + 1 : (idx < 5 ? idx - 1 : 3); }
__device__ __forceinline__ void ln1_rows(const Params& p, int l, unsigned char* lds, int row0, bool stage) {
    const int tid = otid(), lane = tid & 63, gw = row0 + 8 * (tid >> 6), NGW = 1, TEND = gw + 8;
    int* lcnt = (int*)(lds + 65536); int* lbase = lcnt + 32; int* rec = lcnt + 64;
    __syncthreads();
    if (tid < 32) lcnt[tid] = 0;
    float* wr_s = (float*)lds;
    if (stage) for (int i = tid; i < D * 16 / 4; i += NTHREADS) { const f32x4 w = ((const f32x4*)p.in[I_WROUTER])[i]; const int c = i >> 2, e0 = (i & 3) * 4;
        wr_s[(e0 + 0) * D + c] = w[0]; wr_s[(e0 + 1) * D + c] = w[1]; wr_s[(e0 + 2) * D + c] = w[2]; wr_s[(e0 + 3) * D + c] = w[3]; }
    __syncthreads();
    unsigned* cls_cnt = (unsigned*)(p.ws + WS_CTL) + CW_CLS + l * 512;
    int* lists = (int*)(p.ws + WS_LIST); f32x2* gl = (f32x2*)(p.ws + WS_LIST + 2 * MiB);
    const float* g = p.in[I_LN1G] + l * D; const float* bt = p.in[I_LN1B] + l * D;
    f32x4 vn[4];
    { const float* h0 = hrow(p, gw);
#pragma unroll
      for (int j = 0; j < 4; ++j) vn[j] = *(const f32x4*)(h0 + 4 * lane + 256 * j); }
    int nrec = 0;
    for (int r = gw; r < TEND; r += NGW) {
        f32x4 v[4];
#pragma unroll
        for (int j = 0; j < 4; ++j) v[j] = vn[j];
        { const float* h1 = hrow(p, r + NGW < TEND ? r + NGW : r);
#pragma unroll
          for (int j = 0; j < 4; ++j) vn[j] = *(const f32x4*)(h1 + 4 * lane + 256 * j); }
        if (is_dummy(r)) {
#pragma unroll
            for (int j = 0; j < 4; ++j) v[j] = (f32x4){0.f, 0.f, 0.f, 0.f};
            store_row(p, r, v, lane, true); continue; }
        ln_wave(v, g, bt, lane);
        store_row(p, r, v, lane, false);
        float lg[16];
#pragma unroll
        for (int e = 0; e < 16; ++e) lg[e] = 0.f;
#pragma unroll
        for (int e = 0; e < 16; ++e)
#pragma unroll
            for (int j = 0; j < 4; ++j) { const f32x4 w = *(const f32x4*)(wr_s + e * D + 4 * lane + 256 * j);
                lg[e] = fmaf(v[j][0], w[0], lg[e]); lg[e] = fmaf(v[j][1], w[1], lg[e]); lg[e] = fmaf(v[j][2], w[2], lg[e]); lg[e] = fmaf(v[j][3], w[3], lg[e]); }
        float mine = 0.f;
#pragma unroll
        for (int e = 0; e < 16; ++e) { const float rs = sum16(lg[e]); mine = (lane & 15) == e ? rs : mine; }
        mine += __shfl_xor(mine, 16); mine += __shfl_xor(mine, 32);
#pragma unroll
        for (int e = 0; e < 16; ++e) lg[e] = __builtin_bit_cast(float, __builtin_amdgcn_readlane(__builtin_bit_cast(int, mine), e));
        float s[16], sel[16];
#pragma unroll
        for (int e = 0; e < 16; ++e) { s[e] = sigmoidf_(lg[e]); sel[e] = s[e] + p.in[I_BROUTER][e]; }
        int gbest = 0; float gsc = -INFINITY;
#pragma unroll
        for (int gi = 0; gi < 4; ++gi) { float m1 = -INFINITY, m2 = -INFINITY;
#pragma unroll
            for (int j = 0; j < 4; ++j) { const float x = sel[gi * 4 + j]; if (x > m1) { m2 = m1; m1 = x; } else if (x > m2) m2 = x; }
            const float sc = m1 + m2; if (sc > gsc) { gsc = sc; gbest = gi; } }
        float sg[4], sgs[4];
#pragma unroll
        for (int j = 0; j < 4; ++j) { sg[j] = gbest == 0 ? sel[j] : (gbest == 1 ? sel[4 + j] : (gbest == 2 ? sel[8 + j] : sel[12 + j])); sgs[j] = gbest == 0 ? s[j] : (gbest == 1 ? s[4 + j] : (gbest == 2 ? s[8 + j] : s[12 + j])); }
        int j1 = 0;
#pragma unroll
        for (int j = 1; j < 4; ++j) if (sg[j] > sg[j1]) j1 = j;
        int j2 = j1 == 0 ? 1 : 0;
#pragma unroll
        for (int j = 0; j < 4; ++j) if (j != j1 && j != j2 && sg[j] > sg[j2]) j2 = j;
        const int ja = j1 < j2 ? j1 : j2, jb = j1 < j2 ? j2 : j1;
        float sa_ = 0.f, sb_ = 0.f;
#pragma unroll
        for (int j = 0; j < 4; ++j) { if (j == ja) sa_ = sgs[j]; if (j == jb) sb_ = sgs[j]; }
        const float inv = 1.0f / (sa_ + sb_);
        const int cls = gbest * 6 + pair_index(ja, jb);
        if (lane == 0) { const int loc = __hip_atomic_fetch_add(lcnt + cls, 1, __ATOMIC_RELAXED, __HIP_MEMORY_SCOPE_WORKGROUP); rec[(tid >> 6) * 32 + 2 * nrec] = r; rec[(tid >> 6) * 32 + 2 * nrec + 1] = (cls << 16) | loc; gl[r] = (f32x2){sa_ * inv, sb_ * inv}; }
        ++nrec;
    }
    __syncthreads();
    if (tid < 24) lbase[tid] = (int)atomicAdd(cls_cnt + 16 * tid, (unsigned)lcnt[tid]);
    __syncthreads();
    if (lane < nrec) { const int r = rec[(tid >> 6) * 32 + 2 * lane], cl = rec[(tid >> 6) * 32 + 2 * lane + 1]; const int cls = cl >> 16; lists[(size_t)cls * T + lbase[cls] + (cl & 0xffff)] = r; }
}


constexpr size_t WS_CH1 = 655360;
constexpr int CH1_NM = 260, CH1_NW = 260, CH1_NC = 96, CH1_NL = 260, CH1_TOT = CH1_NM + CH1_NW + CH1_NC + CH1_NL;
__device__ __forceinline__ void task_signal(unsigned* c0, unsigned* c1) {
    asm volatile("s_waitcnt vmcnt(0)" ::: "memory");
    __syncthreads();
    if (otid() == 0) { __builtin_amdgcn_fence(__ATOMIC_RELEASE, "agent"); asm volatile("s_waitcnt vmcnt(0)" ::: "memory");
        __hip_atomic_fetch_add(c0, 1u, __ATOMIC_RELAXED, __HIP_MEMORY_SCOPE_AGENT); if (c1) __hip_atomic_fetch_add(c1, 1u, __ATOMIC_RELAXED, __HIP_MEMORY_SCOPE_AGENT); }
}
__device__ __forceinline__ void task_wait(unsigned* c, unsigned target) {
    if (otid() == 0) { unsigned sp = 0; while (__hip_atomic_load(c, __ATOMIC_RELAXED, __HIP_MEMORY_SCOPE_AGENT) < target && ++sp < (1u << 24)) __builtin_amdgcn_s_sleep(2);
        __builtin_amdgcn_fence(__ATOMIC_ACQUIRE, "agent"); asm volatile("s_waitcnt vmcnt(0)" ::: "memory"); }
    __syncthreads();
}
__device__ __forceinline__ void conv_expert_items(const Params& p, int l, LAS unsigned char* lds, int it0, int it1);
__device__ __forceinline__ void chain1_phase(int l, unsigned char* lds, LAS unsigned char* ldsl, unsigned long long& pacc) {
    unsigned long long pt0 = 0;
#define C1P_B(k) do { if (PROBE_PHASE == (k)) pt0 = __builtin_amdgcn_s_memrealtime(); } while (0)
#define C1P_E(k) do { if (PROBE_PHASE == (k)) pacc += __builtin_amdgcn_s_memrealtime() - pt0; } while (0)
    int staged = 0;
    for (;;) {
        unsigned* chq = (unsigned*)(PP().ws + WS_CH1) + 1024 * l;
        volatile int* uw = (volatile int*)(lds + 144000);
        __syncthreads();
        if (otid() == 0) *uw = (int)atomicAdd(chq, 1u);
        __syncthreads();
        const int t = __builtin_amdgcn_readfirstlane(*uw);
        if (t >= CH1_TOT) break;
        if (t < CH1_NM) { const int pm = t >> 2, pn = t & 3;
            C1P_B(50); merge_unit(l, ldsl, pm, pn);
            task_signal(chq + 64 + pm, chq + 16); C1P_E(50);
        } else if (t < CH1_NM + CH1_NW) { const int u = t - CH1_NM, pm = u >> 2, pn = u & 3;
            C1P_B(54); task_wait(chq + 64 + pm, 4u); C1P_E(54);
            C1P_B(51); wout_unit(l, ldsl, pm, pn);
            task_signal(chq + 192 + pm, nullptr); C1P_E(51);
        } else if (t < CH1_NM + CH1_NW + CH1_NC) { const int u = t - CH1_NM - CH1_NW;
            C1P_B(54); task_wait(chq + 16, (unsigned)CH1_NM); C1P_E(54);
            C1P_B(52); conv_expert_items(PP(), l, ldsl, u * 128, u * 128 + 128); C1P_E(52);
        } else { const int u = t - CH1_NM - CH1_NW - CH1_NC, pm = u >> 2, qr = u & 3;
            C1P_B(54); task_wait(chq + 16, (unsigned)CH1_NM);
            task_wait(chq + 192 + pm, 4u); C1P_E(54);
            C1P_B(53); ln1_rows(PP(), l, lds, pm * 256 + qr * 64, staged == 0); staged = 1; C1P_E(53);
        }
    }
}

struct ClsTab { int cnt[24]; int tile0[25]; int row0[24]; };
__device__ __forceinline__ void build_cls_table(const Params& p, int l, int* tab  ) {
    if (otid() == 0) { const unsigned* c = (const unsigned*)(p.ws + WS_CTL) + CW_CLS + l * 512; int acc = 0;
        for (int i = 0; i < 24; ++i) { const int n = (int)__hip_atomic_load(c + 16 * i, __ATOMIC_RELAXED, __HIP_MEMORY_SCOPE_AGENT); tab[i] = n; tab[24 + i] = acc; acc += (n + 255) >> 8; }
        tab[48] = acc; }
    __syncthreads();
}
__device__ __forceinline__ int find_cls(const int* tab, int tile) { int c = 0;
#pragma unroll 1
    for (int i = 1; i < 24; ++i) if (tile >= tab[24 + i]) c = i;
    return c; }
__device__ __forceinline__ void moe_a_unit(int l, LAS unsigned char* lds, const int* tab, int tile, int pn) {
    const int tid = otid();
    unsigned voffB[2]; g8::make_voffB(voffB, D * 2, true);
    {
        const int cls = find_cls(tab, tile), rt = tile - tab[24 + cls], n = tab[cls];
        int ja, jb; pair_of(cls % 6, ja, jb); const int eslot = pn >> 2, e = (cls / 6) * 4 + (eslot ? jb : ja), jblk = pn & 3;
        unsigned voffA[2][2]; { const int* lists = (const int*)(PP().ws + WS_LIST);
#pragma unroll
        for (int i = 0; i < 2; ++i) { int R, C; g8::stage_rc(tid * 16 + i * 8192, R, C);
#pragma unroll
            for (int hh = 0; hh < 2; ++hh) { const int li = rt * 256 + R + hh * 128; const int tok = li < n ? lists[(size_t)cls * T + li] : 0;
                voffA[hh][i] = (unsigned)tok * (D * 2) + (unsigned)C * 2u; } } }
        g8::Acc acc; g8::zero_acc(acc);
        const char* Bb = (const char*)(PP().ws + WS_WEXP) + ((size_t)e * 1024 + jblk * 256) * D * 2;
        const g8::KSeg s = g8::seg1((const char*)(PP().ws + WS_HB), Bb, Bb + (size_t)128 * D * 2, D / 64);
        g8::kloop<true, false>(lds, acc, s, voffA, voffB, 0);
        EPI_COORDS();
        const int* lists = (const int*)(PP().ws + WS_LIST); const f32x2* gl = (const f32x2*)(PP().ws + WS_LIST + 2 * MiB); bf16_t* ACT = (bf16_t*)(PP().ws + WS_ACT);
        int tk[2][4]; float gt[2][4];
#pragma unroll
        for (int ai = 0; ai < 2; ++ai)
#pragma unroll
            for (int m = 0; m < 4; ++m) { const int li = rt * 256 + ai * 128 + wr * 64 + m * 16 + fr; tk[ai][m] = li < n ? lists[(size_t)cls * T + li] : -1; }
#pragma unroll
        for (int ai = 0; ai < 2; ++ai)
#pragma unroll
            for (int m = 0; m < 4; ++m) { const f32x2 g2 = gl[tk[ai][m] >= 0 ? tk[ai][m] : 0]; gt[ai][m] = tk[ai][m] >= 0 ? (eslot ? g2[1] : g2[0]) : 0.f; }
#pragma unroll
        for (int ai = 0; ai < 2; ++ai)
#pragma unroll
            for (int m = 0; m < 4; ++m) { const float gate = gt[ai][m];
                const f32x4 h1a = acc[ai][0][m][0], h1b = acc[ai][0][m][1], h3a = acc[ai][1][m][0], h3b = acc[ai][1][m][1];
                float o[8];
#pragma unroll
                for (int c = 0; c < 4; ++c) { o[c] = gate * (h1a[c] * sigmoidf_(h1a[c])) * h3a[c]; o[4 + c] = gate * (h1b[c] * sigmoidf_(h1b[c])) * h3b[c]; }
                u32x4 w; w.x = pk2(o[0], o[1]); w.y = pk2(o[2], o[3]); w.z = pk2(o[4], o[5]); w.w = pk2(o[6], o[7]);
                *(u32x4*)(ACT + (size_t)(tile * 256 + ai * 128 + wr * 64 + m * 16 + fr) * D + eslot * 512 + jblk * 128 + wc * 32 + 8 * fq) = w; }
    }
}
__device__ __forceinline__ void moe_b_unit(int l, LAS unsigned char* lds, const int* tab, int tile, int pn) {
    unsigned voffA[2][2], voffB[2]; g8::make_voff_contig(voffA, D * 2); g8::make_voffB(voffB, 512 * 2, false);
    {
        const int cls = find_cls(tab, tile), rt = tile - tab[24 + cls], n = tab[cls];
        int ja, jb; pair_of(cls % 6, ja, jb); const int ea = (cls / 6) * 4 + ja, eb = (cls / 6) * 4 + jb;
        g8::Acc acc; g8::zero_acc(acc);
        const char* At = (const char*)(PP().ws + WS_ACT) + (size_t)tile * 256 * D * 2;
        const char* W2 = (const char*)(PP().ws + WS_WEXP + 32 * MiB);
        const char* Ba = W2 + ((size_t)ea * 1024 + pn * 256) * 512 * 2; const char* Bb = W2 + ((size_t)eb * 1024 + pn * 256) * 512 * 2;
        g8::KSeg s2 = g8::seg1(At, Ba, Ba + (size_t)128 * 512 * 2, 16); s2.nt0 = 8; s2.A2 = At + 1024; s2.B02 = Bb; s2.B12 = Bb + (size_t)128 * 512 * 2;
        g8::kloop<false, true>(lds, acc, s2, voffA, voffB, 128 * D * 2);
        EPI_COORDS();
        const int* lists = (const int*)(PP().ws + WS_LIST);
        const int col0 = pn * 256 + wc * 32 + 4 * fq;
        int tk[2][4];
#pragma unroll
        for (int ai = 0; ai < 2; ++ai)
#pragma unroll
            for (int m = 0; m < 4; ++m) { const int li = rt * 256 + ai * 128 + wr * 64 + m * 16 + fr; tk[ai][m] = li < n ? lists[(size_t)cls * T + li] : -1; }
#pragma unroll
        for (int ai = 0; ai < 2; ++ai) { asm volatile("" ::: "memory");
            f32x4 pre[4][2][2]; float* hr[4];
#pragma unroll
            for (int m = 0; m < 4; ++m) { hr[m] = hrow(PP(), tk[ai][m] >= 0 ? tk[ai][m] : 0) + col0;
#pragma unroll
                for (int bj = 0; bj < 2; ++bj)
#pragma unroll
                    for (int nn = 0; nn < 2; ++nn) pre[m][bj][nn] = *(const f32x4*)(hr[m] + bj * 128 + nn * 16); }
#pragma unroll
            for (int m = 0; m < 4; ++m) if (tk[ai][m] >= 0) {
#pragma unroll
                for (int bj = 0; bj < 2; ++bj)
#pragma unroll
                    for (int nn = 0; nn < 2; ++nn) *(f32x4*)(hr[m] + bj * 128 + nn * 16) = pre[m][bj][nn] * ALPHA + acc[ai][bj][m][nn]; } }
    }
}

__device__ __forceinline__ void chain2_phase(int l, unsigned char* lds, LAS unsigned char* ldsl, const int* tab) {
    const int ntiles = tab[48], nA = 8 * ntiles, ntot = nA + 4 * ntiles;
    for (;;) {
        unsigned* chq = (unsigned*)(PP().ws + WS_CH1) + 1024 * l + 512;
        volatile int* uw = (volatile int*)(lds + 144000);
        __syncthreads();
        if (otid() == 0) *uw = (int)atomicAdd(chq, 1u);
        __syncthreads();
        const int t = __builtin_amdgcn_readfirstlane(*uw);
        if (t >= ntot) break;
        if (t < nA) { const int tile = t >> 3;
            moe_a_unit(l, ldsl, tab, tile, t & 7);
            task_signal(chq + 16 + tile, nullptr);
        } else { const int u = t - nA, tile = u >> 2;
            task_wait(chq + 16 + tile, 8u);
            moe_b_unit(l, ldsl, tab, tile, u & 3);
        }
    }
}
__device__ __forceinline__ void ln2_phase(const Params& p, int l) {
    const int tid = otid(), lane = tid & 63, gw = obid() * NWAVES + (tid >> 6), NGW = gridDim.x * NWAVES;
    const float* g = p.in[I_LN2G] + l * D; const float* bt = p.in[I_LN2B] + l * D;
    for (int r = gw; r < T; r += NGW) {
        f32x4 v[4];
        if (is_dummy(r)) {
#pragma unroll
            for (int j = 0; j < 4; ++j) v[j] = (f32x4){0.f, 0.f, 0.f, 0.f};
            store_row(p, r, v, lane, true); continue; }
        const float* hr = hrow(p, r);
#pragma unroll
        for (int j = 0; j < 4; ++j) v[j] = *(const f32x4*)(hr + 4 * lane + 256 * j);
        ln_wave(v, g, bt, lane);
        store_row(p, r, v, lane, false);
    }
}


#define XB_TMO      128
#define XB_XCNT(j)  (256  + 64 * (j))
#define XB_XSUB(j)  (1280 + 64 * (j))
#define XB_XGEN(j)  (2304 + 64 * (j))
#define XB_TOP      3328
#define XB_TOPGEN   3392
#define XCD_BAR_WORDS 3456
#define XB_SPIN_CAP (1u << 22)
constexpr size_t WS_BAR = 8192;
constexpr int LDS_BARST = LDS_BYTES - 16;
__device__ __forceinline__ unsigned xb_ld(unsigned* p)              { return __hip_atomic_load(p, __ATOMIC_RELAXED, __HIP_MEMORY_SCOPE_AGENT); }
__device__ __forceinline__ unsigned xb_add(unsigned* p, unsigned v) { return __hip_atomic_fetch_add(p, v, __ATOMIC_RELAXED, __HIP_MEMORY_SCOPE_AGENT); }
__device__ __forceinline__ unsigned xb_xcc_id() { return (unsigned)__builtin_amdgcn_s_getreg((3 << 11) | 20) & 0xFu; }
#define XB_SPIN(cond, bar) do { unsigned _sp = 0; while (cond) { __builtin_amdgcn_s_sleep(1); \
    if ((++_sp & 255u) == 0u) { if (xb_ld(&(bar)[XB_TMO])) break; if (_sp > XB_SPIN_CAP) { atomicAdd(&(bar)[XB_TMO], 1u); break; } } } } while (0)
__device__ __forceinline__ void xcd_barrier_complete(unsigned* bar, unsigned x, unsigned& nloc, unsigned& nx) {
    const unsigned G = gridDim.x * gridDim.y * gridDim.z;
    unsigned sum, cnt, mine, sp = 0u;
    for (;;) {
        sum = 0u; cnt = 0u; mine = 0u;
#pragma unroll
        for (unsigned j = 0; j < 16; ++j) { const unsigned c = xb_ld(&bar[XB_XCNT(j)]); sum += c; cnt += (c > 0u) ? 1u : 0u; mine = (j == x) ? c : mine; }
        if (sum == G) break;
        __builtin_amdgcn_s_sleep(1);
        if ((++sp & 255u) == 0u) { if (xb_ld(&bar[XB_TMO])) break; if (sp > XB_SPIN_CAP) { atomicAdd(&bar[XB_TMO], 1u); break; } }
    }
    nloc = mine > 0u ? mine : 1u; nx = cnt > 0u ? cnt : 1u;
}
__device__ __forceinline__ void xcd_barrier(unsigned* bar, volatile LAS unsigned* st) {
    asm volatile("s_waitcnt vmcnt(0)" ::: "memory");
    __syncthreads();
    if (threadIdx.x == 0) {
        __builtin_amdgcn_s_waitcnt(0);
        const unsigned x = xb_xcc_id();
        unsigned nloc = st[0], nx = st[1];
        if (nloc == 0u) { xcd_barrier_complete(bar, x, nloc, nx); st[0] = nloc; st[1] = nx; }
        const unsigned old = xb_add(&bar[XB_XSUB(x)], 1u);
        const unsigned gen = old / nloc;
        if (old + 1u == (gen + 1u) * nloc) {
            __builtin_amdgcn_fence(__ATOMIC_RELEASE, "agent");
            asm volatile("s_waitcnt vmcnt(0)" ::: "memory");
            const unsigned og = xb_add(&bar[XB_TOP], 1u);
            const unsigned tg = og / nx;
            if (og + 1u == (tg + 1u) * nx) xb_add(&bar[XB_TOPGEN], 1u);
            else XB_SPIN(xb_ld(&bar[XB_TOPGEN]) == tg, bar);
            __builtin_amdgcn_fence(__ATOMIC_ACQUIRE, "agent");
            xb_add(&bar[XB_XGEN(x)], 1u);
            asm volatile("s_waitcnt vmcnt(0)" ::: "memory");
        } else {
            XB_SPIN(xb_ld(&bar[XB_XGEN(x)]) == gen, bar);
            __builtin_amdgcn_fence(__ATOMIC_ACQUIRE, "agent");
            asm volatile("s_waitcnt vmcnt(0)" ::: "memory");
        }
    }
    __syncthreads();
}

__global__ void __launch_bounds__(NTHREADS, 2) mega(Params p_unused) {
    extern __shared__ __attribute__((aligned(16))) unsigned char lds[];
    cg::grid_group grid = cg::this_grid();
    volatile LAS unsigned* barst = (volatile LAS unsigned*)((LAS unsigned char*)lds + LDS_BARST);
    { unsigned* bar0 = (unsigned*)(PP().ws + WS_BAR);
      if (threadIdx.x == 0) { barst[0] = 0u; barst[1] = 0u; (void)xb_add(bar0 + XB_XCNT(xb_xcc_id()), 1u); } }
    __syncthreads();
#define GBAR() xcd_barrier((unsigned*)(PP().ws + WS_BAR), barst)
    unsigned long long pr_t0 = 0, pr_acc = 0;
#define PH_BEGIN(k) do { if (PROBE_PHASE == (k)) pr_t0 = __builtin_amdgcn_s_memrealtime(); } while (0)
#define PH_END(k) do { if (PROBE_PHASE == (k)) pr_acc += __builtin_amdgcn_s_memrealtime() - pr_t0; } while (0)
#define LDSG() (lds + ozero())
#define LDSL() ((LAS unsigned char*)lds)

    PH_BEGIN(0);
    conv_small_weights(PP(), LDSL());
    ln_in_phase(PP());
    if (gridDim.y == 0x7fffffffu) grid.sync();
    GBAR();
    PH_END(0);
#pragma unroll 1
    for (int l = 0; l < DEPTH; ++l) {
        PH_BEGIN(1);
        inproj_phase(PP(), l, LDSL());
        GBAR();
        PH_END(1); PH_BEGIN(2);
        {
            unsigned* qctr = (unsigned*)(PP().ws + WS_CTL) + CW_R1Q + 2 * l;
            volatile int* uw = (volatile int*)(LDSG() + AT_UNIT);
            int ndone = 0;
            for (;;) {
                __syncthreads();
                if (otid() == 0) *uw = (int)atomicAdd(qctr, 1u);
                __syncthreads();
                const int u = *uw;
                if (u >= INP_TAIL + BATCH * NCH * 8) break;
                if (u < INP_TAIL) { inproj_tail_unit(l, LDSL(), u); continue; }
                if (PROBE_PHASE == 30) pr_t0 = __builtin_amdgcn_s_memrealtime();
                rwkv_prep_unit(PP(), l, u - INP_TAIL, LDSG(), pr_acc); ++ndone;
                if (PROBE_PHASE == 30) pr_acc += __builtin_amdgcn_s_memrealtime() - pr_t0;
            }
            asm volatile("s_waitcnt vmcnt(0)" ::: "memory");
            __syncthreads();
            if (otid() == 0 && ndone > 0) { __builtin_amdgcn_fence(__ATOMIC_RELEASE, "agent"); asm volatile("s_waitcnt vmcnt(0)" ::: "memory"); __hip_atomic_fetch_add(qctr + 1, (unsigned)ndone, __ATOMIC_RELAXED, __HIP_MEMORY_SCOPE_AGENT); }
            const int bid = obid();
            if (bid < 32) {
                if (otid() == 0) { unsigned sp = 0; while (__hip_atomic_load(qctr + 1, __ATOMIC_RELAXED, __HIP_MEMORY_SCOPE_AGENT) < (unsigned)(BATCH * NCH * 8) && ++sp < (1u << 26)) __builtin_amdgcn_s_sleep(4);
                    __builtin_amdgcn_fence(__ATOMIC_ACQUIRE, "agent"); asm volatile("s_waitcnt vmcnt(0)" ::: "memory"); }
                __syncthreads();
                rwkv_scan(PP(), l, bid, LDSG());
            }
            attn_phase(PP(), l, LDSG(), pr_acc);
        }
        GBAR();
        PH_END(2); PH_BEGIN(4);
        chain1_phase(l, LDSG(), LDSL(), pr_acc);
        GBAR();
        PH_END(4); PH_BEGIN(7);
        { int toff = 140 * 1024; asm volatile("" : "+s"(toff)); int* tab = (int*)(lds + toff);
          build_cls_table(PP(), l, tab);
          chain2_phase(l, LDSG(), LDSL(), tab); }
        GBAR();
        PH_END(8); PH_BEGIN(9);
        ln2_phase(PP(), l);
        if (l + 1 < DEPTH) GBAR();
        PH_END(9);
    }
    if (PROBE_PHASE >= 0 && blockIdx.x == PROBE_BLOCK && threadIdx.x == 0) { const unsigned long long t = __builtin_amdgcn_s_memrealtime(); while (__builtin_amdgcn_s_memrealtime() - t < pr_acc) __builtin_amdgcn_s_sleep(8); }
}

extern "C" void kernel_launch(void* const* d_in, const int* in_sizes, int n_in, void* d_out, int out_size,
                              void* d_ws, size_t ws_size, hipStream_t stream) {
    static int grid_blocks = 0;
    if (grid_blocks == 0) {
        int dev = 0, cus = 0, per_cu = 0;
        if (n_in != 29 || ws_size < WS_END || out_size != BATCH * SEQ * D) { fprintf(stderr, "kernel_launch: unexpected problem (n_in %d, ws %zu, out %d)\n", n_in, ws_size, out_size); grid_blocks = -1; return; }
        (void)hipGetDevice(&dev);
        (void)hipDeviceGetAttribute(&cus, hipDeviceAttributeMultiprocessorCount, dev);
        (void)hipFuncSetAttribute((const void*)mega, hipFuncAttributeMaxDynamicSharedMemorySize, LDS_BYTES);
        (void)hipOccupancyMaxActiveBlocksPerMultiprocessor(&per_cu, (const void*)mega, NTHREADS, LDS_BYTES);
        if (per_cu < 1) { fprintf(stderr, "occupancy query returned %d\n", per_cu); grid_blocks = -1; return; }
        grid_blocks = cus;
    }
    if (grid_blocks < 0) return;
    (void)hipMemsetAsync((char*)d_ws + WS_CTL, 0, 32768, stream);
    (void)hipMemsetAsync((char*)d_ws + WS_CH1, 0, 16384, stream);
    Params p{};
    for (int i = 0; i < 29; ++i) p.in[i] = (const float*)d_in[i];
    p.out = (float*)d_out; p.ws = (unsigned char*)d_ws;
    void* args[] = {&p};
    hipError_t e = hipLaunchCooperativeKernel((const void*)mega, dim3(grid_blocks), dim3(NTHREADS), args, LDS_BYTES, stream);
    if (e != hipSuccess) fprintf(stderr, "cooperative launch failed: %s (grid %d)\n", hipGetErrorString(e), grid_blocks);
}
```

```cpp
#include <hip/hip_runtime.h>
#include <hip/hip_cooperative_groups.h>
#include <cstdio>
#include <cstdint>
namespace cg = cooperative_groups;

#define LAS __attribute__((address_space(3)))
typedef unsigned short bf16_t;
typedef short bf16x8 __attribute__((ext_vector_type(8)));
typedef float f32x4 __attribute__((ext_vector_type(4)));
typedef float f32x2 __attribute__((ext_vector_type(2)));
typedef unsigned u32x4 __attribute__((ext_vector_type(4)));
typedef unsigned u32x2 __attribute__((ext_vector_type(2)));

constexpr int NTHREADS = 512, NWAVES = 8;
constexpr int D = 1024, BATCH = 4, SEQ = 4096, DEPTH = 2;
constexpr int LP = 4160;
constexpr int T = BATCH * LP;
constexpr int NCH = LP / 64;
constexpr int PADM = 48;
constexpr int A_COLS = 1064, R_COLS = 1792, IN_COLS = 4904;
constexpr int UA = 1280;
constexpr int UARW = 3072;
constexpr int NIN = 5120;
constexpr float LN_EPS = 1e-5f, GN_EPS = 64e-5f;
constexpr float ALPHA = 1.41421356237309515f;
constexpr int C_Q = 0, C_K = 512, C_V = 640, C_QI = 768, C_KI = 1024, C_WI = 1056;
constexpr int C_R = UA, C_RK = UA + 512, C_RV = UA + 1024, C_XW = UA + 1536, C_XA = UA + 1600, C_XG = UA + 1664;

constexpr size_t MiB = 1u << 20;
constexpr size_t WS_CTL = 0;
constexpr size_t WS_HM = 1 * MiB;
constexpr size_t WS_WSMALL = 2 * MiB;
constexpr size_t WSMALL_LAYER = 14 * MiB;
constexpr size_t WS_HB = 30 * MiB;
constexpr size_t WS_UAR = 63 * MiB;
constexpr size_t WS_GATES = 161 * MiB;
constexpr size_t WS_OAB = 226 * MiB;
constexpr size_t WS_LIST = WS_GATES + 48 * MiB;
constexpr size_t WS_END = 308 * MiB;
constexpr size_t WS_MERGED = WS_UAR;
constexpr size_t WS_ACT = WS_UAR + 33 * MiB;
constexpr size_t WS_WEXP = WS_GATES;
constexpr int ACT_ROWS_MAX = 16448 + 24 * 256;
static_assert(WS_ACT + (size_t)ACT_ROWS_MAX * 2048 <= WS_GATES, "act fits");
constexpr int CW_CLS = 1024;

constexpr int LDS_BYTES = 155648;

struct Params {
    const float* in[29];
    float* out;
    unsigned char* ws;
};
enum { I_X = 0, I_META, I_LNIN_G, I_LNIN_B, I_WIN, I_BGATE, I_MU, I_W0, I_WUP, I_A0, I_AUP, I_GUP, I_KK, I_KA, I_RK, I_GNG, I_GNB,
       I_WBA, I_WBB, I_WOUT, I_LN1G, I_LN1B, I_LN2G, I_LN2B, I_WROUTER, I_BROUTER, I_WEXP1, I_WEXP3, I_WEXP2 };

__device__ __forceinline__ int otid() { int t = threadIdx.x; asm volatile("" : "+v"(t)); return t; }
__device__ __forceinline__ const char* uptr(const char* p) { const unsigned long long v = (unsigned long long)p; const unsigned lo = __builtin_amdgcn_readfirstlane((unsigned)v), hi = __builtin_amdgcn_readfirstlane((unsigned)(v >> 32)); return (const char*)(((unsigned long long)hi << 32) | lo); }
__device__ __forceinline__ int ozero() { int z = 0; asm volatile("" : "+s"(z)); return z; }
__device__ __forceinline__ int obid() { int b = blockIdx.x; asm volatile("" : "+s"(b)); return b; }
typedef __bf16 bf16x2_t __attribute__((ext_vector_type(2)));
__device__ __forceinline__ unsigned f2bf(float f) { return (unsigned)__builtin_bit_cast(unsigned short, (__bf16)f); }
__device__ __forceinline__ unsigned pk2(float lo, float hi) { const f32x2 v = {lo, hi}; return __builtin_bit_cast(unsigned, __builtin_convertvector(v, bf16x2_t)); }
template <int CTRL> __device__ __forceinline__ float dpp_f(float v) { return __builtin_bit_cast(float, __builtin_amdgcn_update_dpp(0, __builtin_bit_cast(int, v), CTRL, 0xF, 0xF, true)); }
__device__ __forceinline__ float sum8(float v) { v += dpp_f<0xB1>(v); v += dpp_f<0x4E>(v); v += dpp_f<0x141>(v); return v; }
__device__ __forceinline__ float sum16(float v) { v = sum8(v); v += dpp_f<0x140>(v); return v; }
__device__ __forceinline__ float bf2f(unsigned short b) { return __builtin_bit_cast(float, (unsigned)b << 16); }
__device__ __forceinline__ float bflo(unsigned w) { return __builtin_bit_cast(float, w << 16); }
__device__ __forceinline__ float bfhi(unsigned w) { return __builtin_bit_cast(float, w & 0xffff0000u); }
__device__ __forceinline__ float wave_sum(float v) { v = sum16(v); v += __shfl_xor(v, 16); v += __shfl_xor(v, 32); return v; }
__device__ __forceinline__ float wave_max(float v) {
#pragma unroll
    for (int o = 1; o < 64; o <<= 1) v = fmaxf(v, __shfl_xor(v, o));
    return v;
}
__device__ __forceinline__ float sigmoidf_(float x) { return __builtin_amdgcn_rcpf(1.0f + __expf(-x)); }
__device__ __forceinline__ float* hrow(const Params& p, int r) {
    const int b = r / LP, pos = r - b * LP;
    return pos >= 64 ? p.out + ((size_t)(b * SEQ + (pos - 64)) << 10) : (float*)(p.ws + WS_HM) + ((size_t)(b * 64 + pos) << 10);
}
__device__ __forceinline__ bool is_dummy(int r) { return (r % LP) < PADM; }

__device__ __forceinline__ void transpose_item(const float* src, int ld_src, int col0, int nvalid, bf16_t* dst  , int ld_dst, LAS float* scr, int lane) {
    const int kr = lane >> 3, c4 = (lane & 7) * 4;
    f32x4 v[8];
#pragma unroll
    for (int i = 0; i < 8; ++i) v[i] = *(const f32x4*)(src + (size_t)(8 * i + kr) * ld_src + col0 + c4);
#pragma unroll
    for (int i = 0; i < 8; ++i) { LAS float* w = scr + (8 * i + kr) * 33 + c4;
        w[0] = c4 + 0 < nvalid ? v[i][0] : 0.f; w[1] = c4 + 1 < nvalid ? v[i][1] : 0.f; w[2] = c4 + 2 < nvalid ? v[i][2] : 0.f; w[3] = c4 + 3 < nvalid ? v[i][3] : 0.f; }
    asm volatile("s_waitcnt lgkmcnt(0)" ::: "memory");
    const int ch = lane & 7;
#pragma unroll
    for (int j = 0; j < 4; ++j) { const int n = (lane >> 3) + 8 * j; const LAS float* s = scr + (8 * ch) * 33 + n;
        u32x4 o; o.x = pk2(s[0 * 33], s[1 * 33]); o.y = pk2(s[2 * 33], s[3 * 33]); o.z = pk2(s[4 * 33], s[5 * 33]); o.w = pk2(s[6 * 33], s[7 * 33]);
        *(u32x4*)(dst + (size_t)n * ld_dst + 8 * ch) = o; }
    asm volatile("s_waitcnt lgkmcnt(0)" ::: "memory");
}

namespace g8 {
constexpr int BM = 256, BK = 64, HALF = 128, HTB = HALF * BK * 2, STAGE_BYTES = 8 * HTB;
__host__ __device__ __forceinline__ int lds_byte(int r, int c) { const int st = (r >> 4) * 2 + (c >> 5), rr = r & 15, cc = c & 31, ob = rr * 64 + cc * 2; return st * 1024 + (ob ^ (((ob >> 9) & 1) << 5)); }
__host__ __device__ __forceinline__ void stage_rc(int b, int& R, int& C) { const int st = b / 1024, sb = b % 1024, swz = sb ^ (((sb >> 9) & 1) << 5); R = (st >> 1) * 16 + swz / 64; C = (st & 1) * 32 + (swz % 64) / 2; }
__host__ __device__ __forceinline__ int perm32(int rho) { const int n = rho >> 4, i = rho & 15; return 8 * (i >> 2) + 4 * n + (i & 3); }

struct KSeg {
    const char* A;
    const char* B0;
    const char* B1;
    int nt;
    int nt0;
    const char* A2;
    const char* B02;
    const char* B12;
};
__device__ __forceinline__ KSeg seg1(const char* A, const char* B0, const char* B1, int nt) { KSeg s; s.A = A; s.B0 = B0; s.B1 = B1; s.nt = nt; s.nt0 = nt; s.A2 = A; s.B02 = B0; s.B12 = B1; return s; }
typedef f32x4 Acc[2][2][4][2];

template <bool GATHER, bool TWOSEG>
__device__ __forceinline__ void kloop(LAS unsigned char* lds, Acc& acc, const KSeg s, const unsigned (&voffA)[2][2], const unsigned (&voffB)[2], const unsigned hstepA) {
    int tid = threadIdx.x; asm volatile("" : "+v"(tid));
    const int wid = __builtin_amdgcn_readfirstlane(tid >> 6), lane = tid & 63, wr = wid >> 2, wc = wid & 3, fr = lane & 15, fq = lane >> 4;
    const unsigned ldsw = (unsigned)wid * 1024u;
    const int aoff = lds_byte(wr * 64 + fr, fq * 8), boff = lds_byte(wc * 32 + fr, fq * 8);
    const int nt = __builtin_amdgcn_readfirstlane(s.nt);
#define G8_SA(b, h) (((b) * 2 + (h)) * HTB)
#define G8_SB(b, h) ((4 + (b) * 2 + (h)) * HTB)
#define G8_STAGE(bufoff, gbase, voff) do { _Pragma("unroll") for (int _i = 0; _i < 2; ++_i) \
        __builtin_amdgcn_global_load_lds((const unsigned*)((const char*)(gbase) + (voff)[_i]), (LAS unsigned*)(lds + (bufoff) + ldsw + _i * 8192), 16, 0, 0); } while (0)
#define G8_LDA(dst, b, h) do { _Pragma("unroll") for (int m = 0; m < 4; ++m) _Pragma("unroll") for (int k = 0; k < 2; ++k) dst[m][k] = *(const LAS bf16x8*)(lds + G8_SA(b, h) + aoff + m * 2048 + k * 1024); } while (0)
#define G8_LDB(dst, b, h) do { _Pragma("unroll") for (int n = 0; n < 2; ++n) _Pragma("unroll") for (int k = 0; k < 2; ++k) dst[n][k] = *(const LAS bf16x8*)(lds + G8_SB(b, h) + boff + n * 2048 + k * 1024); } while (0)
#define G8_MMA(ai, bj, At, Bt) do { __builtin_amdgcn_s_setprio(1); _Pragma("unroll") for (int m = 0; m < 4; ++m) _Pragma("unroll") for (int n = 0; n < 2; ++n) _Pragma("unroll") for (int k = 0; k < 2; ++k) \
        acc[ai][bj][m][n] = __builtin_amdgcn_mfma_f32_16x16x32_bf16(Bt[n][k], At[m][k], acc[ai][bj][m][n], 0, 0, 0); __builtin_amdgcn_s_setprio(0); } while (0)
#define G8_WAIT_V(n) asm volatile("s_waitcnt vmcnt(" #n ")" ::: "memory")
#define G8_WAIT_L(n) asm volatile("s_waitcnt lgkmcnt(" #n ")" ::: "memory")
#define G8_BAR __builtin_amdgcn_s_barrier()
#define G8_SCHED __builtin_amdgcn_sched_barrier(0)
    bf16x8 At[4][2], B0[2][2], B1[2][2];
    const char* pA = uptr(s.A); const char* pB0 = uptr(s.B0); const char* pB1 = uptr(s.B1);
    constexpr int KS = BK * 2;
    const int nt0 = TWOSEG ? s.nt0 : 0; const char* qA = TWOSEG ? uptr(s.A2 - (size_t)nt0 * KS) : pA; const char* qB0 = TWOSEG ? uptr(s.B02 - (size_t)nt0 * KS) : pB0; const char* qB1 = TWOSEG ? uptr(s.B12 - (size_t)nt0 * KS) : pB1;
#define G8_TA(t) ((TWOSEG ? ((t) < nt0 ? pA : qA) : pA) + (size_t)(t) * KS)
#define G8_TB0(t) ((TWOSEG ? ((t) < nt0 ? pB0 : qB0) : pB0) + (size_t)(t) * KS)
#define G8_TB1(t) ((TWOSEG ? ((t) < nt0 ? pB1 : qB1) : pB1) + (size_t)(t) * KS)
#define G8_VA1 voffA[GATHER ? 1 : 0]
#define G8_H1(ptr) ((ptr) + (GATHER ? 0u : hstepA))
    G8_STAGE(G8_SB(0, 0), pB0, voffB); G8_STAGE(G8_SA(0, 0), pA, voffA[0]); G8_STAGE(G8_SB(0, 1), pB1, voffB); G8_STAGE(G8_SA(0, 1), G8_H1(pA), G8_VA1);
    if (wr == 1) G8_BAR;
    G8_WAIT_V(4); G8_BAR;
    G8_STAGE(G8_SB(1, 0), pB0 + KS, voffB); G8_STAGE(G8_SA(1, 0), pA + KS, voffA[0]); G8_STAGE(G8_SB(1, 1), pB1 + KS, voffB);
    G8_WAIT_V(6); G8_BAR;
    for (int t = 0; t < nt - 2; t += 2) {
        const char* a1 = G8_TA(t + 1);
        const char* a2 = G8_TA(t + 2); const char* b02 = G8_TB0(t + 2); const char* b12 = G8_TB1(t + 2);
        const char* a3 = G8_TA(t + 3); const char* b03 = G8_TB0(t + 3); const char* b13 = G8_TB1(t + 3);
        G8_LDB(B0, 0, 0); G8_SCHED; G8_LDA(At, 0, 0); G8_STAGE(G8_SA(1, 1), G8_H1(a1), G8_VA1);
        G8_WAIT_L(8); G8_BAR; G8_WAIT_L(0); G8_MMA(0, 0, At, B0); G8_BAR; G8_SCHED;
        G8_LDB(B1, 0, 1); G8_STAGE(G8_SB(0, 0), b02, voffB);
        G8_BAR; G8_WAIT_L(0); G8_MMA(0, 1, At, B1); G8_BAR;
        G8_LDA(At, 0, 1); G8_STAGE(G8_SA(0, 0), a2, voffA[0]);
        G8_BAR; G8_WAIT_L(0); G8_MMA(1, 0, At, B0); G8_BAR; G8_SCHED;
        G8_STAGE(G8_SB(0, 1), b12, voffB);
        G8_WAIT_V(6); G8_BAR; G8_MMA(1, 1, At, B1); G8_BAR;
        G8_LDB(B0, 1, 0); G8_SCHED; G8_LDA(At, 1, 0); G8_STAGE(G8_SA(0, 1), G8_H1(a2), G8_VA1);
        G8_WAIT_L(8); G8_BAR; G8_WAIT_L(0); G8_MMA(0, 0, At, B0); G8_BAR; G8_SCHED;
        G8_LDB(B1, 1, 1); G8_STAGE(G8_SB(1, 0), b03, voffB);
        G8_BAR; G8_WAIT_L(0); G8_MMA(0, 1, At, B1); G8_BAR;
        G8_LDA(At, 1, 1); G8_STAGE(G8_SA(1, 0), a3, voffA[0]);
        G8_BAR; G8_WAIT_L(0); G8_MMA(1, 0, At, B0); G8_BAR; G8_SCHED;
        G8_STAGE(G8_SB(1, 1), b13, voffB);
        G8_WAIT_V(6); G8_BAR; G8_MMA(1, 1, At, B1); G8_BAR;
    }
    { const char* a1 = G8_TA(nt - 1);
      G8_LDB(B0, 0, 0); G8_LDA(At, 0, 0); G8_STAGE(G8_SA(1, 1), G8_H1(a1), G8_VA1);
      G8_BAR; G8_WAIT_L(0); G8_MMA(0, 0, At, B0); G8_BAR;
      G8_LDB(B1, 0, 1); G8_BAR; G8_WAIT_L(0); G8_MMA(0, 1, At, B1); G8_BAR;
      G8_LDA(At, 0, 1); G8_WAIT_V(4); G8_BAR; G8_WAIT_L(0); G8_MMA(1, 0, At, B0); G8_MMA(1, 1, At, B1); G8_BAR; }
    { G8_LDB(B0, 1, 0); G8_LDA(At, 1, 0); G8_WAIT_V(2); G8_BAR; G8_WAIT_L(0); G8_MMA(0, 0, At, B0); G8_BAR;
      G8_LDB(B1, 1, 1); G8_WAIT_V(0); G8_BAR; G8_WAIT_L(0); G8_MMA(0, 1, At, B1); G8_BAR;
      G8_LDA(At, 1, 1); G8_BAR; G8_WAIT_L(0); G8_MMA(1, 0, At, B0); G8_MMA(1, 1, At, B1); G8_BAR; }
    if (wr == 0) G8_BAR;
#undef G8_TA
#undef G8_VA1
#undef G8_H1
#undef G8_TB0
#undef G8_TB1
#undef G8_SA
#undef G8_SB
#undef G8_STAGE
#undef G8_LDA
#undef G8_LDB
#undef G8_MMA
#undef G8_WAIT_V
#undef G8_WAIT_L
#undef G8_BAR
#undef G8_SCHED
}
template <bool GATHER, bool TWOSEG>
__device__ __forceinline__ void kstream(LAS unsigned char* lds, Acc& acc, const KSeg s, const KSeg nx, const bool first, const unsigned (&voffA)[2][2], const unsigned (&voffB)[2], const unsigned hstepA) {
    int tid = threadIdx.x; asm volatile("" : "+v"(tid));
    const int wid = __builtin_amdgcn_readfirstlane(tid >> 6), lane = tid & 63, wr = wid >> 2, wc = wid & 3, fr = lane & 15, fq = lane >> 4;
    const unsigned ldsw = (unsigned)wid * 1024u;
    const int aoff = lds_byte(wr * 64 + fr, fq * 8), boff = lds_byte(wc * 32 + fr, fq * 8);
    const int nt = __builtin_amdgcn_readfirstlane(s.nt);
#define G8_SA(b, h) (((b) * 2 + (h)) * HTB)
#define G8_SB(b, h) ((4 + (b) * 2 + (h)) * HTB)
#define G8_STAGE(bufoff, gbase, voff) do { _Pragma("unroll") for (int _i = 0; _i < 2; ++_i) \
        __builtin_amdgcn_global_load_lds((const unsigned*)((const char*)(gbase) + (voff)[_i]), (LAS unsigned*)(lds + (bufoff) + ldsw + _i * 8192), 16, 0, 0); } while (0)
#define G8_LDA(dst, b, h) do { _Pragma("unroll") for (int m = 0; m < 4; ++m) _Pragma("unroll") for (int k = 0; k < 2; ++k) dst[m][k] = *(const LAS bf16x8*)(lds + G8_SA(b, h) + aoff + m * 2048 + k * 1024); } while (0)
#define G8_LDB(dst, b, h) do { _Pragma("unroll") for (int n = 0; n < 2; ++n) _Pragma("unroll") for (int k = 0; k < 2; ++k) dst[n][k] = *(const LAS bf16x8*)(lds + G8_SB(b, h) + boff + n * 2048 + k * 1024); } while (0)
#define G8_MMA(ai, bj, At, Bt) do { __builtin_amdgcn_s_setprio(1); _Pragma("unroll") for (int m = 0; m < 4; ++m) _Pragma("unroll") for (int n = 0; n < 2; ++n) _Pragma("unroll") for (int k = 0; k < 2; ++k) \
        acc[ai][bj][m][n] = __builtin_amdgcn_mfma_f32_16x16x32_bf16(Bt[n][k], At[m][k], acc[ai][bj][m][n], 0, 0, 0); __builtin_amdgcn_s_setprio(0); } while (0)
#define G8_WAIT_V(n) asm volatile("s_waitcnt vmcnt(" #n ")" ::: "memory")
#define G8_WAIT_L(n) asm volatile("s_waitcnt lgkmcnt(" #n ")" ::: "memory")
#define G8_BAR __builtin_amdgcn_s_barrier()
#define G8_SCHED __builtin_amdgcn_sched_barrier(0)
    bf16x8 At[4][2], B0[2][2], B1[2][2];
    const char* pA = uptr(s.A); const char* pB0 = uptr(s.B0); const char* pB1 = uptr(s.B1);
    constexpr int KS = BK * 2;
    const int nt0 = TWOSEG ? s.nt0 : 0; const char* qA = TWOSEG ? uptr(s.A2 - (size_t)nt0 * KS) : pA; const char* qB0 = TWOSEG ? uptr(s.B02 - (size_t)nt0 * KS) : pB0; const char* qB1 = TWOSEG ? uptr(s.B12 - (size_t)nt0 * KS) : pB1;
    const char* nA = uptr(nx.A) - (size_t)nt * KS; const char* nB0 = uptr(nx.B0) - (size_t)nt * KS; const char* nB1 = uptr(nx.B1) - (size_t)nt * KS;
#define G8_TA(t) (((t) >= nt ? nA : (TWOSEG ? ((t) < nt0 ? pA : qA) : pA)) + (size_t)(t) * KS)
#define G8_TB0(t) (((t) >= nt ? nB0 : (TWOSEG ? ((t) < nt0 ? pB0 : qB0) : pB0)) + (size_t)(t) * KS)
#define G8_TB1(t) (((t) >= nt ? nB1 : (TWOSEG ? ((t) < nt0 ? pB1 : qB1) : pB1)) + (size_t)(t) * KS)
#define G8_VA1 voffA[GATHER ? 1 : 0]
#define G8_H1(ptr) ((ptr) + (GATHER ? 0u : hstepA))
    if (first) {
    G8_STAGE(G8_SB(0, 0), pB0, voffB); G8_STAGE(G8_SA(0, 0), pA, voffA[0]); G8_STAGE(G8_SB(0, 1), pB1, voffB); G8_STAGE(G8_SA(0, 1), G8_H1(pA), G8_VA1);
    if (wr == 1) G8_BAR;
    G8_WAIT_V(4); G8_BAR;
    G8_STAGE(G8_SB(1, 0), pB0 + KS, voffB); G8_STAGE(G8_SA(1, 0), pA + KS, voffA[0]); G8_STAGE(G8_SB(1, 1), pB1 + KS, voffB);
    G8_WAIT_V(6); G8_BAR;
    }
    for (int t = 0; t < nt; t += 2) {
        const char* a1 = G8_TA(t + 1);
        const char* a2 = G8_TA(t + 2); const char* b02 = G8_TB0(t + 2); const char* b12 = G8_TB1(t + 2);
        const char* a3 = G8_TA(t + 3); const char* b03 = G8_TB0(t + 3); const char* b13 = G8_TB1(t + 3);
        G8_LDB(B0, 0, 0); G8_SCHED; G8_LDA(At, 0, 0); G8_STAGE(G8_SA(1, 1), G8_H1(a1), G8_VA1);
        G8_WAIT_L(8); G8_BAR; G8_WAIT_L(0); G8_MMA(0, 0, At, B0); G8_BAR; G8_SCHED;
        G8_LDB(B1, 0, 1); G8_STAGE(G8_SB(0, 0), b02, voffB);
        G8_BAR; G8_WAIT_L(0); G8_MMA(0, 1, At, B1); G8_BAR;
        G8_LDA(At, 0, 1); G8_STAGE(G8_SA(0, 0), a2, voffA[0]);
        G8_BAR; G8_WAIT_L(0); G8_MMA(1, 0, At, B0); G8_BAR; G8_SCHED;
        G8_STAGE(G8_SB(0, 1), b12, voffB);
        G8_WAIT_V(6); G8_BAR; G8_MMA(1, 1, At, B1); G8_BAR;
        G8_LDB(B0, 1, 0); G8_SCHED; G8_LDA(At, 1, 0); G8_STAGE(G8_SA(0, 1), G8_H1(a2), G8_VA1);
        G8_WAIT_L(8); G8_BAR; G8_WAIT_L(0); G8_MMA(0, 0, At, B0); G8_BAR; G8_SCHED;
        G8_LDB(B1, 1, 1); G8_STAGE(G8_SB(1, 0), b03, voffB);
        G8_BAR; G8_WAIT_L(0); G8_MMA(0, 1, At, B1); G8_BAR;
        G8_LDA(At, 1, 1); G8_STAGE(G8_SA(1, 0), a3, voffA[0]);
        G8_BAR; G8_WAIT_L(0); G8_MMA(1, 0, At, B0); G8_BAR; G8_SCHED;
        G8_STAGE(G8_SB(1, 1), b13, voffB);
        G8_WAIT_V(6); G8_BAR; G8_MMA(1, 1, At, B1); G8_BAR;
    }
#undef G8_TA
#undef G8_VA1
#undef G8_H1
#undef G8_TB0
#undef G8_TB1
#undef G8_SA
#undef G8_SB
#undef G8_STAGE
#undef G8_LDA
#undef G8_LDB
#undef G8_MMA
#undef G8_WAIT_V
#undef G8_WAIT_L
#undef G8_BAR
#undef G8_SCHED
}
__device__ __forceinline__ void kstream_end() { asm volatile("s_waitcnt vmcnt(0)" ::: "memory"); __builtin_amdgcn_s_barrier(); }
__device__ __forceinline__ void zero_acc(Acc& acc) {
#pragma unroll
    for (int a = 0; a < 2; ++a)
#pragma unroll
        for (int b = 0; b < 2; ++b)
#pragma unroll
            for (int m = 0; m < 4; ++m)
#pragma unroll
                for (int n = 0; n < 2; ++n) acc[a][b][m][n] = (f32x4){0.f, 0.f, 0.f, 0.f};
}
__device__ __forceinline__ void make_voff_contig(unsigned (&voffA)[2][2], unsigned pitchA) {
    int tid = threadIdx.x; asm volatile("" : "+v"(tid));
#pragma unroll
    for (int i = 0; i < 2; ++i) { int R, C; stage_rc(tid * 16 + i * 8192, R, C);
        voffA[0][i] = (unsigned)R * pitchA + (unsigned)C * 2u; voffA[1][i] = 0u; }
}
__device__ __forceinline__ void make_voffB(unsigned (&voffB)[2], unsigned pitchB, bool perm) {
    int tid = threadIdx.x; asm volatile("" : "+v"(tid));
#pragma unroll
    for (int i = 0; i < 2; ++i) { int R, C; stage_rc(tid * 16 + i * 8192, R, C); const int Rb = perm ? ((R & ~31) + perm32(R & 31)) : R;
        voffB[i] = (unsigned)Rb * pitchB + (unsigned)C * 2u; }
}
}

__device__ __forceinline__ bool unit_order(int i, int G, int c, int nM, int nN, int& pm, int& pn) {
    const int nwg = nM * nN; const long L = (long)i * G + c; if (L >= nwg) return false;
    int wgid = (int)L; { const int q = nwg / 8, r = nwg % 8, xcd = wgid % 8, off = wgid / 8; wgid = (xcd < r ? xcd * (q + 1) : r * (q + 1) + (xcd - r) * q) + off; }
    const int WGM = 8, nig = WGM * nN, gid = wgid / nig, fm = gid * WGM, gsz = (nM - fm) < WGM ? (nM - fm) : WGM;
    pm = fm + ((wgid % nig) % gsz); pn = (wgid % nig) / gsz; return true;
}

__device__ __forceinline__ void conv_small_weights(const Params& p, LAS unsigned char* lds) {
    const int tid = otid(), lane = tid & 63, wave = tid >> 6, gw = obid() * NWAVES + wave, NGW = gridDim.x * NWAVES;
    LAS float* scr = (LAS float*)(lds + wave * 16384);
    constexpr int I_IN = 16 * (NIN / 32), I_A = 8 * 32, I_O = 16 * 32, I_L = 64, PER = I_IN + 2 * I_A + I_O + I_L;
    for (int it = gw; it < DEPTH * PER; it += NGW) {
        const int l = it / PER; int r = it % PER;
        unsigned char* wl = p.ws + WS_WSMALL + (size_t)l * WSMALL_LAYER;
        if (r < I_IN) { const int kb = r / (NIN / 32), nb = r % (NIN / 32), n0 = nb * 32, k0 = kb * 64;
            int col0, nvalid; if (n0 < UA) { col0 = n0; nvalid = A_COLS - n0; nvalid = nvalid < 0 ? 0 : (nvalid > 32 ? 32 : nvalid); } else { col0 = n0 - (UA - A_COLS); nvalid = 32; }
            transpose_item(p.in[I_WIN] + (size_t)l * D * IN_COLS + (size_t)k0 * IN_COLS, IN_COLS, col0, nvalid, (bf16_t*)wl + (size_t)n0 * D + k0, D, scr, lane); continue; }
        r -= I_IN;
        if (r < 2 * I_A) { const int which = r / I_A; r %= I_A; const int kb = r / 32, nb = r % 32;
            const float* src = p.in[which ? I_WBB : I_WBA] + (size_t)l * 512 * D + (size_t)(kb * 64) * D;
            transpose_item(src, D, nb * 32, 32, (bf16_t*)(wl + (10 + which) * MiB) + (size_t)(nb * 32) * 512 + kb * 64, 512, scr, lane); continue; }
        r -= 2 * I_A;
        if (r < I_O) { const int kb = r / 32, nb = r % 32;
          transpose_item(p.in[I_WOUT] + (size_t)l * D * D + (size_t)(kb * 64) * D, D, nb * 32, 32, (bf16_t*)(wl + 12 * MiB) + (size_t)(nb * 32) * D + kb * 64, D, scr, lane); continue; }
        r -= I_O;
        { bf16_t* lo = (bf16_t*)(p.ws + 65536 + (size_t)l * 262144);
          if (r < 16) transpose_item(p.in[I_WUP] + (size_t)l * 64 * 512, 512, r * 32, 32, lo + (size_t)(r * 32) * 64, 64, scr, lane);
          else if (r < 32) transpose_item(p.in[I_AUP] + (size_t)l * 64 * 512, 512, (r - 16) * 32, 32, lo + 32768 + (size_t)((r - 16) * 32) * 64, 64, scr, lane);
          else { const int q = r - 32, kb = q >> 4, nb = q & 15; transpose_item(p.in[I_GUP] + (size_t)l * 128 * 512 + (size_t)(kb * 64) * 512, 512, nb * 32, 32, lo + 65536 + (size_t)(nb * 32) * 128 + kb * 64, 128, scr, lane); } }
    }
}
__device__ __forceinline__ void conv_expert_items(const Params& p, int l, LAS unsigned char* lds, int it0, int it1) {
    const int tid = otid(), lane = tid & 63, wave = tid >> 6, gw = it0 + wave, NGW = NWAVES;
    LAS float* scr = (LAS float*)(lds + wave * 16384);
    constexpr int I_13 = 16 * 32, I_2 = 8 * 32, PER = I_13 + I_2;
    for (int it = gw; it < it1; it += NGW) {
        const int e = it / PER; int r = it % PER;
        if (r < I_13) { const int kb = r / 32, nb = r % 32, n0 = nb * 32, j = n0 >> 8, half = (n0 >> 7) & 1, c = 128 * j + (n0 & 127);
            const float* src = p.in[half ? I_WEXP3 : I_WEXP1] + (size_t)(l * 16 + e) * D * 512 + (size_t)(kb * 64) * 512;
            transpose_item(src, 512, c, 32, (bf16_t*)(p.ws + WS_WEXP) + (size_t)e * 1024 * 1024 + (size_t)n0 * 1024 + kb * 64, 1024, scr, lane); continue; }
        r -= I_13;
        { const int kb = r / 32, nb = r % 32;
          const float* src = p.in[I_WEXP2] + (size_t)(l * 16 + e) * 512 * D + (size_t)(kb * 64) * D;
          transpose_item(src, D, nb * 32, 32, (bf16_t*)(p.ws + WS_WEXP + 32 * MiB) + (size_t)e * 1024 * 512 + (size_t)(nb * 32) * 512 + kb * 64, 512, scr, lane); }
    }
}

__device__ __forceinline__ void ln_wave(f32x4 (&v)[4], const float* g, const float* bta, int lane) {
    float s = 0.f;
#pragma unroll
    for (int j = 0; j < 4; ++j) s += (v[j][0] + v[j][1]) + (v[j][2] + v[j][3]);
    const float mean = wave_sum(s) * (1.f / D); float s2 = 0.f;
#pragma unroll
    for (int j = 0; j < 4; ++j) { v[j] = v[j] - mean; s2 += (v[j][0] * v[j][0] + v[j][1] * v[j][1]) + (v[j][2] * v[j][2] + v[j][3] * v[j][3]); }
    const float rstd = __builtin_amdgcn_rsqf(wave_sum(s2) * (1.f / D) + LN_EPS);
#pragma unroll
    for (int j = 0; j < 4; ++j) { const f32x4 gg = *(const f32x4*)(g + 4 * lane + 256 * j), bb = *(const f32x4*)(bta + 4 * lane + 256 * j); v[j] = v[j] * rstd * gg + bb; }
}
__device__ __forceinline__ void store_row(const Params& p, int r, const f32x4 (&v)[4], int lane, bool zero) {
    float* hr = hrow(p, r); bf16_t* hb = (bf16_t*)(p.ws + WS_HB) + (size_t)r * D;
#pragma unroll
    for (int j = 0; j < 4; ++j) { const f32x4 o = zero ? (f32x4){0.f, 0.f, 0.f, 0.f} : v[j];
        *(f32x4*)(hr + 4 * lane + 256 * j) = o; u32x2 w; w.x = pk2(o[0], o[1]); w.y = pk2(o[2], o[3]); *(u32x2*)(hb + 4 * lane + 256 * j) = w; }
}
__device__ __forceinline__ void ln_in_phase(const Params& p) {
    const int tid = otid(), lane = tid & 63, gw = obid() * NWAVES + (tid >> 6), NGW = gridDim.x * NWAVES;
    for (int r = gw; r < T; r += NGW) {
        const int b = r / LP, pos = r - b * LP; f32x4 v[4];
        if (pos < PADM) {
#pragma unroll
            for (int j = 0; j < 4; ++j) v[j] = (f32x4){0.f, 0.f, 0.f, 0.f};
            store_row(p, r, v, lane, true); continue; }
        const float* src = pos < 64 ? p.in[I_META] + (size_t)(pos - PADM) * D : p.in[I_X] + ((size_t)(b * SEQ + pos - 64) << 10);
#pragma unroll
        for (int j = 0; j < 4; ++j) v[j] = *(const f32x4*)(src + 4 * lane + 256 * j);
        ln_wave(v, p.in[I_LNIN_G], p.in[I_LNIN_B], lane);
        store_row(p, r, v, lane, false);
    }
}

__device__ __forceinline__ const Params& PP() { const Params* q = (const Params*)__builtin_amdgcn_kernarg_segment_ptr(); asm volatile("" : "+s"(q)); return *q; }

#define EPI_COORDS() int tid_ = threadIdx.x; asm volatile("" : "+v"(tid_)); const int wid = tid_ >> 6, lane = tid_ & 63, wr = wid >> 2, wc = wid & 3, fr = lane & 15, fq = lane >> 4; (void)wr; (void)wc; (void)fr; (void)fq
__device__ __forceinline__ void inproj_epi(const g8::Acc& acc, int l, int pm, int pn) {
    EPI_COORDS();
    const int row0 = pm * 256 + wr * 64 + fr;
    if (pn < 12) {
        bf16_t* O = (bf16_t*)(PP().ws + WS_UAR);
#pragma unroll
        for (int ai = 0; ai < 2; ++ai)
#pragma unroll
            for (int m = 0; m < 4; ++m) { asm volatile("" ::: "memory"); bf16_t* rp = O + (size_t)(row0 + ai * 128 + m * 16) * UARW + pn * 256 + wc * 32 + 8 * fq;
#pragma unroll
                for (int bj = 0; bj < 2; ++bj) { const f32x4 v0 = acc[ai][bj][m][0], v1 = acc[ai][bj][m][1]; u32x4 w; w.x = pk2(v0[0], v0[1]); w.y = pk2(v0[2], v0[3]); w.z = pk2(v1[0], v1[1]); w.w = pk2(v1[2], v1[3]);
                    *(u32x4*)(rp + bj * 128) = w; } }
    } else {
        bf16_t* O = (bf16_t*)(PP().ws + WS_GATES); const int colb = (pn - 12) * 256 + wc * 32 + 8 * fq; const float* bg = PP().in[I_BGATE] + l * 2048;
        f32x4 bv[2][2];
#pragma unroll
        for (int bj = 0; bj < 2; ++bj) { bv[bj][0] = *(const f32x4*)(bg + colb + bj * 128); bv[bj][1] = *(const f32x4*)(bg + colb + bj * 128 + 4); }
#pragma unroll
        for (int ai = 0; ai < 2; ++ai)
#pragma unroll
            for (int m = 0; m < 4; ++m) { asm volatile("" ::: "memory"); bf16_t* rp = O + (size_t)(row0 + ai * 128 + m * 16) * 2048 + colb;
#pragma unroll
                for (int bj = 0; bj < 2; ++bj) { f32x4 v0 = acc[ai][bj][m][0] + bv[bj][0], v1 = acc[ai][bj][m][1] + bv[bj][1];
#pragma unroll
                    for (int e = 0; e < 4; ++e) { v0[e] = sigmoidf_(v0[e]); v1[e] = sigmoidf_(v1[e]); }
                    u32x4 w; w.x = pk2(v0[0], v0[1]); w.y = pk2(v0[2], v0[3]); w.z = pk2(v1[0], v1[1]); w.w = pk2(v1[2], v1[3]);
                    *(u32x4*)(rp + bj * 128) = w; } }
    }
}
constexpr int INP_MAIN = 62 * 20 + 3 * 12, INP_TAIL = 24;
__device__ __forceinline__ bool inproj_order(int i, int G, int c, int& pm, int& pn) {
    const long L = (long)i * G + c; if (L >= INP_MAIN) return false;
    if (L < 62 * 20) return unit_order(i, G, c, 62, 20, pm, pn);
    const int r = (int)L - 62 * 20; pm = 62 + r / 12; pn = r % 12; return true;
}
__device__ __forceinline__ void inproj_phase(const Params& p, int l, LAS unsigned char* lds) {
    unsigned voffA[2][2], voffB[2]; g8::make_voff_contig(voffA, D * 2); g8::make_voffB(voffB, D * 2, true);
    int pm, pn, pm2 = 0, pn2 = 0; const int bid = obid(); const int wr_ = __builtin_amdgcn_readfirstlane(otid() >> 6) >> 2;
    bool has = inproj_order(0, gridDim.x, bid, pm, pn), first = true;
    g8::Acc acc; g8::zero_acc(acc);
    for (int i = 0; has; ++i) {
        const bool hasn = inproj_order(i + 1, gridDim.x, bid, pm2, pn2);
        const char* Ab = (const char*)(PP().ws + WS_HB); const char* Bb = (const char*)(PP().ws + WS_WSMALL + (size_t)l * WSMALL_LAYER);
        const g8::KSeg s = g8::seg1(Ab + (size_t)pm * 256 * D * 2, Bb + (size_t)pn * 256 * D * 2, Bb + (size_t)(pn * 256 + 128) * D * 2, D / 64);
        const int pmn = hasn ? pm2 : pm, pnn = hasn ? pn2 : pn;
        const g8::KSeg nx = g8::seg1(Ab + (size_t)pmn * 256 * D * 2, Bb + (size_t)pnn * 256 * D * 2, Bb + (size_t)(pnn * 256 + 128) * D * 2, D / 64);
        if (!first && wr_ == 1) __builtin_amdgcn_s_barrier();
        g8::kstream<false, false>(lds, acc, s, nx, first, voffA, voffB, 128 * D * 2); first = false;
        if (wr_ == 0) __builtin_amdgcn_s_barrier();
        inproj_epi(acc, l, pm, pn);
        g8::zero_acc(acc); has = hasn; pm = pm2; pn = pn2;
    }
    if (!first) g8::kstream_end();
}
__device__ __forceinline__ void inproj_tail_unit(int l, LAS unsigned char* lds, int g) {
    unsigned voffA[2][2], voffB[2]; g8::make_voff_contig(voffA, D * 2); g8::make_voffB(voffB, D * 2, true);
    const int pm = 62 + (g >> 3), pn = 12 + (g & 7);
    g8::Acc acc; g8::zero_acc(acc);
    const char* Ab = (const char*)(PP().ws + WS_HB); const char* Bb = (const char*)(PP().ws + WS_WSMALL + (size_t)l * WSMALL_LAYER);
    const g8::KSeg s = g8::seg1(Ab + (size_t)pm * 256 * D * 2, Bb + (size_t)pn * 256 * D * 2, Bb + (size_t)(pn * 256 + 128) * D * 2, D / 64);
    g8::kloop<false, false>(lds, acc, s, voffA, voffB, 128 * D * 2);
    inproj_epi(acc, l, pm, pn);
}
__device__ __forceinline__ void merge_unit(int l, LAS unsigned char* lds, int pm, int pn) {
    unsigned voffA[2][2], voffB[2]; g8::make_voff_contig(voffA, D * 2); g8::make_voffB(voffB, 512 * 2, true);
    {
        const int wr_ = __builtin_amdgcn_readfirstlane(otid() >> 6) >> 2;
        g8::Acc acc; g8::zero_acc(acc);
#pragma unroll 1
        for (int br = 0; br < 2; ++br) {
            const char* Bt = (const char*)(PP().ws + WS_WSMALL + (size_t)l * WSMALL_LAYER) + (10 + br) * MiB + (size_t)pn * 256 * 512 * 2;
            const char* Bn = (const char*)(PP().ws + WS_WSMALL + (size_t)l * WSMALL_LAYER) + 11 * MiB + (size_t)pn * 256 * 512 * 2;
            const g8::KSeg s = g8::seg1((const char*)(PP().ws + WS_OAB) + (size_t)pm * 256 * D * 2 + br * 1024, Bt, Bt + (size_t)128 * 512 * 2, 8);
            const g8::KSeg nx = g8::seg1((const char*)(PP().ws + WS_OAB) + (size_t)pm * 256 * D * 2 + 1024, Bn, Bn + (size_t)128 * 512 * 2, 8);
            if (br && wr_ == 1) __builtin_amdgcn_s_barrier();
            g8::kstream<false, false>(lds, acc, s, nx, br == 0, voffA, voffB, 128 * D * 2);
            if (wr_ == 0) __builtin_amdgcn_s_barrier();
            EPI_COORDS();
            const bf16_t* GT = (const bf16_t*)(PP().ws + WS_GATES); bf16_t* O = (bf16_t*)(PP().ws + WS_MERGED);
            const int row0 = pm * 256 + wr * 64 + fr, colb = pn * 256 + wc * 32 + 8 * fq;
#pragma unroll
            for (int ai = 0; ai < 2; ++ai) { asm volatile("" ::: "memory");
                u32x4 gq[4][2], pq[4][2];
#pragma unroll
                for (int m = 0; m < 4; ++m) { const size_t ro = (size_t)(row0 + ai * 128 + m * 16); const bf16_t* gp = GT + ro * 2048 + br * 1024 + colb; const bf16_t* op = O + ro * D + colb;
#pragma unroll
                    for (int bj = 0; bj < 2; ++bj) { gq[m][bj] = *(const u32x4*)(gp + bj * 128); pq[m][bj] = br ? *(const u32x4*)(op + bj * 128) : (u32x4){0u, 0u, 0u, 0u}; } }
#pragma unroll
                for (int m = 0; m < 4; ++m) { const size_t ro = (size_t)(row0 + ai * 128 + m * 16); bf16_t* op = O + ro * D + colb;
#pragma unroll
                    for (int bj = 0; bj < 2; ++bj) { const u32x4 g = gq[m][bj], pr = pq[m][bj]; const f32x4 v0 = acc[ai][bj][m][0], v1 = acc[ai][bj][m][1];
                        u32x4 w; w.x = pk2(v0[0] * bflo(g.x) + bflo(pr.x), v0[1] * bfhi(g.x) + bfhi(pr.x)); w.y = pk2(v0[2] * bflo(g.y) + bflo(pr.y), v0[3] * bfhi(g.y) + bfhi(pr.y));
                        w.z = pk2(v1[0] * bflo(g.z) + bflo(pr.z), v1[1] * bfhi(g.z) + bfhi(pr.z)); w.w = pk2(v1[2] * bflo(g.w) + bflo(pr.w), v1[3] * bfhi(g.w) + bfhi(pr.w));
                        *(u32x4*)(op + bj * 128) = w; } } }
            g8::zero_acc(acc);
        }
        g8::kstream_end();
    }
}
__device__ __forceinline__ void wout_unit(int l, LAS unsigned char* lds, int pm, int pn) {
    unsigned voffA[2][2], voffB[2]; g8::make_voff_contig(voffA, D * 2); g8::make_voffB(voffB, D * 2, false);
    g8::Acc acc; g8::zero_acc(acc);
    const char* Ab = (const char*)(PP().ws + WS_MERGED); const char* Bb = (const char*)(PP().ws + WS_WSMALL + (size_t)l * WSMALL_LAYER + 12 * MiB);
    const g8::KSeg s = g8::seg1(Ab + (size_t)pm * 256 * D * 2, Bb + (size_t)pn * 256 * D * 2, Bb + (size_t)(pn * 256 + 128) * D * 2, D / 64);
    g8::kloop<false, false>(lds, acc, s, voffA, voffB, 128 * D * 2);
    EPI_COORDS();
    const int row0 = pm * 256 + wr * 64 + fr, col0 = pn * 256 + wc * 32 + 4 * fq;
#pragma unroll
    for (int ai = 0; ai < 2; ++ai) { asm volatile("" ::: "memory");
        f32x4 pre[4][2][2]; float* hr[4];
#pragma unroll
        for (int m = 0; m < 4; ++m) { hr[m] = hrow(PP(), row0 + ai * 128 + m * 16) + col0;
#pragma unroll
            for (int bj = 0; bj < 2; ++bj)
#pragma unroll
                for (int n = 0; n < 2; ++n) pre[m][bj][n] = *(const f32x4*)(hr[m] + bj * 128 + n * 16); }
#pragma unroll
        for (int m = 0; m < 4; ++m)
#pragma unroll
            for (int bj = 0; bj < 2; ++bj)
#pragma unroll
                for (int n = 0; n < 2; ++n) *(f32x4*)(hr[m] + bj * 128 + n * 16) = pre[m][bj][n] * ALPHA + acc[ai][bj][m][n]; }
}
__device__ __forceinline__ unsigned score_key(float s) { s += 0.0f; const unsigned u = __builtin_bit_cast(unsigned, s); return (u & 0x80000000u) ? ~u : (u | 0x80000000u); }
__device__ void attn_naive_query(const Params& p, int row, unsigned char* wl, int lane) {
    const bf16_t* U = (const bf16_t*)(p.ws + WS_UAR);
    bf16_t* OA = (bf16_t*)(p.ws + WS_OAB) + (size_t)row * D;
    const int b = row / LP, pos = row - b * LP;
    if (pos < PADM) {
#pragma unroll
        for (int j = 0; j < 8; ++j) OA[j * 64 + lane] = 0;
        return;
    }
    const int nadm = 64 * ((pos >> 6) + 1) - PADM;
    unsigned* keys = (unsigned*)wl; float* p_s = (float*)wl;
    float* qi_s = (float*)(wl + 16640); float* q_s = qi_s + 256; float* w_s = q_s + 512; unsigned short* sel_s = (unsigned short*)(w_s + 16);
    const bf16_t* urow = U + (size_t)row * UARW;
    for (int i = lane; i < 256; i += 64) qi_s[i] = bf2f(urow[C_QI + i]);
    for (int i = lane; i < 512; i += 64) q_s[i] = bf2f(urow[C_Q + i]);
    if (lane < 8) w_s[lane] = bf2f(urow[C_WI + lane]);
    __builtin_amdgcn_fence(__ATOMIC_RELEASE, "wavefront"); __builtin_amdgcn_wave_barrier(); __builtin_amdgcn_fence(__ATOMIC_ACQUIRE, "wavefront");
    const int nj = (nadm + 63) >> 6;
    for (int j = 0; j < nj; ++j) {
        const int ki_idx = lane + 64 * j; unsigned key = 0u;
        if (ki_idx < nadm) {
            const u32x4* kp = (const u32x4*)(U + (size_t)(b * LP + PADM + ki_idx) * UARW + C_KI);
            float kf[32];
#pragma unroll
            for (int c4 = 0; c4 < 4; ++c4) { const u32x4 w = kp[c4];
                kf[c4 * 8 + 0] = bflo(w.x); kf[c4 * 8 + 1] = bfhi(w.x); kf[c4 * 8 + 2] = bflo(w.y); kf[c4 * 8 + 3] = bfhi(w.y);
                kf[c4 * 8 + 4] = bflo(w.z); kf[c4 * 8 + 5] = bfhi(w.z); kf[c4 * 8 + 6] = bflo(w.w); kf[c4 * 8 + 7] = bfhi(w.w); }
            float sc = 0.f;
#pragma unroll 1
            for (int h = 0; h < 8; ++h) { float d = 0.f; asm volatile("" ::: "memory");
#pragma unroll
                for (int e = 0; e < 32; ++e) d = fmaf(qi_s[h * 32 + e], kf[e], d);
                sc = fmaf(w_s[h], fmaxf(d, 0.f), sc); }
            key = score_key(sc); if (key == 0u) key = 1u;
        }
        keys[ki_idx] = key;
    }
    __builtin_amdgcn_fence(__ATOMIC_RELEASE, "wavefront"); __builtin_amdgcn_wave_barrier(); __builtin_amdgcn_fence(__ATOMIC_ACQUIRE, "wavefront");
    unsigned thr = 0u; int need_ties = 0x7fffffff;
    if (nadm > 256) {
        unsigned prefix = 0u; int remaining = 256;
        for (int bit = 31; bit >= 0; --bit) {
            const unsigned cand = prefix | (1u << bit); int cnt = 0;
            for (int j = 0; j < nj; ++j) { const unsigned k = keys[lane + 64 * j]; cnt += __builtin_popcountll(__ballot((k >> bit) == (cand >> bit))); }
            if (cnt >= remaining) prefix = cand; else remaining -= cnt;
        }
        thr = prefix; need_ties = remaining;
    } else thr = 1u;
    int nsel = 0, ties_seen = 0;
    for (int j = 0; j < nj; ++j) {
        const unsigned k = keys[lane + 64 * j];
        const unsigned long long tm = __ballot(k == thr && k != 0u);
        const unsigned long long lt = (1ull << lane) - 1ull;
        const int myrank = ties_seen + __builtin_popcountll(tm & lt);
        const bool selme = (k > thr) || (k == thr && k != 0u && myrank < need_ties);
        const unsigned long long sm = __ballot(selme);
        if (selme) sel_s[nsel + __builtin_popcountll(sm & lt)] = (unsigned short)(PADM + lane + 64 * j);
        nsel += __builtin_popcountll(sm); ties_seen += __builtin_popcountll(tm);
    }
    __builtin_amdgcn_fence(__ATOMIC_RELEASE, "wavefront"); __builtin_amdgcn_wave_barrier(); __builtin_amdgcn_fence(__ATOMIC_ACQUIRE, "wavefront");
    float sc[4][8];
#pragma unroll
    for (int m = 0; m < 4; ++m) {
        asm volatile("" ::: "memory");
        const int i = lane + 64 * m; const bool valid = i < nsel; const int ps = valid ? sel_s[i] : PADM;
        const bf16_t* krow = U + (size_t)(b * LP + ps) * UARW + C_K;
#pragma unroll
        for (int n = 0; n < 2; ++n) {
            float a0 = 0.f, a1 = 0.f, a2 = 0.f, a3 = 0.f;
#pragma unroll 1
            for (int c8 = 0; c8 < 8; ++c8) { asm volatile("" ::: "memory"); const u32x4 w = *(const u32x4*)(krow + n * 64 + c8 * 8);
                float kf[8] = {bflo(w.x), bfhi(w.x), bflo(w.y), bfhi(w.y), bflo(w.z), bfhi(w.z), bflo(w.w), bfhi(w.w)};
#pragma unroll
                for (int e = 0; e < 8; ++e) { const int dd = c8 * 8 + e;
                    a0 = fmaf(q_s[(n * 4 + 0) * 64 + dd], kf[e], a0); a1 = fmaf(q_s[(n * 4 + 1) * 64 + dd], kf[e], a1);
                    a2 = fmaf(q_s[(n * 4 + 2) * 64 + dd], kf[e], a2); a3 = fmaf(q_s[(n * 4 + 3) * 64 + dd], kf[e], a3); } }
            sc[m][n * 4 + 0] = valid ? a0 * 0.125f : -INFINITY; sc[m][n * 4 + 1] = valid ? a1 * 0.125f : -INFINITY;
            sc[m][n * 4 + 2] = valid ? a2 * 0.125f : -INFINITY; sc[m][n * 4 + 3] = valid ? a3 * 0.125f : -INFINITY;
        }
    }
    __builtin_amdgcn_wave_barrier();
    float linv[8];
#pragma unroll
    for (int h = 0; h < 8; ++h) {
        const float mx = wave_max(fmaxf(fmaxf(sc[0][h], sc[1][h]), fmaxf(sc[2][h], sc[3][h]))); float s = 0.f;
#pragma unroll
        for (int m = 0; m < 4; ++m) { const float e = __expf(sc[m][h] - mx); sc[m][h] = e; s += e; }
        linv[h] = 1.0f / wave_sum(s);
    }
#pragma unroll
    for (int m = 0; m < 4; ++m) { const int i = lane + 64 * m;
#pragma unroll
        for (int h = 0; h < 8; ++h) p_s[i * 8 + h] = sc[m][h]; }
    __builtin_amdgcn_fence(__ATOMIC_RELEASE, "wavefront"); __builtin_amdgcn_wave_barrier(); __builtin_amdgcn_fence(__ATOMIC_ACQUIRE, "wavefront");
    float o[8] = {0.f, 0.f, 0.f, 0.f, 0.f, 0.f, 0.f, 0.f};
    for (int i = 0; i < nsel; ++i) {
        const int ps = sel_s[i]; const bf16_t* vrow = U + (size_t)(b * LP + ps) * UARW + C_V;
        const float v0 = bf2f(vrow[lane]), v1 = bf2f(vrow[64 + lane]);
        const f32x4 pa = *(const f32x4*)(p_s + i * 8), pb = *(const f32x4*)(p_s + i * 8 + 4);
        o[0] = fmaf(pa[0], v0, o[0]); o[1] = fmaf(pa[1], v0, o[1]); o[2] = fmaf(pa[2], v0, o[2]); o[3] = fmaf(pa[3], v0, o[3]);
        o[4] = fmaf(pb[0], v1, o[4]); o[5] = fmaf(pb[1], v1, o[5]); o[6] = fmaf(pb[2], v1, o[6]); o[7] = fmaf(pb[3], v1, o[7]);
    }
#pragma unroll
    for (int h = 0; h < 8; ++h) OA[h * 64 + lane] = (bf16_t)f2bf(o[h] * linv[h]);
    __builtin_amdgcn_wave_barrier();
}


__device__ __forceinline__ f32x4 mfma16(bf16x8 a, bf16x8 b, f32x4 c) { return __builtin_amdgcn_mfma_f32_16x16x32_bf16(a, b, c, 0, 0, 0); }
#ifndef PROBE_PHASE
#define PROBE_PHASE -1
#endif
#define PROBE_BLOCK 0
#define LDS_BARRIER() do { asm volatile("s_waitcnt lgkmcnt(0)" ::: "memory"); __builtin_amdgcn_s_barrier(); asm volatile("" ::: "memory"); } while (0)

typedef float f32x16 __attribute__((ext_vector_type(16)));
typedef short s16x4 __attribute__((ext_vector_type(4)));
constexpr int AT_HIST = 0;
constexpr int AT_MASK = 20480;
constexpr int AT_QST = AT_MASK + 16640;
constexpr int AT_KV = 37120;
constexpr int AT_UNIT = AT_KV + 32768;
constexpr int AT_KL = AT_KV;
constexpr int AT_KL_BYTES = LDS_BYTES - 16 - AT_KL;
static_assert(4128 * 12 * 2 <= AT_KL_BYTES, "selection keys fit with 12 queries per sub-pass");
constexpr int CW_R1Q = 48;
constexpr int CW_ATT = 32;
__device__ __forceinline__ int img_off(int row, int ch) { return 2048 * (row >> 3) + 512 * (ch >> 2) + 64 * (row & 7) + 16 * ((ch & 3) ^ ((row >> 2) & 3)); }
__device__ __forceinline__ unsigned comp_key(float sc, int pos) { return (score_key(sc) & 0xFFFFE000u) | (unsigned)(0x1FFF - pos); }

__device__ __forceinline__ void attn_unit(const Params& p, unsigned char* lds, int b, int qt, unsigned long long& pacc) {
    unsigned long long pt0 = 0; if (PROBE_PHASE == 40 || PROBE_PHASE == 42) pt0 = __builtin_amdgcn_s_memrealtime();
    const int tid = otid(), wave = tid >> 6, lane = tid & 63, r = lane & 31, hh = lane >> 5;
    const bf16_t* U = (const bf16_t*)(p.ws + WS_UAR);
    LAS unsigned char* L = (LAS unsigned char*)lds;
    LAS unsigned* hist = (LAS unsigned*)(L + AT_HIST); LAS unsigned* maskw = (LAS unsigned*)(L + AT_MASK);
    const int c = qt >> 1, nkt = 2 * c + 1, nadm = 64 * (c + 1) - PADM;
    const size_t qrow = (size_t)(b * LP + 32 * qt + r);
    if (nadm > 256) {
        LAS unsigned short* KL = (LAS unsigned short*)(L + AT_KL);
        LAS unsigned* h8 = (LAS unsigned*)(L + AT_HIST);
        LAS unsigned* segc = h8 + 4096;
        LAS unsigned* st = segc + 512;
        const int NK = 32 * nkt, c15 = lane & 15, g4 = lane >> 4;
        const int qs = NK * 32 <= AT_KL_BYTES ? 16 : 12;
        for (int i = tid; i < (nkt + 1) * 32; i += NTHREADS) maskw[i] = 0u;
#pragma unroll 1
        for (int qbase = 0; qbase < 32; qbase += qs) {
            const int qn = 32 - qbase < qs ? 32 - qbase : qs; const bool qact = c15 < qn;
            bf16x8 qf[8]; float wq[8];
            { const bf16_t* qp = U + (size_t)(b * LP + 32 * qt + qbase + (qact ? c15 : 0)) * UARW;
#pragma unroll
              for (int h = 0; h < 8; ++h) qf[h] = *(const bf16x8*)(qp + C_QI + h * 32 + 8 * g4);
              const u32x4 w = *(const u32x4*)(qp + C_WI);
              wq[0] = bflo(w.x); wq[1] = bfhi(w.x); wq[2] = bflo(w.y); wq[3] = bfhi(w.y); wq[4] = bflo(w.z); wq[5] = bfhi(w.z); wq[6] = bflo(w.w); wq[7] = bfhi(w.w); }
#pragma unroll
            for (int h = 0; h < 8; ++h) asm volatile("" : "+v"(qf[h]), "+v"(wq[h]));
            for (int i = tid; i < 4096 + 512; i += NTHREADS) h8[i] = 0u;
            LDS_BARRIER();
            {
                const int ng = 2 * nkt; int j = wave;
                const bf16_t* kb = U + (size_t)(b * LP + 32 + c15) * UARW + C_KI + 8 * g4;
                bf16x8 a = *(const bf16x8*)(kb + (size_t)(16 * (j < ng ? j : 0)) * UARW), an = *(const bf16x8*)(kb + (size_t)(16 * (j + NWAVES < ng ? j + NWAVES : 0)) * UARW);
#pragma unroll 1
                for (; j < ng; j += NWAVES) {
                    const bf16x8 a2 = *(const bf16x8*)(kb + (size_t)(16 * (j + 2 * NWAVES < ng ? j + 2 * NWAVES : j)) * UARW);
                    f32x4 sc = {0.f, 0.f, 0.f, 0.f};
#pragma unroll
                    for (int h = 0; h < 8; ++h) { const f32x4 d = mfma16(a, qf[h], (f32x4){0.f, 0.f, 0.f, 0.f});
#pragma unroll
                        for (int e = 0; e < 4; ++e) sc[e] = fmaf(wq[h], fmaxf(d[e], 0.f), sc[e]); }
                    if (qact) {
#pragma unroll
                        for (int e = 0; e < 4; ++e) { const int ki = 16 * j + 4 * g4 + e;
                            const unsigned k16 = ki >= 16 ? (score_key(sc[e]) >> 16) : 0u;
                            KL[ki * qs + c15] = (unsigned short)k16;
                            __hip_atomic_fetch_add(h8 + (k16 >> 8) * 16 + c15, ki >= 16 ? 1u : 0u, __ATOMIC_RELAXED, __HIP_MEMORY_SCOPE_WORKGROUP); } }
                    a = an; an = a2;
                }
            }
            LDS_BARRIER();
            { const int q_ = tid & 15, s8 = tid >> 4; unsigned ss = 0u;
#pragma unroll
              for (int i = 0; i < 8; ++i) ss += h8[(s8 * 8 + i) * 16 + q_];
              segc[s8 * 16 + q_] = ss; }
            LDS_BARRIER();
            if (tid < qn) { unsigned sv[32];
#pragma unroll
                for (int i = 0; i < 32; ++i) sv[i] = segc[i * 16 + tid];
                unsigned cum = 0u; int sgi = 31;
#pragma unroll
                for (int i = 31; i > 0; --i) { const bool go = sgi == i && cum + sv[i] < 256u; cum += go ? sv[i] : 0u; sgi -= go ? 1 : 0; }
                int bin = sgi * 8 + 7; while (bin > sgi * 8 && cum + h8[bin * 16 + tid] < 256u) { cum += h8[bin * 16 + tid]; --bin; }
                st[tid * 4] = (unsigned)bin; st[tid * 4 + 1] = 256u - cum; }
            LDS_BARRIER();
            for (int i = tid; i < 4096; i += NTHREADS) h8[i] = 0u;
            LDS_BARRIER();
            const int q = tid & 15, sg = tid >> 4, SEG = (NK + 31) >> 5, k0 = sg * SEG, k1 = q < qn ? (k0 + SEG < NK ? k0 + SEG : NK) : k0;
            { const unsigned hb = st[q * 4];
#pragma unroll 8
              for (int k = k0; k < k1; ++k) { const unsigned kv = KL[k * qs + q]; __hip_atomic_fetch_add(h8 + (kv & 255u) * 16 + q, (kv >> 8) == hb && kv != 0u ? 1u : 0u, __ATOMIC_RELAXED, __HIP_MEMORY_SCOPE_WORKGROUP); } }
            LDS_BARRIER();
            { const int q_ = tid & 15, s8 = tid >> 4; unsigned ss = 0u;
#pragma unroll
              for (int i = 0; i < 8; ++i) ss += h8[(s8 * 8 + i) * 16 + q_];
              segc[s8 * 16 + q_] = ss; }
            LDS_BARRIER();
            if (tid < qn) { const unsigned rem = st[tid * 4 + 1]; unsigned sv[32];
#pragma unroll
                for (int i = 0; i < 32; ++i) sv[i] = segc[i * 16 + tid];
                unsigned cum = 0u; int sgi = 31;
#pragma unroll
                for (int i = 31; i > 0; --i) { const bool go = sgi == i && cum + sv[i] < rem; cum += go ? sv[i] : 0u; sgi -= go ? 1 : 0; }
                int bin = sgi * 8 + 7; while (bin > sgi * 8 && cum + h8[bin * 16 + tid] < rem) { cum += h8[bin * 16 + tid]; --bin; }
                st[tid * 4 + 2] = (st[tid * 4] << 8) | (unsigned)bin; st[tid * 4 + 3] = rem - cum; }
            LDS_BARRIER();
            const unsigned thr = st[q * 4 + 2], need = st[q * 4 + 3];
            { unsigned cnt = 0u;
#pragma unroll 8
              for (int k = k0; k < k1; ++k) cnt += KL[k * qs + q] == thr ? 1u : 0u;
              segc[sg * 16 + q] = cnt; }
            LDS_BARRIER();
            if (tid < qn) { unsigned cv[32];
#pragma unroll
                for (int s2 = 0; s2 < 32; ++s2) cv[s2] = segc[s2 * 16 + tid];
                unsigned run = 0u;
#pragma unroll
                for (int s2 = 0; s2 < 32; ++s2) { segc[s2 * 16 + tid] = run; run += cv[s2]; } }
            LDS_BARRIER();
            { unsigned rank = segc[sg * 16 + q], word = 0u; int wi = k0 >> 5;
#pragma unroll 4
              for (int k = k0; k < k1; ++k) { if ((k >> 5) != wi) { if (word) __hip_atomic_fetch_or(maskw + (wi + 1) * 32 + qbase + q, word, __ATOMIC_RELAXED, __HIP_MEMORY_SCOPE_WORKGROUP); word = 0u; wi = k >> 5; }
                  const unsigned kv = KL[k * qs + q]; const bool tie = kv == thr; const bool sel = kv > thr || (tie && rank < need); rank += tie ? 1u : 0u;
                  word |= (sel ? 1u : 0u) << (k & 31); }
              if (word) __hip_atomic_fetch_or(maskw + (wi + 1) * 32 + qbase + q, word, __ATOMIC_RELAXED, __HIP_MEMORY_SCOPE_WORKGROUP); }
            LDS_BARRIER();
        }
    } else {
        for (int kt = 1 + wave; kt <= nkt; kt += NWAVES) if (hh == 0) maskw[kt * 32 + r] = kt == 1 ? 0xFFFF0000u : 0xFFFFFFFFu;
        LDS_BARRIER();
    }
    if (PROBE_PHASE == 40) pacc += __builtin_amdgcn_s_memrealtime() - pt0;
    if (PROBE_PHASE == 41) pt0 = __builtin_amdgcn_s_memrealtime();
    {
        const int h = wave, n = h >> 2;
        bf16x8 qf4[4];
#pragma unroll
        for (int kk = 0; kk < 4; ++kk) qf4[kk] = *(const bf16x8*)(U + qrow * UARW + C_Q + h * 64 + 16 * kk + 8 * hh);
        asm volatile("" : "+v"(qf4[0]), "+v"(qf4[1]), "+v"(qf4[2]), "+v"(qf4[3]));
        f32x16 o0, o1;
#pragma unroll
        for (int e = 0; e < 16; ++e) { o0[e] = 0.f; o1[e] = 0.f; }
        float m = -1e30f, lsum = 0.f;
        const int srow = tid >> 4, sch = tid & 15; const int soff = img_off(srow, sch);
        const bf16_t* sbase = U + (size_t)(b * LP + srow) * UARW + sch * 8;
        u32x4 kreg = *(const u32x4*)(sbase + (size_t)32 * UARW + C_K), vreg = *(const u32x4*)(sbase + (size_t)32 * UARW + C_V);
        *(LAS u32x4*)(L + AT_KV + soff) = kreg; *(LAS u32x4*)(L + AT_KV + 8192 + soff) = vreg;
        { const int k2 = nkt >= 2 ? 2 : 1; kreg = *(const u32x4*)(sbase + (size_t)(32 * k2) * UARW + C_K); vreg = *(const u32x4*)(sbase + (size_t)(32 * k2) * UARW + C_V); }
        LDS_BARRIER();
        const int g = (lane >> 4) & 1, q_ = (lane & 15) >> 2, p_ = lane & 3;
        constexpr float SCL = 0.125f * 1.44269504088896f;
#pragma unroll 1
        for (int i = 0; i < nkt; ++i) {
            const int kt = 1 + i; LAS unsigned char* Kimg = L + AT_KV + (i & 1) * 16384; LAS unsigned char* Vimg = Kimg + 8192;
            u32x4 kreg2, vreg2;
            { const int k3 = kt + 2 <= nkt ? kt + 2 : kt; kreg2 = *(const u32x4*)(sbase + (size_t)(32 * k3) * UARW + C_K); vreg2 = *(const u32x4*)(sbase + (size_t)(32 * k3) * UARW + C_V); }
            f32x16 s;
#pragma unroll
            for (int e = 0; e < 16; ++e) s[e] = 0.f;
#pragma unroll
            for (int kk = 0; kk < 4; ++kk) { const bf16x8 a = *(const LAS bf16x8*)(Kimg + img_off(r, 8 * n + 2 * kk + hh)); s = __builtin_amdgcn_mfma_f32_32x32x16_bf16(a, qf4[kk], s, 0, 0, 0); }
            const unsigned mw = maskw[kt * 32 + r] >> (4 * hh);
            float tmax = -INFINITY;
#pragma unroll
            for (int e = 0; e < 16; ++e) { const bool sel = (mw >> ((e & 3) + 8 * (e >> 2))) & 1u; s[e] = sel ? s[e] : -INFINITY; tmax = fmaxf(tmax, s[e]); }
            tmax = fmaxf(tmax, __shfl_xor(tmax, 32));
            const float mnew = fmaxf(m, tmax * SCL);
            if (__any(mnew > m)) { const float alpha = __builtin_amdgcn_exp2f(m - mnew); lsum *= alpha;
#pragma unroll
                for (int e = 0; e < 16; ++e) { o0[e] *= alpha; o1[e] *= alpha; } }
            m = mnew;
            float ps = 0.f;
#pragma unroll
            for (int e = 0; e < 16; ++e) { const float pe = __builtin_amdgcn_exp2f(fmaf(s[e], SCL, -mnew)); s[e] = pe; ps += pe; }
            lsum += ps;
            bf16x8 pf[2];
#pragma unroll
            for (int ks = 0; ks < 2; ++ks) { u32x4 w; w.x = pk2(s[8 * ks + 0], s[8 * ks + 1]); w.y = pk2(s[8 * ks + 2], s[8 * ks + 3]); w.z = pk2(s[8 * ks + 4], s[8 * ks + 5]); w.w = pk2(s[8 * ks + 6], s[8 * ks + 7]); pf[ks] = __builtin_bit_cast(bf16x8, w); }
#pragma unroll
            for (int ks = 0; ks < 2; ++ks)
#pragma unroll
                for (int dt = 0; dt < 2; ++dt) { const int c0 = 8 * n + 4 * dt + 2 * g + (p_ >> 1);
                    const s16x4 lo = __builtin_amdgcn_ds_read_tr16_b64_v4i16((LAS s16x4*)(Vimg + img_off(16 * ks + 4 * hh + q_, c0) + 8 * (p_ & 1)));
                    const s16x4 hi = __builtin_amdgcn_ds_read_tr16_b64_v4i16((LAS s16x4*)(Vimg + img_off(16 * ks + 8 + 4 * hh + q_, c0) + 8 * (p_ & 1)));
                    const bf16x8 a = __builtin_shufflevector(lo, hi, 0, 1, 2, 3, 4, 5, 6, 7);
                    if (dt == 0) o0 = __builtin_amdgcn_mfma_f32_32x32x16_bf16(a, pf[ks], o0, 0, 0, 0); else o1 = __builtin_amdgcn_mfma_f32_32x32x16_bf16(a, pf[ks], o1, 0, 0, 0); }
            if (i + 1 < nkt) { LAS unsigned char* Kn = L + AT_KV + ((i + 1) & 1) * 16384; *(LAS u32x4*)(Kn + soff) = kreg; *(LAS u32x4*)(Kn + 8192 + soff) = vreg; }
            kreg = kreg2; vreg = vreg2;
            LDS_BARRIER();
        }
        lsum += __shfl_xor(lsum, 32);
        const float inv = lsum > 0.f ? 1.0f / lsum : 0.f;
        bf16_t* orow = (bf16_t*)(p.ws + WS_OAB) + qrow * D + h * 64 + 4 * hh;
#pragma unroll
        for (int g4 = 0; g4 < 4; ++g4) { u32x2 w0, w1;
            w0.x = pk2(o0[4 * g4] * inv, o0[4 * g4 + 1] * inv); w0.y = pk2(o0[4 * g4 + 2] * inv, o0[4 * g4 + 3] * inv);
            w1.x = pk2(o1[4 * g4] * inv, o1[4 * g4 + 1] * inv); w1.y = pk2(o1[4 * g4 + 2] * inv, o1[4 * g4 + 3] * inv);
            *(u32x2*)(orow + 8 * g4) = w0; *(u32x2*)(orow + 32 + 8 * g4) = w1; }
        if (qt == 1) {
            bf16_t* z = (bf16_t*)(p.ws + WS_OAB) + (size_t)(b * LP + r) * D + h * 64 + 32 * hh;
#pragma unroll
            for (int j = 0; j < 4; ++j) *(u32x4*)(z + 8 * j) = (u32x4){0u, 0u, 0u, 0u};
        }
    }
    if (PROBE_PHASE == 41 || PROBE_PHASE == 42) pacc += __builtin_amdgcn_s_memrealtime() - pt0;
}
__device__ __forceinline__ void attn_phase(const Params& p, int l, unsigned char* lds, unsigned long long& pacc) {
    unsigned* ctr = (unsigned*)(p.ws + WS_CTL) + CW_ATT + 4 * l;
    volatile int* uw = (volatile int*)(lds + AT_UNIT);
    const int b0 = (obid() & 7) >> 1;
    for (int k = 0; k < 4; ++k) { const int b = (b0 + k) & 3;
        for (;;) {
            __syncthreads();
            if (otid() == 0) *uw = (int)atomicAdd(ctr + b, 1u);
            __syncthreads();
            const int u = *uw;
            if (u >= 129) break;
            attn_unit(p, lds, b, 129 - u, pacc);
        }
    }
}

constexpr size_t WS_RW1 = WS_HB;
constexpr size_t WS_RW2 = 259 * MiB;
constexpr size_t RW2_ARR = (size_t)2080 * 8192;
constexpr size_t WS_LORA = 65536;
constexpr int PS = 72;
constexpr int R1_XW = 0, R1_XA = 9216, R1_XG = 18432;
constexpr int R1_RHS = 0;
constexpr int R1_E = 35840, R1_AA = R1_E + 16640, R1_GS = R1_AA + 9216;
constexpr int R1_LABT = R1_E, R1_LAK = R1_E + 16384;
constexpr int R1_AT = R1_GS + 9216, R1_RT = R1_AT + 9216, R1_BT = R1_RT + 9216, R1_KT = R1_BT + 9216;
constexpr int R1_WT = R1_AT, R1_ZT = R1_BT, R1_LOFF = R1_KT;
constexpr int R1_BTT = R1_KT + 9216, R1_KTT = R1_BTT + 9216, R1_VT = R1_KTT + 9216;
constexpr int R1_MRB = R1_VT + 9216, R1_MRK = R1_MRB + 9216;
constexpr int R1_BS = R1_MRK + 9216, R1_GC = R1_BS + 256, R1_END = R1_GC + 256;
static_assert(R1_END <= LDS_BYTES && R1_LAK + 9216 <= R1_AT && R1_RHS + 33280 <= R1_E, "R1 LDS map");
__device__ __forceinline__ u32x2 pk4(f32x4 v) { u32x2 w; w.x = pk2(v[0], v[1]); w.y = pk2(v[2], v[3]); return w; }

#ifndef PROBE_PHASE
#define PROBE_PHASE -1
#endif
#define R1P(k) do { if (PROBE_PHASE == 20 + (k)) { const unsigned long long t_ = __builtin_amdgcn_s_memrealtime(); pacc += t_ - pt0; } if (PROBE_PHASE == 21 + (k)) pt0 = __builtin_amdgcn_s_memrealtime(); } while (0)
__device__ __forceinline__ void rwkv_prep_unit(const Params& p, int l, int unit, unsigned char* lds, unsigned long long& pacc) {
    unsigned long long pt0 = 0; if (PROBE_PHASE == 20) pt0 = __builtin_amdgcn_s_memrealtime();
    const int tid = otid(), wave = tid >> 6, lane = tid & 63, c15 = lane & 15, g = lane >> 4;
    const int h = unit & 7, bc = unit >> 3, b = bc / NCH, c = bc - b * NCH;
    LAS unsigned char* L = (LAS unsigned char*)lds;
    const bf16_t* U = (const bf16_t*)(p.ws + WS_UAR);
    const int t = tid >> 3, dq = tid & 7, d0 = dq * 8;
    const int row = b * LP + 64 * c + t; const bool hasprev = (64 * c + t) > 0;
    bf16x8 lw[2][2], la[2][2], lg_[2][4];
    { const bf16_t* lora = (const bf16_t*)(p.ws + WS_LORA + (size_t)l * 262144);
#pragma unroll
      for (int nn = 0; nn < 2; ++nn) { const int hd = h * 64 + 16 * (2 * (wave & 1) + nn) + c15;
#pragma unroll
          for (int s2 = 0; s2 < 2; ++s2) { lw[nn][s2] = *(const bf16x8*)(lora + (size_t)hd * 64 + 32 * s2 + 8 * g); la[nn][s2] = *(const bf16x8*)(lora + 32768 + (size_t)hd * 64 + 32 * s2 + 8 * g); }
#pragma unroll
          for (int s4 = 0; s4 < 4; ++s4) lg_[nn][s4] = *(const bf16x8*)(lora + 65536 + (size_t)hd * 128 + 32 * s4 + 8 * g); } }
    float rr[8], kx[8], vx[8], kk[8];
    {
        const bf16_t* uc = U + (size_t)row * UARW; const bf16_t* up = hasprev ? uc - UARW : uc;
        const float* mu = p.in[I_MU] + l * R_COLS;
        auto shift8 = [&](int col, int mucol, float (&out)[8]) {
            const u32x4 a = *(const u32x4*)(uc + col), q = *(const u32x4*)(up + col);
            const f32x4 m0 = *(const f32x4*)(mu + mucol), m1 = *(const f32x4*)(mu + mucol + 4);
            const float x[8] = {bflo(a.x), bfhi(a.x), bflo(a.y), bfhi(a.y), bflo(a.z), bfhi(a.z), bflo(a.w), bfhi(a.w)};
            const float y[8] = {bflo(q.x), bfhi(q.x), bflo(q.y), bfhi(q.y), bflo(q.z), bfhi(q.z), bflo(q.w), bfhi(q.w)};
#pragma unroll
            for (int i = 0; i < 8; ++i) { const float xp = hasprev ? y[i] : 0.f; out[i] = x[i] + (xp - x[i]) * (i < 4 ? m0[i] : m1[i - 4]); } };
        shift8(C_R + h * 64 + d0, h * 64 + d0, rr); shift8(C_RK + h * 64 + d0, 512 + h * 64 + d0, kx); shift8(C_RV + h * 64 + d0, 1024 + h * 64 + d0, vx);
        float xw[8], xa[8], xg0[8], xg1[8];
        shift8(C_XW + d0, 1536 + d0, xw); shift8(C_XA + d0, 1600 + d0, xa); shift8(C_XG + d0, 1664 + d0, xg0); shift8(C_XG + 64 + d0, 1728 + d0, xg1);
        float n2 = 0.f;
        { const f32x4 k0 = *(const f32x4*)(p.in[I_KK] + l * 512 + h * 64 + d0), k1 = *(const f32x4*)(p.in[I_KK] + l * 512 + h * 64 + d0 + 4);
#pragma unroll
          for (int i = 0; i < 8; ++i) { kk[i] = kx[i] * (i < 4 ? k0[i] : k1[i - 4]); n2 = fmaf(kk[i], kk[i], n2); } }
        n2 += __shfl_xor(n2, 1); n2 += __shfl_xor(n2, 2); n2 += __shfl_xor(n2, 4);
        const float rn = rsqrtf(fmaxf(n2, 1e-24f));
#pragma unroll
        for (int i = 0; i < 8; ++i) { kk[i] *= rn; xw[i] = 1.0f - 2.0f * __builtin_amdgcn_rcpf(1.0f + __expf(2.0f * xw[i])); xg0[i] = sigmoidf_(xg0[i]); xg1[i] = sigmoidf_(xg1[i]); }
        u32x4 w;
        w.x = pk2(xw[0], xw[1]); w.y = pk2(xw[2], xw[3]); w.z = pk2(xw[4], xw[5]); w.w = pk2(xw[6], xw[7]); *(LAS u32x4*)(L + R1_XW + (t * PS + d0) * 2) = w;
        w.x = pk2(xa[0], xa[1]); w.y = pk2(xa[2], xa[3]); w.z = pk2(xa[4], xa[5]); w.w = pk2(xa[6], xa[7]); *(LAS u32x4*)(L + R1_XA + (t * PS + d0) * 2) = w;
        w.x = pk2(xg0[0], xg0[1]); w.y = pk2(xg0[2], xg0[3]); w.z = pk2(xg0[4], xg0[5]); w.w = pk2(xg0[6], xg0[7]); *(LAS u32x4*)(L + R1_XG + (t * 136 + d0) * 2) = w;
        w.x = pk2(xg1[0], xg1[1]); w.y = pk2(xg1[2], xg1[3]); w.z = pk2(xg1[4], xg1[5]); w.w = pk2(xg1[6], xg1[7]); *(LAS u32x4*)(L + R1_XG + (t * 136 + 64 + d0) * 2) = w;
    }
    LDS_BARRIER();
    R1P(0);
    const int tm = wave >> 1;
    unsigned char* rw2 = p.ws + WS_RW2 + (size_t)unit * 8192;
    {
#pragma unroll
        for (int nn = 0; nn < 2; ++nn) { const int tn = 2 * (wave & 1) + nn, dcol = 16 * tn + c15, hd = h * 64 + dcol;
            f32x4 aw = {0.f, 0.f, 0.f, 0.f}, aa = aw, ag = aw;
#pragma unroll
            for (int s2 = 0; s2 < 2; ++s2) {
                const bf16x8 xa_ = *(const LAS bf16x8*)(L + R1_XW + ((16 * tm + c15) * PS + 32 * s2 + 8 * g) * 2), xb_ = *(const LAS bf16x8*)(L + R1_XA + ((16 * tm + c15) * PS + 32 * s2 + 8 * g) * 2);
                aw = mfma16(xa_, lw[nn][s2], aw);
                aa = mfma16(xb_, la[nn][s2], aa); }
#pragma unroll
            for (int s4 = 0; s4 < 4; ++s4) ag = mfma16(*(const LAS bf16x8*)(L + R1_XG + ((16 * tm + c15) * 136 + 32 * s4 + 8 * g) * 2), lg_[nn][s4], ag);
            const float w0 = p.in[I_W0][l * 512 + hd], a0 = p.in[I_A0][l * 512 + hd];
#pragma unroll
            for (int e = 0; e < 4; ++e) { const int tt = 16 * tm + 4 * g + e;
                *(LAS float*)(L + R1_E + (tt * 65 + dcol) * 4) = 0.60653065971263342f * sigmoidf_(w0 + aw[e]);
                *(LAS unsigned short*)(L + R1_AA + (tt * PS + dcol) * 2) = (unsigned short)f2bf(sigmoidf_(a0 + aa[e]));
                *(LAS unsigned short*)(L + R1_GS + (tt * PS + dcol) * 2) = (unsigned short)f2bf(ag[e]); }
        }
    }
    LDS_BARRIER();
    R1P(1);
    {
        const int d = tid & 63, sg = tid >> 6; float cum = 0.f, loc[8];
#pragma unroll
        for (int i = 0; i < 8; ++i) { cum += *(const LAS float*)(L + R1_E + ((8 * sg + i) * 65 + d) * 4); loc[i] = cum; }
        *(LAS float*)(L + R1_BS + (sg * 64 + d) * 4 - 2048) = cum;
        LDS_BARRIER();
        float off = 0.f;
#pragma unroll
        for (int q = 0; q < 7; ++q) if (q < sg) off += *(const LAS float*)(L + R1_BS + (q * 64 + d) * 4 - 2048);
#pragma unroll
        for (int i = 0; i < 8; ++i) *(LAS float*)(L + R1_E + ((8 * sg + i) * 65 + d) * 4) = loc[i] + off;
    }
    LDS_BARRIER();
    R1P(2);
    {
        const f32x4 ka0 = *(const f32x4*)(p.in[I_KA] + l * 512 + h * 64 + d0), ka1 = *(const f32x4*)(p.in[I_KA] + l * 512 + h * 64 + d0 + 4);
        const f32x4 rk0 = *(const f32x4*)(p.in[I_RK] + l * 512 + h * 64 + d0), rk1 = *(const f32x4*)(p.in[I_RK] + l * 512 + h * 64 + d0 + 4);
        const u32x4 aw_ = *(const LAS u32x4*)(L + R1_AA + (t * PS + d0) * 2);
        const float av[8] = {bflo(aw_.x), bfhi(aw_.x), bflo(aw_.y), bfhi(aw_.y), bflo(aw_.z), bfhi(aw_.z), bflo(aw_.w), bfhi(aw_.w)};
        float At[8], Bt[8], Kt[8], Rt[8]; float bpart = 0.f;
#pragma unroll
        for (int i = 0; i < 8; ++i) {
            const float cumt = *(const LAS float*)(L + R1_E + (t * 65 + d0 + i) * 4), cump = t > 0 ? *(const LAS float*)(L + R1_E + ((t - 1) * 65 + d0 + i) * 4) : 0.f;
            const float gam = __expf(-cumt), gprev = __expf(-cump), ginv = __expf(cumt);
            const float kmod = kx[i] * (1.0f + (av[i] - 1.0f) * (i < 4 ? ka0[i] : ka1[i - 4]));
            At[i] = -gprev * kk[i]; Bt[i] = kk[i] * av[i] * ginv; Kt[i] = kmod * ginv; Rt[i] = rr[i] * gam;
            bpart = fmaf(rr[i] * kmod, (i < 4 ? rk0[i] : rk1[i - 4]), bpart);
            if (t == 63) *(LAS float*)(L + R1_GC + (d0 + i) * 4) = gam;
            *(LAS float*)(L + R1_RHS + ((d0 + i) * 65 + t) * 4) = At[i];
            *(LAS unsigned short*)(L + R1_BTT + ((d0 + i) * PS + t) * 2) = (unsigned short)f2bf(Bt[i]);
            *(LAS unsigned short*)(L + R1_KTT + ((d0 + i) * PS + t) * 2) = (unsigned short)f2bf(Kt[i]);
            *(LAS unsigned short*)(L + R1_VT + ((d0 + i) * PS + t) * 2) = (unsigned short)f2bf(vx[i]);
        }
        u32x4 w;
        w.x = pk2(At[0], At[1]); w.y = pk2(At[2], At[3]); w.z = pk2(At[4], At[5]); w.w = pk2(At[6], At[7]); *(LAS u32x4*)(L + R1_AT + (t * PS + d0) * 2) = w;
        w.x = pk2(Rt[0], Rt[1]); w.y = pk2(Rt[2], Rt[3]); w.z = pk2(Rt[4], Rt[5]); w.w = pk2(Rt[6], Rt[7]); *(LAS u32x4*)(L + R1_RT + (t * PS + d0) * 2) = w;
        w.x = pk2(Bt[0], Bt[1]); w.y = pk2(Bt[2], Bt[3]); w.z = pk2(Bt[4], Bt[5]); w.w = pk2(Bt[6], Bt[7]); *(LAS u32x4*)(L + R1_BT + (t * PS + d0) * 2) = w;
        w.x = pk2(Kt[0], Kt[1]); w.y = pk2(Kt[2], Kt[3]); w.z = pk2(Kt[4], Kt[5]); w.w = pk2(Kt[6], Kt[7]); *(LAS u32x4*)(L + R1_KT + (t * PS + d0) * 2) = w;
        bpart += __shfl_xor(bpart, 1); bpart += __shfl_xor(bpart, 2); bpart += __shfl_xor(bpart, 4);
        const u32x4 gw = *(const LAS u32x4*)(L + R1_GS + (t * PS + d0) * 2);
        const float gv[8] = {bflo(gw.x), bfhi(gw.x), bflo(gw.y), bfhi(gw.y), bflo(gw.z), bfhi(gw.z), bflo(gw.w), bfhi(gw.w)};
        w.x = pk2(bpart * vx[0] * gv[0], bpart * vx[1] * gv[1]); w.y = pk2(bpart * vx[2] * gv[2], bpart * vx[3] * gv[3]);
        w.z = pk2(bpart * vx[4] * gv[4], bpart * vx[5] * gv[5]); w.w = pk2(bpart * vx[6] * gv[6], bpart * vx[7] * gv[7]);
        *(u32x4*)((bf16_t*)(p.ws + WS_OAB) + (size_t)row * D + 512 + h * 64 + d0) = w;
        *(u32x4*)(rw2 + 2 * RW2_ARR + (size_t)(t * 64 + d0) * 2) = gw;
    }
    LDS_BARRIER();
    R1P(3);
    {
        f32x4 gab[2], gak[2], grb[2], grk[2];
#pragma unroll
        for (int nn = 0; nn < 2; ++nn) { const int tn = 2 * (wave & 1) + nn;
            gab[nn] = (f32x4){0.f, 0.f, 0.f, 0.f}; gak[nn] = gab[nn]; grb[nn] = gab[nn]; grk[nn] = gab[nn];
            if (tn <= tm) {
#pragma unroll
                for (int s2 = 0; s2 < 2; ++s2) { const int ao = ((16 * tm + c15) * PS + 32 * s2 + 8 * g) * 2, bo = ((16 * tn + c15) * PS + 32 * s2 + 8 * g) * 2;
                    const bf16x8 fa = *(const LAS bf16x8*)(L + R1_AT + ao), fr_ = *(const LAS bf16x8*)(L + R1_RT + ao), fb = *(const LAS bf16x8*)(L + R1_BT + bo), fk = *(const LAS bf16x8*)(L + R1_KT + bo);
                    gab[nn] = mfma16(fa, fb, gab[nn]); gak[nn] = mfma16(fa, fk, gak[nn]); grb[nn] = mfma16(fr_, fb, grb[nn]); grk[nn] = mfma16(fr_, fk, grk[nn]); } } }
        LDS_BARRIER();
#pragma unroll
        for (int nn = 0; nn < 2; ++nn) { const int tn = 2 * (wave & 1) + nn, icol = 16 * tn + c15;
            f32x4 lab;
#pragma unroll
            for (int e = 0; e < 4; ++e) { const int tt = 16 * tm + 4 * g + e; const bool strict = icol < tt, incl = icol <= tt;
                lab[e] = strict ? gab[nn][e] : 0.f;
                *(LAS unsigned short*)(L + R1_LAK + (tt * PS + icol) * 2) = (unsigned short)f2bf(strict ? gak[nn][e] : 0.f);
                *(LAS unsigned short*)(L + R1_LOFF + (tt * PS + icol) * 2) = (unsigned short)f2bf(icol < (tt & ~15) ? gab[nn][e] : 0.f);
                *(LAS unsigned short*)(L + R1_MRB + (tt * PS + icol) * 2) = (unsigned short)f2bf(incl ? grb[nn][e] : 0.f);
                *(LAS unsigned short*)(L + R1_MRK + (tt * PS + icol) * 2) = (unsigned short)f2bf(incl ? grk[nn][e] : 0.f); }
            *(LAS f32x4*)(L + R1_LABT + (icol * 64 + 16 * tm + 4 * g) * 4) = lab; }
    }
    LDS_BARRIER();
    R1P(4);
    {
#pragma unroll
        for (int nn = 0; nn < 2; ++nn) { const int tn = 2 * (wave & 1) + nn; f32x4 acc = {0.f, 0.f, 0.f, 0.f};
#pragma unroll
            for (int s2 = 0; s2 < 2; ++s2) acc = mfma16(*(const LAS bf16x8*)(L + R1_LAK + ((16 * tm + c15) * PS + 32 * s2 + 8 * g) * 2), *(const LAS bf16x8*)(L + R1_VT + ((16 * tn + c15) * PS + 32 * s2 + 8 * g) * 2), acc);
#pragma unroll
            for (int e = 0; e < 4; ++e) *(LAS float*)(L + R1_RHS + ((64 + 16 * tn + c15) * 65 + 16 * tm + 4 * g + e) * 4) = acc[e]; }
    }
    LDS_BARRIER();
    R1P(5);
#pragma unroll 1
    for (int Tb = 0; Tb < 4; ++Tb) {
        if (Tb > 0) {
            LAS unsigned char* XT = L + (wave < 4 ? R1_WT + (16 * wave) * PS * 2 : R1_ZT + (16 * (wave - 4)) * PS * 2);
            f32x4 acc = {0.f, 0.f, 0.f, 0.f};
            acc = mfma16(*(const LAS bf16x8*)(L + R1_LOFF + ((16 * Tb + c15) * PS + 8 * g) * 2), *(const LAS bf16x8*)(XT + (c15 * PS + 8 * g) * 2), acc);
            if (Tb == 3) acc = mfma16(*(const LAS bf16x8*)(L + R1_LOFF + ((16 * Tb + c15) * PS + 32 + 8 * g) * 2), *(const LAS bf16x8*)(XT + (c15 * PS + 32 + 8 * g) * 2), acc);
            LAS float* rp = (LAS float*)(L + R1_RHS + ((16 * wave + c15) * 65 + 16 * Tb + 4 * g) * 4);
#pragma unroll
            for (int e = 0; e < 4; ++e) rp[e] += acc[e];
            LDS_BARRIER();
        }
        if (tid < 128) {
            LAS float* xr = (LAS float*)(L + R1_RHS + (tid * 65 + 16 * Tb) * 4);
            float acc[16];
#pragma unroll
            for (int e = 0; e < 16; ++e) acc[e] = xr[e];
#pragma unroll
            for (int ii = 0; ii < 15; ++ii) { const float xi = acc[ii];
#pragma unroll
                for (int q = (ii + 1) / 4; q < 4; ++q) { const f32x4 lv = *(const LAS f32x4*)(L + R1_LABT + ((16 * Tb + ii) * 64 + 16 * Tb + 4 * q) * 4);
#pragma unroll
                    for (int e = 0; e < 4; ++e) if (4 * q + e > ii) acc[4 * q + e] = fmaf(lv[e], xi, acc[4 * q + e]); } }
#pragma unroll
            for (int e = 0; e < 16; ++e) xr[e] = acc[e];
            LAS unsigned char* dst = L + (tid < 64 ? R1_WT + tid * PS * 2 : R1_ZT + (tid - 64) * PS * 2) + 32 * Tb;
            u32x4 w0, w1; w0.x = pk2(acc[0], acc[1]); w0.y = pk2(acc[2], acc[3]); w0.z = pk2(acc[4], acc[5]); w0.w = pk2(acc[6], acc[7]);
            w1.x = pk2(acc[8], acc[9]); w1.y = pk2(acc[10], acc[11]); w1.z = pk2(acc[12], acc[13]); w1.w = pk2(acc[14], acc[15]);
            *(LAS u32x4*)dst = w0; *(LAS u32x4*)(dst + 16) = w1;
        }
        if (Tb < 3) LDS_BARRIER();
    }
    LDS_BARRIER();
    R1P(6);
    {
        unsigned char* rw1 = p.ws + WS_RW1 + (size_t)unit * 16384;
#pragma unroll
        for (int nn = 0; nn < 2; ++nn) { const int tn = 2 * (wave & 1) + nn, col = 16 * tn + c15, r0 = 16 * tm + 4 * g;
            f32x4 aP = {0.f, 0.f, 0.f, 0.f}, aQ = aP, aG = aP, aY = aP;
#pragma unroll
            for (int s2 = 0; s2 < 2; ++s2) { const int ro = ((16 * tm + c15) * PS + 32 * s2 + 8 * g) * 2, co = ((16 * tn + c15) * PS + 32 * s2 + 8 * g) * 2;
                const bf16x8 fWT = *(const LAS bf16x8*)(L + R1_WT + ro), fBTT = *(const LAS bf16x8*)(L + R1_BTT + ro), fKTT = *(const LAS bf16x8*)(L + R1_KTT + ro), fMRB = *(const LAS bf16x8*)(L + R1_MRB + ro), fMRK = *(const LAS bf16x8*)(L + R1_MRK + ro);
                const bf16x8 cBTT = *(const LAS bf16x8*)(L + R1_BTT + co), cZT = *(const LAS bf16x8*)(L + R1_ZT + co), cVT = *(const LAS bf16x8*)(L + R1_VT + co), cMRB = *(const LAS bf16x8*)(L + R1_MRB + co);
                aP = mfma16(fWT, cBTT, aP);
                aQ = mfma16(fBTT, cZT, aQ); aQ = mfma16(fKTT, cVT, aQ);
                aG = mfma16(fWT, cMRB, aG);
                aY = mfma16(fMRB, cZT, aY); aY = mfma16(fMRK, cVT, aY); }
            const float gcc = *(const LAS float*)(L + R1_GC + col * 4);
            const f32x4 gcr = *(const LAS f32x4*)(L + R1_GC + r0 * 4);
            const u32x2 rtw = *(const LAS u32x2*)(L + R1_RT + (col * PS + r0) * 2);
#pragma unroll
            for (int e = 0; e < 4; ++e) { aP[e] = (aP[e] + ((r0 + e) == col ? 1.0f : 0.f)) * gcc; aQ[e] *= gcr[e]; }
            aG[0] += bflo(rtw.x); aG[1] += bfhi(rtw.x); aG[2] += bflo(rtw.y); aG[3] += bfhi(rtw.y);
            *(u32x2*)(rw1 + (size_t)(col * 64 + r0) * 2) = pk4(aP);
            *(u32x2*)(rw1 + 8192 + (size_t)(col * 64 + r0) * 2) = pk4(aG);
            *(u32x2*)(rw2 + (size_t)(col * 64 + r0) * 2) = pk4(aQ);
            *(u32x2*)(rw2 + RW2_ARR + (size_t)(col * 64 + r0) * 2) = pk4(aY); }
    }
    LDS_BARRIER();
    R1P(7);
}

constexpr int R2_SV = 0, R2_YS = 2 * 64 * PS * 2, R2_END = R2_YS + 2 * 64 * 68 * 4;
__device__ __forceinline__ void rwkv_scan(const Params& p, int l, int bh, unsigned char* lds) {
    const int tid = otid(), wave = tid >> 6, lane = tid & 63, c15 = lane & 15, g = lane >> 4;
    const int b = bh >> 3, h = bh & 7, role = wave >> 2, j = wave & 3, vcol = 16 * j + c15;
    LAS unsigned char* L = (LAS unsigned char*)lds;
    for (int i = tid; i < 2 * 64 * PS * 2 / 4; i += NTHREADS) ((LAS unsigned*)(L + R2_SV))[i] = 0u;
    LDS_BARRIER();
    const int et = tid >> 3, ev0 = 8 * (tid & 7);
    f32x4 gn0[2], gn1[2];
    { const float* gp = p.in[I_GNG] + l * 512 + h * 64 + ev0; const float* bp = p.in[I_GNB] + l * 512 + h * 64 + ev0;
      gn0[0] = *(const f32x4*)gp; gn0[1] = *(const f32x4*)(gp + 4); gn1[0] = *(const f32x4*)bp; gn1[1] = *(const f32x4*)(bp + 4); }
    bf16_t* OB = (bf16_t*)(p.ws + WS_OAB) + (size_t)(b * LP + et) * D + 512 + h * 64 + ev0;
    const int unit0 = (b * NCH) * 8 + h;
    const unsigned char* rw1b = p.ws + WS_RW1 + (role ? 8192 : 0) + (size_t)(c15 * 64 + 8 * g) * 2;
    const unsigned char* rw2b = p.ws + WS_RW2 + (role ? RW2_ARR : 0) + (size_t)(vcol * 64 + 4 * g) * 2;
    const unsigned char* ggb = p.ws + WS_RW2 + 2 * RW2_ARR + (size_t)(et * 64 + ev0) * 2;
    bf16x8 A0[4][2], A1[4][2]; u32x2 I0[4], I1[4];
    u32x4 G0 = {0u, 0u, 0u, 0u}, O0 = G0, G1, O1;
#define R2_LOAD(AA, II, cc) do { const size_t un_ = (size_t)(unit0 + 8 * ((cc) < NCH ? (cc) : NCH - 1)); \
        _Pragma("unroll") for (int m = 0; m < 4; ++m) { II[m] = *(const u32x2*)(rw2b + un_ * 8192 + 32 * m); \
            _Pragma("unroll") for (int s2 = 0; s2 < 2; ++s2) AA[m][s2] = *(const bf16x8*)(rw1b + un_ * 16384 + (16 * m * 64 + 32 * s2) * 2); } } while (0)
    R2_LOAD(A0, I0, 0); R2_LOAD(A1, I1, 1);
    G1 = *(const u32x4*)(ggb + (size_t)unit0 * 8192); O1 = *(const u32x4*)OB;
#pragma unroll 1
    for (int c = 0; c <= NCH; ++c) {
        const int cur = c & 1;
        bf16x8 A2[4][2]; u32x2 I2[4];
        R2_LOAD(A2, I2, c + 2);
        u32x4 G2, O2; { const int cn = c + 1 < NCH ? c + 1 : NCH - 1; G2 = *(const u32x4*)(ggb + (size_t)(unit0 + 8 * cn) * 8192); O2 = *(const u32x4*)(OB + (size_t)(64 * cn) * D); }
        if (c > 0) {
            const f32x4 y0 = *(const LAS f32x4*)(L + R2_YS + ((cur ^ 1) * 64 * 68 + et * 68 + ev0) * 4), y1 = *(const LAS f32x4*)(L + R2_YS + ((cur ^ 1) * 64 * 68 + et * 68 + ev0 + 4) * 4);
            float s1 = (y0[0] + y0[1]) + (y0[2] + y0[3]) + (y1[0] + y1[1]) + (y1[2] + y1[3]);
            s1 = sum8(s1); const float mean = s1 * (1.f / 64.f);
            const f32x4 d0 = y0 - mean, d1 = y1 - mean;
            float s2_ = (d0[0] * d0[0] + d0[1] * d0[1]) + (d0[2] * d0[2] + d0[3] * d0[3]) + (d1[0] * d1[0] + d1[1] * d1[1]) + (d1[2] * d1[2] + d1[3] * d1[3]);
            s2_ = sum8(s2_); const float rstd = rsqrtf(s2_ * (1.f / 64.f) + GN_EPS);
            const float gv[8] = {bflo(G0.x), bfhi(G0.x), bflo(G0.y), bfhi(G0.y), bflo(G0.z), bfhi(G0.z), bflo(G0.w), bfhi(G0.w)};
            const float ov[8] = {bflo(O0.x), bfhi(O0.x), bflo(O0.y), bfhi(O0.y), bflo(O0.z), bfhi(O0.z), bflo(O0.w), bfhi(O0.w)};
            float o[8];
#pragma unroll
            for (int i = 0; i < 4; ++i) { o[i] = ov[i] + (d0[i] * rstd * gn0[0][i] + gn1[0][i]) * gv[i]; o[4 + i] = ov[4 + i] + (d1[i] * rstd * gn0[1][i] + gn1[1][i]) * gv[4 + i]; }
            u32x4 w; w.x = pk2(o[0], o[1]); w.y = pk2(o[2], o[3]); w.z = pk2(o[4], o[5]); w.w = pk2(o[6], o[7]);
            *(u32x4*)(OB + (size_t)(64 * (c - 1)) * D) = w;
        }
        if (c < NCH) {
            bf16x8 bf_[2];
#pragma unroll
            for (int s2 = 0; s2 < 2; ++s2) bf_[s2] = *(const LAS bf16x8*)(L + R2_SV + cur * 64 * PS * 2 + (vcol * PS + 32 * s2 + 8 * g) * 2);
            f32x4 acc[4];
#pragma unroll
            for (int m = 0; m < 4; ++m) { acc[m] = (f32x4){bflo(I0[m].x), bfhi(I0[m].x), bflo(I0[m].y), bfhi(I0[m].y)};
#pragma unroll
                for (int s2 = 0; s2 < 2; ++s2) acc[m] = mfma16(A0[m][s2], bf_[s2], acc[m]); }
            if (role == 0) {
#pragma unroll
                for (int m = 0; m < 4; ++m) *(LAS u32x2*)(L + R2_SV + (cur ^ 1) * 64 * PS * 2 + (vcol * PS + 16 * m + 4 * g) * 2) = pk4(acc[m]);
            } else {
#pragma unroll
                for (int m = 0; m < 4; ++m)
#pragma unroll
                    for (int e = 0; e < 4; ++e) *(LAS float*)(L + R2_YS + (cur * 64 * 68 + (16 * m + 4 * g + e) * 68 + vcol) * 4) = acc[m][e];
            }
        }
        LDS_BARRIER();
#pragma unroll
        for (int m = 0; m < 4; ++m) { I0[m] = I1[m]; I1[m] = I2[m]; A0[m][0] = A1[m][0]; A0[m][1] = A1[m][1]; A1[m][0] = A2[m][0]; A1[m][1] = A2[m][1]; }
        G0 = G1; O0 = O1; G1 = G2; O1 = O2;
    }
#undef R2_LOAD
}

__device__ void rwkv_naive(const Params& p, int l, int bh, unsigned char* lds) {
    const int b = bh >> 3, h = bh & 7, tid = otid(), lane = tid & 63, wid = tid >> 6;
    const bf16_t* U = (const bf16_t*)(p.ws + WS_UAR);
    bf16_t* OB = (bf16_t*)(p.ws + WS_OAB);
    float* xs = (float*)lds;
    float* vr = xs + 32 * 256;
    float* vw = vr + 2048; float* vkk = vw + 2048; float* vbb = vkk + 2048; float* vk = vbb + 2048; float* vv = vk + 2048;
    float* gg = vv + 2048; float* bon = gg + 2048; float* ys = bon + 2048;
    const float* mu = p.in[I_MU] + l * R_COLS;
    const int hd = h * 64 + lane;
    const float w0 = p.in[I_W0][l * 512 + hd], a0 = p.in[I_A0][l * 512 + hd], kkc = p.in[I_KK][l * 512 + hd], kac = p.in[I_KA][l * 512 + hd], rkc = p.in[I_RK][l * 512 + hd];
    const float gng = p.in[I_GNG][l * 512 + hd], gnb = p.in[I_GNB][l * 512 + hd];
    const float mur = mu[hd], muk = mu[512 + hd], muv = mu[1024 + hd];
    const float* wup = p.in[I_WUP] + (size_t)l * 64 * 512 + hd; const float* aup = p.in[I_AUP] + (size_t)l * 64 * 512 + hd; const float* gup = p.in[I_GUP] + (size_t)l * 128 * 512 + hd;
    float S[8];
#pragma unroll
    for (int i = 0; i < 8; ++i) S[i] = 0.f;
    const int sv = tid >> 3, sq = tid & 7;
    for (int p0 = 0; p0 < LP; p0 += 32) {
        for (int idx = tid; idx < 32 * 256; idx += NTHREADS) {
            const int tt = idx >> 8, j = idx & 255, pos = p0 + tt; const size_t ro = (size_t)(b * LP + pos) * UARW;
            const float x = bf2f(U[ro + C_XW + j]); const float xp = pos > 0 ? bf2f(U[ro - UARW + C_XW + j]) : 0.f;
            float xv = x + (xp - x) * mu[1536 + j];
            if (j < 64) xv = tanhf(xv); else if (j >= 128) xv = sigmoidf_(xv);
            xs[idx] = xv;
        }
        __syncthreads();
        {
            float dw[4] = {0.f, 0.f, 0.f, 0.f}, da[4] = {0.f, 0.f, 0.f, 0.f}, dg[4] = {0.f, 0.f, 0.f, 0.f};
            for (int j = 0; j < 64; ++j) { const float w1 = wup[(size_t)j * 512], w2 = aup[(size_t)j * 512];
#pragma unroll
                for (int k = 0; k < 4; ++k) { dw[k] = fmaf(xs[(wid * 4 + k) * 256 + j], w1, dw[k]); da[k] = fmaf(xs[(wid * 4 + k) * 256 + 64 + j], w2, da[k]); } }
            for (int j = 0; j < 128; ++j) { const float w3 = gup[(size_t)j * 512];
#pragma unroll
                for (int k = 0; k < 4; ++k) dg[k] = fmaf(xs[(wid * 4 + k) * 256 + 128 + j], w3, dg[k]); }
#pragma unroll
            for (int k = 0; k < 4; ++k) {
                const int tt = wid * 4 + k, pos = p0 + tt; const size_t ro = (size_t)(b * LP + pos) * UARW;
                float r = bf2f(U[ro + C_R + hd]), kx = bf2f(U[ro + C_RK + hd]), vx = bf2f(U[ro + C_RV + hd]);
                if (pos > 0) { const float rp = bf2f(U[ro - UARW + C_R + hd]), kp = bf2f(U[ro - UARW + C_RK + hd]), vp = bf2f(U[ro - UARW + C_RV + hd]);
                    r += (rp - r) * mur; kx += (kp - kx) * muk; vx += (vp - vx) * muv; }
                else { r -= r * mur; kx -= kx * muk; vx -= vx * muv; }
                const float z = -(w0 + dw[k]); const float sp = fmaxf(z, 0.f) + log1pf(__expf(-fabsf(z)));
                const float logw = -sp - 0.5f; const float w = __expf(-__expf(logw));
                const float a = sigmoidf_(a0 + da[k]);
                float kk = kx * kkc; const float nrm = wave_sum(kk * kk); kk *= rsqrtf(fmaxf(nrm, 1e-24f));
                const float kmod = kx * (1.0f + (a - 1.0f) * kac);
                const float bsum = wave_sum(r * kmod * rkc);
                vr[tt * 64 + lane] = r; vw[tt * 64 + lane] = w; vkk[tt * 64 + lane] = kk; vbb[tt * 64 + lane] = kk * a; vk[tt * 64 + lane] = kmod; vv[tt * 64 + lane] = vx;
                gg[tt * 64 + lane] = dg[k]; bon[tt * 64 + lane] = bsum * vx;
            }
        }
        __syncthreads();
        for (int tt = 0; tt < 32; ++tt) {
            const f32x4 k0 = *(const f32x4*)(vkk + tt * 64 + sq * 8), k1 = *(const f32x4*)(vkk + tt * 64 + sq * 8 + 4);
            const f32x4 w0v = *(const f32x4*)(vw + tt * 64 + sq * 8), w1v = *(const f32x4*)(vw + tt * 64 + sq * 8 + 4);
            const f32x4 b0 = *(const f32x4*)(vbb + tt * 64 + sq * 8), b1 = *(const f32x4*)(vbb + tt * 64 + sq * 8 + 4);
            const f32x4 m0 = *(const f32x4*)(vk + tt * 64 + sq * 8), m1 = *(const f32x4*)(vk + tt * 64 + sq * 8 + 4);
            const f32x4 r0 = *(const f32x4*)(vr + tt * 64 + sq * 8), r1 = *(const f32x4*)(vr + tt * 64 + sq * 8 + 4);
            const float vt = vv[tt * 64 + sv];
            float sa = 0.f;
#pragma unroll
            for (int i = 0; i < 4; ++i) { sa = fmaf(S[i], k0[i], sa); sa = fmaf(S[4 + i], k1[i], sa); }
            sa += __shfl_xor(sa, 1); sa += __shfl_xor(sa, 2); sa += __shfl_xor(sa, 4);
            sa = -sa; float y = 0.f;
#pragma unroll
            for (int i = 0; i < 4; ++i) { S[i] = S[i] * w0v[i] + sa * b0[i] + vt * m0[i]; S[4 + i] = S[4 + i] * w1v[i] + sa * b1[i] + vt * m1[i];
                y = fmaf(S[i], r0[i], y); y = fmaf(S[4 + i], r1[i], y); }
            y += __shfl_xor(y, 1); y += __shfl_xor(y, 2); y += __shfl_xor(y, 4);
            if (sq == 0) ys[tt * 64 + sv] = y;
        }
        __syncthreads();
#pragma unroll
        for (int k = 0; k < 4; ++k) { const int tt = wid * 4 + k, pos = p0 + tt; const float y = ys[tt * 64 + lane];
            const float m = wave_sum(y) * (1.f / 64.f); const float dv = y - m; const float var = wave_sum(dv * dv) * (1.f / 64.f);
            const float o = (dv * rsqrtf(var + GN_EPS) * gng + gnb + bon[tt * 64 + lane]) * gg[tt * 64 + lane];
            OB[(size_t)(b * LP + pos) * D + 512 + hd] = (bf16_t)f2bf(o); }
        __syncthreads();
    }
}

__device__ __forceinline__ int pair_index(int a, int b) {   return a == 0 ? b - 1 : (a == 1 ? b + 1 : 5); }
__device__ __forceinline__ void pair_of(int idx, int& a, int& b) { a = idx < 3 ? 0 : (idx < 5 ? 1 : 2); b = idx < 3 ? idx + 1 : (idx < 5 ? idx - 1 : 3); }
__device__ __forceinline__ void ln1_rows(const Params& p, int l, unsigned char* lds, int row0, bool stage) {
    const int tid = otid(), lane = tid & 63, gw = row0 + 8 * (tid >> 6), NGW = 1, TEND = gw + 8;
    int* lcnt = (int*)(lds + 65536); int* lbase = lcnt + 32; int* rec = lcnt + 64;
    __syncthreads();
    if (tid < 32) lcnt[tid] = 0;
    float* wr_s = (float*)lds;
    if (stage) for (int i = tid; i < D * 16 / 4; i += NTHREADS) { const f32x4 w = ((const f32x4*)p.in[I_WROUTER])[i]; const int c = i >> 2, e0 = (i & 3) * 4;
        wr_s[(e0 + 0) * D + c] = w[0]; wr_s[(e0 + 1) * D + c] = w[1]; wr_s[(e0 + 2) * D + c] = w[2]; wr_s[(e0 + 3) * D + c] = w[3]; }
    __syncthreads();
    unsigned* cls_cnt = (unsigned*)(p.ws + WS_CTL) + CW_CLS + l * 512;
    int* lists = (int*)(p.ws + WS_LIST); f32x2* gl = (f32x2*)(p.ws + WS_LIST + 2 * MiB);
    const float* g = p.in[I_LN1G] + l * D; const float* bt = p.in[I_LN1B] + l * D;
    f32x4 vn[4];
    { const float* h0 = hrow(p, gw);
#pragma unroll
      for (int j = 0; j < 4; ++j) vn[j] = *(const f32x4*)(h0 + 4 * lane + 256 * j); }
    int nrec = 0;
    for (int r = gw; r < TEND; r += NGW) {
        f32x4 v[4];
#pragma unroll
        for (int j = 0; j < 4; ++j) v[j] = vn[j];
        { const float* h1 = hrow(p, r + NGW < TEND ? r + NGW : r);
#pragma unroll
          for (int j = 0; j < 4; ++j) vn[j] = *(const f32x4*)(h1 + 4 * lane + 256 * j); }
        if (is_dummy(r)) {
#pragma unroll
            for (int j = 0; j < 4; ++j) v[j] = (f32x4){0.f, 0.f, 0.f, 0.f};
            store_row(p, r, v, lane, true); continue; }
        ln_wave(v, g, bt, lane);
        store_row(p, r, v, lane, false);
        float lg[16];
#pragma unroll
        for (int e = 0; e < 16; ++e) lg[e] = 0.f;
#pragma unroll
        for (int e = 0; e < 16; ++e)
#pragma unroll
            for (int j = 0; j < 4; ++j) { const f32x4 w = *(const f32x4*)(wr_s + e * D + 4 * lane + 256 * j);
                lg[e] = fmaf(v[j][0], w[0], lg[e]); lg[e] = fmaf(v[j][1], w[1], lg[e]); lg[e] = fmaf(v[j][2], w[2], lg[e]); lg[e] = fmaf(v[j][3], w[3], lg[e]); }
        float mine = 0.f;
#pragma unroll
        for (int e = 0; e < 16; ++e) { const float rs = sum16(lg[e]); mine = (lane & 15) == e ? rs : mine; }
        mine += __shfl_xor(mine, 16); mine += __shfl_xor(mine, 32);
#pragma unroll
        for (int e = 0; e < 16; ++e) lg[e] = __builtin_bit_cast(float, __builtin_amdgcn_readlane(__builtin_bit_cast(int, mine), e));
        float s[16], sel[16];
#pragma unroll
        for (int e = 0; e < 16; ++e) { s[e] = sigmoidf_(lg[e]); sel[e] = s[e] + p.in[I_BROUTER][e]; }
        int gbest = 0; float gsc = -INFINITY;
#pragma unroll
        for (int gi = 0; gi < 4; ++gi) { float m1 = -INFINITY, m2 = -INFINITY;
#pragma unroll
            for (int j = 0; j < 4; ++j) { const float x = sel[gi * 4 + j]; if (x > m1) { m2 = m1; m1 = x; } else if (x > m2) m2 = x; }
            const float sc = m1 + m2; if (sc > gsc) { gsc = sc; gbest = gi; } }
        float sg[4], sgs[4];
#pragma unroll
        for (int j = 0; j < 4; ++j) { sg[j] = gbest == 0 ? sel[j] : (gbest == 1 ? sel[4 + j] : (gbest == 2 ? sel[8 + j] : sel[12 + j])); sgs[j] = gbest == 0 ? s[j] : (gbest == 1 ? s[4 + j] : (gbest == 2 ? s[8 + j] : s[12 + j])); }
        int j1 = 0;
#pragma unroll
        for (int j = 1; j < 4; ++j) if (sg[j] > sg[j1]) j1 = j;
        int j2 = j1 == 0 ? 1 : 0;
#pragma unroll
        for (int j = 0; j < 4; ++j) if (j != j1 && j != j2 && sg[j] > sg[j2]) j2 = j;
        const int ja = j1 < j2 ? j1 : j2, jb = j1 < j2 ? j2 : j1;
        float sa_ = 0.f, sb_ = 0.f;
#pragma unroll
        for (int j = 0; j < 4; ++j) { if (j == ja) sa_ = sgs[j]; if (j == jb) sb_ = sgs[j]; }
        const float inv = 1.0f / (sa_ + sb_);
        const int cls = gbest * 6 + pair_index(ja, jb);
        if (lane == 0) { const int loc = __hip_atomic_fetch_add(lcnt + cls, 1, __ATOMIC_RELAXED, __HIP_MEMORY_SCOPE_WORKGROUP); rec[(tid >> 6) * 32 + 2 * nrec] = r; rec[(tid >> 6) * 32 + 2 * nrec + 1] = (cls << 16) | loc; gl[r] = (f32x2){sa_ * inv, sb_ * inv}; }
        ++nrec;
    }
    __syncthreads();
    if (tid < 24) lbase[tid] = (int)atomicAdd(cls_cnt + 16 * tid, (unsigned)lcnt[tid]);
    __syncthreads();
    if (lane < nrec) { const int r = rec[(tid >> 6) * 32 + 2 * lane], cl = rec[(tid >> 6) * 32 + 2 * lane + 1]; const int cls = cl >> 16; lists[(size_t)cls * T + lbase[cls] + (cl & 0xffff)] = r; }
}


constexpr size_t WS_CH1 = 655360;
constexpr int CH1_NM = 260, CH1_NW = 260, CH1_NC = 96, CH1_NL = 260, CH1_TOT = CH1_NM + CH1_NW + CH1_NC + CH1_NL;
__device__ __forceinline__ void task_signal(unsigned* c0, unsigned* c1) {
    asm volatile("s_waitcnt vmcnt(0)" ::: "memory");
    __syncthreads();
    if (otid() == 0) { __builtin_amdgcn_fence(__ATOMIC_RELEASE, "agent"); asm volatile("s_waitcnt vmcnt(0)" ::: "memory");
        __hip_atomic_fetch_add(c0, 1u, __ATOMIC_RELAXED, __HIP_MEMORY_SCOPE_AGENT); if (c1) __hip_atomic_fetch_add(c1, 1u, __ATOMIC_RELAXED, __HIP_MEMORY_SCOPE_AGENT); }
}
__device__ __forceinline__ void task_wait(unsigned* c, unsigned target) {
    if (otid() == 0) { unsigned sp = 0; while (__hip_atomic_load(c, __ATOMIC_RELAXED, __HIP_MEMORY_SCOPE_AGENT) < target && ++sp < (1u << 24)) __builtin_amdgcn_s_sleep(2);
        __builtin_amdgcn_fence(__ATOMIC_ACQUIRE, "agent"); asm volatile("s_waitcnt vmcnt(0)" ::: "memory"); }
    __syncthreads();
}
__device__ __forceinline__ void conv_expert_items(const Params& p, int l, LAS unsigned char* lds, int it0, int it1);
__device__ __forceinline__ void chain1_phase(int l, unsigned char* lds, LAS unsigned char* ldsl, unsigned long long& pacc) {
    unsigned long long pt0 = 0;
#define C1P_B(k) do { if (PROBE_PHASE == (k)) pt0 = __builtin_amdgcn_s_memrealtime(); } while (0)
#define C1P_E(k) do { if (PROBE_PHASE == (k)) pacc += __builtin_amdgcn_s_memrealtime() - pt0; } while (0)
    int staged = 0;
    for (;;) {
        unsigned* chq = (unsigned*)(PP().ws + WS_CH1) + 1024 * l;
        volatile int* uw = (volatile int*)(lds + 144000);
        __syncthreads();
        if (otid() == 0) *uw = (int)atomicAdd(chq, 1u);
        __syncthreads();
        const int t = __builtin_amdgcn_readfirstlane(*uw);
        if (t >= CH1_TOT) break;
        if (t < CH1_NM) { const int pm = t >> 2, pn = t & 3;
            C1P_B(50); merge_unit(l, ldsl, pm, pn);
            task_signal(chq + 64 + pm, chq + 16); C1P_E(50);
        } else if (t < CH1_NM + CH1_NW) { const int u = t - CH1_NM, pm = u >> 2, pn = u & 3;
            C1P_B(54); task_wait(chq + 64 + pm, 4u); C1P_E(54);
            C1P_B(51); wout_unit(l, ldsl, pm, pn);
            task_signal(chq + 192 + pm, nullptr); C1P_E(51);
        } else if (t < CH1_NM + CH1_NW + CH1_NC) { const int u = t - CH1_NM - CH1_NW;
            C1P_B(54); task_wait(chq + 16, (unsigned)CH1_NM); C1P_E(54);
            C1P_B(52); conv_expert_items(PP(), l, ldsl, u * 128, u * 128 + 128); C1P_E(52);
        } else { const int u = t - CH1_NM - CH1_NW - CH1_NC, pm = u >> 2, qr = u & 3;
            C1P_B(54); task_wait(chq + 16, (unsigned)CH1_NM);
            task_wait(chq + 192 + pm, 4u); C1P_E(54);
            C1P_B(53); ln1_rows(PP(), l, lds, pm * 256 + qr * 64, staged == 0); staged = 1; C1P_E(53);
        }
    }
}

struct ClsTab { int cnt[24]; int tile0[25]; int row0[24]; };
__device__ __forceinline__ void build_cls_table(const Params& p, int l, int* tab  ) {
    if (otid() == 0) { const unsigned* c = (const unsigned*)(p.ws + WS_CTL) + CW_CLS + l * 512; int acc = 0;
        for (int i = 0; i < 24; ++i) { const int n = (int)__hip_atomic_load(c + 16 * i, __ATOMIC_RELAXED, __HIP_MEMORY_SCOPE_AGENT); tab[i] = n; tab[24 + i] = acc; acc += (n + 255) >> 8; }
        tab[48] = acc; }
    __syncthreads();
}
__device__ __forceinline__ int find_cls(const int* tab, int tile) { int c = 0;
#pragma unroll 1
    for (int i = 1; i < 24; ++i) if (tile >= tab[24 + i]) c = i;
    return c; }
__device__ __forceinline__ void moe_a_unit(int l, LAS unsigned char* lds, const int* tab, int tile, int pn) {
    const int tid = otid();
    unsigned voffB[2]; g8::make_voffB(voffB, D * 2, true);
    {
        const int cls = find_cls(tab, tile), rt = tile - tab[24 + cls], n = tab[cls];
        int ja, jb; pair_of(cls % 6, ja, jb); const int eslot = pn >> 2, e = (cls / 6) * 4 + (eslot ? jb : ja), jblk = pn & 3;
        unsigned voffA[2][2]; { const int* lists = (const int*)(PP().ws + WS_LIST);
#pragma unroll
        for (int i = 0; i < 2; ++i) { int R, C; g8::stage_rc(tid * 16 + i * 8192, R, C);
#pragma unroll
            for (int hh = 0; hh < 2; ++hh) { const int li = rt * 256 + R + hh * 128; const int tok = li < n ? lists[(size_t)cls * T + li] : 0;
                voffA[hh][i] = (unsigned)tok * (D * 2) + (unsigned)C * 2u; } } }
        g8::Acc acc; g8::zero_acc(acc);
        const char* Bb = (const char*)(PP().ws + WS_WEXP) + ((size_t)e * 1024 + jblk * 256) * D * 2;
        const g8::KSeg s = g8::seg1((const char*)(PP().ws + WS_HB), Bb, Bb + (size_t)128 * D * 2, D / 64);
        g8::kloop<true, false>(lds, acc, s, voffA, voffB, 0);
        EPI_COORDS();
        const int* lists = (const int*)(PP().ws + WS_LIST); const f32x2* gl = (const f32x2*)(PP().ws + WS_LIST + 2 * MiB); bf16_t* ACT = (bf16_t*)(PP().ws + WS_ACT);
        int tk[2][4]; float gt[2][4];
#pragma unroll
        for (int ai = 0; ai < 2; ++ai)
#pragma unroll
            for (int m = 0; m < 4; ++m) { const int li = rt * 256 + ai * 128 + wr * 64 + m * 16 + fr; tk[ai][m] = li < n ? lists[(size_t)cls * T + li] : -1; }
#pragma unroll
        for (int ai = 0; ai < 2; ++ai)
#pragma unroll
            for (int m = 0; m < 4; ++m) { const f32x2 g2 = gl[tk[ai][m] >= 0 ? tk[ai][m] : 0]; gt[ai][m] = tk[ai][m] >= 0 ? (eslot ? g2[1] : g2[0]) : 0.f; }
#pragma unroll
        for (int ai = 0; ai < 2; ++ai)
#pragma unroll
            for (int m = 0; m < 4; ++m) { const float gate = gt[ai][m];
                const f32x4 h1a = acc[ai][0][m][0], h1b = acc[ai][0][m][1], h3a = acc[ai][1][m][0], h3b = acc[ai][1][m][1];
                float o[8];
#pragma unroll
                for (int c = 0; c < 4; ++c) { o[c] = gate * (h1a[c] * sigmoidf_(h1a[c])) * h3a[c]; o[4 + c] = gate * (h1b[c] * sigmoidf_(h1b[c])) * h3b[c]; }
                u32x4 w; w.x = pk2(o[0], o[1]); w.y = pk2(o[2], o[3]); w.z = pk2(o[4], o[5]); w.w = pk2(o[6], o[7]);
                *(u32x4*)(ACT + (size_t)(tile * 256 + ai * 128 + wr * 64 + m * 16 + fr) * D + eslot * 512 + jblk * 128 + wc * 32 + 8 * fq) = w; }
    }
}
__device__ __forceinline__ void moe_b_unit(int l, LAS unsigned char* lds, const int* tab, int tile, int pn) {
    unsigned voffA[2][2], voffB[2]; g8::make_voff_contig(voffA, D * 2); g8::make_voffB(voffB, 512 * 2, false);
    {
        const int cls = find_cls(tab, tile), rt = tile - tab[24 + cls], n = tab[cls];
        int ja, jb; pair_of(cls % 6, ja, jb); const int ea = (cls / 6) * 4 + ja, eb = (cls / 6) * 4 + jb;
        g8::Acc acc; g8::zero_acc(acc);
        const char* At = (const char*)(PP().ws + WS_ACT) + (size_t)tile * 256 * D * 2;
        const char* W2 = (const char*)(PP().ws + WS_WEXP + 32 * MiB);
        const char* Ba = W2 + ((size_t)ea * 1024 + pn * 256) * 512 * 2; const char* Bb = W2 + ((size_t)eb * 1024 + pn * 256) * 512 * 2;
        g8::KSeg s2 = g8::seg1(At, Ba, Ba + (size_t)128 * 512 * 2, 16); s2.nt0 = 8; s2.A2 = At + 1024; s2.B02 = Bb; s2.B12 = Bb + (size_t)128 * 512 * 2;
        g8::kloop<false, true>(lds, acc, s2, voffA, voffB, 128 * D * 2);
        EPI_COORDS();
        const int* lists = (const int*)(PP().ws + WS_LIST);
        const int col0 = pn * 256 + wc * 32 + 4 * fq;
        int tk[2][4];
#pragma unroll
        for (int ai = 0; ai < 2; ++ai)
#pragma unroll
            for (int m = 0; m < 4; ++m) { const int li = rt * 256 + ai * 128 + wr * 64 + m * 16 + fr; tk[ai][m] = li < n ? lists[(size_t)cls * T + li] : -1; }
#pragma unroll
        for (int ai = 0; ai < 2; ++ai) { asm volatile("" ::: "memory");
            f32x4 pre[4][2][2]; float* hr[4];
#pragma unroll
            for (int m = 0; m < 4; ++m) { hr[m] = hrow(PP(), tk[ai][m] >= 0 ? tk[ai][m] : 0) + col0;
#pragma unroll
                for (int bj = 0; bj < 2; ++bj)
#pragma unroll
                    for (int nn = 0; nn < 2; ++nn) pre[m][bj][nn] = *(const f32x4*)(hr[m] + bj * 128 + nn * 16); }
#pragma unroll
            for (int m = 0; m < 4; ++m) if (tk[ai][m] >= 0) {
#pragma unroll
                for (int bj = 0; bj < 2; ++bj)
#pragma unroll
                    for (int nn = 0; nn < 2; ++nn) *(f32x4*)(hr[m] + bj * 128 + nn * 16) = pre[m][bj][nn] * ALPHA + acc[ai][bj][m][nn]; } }
    }
}

__device__ __forceinline__ void chain2_phase(int l, unsigned char* lds, LAS unsigned char* ldsl, const int* tab) {
    const int ntiles = tab[48], nA = 8 * ntiles, ntot = nA + 4 * ntiles;
    for (;;) {
        unsigned* chq = (unsigned*)(PP().ws + WS_CH1) + 1024 * l + 512;
        volatile int* uw = (volatile int*)(lds + 144000);
        __syncthreads();
        if (otid() == 0) *uw = (int)atomicAdd(chq, 1u);
        __syncthreads();
        const int t = __builtin_amdgcn_readfirstlane(*uw);
        if (t >= ntot) break;
        if (t < nA) { const int tile = t >> 3;
            moe_a_unit(l, ldsl, tab, tile, t & 7);
            task_signal(chq + 16 + tile, nullptr);
        } else { const int u = t - nA, tile = u >> 2;
            task_wait(chq + 16 + tile, 8u);
            moe_b_unit(l, ldsl, tab, tile, u & 3);
        }
    }
}
__device__ __forceinline__ void ln2_phase(const Params& p, int l) {
    const int tid = otid(), lane = tid & 63, gw = obid() * NWAVES + (tid >> 6), NGW = gridDim.x * NWAVES;
    const float* g = p.in[I_LN2G] + l * D; const float* bt = p.in[I_LN2B] + l * D;
    for (int r = gw; r < T; r += NGW) {
        f32x4 v[4];
        if (is_dummy(r)) {
#pragma unroll
            for (int j = 0; j < 4; ++j) v[j] = (f32x4){0.f, 0.f, 0.f, 0.f};
            store_row(p, r, v, lane, true); continue; }
        const float* hr = hrow(p, r);
#pragma unroll
        for (int j = 0; j < 4; ++j) v[j] = *(const f32x4*)(hr + 4 * lane + 256 * j);
        ln_wave(v, g, bt, lane);
        store_row(p, r, v, lane, false);
    }
}


#define XB_TMO      128
#define XB_XCNT(j)  (256  + 64 * (j))
#define XB_XSUB(j)  (1280 + 64 * (j))
#define XB_XGEN(j)  (2304 + 64 * (j))
#define XB_TOP      3328
#define XB_TOPGEN   3392
#define XCD_BAR_WORDS 3456
#define XB_SPIN_CAP (1u << 22)
constexpr size_t WS_BAR = 8192;
constexpr int LDS_BARST = LDS_BYTES - 16;
__device__ __forceinline__ unsigned xb_ld(unsigned* p)              { return __hip_atomic_load(p, __ATOMIC_RELAXED, __HIP_MEMORY_SCOPE_AGENT); }
__device__ __forceinline__ unsigned xb_add(unsigned* p, unsigned v) { return __hip_atomic_fetch_add(p, v, __ATOMIC_RELAXED, __HIP_MEMORY_SCOPE_AGENT); }
__device__ __forceinline__ unsigned xb_xcc_id() { return (unsigned)__builtin_amdgcn_s_getreg((3 << 11) | 20) & 0xFu; }
#define XB_SPIN(cond, bar) do { unsigned _sp = 0; while (cond) { __builtin_amdgcn_s_sleep(1); \
    if ((++_sp & 255u) == 0u) { if (xb_ld(&(bar)[XB_TMO])) break; if (_sp > XB_SPIN_CAP) { atomicAdd(&(bar)[XB_TMO], 1u); break; } } } } while (0)
__device__ __forceinline__ void xcd_barrier_complete(unsigned* bar, unsigned x, unsigned& nloc, unsigned& nx) {
    const unsigned G = gridDim.x * gridDim.y * gridDim.z;
    unsigned sum, cnt, mine, sp = 0u;
    for (;;) {
        sum = 0u; cnt = 0u; mine = 0u;
#pragma unroll
        for (unsigned j = 0; j < 16; ++j) { const unsigned c = xb_ld(&bar[XB_XCNT(j)]); sum += c; cnt += (c > 0u) ? 1u : 0u; mine = (j == x) ? c : mine; }
        if (sum == G) break;
        __builtin_amdgcn_s_sleep(1);
        if ((++sp & 255u) == 0u) { if (xb_ld(&bar[XB_TMO])) break; if (sp > XB_SPIN_CAP) { atomicAdd(&bar[XB_TMO], 1u); break; } }
    }
    nloc = mine > 0u ? mine : 1u; nx = cnt > 0u ? cnt : 1u;
}
__device__ __forceinline__ void xcd_barrier(unsigned* bar, volatile LAS unsigned* st) {
    asm volatile("s_waitcnt vmcnt(0)" ::: "memory");
    __syncthreads();
    if (threadIdx.x == 0) {
        __builtin_amdgcn_s_waitcnt(0);
        const unsigned x = xb_xcc_id();
        unsigned nloc = st[0], nx = st[1];
        if (nloc == 0u) { xcd_barrier_complete(bar, x, nloc, nx); st[0] = nloc; st[1] = nx; }
        const unsigned old = xb_add(&bar[XB_XSUB(x)], 1u);
        const unsigned gen = old / nloc;
        if (old + 1u == (gen + 1u) * nloc) {
            __builtin_amdgcn_fence(__ATOMIC_RELEASE, "agent");
            asm volatile("s_waitcnt vmcnt(0)" ::: "memory");
            const unsigned og = xb_add(&bar[XB_TOP], 1u);
            const unsigned tg = og / nx;
            if (og + 1u == (tg + 1u) * nx) xb_add(&bar[XB_TOPGEN], 1u);
            else XB_SPIN(xb_ld(&bar[XB_TOPGEN]) == tg, bar);
            __builtin_amdgcn_fence(__ATOMIC_ACQUIRE, "agent");
            xb_add(&bar[XB_XGEN(x)], 1u);
            asm volatile("s_waitcnt vmcnt(0)" ::: "memory");
        } else {
            XB_SPIN(xb_ld(&bar[XB_XGEN(x)]) == gen, bar);
            __builtin_amdgcn_fence(__ATOMIC_ACQUIRE, "agent");
            asm volatile("s_waitcnt vmcnt(0)" ::: "memory");
        }
    }
    __syncthreads();
}

__global__ void __launch_bounds__(NTHREADS, 2) mega(Params p_unused) {
    extern __shared__ __attribute__((aligned(16))) unsigned char lds[];
    cg::grid_group grid = cg::this_grid();
    volatile LAS unsigned* barst = (volatile LAS unsigned*)((LAS unsigned char*)lds + LDS_BARST);
    { unsigned* bar0 = (unsigned*)(PP().ws + WS_BAR);
      if (threadIdx.x == 0) { barst[0] = 0u; barst[1] = 0u; (void)xb_add(bar0 + XB_XCNT(xb_xcc_id()), 1u); } }
    __syncthreads();
#define GBAR() xcd_barrier((unsigned*)(PP().ws + WS_BAR), barst)
    unsigned long long pr_t0 = 0, pr_acc = 0;
#define PH_BEGIN(k) do { if (PROBE_PHASE == (k)) pr_t0 = __builtin_amdgcn_s_memrealtime(); } while (0)
#define PH_END(k) do { if (PROBE_PHASE == (k)) pr_acc += __builtin_amdgcn_s_memrealtime() - pr_t0; } while (0)
#define LDSG() (lds + ozero())
#define LDSL() ((LAS unsigned char*)lds)

    PH_BEGIN(0);
    conv_small_weights(PP(), LDSL());
    ln_in_phase(PP());
    if (gridDim.y == 0x7fffffffu) grid.sync();
    GBAR();
    PH_END(0);
#pragma unroll 1
    for (int l = 0; l < DEPTH; ++l) {
        PH_BEGIN(1);
        inproj_phase(PP(), l, LDSL());
        GBAR();
        PH_END(1); PH_BEGIN(2);
        {
            unsigned* qctr = (unsigned*)(PP().ws + WS_CTL) + CW_R1Q + 2 * l;
            volatile int* uw = (volatile int*)(LDSG() + AT_UNIT);
            int ndone = 0;
            for (;;) {
                __syncthreads();
                if (otid() == 0) *uw = (int)atomicAdd(qctr, 1u);
                __syncthreads();
                const int u = *uw;
                if (u >= INP_TAIL + BATCH * NCH * 8) break;
                if (u < INP_TAIL) { inproj_tail_unit(l, LDSL(), u); continue; }
                if (PROBE_PHASE == 30) pr_t0 = __builtin_amdgcn_s_memrealtime();
                rwkv_prep_unit(PP(), l, u - INP_TAIL, LDSG(), pr_acc); ++ndone;
                if (PROBE_PHASE == 30) pr_acc += __builtin_amdgcn_s_memrealtime() - pr_t0;
            }
            asm volatile("s_waitcnt vmcnt(0)" ::: "memory");
            __syncthreads();
            if (otid() == 0 && ndone > 0) { __builtin_amdgcn_fence(__ATOMIC_RELEASE, "agent"); asm volatile("s_waitcnt vmcnt(0)" ::: "memory"); __hip_atomic_fetch_add(qctr + 1, (unsigned)ndone, __ATOMIC_RELAXED, __HIP_MEMORY_SCOPE_AGENT); }
            const int bid = obid();
            if (bid < 32) {
                if (otid() == 0) { unsigned sp = 0; while (__hip_atomic_load(qctr + 1, __ATOMIC_RELAXED, __HIP_MEMORY_SCOPE_AGENT) < (unsigned)(BATCH * NCH * 8) && ++sp < (1u << 26)) __builtin_amdgcn_s_sleep(4);
                    __builtin_amdgcn_fence(__ATOMIC_ACQUIRE, "agent"); asm volatile("s_waitcnt vmcnt(0)" ::: "memory"); }
                __syncthreads();
                rwkv_scan(PP(), l, bid, LDSG());
            }
            attn_phase(PP(), l, LDSG(), pr_acc);
        }
        GBAR();
        PH_END(2); PH_BEGIN(4);
        chain1_phase(l, LDSG(), LDSL(), pr_acc);
        GBAR();
        PH_END(4); PH_BEGIN(7);
        { int toff = 140 * 1024; asm volatile("" : "+s"(toff)); int* tab = (int*)(lds + toff);
          build_cls_table(PP(), l, tab);
          chain2_phase(l, LDSG(), LDSL(), tab); }
        GBAR();
        PH_END(8); PH_BEGIN(9);
        ln2_phase(PP(), l);
        if (l + 1 < DEPTH) GBAR();
        PH_END(9);
    }
    if (PROBE_PHASE >= 0 && blockIdx.x == PROBE_BLOCK && threadIdx.x == 0) { const unsigned long long t = __builtin_amdgcn_s_memrealtime(); while (__builtin_amdgcn_s_memrealtime() - t < pr_acc) __builtin_amdgcn_s_sleep(8); }
}

extern "C" void kernel_launch(void* const* d_in, const int* in_sizes, int n_in, void* d_out, int out_size,
                              void* d_ws, size_t ws_size, hipStream_t stream) {
    static int grid_blocks = 0;
    if (grid_blocks == 0) {
        int dev = 0, cus = 0, per_cu = 0;
        if (n_in != 29 || ws_size < WS_END || out_size != BATCH * SEQ * D) { fprintf(stderr, "kernel_launch: unexpected problem (n_in %d, ws %zu, out %d)\n", n_in, ws_size, out_size); grid_blocks = -1; return; }
        (void)hipGetDevice(&dev);
        (void)hipDeviceGetAttribute(&cus, hipDeviceAttributeMultiprocessorCount, dev);
        (void)hipFuncSetAttribute((const void*)mega, hipFuncAttributeMaxDynamicSharedMemorySize, LDS_BYTES);
        (void)hipOccupancyMaxActiveBlocksPerMultiprocessor(&per_cu, (const void*)mega, NTHREADS, LDS_BYTES);
        if (per_cu < 1) { fprintf(stderr, "occupancy query returned %d\n", per_cu); grid_blocks = -1; return; }
        grid_blocks = cus;
    }
    if (grid_blocks < 0) return;
    (void)hipMemsetAsync((char*)d_ws + WS_CTL, 0, 32768, stream);
    (void)hipMemsetAsync((char*)d_ws + WS_CH1, 0, 16384, stream);
    Params p{};
    for (int i = 0; i < 29; ++i) p.in[i] = (const float*)d_in[i];
    p.out = (float*)d_out; p.ws = (unsigned char*)d_ws;
    void* args[] = {&p};
    hipError_t e = hipLaunchCooperativeKernel((const void*)mega, dim3(grid_blocks), dim3(NTHREADS), args, LDS_BYTES, stream);
    if (e != hipSuccess) fprintf(stderr, "cooperative launch failed: %s (grid %d)\n", hipGetErrorString(e), grid_blocks);
}
```

```cpp
#include <hip/hip_runtime.h>
#include <hip/hip_cooperative_groups.h>
#include <cstdio>
#include <cstdint>
namespace cg = cooperative_groups;

#define LAS __attribute__((address_space(3)))
typedef unsigned short bf16_t;
typedef short bf16x8 __attribute__((ext_vector_type(8)));
typedef float f32x4 __attribute__((ext_vector_type(4)));
typedef float f32x2 __attribute__((ext_vector_type(2)));
typedef unsigned u32x4 __attribute__((ext_vector_type(4)));
typedef unsigned u32x2 __attribute__((ext_vector_type(2)));

constexpr int NTHREADS = 512, NWAVES = 8;
constexpr int D = 1024, BATCH = 4, SEQ = 4096, DEPTH = 2;
constexpr int LP = 4160;
constexpr int T = BATCH * LP;
constexpr int NCH = LP / 64;
constexpr int PADM = 48;
constexpr int A_COLS = 1064, R_COLS = 1792, IN_COLS = 4904;
constexpr int UA = 1280;
constexpr int UARW = 3072;
constexpr int NIN = 5120;
constexpr float LN_EPS = 1e-5f, GN_EPS = 64e-5f;
constexpr float ALPHA = 1.41421356237309515f;
constexpr int C_Q = 0, C_K = 512, C_V = 640, C_QI = 768, C_KI = 1024, C_WI = 1056;
constexpr int C_R = UA, C_RK = UA + 512, C_RV = UA + 1024, C_XW = UA + 1536, C_XA = UA + 1600, C_XG = UA + 1664;

constexpr size_t MiB = 1u << 20;
constexpr size_t WS_CTL = 0;
constexpr size_t WS_HM = 1 * MiB;
constexpr size_t WS_WSMALL = 2 * MiB;
constexpr size_t WSMALL_LAYER = 14 * MiB;
constexpr size_t WS_HB = 30 * MiB;
constexpr size_t WS_UAR = 63 * MiB;
constexpr size_t WS_GATES = 161 * MiB;
constexpr size_t WS_OAB = 226 * MiB;
constexpr size_t WS_LIST = WS_GATES + 48 * MiB;
constexpr size_t WS_END = 308 * MiB;
constexpr size_t WS_MERGED = WS_UAR;
constexpr size_t WS_ACT = WS_UAR + 33 * MiB;
constexpr size_t WS_WEXP = WS_GATES;
constexpr int ACT_ROWS_MAX = 16448 + 24 * 256;
static_assert(WS_ACT + (size_t)ACT_ROWS_MAX * 2048 <= WS_GATES, "act fits");
constexpr int CW_CLS = 1024;

constexpr int LDS_BYTES = 155648;

struct Params {
    const float* in[29];
    float* out;
    unsigned char* ws;
};
enum { I_X = 0, I_META, I_LNIN_G, I_LNIN_B, I_WIN, I_BGATE, I_MU, I_W0, I_WUP, I_A0, I_AUP, I_GUP, I_KK, I_KA, I_RK, I_GNG, I_GNB,
       I_WBA, I_WBB, I_WOUT, I_LN1G, I_LN1B, I_LN2G, I_LN2B, I_WROUTER, I_BROUTER, I_WEXP1, I_WEXP3, I_WEXP2 };

__device__ __forceinline__ int otid() { int t = threadIdx.x; asm volatile("" : "+v"(t)); return t; }
__device__ __forceinline__ const char* uptr(const char* p) { const unsigned long long v = (unsigned long long)p; const unsigned lo = __builtin_amdgcn_readfirstlane((unsigned)v), hi = __builtin_amdgcn_readfirstlane((unsigned)(v >> 32)); return (const char*)(((unsigned long long)hi << 32) | lo); }
__device__ __forceinline__ int ozero() { int z = 0; asm volatile("" : "+s"(z)); return z; }
__device__ __forceinline__ int obid() { int b = blockIdx.x; asm volatile("" : "+s"(b)); return b; }
typedef __bf16 bf16x2_t __attribute__((ext_vector_type(2)));
__device__ __forceinline__ unsigned f2bf(float f) { return (unsigned)__builtin_bit_cast(unsigned short, (__bf16)f); }
__device__ __forceinline__ unsigned pk2(float lo, float hi) { const f32x2 v = {lo, hi}; return __builtin_bit_cast(unsigned, __builtin_convertvector(v, bf16x2_t)); }
template <int CTRL> __device__ __forceinline__ float dpp_f(float v) { return __builtin_bit_cast(float, __builtin_amdgcn_update_dpp(0, __builtin_bit_cast(int, v), CTRL, 0xF, 0xF, true)); }
__device__ __forceinline__ float sum8(float v) { v += dpp_f<0xB1>(v); v += dpp_f<0x4E>(v); v += dpp_f<0x141>(v); return v; }
__device__ __forceinline__ float sum16(float v) { v = sum8(v); v += dpp_f<0x140>(v); return v; }
__device__ __forceinline__ float bf2f(unsigned short b) { return __builtin_bit_cast(float, (unsigned)b << 16); }
__device__ __forceinline__ float bflo(unsigned w) { return __builtin_bit_cast(float, w << 16); }
__device__ __forceinline__ float bfhi(unsigned w) { return __builtin_bit_cast(float, w & 0xffff0000u); }
__device__ __forceinline__ float wave_sum(float v) { v = sum16(v); v += __shfl_xor(v, 16); v += __shfl_xor(v, 32); return v; }
__device__ __forceinline__ float wave_max(float v) {
#pragma unroll
    for (int o = 1; o < 64; o <<= 1) v = fmaxf(v, __shfl_xor(v, o));
    return v;
}
__device__ __forceinline__ float sigmoidf_(float x) { return __builtin_amdgcn_rcpf(1.0f + __expf(-x)); }
__device__ __forceinline__ float* hrow(const Params& p, int r) {
    const int b = r / LP, pos = r - b * LP;
    return pos >= 64 ? p.out + ((size_t)(b * SEQ + (pos - 64)) << 10) : (float*)(p.ws + WS_HM) + ((size_t)(b * 64 + pos) << 10);
}
__device__ __forceinline__ bool is_dummy(int r) { return (r % LP) < PADM; }

__device__ __forceinline__ void transpose_item(const float* src, int ld_src, int col0, int nvalid, bf16_t* dst  , int ld_dst, LAS float* scr, int lane) {
    const int kr = lane >> 3, c4 = (lane & 7) * 4;
    f32x4 v[8];
#pragma unroll
    for (int i = 0; i < 8; ++i) v[i] = *(const f32x4*)(src + (size_t)(8 * i + kr) * ld_src + col0 + c4);
#pragma unroll
    for (int i = 0; i < 8; ++i) { LAS float* w = scr + (8 * i + kr) * 33 + c4;
        w[0] = c4 + 0 < nvalid ? v[i][0] : 0.f; w[1] = c4 + 1 < nvalid ? v[i][1] : 0.f; w[2] = c4 + 2 < nvalid ? v[i][2] : 0.f; w[3] = c4 + 3 < nvalid ? v[i][3] : 0.f; }
    asm volatile("s_waitcnt lgkmcnt(0)" ::: "memory");
    const int ch = lane & 7;
#pragma unroll
    for (int j = 0; j < 4; ++j) { const int n = (lane >> 3) + 8 * j; const LAS float* s = scr + (8 * ch) * 33 + n;
        u32x4 o; o.x = pk2(s[0 * 33], s[1 * 33]); o.y = pk2(s[2 * 33], s[3 * 33]); o.z = pk2(s[4 * 33], s[5 * 33]); o.w = pk2(s[6 * 33], s[7 * 33]);
        *(u32x4*)(dst + (size_t)n * ld_dst + 8 * ch) = o; }
    asm volatile("s_waitcnt lgkmcnt(0)" ::: "memory");
}

namespace g8 {
constexpr int BM = 256, BK = 64, HALF = 128, HTB = HALF * BK * 2, STAGE_BYTES = 8 * HTB;
__host__ __device__ __forceinline__ int lds_byte(int r, int c) { const int st = (r >> 4) * 2 + (c >> 5), rr = r & 15, cc = c & 31, ob = rr * 64 + cc * 2; return st * 1024 + (ob ^ (((ob >> 9) & 1) << 5)); }
__host__ __device__ __forceinline__ void stage_rc(int b, int& R, int& C) { const int st = b / 1024, sb = b % 1024, swz = sb ^ (((sb >> 9) & 1) << 5); R = (st >> 1) * 16 + swz / 64; C = (st & 1) * 32 + (swz % 64) / 2; }
__host__ __device__ __forceinline__ int perm32(int rho) { const int n = rho >> 4, i = rho & 15; return 8 * (i >> 2) + 4 * n + (i & 3); }

struct KSeg {
    const char* A;
    const char* B0;
    const char* B1;
    int nt;
    int nt0;
    const char* A2;
    const char* B02;
    const char* B12;
};
__device__ __forceinline__ KSeg seg1(const char* A, const char* B0, const char* B1, int nt) { KSeg s; s.A = A; s.B0 = B0; s.B1 = B1; s.nt = nt; s.nt0 = nt; s.A2 = A; s.B02 = B0; s.B12 = B1; return s; }
typedef f32x4 Acc[2][2][4][2];

template <bool GATHER, bool TWOSEG>
__device__ __forceinline__ void kloop(LAS unsigned char* lds, Acc& acc, const KSeg s, const unsigned (&voffA)[2][2], const unsigned (&voffB)[2], const unsigned hstepA) {
    int tid = threadIdx.x; asm volatile("" : "+v"(tid));
    const int wid = __builtin_amdgcn_readfirstlane(tid >> 6), lane = tid & 63, wr = wid >> 2, wc = wid & 3, fr = lane & 15, fq = lane >> 4;
    const unsigned ldsw = (unsigned)wid * 1024u;
    const int aoff = lds_byte(wr * 64 + fr, fq * 8), boff = lds_byte(wc * 32 + fr, fq * 8);
    const int nt = __builtin_amdgcn_readfirstlane(s.nt);
#define G8_SA(b, h) (((b) * 2 + (h)) * HTB)
#define G8_SB(b, h) ((4 + (b) * 2 + (h)) * HTB)
#define G8_STAGE(bufoff, gbase, voff) do { _Pragma("unroll") for (int _i = 0; _i < 2; ++_i) \
        __builtin_amdgcn_global_load_lds((const unsigned*)((const char*)(gbase) + (voff)[_i]), (LAS unsigned*)(lds + (bufoff) + ldsw + _i * 8192), 16, 0, 0); } while (0)
#define G8_LDA(dst, b, h) do { _Pragma("unroll") for (int m = 0; m < 4; ++m) _Pragma("unroll") for (int k = 0; k < 2; ++k) dst[m][k] = *(const LAS bf16x8*)(lds + G8_SA(b, h) + aoff + m * 2048 + k * 1024); } while (0)
#define G8_LDB(dst, b, h) do { _Pragma("unroll") for (int n = 0; n < 2; ++n) _Pragma("unroll") for (int k = 0; k < 2; ++k) dst[n][k] = *(const LAS bf16x8*)(lds + G8_SB(b, h) + boff + n * 2048 + k * 1024); } while (0)
#define G8_MMA(ai, bj, At, Bt) do { __builtin_amdgcn_s_setprio(1); _Pragma("unroll") for (int m = 0; m < 4; ++m) _Pragma("unroll") for (int n = 0; n < 2; ++n) _Pragma("unroll") for (int k = 0; k < 2; ++k) \
        acc[ai][bj][m][n] = __builtin_amdgcn_mfma_f32_16x16x32_bf16(Bt[n][k], At[m][k], acc[ai][bj][m][n], 0, 0, 0); __builtin_amdgcn_s_setprio(0); } while (0)
#define G8_WAIT_V(n) asm volatile("s_waitcnt vmcnt(" #n ")" ::: "memory")
#define G8_WAIT_L(n) asm volatile("s_waitcnt lgkmcnt(" #n ")" ::: "memory")
#define G8_BAR __builtin_amdgcn_s_barrier()
#define G8_SCHED __builtin_amdgcn_sched_barrier(0)
    bf16x8 At[4][2], B0[2][2], B1[2][2];
    const char* pA = uptr(s.A); const char* pB0 = uptr(s.B0); const char* pB1 = uptr(s.B1);
    constexpr int KS = BK * 2;
    const int nt0 = TWOSEG ? s.nt0 : 0; const char* qA = TWOSEG ? uptr(s.A2 - (size_t)nt0 * KS) : pA; const char* qB0 = TWOSEG ? uptr(s.B02 - (size_t)nt0 * KS) : pB0; const char* qB1 = TWOSEG ? uptr(s.B12 - (size_t)nt0 * KS) : pB1;
#define G8_TA(t) ((TWOSEG ? ((t) < nt0 ? pA : qA) : pA) + (size_t)(t) * KS)
#define G8_TB0(t) ((TWOSEG ? ((t) < nt0 ? pB0 : qB0) : pB0) + (size_t)(t) * KS)
#define G8_TB1(t) ((TWOSEG ? ((t) < nt0 ? pB1 : qB1) : pB1) + (size_t)(t) * KS)
#define G8_VA1 voffA[GATHER ? 1 : 0]
#define G8_H1(ptr) ((ptr) + (GATHER ? 0u : hstepA))
    G8_STAGE(G8_SB(0, 0), pB0, voffB); G8_STAGE(G8_SA(0, 0), pA, voffA[0]); G8_STAGE(G8_SB(0, 1), pB1, voffB); G8_STAGE(G8_SA(0, 1), G8_H1(pA), G8_VA1);
    if (wr == 1) G8_BAR;
    G8_WAIT_V(4); G8_BAR;
    G8_STAGE(G8_SB(1, 0), pB0 + KS, voffB); G8_STAGE(G8_SA(1, 0), pA + KS, voffA[0]); G8_STAGE(G8_SB(1, 1), pB1 + KS, voffB);
    G8_WAIT_V(6); G8_BAR;
    for (int t = 0; t < nt - 2; t += 2) {
        const char* a1 = G8_TA(t + 1);
        const char* a2 = G8_TA(t + 2); const char* b02 = G8_TB0(t + 2); const char* b12 = G8_TB1(t + 2);
        const char* a3 = G8_TA(t + 3); const char* b03 = G8_TB0(t + 3); const char* b13 = G8_TB1(t + 3);
        G8_LDB(B0, 0, 0); G8_SCHED; G8_LDA(At, 0, 0); G8_STAGE(G8_SA(1, 1), G8_H1(a1), G8_VA1);
        G8_WAIT_L(8); G8_BAR; G8_WAIT_L(0); G8_MMA(0, 0, At, B0); G8_BAR; G8_SCHED;
        G8_LDB(B1, 0, 1); G8_STAGE(G8_SB(0, 0), b02, voffB);
        G8_BAR; G8_WAIT_L(0); G8_MMA(0, 1, At, B1); G8_BAR;
        G8_LDA(At, 0, 1); G8_STAGE(G8_SA(0, 0), a2, voffA[0]);
        G8_BAR; G8_WAIT_L(0); G8_MMA(1, 0, At, B0); G8_BAR; G8_SCHED;
        G8_STAGE(G8_SB(0, 1), b12, voffB);
        G8_WAIT_V(6); G8_BAR; G8_MMA(1, 1, At, B1); G8_BAR;
        G8_LDB(B0, 1, 0); G8_SCHED; G8_LDA(At, 1, 0); G8_STAGE(G8_SA(0, 1), G8_H1(a2), G8_VA1);
        G8_WAIT_L(8); G8_BAR; G8_WAIT_L(0); G8_MMA(0, 0, At, B0); G8_BAR; G8_SCHED;
        G8_LDB(B1, 1, 1); G8_STAGE(G8_SB(1, 0), b03, voffB);
        G8_BAR; G8_WAIT_L(0); G8_MMA(0, 1, At, B1); G8_BAR;
        G8_LDA(At, 1, 1); G8_STAGE(G8_SA(1, 0), a3, voffA[0]);
        G8_BAR; G8_WAIT_L(0); G8_MMA(1, 0, At, B0); G8_BAR; G8_SCHED;
        G8_STAGE(G8_SB(1, 1), b13, voffB);
        G8_WAIT_V(6); G8_BAR; G8_MMA(1, 1, At, B1); G8_BAR;
    }
    { const char* a1 = G8_TA(nt - 1);
      G8_LDB(B0, 0, 0); G8_LDA(At, 0, 0); G8_STAGE(G8_SA(1, 1), G8_H1(a1), G8_VA1);
      G8_BAR; G8_WAIT_L(0); G8_MMA(0, 0, At, B0); G8_BAR;
      G8_LDB(B1, 0, 1); G8_BAR; G8_WAIT_L(0); G8_MMA(0, 1, At, B1); G8_BAR;
      G8_LDA(At, 0, 1); G8_WAIT_V(4); G8_BAR; G8_WAIT_L(0); G8_MMA(1, 0, At, B0); G8_MMA(1, 1, At, B1); G8_BAR; }
    { G8_LDB(B0, 1, 0); G8_LDA(At, 1, 0); G8_WAIT_V(2); G8_BAR; G8_WAIT_L(0); G8_MMA(0, 0, At, B0); G8_BAR;
      G8_LDB(B1, 1, 1); G8_WAIT_V(0); G8_BAR; G8_WAIT_L(0); G8_MMA(0, 1, At, B1); G8_BAR;
      G8_LDA(At, 1, 1); G8_BAR; G8_WAIT_L(0); G8_MMA(1, 0, At, B0); G8_MMA(1, 1, At, B1); G8_BAR; }
    if (wr == 0) G8_BAR;
#undef G8_TA
#undef G8_VA1
#undef G8_H1
#undef G8_TB0
#undef G8_TB1
#undef G8_SA
#undef G8_SB
#undef G8_STAGE
#undef G8_LDA
#undef G8_LDB
#undef G8_MMA
#undef G8_WAIT_V
#undef G8_WAIT_L
#undef G8_BAR
#undef G8_SCHED
}
template <bool GATHER, bool TWOSEG>
__device__ __forceinline__ void kstream(LAS unsigned char* lds, Acc& acc, const KSeg s, const KSeg nx, const bool first, const unsigned (&voffA)[2][2], const unsigned (&voffB)[2], const unsigned hstepA) {
    int tid = threadIdx.x; asm volatile("" : "+v"(tid));
    const int wid = __builtin_amdgcn_readfirstlane(tid >> 6), lane = tid & 63, wr = wid >> 2, wc = wid & 3, fr = lane & 15, fq = lane >> 4;
    const unsigned ldsw = (unsigned)wid * 1024u;
    const int aoff = lds_byte(wr * 64 + fr, fq * 8), boff = lds_byte(wc * 32 + fr, fq * 8);
    const int nt = __builtin_amdgcn_readfirstlane(s.nt);
#define G8_SA(b, h) (((b) * 2 + (h)) * HTB)
#define G8_SB(b, h) ((4 + (b) * 2 + (h)) * HTB)
#define G8_STAGE(bufoff, gbase, voff) do { _Pragma("unroll") for (int _i = 0; _i < 2; ++_i) \
        __builtin_amdgcn_global_load_lds((const unsigned*)((const char*)(gbase) + (voff)[_i]), (LAS unsigned*)(lds + (bufoff) + ldsw + _i * 8192), 16, 0, 0); } while (0)
#define G8_LDA(dst, b, h) do { _Pragma("unroll") for (int m = 0; m < 4; ++m) _Pragma("unroll") for (int k = 0; k < 2; ++k) dst[m][k] = *(const LAS bf16x8*)(lds + G8_SA(b, h) + aoff + m * 2048 + k * 1024); } while (0)
#define G8_LDB(dst, b, h) do { _Pragma("unroll") for (int n = 0; n < 2; ++n) _Pragma("unroll") for (int k = 0; k < 2; ++k) dst[n][k] = *(const LAS bf16x8*)(lds + G8_SB(b, h) + boff + n * 2048 + k * 1024); } while (0)
#define G8_MMA(ai, bj, At, Bt) do { __builtin_amdgcn_s_setprio(1); _Pragma("unroll") for (int m = 0; m < 4; ++m) _Pragma("unroll") for (int n = 0; n < 2; ++n) _Pragma("unroll") for (int k = 0; k < 2; ++k) \
        acc[ai][bj][m][n] = __builtin_amdgcn_mfma_f32_16x16x32_bf16(Bt[n][k], At[m][k], acc[ai][bj][m][n], 0, 0, 0); __builtin_amdgcn_s_setprio(0); } while (0)
#define G8_WAIT_V(n) asm volatile("s_waitcnt vmcnt(" #n ")" ::: "memory")
#define G8_WAIT_L(n) asm volatile("s_waitcnt lgkmcnt(" #n ")" ::: "memory")
#define G8_BAR __builtin_amdgcn_s_barrier()
#define G8_SCHED __builtin_amdgcn_sched_barrier(0)
    bf16x8 At[4][2], B0[2][2], B1[2][2];
    const char* pA = uptr(s.A); const char* pB0 = uptr(s.B0); const char* pB1 = uptr(s.B1);
    constexpr int KS = BK * 2;
    const int nt0 = TWOSEG ? s.nt0 : 0; const char* qA = TWOSEG ? uptr(s.A2 - (size_t)nt0 * KS) : pA; const char* qB0 = TWOSEG ? uptr(s.B02 - (size_t)nt0 * KS) : pB0; const char* qB1 = TWOSEG ? uptr(s.B12 - (size_t)nt0 * KS) : pB1;
    const char* nA = uptr(nx.A) - (size_t)nt * KS; const char* nB0 = uptr(nx.B0) - (size_t)nt * KS; const char* nB1 = uptr(nx.B1) - (size_t)nt * KS;
#define G8_TA(t) (((t) >= nt ? nA : (TWOSEG ? ((t) < nt0 ? pA : qA) : pA)) + (size_t)(t) * KS)
#define G8_TB0(t) (((t) >= nt ? nB0 : (TWOSEG ? ((t) < nt0 ? pB0 : qB0) : pB0)) + (size_t)(t) * KS)
#define G8_TB1(t) (((t) >= nt ? nB1 : (TWOSEG ? ((t) < nt0 ? pB1 : qB1) : pB1)) + (size_t)(t) * KS)
#define G8_VA1 voffA[GATHER ? 1 : 0]
#define G8_H1(ptr) ((ptr) + (GATHER ? 0u : hstepA))
    if (first) {
    G8_STAGE(G8_SB(0, 0), pB0, voffB); G8_STAGE(G8_SA(0, 0), pA, voffA[0]); G8_STAGE(G8_SB(0, 1), pB1, voffB); G8_STAGE(G8_SA(0, 1), G8_H1(pA), G8_VA1);
    if (wr == 1) G8_BAR;
    G8_WAIT_V(4); G8_BAR;
    G8_STAGE(G8_SB(1, 0), pB0 + KS, voffB); G8_STAGE(G8_SA(1, 0), pA + KS, voffA[0]); G8_STAGE(G8_SB(1, 1), pB1 + KS, voffB);
    G8_WAIT_V(6); G8_BAR;
    }
    for (int t = 0; t < nt; t += 2) {
        const char* a1 = G8_TA(t + 1);
        const char* a2 = G8_TA(t + 2); const char* b02 = G8_TB0(t + 2); const char* b12 = G8_TB1(t + 2);
        const char* a3 = G8_TA(t + 3); const char* b03 = G8_TB0(t + 3); const char* b13 = G8_TB1(t + 3);
        G8_LDB(B0, 0, 0); G8_SCHED; G8_LDA(At, 0, 0); G8_STAGE(G8_SA(1, 1), G8_H1(a1), G8_VA1);
        G8_WAIT_L(8); G8_BAR; G8_WAIT_L(0); G8_MMA(0, 0, At, B0); G8_BAR; G8_SCHED;
        G8_LDB(B1, 0, 1); G8_STAGE(G8_SB(0, 0), b02, voffB);
        G8_BAR; G8_WAIT_L(0); G8_MMA(0, 1, At, B1); G8_BAR;
        G8_LDA(At, 0, 1); G8_STAGE(G8_SA(0, 0), a2, voffA[0]);
        G8_BAR; G8_WAIT_L(0); G8_MMA(1, 0, At, B0); G8_BAR; G8_SCHED;
        G8_STAGE(G8_SB(0, 1), b12, voffB);
        G8_WAIT_V(6); G8_BAR; G8_MMA(1, 1, At, B1); G8_BAR;
        G8_LDB(B0, 1, 0); G8_SCHED; G8_LDA(At, 1, 0); G8_STAGE(G8_SA(0, 1), G8_H1(a2), G8_VA1);
        G8_WAIT_L(8); G8_BAR; G8_WAIT_L(0); G8_MMA(0, 0, At, B0); G8_BAR; G8_SCHED;
        G8_LDB(B1, 1, 1); G8_STAGE(G8_SB(1, 0), b03, voffB);
        G8_BAR; G8_WAIT_L(0); G8_MMA(0, 1, At, B1); G8_BAR;
        G8_LDA(At, 1, 1); G8_STAGE(G8_SA(1, 0), a3, voffA[0]);
        G8_BAR; G8_WAIT_L(0); G8_MMA(1, 0, At, B0); G8_BAR; G8_SCHED;
        G8_STAGE(G8_SB(1, 1), b13, voffB);
        G8_WAIT_V(6); G8_BAR; G8_MMA(1, 1, At, B1); G8_BAR;
    }
#undef G8_TA
#undef G8_VA1
#undef G8_H1
#undef G8_TB0
#undef G8_TB1
#undef G8_SA
#undef G8_SB
#undef G8_STAGE
#undef G8_LDA
#undef G8_LDB
#undef G8_MMA
#undef G8_WAIT_V
#undef G8_WAIT_L
#undef G8_BAR
#undef G8_SCHED
}
__device__ __forceinline__ void kstream_end() { asm volatile("s_waitcnt vmcnt(0)" ::: "memory"); __builtin_amdgcn_s_barrier(); }
__device__ __forceinline__ void zero_acc(Acc& acc) {
#pragma unroll
    for (int a = 0; a < 2; ++a)
#pragma unroll
        for (int b = 0; b < 2; ++b)
#pragma unroll
            for (int m = 0; m < 4; ++m)
#pragma unroll
                for (int n = 0; n < 2; ++n) acc[a][b][m][n] = (f32x4){0.f, 0.f, 0.f, 0.f};
}
__device__ __forceinline__ void make_voff_contig(unsigned (&voffA)[2][2], unsigned pitchA) {
    int tid = threadIdx.x; asm volatile("" : "+v"(tid));
#pragma unroll
    for (int i = 0; i < 2; ++i) { int R, C; stage_rc(tid * 16 + i * 8192, R, C);
        voffA[0][i] = (unsigned)R * pitchA + (unsigned)C * 2u; voffA[1][i] = 0u; }
}
__device__ __forceinline__ void make_voffB(unsigned (&voffB)[2], unsigned pitchB, bool perm) {
    int tid = threadIdx.x; asm volatile("" : "+v"(tid));
#pragma unroll
    for (int i = 0; i < 2; ++i) { int R, C; stage_rc(tid * 16 + i * 8192, R, C); const int Rb = perm ? ((R & ~31) + perm32(R & 31)) : R;
        voffB[i] = (unsigned)Rb * pitchB + (unsigned)C * 2u; }
}
}

__device__ __forceinline__ bool unit_order(int i, int G, int c, int nM, int nN, int& pm, int& pn) {
    const int nwg = nM * nN; const long L = (long)i * G + c; if (L >= nwg) return false;
    int wgid = (int)L; { const int q = nwg / 8, r = nwg % 8, xcd = wgid % 8, off = wgid / 8; wgid = (xcd < r ? xcd * (q + 1) : r * (q + 1) + (xcd - r) * q) + off; }
    const int WGM = 8, nig = WGM * nN, gid = wgid / nig, fm = gid * WGM, gsz = (nM - fm) < WGM ? (nM - fm) : WGM;
    pm = fm + ((wgid % nig) % gsz); pn = (wgid % nig) / gsz; return true;
}

__device__ __forceinline__ void conv_small_weights(const Params& p, LAS unsigned char* lds) {
    const int tid = otid(), lane = tid & 63, wave = tid >> 6, gw = obid() * NWAVES + wave, NGW = gridDim.x * NWAVES;
    LAS float* scr = (LAS float*)(lds + wave * 16384);
    constexpr int I_IN = 16 * (NIN / 32), I_A = 8 * 32, I_O = 16 * 32, I_L = 64, PER = I_IN + 2 * I_A + I_O + I_L;
    for (int it = gw; it < DEPTH * PER; it += NGW) {
        const int l = it / PER; int r = it % PER;
        unsigned char* wl = p.ws + WS_WSMALL + (size_t)l * WSMALL_LAYER;
        if (r < I_IN) { const int kb = r / (NIN / 32), nb = r % (NIN / 32), n0 = nb * 32, k0 = kb * 64;
            int col0, nvalid; if (n0 < UA) { col0 = n0; nvalid = A_COLS - n0; nvalid = nvalid < 0 ? 0 : (nvalid > 32 ? 32 : nvalid); } else { col0 = n0 - (UA - A_COLS); nvalid = 32; }
            transpose_item(p.in[I_WIN] + (size_t)l * D * IN_COLS + (size_t)k0 * IN_COLS, IN_COLS, col0, nvalid, (bf16_t*)wl + (size_t)n0 * D + k0, D, scr, lane); continue; }
        r -= I_IN;
        if (r < 2 * I_A) { const int which = r / I_A; r %= I_A; const int kb = r / 32, nb = r % 32;
            const float* src = p.in[which ? I_WBB : I_WBA] + (size_t)l * 512 * D + (size_t)(kb * 64) * D;
            transpose_item(src, D, nb * 32, 32, (bf16_t*)(wl + (10 + which) * MiB) + (size_t)(nb * 32) * 512 + kb * 64, 512, scr, lane); continue; }
        r -= 2 * I_A;
        if (r < I_O) { const int kb = r / 32, nb = r % 32;
          transpose_item(p.in[I_WOUT] + (size_t)l * D * D + (size_t)(kb * 64) * D, D, nb * 32, 32, (bf16_t*)(wl + 12 * MiB) + (size_t)(nb * 32) * D + kb * 64, D, scr, lane); continue; }
        r -= I_O;
        { bf16_t* lo = (bf16_t*)(p.ws + 65536 + (size_t)l * 262144);
          if (r < 16) transpose_item(p.in[I_WUP] + (size_t)l * 64 * 512, 512, r * 32, 32, lo + (size_t)(r * 32) * 64, 64, scr, lane);
          else if (r < 32) transpose_item(p.in[I_AUP] + (size_t)l * 64 * 512, 512, (r - 16) * 32, 32, lo + 32768 + (size_t)((r - 16) * 32) * 64, 64, scr, lane);
          else { const int q = r - 32, kb = q >> 4, nb = q & 15; transpose_item(p.in[I_GUP] + (size_t)l * 128 * 512 + (size_t)(kb * 64) * 512, 512, nb * 32, 32, lo + 65536 + (size_t)(nb * 32) * 128 + kb * 64, 128, scr, lane); } }
    }
}
__device__ __forceinline__ void conv_expert_items(const Params& p, int l, LAS unsigned char* lds, int it0, int it1) {
    const int tid = otid(), lane = tid & 63, wave = tid >> 6, gw = it0 + wave, NGW = NWAVES;
    LAS float* scr = (LAS float*)(lds + wave * 16384);
    constexpr int I_13 = 16 * 32, I_2 = 8 * 32, PER = I_13 + I_2;
    for (int it = gw; it < it1; it += NGW) {
        const int e = it / PER; int r = it % PER;
        if (r < I_13) { const int kb = r / 32, nb = r % 32, n0 = nb * 32, j = n0 >> 8, half = (n0 >> 7) & 1, c = 128 * j + (n0 & 127);
            const float* src = p.in[half ? I_WEXP3 : I_WEXP1] + (size_t)(l * 16 + e) * D * 512 + (size_t)(kb * 64) * 512;
            transpose_item(src, 512, c, 32, (bf16_t*)(p.ws + WS_WEXP) + (size_t)e * 1024 * 1024 + (size_t)n0 * 1024 + kb * 64, 1024, scr, lane); continue; }
        r -= I_13;
        { const int kb = r / 32, nb = r % 32;
          const float* src = p.in[I_WEXP2] + (size_t)(l * 16 + e) * 512 * D + (size_t)(kb * 64) * D;
          transpose_item(src, D, nb * 32, 32, (bf16_t*)(p.ws + WS_WEXP + 32 * MiB) + (size_t)e * 1024 * 512 + (size_t)(nb * 32) * 512 + kb * 64, 512, scr, lane); }
    }
}

__device__ __forceinline__ void ln_wave(f32x4 (&v)[4], const float* g, const float* bta, int lane) {
    float s = 0.f;
#pragma unroll
    for (int j = 0; j < 4; ++j) s += (v[j][0] + v[j][1]) + (v[j][2] + v[j][3]);
    const float mean = wave_sum(s) * (1.f / D); float s2 = 0.f;
#pragma unroll
    for (int j = 0; j < 4; ++j) { v[j] = v[j] - mean; s2 += (v[j][0] * v[j][0] + v[j][1] * v[j][1]) + (v[j][2] * v[j][2] + v[j][3] * v[j][3]); }
    const float rstd = __builtin_amdgcn_rsqf(wave_sum(s2) * (1.f / D) + LN_EPS);
#pragma unroll
    for (int j = 0; j < 4; ++j) { const f32x4 gg = *(const f32x4*)(g + 4 * lane + 256 * j), bb = *(const f32x4*)(bta + 4 * lane + 256 * j); v[j] = v[j] * rstd * gg + bb; }
}
__device__ __forceinline__ void store_row(const Params& p, int r, const f32x4 (&v)[4], int lane, bool zero) {
    float* hr = hrow(p, r); bf16_t* hb = (bf16_t*)(p.ws + WS_HB) + (size_t)r * D;
#pragma unroll
    for (int j = 0; j < 4; ++j) { const f32x4 o = zero ? (f32x4){0.f, 0.f, 0.f, 0.f} : v[j];
        *(f32x4*)(hr + 4 * lane + 256 * j) = o; u32x2 w; w.x = pk2(o[0], o[1]); w.y = pk2(o[2], o[3]); *(u32x2*)(hb + 4 * lane + 256 * j) = w; }
}
__device__ __forceinline__ void ln_in_phase(const Params& p) {
    const int tid = otid(), lane = tid & 63, gw = obid() * NWAVES + (tid >> 6), NGW = gridDim.x * NWAVES;
    for (int r = gw; r < T; r += NGW) {
        const int b = r / LP, pos = r - b * LP; f32x4 v[4];
        if (pos < PADM) {
#pragma unroll
            for (int j = 0; j < 4; ++j) v[j] = (f32x4){0.f, 0.f, 0.f, 0.f};
            store_row(p, r, v, lane, true); continue; }
        const float* src = pos < 64 ? p.in[I_META] + (size_t)(pos - PADM) * D : p.in[I_X] + ((size_t)(b * SEQ + pos - 64) << 10);
#pragma unroll
        for (int j = 0; j < 4; ++j) v[j] = *(const f32x4*)(src + 4 * lane + 256 * j);
        ln_wave(v, p.in[I_LNIN_G], p.in[I_LNIN_B], lane);
        store_row(p, r, v, lane, false);
    }
}

__device__ __forceinline__ const Params& PP() { const Params* q = (const Params*)__builtin_amdgcn_kernarg_segment_ptr(); asm volatile("" : "+s"(q)); return *q; }

#define EPI_COORDS() int tid_ = threadIdx.x; asm volatile("" : "+v"(tid_)); const int wid = tid_ >> 6, lane = tid_ & 63, wr = wid >> 2, wc = wid & 3, fr = lane & 15, fq = lane >> 4; (void)wr; (void)wc; (void)fr; (void)fq
__device__ __forceinline__ void inproj_epi(const g8::Acc& acc, int l, int pm, int pn) {
    EPI_COORDS();
    const int row0 = pm * 256 + wr * 64 + fr;
    if (pn < 12) {
        bf16_t* O = (bf16_t*)(PP().ws + WS_UAR);
#pragma unroll
        for (int ai = 0; ai < 2; ++ai)
#pragma unroll
            for (int m = 0; m < 4; ++m) { asm volatile("" ::: "memory"); bf16_t* rp = O + (size_t)(row0 + ai * 128 + m * 16) * UARW + pn * 256 + wc * 32 + 8 * fq;
#pragma unroll
                for (int bj = 0; bj < 2; ++bj) { const f32x4 v0 = acc[ai][bj][m][0], v1 = acc[ai][bj][m][1]; u32x4 w; w.x = pk2(v0[0], v0[1]); w.y = pk2(v0[2], v0[3]); w.z = pk2(v1[0], v1[1]); w.w = pk2(v1[2], v1[3]);
                    *(u32x4*)(rp + bj * 128) = w; } }
    } else {
        bf16_t* O = (bf16_t*)(PP().ws + WS_GATES); const int colb = (pn - 12) * 256 + wc * 32 + 8 * fq; const float* bg = PP().in[I_BGATE] + l * 2048;
        f32x4 bv[2][2];
#pragma unroll
        for (int bj = 0; bj < 2; ++bj) { bv[bj][0] = *(const f32x4*)(bg + colb + bj * 128); bv[bj][1] = *(const f32x4*)(bg + colb + bj * 128 + 4); }
#pragma unroll
        for (int ai = 0; ai < 2; ++ai)
#pragma unroll
            for (int m = 0; m < 4; ++m) { asm volatile("" ::: "memory"); bf16_t* rp = O + (size_t)(row0 + ai * 128 + m * 16) * 2048 + colb;
#pragma unroll
                for (int bj = 0; bj < 2; ++bj) { f32x4 v0 = acc[ai][bj][m][0] + bv[bj][0], v1 = acc[ai][bj][m][1] + bv[bj][1];
#pragma unroll
                    for (int e = 0; e < 4; ++e) { v0[e] = sigmoidf_(v0[e]); v1[e] = sigmoidf_(v1[e]); }
                    u32x4 w; w.x = pk2(v0[0], v0[1]); w.y = pk2(v0[2], v0[3]); w.z = pk2(v1[0], v1[1]); w.w = pk2(v1[2], v1[3]);
                    *(u32x4*)(rp + bj * 128) = w; } }
    }
}
constexpr int INP_MAIN = 62 * 20 + 3 * 12, INP_TAIL = 24;
__device__ __forceinline__ bool inproj_order(int i, int G, int c, int& pm, int& pn) {
    const long L = (long)i * G + c; if (L >= INP_MAIN) return false;
    if (L < 62 * 20) return unit_order(i, G, c, 62, 20, pm, pn);
    const int r = (int)L - 62 * 20; pm = 62 + r / 12; pn = r % 12; return true;
}
__device__ __forceinline__ void inproj_phase(const Params& p, int l, LAS unsigned char* lds) {
    unsigned voffA[2][2], voffB[2]; g8::make_voff_contig(voffA, D * 2); g8::make_voffB(voffB, D * 2, true);
    int pm, pn, pm2 = 0, pn2 = 0; const int bid = obid(); const int wr_ = __builtin_amdgcn_readfirstlane(otid() >> 6) >> 2;
    bool has = inproj_order(0, gridDim.x, bid, pm, pn), first = true;
    g8::Acc acc; g8::zero_acc(acc);
    for (int i = 0; has; ++i) {
        const bool hasn = inproj_order(i + 1, gridDim.x, bid, pm2, pn2);
        const char* Ab = (const char*)(PP().ws + WS_HB); const char* Bb = (const char*)(PP().ws + WS_WSMALL + (size_t)l * WSMALL_LAYER);
        const g8::KSeg s = g8::seg1(Ab + (size_t)pm * 256 * D * 2, Bb + (size_t)pn * 256 * D * 2, Bb + (size_t)(pn * 256 + 128) * D * 2, D / 64);
        const int pmn = hasn ? pm2 : pm, pnn = hasn ? pn2 : pn;
        const g8::KSeg nx = g8::seg1(Ab + (size_t)pmn * 256 * D * 2, Bb + (size_t)pnn * 256 * D * 2, Bb + (size_t)(pnn * 256 + 128) * D * 2, D / 64);
        if (!first && wr_ == 1) __builtin_amdgcn_s_barrier();
        g8::kstream<false, false>(lds, acc, s, nx, first, voffA, voffB, 128 * D * 2); first = false;
        if (wr_ == 0) __builtin_amdgcn_s_barrier();
        inproj_epi(acc, l, pm, pn);
        g8::zero_acc(acc); has = hasn; pm = pm2; pn = pn2;
    }
    if (!first) g8::kstream_end();
}
__device__ __forceinline__ void inproj_tail_unit(int l, LAS unsigned char* lds, int g) {
    unsigned voffA[2][2], voffB[2]; g8::make_voff_contig(voffA, D * 2); g8::make_voffB(voffB, D * 2, true);
    const int pm = 62 + (g >> 3), pn = 12 + (g & 7);
    g8::Acc acc; g8::zero_acc(acc);
    const char* Ab = (const char*)(PP().ws + WS_HB); const char* Bb = (const char*)(PP().ws + WS_WSMALL + (size_t)l * WSMALL_LAYER);
    const g8::KSeg s = g8::seg1(Ab + (size_t)pm * 256 * D * 2, Bb + (size_t)pn * 256 * D * 2, Bb + (size_t)(pn * 256 + 128) * D * 2, D / 64);
    g8::kloop<false, false>(lds, acc, s, voffA, voffB, 128 * D * 2);
    inproj_epi(acc, l, pm, pn);
}
__device__ __forceinline__ void merge_unit(int l, LAS unsigned char* lds, int pm, int pn) {
    unsigned voffA[2][2], voffB[2]; g8::make_voff_contig(voffA, D * 2); g8::make_voffB(voffB, 512 * 2, true);
    {
        const int wr_ = __builtin_amdgcn_readfirstlane(otid() >> 6) >> 2;
        g8::Acc acc; g8::zero_acc(acc);
#pragma unroll 1
        for (int br = 0; br < 2; ++br) {
            const char* Bt = (const char*)(PP().ws + WS_WSMALL + (size_t)l * WSMALL_LAYER) + (10 + br) * MiB + (size_t)pn * 256 * 512 * 2;
            const char* Bn = (const char*)(PP().ws + WS_WSMALL + (size_t)l * WSMALL_LAYER) + 11 * MiB + (size_t)pn * 256 * 512 * 2;
            const g8::KSeg s = g8::seg1((const char*)(PP().ws + WS_OAB) + (size_t)pm * 256 * D * 2 + br * 1024, Bt, Bt + (size_t)128 * 512 * 2, 8);
            const g8::KSeg nx = g8::seg1((const char*)(PP().ws + WS_OAB) + (size_t)pm * 256 * D * 2 + 1024, Bn, Bn + (size_t)128 * 512 * 2, 8);
            if (br && wr_ == 1) __builtin_amdgcn_s_barrier();
            g8::kstream<false, false>(lds, acc, s, nx, br == 0, voffA, voffB, 128 * D * 2);
            if (wr_ == 0) __builtin_amdgcn_s_barrier();
            EPI_COORDS();
            const bf16_t* GT = (const bf16_t*)(PP().ws + WS_GATES); bf16_t* O = (bf16_t*)(PP().ws + WS_MERGED);
            const int row0 = pm * 256 + wr * 64 + fr, colb = pn * 256 + wc * 32 + 8 * fq;
#pragma unroll
            for (int ai = 0; ai < 2; ++ai) { asm volatile("" ::: "memory");
                u32x4 gq[4][2], pq[4][2];
#pragma unroll
                for (int m = 0; m < 4; ++m) { const size_t ro = (size_t)(row0 + ai * 128 + m * 16); const bf16_t* gp = GT + ro * 2048 + br * 1024 + colb; const bf16_t* op = O + ro * D + colb;
#pragma unroll
                    for (int bj = 0; bj < 2; ++bj) { gq[m][bj] = *(const u32x4*)(gp + bj * 128); pq[m][bj] = br ? *(const u32x4*)(op + bj * 128) : (u32x4){0u, 0u, 0u, 0u}; } }
#pragma unroll
                for (int m = 0; m < 4; ++m) { const size_t ro = (size_t)(row0 + ai * 128 + m * 16); bf16_t* op = O + ro * D + colb;
#pragma unroll
                    for (int bj = 0; bj < 2; ++bj) { const u32x4 g = gq[m][bj], pr = pq[m][bj]; const f32x4 v0 = acc[ai][bj][m][0], v1 = acc[ai][bj][m][1];
                        u32x4 w; w.x = pk2(v0[0] * bflo(g.x) + bflo(pr.x), v0[1] * bfhi(g.x) + bfhi(pr.x)); w.y = pk2(v0[2] * bflo(g.y) + bflo(pr.y), v0[3] * bfhi(g.y) + bfhi(pr.y));
                        w.z = pk2(v1[0] * bflo(g.z) + bflo(pr.z), v1[1] * bfhi(g.z) + bfhi(pr.z)); w.w = pk2(v1[2] * bflo(g.w) + bflo(pr.w), v1[3] * bfhi(g.w) + bfhi(pr.w));
                        *(u32x4*)(op + bj * 128) = w; } } }
            g8::zero_acc(acc);
        }
        g8::kstream_end();
    }
}
__device__ __forceinline__ void wout_unit(int l, LAS unsigned char* lds, int pm, int pn) {
    unsigned voffA[2][2], voffB[2]; g8::make_voff_contig(voffA, D * 2); g8::make_voffB(voffB, D * 2, false);
    g8::Acc acc; g8::zero_acc(acc);
    const char* Ab = (const char*)(PP().ws + WS_MERGED); const char* Bb = (const char*)(PP().ws + WS_WSMALL + (size_t)l * WSMALL_LAYER + 12 * MiB);
    const g8::KSeg s = g8::seg1(Ab + (size_t)pm * 256 * D * 2, Bb + (size_t)pn * 256 * D * 2, Bb + (size_t)(pn * 256 + 128) * D * 2, D / 64);
    g8::kloop<false, false>(lds, acc, s, voffA, voffB, 128 * D * 2);
    EPI_COORDS();
    const int row0 = pm * 256 + wr * 64 + fr, col0 = pn * 256 + wc * 32 + 4 * fq;
#pragma unroll
    for (int ai = 0; ai < 2; ++ai) { asm volatile("" ::: "memory");
        f32x4 pre[4][2][2]; float* hr[4];
#pragma unroll
        for (int m = 0; m < 4; ++m) { hr[m] = hrow(PP(), row0 + ai * 128 + m * 16) + col0;
#pragma unroll
            for (int bj = 0; bj < 2; ++bj)
#pragma unroll
                for (int n = 0; n < 2; ++n) pre[m][bj][n] = *(const f32x4*)(hr[m] + bj * 128 + n * 16); }
#pragma unroll
        for (int m = 0; m < 4; ++m)
#pragma unroll
            for (int bj = 0; bj < 2; ++bj)
#pragma unroll
                for (int n = 0; n < 2; ++n) *(f32x4*)(hr[m] + bj * 128 + n * 16) = pre[m][bj][n] * ALPHA + acc[ai][bj][m][n]; }
}
__device__ __forceinline__ unsigned score_key(float s) { s += 0.0f; const unsigned u = __builtin_bit_cast(unsigned, s); return (u & 0x80000000u) ? ~u : (u | 0x80000000u); }
__device__ void attn_naive_query(const Params& p, int row, unsigned char* wl, int lane) {
    const bf16_t* U = (const bf16_t*)(p.ws + WS_UAR);
    bf16_t* OA = (bf16_t*)(p.ws + WS_OAB) + (size_t)row * D;
    const int b = row / LP, pos = row - b * LP;
    if (pos < PADM) {
#pragma unroll
        for (int j = 0; j < 8; ++j) OA[j * 64 + lane] = 0;
        return;
    }
    const int nadm = 64 * ((pos >> 6) + 1) - PADM;
    unsigned* keys = (unsigned*)wl; float* p_s = (float*)wl;
    float* qi_s = (float*)(wl + 16640); float* q_s = qi_s + 256; float* w_s = q_s + 512; unsigned short* sel_s = (unsigned short*)(w_s + 16);
    const bf16_t* urow = U + (size_t)row * UARW;
    for (int i = lane; i < 256; i += 64) qi_s[i] = bf2f(urow[C_QI + i]);
    for (int i = lane; i < 512; i += 64) q_s[i] = bf2f(urow[C_Q + i]);
    if (lane < 8) w_s[lane] = bf2f(urow[C_WI + lane]);
    __builtin_amdgcn_fence(__ATOMIC_RELEASE, "wavefront"); __builtin_amdgcn_wave_barrier(); __builtin_amdgcn_fence(__ATOMIC_ACQUIRE, "wavefront");
    const int nj = (nadm + 63) >> 6;
    for (int j = 0; j < nj; ++j) {
        const int ki_idx = lane + 64 * j; unsigned key = 0u;
        if (ki_idx < nadm) {
            const u32x4* kp = (const u32x4*)(U + (size_t)(b * LP + PADM + ki_idx) * UARW + C_KI);
            float kf[32];
#pragma unroll
            for (int c4 = 0; c4 < 4; ++c4) { const u32x4 w = kp[c4];
                kf[c4 * 8 + 0] = bflo(w.x); kf[c4 * 8 + 1] = bfhi(w.x); kf[c4 * 8 + 2] = bflo(w.y); kf[c4 * 8 + 3] = bfhi(w.y);
                kf[c4 * 8 + 4] = bflo(w.z); kf[c4 * 8 + 5] = bfhi(w.z); kf[c4 * 8 + 6] = bflo(w.w); kf[c4 * 8 + 7] = bfhi(w.w); }
            float sc = 0.f;
#pragma unroll 1
            for (int h = 0; h < 8; ++h) { float d = 0.f; asm volatile("" ::: "memory");
#pragma unroll
                for (int e = 0; e < 32; ++e) d = fmaf(qi_s[h * 32 + e], kf[e], d);
                sc = fmaf(w_s[h], fmaxf(d, 0.f), sc); }
            key = score_key(sc); if (key == 0u) key = 1u;
        }
        keys[ki_idx] = key;
    }
    __builtin_amdgcn_fence(__ATOMIC_RELEASE, "wavefront"); __builtin_amdgcn_wave_barrier(); __builtin_amdgcn_fence(__ATOMIC_ACQUIRE, "wavefront");
    unsigned thr = 0u; int need_ties = 0x7fffffff;
    if (nadm > 256) {
        unsigned prefix = 0u; int remaining = 256;
        for (int bit = 31; bit >= 0; --bit) {
            const unsigned cand = prefix | (1u << bit); int cnt = 0;
            for (int j = 0; j < nj; ++j) { const unsigned k = keys[lane + 64 * j]; cnt += __builtin_popcountll(__ballot((k >> bit) == (cand >> bit))); }
            if (cnt >= remaining) prefix = cand; else remaining -= cnt;
        }
        thr = prefix; need_ties = remaining;
    } else thr = 1u;
    int nsel = 0, ties_seen = 0;
    for (int j = 0; j < nj; ++j) {
        const unsigned k = keys[lane + 64 * j];
        const unsigned long long tm = __ballot(k == thr && k != 0u);
        const unsigned long long lt = (1ull << lane) - 1ull;
        const int myrank = ties_seen + __builtin_popcountll(tm & lt);
        const bool selme = (k > thr) || (k == thr && k != 0u && myrank < need_ties);
        const unsigned long long sm = __ballot(selme);
        if (selme) sel_s[nsel + __builtin_popcountll(sm & lt)] = (unsigned short)(PADM + lane + 64 * j);
        nsel += __builtin_popcountll(sm); ties_seen += __builtin_popcountll(tm);
    }
    __builtin_amdgcn_fence(__ATOMIC_RELEASE, "wavefront"); __builtin_amdgcn_wave_barrier(); __builtin_amdgcn_fence(__ATOMIC_ACQUIRE, "wavefront");
    float sc[4][8];
#pragma unroll
    for (int m = 0; m < 4; ++m) {
        asm volatile("" ::: "memory");
        const int i = lane + 64 * m; const bool valid = i < nsel; const int ps = valid ? sel_s[i] : PADM;
        const bf16_t* krow = U + (size_t)(b * LP + ps) * UARW + C_K;
#pragma unroll
        for (int n = 0; n < 2; ++n) {
            float a0 = 0.f, a1 = 0.f, a2 = 0.f, a3 = 0.f;
#pragma unroll 1
            for (int c8 = 0; c8 < 8; ++c8) { asm volatile("" ::: "memory"); const u32x4 w = *(const u32x4*)(krow + n * 64 + c8 * 8);
                float kf[8] = {bflo(w.x), bfhi(w.x), bflo(w.y), bfhi(w.y), bflo(w.z), bfhi(w.z), bflo(w.w), bfhi(w.w)};
#pragma unroll
                for (int e = 0; e < 8; ++e) { const int dd = c8 * 8 + e;
                    a0 = fmaf(q_s[(n * 4 + 0) * 64 + dd], kf[e], a0); a1 = fmaf(q_s[(n * 4 + 1) * 64 + dd], kf[e], a1);
                    a2 = fmaf(q_s[(n * 4 + 2) * 64 + dd], kf[e], a2); a3 = fmaf(q_s[(n * 4 + 3) * 64 + dd], kf[e], a3); } }
            sc[m][n * 4 + 0] = valid ? a0 * 0.125f : -INFINITY; sc[m][n * 4 + 1] = valid ? a1 * 0.125f : -INFINITY;
            sc[m][n * 4 + 2] = valid ? a2 * 0.125f : -INFINITY; sc[m][n * 4 + 3] = valid ? a3 * 0.125f : -INFINITY;
        }
    }
    __builtin_amdgcn_wave_barrier();
    float linv[8];
#pragma unroll
    for (int h = 0; h < 8; ++h) {
        const float mx = wave_max(fmaxf(fmaxf(sc[0][h], sc[1][h]), fmaxf(sc[2][h], sc[3][h]))); float s = 0.f;
#pragma unroll
        for (int m = 0; m < 4; ++m) { const float e = __expf(sc[m][h] - mx); sc[m][h] = e; s += e; }
        linv[h] = 1.0f / wave_sum(s);
    }
#pragma unroll
    for (int m = 0; m < 4; ++m) { const int i = lane + 64 * m;
#pragma unroll
        for (int h = 0; h < 8; ++h) p_s[i * 8 + h] = sc[m][h]; }
    __builtin_amdgcn_fence(__ATOMIC_RELEASE, "wavefront"); __builtin_amdgcn_wave_barrier(); __builtin_amdgcn_fence(__ATOMIC_ACQUIRE, "wavefront");
    float o[8] = {0.f, 0.f, 0.f, 0.f, 0.f, 0.f, 0.f, 0.f};
    for (int i = 0; i < nsel; ++i) {
        const int ps = sel_s[i]; const bf16_t* vrow = U + (size_t)(b * LP + ps) * UARW + C_V;
        const float v0 = bf2f(vrow[lane]), v1 = bf2f(vrow[64 + lane]);
        const f32x4 pa = *(const f32x4*)(p_s + i * 8), pb = *(const f32x4*)(p_s + i * 8 + 4);
        o[0] = fmaf(pa[0], v0, o[0]); o[1] = fmaf(pa[1], v0, o[1]); o[2] = fmaf(pa[2], v0, o[2]); o[3] = fmaf(pa[3], v0, o[3]);
        o[4] = fmaf(pb[0], v1, o[4]); o[5] = fmaf(pb[1], v1, o[5]); o[6] = fmaf(pb[2], v1, o[6]); o[7] = fmaf(pb[3], v1, o[7]);
    }
#pragma unroll
    for (int h = 0; h < 8; ++h) OA[h * 64 + lane] = (bf16_t)f2bf(o[h] * linv[h]);
    __builtin_amdgcn_wave_barrier();
}


__device__ __forceinline__ f32x4 mfma16(bf16x8 a, bf16x8 b, f32x4 c) { return __builtin_amdgcn_mfma_f32_16x16x32_bf16(a, b, c, 0, 0, 0); }
#ifndef PROBE_PHASE
#define PROBE_PHASE -1
#endif
#define PROBE_BLOCK 0
#define LDS_BARRIER() do { asm volatile("s_waitcnt lgkmcnt(0)" ::: "memory"); __builtin_amdgcn_s_barrier(); asm volatile("" ::: "memory"); } while (0)

typedef float f32x16 __attribute__((ext_vector_type(16)));
typedef short s16x4 __attribute__((ext_vector_type(4)));
constexpr int AT_HIST = 0;
constexpr int AT_MASK = 20480;
constexpr int AT_QST = AT_MASK + 16640;
constexpr int AT_KV = 37120;
constexpr int AT_UNIT = AT_KV + 32768;
constexpr int AT_KL = AT_KV;
constexpr int AT_KL_BYTES = LDS_BYTES - 16 - AT_KL;
static_assert(4128 * 12 * 2 <= AT_KL_BYTES, "selection keys fit with 12 queries per sub-pass");
constexpr int CW_R1Q = 48;
constexpr int CW_ATT = 32;
__device__ __forceinline__ int img_off(int row, int ch) { return 2048 * (row >> 3) + 512 * (ch >> 2) + 64 * (row & 7) + 16 * ((ch & 3) ^ ((row >> 2) & 3)); }
__device__ __forceinline__ unsigned comp_key(float sc, int pos) { return (score_key(sc) & 0xFFFFE000u) | (unsigned)(0x1FFF - pos); }

__device__ __forceinline__ void attn_unit(const Params& p, unsigned char* lds, int b, int qt, unsigned long long& pacc) {
    unsigned long long pt0 = 0; if (PROBE_PHASE == 40 || PROBE_PHASE == 42) pt0 = __builtin_amdgcn_s_memrealtime();
    const int tid = otid(), wave = tid >> 6, lane = tid & 63, r = lane & 31, hh = lane >> 5;
    const bf16_t* U = (const bf16_t*)(p.ws + WS_UAR);
    LAS unsigned char* L = (LAS unsigned char*)lds;
    LAS unsigned* hist = (LAS unsigned*)(L + AT_HIST); LAS unsigned* maskw = (LAS unsigned*)(L + AT_MASK);
    const int c = qt >> 1, nkt = 2 * c + 1, nadm = 64 * (c + 1) - PADM;
    const size_t qrow = (size_t)(b * LP + 32 * qt + r);
    if (nadm > 256) {
        LAS unsigned short* KL = (LAS unsigned short*)(L + AT_KL);
        LAS unsigned* h8 = (LAS unsigned*)(L + AT_HIST);
        LAS unsigned* segc = h8 + 4096;
        LAS unsigned* st = segc + 512;
        const int NK = 32 * nkt, c15 = lane & 15, g4 = lane >> 4;
        const int qs = NK * 32 <= AT_KL_BYTES ? 16 : 12;
        for (int i = tid; i < (nkt + 1) * 32; i += NTHREADS) maskw[i] = 0u;
#pragma unroll 1
        for (int qbase = 0; qbase < 32; qbase += qs) {
            const int qn = 32 - qbase < qs ? 32 - qbase : qs; const bool qact = c15 < qn;
            bf16x8 qf[8]; float wq[8];
            { const bf16_t* qp = U + (size_t)(b * LP + 32 * qt + qbase + (qact ? c15 : 0)) * UARW;
#pragma unroll
              for (int h = 0; h < 8; ++h) qf[h] = *(const bf16x8*)(qp + C_QI + h * 32 + 8 * g4);
              const u32x4 w = *(const u32x4*)(qp + C_WI);
              wq[0] = bflo(w.x); wq[1] = bfhi(w.x); wq[2] = bflo(w.y); wq[3] = bfhi(w.y); wq[4] = bflo(w.z); wq[5] = bfhi(w.z); wq[6] = bflo(w.w); wq[7] = bfhi(w.w); }
#pragma unroll
            for (int h = 0; h < 8; ++h) asm volatile("" : "+v"(qf[h]), "+v"(wq[h]));
            for (int i = tid; i < 4096 + 512; i += NTHREADS) h8[i] = 0u;
            LDS_BARRIER();
            {
                const int ng = 2 * nkt; int j = wave;
                const bf16_t* kb = U + (size_t)(b * LP + 32 + c15) * UARW + C_KI + 8 * g4;
                bf16x8 a = *(const bf16x8*)(kb + (size_t)(16 * (j < ng ? j : 0)) * UARW), an = *(const bf16x8*)(kb + (size_t)(16 * (j + NWAVES < ng ? j + NWAVES : 0)) * UARW);
#pragma unroll 1
                for (; j < ng; j += NWAVES) {
                    const bf16x8 a2 = *(const bf16x8*)(kb + (size_t)(16 * (j + 2 * NWAVES < ng ? j + 2 * NWAVES : j)) * UARW);
                    f32x4 sc = {0.f, 0.f, 0.f, 0.f};
#pragma unroll
                    for (int h = 0; h < 8; ++h) { const f32x4 d = mfma16(a, qf[h], (f32x4){0.f, 0.f, 0.f, 0.f});
#pragma unroll
                        for (int e = 0; e < 4; ++e) sc[e] = fmaf(wq[h], fmaxf(d[e], 0.f), sc[e]); }
                    if (qact) {
#pragma unroll
                        for (int e = 0; e < 4; ++e) { const int ki = 16 * j + 4 * g4 + e;
                            const unsigned k16 = ki >= 16 ? (score_key(sc[e]) >> 16) : 0u;
                            KL[ki * qs + c15] = (unsigned short)k16;
                            __hip_atomic_fetch_add(h8 + (k16 >> 8) * 16 + c15, ki >= 16 ? 1u : 0u, __ATOMIC_RELAXED, __HIP_MEMORY_SCOPE_WORKGROUP); } }
                    a = an; an = a2;
                }
            }
            LDS_BARRIER();
            { const int q_ = tid & 15, s8 = tid >> 4; unsigned ss = 0u;
#pragma unroll
              for (int i = 0; i < 8; ++i) ss += h8[(s8 * 8 + i) * 16 + q_];
              segc[s8 * 16 + q_] = ss; }
            LDS_BARRIER();
            if (tid < qn) { unsigned sv[32];
#pragma unroll
                for (int i = 0; i < 32; ++i) sv[i] = segc[i * 16 + tid];
                unsigned cum = 0u; int sgi = 31;
#pragma unroll
                for (int i = 31; i > 0; --i) { const bool go = sgi == i && cum + sv[i] < 256u; cum += go ? sv[i] : 0u; sgi -= go ? 1 : 0; }
                int bin = sgi * 8 + 7; while (bin > sgi * 8 && cum + h8[bin * 16 + tid] < 256u) { cum += h8[bin * 16 + tid]; --bin; }
                st[tid * 4] = (unsigned)bin; st[tid * 4 + 1] = 256u - cum; }
            LDS_BARRIER();
            for (int i = tid; i < 4096; i += NTHREADS) h8[i] = 0u;
            LDS_BARRIER();
            const int q = tid & 15, sg = tid >> 4, SEG = (NK + 31) >> 5, k0 = sg * SEG, k1 = q < qn ? (k0 + SEG < NK ? k0 + SEG : NK) : k0;
            { const unsigned hb = st[q * 4];
#pragma unroll 8
              for (int k = k0; k < k1; ++k) { const unsigned kv = KL[k * qs + q]; __hip_atomic_fetch_add(h8 + (kv & 255u) * 16 + q, (kv >> 8) == hb && kv != 0u ? 1u : 0u, __ATOMIC_RELAXED, __HIP_MEMORY_SCOPE_WORKGROUP); } }
            LDS_BARRIER();
            { const int q_ = tid & 15, s8 = tid >> 4; unsigned ss = 0u;
#pragma unroll
              for (int i = 0; i < 8; ++i) ss += h8[(s8 * 8 + i) * 16 + q_];
              segc[s8 * 16 + q_] = ss; }
            LDS_BARRIER();
            if (tid < qn) { const unsigned rem = st[tid * 4 + 1]; unsigned sv[32];
#pragma unroll
                for (int i = 0; i < 32; ++i) sv[i] = segc[i * 16 + tid];
                unsigned cum = 0u; int sgi = 31;
#pragma unroll
                for (int i = 31; i > 0; --i) { const bool go = sgi == i && cum + sv[i] < rem; cum += go ? sv[i] : 0u; sgi -= go ? 1 : 0; }
                int bin = sgi * 8 + 7; while (bin > sgi * 8 && cum + h8[bin * 16 + tid] < rem) { cum += h8[bin * 16 + tid]; --bin; }
                st[tid * 4 + 2] = (st[tid * 4] << 8) | (unsigned)bin; st[tid * 4 + 3] = rem - cum; }
            LDS_BARRIER();
            const unsigned thr = st[q * 4 + 2], need = st[q * 4 + 3];
            { unsigned cnt = 0u;
#pragma unroll 8
              for (int k = k0; k < k1; ++k) cnt += KL[k * qs + q] == thr ? 1u : 0u;
              segc[sg * 16 + q] = cnt; }
            LDS_BARRIER();
            if (tid < qn) { unsigned cv[32];
#pragma unroll
                for (int s2 = 0; s2 < 32; ++s2) cv[s2] = segc[s2 * 16 + tid];
                unsigned run = 0u;
#pragma unroll
                for (int s2 = 0; s2 < 32; ++s2) { segc[s2 * 16 + tid] = run; run += cv[s2]; } }
            LDS_BARRIER();
            { unsigned rank = segc[sg * 16 + q], word = 0u; int wi = k0 >> 5;
#pragma unroll 4
              for (int k = k0; k < k1; ++k) { if ((k >> 5) != wi) { if (word) __hip_atomic_fetch_or(maskw + (wi + 1) * 32 + qbase + q, word, __ATOMIC_RELAXED, __HIP_MEMORY_SCOPE_WORKGROUP); word = 0u; wi = k >> 5; }
                  const unsigned kv = KL[k * qs + q]; const bool tie = kv == thr; const bool sel = kv > thr || (tie && rank < need); rank += tie ? 1u : 0u;
                  word |= (sel ? 1u : 0u) << (k & 31); }
              if (word) __hip_atomic_fetch_or(maskw + (wi + 1) * 32 + qbase + q, word, __ATOMIC_RELAXED, __HIP_MEMORY_SCOPE_WORKGROUP); }
            LDS_BARRIER();
        }
    } else {
        for (int kt = 1 + wave; kt <= nkt; kt += NWAVES) if (hh == 0) maskw[kt * 32 + r] = kt == 1 ? 0xFFFF0000u : 0xFFFFFFFFu;
        LDS_BARRIER();
    }
    if (PROBE_PHASE == 40) pacc += __builtin_amdgcn_s_memrealtime() - pt0;
    if (PROBE_PHASE == 41) pt0 = __builtin_amdgcn_s_memrealtime();
    {
        const int h = wave, n = h >> 2;
        bf16x8 qf4[4];
#pragma unroll
        for (int kk = 0; kk < 4; ++kk) qf4[kk] = *(const bf16x8*)(U + qrow * UARW + C_Q + h * 64 + 16 * kk + 8 * hh);
        asm volatile("" : "+v"(qf4[0]), "+v"(qf4[1]), "+v"(qf4[2]), "+v"(qf4[3]));
        f32x16 o0, o1;
#pragma unroll
        for (int e = 0; e < 16; ++e) { o0[e] = 0.f; o1[e] = 0.f; }
        float m = -1e30f, lsum = 0.f;
        const int srow = tid >> 4, sch = tid & 15; const int soff = img_off(srow, sch);
        const bf16_t* sbase = U + (size_t)(b * LP + srow) * UARW + sch * 8;
        u32x4 kreg = *(const u32x4*)(sbase + (size_t)32 * UARW + C_K), vreg = *(const u32x4*)(sbase + (size_t)32 * UARW + C_V);
        *(LAS u32x4*)(L + AT_KV + soff) = kreg; *(LAS u32x4*)(L + AT_KV + 8192 + soff) = vreg;
        { const int k2 = nkt >= 2 ? 2 : 1; kreg = *(const u32x4*)(sbase + (size_t)(32 * k2) * UARW + C_K); vreg = *(const u32x4*)(sbase + (size_t)(32 * k2) * UARW + C_V); }
        LDS_BARRIER();
        const int g = (lane >> 4) & 1, q_ = (lane & 15) >> 2, p_ = lane & 3;
        constexpr float SCL = 0.125f * 1.44269504088896f;
#pragma unroll 1
        for (int i = 0; i < nkt; ++i) {
            const int kt = 1 + i; LAS unsigned char* Kimg = L + AT_KV + (i & 1) * 16384; LAS unsigned char* Vimg = Kimg + 8192;
            u32x4 kreg2, vreg2;
            { const int k3 = kt + 2 <= nkt ? kt + 2 : kt; kreg2 = *(const u32x4*)(sbase + (size_t)(32 * k3) * UARW + C_K); vreg2 = *(const u32x4*)(sbase + (size_t)(32 * k3) * UARW + C_V); }
            f32x16 s;
#pragma unroll
            for (int e = 0; e < 16; ++e) s[e] = 0.f;
#pragma unroll
            for (int kk = 0; kk < 4; ++kk) { const bf16x8 a = *(const LAS bf16x8*)(Kimg + img_off(r, 8 * n + 2 * kk + hh)); s = __builtin_amdgcn_mfma_f32_32x32x16_bf16(a, qf4[kk], s, 0, 0, 0); }
            const unsigned mw = maskw[kt * 32 + r] >> (4 * hh);
            float tmax = -INFINITY;
#pragma unroll
            for (int e = 0; e < 16; ++e) { const bool sel = (mw >> ((e & 3) + 8 * (e >> 2))) & 1u; s[e] = sel ? s[e] : -INFINITY; tmax = fmaxf(tmax, s[e]); }
            tmax = fmaxf(tmax, __shfl_xor(tmax, 32));
            const float mnew = fmaxf(m, tmax * SCL);
            if (__any(mnew > m)) { const float alpha = __builtin_amdgcn_exp2f(m - mnew); lsum *= alpha;
#pragma unroll
                for (int e = 0; e < 16; ++e) { o0[e] *= alpha; o1[e] *= alpha; } }
            m = mnew;
            float ps = 0.f;
#pragma unroll
            for (int e = 0; e < 16; ++e) { const float pe = __builtin_amdgcn_exp2f(fmaf(s[e], SCL, -mnew)); s[e] = pe; ps += pe; }
            lsum += ps;
            bf16x8 pf[2];
#pragma unroll
            for (int ks = 0; ks < 2; ++ks) { u32x4 w; w.x = pk2(s[8 * ks + 0], s[8 * ks + 1]); w.y = pk2(s[8 * ks + 2], s[8 * ks + 3]); w.z = pk2(s[8 * ks + 4], s[8 * ks + 5]); w.w = pk2(s[8 * ks + 6], s[8 * ks + 7]); pf[ks] = __builtin_bit_cast(bf16x8, w); }
#pragma unroll
            for (int ks = 0; ks < 2; ++ks)
#pragma unroll
                for (int dt = 0; dt < 2; ++dt) { const int c0 = 8 * n + 4 * dt + 2 * g + (p_ >> 1);
                    const s16x4 lo = __builtin_amdgcn_ds_read_tr16_b64_v4i16((LAS s16x4*)(Vimg + img_off(16 * ks + 4 * hh + q_, c0) + 8 * (p_ & 1)));
                    const s16x4 hi = __builtin_amdgcn_ds_read_tr16_b64_v4i16((LAS s16x4*)(Vimg + img_off(16 * ks + 8 + 4 * hh + q_, c0) + 8 * (p_ & 1)));
                    const bf16x8 a = __builtin_shufflevector(lo, hi, 0, 1, 2, 3, 4, 5, 6, 7);
                    if (dt == 0) o0 = __builtin_amdgcn_mfma_f32_32x32x16_bf16(a, pf[ks], o0, 0, 0, 0); else o1 = __builtin_amdgcn_mfma_f32_32x32x16_bf16(a, pf[ks], o1, 0, 0, 0); }
            if (i + 1 < nkt) { LAS unsigned char* Kn = L + AT_KV + ((i + 1) & 1) * 16384; *(LAS u32x4*)(Kn + soff) = kreg; *(LAS u32x4*)(Kn + 8192 + soff) = vreg; }
            kreg = kreg2; vreg = vreg2;
            LDS_BARRIER();
        }
        lsum += __shfl_xor(lsum, 32);
        const float inv = lsum > 0.f ? 1.0f / lsum : 0.f;
        bf16_t* orow = (bf16_t*)(p.ws + WS_OAB) + qrow * D + h * 64 + 4 * hh;
#pragma unroll
        for (int g4 = 0; g4 < 4; ++g4) { u32x2 w0, w1;
            w0.x = pk2(o0[4 * g4] * inv, o0[4 * g4 + 1] * inv); w0.y = pk2(o0[4 * g4 + 2] * inv, o0[4 * g4 + 3] * inv);
            w1.x = pk2(o1[4 * g4] * inv, o1[4 * g4 + 1] * inv); w1.y = pk2(o1[4 * g4 + 2] * inv, o1[4 * g4 + 3] * inv);
            *(u32x2*)(orow + 8 * g4) = w0; *(u32x2*)(orow + 32 + 8 * g4) = w1; }
        if (qt == 1) {
            bf16_t* z = (bf16_t*)(p.ws + WS_OAB) + (size_t)(b * LP + r) * D + h * 64 + 32 * hh;
#pragma unroll
            for (int j = 0; j < 4; ++j) *(u32x4*)(z + 8 * j) = (u32x4){0u, 0u, 0u, 0u};
        }
    }
    if (PROBE_PHASE == 41 || PROBE_PHASE == 42) pacc += __builtin_amdgcn_s_memrealtime() - pt0;
}
__device__ __forceinline__ void attn_phase(const Params& p, int l, unsigned char* lds, unsigned long long& pacc) {
    unsigned* ctr = (unsigned*)(p.ws + WS_CTL) + CW_ATT + 4 * l;
    volatile int* uw = (volatile int*)(lds + AT_UNIT);
    const int b0 = (obid() & 7) >> 1;
    for (int k = 0; k < 4; ++k) { const int b = (b0 + k) & 3;
        for (;;) {
            __syncthreads();
            if (otid() == 0) *uw = (int)atomicAdd(ctr + b, 1u);
            __syncthreads();
            const int u = *uw;
            if (u >= 129) break;
            attn_unit(p, lds, b, 129 - u, pacc);
        }
    }
}

constexpr size_t WS_RW1 = WS_HB;
constexpr size_t WS_RW2 = 259 * MiB;
constexpr size_t RW2_ARR = (size_t)2080 * 8192;
constexpr size_t WS_LORA = 65536;
constexpr int PS = 72;
constexpr int R1_XW = 0, R1_XA = 9216, R1_XG = 18432;
constexpr int R1_RHS = 0;
constexpr int R1_E = 35840, R1_AA = R1_E + 16640, R1_GS = R1_AA + 9216;
constexpr int R1_LABT = R1_E, R1_LAK = R1_E + 16384;
constexpr int R1_AT = R1_GS + 9216, R1_RT = R1_AT + 9216, R1_BT = R1_RT + 9216, R1_KT = R1_BT + 9216;
constexpr int R1_WT = R1_AT, R1_ZT = R1_BT, R1_LOFF = R1_KT;
constexpr int R1_BTT = R1_KT + 9216, R1_KTT = R1_BTT + 9216, R1_VT = R1_KTT + 9216;
constexpr int R1_MRB = R1_VT + 9216, R1_MRK = R1_MRB + 9216;
constexpr int R1_BS = R1_MRK + 9216, R1_GC = R1_BS + 256, R1_END = R1_GC + 256;
static_assert(R1_END <= LDS_BYTES && R1_LAK + 9216 <= R1_AT && R1_RHS + 33280 <= R1_E, "R1 LDS map");
__device__ __forceinline__ u32x2 pk4(f32x4 v) { u32x2 w; w.x = pk2(v[0], v[1]); w.y = pk2(v[2], v[3]); return w; }

#ifndef PROBE_PHASE
#define PROBE_PHASE -1
#endif
struct R1PF { u32x4 a[7], q[7]; };
__device__ __forceinline__ void r1_load_rows(const bf16_t* U, int unit, int tid, R1PF& pf) {
    const int h = unit & 7, bc = unit >> 3, b = bc / NCH, c = bc - b * NCH, t = tid >> 3, d0 = (tid & 7) * 8;
    const int row = b * LP + 64 * c + t; const bool hasprev = (64 * c + t) > 0;
    const bf16_t* uc = U + (size_t)row * UARW; const bf16_t* up = hasprev ? uc - UARW : uc;
    const int cols[7] = {C_R + h * 64 + d0, C_RK + h * 64 + d0, C_RV + h * 64 + d0, C_XW + d0, C_XA + d0, C_XG + d0, C_XG + 64 + d0};
#pragma unroll
    for (int i = 0; i < 7; ++i) { pf.a[i] = *(const u32x4*)(uc + cols[i]); pf.q[i] = *(const u32x4*)(up + cols[i]); }
}
#define R1P(k) do { if (PROBE_PHASE == 20 + (k)) { const unsigned long long t_ = __builtin_amdgcn_s_memrealtime(); pacc += t_ - pt0; } if (PROBE_PHASE == 21 + (k)) pt0 = __builtin_amdgcn_s_memrealtime(); } while (0)
__device__ __forceinline__ void rwkv_prep_unit(const Params& p, int l, int unit, unsigned char* lds, unsigned long long& pacc, R1PF& pf, int next_unit) {
    unsigned long long pt0 = 0; if (PROBE_PHASE == 20) pt0 = __builtin_amdgcn_s_memrealtime();
    const int tid = otid(), wave = tid >> 6, lane = tid & 63, c15 = lane & 15, g = lane >> 4;
    const int h = unit & 7, bc = unit >> 3, b = bc / NCH, c = bc - b * NCH;
    LAS unsigned char* L = (LAS unsigned char*)lds;
    const bf16_t* U = (const bf16_t*)(p.ws + WS_UAR);
    const int t = tid >> 3, dq = tid & 7, d0 = dq * 8;
    const int row = b * LP + 64 * c + t; const bool hasprev = (64 * c + t) > 0;
    bf16x8 lw[2][2], la[2][2], lg_[2][4];
    float rr[8], kx[8], vx[8], kk[8];
    {
        const float* mu = p.in[I_MU] + l * R_COLS;
        auto shift8 = [&](int idx, int mucol, float (&out)[8]) {
            const u32x4 a = pf.a[idx], q = pf.q[idx];
            const f32x4 m0 = *(const f32x4*)(mu + mucol), m1 = *(const f32x4*)(mu + mucol + 4);
            const float x[8] = {bflo(a.x), bfhi(a.x), bflo(a.y), bfhi(a.y), bflo(a.z), bfhi(a.z), bflo(a.w), bfhi(a.w)};
            const float y[8] = {bflo(q.x), bfhi(q.x), bflo(q.y), bfhi(q.y), bflo(q.z), bfhi(q.z), bflo(q.w), bfhi(q.w)};
#pragma unroll
            for (int i = 0; i < 8; ++i) { const float xp = hasprev ? y[i] : 0.f; out[i] = x[i] + (xp - x[i]) * (i < 4 ? m0[i] : m1[i - 4]); } };
        shift8(0, h * 64 + d0, rr); shift8(1, 512 + h * 64 + d0, kx); shift8(2, 1024 + h * 64 + d0, vx);
        float xw[8], xa[8], xg0[8], xg1[8];
        shift8(3, 1536 + d0, xw); shift8(4, 1600 + d0, xa); shift8(5, 1664 + d0, xg0); shift8(6, 1728 + d0, xg1);
        asm volatile("" ::: "memory");
        { const bf16_t* lora = (const bf16_t*)(p.ws + WS_LORA + (size_t)l * 262144);
    #pragma unroll
          for (int nn = 0; nn < 2; ++nn) { const int hd = h * 64 + 16 * (2 * (wave & 1) + nn) + c15;
    #pragma unroll
              for (int s2 = 0; s2 < 2; ++s2) { lw[nn][s2] = *(const bf16x8*)(lora + (size_t)hd * 64 + 32 * s2 + 8 * g); la[nn][s2] = *(const bf16x8*)(lora + 32768 + (size_t)hd * 64 + 32 * s2 + 8 * g); }
    #pragma unroll
              for (int s4 = 0; s4 < 4; ++s4) lg_[nn][s4] = *(const bf16x8*)(lora + 65536 + (size_t)hd * 128 + 32 * s4 + 8 * g); } }
        float n2 = 0.f;
        { const f32x4 k0 = *(const f32x4*)(p.in[I_KK] + l * 512 + h * 64 + d0), k1 = *(const f32x4*)(p.in[I_KK] + l * 512 + h * 64 + d0 + 4);
#pragma unroll
          for (int i = 0; i < 8; ++i) { kk[i] = kx[i] * (i < 4 ? k0[i] : k1[i - 4]); n2 = fmaf(kk[i], kk[i], n2); } }
        n2 += __shfl_xor(n2, 1); n2 += __shfl_xor(n2, 2); n2 += __shfl_xor(n2, 4);
        const float rn = rsqrtf(fmaxf(n2, 1e-24f));
#pragma unroll
        for (int i = 0; i < 8; ++i) { kk[i] *= rn; xw[i] = 1.0f - 2.0f * __builtin_amdgcn_rcpf(1.0f + __expf(2.0f * xw[i])); xg0[i] = sigmoidf_(xg0[i]); xg1[i] = sigmoidf_(xg1[i]); }
        u32x4 w;
        w.x = pk2(xw[0], xw[1]); w.y = pk2(xw[2], xw[3]); w.z = pk2(xw[4], xw[5]); w.w = pk2(xw[6], xw[7]); *(LAS u32x4*)(L + R1_XW + (t * PS + d0) * 2) = w;
        w.x = pk2(xa[0], xa[1]); w.y = pk2(xa[2], xa[3]); w.z = pk2(xa[4], xa[5]); w.w = pk2(xa[6], xa[7]); *(LAS u32x4*)(L + R1_XA + (t * PS + d0) * 2) = w;
        w.x = pk2(xg0[0], xg0[1]); w.y = pk2(xg0[2], xg0[3]); w.z = pk2(xg0[4], xg0[5]); w.w = pk2(xg0[6], xg0[7]); *(LAS u32x4*)(L + R1_XG + (t * 136 + d0) * 2) = w;
        w.x = pk2(xg1[0], xg1[1]); w.y = pk2(xg1[2], xg1[3]); w.z = pk2(xg1[4], xg1[5]); w.w = pk2(xg1[6], xg1[7]); *(LAS u32x4*)(L + R1_XG + (t * 136 + 64 + d0) * 2) = w;
    }
    LDS_BARRIER();
    R1P(0);
    const int tm = wave >> 1;
    unsigned char* rw2 = p.ws + WS_RW2 + (size_t)unit * 8192;
    {
#pragma unroll
        for (int nn = 0; nn < 2; ++nn) { const int tn = 2 * (wave & 1) + nn, dcol = 16 * tn + c15, hd = h * 64 + dcol;
            f32x4 aw = {0.f, 0.f, 0.f, 0.f}, aa = aw, ag = aw;
#pragma unroll
            for (int s2 = 0; s2 < 2; ++s2) {
                const bf16x8 xa_ = *(const LAS bf16x8*)(L + R1_XW + ((16 * tm + c15) * PS + 32 * s2 + 8 * g) * 2), xb_ = *(const LAS bf16x8*)(L + R1_XA + ((16 * tm + c15) * PS + 32 * s2 + 8 * g) * 2);
                aw = mfma16(xa_, lw[nn][s2], aw);
                aa = mfma16(xb_, la[nn][s2], aa); }
#pragma unroll
            for (int s4 = 0; s4 < 4; ++s4) ag = mfma16(*(const LAS bf16x8*)(L + R1_XG + ((16 * tm + c15) * 136 + 32 * s4 + 8 * g) * 2), lg_[nn][s4], ag);
            const float w0 = p.in[I_W0][l * 512 + hd], a0 = p.in[I_A0][l * 512 + hd];
#pragma unroll
            for (int e = 0; e < 4; ++e) { const int tt = 16 * tm + 4 * g + e;
                *(LAS float*)(L + R1_E + (tt * 65 + dcol) * 4) = 0.60653065971263342f * sigmoidf_(w0 + aw[e]);
                *(LAS unsigned short*)(L + R1_AA + (tt * PS + dcol) * 2) = (unsigned short)f2bf(sigmoidf_(a0 + aa[e]));
                *(LAS unsigned short*)(L + R1_GS + (tt * PS + dcol) * 2) = (unsigned short)f2bf(ag[e]); }
        }
    }
    LDS_BARRIER();
    R1P(1);
    {
        const int d = tid & 63, sg = tid >> 6; float cum = 0.f, loc[8];
#pragma unroll
        for (int i = 0; i < 8; ++i) { cum += *(const LAS float*)(L + R1_E + ((8 * sg + i) * 65 + d) * 4); loc[i] = cum; }
        *(LAS float*)(L + R1_BS + (sg * 64 + d) * 4 - 2048) = cum;
        LDS_BARRIER();
        float off = 0.f;
#pragma unroll
        for (int q = 0; q < 7; ++q) if (q < sg) off += *(const LAS float*)(L + R1_BS + (q * 64 + d) * 4 - 2048);
#pragma unroll
        for (int i = 0; i < 8; ++i) *(LAS float*)(L + R1_E + ((8 * sg + i) * 65 + d) * 4) = loc[i] + off;
    }
    LDS_BARRIER();
    R1P(2);
    {
        const f32x4 ka0 = *(const f32x4*)(p.in[I_KA] + l * 512 + h * 64 + d0), ka1 = *(const f32x4*)(p.in[I_KA] + l * 512 + h * 64 + d0 + 4);
        const f32x4 rk0 = *(const f32x4*)(p.in[I_RK] + l * 512 + h * 64 + d0), rk1 = *(const f32x4*)(p.in[I_RK] + l * 512 + h * 64 + d0 + 4);
        const u32x4 aw_ = *(const LAS u32x4*)(L + R1_AA + (t * PS + d0) * 2);
        const float av[8] = {bflo(aw_.x), bfhi(aw_.x), bflo(aw_.y), bfhi(aw_.y), bflo(aw_.z), bfhi(aw_.z), bflo(aw_.w), bfhi(aw_.w)};
        float At[8], Bt[8], Kt[8], Rt[8]; float bpart = 0.f;
#pragma unroll
        for (int i = 0; i < 8; ++i) {
            const float cumt = *(const LAS float*)(L + R1_E + (t * 65 + d0 + i) * 4), cump = t > 0 ? *(const LAS float*)(L + R1_E + ((t - 1) * 65 + d0 + i) * 4) : 0.f;
            const float gam = __expf(-cumt), gprev = __expf(-cump), ginv = __expf(cumt);
            const float kmod = kx[i] * (1.0f + (av[i] - 1.0f) * (i < 4 ? ka0[i] : ka1[i - 4]));
            At[i] = -gprev * kk[i]; Bt[i] = kk[i] * av[i] * ginv; Kt[i] = kmod * ginv; Rt[i] = rr[i] * gam;
            bpart = fmaf(rr[i] * kmod, (i < 4 ? rk0[i] : rk1[i - 4]), bpart);
            if (t == 63) *(LAS float*)(L + R1_GC + (d0 + i) * 4) = gam;
            *(LAS float*)(L + R1_RHS + ((d0 + i) * 65 + t) * 4) = At[i];
            *(LAS unsigned short*)(L + R1_BTT + ((d0 + i) * PS + t) * 2) = (unsigned short)f2bf(Bt[i]);
            *(LAS unsigned short*)(L + R1_KTT + ((d0 + i) * PS + t) * 2) = (unsigned short)f2bf(Kt[i]);
            *(LAS unsigned short*)(L + R1_VT + ((d0 + i) * PS + t) * 2) = (unsigned short)f2bf(vx[i]);
        }
        u32x4 w;
        w.x = pk2(At[0], At[1]); w.y = pk2(At[2], At[3]); w.z = pk2(At[4], At[5]); w.w = pk2(At[6], At[7]); *(LAS u32x4*)(L + R1_AT + (t * PS + d0) * 2) = w;
        w.x = pk2(Rt[0], Rt[1]); w.y = pk2(Rt[2], Rt[3]); w.z = pk2(Rt[4], Rt[5]); w.w = pk2(Rt[6], Rt[7]); *(LAS u32x4*)(L + R1_RT + (t * PS + d0) * 2) = w;
        w.x = pk2(Bt[0], Bt[1]); w.y = pk2(Bt[2], Bt[3]); w.z = pk2(Bt[4], Bt[5]); w.w = pk2(Bt[6], Bt[7]); *(LAS u32x4*)(L + R1_BT + (t * PS + d0) * 2) = w;
        w.x = pk2(Kt[0], Kt[1]); w.y = pk2(Kt[2], Kt[3]); w.z = pk2(Kt[4], Kt[5]); w.w = pk2(Kt[6], Kt[7]); *(LAS u32x4*)(L + R1_KT + (t * PS + d0) * 2) = w;
        bpart += __shfl_xor(bpart, 1); bpart += __shfl_xor(bpart, 2); bpart += __shfl_xor(bpart, 4);
        const u32x4 gw = *(const LAS u32x4*)(L + R1_GS + (t * PS + d0) * 2);
        const float gv[8] = {bflo(gw.x), bfhi(gw.x), bflo(gw.y), bfhi(gw.y), bflo(gw.z), bfhi(gw.z), bflo(gw.w), bfhi(gw.w)};
        w.x = pk2(bpart * vx[0] * gv[0], bpart * vx[1] * gv[1]); w.y = pk2(bpart * vx[2] * gv[2], bpart * vx[3] * gv[3]);
        w.z = pk2(bpart * vx[4] * gv[4], bpart * vx[5] * gv[5]); w.w = pk2(bpart * vx[6] * gv[6], bpart * vx[7] * gv[7]);
        *(u32x4*)((bf16_t*)(p.ws + WS_OAB) + (size_t)row * D + 512 + h * 64 + d0) = w;
        *(u32x4*)(rw2 + 2 * RW2_ARR + (size_t)(t * 64 + d0) * 2) = gw;
    }
    LDS_BARRIER();
    R1P(3);
    {
        f32x4 gab[2], gak[2], grb[2], grk[2];
#pragma unroll
        for (int nn = 0; nn < 2; ++nn) { const int tn = 2 * (wave & 1) + nn;
            gab[nn] = (f32x4){0.f, 0.f, 0.f, 0.f}; gak[nn] = gab[nn]; grb[nn] = gab[nn]; grk[nn] = gab[nn];
            if (tn <= tm) {
#pragma unroll
                for (int s2 = 0; s2 < 2; ++s2) { const int ao = ((16 * tm + c15) * PS + 32 * s2 + 8 * g) * 2, bo = ((16 * tn + c15) * PS + 32 * s2 + 8 * g) * 2;
                    const bf16x8 fa = *(const LAS bf16x8*)(L + R1_AT + ao), fr_ = *(const LAS bf16x8*)(L + R1_RT + ao), fb = *(const LAS bf16x8*)(L + R1_BT + bo), fk = *(const LAS bf16x8*)(L + R1_KT + bo);
                    gab[nn] = mfma16(fa, fb, gab[nn]); gak[nn] = mfma16(fa, fk, gak[nn]); grb[nn] = mfma16(fr_, fb, grb[nn]); grk[nn] = mfma16(fr_, fk, grk[nn]); } } }
        LDS_BARRIER();
#pragma unroll
        for (int nn = 0; nn < 2; ++nn) { const int tn = 2 * (wave & 1) + nn, icol = 16 * tn + c15;
            f32x4 lab;
#pragma unroll
            for (int e = 0; e < 4; ++e) { const int tt = 16 * tm + 4 * g + e; const bool strict = icol < tt, incl = icol <= tt;
                lab[e] = strict ? gab[nn][e] : 0.f;
                *(LAS unsigned short*)(L + R1_LAK + (tt * PS + icol) * 2) = (unsigned short)f2bf(strict ? gak[nn][e] : 0.f);
                *(LAS unsigned short*)(L + R1_LOFF + (tt * PS + icol) * 2) = (unsigned short)f2bf(icol < (tt & ~15) ? gab[nn][e] : 0.f);
                *(LAS unsigned short*)(L + R1_MRB + (tt * PS + icol) * 2) = (unsigned short)f2bf(incl ? grb[nn][e] : 0.f);
                *(LAS unsigned short*)(L + R1_MRK + (tt * PS + icol) * 2) = (unsigned short)f2bf(incl ? grk[nn][e] : 0.f); }
            *(LAS f32x4*)(L + R1_LABT + (icol * 64 + 16 * tm + 4 * g) * 4) = lab; }
    }
    LDS_BARRIER();
    R1P(4);
    {
#pragma unroll
        for (int nn = 0; nn < 2; ++nn) { const int tn = 2 * (wave & 1) + nn; f32x4 acc = {0.f, 0.f, 0.f, 0.f};
#pragma unroll
            for (int s2 = 0; s2 < 2; ++s2) acc = mfma16(*(const LAS bf16x8*)(L + R1_LAK + ((16 * tm + c15) * PS + 32 * s2 + 8 * g) * 2), *(const LAS bf16x8*)(L + R1_VT + ((16 * tn + c15) * PS + 32 * s2 + 8 * g) * 2), acc);
#pragma unroll
            for (int e = 0; e < 4; ++e) *(LAS float*)(L + R1_RHS + ((64 + 16 * tn + c15) * 65 + 16 * tm + 4 * g + e) * 4) = acc[e]; }
    }
    LDS_BARRIER();
    R1P(5);
#pragma unroll 1
    for (int Tb = 0; Tb < 4; ++Tb) {
        if (Tb > 0) {
            LAS unsigned char* XT = L + (wave < 4 ? R1_WT + (16 * wave) * PS * 2 : R1_ZT + (16 * (wave - 4)) * PS * 2);
            f32x4 acc = {0.f, 0.f, 0.f, 0.f};
            acc = mfma16(*(const LAS bf16x8*)(L + R1_LOFF + ((16 * Tb + c15) * PS + 8 * g) * 2), *(const LAS bf16x8*)(XT + (c15 * PS + 8 * g) * 2), acc);
            if (Tb == 3) acc = mfma16(*(const LAS bf16x8*)(L + R1_LOFF + ((16 * Tb + c15) * PS + 32 + 8 * g) * 2), *(const LAS bf16x8*)(XT + (c15 * PS + 32 + 8 * g) * 2), acc);
            LAS float* rp = (LAS float*)(L + R1_RHS + ((16 * wave + c15) * 65 + 16 * Tb + 4 * g) * 4);
#pragma unroll
            for (int e = 0; e < 4; ++e) rp[e] += acc[e];
            LDS_BARRIER();
        }
        if (tid < 128) {
            LAS float* xr = (LAS float*)(L + R1_RHS + (tid * 65 + 16 * Tb) * 4);
            float acc[16];
#pragma unroll
            for (int e = 0; e < 16; ++e) acc[e] = xr[e];
#pragma unroll
            for (int ii = 0; ii < 15; ++ii) { const float xi = acc[ii];
#pragma unroll
                for (int q = (ii + 1) / 4; q < 4; ++q) { const f32x4 lv = *(const LAS f32x4*)(L + R1_LABT + ((16 * Tb + ii) * 64 + 16 * Tb + 4 * q) * 4);
#pragma unroll
                    for (int e = 0; e < 4; ++e) if (4 * q + e > ii) acc[4 * q + e] = fmaf(lv[e], xi, acc[4 * q + e]); } }
#pragma unroll
            for (int e = 0; e < 16; ++e) xr[e] = acc[e];
            LAS unsigned char* dst = L + (tid < 64 ? R1_WT + tid * PS * 2 : R1_ZT + (tid - 64) * PS * 2) + 32 * Tb;
            u32x4 w0, w1; w0.x = pk2(acc[0], acc[1]); w0.y = pk2(acc[2], acc[3]); w0.z = pk2(acc[4], acc[5]); w0.w = pk2(acc[6], acc[7]);
            w1.x = pk2(acc[8], acc[9]); w1.y = pk2(acc[10], acc[11]); w1.z = pk2(acc[12], acc[13]); w1.w = pk2(acc[14], acc[15]);
            *(LAS u32x4*)dst = w0; *(LAS u32x4*)(dst + 16) = w1;
        }
        if (Tb < 3) LDS_BARRIER();
    }
    LDS_BARRIER();
    R1P(6);
    if (next_unit >= 0) r1_load_rows(U, next_unit, tid, pf);
    {
        unsigned char* rw1 = p.ws + WS_RW1 + (size_t)unit * 16384;
#pragma unroll
        for (int nn = 0; nn < 2; ++nn) { const int tn = 2 * (wave & 1) + nn, col = 16 * tn + c15, r0 = 16 * tm + 4 * g;
            f32x4 aP = {0.f, 0.f, 0.f, 0.f}, aQ = aP, aG = aP, aY = aP;
#pragma unroll
            for (int s2 = 0; s2 < 2; ++s2) { const int ro = ((16 * tm + c15) * PS + 32 * s2 + 8 * g) * 2, co = ((16 * tn + c15) * PS + 32 * s2 + 8 * g) * 2;
                const bf16x8 fWT = *(const LAS bf16x8*)(L + R1_WT + ro), fBTT = *(const LAS bf16x8*)(L + R1_BTT + ro), fKTT = *(const LAS bf16x8*)(L + R1_KTT + ro), fMRB = *(const LAS bf16x8*)(L + R1_MRB + ro), fMRK = *(const LAS bf16x8*)(L + R1_MRK + ro);
                const bf16x8 cBTT = *(const LAS bf16x8*)(L + R1_BTT + co), cZT = *(const LAS bf16x8*)(L + R1_ZT + co), cVT = *(const LAS bf16x8*)(L + R1_VT + co), cMRB = *(const LAS bf16x8*)(L + R1_MRB + co);
                aP = mfma16(fWT, cBTT, aP);
                aQ = mfma16(fBTT, cZT, aQ); aQ = mfma16(fKTT, cVT, aQ);
                aG = mfma16(fWT, cMRB, aG);
                aY = mfma16(fMRB, cZT, aY); aY = mfma16(fMRK, cVT, aY); }
            const float gcc = *(const LAS float*)(L + R1_GC + col * 4);
            const f32x4 gcr = *(const LAS f32x4*)(L + R1_GC + r0 * 4);
            const u32x2 rtw = *(const LAS u32x2*)(L + R1_RT + (col * PS + r0) * 2);
#pragma unroll
            for (int e = 0; e < 4; ++e) { aP[e] = (aP[e] + ((r0 + e) == col ? 1.0f : 0.f)) * gcc; aQ[e] *= gcr[e]; }
            aG[0] += bflo(rtw.x); aG[1] += bfhi(rtw.x); aG[2] += bflo(rtw.y); aG[3] += bfhi(rtw.y);
            *(u32x2*)(rw1 + (size_t)(col * 64 + r0) * 2) = pk4(aP);
            *(u32x2*)(rw1 + 8192 + (size_t)(col * 64 + r0) * 2) = pk4(aG);
            *(u32x2*)(rw2 + (size_t)(col * 64 + r0) * 2) = pk4(aQ);
            *(u32x2*)(rw2 + RW2_ARR + (size_t)(col * 64 + r0) * 2) = pk4(aY); }
    }
    LDS_BARRIER();
    R1P(7);
}

constexpr int R2_SV = 0, R2_YS = 2 * 64 * PS * 2, R2_END = R2_YS + 2 * 64 * 68 * 4;
__device__ __forceinline__ void rwkv_scan(const Params& p, int l, int bh, unsigned char* lds) {
    const int tid = otid(), wave = tid >> 6, lane = tid & 63, c15 = lane & 15, g = lane >> 4;
    const int b = bh >> 3, h = bh & 7, role = wave >> 2, j = wave & 3, vcol = 16 * j + c15;
    LAS unsigned char* L = (LAS unsigned char*)lds;
    for (int i = tid; i < 2 * 64 * PS * 2 / 4; i += NTHREADS) ((LAS unsigned*)(L + R2_SV))[i] = 0u;
    LDS_BARRIER();
    const int et = tid >> 3, ev0 = 8 * (tid & 7);
    f32x4 gn0[2], gn1[2];
    { const float* gp = p.in[I_GNG] + l * 512 + h * 64 + ev0; const float* bp = p.in[I_GNB] + l * 512 + h * 64 + ev0;
      gn0[0] = *(const f32x4*)gp; gn0[1] = *(const f32x4*)(gp + 4); gn1[0] = *(const f32x4*)bp; gn1[1] = *(const f32x4*)(bp + 4); }
    bf16_t* OB = (bf16_t*)(p.ws + WS_OAB) + (size_t)(b * LP + et) * D + 512 + h * 64 + ev0;
    const int unit0 = (b * NCH) * 8 + h;
    const unsigned char* rw1b = p.ws + WS_RW1 + (role ? 8192 : 0) + (size_t)(c15 * 64 + 8 * g) * 2;
    const unsigned char* rw2b = p.ws + WS_RW2 + (role ? RW2_ARR : 0) + (size_t)(vcol * 64 + 4 * g) * 2;
    const unsigned char* ggb = p.ws + WS_RW2 + 2 * RW2_ARR + (size_t)(et * 64 + ev0) * 2;
    bf16x8 A0[4][2], A1[4][2]; u32x2 I0[4], I1[4];
    u32x4 G0 = {0u, 0u, 0u, 0u}, O0 = G0, G1, O1;
#define R2_LOAD(AA, II, cc) do { const size_t un_ = (size_t)(unit0 + 8 * ((cc) < NCH ? (cc) : NCH - 1)); \
        _Pragma("unroll") for (int m = 0; m < 4; ++m) { II[m] = *(const u32x2*)(rw2b + un_ * 8192 + 32 * m); \
            _Pragma("unroll") for (int s2 = 0; s2 < 2; ++s2) AA[m][s2] = *(const bf16x8*)(rw1b + un_ * 16384 + (16 * m * 64 + 32 * s2) * 2); } } while (0)
    R2_LOAD(A0, I0, 0); R2_LOAD(A1, I1, 1);
    G1 = *(const u32x4*)(ggb + (size_t)unit0 * 8192); O1 = *(const u32x4*)OB;
#pragma unroll 1
    for (int c = 0; c <= NCH; ++c) {
        const int cur = c & 1;
        bf16x8 A2[4][2]; u32x2 I2[4];
        R2_LOAD(A2, I2, c + 2);
        u32x4 G2, O2; { const int cn = c + 1 < NCH ? c + 1 : NCH - 1; G2 = *(const u32x4*)(ggb + (size_t)(unit0 + 8 * cn) * 8192); O2 = *(const u32x4*)(OB + (size_t)(64 * cn) * D); }
        if (c > 0) {
            const f32x4 y0 = *(const LAS f32x4*)(L + R2_YS + ((cur ^ 1) * 64 * 68 + et * 68 + ev0) * 4), y1 = *(const LAS f32x4*)(L + R2_YS + ((cur ^ 1) * 64 * 68 + et * 68 + ev0 + 4) * 4);
            float s1 = (y0[0] + y0[1]) + (y0[2] + y0[3]) + (y1[0] + y1[1]) + (y1[2] + y1[3]);
            s1 = sum8(s1); const float mean = s1 * (1.f / 64.f);
            const f32x4 d0 = y0 - mean, d1 = y1 - mean;
            float s2_ = (d0[0] * d0[0] + d0[1] * d0[1]) + (d0[2] * d0[2] + d0[3] * d0[3]) + (d1[0] * d1[0] + d1[1] * d1[1]) + (d1[2] * d1[2] + d1[3] * d1[3]);
            s2_ = sum8(s2_); const float rstd = rsqrtf(s2_ * (1.f / 64.f) + GN_EPS);
            const float gv[8] = {bflo(G0.x), bfhi(G0.x), bflo(G0.y), bfhi(G0.y), bflo(G0.z), bfhi(G0.z), bflo(G0.w), bfhi(G0.w)};
            const float ov[8] = {bflo(O0.x), bfhi(O0.x), bflo(O0.y), bfhi(O0.y), bflo(O0.z), bfhi(O0.z), bflo(O0.w), bfhi(O0.w)};
            float o[8];
#pragma unroll
            for (int i = 0; i < 4; ++i) { o[i] = ov[i] + (d0[i] * rstd * gn0[0][i] + gn1[0][i]) * gv[i]; o[4 + i] = ov[4 + i] + (d1[i] * rstd * gn0[1][i] + gn1[1][i]) * gv[4 + i]; }
            u32x4 w; w.x = pk2(o[0], o[1]); w.y = pk2(o[2], o[3]); w.z = pk2(o[4], o[5]); w.w = pk2(o[6], o[7]);
            *(u32x4*)(OB + (size_t)(64 * (c - 1)) * D) = w;
        }
        if (c < NCH) {
            bf16x8 bf_[2];
#pragma unroll
            for (int s2 = 0; s2 < 2; ++s2) bf_[s2] = *(const LAS bf16x8*)(L + R2_SV + cur * 64 * PS * 2 + (vcol * PS + 32 * s2 + 8 * g) * 2);
            f32x4 acc[4];
#pragma unroll
            for (int m = 0; m < 4; ++m) { acc[m] = (f32x4){bflo(I0[m].x), bfhi(I0[m].x), bflo(I0[m].y), bfhi(I0[m].y)};
#pragma unroll
                for (int s2 = 0; s2 < 2; ++s2) acc[m] = mfma16(A0[m][s2], bf_[s2], acc[m]); }
            if (role == 0) {
#pragma unroll
                for (int m = 0; m < 4; ++m) *(LAS u32x2*)(L + R2_SV + (cur ^ 1) * 64 * PS * 2 + (vcol * PS + 16 * m + 4 * g) * 2) = pk4(acc[m]);
            } else {
#pragma unroll
                for (int m = 0; m < 4; ++m)
#pragma unroll
                    for (int e = 0; e < 4; ++e) *(LAS float*)(L + R2_YS + (cur * 64 * 68 + (16 * m + 4 * g + e) * 68 + vcol) * 4) = acc[m][e];
            }
        }
        LDS_BARRIER();
#pragma unroll
        for (int m = 0; m < 4; ++m) { I0[m] = I1[m]; I1[m] = I2[m]; A0[m][0] = A1[m][0]; A0[m][1] = A1[m][1]; A1[m][0] = A2[m][0]; A1[m][1] = A2[m][1]; }
        G0 = G1; O0 = O1; G1 = G2; O1 = O2;
    }
#undef R2_LOAD
}

__device__ void rwkv_naive(const Params& p, int l, int bh, unsigned char* lds) {
    const int b = bh >> 3, h = bh & 7, tid = otid(), lane = tid & 63, wid = tid >> 6;
    const bf16_t* U = (const bf16_t*)(p.ws + WS_UAR);
    bf16_t* OB = (bf16_t*)(p.ws + WS_OAB);
    float* xs = (float*)lds;
    float* vr = xs + 32 * 256;
    float* vw = vr + 2048; float* vkk = vw + 2048; float* vbb = vkk + 2048; float* vk = vbb + 2048; float* vv = vk + 2048;
    float* gg = vv + 2048; float* bon = gg + 2048; float* ys = bon + 2048;
    const float* mu = p.in[I_MU] + l * R_COLS;
    const int hd = h * 64 + lane;
    const float w0 = p.in[I_W0][l * 512 + hd], a0 = p.in[I_A0][l * 512 + hd], kkc = p.in[I_KK][l * 512 + hd], kac = p.in[I_KA][l * 512 + hd], rkc = p.in[I_RK][l * 512 + hd];
    const float gng = p.in[I_GNG][l * 512 + hd], gnb = p.in[I_GNB][l * 512 + hd];
    const float mur = mu[hd], muk = mu[512 + hd], muv = mu[1024 + hd];
    const float* wup = p.in[I_WUP] + (size_t)l * 64 * 512 + hd; const float* aup = p.in[I_AUP] + (size_t)l * 64 * 512 + hd; const float* gup = p.in[I_GUP] + (size_t)l * 128 * 512 + hd;
    float S[8];
#pragma unroll
    for (int i = 0; i < 8; ++i) S[i] = 0.f;
    const int sv = tid >> 3, sq = tid & 7;
    for (int p0 = 0; p0 < LP; p0 += 32) {
        for (int idx = tid; idx < 32 * 256; idx += NTHREADS) {
            const int tt = idx >> 8, j = idx & 255, pos = p0 + tt; const size_t ro = (size_t)(b * LP + pos) * UARW;
            const float x = bf2f(U[ro + C_XW + j]); const float xp = pos > 0 ? bf2f(U[ro - UARW + C_XW + j]) : 0.f;
            float xv = x + (xp - x) * mu[1536 + j];
            if (j < 64) xv = tanhf(xv); else if (j >= 128) xv = sigmoidf_(xv);
            xs[idx] = xv;
        }
        __syncthreads();
        {
            float dw[4] = {0.f, 0.f, 0.f, 0.f}, da[4] = {0.f, 0.f, 0.f, 0.f}, dg[4] = {0.f, 0.f, 0.f, 0.f};
            for (int j = 0; j < 64; ++j) { const float w1 = wup[(size_t)j * 512], w2 = aup[(size_t)j * 512];
#pragma unroll
                for (int k = 0; k < 4; ++k) { dw[k] = fmaf(xs[(wid * 4 + k) * 256 + j], w1, dw[k]); da[k] = fmaf(xs[(wid * 4 + k) * 256 + 64 + j], w2, da[k]); } }
            for (int j = 0; j < 128; ++j) { const float w3 = gup[(size_t)j * 512];
#pragma unroll
                for (int k = 0; k < 4; ++k) dg[k] = fmaf(xs[(wid * 4 + k) * 256 + 128 + j], w3, dg[k]); }
#pragma unroll
            for (int k = 0; k < 4; ++k) {
                const int tt = wid * 4 + k, pos = p0 + tt; const size_t ro = (size_t)(b * LP + pos) * UARW;
                float r = bf2f(U[ro + C_R + hd]), kx = bf2f(U[ro + C_RK + hd]), vx = bf2f(U[ro + C_RV + hd]);
                if (pos > 0) { const float rp = bf2f(U[ro - UARW + C_R + hd]), kp = bf2f(U[ro - UARW + C_RK + hd]), vp = bf2f(U[ro - UARW + C_RV + hd]);
                    r += (rp - r) * mur; kx += (kp - kx) * muk; vx += (vp - vx) * muv; }
                else { r -= r * mur; kx -= kx * muk; vx -= vx * muv; }
                const float z = -(w0 + dw[k]); const float sp = fmaxf(z, 0.f) + log1pf(__expf(-fabsf(z)));
                const float logw = -sp - 0.5f; const float w = __expf(-__expf(logw));
                const float a = sigmoidf_(a0 + da[k]);
                float kk = kx * kkc; const float nrm = wave_sum(kk * kk); kk *= rsqrtf(fmaxf(nrm, 1e-24f));
                const float kmod = kx * (1.0f + (a - 1.0f) * kac);
                const float bsum = wave_sum(r * kmod * rkc);
                vr[tt * 64 + lane] = r; vw[tt * 64 + lane] = w; vkk[tt * 64 + lane] = kk; vbb[tt * 64 + lane] = kk * a; vk[tt * 64 + lane] = kmod; vv[tt * 64 + lane] = vx;
                gg[tt * 64 + lane] = dg[k]; bon[tt * 64 + lane] = bsum * vx;
            }
        }
        __syncthreads();
        for (int tt = 0; tt < 32; ++tt) {
            const f32x4 k0 = *(const f32x4*)(vkk + tt * 64 + sq * 8), k1 = *(const f32x4*)(vkk + tt * 64 + sq * 8 + 4);
            const f32x4 w0v = *(const f32x4*)(vw + tt * 64 + sq * 8), w1v = *(const f32x4*)(vw + tt * 64 + sq * 8 + 4);
            const f32x4 b0 = *(const f32x4*)(vbb + tt * 64 + sq * 8), b1 = *(const f32x4*)(vbb + tt * 64 + sq * 8 + 4);
            const f32x4 m0 = *(const f32x4*)(vk + tt * 64 + sq * 8), m1 = *(const f32x4*)(vk + tt * 64 + sq * 8 + 4);
            const f32x4 r0 = *(const f32x4*)(vr + tt * 64 + sq * 8), r1 = *(const f32x4*)(vr + tt * 64 + sq * 8 + 4);
            const float vt = vv[tt * 64 + sv];
            float sa = 0.f;
#pragma unroll
            for (int i = 0; i < 4; ++i) { sa = fmaf(S[i], k0[i], sa); sa = fmaf(S[4 + i], k1[i], sa); }
            sa += __shfl_xor(sa, 1); sa += __shfl_xor(sa, 2); sa += __shfl_xor(sa, 4);
            sa = -sa; float y = 0.f;
#pragma unroll
            for (int i = 0; i < 4; ++i) { S[i] = S[i] * w0v[i] + sa * b0[i] + vt * m0[i]; S[4 + i] = S[4 + i] * w1v[i] + sa * b1[i] + vt * m1[i];
                y = fmaf(S[i], r0[i], y); y = fmaf(S[4 + i], r1[i], y); }
            y += __shfl_xor(y, 1); y += __shfl_xor(y, 2); y += __shfl_xor(y, 4);
            if (sq == 0) ys[tt * 64 + sv] = y;
        }
        __syncthreads();
#pragma unroll
        for (int k = 0; k < 4; ++k) { const int tt = wid * 4 + k, pos = p0 + tt; const float y = ys[tt * 64 + lane];
            const float m = wave_sum(y) * (1.f / 64.f); const float dv = y - m; const float var = wave_sum(dv * dv) * (1.f / 64.f);
            const float o = (dv * rsqrtf(var + GN_EPS) * gng + gnb + bon[tt * 64 + lane]) * gg[tt * 64 + lane];
            OB[(size_t)(b * LP + pos) * D + 512 + hd] = (bf16_t)f2bf(o); }
        __syncthreads();
    }
}

__device__ __forceinline__ int pair_index(int a, int b) {   return a == 0 ? b - 1 : (a == 1 ? b + 1 : 5); }
__device__ __forceinline__ void pair_of(int idx, int& a, int& b) { a = idx < 3 ? 0 : (idx < 5 ? 1 : 2); b = idx < 3 ? idx + 1 : (idx < 5 ? idx - 1 : 3); }
__device__ __forceinline__ void ln1_rows(const Params& p, int l, unsigned char* lds, int row0, bool stage) {
    const int tid = otid(), lane = tid & 63, gw = row0 + 8 * (tid >> 6), NGW = 1, TEND = gw + 8;
    int* lcnt = (int*)(lds + 65536); int* lbase = lcnt + 32; int* rec = lcnt + 64;
    __syncthreads();
    if (tid < 32) lcnt[tid] = 0;
    float* wr_s = (float*)lds;
    if (stage) for (int i = tid; i < D * 16 / 4; i += NTHREADS) { const f32x4 w = ((const f32x4*)p.in[I_WROUTER])[i]; const int c = i >> 2, e0 = (i & 3) * 4;
        wr_s[(e0 + 0) * D + c] = w[0]; wr_s[(e0 + 1) * D + c] = w[1]; wr_s[(e0 + 2) * D + c] = w[2]; wr_s[(e0 + 3) * D + c] = w[3]; }
    __syncthreads();
    unsigned* cls_cnt = (unsigned*)(p.ws + WS_CTL) + CW_CLS + l * 512;
    int* lists = (int*)(p.ws + WS_LIST); f32x2* gl = (f32x2*)(p.ws + WS_LIST + 2 * MiB);
    const float* g = p.in[I_LN1G] + l * D; const float* bt = p.in[I_LN1B] + l * D;
    f32x4 vn[4];
    { const float* h0 = hrow(p, gw);
#pragma unroll
      for (int j = 0; j < 4; ++j) vn[j] = *(const f32x4*)(h0 + 4 * lane + 256 * j); }
    int nrec = 0;
    for (int r = gw; r < TEND; r += NGW) {
        f32x4 v[4];
#pragma unroll
        for (int j = 0; j < 4; ++j) v[j] = vn[j];
        { const float* h1 = hrow(p, r + NGW < TEND ? r + NGW : r);
#pragma unroll
          for (int j = 0; j < 4; ++j) vn[j] = *(const f32x4*)(h1 + 4 * lane + 256 * j); }
        if (is_dummy(r)) {
#pragma unroll
            for (int j = 0; j < 4; ++j) v[j] = (f32x4){0.f, 0.f, 0.f, 0.f};
            store_row(p, r, v, lane, true); continue; }
        ln_wave(v, g, bt, lane);
        store_row(p, r, v, lane, false);
        float lg[16];
#pragma unroll
        for (int e = 0; e < 16; ++e) lg[e] = 0.f;
#pragma unroll
        for (int e = 0; e < 16; ++e)
#pragma unroll
            for (int j = 0; j < 4; ++j) { const f32x4 w = *(const f32x4*)(wr_s + e * D + 4 * lane + 256 * j);
                lg[e] = fmaf(v[j][0], w[0], lg[e]); lg[e] = fmaf(v[j][1], w[1], lg[e]); lg[e] = fmaf(v[j][2], w[2], lg[e]); lg[e] = fmaf(v[j][3], w[3], lg[e]); }
        float mine = 0.f;
#pragma unroll
        for (int e = 0; e < 16; ++e) { const float rs = sum16(lg[e]); mine = (lane & 15) == e ? rs : mine; }
        mine += __shfl_xor(mine, 16); mine += __shfl_xor(mine, 32);
#pragma unroll
        for (int e = 0; e < 16; ++e) lg[e] = __builtin_bit_cast(float, __builtin_amdgcn_readlane(__builtin_bit_cast(int, mine), e));
        float s[16], sel[16];
#pragma unroll
        for (int e = 0; e < 16; ++e) { s[e] = sigmoidf_(lg[e]); sel[e] = s[e] + p.in[I_BROUTER][e]; }
        int gbest = 0; float gsc = -INFINITY;
#pragma unroll
        for (int gi = 0; gi < 4; ++gi) { float m1 = -INFINITY, m2 = -INFINITY;
#pragma unroll
            for (int j = 0; j < 4; ++j) { const float x = sel[gi * 4 + j]; if (x > m1) { m2 = m1; m1 = x; } else if (x > m2) m2 = x; }
            const float sc = m1 + m2; if (sc > gsc) { gsc = sc; gbest = gi; } }
        float sg[4], sgs[4];
#pragma unroll
        for (int j = 0; j < 4; ++j) { sg[j] = gbest == 0 ? sel[j] : (gbest == 1 ? sel[4 + j] : (gbest == 2 ? sel[8 + j] : sel[12 + j])); sgs[j] = gbest == 0 ? s[j] : (gbest == 1 ? s[4 + j] : (gbest == 2 ? s[8 + j] : s[12 + j])); }
        int j1 = 0;
#pragma unroll
        for (int j = 1; j < 4; ++j) if (sg[j] > sg[j1]) j1 = j;
        int j2 = j1 == 0 ? 1 : 0;
#pragma unroll
        for (int j = 0; j < 4; ++j) if (j != j1 && j != j2 && sg[j] > sg[j2]) j2 = j;
        const int ja = j1 < j2 ? j1 : j2, jb = j1 < j2 ? j2 : j1;
        float sa_ = 0.f, sb_ = 0.f;
#pragma unroll
        for (int j = 0; j < 4; ++j) { if (j == ja) sa_ = sgs[j]; if (j == jb) sb_ = sgs[j]; }
        const float inv = 1.0f / (sa_ + sb_);
        const int cls = gbest * 6 + pair_index(ja, jb);
        if (lane == 0) { const int loc = __hip_atomic_fetch_add(lcnt + cls, 1, __ATOMIC_RELAXED, __HIP_MEMORY_SCOPE_WORKGROUP); rec[(tid >> 6) * 32 + 2 * nrec] = r; rec[(tid >> 6) * 32 + 2 * nrec + 1] = (cls << 16) | loc; gl[r] = (f32x2){sa_ * inv, sb_ * inv}; }
        ++nrec;
    }
    __syncthreads();
    if (tid < 24) lbase[tid] = (int)atomicAdd(cls_cnt + 16 * tid, (unsigned)lcnt[tid]);
    __syncthreads();
    if (lane < nrec) { const int r = rec[(tid >> 6) * 32 + 2 * lane], cl = rec[(tid >> 6) * 32 + 2 * lane + 1]; const int cls = cl >> 16; lists[(size_t)cls * T + lbase[cls] + (cl & 0xffff)] = r; }
}


constexpr size_t WS_CH1 = 655360;
constexpr int CH1_NM = 260, CH1_NW = 260, CH1_NC = 96, CH1_NL = 260, CH1_TOT = CH1_NM + CH1_NW + CH1_NC + CH1_NL;
__device__ __forceinline__ void task_signal(unsigned* c0, unsigned* c1) {
    asm volatile("s_waitcnt vmcnt(0)" ::: "memory");
    __syncthreads();
    if (otid() == 0) { __builtin_amdgcn_fence(__ATOMIC_RELEASE, "agent"); asm volatile("s_waitcnt vmcnt(0)" ::: "memory");
        __hip_atomic_fetch_add(c0, 1u, __ATOMIC_RELAXED, __HIP_MEMORY_SCOPE_AGENT); if (c1) __hip_atomic_fetch_add(c1, 1u, __ATOMIC_RELAXED, __HIP_MEMORY_SCOPE_AGENT); }
}
__device__ __forceinline__ void task_wait(unsigned* c, unsigned target) {
    if (otid() == 0) { unsigned sp = 0; while (__hip_atomic_load(c, __ATOMIC_RELAXED, __HIP_MEMORY_SCOPE_AGENT) < target && ++sp < (1u << 24)) __builtin_amdgcn_s_sleep(2);
        __builtin_amdgcn_fence(__ATOMIC_ACQUIRE, "agent"); asm volatile("s_waitcnt vmcnt(0)" ::: "memory"); }
    __syncthreads();
}
__device__ __forceinline__ void conv_expert_items(const Params& p, int l, LAS unsigned char* lds, int it0, int it1);
__device__ __forceinline__ void chain1_phase(int l, unsigned char* lds, LAS unsigned char* ldsl, unsigned long long& pacc) {
    unsigned long long pt0 = 0;
#define C1P_B(k) do { if (PROBE_PHASE == (k)) pt0 = __builtin_amdgcn_s_memrealtime(); } while (0)
#define C1P_E(k) do { if (PROBE_PHASE == (k)) pacc += __builtin_amdgcn_s_memrealtime() - pt0; } while (0)
    int staged = 0;
    for (;;) {
        unsigned* chq = (unsigned*)(PP().ws + WS_CH1) + 1024 * l;
        volatile int* uw = (volatile int*)(lds + 144000);
        __syncthreads();
        if (otid() == 0) *uw = (int)atomicAdd(chq, 1u);
        __syncthreads();
        const int t = __builtin_amdgcn_readfirstlane(*uw);
        if (t >= CH1_TOT) break;
        if (t < CH1_NM) { const int pm = t >> 2, pn = t & 3;
            C1P_B(50); merge_unit(l, ldsl, pm, pn);
            task_signal(chq + 64 + pm, chq + 16); C1P_E(50);
        } else if (t < CH1_NM + CH1_NW) { const int u = t - CH1_NM, pm = u >> 2, pn = u & 3;
            C1P_B(54); task_wait(chq + 64 + pm, 4u); C1P_E(54);
            C1P_B(51); wout_unit(l, ldsl, pm, pn);
            task_signal(chq + 192 + pm, nullptr); C1P_E(51);
        } else if (t < CH1_NM + CH1_NW + CH1_NC) { const int u = t - CH1_NM - CH1_NW;
            C1P_B(54); task_wait(chq + 16, (unsigned)CH1_NM); C1P_E(54);
            C1P_B(52); conv_expert_items(PP(), l, ldsl, u * 128, u * 128 + 128); C1P_E(52);
        } else { const int u = t - CH1_NM - CH1_NW - CH1_NC, pm = u >> 2, qr = u & 3;
            C1P_B(54); task_wait(chq + 16, (unsigned)CH1_NM);
            task_wait(chq + 192 + pm, 4u); C1P_E(54);
            C1P_B(53); ln1_rows(PP(), l, lds, pm * 256 + qr * 64, staged == 0); staged = 1; C1P_E(53);
        }
    }
}

struct ClsTab { int cnt[24]; int tile0[25]; int row0[24]; };
__device__ __forceinline__ void build_cls_table(const Params& p, int l, int* tab  ) {
    if (otid() == 0) { const unsigned* c = (const unsigned*)(p.ws + WS_CTL) + CW_CLS + l * 512; int acc = 0;
        for (int i = 0; i < 24; ++i) { const int n = (int)__hip_atomic_load(c + 16 * i, __ATOMIC_RELAXED, __HIP_MEMORY_SCOPE_AGENT); tab[i] = n; tab[24 + i] = acc; acc += (n + 255) >> 8; }
        tab[48] = acc; }
    __syncthreads();
}
__device__ __forceinline__ int find_cls(const int* tab, int tile) { int c = 0;
#pragma unroll 1
    for (int i = 1; i < 24; ++i) if (tile >= tab[24 + i]) c = i;
    return c; }
__device__ __forceinline__ void moe_a_unit(int l, LAS unsigned char* lds, const int* tab, int tile, int pn) {
    const int tid = otid();
    unsigned voffB[2]; g8::make_voffB(voffB, D * 2, true);
    {
        const int cls = find_cls(tab, tile), rt = tile - tab[24 + cls], n = tab[cls];
        int ja, jb; pair_of(cls % 6, ja, jb); const int eslot = pn >> 2, e = (cls / 6) * 4 + (eslot ? jb : ja), jblk = pn & 3;
        unsigned voffA[2][2]; { const int* lists = (const int*)(PP().ws + WS_LIST);
#pragma unroll
        for (int i = 0; i < 2; ++i) { int R, C; g8::stage_rc(tid * 16 + i * 8192, R, C);
#pragma unroll
            for (int hh = 0; hh < 2; ++hh) { const int li = rt * 256 + R + hh * 128; const int tok = li < n ? lists[(size_t)cls * T + li] : 0;
                voffA[hh][i] = (unsigned)tok * (D * 2) + (unsigned)C * 2u; } } }
        g8::Acc acc; g8::zero_acc(acc);
        const char* Bb = (const char*)(PP().ws + WS_WEXP) + ((size_t)e * 1024 + jblk * 256) * D * 2;
        const g8::KSeg s = g8::seg1((const char*)(PP().ws + WS_HB), Bb, Bb + (size_t)128 * D * 2, D / 64);
        g8::kloop<true, false>(lds, acc, s, voffA, voffB, 0);
        EPI_COORDS();
        const int* lists = (const int*)(PP().ws + WS_LIST); const f32x2* gl = (const f32x2*)(PP().ws + WS_LIST + 2 * MiB); bf16_t* ACT = (bf16_t*)(PP().ws + WS_ACT);
        int tk[2][4]; float gt[2][4];
#pragma unroll
        for (int ai = 0; ai < 2; ++ai)
#pragma unroll
            for (int m = 0; m < 4; ++m) { const int li = rt * 256 + ai * 128 + wr * 64 + m * 16 + fr; tk[ai][m] = li < n ? lists[(size_t)cls * T + li] : -1; }
#pragma unroll
        for (int ai = 0; ai < 2; ++ai)
#pragma unroll
            for (int m = 0; m < 4; ++m) { const f32x2 g2 = gl[tk[ai][m] >= 0 ? tk[ai][m] : 0]; gt[ai][m] = tk[ai][m] >= 0 ? (eslot ? g2[1] : g2[0]) : 0.f; }
#pragma unroll
        for (int ai = 0; ai < 2; ++ai)
#pragma unroll
            for (int m = 0; m < 4; ++m) { const float gate = gt[ai][m];
                const f32x4 h1a = acc[ai][0][m][0], h1b = acc[ai][0][m][1], h3a = acc[ai][1][m][0], h3b = acc[ai][1][m][1];
                float o[8];
#pragma unroll
                for (int c = 0; c < 4; ++c) { o[c] = gate * (h1a[c] * sigmoidf_(h1a[c])) * h3a[c]; o[4 + c] = gate * (h1b[c] * sigmoidf_(h1b[c])) * h3b[c]; }
                u32x4 w; w.x = pk2(o[0], o[1]); w.y = pk2(o[2], o[3]); w.z = pk2(o[4], o[5]); w.w = pk2(o[6], o[7]);
                *(u32x4*)(ACT + (size_t)(tile * 256 + ai * 128 + wr * 64 + m * 16 + fr) * D + eslot * 512 + jblk * 128 + wc * 32 + 8 * fq) = w; }
    }
}
__device__ __forceinline__ void moe_b_unit(int l, LAS unsigned char* lds, const int* tab, int tile, int pn) {
    unsigned voffA[2][2], voffB[2]; g8::make_voff_contig(voffA, D * 2); g8::make_voffB(voffB, 512 * 2, false);
    {
        const int cls = find_cls(tab, tile), rt = tile - tab[24 + cls], n = tab[cls];
        int ja, jb; pair_of(cls % 6, ja, jb); const int ea = (cls / 6) * 4 + ja, eb = (cls / 6) * 4 + jb;
        g8::Acc acc; g8::zero_acc(acc);
        const char* At = (const char*)(PP().ws + WS_ACT) + (size_t)tile * 256 * D * 2;
        const char* W2 = (const char*)(PP().ws + WS_WEXP + 32 * MiB);
        const char* Ba = W2 + ((size_t)ea * 1024 + pn * 256) * 512 * 2; const char* Bb = W2 + ((size_t)eb * 1024 + pn * 256) * 512 * 2;
        g8::KSeg s2 = g8::seg1(At, Ba, Ba + (size_t)128 * 512 * 2, 16); s2.nt0 = 8; s2.A2 = At + 1024; s2.B02 = Bb; s2.B12 = Bb + (size_t)128 * 512 * 2;
        g8::kloop<false, true>(lds, acc, s2, voffA, voffB, 128 * D * 2);
        EPI_COORDS();
        const int* lists = (const int*)(PP().ws + WS_LIST);
        const int col0 = pn * 256 + wc * 32 + 4 * fq;
        int tk[2][4];
#pragma unroll
        for (int ai = 0; ai < 2; ++ai)
#pragma unroll
            for (int m = 0; m < 4; ++m) { const int li = rt * 256 + ai * 128 + wr * 64 + m * 16 + fr; tk[ai][m] = li < n ? lists[(size_t)cls * T + li] : -1; }
#pragma unroll
        for (int ai = 0; ai < 2; ++ai) { asm volatile("" ::: "memory");
            f32x4 pre[4][2][2]; float* hr[4];
#pragma unroll
            for (int m = 0; m < 4; ++m) { hr[m] = hrow(PP(), tk[ai][m] >= 0 ? tk[ai][m] : 0) + col0;
#pragma unroll
                for (int bj = 0; bj < 2; ++bj)
#pragma unroll
                    for (int nn = 0; nn < 2; ++nn) pre[m][bj][nn] = *(const f32x4*)(hr[m] + bj * 128 + nn * 16); }
#pragma unroll
            for (int m = 0; m < 4; ++m) if (tk[ai][m] >= 0) {
#pragma unroll
                for (int bj = 0; bj < 2; ++bj)
#pragma unroll
                    for (int nn = 0; nn < 2; ++nn) *(f32x4*)(hr[m] + bj * 128 + nn * 16) = pre[m][bj][nn] * ALPHA + acc[ai][bj][m][nn]; } }
    }
}

__device__ __forceinline__ void chain2_phase(int l, unsigned char* lds, LAS unsigned char* ldsl, const int* tab) {
    const int ntiles = tab[48], nA = 8 * ntiles, ntot = nA + 4 * ntiles;
    for (;;) {
        unsigned* chq = (unsigned*)(PP().ws + WS_CH1) + 1024 * l + 512;
        volatile int* uw = (volatile int*)(lds + 144000);
        __syncthreads();
        if (otid() == 0) *uw = (int)atomicAdd(chq, 1u);
        __syncthreads();
        const int t = __builtin_amdgcn_readfirstlane(*uw);
        if (t >= ntot) break;
        if (t < nA) { const int tile = t >> 3;
            moe_a_unit(l, ldsl, tab, tile, t & 7);
            task_signal(chq + 16 + tile, nullptr);
        } else { const int u = t - nA, tile = u >> 2;
            task_wait(chq + 16 + tile, 8u);
            moe_b_unit(l, ldsl, tab, tile, u & 3);
        }
    }
}
__device__ __forceinline__ void ln2_phase(const Params& p, int l) {
    const int tid = otid(), lane = tid & 63, gw = obid() * NWAVES + (tid >> 6), NGW = gridDim.x * NWAVES;
    const float* g = p.in[I_LN2G] + l * D; const float* bt = p.in[I_LN2B] + l * D;
    for (int r = gw; r < T; r += NGW) {
        f32x4 v[4];
        if (is_dummy(r)) {
#pragma unroll
            for (int j = 0; j < 4; ++j) v[j] = (f32x4){0.f, 0.f, 0.f, 0.f};
            store_row(p, r, v, lane, true); continue; }
        const float* hr = hrow(p, r);
#pragma unroll
        for (int j = 0; j < 4; ++j) v[j] = *(const f32x4*)(hr + 4 * lane + 256 * j);
        ln_wave(v, g, bt, lane);
        store_row(p, r, v, lane, false);
    }
}


#define XB_TMO      128
#define XB_XCNT(j)  (256  + 64 * (j))
#define XB_XSUB(j)  (1280 + 64 * (j))
#define XB_XGEN(j)  (2304 + 64 * (j))
#define XB_TOP      3328
#define XB_TOPGEN   3392
#define XCD_BAR_WORDS 3456
#define XB_SPIN_CAP (1u << 22)
constexpr size_t WS_BAR = 8192;
constexpr int LDS_BARST = LDS_BYTES - 16;
__device__ __forceinline__ unsigned xb_ld(unsigned* p)              { return __hip_atomic_load(p, __ATOMIC_RELAXED, __HIP_MEMORY_SCOPE_AGENT); }
__device__ __forceinline__ unsigned xb_add(unsigned* p, unsigned v) { return __hip_atomic_fetch_add(p, v, __ATOMIC_RELAXED, __HIP_MEMORY_SCOPE_AGENT); }
__device__ __forceinline__ unsigned xb_xcc_id() { return (unsigned)__builtin_amdgcn_s_getreg((3 << 11) | 20) & 0xFu; }
#define XB_SPIN(cond, bar) do { unsigned _sp = 0; while (cond) { __builtin_amdgcn_s_sleep(1); \
    if ((++_sp & 255u) == 0u) { if (xb_ld(&(bar)[XB_TMO])) break; if (_sp > XB_SPIN_CAP) { atomicAdd(&(bar)[XB_TMO], 1u); break; } } } } while (0)
__device__ __forceinline__ void xcd_barrier_complete(unsigned* bar, unsigned x, unsigned& nloc, unsigned& nx) {
    const unsigned G = gridDim.x * gridDim.y * gridDim.z;
    unsigned sum, cnt, mine, sp = 0u;
    for (;;) {
        sum = 0u; cnt = 0u; mine = 0u;
#pragma unroll
        for (unsigned j = 0; j < 16; ++j) { const unsigned c = xb_ld(&bar[XB_XCNT(j)]); sum += c; cnt += (c > 0u) ? 1u : 0u; mine = (j == x) ? c : mine; }
        if (sum == G) break;
        __builtin_amdgcn_s_sleep(1);
        if ((++sp & 255u) == 0u) { if (xb_ld(&bar[XB_TMO])) break; if (sp > XB_SPIN_CAP) { atomicAdd(&bar[XB_TMO], 1u); break; } }
    }
    nloc = mine > 0u ? mine : 1u; nx = cnt > 0u ? cnt : 1u;
}
__device__ __forceinline__ void xcd_barrier(unsigned* bar, volatile LAS unsigned* st) {
    asm volatile("s_waitcnt vmcnt(0)" ::: "memory");
    __syncthreads();
    if (threadIdx.x == 0) {
        __builtin_amdgcn_s_waitcnt(0);
        const unsigned x = xb_xcc_id();
        unsigned nloc = st[0], nx = st[1];
        if (nloc == 0u) { xcd_barrier_complete(bar, x, nloc, nx); st[0] = nloc; st[1] = nx; }
        const unsigned old = xb_add(&bar[XB_XSUB(x)], 1u);
        const unsigned gen = old / nloc;
        if (old + 1u == (gen + 1u) * nloc) {
            __builtin_amdgcn_fence(__ATOMIC_RELEASE, "agent");
            asm volatile("s_waitcnt vmcnt(0)" ::: "memory");
            const unsigned og = xb_add(&bar[XB_TOP], 1u);
            const unsigned tg = og / nx;
            if (og + 1u == (tg + 1u) * nx) xb_add(&bar[XB_TOPGEN], 1u);
            else XB_SPIN(xb_ld(&bar[XB_TOPGEN]) == tg, bar);
            __builtin_amdgcn_fence(__ATOMIC_ACQUIRE, "agent");
            xb_add(&bar[XB_XGEN(x)], 1u);
            asm volatile("s_waitcnt vmcnt(0)" ::: "memory");
        } else {
            XB_SPIN(xb_ld(&bar[XB_XGEN(x)]) == gen, bar);
            __builtin_amdgcn_fence(__ATOMIC_ACQUIRE, "agent");
            asm volatile("s_waitcnt vmcnt(0)" ::: "memory");
        }
    }
    __syncthreads();
}

__global__ void __launch_bounds__(NTHREADS, 2) mega(Params p_unused) {
    extern __shared__ __attribute__((aligned(16))) unsigned char lds[];
    cg::grid_group grid = cg::this_grid();
    volatile LAS unsigned* barst = (volatile LAS unsigned*)((LAS unsigned char*)lds + LDS_BARST);
    { unsigned* bar0 = (unsigned*)(PP().ws + WS_BAR);
      if (threadIdx.x == 0) { barst[0] = 0u; barst[1] = 0u; (void)xb_add(bar0 + XB_XCNT(xb_xcc_id()), 1u); } }
    __syncthreads();
#define GBAR() xcd_barrier((unsigned*)(PP().ws + WS_BAR), barst)
    unsigned long long pr_t0 = 0, pr_acc = 0;
#define PH_BEGIN(k) do { if (PROBE_PHASE == (k)) pr_t0 = __builtin_amdgcn_s_memrealtime(); } while (0)
#define PH_END(k) do { if (PROBE_PHASE == (k)) pr_acc += __builtin_amdgcn_s_memrealtime() - pr_t0; } while (0)
#define LDSG() (lds + ozero())
#define LDSL() ((LAS unsigned char*)lds)

    PH_BEGIN(0);
    conv_small_weights(PP(), LDSL());
    ln_in_phase(PP());
    if (gridDim.y == 0x7fffffffu) grid.sync();
    GBAR();
    PH_END(0);
#pragma unroll 1
    for (int l = 0; l < DEPTH; ++l) {
        PH_BEGIN(1);
        inproj_phase(PP(), l, LDSL());
        GBAR();
        PH_END(1); PH_BEGIN(2);
        {
            unsigned* qctr = (unsigned*)(PP().ws + WS_CTL) + CW_R1Q + 2 * l;
            volatile int* uw = (volatile int*)(LDSG() + AT_UNIT);
            int ndone = 0;
            constexpr int QEND = INP_TAIL + BATCH * NCH * 8;
#define MIX_POP(dst) do { __syncthreads(); if (otid() == 0) *uw = (int)atomicAdd(qctr, 1u); __syncthreads(); dst = __builtin_amdgcn_readfirstlane(*uw); } while (0)
            int u; MIX_POP(u);
            while (u < INP_TAIL) { inproj_tail_unit(l, LDSL(), u); MIX_POP(u); }
            if (u < QEND) {
                R1PF pf; r1_load_rows((const bf16_t*)(PP().ws + WS_UAR), u - INP_TAIL, otid(), pf);
                do {
                    int un; MIX_POP(un);
                    if (PROBE_PHASE == 30) pr_t0 = __builtin_amdgcn_s_memrealtime();
                    rwkv_prep_unit(PP(), l, u - INP_TAIL, LDSG(), pr_acc, pf, un < QEND ? un - INP_TAIL : -1); ++ndone;
                    if (PROBE_PHASE == 30) pr_acc += __builtin_amdgcn_s_memrealtime() - pr_t0;
                    u = un;
                } while (u < QEND);
            }
#undef MIX_POP
            asm volatile("s_waitcnt vmcnt(0)" ::: "memory");
            __syncthreads();
            if (otid() == 0 && ndone > 0) { __builtin_amdgcn_fence(__ATOMIC_RELEASE, "agent"); asm volatile("s_waitcnt vmcnt(0)" ::: "memory"); __hip_atomic_fetch_add(qctr + 1, (unsigned)ndone, __ATOMIC_RELAXED, __HIP_MEMORY_SCOPE_AGENT); }
            const int bid = obid();
            if (bid < 32) {
                if (otid() == 0) { unsigned sp = 0; while (__hip_atomic_load(qctr + 1, __ATOMIC_RELAXED, __HIP_MEMORY_SCOPE_AGENT) < (unsigned)(BATCH * NCH * 8) && ++sp < (1u << 26)) __builtin_amdgcn_s_sleep(4);
                    __builtin_amdgcn_fence(__ATOMIC_ACQUIRE, "agent"); asm volatile("s_waitcnt vmcnt(0)" ::: "memory"); }
                __syncthreads();
                rwkv_scan(PP(), l, bid, LDSG());
            }
            attn_phase(PP(), l, LDSG(), pr_acc);
        }
        GBAR();
        PH_END(2); PH_BEGIN(4);
        chain1_phase(l, LDSG(), LDSL(), pr_acc);
        GBAR();
        PH_END(4); PH_BEGIN(7);
        { int toff = 140 * 1024; asm volatile("" : "+s"(toff)); int* tab = (int*)(lds + toff);
          build_cls_table(PP(), l, tab);
          chain2_phase(l, LDSG(), LDSL(), tab); }
        GBAR();
        PH_END(8); PH_BEGIN(9);
        ln2_phase(PP(), l);
        if (l + 1 < DEPTH) GBAR();
        PH_END(9);
    }
    if (PROBE_PHASE >= 0 && blockIdx.x == PROBE_BLOCK && threadIdx.x == 0) { const unsigned long long t = __builtin_amdgcn_s_memrealtime(); while (__builtin_amdgcn_s_memrealtime() - t < pr_acc) __builtin_amdgcn_s_sleep(8); }
}

extern "C" void kernel_launch(void* const* d_in, const int* in_sizes, int n_in, void* d_out, int out_size,
                              void* d_ws, size_t ws_size, hipStream_t stream) {
    static int grid_blocks = 0;
    if (grid_blocks == 0) {
        int dev = 0, cus = 0, per_cu = 0;
        if (n_in != 29 || ws_size < WS_END || out_size != BATCH * SEQ * D) { fprintf(stderr, "kernel_launch: unexpected problem (n_in %d, ws %zu, out %d)\n", n_in, ws_size, out_size); grid_blocks = -1; return; }
        (void)hipGetDevice(&dev);
        (void)hipDeviceGetAttribute(&cus, hipDeviceAttributeMultiprocessorCount, dev);
        (void)hipFuncSetAttribute((const void*)mega, hipFuncAttributeMaxDynamicSharedMemorySize, LDS_BYTES);
        (void)hipOccupancyMaxActiveBlocksPerMultiprocessor(&per_cu, (const void*)mega, NTHREADS, LDS_BYTES);
        if (per_cu < 1) { fprintf(stderr, "occupancy query returned %d\n", per_cu); grid_blocks = -1; return; }
        grid_blocks = cus;
    }
    if (grid_blocks < 0) return;
    (void)hipMemsetAsync((char*)d_ws + WS_CTL, 0, 32768, stream);
    (void)hipMemsetAsync((char*)d_ws + WS_CH1, 0, 16384, stream);
    Params p{};
    for (int i = 0; i < 29; ++i) p.in[i] = (const float*)d_in[i];
    p.out = (float*)d_out; p.ws = (unsigned char*)d_ws;
    void* args[] = {&p};
    hipError_t e = hipLaunchCooperativeKernel((const void*)mega, dim3(grid_blocks), dim3(NTHREADS), args, LDS_BYTES, stream);
    if (e != hipSuccess) fprintf(stderr, "cooperative launch failed: %s (grid %d)\n", hipGetErrorString(e), grid_blocks);
}
```

```cpp
#include <hip/hip_runtime.h>
#include <hip/hip_cooperative_groups.h>
#include <cstdio>
#include <cstdint>
#ifndef PROBE_PHASE
#define PROBE_PHASE -1
#endif
#define PROBE_BLOCK 0
#define PRB_B(k) do { if (PROBE_PHASE == (k)) pt0 = __builtin_amdgcn_s_memrealtime(); } while (0)
#define PRB_E(k) do { if (PROBE_PHASE == (k)) pacc += __builtin_amdgcn_s_memrealtime() - pt0; } while (0)
namespace cg = cooperative_groups;

#define LAS __attribute__((address_space(3)))
typedef unsigned short bf16_t;
typedef short bf16x8 __attribute__((ext_vector_type(8)));
typedef float f32x4 __attribute__((ext_vector_type(4)));
typedef float f32x2 __attribute__((ext_vector_type(2)));
typedef unsigned u32x4 __attribute__((ext_vector_type(4)));
typedef unsigned u32x2 __attribute__((ext_vector_type(2)));

constexpr int NTHREADS = 512, NWAVES = 8;
constexpr int D = 1024, BATCH = 4, SEQ = 4096, DEPTH = 2;
constexpr int LP = 4160;
constexpr int T = BATCH * LP;
constexpr int NCH = LP / 64;
constexpr int PADM = 48;
constexpr int A_COLS = 1064, R_COLS = 1792, IN_COLS = 4904;
constexpr int UA = 1280;
constexpr int UARW = 3072;
constexpr int NIN = 5120;
constexpr float LN_EPS = 1e-5f, GN_EPS = 64e-5f;
constexpr float ALPHA = 1.41421356237309515f;
constexpr int C_Q = 0, C_K = 512, C_V = 640, C_QI = 768, C_KI = 1024, C_WI = 1056;
constexpr int C_R = UA, C_RK = UA + 512, C_RV = UA + 1024, C_XW = UA + 1536, C_XA = UA + 1600, C_XG = UA + 1664;

constexpr size_t MiB = 1u << 20;
constexpr size_t WS_CTL = 0;
constexpr size_t WS_HM = 1 * MiB;
constexpr size_t WS_WSMALL = 2 * MiB;
constexpr size_t WSMALL_LAYER = 14 * MiB;
constexpr size_t WS_HB = 30 * MiB;
constexpr size_t WS_UAR = 63 * MiB;
constexpr size_t WS_GATES = 161 * MiB;
constexpr size_t WS_OAB = 226 * MiB;
constexpr size_t WS_LIST = WS_GATES + 48 * MiB;
constexpr size_t WS_END = 308 * MiB;
constexpr size_t WS_MERGED = WS_UAR;
constexpr size_t WS_ACT = WS_UAR + 33 * MiB;
constexpr size_t WS_WEXP = WS_GATES;
constexpr int ACT_ROWS_MAX = 16448 + 24 * 256;
static_assert(WS_ACT + (size_t)ACT_ROWS_MAX * 2048 <= WS_GATES, "act fits");
constexpr int CW_CLS = 1024;

constexpr int LDS_BYTES = 155648;

struct Params {
    const float* in[29];
    float* out;
    unsigned char* ws;
};
enum { I_X = 0, I_META, I_LNIN_G, I_LNIN_B, I_WIN, I_BGATE, I_MU, I_W0, I_WUP, I_A0, I_AUP, I_GUP, I_KK, I_KA, I_RK, I_GNG, I_GNB,
       I_WBA, I_WBB, I_WOUT, I_LN1G, I_LN1B, I_LN2G, I_LN2B, I_WROUTER, I_BROUTER, I_WEXP1, I_WEXP3, I_WEXP2 };

__device__ __forceinline__ int otid() { int t = threadIdx.x; asm volatile("" : "+v"(t)); return t; }
__device__ __forceinline__ const char* uptr(const char* p) { const unsigned long long v = (unsigned long long)p; const unsigned lo = __builtin_amdgcn_readfirstlane((unsigned)v), hi = __builtin_amdgcn_readfirstlane((unsigned)(v >> 32)); return (const char*)(((unsigned long long)hi << 32) | lo); }
__device__ __forceinline__ int ozero() { int z = 0; asm volatile("" : "+s"(z)); return z; }
__device__ __forceinline__ int obid() { int b = blockIdx.x; asm volatile("" : "+s"(b)); return b; }
typedef __bf16 bf16x2_t __attribute__((ext_vector_type(2)));
__device__ __forceinline__ unsigned f2bf(float f) { return (unsigned)__builtin_bit_cast(unsigned short, (__bf16)f); }
__device__ __forceinline__ unsigned pk2(float lo, float hi) { const f32x2 v = {lo, hi}; return __builtin_bit_cast(unsigned, __builtin_convertvector(v, bf16x2_t)); }
template <int CTRL> __device__ __forceinline__ float dpp_f(float v) { return __builtin_bit_cast(float, __builtin_amdgcn_update_dpp(0, __builtin_bit_cast(int, v), CTRL, 0xF, 0xF, true)); }
__device__ __forceinline__ float sum8(float v) { v += dpp_f<0xB1>(v); v += dpp_f<0x4E>(v); v += dpp_f<0x141>(v); return v; }
__device__ __forceinline__ float sum16(float v) { v = sum8(v); v += dpp_f<0x140>(v); return v; }
__device__ __forceinline__ float bf2f(unsigned short b) { return __builtin_bit_cast(float, (unsigned)b << 16); }
__device__ __forceinline__ float bflo(unsigned w) { return __builtin_bit_cast(float, w << 16); }
__device__ __forceinline__ float bfhi(unsigned w) { return __builtin_bit_cast(float, w & 0xffff0000u); }
__device__ __forceinline__ float wave_sum(float v) { v = sum16(v); v += __shfl_xor(v, 16); v += __shfl_xor(v, 32); return v; }
__device__ __forceinline__ float wave_max(float v) {
#pragma unroll
    for (int o = 1; o < 64; o <<= 1) v = fmaxf(v, __shfl_xor(v, o));
    return v;
}
__device__ __forceinline__ float sigmoidf_(float x) { return __builtin_amdgcn_rcpf(1.0f + __expf(-x)); }
__device__ __forceinline__ float* hrow(const Params& p, int r) {
    const int b = r / LP, pos = r - b * LP;
    return pos >= 64 ? p.out + ((size_t)(b * SEQ + (pos - 64)) << 10) : (float*)(p.ws + WS_HM) + ((size_t)(b * 64 + pos) << 10);
}
__device__ __forceinline__ bool is_dummy(int r) { return (r % LP) < PADM; }

__device__ __forceinline__ void transpose_item(const float* src, int ld_src, int col0, int nvalid, bf16_t* dst  , int ld_dst, LAS float* scr, int lane) {
    const int kr = lane >> 3, c4 = (lane & 7) * 4;
    f32x4 v[8];
#pragma unroll
    for (int i = 0; i < 8; ++i) v[i] = *(const f32x4*)(src + (size_t)(8 * i + kr) * ld_src + col0 + c4);
#pragma unroll
    for (int i = 0; i < 8; ++i) { LAS float* w = scr + (8 * i + kr) * 33 + c4;
        w[0] = c4 + 0 < nvalid ? v[i][0] : 0.f; w[1] = c4 + 1 < nvalid ? v[i][1] : 0.f; w[2] = c4 + 2 < nvalid ? v[i][2] : 0.f; w[3] = c4 + 3 < nvalid ? v[i][3] : 0.f; }
    asm volatile("s_waitcnt lgkmcnt(0)" ::: "memory");
    const int ch = lane & 7;
#pragma unroll
    for (int j = 0; j < 4; ++j) { const int n = (lane >> 3) + 8 * j; const LAS float* s = scr + (8 * ch) * 33 + n;
        u32x4 o; o.x = pk2(s[0 * 33], s[1 * 33]); o.y = pk2(s[2 * 33], s[3 * 33]); o.z = pk2(s[4 * 33], s[5 * 33]); o.w = pk2(s[6 * 33], s[7 * 33]);
        *(u32x4*)(dst + (size_t)n * ld_dst + 8 * ch) = o; }
    asm volatile("s_waitcnt lgkmcnt(0)" ::: "memory");
}

namespace g8 {
constexpr int BM = 256, BK = 64, HALF = 128, HTB = HALF * BK * 2, STAGE_BYTES = 8 * HTB;
__host__ __device__ __forceinline__ int lds_byte(int r, int c) { const int st = (r >> 4) * 2 + (c >> 5), rr = r & 15, cc = c & 31, ob = rr * 64 + cc * 2; return st * 1024 + (ob ^ (((ob >> 9) & 1) << 5)); }
__host__ __device__ __forceinline__ void stage_rc(int b, int& R, int& C) { const int st = b / 1024, sb = b % 1024, swz = sb ^ (((sb >> 9) & 1) << 5); R = (st >> 1) * 16 + swz / 64; C = (st & 1) * 32 + (swz % 64) / 2; }
__host__ __device__ __forceinline__ int perm32(int rho) { const int n = rho >> 4, i = rho & 15; return 8 * (i >> 2) + 4 * n + (i & 3); }

struct KSeg {
    const char* A;
    const char* B0;
    const char* B1;
    int nt;
    int nt0;
    const char* A2;
    const char* B02;
    const char* B12;
};
__device__ __forceinline__ KSeg seg1(const char* A, const char* B0, const char* B1, int nt) { KSeg s; s.A = A; s.B0 = B0; s.B1 = B1; s.nt = nt; s.nt0 = nt; s.A2 = A; s.B02 = B0; s.B12 = B1; return s; }
typedef f32x4 Acc[2][2][4][2];

template <bool GATHER, bool TWOSEG>
__device__ __forceinline__ void kloop(LAS unsigned char* lds, Acc& acc, const KSeg s, const unsigned (&voffA)[2][2], const unsigned (&voffB)[2], const unsigned hstepA) {
    int tid = threadIdx.x; asm volatile("" : "+v"(tid));
    const int wid = __builtin_amdgcn_readfirstlane(tid >> 6), lane = tid & 63, wr = wid >> 2, wc = wid & 3, fr = lane & 15, fq = lane >> 4;
    const unsigned ldsw = (unsigned)wid * 1024u;
    const int aoff = lds_byte(wr * 64 + fr, fq * 8), boff = lds_byte(wc * 32 + fr, fq * 8);
    const int nt = __builtin_amdgcn_readfirstlane(s.nt);
#define G8_SA(b, h) (((b) * 2 + (h)) * HTB)
#define G8_SB(b, h) ((4 + (b) * 2 + (h)) * HTB)
#define G8_STAGE(bufoff, gbase, voff) do { _Pragma("unroll") for (int _i = 0; _i < 2; ++_i) \
        __builtin_amdgcn_global_load_lds((const unsigned*)((const char*)(gbase) + (voff)[_i]), (LAS unsigned*)(lds + (bufoff) + ldsw + _i * 8192), 16, 0, 0); } while (0)
#define G8_LDA(dst, b, h) do { _Pragma("unroll") for (int m = 0; m < 4; ++m) _Pragma("unroll") for (int k = 0; k < 2; ++k) dst[m][k] = *(const LAS bf16x8*)(lds + G8_SA(b, h) + aoff + m * 2048 + k * 1024); } while (0)
#define G8_LDB(dst, b, h) do { _Pragma("unroll") for (int n = 0; n < 2; ++n) _Pragma("unroll") for (int k = 0; k < 2; ++k) dst[n][k] = *(const LAS bf16x8*)(lds + G8_SB(b, h) + boff + n * 2048 + k * 1024); } while (0)
#define G8_MMA(ai, bj, At, Bt) do { __builtin_amdgcn_s_setprio(1); _Pragma("unroll") for (int m = 0; m < 4; ++m) _Pragma("unroll") for (int n = 0; n < 2; ++n) _Pragma("unroll") for (int k = 0; k < 2; ++k) \
        acc[ai][bj][m][n] = __builtin_amdgcn_mfma_f32_16x16x32_bf16(Bt[n][k], At[m][k], acc[ai][bj][m][n], 0, 0, 0); __builtin_amdgcn_s_setprio(0); } while (0)
#define G8_WAIT_V(n) asm volatile("s_waitcnt vmcnt(" #n ")" ::: "memory")
#define G8_WAIT_L(n) asm volatile("s_waitcnt lgkmcnt(" #n ")" ::: "memory")
#define G8_BAR __builtin_amdgcn_s_barrier()
#define G8_SCHED __builtin_amdgcn_sched_barrier(0)
    bf16x8 At[4][2], B0[2][2], B1[2][2];
    const char* pA = uptr(s.A); const char* pB0 = uptr(s.B0); const char* pB1 = uptr(s.B1);
    constexpr int KS = BK * 2;
    const int nt0 = TWOSEG ? s.nt0 : 0; const char* qA = TWOSEG ? uptr(s.A2 - (size_t)nt0 * KS) : pA; const char* qB0 = TWOSEG ? uptr(s.B02 - (size_t)nt0 * KS) : pB0; const char* qB1 = TWOSEG ? uptr(s.B12 - (size_t)nt0 * KS) : pB1;
#define G8_TA(t) ((TWOSEG ? ((t) < nt0 ? pA : qA) : pA) + (size_t)(t) * KS)
#define G8_TB0(t) ((TWOSEG ? ((t) < nt0 ? pB0 : qB0) : pB0) + (size_t)(t) * KS)
#define G8_TB1(t) ((TWOSEG ? ((t) < nt0 ? pB1 : qB1) : pB1) + (size_t)(t) * KS)
#define G8_VA1 voffA[GATHER ? 1 : 0]
#define G8_H1(ptr) ((ptr) + (GATHER ? 0u : hstepA))
    G8_STAGE(G8_SB(0, 0), pB0, voffB); G8_STAGE(G8_SA(0, 0), pA, voffA[0]); G8_STAGE(G8_SB(0, 1), pB1, voffB); G8_STAGE(G8_SA(0, 1), G8_H1(pA), G8_VA1);
    if (wr == 1) G8_BAR;
    G8_WAIT_V(4); G8_BAR;
    G8_STAGE(G8_SB(1, 0), pB0 + KS, voffB); G8_STAGE(G8_SA(1, 0), pA + KS, voffA[0]); G8_STAGE(G8_SB(1, 1), pB1 + KS, voffB);
    G8_WAIT_V(6); G8_BAR;
    for (int t = 0; t < nt - 2; t += 2) {
        const char* a1 = G8_TA(t + 1);
        const char* a2 = G8_TA(t + 2); const char* b02 = G8_TB0(t + 2); const char* b12 = G8_TB1(t + 2);
        const char* a3 = G8_TA(t + 3); const char* b03 = G8_TB0(t + 3); const char* b13 = G8_TB1(t + 3);
        G8_LDB(B0, 0, 0); G8_SCHED; G8_LDA(At, 0, 0); G8_STAGE(G8_SA(1, 1), G8_H1(a1), G8_VA1);
        G8_WAIT_L(8); G8_BAR; G8_WAIT_L(0); G8_MMA(0, 0, At, B0); G8_BAR; G8_SCHED;
        G8_LDB(B1, 0, 1); G8_STAGE(G8_SB(0, 0), b02, voffB);
        G8_BAR; G8_WAIT_L(0); G8_MMA(0, 1, At, B1); G8_BAR;
        G8_LDA(At, 0, 1); G8_STAGE(G8_SA(0, 0), a2, voffA[0]);
        G8_BAR; G8_WAIT_L(0); G8_MMA(1, 0, At, B0); G8_BAR; G8_SCHED;
        G8_STAGE(G8_SB(0, 1), b12, voffB);
        G8_WAIT_V(6); G8_BAR; G8_MMA(1, 1, At, B1); G8_BAR;
        G8_LDB(B0, 1, 0); G8_SCHED; G8_LDA(At, 1, 0); G8_STAGE(G8_SA(0, 1), G8_H1(a2), G8_VA1);
        G8_WAIT_L(8); G8_BAR; G8_WAIT_L(0); G8_MMA(0, 0, At, B0); G8_BAR; G8_SCHED;
        G8_LDB(B1, 1, 1); G8_STAGE(G8_SB(1, 0), b03, voffB);
        G8_BAR; G8_WAIT_L(0); G8_MMA(0, 1, At, B1); G8_BAR;
        G8_LDA(At, 1, 1); G8_STAGE(G8_SA(1, 0), a3, voffA[0]);
        G8_BAR; G8_WAIT_L(0); G8_MMA(1, 0, At, B0); G8_BAR; G8_SCHED;
        G8_STAGE(G8_SB(1, 1), b13, voffB);
        G8_WAIT_V(6); G8_BAR; G8_MMA(1, 1, At, B1); G8_BAR;
    }
    { const char* a1 = G8_TA(nt - 1);
      G8_LDB(B0, 0, 0); G8_LDA(At, 0, 0); G8_STAGE(G8_SA(1, 1), G8_H1(a1), G8_VA1);
      G8_BAR; G8_WAIT_L(0); G8_MMA(0, 0, At, B0); G8_BAR;
      G8_LDB(B1, 0, 1); G8_BAR; G8_WAIT_L(0); G8_MMA(0, 1, At, B1); G8_BAR;
      G8_LDA(At, 0, 1); G8_WAIT_V(4); G8_BAR; G8_WAIT_L(0); G8_MMA(1, 0, At, B0); G8_MMA(1, 1, At, B1); G8_BAR; }
    { G8_LDB(B0, 1, 0); G8_LDA(At, 1, 0); G8_WAIT_V(2); G8_BAR; G8_WAIT_L(0); G8_MMA(0, 0, At, B0); G8_BAR;
      G8_LDB(B1, 1, 1); G8_WAIT_V(0); G8_BAR; G8_WAIT_L(0); G8_MMA(0, 1, At, B1); G8_BAR;
      G8_LDA(At, 1, 1); G8_BAR; G8_WAIT_L(0); G8_MMA(1, 0, At, B0); G8_MMA(1, 1, At, B1); G8_BAR; }
    if (wr == 0) G8_BAR;
#undef G8_TA
#undef G8_VA1
#undef G8_H1
#undef G8_TB0
#undef G8_TB1
#undef G8_SA
#undef G8_SB
#undef G8_STAGE
#undef G8_LDA
#undef G8_LDB
#undef G8_MMA
#undef G8_WAIT_V
#undef G8_WAIT_L
#undef G8_BAR
#undef G8_SCHED
}
template <bool GATHER, bool TWOSEG>
__device__ __forceinline__ void kstream(LAS unsigned char* lds, Acc& acc, const KSeg s, const KSeg nx, const bool first, const unsigned (&voffA)[2][2], const unsigned (&voffB)[2], const unsigned hstepA) {
    int tid = threadIdx.x; asm volatile("" : "+v"(tid));
    const int wid = __builtin_amdgcn_readfirstlane(tid >> 6), lane = tid & 63, wr = wid >> 2, wc = wid & 3, fr = lane & 15, fq = lane >> 4;
    const unsigned ldsw = (unsigned)wid * 1024u;
    const int aoff = lds_byte(wr * 64 + fr, fq * 8), boff = lds_byte(wc * 32 + fr, fq * 8);
    const int nt = __builtin_amdgcn_readfirstlane(s.nt);
#define G8_SA(b, h) (((b) * 2 + (h)) * HTB)
#define G8_SB(b, h) ((4 + (b) * 2 + (h)) * HTB)
#define G8_STAGE(bufoff, gbase, voff) do { _Pragma("unroll") for (int _i = 0; _i < 2; ++_i) \
        __builtin_amdgcn_global_load_lds((const unsigned*)((const char*)(gbase) + (voff)[_i]), (LAS unsigned*)(lds + (bufoff) + ldsw + _i * 8192), 16, 0, 0); } while (0)
#define G8_LDA(dst, b, h) do { _Pragma("unroll") for (int m = 0; m < 4; ++m) _Pragma("unroll") for (int k = 0; k < 2; ++k) dst[m][k] = *(const LAS bf16x8*)(lds + G8_SA(b, h) + aoff + m * 2048 + k * 1024); } while (0)
#define G8_LDB(dst, b, h) do { _Pragma("unroll") for (int n = 0; n < 2; ++n) _Pragma("unroll") for (int k = 0; k < 2; ++k) dst[n][k] = *(const LAS bf16x8*)(lds + G8_SB(b, h) + boff + n * 2048 + k * 1024); } while (0)
#define G8_MMA(ai, bj, At, Bt) do { __builtin_amdgcn_s_setprio(1); _Pragma("unroll") for (int m = 0; m < 4; ++m) _Pragma("unroll") for (int n = 0; n < 2; ++n) _Pragma("unroll") for (int k = 0; k < 2; ++k) \
        acc[ai][bj][m][n] = __builtin_amdgcn_mfma_f32_16x16x32_bf16(Bt[n][k], At[m][k], acc[ai][bj][m][n], 0, 0, 0); __builtin_amdgcn_s_setprio(0); } while (0)
#define G8_WAIT_V(n) asm volatile("s_waitcnt vmcnt(" #n ")" ::: "memory")
#define G8_WAIT_L(n) asm volatile("s_waitcnt lgkmcnt(" #n ")" ::: "memory")
#define G8_BAR __builtin_amdgcn_s_barrier()
#define G8_SCHED __builtin_amdgcn_sched_barrier(0)
    bf16x8 At[4][2], B0[2][2], B1[2][2];
    const char* pA = uptr(s.A); const char* pB0 = uptr(s.B0); const char* pB1 = uptr(s.B1);
    constexpr int KS = BK * 2;
    const int nt0 = TWOSEG ? s.nt0 : 0; const char* qA = TWOSEG ? uptr(s.A2 - (size_t)nt0 * KS) : pA; const char* qB0 = TWOSEG ? uptr(s.B02 - (size_t)nt0 * KS) : pB0; const char* qB1 = TWOSEG ? uptr(s.B12 - (size_t)nt0 * KS) : pB1;
    const char* nA = uptr(nx.A) - (size_t)nt * KS; const char* nB0 = uptr(nx.B0) - (size_t)nt * KS; const char* nB1 = uptr(nx.B1) - (size_t)nt * KS;
#define G8_TA(t) (((t) >= nt ? nA : (TWOSEG ? ((t) < nt0 ? pA : qA) : pA)) + (size_t)(t) * KS)
#define G8_TB0(t) (((t) >= nt ? nB0 : (TWOSEG ? ((t) < nt0 ? pB0 : qB0) : pB0)) + (size_t)(t) * KS)
#define G8_TB1(t) (((t) >= nt ? nB1 : (TWOSEG ? ((t) < nt0 ? pB1 : qB1) : pB1)) + (size_t)(t) * KS)
#define G8_VA1 voffA[GATHER ? 1 : 0]
#define G8_H1(ptr) ((ptr) + (GATHER ? 0u : hstepA))
    if (first) {
    G8_STAGE(G8_SB(0, 0), pB0, voffB); G8_STAGE(G8_SA(0, 0), pA, voffA[0]); G8_STAGE(G8_SB(0, 1), pB1, voffB); G8_STAGE(G8_SA(0, 1), G8_H1(pA), G8_VA1);
    if (wr == 1) G8_BAR;
    G8_WAIT_V(4); G8_BAR;
    G8_STAGE(G8_SB(1, 0), pB0 + KS, voffB); G8_STAGE(G8_SA(1, 0), pA + KS, voffA[0]); G8_STAGE(G8_SB(1, 1), pB1 + KS, voffB);
    G8_WAIT_V(6); G8_BAR;
    }
    for (int t = 0; t < nt; t += 2) {
        const char* a1 = G8_TA(t + 1);
        const char* a2 = G8_TA(t + 2); const char* b02 = G8_TB0(t + 2); const char* b12 = G8_TB1(t + 2);
        const char* a3 = G8_TA(t + 3); const char* b03 = G8_TB0(t + 3); const char* b13 = G8_TB1(t + 3);
        G8_LDB(B0, 0, 0); G8_SCHED; G8_LDA(At, 0, 0); G8_STAGE(G8_SA(1, 1), G8_H1(a1), G8_VA1);
        G8_WAIT_L(8); G8_BAR; G8_WAIT_L(0); G8_MMA(0, 0, At, B0); G8_BAR; G8_SCHED;
        G8_LDB(B1, 0, 1); G8_STAGE(G8_SB(0, 0), b02, voffB);
        G8_BAR; G8_WAIT_L(0); G8_MMA(0, 1, At, B1); G8_BAR;
        G8_LDA(At, 0, 1); G8_STAGE(G8_SA(0, 0), a2, voffA[0]);
        G8_BAR; G8_WAIT_L(0); G8_MMA(1, 0, At, B0); G8_BAR; G8_SCHED;
        G8_STAGE(G8_SB(0, 1), b12, voffB);
        G8_WAIT_V(6); G8_BAR; G8_MMA(1, 1, At, B1); G8_BAR;
        G8_LDB(B0, 1, 0); G8_SCHED; G8_LDA(At, 1, 0); G8_STAGE(G8_SA(0, 1), G8_H1(a2), G8_VA1);
        G8_WAIT_L(8); G8_BAR; G8_WAIT_L(0); G8_MMA(0, 0, At, B0); G8_BAR; G8_SCHED;
        G8_LDB(B1, 1, 1); G8_STAGE(G8_SB(1, 0), b03, voffB);
        G8_BAR; G8_WAIT_L(0); G8_MMA(0, 1, At, B1); G8_BAR;
        G8_LDA(At, 1, 1); G8_STAGE(G8_SA(1, 0), a3, voffA[0]);
        G8_BAR; G8_WAIT_L(0); G8_MMA(1, 0, At, B0); G8_BAR; G8_SCHED;
        G8_STAGE(G8_SB(1, 1), b13, voffB);
        G8_WAIT_V(6); G8_BAR; G8_MMA(1, 1, At, B1); G8_BAR;
    }
#undef G8_TA
#undef G8_VA1
#undef G8_H1
#undef G8_TB0
#undef G8_TB1
#undef G8_SA
#undef G8_SB
#undef G8_STAGE
#undef G8_LDA
#undef G8_LDB
#undef G8_MMA
#undef G8_WAIT_V
#undef G8_WAIT_L
#undef G8_BAR
#undef G8_SCHED
}
__device__ __forceinline__ void kstream_end() { asm volatile("s_waitcnt vmcnt(0)" ::: "memory"); __builtin_amdgcn_s_barrier(); }
__device__ __forceinline__ void zero_acc(Acc& acc) {
#pragma unroll
    for (int a = 0; a < 2; ++a)
#pragma unroll
        for (int b = 0; b < 2; ++b)
#pragma unroll
            for (int m = 0; m < 4; ++m)
#pragma unroll
                for (int n = 0; n < 2; ++n) acc[a][b][m][n] = (f32x4){0.f, 0.f, 0.f, 0.f};
}
__device__ __forceinline__ void make_voff_contig(unsigned (&voffA)[2][2], unsigned pitchA) {
    int tid = threadIdx.x; asm volatile("" : "+v"(tid));
#pragma unroll
    for (int i = 0; i < 2; ++i) { int R, C; stage_rc(tid * 16 + i * 8192, R, C);
        voffA[0][i] = (unsigned)R * pitchA + (unsigned)C * 2u; voffA[1][i] = 0u; }
}
__device__ __forceinline__ void make_voffB(unsigned (&voffB)[2], unsigned pitchB, bool perm) {
    int tid = threadIdx.x; asm volatile("" : "+v"(tid));
#pragma unroll
    for (int i = 0; i < 2; ++i) { int R, C; stage_rc(tid * 16 + i * 8192, R, C); const int Rb = perm ? ((R & ~31) + perm32(R & 31)) : R;
        voffB[i] = (unsigned)Rb * pitchB + (unsigned)C * 2u; }
}
}

__device__ __forceinline__ bool unit_order(int i, int G, int c, int nM, int nN, int& pm, int& pn) {
    const int nwg = nM * nN; const long L = (long)i * G + c; if (L >= nwg) return false;
    int wgid = (int)L; { const int q = nwg / 8, r = nwg % 8, xcd = wgid % 8, off = wgid / 8; wgid = (xcd < r ? xcd * (q + 1) : r * (q + 1) + (xcd - r) * q) + off; }
    const int WGM = 8, nig = WGM * nN, gid = wgid / nig, fm = gid * WGM, gsz = (nM - fm) < WGM ? (nM - fm) : WGM;
    pm = fm + ((wgid % nig) % gsz); pn = (wgid % nig) / gsz; return true;
}

__device__ __forceinline__ void conv_small_weights(const Params& p, LAS unsigned char* lds) {
    const int tid = otid(), lane = tid & 63, wave = tid >> 6, gw = obid() * NWAVES + wave, NGW = gridDim.x * NWAVES;
    LAS float* scr = (LAS float*)(lds + wave * 16384);
    constexpr int I_IN = 16 * (NIN / 32), I_A = 8 * 32, I_O = 16 * 32, I_L = 64, PER = I_IN + 2 * I_A + I_O + I_L;
    for (int it = gw; it < DEPTH * PER; it += NGW) {
        const int l = it / PER; int r = it % PER;
        unsigned char* wl = p.ws + WS_WSMALL + (size_t)l * WSMALL_LAYER;
        if (r < I_IN) { const int kb = r / (NIN / 32), nb = r % (NIN / 32), n0 = nb * 32, k0 = kb * 64;
            int col0, nvalid; if (n0 < UA) { col0 = n0; nvalid = A_COLS - n0; nvalid = nvalid < 0 ? 0 : (nvalid > 32 ? 32 : nvalid); } else { col0 = n0 - (UA - A_COLS); nvalid = 32; }
            transpose_item(p.in[I_WIN] + (size_t)l * D * IN_COLS + (size_t)k0 * IN_COLS, IN_COLS, col0, nvalid, (bf16_t*)wl + (size_t)n0 * D + k0, D, scr, lane); continue; }
        r -= I_IN;
        if (r < 2 * I_A) { const int which = r / I_A; r %= I_A; const int kb = r / 32, nb = r % 32;
            const float* src = p.in[which ? I_WBB : I_WBA] + (size_t)l * 512 * D + (size_t)(kb * 64) * D;
            transpose_item(src, D, nb * 32, 32, (bf16_t*)(wl + (10 + which) * MiB) + (size_t)(nb * 32) * 512 + kb * 64, 512, scr, lane); continue; }
        r -= 2 * I_A;
        if (r < I_O) { const int kb = r / 32, nb = r % 32;
          transpose_item(p.in[I_WOUT] + (size_t)l * D * D + (size_t)(kb * 64) * D, D, nb * 32, 32, (bf16_t*)(wl + 12 * MiB) + (size_t)(nb * 32) * D + kb * 64, D, scr, lane); continue; }
        r -= I_O;
        { bf16_t* lo = (bf16_t*)(p.ws + 65536 + (size_t)l * 262144);
          if (r < 16) transpose_item(p.in[I_WUP] + (size_t)l * 64 * 512, 512, r * 32, 32, lo + (size_t)(r * 32) * 64, 64, scr, lane);
          else if (r < 32) transpose_item(p.in[I_AUP] + (size_t)l * 64 * 512, 512, (r - 16) * 32, 32, lo + 32768 + (size_t)((r - 16) * 32) * 64, 64, scr, lane);
          else { const int q = r - 32, kb = q >> 4, nb = q & 15; transpose_item(p.in[I_GUP] + (size_t)l * 128 * 512 + (size_t)(kb * 64) * 512, 512, nb * 32, 32, lo + 65536 + (size_t)(nb * 32) * 128 + kb * 64, 128, scr, lane); } }
    }
}
__device__ __forceinline__ void conv_expert_items(const Params& p, int l, LAS unsigned char* lds, int it0, int it1) {
    const int tid = otid(), lane = tid & 63, wave = tid >> 6, gw = it0 + wave, NGW = NWAVES;
    LAS float* scr = (LAS float*)(lds + wave * 16384);
    constexpr int I_13 = 16 * 32, I_2 = 8 * 32, PER = I_13 + I_2;
    for (int it = gw; it < it1; it += NGW) {
        const int e = it / PER; int r = it % PER;
        if (r < I_13) { const int kb = r / 32, nb = r % 32, n0 = nb * 32, j = n0 >> 8, half = (n0 >> 7) & 1, c = 128 * j + (n0 & 127);
            const float* src = p.in[half ? I_WEXP3 : I_WEXP1] + (size_t)(l * 16 + e) * D * 512 + (size_t)(kb * 64) * 512;
            transpose_item(src, 512, c, 32, (bf16_t*)(p.ws + WS_WEXP) + (size_t)e * 1024 * 1024 + (size_t)n0 * 1024 + kb * 64, 1024, scr, lane); continue; }
        r -= I_13;
        { const int kb = r / 32, nb = r % 32;
          const float* src = p.in[I_WEXP2] + (size_t)(l * 16 + e) * 512 * D + (size_t)(kb * 64) * D;
          transpose_item(src, D, nb * 32, 32, (bf16_t*)(p.ws + WS_WEXP + 32 * MiB) + (size_t)e * 1024 * 512 + (size_t)(nb * 32) * 512 + kb * 64, 512, scr, lane); }
    }
}

__device__ __forceinline__ void ln_wave(f32x4 (&v)[4], const float* g, const float* bta, int lane) {
    float s = 0.f;
#pragma unroll
    for (int j = 0; j < 4; ++j) s += (v[j][0] + v[j][1]) + (v[j][2] + v[j][3]);
    const float mean = wave_sum(s) * (1.f / D); float s2 = 0.f;
#pragma unroll
    for (int j = 0; j < 4; ++j) { v[j] = v[j] - mean; s2 += (v[j][0] * v[j][0] + v[j][1] * v[j][1]) + (v[j][2] * v[j][2] + v[j][3] * v[j][3]); }
    const float rstd = __builtin_amdgcn_rsqf(wave_sum(s2) * (1.f / D) + LN_EPS);
#pragma unroll
    for (int j = 0; j < 4; ++j) { const f32x4 gg = *(const f32x4*)(g + 4 * lane + 256 * j), bb = *(const f32x4*)(bta + 4 * lane + 256 * j); v[j] = v[j] * rstd * gg + bb; }
}
__device__ __forceinline__ void store_row(const Params& p, int r, const f32x4 (&v)[4], int lane, bool zero) {
    float* hr = hrow(p, r); bf16_t* hb = (bf16_t*)(p.ws + WS_HB) + (size_t)r * D;
#pragma unroll
    for (int j = 0; j < 4; ++j) { const f32x4 o = zero ? (f32x4){0.f, 0.f, 0.f, 0.f} : v[j];
        *(f32x4*)(hr + 4 * lane + 256 * j) = o; u32x2 w; w.x = pk2(o[0], o[1]); w.y = pk2(o[2], o[3]); *(u32x2*)(hb + 4 * lane + 256 * j) = w; }
}
__device__ __forceinline__ void ln_in_phase(const Params& p) {
    const int tid = otid(), lane = tid & 63, gw = obid() * NWAVES + (tid >> 6), NGW = gridDim.x * NWAVES;
    for (int r = gw; r < T; r += NGW) {
        const int b = r / LP, pos = r - b * LP; f32x4 v[4];
        if (pos < PADM) {
#pragma unroll
            for (int j = 0; j < 4; ++j) v[j] = (f32x4){0.f, 0.f, 0.f, 0.f};
            store_row(p, r, v, lane, true); continue; }
        const float* src = pos < 64 ? p.in[I_META] + (size_t)(pos - PADM) * D : p.in[I_X] + ((size_t)(b * SEQ + pos - 64) << 10);
#pragma unroll
        for (int j = 0; j < 4; ++j) v[j] = *(const f32x4*)(src + 4 * lane + 256 * j);
        ln_wave(v, p.in[I_LNIN_G], p.in[I_LNIN_B], lane);
        store_row(p, r, v, lane, false);
    }
}

__device__ __forceinline__ const Params& PP() { const Params* q = (const Params*)__builtin_amdgcn_kernarg_segment_ptr(); asm volatile("" : "+s"(q)); return *q; }

#define EPI_COORDS() int tid_ = threadIdx.x; asm volatile("" : "+v"(tid_)); const int wid = tid_ >> 6, lane = tid_ & 63, wr = wid >> 2, wc = wid & 3, fr = lane & 15, fq = lane >> 4; (void)wr; (void)wc; (void)fr; (void)fq
__device__ __forceinline__ void inproj_epi(const g8::Acc& acc, int l, int pm, int pn) {
    EPI_COORDS();
    const int row0 = pm * 256 + wr * 64 + fr;
    if (pn < 12) {
        bf16_t* O = (bf16_t*)(PP().ws + WS_UAR);
#pragma unroll
        for (int ai = 0; ai < 2; ++ai)
#pragma unroll
            for (int m = 0; m < 4; ++m) { asm volatile("" ::: "memory"); bf16_t* rp = O + (size_t)(row0 + ai * 128 + m * 16) * UARW + pn * 256 + wc * 32 + 8 * fq;
#pragma unroll
                for (int bj = 0; bj < 2; ++bj) { const f32x4 v0 = acc[ai][bj][m][0], v1 = acc[ai][bj][m][1]; u32x4 w; w.x = pk2(v0[0], v0[1]); w.y = pk2(v0[2], v0[3]); w.z = pk2(v1[0], v1[1]); w.w = pk2(v1[2], v1[3]);
                    *(u32x4*)(rp + bj * 128) = w; } }
    } else {
        bf16_t* O = (bf16_t*)(PP().ws + WS_GATES); const int colb = (pn - 12) * 256 + wc * 32 + 8 * fq; const float* bg = PP().in[I_BGATE] + l * 2048;
        f32x4 bv[2][2];
#pragma unroll
        for (int bj = 0; bj < 2; ++bj) { bv[bj][0] = *(const f32x4*)(bg + colb + bj * 128); bv[bj][1] = *(const f32x4*)(bg + colb + bj * 128 + 4); }
#pragma unroll
        for (int ai = 0; ai < 2; ++ai)
#pragma unroll
            for (int m = 0; m < 4; ++m) { asm volatile("" ::: "memory"); bf16_t* rp = O + (size_t)(row0 + ai * 128 + m * 16) * 2048 + colb;
#pragma unroll
                for (int bj = 0; bj < 2; ++bj) { f32x4 v0 = acc[ai][bj][m][0] + bv[bj][0], v1 = acc[ai][bj][m][1] + bv[bj][1];
#pragma unroll
                    for (int e = 0; e < 4; ++e) { v0[e] = sigmoidf_(v0[e]); v1[e] = sigmoidf_(v1[e]); }
                    u32x4 w; w.x = pk2(v0[0], v0[1]); w.y = pk2(v0[2], v0[3]); w.z = pk2(v1[0], v1[1]); w.w = pk2(v1[2], v1[3]);
                    *(u32x4*)(rp + bj * 128) = w; } }
    }
}
constexpr int INP_MAIN = 62 * 20 + 3 * 12, INP_TAIL = 24;
__device__ __forceinline__ bool inproj_order(int i, int G, int c, int& pm, int& pn) {
    const long L = (long)i * G + c; if (L >= INP_MAIN) return false;
    if (L < 62 * 20) return unit_order(i, G, c, 62, 20, pm, pn);
    const int r = (int)L - 62 * 20; pm = 62 + r / 12; pn = r % 12; return true;
}
__device__ __forceinline__ void inproj_phase(const Params& p, int l, LAS unsigned char* lds) {
    unsigned voffA[2][2], voffB[2]; g8::make_voff_contig(voffA, D * 2); g8::make_voffB(voffB, D * 2, true);
    int pm, pn, pm2 = 0, pn2 = 0; const int bid = obid(); const int wr_ = __builtin_amdgcn_readfirstlane(otid() >> 6) >> 2;
    bool has = inproj_order(0, gridDim.x, bid, pm, pn), first = true;
    g8::Acc acc; g8::zero_acc(acc);
    for (int i = 0; has; ++i) {
        const bool hasn = inproj_order(i + 1, gridDim.x, bid, pm2, pn2);
        const char* Ab = (const char*)(PP().ws + WS_HB); const char* Bb = (const char*)(PP().ws + WS_WSMALL + (size_t)l * WSMALL_LAYER);
        const g8::KSeg s = g8::seg1(Ab + (size_t)pm * 256 * D * 2, Bb + (size_t)pn * 256 * D * 2, Bb + (size_t)(pn * 256 + 128) * D * 2, D / 64);
        const int pmn = hasn ? pm2 : pm, pnn = hasn ? pn2 : pn;
        const g8::KSeg nx = g8::seg1(Ab + (size_t)pmn * 256 * D * 2, Bb + (size_t)pnn * 256 * D * 2, Bb + (size_t)(pnn * 256 + 128) * D * 2, D / 64);
        if (!first && wr_ == 1) __builtin_amdgcn_s_barrier();
        g8::kstream<false, false>(lds, acc, s, nx, first, voffA, voffB, 128 * D * 2); first = false;
        if (wr_ == 0) __builtin_amdgcn_s_barrier();
        inproj_epi(acc, l, pm, pn);
        g8::zero_acc(acc); has = hasn; pm = pm2; pn = pn2;
    }
    if (!first) g8::kstream_end();
}
__device__ __forceinline__ void inproj_tail_unit(int l, LAS unsigned char* lds, int g) {
    unsigned voffA[2][2], voffB[2]; g8::make_voff_contig(voffA, D * 2); g8::make_voffB(voffB, D * 2, true);
    const int pm = 62 + (g >> 3), pn = 12 + (g & 7);
    g8::Acc acc; g8::zero_acc(acc);
    const char* Ab = (const char*)(PP().ws + WS_HB); const char* Bb = (const char*)(PP().ws + WS_WSMALL + (size_t)l * WSMALL_LAYER);
    const g8::KSeg s = g8::seg1(Ab + (size_t)pm * 256 * D * 2, Bb + (size_t)pn * 256 * D * 2, Bb + (size_t)(pn * 256 + 128) * D * 2, D / 64);
    g8::kloop<false, false>(lds, acc, s, voffA, voffB, 128 * D * 2);
    inproj_epi(acc, l, pm, pn);
}
__device__ __forceinline__ void merge_unit(int l, LAS unsigned char* lds, int pm, int pn, unsigned long long& pacc) {
    unsigned long long pt0 = 0;
    unsigned voffA[2][2], voffB[2]; g8::make_voff_contig(voffA, D * 2); g8::make_voffB(voffB, 512 * 2, true);
    {
        const int wr_ = __builtin_amdgcn_readfirstlane(otid() >> 6) >> 2;
        g8::Acc acc; g8::zero_acc(acc);
#pragma unroll 1
        for (int br = 0; br < 2; ++br) {
            const char* Bt = (const char*)(PP().ws + WS_WSMALL + (size_t)l * WSMALL_LAYER) + (10 + br) * MiB + (size_t)pn * 256 * 512 * 2;
            const char* Bn = (const char*)(PP().ws + WS_WSMALL + (size_t)l * WSMALL_LAYER) + 11 * MiB + (size_t)pn * 256 * 512 * 2;
            const g8::KSeg s = g8::seg1((const char*)(PP().ws + WS_OAB) + (size_t)pm * 256 * D * 2 + br * 1024, Bt, Bt + (size_t)128 * 512 * 2, 8);
            const g8::KSeg nx = g8::seg1((const char*)(PP().ws + WS_OAB) + (size_t)pm * 256 * D * 2 + 1024, Bn, Bn + (size_t)128 * 512 * 2, 8);
            if (br && wr_ == 1) __builtin_amdgcn_s_barrier();
            PRB_B(60 + 2 * br); g8::kstream<false, false>(lds, acc, s, nx, br == 0, voffA, voffB, 128 * D * 2); PRB_E(60 + 2 * br);
            if (wr_ == 0) __builtin_amdgcn_s_barrier();
            EPI_COORDS(); PRB_B(61 + 2 * br);
            const bf16_t* GT = (const bf16_t*)(PP().ws + WS_GATES); bf16_t* O = (bf16_t*)(PP().ws + WS_MERGED);
            const int row0 = pm * 256 + wr * 64 + fr, colb = pn * 256 + wc * 32 + 8 * fq;
#pragma unroll
            for (int ai = 0; ai < 2; ++ai) { asm volatile("" ::: "memory");
                u32x4 gq[4][2], pq[4][2];
#pragma unroll
                for (int m = 0; m < 4; ++m) { const size_t ro = (size_t)(row0 + ai * 128 + m * 16); const bf16_t* gp = GT + ro * 2048 + br * 1024 + colb; const bf16_t* op = O + ro * D + colb;
#pragma unroll
                    for (int bj = 0; bj < 2; ++bj) { gq[m][bj] = *(const u32x4*)(gp + bj * 128); pq[m][bj] = br ? *(const u32x4*)(op + bj * 128) : (u32x4){0u, 0u, 0u, 0u}; } }
#pragma unroll
                for (int m = 0; m < 4; ++m) { const size_t ro = (size_t)(row0 + ai * 128 + m * 16); bf16_t* op = O + ro * D + colb;
#pragma unroll
                    for (int bj = 0; bj < 2; ++bj) { const u32x4 g = gq[m][bj], pr = pq[m][bj]; const f32x4 v0 = acc[ai][bj][m][0], v1 = acc[ai][bj][m][1];
                        u32x4 w; w.x = pk2(v0[0] * bflo(g.x) + bflo(pr.x), v0[1] * bfhi(g.x) + bfhi(pr.x)); w.y = pk2(v0[2] * bflo(g.y) + bflo(pr.y), v0[3] * bfhi(g.y) + bfhi(pr.y));
                        w.z = pk2(v1[0] * bflo(g.z) + bflo(pr.z), v1[1] * bfhi(g.z) + bfhi(pr.z)); w.w = pk2(v1[2] * bflo(g.w) + bflo(pr.w), v1[3] * bfhi(g.w) + bfhi(pr.w));
                        *(u32x4*)(op + bj * 128) = w; } } }
            PRB_E(61 + 2 * br);
            g8::zero_acc(acc);
        }
        g8::kstream_end();
    }
}
__device__ __forceinline__ void wout_unit(int l, LAS unsigned char* lds, int pm, int pn) {
    unsigned voffA[2][2], voffB[2]; g8::make_voff_contig(voffA, D * 2); g8::make_voffB(voffB, D * 2, false);
    g8::Acc acc; g8::zero_acc(acc);
    const char* Ab = (const char*)(PP().ws + WS_MERGED); const char* Bb = (const char*)(PP().ws + WS_WSMALL + (size_t)l * WSMALL_LAYER + 12 * MiB);
    const g8::KSeg s = g8::seg1(Ab + (size_t)pm * 256 * D * 2, Bb + (size_t)pn * 256 * D * 2, Bb + (size_t)(pn * 256 + 128) * D * 2, D / 64);
    g8::kloop<false, false>(lds, acc, s, voffA, voffB, 128 * D * 2);
    EPI_COORDS();
    const int row0 = pm * 256 + wr * 64 + fr, col0 = pn * 256 + wc * 32 + 4 * fq;
#pragma unroll
    for (int ai = 0; ai < 2; ++ai) { asm volatile("" ::: "memory");
        f32x4 pre[4][2][2]; float* hr[4];
#pragma unroll
        for (int m = 0; m < 4; ++m) { hr[m] = hrow(PP(), row0 + ai * 128 + m * 16) + col0;
#pragma unroll
            for (int bj = 0; bj < 2; ++bj)
#pragma unroll
                for (int n = 0; n < 2; ++n) pre[m][bj][n] = *(const f32x4*)(hr[m] + bj * 128 + n * 16); }
#pragma unroll
        for (int m = 0; m < 4; ++m)
#pragma unroll
            for (int bj = 0; bj < 2; ++bj)
#pragma unroll
                for (int n = 0; n < 2; ++n) *(f32x4*)(hr[m] + bj * 128 + n * 16) = pre[m][bj][n] * ALPHA + acc[ai][bj][m][n]; }
}
__device__ __forceinline__ unsigned score_key(float s) { s += 0.0f; const unsigned u = __builtin_bit_cast(unsigned, s); return (u & 0x80000000u) ? ~u : (u | 0x80000000u); }
__device__ void attn_naive_query(const Params& p, int row, unsigned char* wl, int lane) {
    const bf16_t* U = (const bf16_t*)(p.ws + WS_UAR);
    bf16_t* OA = (bf16_t*)(p.ws + WS_OAB) + (size_t)row * D;
    const int b = row / LP, pos = row - b * LP;
    if (pos < PADM) {
#pragma unroll
        for (int j = 0; j < 8; ++j) OA[j * 64 + lane] = 0;
        return;
    }
    const int nadm = 64 * ((pos >> 6) + 1) - PADM;
    unsigned* keys = (unsigned*)wl; float* p_s = (float*)wl;
    float* qi_s = (float*)(wl + 16640); float* q_s = qi_s + 256; float* w_s = q_s + 512; unsigned short* sel_s = (unsigned short*)(w_s + 16);
    const bf16_t* urow = U + (size_t)row * UARW;
    for (int i = lane; i < 256; i += 64) qi_s[i] = bf2f(urow[C_QI + i]);
    for (int i = lane; i < 512; i += 64) q_s[i] = bf2f(urow[C_Q + i]);
    if (lane < 8) w_s[lane] = bf2f(urow[C_WI + lane]);
    __builtin_amdgcn_fence(__ATOMIC_RELEASE, "wavefront"); __builtin_amdgcn_wave_barrier(); __builtin_amdgcn_fence(__ATOMIC_ACQUIRE, "wavefront");
    const int nj = (nadm + 63) >> 6;
    for (int j = 0; j < nj; ++j) {
        const int ki_idx = lane + 64 * j; unsigned key = 0u;
        if (ki_idx < nadm) {
            const u32x4* kp = (const u32x4*)(U + (size_t)(b * LP + PADM + ki_idx) * UARW + C_KI);
            float kf[32];
#pragma unroll
            for (int c4 = 0; c4 < 4; ++c4) { const u32x4 w = kp[c4];
                kf[c4 * 8 + 0] = bflo(w.x); kf[c4 * 8 + 1] = bfhi(w.x); kf[c4 * 8 + 2] = bflo(w.y); kf[c4 * 8 + 3] = bfhi(w.y);
                kf[c4 * 8 + 4] = bflo(w.z); kf[c4 * 8 + 5] = bfhi(w.z); kf[c4 * 8 + 6] = bflo(w.w); kf[c4 * 8 + 7] = bfhi(w.w); }
            float sc = 0.f;
#pragma unroll 1
            for (int h = 0; h < 8; ++h) { float d = 0.f; asm volatile("" ::: "memory");
#pragma unroll
                for (int e = 0; e < 32; ++e) d = fmaf(qi_s[h * 32 + e], kf[e], d);
                sc = fmaf(w_s[h], fmaxf(d, 0.f), sc); }
            key = score_key(sc); if (key == 0u) key = 1u;
        }
        keys[ki_idx] = key;
    }
    __builtin_amdgcn_fence(__ATOMIC_RELEASE, "wavefront"); __builtin_amdgcn_wave_barrier(); __builtin_amdgcn_fence(__ATOMIC_ACQUIRE, "wavefront");
    unsigned thr = 0u; int need_ties = 0x7fffffff;
    if (nadm > 256) {
        unsigned prefix = 0u; int remaining = 256;
        for (int bit = 31; bit >= 0; --bit) {
            const unsigned cand = prefix | (1u << bit); int cnt = 0;
            for (int j = 0; j < nj; ++j) { const unsigned k = keys[lane + 64 * j]; cnt += __builtin_popcountll(__ballot((k >> bit) == (cand >> bit))); }
            if (cnt >= remaining) prefix = cand; else remaining -= cnt;
        }
        thr = prefix; need_ties = remaining;
    } else thr = 1u;
    int nsel = 0, ties_seen = 0;
    for (int j = 0; j < nj; ++j) {
        const unsigned k = keys[lane + 64 * j];
        const unsigned long long tm = __ballot(k == thr && k != 0u);
        const unsigned long long lt = (1ull << lane) - 1ull;
        const int myrank = ties_seen + __builtin_popcountll(tm & lt);
        const bool selme = (k > thr) || (k == thr && k != 0u && myrank < need_ties);
        const unsigned long long sm = __ballot(selme);
        if (selme) sel_s[nsel + __builtin_popcountll(sm & lt)] = (unsigned short)(PADM + lane + 64 * j);
        nsel += __builtin_popcountll(sm); ties_seen += __builtin_popcountll(tm);
    }
    __builtin_amdgcn_fence(__ATOMIC_RELEASE, "wavefront"); __builtin_amdgcn_wave_barrier(); __builtin_amdgcn_fence(__ATOMIC_ACQUIRE, "wavefront");
    float sc[4][8];
#pragma unroll
    for (int m = 0; m < 4; ++m) {
        asm volatile("" ::: "memory");
        const int i = lane + 64 * m; const bool valid = i < nsel; const int ps = valid ? sel_s[i] : PADM;
        const bf16_t* krow = U + (size_t)(b * LP + ps) * UARW + C_K;
#pragma unroll
        for (int n = 0; n < 2; ++n) {
            float a0 = 0.f, a1 = 0.f, a2 = 0.f, a3 = 0.f;
#pragma unroll 1
            for (int c8 = 0; c8 < 8; ++c8) { asm volatile("" ::: "memory"); const u32x4 w = *(const u32x4*)(krow + n * 64 + c8 * 8);
                float kf[8] = {bflo(w.x), bfhi(w.x), bflo(w.y), bfhi(w.y), bflo(w.z), bfhi(w.z), bflo(w.w), bfhi(w.w)};
#pragma unroll
                for (int e = 0; e < 8; ++e) { const int dd = c8 * 8 + e;
                    a0 = fmaf(q_s[(n * 4 + 0) * 64 + dd], kf[e], a0); a1 = fmaf(q_s[(n * 4 + 1) * 64 + dd], kf[e], a1);
                    a2 = fmaf(q_s[(n * 4 + 2) * 64 + dd], kf[e], a2); a3 = fmaf(q_s[(n * 4 + 3) * 64 + dd], kf[e], a3); } }
            sc[m][n * 4 + 0] = valid ? a0 * 0.125f : -INFINITY; sc[m][n * 4 + 1] = valid ? a1 * 0.125f : -INFINITY;
            sc[m][n * 4 + 2] = valid ? a2 * 0.125f : -INFINITY; sc[m][n * 4 + 3] = valid ? a3 * 0.125f : -INFINITY;
        }
    }
    __builtin_amdgcn_wave_barrier();
    float linv[8];
#pragma unroll
    for (int h = 0; h < 8; ++h) {
        const float mx = wave_max(fmaxf(fmaxf(sc[0][h], sc[1][h]), fmaxf(sc[2][h], sc[3][h]))); float s = 0.f;
#pragma unroll
        for (int m = 0; m < 4; ++m) { const float e = __expf(sc[m][h] - mx); sc[m][h] = e; s += e; }
        linv[h] = 1.0f / wave_sum(s);
    }
#pragma unroll
    for (int m = 0; m < 4; ++m) { const int i = lane + 64 * m;
#pragma unroll
        for (int h = 0; h < 8; ++h) p_s[i * 8 + h] = sc[m][h]; }
    __builtin_amdgcn_fence(__ATOMIC_RELEASE, "wavefront"); __builtin_amdgcn_wave_barrier(); __builtin_amdgcn_fence(__ATOMIC_ACQUIRE, "wavefront");
    float o[8] = {0.f, 0.f, 0.f, 0.f, 0.f, 0.f, 0.f, 0.f};
    for (int i = 0; i < nsel; ++i) {
        const int ps = sel_s[i]; const bf16_t* vrow = U + (size_t)(b * LP + ps) * UARW + C_V;
        const float v0 = bf2f(vrow[lane]), v1 = bf2f(vrow[64 + lane]);
        const f32x4 pa = *(const f32x4*)(p_s + i * 8), pb = *(const f32x4*)(p_s + i * 8 + 4);
        o[0] = fmaf(pa[0], v0, o[0]); o[1] = fmaf(pa[1], v0, o[1]); o[2] = fmaf(pa[2], v0, o[2]); o[3] = fmaf(pa[3], v0, o[3]);
        o[4] = fmaf(pb[0], v1, o[4]); o[5] = fmaf(pb[1], v1, o[5]); o[6] = fmaf(pb[2], v1, o[6]); o[7] = fmaf(pb[3], v1, o[7]);
    }
#pragma unroll
    for (int h = 0; h < 8; ++h) OA[h * 64 + lane] = (bf16_t)f2bf(o[h] * linv[h]);
    __builtin_amdgcn_wave_barrier();
}


__device__ __forceinline__ f32x4 mfma16(bf16x8 a, bf16x8 b, f32x4 c) { return __builtin_amdgcn_mfma_f32_16x16x32_bf16(a, b, c, 0, 0, 0); }
#define LDS_BARRIER() do { asm volatile("s_waitcnt lgkmcnt(0)" ::: "memory"); __builtin_amdgcn_s_barrier(); asm volatile("" ::: "memory"); } while (0)

typedef float f32x16 __attribute__((ext_vector_type(16)));
typedef short s16x4 __attribute__((ext_vector_type(4)));
constexpr int AT_HIST = 0;
constexpr int AT_MASK = 20480;
constexpr int AT_QST = AT_MASK + 16640;
constexpr int AT_KV = 37120;
constexpr int AT_UNIT = AT_KV + 32768;
constexpr int AT_KL = AT_KV;
constexpr int AT_KL_BYTES = LDS_BYTES - 16 - AT_KL;
static_assert(4128 * 12 * 2 <= AT_KL_BYTES, "selection keys fit with 12 queries per sub-pass");
constexpr int CW_R1Q = 48;
constexpr int CW_ATT = 32;
__device__ __forceinline__ int img_off(int row, int ch) { return 2048 * (row >> 3) + 512 * (ch >> 2) + 64 * (row & 7) + 16 * ((ch & 3) ^ ((row >> 2) & 3)); }
__device__ __forceinline__ unsigned comp_key(float sc, int pos) { return (score_key(sc) & 0xFFFFE000u) | (unsigned)(0x1FFF - pos); }

__device__ __forceinline__ void attn_unit(const Params& p, unsigned char* lds, int b, int qt, unsigned long long& pacc) {
    unsigned long long pt0 = 0; if (PROBE_PHASE == 40 || PROBE_PHASE == 42) pt0 = __builtin_amdgcn_s_memrealtime();
    const int tid = otid(), wave = tid >> 6, lane = tid & 63, r = lane & 31, hh = lane >> 5;
    const bf16_t* U = (const bf16_t*)(p.ws + WS_UAR);
    LAS unsigned char* L = (LAS unsigned char*)lds;
    LAS unsigned* hist = (LAS unsigned*)(L + AT_HIST); LAS unsigned* maskw = (LAS unsigned*)(L + AT_MASK);
    const int c = qt >> 1, nkt = 2 * c + 1, nadm = 64 * (c + 1) - PADM;
    const size_t qrow = (size_t)(b * LP + 32 * qt + r);
    if (nadm > 256) {
        LAS unsigned short* KL = (LAS unsigned short*)(L + AT_KL);
        LAS unsigned* h8 = (LAS unsigned*)(L + AT_HIST);
        LAS unsigned* segc = h8 + 4096;
        LAS unsigned* st = segc + 512;
        const int NK = 32 * nkt, c15 = lane & 15, g4 = lane >> 4;
        const int qs = NK * 32 <= AT_KL_BYTES ? 16 : 12;
        for (int i = tid; i < (nkt + 1) * 32; i += NTHREADS) maskw[i] = 0u;
#pragma unroll 1
        for (int qbase = 0; qbase < 32; qbase += qs) {
            const int qn = 32 - qbase < qs ? 32 - qbase : qs; const bool qact = c15 < qn;
            bf16x8 qf[8]; float wq[8];
            { const bf16_t* qp = U + (size_t)(b * LP + 32 * qt + qbase + (qact ? c15 : 0)) * UARW;
#pragma unroll
              for (int h = 0; h < 8; ++h) qf[h] = *(const bf16x8*)(qp + C_QI + h * 32 + 8 * g4);
              const u32x4 w = *(const u32x4*)(qp + C_WI);
              wq[0] = bflo(w.x); wq[1] = bfhi(w.x); wq[2] = bflo(w.y); wq[3] = bfhi(w.y); wq[4] = bflo(w.z); wq[5] = bfhi(w.z); wq[6] = bflo(w.w); wq[7] = bfhi(w.w); }
#pragma unroll
            for (int h = 0; h < 8; ++h) asm volatile("" : "+v"(qf[h]), "+v"(wq[h]));
            for (int i = tid; i < 4096 + 512; i += NTHREADS) h8[i] = 0u;
            LDS_BARRIER();
            {
                const int ng = 2 * nkt; int j = wave;
                const bf16_t* kb = U + (size_t)(b * LP + 32 + c15) * UARW + C_KI + 8 * g4;
                bf16x8 a = *(const bf16x8*)(kb + (size_t)(16 * (j < ng ? j : 0)) * UARW), an = *(const bf16x8*)(kb + (size_t)(16 * (j + NWAVES < ng ? j + NWAVES : 0)) * UARW);
#pragma unroll 1
                for (; j < ng; j += NWAVES) {
                    const bf16x8 a2 = *(const bf16x8*)(kb + (size_t)(16 * (j + 2 * NWAVES < ng ? j + 2 * NWAVES : j)) * UARW);
                    f32x4 sc = {0.f, 0.f, 0.f, 0.f};
#pragma unroll
                    for (int h = 0; h < 8; ++h) { const f32x4 d = mfma16(a, qf[h], (f32x4){0.f, 0.f, 0.f, 0.f});
#pragma unroll
                        for (int e = 0; e < 4; ++e) sc[e] = fmaf(wq[h], fmaxf(d[e], 0.f), sc[e]); }
                    if (qact) {
#pragma unroll
                        for (int e = 0; e < 4; ++e) { const int ki = 16 * j + 4 * g4 + e;
                            const unsigned k16 = ki >= 16 ? (score_key(sc[e]) >> 16) : 0u;
                            KL[ki * qs + c15] = (unsigned short)k16;
                            __hip_atomic_fetch_add(h8 + (k16 >> 8) * 16 + c15, ki >= 16 ? 1u : 0u, __ATOMIC_RELAXED, __HIP_MEMORY_SCOPE_WORKGROUP); } }
                    a = an; an = a2;
                }
            }
            LDS_BARRIER();
            { const int q_ = tid & 15, s8 = tid >> 4; unsigned ss = 0u;
#pragma unroll
              for (int i = 0; i < 8; ++i) ss += h8[(s8 * 8 + i) * 16 + q_];
              segc[s8 * 16 + q_] = ss; }
            LDS_BARRIER();
            if (tid < qn) { unsigned sv[32];
#pragma unroll
                for (int i = 0; i < 32; ++i) sv[i] = segc[i * 16 + tid];
                unsigned cum = 0u; int sgi = 31;
#pragma unroll
                for (int i = 31; i > 0; --i) { const bool go = sgi == i && cum + sv[i] < 256u; cum += go ? sv[i] : 0u; sgi -= go ? 1 : 0; }
                int bin = sgi * 8 + 7; while (bin > sgi * 8 && cum + h8[bin * 16 + tid] < 256u) { cum += h8[bin * 16 + tid]; --bin; }
                st[tid * 4] = (unsigned)bin; st[tid * 4 + 1] = 256u - cum; }
            LDS_BARRIER();
            for (int i = tid; i < 4096; i += NTHREADS) h8[i] = 0u;
            LDS_BARRIER();
            const int q = tid & 15, sg = tid >> 4, SEG = (NK + 31) >> 5, k0 = sg * SEG, k1 = q < qn ? (k0 + SEG < NK ? k0 + SEG : NK) : k0;
            { const unsigned hb = st[q * 4];
#pragma unroll 8
              for (int k = k0; k < k1; ++k) { const unsigned kv = KL[k * qs + q]; __hip_atomic_fetch_add(h8 + (kv & 255u) * 16 + q, (kv >> 8) == hb && kv != 0u ? 1u : 0u, __ATOMIC_RELAXED, __HIP_MEMORY_SCOPE_WORKGROUP); } }
            LDS_BARRIER();
            { const int q_ = tid & 15, s8 = tid >> 4; unsigned ss = 0u;
#pragma unroll
              for (int i = 0; i < 8; ++i) ss += h8[(s8 * 8 + i) * 16 + q_];
              segc[s8 * 16 + q_] = ss; }
            LDS_BARRIER();
            if (tid < qn) { const unsigned rem = st[tid * 4 + 1]; unsigned sv[32];
#pragma unroll
                for (int i = 0; i < 32; ++i) sv[i] = segc[i * 16 + tid];
                unsigned cum = 0u; int sgi = 31;
#pragma unroll
                for (int i = 31; i > 0; --i) { const bool go = sgi == i && cum + sv[i] < rem; cum += go ? sv[i] : 0u; sgi -= go ? 1 : 0; }
                int bin = sgi * 8 + 7; while (bin > sgi * 8 && cum + h8[bin * 16 + tid] < rem) { cum += h8[bin * 16 + tid]; --bin; }
                st[tid * 4 + 2] = (st[tid * 4] << 8) | (unsigned)bin; st[tid * 4 + 3] = rem - cum; }
            LDS_BARRIER();
            const unsigned thr = st[q * 4 + 2], need = st[q * 4 + 3];
            { unsigned cnt = 0u;
#pragma unroll 8
              for (int k = k0; k < k1; ++k) cnt += KL[k * qs + q] == thr ? 1u : 0u;
              segc[sg * 16 + q] = cnt; }
            LDS_BARRIER();
            if (tid < qn) { unsigned cv[32];
#pragma unroll
                for (int s2 = 0; s2 < 32; ++s2) cv[s2] = segc[s2 * 16 + tid];
                unsigned run = 0u;
#pragma unroll
                for (int s2 = 0; s2 < 32; ++s2) { segc[s2 * 16 + tid] = run; run += cv[s2]; } }
            LDS_BARRIER();
            { unsigned rank = segc[sg * 16 + q], word = 0u; int wi = k0 >> 5;
#pragma unroll 4
              for (int k = k0; k < k1; ++k) { if ((k >> 5) != wi) { if (word) __hip_atomic_fetch_or(maskw + (wi + 1) * 32 + qbase + q, word, __ATOMIC_RELAXED, __HIP_MEMORY_SCOPE_WORKGROUP); word = 0u; wi = k >> 5; }
                  const unsigned kv = KL[k * qs + q]; const bool tie = kv == thr; const bool sel = kv > thr || (tie && rank < need); rank += tie ? 1u : 0u;
                  word |= (sel ? 1u : 0u) << (k & 31); }
              if (word) __hip_atomic_fetch_or(maskw + (wi + 1) * 32 + qbase + q, word, __ATOMIC_RELAXED, __HIP_MEMORY_SCOPE_WORKGROUP); }
            LDS_BARRIER();
        }
    } else {
        for (int kt = 1 + wave; kt <= nkt; kt += NWAVES) if (hh == 0) maskw[kt * 32 + r] = kt == 1 ? 0xFFFF0000u : 0xFFFFFFFFu;
        LDS_BARRIER();
    }
    if (PROBE_PHASE == 40) pacc += __builtin_amdgcn_s_memrealtime() - pt0;
    if (PROBE_PHASE == 41) pt0 = __builtin_amdgcn_s_memrealtime();
    {
        const int h = wave, n = h >> 2;
        bf16x8 qf4[4];
#pragma unroll
        for (int kk = 0; kk < 4; ++kk) qf4[kk] = *(const bf16x8*)(U + qrow * UARW + C_Q + h * 64 + 16 * kk + 8 * hh);
        asm volatile("" : "+v"(qf4[0]), "+v"(qf4[1]), "+v"(qf4[2]), "+v"(qf4[3]));
        f32x16 o0, o1;
#pragma unroll
        for (int e = 0; e < 16; ++e) { o0[e] = 0.f; o1[e] = 0.f; }
        float m = -1e30f, lsum = 0.f;
        const int srow = tid >> 4, sch = tid & 15; const int soff = img_off(srow, sch);
        const bf16_t* sbase = U + (size_t)(b * LP + srow) * UARW + sch * 8;
        u32x4 kreg = *(const u32x4*)(sbase + (size_t)32 * UARW + C_K), vreg = *(const u32x4*)(sbase + (size_t)32 * UARW + C_V);
        *(LAS u32x4*)(L + AT_KV + soff) = kreg; *(LAS u32x4*)(L + AT_KV + 8192 + soff) = vreg;
        { const int k2 = nkt >= 2 ? 2 : 1; kreg = *(const u32x4*)(sbase + (size_t)(32 * k2) * UARW + C_K); vreg = *(const u32x4*)(sbase + (size_t)(32 * k2) * UARW + C_V); }
        LDS_BARRIER();
        const int g = (lane >> 4) & 1, q_ = (lane & 15) >> 2, p_ = lane & 3;
        constexpr float SCL = 0.125f * 1.44269504088896f;
#pragma unroll 1
        for (int i = 0; i < nkt; ++i) {
            const int kt = 1 + i; LAS unsigned char* Kimg = L + AT_KV + (i & 1) * 16384; LAS unsigned char* Vimg = Kimg + 8192;
            u32x4 kreg2, vreg2;
            { const int k3 = kt + 2 <= nkt ? kt + 2 : kt; kreg2 = *(const u32x4*)(sbase + (size_t)(32 * k3) * UARW + C_K); vreg2 = *(const u32x4*)(sbase + (size_t)(32 * k3) * UARW + C_V); }
            f32x16 s;
#pragma unroll
            for (int e = 0; e < 16; ++e) s[e] = 0.f;
#pragma unroll
            for (int kk = 0; kk < 4; ++kk) { const bf16x8 a = *(const LAS bf16x8*)(Kimg + img_off(r, 8 * n + 2 * kk + hh)); s = __builtin_amdgcn_mfma_f32_32x32x16_bf16(a, qf4[kk], s, 0, 0, 0); }
            const unsigned mw = maskw[kt * 32 + r] >> (4 * hh);
            float tmax = -INFINITY;
#pragma unroll
            for (int e = 0; e < 16; ++e) { const bool sel = (mw >> ((e & 3) + 8 * (e >> 2))) & 1u; s[e] = sel ? s[e] : -INFINITY; tmax = fmaxf(tmax, s[e]); }
            tmax = fmaxf(tmax, __shfl_xor(tmax, 32));
            const float mnew = fmaxf(m, tmax * SCL);
            if (__any(mnew > m)) { const float alpha = __builtin_amdgcn_exp2f(m - mnew); lsum *= alpha;
#pragma unroll
                for (int e = 0; e < 16; ++e) { o0[e] *= alpha; o1[e] *= alpha; } }
            m = mnew;
            float ps = 0.f;
#pragma unroll
            for (int e = 0; e < 16; ++e) { const float pe = __builtin_amdgcn_exp2f(fmaf(s[e], SCL, -mnew)); s[e] = pe; ps += pe; }
            lsum += ps;
            bf16x8 pf[2];
#pragma unroll
            for (int ks = 0; ks < 2; ++ks) { u32x4 w; w.x = pk2(s[8 * ks + 0], s[8 * ks + 1]); w.y = pk2(s[8 * ks + 2], s[8 * ks + 3]); w.z = pk2(s[8 * ks + 4], s[8 * ks + 5]); w.w = pk2(s[8 * ks + 6], s[8 * ks + 7]); pf[ks] = __builtin_bit_cast(bf16x8, w); }
#pragma unroll
            for (int ks = 0; ks < 2; ++ks)
#pragma unroll
                for (int dt = 0; dt < 2; ++dt) { const int c0 = 8 * n + 4 * dt + 2 * g + (p_ >> 1);
                    const s16x4 lo = __builtin_amdgcn_ds_read_tr16_b64_v4i16((LAS s16x4*)(Vimg + img_off(16 * ks + 4 * hh + q_, c0) + 8 * (p_ & 1)));
                    const s16x4 hi = __builtin_amdgcn_ds_read_tr16_b64_v4i16((LAS s16x4*)(Vimg + img_off(16 * ks + 8 + 4 * hh + q_, c0) + 8 * (p_ & 1)));
                    const bf16x8 a = __builtin_shufflevector(lo, hi, 0, 1, 2, 3, 4, 5, 6, 7);
                    if (dt == 0) o0 = __builtin_amdgcn_mfma_f32_32x32x16_bf16(a, pf[ks], o0, 0, 0, 0); else o1 = __builtin_amdgcn_mfma_f32_32x32x16_bf16(a, pf[ks], o1, 0, 0, 0); }
            if (i + 1 < nkt) { LAS unsigned char* Kn = L + AT_KV + ((i + 1) & 1) * 16384; *(LAS u32x4*)(Kn + soff) = kreg; *(LAS u32x4*)(Kn + 8192 + soff) = vreg; }
            kreg = kreg2; vreg = vreg2;
            LDS_BARRIER();
        }
        lsum += __shfl_xor(lsum, 32);
        const float inv = lsum > 0.f ? 1.0f / lsum : 0.f;
        bf16_t* orow = (bf16_t*)(p.ws + WS_OAB) + qrow * D + h * 64 + 4 * hh;
#pragma unroll
        for (int g4 = 0; g4 < 4; ++g4) { u32x2 w0, w1;
            w0.x = pk2(o0[4 * g4] * inv, o0[4 * g4 + 1] * inv); w0.y = pk2(o0[4 * g4 + 2] * inv, o0[4 * g4 + 3] * inv);
            w1.x = pk2(o1[4 * g4] * inv, o1[4 * g4 + 1] * inv); w1.y = pk2(o1[4 * g4 + 2] * inv, o1[4 * g4 + 3] * inv);
            *(u32x2*)(orow + 8 * g4) = w0; *(u32x2*)(orow + 32 + 8 * g4) = w1; }
        if (qt == 1) {
            bf16_t* z = (bf16_t*)(p.ws + WS_OAB) + (size_t)(b * LP + r) * D + h * 64 + 32 * hh;
#pragma unroll
            for (int j = 0; j < 4; ++j) *(u32x4*)(z + 8 * j) = (u32x4){0u, 0u, 0u, 0u};
        }
    }
    if (PROBE_PHASE == 41 || PROBE_PHASE == 42) pacc += __builtin_amdgcn_s_memrealtime() - pt0;
}
__device__ __forceinline__ void attn_phase(const Params& p, int l, unsigned char* lds, unsigned long long& pacc) {
    unsigned* ctr = (unsigned*)(p.ws + WS_CTL) + CW_ATT + 4 * l;
    volatile int* uw = (volatile int*)(lds + AT_UNIT);
    const int b0 = (obid() & 7) >> 1;
    for (int k = 0; k < 4; ++k) { const int b = (b0 + k) & 3;
        for (;;) {
            __syncthreads();
            if (otid() == 0) *uw = (int)atomicAdd(ctr + b, 1u);
            __syncthreads();
            const int u = *uw;
            if (u >= 129) break;
            attn_unit(p, lds, b, 129 - u, pacc);
        }
    }
}

constexpr size_t WS_RW1 = WS_HB;
constexpr size_t WS_RW2 = 259 * MiB;
constexpr size_t RW2_ARR = (size_t)2080 * 8192;
constexpr size_t WS_LORA = 65536;
constexpr int PS = 72;
constexpr int R1_XW = 0, R1_XA = 9216, R1_XG = 18432;
constexpr int R1_RHS = 0;
constexpr int R1_E = 35840, R1_AA = R1_E + 16640, R1_GS = R1_AA + 9216;
constexpr int R1_LABT = R1_E, R1_LAK = R1_E + 16384;
constexpr int R1_AT = R1_GS + 9216, R1_RT = R1_AT + 9216, R1_BT = R1_RT + 9216, R1_KT = R1_BT + 9216;
constexpr int R1_WT = R1_AT, R1_ZT = R1_BT, R1_LOFF = R1_KT;
constexpr int R1_BTT = R1_KT + 9216, R1_KTT = R1_BTT + 9216, R1_VT = R1_KTT + 9216;
constexpr int R1_MRB = R1_VT + 9216, R1_MRK = R1_MRB + 9216;
constexpr int R1_BS = R1_MRK + 9216, R1_GC = R1_BS + 256, R1_END = R1_GC + 256;
static_assert(R1_END <= LDS_BYTES && R1_LAK + 9216 <= R1_AT && R1_RHS + 33280 <= R1_E, "R1 LDS map");
__device__ __forceinline__ u32x2 pk4(f32x4 v) { u32x2 w; w.x = pk2(v[0], v[1]); w.y = pk2(v[2], v[3]); return w; }

struct R1PF { u32x4 a[7], q[7]; };
__device__ __forceinline__ void r1_load_rows(const bf16_t* U, int unit, int tid, R1PF& pf) {
    const int h = unit & 7, bc = unit >> 3, b = bc / NCH, c = bc - b * NCH, t = tid >> 3, d0 = (tid & 7) * 8;
    const int row = b * LP + 64 * c + t; const bool hasprev = (64 * c + t) > 0;
    const bf16_t* uc = U + (size_t)row * UARW; const bf16_t* up = hasprev ? uc - UARW : uc;
    const int cols[7] = {C_R + h * 64 + d0, C_RK + h * 64 + d0, C_RV + h * 64 + d0, C_XW + d0, C_XA + d0, C_XG + d0, C_XG + 64 + d0};
#pragma unroll
    for (int i = 0; i < 7; ++i) { pf.a[i] = *(const u32x4*)(uc + cols[i]); pf.q[i] = *(const u32x4*)(up + cols[i]); }
}
#define R1P(k) do { if (PROBE_PHASE == 20 + (k)) { const unsigned long long t_ = __builtin_amdgcn_s_memrealtime(); pacc += t_ - pt0; } if (PROBE_PHASE == 21 + (k)) pt0 = __builtin_amdgcn_s_memrealtime(); } while (0)
__device__ __forceinline__ void rwkv_prep_unit(const Params& p, int l, int unit, unsigned char* lds, unsigned long long& pacc, R1PF& pf, int next_unit) {
    unsigned long long pt0 = 0; if (PROBE_PHASE == 20) pt0 = __builtin_amdgcn_s_memrealtime();
    const int tid = otid(), wave = tid >> 6, lane = tid & 63, c15 = lane & 15, g = lane >> 4;
    const int h = unit & 7, bc = unit >> 3, b = bc / NCH, c = bc - b * NCH;
    LAS unsigned char* L = (LAS unsigned char*)lds;
    const bf16_t* U = (const bf16_t*)(p.ws + WS_UAR);
    const int t = tid >> 3, dq = tid & 7, d0 = dq * 8;
    const int row = b * LP + 64 * c + t; const bool hasprev = (64 * c + t) > 0;
    bf16x8 lw[2][2], la[2][2], lg_[2][4];
    float rr[8], kx[8], vx[8], kk[8];
    {
        const float* mu = p.in[I_MU] + l * R_COLS;
        auto shift8 = [&](int idx, int mucol, float (&out)[8]) {
            const u32x4 a = pf.a[idx], q = pf.q[idx];
            const f32x4 m0 = *(const f32x4*)(mu + mucol), m1 = *(const f32x4*)(mu + mucol + 4);
            const float x[8] = {bflo(a.x), bfhi(a.x), bflo(a.y), bfhi(a.y), bflo(a.z), bfhi(a.z), bflo(a.w), bfhi(a.w)};
            const float y[8] = {bflo(q.x), bfhi(q.x), bflo(q.y), bfhi(q.y), bflo(q.z), bfhi(q.z), bflo(q.w), bfhi(q.w)};
#pragma unroll
            for (int i = 0; i < 8; ++i) { const float xp = hasprev ? y[i] : 0.f; out[i] = x[i] + (xp - x[i]) * (i < 4 ? m0[i] : m1[i - 4]); } };
        shift8(0, h * 64 + d0, rr); shift8(1, 512 + h * 64 + d0, kx); shift8(2, 1024 + h * 64 + d0, vx);
        float xw[8], xa[8], xg0[8], xg1[8];
        shift8(3, 1536 + d0, xw); shift8(4, 1600 + d0, xa); shift8(5, 1664 + d0, xg0); shift8(6, 1728 + d0, xg1);
        asm volatile("" ::: "memory");
        { const bf16_t* lora = (const bf16_t*)(p.ws + WS_LORA + (size_t)l * 262144);
    #pragma unroll
          for (int nn = 0; nn < 2; ++nn) { const int hd = h * 64 + 16 * (2 * (wave & 1) + nn) + c15;
    #pragma unroll
              for (int s2 = 0; s2 < 2; ++s2) { lw[nn][s2] = *(const bf16x8*)(lora + (size_t)hd * 64 + 32 * s2 + 8 * g); la[nn][s2] = *(const bf16x8*)(lora + 32768 + (size_t)hd * 64 + 32 * s2 + 8 * g); }
    #pragma unroll
              for (int s4 = 0; s4 < 4; ++s4) lg_[nn][s4] = *(const bf16x8*)(lora + 65536 + (size_t)hd * 128 + 32 * s4 + 8 * g); } }
        float n2 = 0.f;
        { const f32x4 k0 = *(const f32x4*)(p.in[I_KK] + l * 512 + h * 64 + d0), k1 = *(const f32x4*)(p.in[I_KK] + l * 512 + h * 64 + d0 + 4);
#pragma unroll
          for (int i = 0; i < 8; ++i) { kk[i] = kx[i] * (i < 4 ? k0[i] : k1[i - 4]); n2 = fmaf(kk[i], kk[i], n2); } }
        n2 += __shfl_xor(n2, 1); n2 += __shfl_xor(n2, 2); n2 += __shfl_xor(n2, 4);
        const float rn = rsqrtf(fmaxf(n2, 1e-24f));
#pragma unroll
        for (int i = 0; i < 8; ++i) { kk[i] *= rn; xw[i] = 1.0f - 2.0f * __builtin_amdgcn_rcpf(1.0f + __expf(2.0f * xw[i])); xg0[i] = sigmoidf_(xg0[i]); xg1[i] = sigmoidf_(xg1[i]); }
        u32x4 w;
        w.x = pk2(xw[0], xw[1]); w.y = pk2(xw[2], xw[3]); w.z = pk2(xw[4], xw[5]); w.w = pk2(xw[6], xw[7]); *(LAS u32x4*)(L + R1_XW + (t * PS + d0) * 2) = w;
        w.x = pk2(xa[0], xa[1]); w.y = pk2(xa[2], xa[3]); w.z = pk2(xa[4], xa[5]); w.w = pk2(xa[6], xa[7]); *(LAS u32x4*)(L + R1_XA + (t * PS + d0) * 2) = w;
        w.x = pk2(xg0[0], xg0[1]); w.y = pk2(xg0[2], xg0[3]); w.z = pk2(xg0[4], xg0[5]); w.w = pk2(xg0[6], xg0[7]); *(LAS u32x4*)(L + R1_XG + (t * 136 + d0) * 2) = w;
        w.x = pk2(xg1[0], xg1[1]); w.y = pk2(xg1[2], xg1[3]); w.z = pk2(xg1[4], xg1[5]); w.w = pk2(xg1[6], xg1[7]); *(LAS u32x4*)(L + R1_XG + (t * 136 + 64 + d0) * 2) = w;
    }
    LDS_BARRIER();
    R1P(0);
    const int tm = wave >> 1;
    unsigned char* rw2 = p.ws + WS_RW2 + (size_t)unit * 8192;
    {
#pragma unroll
        for (int nn = 0; nn < 2; ++nn) { const int tn = 2 * (wave & 1) + nn, dcol = 16 * tn + c15, hd = h * 64 + dcol;
            f32x4 aw = {0.f, 0.f, 0.f, 0.f}, aa = aw, ag = aw;
#pragma unroll
            for (int s2 = 0; s2 < 2; ++s2) {
                const bf16x8 xa_ = *(const LAS bf16x8*)(L + R1_XW + ((16 * tm + c15) * PS + 32 * s2 + 8 * g) * 2), xb_ = *(const LAS bf16x8*)(L + R1_XA + ((16 * tm + c15) * PS + 32 * s2 + 8 * g) * 2);
                aw = mfma16(xa_, lw[nn][s2], aw);
                aa = mfma16(xb_, la[nn][s2], aa); }
#pragma unroll
            for (int s4 = 0; s4 < 4; ++s4) ag = mfma16(*(const LAS bf16x8*)(L + R1_XG + ((16 * tm + c15) * 136 + 32 * s4 + 8 * g) * 2), lg_[nn][s4], ag);
            const float w0 = p.in[I_W0][l * 512 + hd], a0 = p.in[I_A0][l * 512 + hd];
#pragma unroll
            for (int e = 0; e < 4; ++e) { const int tt = 16 * tm + 4 * g + e;
                *(LAS float*)(L + R1_E + (tt * 65 + dcol) * 4) = 0.60653065971263342f * sigmoidf_(w0 + aw[e]);
                *(LAS unsigned short*)(L + R1_AA + (tt * PS + dcol) * 2) = (unsigned short)f2bf(sigmoidf_(a0 + aa[e]));
                *(LAS unsigned short*)(L + R1_GS + (tt * PS + dcol) * 2) = (unsigned short)f2bf(ag[e]); }
        }
    }
    LDS_BARRIER();
    R1P(1);
    {
        const int d = tid & 63, sg = tid >> 6; float cum = 0.f, loc[8];
#pragma unroll
        for (int i = 0; i < 8; ++i) { cum += *(const LAS float*)(L + R1_E + ((8 * sg + i) * 65 + d) * 4); loc[i] = cum; }
        *(LAS float*)(L + R1_BS + (sg * 64 + d) * 4 - 2048) = cum;
        LDS_BARRIER();
        float off = 0.f;
#pragma unroll
        for (int q = 0; q < 7; ++q) if (q < sg) off += *(const LAS float*)(L + R1_BS + (q * 64 + d) * 4 - 2048);
#pragma unroll
        for (int i = 0; i < 8; ++i) *(LAS float*)(L + R1_E + ((8 * sg + i) * 65 + d) * 4) = loc[i] + off;
    }
    LDS_BARRIER();
    R1P(2);
    {
        const f32x4 ka0 = *(const f32x4*)(p.in[I_KA] + l * 512 + h * 64 + d0), ka1 = *(const f32x4*)(p.in[I_KA] + l * 512 + h * 64 + d0 + 4);
        const f32x4 rk0 = *(const f32x4*)(p.in[I_RK] + l * 512 + h * 64 + d0), rk1 = *(const f32x4*)(p.in[I_RK] + l * 512 + h * 64 + d0 + 4);
        const u32x4 aw_ = *(const LAS u32x4*)(L + R1_AA + (t * PS + d0) * 2);
        const float av[8] = {bflo(aw_.x), bfhi(aw_.x), bflo(aw_.y), bfhi(aw_.y), bflo(aw_.z), bfhi(aw_.z), bflo(aw_.w), bfhi(aw_.w)};
        float At[8], Bt[8], Kt[8], Rt[8]; float bpart = 0.f;
#pragma unroll
        for (int i = 0; i < 8; ++i) {
            const float cumt = *(const LAS float*)(L + R1_E + (t * 65 + d0 + i) * 4), cump = t > 0 ? *(const LAS float*)(L + R1_E + ((t - 1) * 65 + d0 + i) * 4) : 0.f;
            const float gam = __expf(-cumt), gprev = __expf(-cump), ginv = __expf(cumt);
            const float kmod = kx[i] * (1.0f + (av[i] - 1.0f) * (i < 4 ? ka0[i] : ka1[i - 4]));
            At[i] = -gprev * kk[i]; Bt[i] = kk[i] * av[i] * ginv; Kt[i] = kmod * ginv; Rt[i] = rr[i] * gam;
            bpart = fmaf(rr[i] * kmod, (i < 4 ? rk0[i] : rk1[i - 4]), bpart);
            if (t == 63) *(LAS float*)(L + R1_GC + (d0 + i) * 4) = gam;
            *(LAS float*)(L + R1_RHS + ((d0 + i) * 65 + t) * 4) = At[i];
            *(LAS unsigned short*)(L + R1_BTT + ((d0 + i) * PS + t) * 2) = (unsigned short)f2bf(Bt[i]);
            *(LAS unsigned short*)(L + R1_KTT + ((d0 + i) * PS + t) * 2) = (unsigned short)f2bf(Kt[i]);
            *(LAS unsigned short*)(L + R1_VT + ((d0 + i) * PS + t) * 2) = (unsigned short)f2bf(vx[i]);
        }
        u32x4 w;
        w.x = pk2(At[0], At[1]); w.y = pk2(At[2], At[3]); w.z = pk2(At[4], At[5]); w.w = pk2(At[6], At[7]); *(LAS u32x4*)(L + R1_AT + (t * PS + d0) * 2) = w;
        w.x = pk2(Rt[0], Rt[1]); w.y = pk2(Rt[2], Rt[3]); w.z = pk2(Rt[4], Rt[5]); w.w = pk2(Rt[6], Rt[7]); *(LAS u32x4*)(L + R1_RT + (t * PS + d0) * 2) = w;
        w.x = pk2(Bt[0], Bt[1]); w.y = pk2(Bt[2], Bt[3]); w.z = pk2(Bt[4], Bt[5]); w.w = pk2(Bt[6], Bt[7]); *(LAS u32x4*)(L + R1_BT + (t * PS + d0) * 2) = w;
        w.x = pk2(Kt[0], Kt[1]); w.y = pk2(Kt[2], Kt[3]); w.z = pk2(Kt[4], Kt[5]); w.w = pk2(Kt[6], Kt[7]); *(LAS u32x4*)(L + R1_KT + (t * PS + d0) * 2) = w;
        bpart += __shfl_xor(bpart, 1); bpart += __shfl_xor(bpart, 2); bpart += __shfl_xor(bpart, 4);
        const u32x4 gw = *(const LAS u32x4*)(L + R1_GS + (t * PS + d0) * 2);
        const float gv[8] = {bflo(gw.x), bfhi(gw.x), bflo(gw.y), bfhi(gw.y), bflo(gw.z), bfhi(gw.z), bflo(gw.w), bfhi(gw.w)};
        w.x = pk2(bpart * vx[0] * gv[0], bpart * vx[1] * gv[1]); w.y = pk2(bpart * vx[2] * gv[2], bpart * vx[3] * gv[3]);
        w.z = pk2(bpart * vx[4] * gv[4], bpart * vx[5] * gv[5]); w.w = pk2(bpart * vx[6] * gv[6], bpart * vx[7] * gv[7]);
        *(u32x4*)((bf16_t*)(p.ws + WS_OAB) + (size_t)row * D + 512 + h * 64 + d0) = w;
        *(u32x4*)(rw2 + 2 * RW2_ARR + (size_t)(t * 64 + d0) * 2) = gw;
    }
    LDS_BARRIER();
    R1P(3);
    {
        f32x4 gab[2], gak[2], grb[2], grk[2];
#pragma unroll
        for (int nn = 0; nn < 2; ++nn) { const int tn = 2 * (wave & 1) + nn;
            gab[nn] = (f32x4){0.f, 0.f, 0.f, 0.f}; gak[nn] = gab[nn]; grb[nn] = gab[nn]; grk[nn] = gab[nn];
            if (tn <= tm) {
#pragma unroll
                for (int s2 = 0; s2 < 2; ++s2) { const int ao = ((16 * tm + c15) * PS + 32 * s2 + 8 * g) * 2, bo = ((16 * tn + c15) * PS + 32 * s2 + 8 * g) * 2;
                    const bf16x8 fa = *(const LAS bf16x8*)(L + R1_AT + ao), fr_ = *(const LAS bf16x8*)(L + R1_RT + ao), fb = *(const LAS bf16x8*)(L + R1_BT + bo), fk = *(const LAS bf16x8*)(L + R1_KT + bo);
                    gab[nn] = mfma16(fa, fb, gab[nn]); gak[nn] = mfma16(fa, fk, gak[nn]); grb[nn] = mfma16(fr_, fb, grb[nn]); grk[nn] = mfma16(fr_, fk, grk[nn]); } } }
        LDS_BARRIER();
#pragma unroll
        for (int nn = 0; nn < 2; ++nn) { const int tn = 2 * (wave & 1) + nn, icol = 16 * tn + c15;
            f32x4 lab;
#pragma unroll
            for (int e = 0; e < 4; ++e) { const int tt = 16 * tm + 4 * g + e; const bool strict = icol < tt, incl = icol <= tt;
                lab[e] = strict ? gab[nn][e] : 0.f;
                *(LAS unsigned short*)(L + R1_LAK + (tt * PS + icol) * 2) = (unsigned short)f2bf(strict ? gak[nn][e] : 0.f);
                *(LAS unsigned short*)(L + R1_LOFF + (tt * PS + icol) * 2) = (unsigned short)f2bf(icol < (tt & ~15) ? gab[nn][e] : 0.f);
                *(LAS unsigned short*)(L + R1_MRB + (tt * PS + icol) * 2) = (unsigned short)f2bf(incl ? grb[nn][e] : 0.f);
                *(LAS unsigned short*)(L + R1_MRK + (tt * PS + icol) * 2) = (unsigned short)f2bf(incl ? grk[nn][e] : 0.f); }
            *(LAS f32x4*)(L + R1_LABT + (icol * 64 + 16 * tm + 4 * g) * 4) = lab; }
    }
    LDS_BARRIER();
    R1P(4);
    {
#pragma unroll
        for (int nn = 0; nn < 2; ++nn) { const int tn = 2 * (wave & 1) + nn; f32x4 acc = {0.f, 0.f, 0.f, 0.f};
#pragma unroll
            for (int s2 = 0; s2 < 2; ++s2) acc = mfma16(*(const LAS bf16x8*)(L + R1_LAK + ((16 * tm + c15) * PS + 32 * s2 + 8 * g) * 2), *(const LAS bf16x8*)(L + R1_VT + ((16 * tn + c15) * PS + 32 * s2 + 8 * g) * 2), acc);
#pragma unroll
            for (int e = 0; e < 4; ++e) *(LAS float*)(L + R1_RHS + ((64 + 16 * tn + c15) * 65 + 16 * tm + 4 * g + e) * 4) = acc[e]; }
    }
    LDS_BARRIER();
    R1P(5);
#pragma unroll 1
    for (int Tb = 0; Tb < 4; ++Tb) {
        if (Tb > 0) {
            LAS unsigned char* XT = L + (wave < 4 ? R1_WT + (16 * wave) * PS * 2 : R1_ZT + (16 * (wave - 4)) * PS * 2);
            f32x4 acc = {0.f, 0.f, 0.f, 0.f};
            acc = mfma16(*(const LAS bf16x8*)(L + R1_LOFF + ((16 * Tb + c15) * PS + 8 * g) * 2), *(const LAS bf16x8*)(XT + (c15 * PS + 8 * g) * 2), acc);
            if (Tb == 3) acc = mfma16(*(const LAS bf16x8*)(L + R1_LOFF + ((16 * Tb + c15) * PS + 32 + 8 * g) * 2), *(const LAS bf16x8*)(XT + (c15 * PS + 32 + 8 * g) * 2), acc);
            LAS float* rp = (LAS float*)(L + R1_RHS + ((16 * wave + c15) * 65 + 16 * Tb + 4 * g) * 4);
#pragma unroll
            for (int e = 0; e < 4; ++e) rp[e] += acc[e];
            LDS_BARRIER();
        }
        if (tid < 128) {
            LAS float* xr = (LAS float*)(L + R1_RHS + (tid * 65 + 16 * Tb) * 4);
            float acc[16];
#pragma unroll
            for (int e = 0; e < 16; ++e) acc[e] = xr[e];
#pragma unroll
            for (int ii = 0; ii < 15; ++ii) { const float xi = acc[ii];
#pragma unroll
                for (int q = (ii + 1) / 4; q < 4; ++q) { const f32x4 lv = *(const LAS f32x4*)(L + R1_LABT + ((16 * Tb + ii) * 64 + 16 * Tb + 4 * q) * 4);
#pragma unroll
                    for (int e = 0; e < 4; ++e) if (4 * q + e > ii) acc[4 * q + e] = fmaf(lv[e], xi, acc[4 * q + e]); } }
#pragma unroll
            for (int e = 0; e < 16; ++e) xr[e] = acc[e];
            LAS unsigned char* dst = L + (tid < 64 ? R1_WT + tid * PS * 2 : R1_ZT + (tid - 64) * PS * 2) + 32 * Tb;
            u32x4 w0, w1; w0.x = pk2(acc[0], acc[1]); w0.y = pk2(acc[2], acc[3]); w0.z = pk2(acc[4], acc[5]); w0.w = pk2(acc[6], acc[7]);
            w1.x = pk2(acc[8], acc[9]); w1.y = pk2(acc[10], acc[11]); w1.z = pk2(acc[12], acc[13]); w1.w = pk2(acc[14], acc[15]);
            *(LAS u32x4*)dst = w0; *(LAS u32x4*)(dst + 16) = w1;
        }
        if (Tb < 3) LDS_BARRIER();
    }
    LDS_BARRIER();
    R1P(6);
    if (next_unit >= 0) r1_load_rows(U, next_unit, tid, pf);
    {
        unsigned char* rw1 = p.ws + WS_RW1 + (size_t)unit * 16384;
#pragma unroll
        for (int nn = 0; nn < 2; ++nn) { const int tn = 2 * (wave & 1) + nn, col = 16 * tn + c15, r0 = 16 * tm + 4 * g;
            f32x4 aP = {0.f, 0.f, 0.f, 0.f}, aQ = aP, aG = aP, aY = aP;
#pragma unroll
            for (int s2 = 0; s2 < 2; ++s2) { const int ro = ((16 * tm + c15) * PS + 32 * s2 + 8 * g) * 2, co = ((16 * tn + c15) * PS + 32 * s2 + 8 * g) * 2;
                const bf16x8 fWT = *(const LAS bf16x8*)(L + R1_WT + ro), fBTT = *(const LAS bf16x8*)(L + R1_BTT + ro), fKTT = *(const LAS bf16x8*)(L + R1_KTT + ro), fMRB = *(const LAS bf16x8*)(L + R1_MRB + ro), fMRK = *(const LAS bf16x8*)(L + R1_MRK + ro);
                const bf16x8 cBTT = *(const LAS bf16x8*)(L + R1_BTT + co), cZT = *(const LAS bf16x8*)(L + R1_ZT + co), cVT = *(const LAS bf16x8*)(L + R1_VT + co), cMRB = *(const LAS bf16x8*)(L + R1_MRB + co);
                aP = mfma16(fWT, cBTT, aP);
                aQ = mfma16(fBTT, cZT, aQ); aQ = mfma16(fKTT, cVT, aQ);
                aG = mfma16(fWT, cMRB, aG);
                aY = mfma16(fMRB, cZT, aY); aY = mfma16(fMRK, cVT, aY); }
            const float gcc = *(const LAS float*)(L + R1_GC + col * 4);
            const f32x4 gcr = *(const LAS f32x4*)(L + R1_GC + r0 * 4);
            const u32x2 rtw = *(const LAS u32x2*)(L + R1_RT + (col * PS + r0) * 2);
#pragma unroll
            for (int e = 0; e < 4; ++e) { aP[e] = (aP[e] + ((r0 + e) == col ? 1.0f : 0.f)) * gcc; aQ[e] *= gcr[e]; }
            aG[0] += bflo(rtw.x); aG[1] += bfhi(rtw.x); aG[2] += bflo(rtw.y); aG[3] += bfhi(rtw.y);
            *(u32x2*)(rw1 + (size_t)(col * 64 + r0) * 2) = pk4(aP);
            *(u32x2*)(rw1 + 8192 + (size_t)(col * 64 + r0) * 2) = pk4(aG);
            *(u32x2*)(rw2 + (size_t)(col * 64 + r0) * 2) = pk4(aQ);
            *(u32x2*)(rw2 + RW2_ARR + (size_t)(col * 64 + r0) * 2) = pk4(aY); }
    }
    LDS_BARRIER();
    R1P(7);
}

constexpr int R2_SV = 0, R2_YS = 2 * 64 * PS * 2, R2_END = R2_YS + 2 * 64 * 68 * 4;
__device__ __forceinline__ void rwkv_scan(const Params& p, int l, int bh, unsigned char* lds) {
    const int tid = otid(), wave = tid >> 6, lane = tid & 63, c15 = lane & 15, g = lane >> 4;
    const int b = bh >> 3, h = bh & 7, role = wave >> 2, j = wave & 3, vcol = 16 * j + c15;
    LAS unsigned char* L = (LAS unsigned char*)lds;
    for (int i = tid; i < 2 * 64 * PS * 2 / 4; i += NTHREADS) ((LAS unsigned*)(L + R2_SV))[i] = 0u;
    LDS_BARRIER();
    const int et = tid >> 3, ev0 = 8 * (tid & 7);
    f32x4 gn0[2], gn1[2];
    { const float* gp = p.in[I_GNG] + l * 512 + h * 64 + ev0; const float* bp = p.in[I_GNB] + l * 512 + h * 64 + ev0;
      gn0[0] = *(const f32x4*)gp; gn0[1] = *(const f32x4*)(gp + 4); gn1[0] = *(const f32x4*)bp; gn1[1] = *(const f32x4*)(bp + 4); }
    bf16_t* OB = (bf16_t*)(p.ws + WS_OAB) + (size_t)(b * LP + et) * D + 512 + h * 64 + ev0;
    const int unit0 = (b * NCH) * 8 + h;
    const unsigned char* rw1b = p.ws + WS_RW1 + (role ? 8192 : 0) + (size_t)(c15 * 64 + 8 * g) * 2;
    const unsigned char* rw2b = p.ws + WS_RW2 + (role ? RW2_ARR : 0) + (size_t)(vcol * 64 + 4 * g) * 2;
    const unsigned char* ggb = p.ws + WS_RW2 + 2 * RW2_ARR + (size_t)(et * 64 + ev0) * 2;
    bf16x8 A0[4][2], A1[4][2]; u32x2 I0[4], I1[4];
    u32x4 G0 = {0u, 0u, 0u, 0u}, O0 = G0, G1, O1;
#define R2_LOAD(AA, II, cc) do { const size_t un_ = (size_t)(unit0 + 8 * ((cc) < NCH ? (cc) : NCH - 1)); \
        _Pragma("unroll") for (int m = 0; m < 4; ++m) { II[m] = *(const u32x2*)(rw2b + un_ * 8192 + 32 * m); \
            _Pragma("unroll") for (int s2 = 0; s2 < 2; ++s2) AA[m][s2] = *(const bf16x8*)(rw1b + un_ * 16384 + (16 * m * 64 + 32 * s2) * 2); } } while (0)
    R2_LOAD(A0, I0, 0); R2_LOAD(A1, I1, 1);
    G1 = *(const u32x4*)(ggb + (size_t)unit0 * 8192); O1 = *(const u32x4*)OB;
#pragma unroll 1
    for (int c = 0; c <= NCH; ++c) {
        const int cur = c & 1;
        bf16x8 A2[4][2]; u32x2 I2[4];
        R2_LOAD(A2, I2, c + 2);
        u32x4 G2, O2; { const int cn = c + 1 < NCH ? c + 1 : NCH - 1; G2 = *(const u32x4*)(ggb + (size_t)(unit0 + 8 * cn) * 8192); O2 = *(const u32x4*)(OB + (size_t)(64 * cn) * D); }
        if (c > 0) {
            const f32x4 y0 = *(const LAS f32x4*)(L + R2_YS + ((cur ^ 1) * 64 * 68 + et * 68 + ev0) * 4), y1 = *(const LAS f32x4*)(L + R2_YS + ((cur ^ 1) * 64 * 68 + et * 68 + ev0 + 4) * 4);
            float s1 = (y0[0] + y0[1]) + (y0[2] + y0[3]) + (y1[0] + y1[1]) + (y1[2] + y1[3]);
            s1 = sum8(s1); const float mean = s1 * (1.f / 64.f);
            const f32x4 d0 = y0 - mean, d1 = y1 - mean;
            float s2_ = (d0[0] * d0[0] + d0[1] * d0[1]) + (d0[2] * d0[2] + d0[3] * d0[3]) + (d1[0] * d1[0] + d1[1] * d1[1]) + (d1[2] * d1[2] + d1[3] * d1[3]);
            s2_ = sum8(s2_); const float rstd = rsqrtf(s2_ * (1.f / 64.f) + GN_EPS);
            const float gv[8] = {bflo(G0.x), bfhi(G0.x), bflo(G0.y), bfhi(G0.y), bflo(G0.z), bfhi(G0.z), bflo(G0.w), bfhi(G0.w)};
            const float ov[8] = {bflo(O0.x), bfhi(O0.x), bflo(O0.y), bfhi(O0.y), bflo(O0.z), bfhi(O0.z), bflo(O0.w), bfhi(O0.w)};
            float o[8];
#pragma unroll
            for (int i = 0; i < 4; ++i) { o[i] = ov[i] + (d0[i] * rstd * gn0[0][i] + gn1[0][i]) * gv[i]; o[4 + i] = ov[4 + i] + (d1[i] * rstd * gn0[1][i] + gn1[1][i]) * gv[4 + i]; }
            u32x4 w; w.x = pk2(o[0], o[1]); w.y = pk2(o[2], o[3]); w.z = pk2(o[4], o[5]); w.w = pk2(o[6], o[7]);
            *(u32x4*)(OB + (size_t)(64 * (c - 1)) * D) = w;
        }
        if (c < NCH) {
            bf16x8 bf_[2];
#pragma unroll
            for (int s2 = 0; s2 < 2; ++s2) bf_[s2] = *(const LAS bf16x8*)(L + R2_SV + cur * 64 * PS * 2 + (vcol * PS + 32 * s2 + 8 * g) * 2);
            f32x4 acc[4];
#pragma unroll
            for (int m = 0; m < 4; ++m) { acc[m] = (f32x4){bflo(I0[m].x), bfhi(I0[m].x), bflo(I0[m].y), bfhi(I0[m].y)};
#pragma unroll
                for (int s2 = 0; s2 < 2; ++s2) acc[m] = mfma16(A0[m][s2], bf_[s2], acc[m]); }
            if (role == 0) {
#pragma unroll
                for (int m = 0; m < 4; ++m) *(LAS u32x2*)(L + R2_SV + (cur ^ 1) * 64 * PS * 2 + (vcol * PS + 16 * m + 4 * g) * 2) = pk4(acc[m]);
            } else {
#pragma unroll
                for (int m = 0; m < 4; ++m)
#pragma unroll
                    for (int e = 0; e < 4; ++e) *(LAS float*)(L + R2_YS + (cur * 64 * 68 + (16 * m + 4 * g + e) * 68 + vcol) * 4) = acc[m][e];
            }
        }
        LDS_BARRIER();
#pragma unroll
        for (int m = 0; m < 4; ++m) { I0[m] = I1[m]; I1[m] = I2[m]; A0[m][0] = A1[m][0]; A0[m][1] = A1[m][1]; A1[m][0] = A2[m][0]; A1[m][1] = A2[m][1]; }
        G0 = G1; O0 = O1; G1 = G2; O1 = O2;
    }
#undef R2_LOAD
}

__device__ void rwkv_naive(const Params& p, int l, int bh, unsigned char* lds) {
    const int b = bh >> 3, h = bh & 7, tid = otid(), lane = tid & 63, wid = tid >> 6;
    const bf16_t* U = (const bf16_t*)(p.ws + WS_UAR);
    bf16_t* OB = (bf16_t*)(p.ws + WS_OAB);
    float* xs = (float*)lds;
    float* vr = xs + 32 * 256;
    float* vw = vr + 2048; float* vkk = vw + 2048; float* vbb = vkk + 2048; float* vk = vbb + 2048; float* vv = vk + 2048;
    float* gg = vv + 2048; float* bon = gg + 2048; float* ys = bon + 2048;
    const float* mu = p.in[I_MU] + l * R_COLS;
    const int hd = h * 64 + lane;
    const float w0 = p.in[I_W0][l * 512 + hd], a0 = p.in[I_A0][l * 512 + hd], kkc = p.in[I_KK][l * 512 + hd], kac = p.in[I_KA][l * 512 + hd], rkc = p.in[I_RK][l * 512 + hd];
    const float gng = p.in[I_GNG][l * 512 + hd], gnb = p.in[I_GNB][l * 512 + hd];
    const float mur = mu[hd], muk = mu[512 + hd], muv = mu[1024 + hd];
    const float* wup = p.in[I_WUP] + (size_t)l * 64 * 512 + hd; const float* aup = p.in[I_AUP] + (size_t)l * 64 * 512 + hd; const float* gup = p.in[I_GUP] + (size_t)l * 128 * 512 + hd;
    float S[8];
#pragma unroll
    for (int i = 0; i < 8; ++i) S[i] = 0.f;
    const int sv = tid >> 3, sq = tid & 7;
    for (int p0 = 0; p0 < LP; p0 += 32) {
        for (int idx = tid; idx < 32 * 256; idx += NTHREADS) {
            const int tt = idx >> 8, j = idx & 255, pos = p0 + tt; const size_t ro = (size_t)(b * LP + pos) * UARW;
            const float x = bf2f(U[ro + C_XW + j]); const float xp = pos > 0 ? bf2f(U[ro - UARW + C_XW + j]) : 0.f;
            float xv = x + (xp - x) * mu[1536 + j];
            if (j < 64) xv = tanhf(xv); else if (j >= 128) xv = sigmoidf_(xv);
            xs[idx] = xv;
        }
        __syncthreads();
        {
            float dw[4] = {0.f, 0.f, 0.f, 0.f}, da[4] = {0.f, 0.f, 0.f, 0.f}, dg[4] = {0.f, 0.f, 0.f, 0.f};
            for (int j = 0; j < 64; ++j) { const float w1 = wup[(size_t)j * 512], w2 = aup[(size_t)j * 512];
#pragma unroll
                for (int k = 0; k < 4; ++k) { dw[k] = fmaf(xs[(wid * 4 + k) * 256 + j], w1, dw[k]); da[k] = fmaf(xs[(wid * 4 + k) * 256 + 64 + j], w2, da[k]); } }
            for (int j = 0; j < 128; ++j) { const float w3 = gup[(size_t)j * 512];
#pragma unroll
                for (int k = 0; k < 4; ++k) dg[k] = fmaf(xs[(wid * 4 + k) * 256 + 128 + j], w3, dg[k]); }
#pragma unroll
            for (int k = 0; k < 4; ++k) {
                const int tt = wid * 4 + k, pos = p0 + tt; const size_t ro = (size_t)(b * LP + pos) * UARW;
                float r = bf2f(U[ro + C_R + hd]), kx = bf2f(U[ro + C_RK + hd]), vx = bf2f(U[ro + C_RV + hd]);
                if (pos > 0) { const float rp = bf2f(U[ro - UARW + C_R + hd]), kp = bf2f(U[ro - UARW + C_RK + hd]), vp = bf2f(U[ro - UARW + C_RV + hd]);
                    r += (rp - r) * mur; kx += (kp - kx) * muk; vx += (vp - vx) * muv; }
                else { r -= r * mur; kx -= kx * muk; vx -= vx * muv; }
                const float z = -(w0 + dw[k]); const float sp = fmaxf(z, 0.f) + log1pf(__expf(-fabsf(z)));
                const float logw = -sp - 0.5f; const float w = __expf(-__expf(logw));
                const float a = sigmoidf_(a0 + da[k]);
                float kk = kx * kkc; const float nrm = wave_sum(kk * kk); kk *= rsqrtf(fmaxf(nrm, 1e-24f));
                const float kmod = kx * (1.0f + (a - 1.0f) * kac);
                const float bsum = wave_sum(r * kmod * rkc);
                vr[tt * 64 + lane] = r; vw[tt * 64 + lane] = w; vkk[tt * 64 + lane] = kk; vbb[tt * 64 + lane] = kk * a; vk[tt * 64 + lane] = kmod; vv[tt * 64 + lane] = vx;
                gg[tt * 64 + lane] = dg[k]; bon[tt * 64 + lane] = bsum * vx;
            }
        }
        __syncthreads();
        for (int tt = 0; tt < 32; ++tt) {
            const f32x4 k0 = *(const f32x4*)(vkk + tt * 64 + sq * 8), k1 = *(const f32x4*)(vkk + tt * 64 + sq * 8 + 4);
            const f32x4 w0v = *(const f32x4*)(vw + tt * 64 + sq * 8), w1v = *(const f32x4*)(vw + tt * 64 + sq * 8 + 4);
            const f32x4 b0 = *(const f32x4*)(vbb + tt * 64 + sq * 8), b1 = *(const f32x4*)(vbb + tt * 64 + sq * 8 + 4);
            const f32x4 m0 = *(const f32x4*)(vk + tt * 64 + sq * 8), m1 = *(const f32x4*)(vk + tt * 64 + sq * 8 + 4);
            const f32x4 r0 = *(const f32x4*)(vr + tt * 64 + sq * 8), r1 = *(const f32x4*)(vr + tt * 64 + sq * 8 + 4);
            const float vt = vv[tt * 64 + sv];
            float sa = 0.f;
#pragma unroll
            for (int i = 0; i < 4; ++i) { sa = fmaf(S[i], k0[i], sa); sa = fmaf(S[4 + i], k1[i], sa); }
            sa += __shfl_xor(sa, 1); sa += __shfl_xor(sa, 2); sa += __shfl_xor(sa, 4);
            sa = -sa; float y = 0.f;
#pragma unroll
            for (int i = 0; i < 4; ++i) { S[i] = S[i] * w0v[i] + sa * b0[i] + vt * m0[i]; S[4 + i] = S[4 + i] * w1v[i] + sa * b1[i] + vt * m1[i];
                y = fmaf(S[i], r0[i], y); y = fmaf(S[4 + i], r1[i], y); }
            y += __shfl_xor(y, 1); y += __shfl_xor(y, 2); y += __shfl_xor(y, 4);
            if (sq == 0) ys[tt * 64 + sv] = y;
        }
        __syncthreads();
#pragma unroll
        for (int k = 0; k < 4; ++k) { const int tt = wid * 4 + k, pos = p0 + tt; const float y = ys[tt * 64 + lane];
            const float m = wave_sum(y) * (1.f / 64.f); const float dv = y - m; const float var = wave_sum(dv * dv) * (1.f / 64.f);
            const float o = (dv * rsqrtf(var + GN_EPS) * gng + gnb + bon[tt * 64 + lane]) * gg[tt * 64 + lane];
            OB[(size_t)(b * LP + pos) * D + 512 + hd] = (bf16_t)f2bf(o); }
        __syncthreads();
    }
}

__device__ __forceinline__ int pair_index(int a, int b) {   return a == 0 ? b - 1 : (a == 1 ? b + 1 : 5); }
__device__ __forceinline__ void pair_of(int idx, int& a, int& b) { a = idx < 3 ? 0 : (idx < 5 ? 1 : 2); b = idx < 3 ? idx + 1 : (idx < 5 ? idx - 1 : 3); }
__device__ __forceinline__ void ln1_rows(const Params& p, int l, unsigned char* lds, int row0, bool stage) {
    const int tid = otid(), lane = tid & 63, gw = row0 + 8 * (tid >> 6), NGW = 1, TEND = gw + 8;
    int* lcnt = (int*)(lds + 65536); int* lbase = lcnt + 32; int* rec = lcnt + 64;
    __syncthreads();
    if (tid < 32) lcnt[tid] = 0;
    float* wr_s = (float*)lds;
    if (stage) for (int i = tid; i < D * 16 / 4; i += NTHREADS) { const f32x4 w = ((const f32x4*)p.in[I_WROUTER])[i]; const int c = i >> 2, e0 = (i & 3) * 4;
        wr_s[(e0 + 0) * D + c] = w[0]; wr_s[(e0 + 1) * D + c] = w[1]; wr_s[(e0 + 2) * D + c] = w[2]; wr_s[(e0 + 3) * D + c] = w[3]; }
    __syncthreads();
    unsigned* cls_cnt = (unsigned*)(p.ws + WS_CTL) + CW_CLS + l * 512;
    int* lists = (int*)(p.ws + WS_LIST); f32x2* gl = (f32x2*)(p.ws + WS_LIST + 2 * MiB);
    const float* g = p.in[I_LN1G] + l * D; const float* bt = p.in[I_LN1B] + l * D;
    f32x4 vn[4];
    { const float* h0 = hrow(p, gw);
#pragma unroll
      for (int j = 0; j < 4; ++j) vn[j] = *(const f32x4*)(h0 + 4 * lane + 256 * j); }
    int nrec = 0;
    for (int r = gw; r < TEND; r += NGW) {
        f32x4 v[4];
#pragma unroll
        for (int j = 0; j < 4; ++j) v[j] = vn[j];
        { const float* h1 = hrow(p, r + NGW < TEND ? r + NGW : r);
#pragma unroll
          for (int j = 0; j < 4; ++j) vn[j] = *(const f32x4*)(h1 + 4 * lane + 256 * j); }
        if (is_dummy(r)) {
#pragma unroll
            for (int j = 0; j < 4; ++j) v[j] = (f32x4){0.f, 0.f, 0.f, 0.f};
            store_row(p, r, v, lane, true); continue; }
        ln_wave(v, g, bt, lane);
        store_row(p, r, v, lane, false);
        float lg[16];
#pragma unroll
        for (int e = 0; e < 16; ++e) lg[e] = 0.f;
#pragma unroll
        for (int e = 0; e < 16; ++e)
#pragma unroll
            for (int j = 0; j < 4; ++j) { const f32x4 w = *(const f32x4*)(wr_s + e * D + 4 * lane + 256 * j);
                lg[e] = fmaf(v[j][0], w[0], lg[e]); lg[e] = fmaf(v[j][1], w[1], lg[e]); lg[e] = fmaf(v[j][2], w[2], lg[e]); lg[e] = fmaf(v[j][3], w[3], lg[e]); }
        float mine = 0.f;
#pragma unroll
        for (int e = 0; e < 16; ++e) { const float rs = sum16(lg[e]); mine = (lane & 15) == e ? rs : mine; }
        mine += __shfl_xor(mine, 16); mine += __shfl_xor(mine, 32);
#pragma unroll
        for (int e = 0; e < 16; ++e) lg[e] = __builtin_bit_cast(float, __builtin_amdgcn_readlane(__builtin_bit_cast(int, mine), e));
        float s[16], sel[16];
#pragma unroll
        for (int e = 0; e < 16; ++e) { s[e] = sigmoidf_(lg[e]); sel[e] = s[e] + p.in[I_BROUTER][e]; }
        int gbest = 0; float gsc = -INFINITY;
#pragma unroll
        for (int gi = 0; gi < 4; ++gi) { float m1 = -INFINITY, m2 = -INFINITY;
#pragma unroll
            for (int j = 0; j < 4; ++j) { const float x = sel[gi * 4 + j]; if (x > m1) { m2 = m1; m1 = x; } else if (x > m2) m2 = x; }
            const float sc = m1 + m2; if (sc > gsc) { gsc = sc; gbest = gi; } }
        float sg[4], sgs[4];
#pragma unroll
        for (int j = 0; j < 4; ++j) { sg[j] = gbest == 0 ? sel[j] : (gbest == 1 ? sel[4 + j] : (gbest == 2 ? sel[8 + j] : sel[12 + j])); sgs[j] = gbest == 0 ? s[j] : (gbest == 1 ? s[4 + j] : (gbest == 2 ? s[8 + j] : s[12 + j])); }
        int j1 = 0;
#pragma unroll
        for (int j = 1; j < 4; ++j) if (sg[j] > sg[j1]) j1 = j;
        int j2 = j1 == 0 ? 1 : 0;
#pragma unroll
        for (int j = 0; j < 4; ++j) if (j != j1 && j != j2 && sg[j] > sg[j2]) j2 = j;
        const int ja = j1 < j2 ? j1 : j2, jb = j1 < j2 ? j2 : j1;
        float sa_ = 0.f, sb_ = 0.f;
#pragma unroll
        for (int j = 0; j < 4; ++j) { if (j == ja) sa_ = sgs[j]; if (j == jb) sb_ = sgs[j]; }
        const float inv = 1.0f / (sa_ + sb_);
        const int cls = gbest * 6 + pair_index(ja, jb);
        if (lane == 0) { const int loc = __hip_atomic_fetch_add(lcnt + cls, 1, __ATOMIC_RELAXED, __HIP_MEMORY_SCOPE_WORKGROUP); rec[(tid >> 6) * 32 + 2 * nrec] = r; rec[(tid >> 6) * 32 + 2 * nrec + 1] = (cls << 16) | loc; gl[r] = (f32x2){sa_ * inv, sb_ * inv}; }
        ++nrec;
    }
    __syncthreads();
    if (tid < 24) lbase[tid] = (int)atomicAdd(cls_cnt + 16 * tid, (unsigned)lcnt[tid]);
    __syncthreads();
    if (lane < nrec) { const int r = rec[(tid >> 6) * 32 + 2 * lane], cl = rec[(tid >> 6) * 32 + 2 * lane + 1]; const int cls = cl >> 16; lists[(size_t)cls * T + lbase[cls] + (cl & 0xffff)] = r; }
}


constexpr size_t WS_CH1 = 655360;
constexpr int CH1_NM = 260, CH1_NW = 260, CH1_NC = 96, CH1_NL = 260, CH1_TOT = CH1_NM + CH1_NW + CH1_NC + CH1_NL;
__device__ __forceinline__ void task_signal(unsigned* c0, unsigned* c1) {
    asm volatile("s_waitcnt vmcnt(0)" ::: "memory");
    __syncthreads();
    if (otid() == 0) { __builtin_amdgcn_fence(__ATOMIC_RELEASE, "agent"); asm volatile("s_waitcnt vmcnt(0)" ::: "memory");
        __hip_atomic_fetch_add(c0, 1u, __ATOMIC_RELAXED, __HIP_MEMORY_SCOPE_AGENT); if (c1) __hip_atomic_fetch_add(c1, 1u, __ATOMIC_RELAXED, __HIP_MEMORY_SCOPE_AGENT); }
}
__device__ __forceinline__ void task_wait(unsigned* c, unsigned target) {
    if (otid() == 0) { unsigned sp = 0; while (__hip_atomic_load(c, __ATOMIC_RELAXED, __HIP_MEMORY_SCOPE_AGENT) < target && ++sp < (1u << 24)) __builtin_amdgcn_s_sleep(2);
        __builtin_amdgcn_fence(__ATOMIC_ACQUIRE, "agent"); asm volatile("s_waitcnt vmcnt(0)" ::: "memory"); }
    __syncthreads();
}
__device__ __forceinline__ bool xq_pop(unsigned* qb, int ntiles, int per_tile, int extra, int& k, volatile int* uw, int& q, int& t) {
    __syncthreads();
    if (otid() == 0) { const int home = (int)(__builtin_amdgcn_s_getreg((3 << 11) | 20) & 7u); int kk = k, qq = -1, tt = 0;
        while (kk < 8) { qq = (home + kk) & 7; tt = (int)atomicAdd(qb + 32 * qq, 1u); if (tt < per_tile * ((ntiles + 7 - qq) >> 3) + extra) break; ++kk; qq = -1; }
        uw[0] = qq; uw[1] = tt; uw[2] = kk; }
    __syncthreads();
    q = __builtin_amdgcn_readfirstlane(uw[0]); t = __builtin_amdgcn_readfirstlane(uw[1]); k = __builtin_amdgcn_readfirstlane(uw[2]);
    return q >= 0;
}
__device__ __forceinline__ void conv_expert_items(const Params& p, int l, LAS unsigned char* lds, int it0, int it1);
__device__ __forceinline__ void chain1_phase(int l, unsigned char* lds, LAS unsigned char* ldsl, unsigned long long& pacc) {
    unsigned long long pt0 = 0;
#define C1P_B(k) do { if (PROBE_PHASE == (k)) pt0 = __builtin_amdgcn_s_memrealtime(); } while (0)
#define C1P_E(k) do { if (PROBE_PHASE == (k)) pacc += __builtin_amdgcn_s_memrealtime() - pt0; } while (0)
    int staged = 0, k = 0;
    for (;;) {
        unsigned* chq = (unsigned*)(PP().ws + WS_CH1) + 1024 * l;
        int q, t; if (!xq_pop(chq + 272, 65, 12, CH1_NC / 8, k, (volatile int*)(lds + 144000), q, t)) break;
        const int np4 = 4 * ((72 - q) >> 3);
        if (t < np4) { const int pm = q + 8 * (t >> 2), pn = t & 3;
            C1P_B(50); merge_unit(l, ldsl, pm, pn, pacc);
            task_signal(chq + 64 + pm, chq + 16); C1P_E(50); staged = 0;
        } else if (t < 2 * np4) { const int u = t - np4, pm = q + 8 * (u >> 2), pn = u & 3;
            C1P_B(54); task_wait(chq + 64 + pm, 4u); C1P_E(54);
            C1P_B(51); wout_unit(l, ldsl, pm, pn);
            task_signal(chq + 192 + pm, nullptr); C1P_E(51); staged = 0;
        } else if (t < 2 * np4 + CH1_NC / 8) { const int u = q * (CH1_NC / 8) + t - 2 * np4;
            C1P_B(54); task_wait(chq + 16, (unsigned)CH1_NM); C1P_E(54);
            C1P_B(52); conv_expert_items(PP(), l, ldsl, u * 128, u * 128 + 128); C1P_E(52); staged = 0;
        } else { const int u = t - 2 * np4 - CH1_NC / 8, pm = q + 8 * (u >> 2), qr = u & 3;
            C1P_B(54); task_wait(chq + 16, (unsigned)CH1_NM);
            task_wait(chq + 192 + pm, 4u); C1P_E(54);
            C1P_B(53); ln1_rows(PP(), l, lds, pm * 256 + qr * 64, staged == 0); staged = 1; C1P_E(53);
        }
    }
}

struct ClsTab { int cnt[24]; int tile0[25]; int row0[24]; };
__device__ __forceinline__ void build_cls_table(const Params& p, int l, int* tab  ) {
    if (otid() == 0) { const unsigned* c = (const unsigned*)(p.ws + WS_CTL) + CW_CLS + l * 512; int acc = 0;
        for (int i = 0; i < 24; ++i) { const int n = (int)__hip_atomic_load(c + 16 * i, __ATOMIC_RELAXED, __HIP_MEMORY_SCOPE_AGENT); tab[i] = n; tab[24 + i] = acc; acc += (n + 255) >> 8; }
        tab[48] = acc; }
    __syncthreads();
}
__device__ __forceinline__ int find_cls(const int* tab, int tile) { int c = 0;
#pragma unroll 1
    for (int i = 1; i < 24; ++i) if (tile >= tab[24 + i]) c = i;
    return c; }
__device__ __forceinline__ void moe_a_unit(int l, LAS unsigned char* lds, const int* tab, int tile, int pn) {
    const int tid = otid();
    unsigned voffB[2]; g8::make_voffB(voffB, D * 2, true);
    {
        const int cls = find_cls(tab, tile), rt = tile - tab[24 + cls], n = tab[cls];
        int ja, jb; pair_of(cls % 6, ja, jb); const int eslot = pn >> 2, e = (cls / 6) * 4 + (eslot ? jb : ja), jblk = pn & 3;
        unsigned voffA[2][2]; { const int* lists = (const int*)(PP().ws + WS_LIST);
#pragma unroll
        for (int i = 0; i < 2; ++i) { int R, C; g8::stage_rc(tid * 16 + i * 8192, R, C);
#pragma unroll
            for (int hh = 0; hh < 2; ++hh) { const int li = rt * 256 + R + hh * 128; const int tok = li < n ? lists[(size_t)cls * T + li] : 0;
                voffA[hh][i] = (unsigned)tok * (D * 2) + (unsigned)C * 2u; } } }
        g8::Acc acc; g8::zero_acc(acc);
        const char* Bb = (const char*)(PP().ws + WS_WEXP) + ((size_t)e * 1024 + jblk * 256) * D * 2;
        const g8::KSeg s = g8::seg1((const char*)(PP().ws + WS_HB), Bb, Bb + (size_t)128 * D * 2, D / 64);
        g8::kloop<true, false>(lds, acc, s, voffA, voffB, 0);
        EPI_COORDS();
        const int* lists = (const int*)(PP().ws + WS_LIST); const f32x2* gl = (const f32x2*)(PP().ws + WS_LIST + 2 * MiB); bf16_t* ACT = (bf16_t*)(PP().ws + WS_ACT);
        int tk[2][4]; float gt[2][4];
#pragma unroll
        for (int ai = 0; ai < 2; ++ai)
#pragma unroll
            for (int m = 0; m < 4; ++m) { const int li = rt * 256 + ai * 128 + wr * 64 + m * 16 + fr; tk[ai][m] = li < n ? lists[(size_t)cls * T + li] : -1; }
#pragma unroll
        for (int ai = 0; ai < 2; ++ai)
#pragma unroll
            for (int m = 0; m < 4; ++m) { const f32x2 g2 = gl[tk[ai][m] >= 0 ? tk[ai][m] : 0]; gt[ai][m] = tk[ai][m] >= 0 ? (eslot ? g2[1] : g2[0]) : 0.f; }
#pragma unroll
        for (int ai = 0; ai < 2; ++ai)
#pragma unroll
            for (int m = 0; m < 4; ++m) { const float gate = gt[ai][m];
                const f32x4 h1a = acc[ai][0][m][0], h1b = acc[ai][0][m][1], h3a = acc[ai][1][m][0], h3b = acc[ai][1][m][1];
                float o[8];
#pragma unroll
                for (int c = 0; c < 4; ++c) { o[c] = gate * (h1a[c] * sigmoidf_(h1a[c])) * h3a[c]; o[4 + c] = gate * (h1b[c] * sigmoidf_(h1b[c])) * h3b[c]; }
                u32x4 w; w.x = pk2(o[0], o[1]); w.y = pk2(o[2], o[3]); w.z = pk2(o[4], o[5]); w.w = pk2(o[6], o[7]);
                *(u32x4*)(ACT + (size_t)(tile * 256 + ai * 128 + wr * 64 + m * 16 + fr) * D + eslot * 512 + jblk * 128 + wc * 32 + 8 * fq) = w; }
    }
}
__device__ __forceinline__ void moe_b_unit(int l, LAS unsigned char* lds, const int* tab, int tile, int pn) {
    unsigned voffA[2][2], voffB[2]; g8::make_voff_contig(voffA, D * 2); g8::make_voffB(voffB, 512 * 2, false);
    {
        const int cls = find_cls(tab, tile), rt = tile - tab[24 + cls], n = tab[cls];
        int ja, jb; pair_of(cls % 6, ja, jb); const int ea = (cls / 6) * 4 + ja, eb = (cls / 6) * 4 + jb;
        g8::Acc acc; g8::zero_acc(acc);
        const char* At = (const char*)(PP().ws + WS_ACT) + (size_t)tile * 256 * D * 2;
        const char* W2 = (const char*)(PP().ws + WS_WEXP + 32 * MiB);
        const char* Ba = W2 + ((size_t)ea * 1024 + pn * 256) * 512 * 2; const char* Bb = W2 + ((size_t)eb * 1024 + pn * 256) * 512 * 2;
        g8::KSeg s2 = g8::seg1(At, Ba, Ba + (size_t)128 * 512 * 2, 16); s2.nt0 = 8; s2.A2 = At + 1024; s2.B02 = Bb; s2.B12 = Bb + (size_t)128 * 512 * 2;
        g8::kloop<false, true>(lds, acc, s2, voffA, voffB, 128 * D * 2);
        EPI_COORDS();
        const int* lists = (const int*)(PP().ws + WS_LIST);
        const int col0 = pn * 256 + wc * 32 + 4 * fq;
        int tk[2][4];
#pragma unroll
        for (int ai = 0; ai < 2; ++ai)
#pragma unroll
            for (int m = 0; m < 4; ++m) { const int li = rt * 256 + ai * 128 + wr * 64 + m * 16 + fr; tk[ai][m] = li < n ? lists[(size_t)cls * T + li] : -1; }
#pragma unroll
        for (int ai = 0; ai < 2; ++ai) { asm volatile("" ::: "memory");
            f32x4 pre[4][2][2]; float* hr[4];
#pragma unroll
            for (int m = 0; m < 4; ++m) { hr[m] = hrow(PP(), tk[ai][m] >= 0 ? tk[ai][m] : 0) + col0;
#pragma unroll
                for (int bj = 0; bj < 2; ++bj)
#pragma unroll
                    for (int nn = 0; nn < 2; ++nn) pre[m][bj][nn] = *(const f32x4*)(hr[m] + bj * 128 + nn * 16); }
#pragma unroll
            for (int m = 0; m < 4; ++m) if (tk[ai][m] >= 0) {
#pragma unroll
                for (int bj = 0; bj < 2; ++bj)
#pragma unroll
                    for (int nn = 0; nn < 2; ++nn) *(f32x4*)(hr[m] + bj * 128 + nn * 16) = pre[m][bj][nn] * ALPHA + acc[ai][bj][m][nn]; } }
    }
}

__device__ __forceinline__ void chain2_phase(int l, unsigned char* lds, LAS unsigned char* ldsl, const int* tab) {
    const int ntiles = tab[48]; int k = 0;
    for (;;) {
        unsigned* chq = (unsigned*)(PP().ws + WS_CH1) + 1024 * l + 512;
        int q, t; if (!xq_pop(chq + 256, ntiles, 12, 0, k, (volatile int*)(lds + 144000), q, t)) break;
        const int nA = 8 * ((ntiles + 7 - q) >> 3);
        if (t < nA) { const int tile = q + 8 * (t >> 3);
            moe_a_unit(l, ldsl, tab, tile, t & 7);
            task_signal(chq + 16 + tile, nullptr);
        } else { const int u = t - nA, tile = q + 8 * (u >> 2);
            task_wait(chq + 16 + tile, 8u);
            moe_b_unit(l, ldsl, tab, tile, u & 3);
        }
    }
}
__device__ __forceinline__ void ln2_phase(const Params& p, int l) {
    const int tid = otid(), lane = tid & 63, gw = obid() * NWAVES + (tid >> 6), NGW = gridDim.x * NWAVES;
    const float* g = p.in[I_LN2G] + l * D; const float* bt = p.in[I_LN2B] + l * D;
    for (int r = gw; r < T; r += NGW) {
        f32x4 v[4];
        if (is_dummy(r)) {
#pragma unroll
            for (int j = 0; j < 4; ++j) v[j] = (f32x4){0.f, 0.f, 0.f, 0.f};
            store_row(p, r, v, lane, true); continue; }
        const float* hr = hrow(p, r);
#pragma unroll
        for (int j = 0; j < 4; ++j) v[j] = *(const f32x4*)(hr + 4 * lane + 256 * j);
        ln_wave(v, g, bt, lane);
        store_row(p, r, v, lane, false);
    }
}


#define XB_TMO      128
#define XB_XCNT(j)  (256  + 64 * (j))
#define XB_XSUB(j)  (1280 + 64 * (j))
#define XB_XGEN(j)  (2304 + 64 * (j))
#define XB_TOP      3328
#define XB_TOPGEN   3392
#define XCD_BAR_WORDS 3456
#define XB_SPIN_CAP (1u << 22)
constexpr size_t WS_BAR = 8192;
constexpr int LDS_BARST = LDS_BYTES - 16;
__device__ __forceinline__ unsigned xb_ld(unsigned* p)              { return __hip_atomic_load(p, __ATOMIC_RELAXED, __HIP_MEMORY_SCOPE_AGENT); }
__device__ __forceinline__ unsigned xb_add(unsigned* p, unsigned v) { return __hip_atomic_fetch_add(p, v, __ATOMIC_RELAXED, __HIP_MEMORY_SCOPE_AGENT); }
__device__ __forceinline__ unsigned xb_xcc_id() { return (unsigned)__builtin_amdgcn_s_getreg((3 << 11) | 20) & 0xFu; }
#define XB_SPIN(cond, bar) do { unsigned _sp = 0; while (cond) { __builtin_amdgcn_s_sleep(1); \
    if ((++_sp & 255u) == 0u) { if (xb_ld(&(bar)[XB_TMO])) break; if (_sp > XB_SPIN_CAP) { atomicAdd(&(bar)[XB_TMO], 1u); break; } } } } while (0)
__device__ __forceinline__ void xcd_barrier_complete(unsigned* bar, unsigned x, unsigned& nloc, unsigned& nx) {
    const unsigned G = gridDim.x * gridDim.y * gridDim.z;
    unsigned sum, cnt, mine, sp = 0u;
    for (;;) {
        sum = 0u; cnt = 0u; mine = 0u;
#pragma unroll
        for (unsigned j = 0; j < 16; ++j) { const unsigned c = xb_ld(&bar[XB_XCNT(j)]); sum += c; cnt += (c > 0u) ? 1u : 0u; mine = (j == x) ? c : mine; }
        if (sum == G) break;
        __builtin_amdgcn_s_sleep(1);
        if ((++sp & 255u) == 0u) { if (xb_ld(&bar[XB_TMO])) break; if (sp > XB_SPIN_CAP) { atomicAdd(&bar[XB_TMO], 1u); break; } }
    }
    nloc = mine > 0u ? mine : 1u; nx = cnt > 0u ? cnt : 1u;
}
__device__ __forceinline__ void xcd_barrier(unsigned* bar, volatile LAS unsigned* st) {
    asm volatile("s_waitcnt vmcnt(0)" ::: "memory");
    __syncthreads();
    if (threadIdx.x == 0) {
        __builtin_amdgcn_s_waitcnt(0);
        const unsigned x = xb_xcc_id();
        unsigned nloc = st[0], nx = st[1];
        if (nloc == 0u) { xcd_barrier_complete(bar, x, nloc, nx); st[0] = nloc; st[1] = nx; }
        const unsigned old = xb_add(&bar[XB_XSUB(x)], 1u);
        const unsigned gen = old / nloc;
        if (old + 1u == (gen + 1u) * nloc) {
            __builtin_amdgcn_fence(__ATOMIC_RELEASE, "agent");
            asm volatile("s_waitcnt vmcnt(0)" ::: "memory");
            const unsigned og = xb_add(&bar[XB_TOP], 1u);
            const unsigned tg = og / nx;
            if (og + 1u == (tg + 1u) * nx) xb_add(&bar[XB_TOPGEN], 1u);
            else XB_SPIN(xb_ld(&bar[XB_TOPGEN]) == tg, bar);
            __builtin_amdgcn_fence(__ATOMIC_ACQUIRE, "agent");
            xb_add(&bar[XB_XGEN(x)], 1u);
            asm volatile("s_waitcnt vmcnt(0)" ::: "memory");
        } else {
            XB_SPIN(xb_ld(&bar[XB_XGEN(x)]) == gen, bar);
            __builtin_amdgcn_fence(__ATOMIC_ACQUIRE, "agent");
            asm volatile("s_waitcnt vmcnt(0)" ::: "memory");
        }
    }
    __syncthreads();
}

__global__ void __launch_bounds__(NTHREADS, 2) mega(Params p_unused) {
    extern __shared__ __attribute__((aligned(16))) unsigned char lds[];
    cg::grid_group grid = cg::this_grid();
    volatile LAS unsigned* barst = (volatile LAS unsigned*)((LAS unsigned char*)lds + LDS_BARST);
    { unsigned* bar0 = (unsigned*)(PP().ws + WS_BAR);
      if (threadIdx.x == 0) { barst[0] = 0u; barst[1] = 0u; (void)xb_add(bar0 + XB_XCNT(xb_xcc_id()), 1u); } }
    __syncthreads();
#define GBAR() xcd_barrier((unsigned*)(PP().ws + WS_BAR), barst)
    unsigned long long pr_t0 = 0, pr_acc = 0;
#define PH_BEGIN(k) do { if (PROBE_PHASE == (k)) pr_t0 = __builtin_amdgcn_s_memrealtime(); } while (0)
#define PH_END(k) do { if (PROBE_PHASE == (k)) pr_acc += __builtin_amdgcn_s_memrealtime() - pr_t0; } while (0)
#define LDSG() (lds + ozero())
#define LDSL() ((LAS unsigned char*)lds)

    PH_BEGIN(0);
    conv_small_weights(PP(), LDSL());
    ln_in_phase(PP());
    if (gridDim.y == 0x7fffffffu) grid.sync();
    GBAR();
    PH_END(0);
#pragma unroll 1
    for (int l = 0; l < DEPTH; ++l) {
        PH_BEGIN(1);
        inproj_phase(PP(), l, LDSL());
        GBAR();
        PH_END(1); PH_BEGIN(2);
        {
            unsigned* qctr = (unsigned*)(PP().ws + WS_CTL) + CW_R1Q + 2 * l;
            volatile int* uw = (volatile int*)(LDSG() + AT_UNIT);
            int ndone = 0;
            constexpr int QEND = INP_TAIL + BATCH * NCH * 8;
#define MIX_POP(dst) do { __syncthreads(); if (otid() == 0) *uw = (int)atomicAdd(qctr, 1u); __syncthreads(); dst = __builtin_amdgcn_readfirstlane(*uw); } while (0)
            int u; MIX_POP(u);
            while (u < INP_TAIL) { inproj_tail_unit(l, LDSL(), u); MIX_POP(u); }
            if (u < QEND) {
                R1PF pf; r1_load_rows((const bf16_t*)(PP().ws + WS_UAR), u - INP_TAIL, otid(), pf);
                do {
                    int un; MIX_POP(un);
                    if (PROBE_PHASE == 30) pr_t0 = __builtin_amdgcn_s_memrealtime();
                    rwkv_prep_unit(PP(), l, u - INP_TAIL, LDSG(), pr_acc, pf, un < QEND ? un - INP_TAIL : -1); ++ndone;
                    if (PROBE_PHASE == 30) pr_acc += __builtin_amdgcn_s_memrealtime() - pr_t0;
                    u = un;
                } while (u < QEND);
            }
#undef MIX_POP
            asm volatile("s_waitcnt vmcnt(0)" ::: "memory");
            __syncthreads();
            if (otid() == 0 && ndone > 0) { __builtin_amdgcn_fence(__ATOMIC_RELEASE, "agent"); asm volatile("s_waitcnt vmcnt(0)" ::: "memory"); __hip_atomic_fetch_add(qctr + 1, (unsigned)ndone, __ATOMIC_RELAXED, __HIP_MEMORY_SCOPE_AGENT); }
            const int bid = obid();
            if (bid < 32) {
                if (otid() == 0) { unsigned sp = 0; while (__hip_atomic_load(qctr + 1, __ATOMIC_RELAXED, __HIP_MEMORY_SCOPE_AGENT) < (unsigned)(BATCH * NCH * 8) && ++sp < (1u << 26)) __builtin_amdgcn_s_sleep(4);
                    __builtin_amdgcn_fence(__ATOMIC_ACQUIRE, "agent"); asm volatile("s_waitcnt vmcnt(0)" ::: "memory"); }
                __syncthreads();
                rwkv_scan(PP(), l, bid, LDSG());
            }
            attn_phase(PP(), l, LDSG(), pr_acc);
        }
        GBAR();
        PH_END(2); PH_BEGIN(4);
        chain1_phase(l, LDSG(), LDSL(), pr_acc);
        GBAR();
        PH_END(4); PH_BEGIN(7);
        { int toff = 140 * 1024; asm volatile("" : "+s"(toff)); int* tab = (int*)(lds + toff);
          build_cls_table(PP(), l, tab);
          chain2_phase(l, LDSG(), LDSL(), tab); }
        GBAR();
        PH_END(8); PH_BEGIN(9);
        ln2_phase(PP(), l);
        if (l + 1 < DEPTH) GBAR();
        PH_END(9);
    }
    if (PROBE_PHASE >= 0 && blockIdx.x == PROBE_BLOCK && threadIdx.x == 0) { const unsigned long long t = __builtin_amdgcn_s_memrealtime(); while (__builtin_amdgcn_s_memrealtime() - t < pr_acc) __builtin_amdgcn_s_sleep(8); }
}

extern "C" void kernel_launch(void* const* d_in, const int* in_sizes, int n_in, void* d_out, int out_size,
                              void* d_ws, size_t ws_size, hipStream_t stream) {
    static int grid_blocks = 0;
    if (grid_blocks == 0) {
        int dev = 0, cus = 0, per_cu = 0;
        if (n_in != 29 || ws_size < WS_END || out_size != BATCH * SEQ * D) { fprintf(stderr, "kernel_launch: unexpected problem (n_in %d, ws %zu, out %d)\n", n_in, ws_size, out_size); grid_blocks = -1; return; }
        (void)hipGetDevice(&dev);
        (void)hipDeviceGetAttribute(&cus, hipDeviceAttributeMultiprocessorCount, dev);
        (void)hipFuncSetAttribute((const void*)mega, hipFuncAttributeMaxDynamicSharedMemorySize, LDS_BYTES);
        (void)hipOccupancyMaxActiveBlocksPerMultiprocessor(&per_cu, (const void*)mega, NTHREADS, LDS_BYTES);
        if (per_cu < 1) { fprintf(stderr, "occupancy query returned %d\n", per_cu); grid_blocks = -1; return; }
        grid_blocks = cus;
    }
    if (grid_blocks < 0) return;
    (void)hipMemsetAsync((char*)d_ws + WS_CTL, 0, 32768, stream);
    (void)hipMemsetAsync((char*)d_ws + WS_CH1, 0, 16384, stream);
    Params p{};
    for (int i = 0; i < 29; ++i) p.in[i] = (const float*)d_in[i];
    p.out = (float*)d_out; p.ws = (unsigned char*)d_ws;
    void* args[] = {&p};
    hipError_t e = hipLaunchCooperativeKernel((const void*)mega, dim3(grid_blocks), dim3(NTHREADS), args, LDS_BYTES, stream);
    if (e != hipSuccess) fprintf(stderr, "cooperative launch failed: %s (grid %d)\n", hipGetErrorString(e), grid_blocks);
}
```

```cpp
#include <hip/hip_runtime.h>
#include <hip/hip_cooperative_groups.h>
#include <cstdio>
#include <cstdint>
#ifndef PROBE_PHASE
#define PROBE_PHASE -1
#endif
#define PROBE_BLOCK 0
#define PRB_B(k) do { if (PROBE_PHASE == (k)) pt0 = __builtin_amdgcn_s_memrealtime(); } while (0)
#define PRB_E(k) do { if (PROBE_PHASE == (k)) pacc += __builtin_amdgcn_s_memrealtime() - pt0; } while (0)
namespace cg = cooperative_groups;

#define LAS __attribute__((address_space(3)))
typedef unsigned short bf16_t;
typedef short bf16x8 __attribute__((ext_vector_type(8)));
typedef float f32x4 __attribute__((ext_vector_type(4)));
typedef float f32x2 __attribute__((ext_vector_type(2)));
typedef unsigned u32x4 __attribute__((ext_vector_type(4)));
typedef unsigned u32x2 __attribute__((ext_vector_type(2)));

constexpr int NTHREADS = 512, NWAVES = 8;
constexpr int D = 1024, BATCH = 4, SEQ = 4096, DEPTH = 2;
constexpr int LP = 4160;
constexpr int T = BATCH * LP;
constexpr int NCH = LP / 64;
constexpr int PADM = 48;
constexpr int A_COLS = 1064, R_COLS = 1792, IN_COLS = 4904;
constexpr int UA = 1280;
constexpr int UARW = 3072;
constexpr int NIN = 5120;
constexpr float LN_EPS = 1e-5f, GN_EPS = 64e-5f;
constexpr float ALPHA = 1.41421356237309515f;
constexpr int C_Q = 0, C_K = 512, C_V = 640, C_QI = 768, C_KI = 1024, C_WI = 1056;
constexpr int C_R = UA, C_RK = UA + 512, C_RV = UA + 1024, C_XW = UA + 1536, C_XA = UA + 1600, C_XG = UA + 1664;

constexpr size_t MiB = 1u << 20;
constexpr size_t WS_CTL = 0;
constexpr size_t WS_HM = 1 * MiB;
constexpr size_t WS_WSMALL = 2 * MiB;
constexpr size_t WSMALL_LAYER = 14 * MiB;
constexpr size_t WS_HB = 30 * MiB;
constexpr size_t WS_UAR = 63 * MiB;
constexpr size_t WS_GATES = 161 * MiB;
constexpr size_t WS_OAB = 226 * MiB;
constexpr size_t WS_LIST = WS_GATES + 48 * MiB;
constexpr size_t WS_END = 308 * MiB;
constexpr size_t WS_MERGED = WS_UAR;
constexpr size_t WS_ACT = WS_UAR + 33 * MiB;
constexpr size_t WS_WEXP = WS_GATES;
constexpr int ACT_ROWS_MAX = 16448 + 24 * 256;
static_assert(WS_ACT + (size_t)ACT_ROWS_MAX * 2048 <= WS_GATES, "act fits");
constexpr int CW_CLS = 1024;

constexpr int LDS_BYTES = 155648;

struct Params {
    const float* in[29];
    float* out;
    unsigned char* ws;
};
enum { I_X = 0, I_META, I_LNIN_G, I_LNIN_B, I_WIN, I_BGATE, I_MU, I_W0, I_WUP, I_A0, I_AUP, I_GUP, I_KK, I_KA, I_RK, I_GNG, I_GNB,
       I_WBA, I_WBB, I_WOUT, I_LN1G, I_LN1B, I_LN2G, I_LN2B, I_WROUTER, I_BROUTER, I_WEXP1, I_WEXP3, I_WEXP2 };

__device__ __forceinline__ int otid() { int t = threadIdx.x; asm volatile("" : "+v"(t)); return t; }
__device__ __forceinline__ const char* uptr(const char* p) { const unsigned long long v = (unsigned long long)p; const unsigned lo = __builtin_amdgcn_readfirstlane((unsigned)v), hi = __builtin_amdgcn_readfirstlane((unsigned)(v >> 32)); return (const char*)(((unsigned long long)hi << 32) | lo); }
__device__ __forceinline__ int ozero() { int z = 0; asm volatile("" : "+s"(z)); return z; }
__device__ __forceinline__ int obid() { int b = blockIdx.x; asm volatile("" : "+s"(b)); return b; }
typedef __bf16 bf16x2_t __attribute__((ext_vector_type(2)));
__device__ __forceinline__ unsigned f2bf(float f) { return (unsigned)__builtin_bit_cast(unsigned short, (__bf16)f); }
__device__ __forceinline__ unsigned pk2(float lo, float hi) { const f32x2 v = {lo, hi}; return __builtin_bit_cast(unsigned, __builtin_convertvector(v, bf16x2_t)); }
template <int CTRL> __device__ __forceinline__ float dpp_f(float v) { return __builtin_bit_cast(float, __builtin_amdgcn_update_dpp(0, __builtin_bit_cast(int, v), CTRL, 0xF, 0xF, true)); }
__device__ __forceinline__ float sum8(float v) { v += dpp_f<0xB1>(v); v += dpp_f<0x4E>(v); v += dpp_f<0x141>(v); return v; }
__device__ __forceinline__ float sum16(float v) { v = sum8(v); v += dpp_f<0x140>(v); return v; }
__device__ __forceinline__ float bf2f(unsigned short b) { return __builtin_bit_cast(float, (unsigned)b << 16); }
__device__ __forceinline__ float bflo(unsigned w) { return __builtin_bit_cast(float, w << 16); }
__device__ __forceinline__ float bfhi(unsigned w) { return __builtin_bit_cast(float, w & 0xffff0000u); }
__device__ __forceinline__ float wave_sum(float v) { v = sum16(v); v += __shfl_xor(v, 16); v += __shfl_xor(v, 32); return v; }
__device__ __forceinline__ float wave_max(float v) {
#pragma unroll
    for (int o = 1; o < 64; o <<= 1) v = fmaxf(v, __shfl_xor(v, o));
    return v;
}
__device__ __forceinline__ float sigmoidf_(float x) { return __builtin_amdgcn_rcpf(1.0f + __expf(-x)); }
__device__ __forceinline__ float* hrow(const Params& p, int r) {
    const int b = r / LP, pos = r - b * LP;
    return pos >= 64 ? p.out + ((size_t)(b * SEQ + (pos - 64)) << 10) : (float*)(p.ws + WS_HM) + ((size_t)(b * 64 + pos) << 10);
}
__device__ __forceinline__ bool is_dummy(int r) { return (r % LP) < PADM; }

__device__ __forceinline__ void transpose_item(const float* src, int ld_src, int col0, int nvalid, bf16_t* dst  , int ld_dst, LAS float* scr, int lane) {
    const int kr = lane >> 3, c4 = (lane & 7) * 4;
    f32x4 v[8];
#pragma unroll
    for (int i = 0; i < 8; ++i) v[i] = *(const f32x4*)(src + (size_t)(8 * i + kr) * ld_src + col0 + c4);
#pragma unroll
    for (int i = 0; i < 8; ++i) { LAS float* w = scr + (8 * i + kr) * 33 + c4;
        w[0] = c4 + 0 < nvalid ? v[i][0] : 0.f; w[1] = c4 + 1 < nvalid ? v[i][1] : 0.f; w[2] = c4 + 2 < nvalid ? v[i][2] : 0.f; w[3] = c4 + 3 < nvalid ? v[i][3] : 0.f; }
    asm volatile("s_waitcnt lgkmcnt(0)" ::: "memory");
    const int ch = lane & 7;
#pragma unroll
    for (int j = 0; j < 4; ++j) { const int n = (lane >> 3) + 8 * j; const LAS float* s = scr + (8 * ch) * 33 + n;
        u32x4 o; o.x = pk2(s[0 * 33], s[1 * 33]); o.y = pk2(s[2 * 33], s[3 * 33]); o.z = pk2(s[4 * 33], s[5 * 33]); o.w = pk2(s[6 * 33], s[7 * 33]);
        *(u32x4*)(dst + (size_t)n * ld_dst + 8 * ch) = o; }
    asm volatile("s_waitcnt lgkmcnt(0)" ::: "memory");
}

namespace g8 {
constexpr int BM = 256, BK = 64, HALF = 128, HTB = HALF * BK * 2, STAGE_BYTES = 8 * HTB;
__host__ __device__ __forceinline__ int lds_byte(int r, int c) { const int st = (r >> 4) * 2 + (c >> 5), rr = r & 15, cc = c & 31, ob = rr * 64 + cc * 2; return st * 1024 + (ob ^ (((ob >> 9) & 1) << 5)); }
__host__ __device__ __forceinline__ void stage_rc(int b, int& R, int& C) { const int st = b / 1024, sb = b % 1024, swz = sb ^ (((sb >> 9) & 1) << 5); R = (st >> 1) * 16 + swz / 64; C = (st & 1) * 32 + (swz % 64) / 2; }
__host__ __device__ __forceinline__ int perm32(int rho) { const int n = rho >> 4, i = rho & 15; return 8 * (i >> 2) + 4 * n + (i & 3); }

struct KSeg {
    const char* A;
    const char* B0;
    const char* B1;
    int nt;
    int nt0;
    const char* A2;
    const char* B02;
    const char* B12;
};
__device__ __forceinline__ KSeg seg1(const char* A, const char* B0, const char* B1, int nt) { KSeg s; s.A = A; s.B0 = B0; s.B1 = B1; s.nt = nt; s.nt0 = nt; s.A2 = A; s.B02 = B0; s.B12 = B1; return s; }
typedef f32x4 Acc[2][2][4][2];

template <bool GATHER, bool TWOSEG>
__device__ __forceinline__ void kloop(LAS unsigned char* lds, Acc& acc, const KSeg s, const unsigned (&voffA)[2][2], const unsigned (&voffB)[2], const unsigned hstepA) {
    int tid = threadIdx.x; asm volatile("" : "+v"(tid));
    const int wid = __builtin_amdgcn_readfirstlane(tid >> 6), lane = tid & 63, wr = wid >> 2, wc = wid & 3, fr = lane & 15, fq = lane >> 4;
    const unsigned ldsw = (unsigned)wid * 1024u;
    const int aoff = lds_byte(wr * 64 + fr, fq * 8), boff = lds_byte(wc * 32 + fr, fq * 8);
    const int nt = __builtin_amdgcn_readfirstlane(s.nt);
#define G8_SA(b, h) (((b) * 2 + (h)) * HTB)
#define G8_SB(b, h) ((4 + (b) * 2 + (h)) * HTB)
#define G8_STAGE(bufoff, gbase, voff) do { _Pragma("unroll") for (int _i = 0; _i < 2; ++_i) \
        __builtin_amdgcn_global_load_lds((const unsigned*)((const char*)(gbase) + (voff)[_i]), (LAS unsigned*)(lds + (bufoff) + ldsw + _i * 8192), 16, 0, 0); } while (0)
#define G8_LDA(dst, b, h) do { _Pragma("unroll") for (int m = 0; m < 4; ++m) _Pragma("unroll") for (int k = 0; k < 2; ++k) dst[m][k] = *(const LAS bf16x8*)(lds + G8_SA(b, h) + aoff + m * 2048 + k * 1024); } while (0)
#define G8_LDB(dst, b, h) do { _Pragma("unroll") for (int n = 0; n < 2; ++n) _Pragma("unroll") for (int k = 0; k < 2; ++k) dst[n][k] = *(const LAS bf16x8*)(lds + G8_SB(b, h) + boff + n * 2048 + k * 1024); } while (0)
#define G8_MMA(ai, bj, At, Bt) do { __builtin_amdgcn_s_setprio(1); _Pragma("unroll") for (int m = 0; m < 4; ++m) _Pragma("unroll") for (int n = 0; n < 2; ++n) _Pragma("unroll") for (int k = 0; k < 2; ++k) \
        acc[ai][bj][m][n] = __builtin_amdgcn_mfma_f32_16x16x32_bf16(Bt[n][k], At[m][k], acc[ai][bj][m][n], 0, 0, 0); __builtin_amdgcn_s_setprio(0); } while (0)
#define G8_WAIT_V(n) asm volatile("s_waitcnt vmcnt(" #n ")" ::: "memory")
#define G8_WAIT_L(n) asm volatile("s_waitcnt lgkmcnt(" #n ")" ::: "memory")
#define G8_BAR __builtin_amdgcn_s_barrier()
#define G8_SCHED __builtin_amdgcn_sched_barrier(0)
    bf16x8 At[4][2], B0[2][2], B1[2][2];
    const char* pA = uptr(s.A); const char* pB0 = uptr(s.B0); const char* pB1 = uptr(s.B1);
    constexpr int KS = BK * 2;
    const int nt0 = TWOSEG ? s.nt0 : 0; const char* qA = TWOSEG ? uptr(s.A2 - (size_t)nt0 * KS) : pA; const char* qB0 = TWOSEG ? uptr(s.B02 - (size_t)nt0 * KS) : pB0; const char* qB1 = TWOSEG ? uptr(s.B12 - (size_t)nt0 * KS) : pB1;
#define G8_TA(t) ((TWOSEG ? ((t) < nt0 ? pA : qA) : pA) + (size_t)(t) * KS)
#define G8_TB0(t) ((TWOSEG ? ((t) < nt0 ? pB0 : qB0) : pB0) + (size_t)(t) * KS)
#define G8_TB1(t) ((TWOSEG ? ((t) < nt0 ? pB1 : qB1) : pB1) + (size_t)(t) * KS)
#define G8_VA1 voffA[GATHER ? 1 : 0]
#define G8_H1(ptr) ((ptr) + (GATHER ? 0u : hstepA))
    G8_STAGE(G8_SB(0, 0), pB0, voffB); G8_STAGE(G8_SA(0, 0), pA, voffA[0]); G8_STAGE(G8_SB(0, 1), pB1, voffB); G8_STAGE(G8_SA(0, 1), G8_H1(pA), G8_VA1);
    if (wr == 1) G8_BAR;
    G8_WAIT_V(4); G8_BAR;
    G8_STAGE(G8_SB(1, 0), pB0 + KS, voffB); G8_STAGE(G8_SA(1, 0), pA + KS, voffA[0]); G8_STAGE(G8_SB(1, 1), pB1 + KS, voffB);
    G8_WAIT_V(6); G8_BAR;
    for (int t = 0; t < nt - 2; t += 2) {
        const char* a1 = G8_TA(t + 1);
        const char* a2 = G8_TA(t + 2); const char* b02 = G8_TB0(t + 2); const char* b12 = G8_TB1(t + 2);
        const char* a3 = G8_TA(t + 3); const char* b03 = G8_TB0(t + 3); const char* b13 = G8_TB1(t + 3);
        G8_LDB(B0, 0, 0); G8_SCHED; G8_LDA(At, 0, 0); G8_STAGE(G8_SA(1, 1), G8_H1(a1), G8_VA1);
        G8_WAIT_L(8); G8_BAR; G8_WAIT_L(0); G8_MMA(0, 0, At, B0); G8_BAR; G8_SCHED;
        G8_LDB(B1, 0, 1); G8_STAGE(G8_SB(0, 0), b02, voffB);
        G8_BAR; G8_WAIT_L(0); G8_MMA(0, 1, At, B1); G8_BAR;
        G8_LDA(At, 0, 1); G8_STAGE(G8_SA(0, 0), a2, voffA[0]);
        G8_BAR; G8_WAIT_L(0); G8_MMA(1, 0, At, B0); G8_BAR; G8_SCHED;
        G8_STAGE(G8_SB(0, 1), b12, voffB);
        G8_WAIT_V(6); G8_BAR; G8_MMA(1, 1, At, B1); G8_BAR;
        G8_LDB(B0, 1, 0); G8_SCHED; G8_LDA(At, 1, 0); G8_STAGE(G8_SA(0, 1), G8_H1(a2), G8_VA1);
        G8_WAIT_L(8); G8_BAR; G8_WAIT_L(0); G8_MMA(0, 0, At, B0); G8_BAR; G8_SCHED;
        G8_LDB(B1, 1, 1); G8_STAGE(G8_SB(1, 0), b03, voffB);
        G8_BAR; G8_WAIT_L(0); G8_MMA(0, 1, At, B1); G8_BAR;
        G8_LDA(At, 1, 1); G8_STAGE(G8_SA(1, 0), a3, voffA[0]);
        G8_BAR; G8_WAIT_L(0); G8_MMA(1, 0, At, B0); G8_BAR; G8_SCHED;
        G8_STAGE(G8_SB(1, 1), b13, voffB);
        G8_WAIT_V(6); G8_BAR; G8_MMA(1, 1, At, B1); G8_BAR;
    }
    { const char* a1 = G8_TA(nt - 1);
      G8_LDB(B0, 0, 0); G8_LDA(At, 0, 0); G8_STAGE(G8_SA(1, 1), G8_H1(a1), G8_VA1);
      G8_BAR; G8_WAIT_L(0); G8_MMA(0, 0, At, B0); G8_BAR;
      G8_LDB(B1, 0, 1); G8_BAR; G8_WAIT_L(0); G8_MMA(0, 1, At, B1); G8_BAR;
      G8_LDA(At, 0, 1); G8_WAIT_V(4); G8_BAR; G8_WAIT_L(0); G8_MMA(1, 0, At, B0); G8_MMA(1, 1, At, B1); G8_BAR; }
    { G8_LDB(B0, 1, 0); G8_LDA(At, 1, 0); G8_WAIT_V(2); G8_BAR; G8_WAIT_L(0); G8_MMA(0, 0, At, B0); G8_BAR;
      G8_LDB(B1, 1, 1); G8_WAIT_V(0); G8_BAR; G8_WAIT_L(0); G8_MMA(0, 1, At, B1); G8_BAR;
      G8_LDA(At, 1, 1); G8_BAR; G8_WAIT_L(0); G8_MMA(1, 0, At, B0); G8_MMA(1, 1, At, B1); G8_BAR; }
    if (wr == 0) G8_BAR;
#undef G8_TA
#undef G8_VA1
#undef G8_H1
#undef G8_TB0
#undef G8_TB1
#undef G8_SA
#undef G8_SB
#undef G8_STAGE
#undef G8_LDA
#undef G8_LDB
#undef G8_MMA
#undef G8_WAIT_V
#undef G8_WAIT_L
#undef G8_BAR
#undef G8_SCHED
}
template <bool GATHER, bool TWOSEG>
__device__ __forceinline__ void kstream(LAS unsigned char* lds, Acc& acc, const KSeg s, const KSeg nx, const bool first, const unsigned (&voffA)[2][2], const unsigned (&voffB)[2], const unsigned hstepA) {
    int tid = threadIdx.x; asm volatile("" : "+v"(tid));
    const int wid = __builtin_amdgcn_readfirstlane(tid >> 6), lane = tid & 63, wr = wid >> 2, wc = wid & 3, fr = lane & 15, fq = lane >> 4;
    const unsigned ldsw = (unsigned)wid * 1024u;
    const int aoff = lds_byte(wr * 64 + fr, fq * 8), boff = lds_byte(wc * 32 + fr, fq * 8);
    const int nt = __builtin_amdgcn_readfirstlane(s.nt);
#define G8_SA(b, h) (((b) * 2 + (h)) * HTB)
#define G8_SB(b, h) ((4 + (b) * 2 + (h)) * HTB)
#define G8_STAGE(bufoff, gbase, voff) do { _Pragma("unroll") for (int _i = 0; _i < 2; ++_i) \
        __builtin_amdgcn_global_load_lds((const unsigned*)((const char*)(gbase) + (voff)[_i]), (LAS unsigned*)(lds + (bufoff) + ldsw + _i * 8192), 16, 0, 0); } while (0)
#define G8_LDA(dst, b, h) do { _Pragma("unroll") for (int m = 0; m < 4; ++m) _Pragma("unroll") for (int k = 0; k < 2; ++k) dst[m][k] = *(const LAS bf16x8*)(lds + G8_SA(b, h) + aoff + m * 2048 + k * 1024); } while (0)
#define G8_LDB(dst, b, h) do { _Pragma("unroll") for (int n = 0; n < 2; ++n) _Pragma("unroll") for (int k = 0; k < 2; ++k) dst[n][k] = *(const LAS bf16x8*)(lds + G8_SB(b, h) + boff + n * 2048 + k * 1024); } while (0)
#define G8_MMA(ai, bj, At, Bt) do { __builtin_amdgcn_s_setprio(1); _Pragma("unroll") for (int m = 0; m < 4; ++m) _Pragma("unroll") for (int n = 0; n < 2; ++n) _Pragma("unroll") for (int k = 0; k < 2; ++k) \
        acc[ai][bj][m][n] = __builtin_amdgcn_mfma_f32_16x16x32_bf16(Bt[n][k], At[m][k], acc[ai][bj][m][n], 0, 0, 0); __builtin_amdgcn_s_setprio(0); } while (0)
#define G8_WAIT_V(n) asm volatile("s_waitcnt vmcnt(" #n ")" ::: "memory")
#define G8_WAIT_L(n) asm volatile("s_waitcnt lgkmcnt(" #n ")" ::: "memory")
#define G8_BAR __builtin_amdgcn_s_barrier()
#define G8_SCHED __builtin_amdgcn_sched_barrier(0)
    bf16x8 At[4][2], B0[2][2], B1[2][2];
    const char* pA = uptr(s.A); const char* pB0 = uptr(s.B0); const char* pB1 = uptr(s.B1);
    constexpr int KS = BK * 2;
    const int nt0 = TWOSEG ? s.nt0 : 0; const char* qA = TWOSEG ? uptr(s.A2 - (size_t)nt0 * KS) : pA; const char* qB0 = TWOSEG ? uptr(s.B02 - (size_t)nt0 * KS) : pB0; const char* qB1 = TWOSEG ? uptr(s.B12 - (size_t)nt0 * KS) : pB1;
    const char* nA = uptr(nx.A) - (size_t)nt * KS; const char* nB0 = uptr(nx.B0) - (size_t)nt * KS; const char* nB1 = uptr(nx.B1) - (size_t)nt * KS;
#define G8_TA(t) (((t) >= nt ? nA : (TWOSEG ? ((t) < nt0 ? pA : qA) : pA)) + (size_t)(t) * KS)
#define G8_TB0(t) (((t) >= nt ? nB0 : (TWOSEG ? ((t) < nt0 ? pB0 : qB0) : pB0)) + (size_t)(t) * KS)
#define G8_TB1(t) (((t) >= nt ? nB1 : (TWOSEG ? ((t) < nt0 ? pB1 : qB1) : pB1)) + (size_t)(t) * KS)
#define G8_VA1 voffA[GATHER ? 1 : 0]
#define G8_H1(ptr) ((ptr) + (GATHER ? 0u : hstepA))
    if (first) {
    G8_STAGE(G8_SB(0, 0), pB0, voffB); G8_STAGE(G8_SA(0, 0), pA, voffA[0]); G8_STAGE(G8_SB(0, 1), pB1, voffB); G8_STAGE(G8_SA(0, 1), G8_H1(pA), G8_VA1);
    if (wr == 1) G8_BAR;
    G8_WAIT_V(4); G8_BAR;
    G8_STAGE(G8_SB(1, 0), pB0 + KS, voffB); G8_STAGE(G8_SA(1, 0), pA + KS, voffA[0]); G8_STAGE(G8_SB(1, 1), pB1 + KS, voffB);
    G8_WAIT_V(6); G8_BAR;
    }
    for (int t = 0; t < nt; t += 2) {
        const char* a1 = G8_TA(t + 1);
        const char* a2 = G8_TA(t + 2); const char* b02 = G8_TB0(t + 2); const char* b12 = G8_TB1(t + 2);
        const char* a3 = G8_TA(t + 3); const char* b03 = G8_TB0(t + 3); const char* b13 = G8_TB1(t + 3);
        G8_LDB(B0, 0, 0); G8_SCHED; G8_LDA(At, 0, 0); G8_STAGE(G8_SA(1, 1), G8_H1(a1), G8_VA1);
        G8_WAIT_L(8); G8_BAR; G8_WAIT_L(0); G8_MMA(0, 0, At, B0); G8_BAR; G8_SCHED;
        G8_LDB(B1, 0, 1); G8_STAGE(G8_SB(0, 0), b02, voffB);
        G8_BAR; G8_WAIT_L(0); G8_MMA(0, 1, At, B1); G8_BAR;
        G8_LDA(At, 0, 1); G8_STAGE(G8_SA(0, 0), a2, voffA[0]);
        G8_BAR; G8_WAIT_L(0); G8_MMA(1, 0, At, B0); G8_BAR; G8_SCHED;
        G8_STAGE(G8_SB(0, 1), b12, voffB);
        G8_WAIT_V(6); G8_BAR; G8_MMA(1, 1, At, B1); G8_BAR;
        G8_LDB(B0, 1, 0); G8_SCHED; G8_LDA(At, 1, 0); G8_STAGE(G8_SA(0, 1), G8_H1(a2), G8_VA1);
        G8_WAIT_L(8); G8_BAR; G8_WAIT_L(0); G8_MMA(0, 0, At, B0); G8_BAR; G8_SCHED;
        G8_LDB(B1, 1, 1); G8_STAGE(G8_SB(1, 0), b03, voffB);
        G8_BAR; G8_WAIT_L(0); G8_MMA(0, 1, At, B1); G8_BAR;
        G8_LDA(At, 1, 1); G8_STAGE(G8_SA(1, 0), a3, voffA[0]);
        G8_BAR; G8_WAIT_L(0); G8_MMA(1, 0, At, B0); G8_BAR; G8_SCHED;
        G8_STAGE(G8_SB(1, 1), b13, voffB);
        G8_WAIT_V(6); G8_BAR; G8_MMA(1, 1, At, B1); G8_BAR;
    }
#undef G8_TA
#undef G8_VA1
#undef G8_H1
#undef G8_TB0
#undef G8_TB1
#undef G8_SA
#undef G8_SB
#undef G8_STAGE
#undef G8_LDA
#undef G8_LDB
#undef G8_MMA
#undef G8_WAIT_V
#undef G8_WAIT_L
#undef G8_BAR
#undef G8_SCHED
}
__device__ __forceinline__ void kstream_end() { asm volatile("s_waitcnt vmcnt(0)" ::: "memory"); __builtin_amdgcn_s_barrier(); }
__device__ __forceinline__ void zero_acc(Acc& acc) {
#pragma unroll
    for (int a = 0; a < 2; ++a)
#pragma unroll
        for (int b = 0; b < 2; ++b)
#pragma unroll
            for (int m = 0; m < 4; ++m)
#pragma unroll
                for (int n = 0; n < 2; ++n) acc[a][b][m][n] = (f32x4){0.f, 0.f, 0.f, 0.f};
}
__device__ __forceinline__ void make_voff_contig(unsigned (&voffA)[2][2], unsigned pitchA) {
    int tid = threadIdx.x; asm volatile("" : "+v"(tid));
#pragma unroll
    for (int i = 0; i < 2; ++i) { int R, C; stage_rc(tid * 16 + i * 8192, R, C);
        voffA[0][i] = (unsigned)R * pitchA + (unsigned)C * 2u; voffA[1][i] = 0u; }
}
__device__ __forceinline__ void make_voffB(unsigned (&voffB)[2], unsigned pitchB, bool perm) {
    int tid = threadIdx.x; asm volatile("" : "+v"(tid));
#pragma unroll
    for (int i = 0; i < 2; ++i) { int R, C; stage_rc(tid * 16 + i * 8192, R, C); const int Rb = perm ? ((R & ~31) + perm32(R & 31)) : R;
        voffB[i] = (unsigned)Rb * pitchB + (unsigned)C * 2u; }
}
}

__device__ __forceinline__ bool unit_order(int i, int G, int c, int nM, int nN, int& pm, int& pn) {
    const int nwg = nM * nN; const long L = (long)i * G + c; if (L >= nwg) return false;
    int wgid = (int)L; { const int q = nwg / 8, r = nwg % 8, xcd = wgid % 8, off = wgid / 8; wgid = (xcd < r ? xcd * (q + 1) : r * (q + 1) + (xcd - r) * q) + off; }
    const int WGM = 8, nig = WGM * nN, gid = wgid / nig, fm = gid * WGM, gsz = (nM - fm) < WGM ? (nM - fm) : WGM;
    pm = fm + ((wgid % nig) % gsz); pn = (wgid % nig) / gsz; return true;
}

__device__ __forceinline__ void conv_small_weights(const Params& p, LAS unsigned char* lds) {
    const int tid = otid(), lane = tid & 63, wave = tid >> 6, gw = obid() * NWAVES + wave, NGW = gridDim.x * NWAVES;
    LAS float* scr = (LAS float*)(lds + wave * 16384);
    constexpr int I_IN = 16 * (NIN / 32), I_A = 8 * 32, I_O = 16 * 32, I_L = 64, PER = I_IN + 2 * I_A + I_O + I_L;
    for (int it = gw; it < DEPTH * PER; it += NGW) {
        const int l = it / PER; int r = it % PER;
        unsigned char* wl = p.ws + WS_WSMALL + (size_t)l * WSMALL_LAYER;
        if (r < I_IN) { const int kb = r / (NIN / 32), nb = r % (NIN / 32), n0 = nb * 32, k0 = kb * 64;
            int col0, nvalid; if (n0 < UA) { col0 = n0; nvalid = A_COLS - n0; nvalid = nvalid < 0 ? 0 : (nvalid > 32 ? 32 : nvalid); } else { col0 = n0 - (UA - A_COLS); nvalid = 32; }
            transpose_item(p.in[I_WIN] + (size_t)l * D * IN_COLS + (size_t)k0 * IN_COLS, IN_COLS, col0, nvalid, (bf16_t*)wl + (size_t)n0 * D + k0, D, scr, lane); continue; }
        r -= I_IN;
        if (r < 2 * I_A) { const int which = r / I_A; r %= I_A; const int kb = r / 32, nb = r % 32;
            const float* src = p.in[which ? I_WBB : I_WBA] + (size_t)l * 512 * D + (size_t)(kb * 64) * D;
            transpose_item(src, D, nb * 32, 32, (bf16_t*)(wl + (10 + which) * MiB) + (size_t)(nb * 32) * 512 + kb * 64, 512, scr, lane); continue; }
        r -= 2 * I_A;
        if (r < I_O) { const int kb = r / 32, nb = r % 32;
          transpose_item(p.in[I_WOUT] + (size_t)l * D * D + (size_t)(kb * 64) * D, D, nb * 32, 32, (bf16_t*)(wl + 12 * MiB) + (size_t)(nb * 32) * D + kb * 64, D, scr, lane); continue; }
        r -= I_O;
        { bf16_t* lo = (bf16_t*)(p.ws + 65536 + (size_t)l * 262144);
          if (r < 16) transpose_item(p.in[I_WUP] + (size_t)l * 64 * 512, 512, r * 32, 32, lo + (size_t)(r * 32) * 64, 64, scr, lane);
          else if (r < 32) transpose_item(p.in[I_AUP] + (size_t)l * 64 * 512, 512, (r - 16) * 32, 32, lo + 32768 + (size_t)((r - 16) * 32) * 64, 64, scr, lane);
          else { const int q = r - 32, kb = q >> 4, nb = q & 15; transpose_item(p.in[I_GUP] + (size_t)l * 128 * 512 + (size_t)(kb * 64) * 512, 512, nb * 32, 32, lo + 65536 + (size_t)(nb * 32) * 128 + kb * 64, 128, scr, lane); } }
    }
}
__device__ __forceinline__ void conv_expert_items(const Params& p, int l, LAS unsigned char* lds, int it0, int it1) {
    const int tid = otid(), lane = tid & 63, wave = tid >> 6, gw = it0 + wave, NGW = NWAVES;
    LAS float* scr = (LAS float*)(lds + wave * 16384);
    constexpr int I_13 = 16 * 32, I_2 = 8 * 32, PER = I_13 + I_2;
    for (int it = gw; it < it1; it += NGW) {
        const int e = it / PER; int r = it % PER;
        if (r < I_13) { const int kb = r / 32, nb = r % 32, n0 = nb * 32, j = n0 >> 8, half = (n0 >> 7) & 1, c = 128 * j + (n0 & 127);
            const float* src = p.in[half ? I_WEXP3 : I_WEXP1] + (size_t)(l * 16 + e) * D * 512 + (size_t)(kb * 64) * 512;
            transpose_item(src, 512, c, 32, (bf16_t*)(p.ws + WS_WEXP) + (size_t)e * 1024 * 1024 + (size_t)n0 * 1024 + kb * 64, 1024, scr, lane); continue; }
        r -= I_13;
        { const int kb = r / 32, nb = r % 32;
          const float* src = p.in[I_WEXP2] + (size_t)(l * 16 + e) * 512 * D + (size_t)(kb * 64) * D;
          transpose_item(src, D, nb * 32, 32, (bf16_t*)(p.ws + WS_WEXP + 32 * MiB) + (size_t)e * 1024 * 512 + (size_t)(nb * 32) * 512 + kb * 64, 512, scr, lane); }
    }
}

__device__ __forceinline__ void ln_wave(f32x4 (&v)[4], const float* g, const float* bta, int lane) {
    float s = 0.f;
#pragma unroll
    for (int j = 0; j < 4; ++j) s += (v[j][0] + v[j][1]) + (v[j][2] + v[j][3]);
    const float mean = wave_sum(s) * (1.f / D); float s2 = 0.f;
#pragma unroll
    for (int j = 0; j < 4; ++j) { v[j] = v[j] - mean; s2 += (v[j][0] * v[j][0] + v[j][1] * v[j][1]) + (v[j][2] * v[j][2] + v[j][3] * v[j][3]); }
    const float rstd = __builtin_amdgcn_rsqf(wave_sum(s2) * (1.f / D) + LN_EPS);
#pragma unroll
    for (int j = 0; j < 4; ++j) { const f32x4 gg = *(const f32x4*)(g + 4 * lane + 256 * j), bb = *(const f32x4*)(bta + 4 * lane + 256 * j); v[j] = v[j] * rstd * gg + bb; }
}
__device__ __forceinline__ void store_row(const Params& p, int r, const f32x4 (&v)[4], int lane, bool zero) {
    float* hr = hrow(p, r); bf16_t* hb = (bf16_t*)(p.ws + WS_HB) + (size_t)r * D;
#pragma unroll
    for (int j = 0; j < 4; ++j) { const f32x4 o = zero ? (f32x4){0.f, 0.f, 0.f, 0.f} : v[j];
        *(f32x4*)(hr + 4 * lane + 256 * j) = o; u32x2 w; w.x = pk2(o[0], o[1]); w.y = pk2(o[2], o[3]); *(u32x2*)(hb + 4 * lane + 256 * j) = w; }
}
__device__ __forceinline__ void ln_in_phase(const Params& p) {
    const int tid = otid(), lane = tid & 63, gw = obid() * NWAVES + (tid >> 6), NGW = gridDim.x * NWAVES;
    for (int r = gw; r < T; r += NGW) {
        const int b = r / LP, pos = r - b * LP; f32x4 v[4];
        if (pos < PADM) {
#pragma unroll
            for (int j = 0; j < 4; ++j) v[j] = (f32x4){0.f, 0.f, 0.f, 0.f};
            store_row(p, r, v, lane, true); continue; }
        const float* src = pos < 64 ? p.in[I_META] + (size_t)(pos - PADM) * D : p.in[I_X] + ((size_t)(b * SEQ + pos - 64) << 10);
#pragma unroll
        for (int j = 0; j < 4; ++j) v[j] = *(const f32x4*)(src + 4 * lane + 256 * j);
        ln_wave(v, p.in[I_LNIN_G], p.in[I_LNIN_B], lane);
        store_row(p, r, v, lane, false);
    }
}

__device__ __forceinline__ const Params& PP() { const Params* q = (const Params*)__builtin_amdgcn_kernarg_segment_ptr(); asm volatile("" : "+s"(q)); return *q; }

#define EPI_COORDS() int tid_ = threadIdx.x; asm volatile("" : "+v"(tid_)); const int wid = tid_ >> 6, lane = tid_ & 63, wr = wid >> 2, wc = wid & 3, fr = lane & 15, fq = lane >> 4; (void)wr; (void)wc; (void)fr; (void)fq
__device__ __forceinline__ void inproj_epi(const g8::Acc& acc, int l, int pm, int pn) {
    EPI_COORDS();
    const int row0 = pm * 256 + wr * 64 + fr;
    if (pn < 12) {
        bf16_t* O = (bf16_t*)(PP().ws + WS_UAR);
#pragma unroll
        for (int ai = 0; ai < 2; ++ai)
#pragma unroll
            for (int m = 0; m < 4; ++m) { asm volatile("" ::: "memory"); bf16_t* rp = O + (size_t)(row0 + ai * 128 + m * 16) * UARW + pn * 256 + wc * 32 + 8 * fq;
#pragma unroll
                for (int bj = 0; bj < 2; ++bj) { const f32x4 v0 = acc[ai][bj][m][0], v1 = acc[ai][bj][m][1]; u32x4 w; w.x = pk2(v0[0], v0[1]); w.y = pk2(v0[2], v0[3]); w.z = pk2(v1[0], v1[1]); w.w = pk2(v1[2], v1[3]);
                    *(u32x4*)(rp + bj * 128) = w; } }
    } else {
        bf16_t* O = (bf16_t*)(PP().ws + WS_GATES); const int colb = (pn - 12) * 256 + wc * 32 + 8 * fq; const float* bg = PP().in[I_BGATE] + l * 2048;
        f32x4 bv[2][2];
#pragma unroll
        for (int bj = 0; bj < 2; ++bj) { bv[bj][0] = *(const f32x4*)(bg + colb + bj * 128); bv[bj][1] = *(const f32x4*)(bg + colb + bj * 128 + 4); }
#pragma unroll
        for (int ai = 0; ai < 2; ++ai)
#pragma unroll
            for (int m = 0; m < 4; ++m) { asm volatile("" ::: "memory"); bf16_t* rp = O + (size_t)(row0 + ai * 128 + m * 16) * 2048 + colb;
#pragma unroll
                for (int bj = 0; bj < 2; ++bj) { f32x4 v0 = acc[ai][bj][m][0] + bv[bj][0], v1 = acc[ai][bj][m][1] + bv[bj][1];
#pragma unroll
                    for (int e = 0; e < 4; ++e) { v0[e] = sigmoidf_(v0[e]); v1[e] = sigmoidf_(v1[e]); }
                    u32x4 w; w.x = pk2(v0[0], v0[1]); w.y = pk2(v0[2], v0[3]); w.z = pk2(v1[0], v1[1]); w.w = pk2(v1[2], v1[3]);
                    *(u32x4*)(rp + bj * 128) = w; } }
    }
}
constexpr int INP_MAIN = 62 * 20 + 3 * 12, INP_TAIL = 24;
__device__ __forceinline__ bool inproj_order(int i, int G, int c, int& pm, int& pn) {
    const long L = (long)i * G + c; if (L >= INP_MAIN) return false;
    if (L < 62 * 20) return unit_order(i, G, c, 62, 20, pm, pn);
    const int r = (int)L - 62 * 20; pm = 62 + r / 12; pn = r % 12; return true;
}
__device__ __forceinline__ void inproj_phase(const Params& p, int l, LAS unsigned char* lds) {
    unsigned voffA[2][2], voffB[2]; g8::make_voff_contig(voffA, D * 2); g8::make_voffB(voffB, D * 2, true);
    int pm, pn, pm2 = 0, pn2 = 0; const int bid = obid(); const int wr_ = __builtin_amdgcn_readfirstlane(otid() >> 6) >> 2;
    bool has = inproj_order(0, gridDim.x, bid, pm, pn), first = true;
    g8::Acc acc; g8::zero_acc(acc);
    for (int i = 0; has; ++i) {
        const bool hasn = inproj_order(i + 1, gridDim.x, bid, pm2, pn2);
        const char* Ab = (const char*)(PP().ws + WS_HB); const char* Bb = (const char*)(PP().ws + WS_WSMALL + (size_t)l * WSMALL_LAYER);
        const g8::KSeg s = g8::seg1(Ab + (size_t)pm * 256 * D * 2, Bb + (size_t)pn * 256 * D * 2, Bb + (size_t)(pn * 256 + 128) * D * 2, D / 64);
        const int pmn = hasn ? pm2 : pm, pnn = hasn ? pn2 : pn;
        const g8::KSeg nx = g8::seg1(Ab + (size_t)pmn * 256 * D * 2, Bb + (size_t)pnn * 256 * D * 2, Bb + (size_t)(pnn * 256 + 128) * D * 2, D / 64);
        if (!first && wr_ == 1) __builtin_amdgcn_s_barrier();
        g8::kstream<false, false>(lds, acc, s, nx, first, voffA, voffB, 128 * D * 2); first = false;
        if (wr_ == 0) __builtin_amdgcn_s_barrier();
        inproj_epi(acc, l, pm, pn);
        g8::zero_acc(acc); has = hasn; pm = pm2; pn = pn2;
    }
    if (!first) g8::kstream_end();
}
__device__ __forceinline__ void inproj_tail_unit(int l, LAS unsigned char* lds, int g) {
    unsigned voffA[2][2], voffB[2]; g8::make_voff_contig(voffA, D * 2); g8::make_voffB(voffB, D * 2, true);
    const int pm = 62 + (g >> 3), pn = 12 + (g & 7);
    g8::Acc acc; g8::zero_acc(acc);
    const char* Ab = (const char*)(PP().ws + WS_HB); const char* Bb = (const char*)(PP().ws + WS_WSMALL + (size_t)l * WSMALL_LAYER);
    const g8::KSeg s = g8::seg1(Ab + (size_t)pm * 256 * D * 2, Bb + (size_t)pn * 256 * D * 2, Bb + (size_t)(pn * 256 + 128) * D * 2, D / 64);
    g8::kloop<false, false>(lds, acc, s, voffA, voffB, 128 * D * 2);
    inproj_epi(acc, l, pm, pn);
}
__device__ __forceinline__ void merge_unit(int l, LAS unsigned char* lds, int pm, int pn, unsigned long long& pacc) {
    unsigned long long pt0 = 0;
    unsigned voffA[2][2], voffB[2]; g8::make_voff_contig(voffA, D * 2); g8::make_voffB(voffB, 512 * 2, true);
    {
        const int wr_ = __builtin_amdgcn_readfirstlane(otid() >> 6) >> 2;
        g8::Acc acc; g8::zero_acc(acc);
#pragma unroll 1
        for (int br = 0; br < 2; ++br) {
            const char* Bt = (const char*)(PP().ws + WS_WSMALL + (size_t)l * WSMALL_LAYER) + (10 + br) * MiB + (size_t)pn * 256 * 512 * 2;
            const char* Bn = (const char*)(PP().ws + WS_WSMALL + (size_t)l * WSMALL_LAYER) + 11 * MiB + (size_t)pn * 256 * 512 * 2;
            const g8::KSeg s = g8::seg1((const char*)(PP().ws + WS_OAB) + (size_t)pm * 256 * D * 2 + br * 1024, Bt, Bt + (size_t)128 * 512 * 2, 8);
            const g8::KSeg nx = g8::seg1((const char*)(PP().ws + WS_OAB) + (size_t)pm * 256 * D * 2 + 1024, Bn, Bn + (size_t)128 * 512 * 2, 8);
            if (br && wr_ == 1) __builtin_amdgcn_s_barrier();
            PRB_B(60 + 2 * br); g8::kstream<false, false>(lds, acc, s, nx, br == 0, voffA, voffB, 128 * D * 2); PRB_E(60 + 2 * br);
            if (wr_ == 0) __builtin_amdgcn_s_barrier();
            EPI_COORDS(); PRB_B(61 + 2 * br);
            const bf16_t* GT = (const bf16_t*)(PP().ws + WS_GATES); bf16_t* O = (bf16_t*)(PP().ws + WS_MERGED);
            const int row0 = pm * 256 + wr * 64 + fr, colb = pn * 256 + wc * 32 + 8 * fq;
#pragma unroll
            for (int ai = 0; ai < 2; ++ai) { asm volatile("" ::: "memory");
                u32x4 gq[4][2], pq[4][2];
#pragma unroll
                for (int m = 0; m < 4; ++m) { const size_t ro = (size_t)(row0 + ai * 128 + m * 16); const bf16_t* gp = GT + ro * 2048 + br * 1024 + colb; const bf16_t* op = O + ro * D + colb;
#pragma unroll
                    for (int bj = 0; bj < 2; ++bj) { gq[m][bj] = *(const u32x4*)(gp + bj * 128); pq[m][bj] = br ? *(const u32x4*)(op + bj * 128) : (u32x4){0u, 0u, 0u, 0u}; } }
#pragma unroll
                for (int m = 0; m < 4; ++m) { const size_t ro = (size_t)(row0 + ai * 128 + m * 16); bf16_t* op = O + ro * D + colb;
#pragma unroll
                    for (int bj = 0; bj < 2; ++bj) { const u32x4 g = gq[m][bj], pr = pq[m][bj]; const f32x4 v0 = acc[ai][bj][m][0], v1 = acc[ai][bj][m][1];
                        u32x4 w; w.x = pk2(v0[0] * bflo(g.x) + bflo(pr.x), v0[1] * bfhi(g.x) + bfhi(pr.x)); w.y = pk2(v0[2] * bflo(g.y) + bflo(pr.y), v0[3] * bfhi(g.y) + bfhi(pr.y));
                        w.z = pk2(v1[0] * bflo(g.z) + bflo(pr.z), v1[1] * bfhi(g.z) + bfhi(pr.z)); w.w = pk2(v1[2] * bflo(g.w) + bflo(pr.w), v1[3] * bfhi(g.w) + bfhi(pr.w));
                        *(u32x4*)(op + bj * 128) = w; } } }
            PRB_E(61 + 2 * br);
            g8::zero_acc(acc);
        }
        g8::kstream_end();
    }
}
__device__ __forceinline__ void wout_unit(int l, LAS unsigned char* lds, int pm, int pn) {
    unsigned voffA[2][2], voffB[2]; g8::make_voff_contig(voffA, D * 2); g8::make_voffB(voffB, D * 2, false);
    g8::Acc acc; g8::zero_acc(acc);
    const char* Ab = (const char*)(PP().ws + WS_MERGED); const char* Bb = (const char*)(PP().ws + WS_WSMALL + (size_t)l * WSMALL_LAYER + 12 * MiB);
    const g8::KSeg s = g8::seg1(Ab + (size_t)pm * 256 * D * 2, Bb + (size_t)pn * 256 * D * 2, Bb + (size_t)(pn * 256 + 128) * D * 2, D / 64);
    g8::kloop<false, false>(lds, acc, s, voffA, voffB, 128 * D * 2);
    EPI_COORDS();
    const int row0 = pm * 256 + wr * 64 + fr, col0 = pn * 256 + wc * 32 + 4 * fq;
#pragma unroll
    for (int ai = 0; ai < 2; ++ai) { asm volatile("" ::: "memory");
        f32x4 pre[4][2][2]; float* hr[4];
#pragma unroll
        for (int m = 0; m < 4; ++m) { hr[m] = hrow(PP(), row0 + ai * 128 + m * 16) + col0;
#pragma unroll
            for (int bj = 0; bj < 2; ++bj)
#pragma unroll
                for (int n = 0; n < 2; ++n) pre[m][bj][n] = *(const f32x4*)(hr[m] + bj * 128 + n * 16); }
#pragma unroll
        for (int m = 0; m < 4; ++m)
#pragma unroll
            for (int bj = 0; bj < 2; ++bj)
#pragma unroll
                for (int n = 0; n < 2; ++n) *(f32x4*)(hr[m] + bj * 128 + n * 16) = pre[m][bj][n] * ALPHA + acc[ai][bj][m][n]; }
}
__device__ __forceinline__ unsigned score_key(float s) { s += 0.0f; const unsigned u = __builtin_bit_cast(unsigned, s); return (u & 0x80000000u) ? ~u : (u | 0x80000000u); }
__device__ void attn_naive_query(const Params& p, int row, unsigned char* wl, int lane) {
    const bf16_t* U = (const bf16_t*)(p.ws + WS_UAR);
    bf16_t* OA = (bf16_t*)(p.ws + WS_OAB) + (size_t)row * D;
    const int b = row / LP, pos = row - b * LP;
    if (pos < PADM) {
#pragma unroll
        for (int j = 0; j < 8; ++j) OA[j * 64 + lane] = 0;
        return;
    }
    const int nadm = 64 * ((pos >> 6) + 1) - PADM;
    unsigned* keys = (unsigned*)wl; float* p_s = (float*)wl;
    float* qi_s = (float*)(wl + 16640); float* q_s = qi_s + 256; float* w_s = q_s + 512; unsigned short* sel_s = (unsigned short*)(w_s + 16);
    const bf16_t* urow = U + (size_t)row * UARW;
    for (int i = lane; i < 256; i += 64) qi_s[i] = bf2f(urow[C_QI + i]);
    for (int i = lane; i < 512; i += 64) q_s[i] = bf2f(urow[C_Q + i]);
    if (lane < 8) w_s[lane] = bf2f(urow[C_WI + lane]);
    __builtin_amdgcn_fence(__ATOMIC_RELEASE, "wavefront"); __builtin_amdgcn_wave_barrier(); __builtin_amdgcn_fence(__ATOMIC_ACQUIRE, "wavefront");
    const int nj = (nadm + 63) >> 6;
    for (int j = 0; j < nj; ++j) {
        const int ki_idx = lane + 64 * j; unsigned key = 0u;
        if (ki_idx < nadm) {
            const u32x4* kp = (const u32x4*)(U + (size_t)(b * LP + PADM + ki_idx) * UARW + C_KI);
            float kf[32];
#pragma unroll
            for (int c4 = 0; c4 < 4; ++c4) { const u32x4 w = kp[c4];
                kf[c4 * 8 + 0] = bflo(w.x); kf[c4 * 8 + 1] = bfhi(w.x); kf[c4 * 8 + 2] = bflo(w.y); kf[c4 * 8 + 3] = bfhi(w.y);
                kf[c4 * 8 + 4] = bflo(w.z); kf[c4 * 8 + 5] = bfhi(w.z); kf[c4 * 8 + 6] = bflo(w.w); kf[c4 * 8 + 7] = bfhi(w.w); }
            float sc = 0.f;
#pragma unroll 1
            for (int h = 0; h < 8; ++h) { float d = 0.f; asm volatile("" ::: "memory");
#pragma unroll
                for (int e = 0; e < 32; ++e) d = fmaf(qi_s[h * 32 + e], kf[e], d);
                sc = fmaf(w_s[h], fmaxf(d, 0.f), sc); }
            key = score_key(sc); if (key == 0u) key = 1u;
        }
        keys[ki_idx] = key;
    }
    __builtin_amdgcn_fence(__ATOMIC_RELEASE, "wavefront"); __builtin_amdgcn_wave_barrier(); __builtin_amdgcn_fence(__ATOMIC_ACQUIRE, "wavefront");
    unsigned thr = 0u; int need_ties = 0x7fffffff;
    if (nadm > 256) {
        unsigned prefix = 0u; int remaining = 256;
        for (int bit = 31; bit >= 0; --bit) {
            const unsigned cand = prefix | (1u << bit); int cnt = 0;
            for (int j = 0; j < nj; ++j) { const unsigned k = keys[lane + 64 * j]; cnt += __builtin_popcountll(__ballot((k >> bit) == (cand >> bit))); }
            if (cnt >= remaining) prefix = cand; else remaining -= cnt;
        }
        thr = prefix; need_ties = remaining;
    } else thr = 1u;
    int nsel = 0, ties_seen = 0;
    for (int j = 0; j < nj; ++j) {
        const unsigned k = keys[lane + 64 * j];
        const unsigned long long tm = __ballot(k == thr && k != 0u);
        const unsigned long long lt = (1ull << lane) - 1ull;
        const int myrank = ties_seen + __builtin_popcountll(tm & lt);
        const bool selme = (k > thr) || (k == thr && k != 0u && myrank < need_ties);
        const unsigned long long sm = __ballot(selme);
        if (selme) sel_s[nsel + __builtin_popcountll(sm & lt)] = (unsigned short)(PADM + lane + 64 * j);
        nsel += __builtin_popcountll(sm); ties_seen += __builtin_popcountll(tm);
    }
    __builtin_amdgcn_fence(__ATOMIC_RELEASE, "wavefront"); __builtin_amdgcn_wave_barrier(); __builtin_amdgcn_fence(__ATOMIC_ACQUIRE, "wavefront");
    float sc[4][8];
#pragma unroll
    for (int m = 0; m < 4; ++m) {
        asm volatile("" ::: "memory");
        const int i = lane + 64 * m; const bool valid = i < nsel; const int ps = valid ? sel_s[i] : PADM;
        const bf16_t* krow = U + (size_t)(b * LP + ps) * UARW + C_K;
#pragma unroll
        for (int n = 0; n < 2; ++n) {
            float a0 = 0.f, a1 = 0.f, a2 = 0.f, a3 = 0.f;
#pragma unroll 1
            for (int c8 = 0; c8 < 8; ++c8) { asm volatile("" ::: "memory"); const u32x4 w = *(const u32x4*)(krow + n * 64 + c8 * 8);
                float kf[8] = {bflo(w.x), bfhi(w.x), bflo(w.y), bfhi(w.y), bflo(w.z), bfhi(w.z), bflo(w.w), bfhi(w.w)};
#pragma unroll
                for (int e = 0; e < 8; ++e) { const int dd = c8 * 8 + e;
                    a0 = fmaf(q_s[(n * 4 + 0) * 64 + dd], kf[e], a0); a1 = fmaf(q_s[(n * 4 + 1) * 64 + dd], kf[e], a1);
                    a2 = fmaf(q_s[(n * 4 + 2) * 64 + dd], kf[e], a2); a3 = fmaf(q_s[(n * 4 + 3) * 64 + dd], kf[e], a3); } }
            sc[m][n * 4 + 0] = valid ? a0 * 0.125f : -INFINITY; sc[m][n * 4 + 1] = valid ? a1 * 0.125f : -INFINITY;
            sc[m][n * 4 + 2] = valid ? a2 * 0.125f : -INFINITY; sc[m][n * 4 + 3] = valid ? a3 * 0.125f : -INFINITY;
        }
    }
    __builtin_amdgcn_wave_barrier();
    float linv[8];
#pragma unroll
    for (int h = 0; h < 8; ++h) {
        const float mx = wave_max(fmaxf(fmaxf(sc[0][h], sc[1][h]), fmaxf(sc[2][h], sc[3][h]))); float s = 0.f;
#pragma unroll
        for (int m = 0; m < 4; ++m) { const float e = __expf(sc[m][h] - mx); sc[m][h] = e; s += e; }
        linv[h] = 1.0f / wave_sum(s);
    }
#pragma unroll
    for (int m = 0; m < 4; ++m) { const int i = lane + 64 * m;
#pragma unroll
        for (int h = 0; h < 8; ++h) p_s[i * 8 + h] = sc[m][h]; }
    __builtin_amdgcn_fence(__ATOMIC_RELEASE, "wavefront"); __builtin_amdgcn_wave_barrier(); __builtin_amdgcn_fence(__ATOMIC_ACQUIRE, "wavefront");
    float o[8] = {0.f, 0.f, 0.f, 0.f, 0.f, 0.f, 0.f, 0.f};
    for (int i = 0; i < nsel; ++i) {
        const int ps = sel_s[i]; const bf16_t* vrow = U + (size_t)(b * LP + ps) * UARW + C_V;
        const float v0 = bf2f(vrow[lane]), v1 = bf2f(vrow[64 + lane]);
        const f32x4 pa = *(const f32x4*)(p_s + i * 8), pb = *(const f32x4*)(p_s + i * 8 + 4);
        o[0] = fmaf(pa[0], v0, o[0]); o[1] = fmaf(pa[1], v0, o[1]); o[2] = fmaf(pa[2], v0, o[2]); o[3] = fmaf(pa[3], v0, o[3]);
        o[4] = fmaf(pb[0], v1, o[4]); o[5] = fmaf(pb[1], v1, o[5]); o[6] = fmaf(pb[2], v1, o[6]); o[7] = fmaf(pb[3], v1, o[7]);
    }
#pragma unroll
    for (int h = 0; h < 8; ++h) OA[h * 64 + lane] = (bf16_t)f2bf(o[h] * linv[h]);
    __builtin_amdgcn_wave_barrier();
}


__device__ __forceinline__ f32x4 mfma16(bf16x8 a, bf16x8 b, f32x4 c) { return __builtin_amdgcn_mfma_f32_16x16x32_bf16(a, b, c, 0, 0, 0); }
#define LDS_BARRIER() do { asm volatile("s_waitcnt lgkmcnt(0)" ::: "memory"); __builtin_amdgcn_s_barrier(); asm volatile("" ::: "memory"); } while (0)

typedef float f32x16 __attribute__((ext_vector_type(16)));
typedef short s16x4 __attribute__((ext_vector_type(4)));
constexpr int AT_HIST = 0;
constexpr int AT_MASK = 20480;
constexpr int AT_QST = AT_MASK + 16640;
constexpr int AT_KV = 37120;
constexpr int AT_UNIT = AT_KV + 32768;
constexpr int AT_KL = AT_KV;
constexpr int AT_KL_BYTES = LDS_BYTES - 16 - AT_KL;
static_assert((4128 + 8) * 12 * 2 <= AT_KL_BYTES, "selection keys fit with 12 queries per sub-pass");
constexpr int CW_R1Q = 48;
constexpr int CW_ATT = 32;
__device__ __forceinline__ int img_off(int row, int ch) { return 2048 * (row >> 3) + 512 * (ch >> 2) + 64 * (row & 7) + 16 * ((ch & 3) ^ ((row >> 2) & 3)); }
__device__ __forceinline__ unsigned comp_key(float sc, int pos) { return (score_key(sc) & 0xFFFFE000u) | (unsigned)(0x1FFF - pos); }

__device__ __forceinline__ void attn_unit(const Params& p, unsigned char* lds, int b, int qt, unsigned long long& pacc) {
    unsigned long long pt0 = 0; if (PROBE_PHASE == 40 || PROBE_PHASE == 42) pt0 = __builtin_amdgcn_s_memrealtime();
    const int tid = otid(), wave = tid >> 6, lane = tid & 63, r = lane & 31, hh = lane >> 5;
    const bf16_t* U = (const bf16_t*)(p.ws + WS_UAR);
    LAS unsigned char* L = (LAS unsigned char*)lds;
    LAS unsigned* hist = (LAS unsigned*)(L + AT_HIST); LAS unsigned* maskw = (LAS unsigned*)(L + AT_MASK);
    const int c = qt >> 1, nkt = 2 * c + 1, nadm = 64 * (c + 1) - PADM;
    const size_t qrow = (size_t)(b * LP + 32 * qt + r);
    if (nadm > 256) {
        LAS unsigned short* KL = (LAS unsigned short*)(L + AT_KL);
        LAS unsigned* h8 = (LAS unsigned*)(L + AT_HIST);
        LAS unsigned* segc = h8 + 4096;
        LAS unsigned* st = segc + 512;
        const int NK = 32 * nkt, c15 = lane & 15, g4 = lane >> 4;
        const int KST = NK + 8, qs = KST * 32 <= AT_KL_BYTES ? 16 : 12;
        for (int i = tid; i < (nkt + 1) * 32; i += NTHREADS) maskw[i] = 0u;
#pragma unroll 1
        for (int qbase = 0; qbase < 32; qbase += qs) {
            const int qn = 32 - qbase < qs ? 32 - qbase : qs; const bool qact = c15 < qn;
            bf16x8 qf[8]; float wq[8];
            { const bf16_t* qp = U + (size_t)(b * LP + 32 * qt + qbase + (qact ? c15 : 0)) * UARW;
#pragma unroll
              for (int h = 0; h < 8; ++h) qf[h] = *(const bf16x8*)(qp + C_QI + h * 32 + 8 * g4);
              const u32x4 w = *(const u32x4*)(qp + C_WI);
              wq[0] = bflo(w.x); wq[1] = bfhi(w.x); wq[2] = bflo(w.y); wq[3] = bfhi(w.y); wq[4] = bflo(w.z); wq[5] = bfhi(w.z); wq[6] = bflo(w.w); wq[7] = bfhi(w.w); }
#pragma unroll
            for (int h = 0; h < 8; ++h) asm volatile("" : "+v"(qf[h]), "+v"(wq[h]));
            for (int i = tid; i < 4096 + 512; i += NTHREADS) h8[i] = 0u;
            LDS_BARRIER();
            {
                const int ng = 2 * nkt; int j = wave;
                const bf16_t* kb = U + (size_t)(b * LP + 32 + c15) * UARW + C_KI + 8 * g4;
                bf16x8 a = *(const bf16x8*)(kb + (size_t)(16 * (j < ng ? j : 0)) * UARW), an = *(const bf16x8*)(kb + (size_t)(16 * (j + NWAVES < ng ? j + NWAVES : 0)) * UARW);
#pragma unroll 1
                for (; j < ng; j += NWAVES) {
                    const bf16x8 a2 = *(const bf16x8*)(kb + (size_t)(16 * (j + 2 * NWAVES < ng ? j + 2 * NWAVES : j)) * UARW);
                    f32x4 sc = {0.f, 0.f, 0.f, 0.f};
#pragma unroll
                    for (int h = 0; h < 8; ++h) { const f32x4 d = mfma16(a, qf[h], (f32x4){0.f, 0.f, 0.f, 0.f});
#pragma unroll
                        for (int e = 0; e < 4; ++e) sc[e] = fmaf(wq[h], fmaxf(d[e], 0.f), sc[e]); }
                    if (qact) { unsigned kq[4];
#pragma unroll
                        for (int e = 0; e < 4; ++e) { kq[e] = j >= 1 ? (score_key(sc[e]) >> 16) : 0u;
                            __hip_atomic_fetch_add(h8 + (kq[e] >> 8) * 16 + c15, j >= 1 ? 1u : 0u, __ATOMIC_RELAXED, __HIP_MEMORY_SCOPE_WORKGROUP); }
                        u32x2 w; w.x = kq[0] | (kq[1] << 16); w.y = kq[2] | (kq[3] << 16);
                        *(LAS u32x2*)(KL + c15 * KST + 16 * j + 4 * g4) = w; }
                    a = an; an = a2;
                }
            }
            LDS_BARRIER();
            { const int q_ = tid & 15, s8 = tid >> 4; unsigned ss = 0u;
#pragma unroll
              for (int i = 0; i < 8; ++i) ss += h8[(s8 * 8 + i) * 16 + q_];
              segc[s8 * 16 + q_] = ss; }
            LDS_BARRIER();
            if (tid < qn) { unsigned sv[32];
#pragma unroll
                for (int i = 0; i < 32; ++i) sv[i] = segc[i * 16 + tid];
                unsigned cum = 0u; int sgi = 31;
#pragma unroll
                for (int i = 31; i > 0; --i) { const bool go = sgi == i && cum + sv[i] < 256u; cum += go ? sv[i] : 0u; sgi -= go ? 1 : 0; }
                int bin = sgi * 8 + 7; while (bin > sgi * 8 && cum + h8[bin * 16 + tid] < 256u) { cum += h8[bin * 16 + tid]; --bin; }
                st[tid * 4] = (unsigned)bin; st[tid * 4 + 1] = 256u - cum; }
            LDS_BARRIER();
            for (int i = tid; i < 4096; i += NTHREADS) h8[i] = 0u;
            LDS_BARRIER();
            const int q = tid & 15, sg = tid >> 4, SEGH = (2 * nkt + 31) >> 5, h0 = sg * SEGH, h1 = q < qn ? (h0 + SEGH < 2 * nkt ? h0 + SEGH : 2 * nkt) : h0;
            const LAS unsigned short* kq_ = KL + q * KST;
#define KW8(v, i) (((i) & 1) ? ((i) < 2 ? v.x : (i) < 4 ? v.y : (i) < 6 ? v.z : v.w) >> 16 : ((i) < 2 ? v.x : (i) < 4 ? v.y : (i) < 6 ? v.z : v.w) & 0xFFFFu)
            { const unsigned hb = st[q * 4];
#pragma unroll 1
              for (int hf = h0; hf < h1; ++hf) { const u32x4 va = *(const LAS u32x4*)(kq_ + 16 * hf), vb = *(const LAS u32x4*)(kq_ + 16 * hf + 8);
#pragma unroll
                  for (int i = 0; i < 16; ++i) { const unsigned kv = i < 8 ? KW8(va, i) : KW8(vb, i - 8);
                      if ((kv >> 8) == hb && kv != 0u) __hip_atomic_fetch_add(h8 + (kv & 255u) * 16 + q, 1u, __ATOMIC_RELAXED, __HIP_MEMORY_SCOPE_WORKGROUP); } } }
            LDS_BARRIER();
            { const int q_ = tid & 15, s8 = tid >> 4; unsigned ss = 0u;
#pragma unroll
              for (int i = 0; i < 8; ++i) ss += h8[(s8 * 8 + i) * 16 + q_];
              segc[s8 * 16 + q_] = ss; }
            LDS_BARRIER();
            if (tid < qn) { const unsigned rem = st[tid * 4 + 1]; unsigned sv[32];
#pragma unroll
                for (int i = 0; i < 32; ++i) sv[i] = segc[i * 16 + tid];
                unsigned cum = 0u; int sgi = 31;
#pragma unroll
                for (int i = 31; i > 0; --i) { const bool go = sgi == i && cum + sv[i] < rem; cum += go ? sv[i] : 0u; sgi -= go ? 1 : 0; }
                int bin = sgi * 8 + 7; while (bin > sgi * 8 && cum + h8[bin * 16 + tid] < rem) { cum += h8[bin * 16 + tid]; --bin; }
                st[tid * 4 + 2] = (st[tid * 4] << 8) | (unsigned)bin; st[tid * 4 + 3] = rem - cum; }
            LDS_BARRIER();
            const unsigned thr = st[q * 4 + 2], need = st[q * 4 + 3];
            { unsigned cnt = 0u;
#pragma unroll 1
              for (int hf = h0; hf < h1; ++hf) { const u32x4 va = *(const LAS u32x4*)(kq_ + 16 * hf), vb = *(const LAS u32x4*)(kq_ + 16 * hf + 8);
#pragma unroll
                  for (int i = 0; i < 16; ++i) { const unsigned kv = i < 8 ? KW8(va, i) : KW8(vb, i - 8); cnt += kv == thr ? 1u : 0u; } }
              segc[sg * 16 + q] = cnt; }
            LDS_BARRIER();
            if (tid < qn) { unsigned cv[32];
#pragma unroll
                for (int s2 = 0; s2 < 32; ++s2) cv[s2] = segc[s2 * 16 + tid];
                unsigned run = 0u;
#pragma unroll
                for (int s2 = 0; s2 < 32; ++s2) { segc[s2 * 16 + tid] = run; run += cv[s2]; } }
            LDS_BARRIER();
            { unsigned rank = segc[sg * 16 + q];
#pragma unroll 1
              for (int hf = h0; hf < h1; ++hf) { const u32x4 va = *(const LAS u32x4*)(kq_ + 16 * hf), vb = *(const LAS u32x4*)(kq_ + 16 * hf + 8); unsigned bits = 0u;
#pragma unroll
                  for (int i = 0; i < 16; ++i) { const unsigned kv = i < 8 ? KW8(va, i) : KW8(vb, i - 8); const bool tie = kv == thr; const bool sel = kv > thr || (tie && rank < need); rank += tie ? 1u : 0u;
                      bits |= (sel ? 1u : 0u) << i; }
                  *(LAS unsigned short*)((LAS unsigned char*)maskw + ((hf >> 1) + 1) * 128 + (qbase + q) * 4 + (hf & 1) * 2) = (unsigned short)bits; } }
#undef KW8
            LDS_BARRIER();
        }
    } else {
        for (int kt = 1 + wave; kt <= nkt; kt += NWAVES) if (hh == 0) maskw[kt * 32 + r] = kt == 1 ? 0xFFFF0000u : 0xFFFFFFFFu;
        LDS_BARRIER();
    }
    if (PROBE_PHASE == 40) pacc += __builtin_amdgcn_s_memrealtime() - pt0;
    if (PROBE_PHASE == 41) pt0 = __builtin_amdgcn_s_memrealtime();
    {
        const int h = wave, n = h >> 2;
        bf16x8 qf4[4];
#pragma unroll
        for (int kk = 0; kk < 4; ++kk) qf4[kk] = *(const bf16x8*)(U + qrow * UARW + C_Q + h * 64 + 16 * kk + 8 * hh);
        asm volatile("" : "+v"(qf4[0]), "+v"(qf4[1]), "+v"(qf4[2]), "+v"(qf4[3]));
        f32x16 o0, o1;
#pragma unroll
        for (int e = 0; e < 16; ++e) { o0[e] = 0.f; o1[e] = 0.f; }
        float m = -1e30f, lsum = 0.f;
        const int srow = tid >> 4, sch = tid & 15; const int soff = img_off(srow, sch);
        const bf16_t* sbase = U + (size_t)(b * LP + srow) * UARW + sch * 8;
        u32x4 kreg = *(const u32x4*)(sbase + (size_t)32 * UARW + C_K), vreg = *(const u32x4*)(sbase + (size_t)32 * UARW + C_V);
        *(LAS u32x4*)(L + AT_KV + soff) = kreg; *(LAS u32x4*)(L + AT_KV + 8192 + soff) = vreg;
        { const int k2 = nkt >= 2 ? 2 : 1; kreg = *(const u32x4*)(sbase + (size_t)(32 * k2) * UARW + C_K); vreg = *(const u32x4*)(sbase + (size_t)(32 * k2) * UARW + C_V); }
        LDS_BARRIER();
        const int g = (lane >> 4) & 1, q_ = (lane & 15) >> 2, p_ = lane & 3;
        constexpr float SCL = 0.125f * 1.44269504088896f;
#pragma unroll 1
        for (int i = 0; i < nkt; ++i) {
            const int kt = 1 + i; LAS unsigned char* Kimg = L + AT_KV + (i & 1) * 16384; LAS unsigned char* Vimg = Kimg + 8192;
            u32x4 kreg2, vreg2;
            { const int k3 = kt + 2 <= nkt ? kt + 2 : kt; kreg2 = *(const u32x4*)(sbase + (size_t)(32 * k3) * UARW + C_K); vreg2 = *(const u32x4*)(sbase + (size_t)(32 * k3) * UARW + C_V); }
            f32x16 s;
#pragma unroll
            for (int e = 0; e < 16; ++e) s[e] = 0.f;
#pragma unroll
            for (int kk = 0; kk < 4; ++kk) { const bf16x8 a = *(const LAS bf16x8*)(Kimg + img_off(r, 8 * n + 2 * kk + hh)); s = __builtin_amdgcn_mfma_f32_32x32x16_bf16(a, qf4[kk], s, 0, 0, 0); }
            const unsigned mw = maskw[kt * 32 + r] >> (4 * hh);
            float tmax = -INFINITY;
#pragma unroll
            for (int e = 0; e < 16; ++e) { const bool sel = (mw >> ((e & 3) + 8 * (e >> 2))) & 1u; s[e] = sel ? s[e] : -INFINITY; tmax = fmaxf(tmax, s[e]); }
            tmax = fmaxf(tmax, __shfl_xor(tmax, 32));
            const float mnew = fmaxf(m, tmax * SCL);
            if (__any(mnew > m)) { const float alpha = __builtin_amdgcn_exp2f(m - mnew); lsum *= alpha;
#pragma unroll
                for (int e = 0; e < 16; ++e) { o0[e] *= alpha; o1[e] *= alpha; } }
            m = mnew;
            float ps = 0.f;
#pragma unroll
            for (int e = 0; e < 16; ++e) { const float pe = __builtin_amdgcn_exp2f(fmaf(s[e], SCL, -mnew)); s[e] = pe; ps += pe; }
            lsum += ps;
            bf16x8 pf[2];
#pragma unroll
            for (int ks = 0; ks < 2; ++ks) { u32x4 w; w.x = pk2(s[8 * ks + 0], s[8 * ks + 1]); w.y = pk2(s[8 * ks + 2], s[8 * ks + 3]); w.z = pk2(s[8 * ks + 4], s[8 * ks + 5]); w.w = pk2(s[8 * ks + 6], s[8 * ks + 7]); pf[ks] = __builtin_bit_cast(bf16x8, w); }
#pragma unroll
            for (int ks = 0; ks < 2; ++ks)
#pragma unroll
                for (int dt = 0; dt < 2; ++dt) { const int c0 = 8 * n + 4 * dt + 2 * g + (p_ >> 1);
                    const s16x4 lo = __builtin_amdgcn_ds_read_tr16_b64_v4i16((LAS s16x4*)(Vimg + img_off(16 * ks + 4 * hh + q_, c0) + 8 * (p_ & 1)));
                    const s16x4 hi = __builtin_amdgcn_ds_read_tr16_b64_v4i16((LAS s16x4*)(Vimg + img_off(16 * ks + 8 + 4 * hh + q_, c0) + 8 * (p_ & 1)));
                    const bf16x8 a = __builtin_shufflevector(lo, hi, 0, 1, 2, 3, 4, 5, 6, 7);
                    if (dt == 0) o0 = __builtin_amdgcn_mfma_f32_32x32x16_bf16(a, pf[ks], o0, 0, 0, 0); else o1 = __builtin_amdgcn_mfma_f32_32x32x16_bf16(a, pf[ks], o1, 0, 0, 0); }
            if (i + 1 < nkt) { LAS unsigned char* Kn = L + AT_KV + ((i + 1) & 1) * 16384; *(LAS u32x4*)(Kn + soff) = kreg; *(LAS u32x4*)(Kn + 8192 + soff) = vreg; }
            kreg = kreg2; vreg = vreg2;
            LDS_BARRIER();
        }
        lsum += __shfl_xor(lsum, 32);
        const float inv = lsum > 0.f ? 1.0f / lsum : 0.f;
        bf16_t* orow = (bf16_t*)(p.ws + WS_OAB) + qrow * D + h * 64 + 4 * hh;
#pragma unroll
        for (int g4 = 0; g4 < 4; ++g4) { u32x2 w0, w1;
            w0.x = pk2(o0[4 * g4] * inv, o0[4 * g4 + 1] * inv); w0.y = pk2(o0[4 * g4 + 2] * inv, o0[4 * g4 + 3] * inv);
            w1.x = pk2(o1[4 * g4] * inv, o1[4 * g4 + 1] * inv); w1.y = pk2(o1[4 * g4 + 2] * inv, o1[4 * g4 + 3] * inv);
            *(u32x2*)(orow + 8 * g4) = w0; *(u32x2*)(orow + 32 + 8 * g4) = w1; }
        if (qt == 1) {
            bf16_t* z = (bf16_t*)(p.ws + WS_OAB) + (size_t)(b * LP + r) * D + h * 64 + 32 * hh;
#pragma unroll
            for (int j = 0; j < 4; ++j) *(u32x4*)(z + 8 * j) = (u32x4){0u, 0u, 0u, 0u};
        }
    }
    if (PROBE_PHASE == 41 || PROBE_PHASE == 42) pacc += __builtin_amdgcn_s_memrealtime() - pt0;
}
__device__ __forceinline__ void attn_phase(const Params& p, int l, unsigned char* lds, unsigned long long& pacc) {
    unsigned* ctr = (unsigned*)(p.ws + WS_CTL) + CW_ATT + 4 * l;
    volatile int* uw = (volatile int*)(lds + AT_UNIT);
    const int b0 = (obid() & 7) >> 1;
    for (int k = 0; k < 4; ++k) { const int b = (b0 + k) & 3;
        for (;;) {
            __syncthreads();
            if (otid() == 0) *uw = (int)atomicAdd(ctr + b, 1u);
            __syncthreads();
            const int u = *uw;
            if (u >= 129) break;
            attn_unit(p, lds, b, 129 - u, pacc);
        }
    }
}

constexpr size_t WS_RW1 = WS_HB;
constexpr size_t WS_RW2 = 259 * MiB;
constexpr size_t RW2_ARR = (size_t)2080 * 8192;
constexpr size_t WS_LORA = 65536;
constexpr int PS = 72;
constexpr int R1_XW = 0, R1_XA = 9216, R1_XG = 18432;
constexpr int R1_RHS = 0;
constexpr int R1_E = 35840, R1_AA = R1_E + 16640, R1_GS = R1_AA + 9216;
constexpr int R1_LABT = R1_E, R1_LAK = R1_E + 16384;
constexpr int R1_AT = R1_GS + 9216, R1_RT = R1_AT + 9216, R1_BT = R1_RT + 9216, R1_KT = R1_BT + 9216;
constexpr int R1_WT = R1_AT, R1_ZT = R1_BT, R1_LOFF = R1_KT;
constexpr int R1_BTT = R1_KT + 9216, R1_KTT = R1_BTT + 9216, R1_VT = R1_KTT + 9216;
constexpr int R1_MRB = R1_VT + 9216, R1_MRK = R1_MRB + 9216;
constexpr int R1_BS = R1_MRK + 9216, R1_GC = R1_BS + 256, R1_END = R1_GC + 256;
static_assert(R1_END <= LDS_BYTES && R1_LAK + 9216 <= R1_AT && R1_RHS + 33280 <= R1_E, "R1 LDS map");
__device__ __forceinline__ u32x2 pk4(f32x4 v) { u32x2 w; w.x = pk2(v[0], v[1]); w.y = pk2(v[2], v[3]); return w; }

struct R1PF { u32x4 a[7], q[7]; };
__device__ __forceinline__ void r1_load_rows(const bf16_t* U, int unit, int tid, R1PF& pf) {
    const int h = unit & 7, bc = unit >> 3, b = bc / NCH, c = bc - b * NCH, t = tid >> 3, d0 = (tid & 7) * 8;
    const int row = b * LP + 64 * c + t; const bool hasprev = (64 * c + t) > 0;
    const bf16_t* uc = U + (size_t)row * UARW; const bf16_t* up = hasprev ? uc - UARW : uc;
    const int cols[7] = {C_R + h * 64 + d0, C_RK + h * 64 + d0, C_RV + h * 64 + d0, C_XW + d0, C_XA + d0, C_XG + d0, C_XG + 64 + d0};
#pragma unroll
    for (int i = 0; i < 7; ++i) { pf.a[i] = *(const u32x4*)(uc + cols[i]); pf.q[i] = *(const u32x4*)(up + cols[i]); }
}
#define R1P(k) do { if (PROBE_PHASE == 20 + (k)) { const unsigned long long t_ = __builtin_amdgcn_s_memrealtime(); pacc += t_ - pt0; } if (PROBE_PHASE == 21 + (k)) pt0 = __builtin_amdgcn_s_memrealtime(); } while (0)
__device__ __forceinline__ void rwkv_prep_unit(const Params& p, int l, int unit, unsigned char* lds, unsigned long long& pacc, R1PF& pf, int next_unit) {
    unsigned long long pt0 = 0; if (PROBE_PHASE == 20) pt0 = __builtin_amdgcn_s_memrealtime();
    const int tid = otid(), wave = tid >> 6, lane = tid & 63, c15 = lane & 15, g = lane >> 4;
    const int h = unit & 7, bc = unit >> 3, b = bc / NCH, c = bc - b * NCH;
    LAS unsigned char* L = (LAS unsigned char*)lds;
    const bf16_t* U = (const bf16_t*)(p.ws + WS_UAR);
    const int t = tid >> 3, dq = tid & 7, d0 = dq * 8;
    const int row = b * LP + 64 * c + t; const bool hasprev = (64 * c + t) > 0;
    bf16x8 lw[2][2], la[2][2], lg_[2][4];
    float rr[8], kx[8], vx[8], kk[8];
    {
        const float* mu = p.in[I_MU] + l * R_COLS;
        auto shift8 = [&](int idx, int mucol, float (&out)[8]) {
            const u32x4 a = pf.a[idx], q = pf.q[idx];
            const f32x4 m0 = *(const f32x4*)(mu + mucol), m1 = *(const f32x4*)(mu + mucol + 4);
            const float x[8] = {bflo(a.x), bfhi(a.x), bflo(a.y), bfhi(a.y), bflo(a.z), bfhi(a.z), bflo(a.w), bfhi(a.w)};
            const float y[8] = {bflo(q.x), bfhi(q.x), bflo(q.y), bfhi(q.y), bflo(q.z), bfhi(q.z), bflo(q.w), bfhi(q.w)};
#pragma unroll
            for (int i = 0; i < 8; ++i) { const float xp = hasprev ? y[i] : 0.f; out[i] = x[i] + (xp - x[i]) * (i < 4 ? m0[i] : m1[i - 4]); } };
        shift8(0, h * 64 + d0, rr); shift8(1, 512 + h * 64 + d0, kx); shift8(2, 1024 + h * 64 + d0, vx);
#pragma unroll
        for (int i = 0; i < 8; ++i) asm volatile("" : "+v"(rr[i]), "+v"(kx[i]), "+v"(vx[i]));
        float xw[8], xa[8], xg0[8], xg1[8];
        shift8(3, 1536 + d0, xw); shift8(4, 1600 + d0, xa); shift8(5, 1664 + d0, xg0); shift8(6, 1728 + d0, xg1);
        asm volatile("" ::: "memory");
        { const bf16_t* lora = (const bf16_t*)(p.ws + WS_LORA + (size_t)l * 262144);
    #pragma unroll
          for (int nn = 0; nn < 2; ++nn) { const int hd = h * 64 + 16 * (2 * (wave & 1) + nn) + c15;
    #pragma unroll
              for (int s2 = 0; s2 < 2; ++s2) { lw[nn][s2] = *(const bf16x8*)(lora + (size_t)hd * 64 + 32 * s2 + 8 * g); la[nn][s2] = *(const bf16x8*)(lora + 32768 + (size_t)hd * 64 + 32 * s2 + 8 * g); }
    #pragma unroll
              for (int s4 = 0; s4 < 4; ++s4) lg_[nn][s4] = *(const bf16x8*)(lora + 65536 + (size_t)hd * 128 + 32 * s4 + 8 * g); } }
        float n2 = 0.f;
        { const f32x4 k0 = *(const f32x4*)(p.in[I_KK] + l * 512 + h * 64 + d0), k1 = *(const f32x4*)(p.in[I_KK] + l * 512 + h * 64 + d0 + 4);
#pragma unroll
          for (int i = 0; i < 8; ++i) { kk[i] = kx[i] * (i < 4 ? k0[i] : k1[i - 4]); n2 = fmaf(kk[i], kk[i], n2); } }
        n2 += __shfl_xor(n2, 1); n2 += __shfl_xor(n2, 2); n2 += __shfl_xor(n2, 4);
        const float rn = rsqrtf(fmaxf(n2, 1e-24f));
#pragma unroll
        for (int i = 0; i < 8; ++i) { kk[i] *= rn; xw[i] = 1.0f - 2.0f * __builtin_amdgcn_rcpf(1.0f + __expf(2.0f * xw[i])); xg0[i] = sigmoidf_(xg0[i]); xg1[i] = sigmoidf_(xg1[i]); }
        u32x4 w;
        w.x = pk2(xw[0], xw[1]); w.y = pk2(xw[2], xw[3]); w.z = pk2(xw[4], xw[5]); w.w = pk2(xw[6], xw[7]); *(LAS u32x4*)(L + R1_XW + (t * PS + d0) * 2) = w;
        w.x = pk2(xa[0], xa[1]); w.y = pk2(xa[2], xa[3]); w.z = pk2(xa[4], xa[5]); w.w = pk2(xa[6], xa[7]); *(LAS u32x4*)(L + R1_XA + (t * PS + d0) * 2) = w;
        w.x = pk2(xg0[0], xg0[1]); w.y = pk2(xg0[2], xg0[3]); w.z = pk2(xg0[4], xg0[5]); w.w = pk2(xg0[6], xg0[7]); *(LAS u32x4*)(L + R1_XG + (t * 136 + d0) * 2) = w;
        w.x = pk2(xg1[0], xg1[1]); w.y = pk2(xg1[2], xg1[3]); w.z = pk2(xg1[4], xg1[5]); w.w = pk2(xg1[6], xg1[7]); *(LAS u32x4*)(L + R1_XG + (t * 136 + 64 + d0) * 2) = w;
    }
    LDS_BARRIER();
    R1P(0);
    const int tm = wave >> 1;
    unsigned char* rw2 = p.ws + WS_RW2 + (size_t)unit * 8192;
    {
#pragma unroll
        for (int nn = 0; nn < 2; ++nn) { const int tn = 2 * (wave & 1) + nn, dcol = 16 * tn + c15, hd = h * 64 + dcol;
            f32x4 aw = {0.f, 0.f, 0.f, 0.f}, aa = aw, ag = aw;
#pragma unroll
            for (int s2 = 0; s2 < 2; ++s2) {
                const bf16x8 xa_ = *(const LAS bf16x8*)(L + R1_XW + ((16 * tm + c15) * PS + 32 * s2 + 8 * g) * 2), xb_ = *(const LAS bf16x8*)(L + R1_XA + ((16 * tm + c15) * PS + 32 * s2 + 8 * g) * 2);
                aw = mfma16(xa_, lw[nn][s2], aw);
                aa = mfma16(xb_, la[nn][s2], aa); }
#pragma unroll
            for (int s4 = 0; s4 < 4; ++s4) ag = mfma16(*(const LAS bf16x8*)(L + R1_XG + ((16 * tm + c15) * 136 + 32 * s4 + 8 * g) * 2), lg_[nn][s4], ag);
            const float w0 = p.in[I_W0][l * 512 + hd], a0 = p.in[I_A0][l * 512 + hd];
#pragma unroll
            for (int e = 0; e < 4; ++e) { const int tt = 16 * tm + 4 * g + e;
                *(LAS float*)(L + R1_E + (tt * 65 + dcol) * 4) = 0.60653065971263342f * sigmoidf_(w0 + aw[e]);
                *(LAS unsigned short*)(L + R1_AA + (tt * PS + dcol) * 2) = (unsigned short)f2bf(sigmoidf_(a0 + aa[e]));
                *(LAS unsigned short*)(L + R1_GS + (tt * PS + dcol) * 2) = (unsigned short)f2bf(ag[e]); }
        }
    }
    LDS_BARRIER();
    R1P(1);
    {
        const int d = tid & 63, sg = tid >> 6; float cum = 0.f, loc[8];
#pragma unroll
        for (int i = 0; i < 8; ++i) { cum += *(const LAS float*)(L + R1_E + ((8 * sg + i) * 65 + d) * 4); loc[i] = cum; }
        *(LAS float*)(L + R1_BS + (sg * 64 + d) * 4 - 2048) = cum;
        LDS_BARRIER();
        float off = 0.f;
#pragma unroll
        for (int q = 0; q < 7; ++q) if (q < sg) off += *(const LAS float*)(L + R1_BS + (q * 64 + d) * 4 - 2048);
#pragma unroll
        for (int i = 0; i < 8; ++i) *(LAS float*)(L + R1_E + ((8 * sg + i) * 65 + d) * 4) = loc[i] + off;
    }
    LDS_BARRIER();
    R1P(2);
    {
        const f32x4 ka0 = *(const f32x4*)(p.in[I_KA] + l * 512 + h * 64 + d0), ka1 = *(const f32x4*)(p.in[I_KA] + l * 512 + h * 64 + d0 + 4);
        const f32x4 rk0 = *(const f32x4*)(p.in[I_RK] + l * 512 + h * 64 + d0), rk1 = *(const f32x4*)(p.in[I_RK] + l * 512 + h * 64 + d0 + 4);
        const u32x4 aw_ = *(const LAS u32x4*)(L + R1_AA + (t * PS + d0) * 2);
        const float av[8] = {bflo(aw_.x), bfhi(aw_.x), bflo(aw_.y), bfhi(aw_.y), bflo(aw_.z), bfhi(aw_.z), bflo(aw_.w), bfhi(aw_.w)};
        float At[8], Bt[8], Kt[8], Rt[8]; float bpart = 0.f;
#pragma unroll
        for (int i = 0; i < 8; ++i) {
            const float cumt = *(const LAS float*)(L + R1_E + (t * 65 + d0 + i) * 4), cump = t > 0 ? *(const LAS float*)(L + R1_E + ((t - 1) * 65 + d0 + i) * 4) : 0.f;
            const float gam = __expf(-cumt), gprev = __expf(-cump), ginv = __expf(cumt);
            const float kmod = kx[i] * (1.0f + (av[i] - 1.0f) * (i < 4 ? ka0[i] : ka1[i - 4]));
            At[i] = -gprev * kk[i]; Bt[i] = kk[i] * av[i] * ginv; Kt[i] = kmod * ginv; Rt[i] = rr[i] * gam;
            bpart = fmaf(rr[i] * kmod, (i < 4 ? rk0[i] : rk1[i - 4]), bpart);
            if (t == 63) *(LAS float*)(L + R1_GC + (d0 + i) * 4) = gam;
            *(LAS float*)(L + R1_RHS + ((d0 + i) * 65 + t) * 4) = At[i];
            *(LAS unsigned short*)(L + R1_BTT + ((d0 + i) * PS + t) * 2) = (unsigned short)f2bf(Bt[i]);
            *(LAS unsigned short*)(L + R1_KTT + ((d0 + i) * PS + t) * 2) = (unsigned short)f2bf(Kt[i]);
            *(LAS unsigned short*)(L + R1_VT + ((d0 + i) * PS + t) * 2) = (unsigned short)f2bf(vx[i]);
        }
        u32x4 w;
        w.x = pk2(At[0], At[1]); w.y = pk2(At[2], At[3]); w.z = pk2(At[4], At[5]); w.w = pk2(At[6], At[7]); *(LAS u32x4*)(L + R1_AT + (t * PS + d0) * 2) = w;
        w.x = pk2(Rt[0], Rt[1]); w.y = pk2(Rt[2], Rt[3]); w.z = pk2(Rt[4], Rt[5]); w.w = pk2(Rt[6], Rt[7]); *(LAS u32x4*)(L + R1_RT + (t * PS + d0) * 2) = w;
        w.x = pk2(Bt[0], Bt[1]); w.y = pk2(Bt[2], Bt[3]); w.z = pk2(Bt[4], Bt[5]); w.w = pk2(Bt[6], Bt[7]); *(LAS u32x4*)(L + R1_BT + (t * PS + d0) * 2) = w;
        w.x = pk2(Kt[0], Kt[1]); w.y = pk2(Kt[2], Kt[3]); w.z = pk2(Kt[4], Kt[5]); w.w = pk2(Kt[6], Kt[7]); *(LAS u32x4*)(L + R1_KT + (t * PS + d0) * 2) = w;
        bpart += __shfl_xor(bpart, 1); bpart += __shfl_xor(bpart, 2); bpart += __shfl_xor(bpart, 4);
        const u32x4 gw = *(const LAS u32x4*)(L + R1_GS + (t * PS + d0) * 2);
        const float gv[8] = {bflo(gw.x), bfhi(gw.x), bflo(gw.y), bfhi(gw.y), bflo(gw.z), bfhi(gw.z), bflo(gw.w), bfhi(gw.w)};
        w.x = pk2(bpart * vx[0] * gv[0], bpart * vx[1] * gv[1]); w.y = pk2(bpart * vx[2] * gv[2], bpart * vx[3] * gv[3]);
        w.z = pk2(bpart * vx[4] * gv[4], bpart * vx[5] * gv[5]); w.w = pk2(bpart * vx[6] * gv[6], bpart * vx[7] * gv[7]);
        *(u32x4*)((bf16_t*)(p.ws + WS_OAB) + (size_t)row * D + 512 + h * 64 + d0) = w;
        *(u32x4*)(rw2 + 2 * RW2_ARR + (size_t)(t * 64 + d0) * 2) = gw;
    }
    LDS_BARRIER();
    R1P(3);
    {
        f32x4 gab[2], gak[2], grb[2], grk[2];
#pragma unroll
        for (int nn = 0; nn < 2; ++nn) { const int tn = 2 * (wave & 1) + nn;
            gab[nn] = (f32x4){0.f, 0.f, 0.f, 0.f}; gak[nn] = gab[nn]; grb[nn] = gab[nn]; grk[nn] = gab[nn];
            if (tn <= tm) {
#pragma unroll
                for (int s2 = 0; s2 < 2; ++s2) { const int ao = ((16 * tm + c15) * PS + 32 * s2 + 8 * g) * 2, bo = ((16 * tn + c15) * PS + 32 * s2 + 8 * g) * 2;
                    const bf16x8 fa = *(const LAS bf16x8*)(L + R1_AT + ao), fr_ = *(const LAS bf16x8*)(L + R1_RT + ao), fb = *(const LAS bf16x8*)(L + R1_BT + bo), fk = *(const LAS bf16x8*)(L + R1_KT + bo);
                    gab[nn] = mfma16(fa, fb, gab[nn]); gak[nn] = mfma16(fa, fk, gak[nn]); grb[nn] = mfma16(fr_, fb, grb[nn]); grk[nn] = mfma16(fr_, fk, grk[nn]); } } }
        LDS_BARRIER();
#pragma unroll
        for (int nn = 0; nn < 2; ++nn) { const int tn = 2 * (wave & 1) + nn, icol = 16 * tn + c15;
            f32x4 lab;
#pragma unroll
            for (int e = 0; e < 4; ++e) { const int tt = 16 * tm + 4 * g + e; const bool strict = icol < tt, incl = icol <= tt;
                lab[e] = strict ? gab[nn][e] : 0.f;
                *(LAS unsigned short*)(L + R1_LAK + (tt * PS + icol) * 2) = (unsigned short)f2bf(strict ? gak[nn][e] : 0.f);
                *(LAS unsigned short*)(L + R1_LOFF + (tt * PS + icol) * 2) = (unsigned short)f2bf(icol < (tt & ~15) ? gab[nn][e] : 0.f);
                *(LAS unsigned short*)(L + R1_MRB + (tt * PS + icol) * 2) = (unsigned short)f2bf(incl ? grb[nn][e] : 0.f);
                *(LAS unsigned short*)(L + R1_MRK + (tt * PS + icol) * 2) = (unsigned short)f2bf(incl ? grk[nn][e] : 0.f); }
            *(LAS f32x4*)(L + R1_LABT + (icol * 64 + 16 * tm + 4 * g) * 4) = lab; }
    }
    LDS_BARRIER();
    R1P(4);
    {
#pragma unroll
        for (int nn = 0; nn < 2; ++nn) { const int tn = 2 * (wave & 1) + nn; f32x4 acc = {0.f, 0.f, 0.f, 0.f};
#pragma unroll
            for (int s2 = 0; s2 < 2; ++s2) acc = mfma16(*(const LAS bf16x8*)(L + R1_LAK + ((16 * tm + c15) * PS + 32 * s2 + 8 * g) * 2), *(const LAS bf16x8*)(L + R1_VT + ((16 * tn + c15) * PS + 32 * s2 + 8 * g) * 2), acc);
#pragma unroll
            for (int e = 0; e < 4; ++e) *(LAS float*)(L + R1_RHS + ((64 + 16 * tn + c15) * 65 + 16 * tm + 4 * g + e) * 4) = acc[e]; }
    }
    LDS_BARRIER();
    R1P(5);
#pragma unroll 1
    for (int Tb = 0; Tb < 4; ++Tb) {
        if (Tb > 0) {
            LAS unsigned char* XT = L + (wave < 4 ? R1_WT + (16 * wave) * PS * 2 : R1_ZT + (16 * (wave - 4)) * PS * 2);
            f32x4 acc = {0.f, 0.f, 0.f, 0.f};
            acc = mfma16(*(const LAS bf16x8*)(L + R1_LOFF + ((16 * Tb + c15) * PS + 8 * g) * 2), *(const LAS bf16x8*)(XT + (c15 * PS + 8 * g) * 2), acc);
            if (Tb == 3) acc = mfma16(*(const LAS bf16x8*)(L + R1_LOFF + ((16 * Tb + c15) * PS + 32 + 8 * g) * 2), *(const LAS bf16x8*)(XT + (c15 * PS + 32 + 8 * g) * 2), acc);
            LAS float* rp = (LAS float*)(L + R1_RHS + ((16 * wave + c15) * 65 + 16 * Tb + 4 * g) * 4);
#pragma unroll
            for (int e = 0; e < 4; ++e) rp[e] += acc[e];
            LDS_BARRIER();
        }
        if (tid < 128) {
            LAS float* xr = (LAS float*)(L + R1_RHS + (tid * 65 + 16 * Tb) * 4);
            float acc[16];
#pragma unroll
            for (int e = 0; e < 16; ++e) acc[e] = xr[e];
#pragma unroll
            for (int ii = 0; ii < 15; ++ii) { const float xi = acc[ii];
#pragma unroll
                for (int q = (ii + 1) / 4; q < 4; ++q) { const f32x4 lv = *(const LAS f32x4*)(L + R1_LABT + ((16 * Tb + ii) * 64 + 16 * Tb + 4 * q) * 4);
#pragma unroll
                    for (int e = 0; e < 4; ++e) if (4 * q + e > ii) acc[4 * q + e] = fmaf(lv[e], xi, acc[4 * q + e]); } }
#pragma unroll
            for (int e = 0; e < 16; ++e) xr[e] = acc[e];
            LAS unsigned char* dst = L + (tid < 64 ? R1_WT + tid * PS * 2 : R1_ZT + (tid - 64) * PS * 2) + 32 * Tb;
            u32x4 w0, w1; w0.x = pk2(acc[0], acc[1]); w0.y = pk2(acc[2], acc[3]); w0.z = pk2(acc[4], acc[5]); w0.w = pk2(acc[6], acc[7]);
            w1.x = pk2(acc[8], acc[9]); w1.y = pk2(acc[10], acc[11]); w1.z = pk2(acc[12], acc[13]); w1.w = pk2(acc[14], acc[15]);
            *(LAS u32x4*)dst = w0; *(LAS u32x4*)(dst + 16) = w1;
        }
        if (Tb < 3) LDS_BARRIER();
    }
    LDS_BARRIER();
    R1P(6);
    {
        unsigned char* rw1 = p.ws + WS_RW1 + (size_t)unit * 16384;
#pragma unroll
        for (int nn = 0; nn < 2; ++nn) { const int tn = 2 * (wave & 1) + nn, col = 16 * tn + c15, r0 = 16 * tm + 4 * g;
            f32x4 aP = {0.f, 0.f, 0.f, 0.f}, aQ = aP, aG = aP, aY = aP;
#pragma unroll
            for (int s2 = 0; s2 < 2; ++s2) { const int ro = ((16 * tm + c15) * PS + 32 * s2 + 8 * g) * 2, co = ((16 * tn + c15) * PS + 32 * s2 + 8 * g) * 2;
                const bf16x8 fWT = *(const LAS bf16x8*)(L + R1_WT + ro), fBTT = *(const LAS bf16x8*)(L + R1_BTT + ro), fKTT = *(const LAS bf16x8*)(L + R1_KTT + ro), fMRB = *(const LAS bf16x8*)(L + R1_MRB + ro), fMRK = *(const LAS bf16x8*)(L + R1_MRK + ro);
                const bf16x8 cBTT = *(const LAS bf16x8*)(L + R1_BTT + co), cZT = *(const LAS bf16x8*)(L + R1_ZT + co), cVT = *(const LAS bf16x8*)(L + R1_VT + co), cMRB = *(const LAS bf16x8*)(L + R1_MRB + co);
                aP = mfma16(fWT, cBTT, aP);
                aQ = mfma16(fBTT, cZT, aQ); aQ = mfma16(fKTT, cVT, aQ);
                aG = mfma16(fWT, cMRB, aG);
                aY = mfma16(fMRB, cZT, aY); aY = mfma16(fMRK, cVT, aY); }
            const float gcc = *(const LAS float*)(L + R1_GC + col * 4);
            const f32x4 gcr = *(const LAS f32x4*)(L + R1_GC + r0 * 4);
            const u32x2 rtw = *(const LAS u32x2*)(L + R1_RT + (col * PS + r0) * 2);
#pragma unroll
            for (int e = 0; e < 4; ++e) { aP[e] = (aP[e] + ((r0 + e) == col ? 1.0f : 0.f)) * gcc; aQ[e] *= gcr[e]; }
            aG[0] += bflo(rtw.x); aG[1] += bfhi(rtw.x); aG[2] += bflo(rtw.y); aG[3] += bfhi(rtw.y);
            *(u32x2*)(rw1 + (size_t)(col * 64 + r0) * 2) = pk4(aP);
            *(u32x2*)(rw1 + 8192 + (size_t)(col * 64 + r0) * 2) = pk4(aG);
            *(u32x2*)(rw2 + (size_t)(col * 64 + r0) * 2) = pk4(aQ);
            *(u32x2*)(rw2 + RW2_ARR + (size_t)(col * 64 + r0) * 2) = pk4(aY); }
    }
    if (next_unit >= 0) r1_load_rows(U, next_unit, tid, pf);
    LDS_BARRIER();
    R1P(7);
}

constexpr int R2_SV = 0, R2_YS = 2 * 64 * PS * 2, R2_END = R2_YS + 2 * 64 * 68 * 4;
__device__ __forceinline__ void rwkv_scan(const Params& p, int l, int bh, unsigned char* lds) {
    const int tid = otid(), wave = tid >> 6, lane = tid & 63, c15 = lane & 15, g = lane >> 4;
    const int b = bh >> 3, h = bh & 7, role = wave >> 2, j = wave & 3, vcol = 16 * j + c15;
    LAS unsigned char* L = (LAS unsigned char*)lds;
    for (int i = tid; i < 2 * 64 * PS * 2 / 4; i += NTHREADS) ((LAS unsigned*)(L + R2_SV))[i] = 0u;
    LDS_BARRIER();
    const int et = tid >> 3, ev0 = 8 * (tid & 7);
    f32x4 gn0[2], gn1[2];
    { const float* gp = p.in[I_GNG] + l * 512 + h * 64 + ev0; const float* bp = p.in[I_GNB] + l * 512 + h * 64 + ev0;
      gn0[0] = *(const f32x4*)gp; gn0[1] = *(const f32x4*)(gp + 4); gn1[0] = *(const f32x4*)bp; gn1[1] = *(const f32x4*)(bp + 4); }
    bf16_t* OB = (bf16_t*)(p.ws + WS_OAB) + (size_t)(b * LP + et) * D + 512 + h * 64 + ev0;
    const int unit0 = (b * NCH) * 8 + h;
    const unsigned char* rw1b = p.ws + WS_RW1 + (role ? 8192 : 0) + (size_t)(c15 * 64 + 8 * g) * 2;
    const unsigned char* rw2b = p.ws + WS_RW2 + (role ? RW2_ARR : 0) + (size_t)(vcol * 64 + 4 * g) * 2;
    const unsigned char* ggb = p.ws + WS_RW2 + 2 * RW2_ARR + (size_t)(et * 64 + ev0) * 2;
    bf16x8 A0[4][2], A1[4][2]; u32x2 I0[4], I1[4];
    u32x4 G0 = {0u, 0u, 0u, 0u}, O0 = G0, G1, O1;
#define R2_LOAD(AA, II, cc) do { const size_t un_ = (size_t)(unit0 + 8 * ((cc) < NCH ? (cc) : NCH - 1)); \
        _Pragma("unroll") for (int m = 0; m < 4; ++m) { II[m] = *(const u32x2*)(rw2b + un_ * 8192 + 32 * m); \
            _Pragma("unroll") for (int s2 = 0; s2 < 2; ++s2) AA[m][s2] = *(const bf16x8*)(rw1b + un_ * 16384 + (16 * m * 64 + 32 * s2) * 2); } } while (0)
    R2_LOAD(A0, I0, 0); R2_LOAD(A1, I1, 1);
    G1 = *(const u32x4*)(ggb + (size_t)unit0 * 8192); O1 = *(const u32x4*)OB;
#pragma unroll 1
    for (int c = 0; c <= NCH; ++c) {
        const int cur = c & 1;
        bf16x8 A2[4][2]; u32x2 I2[4];
        R2_LOAD(A2, I2, c + 2);
        u32x4 G2, O2; { const int cn = c + 1 < NCH ? c + 1 : NCH - 1; G2 = *(const u32x4*)(ggb + (size_t)(unit0 + 8 * cn) * 8192); O2 = *(const u32x4*)(OB + (size_t)(64 * cn) * D); }
        if (c > 0) {
            const f32x4 y0 = *(const LAS f32x4*)(L + R2_YS + ((cur ^ 1) * 64 * 68 + et * 68 + ev0) * 4), y1 = *(const LAS f32x4*)(L + R2_YS + ((cur ^ 1) * 64 * 68 + et * 68 + ev0 + 4) * 4);
            float s1 = (y0[0] + y0[1]) + (y0[2] + y0[3]) + (y1[0] + y1[1]) + (y1[2] + y1[3]);
            s1 = sum8(s1); const float mean = s1 * (1.f / 64.f);
            const f32x4 d0 = y0 - mean, d1 = y1 - mean;
            float s2_ = (d0[0] * d0[0] + d0[1] * d0[1]) + (d0[2] * d0[2] + d0[3] * d0[3]) + (d1[0] * d1[0] + d1[1] * d1[1]) + (d1[2] * d1[2] + d1[3] * d1[3]);
            s2_ = sum8(s2_); const float rstd = rsqrtf(s2_ * (1.f / 64.f) + GN_EPS);
            const float gv[8] = {bflo(G0.x), bfhi(G0.x), bflo(G0.y), bfhi(G0.y), bflo(G0.z), bfhi(G0.z), bflo(G0.w), bfhi(G0.w)};
            const float ov[8] = {bflo(O0.x), bfhi(O0.x), bflo(O0.y), bfhi(O0.y), bflo(O0.z), bfhi(O0.z), bflo(O0.w), bfhi(O0.w)};
            float o[8];
#pragma unroll
            for (int i = 0; i < 4; ++i) { o[i] = ov[i] + (d0[i] * rstd * gn0[0][i] + gn1[0][i]) * gv[i]; o[4 + i] = ov[4 + i] + (d1[i] * rstd * gn0[1][i] + gn1[1][i]) * gv[4 + i]; }
            u32x4 w; w.x = pk2(o[0], o[1]); w.y = pk2(o[2], o[3]); w.z = pk2(o[4], o[5]); w.w = pk2(o[6], o[7]);
            *(u32x4*)(OB + (size_t)(64 * (c - 1)) * D) = w;
        }
        if (c < NCH) {
            bf16x8 bf_[2];
#pragma unroll
            for (int s2 = 0; s2 < 2; ++s2) bf_[s2] = *(const LAS bf16x8*)(L + R2_SV + cur * 64 * PS * 2 + (vcol * PS + 32 * s2 + 8 * g) * 2);
            f32x4 acc[4];
#pragma unroll
            for (int m = 0; m < 4; ++m) { acc[m] = (f32x4){bflo(I0[m].x), bfhi(I0[m].x), bflo(I0[m].y), bfhi(I0[m].y)};
#pragma unroll
                for (int s2 = 0; s2 < 2; ++s2) acc[m] = mfma16(A0[m][s2], bf_[s2], acc[m]); }
            if (role == 0) {
#pragma unroll
                for (int m = 0; m < 4; ++m) *(LAS u32x2*)(L + R2_SV + (cur ^ 1) * 64 * PS * 2 + (vcol * PS + 16 * m + 4 * g) * 2) = pk4(acc[m]);
            } else {
#pragma unroll
                for (int m = 0; m < 4; ++m)
#pragma unroll
                    for (int e = 0; e < 4; ++e) *(LAS float*)(L + R2_YS + (cur * 64 * 68 + (16 * m + 4 * g + e) * 68 + vcol) * 4) = acc[m][e];
            }
        }
        LDS_BARRIER();
#pragma unroll
        for (int m = 0; m < 4; ++m) { I0[m] = I1[m]; I1[m] = I2[m]; A0[m][0] = A1[m][0]; A0[m][1] = A1[m][1]; A1[m][0] = A2[m][0]; A1[m][1] = A2[m][1]; }
        G0 = G1; O0 = O1; G1 = G2; O1 = O2;
    }
#undef R2_LOAD
}

__device__ void rwkv_naive(const Params& p, int l, int bh, unsigned char* lds) {
    const int b = bh >> 3, h = bh & 7, tid = otid(), lane = tid & 63, wid = tid >> 6;
    const bf16_t* U = (const bf16_t*)(p.ws + WS_UAR);
    bf16_t* OB = (bf16_t*)(p.ws + WS_OAB);
    float* xs = (float*)lds;
    float* vr = xs + 32 * 256;
    float* vw = vr + 2048; float* vkk = vw + 2048; float* vbb = vkk + 2048; float* vk = vbb + 2048; float* vv = vk + 2048;
    float* gg = vv + 2048; float* bon = gg + 2048; float* ys = bon + 2048;
    const float* mu = p.in[I_MU] + l * R_COLS;
    const int hd = h * 64 + lane;
    const float w0 = p.in[I_W0][l * 512 + hd], a0 = p.in[I_A0][l * 512 + hd], kkc = p.in[I_KK][l * 512 + hd], kac = p.in[I_KA][l * 512 + hd], rkc = p.in[I_RK][l * 512 + hd];
    const float gng = p.in[I_GNG][l * 512 + hd], gnb = p.in[I_GNB][l * 512 + hd];
    const float mur = mu[hd], muk = mu[512 + hd], muv = mu[1024 + hd];
    const float* wup = p.in[I_WUP] + (size_t)l * 64 * 512 + hd; const float* aup = p.in[I_AUP] + (size_t)l * 64 * 512 + hd; const float* gup = p.in[I_GUP] + (size_t)l * 128 * 512 + hd;
    float S[8];
#pragma unroll
    for (int i = 0; i < 8; ++i) S[i] = 0.f;
    const int sv = tid >> 3, sq = tid & 7;
    for (int p0 = 0; p0 < LP; p0 += 32) {
        for (int idx = tid; idx < 32 * 256; idx += NTHREADS) {
            const int tt = idx >> 8, j = idx & 255, pos = p0 + tt; const size_t ro = (size_t)(b * LP + pos) * UARW;
            const float x = bf2f(U[ro + C_XW + j]); const float xp = pos > 0 ? bf2f(U[ro - UARW + C_XW + j]) : 0.f;
            float xv = x + (xp - x) * mu[1536 + j];
            if (j < 64) xv = tanhf(xv); else if (j >= 128) xv = sigmoidf_(xv);
            xs[idx] = xv;
        }
        __syncthreads();
        {
            float dw[4] = {0.f, 0.f, 0.f, 0.f}, da[4] = {0.f, 0.f, 0.f, 0.f}, dg[4] = {0.f, 0.f, 0.f, 0.f};
            for (int j = 0; j < 64; ++j) { const float w1 = wup[(size_t)j * 512], w2 = aup[(size_t)j * 512];
#pragma unroll
                for (int k = 0; k < 4; ++k) { dw[k] = fmaf(xs[(wid * 4 + k) * 256 + j], w1, dw[k]); da[k] = fmaf(xs[(wid * 4 + k) * 256 + 64 + j], w2, da[k]); } }
            for (int j = 0; j < 128; ++j) { const float w3 = gup[(size_t)j * 512];
#pragma unroll
                for (int k = 0; k < 4; ++k) dg[k] = fmaf(xs[(wid * 4 + k) * 256 + 128 + j], w3, dg[k]); }
#pragma unroll
            for (int k = 0; k < 4; ++k) {
                const int tt = wid * 4 + k, pos = p0 + tt; const size_t ro = (size_t)(b * LP + pos) * UARW;
                float r = bf2f(U[ro + C_R + hd]), kx = bf2f(U[ro + C_RK + hd]), vx = bf2f(U[ro + C_RV + hd]);
                if (pos > 0) { const float rp = bf2f(U[ro - UARW + C_R + hd]), kp = bf2f(U[ro - UARW + C_RK + hd]), vp = bf2f(U[ro - UARW + C_RV + hd]);
                    r += (rp - r) * mur; kx += (kp - kx) * muk; vx += (vp - vx) * muv; }
                else { r -= r * mur; kx -= kx * muk; vx -= vx * muv; }
                const float z = -(w0 + dw[k]); const float sp = fmaxf(z, 0.f) + log1pf(__expf(-fabsf(z)));
                const float logw = -sp - 0.5f; const float w = __expf(-__expf(logw));
                const float a = sigmoidf_(a0 + da[k]);
                float kk = kx * kkc; const float nrm = wave_sum(kk * kk); kk *= rsqrtf(fmaxf(nrm, 1e-24f));
                const float kmod = kx * (1.0f + (a - 1.0f) * kac);
                const float bsum = wave_sum(r * kmod * rkc);
                vr[tt * 64 + lane] = r; vw[tt * 64 + lane] = w; vkk[tt * 64 + lane] = kk; vbb[tt * 64 + lane] = kk * a; vk[tt * 64 + lane] = kmod; vv[tt * 64 + lane] = vx;
                gg[tt * 64 + lane] = dg[k]; bon[tt * 64 + lane] = bsum * vx;
            }
        }
        __syncthreads();
        for (int tt = 0; tt < 32; ++tt) {
            const f32x4 k0 = *(const f32x4*)(vkk + tt * 64 + sq * 8), k1 = *(const f32x4*)(vkk + tt * 64 + sq * 8 + 4);
            const f32x4 w0v = *(const f32x4*)(vw + tt * 64 + sq * 8), w1v = *(const f32x4*)(vw + tt * 64 + sq * 8 + 4);
            const f32x4 b0 = *(const f32x4*)(vbb + tt * 64 + sq * 8), b1 = *(const f32x4*)(vbb + tt * 64 + sq * 8 + 4);
            const f32x4 m0 = *(const f32x4*)(vk + tt * 64 + sq * 8), m1 = *(const f32x4*)(vk + tt * 64 + sq * 8 + 4);
            const f32x4 r0 = *(const f32x4*)(vr + tt * 64 + sq * 8), r1 = *(const f32x4*)(vr + tt * 64 + sq * 8 + 4);
            const float vt = vv[tt * 64 + sv];
            float sa = 0.f;
#pragma unroll
            for (int i = 0; i < 4; ++i) { sa = fmaf(S[i], k0[i], sa); sa = fmaf(S[4 + i], k1[i], sa); }
            sa += __shfl_xor(sa, 1); sa += __shfl_xor(sa, 2); sa += __shfl_xor(sa, 4);
            sa = -sa; float y = 0.f;
#pragma unroll
            for (int i = 0; i < 4; ++i) { S[i] = S[i] * w0v[i] + sa * b0[i] + vt * m0[i]; S[4 + i] = S[4 + i] * w1v[i] + sa * b1[i] + vt * m1[i];
                y = fmaf(S[i], r0[i], y); y = fmaf(S[4 + i], r1[i], y); }
            y += __shfl_xor(y, 1); y += __shfl_xor(y, 2); y += __shfl_xor(y, 4);
            if (sq == 0) ys[tt * 64 + sv] = y;
        }
        __syncthreads();
#pragma unroll
        for (int k = 0; k < 4; ++k) { const int tt = wid * 4 + k, pos = p0 + tt; const float y = ys[tt * 64 + lane];
            const float m = wave_sum(y) * (1.f / 64.f); const float dv = y - m; const float var = wave_sum(dv * dv) * (1.f / 64.f);
            const float o = (dv * rsqrtf(var + GN_EPS) * gng + gnb + bon[tt * 64 + lane]) * gg[tt * 64 + lane];
            OB[(size_t)(b * LP + pos) * D + 512 + hd] = (bf16_t)f2bf(o); }
        __syncthreads();
    }
}

__device__ __forceinline__ int pair_index(int a, int b) {   return a == 0 ? b - 1 : (a == 1 ? b + 1 : 5); }
__device__ __forceinline__ void pair_of(int idx, int& a, int& b) { a = idx < 3 ? 0 : (idx < 5 ? 1 : 2); b = idx < 3 ? idx + 1 : (idx < 5 ? idx - 1 : 3); }
__device__ __forceinline__ void ln1_rows(const Params& p, int l, unsigned char* lds, int row0, bool stage) {
    const int tid = otid(), lane = tid & 63, gw = row0 + 8 * (tid >> 6), NGW = 1, TEND = gw + 8;
    int* lcnt = (int*)(lds + 65536); int* lbase = lcnt + 32; int* rec = lcnt + 64;
    __syncthreads();
    if (tid < 32) lcnt[tid] = 0;
    float* wr_s = (float*)lds;
    if (stage) for (int i = tid; i < D * 16 / 4; i += NTHREADS) { const f32x4 w = ((const f32x4*)p.in[I_WROUTER])[i]; const int c = i >> 2, e0 = (i & 3) * 4;
        wr_s[(e0 + 0) * D + c] = w[0]; wr_s[(e0 + 1) * D + c] = w[1]; wr_s[(e0 + 2) * D + c] = w[2]; wr_s[(e0 + 3) * D + c] = w[3]; }
    __syncthreads();
    unsigned* cls_cnt = (unsigned*)(p.ws + WS_CTL) + CW_CLS + l * 512;
    int* lists = (int*)(p.ws + WS_LIST); f32x2* gl = (f32x2*)(p.ws + WS_LIST + 2 * MiB);
    const float* g = p.in[I_LN1G] + l * D; const float* bt = p.in[I_LN1B] + l * D;
    f32x4 vn[4];
    { const float* h0 = hrow(p, gw);
#pragma unroll
      for (int j = 0; j < 4; ++j) vn[j] = *(const f32x4*)(h0 + 4 * lane + 256 * j); }
    int nrec = 0;
    for (int r = gw; r < TEND; r += NGW) {
        f32x4 v[4];
#pragma unroll
        for (int j = 0; j < 4; ++j) v[j] = vn[j];
        { const float* h1 = hrow(p, r + NGW < TEND ? r + NGW : r);
#pragma unroll
          for (int j = 0; j < 4; ++j) vn[j] = *(const f32x4*)(h1 + 4 * lane + 256 * j); }
        if (is_dummy(r)) {
#pragma unroll
            for (int j = 0; j < 4; ++j) v[j] = (f32x4){0.f, 0.f, 0.f, 0.f};
            store_row(p, r, v, lane, true); continue; }
        ln_wave(v, g, bt, lane);
        store_row(p, r, v, lane, false);
        float lg[16];
#pragma unroll
        for (int e = 0; e < 16; ++e) lg[e] = 0.f;
#pragma unroll
        for (int e = 0; e < 16; ++e)
#pragma unroll
            for (int j = 0; j < 4; ++j) { const f32x4 w = *(const f32x4*)(wr_s + e * D + 4 * lane + 256 * j);
                lg[e] = fmaf(v[j][0], w[0], lg[e]); lg[e] = fmaf(v[j][1], w[1], lg[e]); lg[e] = fmaf(v[j][2], w[2], lg[e]); lg[e] = fmaf(v[j][3], w[3], lg[e]); }
        float mine = 0.f;
#pragma unroll
        for (int e = 0; e < 16; ++e) { const float rs = sum16(lg[e]); mine = (lane & 15) == e ? rs : mine; }
        mine += __shfl_xor(mine, 16); mine += __shfl_xor(mine, 32);
#pragma unroll
        for (int e = 0; e < 16; ++e) lg[e] = __builtin_bit_cast(float, __builtin_amdgcn_readlane(__builtin_bit_cast(int, mine), e));
        float s[16], sel[16];
#pragma unroll
        for (int e = 0; e < 16; ++e) { s[e] = sigmoidf_(lg[e]); sel[e] = s[e] + p.in[I_BROUTER][e]; }
        int gbest = 0; float gsc = -INFINITY;
#pragma unroll
        for (int gi = 0; gi < 4; ++gi) { float m1 = -INFINITY, m2 = -INFINITY;
#pragma unroll
            for (int j = 0; j < 4; ++j) { const float x = sel[gi * 4 + j]; if (x > m1) { m2 = m1; m1 = x; } else if (x > m2) m2 = x; }
            const float sc = m1 + m2; if (sc > gsc) { gsc = sc; gbest = gi; } }
        float sg[4], sgs[4];
#pragma unroll
        for (int j = 0; j < 4; ++j) { sg[j] = gbest == 0 ? sel[j] : (gbest == 1 ? sel[4 + j] : (gbest == 2 ? sel[8 + j] : sel[12 + j])); sgs[j] = gbest == 0 ? s[j] : (gbest == 1 ? s[4 + j] : (gbest == 2 ? s[8 + j] : s[12 + j])); }
        int j1 = 0;
#pragma unroll
        for (int j = 1; j < 4; ++j) if (sg[j] > sg[j1]) j1 = j;
        int j2 = j1 == 0 ? 1 : 0;
#pragma unroll
        for (int j = 0; j < 4; ++j) if (j != j1 && j != j2 && sg[j] > sg[j2]) j2 = j;
        const int ja = j1 < j2 ? j1 : j2, jb = j1 < j2 ? j2 : j1;
        float sa_ = 0.f, sb_ = 0.f;
#pragma unroll
        for (int j = 0; j < 4; ++j) { if (j == ja) sa_ = sgs[j]; if (j == jb) sb_ = sgs[j]; }
        const float inv = 1.0f / (sa_ + sb_);
        const int cls = gbest * 6 + pair_index(ja, jb);
        if (lane == 0) { const int loc = __hip_atomic_fetch_add(lcnt + cls, 1, __ATOMIC_RELAXED, __HIP_MEMORY_SCOPE_WORKGROUP); rec[(tid >> 6) * 32 + 2 * nrec] = r; rec[(tid >> 6) * 32 + 2 * nrec + 1] = (cls << 16) | loc; gl[r] = (f32x2){sa_ * inv, sb_ * inv}; }
        ++nrec;
    }
    __syncthreads();
    if (tid < 24) lbase[tid] = (int)atomicAdd(cls_cnt + 16 * tid, (unsigned)lcnt[tid]);
    __syncthreads();
    if (lane < nrec) { const int r = rec[(tid >> 6) * 32 + 2 * lane], cl = rec[(tid >> 6) * 32 + 2 * lane + 1]; const int cls = cl >> 16; lists[(size_t)cls * T + lbase[cls] + (cl & 0xffff)] = r; }
}


constexpr size_t WS_CH1 = 655360;
constexpr int CH1_NM = 260, CH1_NW = 260, CH1_NC = 96, CH1_NL = 260, CH1_TOT = CH1_NM + CH1_NW + CH1_NC + CH1_NL;
__device__ __forceinline__ void task_signal(unsigned* c0, unsigned* c1) {
    asm volatile("s_waitcnt vmcnt(0)" ::: "memory");
    __syncthreads();
    if (otid() == 0) { __builtin_amdgcn_fence(__ATOMIC_RELEASE, "agent"); asm volatile("s_waitcnt vmcnt(0)" ::: "memory");
        __hip_atomic_fetch_add(c0, 1u, __ATOMIC_RELAXED, __HIP_MEMORY_SCOPE_AGENT); if (c1) __hip_atomic_fetch_add(c1, 1u, __ATOMIC_RELAXED, __HIP_MEMORY_SCOPE_AGENT); }
}
__device__ __forceinline__ void task_wait(unsigned* c, unsigned target) {
    if (otid() == 0) { unsigned sp = 0; while (__hip_atomic_load(c, __ATOMIC_RELAXED, __HIP_MEMORY_SCOPE_AGENT) < target && ++sp < (1u << 24)) __builtin_amdgcn_s_sleep(2);
        __builtin_amdgcn_fence(__ATOMIC_ACQUIRE, "agent"); asm volatile("s_waitcnt vmcnt(0)" ::: "memory"); }
    __syncthreads();
}
__device__ __forceinline__ bool xq_pop(unsigned* qb, int ntiles, int per_tile, int extra, int& k, volatile int* uw, int& q, int& t) {
    __syncthreads();
    if (otid() == 0) { const int home = (int)(__builtin_amdgcn_s_getreg((3 << 11) | 20) & 7u); int kk = k, qq = -1, tt = 0;
        while (kk < 8) { qq = (home + kk) & 7; tt = (int)atomicAdd(qb + 32 * qq, 1u); if (tt < per_tile * ((ntiles + 7 - qq) >> 3) + extra) break; ++kk; qq = -1; }
        uw[0] = qq; uw[1] = tt; uw[2] = kk; }
    __syncthreads();
    q = __builtin_amdgcn_readfirstlane(uw[0]); t = __builtin_amdgcn_readfirstlane(uw[1]); k = __builtin_amdgcn_readfirstlane(uw[2]);
    return q >= 0;
}
__device__ __forceinline__ void conv_expert_items(const Params& p, int l, LAS unsigned char* lds, int it0, int it1);
__device__ __forceinline__ void chain1_phase(int l, unsigned char* lds, LAS unsigned char* ldsl, unsigned long long& pacc) {
    unsigned long long pt0 = 0;
#define C1P_B(k) do { if (PROBE_PHASE == (k)) pt0 = __builtin_amdgcn_s_memrealtime(); } while (0)
#define C1P_E(k) do { if (PROBE_PHASE == (k)) pacc += __builtin_amdgcn_s_memrealtime() - pt0; } while (0)
    int staged = 0, k = 0;
    for (;;) {
        unsigned* chq = (unsigned*)(PP().ws + WS_CH1) + 1024 * l;
        int q, t; if (!xq_pop(chq + 272, 65, 12, CH1_NC / 8, k, (volatile int*)(lds + 144000), q, t)) break;
        const int np4 = 4 * ((72 - q) >> 3);
        if (t < np4) { const int pm = q + 8 * (t >> 2), pn = t & 3;
            C1P_B(50); merge_unit(l, ldsl, pm, pn, pacc);
            task_signal(chq + 64 + pm, chq + 16); C1P_E(50); staged = 0;
        } else if (t < 2 * np4) { const int u = t - np4, pm = q + 8 * (u >> 2), pn = u & 3;
            C1P_B(54); task_wait(chq + 64 + pm, 4u); C1P_E(54);
            C1P_B(51); wout_unit(l, ldsl, pm, pn);
            task_signal(chq + 192 + pm, nullptr); C1P_E(51); staged = 0;
        } else if (t < 2 * np4 + CH1_NC / 8) { const int u = q * (CH1_NC / 8) + t - 2 * np4;
            C1P_B(54); task_wait(chq + 16, (unsigned)CH1_NM); C1P_E(54);
            C1P_B(52); conv_expert_items(PP(), l, ldsl, u * 128, u * 128 + 128); C1P_E(52); staged = 0;
        } else { const int u = t - 2 * np4 - CH1_NC / 8, pm = q + 8 * (u >> 2), qr = u & 3;
            C1P_B(54); task_wait(chq + 16, (unsigned)CH1_NM);
            task_wait(chq + 192 + pm, 4u); C1P_E(54);
            C1P_B(53); ln1_rows(PP(), l, lds, pm * 256 + qr * 64, staged == 0); staged = 1; C1P_E(53);
        }
    }
}

struct ClsTab { int cnt[24]; int tile0[25]; int row0[24]; };
__device__ __forceinline__ void build_cls_table(const Params& p, int l, int* tab  ) {
    if (otid() == 0) { const unsigned* c = (const unsigned*)(p.ws + WS_CTL) + CW_CLS + l * 512; int acc = 0;
        for (int i = 0; i < 24; ++i) { const int n = (int)__hip_atomic_load(c + 16 * i, __ATOMIC_RELAXED, __HIP_MEMORY_SCOPE_AGENT); tab[i] = n; tab[24 + i] = acc; acc += (n + 255) >> 8; }
        tab[48] = acc; }
    __syncthreads();
}
__device__ __forceinline__ int find_cls(const int* tab, int tile) { int c = 0;
#pragma unroll 1
    for (int i = 1; i < 24; ++i) if (tile >= tab[24 + i]) c = i;
    return c; }
__device__ __forceinline__ void moe_a_unit(int l, LAS unsigned char* lds, const int* tab, int tile, int pn) {
    const int tid = otid();
    unsigned voffB[2]; g8::make_voffB(voffB, D * 2, true);
    {
        const int cls = find_cls(tab, tile), rt = tile - tab[24 + cls], n = tab[cls];
        int ja, jb; pair_of(cls % 6, ja, jb); const int eslot = pn >> 2, e = (cls / 6) * 4 + (eslot ? jb : ja), jblk = pn & 3;
        unsigned voffA[2][2]; { const int* lists = (const int*)(PP().ws + WS_LIST);
#pragma unroll
        for (int i = 0; i < 2; ++i) { int R, C; g8::stage_rc(tid * 16 + i * 8192, R, C);
#pragma unroll
            for (int hh = 0; hh < 2; ++hh) { const int li = rt * 256 + R + hh * 128; const int tok = li < n ? lists[(size_t)cls * T + li] : 0;
                voffA[hh][i] = (unsigned)tok * (D * 2) + (unsigned)C * 2u; } } }
        g8::Acc acc; g8::zero_acc(acc);
        const char* Bb = (const char*)(PP().ws + WS_WEXP) + ((size_t)e * 1024 + jblk * 256) * D * 2;
        const g8::KSeg s = g8::seg1((const char*)(PP().ws + WS_HB), Bb, Bb + (size_t)128 * D * 2, D / 64);
        g8::kloop<true, false>(lds, acc, s, voffA, voffB, 0);
        EPI_COORDS();
        const int* lists = (const int*)(PP().ws + WS_LIST); const f32x2* gl = (const f32x2*)(PP().ws + WS_LIST + 2 * MiB); bf16_t* ACT = (bf16_t*)(PP().ws + WS_ACT);
        int tk[2][4]; float gt[2][4];
#pragma unroll
        for (int ai = 0; ai < 2; ++ai)
#pragma unroll
            for (int m = 0; m < 4; ++m) { const int li = rt * 256 + ai * 128 + wr * 64 + m * 16 + fr; tk[ai][m] = li < n ? lists[(size_t)cls * T + li] : -1; }
#pragma unroll
        for (int ai = 0; ai < 2; ++ai)
#pragma unroll
            for (int m = 0; m < 4; ++m) { const f32x2 g2 = gl[tk[ai][m] >= 0 ? tk[ai][m] : 0]; gt[ai][m] = tk[ai][m] >= 0 ? (eslot ? g2[1] : g2[0]) : 0.f; }
#pragma unroll
        for (int ai = 0; ai < 2; ++ai)
#pragma unroll
            for (int m = 0; m < 4; ++m) { const float gate = gt[ai][m];
                const f32x4 h1a = acc[ai][0][m][0], h1b = acc[ai][0][m][1], h3a = acc[ai][1][m][0], h3b = acc[ai][1][m][1];
                float o[8];
#pragma unroll
                for (int c = 0; c < 4; ++c) { o[c] = gate * (h1a[c] * sigmoidf_(h1a[c])) * h3a[c]; o[4 + c] = gate * (h1b[c] * sigmoidf_(h1b[c])) * h3b[c]; }
                u32x4 w; w.x = pk2(o[0], o[1]); w.y = pk2(o[2], o[3]); w.z = pk2(o[4], o[5]); w.w = pk2(o[6], o[7]);
                *(u32x4*)(ACT + (size_t)(tile * 256 + ai * 128 + wr * 64 + m * 16 + fr) * D + eslot * 512 + jblk * 128 + wc * 32 + 8 * fq) = w; }
    }
}
__device__ __forceinline__ void moe_b_unit(int l, LAS unsigned char* lds, const int* tab, int tile, int pn) {
    unsigned voffA[2][2], voffB[2]; g8::make_voff_contig(voffA, D * 2); g8::make_voffB(voffB, 512 * 2, false);
    {
        const int cls = find_cls(tab, tile), rt = tile - tab[24 + cls], n = tab[cls];
        int ja, jb; pair_of(cls % 6, ja, jb); const int ea = (cls / 6) * 4 + ja, eb = (cls / 6) * 4 + jb;
        g8::Acc acc; g8::zero_acc(acc);
        const char* At = (const char*)(PP().ws + WS_ACT) + (size_t)tile * 256 * D * 2;
        const char* W2 = (const char*)(PP().ws + WS_WEXP + 32 * MiB);
        const char* Ba = W2 + ((size_t)ea * 1024 + pn * 256) * 512 * 2; const char* Bb = W2 + ((size_t)eb * 1024 + pn * 256) * 512 * 2;
        g8::KSeg s2 = g8::seg1(At, Ba, Ba + (size_t)128 * 512 * 2, 16); s2.nt0 = 8; s2.A2 = At + 1024; s2.B02 = Bb; s2.B12 = Bb + (size_t)128 * 512 * 2;
        g8::kloop<false, true>(lds, acc, s2, voffA, voffB, 128 * D * 2);
        EPI_COORDS();
        const int* lists = (const int*)(PP().ws + WS_LIST);
        const int col0 = pn * 256 + wc * 32 + 4 * fq;
        int tk[2][4];
#pragma unroll
        for (int ai = 0; ai < 2; ++ai)
#pragma unroll
            for (int m = 0; m < 4; ++m) { const int li = rt * 256 + ai * 128 + wr * 64 + m * 16 + fr; tk[ai][m] = li < n ? lists[(size_t)cls * T + li] : -1; }
#pragma unroll
        for (int ai = 0; ai < 2; ++ai) { asm volatile("" ::: "memory");
            f32x4 pre[4][2][2]; float* hr[4];
#pragma unroll
            for (int m = 0; m < 4; ++m) { hr[m] = hrow(PP(), tk[ai][m] >= 0 ? tk[ai][m] : 0) + col0;
#pragma unroll
                for (int bj = 0; bj < 2; ++bj)
#pragma unroll
                    for (int nn = 0; nn < 2; ++nn) pre[m][bj][nn] = *(const f32x4*)(hr[m] + bj * 128 + nn * 16); }
#pragma unroll
            for (int m = 0; m < 4; ++m) if (tk[ai][m] >= 0) {
#pragma unroll
                for (int bj = 0; bj < 2; ++bj)
#pragma unroll
                    for (int nn = 0; nn < 2; ++nn) *(f32x4*)(hr[m] + bj * 128 + nn * 16) = pre[m][bj][nn] * ALPHA + acc[ai][bj][m][nn]; } }
    }
}

__device__ __forceinline__ void chain2_phase(int l, unsigned char* lds, LAS unsigned char* ldsl, const int* tab) {
    const int ntiles = tab[48]; int k = 0;
    for (;;) {
        unsigned* chq = (unsigned*)(PP().ws + WS_CH1) + 1024 * l + 512;
        int q, t; if (!xq_pop(chq + 256, ntiles, 12, 0, k, (volatile int*)(lds + 144000), q, t)) break;
        const int nA = 8 * ((ntiles + 7 - q) >> 3);
        if (t < nA) { const int tile = q + 8 * (t >> 3);
            moe_a_unit(l, ldsl, tab, tile, t & 7);
            task_signal(chq + 16 + tile, nullptr);
        } else { const int u = t - nA, tile = q + 8 * (u >> 2);
            task_wait(chq + 16 + tile, 8u);
            moe_b_unit(l, ldsl, tab, tile, u & 3);
        }
    }
}
__device__ __forceinline__ void ln2_phase(const Params& p, int l) {
    const int tid = otid(), lane = tid & 63, gw = obid() * NWAVES + (tid >> 6), NGW = gridDim.x * NWAVES;
    const float* g = p.in[I_LN2G] + l * D; const float* bt = p.in[I_LN2B] + l * D;
    for (int r = gw; r < T; r += NGW) {
        f32x4 v[4];
        if (is_dummy(r)) {
#pragma unroll
            for (int j = 0; j < 4; ++j) v[j] = (f32x4){0.f, 0.f, 0.f, 0.f};
            store_row(p, r, v, lane, true); continue; }
        const float* hr = hrow(p, r);
#pragma unroll
        for (int j = 0; j < 4; ++j) v[j] = *(const f32x4*)(hr + 4 * lane + 256 * j);
        ln_wave(v, g, bt, lane);
        store_row(p, r, v, lane, false);
    }
}


#define XB_TMO      128
#define XB_XCNT(j)  (256  + 64 * (j))
#define XB_XSUB(j)  (1280 + 64 * (j))
#define XB_XGEN(j)  (2304 + 64 * (j))
#define XB_TOP      3328
#define XB_TOPGEN   3392
#define XCD_BAR_WORDS 3456
#define XB_SPIN_CAP (1u << 22)
constexpr size_t WS_BAR = 8192;
constexpr int LDS_BARST = LDS_BYTES - 16;
__device__ __forceinline__ unsigned xb_ld(unsigned* p)              { return __hip_atomic_load(p, __ATOMIC_RELAXED, __HIP_MEMORY_SCOPE_AGENT); }
__device__ __forceinline__ unsigned xb_add(unsigned* p, unsigned v) { return __hip_atomic_fetch_add(p, v, __ATOMIC_RELAXED, __HIP_MEMORY_SCOPE_AGENT); }
__device__ __forceinline__ unsigned xb_xcc_id() { return (unsigned)__builtin_amdgcn_s_getreg((3 << 11) | 20) & 0xFu; }
#define XB_SPIN(cond, bar) do { unsigned _sp = 0; while (cond) { __builtin_amdgcn_s_sleep(1); \
    if ((++_sp & 255u) == 0u) { if (xb_ld(&(bar)[XB_TMO])) break; if (_sp > XB_SPIN_CAP) { atomicAdd(&(bar)[XB_TMO], 1u); break; } } } } while (0)
__device__ __forceinline__ void xcd_barrier_complete(unsigned* bar, unsigned x, unsigned& nloc, unsigned& nx) {
    const unsigned G = gridDim.x * gridDim.y * gridDim.z;
    unsigned sum, cnt, mine, sp = 0u;
    for (;;) {
        sum = 0u; cnt = 0u; mine = 0u;
#pragma unroll
        for (unsigned j = 0; j < 16; ++j) { const unsigned c = xb_ld(&bar[XB_XCNT(j)]); sum += c; cnt += (c > 0u) ? 1u : 0u; mine = (j == x) ? c : mine; }
        if (sum == G) break;
        __builtin_amdgcn_s_sleep(1);
        if ((++sp & 255u) == 0u) { if (xb_ld(&bar[XB_TMO])) break; if (sp > XB_SPIN_CAP) { atomicAdd(&bar[XB_TMO], 1u); break; } }
    }
    nloc = mine > 0u ? mine : 1u; nx = cnt > 0u ? cnt : 1u;
}
__device__ __forceinline__ void xcd_barrier(unsigned* bar, volatile LAS unsigned* st) {
    asm volatile("s_waitcnt vmcnt(0)" ::: "memory");
    __syncthreads();
    if (threadIdx.x == 0) {
        __builtin_amdgcn_s_waitcnt(0);
        const unsigned x = xb_xcc_id();
        unsigned nloc = st[0], nx = st[1];
        if (nloc == 0u) { xcd_barrier_complete(bar, x, nloc, nx); st[0] = nloc; st[1] = nx; }
        const unsigned old = xb_add(&bar[XB_XSUB(x)], 1u);
        const unsigned gen = old / nloc;
        if (old + 1u == (gen + 1u) * nloc) {
            __builtin_amdgcn_fence(__ATOMIC_RELEASE, "agent");
            asm volatile("s_waitcnt vmcnt(0)" ::: "memory");
            const unsigned og = xb_add(&bar[XB_TOP], 1u);
            const unsigned tg = og / nx;
            if (og + 1u == (tg + 1u) * nx) xb_add(&bar[XB_TOPGEN], 1u);
            else XB_SPIN(xb_ld(&bar[XB_TOPGEN]) == tg, bar);
            __builtin_amdgcn_fence(__ATOMIC_ACQUIRE, "agent");
            xb_add(&bar[XB_XGEN(x)], 1u);
            asm volatile("s_waitcnt vmcnt(0)" ::: "memory");
        } else {
            XB_SPIN(xb_ld(&bar[XB_XGEN(x)]) == gen, bar);
            __builtin_amdgcn_fence(__ATOMIC_ACQUIRE, "agent");
            asm volatile("s_waitcnt vmcnt(0)" ::: "memory");
        }
    }
    __syncthreads();
}

__global__ void __launch_bounds__(NTHREADS, 2) mega(Params p_unused) {
    extern __shared__ __attribute__((aligned(16))) unsigned char lds[];
    cg::grid_group grid = cg::this_grid();
    volatile LAS unsigned* barst = (volatile LAS unsigned*)((LAS unsigned char*)lds + LDS_BARST);
    { unsigned* bar0 = (unsigned*)(PP().ws + WS_BAR);
      if (threadIdx.x == 0) { barst[0] = 0u; barst[1] = 0u; (void)xb_add(bar0 + XB_XCNT(xb_xcc_id()), 1u); } }
    __syncthreads();
#define GBAR() xcd_barrier((unsigned*)(PP().ws + WS_BAR), barst)
    unsigned long long pr_t0 = 0, pr_acc = 0;
#define PH_BEGIN(k) do { if (PROBE_PHASE == (k)) pr_t0 = __builtin_amdgcn_s_memrealtime(); } while (0)
#define PH_END(k) do { if (PROBE_PHASE == (k)) pr_acc += __builtin_amdgcn_s_memrealtime() - pr_t0; } while (0)
#define LDSG() (lds + ozero())
#define LDSL() ((LAS unsigned char*)lds)

    PH_BEGIN(0);
    conv_small_weights(PP(), LDSL());
    ln_in_phase(PP());
    if (gridDim.y == 0x7fffffffu) grid.sync();
    GBAR();
    PH_END(0);
#pragma unroll 1
    for (int l = 0; l < DEPTH; ++l) {
        PH_BEGIN(1);
        inproj_phase(PP(), l, LDSL());
        GBAR();
        PH_END(1); PH_BEGIN(2);
        {
            unsigned* qctr = (unsigned*)(PP().ws + WS_CTL) + CW_R1Q + 2 * l;
            volatile int* uw = (volatile int*)(LDSG() + AT_UNIT);
            int ndone = 0;
            constexpr int QEND = INP_TAIL + BATCH * NCH * 8;
#define MIX_POP(dst) do { __syncthreads(); if (otid() == 0) *uw = (int)atomicAdd(qctr, 1u); __syncthreads(); dst = __builtin_amdgcn_readfirstlane(*uw); } while (0)
            int u; MIX_POP(u);
            while (u < INP_TAIL) { inproj_tail_unit(l, LDSL(), u); MIX_POP(u); }
            if (u < QEND) {
                R1PF pf; r1_load_rows((const bf16_t*)(PP().ws + WS_UAR), u - INP_TAIL, otid(), pf);
                do {
                    int un; MIX_POP(un);
                    if (PROBE_PHASE == 30) pr_t0 = __builtin_amdgcn_s_memrealtime();
                    rwkv_prep_unit(PP(), l, u - INP_TAIL, LDSG(), pr_acc, pf, un < QEND ? un - INP_TAIL : -1); ++ndone;
                    if (PROBE_PHASE == 30) pr_acc += __builtin_amdgcn_s_memrealtime() - pr_t0;
                    u = un;
                } while (u < QEND);
            }
#undef MIX_POP
            asm volatile("s_waitcnt vmcnt(0)" ::: "memory");
            __syncthreads();
            if (otid() == 0 && ndone > 0) { __builtin_amdgcn_fence(__ATOMIC_RELEASE, "agent"); asm volatile("s_waitcnt vmcnt(0)" ::: "memory"); __hip_atomic_fetch_add(qctr + 1, (unsigned)ndone, __ATOMIC_RELAXED, __HIP_MEMORY_SCOPE_AGENT); }
            const int bid = obid();
            if (bid < 32) {
                if (otid() == 0) { unsigned sp = 0; while (__hip_atomic_load(qctr + 1, __ATOMIC_RELAXED, __HIP_MEMORY_SCOPE_AGENT) < (unsigned)(BATCH * NCH * 8) && ++sp < (1u << 26)) __builtin_amdgcn_s_sleep(4);
                    __builtin_amdgcn_fence(__ATOMIC_ACQUIRE, "agent"); asm volatile("s_waitcnt vmcnt(0)" ::: "memory"); }
                __syncthreads();
                rwkv_scan(PP(), l, bid, LDSG());
            }
            attn_phase(PP(), l, LDSG(), pr_acc);
        }
        GBAR();
        PH_END(2); PH_BEGIN(4);
        chain1_phase(l, LDSG(), LDSL(), pr_acc);
        GBAR();
        PH_END(4); PH_BEGIN(8);
        { int toff = 140 * 1024; asm volatile("" : "+s"(toff)); int* tab = (int*)(lds + toff);
          build_cls_table(PP(), l, tab);
          chain2_phase(l, LDSG(), LDSL(), tab); }
        GBAR();
        PH_END(8); PH_BEGIN(9);
        ln2_phase(PP(), l);
        if (l + 1 < DEPTH) GBAR();
        PH_END(9);
    }
    if (PROBE_PHASE >= 0 && blockIdx.x == PROBE_BLOCK && threadIdx.x == 0) { const unsigned long long t = __builtin_amdgcn_s_memrealtime(); while (__builtin_amdgcn_s_memrealtime() - t < pr_acc) __builtin_amdgcn_s_sleep(8); }
}

extern "C" void kernel_launch(void* const* d_in, const int* in_sizes, int n_in, void* d_out, int out_size,
                              void* d_ws, size_t ws_size, hipStream_t stream) {
    static int grid_blocks = 0;
    if (grid_blocks == 0) {
        int dev = 0, cus = 0, per_cu = 0;
        if (n_in != 29 || ws_size < WS_END || out_size != BATCH * SEQ * D) { fprintf(stderr, "kernel_launch: unexpected problem (n_in %d, ws %zu, out %d)\n", n_in, ws_size, out_size); grid_blocks = -1; return; }
        (void)hipGetDevice(&dev);
        (void)hipDeviceGetAttribute(&cus, hipDeviceAttributeMultiprocessorCount, dev);
        (void)hipFuncSetAttribute((const void*)mega, hipFuncAttributeMaxDynamicSharedMemorySize, LDS_BYTES);
        (void)hipOccupancyMaxActiveBlocksPerMultiprocessor(&per_cu, (const void*)mega, NTHREADS, LDS_BYTES);
        if (per_cu < 1) { fprintf(stderr, "occupancy query returned %d\n", per_cu); grid_blocks = -1; return; }
        grid_blocks = cus;
    }
    if (grid_blocks < 0) return;
    (void)hipMemsetAsync((char*)d_ws + WS_CTL, 0, 32768, stream);
    (void)hipMemsetAsync((char*)d_ws + WS_CH1, 0, 16384, stream);
    Params p{};
    for (int i = 0; i < 29; ++i) p.in[i] = (const float*)d_in[i];
    p.out = (float*)d_out; p.ws = (unsigned char*)d_ws;
    void* args[] = {&p};
    hipError_t e = hipLaunchCooperativeKernel((const void*)mega, dim3(grid_blocks), dim3(NTHREADS), args, LDS_BYTES, stream);
    if (e != hipSuccess) fprintf(stderr, "cooperative launch failed: %s (grid %d)\n", hipGetErrorString(e), grid_blocks);
}
```
